# Optimizing an MI355X kernel written in HIP

```python
import jax
import jax.numpy as jnp
from jax import lax
import numpy as np

D_MODEL = 1024
BATCH = 8
SEQ = 4096
DEPTH = 2

CTX_LEN = 256
GRID_W = 64
EPS = 1e-6
N_MOD = 6

N_HEADS = 8
N_KV_HEADS = 2
GQA_GROUP = N_HEADS // N_KV_HEADS
HEAD_DIM = 64
WINDOW = 128
ATTN_BLOCK = 128
ATTN_W = N_HEADS * HEAD_DIM
KV_W = N_KV_HEADS * HEAD_DIM
ROPE_BASE = 10000.0
ROPE_FREQS = HEAD_DIM // 4

POOL_SIZES = (2, 4, 8, 16)
POOL_GROUP_W = 64
POOL_W = len(POOL_SIZES) * POOL_GROUP_W

SGU_CHUNK = 128
SGU_GROUPS = 4
SGU_W = 256
SGU_GROUP_W = SGU_W // SGU_GROUPS

N_BRANCH = 3
Q_OFF = 0
K_OFF = Q_OFF + ATTN_W
V_OFF = K_OFF + KV_W
POOL_OFF = V_OFF + KV_W
SGU_U_OFF = POOL_OFF + POOL_W
SGU_V_OFF = SGU_U_OFF + SGU_W
GATE_OFF = SGU_V_OFF + SGU_W
IN_W = GATE_OFF + N_BRANCH * D_MODEL

PEER_HEADS = 8
PEER_KEYS = 128
PEER_EXPERTS = PEER_KEYS * PEER_KEYS
PEER_KEY_DIM = 256
PEER_HALF = PEER_KEY_DIM // 2
PEER_TOPK = 16
PEER_BLOCK = 128

kernel_name = "hybrid_dit_window_attn_pool_sgu_peer"


def rms_norm(x, g):
    xf = x.astype(jnp.float32)
    y = xf * lax.rsqrt(jnp.mean(xf * xf, axis=-1, keepdims=True) + EPS)
    return (y * g.astype(jnp.float32)).astype(x.dtype)


def adaln_params(cond, w_mod, b_mod):
    m = jax.nn.silu(cond) @ w_mod + b_mod
    return jnp.split(m[:, None, :], N_MOD, axis=-1)


def modulate(x, g, shift, scale):
    return rms_norm(x, g) * (1.0 + scale) + shift


def axial_rope(length):
    rows = length // GRID_W
    row = jnp.repeat(jnp.arange(rows, dtype=jnp.float32), GRID_W)
    col = jnp.tile(jnp.arange(GRID_W, dtype=jnp.float32), rows)
    inv = ROPE_BASE ** (-jnp.arange(ROPE_FREQS, dtype=jnp.float32) / ROPE_FREQS)
    ang = jnp.stack([row[:, None] * inv, col[:, None] * inv], axis=1)
    return jnp.cos(ang), jnp.sin(ang)


def apply_rope(x, cos, sin):
    b, l, h, _ = x.shape
    xs = x.astype(jnp.float32).reshape(b, l, h, 2, 2, ROPE_FREQS)
    x1, x2 = xs[..., 0, :], xs[..., 1, :]
    c, s = cos[None, :, None], sin[None, :, None]
    out = jnp.stack([x1 * c - x2 * s, x2 * c + x1 * s], axis=-2)
    return out.reshape(b, l, h, HEAD_DIM).astype(x.dtype)


def attention_latent(q, k, v, k_ctx, v_ctx, sink):
    b, l = q.shape[:2]
    n_blocks = l // ATTN_BLOCK
    span = ATTN_BLOCK + 2 * WINDOW
    pad = ((0, 0), (WINDOW, WINDOW), (0, 0), (0, 0))
    kp, vp = jnp.pad(k, pad), jnp.pad(v, pad)
    qb = q.reshape(b, n_blocks, ATTN_BLOCK, N_KV_HEADS, GQA_GROUP, HEAD_DIM)
    qb = jnp.moveaxis(qb, 1, 0)
    scale = HEAD_DIM ** -0.5
    qi = jnp.arange(ATTN_BLOCK)[:, None]
    kj = jnp.arange(span)[None, :]
    in_window = jnp.abs(kj - WINDOW - qi) <= WINDOW
    sink_logit = jnp.broadcast_to(
        sink.astype(jnp.float32).reshape(N_KV_HEADS, GQA_GROUP)[None, :, :, None, None],
        (b, N_KV_HEADS, GQA_GROUP, ATTN_BLOCK, 1))
    n_ctx = k_ctx.shape[1]

    def one_block(args):
        n, q_blk = args
        start = n * ATTN_BLOCK
        k_win = lax.dynamic_slice_in_dim(kp, start, span, axis=1)
        v_win = lax.dynamic_slice_in_dim(vp, start, span, axis=1)
        kpos = start - WINDOW + kj
        valid = in_window & (kpos >= 0) & (kpos < l)
        s_win = jnp.einsum("bqhgd,bkhd->bhgqk", q_blk, k_win, preferred_element_type=jnp.float32) * scale
        s_win = jnp.where(valid, s_win, -jnp.inf)
        s_ctx = jnp.einsum("bqhgd,bkhd->bhgqk", q_blk, k_ctx, preferred_element_type=jnp.float32) * scale
        p = jax.nn.softmax(jnp.concatenate([s_win, s_ctx, sink_logit], axis=-1), axis=-1)
        o = jnp.einsum("bhgqk,bkhd->bqhgd", p[..., :span].astype(v.dtype), v_win)
        o = o + jnp.einsum("bhgqk,bkhd->bqhgd", p[..., span:span + n_ctx].astype(v.dtype), v_ctx)
        return o

    out = lax.map(one_block, (jnp.arange(n_blocks), qb))
    return jnp.moveaxis(out, 0, 1).reshape(b, l, ATTN_W)


def attention_context(q, k, v, sink):
    b, n_ctx = q.shape[:2]
    qg = q.reshape(b, n_ctx, N_KV_HEADS, GQA_GROUP, HEAD_DIM)
    s = jnp.einsum("bqhgd,bkhd->bhgqk", qg, k, preferred_element_type=jnp.float32) * HEAD_DIM ** -0.5
    sink_logit = jnp.broadcast_to(
        sink.astype(jnp.float32).reshape(N_KV_HEADS, GQA_GROUP)[None, :, :, None, None],
        (b, N_KV_HEADS, GQA_GROUP, n_ctx, 1))
    p = jax.nn.softmax(jnp.concatenate([s, sink_logit], axis=-1), axis=-1)
    o = jnp.einsum("bhgqk,bkhd->bqhgd", p[..., :n_ctx].astype(v.dtype), v)
    return o.reshape(b, n_ctx, ATTN_W)


def pool_mixer(z, pool_w, pool_scale):
    b, l, _ = z.shape
    zf = z.astype(jnp.float32)
    cs = jnp.pad(jnp.cumsum(zf, axis=1), ((0, 0), (1, 0), (0, 0)))
    t = jnp.arange(l)
    groups = []
    for g, size in enumerate(POOL_SIZES):
        lo = jnp.clip(t - size // 2, 0, l)
        hi = jnp.clip(t + size // 2, 0, l)
        sl = slice(g * POOL_GROUP_W, (g + 1) * POOL_GROUP_W)
        csg = cs[..., sl]
        mean = (csg[:, hi] - csg[:, lo]) / (hi - lo).astype(jnp.float32)[None, :, None]
        groups.append(mean - zf[..., sl])
    d = jnp.stack(groups, axis=2).astype(z.dtype)
    y = jnp.einsum("blgc,gce->blge", d, pool_w).reshape(b, l, POOL_W)
    return y * pool_scale


def sgu_mixer(u, v, sgu_w, sgu_b):
    b, l, _ = u.shape
    n_chunks = l // SGU_CHUNK
    vf = v.astype(jnp.float32)
    vn = (vf * lax.rsqrt(jnp.mean(vf * vf, axis=-1, keepdims=True) + EPS)).astype(v.dtype)
    vc = vn.reshape(b, n_chunks, SGU_CHUNK, SGU_GROUPS, SGU_GROUP_W)
    mixed = jnp.einsum("hpq,bnqhc->bnphc", sgu_w, vc) + sgu_b.T[None, None, :, :, None]
    return u * mixed.reshape(b, l, SGU_W)


def merge_branches(proj, y_attn, pool_w, pool_scale, sgu_w, sgu_b, w_br_attn, w_br_pool, w_br_sgu, w_out):
    y_pool = pool_mixer(proj[..., POOL_OFF:SGU_U_OFF], pool_w, pool_scale)
    y_sgu = sgu_mixer(jax.nn.gelu(proj[..., SGU_U_OFF:SGU_V_OFF]),
                      jax.nn.gelu(proj[..., SGU_V_OFF:GATE_OFF]), sgu_w, sgu_b)
    gates = jax.nn.sigmoid(proj[..., GATE_OFF:].reshape(*proj.shape[:-1], N_BRANCH, D_MODEL))
    merged = (gates[..., 0, :] * (y_attn @ w_br_attn)
              + gates[..., 1, :] * (y_pool @ w_br_pool)
              + gates[..., 2, :] * (y_sgu @ w_br_sgu))
    return merged @ w_out


def peer_ffn(h, w_q, subkeys, u_tab, v_tab):
    t = h.shape[0]
    blocks = h.reshape(t // PEER_BLOCK, PEER_BLOCK, D_MODEL)

    def one_block(xb):
        q = (xb @ w_q).reshape(PEER_BLOCK, PEER_HEADS, 2, PEER_HALF)
        s = jnp.einsum("thpd,hpkd->thpk", q, subkeys, preferred_element_type=jnp.float32)
        sv, si = lax.top_k(s, PEER_TOPK)
        n_cand = PEER_TOPK * PEER_TOPK
        cand_s = (sv[..., 0, :, None] + sv[..., 1, None, :]).reshape(PEER_BLOCK, PEER_HEADS, n_cand)
        cand_e = (si[..., 0, :, None] * PEER_KEYS + si[..., 1, None, :]).reshape(PEER_BLOCK, PEER_HEADS, n_cand)
        top_s, top_pos = lax.top_k(cand_s, PEER_TOPK)
        experts = jnp.take_along_axis(cand_e, top_pos, axis=-1)
        gate = jax.nn.softmax(top_s, axis=-1)
        u_sel = u_tab[experts]
        v_sel = v_tab[experts]
        act = jax.nn.gelu(jnp.einsum("td,thkd->thk", xb, u_sel, preferred_element_type=jnp.float32))
        return jnp.einsum("thk,thkd->td", (gate * act).astype(xb.dtype), v_sel)

    return lax.map(one_block, blocks).reshape(t, D_MODEL)


def setup_inputs(seed: int = 0) -> dict:
    key = jax.random.key(seed)
    ks = jax.random.split(key, 24)
    nrm = jax.random.normal
    f32 = jnp.float32
    L, D = DEPTH, D_MODEL
    return {
        "x": nrm(ks[0], (BATCH, SEQ, D), f32),
        "c": nrm(ks[1], (BATCH, D), f32),
        "ctx": nrm(ks[2], (BATCH, CTX_LEN, D), f32),
        "c_ctx": nrm(ks[3], (D,), f32),
        "w_mod": nrm(ks[4], (L, D, N_MOD * D), f32) * (0.5 * D ** -0.5),
        "b_mod": 0.02 * nrm(ks[5], (L, N_MOD * D), f32),
        "g_mix": 1.0 + 0.02 * nrm(ks[6], (L, D), f32),
        "g_ffn": 1.0 + 0.02 * nrm(ks[7], (L, D), f32),
        "w_in": nrm(ks[8], (L, D, IN_W), f32) * D ** -0.5,
        "attn_sink": 0.5 * nrm(ks[9], (L, N_HEADS), f32),
        "pool_w": nrm(ks[10], (L, len(POOL_SIZES), POOL_GROUP_W, POOL_GROUP_W), f32) * POOL_GROUP_W ** -0.5,
        "pool_scale": 1.0 + 0.02 * nrm(ks[11], (L, POOL_W), f32),
        "sgu_w": nrm(ks[12], (L, SGU_GROUPS, SGU_CHUNK, SGU_CHUNK), f32) * SGU_CHUNK ** -0.5,
        "sgu_b": 1.0 + 0.02 * nrm(ks[13], (L, SGU_GROUPS, SGU_CHUNK), f32),
        "w_br_attn": nrm(ks[14], (L, ATTN_W, D), f32) * ATTN_W ** -0.5,
        "w_br_pool": nrm(ks[15], (L, POOL_W, D), f32) * POOL_W ** -0.5,
        "w_br_sgu": nrm(ks[16], (L, SGU_W, D), f32) * SGU_W ** -0.5,
        "w_out": nrm(ks[17], (L, D, D), f32) * D ** -0.5,
        "peer_wq": nrm(ks[18], (L, D, PEER_HEADS * PEER_KEY_DIM), f32) * D ** -0.5,
        "peer_subkeys": nrm(ks[19], (L, PEER_HEADS, 2, PEER_KEYS, PEER_HALF), f32) * PEER_HALF ** -0.5,
        "peer_u": nrm(ks[20], (L, PEER_EXPERTS, D), f32) * D ** -0.5,
        "peer_v": 0.5 * nrm(ks[21], (L, PEER_EXPERTS, D), f32),
        "g_final": 1.0 + 0.02 * nrm(ks[22], (D,), f32),
    }


def reference(x, c, ctx, c_ctx, w_mod, b_mod, g_mix, g_ffn, w_in, attn_sink, pool_w, pool_scale,
              sgu_w, sgu_b, w_br_attn, w_br_pool, w_br_sgu, w_out, peer_wq, peer_subkeys,
              peer_u, peer_v, g_final):
    b, l, _ = x.shape
    n_ctx = ctx.shape[1]
    cos, sin = axial_rope(l)
    xc = ctx
    for layer in range(DEPTH):
        last = layer == DEPTH - 1
        sh1, sc1, gt1, sh2, sc2, gt2 = adaln_params(c, w_mod[layer], b_mod[layer])
        csh1, csc1, cgt1, csh2, csc2, cgt2 = adaln_params(c_ctx[None], w_mod[layer], b_mod[layer])

        h = modulate(x, g_mix[layer], sh1, sc1)
        hc = modulate(xc, g_mix[layer], csh1, csc1)
        proj = h @ w_in[layer]
        if last:
            kv_c = hc @ w_in[layer][:, K_OFF:POOL_OFF]
        else:
            proj_c = hc @ w_in[layer]
            kv_c = proj_c[..., K_OFF:POOL_OFF]
        k_c = kv_c[..., :KV_W].reshape(b, n_ctx, N_KV_HEADS, HEAD_DIM)
        v_c = kv_c[..., KV_W:].reshape(b, n_ctx, N_KV_HEADS, HEAD_DIM)

        q = apply_rope(proj[..., Q_OFF:K_OFF].reshape(b, l, N_HEADS, HEAD_DIM), cos, sin)
        k = apply_rope(proj[..., K_OFF:V_OFF].reshape(b, l, N_KV_HEADS, HEAD_DIM), cos, sin)
        v = proj[..., V_OFF:POOL_OFF].reshape(b, l, N_KV_HEADS, HEAD_DIM)
        y_attn = attention_latent(q, k, v, k_c, v_c, attn_sink[layer])
        x = x + gt1 * merge_branches(proj, y_attn, pool_w[layer], pool_scale[layer], sgu_w[layer],
                                     sgu_b[layer], w_br_attn[layer], w_br_pool[layer],
                                     w_br_sgu[layer], w_out[layer])
        if not last:
            q_c = proj_c[..., Q_OFF:K_OFF].reshape(b, n_ctx, N_HEADS, HEAD_DIM)
            y_attn_c = attention_context(q_c, k_c, v_c, attn_sink[layer])
            xc = xc + cgt1 * merge_branches(proj_c, y_attn_c, pool_w[layer], pool_scale[layer],
                                            sgu_w[layer], sgu_b[layer], w_br_attn[layer],
                                            w_br_pool[layer], w_br_sgu[layer], w_out[layer])

        h = modulate(x, g_ffn[layer], sh2, sc2)
        x = x + gt2 * peer_ffn(h.reshape(b * l, D_MODEL), peer_wq[layer], peer_subkeys[layer],
                               peer_u[layer], peer_v[layer]).reshape(b, l, D_MODEL)
        if not last:
            hc = modulate(xc, g_ffn[layer], csh2, csc2)
            xc = xc + cgt2 * peer_ffn(hc.reshape(b * n_ctx, D_MODEL), peer_wq[layer], peer_subkeys[layer],
                                      peer_u[layer], peer_v[layer]).reshape(b, n_ctx, D_MODEL)
    return rms_norm(x, g_final)
```

```cpp
#include <hip/hip_runtime.h>
#include <hip/hip_cooperative_groups.h>
#include <stdint.h>
#include <stdio.h>
namespace cg = cooperative_groups;

#ifndef MK_SINGLE
#define MK_SINGLE 0
#endif

#define LAS __attribute__((address_space(3)))
typedef unsigned short bf16_t;
typedef short bf16x8 __attribute__((ext_vector_type(8)));
typedef short s16x4 __attribute__((ext_vector_type(4)));
typedef float f32x4 __attribute__((ext_vector_type(4)));
typedef float f32x2 __attribute__((ext_vector_type(2)));
typedef float f32x16 __attribute__((ext_vector_type(16)));
typedef unsigned u32x4 __attribute__((ext_vector_type(4)));
typedef unsigned u32x2 __attribute__((ext_vector_type(2)));
typedef __bf16 bf16x2_t __attribute__((ext_vector_type(2)));
#define DI __device__ __forceinline__
#define MFMA32(a, b, c) __builtin_amdgcn_mfma_f32_32x32x16_bf16((a), (b), (c), 0, 0, 0)

constexpr int D = 1024, NB = 8, SEQ = 4096, NCTX = 256, DEPTH = 2;
constexpr int TL = NB * SEQ, TC = NB * NCTX, T = TL + TC;
constexpr int INW = 4608, NMOD = 6 * D, PW = 1536;
constexpr int QOFF = 0, KOFF = 512, VOFF = 640, POOLOFF = 768, SUOFF = 1024, SVOFF = 1280, GATEOFF = 1536;
constexpr int NEXP = 16384;
constexpr float EPS = 1e-6f;
constexpr float LOG2E = 1.4426950408889634f;
constexpr float QSCALE = 0.125f * LOG2E;

constexpr size_t MiB = 1u << 20;
constexpr size_t WS_CTL = 0, WS_MOD = 1 * MiB, CTL_ZERO_BYTES = 2 * MiB;
constexpr size_t WS_ROPE = 2 * MiB, WS_SGUW = 2 * MiB + 65536;
constexpr size_t WS_WIN = 4 * MiB, WS_WBR = 22 * MiB, WS_WOUT = 26 * MiB, WS_WFOLD = 30 * MiB;
constexpr size_t WS_XCTX = 38 * MiB, WS_UTAB = 46 * MiB, WS_VTAB = 78 * MiB;
constexpr size_t WS_IDX = 110 * MiB, WS_GW = 120 * MiB;
constexpr size_t WS_H = 142 * MiB;
constexpr size_t WS_P = 210 * MiB, WS_Y = 312 * MiB, WS_MERGED = 380 * MiB, WS_VT = 448 * MiB, WS_VTC = 456 * MiB, WS_VST = 460 * MiB;
constexpr size_t WS_ST = 210 * MiB;
constexpr size_t WS_END = 512 * MiB;
static_assert(WS_ST + (size_t)2048 * T * 4 <= WS_END, "ST fits");
static_assert(WS_VST + (size_t)272 * 256 * 128 * 2 <= WS_END, "VsT fits");
static_assert(WS_H + (size_t)T * D * 2 <= WS_P, "H fits");
static_assert(WS_P + (size_t)T * PW * 2 <= WS_Y && WS_Y + (size_t)T * D * 2 <= WS_MERGED && WS_MERGED + (size_t)T * D * 2 <= WS_VT, "P/Y/MERGED fit");
static_assert(WS_IDX + (size_t)T * 128 * 2 <= WS_GW && WS_GW + (size_t)T * 128 * 4 <= WS_H, "idx/gw fit");

constexpr int LDS_BYTES = 147456;
constexpr int NTHREADS = 512, NWAVES = 8;

struct Params {
    const float *x, *c, *ctx, *c_ctx, *w_mod, *b_mod, *g_mix, *g_ffn, *w_in, *attn_sink, *pool_w, *pool_scale, *sgu_w, *sgu_b,
        *w_br_attn, *w_br_pool, *w_br_sgu, *w_out, *peer_wq, *peer_subkeys, *peer_u, *peer_v, *g_final;
    float* out; unsigned char* ws;
    int ph_lo, ph_hi;
};

DI unsigned f2bf(float f) { unsigned u = __builtin_bit_cast(unsigned, f); return (u + 0x7fffu + ((u >> 16) & 1u)) >> 16; }
DI unsigned pk2(float lo, float hi) { return f2bf(lo) | (f2bf(hi) << 16); }
DI float bf2f(unsigned short u) { return __builtin_bit_cast(float, (unsigned)u << 16); }
DI float bflo(unsigned w) { return __builtin_bit_cast(float, w << 16); }
DI float bfhi(unsigned w) { return __builtin_bit_cast(float, w & 0xffff0000u); }
DI int crow(int reg, int h) { return (reg & 3) + 8 * (reg >> 2) + 4 * h; }
DI float wave_sum(float v) {
#pragma unroll
    for (int o = 1; o < 64; o <<= 1) v += __shfl_xor(v, o);
    return v;
}
DI float sigmoidf_(float x) { return 1.0f / (1.0f + __expf(-x)); }
DI float gelu_tanh(float x) { const float u = 0.7978845608028654f * (x + 0.044715f * x * x * x); return x / (1.0f + __expf(-2.0f * u)); }
DI float silu_(float x) { return x / (1.0f + __expf(-x)); }

struct Frame {
    int tid, lane, wave, gw, ngw, gtid, ngt;
    LAS unsigned char* lds;
};

template <int NM, int NN>
DI void wave_gemm(const bf16_t* __restrict__ A, int lda, const bf16_t* __restrict__ Bt, int ldb, int K, int m0, int n0, f32x16 (&acc)[NM][NN], int lane) {
    const int r = lane & 31, h = lane >> 5;
    const bf16_t* ap = A + (size_t)(m0 + r) * lda + 8 * h;
    const bf16_t* bp = Bt + (size_t)(n0 + r) * ldb + 8 * h;
    for (int k0 = 0; k0 < K; k0 += 16) {
        bf16x8 a[NM], b[NN];
#pragma unroll
        for (int i = 0; i < NM; ++i) a[i] = *(const bf16x8*)(ap + (size_t)(32 * i) * lda + k0);
#pragma unroll
        for (int j = 0; j < NN; ++j) b[j] = *(const bf16x8*)(bp + (size_t)(32 * j) * ldb + k0);
#pragma unroll
        for (int i = 0; i < NM; ++i)
#pragma unroll
            for (int j = 0; j < NN; ++j) acc[i][j] = MFMA32(a[i], b[j], acc[i][j]);
    }
}
template <int NM, int NN> DI void zero_acc(f32x16 (&acc)[NM][NN]) {
#pragma unroll
    for (int i = 0; i < NM; ++i)
#pragma unroll
        for (int j = 0; j < NN; ++j)
#pragma unroll
            for (int r = 0; r < 16; ++r) acc[i][j][r] = 0.f;
}

DI void transpose_item(const float* W, int K, int N, bf16_t* WT, int ldd, int row_off, int col_off, LAS float* scr, int item, int lane) {
    const int nblk = N / 32, kb = item / nblk, nb = item % nblk, k0 = 64 * kb, n0 = 32 * nb;
#pragma unroll 8
    for (int i = 0; i < 32; ++i) { const int kk = 2 * i + (lane >> 5); scr[kk * 33 + (lane & 31)] = W[(size_t)(k0 + kk) * N + n0 + (lane & 31)]; }
    asm volatile("s_waitcnt lgkmcnt(0)" ::: "memory");
    const int c = lane & 7;
#pragma unroll
    for (int j = 0; j < 4; ++j) { const int n = (lane >> 3) + 8 * j; const LAS float* s = scr + (8 * c) * 33 + n;
        u32x4 o; o.x = pk2(s[0 * 33], s[1 * 33]); o.y = pk2(s[2 * 33], s[3 * 33]); o.z = pk2(s[4 * 33], s[5 * 33]); o.w = pk2(s[6 * 33], s[7 * 33]);
        *(u32x4*)(WT + (size_t)(row_off + n0 + n) * ldd + col_off + k0 + 8 * c) = o; }
    asm volatile("s_waitcnt lgkmcnt(0)" ::: "memory");
}

DI void convert_tables(const Params& p, const Frame& F, int layer) {
    const size_t n4 = (size_t)NEXP * D / 4;
    const f32x4* su = (const f32x4*)(p.peer_u + (size_t)layer * NEXP * D);
    const f32x4* sv = (const f32x4*)(p.peer_v + (size_t)layer * NEXP * D);
    u32x2* du = (u32x2*)(p.ws + WS_UTAB); u32x2* dv = (u32x2*)(p.ws + WS_VTAB);
    for (size_t i = F.gtid; i < n4; i += F.ngt) {
        const f32x4 a = su[i], b = sv[i];
        u32x2 oa, ob; oa.x = pk2(a.x, a.y); oa.y = pk2(a.z, a.w); ob.x = pk2(b.x, b.y); ob.y = pk2(b.z, b.w);
        du[i] = oa; dv[i] = ob;
    }
}

DI void phase_prep(const Params& p, const Frame& F) {
    unsigned char* ws = p.ws;
    {
        LAS float* wq = (LAS float*)F.lds;
        for (int it = blockIdx.x; it < 2 * 16 * 16; it += gridDim.x) {
            const int cc = it & 15, hp = (it >> 4) & 15, l = it >> 8;
            const float* src = p.peer_wq + (size_t)l * D * 2048 + hp * 128;
            __syncthreads();
            for (int e = F.tid; e < 64 * 128; e += NTHREADS) { const int ci = e >> 7, d = e & 127; wq[d * 65 + ci] = src[(size_t)(cc * 64 + ci) * 2048 + d]; }
            __syncthreads();
            const int ci = F.tid & 63, kg = F.tid >> 6;
            const float* sk = p.peer_subkeys + ((size_t)(l * 16 + hp) * 128 + 16 * kg) * 128;
            float acc[16];
#pragma unroll
            for (int k = 0; k < 16; ++k) acc[k] = 0.f;
            for (int d = 0; d < 128; ++d) { const float w = wq[d * 65 + ci];
#pragma unroll
                for (int k = 0; k < 16; ++k) acc[k] += w * sk[k * 128 + d]; }
            bf16_t* dst = (bf16_t*)(ws + WS_WFOLD) + ((size_t)l * 2048 + hp * 128 + 16 * kg) * D + cc * 64 + ci;
#pragma unroll
            for (int k = 0; k < 16; ++k) dst[(size_t)k * D] = (bf16_t)f2bf(acc[k]);
        }
        __syncthreads();
    }
    {
        LAS float* scr = (LAS float*)(F.lds + F.wave * 16384);
        constexpr int I_IN = (D / 64) * (INW / 32), I_BA = (512 / 64) * (D / 32), I_BS = (256 / 64) * (D / 32), I_O = (D / 64) * (D / 32);
        constexpr int PER_L = I_IN + I_BA + I_BS + I_O;
        for (int it = F.gw; it < 2 * PER_L; it += F.ngw) {
            const int l = it / PER_L; int r = it % PER_L;
            if (r < I_IN) { transpose_item(p.w_in + (size_t)l * D * INW, D, INW, (bf16_t*)(ws + WS_WIN) + (size_t)l * INW * D, D, 0, 0, scr, r, F.lane); continue; } r -= I_IN;
            if (r < I_BA) { transpose_item(p.w_br_attn + (size_t)l * 512 * D, 512, D, (bf16_t*)(ws + WS_WBR) + (size_t)l * D * D, D, 0, 0, scr, r, F.lane); continue; } r -= I_BA;
            if (r < I_BS) { transpose_item(p.w_br_sgu + (size_t)l * 256 * D, 256, D, (bf16_t*)(ws + WS_WBR) + (size_t)l * D * D, D, 0, 768, scr, r, F.lane); continue; } r -= I_BS;
            transpose_item(p.w_out + (size_t)l * D * D, D, D, (bf16_t*)(ws + WS_WOUT) + (size_t)l * D * D, D, 0, 0, scr, r, F.lane);
        }
    }
    for (int i = F.gtid; i < 2 * 256 * D; i += F.ngt) {
        const int n = i & 1023, rc = (i >> 10) & 255, l = i >> 18, g = rc >> 6;
        const float* pw = p.pool_w + ((size_t)l * 256 + rc) * 64;
        const float* ps = p.pool_scale + l * 256 + 64 * g;
        const float* wb = p.w_br_pool + ((size_t)l * 256 + 64 * g) * D + n;
        float a = 0.f;
        for (int e = 0; e < 64; ++e) a += pw[e] * ps[e] * wb[(size_t)e * D];
        ((bf16_t*)(ws + WS_WBR))[(size_t)l * D * D + (size_t)n * D + 512 + rc] = (bf16_t)f2bf(a);
    }
    for (int i = F.gtid; i < 2 * 4 * 128 * 128; i += F.ngt) ((bf16_t*)(ws + WS_SGUW))[i] = (bf16_t)f2bf(p.sgu_w[i]);
    for (int i = F.gtid; i < 64 * 16; i += F.ngt) {
        const int pos = i >> 4, fi = i & 15;
        const float inv = powf(10000.0f, -(float)fi / 16.0f);
        const float ang = (float)pos * inv;
        ((f32x2*)(ws + WS_ROPE))[i] = (f32x2){cosf(ang), sinf(ang)};
    }
    convert_tables(p, F, 0);
    {
        float* MOD = (float*)(ws + WS_MOD);
        LAS float* scd = (LAS float*)F.lds;
        LAS float* red = scd + 9 * D;
        __syncthreads();
        for (int e = F.tid; e < 9 * D; e += NTHREADS) { const int r = e >> 10, k = e & 1023; scd[e] = silu_((r < 8) ? p.c[r * D + k] : p.c_ctx[k]); }
        __syncthreads();
        for (int it = blockIdx.x; it < 2 * 96; it += gridDim.x) {
            const int cgp = it % 96, l = it / 96, col = cgp * 64 + F.lane;
            float acc[9];
#pragma unroll
            for (int r = 0; r < 9; ++r) acc[r] = 0.f;
            const float* wp = p.w_mod + ((size_t)l * D + F.wave * 128) * NMOD + col;
#pragma unroll 4
            for (int k = 0; k < 128; ++k) {
                const float w = wp[(size_t)k * NMOD];
#pragma unroll
                for (int r = 0; r < 9; ++r) acc[r] += scd[r * D + F.wave * 128 + k] * w;
            }
#pragma unroll
            for (int r = 0; r < 9; ++r) red[(F.wave * 9 + r) * 64 + F.lane] = acc[r];
            __syncthreads();
            for (int e = F.tid; e < 9 * 64; e += NTHREADS) {
                const int r = e >> 6, ln = e & 63; float s = p.b_mod[l * NMOD + cgp * 64 + ln];
#pragma unroll
                for (int w = 0; w < 8; ++w) s += red[(w * 9 + r) * 64 + ln];
                MOD[((size_t)l * 9 + r) * NMOD + cgp * 64 + ln] = s;
            }
            __syncthreads();
        }
    }
}

DI const float* mod_vec(const Params& p, int l, int row, int j) {
    const int r = row < TL ? row / SEQ : 8;
    return (const float*)(p.ws + WS_MOD) + ((size_t)l * 9 + r) * NMOD + j * D;
}
DI float* xrow_ptr(const Params& p, int row) { return row < TL ? p.out + (size_t)row * D : (float*)(p.ws + WS_XCTX) + (size_t)(row - TL) * D; }
DI const float* xin_ptr(const Params& p, int row) { return row < TL ? p.x + (size_t)row * D : p.ctx + (size_t)(row - TL) * D; }

DI void modulate_row_wave(const float* src, const float* g, const float* sh, const float* sc, bf16_t* dst, int lane) {
    f32x4 v[4]; float ss = 0.f;
#pragma unroll
    for (int j = 0; j < 4; ++j) { v[j] = ((const f32x4*)src)[lane + 64 * j]; ss += v[j].x * v[j].x + v[j].y * v[j].y + v[j].z * v[j].z + v[j].w * v[j].w; }
    const float rinv = rsqrtf(wave_sum(ss) * (1.0f / D) + EPS);
#pragma unroll
    for (int j = 0; j < 4; ++j) {
        const f32x4 gg = ((const f32x4*)g)[lane + 64 * j], s1 = ((const f32x4*)sh)[lane + 64 * j], s2 = ((const f32x4*)sc)[lane + 64 * j];
        const f32x4 o = v[j] * rinv * gg * (s2 + 1.0f) + s1;
        u32x2 w; w.x = pk2(o.x, o.y); w.y = pk2(o.z, o.w);
        ((u32x2*)dst)[lane + 64 * j] = w;
    }
}

DI void phase_norm(const Params& p, const Frame& F, int l, int which  , bool from_input) {
    const int nrows = (l == 0) ? T : TL;
    const float* g = (which == 0 ? p.g_mix : p.g_ffn) + l * D;
    for (int row = F.gw; row < nrows; row += F.ngw) {
        const float* src = from_input ? xin_ptr(p, row) : xrow_ptr(p, row);
        modulate_row_wave(src, g, mod_vec(p, l, row, which * 3 + 0), mod_vec(p, l, row, which * 3 + 1), (bf16_t*)(p.ws + WS_H) + (size_t)row * D, F.lane);
    }
}

DI void g1_epilogue(const Params& p, int l, const f32x16& acc, int row0, int col0, int lane) {
    const int h = lane >> 5, w = lane & 31, col = col0 + w;
    bf16_t* P = (bf16_t*)(p.ws + WS_P);
    if (col0 < VOFF) {
        const float sc = (col0 < KOFF) ? QSCALE : 1.0f;
        const int axis = (col0 >> 5) & 1, fi = w & 15;
        const f32x2* tab = (const f32x2*)(p.ws + WS_ROPE);
#pragma unroll
        for (int r = 0; r < 16; ++r) {
            const int row = row0 + crow(r, h);
            const float own = acc[r], oth = __shfl_xor(own, 16);
            float o = own;
            if (row < TL) {
                const int t = row & (SEQ - 1), pos = axis ? (t & 63) : (t >> 6);
                const f32x2 cs = tab[pos * 16 + fi];
                o = (w < 16) ? (own * cs.x - oth * cs.y) : (own * cs.x + oth * cs.y);
            }
            P[(size_t)row * PW + col] = (bf16_t)f2bf(o * sc);
        }
    } else if (col0 < POOLOFF) {
        const int hk = (col - VOFF) >> 6, d = (col - VOFF) & 63;
#pragma unroll
        for (int r = 0; r < 16; ++r) {
            const int row = row0 + crow(r, h);
            const bf16_t v = (bf16_t)f2bf(acc[r]);
            if (row < TL) { const int b = row / SEQ, t = row & (SEQ - 1); ((bf16_t*)(p.ws + WS_VT))[((size_t)(b * 2 + hk) * 64 + d) * SEQ + t] = v; }
            else { const int rc = row - TL, b = rc / NCTX, j = rc & (NCTX - 1); ((bf16_t*)(p.ws + WS_VTC))[((size_t)(b * 2 + hk) * 64 + d) * NCTX + j] = v; }
        }
    } else if (col0 < SUOFF) {
#pragma unroll
        for (int r = 0; r < 16; ++r) { const int row = row0 + crow(r, h); P[(size_t)row * PW + col] = (bf16_t)f2bf(acc[r]); }
    } else if (col0 < SVOFF) {
#pragma unroll
        for (int r = 0; r < 16; ++r) { const int row = row0 + crow(r, h); P[(size_t)row * PW + col] = (bf16_t)f2bf(gelu_tanh(acc[r])); }
    } else {
        const int c = col - SVOFF;
#pragma unroll
        for (int r = 0; r < 16; ++r) { const int row = row0 + crow(r, h); const int chunk = row >> 7, q = row & 127;
            ((bf16_t*)(p.ws + WS_VST))[((size_t)chunk * 256 + c) * 128 + q] = (bf16_t)f2bf(gelu_tanh(acc[r])); }
    }
}

DI void phase_g1(const Params& p, const Frame& F, int l) {
    const bf16_t* H = (const bf16_t*)(p.ws + WS_H);
    const bf16_t* W = (const bf16_t*)(p.ws + WS_WIN) + (size_t)l * INW * D;
    const int n_main = (l == 0 ? T / 64 : TL / 64) * (PW / 64);
    const int n_extra = (l == 0) ? 0 : (TC / 64) * 4;
    for (int it = F.gw; it < n_main + n_extra; it += F.ngw) {
        int mt, nt;
        if (it < n_main) { mt = it / (PW / 64); nt = it % (PW / 64); } else { const int e = it - n_main; mt = TL / 64 + e / 4; nt = 8 + (e & 3); }
        f32x16 acc[2][2]; zero_acc(acc);
        wave_gemm<2, 2>(H, D, W, D, D, mt * 64, nt * 64, acc, F.lane);
#pragma unroll
        for (int i = 0; i < 2; ++i)
#pragma unroll
            for (int j = 0; j < 2; ++j) g1_epilogue(p, l, acc[i][j], mt * 64 + 32 * i, nt * 64 + 32 * j, F.lane);
    }
}

DI bf16x8 pack8(const f32x16& x, int s) {
    u32x4 pk;
#pragma unroll
    for (int j = 0; j < 4; ++j) { f32x2 v = {x[8 * s + 2 * j], x[8 * s + 2 * j + 1]}; pk[j] = __builtin_bit_cast(unsigned, __builtin_convertvector(v, bf16x2_t)); }
    return __builtin_bit_cast(bf16x8, pk);
}

DI void attn_block(const bf16x8 (&qf)[4], const bf16_t* kptr, const bf16_t* vptr, size_t vstride_d32, int mask_mode, int kq_off, int lane,
                   float& m, float& lpart, f32x16 (&o)[2]) {
    const int h = lane >> 5;
    f32x16 st;
#pragma unroll
    for (int r = 0; r < 16; ++r) st[r] = 0.f;
#pragma unroll
    for (int s = 0; s < 4; ++s) { const bf16x8 kf = *(const bf16x8*)(kptr + 16 * s); st = MFMA32(kf, qf[s], st); }
    if (mask_mode) {
#pragma unroll
        for (int r = 0; r < 16; ++r) { const int dlt = kq_off + crow(r, h); if (dlt > 128 || dlt < -128) st[r] = -1e30f; }
    }
    float bm = st[0];
#pragma unroll
    for (int r = 1; r < 16; ++r) bm = fmaxf(bm, st[r]);
    bm = fmaxf(bm, __shfl_xor(bm, 32));
    const float mn = fmaxf(m, bm), alpha = exp2f(m - mn);
    m = mn;
    float ps = 0.f;
#pragma unroll
    for (int r = 0; r < 16; ++r) { st[r] = exp2f(st[r] - mn); ps += st[r]; }
    lpart = lpart * alpha + ps;
#pragma unroll
    for (int d = 0; d < 2; ++d)
#pragma unroll
        for (int r = 0; r < 16; ++r) o[d][r] *= alpha;
    const bf16x8 pf0 = pack8(st, 0), pf1 = pack8(st, 1);
#pragma unroll
    for (int d = 0; d < 2; ++d) {
        const bf16_t* vp = vptr + (size_t)d * vstride_d32;
        const s16x4 a0 = *(const s16x4*)(vp), a1 = *(const s16x4*)(vp + 8), b0 = *(const s16x4*)(vp + 16), b1 = *(const s16x4*)(vp + 24);
        const bf16x8 v0 = __builtin_shufflevector(a0, a1, 0, 1, 2, 3, 4, 5, 6, 7), v1 = __builtin_shufflevector(b0, b1, 0, 1, 2, 3, 4, 5, 6, 7);
        o[d] = MFMA32(v0, pf0, o[d]);
        o[d] = MFMA32(v1, pf1, o[d]);
    }
}

DI void attn_task(const Params& p, int l, int task, int lane) {
    const int r = lane & 31, h = lane >> 5;
    const bf16_t* P = (const bf16_t*)(p.ws + WS_P);
    const bf16_t* VT = (const bf16_t*)(p.ws + WS_VT);
    const bf16_t* VTC = (const bf16_t*)(p.ws + WS_VTC);
    bf16_t* Y = (bf16_t*)(p.ws + WS_Y);
    const bool latent = task < 8192;
    int b, head, qb, q0row, p0;
    if (latent) { qb = task & 127; head = (task >> 7) & 7; b = task >> 10; p0 = qb * 32; q0row = b * SEQ + p0; }
    else { const int t2 = task - 8192; qb = t2 & 7; head = (t2 >> 3) & 7; b = t2 >> 6; p0 = qb * 32; q0row = TL + b * NCTX + p0; }
    const int hk = head >> 2;
    bf16x8 qf[4];
#pragma unroll
    for (int s = 0; s < 4; ++s) qf[s] = *(const bf16x8*)(P + (size_t)(q0row + r) * PW + head * 64 + 16 * s + 8 * h);
    float m = p.attn_sink[l * 8 + head] * LOG2E, lpart = (h == 0) ? 1.0f : 0.0f;
    f32x16 o[2];
#pragma unroll
    for (int d = 0; d < 2; ++d)
#pragma unroll
        for (int i = 0; i < 16; ++i) o[d][i] = 0.f;
    if (latent) {
        for (int kb = p0 - 128; kb <= p0 + 128; kb += 32) {
            if (kb < 0 || kb >= SEQ) continue;
            const bf16_t* kptr = P + (size_t)(b * SEQ + kb + r) * PW + KOFF + hk * 64 + 8 * h;
            const bf16_t* vptr = VT + ((size_t)(b * 2 + hk) * 64 + r) * SEQ + kb + 4 * h;
            const int mm = (kb == p0 - 128 || kb == p0 + 128) ? 1 : 0;
            attn_block(qf, kptr, vptr, (size_t)32 * SEQ, mm, kb - (p0 + r), lane, m, lpart, o);
        }
    }
    for (int kb = 0; kb < NCTX; kb += 32) {
        const bf16_t* kptr = P + (size_t)(TL + b * NCTX + kb + r) * PW + KOFF + hk * 64 + 8 * h;
        const bf16_t* vptr = VTC + ((size_t)(b * 2 + hk) * 64 + r) * NCTX + kb + 4 * h;
        attn_block(qf, kptr, vptr, (size_t)32 * NCTX, 0, 0, lane, m, lpart, o);
    }
    const float inv = 1.0f / (lpart + __shfl_xor(lpart, 32));
    bf16_t* yrow = Y + (size_t)(q0row + r) * D + head * 64;
#pragma unroll
    for (int d = 0; d < 2; ++d)
#pragma unroll
        for (int g = 0; g < 4; ++g) {
            u32x2 w; w.x = pk2(o[d][4 * g] * inv, o[d][4 * g + 1] * inv); w.y = pk2(o[d][4 * g + 2] * inv, o[d][4 * g + 3] * inv);
            *(u32x2*)(yrow + 32 * d + 8 * g + 4 * h) = w;
        }
}

DI void sgu_unit(const Params& p, const Frame& F, int l, int chunk) {
    constexpr int VS = 136;
    LAS float* part = (LAS float*)F.lds;
    LAS float* rq = part + 512;
    LAS bf16_t* vnT = (LAS bf16_t*)(F.lds + 4096);
    const bf16_t* VsT = (const bf16_t*)(p.ws + WS_VST) + (size_t)chunk * 256 * 128;
    const bf16_t* P = (const bf16_t*)(p.ws + WS_P);
    bf16_t* Y = (bf16_t*)(p.ws + WS_Y);
    __syncthreads();
    { const int q = F.tid & 127, part_i = F.tid >> 7; float ss = 0.f;
        for (int c = part_i * 64; c < part_i * 64 + 64; ++c) { const float v = bf2f(VsT[c * 128 + q]); ss += v * v; }
        part[part_i * 128 + q] = ss; }
    __syncthreads();
    if (F.tid < 128) rq[F.tid] = rsqrtf((part[F.tid] + part[128 + F.tid] + part[256 + F.tid] + part[384 + F.tid]) * (1.0f / 256.0f) + EPS);
    __syncthreads();
    for (int i = F.tid; i < 256 * 16; i += NTHREADS) {
        const int c = i >> 4, q8 = (i & 15) * 8;
        const u32x4 v = *(const u32x4*)(VsT + c * 128 + q8);
        u32x4 o;
#pragma unroll
        for (int j = 0; j < 4; ++j) o[j] = pk2(bflo(v[j]) * rq[q8 + 2 * j], bfhi(v[j]) * rq[q8 + 2 * j + 1]);
        *(LAS u32x4*)(vnT + c * VS + q8) = o;
    }
    __syncthreads();
    const int lane = F.lane, r = lane & 31, h = lane >> 5, g = F.wave >> 1, ph = F.wave & 1;
    const bf16_t* Wg = (const bf16_t*)(p.ws + WS_SGUW) + ((size_t)l * 4 + g) * 128 * 128;
#pragma unroll 1
    for (int pb = 0; pb < 2; ++pb) {
        const int p0 = 64 * ph + 32 * pb;
#pragma unroll 1
        for (int cb = 0; cb < 2; ++cb) {
            const int c0 = 64 * g + 32 * cb;
            f32x16 acc;
#pragma unroll
            for (int i = 0; i < 16; ++i) acc[i] = 0.f;
#pragma unroll
            for (int s = 0; s < 8; ++s) {
                const bf16x8 a = *(const LAS bf16x8*)(vnT + (c0 + r) * VS + 16 * s + 8 * h);
                const bf16x8 b = *(const bf16x8*)(Wg + (size_t)(p0 + r) * 128 + 16 * s + 8 * h);
                acc = MFMA32(a, b, acc);
            }
            const int row = chunk * 128 + p0 + r;
            const float bias = p.sgu_b[(l * 4 + g) * 128 + p0 + r];
#pragma unroll
            for (int q4 = 0; q4 < 4; ++q4) {
                const int cc = c0 + 8 * q4 + 4 * h;
                const u32x2 u = *(const u32x2*)(P + (size_t)row * PW + SUOFF + cc);
                u32x2 w;
                w.x = pk2(bflo(u.x) * (acc[4 * q4] + bias), bfhi(u.x) * (acc[4 * q4 + 1] + bias));
                w.y = pk2(bflo(u.y) * (acc[4 * q4 + 2] + bias), bfhi(u.y) * (acc[4 * q4 + 3] + bias));
                *(u32x2*)(Y + (size_t)row * D + 768 + cc) = w;
            }
        }
    }
}

DI void phase_mix(const Params& p, const Frame& F, int l) {
    const int ntask = (l == 0) ? 8192 + 512 : 8192;
    for (int task = F.gw; task < ntask; task += F.ngw) attn_task(p, l, task, F.lane);
    const int nchunk = (l == 0) ? T / 128 : TL / 128;
    for (int ch = blockIdx.x; ch < nchunk; ch += gridDim.x) sgu_unit(p, F, l, ch);
    const int nrows = (l == 0) ? T : TL;
    const bf16_t* P = (const bf16_t*)(p.ws + WS_P);
    bf16_t* Y = (bf16_t*)(p.ws + WS_Y);
    for (int i = F.gtid; i < nrows * 32; i += F.ngt) {
        const int row = i >> 5, ck = i & 31, g = ck >> 3, half = 1 << g;
        int base, t, len;
        if (row < TL) { base = row & ~(SEQ - 1); t = row & (SEQ - 1); len = SEQ; } else { const int rc = row - TL; base = TL + (rc & ~(NCTX - 1)); t = rc & (NCTX - 1); len = NCTX; }
        const int lo = max(t - half, 0), hi = min(t + half, len);
        float s[8];
#pragma unroll
        for (int j = 0; j < 8; ++j) s[j] = 0.f;
        for (int tt = lo; tt < hi; ++tt) {
            const u32x4 v = *(const u32x4*)(P + (size_t)(base + tt) * PW + POOLOFF + ck * 8);
#pragma unroll
            for (int j = 0; j < 4; ++j) { s[2 * j] += bflo(v[j]); s[2 * j + 1] += bfhi(v[j]); }
        }
        const float inv = 1.0f / (float)(hi - lo);
        const u32x4 z = *(const u32x4*)(P + (size_t)row * PW + POOLOFF + ck * 8);
        u32x4 o;
#pragma unroll
        for (int j = 0; j < 4; ++j) o[j] = pk2(s[2 * j] * inv - bflo(z[j]), s[2 * j + 1] * inv - bfhi(z[j]));
        *(u32x4*)(Y + (size_t)row * D + 512 + ck * 8) = o;
    }
}

DI void phase_g2(const Params& p, const Frame& F, int l) {
    const bf16_t* H = (const bf16_t*)(p.ws + WS_H);
    const bf16_t* Yb = (const bf16_t*)(p.ws + WS_Y);
    const bf16_t* Wg = (const bf16_t*)(p.ws + WS_WIN) + (size_t)l * INW * D + (size_t)GATEOFF * D;
    const bf16_t* Wb = (const bf16_t*)(p.ws + WS_WBR) + (size_t)l * D * D;
    bf16_t* M = (bf16_t*)(p.ws + WS_MERGED);
    const int nrows = (l == 0) ? T : TL, nit = (nrows / 64) * (D / 32);
    for (int it = F.gw; it < nit; it += F.ngw) {
        const int mt = it / (D / 32), nt = it % (D / 32), m0 = mt * 64, n0 = nt * 32;
        f32x16 tot[2][1]; zero_acc(tot);
#pragma unroll 1
        for (int i = 0; i < 3; ++i) {
            const int koff = (i == 0) ? 0 : (i == 1 ? 512 : 768), kk = (i == 0) ? 512 : 256;
            f32x16 g[2][1], pr[2][1]; zero_acc(g); zero_acc(pr);
            wave_gemm<2, 1>(H, D, Wg + (size_t)i * D * D, D, D, m0, n0, g, F.lane);
            wave_gemm<2, 1>(Yb + koff, D, Wb + koff, D, kk, m0, n0, pr, F.lane);
#pragma unroll
            for (int a = 0; a < 2; ++a)
#pragma unroll
                for (int r = 0; r < 16; ++r) tot[a][0][r] += sigmoidf_(g[a][0][r]) * pr[a][0][r];
        }
        const int h = F.lane >> 5, col = n0 + (F.lane & 31);
#pragma unroll
        for (int a = 0; a < 2; ++a)
#pragma unroll
            for (int r = 0; r < 16; ++r) M[(size_t)(m0 + 32 * a + crow(r, h)) * D + col] = (bf16_t)f2bf(tot[a][0][r]);
    }
}

DI void phase_g3(const Params& p, const Frame& F, int l) {
    const bf16_t* M = (const bf16_t*)(p.ws + WS_MERGED);
    const bf16_t* W = (const bf16_t*)(p.ws + WS_WOUT) + (size_t)l * D * D;
    const int nrows = (l == 0) ? T : TL, nit = (nrows / 64) * (D / 64);
    for (int it = F.gw; it < nit; it += F.ngw) {
        const int mt = it / (D / 64), nt = it % (D / 64), m0 = mt * 64, n0 = nt * 64;
        f32x16 acc[2][2]; zero_acc(acc);
        wave_gemm<2, 2>(M, D, W, D, D, m0, n0, acc, F.lane);
        const int h = F.lane >> 5;
#pragma unroll
        for (int a = 0; a < 2; ++a)
#pragma unroll
            for (int j = 0; j < 2; ++j) {
                const int col = n0 + 32 * j + (F.lane & 31);
#pragma unroll
                for (int r = 0; r < 16; ++r) {
                    const int row = m0 + 32 * a + crow(r, h);
                    const float xs = (l == 0) ? xin_ptr(p, row)[col] : xrow_ptr(p, row)[col];
                    xrow_ptr(p, row)[col] = xs + mod_vec(p, l, row, 2)[col] * acc[a][j][r];
                }
            }
    }
}

DI void phase_g45(const Params& p, const Frame& F, int l) {
    const bf16_t* H = (const bf16_t*)(p.ws + WS_H);
    const bf16_t* W = (const bf16_t*)(p.ws + WS_WFOLD) + (size_t)l * 2048 * D;
    float* ST = (float*)(p.ws + WS_ST);
    const int nrows = (l == 0) ? T : TL, nit = (2048 / 64) * (nrows / 64);
    for (int it = F.gw; it < nit; it += F.ngw) {
        const int nt = it / 32, mt = it % 32, m0 = mt * 64, n0 = nt * 64;
        f32x16 acc[2][2]; zero_acc(acc);
        wave_gemm<2, 2>(W, D, H, D, D, m0, n0, acc, F.lane);
        const int h = F.lane >> 5;
#pragma unroll
        for (int a = 0; a < 2; ++a)
#pragma unroll
            for (int j = 0; j < 2; ++j)
#pragma unroll
                for (int r = 0; r < 16; ++r) ST[(size_t)(m0 + 32 * a + crow(r, h)) * T + n0 + 32 * j + (F.lane & 31)] = acc[a][j][r];
    }
}

DI unsigned fkey(float f) { const unsigned u = __builtin_bit_cast(unsigned, f); return (u & 0x80000000u) ? ~u : (u | 0x80000000u); }
DI float fkey_inv(unsigned k) { const unsigned u = (k & 0x80000000u) ? (k & 0x7fffffffu) : ~k; return __builtin_bit_cast(float, u); }
#define INSERT16(L, x) do { unsigned x_ = (x); _Pragma("unroll") for (int k_ = 0; k_ < 16; ++k_) { const unsigned hi_ = max(L[k_], x_); x_ = min(L[k_], x_); L[k_] = hi_; } } while (0)

DI void phase_sel(const Params& p, const Frame& F, int l) {
    const float* ST = (const float*)(p.ws + WS_ST);
    unsigned short* IDX = (unsigned short*)(p.ws + WS_IDX);
    float* GW = (float*)(p.ws + WS_GW);
    LAS unsigned char* ib = (LAS unsigned char*)F.lds;
    const int ntok = (l == 0) ? T : TL;
    for (int i0 = blockIdx.x * NTHREADS; i0 < ntok * 8; i0 += gridDim.x * NTHREADS) {
        const int i = i0 + F.tid;
        const int tok = i % ntok, head = i / ntok;
        unsigned la[16], lb[16];
#pragma unroll
        for (int k = 0; k < 16; ++k) { la[k] = 0u; lb[k] = 0u; }
        const float* s0 = ST + (size_t)(head * 256) * T + tok;
#pragma unroll 4
        for (int k = 0; k < 128; ++k) { const unsigned key = (fkey(s0[(size_t)k * T]) & ~127u) | (unsigned)(127 - k); INSERT16(la, key); }
        const float* s1 = s0 + (size_t)128 * T;
#pragma unroll 4
        for (int k = 0; k < 128; ++k) { const unsigned key = (fkey(s1[(size_t)k * T]) & ~127u) | (unsigned)(127 - k); INSERT16(lb, key); }
        float va[16], vb[16];
#pragma unroll
        for (int k = 0; k < 16; ++k) {
            va[k] = fkey_inv(la[k] & ~127u); vb[k] = fkey_inv(lb[k] & ~127u);
            ib[k * NTHREADS + F.tid] = (unsigned char)(127u - (la[k] & 127u));
            ib[(16 + k) * NTHREADS + F.tid] = (unsigned char)(127u - (lb[k] & 127u));
        }
        unsigned lc[16];
#pragma unroll
        for (int k = 0; k < 16; ++k) lc[k] = 0u;
#pragma unroll
        for (int a = 0; a < 16; ++a)
#pragma unroll
            for (int b = 0; b < 16; ++b)
                if ((a + 1) * (b + 1) <= 16) { const unsigned key = (fkey(va[a] + vb[b]) & ~255u) | (unsigned)(255 - (a * 16 + b)); INSERT16(lc, key); }
        float e[16], sum = 0.f; const float v0 = fkey_inv(lc[0] & ~255u);
#pragma unroll
        for (int k = 0; k < 16; ++k) { e[k] = __expf(fkey_inv(lc[k] & ~255u) - v0); sum += e[k]; }
        const float inv = 1.0f / sum;
        asm volatile("s_waitcnt lgkmcnt(0)" ::: "memory");
#pragma unroll
        for (int k = 0; k < 16; ++k) {
            const unsigned pos = 255u - (lc[k] & 255u), a = pos >> 4, b = pos & 15u;
            const unsigned ea = ib[a * NTHREADS + F.tid], eb = ib[(16 + b) * NTHREADS + F.tid];
            IDX[(size_t)tok * 128 + head * 16 + k] = (unsigned short)(ea * 128u + eb);
            GW[(size_t)tok * 128 + head * 16 + k] = e[k] * inv;
        }
        asm volatile("s_waitcnt lgkmcnt(0)" ::: "memory");
    }
}

DI void phase_gather(const Params& p, const Frame& F, int l) {
    const int ntok = (l == 0) ? T : TL, lane = F.lane;
    const bf16_t* H = (const bf16_t*)(p.ws + WS_H);
    const bf16_t* UT = (const bf16_t*)(p.ws + WS_UTAB);
    const bf16_t* VTb = (const bf16_t*)(p.ws + WS_VTAB);
    const unsigned short* IDX = (const unsigned short*)(p.ws + WS_IDX);
    const float* GW = (const float*)(p.ws + WS_GW);
    for (int tok = F.gw; tok < ntok; tok += F.ngw) {
        float hx[16];
        { const u32x4 a = *(const u32x4*)(H + (size_t)tok * D + 8 * lane), b = *(const u32x4*)(H + (size_t)tok * D + 512 + 8 * lane);
#pragma unroll
            for (int j = 0; j < 4; ++j) { hx[2 * j] = bflo(a[j]); hx[2 * j + 1] = bfhi(a[j]); hx[8 + 2 * j] = bflo(b[j]); hx[8 + 2 * j + 1] = bfhi(b[j]); } }
        const int e0 = IDX[(size_t)tok * 128 + lane], e1 = IDX[(size_t)tok * 128 + 64 + lane];
        const float g0 = GW[(size_t)tok * 128 + lane], g1 = GW[(size_t)tok * 128 + 64 + lane];
        float c0 = 0.f, c1 = 0.f;
#pragma unroll 1
        for (int kk = 0; kk < 128; kk += 4) {
            float dsum[4];
#pragma unroll
            for (int u = 0; u < 4; ++u) {
                const int k = kk + u;
                const int e = __shfl((k < 64) ? e0 : e1, k & 63);
                const u32x4 a = *(const u32x4*)(UT + (size_t)e * D + 8 * lane), b = *(const u32x4*)(UT + (size_t)e * D + 512 + 8 * lane);
                float d = 0.f;
#pragma unroll
                for (int j = 0; j < 4; ++j) { d += hx[2 * j] * bflo(a[j]) + hx[2 * j + 1] * bfhi(a[j]); d += hx[8 + 2 * j] * bflo(b[j]) + hx[8 + 2 * j + 1] * bfhi(b[j]); }
                dsum[u] = d;
            }
#pragma unroll
            for (int u = 0; u < 4; ++u) {
                const int k = kk + u;
                const float tot = wave_sum(dsum[u]);
                const float act = gelu_tanh(tot);
                if (k < 64) { if (lane == k) c0 = g0 * act; } else { if (lane == k - 64) c1 = g1 * act; }
            }
        }
        float acc[16];
#pragma unroll
        for (int j = 0; j < 16; ++j) acc[j] = 0.f;
#pragma unroll 1
        for (int kk = 0; kk < 128; kk += 4) {
#pragma unroll
            for (int u = 0; u < 4; ++u) {
                const int k = kk + u;
                const int e = __shfl((k < 64) ? e0 : e1, k & 63);
                const float cf = __shfl((k < 64) ? c0 : c1, k & 63);
                const u32x4 a = *(const u32x4*)(VTb + (size_t)e * D + 8 * lane), b = *(const u32x4*)(VTb + (size_t)e * D + 512 + 8 * lane);
#pragma unroll
                for (int j = 0; j < 4; ++j) { acc[2 * j] += cf * bflo(a[j]); acc[2 * j + 1] += cf * bfhi(a[j]); acc[8 + 2 * j] += cf * bflo(b[j]); acc[8 + 2 * j + 1] += cf * bfhi(b[j]); }
            }
        }
        float* xr = xrow_ptr(p, tok);
        const float* gt2 = mod_vec(p, l, tok, 5);
        float x2[16]; float ss = 0.f;
#pragma unroll
        for (int half = 0; half < 2; ++half)
#pragma unroll
            for (int q = 0; q < 2; ++q) {
                const int col = 512 * half + 8 * lane + 4 * q;
                const f32x4 xv = *(const f32x4*)(xr + col), gv = *(const f32x4*)(gt2 + col);
#pragma unroll
                for (int j = 0; j < 4; ++j) { const float v = xv[j] + gv[j] * acc[8 * half + 4 * q + j]; x2[8 * half + 4 * q + j] = v; ss += v * v; }
            }
        const float rinv = rsqrtf(wave_sum(ss) * (1.0f / D) + EPS);
        if (l == DEPTH - 1) {
#pragma unroll
            for (int half = 0; half < 2; ++half)
#pragma unroll
                for (int q = 0; q < 2; ++q) {
                    const int col = 512 * half + 8 * lane + 4 * q;
                    const f32x4 gv = *(const f32x4*)(p.g_final + col);
                    f32x4 o;
#pragma unroll
                    for (int j = 0; j < 4; ++j) o[j] = x2[8 * half + 4 * q + j] * rinv * gv[j];
                    *(f32x4*)(xr + col) = o;
                }
        } else {
            const float* g = p.g_mix + (l + 1) * D; const float* sh = mod_vec(p, l + 1, tok, 0); const float* sc = mod_vec(p, l + 1, tok, 1);
            bf16_t* hrow = (bf16_t*)(p.ws + WS_H) + (size_t)tok * D;
#pragma unroll
            for (int half = 0; half < 2; ++half) {
                u32x4 hw;
#pragma unroll
                for (int q = 0; q < 2; ++q) {
                    const int col = 512 * half + 8 * lane + 4 * q;
                    const f32x4 gv = *(const f32x4*)(g + col), s1 = *(const f32x4*)(sh + col), s2 = *(const f32x4*)(sc + col);
                    f32x4 xo, ho;
#pragma unroll
                    for (int j = 0; j < 4; ++j) { xo[j] = x2[8 * half + 4 * q + j]; ho[j] = xo[j] * rinv * gv[j] * (1.0f + s2[j]) + s1[j]; }
                    *(f32x4*)(xr + col) = xo;
                    hw[2 * q] = pk2(ho[0], ho[1]); hw[2 * q + 1] = pk2(ho[2], ho[3]);
                }
                *(u32x4*)(hrow + 512 * half + 8 * lane) = hw;
            }
        }
    }
}

constexpr int NPHASE = 18;
template <int PH> DI void run_phase(const Params& p, const Frame& F) {
    if constexpr (PH == 0) phase_prep(p, F);
    else if constexpr (PH == 1) phase_norm(p, F, 0, 0, true);
    else if constexpr (PH == 2) phase_g1(p, F, 0);
    else if constexpr (PH == 3) phase_mix(p, F, 0);
    else if constexpr (PH == 4) phase_g2(p, F, 0);
    else if constexpr (PH == 5) phase_g3(p, F, 0);
    else if constexpr (PH == 6) phase_norm(p, F, 0, 1, false);
    else if constexpr (PH == 7) phase_g45(p, F, 0);
    else if constexpr (PH == 8) phase_sel(p, F, 0);
    else if constexpr (PH == 9) phase_gather(p, F, 0);
    else if constexpr (PH == 10) { phase_g1(p, F, 1); convert_tables(p, F, 1); }
    else if constexpr (PH == 11) phase_mix(p, F, 1);
    else if constexpr (PH == 12) phase_g2(p, F, 1);
    else if constexpr (PH == 13) phase_g3(p, F, 1);
    else if constexpr (PH == 14) phase_norm(p, F, 1, 1, false);
    else if constexpr (PH == 15) phase_g45(p, F, 1);
    else if constexpr (PH == 16) phase_sel(p, F, 1);
    else if constexpr (PH == 17) phase_gather(p, F, 1);
}
DI Frame make_frame(unsigned char* lds_raw) {
    Frame F;
    F.lds = (LAS unsigned char*)lds_raw;
    F.tid = threadIdx.x; F.lane = F.tid & 63; F.wave = __builtin_amdgcn_readfirstlane(F.tid >> 6);
    F.gw = blockIdx.x * NWAVES + F.wave; F.ngw = gridDim.x * NWAVES; F.gtid = blockIdx.x * NTHREADS + F.tid; F.ngt = gridDim.x * NTHREADS;
    return F;
}
template <int PH> __global__ void __launch_bounds__(NTHREADS, 2) phase_kernel(Params p) {
    extern __shared__ __attribute__((aligned(16))) unsigned char lds_raw[];
    const Frame F = make_frame(lds_raw);
    run_phase<PH>(p, F);
}
template <int PH> static void launch_phases(const Params& p, int grid, hipStream_t stream) {
    if constexpr (PH < NPHASE) {
        (void)hipFuncSetAttribute((const void*)phase_kernel<PH>, hipFuncAttributeMaxDynamicSharedMemorySize, LDS_BYTES);
        hipLaunchKernelGGL(phase_kernel<PH>, dim3(grid), dim3(NTHREADS), LDS_BYTES, stream, p);
        launch_phases<PH + 1>(p, grid, stream);
    }
}

extern "C" void kernel_launch(void* const* d_in, const int* in_sizes, int n_in, void* d_out, int out_size, void* d_ws, size_t ws_size, hipStream_t stream) {
    static int grid = 0;
    if (grid == 0) {
        if (n_in != 23 || out_size != TL * D || ws_size < WS_END) { fprintf(stderr, "kernel_launch: unexpected shapes (n_in %d out %d ws %zu)\n", n_in, out_size, ws_size); grid = -1; return; }
        int dev = 0, cus = 0;
        (void)hipGetDevice(&dev);
        (void)hipDeviceGetAttribute(&cus, hipDeviceAttributeMultiprocessorCount, dev);
        grid = cus;
    }
    if (grid < 0) return;
    (void)hipMemsetAsync((char*)d_ws + WS_CTL, 0, CTL_ZERO_BYTES, stream);
    Params p{};
    const float** dst = (const float**)&p;
    for (int i = 0; i < 23; ++i) dst[i] = (const float*)d_in[i];
    p.out = (float*)d_out; p.ws = (unsigned char*)d_ws;
    launch_phases<0>(p, grid, stream);
}
```

```cpp
#include <hip/hip_runtime.h>
#include <hip/hip_cooperative_groups.h>
#include <stdint.h>
#include <stdio.h>
namespace cg = cooperative_groups;

#ifndef MK_SINGLE
#define MK_SINGLE 0
#endif

#define LAS __attribute__((address_space(3)))
typedef unsigned short bf16_t;
typedef short bf16x8 __attribute__((ext_vector_type(8)));
typedef short s16x4 __attribute__((ext_vector_type(4)));
typedef float f32x4 __attribute__((ext_vector_type(4)));
typedef float f32x2 __attribute__((ext_vector_type(2)));
typedef float f32x16 __attribute__((ext_vector_type(16)));
typedef unsigned u32x4 __attribute__((ext_vector_type(4)));
typedef unsigned u32x2 __attribute__((ext_vector_type(2)));
typedef __bf16 bf16x2_t __attribute__((ext_vector_type(2)));
#define DI __device__ __forceinline__
#define MFMA32(a, b, c) __builtin_amdgcn_mfma_f32_32x32x16_bf16((a), (b), (c), 0, 0, 0)

constexpr int D = 1024, NB = 8, SEQ = 4096, NCTX = 256, DEPTH = 2;
constexpr int TL = NB * SEQ, TC = NB * NCTX, T = TL + TC;
constexpr int INW = 4608, NMOD = 6 * D, PW = 1536;
constexpr int QOFF = 0, KOFF = 512, VOFF = 640, POOLOFF = 768, SUOFF = 1024, SVOFF = 1280, GATEOFF = 1536;
constexpr int NEXP = 16384;
constexpr float EPS = 1e-6f;
constexpr float LOG2E = 1.4426950408889634f;
constexpr float QSCALE = 0.125f * LOG2E;

constexpr size_t MiB = 1u << 20;
constexpr size_t WS_CTL = 0, WS_MOD = 1 * MiB, CTL_ZERO_BYTES = 2 * MiB;
constexpr size_t WS_ROPE = 2 * MiB, WS_SGUW = 2 * MiB + 65536;
constexpr size_t WS_WIN = 4 * MiB, WS_WBR = 22 * MiB, WS_WOUT = 26 * MiB, WS_WFOLD = 30 * MiB;
constexpr size_t WS_XCTX = 38 * MiB, WS_UTAB = 46 * MiB, WS_VTAB = 78 * MiB;
constexpr size_t WS_IDX = 110 * MiB, WS_GW = 120 * MiB;
constexpr size_t WS_H = 142 * MiB;
constexpr size_t WS_P = 210 * MiB, WS_Y = 312 * MiB, WS_MERGED = 380 * MiB, WS_VT = 448 * MiB, WS_VTC = 456 * MiB, WS_VST = 460 * MiB;
constexpr size_t WS_ST = 210 * MiB;
constexpr size_t WS_END = 512 * MiB;
static_assert(WS_ST + (size_t)2048 * T * 4 <= WS_END, "ST fits");
static_assert(WS_VST + (size_t)272 * 256 * 128 * 2 <= WS_END, "VsT fits");
static_assert(WS_H + (size_t)T * D * 2 <= WS_P, "H fits");
static_assert(WS_P + (size_t)T * PW * 2 <= WS_Y && WS_Y + (size_t)T * D * 2 <= WS_MERGED && WS_MERGED + (size_t)T * D * 2 <= WS_VT, "P/Y/MERGED fit");
static_assert(WS_IDX + (size_t)T * 128 * 2 <= WS_GW && WS_GW + (size_t)T * 128 * 4 <= WS_H, "idx/gw fit");

constexpr int LDS_BYTES = 147456;
constexpr int NTHREADS = 512, NWAVES = 8;

struct Params {
    const float *x, *c, *ctx, *c_ctx, *w_mod, *b_mod, *g_mix, *g_ffn, *w_in, *attn_sink, *pool_w, *pool_scale, *sgu_w, *sgu_b,
        *w_br_attn, *w_br_pool, *w_br_sgu, *w_out, *peer_wq, *peer_subkeys, *peer_u, *peer_v, *g_final;
    float* out; unsigned char* ws;
    int ph_lo, ph_hi;
};

DI unsigned f2bf(float f) { unsigned u = __builtin_bit_cast(unsigned, f); return (u + 0x7fffu + ((u >> 16) & 1u)) >> 16; }
DI unsigned pk2(float lo, float hi) { return f2bf(lo) | (f2bf(hi) << 16); }
DI float bf2f(unsigned short u) { return __builtin_bit_cast(float, (unsigned)u << 16); }
DI float bflo(unsigned w) { return __builtin_bit_cast(float, w << 16); }
DI float bfhi(unsigned w) { return __builtin_bit_cast(float, w & 0xffff0000u); }
DI int crow(int reg, int h) { return (reg & 3) + 8 * (reg >> 2) + 4 * h; }
DI float wave_sum(float v) {
#pragma unroll
    for (int o = 1; o < 64; o <<= 1) v += __shfl_xor(v, o);
    return v;
}
DI float sigmoidf_(float x) { return 1.0f / (1.0f + __expf(-x)); }
DI float gelu_tanh(float x) { const float u = 0.7978845608028654f * (x + 0.044715f * x * x * x); return x / (1.0f + __expf(-2.0f * u)); }
DI float silu_(float x) { return x / (1.0f + __expf(-x)); }

struct Frame {
    int tid, lane, wave, gw, ngw, gtid, ngt;
    LAS unsigned char* lds;
};

template <int NM, int NN>
DI void wave_gemm(const bf16_t* __restrict__ A, int lda, const bf16_t* __restrict__ Bt, int ldb, int K, int m0, int n0, f32x16 (&acc)[NM][NN], int lane) {
    const int r = lane & 31, h = lane >> 5;
    const bf16_t* ap = A + (size_t)(m0 + r) * lda + 8 * h;
    const bf16_t* bp = Bt + (size_t)(n0 + r) * ldb + 8 * h;
    for (int k0 = 0; k0 < K; k0 += 16) {
        bf16x8 a[NM], b[NN];
#pragma unroll
        for (int i = 0; i < NM; ++i) a[i] = *(const bf16x8*)(ap + (size_t)(32 * i) * lda + k0);
#pragma unroll
        for (int j = 0; j < NN; ++j) b[j] = *(const bf16x8*)(bp + (size_t)(32 * j) * ldb + k0);
#pragma unroll
        for (int i = 0; i < NM; ++i)
#pragma unroll
            for (int j = 0; j < NN; ++j) acc[i][j] = MFMA32(a[i], b[j], acc[i][j]);
    }
}
template <int NM, int NN> DI void zero_acc(f32x16 (&acc)[NM][NN]) {
#pragma unroll
    for (int i = 0; i < NM; ++i)
#pragma unroll
        for (int j = 0; j < NN; ++j)
#pragma unroll
            for (int r = 0; r < 16; ++r) acc[i][j][r] = 0.f;
}

DI void transpose_item(const float* W, int K, int N, bf16_t* WT, int ldd, int row_off, int col_off, LAS float* scr, int item, int lane) {
    const int nblk = N / 32, kb = item / nblk, nb = item % nblk, k0 = 64 * kb, n0 = 32 * nb;
#pragma unroll 8
    for (int i = 0; i < 32; ++i) { const int kk = 2 * i + (lane >> 5); scr[kk * 33 + (lane & 31)] = W[(size_t)(k0 + kk) * N + n0 + (lane & 31)]; }
    asm volatile("s_waitcnt lgkmcnt(0)" ::: "memory");
    const int c = lane & 7;
#pragma unroll
    for (int j = 0; j < 4; ++j) { const int n = (lane >> 3) + 8 * j; const LAS float* s = scr + (8 * c) * 33 + n;
        u32x4 o; o.x = pk2(s[0 * 33], s[1 * 33]); o.y = pk2(s[2 * 33], s[3 * 33]); o.z = pk2(s[4 * 33], s[5 * 33]); o.w = pk2(s[6 * 33], s[7 * 33]);
        *(u32x4*)(WT + (size_t)(row_off + n0 + n) * ldd + col_off + k0 + 8 * c) = o; }
    asm volatile("s_waitcnt lgkmcnt(0)" ::: "memory");
}

DI void convert_tables(const Params& p, const Frame& F, int layer) {
    const size_t n4 = (size_t)NEXP * D / 4;
    const f32x4* su = (const f32x4*)(p.peer_u + (size_t)layer * NEXP * D);
    const f32x4* sv = (const f32x4*)(p.peer_v + (size_t)layer * NEXP * D);
    u32x2* du = (u32x2*)(p.ws + WS_UTAB); u32x2* dv = (u32x2*)(p.ws + WS_VTAB);
    for (size_t i = F.gtid; i < n4; i += F.ngt) {
        const f32x4 a = su[i], b = sv[i];
        u32x2 oa, ob; oa.x = pk2(a.x, a.y); oa.y = pk2(a.z, a.w); ob.x = pk2(b.x, b.y); ob.y = pk2(b.z, b.w);
        du[i] = oa; dv[i] = ob;
    }
}

DI void phase_prep(const Params& p, const Frame& F) {
    unsigned char* ws = p.ws;
    {
        LAS float* wq = (LAS float*)F.lds;
        for (int it = blockIdx.x; it < 2 * 16 * 16; it += gridDim.x) {
            const int cc = it & 15, hp = (it >> 4) & 15, l = it >> 8;
            const float* src = p.peer_wq + (size_t)l * D * 2048 + hp * 128;
            __syncthreads();
            for (int e = F.tid; e < 64 * 128; e += NTHREADS) { const int ci = e >> 7, d = e & 127; wq[d * 65 + ci] = src[(size_t)(cc * 64 + ci) * 2048 + d]; }
            __syncthreads();
            const int ci = F.tid & 63, kg = F.tid >> 6;
            const float* sk = p.peer_subkeys + ((size_t)(l * 16 + hp) * 128 + 16 * kg) * 128;
            float acc[16];
#pragma unroll
            for (int k = 0; k < 16; ++k) acc[k] = 0.f;
            for (int d = 0; d < 128; ++d) { const float w = wq[d * 65 + ci];
#pragma unroll
                for (int k = 0; k < 16; ++k) acc[k] += w * sk[k * 128 + d]; }
            bf16_t* dst = (bf16_t*)(ws + WS_WFOLD) + ((size_t)l * 2048 + hp * 128 + 16 * kg) * D + cc * 64 + ci;
#pragma unroll
            for (int k = 0; k < 16; ++k) dst[(size_t)k * D] = (bf16_t)f2bf(acc[k]);
        }
        __syncthreads();
    }
    {
        LAS float* scr = (LAS float*)(F.lds + F.wave * 16384);
        constexpr int I_IN = (D / 64) * (INW / 32), I_BA = (512 / 64) * (D / 32), I_BS = (256 / 64) * (D / 32), I_O = (D / 64) * (D / 32);
        constexpr int PER_L = I_IN + I_BA + I_BS + I_O;
        for (int it = F.gw; it < 2 * PER_L; it += F.ngw) {
            const int l = it / PER_L; int r = it % PER_L;
            if (r < I_IN) { transpose_item(p.w_in + (size_t)l * D * INW, D, INW, (bf16_t*)(ws + WS_WIN) + (size_t)l * INW * D, D, 0, 0, scr, r, F.lane); continue; } r -= I_IN;
            if (r < I_BA) { transpose_item(p.w_br_attn + (size_t)l * 512 * D, 512, D, (bf16_t*)(ws + WS_WBR) + (size_t)l * D * D, D, 0, 0, scr, r, F.lane); continue; } r -= I_BA;
            if (r < I_BS) { transpose_item(p.w_br_sgu + (size_t)l * 256 * D, 256, D, (bf16_t*)(ws + WS_WBR) + (size_t)l * D * D, D, 0, 768, scr, r, F.lane); continue; } r -= I_BS;
            transpose_item(p.w_out + (size_t)l * D * D, D, D, (bf16_t*)(ws + WS_WOUT) + (size_t)l * D * D, D, 0, 0, scr, r, F.lane);
        }
    }
    for (int i = F.gtid; i < 2 * 256 * D; i += F.ngt) {
        const int n = i & 1023, rc = (i >> 10) & 255, l = i >> 18, g = rc >> 6;
        const float* pw = p.pool_w + ((size_t)l * 256 + rc) * 64;
        const float* ps = p.pool_scale + l * 256 + 64 * g;
        const float* wb = p.w_br_pool + ((size_t)l * 256 + 64 * g) * D + n;
        float a = 0.f;
        for (int e = 0; e < 64; ++e) a += pw[e] * ps[e] * wb[(size_t)e * D];
        ((bf16_t*)(ws + WS_WBR))[(size_t)l * D * D + (size_t)n * D + 512 + rc] = (bf16_t)f2bf(a);
    }
    for (int i = F.gtid; i < 2 * 4 * 128 * 128; i += F.ngt) ((bf16_t*)(ws + WS_SGUW))[i] = (bf16_t)f2bf(p.sgu_w[i]);
    for (int i = F.gtid; i < 64 * 16; i += F.ngt) {
        const int pos = i >> 4, fi = i & 15;
        const float inv = powf(10000.0f, -(float)fi / 16.0f);
        const float ang = (float)pos * inv;
        ((f32x2*)(ws + WS_ROPE))[i] = (f32x2){cosf(ang), sinf(ang)};
    }
    convert_tables(p, F, 0);
    {
        float* MOD = (float*)(ws + WS_MOD);
        LAS float* scd = (LAS float*)F.lds;
        LAS float* red = scd + 9 * D;
        __syncthreads();
        for (int e = F.tid; e < 9 * D; e += NTHREADS) { const int r = e >> 10, k = e & 1023; scd[e] = silu_((r < 8) ? p.c[r * D + k] : p.c_ctx[k]); }
        __syncthreads();
        for (int it = blockIdx.x; it < 2 * 96; it += gridDim.x) {
            const int cgp = it % 96, l = it / 96, col = cgp * 64 + F.lane;
            float acc[9];
#pragma unroll
            for (int r = 0; r < 9; ++r) acc[r] = 0.f;
            const float* wp = p.w_mod + ((size_t)l * D + F.wave * 128) * NMOD + col;
#pragma unroll 4
            for (int k = 0; k < 128; ++k) {
                const float w = wp[(size_t)k * NMOD];
#pragma unroll
                for (int r = 0; r < 9; ++r) acc[r] += scd[r * D + F.wave * 128 + k] * w;
            }
#pragma unroll
            for (int r = 0; r < 9; ++r) red[(F.wave * 9 + r) * 64 + F.lane] = acc[r];
            __syncthreads();
            for (int e = F.tid; e < 9 * 64; e += NTHREADS) {
                const int r = e >> 6, ln = e & 63; float s = p.b_mod[l * NMOD + cgp * 64 + ln];
#pragma unroll
                for (int w = 0; w < 8; ++w) s += red[(w * 9 + r) * 64 + ln];
                MOD[((size_t)l * 9 + r) * NMOD + cgp * 64 + ln] = s;
            }
            __syncthreads();
        }
    }
}

DI const float* mod_vec(const Params& p, int l, int row, int j) {
    const int r = row < TL ? row / SEQ : 8;
    return (const float*)(p.ws + WS_MOD) + ((size_t)l * 9 + r) * NMOD + j * D;
}
DI float* xrow_ptr(const Params& p, int row) { return row < TL ? p.out + (size_t)row * D : (float*)(p.ws + WS_XCTX) + (size_t)(row - TL) * D; }
DI const float* xin_ptr(const Params& p, int row) { return row < TL ? p.x + (size_t)row * D : p.ctx + (size_t)(row - TL) * D; }

DI void modulate_row_wave(const float* src, const float* g, const float* sh, const float* sc, bf16_t* dst, int lane) {
    f32x4 v[4]; float ss = 0.f;
#pragma unroll
    for (int j = 0; j < 4; ++j) { v[j] = ((const f32x4*)src)[lane + 64 * j]; ss += v[j].x * v[j].x + v[j].y * v[j].y + v[j].z * v[j].z + v[j].w * v[j].w; }
    const float rinv = rsqrtf(wave_sum(ss) * (1.0f / D) + EPS);
#pragma unroll
    for (int j = 0; j < 4; ++j) {
        const f32x4 gg = ((const f32x4*)g)[lane + 64 * j], s1 = ((const f32x4*)sh)[lane + 64 * j], s2 = ((const f32x4*)sc)[lane + 64 * j];
        const f32x4 o = v[j] * rinv * gg * (s2 + 1.0f) + s1;
        u32x2 w; w.x = pk2(o.x, o.y); w.y = pk2(o.z, o.w);
        ((u32x2*)dst)[lane + 64 * j] = w;
    }
}

DI void phase_norm(const Params& p, const Frame& F, int l, int which  , bool from_input) {
    const int nrows = (l == 0) ? T : TL;
    const float* g = (which == 0 ? p.g_mix : p.g_ffn) + l * D;
    for (int row = F.gw; row < nrows; row += F.ngw) {
        const float* src = from_input ? xin_ptr(p, row) : xrow_ptr(p, row);
        modulate_row_wave(src, g, mod_vec(p, l, row, which * 3 + 0), mod_vec(p, l, row, which * 3 + 1), (bf16_t*)(p.ws + WS_H) + (size_t)row * D, F.lane);
    }
}

DI void g1_epilogue(const Params& p, int l, const f32x16& acc, int row0, int col0, int lane) {
    const int h = lane >> 5, w = lane & 31, col = col0 + w;
    bf16_t* P = (bf16_t*)(p.ws + WS_P);
    if (col0 < VOFF) {
        const float sc = (col0 < KOFF) ? QSCALE : 1.0f;
        const int axis = (col0 >> 5) & 1, fi = w & 15;
        const f32x2* tab = (const f32x2*)(p.ws + WS_ROPE);
#pragma unroll
        for (int r = 0; r < 16; ++r) {
            const int row = row0 + crow(r, h);
            const float own = acc[r], oth = __shfl_xor(own, 16);
            float o = own;
            if (row < TL) {
                const int t = row & (SEQ - 1), pos = axis ? (t & 63) : (t >> 6);
                const f32x2 cs = tab[pos * 16 + fi];
                o = (w < 16) ? (own * cs.x - oth * cs.y) : (own * cs.x + oth * cs.y);
            }
            P[(size_t)row * PW + col] = (bf16_t)f2bf(o * sc);
        }
    } else if (col0 < POOLOFF) {
        const int hk = (col - VOFF) >> 6, d = (col - VOFF) & 63;
#pragma unroll
        for (int r = 0; r < 16; ++r) {
            const int row = row0 + crow(r, h);
            const bf16_t v = (bf16_t)f2bf(acc[r]);
            if (row < TL) { const int b = row / SEQ, t = row & (SEQ - 1); ((bf16_t*)(p.ws + WS_VT))[((size_t)(b * 2 + hk) * 64 + d) * SEQ + t] = v; }
            else { const int rc = row - TL, b = rc / NCTX, j = rc & (NCTX - 1); ((bf16_t*)(p.ws + WS_VTC))[((size_t)(b * 2 + hk) * 64 + d) * NCTX + j] = v; }
        }
    } else if (col0 < SUOFF) {
#pragma unroll
        for (int r = 0; r < 16; ++r) { const int row = row0 + crow(r, h); P[(size_t)row * PW + col] = (bf16_t)f2bf(acc[r]); }
    } else if (col0 < SVOFF) {
#pragma unroll
        for (int r = 0; r < 16; ++r) { const int row = row0 + crow(r, h); P[(size_t)row * PW + col] = (bf16_t)f2bf(gelu_tanh(acc[r])); }
    } else {
        const int c = col - SVOFF;
#pragma unroll
        for (int r = 0; r < 16; ++r) { const int row = row0 + crow(r, h); const int chunk = row >> 7, q = row & 127;
            ((bf16_t*)(p.ws + WS_VST))[((size_t)chunk * 256 + c) * 128 + q] = (bf16_t)f2bf(gelu_tanh(acc[r])); }
    }
}

DI void phase_g1(const Params& p, const Frame& F, int l) {
    const bf16_t* H = (const bf16_t*)(p.ws + WS_H);
    const bf16_t* W = (const bf16_t*)(p.ws + WS_WIN) + (size_t)l * INW * D;
    const int n_main = (l == 0 ? T / 64 : TL / 64) * (PW / 32);
    const int n_extra = (l == 0) ? 0 : (TC / 64) * 8;
    for (int it = F.gw; it < n_main + n_extra; it += F.ngw) {
        int mt, nt;
        if (it < n_main) { mt = it / (PW / 32); nt = it % (PW / 32); } else { const int e = it - n_main; mt = TL / 64 + e / 8; nt = 16 + (e & 7); }
        f32x16 acc[2][1]; zero_acc(acc);
        wave_gemm<2, 1>(H, D, W, D, D, mt * 64, nt * 32, acc, F.lane);
#pragma unroll 1
        for (int i = 0; i < 2; ++i) g1_epilogue(p, l, i == 0 ? acc[0][0] : acc[1][0], mt * 64 + 32 * i, nt * 32, F.lane);
    }
}

DI bf16x8 pack8(const f32x16& x, int s) {
    u32x4 pk;
#pragma unroll
    for (int j = 0; j < 4; ++j) { f32x2 v = {x[8 * s + 2 * j], x[8 * s + 2 * j + 1]}; pk[j] = __builtin_bit_cast(unsigned, __builtin_convertvector(v, bf16x2_t)); }
    return __builtin_bit_cast(bf16x8, pk);
}

DI void attn_block(const bf16x8 (&qf)[4], const bf16_t* kptr, const bf16_t* vptr, size_t vstride_d32, int mask_mode, int kq_off, int lane,
                   float& m, float& lpart, f32x16 (&o)[2]) {
    const int h = lane >> 5;
    f32x16 st;
#pragma unroll
    for (int r = 0; r < 16; ++r) st[r] = 0.f;
#pragma unroll
    for (int s = 0; s < 4; ++s) { const bf16x8 kf = *(const bf16x8*)(kptr + 16 * s); st = MFMA32(kf, qf[s], st); }
    if (mask_mode) {
#pragma unroll
        for (int r = 0; r < 16; ++r) { const int dlt = kq_off + crow(r, h); if (dlt > 128 || dlt < -128) st[r] = -1e30f; }
    }
    float bm = st[0];
#pragma unroll
    for (int r = 1; r < 16; ++r) bm = fmaxf(bm, st[r]);
    bm = fmaxf(bm, __shfl_xor(bm, 32));
    const float mn = fmaxf(m, bm), alpha = exp2f(m - mn);
    m = mn;
    float ps = 0.f;
#pragma unroll
    for (int r = 0; r < 16; ++r) { st[r] = exp2f(st[r] - mn); ps += st[r]; }
    lpart = lpart * alpha + ps;
#pragma unroll
    for (int d = 0; d < 2; ++d)
#pragma unroll
        for (int r = 0; r < 16; ++r) o[d][r] *= alpha;
    const bf16x8 pf0 = pack8(st, 0), pf1 = pack8(st, 1);
#pragma unroll
    for (int d = 0; d < 2; ++d) {
        const bf16_t* vp = vptr + (size_t)d * vstride_d32;
        const s16x4 a0 = *(const s16x4*)(vp), a1 = *(const s16x4*)(vp + 8), b0 = *(const s16x4*)(vp + 16), b1 = *(const s16x4*)(vp + 24);
        const bf16x8 v0 = __builtin_shufflevector(a0, a1, 0, 1, 2, 3, 4, 5, 6, 7), v1 = __builtin_shufflevector(b0, b1, 0, 1, 2, 3, 4, 5, 6, 7);
        o[d] = MFMA32(v0, pf0, o[d]);
        o[d] = MFMA32(v1, pf1, o[d]);
    }
}

DI void attn_task(const Params& p, int l, int task, int lane) {
    const int r = lane & 31, h = lane >> 5;
    const bf16_t* P = (const bf16_t*)(p.ws + WS_P);
    const bf16_t* VT = (const bf16_t*)(p.ws + WS_VT);
    const bf16_t* VTC = (const bf16_t*)(p.ws + WS_VTC);
    bf16_t* Y = (bf16_t*)(p.ws + WS_Y);
    const bool latent = task < 8192;
    int b, head, qb, q0row, p0;
    if (latent) { qb = task & 127; head = (task >> 7) & 7; b = task >> 10; p0 = qb * 32; q0row = b * SEQ + p0; }
    else { const int t2 = task - 8192; qb = t2 & 7; head = (t2 >> 3) & 7; b = t2 >> 6; p0 = qb * 32; q0row = TL + b * NCTX + p0; }
    const int hk = head >> 2;
    bf16x8 qf[4];
#pragma unroll
    for (int s = 0; s < 4; ++s) qf[s] = *(const bf16x8*)(P + (size_t)(q0row + r) * PW + head * 64 + 16 * s + 8 * h);
    float m = p.attn_sink[l * 8 + head] * LOG2E, lpart = (h == 0) ? 1.0f : 0.0f;
    f32x16 o[2];
#pragma unroll
    for (int d = 0; d < 2; ++d)
#pragma unroll
        for (int i = 0; i < 16; ++i) o[d][i] = 0.f;
    if (latent) {
        for (int kb = p0 - 128; kb <= p0 + 128; kb += 32) {
            if (kb < 0 || kb >= SEQ) continue;
            const bf16_t* kptr = P + (size_t)(b * SEQ + kb + r) * PW + KOFF + hk * 64 + 8 * h;
            const bf16_t* vptr = VT + ((size_t)(b * 2 + hk) * 64 + r) * SEQ + kb + 4 * h;
            const int mm = (kb == p0 - 128 || kb == p0 + 128) ? 1 : 0;
            attn_block(qf, kptr, vptr, (size_t)32 * SEQ, mm, kb - (p0 + r), lane, m, lpart, o);
        }
    }
    for (int kb = 0; kb < NCTX; kb += 32) {
        const bf16_t* kptr = P + (size_t)(TL + b * NCTX + kb + r) * PW + KOFF + hk * 64 + 8 * h;
        const bf16_t* vptr = VTC + ((size_t)(b * 2 + hk) * 64 + r) * NCTX + kb + 4 * h;
        attn_block(qf, kptr, vptr, (size_t)32 * NCTX, 0, 0, lane, m, lpart, o);
    }
    const float inv = 1.0f / (lpart + __shfl_xor(lpart, 32));
    bf16_t* yrow = Y + (size_t)(q0row + r) * D + head * 64;
#pragma unroll
    for (int d = 0; d < 2; ++d)
#pragma unroll
        for (int g = 0; g < 4; ++g) {
            u32x2 w; w.x = pk2(o[d][4 * g] * inv, o[d][4 * g + 1] * inv); w.y = pk2(o[d][4 * g + 2] * inv, o[d][4 * g + 3] * inv);
            *(u32x2*)(yrow + 32 * d + 8 * g + 4 * h) = w;
        }
}

DI void sgu_unit(const Params& p, const Frame& F, int l, int chunk) {
    constexpr int VS = 136;
    LAS float* part = (LAS float*)F.lds;
    LAS float* rq = part + 512;
    LAS bf16_t* vnT = (LAS bf16_t*)(F.lds + 4096);
    const bf16_t* VsT = (const bf16_t*)(p.ws + WS_VST) + (size_t)chunk * 256 * 128;
    const bf16_t* P = (const bf16_t*)(p.ws + WS_P);
    bf16_t* Y = (bf16_t*)(p.ws + WS_Y);
    __syncthreads();
    { const int q = F.tid & 127, part_i = F.tid >> 7; float ss = 0.f;
        for (int c = part_i * 64; c < part_i * 64 + 64; ++c) { const float v = bf2f(VsT[c * 128 + q]); ss += v * v; }
        part[part_i * 128 + q] = ss; }
    __syncthreads();
    if (F.tid < 128) rq[F.tid] = rsqrtf((part[F.tid] + part[128 + F.tid] + part[256 + F.tid] + part[384 + F.tid]) * (1.0f / 256.0f) + EPS);
    __syncthreads();
    for (int i = F.tid; i < 256 * 16; i += NTHREADS) {
        const int c = i >> 4, q8 = (i & 15) * 8;
        const u32x4 v = *(const u32x4*)(VsT + c * 128 + q8);
        u32x4 o;
#pragma unroll
        for (int j = 0; j < 4; ++j) o[j] = pk2(bflo(v[j]) * rq[q8 + 2 * j], bfhi(v[j]) * rq[q8 + 2 * j + 1]);
        *(LAS u32x4*)(vnT + c * VS + q8) = o;
    }
    __syncthreads();
    const int lane = F.lane, r = lane & 31, h = lane >> 5, g = F.wave >> 1, ph = F.wave & 1;
    const bf16_t* Wg = (const bf16_t*)(p.ws + WS_SGUW) + ((size_t)l * 4 + g) * 128 * 128;
#pragma unroll 1
    for (int pb = 0; pb < 2; ++pb) {
        const int p0 = 64 * ph + 32 * pb;
#pragma unroll 1
        for (int cb = 0; cb < 2; ++cb) {
            const int c0 = 64 * g + 32 * cb;
            f32x16 acc;
#pragma unroll
            for (int i = 0; i < 16; ++i) acc[i] = 0.f;
#pragma unroll
            for (int s = 0; s < 8; ++s) {
                const bf16x8 a = *(const LAS bf16x8*)(vnT + (c0 + r) * VS + 16 * s + 8 * h);
                const bf16x8 b = *(const bf16x8*)(Wg + (size_t)(p0 + r) * 128 + 16 * s + 8 * h);
                acc = MFMA32(a, b, acc);
            }
            const int row = chunk * 128 + p0 + r;
            const float bias = p.sgu_b[(l * 4 + g) * 128 + p0 + r];
#pragma unroll
            for (int q4 = 0; q4 < 4; ++q4) {
                const int cc = c0 + 8 * q4 + 4 * h;
                const u32x2 u = *(const u32x2*)(P + (size_t)row * PW + SUOFF + cc);
                u32x2 w;
                w.x = pk2(bflo(u.x) * (acc[4 * q4] + bias), bfhi(u.x) * (acc[4 * q4 + 1] + bias));
                w.y = pk2(bflo(u.y) * (acc[4 * q4 + 2] + bias), bfhi(u.y) * (acc[4 * q4 + 3] + bias));
                *(u32x2*)(Y + (size_t)row * D + 768 + cc) = w;
            }
        }
    }
}

DI void phase_mix(const Params& p, const Frame& F, int l) {
    const int ntask = (l == 0) ? 8192 + 512 : 8192;
    for (int task = F.gw; task < ntask; task += F.ngw) attn_task(p, l, task, F.lane);
    const int nchunk = (l == 0) ? T / 128 : TL / 128;
    for (int ch = blockIdx.x; ch < nchunk; ch += gridDim.x) sgu_unit(p, F, l, ch);
    const int nrows = (l == 0) ? T : TL;
    const bf16_t* P = (const bf16_t*)(p.ws + WS_P);
    bf16_t* Y = (bf16_t*)(p.ws + WS_Y);
    for (int i = F.gtid; i < nrows * 32; i += F.ngt) {
        const int row = i >> 5, ck = i & 31, g = ck >> 3, half = 1 << g;
        int base, t, len;
        if (row < TL) { base = row & ~(SEQ - 1); t = row & (SEQ - 1); len = SEQ; } else { const int rc = row - TL; base = TL + (rc & ~(NCTX - 1)); t = rc & (NCTX - 1); len = NCTX; }
        const int lo = max(t - half, 0), hi = min(t + half, len);
        float s[8];
#pragma unroll
        for (int j = 0; j < 8; ++j) s[j] = 0.f;
        for (int tt = lo; tt < hi; ++tt) {
            const u32x4 v = *(const u32x4*)(P + (size_t)(base + tt) * PW + POOLOFF + ck * 8);
#pragma unroll
            for (int j = 0; j < 4; ++j) { s[2 * j] += bflo(v[j]); s[2 * j + 1] += bfhi(v[j]); }
        }
        const float inv = 1.0f / (float)(hi - lo);
        const u32x4 z = *(const u32x4*)(P + (size_t)row * PW + POOLOFF + ck * 8);
        u32x4 o;
#pragma unroll
        for (int j = 0; j < 4; ++j) o[j] = pk2(s[2 * j] * inv - bflo(z[j]), s[2 * j + 1] * inv - bfhi(z[j]));
        *(u32x4*)(Y + (size_t)row * D + 512 + ck * 8) = o;
    }
}

DI void phase_g2(const Params& p, const Frame& F, int l) {
    const bf16_t* H = (const bf16_t*)(p.ws + WS_H);
    const bf16_t* Yb = (const bf16_t*)(p.ws + WS_Y);
    const bf16_t* Wg = (const bf16_t*)(p.ws + WS_WIN) + (size_t)l * INW * D + (size_t)GATEOFF * D;
    const bf16_t* Wb = (const bf16_t*)(p.ws + WS_WBR) + (size_t)l * D * D;
    bf16_t* M = (bf16_t*)(p.ws + WS_MERGED);
    const int nrows = (l == 0) ? T : TL, nit = (nrows / 64) * (D / 32);
    for (int it = F.gw; it < nit; it += F.ngw) {
        const int mt = it / (D / 32), nt = it % (D / 32), m0 = mt * 64, n0 = nt * 32;
        f32x16 tot[2][1]; zero_acc(tot);
#pragma unroll 1
        for (int i = 0; i < 3; ++i) {
            const int koff = (i == 0) ? 0 : (i == 1 ? 512 : 768), kk = (i == 0) ? 512 : 256;
            f32x16 g[2][1], pr[2][1]; zero_acc(g); zero_acc(pr);
            wave_gemm<2, 1>(H, D, Wg + (size_t)i * D * D, D, D, m0, n0, g, F.lane);
            wave_gemm<2, 1>(Yb + koff, D, Wb + koff, D, kk, m0, n0, pr, F.lane);
#pragma unroll
            for (int a = 0; a < 2; ++a)
#pragma unroll
                for (int r = 0; r < 16; ++r) tot[a][0][r] += sigmoidf_(g[a][0][r]) * pr[a][0][r];
        }
        const int h = F.lane >> 5, col = n0 + (F.lane & 31);
#pragma unroll
        for (int a = 0; a < 2; ++a)
#pragma unroll
            for (int r = 0; r < 16; ++r) M[(size_t)(m0 + 32 * a + crow(r, h)) * D + col] = (bf16_t)f2bf(tot[a][0][r]);
    }
}

DI void phase_g3(const Params& p, const Frame& F, int l) {
    const bf16_t* M = (const bf16_t*)(p.ws + WS_MERGED);
    const bf16_t* W = (const bf16_t*)(p.ws + WS_WOUT) + (size_t)l * D * D;
    const int nrows = (l == 0) ? T : TL, nit = (nrows / 64) * (D / 64);
    for (int it = F.gw; it < nit; it += F.ngw) {
        const int mt = it / (D / 64), nt = it % (D / 64), m0 = mt * 64, n0 = nt * 64;
        f32x16 acc[2][2]; zero_acc(acc);
        wave_gemm<2, 2>(M, D, W, D, D, m0, n0, acc, F.lane);
        const int h = F.lane >> 5;
#pragma unroll
        for (int a = 0; a < 2; ++a)
#pragma unroll
            for (int j = 0; j < 2; ++j) {
                const int col = n0 + 32 * j + (F.lane & 31);
#pragma unroll
                for (int r = 0; r < 16; ++r) {
                    const int row = m0 + 32 * a + crow(r, h);
                    const float xs = (l == 0) ? xin_ptr(p, row)[col] : xrow_ptr(p, row)[col];
                    xrow_ptr(p, row)[col] = xs + mod_vec(p, l, row, 2)[col] * acc[a][j][r];
                }
            }
    }
}

DI void phase_g45(const Params& p, const Frame& F, int l) {
    const bf16_t* H = (const bf16_t*)(p.ws + WS_H);
    const bf16_t* W = (const bf16_t*)(p.ws + WS_WFOLD) + (size_t)l * 2048 * D;
    float* ST = (float*)(p.ws + WS_ST);
    const int nrows = (l == 0) ? T : TL, nit = (2048 / 64) * (nrows / 64);
    for (int it = F.gw; it < nit; it += F.ngw) {
        const int nt = it / 32, mt = it % 32, m0 = mt * 64, n0 = nt * 64;
        f32x16 acc[2][2]; zero_acc(acc);
        wave_gemm<2, 2>(W, D, H, D, D, m0, n0, acc, F.lane);
        const int h = F.lane >> 5;
#pragma unroll
        for (int a = 0; a < 2; ++a)
#pragma unroll
            for (int j = 0; j < 2; ++j)
#pragma unroll
                for (int r = 0; r < 16; ++r) ST[(size_t)(m0 + 32 * a + crow(r, h)) * T + n0 + 32 * j + (F.lane & 31)] = acc[a][j][r];
    }
}

DI unsigned fkey(float f) { const unsigned u = __builtin_bit_cast(unsigned, f); return (u & 0x80000000u) ? ~u : (u | 0x80000000u); }
DI float fkey_inv(unsigned k) { const unsigned u = (k & 0x80000000u) ? (k & 0x7fffffffu) : ~k; return __builtin_bit_cast(float, u); }
#define INSERT16(L, x) do { unsigned x_ = (x); _Pragma("unroll") for (int k_ = 0; k_ < 16; ++k_) { const unsigned hi_ = max(L[k_], x_); x_ = min(L[k_], x_); L[k_] = hi_; } } while (0)

DI void phase_sel(const Params& p, const Frame& F, int l) {
    const float* ST = (const float*)(p.ws + WS_ST);
    unsigned short* IDX = (unsigned short*)(p.ws + WS_IDX);
    float* GW = (float*)(p.ws + WS_GW);
    LAS unsigned char* ib = (LAS unsigned char*)F.lds;
    const int ntok = (l == 0) ? T : TL;
    for (int i0 = blockIdx.x * NTHREADS; i0 < ntok * 8; i0 += gridDim.x * NTHREADS) {
        const int i = i0 + F.tid;
        const int tok = i % ntok, head = i / ntok;
        unsigned la[16], lb[16];
#pragma unroll
        for (int k = 0; k < 16; ++k) { la[k] = 0u; lb[k] = 0u; }
        const float* s0 = ST + (size_t)(head * 256) * T + tok;
#pragma unroll 4
        for (int k = 0; k < 128; ++k) { const unsigned key = (fkey(s0[(size_t)k * T]) & ~127u) | (unsigned)(127 - k); INSERT16(la, key); }
        const float* s1 = s0 + (size_t)128 * T;
#pragma unroll 4
        for (int k = 0; k < 128; ++k) { const unsigned key = (fkey(s1[(size_t)k * T]) & ~127u) | (unsigned)(127 - k); INSERT16(lb, key); }
        float va[16], vb[16];
#pragma unroll
        for (int k = 0; k < 16; ++k) {
            va[k] = fkey_inv(la[k] & ~127u); vb[k] = fkey_inv(lb[k] & ~127u);
            ib[k * NTHREADS + F.tid] = (unsigned char)(127u - (la[k] & 127u));
            ib[(16 + k) * NTHREADS + F.tid] = (unsigned char)(127u - (lb[k] & 127u));
        }
        unsigned lc[16];
#pragma unroll
        for (int k = 0; k < 16; ++k) lc[k] = 0u;
#pragma unroll
        for (int a = 0; a < 16; ++a)
#pragma unroll
            for (int b = 0; b < 16; ++b)
                if ((a + 1) * (b + 1) <= 16) { const unsigned key = (fkey(va[a] + vb[b]) & ~255u) | (unsigned)(255 - (a * 16 + b)); INSERT16(lc, key); }
        float e[16], sum = 0.f; const float v0 = fkey_inv(lc[0] & ~255u);
#pragma unroll
        for (int k = 0; k < 16; ++k) { e[k] = __expf(fkey_inv(lc[k] & ~255u) - v0); sum += e[k]; }
        const float inv = 1.0f / sum;
        asm volatile("s_waitcnt lgkmcnt(0)" ::: "memory");
#pragma unroll
        for (int k = 0; k < 16; ++k) {
            const unsigned pos = 255u - (lc[k] & 255u), a = pos >> 4, b = pos & 15u;
            const unsigned ea = ib[a * NTHREADS + F.tid], eb = ib[(16 + b) * NTHREADS + F.tid];
            IDX[(size_t)tok * 128 + head * 16 + k] = (unsigned short)(ea * 128u + eb);
            GW[(size_t)tok * 128 + head * 16 + k] = e[k] * inv;
        }
        asm volatile("s_waitcnt lgkmcnt(0)" ::: "memory");
    }
}

DI void phase_gather(const Params& p, const Frame& F, int l) {
    const int ntok = (l == 0) ? T : TL, lane = F.lane;
    const bf16_t* H = (const bf16_t*)(p.ws + WS_H);
    const bf16_t* UT = (const bf16_t*)(p.ws + WS_UTAB);
    const bf16_t* VTb = (const bf16_t*)(p.ws + WS_VTAB);
    const unsigned short* IDX = (const unsigned short*)(p.ws + WS_IDX);
    const float* GW = (const float*)(p.ws + WS_GW);
    for (int tok = F.gw; tok < ntok; tok += F.ngw) {
        float hx[16];
        { const u32x4 a = *(const u32x4*)(H + (size_t)tok * D + 8 * lane), b = *(const u32x4*)(H + (size_t)tok * D + 512 + 8 * lane);
#pragma unroll
            for (int j = 0; j < 4; ++j) { hx[2 * j] = bflo(a[j]); hx[2 * j + 1] = bfhi(a[j]); hx[8 + 2 * j] = bflo(b[j]); hx[8 + 2 * j + 1] = bfhi(b[j]); } }
        const int e0 = IDX[(size_t)tok * 128 + lane], e1 = IDX[(size_t)tok * 128 + 64 + lane];
        const float g0 = GW[(size_t)tok * 128 + lane], g1 = GW[(size_t)tok * 128 + 64 + lane];
        float c0 = 0.f, c1 = 0.f;
#pragma unroll 1
        for (int kk = 0; kk < 128; kk += 4) {
            float dsum[4];
#pragma unroll
            for (int u = 0; u < 4; ++u) {
                const int k = kk + u;
                const int e = __shfl((k < 64) ? e0 : e1, k & 63);
                const u32x4 a = *(const u32x4*)(UT + (size_t)e * D + 8 * lane), b = *(const u32x4*)(UT + (size_t)e * D + 512 + 8 * lane);
                float d = 0.f;
#pragma unroll
                for (int j = 0; j < 4; ++j) { d += hx[2 * j] * bflo(a[j]) + hx[2 * j + 1] * bfhi(a[j]); d += hx[8 + 2 * j] * bflo(b[j]) + hx[8 + 2 * j + 1] * bfhi(b[j]); }
                dsum[u] = d;
            }
#pragma unroll
            for (int u = 0; u < 4; ++u) {
                const int k = kk + u;
                const float tot = wave_sum(dsum[u]);
                const float act = gelu_tanh(tot);
                if (k < 64) { if (lane == k) c0 = g0 * act; } else { if (lane == k - 64) c1 = g1 * act; }
            }
        }
        float acc[16];
#pragma unroll
        for (int j = 0; j < 16; ++j) acc[j] = 0.f;
#pragma unroll 1
        for (int kk = 0; kk < 128; kk += 4) {
#pragma unroll
            for (int u = 0; u < 4; ++u) {
                const int k = kk + u;
                const int e = __shfl((k < 64) ? e0 : e1, k & 63);
                const float cf = __shfl((k < 64) ? c0 : c1, k & 63);
                const u32x4 a = *(const u32x4*)(VTb + (size_t)e * D + 8 * lane), b = *(const u32x4*)(VTb + (size_t)e * D + 512 + 8 * lane);
#pragma unroll
                for (int j = 0; j < 4; ++j) { acc[2 * j] += cf * bflo(a[j]); acc[2 * j + 1] += cf * bfhi(a[j]); acc[8 + 2 * j] += cf * bflo(b[j]); acc[8 + 2 * j + 1] += cf * bfhi(b[j]); }
            }
        }
        float* xr = xrow_ptr(p, tok);
        const float* gt2 = mod_vec(p, l, tok, 5);
        float x2[16]; float ss = 0.f;
#pragma unroll
        for (int half = 0; half < 2; ++half)
#pragma unroll
            for (int q = 0; q < 2; ++q) {
                const int col = 512 * half + 8 * lane + 4 * q;
                const f32x4 xv = *(const f32x4*)(xr + col), gv = *(const f32x4*)(gt2 + col);
#pragma unroll
                for (int j = 0; j < 4; ++j) { const float v = xv[j] + gv[j] * acc[8 * half + 4 * q + j]; x2[8 * half + 4 * q + j] = v; ss += v * v; }
            }
        const float rinv = rsqrtf(wave_sum(ss) * (1.0f / D) + EPS);
        if (l == DEPTH - 1) {
#pragma unroll
            for (int half = 0; half < 2; ++half)
#pragma unroll
                for (int q = 0; q < 2; ++q) {
                    const int col = 512 * half + 8 * lane + 4 * q;
                    const f32x4 gv = *(const f32x4*)(p.g_final + col);
                    f32x4 o;
#pragma unroll
                    for (int j = 0; j < 4; ++j) o[j] = x2[8 * half + 4 * q + j] * rinv * gv[j];
                    *(f32x4*)(xr + col) = o;
                }
        } else {
            const float* g = p.g_mix + (l + 1) * D; const float* sh = mod_vec(p, l + 1, tok, 0); const float* sc = mod_vec(p, l + 1, tok, 1);
            bf16_t* hrow = (bf16_t*)(p.ws + WS_H) + (size_t)tok * D;
#pragma unroll
            for (int half = 0; half < 2; ++half) {
                u32x4 hw;
#pragma unroll
                for (int q = 0; q < 2; ++q) {
                    const int col = 512 * half + 8 * lane + 4 * q;
                    const f32x4 gv = *(const f32x4*)(g + col), s1 = *(const f32x4*)(sh + col), s2 = *(const f32x4*)(sc + col);
                    f32x4 xo, ho;
#pragma unroll
                    for (int j = 0; j < 4; ++j) { xo[j] = x2[8 * half + 4 * q + j]; ho[j] = xo[j] * rinv * gv[j] * (1.0f + s2[j]) + s1[j]; }
                    *(f32x4*)(xr + col) = xo;
                    hw[2 * q] = pk2(ho[0], ho[1]); hw[2 * q + 1] = pk2(ho[2], ho[3]);
                }
                *(u32x4*)(hrow + 512 * half + 8 * lane) = hw;
            }
        }
    }
}

constexpr int NPHASE = 18;
template <int PH> DI void run_phase(const Params& p, const Frame& F) {
    if constexpr (PH == 0) phase_prep(p, F);
    else if constexpr (PH == 1) phase_norm(p, F, 0, 0, true);
    else if constexpr (PH == 2) phase_g1(p, F, 0);
    else if constexpr (PH == 3) phase_mix(p, F, 0);
    else if constexpr (PH == 4) phase_g2(p, F, 0);
    else if constexpr (PH == 5) phase_g3(p, F, 0);
    else if constexpr (PH == 6) phase_norm(p, F, 0, 1, false);
    else if constexpr (PH == 7) phase_g45(p, F, 0);
    else if constexpr (PH == 8) phase_sel(p, F, 0);
    else if constexpr (PH == 9) phase_gather(p, F, 0);
    else if constexpr (PH == 10) { phase_g1(p, F, 1); convert_tables(p, F, 1); }
    else if constexpr (PH == 11) phase_mix(p, F, 1);
    else if constexpr (PH == 12) phase_g2(p, F, 1);
    else if constexpr (PH == 13) phase_g3(p, F, 1);
    else if constexpr (PH == 14) phase_norm(p, F, 1, 1, false);
    else if constexpr (PH == 15) phase_g45(p, F, 1);
    else if constexpr (PH == 16) phase_sel(p, F, 1);
    else if constexpr (PH == 17) phase_gather(p, F, 1);
}
DI Frame make_frame(unsigned char* lds_raw) {
    Frame F;
    F.lds = (LAS unsigned char*)lds_raw;
    F.tid = threadIdx.x; F.lane = F.tid & 63; F.wave = __builtin_amdgcn_readfirstlane(F.tid >> 6);
    F.gw = blockIdx.x * NWAVES + F.wave; F.ngw = gridDim.x * NWAVES; F.gtid = blockIdx.x * NTHREADS + F.tid; F.ngt = gridDim.x * NTHREADS;
    return F;
}
template <int PH> __global__ void __launch_bounds__(NTHREADS, 2) phase_kernel(Params p) {
    extern __shared__ __attribute__((aligned(16))) unsigned char lds_raw[];
    const Frame F = make_frame(lds_raw);
    run_phase<PH>(p, F);
}
template <int PH> DI void run_all(const Params& p, const Frame& F, cg::grid_group& grid) {
    if constexpr (PH < NPHASE) {
        run_phase<PH>(p, F);
        if constexpr (PH + 1 < NPHASE) grid.sync();
        run_all<PH + 1>(p, F, grid);
    }
}
__global__ void __launch_bounds__(NTHREADS, 2) mega(Params p) {
    extern __shared__ __attribute__((aligned(16))) unsigned char lds_raw[];
    const Frame F = make_frame(lds_raw);
    cg::grid_group grid = cg::this_grid();
    run_all<0>(p, F, grid);
}

extern "C" void kernel_launch(void* const* d_in, const int* in_sizes, int n_in, void* d_out, int out_size, void* d_ws, size_t ws_size, hipStream_t stream) {
    static int grid = 0;
    if (grid == 0) {
        if (n_in != 23 || out_size != TL * D || ws_size < WS_END) { fprintf(stderr, "kernel_launch: unexpected shapes (n_in %d out %d ws %zu)\n", n_in, out_size, ws_size); grid = -1; return; }
        int dev = 0, cus = 0, per_cu = 0;
        (void)hipGetDevice(&dev);
        (void)hipDeviceGetAttribute(&cus, hipDeviceAttributeMultiprocessorCount, dev);
        (void)hipFuncSetAttribute((const void*)mega, hipFuncAttributeMaxDynamicSharedMemorySize, LDS_BYTES);
        (void)hipOccupancyMaxActiveBlocksPerMultiprocessor(&per_cu, (const void*)mega, NTHREADS, LDS_BYTES);
        if (per_cu < 1) { fprintf(stderr, "kernel_launch: occupancy query reports %d blocks per CU\n", per_cu); grid = -1; return; }
        grid = cus;
    }
    if (grid < 0) return;
    (void)hipMemsetAsync((char*)d_ws + WS_CTL, 0, CTL_ZERO_BYTES, stream);
    Params p{};
    const float** dst = (const float**)&p;
    for (int i = 0; i < 23; ++i) dst[i] = (const float*)d_in[i];
    p.out = (float*)d_out; p.ws = (unsigned char*)d_ws;
    void* args[] = {&p};
    hipError_t e = hipLaunchCooperativeKernel((const void*)mega, dim3(grid), dim3(NTHREADS), args, LDS_BYTES, stream);
    if (e != hipSuccess) fprintf(stderr, "cooperative launch failed: %s (grid %d)\n", hipGetErrorString(e), grid);
}
```

```cpp
#include <hip/hip_runtime.h>
#include <hip/hip_cooperative_groups.h>
#include <stdint.h>
#include <stdio.h>
namespace cg = cooperative_groups;

#ifndef MK_SINGLE
#define MK_SINGLE 0
#endif

#define LAS __attribute__((address_space(3)))
typedef unsigned short bf16_t;
typedef short bf16x8 __attribute__((ext_vector_type(8)));
typedef short s16x4 __attribute__((ext_vector_type(4)));
typedef float f32x4 __attribute__((ext_vector_type(4)));
typedef float f32x2 __attribute__((ext_vector_type(2)));
typedef float f32x16 __attribute__((ext_vector_type(16)));
typedef unsigned u32x4 __attribute__((ext_vector_type(4)));
typedef unsigned u32x2 __attribute__((ext_vector_type(2)));
typedef __bf16 bf16x2_t __attribute__((ext_vector_type(2)));
#define DI __device__ __forceinline__
#define MFMA32(a, b, c) __builtin_amdgcn_mfma_f32_32x32x16_bf16((a), (b), (c), 0, 0, 0)

constexpr int D = 1024, NB = 8, SEQ = 4096, NCTX = 256, DEPTH = 2;
constexpr int TL = NB * SEQ, TC = NB * NCTX, T = TL + TC;
constexpr int INW = 4608, NMOD = 6 * D, PW = 1536;
constexpr int QOFF = 0, KOFF = 512, VOFF = 640, POOLOFF = 768, SUOFF = 1024, SVOFF = 1280, GATEOFF = 1536;
constexpr int NEXP = 16384;
constexpr float EPS = 1e-6f;
constexpr float LOG2E = 1.4426950408889634f;
constexpr float QSCALE = 0.125f * LOG2E;

constexpr size_t MiB = 1u << 20;
constexpr size_t WS_CTL = 0, WS_MOD = 1 * MiB, CTL_ZERO_BYTES = 2 * MiB;
constexpr size_t WS_ROPE = 2 * MiB, WS_SGUW = 2 * MiB + 65536;
constexpr size_t WS_WIN = 4 * MiB, WS_WBR = 22 * MiB, WS_WOUT = 26 * MiB, WS_WFOLD = 30 * MiB;
constexpr size_t WS_XCTX = 38 * MiB, WS_UTAB = 46 * MiB, WS_VTAB = 78 * MiB;
constexpr size_t WS_IDX = 110 * MiB, WS_GW = 120 * MiB;
constexpr size_t WS_H = 142 * MiB;
constexpr size_t WS_P = 210 * MiB, WS_Y = 312 * MiB, WS_MERGED = 380 * MiB, WS_VT = 448 * MiB, WS_VTC = 456 * MiB, WS_VST = 460 * MiB;
constexpr size_t WS_ST = 210 * MiB;
constexpr size_t WS_END = 512 * MiB;
static_assert(WS_ST + (size_t)2048 * T * 4 <= WS_END, "ST fits");
static_assert(WS_VST + (size_t)272 * 256 * 128 * 2 <= WS_END, "VsT fits");
static_assert(WS_H + (size_t)T * D * 2 <= WS_P, "H fits");
static_assert(WS_P + (size_t)T * PW * 2 <= WS_Y && WS_Y + (size_t)T * D * 2 <= WS_MERGED && WS_MERGED + (size_t)T * D * 2 <= WS_VT, "P/Y/MERGED fit");
static_assert(WS_IDX + (size_t)T * 128 * 2 <= WS_GW && WS_GW + (size_t)T * 128 * 4 <= WS_H, "idx/gw fit");

constexpr int LDS_BYTES = 147456;
constexpr int NTHREADS = 512, NWAVES = 8;

enum { I_x, I_c, I_ctx, I_c_ctx, I_w_mod, I_b_mod, I_g_mix, I_g_ffn, I_w_in, I_attn_sink, I_pool_w, I_pool_scale, I_sgu_w, I_sgu_b, I_w_br_attn, I_w_br_pool, I_w_br_sgu, I_w_out, I_peer_wq, I_peer_subkeys, I_peer_u, I_peer_v, I_g_final, N_IN };
struct Params {
    const float* in[N_IN];
    float* out; unsigned char* ws;
    int ph_lo, ph_hi;
};

DI unsigned f2bf(float f) { unsigned u = __builtin_bit_cast(unsigned, f); return (u + 0x7fffu + ((u >> 16) & 1u)) >> 16; }
DI unsigned pk2(float lo, float hi) { return f2bf(lo) | (f2bf(hi) << 16); }
DI float bf2f(unsigned short u) { return __builtin_bit_cast(float, (unsigned)u << 16); }
DI float bflo(unsigned w) { return __builtin_bit_cast(float, w << 16); }
DI float bfhi(unsigned w) { return __builtin_bit_cast(float, w & 0xffff0000u); }
DI int crow(int reg, int h) { return (reg & 3) + 8 * (reg >> 2) + 4 * h; }
DI float wave_sum(float v) {
#pragma unroll
    for (int o = 1; o < 64; o <<= 1) v += __shfl_xor(v, o);
    return v;
}
DI float sigmoidf_(float x) { return 1.0f / (1.0f + __expf(-x)); }
DI float gelu_tanh(float x) { const float u = 0.7978845608028654f * (x + 0.044715f * x * x * x); return x / (1.0f + __expf(-2.0f * u)); }
DI float silu_(float x) { return x / (1.0f + __expf(-x)); }

struct Frame {
    int tid, lane, wave, gw, ngw, gtid, ngt, bid, nb;
    LAS unsigned char* lds;
};

template <int NM, int NN>
DI void wave_gemm(const bf16_t* __restrict__ A, int lda, const bf16_t* __restrict__ Bt, int ldb, int K, int m0, int n0, f32x16 (&acc)[NM][NN], int lane) {
    const int r = lane & 31, h = lane >> 5;
    const bf16_t* ap = A + (size_t)(m0 + r) * lda + 8 * h;
    const bf16_t* bp = Bt + (size_t)(n0 + r) * ldb + 8 * h;
    for (int k0 = 0; k0 < K; k0 += 16) {
        bf16x8 a[NM], b[NN];
#pragma unroll
        for (int i = 0; i < NM; ++i) a[i] = *(const bf16x8*)(ap + (size_t)(32 * i) * lda + k0);
#pragma unroll
        for (int j = 0; j < NN; ++j) b[j] = *(const bf16x8*)(bp + (size_t)(32 * j) * ldb + k0);
#pragma unroll
        for (int i = 0; i < NM; ++i)
#pragma unroll
            for (int j = 0; j < NN; ++j) acc[i][j] = MFMA32(a[i], b[j], acc[i][j]);
    }
}
template <int NM, int NN> DI void zero_acc(f32x16 (&acc)[NM][NN]) {
#pragma unroll
    for (int i = 0; i < NM; ++i)
#pragma unroll
        for (int j = 0; j < NN; ++j)
#pragma unroll
            for (int r = 0; r < 16; ++r) acc[i][j][r] = 0.f;
}

namespace pg8 {
constexpr int BM = 256, BK = 64, HALF = 128, HTB = HALF * BK * 2, STAGE_BYTES = 8 * HTB, NXCD = 8, WGM = 8, LD = 1024;
DI int lds_byte(int r, int c) { const int st = (r >> 4) * 2 + (c >> 5), rr = r & 15, cc = c & 31, ob = rr * 64 + cc * 2; return st * 1024 + (ob ^ (((ob >> 9) & 1) << 5)); }
DI void stage_rc(int b, int& R, int& C) { const int st = b / 1024, sb = b % 1024, swz = sb ^ (((sb >> 9) & 1) << 5); R = (st >> 1) * 16 + swz / 64; C = (st & 1) * 32 + (swz % 64) / 2; }
DI int perm32(int rho) { const int n = rho >> 4, i = rho & 15; return 8 * (i >> 2) + 4 * n + (i & 3); }
struct Unit { int pm, pn, sub, nt; const char* a; const char* b; };
DI void tile_of(int L, int nM, int nN, int& pm, int& pn) {
    const int nwg = nM * nN; int wgid = L;
    { const int q = nwg / NXCD, r = nwg % NXCD, xcd = wgid % NXCD, off = wgid / NXCD; wgid = (xcd < r ? xcd * (q + 1) : r * (q + 1) + (xcd - r) * q) + off; }
    const int nig = WGM * nN, gid = wgid / nig, fm = gid * WGM, gsz = (nM - fm) < WGM ? (nM - fm) : WGM;
    pm = fm + ((wgid % nig) % gsz); pn = (wgid % nig) / gsz;
}
template <class Epi, class Sched>
DI void gemm_phase(LAS unsigned char* lds, const int tid, const Sched& S, const Epi& E) {
    const int wid = __builtin_amdgcn_readfirstlane(tid >> 6), lane = tid & 63, wr = wid >> 2, wc = wid & 3, fr = lane & 15, fq = lane >> 4;
    unsigned voffA[2], voffB[2];
#pragma unroll
    for (int i = 0; i < 2; ++i) { int R, C; stage_rc(tid * 16 + i * 8192, R, C); const int Rb = Epi::PERM ? ((R & ~31) + perm32(R & 31)) : R;
        voffA[i] = (unsigned)(R * LD + C) * 2u; voffB[i] = (unsigned)(Rb * LD + C) * 2u; }
    const size_t kstep = (size_t)(BK * 2);
    const size_t hstep = (size_t)HALF * LD * 2;
    const unsigned ldsw = (unsigned)wid * 1024u;
    const int aoff = lds_byte(wr * 64 + fr, fq * 8), boff = lds_byte(wc * 32 + fr, fq * 8);
#define PG8_SA(b, h) (((b) * 2 + (h)) * HTB)
#define PG8_SB(b, h) ((4 + (b) * 2 + (h)) * HTB)
#define PG8_STAGE(bufoff, gbase, voff) do { _Pragma("unroll") for (int _i = 0; _i < 2; ++_i) \
        __builtin_amdgcn_global_load_lds((const unsigned*)((const char*)(gbase) + (voff)[_i]), (LAS unsigned*)(lds + (bufoff) + ldsw + _i * 8192), 16, 0, 0); } while (0)
#define PG8_LDA(dst, b, h) do { _Pragma("unroll") for (int m = 0; m < 4; ++m) _Pragma("unroll") for (int k = 0; k < 2; ++k) dst[m][k] = *(const LAS bf16x8*)(lds + PG8_SA(b, h) + aoff + m * 2048 + k * 1024); } while (0)
#define PG8_LDB(dst, b, h) do { _Pragma("unroll") for (int n = 0; n < 2; ++n) _Pragma("unroll") for (int k = 0; k < 2; ++k) dst[n][k] = *(const LAS bf16x8*)(lds + PG8_SB(b, h) + boff + n * 2048 + k * 1024); } while (0)
#define PG8_MMA(ai, bj, At, Bt) do { __builtin_amdgcn_s_setprio(1); _Pragma("unroll") for (int m = 0; m < 4; ++m) _Pragma("unroll") for (int n = 0; n < 2; ++n) _Pragma("unroll") for (int k = 0; k < 2; ++k) \
        acc[ai][bj][m][n] = __builtin_amdgcn_mfma_f32_16x16x32_bf16(Bt[n][k], At[m][k], acc[ai][bj][m][n], 0, 0, 0); __builtin_amdgcn_s_setprio(0); } while (0)
#define PG8_WAIT_V(n) asm volatile("s_waitcnt vmcnt(" #n ")" ::: "memory")
#define PG8_WAIT_L(n) asm volatile("s_waitcnt lgkmcnt(" #n ")" ::: "memory")
#define PG8_BAR __builtin_amdgcn_s_barrier()
#define PG8_SCHED __builtin_amdgcn_sched_barrier(0)
    Unit cur, nxt; int ui = 0;
    if (!S.next(0, cur)) return;
    f32x4 acc[2][2][4][2];
#pragma unroll
    for (int a = 0; a < 2; ++a)
#pragma unroll
        for (int b = 0; b < 2; ++b)
#pragma unroll
            for (int m = 0; m < 4; ++m)
#pragma unroll
                for (int n = 0; n < 2; ++n) acc[a][b][m][n] = (f32x4){0.f, 0.f, 0.f, 0.f};
    bf16x8 At[4][2], B0[2][2], B1[2][2];
    const char* cA = cur.a; const char* cB = cur.b;
    PG8_STAGE(PG8_SB(0, 0), cB, voffB); PG8_STAGE(PG8_SB(0, 1), cB + hstep, voffB); PG8_STAGE(PG8_SA(0, 0), cA, voffA); PG8_STAGE(PG8_SA(0, 1), cA + hstep, voffA);
    if (wr == 1) PG8_BAR;
    PG8_WAIT_V(2); PG8_BAR;
    PG8_STAGE(PG8_SB(1, 0), cB + kstep, voffB); PG8_STAGE(PG8_SA(1, 0), cA + kstep, voffA); PG8_STAGE(PG8_SB(1, 1), cB + hstep + kstep, voffB);
    PG8_WAIT_V(6); PG8_BAR;
    for (;;) {
        const bool has_next = S.next(ui + 1, nxt);
        const char* nA = has_next ? nxt.a : cA; const char* nB = has_next ? nxt.b : cB;
        const int nt = cur.nt;
        for (int t = 0; t < nt; t += 2) {
            const bool last = (t == nt - 2);
            const char* a1 = cA + (size_t)(t + 1) * kstep;
            const char* a2 = last ? nA : cA + (size_t)(t + 2) * kstep; const char* b2 = last ? nB : cB + (size_t)(t + 2) * kstep;
            const char* a3 = a2 + kstep; const char* b3 = b2 + kstep;
            PG8_LDB(B0, 0, 0); PG8_LDB(B1, 0, 1); PG8_SCHED; PG8_LDA(At, 0, 0); PG8_STAGE(PG8_SA(1, 1), a1 + hstep, voffA);
            PG8_WAIT_V(8); PG8_WAIT_L(0); PG8_BAR; PG8_MMA(0, 0, At, B0); PG8_MMA(0, 1, At, B1); PG8_BAR; PG8_SCHED;
            PG8_LDA(At, 0, 1); PG8_STAGE(PG8_SB(0, 0), b2, voffB); PG8_STAGE(PG8_SB(0, 1), b2 + hstep, voffB); PG8_STAGE(PG8_SA(0, 0), a2, voffA);
            PG8_WAIT_V(8); PG8_WAIT_L(0); PG8_BAR; PG8_MMA(1, 0, At, B0); PG8_MMA(1, 1, At, B1); PG8_BAR; PG8_SCHED;
            PG8_LDB(B0, 1, 0); PG8_LDB(B1, 1, 1); PG8_SCHED; PG8_LDA(At, 1, 0); PG8_STAGE(PG8_SA(0, 1), a2 + hstep, voffA);
            PG8_WAIT_V(8); PG8_WAIT_L(0); PG8_BAR; PG8_MMA(0, 0, At, B0); PG8_MMA(0, 1, At, B1); PG8_BAR; PG8_SCHED;
            PG8_LDA(At, 1, 1); PG8_STAGE(PG8_SB(1, 0), b3, voffB); PG8_STAGE(PG8_SB(1, 1), b3 + hstep, voffB); PG8_STAGE(PG8_SA(1, 0), a3, voffA);
            PG8_WAIT_V(8); PG8_WAIT_L(0); PG8_BAR; PG8_MMA(1, 0, At, B0); PG8_MMA(1, 1, At, B1); PG8_BAR; PG8_SCHED;
        }
        if (wr == 0) PG8_BAR;
        E(acc, cur, wr, wc, fr, fq);
        if (!has_next) break;
#pragma unroll
        for (int a = 0; a < 2; ++a)
#pragma unroll
            for (int b = 0; b < 2; ++b)
#pragma unroll
                for (int m = 0; m < 4; ++m)
#pragma unroll
                    for (int n = 0; n < 2; ++n) acc[a][b][m][n] = (f32x4){0.f, 0.f, 0.f, 0.f};
        cur = nxt; cA = nA; cB = nB; ++ui;
        if (wr == 1) PG8_BAR;
    }
    PG8_WAIT_V(0);
    PG8_BAR;
#undef PG8_SA
#undef PG8_SB
#undef PG8_STAGE
#undef PG8_LDA
#undef PG8_LDB
#undef PG8_MMA
#undef PG8_WAIT_V
#undef PG8_WAIT_L
#undef PG8_BAR
#undef PG8_SCHED
}
}

DI void transpose_item(const float* W, int K, int N, bf16_t* WT, int ldd, int row_off, int col_off, LAS float* scr, int item, int lane) {
    const int nblk = N / 32, kb = item / nblk, nb = item % nblk, k0 = 64 * kb, n0 = 32 * nb;
#pragma unroll 8
    for (int i = 0; i < 32; ++i) { const int kk = 2 * i + (lane >> 5); scr[kk * 33 + (lane & 31)] = W[(size_t)(k0 + kk) * N + n0 + (lane & 31)]; }
    asm volatile("s_waitcnt lgkmcnt(0)" ::: "memory");
    const int c = lane & 7;
#pragma unroll
    for (int j = 0; j < 4; ++j) { const int n = (lane >> 3) + 8 * j; const LAS float* s = scr + (8 * c) * 33 + n;
        u32x4 o; o.x = pk2(s[0 * 33], s[1 * 33]); o.y = pk2(s[2 * 33], s[3 * 33]); o.z = pk2(s[4 * 33], s[5 * 33]); o.w = pk2(s[6 * 33], s[7 * 33]);
        *(u32x4*)(WT + (size_t)(row_off + n0 + n) * ldd + col_off + k0 + 8 * c) = o; }
    asm volatile("s_waitcnt lgkmcnt(0)" ::: "memory");
}

DI void convert_tables(const Params& p, const Frame& F, int layer) {
    const size_t n4 = (size_t)NEXP * D / 4;
    const f32x4* su = (const f32x4*)(p.in[I_peer_u] + (size_t)layer * NEXP * D);
    const f32x4* sv = (const f32x4*)(p.in[I_peer_v] + (size_t)layer * NEXP * D);
    u32x2* du = (u32x2*)(p.ws + WS_UTAB); u32x2* dv = (u32x2*)(p.ws + WS_VTAB);
    for (size_t i = F.gtid; i < n4; i += F.ngt) {
        const f32x4 a = su[i], b = sv[i];
        u32x2 oa, ob; oa.x = pk2(a.x, a.y); oa.y = pk2(a.z, a.w); ob.x = pk2(b.x, b.y); ob.y = pk2(b.z, b.w);
        du[i] = oa; dv[i] = ob;
    }
}

DI void phase_prep(const Params& p, const Frame& F) {
    unsigned char* ws = p.ws;
    {
        LAS float* wq = (LAS float*)F.lds;
        for (int it = F.bid; it < 2 * 16 * 16; it += F.nb) {
            const int cc = it & 15, hp = (it >> 4) & 15, l = it >> 8;
            const float* src = p.in[I_peer_wq] + (size_t)l * D * 2048 + hp * 128;
            __syncthreads();
            for (int e = F.tid; e < 64 * 128; e += NTHREADS) { const int ci = e >> 7, d = e & 127; wq[d * 65 + ci] = src[(size_t)(cc * 64 + ci) * 2048 + d]; }
            __syncthreads();
            const int ci = F.tid & 63, kg = F.tid >> 6;
            const float* sk = p.in[I_peer_subkeys] + ((size_t)(l * 16 + hp) * 128 + 16 * kg) * 128;
            float acc[16];
#pragma unroll
            for (int k = 0; k < 16; ++k) acc[k] = 0.f;
            for (int d = 0; d < 128; ++d) { const float w = wq[d * 65 + ci];
#pragma unroll
                for (int k = 0; k < 16; ++k) acc[k] += w * sk[k * 128 + d]; }
            bf16_t* dst = (bf16_t*)(ws + WS_WFOLD) + ((size_t)l * 2048 + hp * 128 + 16 * kg) * D + cc * 64 + ci;
#pragma unroll
            for (int k = 0; k < 16; ++k) dst[(size_t)k * D] = (bf16_t)f2bf(acc[k]);
        }
        __syncthreads();
    }
    {
        LAS float* scr = (LAS float*)(F.lds + F.wave * 16384);
        constexpr int I_IN = (D / 64) * (INW / 32), I_BA = (512 / 64) * (D / 32), I_BS = (256 / 64) * (D / 32), I_O = (D / 64) * (D / 32);
        constexpr int PER_L = I_IN + I_BA + I_BS + I_O;
        for (int it = F.gw; it < 2 * PER_L; it += F.ngw) {
            const int l = it / PER_L; int r = it % PER_L;
            if (r < I_IN) { transpose_item(p.in[I_w_in] + (size_t)l * D * INW, D, INW, (bf16_t*)(ws + WS_WIN) + (size_t)l * INW * D, D, 0, 0, scr, r, F.lane); continue; } r -= I_IN;
            if (r < I_BA) { transpose_item(p.in[I_w_br_attn] + (size_t)l * 512 * D, 512, D, (bf16_t*)(ws + WS_WBR) + (size_t)l * D * D, D, 0, 0, scr, r, F.lane); continue; } r -= I_BA;
            if (r < I_BS) { transpose_item(p.in[I_w_br_sgu] + (size_t)l * 256 * D, 256, D, (bf16_t*)(ws + WS_WBR) + (size_t)l * D * D, D, 0, 768, scr, r, F.lane); continue; } r -= I_BS;
            transpose_item(p.in[I_w_out] + (size_t)l * D * D, D, D, (bf16_t*)(ws + WS_WOUT) + (size_t)l * D * D, D, 0, 0, scr, r, F.lane);
        }
    }
    for (int i = F.gtid; i < 2 * 256 * D; i += F.ngt) {
        const int n = i & 1023, rc = (i >> 10) & 255, l = i >> 18, g = rc >> 6;
        const float* pw = p.in[I_pool_w] + ((size_t)l * 256 + rc) * 64;
        const float* ps = p.in[I_pool_scale] + l * 256 + 64 * g;
        const float* wb = p.in[I_w_br_pool] + ((size_t)l * 256 + 64 * g) * D + n;
        float a = 0.f;
        for (int e = 0; e < 64; ++e) a += pw[e] * ps[e] * wb[(size_t)e * D];
        ((bf16_t*)(ws + WS_WBR))[(size_t)l * D * D + (size_t)n * D + 512 + rc] = (bf16_t)f2bf(a);
    }
    for (int i = F.gtid; i < 2 * 4 * 128 * 128; i += F.ngt) ((bf16_t*)(ws + WS_SGUW))[i] = (bf16_t)f2bf(p.in[I_sgu_w][i]);
    for (int i = F.gtid; i < 64 * 16; i += F.ngt) {
        const int pos = i >> 4, fi = i & 15;
        const float inv = powf(10000.0f, -(float)fi / 16.0f);
        const float ang = (float)pos * inv;
        ((f32x2*)(ws + WS_ROPE))[i] = (f32x2){cosf(ang), sinf(ang)};
    }
    convert_tables(p, F, 0);
    {
        float* MOD = (float*)(ws + WS_MOD);
        LAS float* scd = (LAS float*)F.lds;
        LAS float* red = scd + 9 * D;
        __syncthreads();
        for (int e = F.tid; e < 9 * D; e += NTHREADS) { const int r = e >> 10, k = e & 1023; scd[e] = silu_((r < 8) ? p.in[I_c][r * D + k] : p.in[I_c_ctx][k]); }
        __syncthreads();
        for (int it = F.bid; it < 2 * 96; it += F.nb) {
            const int cgp = it % 96, l = it / 96, col = cgp * 64 + F.lane;
            float acc[9];
#pragma unroll
            for (int r = 0; r < 9; ++r) acc[r] = 0.f;
            const float* wp = p.in[I_w_mod] + ((size_t)l * D + F.wave * 128) * NMOD + col;
#pragma unroll 4
            for (int k = 0; k < 128; ++k) {
                const float w = wp[(size_t)k * NMOD];
#pragma unroll
                for (int r = 0; r < 9; ++r) acc[r] += scd[r * D + F.wave * 128 + k] * w;
            }
#pragma unroll
            for (int r = 0; r < 9; ++r) red[(F.wave * 9 + r) * 64 + F.lane] = acc[r];
            __syncthreads();
            for (int e = F.tid; e < 9 * 64; e += NTHREADS) {
                const int r = e >> 6, ln = e & 63; float s = p.in[I_b_mod][l * NMOD + cgp * 64 + ln];
#pragma unroll
                for (int w = 0; w < 8; ++w) s += red[(w * 9 + r) * 64 + ln];
                MOD[((size_t)l * 9 + r) * NMOD + cgp * 64 + ln] = s;
            }
            __syncthreads();
        }
    }
}

DI const float* mod_vec(const Params& p, int l, int row, int j) {
    const int r = row < TL ? row / SEQ : 8;
    return (const float*)(p.ws + WS_MOD) + ((size_t)l * 9 + r) * NMOD + j * D;
}
DI float* xrow_ptr(const Params& p, int row) { return row < TL ? p.out + (size_t)row * D : (float*)(p.ws + WS_XCTX) + (size_t)(row - TL) * D; }
DI const float* xin_ptr(const Params& p, int row) { return row < TL ? p.in[I_x] + (size_t)row * D : p.in[I_ctx] + (size_t)(row - TL) * D; }

DI void modulate_row_wave(const float* src, const float* g, const float* sh, const float* sc, bf16_t* dst, int lane) {
    f32x4 v[4]; float ss = 0.f;
#pragma unroll
    for (int j = 0; j < 4; ++j) { v[j] = ((const f32x4*)src)[lane + 64 * j]; ss += v[j].x * v[j].x + v[j].y * v[j].y + v[j].z * v[j].z + v[j].w * v[j].w; }
    const float rinv = rsqrtf(wave_sum(ss) * (1.0f / D) + EPS);
#pragma unroll
    for (int j = 0; j < 4; ++j) {
        const f32x4 gg = ((const f32x4*)g)[lane + 64 * j], s1 = ((const f32x4*)sh)[lane + 64 * j], s2 = ((const f32x4*)sc)[lane + 64 * j];
        const f32x4 o = v[j] * rinv * gg * (s2 + 1.0f) + s1;
        u32x2 w; w.x = pk2(o.x, o.y); w.y = pk2(o.z, o.w);
        ((u32x2*)dst)[lane + 64 * j] = w;
    }
}

DI void phase_norm(const Params& p, const Frame& F, int l, int which  , bool from_input) {
    const int nrows = (l == 0) ? T : TL;
    const float* g = (which == 0 ? p.in[I_g_mix] : p.in[I_g_ffn]) + l * D;
    for (int row = F.gw; row < nrows; row += F.ngw) {
        const float* src = from_input ? xin_ptr(p, row) : xrow_ptr(p, row);
        modulate_row_wave(src, g, mod_vec(p, l, row, which * 3 + 0), mod_vec(p, l, row, which * 3 + 1), (bf16_t*)(p.ws + WS_H) + (size_t)row * D, F.lane);
    }
}

DI void g1_epilogue(const Params& p, int l, const f32x16& acc, int row0, int col0, int lane) {
    const int h = lane >> 5, w = lane & 31, col = col0 + w;
    bf16_t* P = (bf16_t*)(p.ws + WS_P);
    if (col0 < VOFF) {
        const float sc = (col0 < KOFF) ? QSCALE : 1.0f;
        const int axis = (col0 >> 5) & 1, fi = w & 15;
        const f32x2* tab = (const f32x2*)(p.ws + WS_ROPE);
#pragma unroll
        for (int r = 0; r < 16; ++r) {
            const int row = row0 + crow(r, h);
            const float own = acc[r], oth = __shfl_xor(own, 16);
            float o = own;
            if (row < TL) {
                const int t = row & (SEQ - 1), pos = axis ? (t & 63) : (t >> 6);
                const f32x2 cs = tab[pos * 16 + fi];
                o = (w < 16) ? (own * cs.x - oth * cs.y) : (own * cs.x + oth * cs.y);
            }
            P[(size_t)row * PW + col] = (bf16_t)f2bf(o * sc);
        }
    } else if (col0 < POOLOFF) {
        const int hk = (col - VOFF) >> 6, d = (col - VOFF) & 63;
#pragma unroll
        for (int r = 0; r < 16; ++r) {
            const int row = row0 + crow(r, h);
            const bf16_t v = (bf16_t)f2bf(acc[r]);
            if (row < TL) { const int b = row / SEQ, t = row & (SEQ - 1); ((bf16_t*)(p.ws + WS_VT))[((size_t)(b * 2 + hk) * 64 + d) * SEQ + t] = v; }
            else { const int rc = row - TL, b = rc / NCTX, j = rc & (NCTX - 1); ((bf16_t*)(p.ws + WS_VTC))[((size_t)(b * 2 + hk) * 64 + d) * NCTX + j] = v; }
        }
    } else if (col0 < SUOFF) {
#pragma unroll
        for (int r = 0; r < 16; ++r) { const int row = row0 + crow(r, h); P[(size_t)row * PW + col] = (bf16_t)f2bf(acc[r]); }
    } else if (col0 < SVOFF) {
#pragma unroll
        for (int r = 0; r < 16; ++r) { const int row = row0 + crow(r, h); P[(size_t)row * PW + col] = (bf16_t)f2bf(gelu_tanh(acc[r])); }
    } else {
        const int c = col - SVOFF;
#pragma unroll
        for (int r = 0; r < 16; ++r) { const int row = row0 + crow(r, h); const int chunk = row >> 7, q = row & 127;
            ((bf16_t*)(p.ws + WS_VST))[((size_t)chunk * 256 + c) * 128 + q] = (bf16_t)f2bf(gelu_tanh(acc[r])); }
    }
}

DI void g1_simple(const Params& p, const Frame& F, int l, int row_lo, int nrows, int ct_lo, int nct) {
    const bf16_t* H = (const bf16_t*)(p.ws + WS_H);
    const bf16_t* W = (const bf16_t*)(p.ws + WS_WIN) + (size_t)l * INW * D;
    const int nit = (nrows / 64) * nct;
    for (int it = F.gw; it < nit; it += F.ngw) {
        const int mt = it / nct, nt = ct_lo + it % nct, m0 = row_lo + mt * 64;
        f32x16 acc[2][1]; zero_acc(acc);
        wave_gemm<2, 1>(H, D, W, D, D, m0, nt * 32, acc, F.lane);
#pragma unroll 1
        for (int i = 0; i < 2; ++i) g1_epilogue(p, l, i == 0 ? acc[0][0] : acc[1][0], m0 + 32 * i, nt * 32, F.lane);
    }
}

struct EpiG1 {
    static constexpr bool PERM = true;
    unsigned char* ws;
    DI void operator()(const f32x4 (&acc)[2][2][4][2], const pg8::Unit& u, int wr, int wc, int fr, int fq) const {
        bf16_t* P = (bf16_t*)(ws + WS_P);
        const int rbase = u.pm * 256 + wr * 64 + fr;
#pragma unroll
        for (int ai = 0; ai < 2; ++ai)
#pragma unroll
            for (int m = 0; m < 4; ++m) {
                const int row = rbase + 128 * ai + 16 * m;
#pragma unroll
                for (int bj = 0; bj < 2; ++bj) {
                    const int c0 = u.pn * 256 + 128 * bj + 32 * wc + 8 * fq;
                    float v[8];
#pragma unroll
                    for (int j = 0; j < 4; ++j) { v[j] = acc[ai][bj][m][0][j]; v[4 + j] = acc[ai][bj][m][1][j]; }
                    if (c0 < VOFF) {
                        const float sc = (c0 < KOFF) ? QSCALE : 1.0f;
                        const int t = row & (SEQ - 1), pos = (wc & 1) ? (t & 63) : (t >> 6);
                        const f32x4* tab = (const f32x4*)(ws + WS_ROPE) + (pos * 16 + 8 * (fq & 1)) / 2;
                        u32x4 o;
#pragma unroll
                        for (int j2 = 0; j2 < 4; ++j2) {
                            const f32x4 cs = tab[j2];
                            const float o0 = __shfl_xor(v[2 * j2], 32), o1 = __shfl_xor(v[2 * j2 + 1], 32);
                            const float r0 = (fq < 2) ? (v[2 * j2] * cs.x - o0 * cs.y) : (v[2 * j2] * cs.x + o0 * cs.y);
                            const float r1 = (fq < 2) ? (v[2 * j2 + 1] * cs.z - o1 * cs.w) : (v[2 * j2 + 1] * cs.z + o1 * cs.w);
                            o[j2] = pk2(r0 * sc, r1 * sc);
                        }
                        *(u32x4*)(P + (size_t)row * PW + c0) = o;
                    } else if (c0 < POOLOFF) {
                        const int hk = wc >> 1, d0 = 32 * (wc & 1) + 8 * fq, b = row / SEQ, t = row & (SEQ - 1);
                        bf16_t* vt = (bf16_t*)(ws + WS_VT) + ((size_t)(b * 2 + hk) * 64 + d0) * SEQ + t;
#pragma unroll
                        for (int j = 0; j < 8; ++j) vt[(size_t)j * SEQ] = (bf16_t)f2bf(v[j]);
                    } else if (c0 < SUOFF) {
                        u32x4 o;
#pragma unroll
                        for (int j2 = 0; j2 < 4; ++j2) o[j2] = pk2(v[2 * j2], v[2 * j2 + 1]);
                        *(u32x4*)(P + (size_t)row * PW + c0) = o;
                    } else if (c0 < SVOFF) {
                        u32x4 o;
#pragma unroll
                        for (int j2 = 0; j2 < 4; ++j2) o[j2] = pk2(gelu_tanh(v[2 * j2]), gelu_tanh(v[2 * j2 + 1]));
                        *(u32x4*)(P + (size_t)row * PW + c0) = o;
                    } else {
                        const int c = c0 - SVOFF, chunk = row >> 7, q = row & 127;
                        bf16_t* vs = (bf16_t*)(ws + WS_VST) + ((size_t)chunk * 256 + c) * 128 + q;
#pragma unroll
                        for (int j = 0; j < 8; ++j) vs[j * 128] = (bf16_t)f2bf(gelu_tanh(v[j]));
                    }
                }
                asm volatile("" ::: "memory");
            }
    }
};
struct SchedGrid {
    int nM, nN, G, c; const char* A; const char* B;
    DI bool next(int i, pg8::Unit& u) const {
        const int L = i * G + c; if (L >= nM * nN) return false;
        pg8::tile_of(L, nM, nN, u.pm, u.pn); u.sub = 0; u.nt = D / 64;
        u.a = A + (size_t)u.pm * 256 * D * 2; u.b = B + (size_t)u.pn * 256 * D * 2; return true;
    }
};

DI void phase_g1(const Params& p, const Frame& F, int l) {
    SchedGrid S{TL / 256, PW / 256, F.nb, F.bid, (const char*)(p.ws + WS_H), (const char*)(p.ws + WS_WIN) + (size_t)l * INW * D * 2};
    EpiG1 E{p.ws};
    pg8::gemm_phase(F.lds, F.tid, S, E);
    if (l == 0) g1_simple(p, F, l, TL, TC, 0, PW / 32);
    else g1_simple(p, F, l, TL, TC, 16, 8);
}

DI bf16x8 pack8(const f32x16& x, int s) {
    u32x4 pk;
#pragma unroll
    for (int j = 0; j < 4; ++j) { f32x2 v = {x[8 * s + 2 * j], x[8 * s + 2 * j + 1]}; pk[j] = __builtin_bit_cast(unsigned, __builtin_convertvector(v, bf16x2_t)); }
    return __builtin_bit_cast(bf16x8, pk);
}

DI void attn_block(const bf16x8 (&qf)[4], const bf16_t* kptr, const bf16_t* vptr, size_t vstride_d32, int mask_mode, int kq_off, int lane,
                   float& m, float& lpart, f32x16 (&o)[2]) {
    const int h = lane >> 5;
    f32x16 st;
#pragma unroll
    for (int r = 0; r < 16; ++r) st[r] = 0.f;
#pragma unroll
    for (int s = 0; s < 4; ++s) { const bf16x8 kf = *(const bf16x8*)(kptr + 16 * s); st = MFMA32(kf, qf[s], st); }
    if (mask_mode) {
#pragma unroll
        for (int r = 0; r < 16; ++r) { const int dlt = kq_off + crow(r, h); if (dlt > 128 || dlt < -128) st[r] = -1e30f; }
    }
    float bm = st[0];
#pragma unroll
    for (int r = 1; r < 16; ++r) bm = fmaxf(bm, st[r]);
    bm = fmaxf(bm, __shfl_xor(bm, 32));
    const float mn = fmaxf(m, bm), alpha = exp2f(m - mn);
    m = mn;
    float ps = 0.f;
#pragma unroll
    for (int r = 0; r < 16; ++r) { st[r] = exp2f(st[r] - mn); ps += st[r]; }
    lpart = lpart * alpha + ps;
#pragma unroll
    for (int d = 0; d < 2; ++d)
#pragma unroll
        for (int r = 0; r < 16; ++r) o[d][r] *= alpha;
    const bf16x8 pf0 = pack8(st, 0), pf1 = pack8(st, 1);
#pragma unroll
    for (int d = 0; d < 2; ++d) {
        const bf16_t* vp = vptr + (size_t)d * vstride_d32;
        const s16x4 a0 = *(const s16x4*)(vp), a1 = *(const s16x4*)(vp + 8), b0 = *(const s16x4*)(vp + 16), b1 = *(const s16x4*)(vp + 24);
        const bf16x8 v0 = __builtin_shufflevector(a0, a1, 0, 1, 2, 3, 4, 5, 6, 7), v1 = __builtin_shufflevector(b0, b1, 0, 1, 2, 3, 4, 5, 6, 7);
        o[d] = MFMA32(v0, pf0, o[d]);
        o[d] = MFMA32(v1, pf1, o[d]);
    }
}

DI void attn_task(const Params& p, int l, int task, int lane) {
    const int r = lane & 31, h = lane >> 5;
    const bf16_t* P = (const bf16_t*)(p.ws + WS_P);
    const bf16_t* VT = (const bf16_t*)(p.ws + WS_VT);
    const bf16_t* VTC = (const bf16_t*)(p.ws + WS_VTC);
    bf16_t* Y = (bf16_t*)(p.ws + WS_Y);
    const bool latent = task < 8192;
    int b, head, qb, q0row, p0;
    if (latent) { qb = task & 127; head = (task >> 7) & 7; b = task >> 10; p0 = qb * 32; q0row = b * SEQ + p0; }
    else { const int t2 = task - 8192; qb = t2 & 7; head = (t2 >> 3) & 7; b = t2 >> 6; p0 = qb * 32; q0row = TL + b * NCTX + p0; }
    const int hk = head >> 2;
    bf16x8 qf[4];
#pragma unroll
    for (int s = 0; s < 4; ++s) qf[s] = *(const bf16x8*)(P + (size_t)(q0row + r) * PW + head * 64 + 16 * s + 8 * h);
    float m = p.in[I_attn_sink][l * 8 + head] * LOG2E, lpart = (h == 0) ? 1.0f : 0.0f;
    f32x16 o[2];
#pragma unroll
    for (int d = 0; d < 2; ++d)
#pragma unroll
        for (int i = 0; i < 16; ++i) o[d][i] = 0.f;
    if (latent) {
        for (int kb = p0 - 128; kb <= p0 + 128; kb += 32) {
            if (kb < 0 || kb >= SEQ) continue;
            const bf16_t* kptr = P + (size_t)(b * SEQ + kb + r) * PW + KOFF + hk * 64 + 8 * h;
            const bf16_t* vptr = VT + ((size_t)(b * 2 + hk) * 64 + r) * SEQ + kb + 4 * h;
            const int mm = (kb == p0 - 128 || kb == p0 + 128) ? 1 : 0;
            attn_block(qf, kptr, vptr, (size_t)32 * SEQ, mm, kb - (p0 + r), lane, m, lpart, o);
        }
    }
    for (int kb = 0; kb < NCTX; kb += 32) {
        const bf16_t* kptr = P + (size_t)(TL + b * NCTX + kb + r) * PW + KOFF + hk * 64 + 8 * h;
        const bf16_t* vptr = VTC + ((size_t)(b * 2 + hk) * 64 + r) * NCTX + kb + 4 * h;
        attn_block(qf, kptr, vptr, (size_t)32 * NCTX, 0, 0, lane, m, lpart, o);
    }
    const float inv = 1.0f / (lpart + __shfl_xor(lpart, 32));
    bf16_t* yrow = Y + (size_t)(q0row + r) * D + head * 64;
#pragma unroll
    for (int d = 0; d < 2; ++d)
#pragma unroll
        for (int g = 0; g < 4; ++g) {
            u32x2 w; w.x = pk2(o[d][4 * g] * inv, o[d][4 * g + 1] * inv); w.y = pk2(o[d][4 * g + 2] * inv, o[d][4 * g + 3] * inv);
            *(u32x2*)(yrow + 32 * d + 8 * g + 4 * h) = w;
        }
}

DI void sgu_unit(const Params& p, const Frame& F, int l, int chunk) {
    constexpr int VS = 136;
    LAS float* part = (LAS float*)F.lds;
    LAS float* rq = part + 512;
    LAS bf16_t* vnT = (LAS bf16_t*)(F.lds + 4096);
    const bf16_t* VsT = (const bf16_t*)(p.ws + WS_VST) + (size_t)chunk * 256 * 128;
    const bf16_t* P = (const bf16_t*)(p.ws + WS_P);
    bf16_t* Y = (bf16_t*)(p.ws + WS_Y);
    __syncthreads();
    { const int q = F.tid & 127, part_i = F.tid >> 7; float ss = 0.f;
        for (int c = part_i * 64; c < part_i * 64 + 64; ++c) { const float v = bf2f(VsT[c * 128 + q]); ss += v * v; }
        part[part_i * 128 + q] = ss; }
    __syncthreads();
    if (F.tid < 128) rq[F.tid] = rsqrtf((part[F.tid] + part[128 + F.tid] + part[256 + F.tid] + part[384 + F.tid]) * (1.0f / 256.0f) + EPS);
    __syncthreads();
    for (int i = F.tid; i < 256 * 16; i += NTHREADS) {
        const int c = i >> 4, q8 = (i & 15) * 8;
        const u32x4 v = *(const u32x4*)(VsT + c * 128 + q8);
        u32x4 o;
#pragma unroll
        for (int j = 0; j < 4; ++j) o[j] = pk2(bflo(v[j]) * rq[q8 + 2 * j], bfhi(v[j]) * rq[q8 + 2 * j + 1]);
        *(LAS u32x4*)(vnT + c * VS + q8) = o;
    }
    __syncthreads();
    const int lane = F.lane, r = lane & 31, h = lane >> 5, g = F.wave >> 1, ph = F.wave & 1;
    const bf16_t* Wg = (const bf16_t*)(p.ws + WS_SGUW) + ((size_t)l * 4 + g) * 128 * 128;
#pragma unroll 1
    for (int pb = 0; pb < 2; ++pb) {
        const int p0 = 64 * ph + 32 * pb;
#pragma unroll 1
        for (int cb = 0; cb < 2; ++cb) {
            const int c0 = 64 * g + 32 * cb;
            f32x16 acc;
#pragma unroll
            for (int i = 0; i < 16; ++i) acc[i] = 0.f;
#pragma unroll
            for (int s = 0; s < 8; ++s) {
                const bf16x8 a = *(const LAS bf16x8*)(vnT + (c0 + r) * VS + 16 * s + 8 * h);
                const bf16x8 b = *(const bf16x8*)(Wg + (size_t)(p0 + r) * 128 + 16 * s + 8 * h);
                acc = MFMA32(a, b, acc);
            }
            const int row = chunk * 128 + p0 + r;
            const float bias = p.in[I_sgu_b][(l * 4 + g) * 128 + p0 + r];
#pragma unroll
            for (int q4 = 0; q4 < 4; ++q4) {
                const int cc = c0 + 8 * q4 + 4 * h;
                const u32x2 u = *(const u32x2*)(P + (size_t)row * PW + SUOFF + cc);
                u32x2 w;
                w.x = pk2(bflo(u.x) * (acc[4 * q4] + bias), bfhi(u.x) * (acc[4 * q4 + 1] + bias));
                w.y = pk2(bflo(u.y) * (acc[4 * q4 + 2] + bias), bfhi(u.y) * (acc[4 * q4 + 3] + bias));
                *(u32x2*)(Y + (size_t)row * D + 768 + cc) = w;
            }
        }
    }
}

DI void phase_mix(const Params& p, const Frame& F, int l) {
    const int ntask = (l == 0) ? 8192 + 512 : 8192;
    for (int task = F.gw; task < ntask; task += F.ngw) attn_task(p, l, task, F.lane);
    const int nchunk = (l == 0) ? T / 128 : TL / 128;
    for (int ch = F.bid; ch < nchunk; ch += F.nb) sgu_unit(p, F, l, ch);
    const int nrows = (l == 0) ? T : TL;
    const bf16_t* P = (const bf16_t*)(p.ws + WS_P);
    bf16_t* Y = (bf16_t*)(p.ws + WS_Y);
    for (int i = F.gtid; i < nrows * 32; i += F.ngt) {
        const int row = i >> 5, ck = i & 31, g = ck >> 3, half = 1 << g;
        int base, t, len;
        if (row < TL) { base = row & ~(SEQ - 1); t = row & (SEQ - 1); len = SEQ; } else { const int rc = row - TL; base = TL + (rc & ~(NCTX - 1)); t = rc & (NCTX - 1); len = NCTX; }
        const int lo = max(t - half, 0), hi = min(t + half, len);
        float s[8];
#pragma unroll
        for (int j = 0; j < 8; ++j) s[j] = 0.f;
        for (int tt = lo; tt < hi; ++tt) {
            const u32x4 v = *(const u32x4*)(P + (size_t)(base + tt) * PW + POOLOFF + ck * 8);
#pragma unroll
            for (int j = 0; j < 4; ++j) { s[2 * j] += bflo(v[j]); s[2 * j + 1] += bfhi(v[j]); }
        }
        const float inv = 1.0f / (float)(hi - lo);
        const u32x4 z = *(const u32x4*)(P + (size_t)row * PW + POOLOFF + ck * 8);
        u32x4 o;
#pragma unroll
        for (int j = 0; j < 4; ++j) o[j] = pk2(s[2 * j] * inv - bflo(z[j]), s[2 * j + 1] * inv - bfhi(z[j]));
        *(u32x4*)(Y + (size_t)row * D + 512 + ck * 8) = o;
    }
}

DI void g2_simple(const Params& p, const Frame& F, int l, int row_lo, int nrows) {
    const bf16_t* H = (const bf16_t*)(p.ws + WS_H);
    const bf16_t* Yb = (const bf16_t*)(p.ws + WS_Y);
    const bf16_t* Wg = (const bf16_t*)(p.ws + WS_WIN) + (size_t)l * INW * D + (size_t)GATEOFF * D;
    const bf16_t* Wb = (const bf16_t*)(p.ws + WS_WBR) + (size_t)l * D * D;
    bf16_t* M = (bf16_t*)(p.ws + WS_MERGED);
    const int nit = (nrows / 64) * (D / 32);
    for (int it = F.gw; it < nit; it += F.ngw) {
        const int mt = it / (D / 32), nt = it % (D / 32), m0 = row_lo + mt * 64, n0 = nt * 32;
        f32x16 tot[2][1]; zero_acc(tot);
#pragma unroll 1
        for (int i = 0; i < 3; ++i) {
            const int koff = (i == 0) ? 0 : (i == 1 ? 512 : 768), kk = (i == 0) ? 512 : 256;
            f32x16 g[2][1], pr[2][1]; zero_acc(g); zero_acc(pr);
            wave_gemm<2, 1>(H, D, Wg + (size_t)i * D * D, D, D, m0, n0, g, F.lane);
            wave_gemm<2, 1>(Yb + koff, D, Wb + koff, D, kk, m0, n0, pr, F.lane);
#pragma unroll
            for (int a = 0; a < 2; ++a)
#pragma unroll
                for (int r = 0; r < 16; ++r) tot[a][0][r] += sigmoidf_(g[a][0][r]) * pr[a][0][r];
        }
        const int h = F.lane >> 5, col = n0 + (F.lane & 31);
#pragma unroll
        for (int a = 0; a < 2; ++a)
#pragma unroll
            for (int r = 0; r < 16; ++r) M[(size_t)(m0 + 32 * a + crow(r, h)) * D + col] = (bf16_t)f2bf(tot[a][0][r]);
    }
}
struct SchedG2 {
    int G, c; const char *H, *Y, *Wg, *Wb;
    DI bool next(int i, pg8::Unit& u) const {
        const int tile = (i / 6) * G + c; if (tile >= (TL / 256) * 4) return false;
        const int sub = i % 6, br = sub >> 1;
        pg8::tile_of(tile, TL / 256, 4, u.pm, u.pn); u.sub = sub;
        if ((sub & 1) == 0) { u.nt = 16; u.a = H + (size_t)u.pm * 256 * D * 2; u.b = Wg + ((size_t)br * D + u.pn * 256) * D * 2; }
        else { const int koff = (br == 0) ? 0 : (br == 1 ? 512 : 768); u.nt = (br == 0) ? 8 : 4;
               u.a = Y + ((size_t)u.pm * 256 * D + koff) * 2; u.b = Wb + ((size_t)u.pn * 256 * D + koff) * 2; }
        return true;
    }
};
struct EpiG2 {
    static constexpr bool PERM = true;
    bf16_t* scr; bf16_t* M;
    DI void operator()(const f32x4 (&acc)[2][2][4][2], const pg8::Unit& u, int wr, int wc, int fr, int fq) const {
#pragma unroll
        for (int ai = 0; ai < 2; ++ai)
#pragma unroll
            for (int m = 0; m < 4; ++m) {
                const int rl = 128 * ai + 64 * wr + 16 * m + fr;
#pragma unroll
                for (int bj = 0; bj < 2; ++bj) {
                    const int cl = 128 * bj + 32 * wc + 8 * fq;
                    float v[8];
#pragma unroll
                    for (int j = 0; j < 4; ++j) { v[j] = acc[ai][bj][m][0][j]; v[4 + j] = acc[ai][bj][m][1][j]; }
                    u32x4* sp = (u32x4*)(scr + rl * 256 + cl);
                    if ((u.sub & 1) == 0) {
                        u32x4 o;
#pragma unroll
                        for (int j2 = 0; j2 < 4; ++j2) o[j2] = pk2(sigmoidf_(v[2 * j2]), sigmoidf_(v[2 * j2 + 1]));
                        *sp = o;
                    } else {
                        const u32x4 g = *sp;
                        u32x4* mp = (u32x4*)(M + (size_t)(u.pm * 256 + rl) * D + u.pn * 256 + cl);
                        float o[8];
#pragma unroll
                        for (int j2 = 0; j2 < 4; ++j2) { o[2 * j2] = bflo(g[j2]) * v[2 * j2]; o[2 * j2 + 1] = bfhi(g[j2]) * v[2 * j2 + 1]; }
                        if (u.sub > 1) { const u32x4 old = *mp;
#pragma unroll
                            for (int j2 = 0; j2 < 4; ++j2) { o[2 * j2] += bflo(old[j2]); o[2 * j2 + 1] += bfhi(old[j2]); } }
                        u32x4 w;
#pragma unroll
                        for (int j2 = 0; j2 < 4; ++j2) w[j2] = pk2(o[2 * j2], o[2 * j2 + 1]);
                        *mp = w;
                    }
                }
                asm volatile("" ::: "memory");
            }
    }
};
DI void phase_g2(const Params& p, const Frame& F, int l) {
    SchedG2 S{F.nb, F.bid, (const char*)(p.ws + WS_H), (const char*)(p.ws + WS_Y),
              (const char*)(p.ws + WS_WIN) + ((size_t)l * INW + GATEOFF) * D * 2, (const char*)(p.ws + WS_WBR) + (size_t)l * D * D * 2};
    EpiG2 E{(bf16_t*)(p.ws + WS_IDX) + (size_t)F.bid * 65536, (bf16_t*)(p.ws + WS_MERGED)};
    pg8::gemm_phase(F.lds, F.tid, S, E);
    if (l == 0) g2_simple(p, F, l, TL, TC);
}

DI void g3_simple(const Params& p, const Frame& F, int l, int row_lo, int nrows) {
    const bf16_t* M = (const bf16_t*)(p.ws + WS_MERGED);
    const bf16_t* W = (const bf16_t*)(p.ws + WS_WOUT) + (size_t)l * D * D;
    const int nit = (nrows / 64) * (D / 64);
    for (int it = F.gw; it < nit; it += F.ngw) {
        const int mt = it / (D / 64), nt = it % (D / 64), m0 = row_lo + mt * 64, n0 = nt * 64;
        f32x16 acc[2][2]; zero_acc(acc);
        wave_gemm<2, 2>(M, D, W, D, D, m0, n0, acc, F.lane);
        const int h = F.lane >> 5;
#pragma unroll
        for (int a = 0; a < 2; ++a)
#pragma unroll
            for (int j = 0; j < 2; ++j) {
                const int col = n0 + 32 * j + (F.lane & 31);
#pragma unroll
                for (int r = 0; r < 16; ++r) {
                    const int row = m0 + 32 * a + crow(r, h);
                    const float xs = (l == 0) ? xin_ptr(p, row)[col] : xrow_ptr(p, row)[col];
                    xrow_ptr(p, row)[col] = xs + mod_vec(p, l, row, 2)[col] * acc[a][j][r];
                }
            }
    }
}
struct EpiG3 {
    static constexpr bool PERM = false;
    const float* xsrc; float* xdst; const float* mod;
    DI void operator()(const f32x4 (&acc)[2][2][4][2], const pg8::Unit& u, int wr, int wc, int fr, int fq) const {
        const int col0 = u.pn * 256 + wc * 32 + 4 * fq;
        const float* gt = mod + (size_t)(u.pm >> 4) * NMOD + 2 * D;
#pragma unroll
        for (int ai = 0; ai < 2; ++ai)
#pragma unroll
            for (int m = 0; m < 4; ++m) {
                const size_t off = (size_t)(u.pm * 256 + wr * 64 + fr + 128 * ai + 16 * m) * D;
#pragma unroll
                for (int bj = 0; bj < 2; ++bj)
#pragma unroll
                    for (int n = 0; n < 2; ++n) {
                        const int c = col0 + 128 * bj + 16 * n;
                        const f32x4 xv = *(const f32x4*)(xsrc + off + c), gv = *(const f32x4*)(gt + c);
                        *(f32x4*)(xdst + off + c) = xv + gv * acc[ai][bj][m][n];
                    }
                asm volatile("" ::: "memory");
            }
    }
};
DI void phase_g3(const Params& p, const Frame& F, int l) {
    SchedGrid S{TL / 256, D / 256, F.nb, F.bid, (const char*)(p.ws + WS_MERGED), (const char*)(p.ws + WS_WOUT) + (size_t)l * D * D * 2};
    EpiG3 E{(l == 0) ? p.in[I_x] : p.out, p.out, (const float*)(p.ws + WS_MOD) + (size_t)l * 9 * NMOD};
    pg8::gemm_phase(F.lds, F.tid, S, E);
    if (l == 0) g3_simple(p, F, l, TL, TC);
}

DI void g45_simple(const Params& p, const Frame& F, int l, int row_lo, int nrows) {
    const bf16_t* H = (const bf16_t*)(p.ws + WS_H);
    const bf16_t* W = (const bf16_t*)(p.ws + WS_WFOLD) + (size_t)l * 2048 * D;
    float* ST = (float*)(p.ws + WS_ST);
    const int nit = (2048 / 64) * (nrows / 64);
    for (int it = F.gw; it < nit; it += F.ngw) {
        const int nt = it / 32, mt = it % 32, m0 = mt * 64, n0 = row_lo + nt * 64;
        f32x16 acc[2][2]; zero_acc(acc);
        wave_gemm<2, 2>(W, D, H, D, D, m0, n0, acc, F.lane);
        const int h = F.lane >> 5;
#pragma unroll
        for (int a = 0; a < 2; ++a)
#pragma unroll
            for (int j = 0; j < 2; ++j)
#pragma unroll
                for (int r = 0; r < 16; ++r) ST[(size_t)(m0 + 32 * a + crow(r, h)) * T + n0 + 32 * j + (F.lane & 31)] = acc[a][j][r];
    }
}
struct EpiG45 {
    static constexpr bool PERM = false;
    float* ST;
    DI void operator()(const f32x4 (&acc)[2][2][4][2], const pg8::Unit& u, int wr, int wc, int fr, int fq) const {
        const int col0 = u.pn * 256 + wc * 32 + 4 * fq;
#pragma unroll
        for (int ai = 0; ai < 2; ++ai)
#pragma unroll
            for (int m = 0; m < 4; ++m) {
                float* rowp = ST + (size_t)(u.pm * 256 + wr * 64 + fr + 128 * ai + 16 * m) * T + col0;
#pragma unroll
                for (int bj = 0; bj < 2; ++bj)
#pragma unroll
                    for (int n = 0; n < 2; ++n) *(f32x4*)(rowp + 128 * bj + 16 * n) = acc[ai][bj][m][n];
            }
    }
};
DI void phase_g45(const Params& p, const Frame& F, int l) {
    SchedGrid S{2048 / 256, TL / 256, F.nb, F.bid, (const char*)(p.ws + WS_WFOLD) + (size_t)l * 2048 * D * 2, (const char*)(p.ws + WS_H)};
    EpiG45 E{(float*)(p.ws + WS_ST)};
    pg8::gemm_phase(F.lds, F.tid, S, E);
    if (l == 0) g45_simple(p, F, l, TL, TC);
}

DI unsigned fkey(float f) { const unsigned u = __builtin_bit_cast(unsigned, f); return (u & 0x80000000u) ? ~u : (u | 0x80000000u); }
DI float fkey_inv(unsigned k) { const unsigned u = (k & 0x80000000u) ? (k & 0x7fffffffu) : ~k; return __builtin_bit_cast(float, u); }
#define INSERT16(L, x) do { unsigned x_ = (x); _Pragma("unroll") for (int k_ = 0; k_ < 16; ++k_) { const unsigned hi_ = max(L[k_], x_); x_ = min(L[k_], x_); L[k_] = hi_; } } while (0)

DI void phase_sel(const Params& p, const Frame& F, int l) {
    const float* ST = (const float*)(p.ws + WS_ST);
    unsigned short* IDX = (unsigned short*)(p.ws + WS_IDX);
    float* GW = (float*)(p.ws + WS_GW);
    LAS unsigned char* ib = (LAS unsigned char*)F.lds;
    const int ntok = (l == 0) ? T : TL;
    for (int i0 = F.bid * NTHREADS; i0 < ntok * 8; i0 += F.nb * NTHREADS) {
        const int i = i0 + F.tid;
        const int tok = i % ntok, head = i / ntok;
        unsigned la[16], lb[16];
#pragma unroll
        for (int k = 0; k < 16; ++k) { la[k] = 0u; lb[k] = 0u; }
        const float* s0 = ST + (size_t)(head * 256) * T + tok;
#pragma unroll 4
        for (int k = 0; k < 128; ++k) { const unsigned key = (fkey(s0[(size_t)k * T]) & ~127u) | (unsigned)(127 - k); INSERT16(la, key); }
        const float* s1 = s0 + (size_t)128 * T;
#pragma unroll 4
        for (int k = 0; k < 128; ++k) { const unsigned key = (fkey(s1[(size_t)k * T]) & ~127u) | (unsigned)(127 - k); INSERT16(lb, key); }
        float va[16], vb[16];
#pragma unroll
        for (int k = 0; k < 16; ++k) {
            va[k] = fkey_inv(la[k] & ~127u); vb[k] = fkey_inv(lb[k] & ~127u);
            ib[k * NTHREADS + F.tid] = (unsigned char)(127u - (la[k] & 127u));
            ib[(16 + k) * NTHREADS + F.tid] = (unsigned char)(127u - (lb[k] & 127u));
        }
        unsigned lc[16];
#pragma unroll
        for (int k = 0; k < 16; ++k) lc[k] = 0u;
#pragma unroll
        for (int a = 0; a < 16; ++a)
#pragma unroll
            for (int b = 0; b < 16; ++b)
                if ((a + 1) * (b + 1) <= 16) { const unsigned key = (fkey(va[a] + vb[b]) & ~255u) | (unsigned)(255 - (a * 16 + b)); INSERT16(lc, key); }
        float e[16], sum = 0.f; const float v0 = fkey_inv(lc[0] & ~255u);
#pragma unroll
        for (int k = 0; k < 16; ++k) { e[k] = __expf(fkey_inv(lc[k] & ~255u) - v0); sum += e[k]; }
        const float inv = 1.0f / sum;
        asm volatile("s_waitcnt lgkmcnt(0)" ::: "memory");
#pragma unroll
        for (int k = 0; k < 16; ++k) {
            const unsigned pos = 255u - (lc[k] & 255u), a = pos >> 4, b = pos & 15u;
            const unsigned ea = ib[a * NTHREADS + F.tid], eb = ib[(16 + b) * NTHREADS + F.tid];
            IDX[(size_t)tok * 128 + head * 16 + k] = (unsigned short)(ea * 128u + eb);
            GW[(size_t)tok * 128 + head * 16 + k] = e[k] * inv;
        }
        asm volatile("s_waitcnt lgkmcnt(0)" ::: "memory");
    }
}

DI void phase_gather(const Params& p, const Frame& F, int l) {
    const int ntok = (l == 0) ? T : TL, lane = F.lane;
    const bf16_t* H = (const bf16_t*)(p.ws + WS_H);
    const bf16_t* UT = (const bf16_t*)(p.ws + WS_UTAB);
    const bf16_t* VTb = (const bf16_t*)(p.ws + WS_VTAB);
    const unsigned short* IDX = (const unsigned short*)(p.ws + WS_IDX);
    const float* GW = (const float*)(p.ws + WS_GW);
    for (int tok = F.gw; tok < ntok; tok += F.ngw) {
        float hx[16];
        { const u32x4 a = *(const u32x4*)(H + (size_t)tok * D + 8 * lane), b = *(const u32x4*)(H + (size_t)tok * D + 512 + 8 * lane);
#pragma unroll
            for (int j = 0; j < 4; ++j) { hx[2 * j] = bflo(a[j]); hx[2 * j + 1] = bfhi(a[j]); hx[8 + 2 * j] = bflo(b[j]); hx[8 + 2 * j + 1] = bfhi(b[j]); } }
        const int e0 = IDX[(size_t)tok * 128 + lane], e1 = IDX[(size_t)tok * 128 + 64 + lane];
        const float g0 = GW[(size_t)tok * 128 + lane], g1 = GW[(size_t)tok * 128 + 64 + lane];
        float c0 = 0.f, c1 = 0.f;
#pragma unroll 1
        for (int kk = 0; kk < 128; kk += 4) {
            float dsum[4];
#pragma unroll
            for (int u = 0; u < 4; ++u) {
                const int k = kk + u;
                const int e = __shfl((k < 64) ? e0 : e1, k & 63);
                const u32x4 a = *(const u32x4*)(UT + (size_t)e * D + 8 * lane), b = *(const u32x4*)(UT + (size_t)e * D + 512 + 8 * lane);
                float d = 0.f;
#pragma unroll
                for (int j = 0; j < 4; ++j) { d += hx[2 * j] * bflo(a[j]) + hx[2 * j + 1] * bfhi(a[j]); d += hx[8 + 2 * j] * bflo(b[j]) + hx[8 + 2 * j + 1] * bfhi(b[j]); }
                dsum[u] = d;
            }
#pragma unroll
            for (int u = 0; u < 4; ++u) {
                const int k = kk + u;
                const float tot = wave_sum(dsum[u]);
                const float act = gelu_tanh(tot);
                if (k < 64) { if (lane == k) c0 = g0 * act; } else { if (lane == k - 64) c1 = g1 * act; }
            }
        }
        float acc[16];
#pragma unroll
        for (int j = 0; j < 16; ++j) acc[j] = 0.f;
#pragma unroll 1
        for (int kk = 0; kk < 128; kk += 4) {
#pragma unroll
            for (int u = 0; u < 4; ++u) {
                const int k = kk + u;
                const int e = __shfl((k < 64) ? e0 : e1, k & 63);
                const float cf = __shfl((k < 64) ? c0 : c1, k & 63);
                const u32x4 a = *(const u32x4*)(VTb + (size_t)e * D + 8 * lane), b = *(const u32x4*)(VTb + (size_t)e * D + 512 + 8 * lane);
#pragma unroll
                for (int j = 0; j < 4; ++j) { acc[2 * j] += cf * bflo(a[j]); acc[2 * j + 1] += cf * bfhi(a[j]); acc[8 + 2 * j] += cf * bflo(b[j]); acc[8 + 2 * j + 1] += cf * bfhi(b[j]); }
            }
        }
        float* xr = xrow_ptr(p, tok);
        const float* gt2 = mod_vec(p, l, tok, 5);
        float x2[16]; float ss = 0.f;
#pragma unroll
        for (int half = 0; half < 2; ++half)
#pragma unroll
            for (int q = 0; q < 2; ++q) {
                const int col = 512 * half + 8 * lane + 4 * q;
                const f32x4 xv = *(const f32x4*)(xr + col), gv = *(const f32x4*)(gt2 + col);
#pragma unroll
                for (int j = 0; j < 4; ++j) { const float v = xv[j] + gv[j] * acc[8 * half + 4 * q + j]; x2[8 * half + 4 * q + j] = v; ss += v * v; }
            }
        const float rinv = rsqrtf(wave_sum(ss) * (1.0f / D) + EPS);
        if (l == DEPTH - 1) {
#pragma unroll
            for (int half = 0; half < 2; ++half)
#pragma unroll
                for (int q = 0; q < 2; ++q) {
                    const int col = 512 * half + 8 * lane + 4 * q;
                    const f32x4 gv = *(const f32x4*)(p.in[I_g_final] + col);
                    f32x4 o;
#pragma unroll
                    for (int j = 0; j < 4; ++j) o[j] = x2[8 * half + 4 * q + j] * rinv * gv[j];
                    *(f32x4*)(xr + col) = o;
                }
        } else {
            const float* g = p.in[I_g_mix] + (l + 1) * D; const float* sh = mod_vec(p, l + 1, tok, 0); const float* sc = mod_vec(p, l + 1, tok, 1);
            bf16_t* hrow = (bf16_t*)(p.ws + WS_H) + (size_t)tok * D;
#pragma unroll
            for (int half = 0; half < 2; ++half) {
                u32x4 hw;
#pragma unroll
                for (int q = 0; q < 2; ++q) {
                    const int col = 512 * half + 8 * lane + 4 * q;
                    const f32x4 gv = *(const f32x4*)(g + col), s1 = *(const f32x4*)(sh + col), s2 = *(const f32x4*)(sc + col);
                    f32x4 xo, ho;
#pragma unroll
                    for (int j = 0; j < 4; ++j) { xo[j] = x2[8 * half + 4 * q + j]; ho[j] = xo[j] * rinv * gv[j] * (1.0f + s2[j]) + s1[j]; }
                    *(f32x4*)(xr + col) = xo;
                    hw[2 * q] = pk2(ho[0], ho[1]); hw[2 * q + 1] = pk2(ho[2], ho[3]);
                }
                *(u32x4*)(hrow + 512 * half + 8 * lane) = hw;
            }
        }
    }
}

constexpr int NPHASE = 18;
template <int PH> DI void run_phase(const Params& p, const Frame& F) {
    if constexpr (PH == 0) phase_prep(p, F);
    else if constexpr (PH == 1) phase_norm(p, F, 0, 0, true);
    else if constexpr (PH == 2) phase_g1(p, F, 0);
    else if constexpr (PH == 3) phase_mix(p, F, 0);
    else if constexpr (PH == 4) phase_g2(p, F, 0);
    else if constexpr (PH == 5) phase_g3(p, F, 0);
    else if constexpr (PH == 6) phase_norm(p, F, 0, 1, false);
    else if constexpr (PH == 7) phase_g45(p, F, 0);
    else if constexpr (PH == 8) phase_sel(p, F, 0);
    else if constexpr (PH == 9) phase_gather(p, F, 0);
    else if constexpr (PH == 10) { phase_g1(p, F, 1); convert_tables(p, F, 1); }
    else if constexpr (PH == 11) phase_mix(p, F, 1);
    else if constexpr (PH == 12) phase_g2(p, F, 1);
    else if constexpr (PH == 13) phase_g3(p, F, 1);
    else if constexpr (PH == 14) phase_norm(p, F, 1, 1, false);
    else if constexpr (PH == 15) phase_g45(p, F, 1);
    else if constexpr (PH == 16) phase_sel(p, F, 1);
    else if constexpr (PH == 17) phase_gather(p, F, 1);
}
DI Frame make_frame(unsigned char* lds_raw) {
    Frame F;
    F.lds = (LAS unsigned char*)lds_raw;
    int tid = threadIdx.x; asm volatile("" : "+v"(tid));
    int bid = blockIdx.x, nb = gridDim.x; asm volatile("" : "+s"(bid), "+s"(nb));
    F.tid = tid; F.lane = tid & 63; F.wave = __builtin_amdgcn_readfirstlane(tid >> 6); F.bid = bid; F.nb = nb;
    F.gw = bid * NWAVES + F.wave; F.ngw = nb * NWAVES; F.gtid = bid * NTHREADS + tid; F.ngt = nb * NTHREADS;
    return F;
}
template <int PH> DI void run_phase_fresh(unsigned char* lds_raw) {
#if defined(__HIP_DEVICE_COMPILE__)
    const __attribute__((address_space(4))) unsigned long long* pp = (const __attribute__((address_space(4))) unsigned long long*)__builtin_amdgcn_kernarg_segment_ptr();
    asm volatile("" : "+s"(pp));
    Params p;
#pragma unroll
    for (int i = 0; i < N_IN; ++i) p.in[i] = (const float*)(const __attribute__((address_space(1))) float*)pp[i];
    p.out = (float*)(__attribute__((address_space(1))) float*)pp[N_IN]; p.ws = (unsigned char*)(__attribute__((address_space(1))) unsigned char*)pp[N_IN + 1]; p.ph_lo = 0; p.ph_hi = 0;
#else
    Params p{};
#endif
    const Frame F = make_frame(lds_raw);
    run_phase<PH>(p, F);
}
template <int PH> __global__ void __launch_bounds__(NTHREADS, 2) phase_kernel(Params p) {
    extern __shared__ __attribute__((aligned(16))) unsigned char lds_raw[];
    run_phase_fresh<PH>(lds_raw);
}
template <int PH> DI void run_all(unsigned char* lds_raw, cg::grid_group& grid) {
    if constexpr (PH < NPHASE) {
        run_phase_fresh<PH>(lds_raw);
        if constexpr (PH + 1 < NPHASE) grid.sync();
        run_all<PH + 1>(lds_raw, grid);
    }
}
__global__ void __launch_bounds__(NTHREADS, 2) mega(Params p) {
    extern __shared__ __attribute__((aligned(16))) unsigned char lds_raw[];
    cg::grid_group grid = cg::this_grid();
    run_all<0>(lds_raw, grid);
}

extern "C" void kernel_launch(void* const* d_in, const int* in_sizes, int n_in, void* d_out, int out_size, void* d_ws, size_t ws_size, hipStream_t stream) {
    static int grid = 0;
    if (grid == 0) {
        if (n_in != 23 || out_size != TL * D || ws_size < WS_END) { fprintf(stderr, "kernel_launch: unexpected shapes (n_in %d out %d ws %zu)\n", n_in, out_size, ws_size); grid = -1; return; }
        int dev = 0, cus = 0, per_cu = 0;
        (void)hipGetDevice(&dev);
        (void)hipDeviceGetAttribute(&cus, hipDeviceAttributeMultiprocessorCount, dev);
        (void)hipFuncSetAttribute((const void*)mega, hipFuncAttributeMaxDynamicSharedMemorySize, LDS_BYTES);
        (void)hipOccupancyMaxActiveBlocksPerMultiprocessor(&per_cu, (const void*)mega, NTHREADS, LDS_BYTES);
        if (per_cu < 1) { fprintf(stderr, "kernel_launch: occupancy query reports %d blocks per CU\n", per_cu); grid = -1; return; }
        grid = cus;
    }
    if (grid < 0) return;
    (void)hipMemsetAsync((char*)d_ws + WS_CTL, 0, CTL_ZERO_BYTES, stream);
    Params p{};
    for (int i = 0; i < N_IN; ++i) p.in[i] = (const float*)d_in[i];
    p.out = (float*)d_out; p.ws = (unsigned char*)d_ws;
    void* args[] = {&p};
    hipError_t e = hipLaunchCooperativeKernel((const void*)mega, dim3(grid), dim3(NTHREADS), args, LDS_BYTES, stream);
    if (e != hipSuccess) fprintf(stderr, "cooperative launch failed: %s (grid %d)\n", hipGetErrorString(e), grid);
}
```

```cpp
#include <hip/hip_runtime.h>
#include <hip/hip_cooperative_groups.h>
#include <stdint.h>
#include <stdio.h>
namespace cg = cooperative_groups;

#ifndef PROBE_PH
#define PROBE_PH -1
#endif
#ifndef PROBE_SYNC
#define PROBE_SYNC 0
#endif
#ifndef MK_SINGLE
#define MK_SINGLE 0
#endif

#define LAS __attribute__((address_space(3)))
typedef unsigned short bf16_t;
typedef short bf16x8 __attribute__((ext_vector_type(8)));
typedef short s16x4 __attribute__((ext_vector_type(4)));
typedef float f32x4 __attribute__((ext_vector_type(4)));
typedef float f32x2 __attribute__((ext_vector_type(2)));
typedef float f32x16 __attribute__((ext_vector_type(16)));
typedef unsigned u32x4 __attribute__((ext_vector_type(4)));
typedef unsigned u32x2 __attribute__((ext_vector_type(2)));
typedef __bf16 bf16x2_t __attribute__((ext_vector_type(2)));
#define DI __device__ __forceinline__
#define MFMA32(a, b, c) __builtin_amdgcn_mfma_f32_32x32x16_bf16((a), (b), (c), 0, 0, 0)

constexpr int D = 1024, NB = 8, SEQ = 4096, NCTX = 256, DEPTH = 2;
constexpr int TL = NB * SEQ, TC = NB * NCTX, T = TL + TC;
constexpr int INW = 4608, NMOD = 6 * D, PW = 1536;
constexpr int QOFF = 0, KOFF = 512, VOFF = 640, POOLOFF = 768, SUOFF = 1024, SVOFF = 1280, GATEOFF = 1536;
constexpr int NEXP = 16384;
constexpr float EPS = 1e-6f;
constexpr float LOG2E = 1.4426950408889634f;
constexpr float QSCALE = 0.125f * LOG2E;

constexpr size_t MiB = 1u << 20;
constexpr size_t WS_CTL = 0, WS_MOD = 1 * MiB, CTL_ZERO_BYTES = 2 * MiB;
constexpr size_t WS_ROPE = 2 * MiB, WS_SGUW = 2 * MiB + 65536, WS_TSCALE = 3 * MiB;
constexpr size_t WS_WIN = 4 * MiB, WS_WBR = 22 * MiB, WS_WOUT = 26 * MiB, WS_WFOLD = 30 * MiB;
constexpr size_t WS_XCTX = 38 * MiB, WS_UTAB = 46 * MiB, WS_VTAB = 78 * MiB;
constexpr size_t WS_IDX = 110 * MiB, WS_GW = 120 * MiB;
constexpr size_t WS_H = 142 * MiB;
constexpr size_t WS_P = 210 * MiB, WS_Y = 312 * MiB, WS_MERGED = 380 * MiB, WS_VT = 448 * MiB, WS_VTC = 456 * MiB, WS_VST = 460 * MiB;
constexpr size_t WS_ST = 210 * MiB, WS_SU = 482 * MiB;
constexpr size_t WS_END = 512 * MiB;
static_assert(WS_ST + (size_t)2048 * T * 4 <= WS_END, "ST fits");
static_assert(WS_VST + (size_t)272 * 256 * 128 * 2 <= WS_END, "VsT fits");
static_assert(WS_H + (size_t)T * D * 2 <= WS_P, "H fits");
static_assert(WS_P + (size_t)T * PW * 2 <= WS_Y && WS_Y + (size_t)T * D * 2 <= WS_MERGED && WS_MERGED + (size_t)T * D * 2 <= WS_VT, "P/Y/MERGED fit");
static_assert(WS_IDX + (size_t)T * 128 * 2 <= WS_GW && WS_GW + (size_t)T * 128 * 4 <= WS_H && WS_SU + (size_t)T * 128 * 4 <= WS_END && WS_ST + (size_t)2048 * T * 4 <= WS_SU, "idx/gw/su fit");

constexpr int LDS_BYTES = 147456;
constexpr int NTHREADS = 512, NWAVES = 8;

enum { I_x, I_c, I_ctx, I_c_ctx, I_w_mod, I_b_mod, I_g_mix, I_g_ffn, I_w_in, I_attn_sink, I_pool_w, I_pool_scale, I_sgu_w, I_sgu_b, I_w_br_attn, I_w_br_pool, I_w_br_sgu, I_w_out, I_peer_wq, I_peer_subkeys, I_peer_u, I_peer_v, I_g_final, N_IN };
struct Params {
    const float* in[N_IN];
    float* out; unsigned char* ws;
    int ph_lo, ph_hi;
};

DI unsigned f2bf(float f) { unsigned u = __builtin_bit_cast(unsigned, f); return (u + 0x7fffu + ((u >> 16) & 1u)) >> 16; }
DI unsigned pk2(float lo, float hi) { return f2bf(lo) | (f2bf(hi) << 16); }
DI float bf2f(unsigned short u) { return __builtin_bit_cast(float, (unsigned)u << 16); }
DI float bflo(unsigned w) { return __builtin_bit_cast(float, w << 16); }
DI float bfhi(unsigned w) { return __builtin_bit_cast(float, w & 0xffff0000u); }
DI int crow(int reg, int h) { return (reg & 3) + 8 * (reg >> 2) + 4 * h; }
DI float wave_sum(float v) {
#pragma unroll
    for (int o = 1; o < 64; o <<= 1) v += __shfl_xor(v, o);
    return v;
}
DI float sigmoidf_(float x) { return 1.0f / (1.0f + __expf(-x)); }
DI float gelu_tanh(float x) { const float u = 0.7978845608028654f * (x + 0.044715f * x * x * x); return x / (1.0f + __expf(-2.0f * u)); }
DI float silu_(float x) { return x / (1.0f + __expf(-x)); }

struct Frame {
    int tid, lane, wave, gw, ngw, gtid, ngt, bid, nb;
    LAS unsigned char* lds;
};

template <int NM, int NN>
DI void wave_gemm(const bf16_t* __restrict__ A, int lda, const bf16_t* __restrict__ Bt, int ldb, int K, int m0, int n0, f32x16 (&acc)[NM][NN], int lane) {
    const int r = lane & 31, h = lane >> 5;
    const bf16_t* ap = A + (size_t)(m0 + r) * lda + 8 * h;
    const bf16_t* bp = Bt + (size_t)(n0 + r) * ldb + 8 * h;
    for (int k0 = 0; k0 < K; k0 += 16) {
        bf16x8 a[NM], b[NN];
#pragma unroll
        for (int i = 0; i < NM; ++i) a[i] = *(const bf16x8*)(ap + (size_t)(32 * i) * lda + k0);
#pragma unroll
        for (int j = 0; j < NN; ++j) b[j] = *(const bf16x8*)(bp + (size_t)(32 * j) * ldb + k0);
#pragma unroll
        for (int i = 0; i < NM; ++i)
#pragma unroll
            for (int j = 0; j < NN; ++j) acc[i][j] = MFMA32(a[i], b[j], acc[i][j]);
    }
}
template <int NM, int NN> DI void zero_acc(f32x16 (&acc)[NM][NN]) {
#pragma unroll
    for (int i = 0; i < NM; ++i)
#pragma unroll
        for (int j = 0; j < NN; ++j)
#pragma unroll
            for (int r = 0; r < 16; ++r) acc[i][j][r] = 0.f;
}

namespace pg8 {
constexpr int BM = 256, BK = 64, HALF = 128, HTB = HALF * BK * 2, STAGE_BYTES = 8 * HTB, NXCD = 8, WGM = 8, LD = 1024;
DI int lds_byte(int r, int c) { const int st = (r >> 4) * 2 + (c >> 5), rr = r & 15, cc = c & 31, ob = rr * 64 + cc * 2; return st * 1024 + (ob ^ (((ob >> 9) & 1) << 5)); }
DI void stage_rc(int b, int& R, int& C) { const int st = b / 1024, sb = b % 1024, swz = sb ^ (((sb >> 9) & 1) << 5); R = (st >> 1) * 16 + swz / 64; C = (st & 1) * 32 + (swz % 64) / 2; }
DI int perm32(int rho) { const int n = rho >> 4, i = rho & 15; return 8 * (i >> 2) + 4 * n + (i & 3); }
struct Unit { int pm, pn, sub, nt; const char* a; const char* b; };
DI void tile_of(int L, int nM, int nN, int& pm, int& pn) {
    const int nwg = nM * nN; int wgid = L;
    { const int q = nwg / NXCD, r = nwg % NXCD, xcd = wgid % NXCD, off = wgid / NXCD; wgid = (xcd < r ? xcd * (q + 1) : r * (q + 1) + (xcd - r) * q) + off; }
    const int nig = WGM * nN, gid = wgid / nig, fm = gid * WGM, gsz = (nM - fm) < WGM ? (nM - fm) : WGM;
    pm = fm + ((wgid % nig) % gsz); pn = (wgid % nig) / gsz;
}
template <class Epi, class Sched>
DI void gemm_phase(LAS unsigned char* lds, const int tid, const Sched& S, const Epi& E) {
    const int wid = __builtin_amdgcn_readfirstlane(tid >> 6), lane = tid & 63, wr = wid >> 2, wc = wid & 3, fr = lane & 15, fq = lane >> 4;
    unsigned voffA[2], voffB[2];
#pragma unroll
    for (int i = 0; i < 2; ++i) { int R, C; stage_rc(tid * 16 + i * 8192, R, C); const int Rb = Epi::PERM ? ((R & ~31) + perm32(R & 31)) : R;
        voffA[i] = (unsigned)(R * LD + C) * 2u; voffB[i] = (unsigned)(Rb * LD + C) * 2u; }
    const size_t kstep = (size_t)(BK * 2);
    const size_t hstep = (size_t)HALF * LD * 2;
    const unsigned ldsw = (unsigned)wid * 1024u;
    const int aoff = lds_byte(wr * 64 + fr, fq * 8), boff = lds_byte(wc * 32 + fr, fq * 8);
#define PG8_SA(b, h) (((b) * 2 + (h)) * HTB)
#define PG8_SB(b, h) ((4 + (b) * 2 + (h)) * HTB)
#define PG8_STAGE(bufoff, gbase, voff) do { _Pragma("unroll") for (int _i = 0; _i < 2; ++_i) \
        __builtin_amdgcn_global_load_lds((const unsigned*)((const char*)(gbase) + (voff)[_i]), (LAS unsigned*)(lds + (bufoff) + ldsw + _i * 8192), 16, 0, 0); } while (0)
#define PG8_LDA(dst, b, h) do { _Pragma("unroll") for (int m = 0; m < 4; ++m) _Pragma("unroll") for (int k = 0; k < 2; ++k) dst[m][k] = *(const LAS bf16x8*)(lds + PG8_SA(b, h) + aoff + m * 2048 + k * 1024); } while (0)
#define PG8_LDB(dst, b, h) do { _Pragma("unroll") for (int n = 0; n < 2; ++n) _Pragma("unroll") for (int k = 0; k < 2; ++k) dst[n][k] = *(const LAS bf16x8*)(lds + PG8_SB(b, h) + boff + n * 2048 + k * 1024); } while (0)
#define PG8_MMA(ai, bj, At, Bt) do { __builtin_amdgcn_s_setprio(1); _Pragma("unroll") for (int m = 0; m < 4; ++m) _Pragma("unroll") for (int n = 0; n < 2; ++n) _Pragma("unroll") for (int k = 0; k < 2; ++k) \
        acc[ai][bj][m][n] = __builtin_amdgcn_mfma_f32_16x16x32_bf16(Bt[n][k], At[m][k], acc[ai][bj][m][n], 0, 0, 0); __builtin_amdgcn_s_setprio(0); } while (0)
#define PG8_WAIT_V(n) asm volatile("s_waitcnt vmcnt(" #n ")" ::: "memory")
#define PG8_WAIT_L(n) asm volatile("s_waitcnt lgkmcnt(" #n ")" ::: "memory")
#define PG8_BAR __builtin_amdgcn_s_barrier()
#define PG8_SCHED __builtin_amdgcn_sched_barrier(0)
    Unit cur, nxt; int ui = 0;
    if (!S.next(0, cur)) return;
    f32x4 acc[2][2][4][2];
#pragma unroll
    for (int a = 0; a < 2; ++a)
#pragma unroll
        for (int b = 0; b < 2; ++b)
#pragma unroll
            for (int m = 0; m < 4; ++m)
#pragma unroll
                for (int n = 0; n < 2; ++n) acc[a][b][m][n] = (f32x4){0.f, 0.f, 0.f, 0.f};
    bf16x8 At[4][2], B0[2][2], B1[2][2];
    const char* cA = cur.a; const char* cB = cur.b;
    PG8_STAGE(PG8_SB(0, 0), cB, voffB); PG8_STAGE(PG8_SB(0, 1), cB + hstep, voffB); PG8_STAGE(PG8_SA(0, 0), cA, voffA); PG8_STAGE(PG8_SA(0, 1), cA + hstep, voffA);
    if (wr == 1) PG8_BAR;
    PG8_WAIT_V(2); PG8_BAR;
    PG8_STAGE(PG8_SB(1, 0), cB + kstep, voffB); PG8_STAGE(PG8_SA(1, 0), cA + kstep, voffA); PG8_STAGE(PG8_SB(1, 1), cB + hstep + kstep, voffB);
    PG8_WAIT_V(6); PG8_BAR;
    for (;;) {
        const bool has_next = S.next(ui + 1, nxt);
        const char* nA = has_next ? nxt.a : cA; const char* nB = has_next ? nxt.b : cB;
        const int nt = cur.nt;
        for (int t = 0; t < nt; t += 2) {
            const bool last = (t == nt - 2);
            const char* a1 = cA + (size_t)(t + 1) * kstep;
            const char* a2 = last ? nA : cA + (size_t)(t + 2) * kstep; const char* b2 = last ? nB : cB + (size_t)(t + 2) * kstep;
            const char* a3 = a2 + kstep; const char* b3 = b2 + kstep;
            PG8_LDB(B0, 0, 0); PG8_LDB(B1, 0, 1); PG8_SCHED; PG8_LDA(At, 0, 0); PG8_STAGE(PG8_SA(1, 1), a1 + hstep, voffA);
            PG8_WAIT_V(8); PG8_WAIT_L(0); PG8_BAR; PG8_MMA(0, 0, At, B0); PG8_MMA(0, 1, At, B1); PG8_BAR; PG8_SCHED;
            PG8_LDA(At, 0, 1); PG8_STAGE(PG8_SB(0, 0), b2, voffB); PG8_STAGE(PG8_SB(0, 1), b2 + hstep, voffB); PG8_STAGE(PG8_SA(0, 0), a2, voffA);
            PG8_WAIT_V(8); PG8_WAIT_L(0); PG8_BAR; PG8_MMA(1, 0, At, B0); PG8_MMA(1, 1, At, B1); PG8_BAR; PG8_SCHED;
            PG8_LDB(B0, 1, 0); PG8_LDB(B1, 1, 1); PG8_SCHED; PG8_LDA(At, 1, 0); PG8_STAGE(PG8_SA(0, 1), a2 + hstep, voffA);
            PG8_WAIT_V(8); PG8_WAIT_L(0); PG8_BAR; PG8_MMA(0, 0, At, B0); PG8_MMA(0, 1, At, B1); PG8_BAR; PG8_SCHED;
            PG8_LDA(At, 1, 1); PG8_STAGE(PG8_SB(1, 0), b3, voffB); PG8_STAGE(PG8_SB(1, 1), b3 + hstep, voffB); PG8_STAGE(PG8_SA(1, 0), a3, voffA);
            PG8_WAIT_V(8); PG8_WAIT_L(0); PG8_BAR; PG8_MMA(1, 0, At, B0); PG8_MMA(1, 1, At, B1); PG8_BAR; PG8_SCHED;
        }
        if (wr == 0) PG8_BAR;
        E(acc, cur, wr, wc, fr, fq);
        if (!has_next) break;
#pragma unroll
        for (int a = 0; a < 2; ++a)
#pragma unroll
            for (int b = 0; b < 2; ++b)
#pragma unroll
                for (int m = 0; m < 4; ++m)
#pragma unroll
                    for (int n = 0; n < 2; ++n) acc[a][b][m][n] = (f32x4){0.f, 0.f, 0.f, 0.f};
        cur = nxt; cA = nA; cB = nB; ++ui;
        if (wr == 1) PG8_BAR;
    }
    PG8_WAIT_V(0);
    PG8_BAR;
#undef PG8_SA
#undef PG8_SB
#undef PG8_STAGE
#undef PG8_LDA
#undef PG8_LDB
#undef PG8_MMA
#undef PG8_WAIT_V
#undef PG8_WAIT_L
#undef PG8_BAR
#undef PG8_SCHED
}
}

DI void transpose_item(const float* W, int K, int N, bf16_t* WT, int ldd, int row_off, int col_off, LAS float* scr, int item, int lane) {
    const int nblk = N / 32, kb = item / nblk, nb = item % nblk, k0 = 64 * kb, n0 = 32 * nb;
#pragma unroll 8
    for (int i = 0; i < 32; ++i) { const int kk = 2 * i + (lane >> 5); scr[kk * 33 + (lane & 31)] = W[(size_t)(k0 + kk) * N + n0 + (lane & 31)]; }
    asm volatile("s_waitcnt lgkmcnt(0)" ::: "memory");
    const int c = lane & 7;
#pragma unroll
    for (int j = 0; j < 4; ++j) { const int n = (lane >> 3) + 8 * j; const LAS float* s = scr + (8 * c) * 33 + n;
        u32x4 o; o.x = pk2(s[0 * 33], s[1 * 33]); o.y = pk2(s[2 * 33], s[3 * 33]); o.z = pk2(s[4 * 33], s[5 * 33]); o.w = pk2(s[6 * 33], s[7 * 33]);
        *(u32x4*)(WT + (size_t)(row_off + n0 + n) * ldd + col_off + k0 + 8 * c) = o; }
    asm volatile("s_waitcnt lgkmcnt(0)" ::: "memory");
}

DI void convert_tables(const Params& p, const Frame& F) {
    for (int it = F.gw; it < 4 * NEXP; it += F.ngw) {
        const int e = it & (NEXP - 1), tbl = (it >> 14) & 1, l = it >> 15;
        const f32x4* src = (const f32x4*)((tbl ? p.in[I_peer_v] : p.in[I_peer_u]) + ((size_t)l * NEXP + e) * D) + 4 * F.lane;
        f32x4 v[4]; float am = 0.f;
#pragma unroll
        for (int j = 0; j < 4; ++j) { v[j] = src[j]; am = fmaxf(am, fmaxf(fmaxf(fabsf(v[j].x), fabsf(v[j].y)), fmaxf(fabsf(v[j].z), fabsf(v[j].w)))); }
#pragma unroll
        for (int o = 1; o < 64; o <<= 1) am = fmaxf(am, __shfl_xor(am, o));
        const float sc = (am > 0.f) ? exp2f(floorf(log2f(224.0f / am))) : 1.0f;
        u32x4 q;
#pragma unroll
        for (int j = 0; j < 4; ++j) { int w = 0; w = __builtin_amdgcn_cvt_pk_fp8_f32(v[j].x * sc, v[j].y * sc, w, false); w = __builtin_amdgcn_cvt_pk_fp8_f32(v[j].z * sc, v[j].w * sc, w, true); q[j] = (unsigned)w; }
        *(u32x4*)(p.ws + (tbl ? WS_VTAB : WS_UTAB) + ((size_t)l * NEXP + e) * D + 16 * F.lane) = q;
        if (F.lane == 0) ((float*)(p.ws + WS_TSCALE))[(l * 2 + tbl) * NEXP + e] = 1.0f / sc;
    }
}

DI void phase_prep(const Params& p, const Frame& F) {
    unsigned char* ws = p.ws;
    {
        LAS float* wq = (LAS float*)F.lds;
        for (int it = F.bid; it < 2 * 16 * 16; it += F.nb) {
            const int cc = it & 15, hp = (it >> 4) & 15, l = it >> 8;
            const float* src = p.in[I_peer_wq] + (size_t)l * D * 2048 + hp * 128;
            __syncthreads();
            for (int e = F.tid; e < 64 * 128; e += NTHREADS) { const int ci = e >> 7, d = e & 127; wq[d * 65 + ci] = src[(size_t)(cc * 64 + ci) * 2048 + d]; }
            __syncthreads();
            const int ci = F.tid & 63, kg = F.tid >> 6;
            const float* sk = p.in[I_peer_subkeys] + ((size_t)(l * 16 + hp) * 128 + 16 * kg) * 128;
            float acc[16];
#pragma unroll
            for (int k = 0; k < 16; ++k) acc[k] = 0.f;
            for (int d = 0; d < 128; ++d) { const float w = wq[d * 65 + ci];
#pragma unroll
                for (int k = 0; k < 16; ++k) acc[k] += w * sk[k * 128 + d]; }
            bf16_t* dst = (bf16_t*)(ws + WS_WFOLD) + ((size_t)l * 2048 + hp * 128 + 16 * kg) * D + cc * 64 + ci;
#pragma unroll
            for (int k = 0; k < 16; ++k) dst[(size_t)k * D] = (bf16_t)f2bf(acc[k]);
        }
        __syncthreads();
    }
    {
        LAS float* scr = (LAS float*)(F.lds + F.wave * 16384);
        constexpr int I_IN = (D / 64) * (INW / 32), I_BA = (512 / 64) * (D / 32), I_BS = (256 / 64) * (D / 32), I_O = (D / 64) * (D / 32);
        constexpr int PER_L = I_IN + I_BA + I_BS + I_O;
        for (int it = F.gw; it < 2 * PER_L; it += F.ngw) {
            const int l = it / PER_L; int r = it % PER_L;
            if (r < I_IN) { transpose_item(p.in[I_w_in] + (size_t)l * D * INW, D, INW, (bf16_t*)(ws + WS_WIN) + (size_t)l * INW * D, D, 0, 0, scr, r, F.lane); continue; } r -= I_IN;
            if (r < I_BA) { transpose_item(p.in[I_w_br_attn] + (size_t)l * 512 * D, 512, D, (bf16_t*)(ws + WS_WBR) + (size_t)l * D * D, D, 0, 0, scr, r, F.lane); continue; } r -= I_BA;
            if (r < I_BS) { transpose_item(p.in[I_w_br_sgu] + (size_t)l * 256 * D, 256, D, (bf16_t*)(ws + WS_WBR) + (size_t)l * D * D, D, 0, 768, scr, r, F.lane); continue; } r -= I_BS;
            transpose_item(p.in[I_w_out] + (size_t)l * D * D, D, D, (bf16_t*)(ws + WS_WOUT) + (size_t)l * D * D, D, 0, 0, scr, r, F.lane);
        }
    }
    for (int i = F.gtid; i < 2 * 256 * D; i += F.ngt) {
        const int n = i & 1023, rc = (i >> 10) & 255, l = i >> 18, g = rc >> 6;
        const float* pw = p.in[I_pool_w] + ((size_t)l * 256 + rc) * 64;
        const float* ps = p.in[I_pool_scale] + l * 256 + 64 * g;
        const float* wb = p.in[I_w_br_pool] + ((size_t)l * 256 + 64 * g) * D + n;
        float a = 0.f;
        for (int e = 0; e < 64; ++e) a += pw[e] * ps[e] * wb[(size_t)e * D];
        ((bf16_t*)(ws + WS_WBR))[(size_t)l * D * D + (size_t)n * D + 512 + rc] = (bf16_t)f2bf(a);
    }
    for (int i = F.gtid; i < 2 * 4 * 128 * 128; i += F.ngt) ((bf16_t*)(ws + WS_SGUW))[i] = (bf16_t)f2bf(p.in[I_sgu_w][i]);
    for (int i = F.gtid; i < 64 * 16; i += F.ngt) {
        const int pos = i >> 4, fi = i & 15;
        const float inv = powf(10000.0f, -(float)fi / 16.0f);
        const float ang = (float)pos * inv;
        ((f32x2*)(ws + WS_ROPE))[i] = (f32x2){cosf(ang), sinf(ang)};
    }
    convert_tables(p, F);
    {
        float* MOD = (float*)(ws + WS_MOD);
        LAS float* scd = (LAS float*)F.lds;
        LAS float* red = scd + 9 * D;
        __syncthreads();
        for (int e = F.tid; e < 9 * D; e += NTHREADS) { const int r = e >> 10, k = e & 1023; scd[e] = silu_((r < 8) ? p.in[I_c][r * D + k] : p.in[I_c_ctx][k]); }
        __syncthreads();
        for (int it = F.bid; it < 2 * 96; it += F.nb) {
            const int cgp = it % 96, l = it / 96, col = cgp * 64 + F.lane;
            float acc[9];
#pragma unroll
            for (int r = 0; r < 9; ++r) acc[r] = 0.f;
            const float* wp = p.in[I_w_mod] + ((size_t)l * D + F.wave * 128) * NMOD + col;
#pragma unroll 4
            for (int k = 0; k < 128; ++k) {
                const float w = wp[(size_t)k * NMOD];
#pragma unroll
                for (int r = 0; r < 9; ++r) acc[r] += scd[r * D + F.wave * 128 + k] * w;
            }
#pragma unroll
            for (int r = 0; r < 9; ++r) red[(F.wave * 9 + r) * 64 + F.lane] = acc[r];
            __syncthreads();
            for (int e = F.tid; e < 9 * 64; e += NTHREADS) {
                const int r = e >> 6, ln = e & 63; float s = p.in[I_b_mod][l * NMOD + cgp * 64 + ln];
#pragma unroll
                for (int w = 0; w < 8; ++w) s += red[(w * 9 + r) * 64 + ln];
                MOD[((size_t)l * 9 + r) * NMOD + cgp * 64 + ln] = s;
            }
            __syncthreads();
        }
    }
}

DI const float* mod_vec(const Params& p, int l, int row, int j) {
    const int r = row < TL ? row / SEQ : 8;
    return (const float*)(p.ws + WS_MOD) + ((size_t)l * 9 + r) * NMOD + j * D;
}
DI float* xrow_ptr(const Params& p, int row) { return row < TL ? p.out + (size_t)row * D : (float*)(p.ws + WS_XCTX) + (size_t)(row - TL) * D; }
DI const float* xin_ptr(const Params& p, int row) { return row < TL ? p.in[I_x] + (size_t)row * D : p.in[I_ctx] + (size_t)(row - TL) * D; }

DI void modulate_row_wave(const float* src, const float* g, const float* sh, const float* sc, bf16_t* dst, int lane) {
    f32x4 v[4]; float ss = 0.f;
#pragma unroll
    for (int j = 0; j < 4; ++j) { v[j] = ((const f32x4*)src)[lane + 64 * j]; ss += v[j].x * v[j].x + v[j].y * v[j].y + v[j].z * v[j].z + v[j].w * v[j].w; }
    const float rinv = rsqrtf(wave_sum(ss) * (1.0f / D) + EPS);
#pragma unroll
    for (int j = 0; j < 4; ++j) {
        const f32x4 gg = ((const f32x4*)g)[lane + 64 * j], s1 = ((const f32x4*)sh)[lane + 64 * j], s2 = ((const f32x4*)sc)[lane + 64 * j];
        const f32x4 o = v[j] * rinv * gg * (s2 + 1.0f) + s1;
        u32x2 w; w.x = pk2(o.x, o.y); w.y = pk2(o.z, o.w);
        ((u32x2*)dst)[lane + 64 * j] = w;
    }
}

DI void phase_norm(const Params& p, const Frame& F, int l, int which  , bool from_input, int nrows) {
    const float* g = (which == 0 ? p.in[I_g_mix] : p.in[I_g_ffn]) + l * D;
    for (int row = F.gw; row < nrows; row += F.ngw) {
        const float* src = from_input ? xin_ptr(p, row) : xrow_ptr(p, row);
        modulate_row_wave(src, g, mod_vec(p, l, row, which * 3 + 0), mod_vec(p, l, row, which * 3 + 1), (bf16_t*)(p.ws + WS_H) + (size_t)row * D, F.lane);
    }
}
DI void phase_final(const Params& p, const Frame& F) {
    for (int row = F.gw; row < TL; row += F.ngw) {
        f32x4* xr = (f32x4*)(p.out + (size_t)row * D);
        f32x4 v[4]; float ss = 0.f;
#pragma unroll
        for (int j = 0; j < 4; ++j) { v[j] = xr[F.lane + 64 * j]; ss += v[j].x * v[j].x + v[j].y * v[j].y + v[j].z * v[j].z + v[j].w * v[j].w; }
        const float rinv = rsqrtf(wave_sum(ss) * (1.0f / D) + EPS);
#pragma unroll
        for (int j = 0; j < 4; ++j) xr[F.lane + 64 * j] = v[j] * rinv * ((const f32x4*)p.in[I_g_final])[F.lane + 64 * j];
    }
}

DI void g1_epilogue(const Params& p, int l, const f32x16& acc, int row0, int col0, int lane) {
    const int h = lane >> 5, w = lane & 31, col = col0 + w;
    bf16_t* P = (bf16_t*)(p.ws + WS_P);
    if (col0 < VOFF) {
        const float sc = (col0 < KOFF) ? QSCALE : 1.0f;
        const int axis = (col0 >> 5) & 1, fi = w & 15;
        const f32x2* tab = (const f32x2*)(p.ws + WS_ROPE);
#pragma unroll
        for (int r = 0; r < 16; ++r) {
            const int row = row0 + crow(r, h);
            const float own = acc[r], oth = __shfl_xor(own, 16);
            float o = own;
            if (row < TL) {
                const int t = row & (SEQ - 1), pos = axis ? (t & 63) : (t >> 6);
                const f32x2 cs = tab[pos * 16 + fi];
                o = (w < 16) ? (own * cs.x - oth * cs.y) : (own * cs.x + oth * cs.y);
            }
            P[(size_t)row * PW + col] = (bf16_t)f2bf(o * sc);
        }
    } else if (col0 < POOLOFF) {
        const int hk = (col - VOFF) >> 6, d = (col - VOFF) & 63;
#pragma unroll
        for (int r = 0; r < 16; ++r) {
            const int row = row0 + crow(r, h);
            const bf16_t v = (bf16_t)f2bf(acc[r]);
            if (row < TL) { const int b = row / SEQ, t = row & (SEQ - 1); ((bf16_t*)(p.ws + WS_VT))[((size_t)(b * 2 + hk) * 64 + d) * SEQ + t] = v; }
            else { const int rc = row - TL, b = rc / NCTX, j = rc & (NCTX - 1); ((bf16_t*)(p.ws + WS_VTC))[((size_t)(b * 2 + hk) * 64 + d) * NCTX + j] = v; }
        }
    } else if (col0 < SUOFF) {
#pragma unroll
        for (int r = 0; r < 16; ++r) { const int row = row0 + crow(r, h); P[(size_t)row * PW + col] = (bf16_t)f2bf(acc[r]); }
    } else if (col0 < SVOFF) {
#pragma unroll
        for (int r = 0; r < 16; ++r) { const int row = row0 + crow(r, h); P[(size_t)row * PW + col] = (bf16_t)f2bf(gelu_tanh(acc[r])); }
    } else {
        const int c = col - SVOFF;
#pragma unroll
        for (int r = 0; r < 16; ++r) { const int row = row0 + crow(r, h); const int chunk = row >> 7, q = row & 127;
            ((bf16_t*)(p.ws + WS_VST))[((size_t)chunk * 256 + c) * 128 + q] = (bf16_t)f2bf(gelu_tanh(acc[r])); }
    }
}

DI void g1_simple(const Params& p, const Frame& F, int l, int row_lo, int nrows, int ct_lo, int nct) {
    const bf16_t* H = (const bf16_t*)(p.ws + WS_H);
    const bf16_t* W = (const bf16_t*)(p.ws + WS_WIN) + (size_t)l * INW * D;
    const int nit = (nrows / 64) * nct;
    for (int it = F.gw; it < nit; it += F.ngw) {
        const int mt = it / nct, nt = ct_lo + it % nct, m0 = row_lo + mt * 64;
        f32x16 acc[2][1]; zero_acc(acc);
        wave_gemm<2, 1>(H, D, W, D, D, m0, nt * 32, acc, F.lane);
#pragma unroll 1
        for (int i = 0; i < 2; ++i) g1_epilogue(p, l, i == 0 ? acc[0][0] : acc[1][0], m0 + 32 * i, nt * 32, F.lane);
    }
}

struct EpiG1 {
    static constexpr bool PERM = true;
    unsigned char* ws;
    DI void operator()(const f32x4 (&acc)[2][2][4][2], const pg8::Unit& u, int wr, int wc, int fr, int fq) const {
        bf16_t* P = (bf16_t*)(ws + WS_P);
        const int rbase = u.pm * 256 + wr * 64 + fr;
#pragma unroll
        for (int ai = 0; ai < 2; ++ai)
#pragma unroll
            for (int m = 0; m < 4; ++m) {
                const int row = rbase + 128 * ai + 16 * m;
#pragma unroll
                for (int bj = 0; bj < 2; ++bj) {
                    const int c0 = u.pn * 256 + 128 * bj + 32 * wc + 8 * fq;
                    float v[8];
#pragma unroll
                    for (int j = 0; j < 4; ++j) { v[j] = acc[ai][bj][m][0][j]; v[4 + j] = acc[ai][bj][m][1][j]; }
                    if (c0 < VOFF) {
                        const float sc = (c0 < KOFF) ? QSCALE : 1.0f;
                        const int t = row & (SEQ - 1), pos = (wc & 1) ? (t & 63) : (t >> 6);
                        const f32x4* tab = (const f32x4*)(ws + WS_ROPE) + (pos * 16 + 8 * (fq & 1)) / 2;
                        u32x4 o;
#pragma unroll
                        for (int j2 = 0; j2 < 4; ++j2) {
                            const f32x4 cs = tab[j2];
                            const float o0 = __shfl_xor(v[2 * j2], 32), o1 = __shfl_xor(v[2 * j2 + 1], 32);
                            const float r0 = (fq < 2) ? (v[2 * j2] * cs.x - o0 * cs.y) : (v[2 * j2] * cs.x + o0 * cs.y);
                            const float r1 = (fq < 2) ? (v[2 * j2 + 1] * cs.z - o1 * cs.w) : (v[2 * j2 + 1] * cs.z + o1 * cs.w);
                            o[j2] = pk2(r0 * sc, r1 * sc);
                        }
                        *(u32x4*)(P + (size_t)row * PW + c0) = o;
                    } else if (c0 < POOLOFF) {
                        const int hk = wc >> 1, d0 = 32 * (wc & 1) + 8 * fq, b = row / SEQ, t = row & (SEQ - 1);
                        bf16_t* vt = (bf16_t*)(ws + WS_VT) + ((size_t)(b * 2 + hk) * 64 + d0) * SEQ + t;
#pragma unroll
                        for (int j = 0; j < 8; ++j) vt[(size_t)j * SEQ] = (bf16_t)f2bf(v[j]);
                    } else if (c0 < SUOFF) {
                        u32x4 o;
#pragma unroll
                        for (int j2 = 0; j2 < 4; ++j2) o[j2] = pk2(v[2 * j2], v[2 * j2 + 1]);
                        *(u32x4*)(P + (size_t)row * PW + c0) = o;
                    } else if (c0 < SVOFF) {
                        u32x4 o;
#pragma unroll
                        for (int j2 = 0; j2 < 4; ++j2) o[j2] = pk2(gelu_tanh(v[2 * j2]), gelu_tanh(v[2 * j2 + 1]));
                        *(u32x4*)(P + (size_t)row * PW + c0) = o;
                    } else {
                        const int c = c0 - SVOFF, chunk = row >> 7, q = row & 127;
                        bf16_t* vs = (bf16_t*)(ws + WS_VST) + ((size_t)chunk * 256 + c) * 128 + q;
#pragma unroll
                        for (int j = 0; j < 8; ++j) vs[j * 128] = (bf16_t)f2bf(gelu_tanh(v[j]));
                    }
                }
                asm volatile("" ::: "memory");
            }
    }
};
struct SchedGrid {
    int nM, nN, G, c; const char* A; const char* B;
    DI bool next(int i, pg8::Unit& u) const {
        const int L = i * G + c; if (L >= nM * nN) return false;
        pg8::tile_of(L, nM, nN, u.pm, u.pn); u.sub = 0; u.nt = D / 64;
        u.a = A + (size_t)u.pm * 256 * D * 2; u.b = B + (size_t)u.pn * 256 * D * 2; return true;
    }
};

DI void phase_g1(const Params& p, const Frame& F, int l) {
    SchedGrid S{TL / 256, PW / 256, F.nb, F.bid, (const char*)(p.ws + WS_H), (const char*)(p.ws + WS_WIN) + (size_t)l * INW * D * 2};
    EpiG1 E{p.ws};
    pg8::gemm_phase(F.lds, F.tid, S, E);
    if (l == 0) g1_simple(p, F, l, TL, TC, 0, PW / 32);
    else g1_simple(p, F, l, TL, TC, 16, 8);
}

DI bf16x8 pack8(const f32x16& x, int s) {
    u32x4 pk;
#pragma unroll
    for (int j = 0; j < 4; ++j) { f32x2 v = {x[8 * s + 2 * j], x[8 * s + 2 * j + 1]}; pk[j] = __builtin_bit_cast(unsigned, __builtin_convertvector(v, bf16x2_t)); }
    return __builtin_bit_cast(bf16x8, pk);
}

DI void attn_block(const bf16x8 (&qf)[4], const bf16_t* kptr, const bf16_t* vptr, size_t vstride_d32, int mask_mode, int kq_off, int lane,
                   float& m, float& lpart, f32x16 (&o)[2]) {
    const int h = lane >> 5;
    f32x16 st;
#pragma unroll
    for (int r = 0; r < 16; ++r) st[r] = 0.f;
#pragma unroll
    for (int s = 0; s < 4; ++s) { const bf16x8 kf = *(const bf16x8*)(kptr + 16 * s); st = MFMA32(kf, qf[s], st); }
    if (mask_mode) {
#pragma unroll
        for (int r = 0; r < 16; ++r) { const int dlt = kq_off + crow(r, h); if (dlt > 128 || dlt < -128) st[r] = -1e30f; }
    }
    float bm = st[0];
#pragma unroll
    for (int r = 1; r < 16; ++r) bm = fmaxf(bm, st[r]);
    bm = fmaxf(bm, __shfl_xor(bm, 32));
    const float mn = fmaxf(m, bm), alpha = exp2f(m - mn);
    m = mn;
    float ps = 0.f;
#pragma unroll
    for (int r = 0; r < 16; ++r) { st[r] = exp2f(st[r] - mn); ps += st[r]; }
    lpart = lpart * alpha + ps;
#pragma unroll
    for (int d = 0; d < 2; ++d)
#pragma unroll
        for (int r = 0; r < 16; ++r) o[d][r] *= alpha;
    const bf16x8 pf0 = pack8(st, 0), pf1 = pack8(st, 1);
#pragma unroll
    for (int d = 0; d < 2; ++d) {
        const bf16_t* vp = vptr + (size_t)d * vstride_d32;
        const s16x4 a0 = *(const s16x4*)(vp), a1 = *(const s16x4*)(vp + 8), b0 = *(const s16x4*)(vp + 16), b1 = *(const s16x4*)(vp + 24);
        const bf16x8 v0 = __builtin_shufflevector(a0, a1, 0, 1, 2, 3, 4, 5, 6, 7), v1 = __builtin_shufflevector(b0, b1, 0, 1, 2, 3, 4, 5, 6, 7);
        o[d] = MFMA32(v0, pf0, o[d]);
        o[d] = MFMA32(v1, pf1, o[d]);
    }
}

DI void attn_task(const Params& p, int l, int task, int lane) {
    const int r = lane & 31, h = lane >> 5;
    const bf16_t* P = (const bf16_t*)(p.ws + WS_P);
    const bf16_t* VT = (const bf16_t*)(p.ws + WS_VT);
    const bf16_t* VTC = (const bf16_t*)(p.ws + WS_VTC);
    bf16_t* Y = (bf16_t*)(p.ws + WS_Y);
    const bool latent = task < 8192;
    int b, head, qb, q0row, p0;
    if (latent) { qb = task & 127; head = (task >> 7) & 7; b = task >> 10; p0 = qb * 32; q0row = b * SEQ + p0; }
    else { const int t2 = task - 8192; qb = t2 & 7; head = (t2 >> 3) & 7; b = t2 >> 6; p0 = qb * 32; q0row = TL + b * NCTX + p0; }
    const int hk = head >> 2;
    bf16x8 qf[4];
#pragma unroll
    for (int s = 0; s < 4; ++s) qf[s] = *(const bf16x8*)(P + (size_t)(q0row + r) * PW + head * 64 + 16 * s + 8 * h);
    float m = p.in[I_attn_sink][l * 8 + head] * LOG2E, lpart = (h == 0) ? 1.0f : 0.0f;
    f32x16 o[2];
#pragma unroll
    for (int d = 0; d < 2; ++d)
#pragma unroll
        for (int i = 0; i < 16; ++i) o[d][i] = 0.f;
    if (latent) {
        for (int kb = p0 - 128; kb <= p0 + 128; kb += 32) {
            if (kb < 0 || kb >= SEQ) continue;
            const bf16_t* kptr = P + (size_t)(b * SEQ + kb + r) * PW + KOFF + hk * 64 + 8 * h;
            const bf16_t* vptr = VT + ((size_t)(b * 2 + hk) * 64 + r) * SEQ + kb + 4 * h;
            const int mm = (kb == p0 - 128 || kb == p0 + 128) ? 1 : 0;
            attn_block(qf, kptr, vptr, (size_t)32 * SEQ, mm, kb - (p0 + r), lane, m, lpart, o);
        }
    }
    for (int kb = 0; kb < NCTX; kb += 32) {
        const bf16_t* kptr = P + (size_t)(TL + b * NCTX + kb + r) * PW + KOFF + hk * 64 + 8 * h;
        const bf16_t* vptr = VTC + ((size_t)(b * 2 + hk) * 64 + r) * NCTX + kb + 4 * h;
        attn_block(qf, kptr, vptr, (size_t)32 * NCTX, 0, 0, lane, m, lpart, o);
    }
    const float inv = 1.0f / (lpart + __shfl_xor(lpart, 32));
    bf16_t* yrow = Y + (size_t)(q0row + r) * D + head * 64;
#pragma unroll
    for (int d = 0; d < 2; ++d)
#pragma unroll
        for (int g = 0; g < 4; ++g) {
            u32x2 w; w.x = pk2(o[d][4 * g] * inv, o[d][4 * g + 1] * inv); w.y = pk2(o[d][4 * g + 2] * inv, o[d][4 * g + 3] * inv);
            *(u32x2*)(yrow + 32 * d + 8 * g + 4 * h) = w;
        }
}

DI void sgu_unit(const Params& p, const Frame& F, int l, int chunk) {
    constexpr int VS = 136;
    LAS float* part = (LAS float*)F.lds;
    LAS float* rq = part + 512;
    LAS bf16_t* vnT = (LAS bf16_t*)(F.lds + 4096);
    const bf16_t* VsT = (const bf16_t*)(p.ws + WS_VST) + (size_t)chunk * 256 * 128;
    const bf16_t* P = (const bf16_t*)(p.ws + WS_P);
    bf16_t* Y = (bf16_t*)(p.ws + WS_Y);
    __syncthreads();
    { const int q = F.tid & 127, part_i = F.tid >> 7; float ss = 0.f;
        for (int c = part_i * 64; c < part_i * 64 + 64; ++c) { const float v = bf2f(VsT[c * 128 + q]); ss += v * v; }
        part[part_i * 128 + q] = ss; }
    __syncthreads();
    if (F.tid < 128) rq[F.tid] = rsqrtf((part[F.tid] + part[128 + F.tid] + part[256 + F.tid] + part[384 + F.tid]) * (1.0f / 256.0f) + EPS);
    __syncthreads();
    for (int i = F.tid; i < 256 * 16; i += NTHREADS) {
        const int c = i >> 4, q8 = (i & 15) * 8;
        const u32x4 v = *(const u32x4*)(VsT + c * 128 + q8);
        u32x4 o;
#pragma unroll
        for (int j = 0; j < 4; ++j) o[j] = pk2(bflo(v[j]) * rq[q8 + 2 * j], bfhi(v[j]) * rq[q8 + 2 * j + 1]);
        *(LAS u32x4*)(vnT + c * VS + q8) = o;
    }
    __syncthreads();
    const int lane = F.lane, r = lane & 31, h = lane >> 5, g = F.wave >> 1, ph = F.wave & 1;
    const bf16_t* Wg = (const bf16_t*)(p.ws + WS_SGUW) + ((size_t)l * 4 + g) * 128 * 128;
#pragma unroll 1
    for (int pb = 0; pb < 2; ++pb) {
        const int p0 = 64 * ph + 32 * pb;
#pragma unroll 1
        for (int cb = 0; cb < 2; ++cb) {
            const int c0 = 64 * g + 32 * cb;
            f32x16 acc;
#pragma unroll
            for (int i = 0; i < 16; ++i) acc[i] = 0.f;
#pragma unroll
            for (int s = 0; s < 8; ++s) {
                const bf16x8 a = *(const LAS bf16x8*)(vnT + (c0 + r) * VS + 16 * s + 8 * h);
                const bf16x8 b = *(const bf16x8*)(Wg + (size_t)(p0 + r) * 128 + 16 * s + 8 * h);
                acc = MFMA32(a, b, acc);
            }
            const int row = chunk * 128 + p0 + r;
            const float bias = p.in[I_sgu_b][(l * 4 + g) * 128 + p0 + r];
#pragma unroll
            for (int q4 = 0; q4 < 4; ++q4) {
                const int cc = c0 + 8 * q4 + 4 * h;
                const u32x2 u = *(const u32x2*)(P + (size_t)row * PW + SUOFF + cc);
                u32x2 w;
                w.x = pk2(bflo(u.x) * (acc[4 * q4] + bias), bfhi(u.x) * (acc[4 * q4 + 1] + bias));
                w.y = pk2(bflo(u.y) * (acc[4 * q4 + 2] + bias), bfhi(u.y) * (acc[4 * q4 + 3] + bias));
                *(u32x2*)(Y + (size_t)row * D + 768 + cc) = w;
            }
        }
    }
}

DI void phase_mix(const Params& p, const Frame& F, int l) {
    const int ntask = (l == 0) ? 8192 + 512 : 8192;
    for (int task = F.gw; task < ntask; task += F.ngw) attn_task(p, l, task, F.lane);
    const int nchunk = (l == 0) ? T / 128 : TL / 128;
    for (int ch = F.bid; ch < nchunk; ch += F.nb) sgu_unit(p, F, l, ch);
    const int nrows = (l == 0) ? T : TL;
    const bf16_t* P = (const bf16_t*)(p.ws + WS_P);
    bf16_t* Y = (bf16_t*)(p.ws + WS_Y);
    for (int i = F.gtid; i < nrows * 32; i += F.ngt) {
        const int row = i >> 5, ck = i & 31, g = ck >> 3, half = 1 << g;
        int base, t, len;
        if (row < TL) { base = row & ~(SEQ - 1); t = row & (SEQ - 1); len = SEQ; } else { const int rc = row - TL; base = TL + (rc & ~(NCTX - 1)); t = rc & (NCTX - 1); len = NCTX; }
        const int lo = max(t - half, 0), hi = min(t + half, len);
        float s[8];
#pragma unroll
        for (int j = 0; j < 8; ++j) s[j] = 0.f;
        for (int tt = lo; tt < hi; ++tt) {
            const u32x4 v = *(const u32x4*)(P + (size_t)(base + tt) * PW + POOLOFF + ck * 8);
#pragma unroll
            for (int j = 0; j < 4; ++j) { s[2 * j] += bflo(v[j]); s[2 * j + 1] += bfhi(v[j]); }
        }
        const float inv = 1.0f / (float)(hi - lo);
        const u32x4 z = *(const u32x4*)(P + (size_t)row * PW + POOLOFF + ck * 8);
        u32x4 o;
#pragma unroll
        for (int j = 0; j < 4; ++j) o[j] = pk2(s[2 * j] * inv - bflo(z[j]), s[2 * j + 1] * inv - bfhi(z[j]));
        *(u32x4*)(Y + (size_t)row * D + 512 + ck * 8) = o;
    }
}

DI void g2_simple(const Params& p, const Frame& F, int l, int row_lo, int nrows) {
    const bf16_t* H = (const bf16_t*)(p.ws + WS_H);
    const bf16_t* Yb = (const bf16_t*)(p.ws + WS_Y);
    const bf16_t* Wg = (const bf16_t*)(p.ws + WS_WIN) + (size_t)l * INW * D + (size_t)GATEOFF * D;
    const bf16_t* Wb = (const bf16_t*)(p.ws + WS_WBR) + (size_t)l * D * D;
    bf16_t* M = (bf16_t*)(p.ws + WS_MERGED);
    const int nit = (nrows / 64) * (D / 32);
    for (int it = F.gw; it < nit; it += F.ngw) {
        const int mt = it / (D / 32), nt = it % (D / 32), m0 = row_lo + mt * 64, n0 = nt * 32;
        f32x16 tot[2][1]; zero_acc(tot);
#pragma unroll 1
        for (int i = 0; i < 3; ++i) {
            const int koff = (i == 0) ? 0 : (i == 1 ? 512 : 768), kk = (i == 0) ? 512 : 256;
            f32x16 g[2][1], pr[2][1]; zero_acc(g); zero_acc(pr);
            wave_gemm<2, 1>(H, D, Wg + (size_t)i * D * D, D, D, m0, n0, g, F.lane);
            wave_gemm<2, 1>(Yb + koff, D, Wb + koff, D, kk, m0, n0, pr, F.lane);
#pragma unroll
            for (int a = 0; a < 2; ++a)
#pragma unroll
                for (int r = 0; r < 16; ++r) tot[a][0][r] += sigmoidf_(g[a][0][r]) * pr[a][0][r];
        }
        const int h = F.lane >> 5, col = n0 + (F.lane & 31);
#pragma unroll
        for (int a = 0; a < 2; ++a)
#pragma unroll
            for (int r = 0; r < 16; ++r) M[(size_t)(m0 + 32 * a + crow(r, h)) * D + col] = (bf16_t)f2bf(tot[a][0][r]);
    }
}
struct SchedG2 {
    int G, c; const char *H, *Y, *Wg, *Wb;
    DI bool next(int i, pg8::Unit& u) const {
        const int tile = (i / 6) * G + c; if (tile >= (TL / 256) * 4) return false;
        const int sub = i % 6, br = sub >> 1;
        pg8::tile_of(tile, TL / 256, 4, u.pm, u.pn); u.sub = sub;
        if ((sub & 1) == 0) { u.nt = 16; u.a = H + (size_t)u.pm * 256 * D * 2; u.b = Wg + ((size_t)br * D + u.pn * 256) * D * 2; }
        else { const int koff = (br == 0) ? 0 : (br == 1 ? 512 : 768); u.nt = (br == 0) ? 8 : 4;
               u.a = Y + ((size_t)u.pm * 256 * D + koff) * 2; u.b = Wb + ((size_t)u.pn * 256 * D + koff) * 2; }
        return true;
    }
};
struct EpiG2 {
    static constexpr bool PERM = true;
    bf16_t* scr; bf16_t* M;
    DI void operator()(const f32x4 (&acc)[2][2][4][2], const pg8::Unit& u, int wr, int wc, int fr, int fq) const {
#pragma unroll
        for (int ai = 0; ai < 2; ++ai)
#pragma unroll
            for (int m = 0; m < 4; ++m) {
                const int rl = 128 * ai + 64 * wr + 16 * m + fr;
#pragma unroll
                for (int bj = 0; bj < 2; ++bj) {
                    const int cl = 128 * bj + 32 * wc + 8 * fq;
                    float v[8];
#pragma unroll
                    for (int j = 0; j < 4; ++j) { v[j] = acc[ai][bj][m][0][j]; v[4 + j] = acc[ai][bj][m][1][j]; }
                    u32x4* sp = (u32x4*)(scr + rl * 256 + cl);
                    if ((u.sub & 1) == 0) {
                        u32x4 o;
#pragma unroll
                        for (int j2 = 0; j2 < 4; ++j2) o[j2] = pk2(sigmoidf_(v[2 * j2]), sigmoidf_(v[2 * j2 + 1]));
                        *sp = o;
                    } else {
                        const u32x4 g = *sp;
                        u32x4* mp = (u32x4*)(M + (size_t)(u.pm * 256 + rl) * D + u.pn * 256 + cl);
                        float o[8];
#pragma unroll
                        for (int j2 = 0; j2 < 4; ++j2) { o[2 * j2] = bflo(g[j2]) * v[2 * j2]; o[2 * j2 + 1] = bfhi(g[j2]) * v[2 * j2 + 1]; }
                        if (u.sub > 1) { const u32x4 old = *mp;
#pragma unroll
                            for (int j2 = 0; j2 < 4; ++j2) { o[2 * j2] += bflo(old[j2]); o[2 * j2 + 1] += bfhi(old[j2]); } }
                        u32x4 w;
#pragma unroll
                        for (int j2 = 0; j2 < 4; ++j2) w[j2] = pk2(o[2 * j2], o[2 * j2 + 1]);
                        *mp = w;
                    }
                }
                asm volatile("" ::: "memory");
            }
    }
};
DI void phase_g2(const Params& p, const Frame& F, int l) {
    SchedG2 S{F.nb, F.bid, (const char*)(p.ws + WS_H), (const char*)(p.ws + WS_Y),
              (const char*)(p.ws + WS_WIN) + ((size_t)l * INW + GATEOFF) * D * 2, (const char*)(p.ws + WS_WBR) + (size_t)l * D * D * 2};
    EpiG2 E{(bf16_t*)(p.ws + WS_IDX) + (size_t)F.bid * 65536, (bf16_t*)(p.ws + WS_MERGED)};
    pg8::gemm_phase(F.lds, F.tid, S, E);
    if (l == 0) g2_simple(p, F, l, TL, TC);
}

DI void g3_simple(const Params& p, const Frame& F, int l, int row_lo, int nrows) {
    const bf16_t* M = (const bf16_t*)(p.ws + WS_MERGED);
    const bf16_t* W = (const bf16_t*)(p.ws + WS_WOUT) + (size_t)l * D * D;
    const int nit = (nrows / 64) * (D / 64);
    for (int it = F.gw; it < nit; it += F.ngw) {
        const int mt = it / (D / 64), nt = it % (D / 64), m0 = row_lo + mt * 64, n0 = nt * 64;
        f32x16 acc[2][2]; zero_acc(acc);
        wave_gemm<2, 2>(M, D, W, D, D, m0, n0, acc, F.lane);
        const int h = F.lane >> 5;
#pragma unroll
        for (int a = 0; a < 2; ++a)
#pragma unroll
            for (int j = 0; j < 2; ++j) {
                const int col = n0 + 32 * j + (F.lane & 31);
#pragma unroll
                for (int r = 0; r < 16; ++r) {
                    const int row = m0 + 32 * a + crow(r, h);
                    const float xs = (l == 0) ? xin_ptr(p, row)[col] : xrow_ptr(p, row)[col];
                    xrow_ptr(p, row)[col] = xs + mod_vec(p, l, row, 2)[col] * acc[a][j][r];
                }
            }
    }
}
struct EpiG3 {
    static constexpr bool PERM = false;
    const float* xsrc; float* xdst; const float* mod;
    DI void operator()(const f32x4 (&acc)[2][2][4][2], const pg8::Unit& u, int wr, int wc, int fr, int fq) const {
        const int col0 = u.pn * 256 + wc * 32 + 4 * fq;
        const float* gt = mod + (size_t)(u.pm >> 4) * NMOD + 2 * D;
#pragma unroll
        for (int ai = 0; ai < 2; ++ai)
#pragma unroll
            for (int m = 0; m < 4; ++m) {
                const size_t off = (size_t)(u.pm * 256 + wr * 64 + fr + 128 * ai + 16 * m) * D;
#pragma unroll
                for (int bj = 0; bj < 2; ++bj)
#pragma unroll
                    for (int n = 0; n < 2; ++n) {
                        const int c = col0 + 128 * bj + 16 * n;
                        const f32x4 xv = *(const f32x4*)(xsrc + off + c), gv = *(const f32x4*)(gt + c);
                        *(f32x4*)(xdst + off + c) = xv + gv * acc[ai][bj][m][n];
                    }
                asm volatile("" ::: "memory");
            }
    }
};
DI void phase_g3(const Params& p, const Frame& F, int l) {
    SchedGrid S{TL / 256, D / 256, F.nb, F.bid, (const char*)(p.ws + WS_MERGED), (const char*)(p.ws + WS_WOUT) + (size_t)l * D * D * 2};
    EpiG3 E{(l == 0) ? p.in[I_x] : p.out, p.out, (const float*)(p.ws + WS_MOD) + (size_t)l * 9 * NMOD};
    pg8::gemm_phase(F.lds, F.tid, S, E);
    if (l == 0) g3_simple(p, F, l, TL, TC);
}

DI void g45_simple(const Params& p, const Frame& F, int l, int row_lo, int nrows) {
    const bf16_t* H = (const bf16_t*)(p.ws + WS_H);
    const bf16_t* W = (const bf16_t*)(p.ws + WS_WFOLD) + (size_t)l * 2048 * D;
    float* ST = (float*)(p.ws + WS_ST);
    const int nit = (2048 / 64) * (nrows / 64);
    for (int it = F.gw; it < nit; it += F.ngw) {
        const int nt = it / 32, mt = it % 32, m0 = mt * 64, n0 = row_lo + nt * 64;
        f32x16 acc[2][2]; zero_acc(acc);
        wave_gemm<2, 2>(W, D, H, D, D, m0, n0, acc, F.lane);
        const int h = F.lane >> 5;
#pragma unroll
        for (int a = 0; a < 2; ++a)
#pragma unroll
            for (int j = 0; j < 2; ++j)
#pragma unroll
                for (int r = 0; r < 16; ++r) ST[(size_t)(m0 + 32 * a + crow(r, h)) * T + n0 + 32 * j + (F.lane & 31)] = acc[a][j][r];
    }
}
struct EpiG45 {
    static constexpr bool PERM = false;
    float* ST;
    DI void operator()(const f32x4 (&acc)[2][2][4][2], const pg8::Unit& u, int wr, int wc, int fr, int fq) const {
        const int col0 = u.pn * 256 + wc * 32 + 4 * fq;
#pragma unroll
        for (int ai = 0; ai < 2; ++ai)
#pragma unroll
            for (int m = 0; m < 4; ++m) {
                float* rowp = ST + (size_t)(u.pm * 256 + wr * 64 + fr + 128 * ai + 16 * m) * T + col0;
#pragma unroll
                for (int bj = 0; bj < 2; ++bj)
#pragma unroll
                    for (int n = 0; n < 2; ++n) *(f32x4*)(rowp + 128 * bj + 16 * n) = acc[ai][bj][m][n];
            }
    }
};
DI void phase_g45(const Params& p, const Frame& F, int l) {
    SchedGrid S{2048 / 256, TL / 256, F.nb, F.bid, (const char*)(p.ws + WS_WFOLD) + (size_t)l * 2048 * D * 2, (const char*)(p.ws + WS_H)};
    EpiG45 E{(float*)(p.ws + WS_ST)};
    pg8::gemm_phase(F.lds, F.tid, S, E);
    if (l == 0) g45_simple(p, F, l, TL, TC);
}

DI unsigned fkey(float f) { const unsigned u = __builtin_bit_cast(unsigned, f); return (u & 0x80000000u) ? ~u : (u | 0x80000000u); }
DI float fkey_inv(unsigned k) { const unsigned u = (k & 0x80000000u) ? (k & 0x7fffffffu) : ~k; return __builtin_bit_cast(float, u); }
#define INSERT16(L, x) do { unsigned x_ = (x); _Pragma("unroll") for (int k_ = 0; k_ < 16; ++k_) { const unsigned hi_ = max(L[k_], x_); x_ = min(L[k_], x_); L[k_] = hi_; } } while (0)

DI void phase_sel(const Params& p, const Frame& F, int l) {
    const float* ST = (const float*)(p.ws + WS_ST);
    unsigned short* IDX = (unsigned short*)(p.ws + WS_IDX);
    float* GW = (float*)(p.ws + WS_GW);
    float* SU = (float*)(p.ws + WS_SU);
    const float* TSC = (const float*)(p.ws + WS_TSCALE) + (size_t)l * 2 * NEXP;
    LAS unsigned char* ib = (LAS unsigned char*)F.lds;
    const int ntok = (l == 0) ? T : TL;
    for (int i0 = F.bid * NTHREADS; i0 < ntok * 8; i0 += F.nb * NTHREADS) {
        const int i = i0 + F.tid;
        const int tok = i % ntok, head = i / ntok;
        unsigned la[16], lb[16];
#pragma unroll
        for (int k = 0; k < 16; ++k) { la[k] = 0u; lb[k] = 0u; }
        const float* s0 = ST + (size_t)(head * 256) * T + tok;
#pragma unroll 1
        for (int k0 = 0; k0 < 256; k0 += 32) {
            float buf[32];
#pragma unroll
            for (int j = 0; j < 32; ++j) buf[j] = s0[(size_t)(k0 + j) * T];
            if (k0 < 128) {
#pragma unroll
                for (int j = 0; j < 32; ++j) { const unsigned key = (fkey(buf[j]) & ~127u) | (unsigned)(127 - ((k0 + j) & 127)); INSERT16(la, key); }
            } else {
#pragma unroll
                for (int j = 0; j < 32; ++j) { const unsigned key = (fkey(buf[j]) & ~127u) | (unsigned)(127 - ((k0 + j) & 127)); INSERT16(lb, key); }
            }
        }
        float va[16], vb[16];
#pragma unroll
        for (int k = 0; k < 16; ++k) {
            va[k] = fkey_inv(la[k] & ~127u); vb[k] = fkey_inv(lb[k] & ~127u);
            ib[k * NTHREADS + F.tid] = (unsigned char)(127u - (la[k] & 127u));
            ib[(16 + k) * NTHREADS + F.tid] = (unsigned char)(127u - (lb[k] & 127u));
        }
        unsigned lc[16];
#pragma unroll
        for (int k = 0; k < 16; ++k) lc[k] = 0u;
#pragma unroll
        for (int a = 0; a < 16; ++a)
#pragma unroll
            for (int b = 0; b < 16; ++b)
                if ((a + 1) * (b + 1) <= 16) { const unsigned key = (fkey(va[a] + vb[b]) & ~255u) | (unsigned)(255 - (a * 16 + b)); INSERT16(lc, key); }
        float e[16], sum = 0.f; const float v0 = fkey_inv(lc[0] & ~255u);
#pragma unroll
        for (int k = 0; k < 16; ++k) { e[k] = __expf(fkey_inv(lc[k] & ~255u) - v0); sum += e[k]; }
        const float inv = 1.0f / sum;
        asm volatile("s_waitcnt lgkmcnt(0)" ::: "memory");
#pragma unroll
        for (int k = 0; k < 16; ++k) {
            const unsigned pos = 255u - (lc[k] & 255u), a = pos >> 4, b = pos & 15u;
            const unsigned ea = ib[a * NTHREADS + F.tid], eb = ib[(16 + b) * NTHREADS + F.tid];
            const unsigned ex = ea * 128u + eb;
            IDX[(size_t)tok * 128 + head * 16 + k] = (unsigned short)ex;
            GW[(size_t)tok * 128 + head * 16 + k] = e[k] * inv * TSC[NEXP + ex];
            SU[(size_t)tok * 128 + head * 16 + k] = TSC[ex];
        }
        asm volatile("s_waitcnt lgkmcnt(0)" ::: "memory");
    }
}

DI float dot16_fp8(const u32x4 q, const float (&hx)[16]) {
    f32x2 a = {0.f, 0.f};
#pragma unroll
    for (int j = 0; j < 4; ++j) {
        const f32x2 lo = __builtin_amdgcn_cvt_pk_f32_fp8((int)q[j], false), hi = __builtin_amdgcn_cvt_pk_f32_fp8((int)q[j], true);
        a += lo * (f32x2){hx[4 * j], hx[4 * j + 1]}; a += hi * (f32x2){hx[4 * j + 2], hx[4 * j + 3]};
    }
    return a.x + a.y;
}
DI void phase_peer_u(const Params& p, const Frame& F, int l, bool dummy = false) {
    const int ntok = (l == 0) ? T : TL, lane = F.lane;
    const int slice = F.bid & 7, sw = (F.bid >> 3) * NWAVES + F.wave, nsw = (F.nb >> 3) * NWAVES;
    const bf16_t* H = (const bf16_t*)(p.ws + WS_H);
    const unsigned char* UT = p.ws + WS_UTAB + (size_t)l * NEXP * D;
    const unsigned short* IDX = (const unsigned short*)(p.ws + WS_IDX);
    float* GW = (float*)(p.ws + WS_GW);
    float* CO = dummy ? (float*)(p.ws + WS_ST) : GW;
    const float* SU = (const float*)(p.ws + WS_SU);
    const int b5 = lane >> 5, b4 = (lane >> 4) & 1;
    for (int tok = sw; tok < ntok; tok += nsw) {
        float hx[16];
        { const u32x4 a = *(const u32x4*)(H + (size_t)tok * D + 16 * lane), b = *(const u32x4*)(H + (size_t)tok * D + 16 * lane + 8);
#pragma unroll
            for (int j = 0; j < 4; ++j) { hx[2 * j] = bflo(a[j]); hx[2 * j + 1] = bfhi(a[j]); hx[8 + 2 * j] = bflo(b[j]); hx[8 + 2 * j + 1] = bfhi(b[j]); } }
#pragma unroll 1
        for (int half = 0; half < 2; ++half) {
            const int ev = IDX[(size_t)tok * 128 + 64 * half + lane];
            const float gv = GW[(size_t)tok * 128 + 64 * half + lane], sv = SU[(size_t)tok * 128 + 64 * half + lane];
            unsigned long long m = __ballot((ev >> 11) == slice);
            while (m) {
                int kk[4]; int n = 0;
#pragma unroll
                for (int u = 0; u < 4; ++u) { if (m) { kk[u] = __builtin_ctzll(m); m &= m - 1; n = u + 1; } else kk[u] = kk[0]; }
                float d[4];
#pragma unroll
                for (int u = 0; u < 4; ++u) {
                    const int e = __builtin_amdgcn_readlane(ev, kk[u]);
                    const u32x4 q = *(const u32x4*)(UT + (size_t)e * D + 16 * lane);
                    d[u] = dot16_fp8(q, hx);
                }
                float k0 = b5 ? d[2] : d[0], k1 = b5 ? d[3] : d[1];
                const float s0 = b5 ? d[0] : d[2], s1 = b5 ? d[1] : d[3];
                k0 += __shfl_xor(s0, 32); k1 += __shfl_xor(s1, 32);
                float kv = b4 ? k1 : k0; const float ss = b4 ? k0 : k1;
                kv += __shfl_xor(ss, 16);
                kv += __shfl_xor(kv, 8); kv += __shfl_xor(kv, 4); kv += __shfl_xor(kv, 2); kv += __shfl_xor(kv, 1);
                const int u_me = 2 * b5 + b4;
                const int k_me = (u_me == 0) ? kk[0] : (u_me == 1) ? kk[1] : (u_me == 2) ? kk[2] : kk[3];
                const float g_me = __shfl(gv, k_me), s_me = __shfl(sv, k_me);
                if ((lane & 15) == 0 && u_me < n) CO[(size_t)tok * 128 + 64 * half + k_me] = g_me * gelu_tanh(kv * s_me);
            }
        }
    }
}
DI void phase_peer_v(const Params& p, const Frame& F, int l, bool dummy = false) {
    const int ntok = (l == 0) ? T : TL, lane = F.lane;
    const int slice = F.bid & 7, sw = (F.bid >> 3) * NWAVES + F.wave, nsw = (F.nb >> 3) * NWAVES;
    const unsigned char* VT8 = p.ws + WS_VTAB + (size_t)l * NEXP * D + 128 * slice + 16 * (lane & 7);
    const unsigned short* IDX = (const unsigned short*)(p.ws + WS_IDX);
    const float* CF = (const float*)(p.ws + WS_GW);
    const int b5 = lane >> 5, b4 = (lane >> 4) & 1, b3 = (lane >> 3) & 1;
    for (int tok = sw; tok < ntok; tok += nsw) {
        f32x2 a[8];
#pragma unroll
        for (int j = 0; j < 8; ++j) a[j] = (f32x2){0.f, 0.f};
        const unsigned short* ip = IDX + (size_t)tok * 128 + (lane >> 3);
        const float* cp = CF + (size_t)tok * 128 + (lane >> 3);
#pragma unroll
        for (int i = 0; i < 16; ++i) {
            const int e = ip[8 * i]; const float cf = cp[8 * i];
            const u32x4 q = *(const u32x4*)(VT8 + (size_t)e * D);
            const f32x2 c2 = {cf, cf};
#pragma unroll
            for (int j = 0; j < 4; ++j) {
                a[2 * j] += c2 * __builtin_amdgcn_cvt_pk_f32_fp8((int)q[j], false);
                a[2 * j + 1] += c2 * __builtin_amdgcn_cvt_pk_f32_fp8((int)q[j], true);
            }
        }
        f32x2 k4[4];
#pragma unroll
        for (int j = 0; j < 4; ++j) { const f32x2 keep = b5 ? a[4 + j] : a[j], send = b5 ? a[j] : a[4 + j];
            k4[j] = keep + (f32x2){__shfl_xor(send.x, 32), __shfl_xor(send.y, 32)}; }
        f32x2 k2[2];
#pragma unroll
        for (int j = 0; j < 2; ++j) { const f32x2 keep = b4 ? k4[2 + j] : k4[j], send = b4 ? k4[j] : k4[2 + j];
            k2[j] = keep + (f32x2){__shfl_xor(send.x, 16), __shfl_xor(send.y, 16)}; }
        f32x2 k1;
        { const f32x2 keep = b3 ? k2[1] : k2[0], send = b3 ? k2[0] : k2[1];
            k1 = keep + (f32x2){__shfl_xor(send.x, 8), __shfl_xor(send.y, 8)}; }
        const int col = 128 * slice + 16 * (lane & 7) + 8 * b5 + 4 * b4 + 2 * b3;
        f32x2* xp = (f32x2*)(xrow_ptr(p, tok) + col);
        f32x2* xo = dummy ? (f32x2*)((float*)(p.ws + WS_ST) + (size_t)tok * D + col) : xp;
        const f32x2 gt = *(const f32x2*)(mod_vec(p, l, tok, 5) + col);
        *xo = *xp + gt * k1;
    }
}

#define XB_TMO      128
#define XB_XCNT(j)  (256  + 64 * (j))
#define XB_XSUB(j)  (1280 + 64 * (j))
#define XB_XGEN(j)  (2304 + 64 * (j))
#define XB_TOP      3328
#define XB_TOPGEN   3392
#define XCD_BAR_WORDS 3456
#define XB_SPIN_CAP (1u << 18)
DI unsigned xb_ld(unsigned* p)              { return __hip_atomic_load(p, __ATOMIC_RELAXED, __HIP_MEMORY_SCOPE_AGENT); }
DI unsigned xb_add(unsigned* p, unsigned v) { return __hip_atomic_fetch_add(p, v, __ATOMIC_RELAXED, __HIP_MEMORY_SCOPE_AGENT); }
DI unsigned xb_xcc_id() { return (unsigned)__builtin_amdgcn_s_getreg((3 << 11) | 20) & 0xFu; }
#define XB_SPIN(cond, bar) do { unsigned _sp = 0; while (cond) { __builtin_amdgcn_s_sleep(1); \
    if ((++_sp & 255u) == 0u) { if (xb_ld(&(bar)[XB_TMO])) break; if (_sp > XB_SPIN_CAP) { atomicAdd(&(bar)[XB_TMO], 1u); break; } } } } while (0)
struct XcdBarrier { unsigned* bar; unsigned x; volatile LAS unsigned* st; };
DI XcdBarrier xcd_barrier_post(unsigned* bar, volatile LAS unsigned* st) {
    XcdBarrier b; b.bar = bar; b.x = xb_xcc_id(); b.st = st;
    if (threadIdx.x == 0) (void)xb_add(&bar[XB_XCNT(b.x)], 1u);
    return b;
}
DI void xcd_barrier_complete(unsigned* bar, unsigned x, unsigned& nloc, unsigned& nx) {
    const unsigned G = gridDim.x * gridDim.y * gridDim.z;
    unsigned sum, cnt, mine, sp = 0u;
    for (;;) {
        sum = 0u; cnt = 0u; mine = 0u;
#pragma unroll
        for (unsigned j = 0; j < 16; ++j) { const unsigned c = xb_ld(&bar[XB_XCNT(j)]); sum += c; cnt += (c > 0u) ? 1u : 0u; mine = (j == x) ? c : mine; }
        if (sum == G) break;
        __builtin_amdgcn_s_sleep(1);
        if ((++sp & 255u) == 0u) { if (xb_ld(&bar[XB_TMO])) break; if (sp > XB_SPIN_CAP) { atomicAdd(&bar[XB_TMO], 1u); break; } }
    }
    nloc = mine > 0u ? mine : 1u; nx = cnt > 0u ? cnt : 1u;
}
DI void xcd_barrier(const XcdBarrier& b) {
    asm volatile("s_waitcnt vmcnt(0)" ::: "memory");
    __syncthreads();
    if (threadIdx.x == 0) {
        unsigned* bar = b.bar;
        __builtin_amdgcn_s_waitcnt(0);
        unsigned nloc = b.st[0], nx = b.st[1];
        if (nloc == 0u) { xcd_barrier_complete(bar, b.x, nloc, nx); b.st[0] = nloc; b.st[1] = nx; }
        const unsigned old = xb_add(&bar[XB_XSUB(b.x)], 1u);
        const unsigned gen = old / nloc;
        if (old + 1u == (gen + 1u) * nloc) {
            __builtin_amdgcn_fence(__ATOMIC_RELEASE, "agent");
            asm volatile("s_waitcnt vmcnt(0)" ::: "memory");
            const unsigned og = xb_add(&bar[XB_TOP], 1u);
            const unsigned tg = og / nx;
            if (og + 1u == (tg + 1u) * nx) xb_add(&bar[XB_TOPGEN], 1u);
            else XB_SPIN(xb_ld(&bar[XB_TOPGEN]) == tg, bar);
            __builtin_amdgcn_fence(__ATOMIC_ACQUIRE, "agent");
            xb_add(&bar[XB_XGEN(b.x)], 1u);
            asm volatile("s_waitcnt vmcnt(0)" ::: "memory");
        } else {
            XB_SPIN(xb_ld(&bar[XB_XGEN(b.x)]) == gen, bar);
            __builtin_amdgcn_fence(__ATOMIC_ACQUIRE, "agent");
            asm volatile("s_waitcnt vmcnt(0)" ::: "memory");
        }
    }
    __syncthreads();
}
constexpr int LDS_BAR_OFF = 135168;

constexpr int NPHASE = 22;
template <int PH> DI void run_phase(const Params& p, const Frame& F) {
    if constexpr (PH == 0) phase_prep(p, F);
    else if constexpr (PH == 1) phase_norm(p, F, 0, 0, true, T);
    else if constexpr (PH == 2) phase_g1(p, F, 0);
    else if constexpr (PH == 3) phase_mix(p, F, 0);
    else if constexpr (PH == 4) phase_g2(p, F, 0);
    else if constexpr (PH == 5) phase_g3(p, F, 0);
    else if constexpr (PH == 6) phase_norm(p, F, 0, 1, false, T);
    else if constexpr (PH == 7) phase_g45(p, F, 0);
    else if constexpr (PH == 8) phase_sel(p, F, 0);
    else if constexpr (PH == 9) phase_peer_u(p, F, 0);
    else if constexpr (PH == 10) phase_peer_v(p, F, 0);
    else if constexpr (PH == 11) phase_norm(p, F, 1, 0, false, T);
    else if constexpr (PH == 12) phase_g1(p, F, 1);
    else if constexpr (PH == 13) phase_mix(p, F, 1);
    else if constexpr (PH == 14) phase_g2(p, F, 1);
    else if constexpr (PH == 15) phase_g3(p, F, 1);
    else if constexpr (PH == 16) phase_norm(p, F, 1, 1, false, TL);
    else if constexpr (PH == 17) phase_g45(p, F, 1);
    else if constexpr (PH == 18) phase_sel(p, F, 1);
    else if constexpr (PH == 19) phase_peer_u(p, F, 1);
    else if constexpr (PH == 20) phase_peer_v(p, F, 1);
    else if constexpr (PH == 21) phase_final(p, F);
}
DI Frame make_frame(unsigned char* lds_raw) {
    Frame F;
    F.lds = (LAS unsigned char*)lds_raw;
    int tid = threadIdx.x; asm volatile("" : "+v"(tid));
    int bid = blockIdx.x, nb = gridDim.x; asm volatile("" : "+s"(bid), "+s"(nb));
    F.tid = tid; F.lane = tid & 63; F.wave = __builtin_amdgcn_readfirstlane(tid >> 6); F.bid = bid; F.nb = nb;
    F.gw = bid * NWAVES + F.wave; F.ngw = nb * NWAVES; F.gtid = bid * NTHREADS + tid; F.ngt = nb * NTHREADS;
    return F;
}
template <int PH> DI void run_phase_fresh(unsigned char* lds_raw) {
#if defined(__HIP_DEVICE_COMPILE__)
    const __attribute__((address_space(4))) unsigned long long* pp = (const __attribute__((address_space(4))) unsigned long long*)__builtin_amdgcn_kernarg_segment_ptr();
    asm volatile("" : "+s"(pp));
    Params p;
#pragma unroll
    for (int i = 0; i < N_IN; ++i) p.in[i] = (const float*)(const __attribute__((address_space(1))) float*)pp[i];
    p.out = (float*)(__attribute__((address_space(1))) float*)pp[N_IN]; p.ws = (unsigned char*)(__attribute__((address_space(1))) unsigned char*)pp[N_IN + 1]; p.ph_lo = 0; p.ph_hi = 0;
#else
    Params p{};
#endif
    const Frame F = make_frame(lds_raw);
    run_phase<PH>(p, F);
}
template <int PH> __global__ void __launch_bounds__(NTHREADS, 2) phase_kernel(Params p) {
    extern __shared__ __attribute__((aligned(16))) unsigned char lds_raw[];
    run_phase_fresh<PH>(lds_raw);
}
template <int PH> DI void run_all(unsigned char* lds_raw, cg::grid_group& grid, const XcdBarrier& bar) {
    if constexpr (PH < NPHASE) {
        run_phase_fresh<PH>(lds_raw);
        if constexpr (PH == 0) grid.sync();
        else if constexpr (PH + 1 < NPHASE) xcd_barrier(bar);
        run_all<PH + 1>(lds_raw, grid, bar);
    }
}
__global__ void __launch_bounds__(NTHREADS, 2) mega(Params p) {
    extern __shared__ __attribute__((aligned(16))) unsigned char lds_raw[];
    cg::grid_group grid = cg::this_grid();
    volatile LAS unsigned* st = (volatile LAS unsigned*)((LAS unsigned char*)lds_raw + LDS_BAR_OFF);
    if (threadIdx.x < 2) st[threadIdx.x] = 0u;
    __syncthreads();
    const XcdBarrier bar = xcd_barrier_post((unsigned*)(p.ws + WS_CTL), st);
    run_all<0>(lds_raw, grid, bar);
}

extern "C" void kernel_launch(void* const* d_in, const int* in_sizes, int n_in, void* d_out, int out_size, void* d_ws, size_t ws_size, hipStream_t stream) {
    static int grid = 0;
    if (grid == 0) {
        if (n_in != 23 || out_size != TL * D || ws_size < WS_END) { fprintf(stderr, "kernel_launch: unexpected shapes (n_in %d out %d ws %zu)\n", n_in, out_size, ws_size); grid = -1; return; }
        int dev = 0, cus = 0, per_cu = 0;
        (void)hipGetDevice(&dev);
        (void)hipDeviceGetAttribute(&cus, hipDeviceAttributeMultiprocessorCount, dev);
        (void)hipFuncSetAttribute((const void*)mega, hipFuncAttributeMaxDynamicSharedMemorySize, LDS_BYTES);
        (void)hipOccupancyMaxActiveBlocksPerMultiprocessor(&per_cu, (const void*)mega, NTHREADS, LDS_BYTES);
        if (per_cu < 1) { fprintf(stderr, "kernel_launch: occupancy query reports %d blocks per CU\n", per_cu); grid = -1; return; }
        grid = cus & ~7;
        if (grid < 8) { fprintf(stderr, "kernel_launch: needs at least 8 CUs\n"); grid = -1; return; }
    }
    if (grid < 0) return;
    (void)hipMemsetAsync((char*)d_ws + WS_CTL, 0, CTL_ZERO_BYTES, stream);
    Params p{};
    for (int i = 0; i < N_IN; ++i) p.in[i] = (const float*)d_in[i];
    p.out = (float*)d_out; p.ws = (unsigned char*)d_ws;
    void* args[] = {&p};
    hipError_t e = hipLaunchCooperativeKernel((const void*)mega, dim3(grid), dim3(NTHREADS), args, LDS_BYTES, stream);
    if (e != hipSuccess) fprintf(stderr, "cooperative launch failed: %s (grid %d)\n", hipGetErrorString(e), grid);
}
```

```cpp
#include <hip/hip_runtime.h>
#include <hip/hip_cooperative_groups.h>
#include <stdint.h>
#include <stdio.h>
namespace cg = cooperative_groups;

#ifndef PROBE_PH
#define PROBE_PH -1
#endif
#ifndef PROBE_SYNC
#define PROBE_SYNC 0
#endif
#ifndef MK_SINGLE
#define MK_SINGLE 0
#endif

#define LAS __attribute__((address_space(3)))
typedef unsigned short bf16_t;
typedef short bf16x8 __attribute__((ext_vector_type(8)));
typedef short s16x4 __attribute__((ext_vector_type(4)));
typedef float f32x4 __attribute__((ext_vector_type(4)));
typedef float f32x2 __attribute__((ext_vector_type(2)));
typedef float f32x16 __attribute__((ext_vector_type(16)));
typedef unsigned u32x4 __attribute__((ext_vector_type(4)));
typedef unsigned u32x2 __attribute__((ext_vector_type(2)));
typedef __bf16 bf16x2_t __attribute__((ext_vector_type(2)));
typedef _Float16 f16x2_t __attribute__((ext_vector_type(2)));
#define DI __device__ __forceinline__
DI unsigned pkh2(float lo, float hi) { f16x2_t v = {(_Float16)lo, (_Float16)hi}; return __builtin_bit_cast(unsigned, v); }
#define MFMA32(a, b, c) __builtin_amdgcn_mfma_f32_32x32x16_bf16((a), (b), (c), 0, 0, 0)

constexpr int D = 1024, NB = 8, SEQ = 4096, NCTX = 256, DEPTH = 2;
constexpr int TL = NB * SEQ, TC = NB * NCTX, T = TL + TC;
constexpr int INW = 4608, NMOD = 6 * D, PW = 1600, PN = 1536;
constexpr int VTS = SEQ + 64;
constexpr int QOFF = 0, KOFF = 512, VOFF = 640, POOLOFF = 768, SUOFF = 1024, SVOFF = 1280, GATEOFF = 1536;
constexpr int NEXP = 16384;
constexpr float EPS = 1e-6f;
constexpr float LOG2E = 1.4426950408889634f;
constexpr float QSCALE = 0.125f * LOG2E;

constexpr size_t MiB = 1u << 20;
constexpr size_t WS_CTL = 0, WS_MOD = 1 * MiB, CTL_ZERO_BYTES = 2 * MiB;
constexpr size_t WS_ROPE = 2 * MiB, WS_SGUW = 2 * MiB + 65536, WS_TSCALE = 3 * MiB;
constexpr size_t WS_WIN = 4 * MiB, WS_WBR = 22 * MiB, WS_WOUT = 26 * MiB, WS_WFOLD = 30 * MiB;
constexpr size_t WS_XCTX = 38 * MiB, WS_UTAB = 46 * MiB, WS_VTAB = 78 * MiB;
constexpr size_t WS_IDX = 110 * MiB, WS_GW = 120 * MiB;
constexpr size_t WS_H = 142 * MiB;
constexpr size_t WS_P = 210 * MiB, WS_Y = 318 * MiB, WS_MERGED = 386 * MiB, WS_VT = 454 * MiB, WS_VTC = 463 * MiB, WS_VST = 464 * MiB;
constexpr size_t WS_ST = 210 * MiB, WS_H8 = 346 * MiB, WS_HS = 380 * MiB, WS_SU = 482 * MiB;
constexpr size_t WS_END = 512 * MiB;
static_assert(WS_ST + (size_t)2048 * T * 2 <= WS_H8 && WS_H8 + (size_t)T * D <= WS_HS, "ST / H8 fit");
static_assert(WS_VST + (size_t)272 * 256 * 128 * 2 <= WS_SU && WS_VT + (size_t)NB * 2 * 64 * VTS * 2 <= WS_VTC, "VsT / VT fit");
static_assert(WS_H + (size_t)T * D * 2 <= WS_P, "H fits");
static_assert(WS_P + (size_t)T * PW * 2 <= WS_Y && WS_Y + (size_t)T * D * 2 <= WS_MERGED && WS_MERGED + (size_t)T * D * 2 <= WS_VT, "P/Y/MERGED fit");
static_assert(WS_IDX + (size_t)T * 128 * 2 <= WS_GW && WS_GW + (size_t)T * 128 * 4 <= WS_H && WS_SU + (size_t)T * 128 * 4 <= WS_END && WS_HS + (size_t)T * 4 <= WS_SU, "idx/gw/su fit");

constexpr int LDS_BYTES = 147456;
constexpr int NTHREADS = 512, NWAVES = 8;

enum { I_x, I_c, I_ctx, I_c_ctx, I_w_mod, I_b_mod, I_g_mix, I_g_ffn, I_w_in, I_attn_sink, I_pool_w, I_pool_scale, I_sgu_w, I_sgu_b, I_w_br_attn, I_w_br_pool, I_w_br_sgu, I_w_out, I_peer_wq, I_peer_subkeys, I_peer_u, I_peer_v, I_g_final, N_IN };
struct Params {
    const float* in[N_IN];
    float* out; unsigned char* ws;
    int ph_lo, ph_hi;
};

DI unsigned f2bf(float f) { unsigned u = __builtin_bit_cast(unsigned, f); return (u + 0x7fffu + ((u >> 16) & 1u)) >> 16; }
DI unsigned pk2(float lo, float hi) { return f2bf(lo) | (f2bf(hi) << 16); }
DI float bf2f(unsigned short u) { return __builtin_bit_cast(float, (unsigned)u << 16); }
DI float bflo(unsigned w) { return __builtin_bit_cast(float, w << 16); }
DI float bfhi(unsigned w) { return __builtin_bit_cast(float, w & 0xffff0000u); }
DI int crow(int reg, int h) { return (reg & 3) + 8 * (reg >> 2) + 4 * h; }
DI float wave_sum(float v) {
#pragma unroll
    for (int o = 1; o < 64; o <<= 1) v += __shfl_xor(v, o);
    return v;
}
DI float sigmoidf_(float x) { return 1.0f / (1.0f + __expf(-x)); }
DI float gelu_tanh(float x) { const float u = 0.7978845608028654f * (x + 0.044715f * x * x * x); return x / (1.0f + __expf(-2.0f * u)); }
DI float silu_(float x) { return x / (1.0f + __expf(-x)); }

struct Frame {
    int tid, lane, wave, gw, ngw, gtid, ngt, bid, nb;
    LAS unsigned char* lds;
};

template <int NM, int NN>
DI void wave_gemm(const bf16_t* __restrict__ A, int lda, const bf16_t* __restrict__ Bt, int ldb, int K, int m0, int n0, f32x16 (&acc)[NM][NN], int lane) {
    const int r = lane & 31, h = lane >> 5;
    const bf16_t* ap = A + (size_t)(m0 + r) * lda + 8 * h;
    const bf16_t* bp = Bt + (size_t)(n0 + r) * ldb + 8 * h;
    for (int k0 = 0; k0 < K; k0 += 64) {
        bf16x8 a[4][NM], b[4][NN];
#pragma unroll
        for (int s = 0; s < 4; ++s) {
#pragma unroll
            for (int i = 0; i < NM; ++i) a[s][i] = *(const bf16x8*)(ap + (size_t)(32 * i) * lda + k0 + 16 * s);
#pragma unroll
            for (int j = 0; j < NN; ++j) b[s][j] = *(const bf16x8*)(bp + (size_t)(32 * j) * ldb + k0 + 16 * s);
        }
#pragma unroll
        for (int s = 0; s < 4; ++s)
#pragma unroll
            for (int i = 0; i < NM; ++i)
#pragma unroll
                for (int j = 0; j < NN; ++j) acc[i][j] = MFMA32(a[s][i], b[s][j], acc[i][j]);
    }
}
template <int NM, int NN> DI void zero_acc(f32x16 (&acc)[NM][NN]) {
#pragma unroll
    for (int i = 0; i < NM; ++i)
#pragma unroll
        for (int j = 0; j < NN; ++j)
#pragma unroll
            for (int r = 0; r < 16; ++r) acc[i][j][r] = 0.f;
}

namespace pg8 {
constexpr int BM = 256, BK = 64, HALF = 128, HTB = HALF * BK * 2, STAGE_BYTES = 8 * HTB, NXCD = 8, WGM = 8, LD = 1024;
DI int lds_byte(int r, int c) { const int st = (r >> 4) * 2 + (c >> 5), rr = r & 15, cc = c & 31, ob = rr * 64 + cc * 2; return st * 1024 + (ob ^ (((ob >> 9) & 1) << 5)); }
DI void stage_rc(int b, int& R, int& C) { const int st = b / 1024, sb = b % 1024, swz = sb ^ (((sb >> 9) & 1) << 5); R = (st >> 1) * 16 + swz / 64; C = (st & 1) * 32 + (swz % 64) / 2; }
DI int perm32(int rho) { const int n = rho >> 4, i = rho & 15; return 8 * (i >> 2) + 4 * n + (i & 3); }
struct Unit { int pm, pn, sub, nt; const char* a; const char* b; };
DI void tile_of(int L, int nM, int nN, int& pm, int& pn) {
    const int nwg = nM * nN; int wgid = L;
    { const int q = nwg / NXCD, r = nwg % NXCD, xcd = wgid % NXCD, off = wgid / NXCD; wgid = (xcd < r ? xcd * (q + 1) : r * (q + 1) + (xcd - r) * q) + off; }
    const int nig = WGM * nN, gid = wgid / nig, fm = gid * WGM, gsz = (nM - fm) < WGM ? (nM - fm) : WGM;
    pm = fm + ((wgid % nig) % gsz); pn = (wgid % nig) / gsz;
}
template <class Epi, class Sched>
DI void gemm_phase(LAS unsigned char* lds, const int tid, const Sched& S, const Epi& E) {
    const int wid = __builtin_amdgcn_readfirstlane(tid >> 6), lane = tid & 63, wr = wid >> 2, wc = wid & 3, fr = lane & 15, fq = lane >> 4;
    unsigned voffA[2], voffB[2];
#pragma unroll
    for (int i = 0; i < 2; ++i) { int R, C; stage_rc(tid * 16 + i * 8192, R, C); const int Rb = Epi::PERM ? ((R & ~31) + perm32(R & 31)) : R;
        voffA[i] = (unsigned)(R * LD + C) * 2u; voffB[i] = (unsigned)(Rb * LD + C) * 2u; }
    const size_t kstep = (size_t)(BK * 2);
    const size_t hstep = (size_t)HALF * LD * 2;
    const unsigned ldsw = (unsigned)wid * 1024u;
    const int aoff = lds_byte(wr * 64 + fr, fq * 8), boff = lds_byte(wc * 32 + fr, fq * 8);
#define PG8_SA(b, h) (((b) * 2 + (h)) * HTB)
#define PG8_SB(b, h) ((4 + (b) * 2 + (h)) * HTB)
#define PG8_STAGE(bufoff, gbase, voff) do { _Pragma("unroll") for (int _i = 0; _i < 2; ++_i) \
        __builtin_amdgcn_global_load_lds((const unsigned*)((const char*)(gbase) + (voff)[_i]), (LAS unsigned*)(lds + (bufoff) + ldsw + _i * 8192), 16, 0, 0); } while (0)
#define PG8_LDA(dst, b, h) do { _Pragma("unroll") for (int m = 0; m < 4; ++m) _Pragma("unroll") for (int k = 0; k < 2; ++k) dst[m][k] = *(const LAS bf16x8*)(lds + PG8_SA(b, h) + aoff + m * 2048 + k * 1024); } while (0)
#define PG8_LDB(dst, b, h) do { _Pragma("unroll") for (int n = 0; n < 2; ++n) _Pragma("unroll") for (int k = 0; k < 2; ++k) dst[n][k] = *(const LAS bf16x8*)(lds + PG8_SB(b, h) + boff + n * 2048 + k * 1024); } while (0)
#define PG8_MMA(ai, bj, At, Bt) do { __builtin_amdgcn_s_setprio(1); _Pragma("unroll") for (int m = 0; m < 4; ++m) _Pragma("unroll") for (int n = 0; n < 2; ++n) _Pragma("unroll") for (int k = 0; k < 2; ++k) \
        acc[ai][bj][m][n] = __builtin_amdgcn_mfma_f32_16x16x32_bf16(Bt[n][k], At[m][k], acc[ai][bj][m][n], 0, 0, 0); __builtin_amdgcn_s_setprio(0); } while (0)
#define PG8_WAIT_V(n) asm volatile("s_waitcnt vmcnt(" #n ")" ::: "memory")
#define PG8_WAIT_L(n) asm volatile("s_waitcnt lgkmcnt(" #n ")" ::: "memory")
#define PG8_BAR __builtin_amdgcn_s_barrier()
#define PG8_SCHED __builtin_amdgcn_sched_barrier(0)
    Unit cur, nxt; int ui = 0;
    if (!S.next(0, cur)) return;
    f32x4 acc[2][2][4][2];
#pragma unroll
    for (int a = 0; a < 2; ++a)
#pragma unroll
        for (int b = 0; b < 2; ++b)
#pragma unroll
            for (int m = 0; m < 4; ++m)
#pragma unroll
                for (int n = 0; n < 2; ++n) acc[a][b][m][n] = (f32x4){0.f, 0.f, 0.f, 0.f};
    bf16x8 At[4][2], B0[2][2], B1[2][2];
    const char* cA = cur.a; const char* cB = cur.b;
    PG8_STAGE(PG8_SB(0, 0), cB, voffB); PG8_STAGE(PG8_SB(0, 1), cB + hstep, voffB); PG8_STAGE(PG8_SA(0, 0), cA, voffA); PG8_STAGE(PG8_SA(0, 1), cA + hstep, voffA);
    if (wr == 1) PG8_BAR;
    PG8_WAIT_V(2); PG8_BAR;
    PG8_STAGE(PG8_SB(1, 0), cB + kstep, voffB); PG8_STAGE(PG8_SA(1, 0), cA + kstep, voffA); PG8_STAGE(PG8_SB(1, 1), cB + hstep + kstep, voffB);
    PG8_WAIT_V(6); PG8_BAR;
    for (;;) {
        const bool has_next = S.next(ui + 1, nxt);
        const char* nA = has_next ? nxt.a : cA; const char* nB = has_next ? nxt.b : cB;
        const int nt = cur.nt;
        for (int t = 0; t < nt; t += 2) {
            const bool last = (t == nt - 2);
            const char* a1 = cA + (size_t)(t + 1) * kstep;
            const char* a2 = last ? nA : cA + (size_t)(t + 2) * kstep; const char* b2 = last ? nB : cB + (size_t)(t + 2) * kstep;
            const char* a3 = a2 + kstep; const char* b3 = b2 + kstep;
            PG8_LDB(B0, 0, 0); PG8_LDB(B1, 0, 1); PG8_SCHED; PG8_LDA(At, 0, 0); PG8_STAGE(PG8_SA(1, 1), a1 + hstep, voffA);
            PG8_WAIT_V(8); PG8_WAIT_L(0); PG8_BAR; PG8_MMA(0, 0, At, B0); PG8_MMA(0, 1, At, B1); PG8_BAR; PG8_SCHED;
            PG8_LDA(At, 0, 1); PG8_STAGE(PG8_SB(0, 0), b2, voffB); PG8_STAGE(PG8_SB(0, 1), b2 + hstep, voffB); PG8_STAGE(PG8_SA(0, 0), a2, voffA);
            PG8_WAIT_V(8); PG8_WAIT_L(0); PG8_BAR; PG8_MMA(1, 0, At, B0); PG8_MMA(1, 1, At, B1); PG8_BAR; PG8_SCHED;
            PG8_LDB(B0, 1, 0); PG8_LDB(B1, 1, 1); PG8_SCHED; PG8_LDA(At, 1, 0); PG8_STAGE(PG8_SA(0, 1), a2 + hstep, voffA);
            PG8_WAIT_V(8); PG8_WAIT_L(0); PG8_BAR; PG8_MMA(0, 0, At, B0); PG8_MMA(0, 1, At, B1); PG8_BAR; PG8_SCHED;
            PG8_LDA(At, 1, 1); PG8_STAGE(PG8_SB(1, 0), b3, voffB); PG8_STAGE(PG8_SB(1, 1), b3 + hstep, voffB); PG8_STAGE(PG8_SA(1, 0), a3, voffA);
            PG8_WAIT_V(8); PG8_WAIT_L(0); PG8_BAR; PG8_MMA(1, 0, At, B0); PG8_MMA(1, 1, At, B1); PG8_BAR; PG8_SCHED;
        }
        if (wr == 0) PG8_BAR;
        E(acc, cur, wr, wc, fr, fq);
        if (!has_next) break;
#pragma unroll
        for (int a = 0; a < 2; ++a)
#pragma unroll
            for (int b = 0; b < 2; ++b)
#pragma unroll
                for (int m = 0; m < 4; ++m)
#pragma unroll
                    for (int n = 0; n < 2; ++n) acc[a][b][m][n] = (f32x4){0.f, 0.f, 0.f, 0.f};
        cur = nxt; cA = nA; cB = nB; ++ui;
        if (wr == 1) PG8_BAR;
    }
    PG8_WAIT_V(0);
    PG8_BAR;
#undef PG8_SA
#undef PG8_SB
#undef PG8_STAGE
#undef PG8_LDA
#undef PG8_LDB
#undef PG8_MMA
#undef PG8_WAIT_V
#undef PG8_WAIT_L
#undef PG8_BAR
#undef PG8_SCHED
}
}

DI void transpose_item(const float* W, int K, int N, bf16_t* WT, int ldd, int row_off, int col_off, LAS float* scr, int item, int lane) {
    const int nblk = N / 32, kb = item / nblk, nb = item % nblk, k0 = 64 * kb, n0 = 32 * nb;
#pragma unroll 8
    for (int i = 0; i < 32; ++i) { const int kk = 2 * i + (lane >> 5); scr[kk * 33 + (lane & 31)] = W[(size_t)(k0 + kk) * N + n0 + (lane & 31)]; }
    asm volatile("s_waitcnt lgkmcnt(0)" ::: "memory");
    const int c = lane & 7;
#pragma unroll
    for (int j = 0; j < 4; ++j) { const int n = (lane >> 3) + 8 * j; const LAS float* s = scr + (8 * c) * 33 + n;
        u32x4 o; o.x = pk2(s[0 * 33], s[1 * 33]); o.y = pk2(s[2 * 33], s[3 * 33]); o.z = pk2(s[4 * 33], s[5 * 33]); o.w = pk2(s[6 * 33], s[7 * 33]);
        *(u32x4*)(WT + (size_t)(row_off + n0 + n) * ldd + col_off + k0 + 8 * c) = o; }
    asm volatile("s_waitcnt lgkmcnt(0)" ::: "memory");
}

DI void convert_tables(const Params& p, const Frame& F) {
    for (int it = F.gw; it < 4 * NEXP; it += F.ngw) {
        const int e = it & (NEXP - 1), tbl = (it >> 14) & 1, l = it >> 15;
        const f32x4* src = (const f32x4*)((tbl ? p.in[I_peer_v] : p.in[I_peer_u]) + ((size_t)l * NEXP + e) * D) + 4 * F.lane;
        f32x4 v[4]; float am = 0.f;
#pragma unroll
        for (int j = 0; j < 4; ++j) { v[j] = src[j]; am = fmaxf(am, fmaxf(fmaxf(fabsf(v[j].x), fabsf(v[j].y)), fmaxf(fabsf(v[j].z), fabsf(v[j].w)))); }
#pragma unroll
        for (int o = 1; o < 64; o <<= 1) am = fmaxf(am, __shfl_xor(am, o));
        const float sc = (am > 0.f) ? exp2f(floorf(log2f(224.0f / am))) : 1.0f;
        u32x4 q;
#pragma unroll
        for (int j = 0; j < 4; ++j) { int w = 0; w = __builtin_amdgcn_cvt_pk_fp8_f32(v[j].x * sc, v[j].y * sc, w, false); w = __builtin_amdgcn_cvt_pk_fp8_f32(v[j].z * sc, v[j].w * sc, w, true); q[j] = (unsigned)w; }
        *(u32x4*)(p.ws + (tbl ? WS_VTAB : WS_UTAB) + ((size_t)l * NEXP + e) * D + 16 * F.lane) = q;
        if (F.lane == 0) ((float*)(p.ws + WS_TSCALE))[(l * 2 + tbl) * NEXP + e] = 1.0f / sc;
    }
}

DI void phase_prep(const Params& p, const Frame& F) {
    unsigned char* ws = p.ws;
    {
        LAS float* wq = (LAS float*)F.lds;
        for (int it = F.bid; it < 2 * 16 * 16; it += F.nb) {
            const int cc = it & 15, hp = (it >> 4) & 15, l = it >> 8;
            const float* src = p.in[I_peer_wq] + (size_t)l * D * 2048 + hp * 128;
            __syncthreads();
            for (int e = F.tid; e < 64 * 128; e += NTHREADS) { const int ci = e >> 7, d = e & 127; wq[d * 65 + ci] = src[(size_t)(cc * 64 + ci) * 2048 + d]; }
            __syncthreads();
            const int ci = F.tid & 63, kg = F.tid >> 6;
            const float* sk = p.in[I_peer_subkeys] + ((size_t)(l * 16 + hp) * 128 + 16 * kg) * 128;
            float acc[16];
#pragma unroll
            for (int k = 0; k < 16; ++k) acc[k] = 0.f;
            for (int d = 0; d < 128; ++d) { const float w = wq[d * 65 + ci];
#pragma unroll
                for (int k = 0; k < 16; ++k) acc[k] += w * sk[k * 128 + d]; }
            bf16_t* dst = (bf16_t*)(ws + WS_WFOLD) + ((size_t)l * 2048 + hp * 128 + 16 * kg) * D + cc * 64 + ci;
#pragma unroll
            for (int k = 0; k < 16; ++k) dst[(size_t)k * D] = (bf16_t)f2bf(acc[k]);
        }
        __syncthreads();
    }
    {
        LAS float* scr = (LAS float*)(F.lds + F.wave * 16384);
        constexpr int I_IN = (D / 64) * (INW / 32), I_BA = (512 / 64) * (D / 32), I_BS = (256 / 64) * (D / 32), I_O = (D / 64) * (D / 32);
        constexpr int PER_L = I_IN + I_BA + I_BS + I_O;
        for (int it = F.gw; it < 2 * PER_L; it += F.ngw) {
            const int l = it / PER_L; int r = it % PER_L;
            if (r < I_IN) { transpose_item(p.in[I_w_in] + (size_t)l * D * INW, D, INW, (bf16_t*)(ws + WS_WIN) + (size_t)l * INW * D, D, 0, 0, scr, r, F.lane); continue; } r -= I_IN;
            if (r < I_BA) { transpose_item(p.in[I_w_br_attn] + (size_t)l * 512 * D, 512, D, (bf16_t*)(ws + WS_WBR) + (size_t)l * D * D, D, 0, 0, scr, r, F.lane); continue; } r -= I_BA;
            if (r < I_BS) { transpose_item(p.in[I_w_br_sgu] + (size_t)l * 256 * D, 256, D, (bf16_t*)(ws + WS_WBR) + (size_t)l * D * D, D, 0, 768, scr, r, F.lane); continue; } r -= I_BS;
            transpose_item(p.in[I_w_out] + (size_t)l * D * D, D, D, (bf16_t*)(ws + WS_WOUT) + (size_t)l * D * D, D, 0, 0, scr, r, F.lane);
        }
    }
    for (int i = F.gtid; i < 2 * 256 * D; i += F.ngt) {
        const int n = i & 1023, rc = (i >> 10) & 255, l = i >> 18, g = rc >> 6;
        const float* pw = p.in[I_pool_w] + ((size_t)l * 256 + rc) * 64;
        const float* ps = p.in[I_pool_scale] + l * 256 + 64 * g;
        const float* wb = p.in[I_w_br_pool] + ((size_t)l * 256 + 64 * g) * D + n;
        float a = 0.f;
        for (int e = 0; e < 64; ++e) a += pw[e] * ps[e] * wb[(size_t)e * D];
        ((bf16_t*)(ws + WS_WBR))[(size_t)l * D * D + (size_t)n * D + 512 + rc] = (bf16_t)f2bf(a);
    }
    for (int i = F.gtid; i < 2 * 4 * 128 * 128; i += F.ngt) ((bf16_t*)(ws + WS_SGUW))[i] = (bf16_t)f2bf(p.in[I_sgu_w][i]);
    for (int i = F.gtid; i < 64 * 16; i += F.ngt) {
        const int pos = i >> 4, fi = i & 15;
        const float inv = powf(10000.0f, -(float)fi / 16.0f);
        const float ang = (float)pos * inv;
        ((f32x2*)(ws + WS_ROPE))[i] = (f32x2){cosf(ang), sinf(ang)};
    }
    convert_tables(p, F);
    {
        float* MOD = (float*)(ws + WS_MOD);
        LAS float* scd = (LAS float*)F.lds;
        LAS float* red = scd + 9 * D;
        __syncthreads();
        for (int e = F.tid; e < 9 * D; e += NTHREADS) { const int r = e >> 10, k = e & 1023; scd[e] = silu_((r < 8) ? p.in[I_c][r * D + k] : p.in[I_c_ctx][k]); }
        __syncthreads();
        for (int it = F.bid; it < 2 * 96; it += F.nb) {
            const int cgp = it % 96, l = it / 96, col = cgp * 64 + F.lane;
            float acc[9];
#pragma unroll
            for (int r = 0; r < 9; ++r) acc[r] = 0.f;
            const float* wp = p.in[I_w_mod] + ((size_t)l * D + F.wave * 128) * NMOD + col;
#pragma unroll 4
            for (int k = 0; k < 128; ++k) {
                const float w = wp[(size_t)k * NMOD];
#pragma unroll
                for (int r = 0; r < 9; ++r) acc[r] += scd[r * D + F.wave * 128 + k] * w;
            }
#pragma unroll
            for (int r = 0; r < 9; ++r) red[(F.wave * 9 + r) * 64 + F.lane] = acc[r];
            __syncthreads();
            for (int e = F.tid; e < 9 * 64; e += NTHREADS) {
                const int r = e >> 6, ln = e & 63; float s = p.in[I_b_mod][l * NMOD + cgp * 64 + ln];
#pragma unroll
                for (int w = 0; w < 8; ++w) s += red[(w * 9 + r) * 64 + ln];
                MOD[((size_t)l * 9 + r) * NMOD + cgp * 64 + ln] = s;
            }
            __syncthreads();
        }
    }
}

DI const float* mod_vec(const Params& p, int l, int row, int j) {
    const int r = row < TL ? row / SEQ : 8;
    return (const float*)(p.ws + WS_MOD) + ((size_t)l * 9 + r) * NMOD + j * D;
}
DI float* xrow_ptr(const Params& p, int row) { return row < TL ? p.out + (size_t)row * D : (float*)(p.ws + WS_XCTX) + (size_t)(row - TL) * D; }
DI const float* xin_ptr(const Params& p, int row) { return row < TL ? p.in[I_x] + (size_t)row * D : p.in[I_ctx] + (size_t)(row - TL) * D; }

DI void modulate_row_wave(const float* src, const float* g, const float* sh, const float* sc, bf16_t* dst, int lane, unsigned char* h8 = nullptr, float* hs = nullptr) {
    f32x4 v[4]; float ss = 0.f;
#pragma unroll
    for (int j = 0; j < 4; ++j) { v[j] = ((const f32x4*)src)[lane + 64 * j]; ss += v[j].x * v[j].x + v[j].y * v[j].y + v[j].z * v[j].z + v[j].w * v[j].w; }
    const float rinv = rsqrtf(wave_sum(ss) * (1.0f / D) + EPS);
    float am = 0.f;
#pragma unroll
    for (int j = 0; j < 4; ++j) {
        const f32x4 gg = ((const f32x4*)g)[lane + 64 * j], s1 = ((const f32x4*)sh)[lane + 64 * j], s2 = ((const f32x4*)sc)[lane + 64 * j];
        const f32x4 o = v[j] * rinv * gg * (s2 + 1.0f) + s1;
        u32x2 w; w.x = pk2(o.x, o.y); w.y = pk2(o.z, o.w);
        ((u32x2*)dst)[lane + 64 * j] = w;
        v[j] = o; am = fmaxf(am, fmaxf(fmaxf(fabsf(o.x), fabsf(o.y)), fmaxf(fabsf(o.z), fabsf(o.w))));
    }
    if (h8) {
#pragma unroll
        for (int o = 1; o < 64; o <<= 1) am = fmaxf(am, __shfl_xor(am, o));
        const float scl = (am > 0.f) ? exp2f(floorf(log2f(224.0f / am))) : 1.0f;
#pragma unroll
        for (int j = 0; j < 4; ++j) { int w = 0; w = __builtin_amdgcn_cvt_pk_fp8_f32(v[j].x * scl, v[j].y * scl, w, false); w = __builtin_amdgcn_cvt_pk_fp8_f32(v[j].z * scl, v[j].w * scl, w, true);
            ((unsigned*)h8)[lane + 64 * j] = (unsigned)w; }
        if (lane == 0) *hs = 1.0f / scl;
    }
}

DI void phase_norm(const Params& p, const Frame& F, int l, int which  , bool from_input, int nrows) {
    const float* g = (which == 0 ? p.in[I_g_mix] : p.in[I_g_ffn]) + l * D;
    for (int row = F.gw; row < nrows; row += F.ngw) {
        const float* src = from_input ? xin_ptr(p, row) : xrow_ptr(p, row);
        modulate_row_wave(src, g, mod_vec(p, l, row, which * 3 + 0), mod_vec(p, l, row, which * 3 + 1), (bf16_t*)(p.ws + WS_H) + (size_t)row * D, F.lane,
                          which ? p.ws + WS_H8 + (size_t)row * D : nullptr, which ? (float*)(p.ws + WS_HS) + row : nullptr);
    }
}
DI void phase_final(const Params& p, const Frame& F) {
    for (int row = F.gw; row < TL; row += F.ngw) {
        f32x4* xr = (f32x4*)(p.out + (size_t)row * D);
        f32x4 v[4]; float ss = 0.f;
#pragma unroll
        for (int j = 0; j < 4; ++j) { v[j] = xr[F.lane + 64 * j]; ss += v[j].x * v[j].x + v[j].y * v[j].y + v[j].z * v[j].z + v[j].w * v[j].w; }
        const float rinv = rsqrtf(wave_sum(ss) * (1.0f / D) + EPS);
#pragma unroll
        for (int j = 0; j < 4; ++j) xr[F.lane + 64 * j] = v[j] * rinv * ((const f32x4*)p.in[I_g_final])[F.lane + 64 * j];
    }
}

DI void g1_epilogue(const Params& p, int l, const f32x16& acc, int row0, int col0, int lane) {
    const int h = lane >> 5, w = lane & 31, col = col0 + w;
    bf16_t* P = (bf16_t*)(p.ws + WS_P);
    if (col0 < VOFF) {
        const float sc = (col0 < KOFF) ? QSCALE : 1.0f;
        const int axis = (col0 >> 5) & 1, fi = w & 15;
        const f32x2* tab = (const f32x2*)(p.ws + WS_ROPE);
#pragma unroll
        for (int r = 0; r < 16; ++r) {
            const int row = row0 + crow(r, h);
            const float own = acc[r], oth = __shfl_xor(own, 16);
            float o = own;
            if (row < TL) {
                const int t = row & (SEQ - 1), pos = axis ? (t & 63) : (t >> 6);
                const f32x2 cs = tab[pos * 16 + fi];
                o = (w < 16) ? (own * cs.x - oth * cs.y) : (own * cs.x + oth * cs.y);
            }
            P[(size_t)row * PW + col] = (bf16_t)f2bf(o * sc);
        }
    } else if (col0 < POOLOFF) {
        const int hk = (col - VOFF) >> 6, d = (col - VOFF) & 63;
#pragma unroll
        for (int r = 0; r < 16; ++r) {
            const int row = row0 + crow(r, h);
            const bf16_t v = (bf16_t)f2bf(acc[r]);
            if (row < TL) { const int b = row / SEQ, t = row & (SEQ - 1); ((bf16_t*)(p.ws + WS_VT))[((size_t)(b * 2 + hk) * 64 + d) * VTS + t] = v; }
            else { const int rc = row - TL, b = rc / NCTX, j = rc & (NCTX - 1); ((bf16_t*)(p.ws + WS_VTC))[((size_t)(b * 2 + hk) * 64 + d) * NCTX + j] = v; }
        }
    } else if (col0 < SUOFF) {
#pragma unroll
        for (int r = 0; r < 16; ++r) { const int row = row0 + crow(r, h); P[(size_t)row * PW + col] = (bf16_t)f2bf(acc[r]); }
    } else if (col0 < SVOFF) {
#pragma unroll
        for (int r = 0; r < 16; ++r) { const int row = row0 + crow(r, h); P[(size_t)row * PW + col] = (bf16_t)f2bf(gelu_tanh(acc[r])); }
    } else {
        const int c = col - SVOFF;
#pragma unroll
        for (int r = 0; r < 16; ++r) { const int row = row0 + crow(r, h); const int chunk = row >> 7, q = row & 127;
            ((bf16_t*)(p.ws + WS_VST))[((size_t)chunk * 256 + c) * 128 + q] = (bf16_t)f2bf(gelu_tanh(acc[r])); }
    }
}

DI void g1_simple(const Params& p, const Frame& F, int l, int row_lo, int nrows, int ct_lo, int nct) {
    const bf16_t* H = (const bf16_t*)(p.ws + WS_H);
    const bf16_t* W = (const bf16_t*)(p.ws + WS_WIN) + (size_t)l * INW * D;
    const int nit = (nrows / 64) * nct;
    for (int it = F.gw; it < nit; it += F.ngw) {
        const int mt = it / nct, nt = ct_lo + it % nct, m0 = row_lo + mt * 64;
        f32x16 acc[2][1]; zero_acc(acc);
        wave_gemm<2, 1>(H, D, W, D, D, m0, nt * 32, acc, F.lane);
#pragma unroll 1
        for (int i = 0; i < 2; ++i) g1_epilogue(p, l, i == 0 ? acc[0][0] : acc[1][0], m0 + 32 * i, nt * 32, F.lane);
    }
}

struct EpiG1 {
    static constexpr bool PERM = true;
    unsigned char* ws;
    DI void operator()(const f32x4 (&acc)[2][2][4][2], const pg8::Unit& u, int wr, int wc, int fr, int fq) const {
        bf16_t* P = (bf16_t*)(ws + WS_P);
        const int rbase = u.pm * 256 + wr * 64 + fr;
#pragma unroll
        for (int ai = 0; ai < 2; ++ai)
#pragma unroll
            for (int m = 0; m < 4; ++m) {
                const int row = rbase + 128 * ai + 16 * m;
#pragma unroll
                for (int bj = 0; bj < 2; ++bj) {
                    const int c0 = u.pn * 256 + 128 * bj + 32 * wc + 8 * fq;
                    float v[8];
#pragma unroll
                    for (int j = 0; j < 4; ++j) { v[j] = acc[ai][bj][m][0][j]; v[4 + j] = acc[ai][bj][m][1][j]; }
                    if (c0 < VOFF) {
                        const float sc = (c0 < KOFF) ? QSCALE : 1.0f;
                        const int t = row & (SEQ - 1), pos = (wc & 1) ? (t & 63) : (t >> 6);
                        const f32x4* tab = (const f32x4*)(ws + WS_ROPE) + (pos * 16 + 8 * (fq & 1)) / 2;
                        u32x4 o;
#pragma unroll
                        for (int j2 = 0; j2 < 4; ++j2) {
                            const f32x4 cs = tab[j2];
                            const float o0 = __shfl_xor(v[2 * j2], 32), o1 = __shfl_xor(v[2 * j2 + 1], 32);
                            const float r0 = (fq < 2) ? (v[2 * j2] * cs.x - o0 * cs.y) : (v[2 * j2] * cs.x + o0 * cs.y);
                            const float r1 = (fq < 2) ? (v[2 * j2 + 1] * cs.z - o1 * cs.w) : (v[2 * j2 + 1] * cs.z + o1 * cs.w);
                            o[j2] = pk2(r0 * sc, r1 * sc);
                        }
                        *(u32x4*)(P + (size_t)row * PW + c0) = o;
                    } else if (c0 < POOLOFF) {
                        const int hk = wc >> 1, d0 = 32 * (wc & 1) + 8 * fq, b = row / SEQ, t = row & (SEQ - 1);
                        bf16_t* vt = (bf16_t*)(ws + WS_VT) + ((size_t)(b * 2 + hk) * 64 + d0) * VTS + t;
#pragma unroll
                        for (int j = 0; j < 8; ++j) vt[(size_t)j * VTS] = (bf16_t)f2bf(v[j]);
                    } else if (c0 < SUOFF) {
                        u32x4 o;
#pragma unroll
                        for (int j2 = 0; j2 < 4; ++j2) o[j2] = pk2(v[2 * j2], v[2 * j2 + 1]);
                        *(u32x4*)(P + (size_t)row * PW + c0) = o;
                    } else if (c0 < SVOFF) {
                        u32x4 o;
#pragma unroll
                        for (int j2 = 0; j2 < 4; ++j2) o[j2] = pk2(gelu_tanh(v[2 * j2]), gelu_tanh(v[2 * j2 + 1]));
                        *(u32x4*)(P + (size_t)row * PW + c0) = o;
                    } else {
                        const int c = c0 - SVOFF, chunk = row >> 7, q = row & 127;
                        bf16_t* vs = (bf16_t*)(ws + WS_VST) + ((size_t)chunk * 256 + c) * 128 + q;
#pragma unroll
                        for (int j = 0; j < 8; ++j) vs[j * 128] = (bf16_t)f2bf(gelu_tanh(v[j]));
                    }
                }
                asm volatile("" ::: "memory");
            }
    }
};
struct SchedGrid {
    int nM, nN, G, c; const char* A; const char* B;
    DI bool next(int i, pg8::Unit& u) const {
        const int L = i * G + c; if (L >= nM * nN) return false;
        pg8::tile_of(L, nM, nN, u.pm, u.pn); u.sub = 0; u.nt = D / 64;
        u.a = A + (size_t)u.pm * 256 * D * 2; u.b = B + (size_t)u.pn * 256 * D * 2; return true;
    }
};

DI void phase_g1(const Params& p, const Frame& F, int l) {
    SchedGrid S{TL / 256, PN / 256, F.nb, F.bid, (const char*)(p.ws + WS_H), (const char*)(p.ws + WS_WIN) + (size_t)l * INW * D * 2};
    EpiG1 E{p.ws};
    pg8::gemm_phase(F.lds, F.tid, S, E);
    if (l == 0) g1_simple(p, F, l, TL, TC, 0, PN / 32);
    else g1_simple(p, F, l, TL, TC, 16, 8);
}

DI bf16x8 pack8(const f32x16& x, int s) {
    u32x4 pk;
#pragma unroll
    for (int j = 0; j < 4; ++j) { f32x2 v = {x[8 * s + 2 * j], x[8 * s + 2 * j + 1]}; pk[j] = __builtin_bit_cast(unsigned, __builtin_convertvector(v, bf16x2_t)); }
    return __builtin_bit_cast(bf16x8, pk);
}

struct AttnFrags { bf16x8 kf[4]; s16x4 vf[2][4]; };
DI void attn_load(AttnFrags& f, const bf16_t* kptr, const bf16_t* vptr, size_t vstride_d32) {
#pragma unroll
    for (int s = 0; s < 4; ++s) f.kf[s] = *(const bf16x8*)(kptr + 16 * s);
#pragma unroll
    for (int d = 0; d < 2; ++d)
#pragma unroll
        for (int q = 0; q < 4; ++q) f.vf[d][q] = *(const s16x4*)(vptr + (size_t)d * vstride_d32 + 8 * q);
}
DI void attn_block(const bf16x8 (&qf)[4], const AttnFrags& f, int mask_mode, int kq_off, int lane, float& m, float& lpart, f32x16 (&o)[2]) {
    const int h = lane >> 5;
    f32x16 st;
#pragma unroll
    for (int r = 0; r < 16; ++r) st[r] = 0.f;
#pragma unroll
    for (int s = 0; s < 4; ++s) st = MFMA32(f.kf[s], qf[s], st);
    if (mask_mode) {
#pragma unroll
        for (int r = 0; r < 16; ++r) { const int dlt = kq_off + crow(r, h); if (dlt > 128 || dlt < -128) st[r] = -1e30f; }
    }
    float bm = st[0];
#pragma unroll
    for (int r = 1; r < 16; ++r) bm = fmaxf(bm, st[r]);
    bm = fmaxf(bm, __shfl_xor(bm, 32));
    const float mn = fmaxf(m, bm), alpha = exp2f(m - mn);
    m = mn;
    float ps = 0.f;
#pragma unroll
    for (int r = 0; r < 16; ++r) { st[r] = exp2f(st[r] - mn); ps += st[r]; }
    lpart = lpart * alpha + ps;
#pragma unroll
    for (int d = 0; d < 2; ++d)
#pragma unroll
        for (int r = 0; r < 16; ++r) o[d][r] *= alpha;
    const bf16x8 pf0 = pack8(st, 0), pf1 = pack8(st, 1);
#pragma unroll
    for (int d = 0; d < 2; ++d) {
        const bf16x8 v0 = __builtin_shufflevector(f.vf[d][0], f.vf[d][1], 0, 1, 2, 3, 4, 5, 6, 7), v1 = __builtin_shufflevector(f.vf[d][2], f.vf[d][3], 0, 1, 2, 3, 4, 5, 6, 7);
        o[d] = MFMA32(v0, pf0, o[d]);
        o[d] = MFMA32(v1, pf1, o[d]);
    }
}

DI void attn_task(const Params& p, int l, int task, int lane) {
    const int r = lane & 31, h = lane >> 5;
    const bf16_t* P = (const bf16_t*)(p.ws + WS_P);
    const bf16_t* VT = (const bf16_t*)(p.ws + WS_VT);
    const bf16_t* VTC = (const bf16_t*)(p.ws + WS_VTC);
    bf16_t* Y = (bf16_t*)(p.ws + WS_Y);
    const bool latent = task < 8192;
    int b, head, qb, q0row, p0;
    if (latent) { qb = task & 127; head = (task >> 7) & 7; b = task >> 10; p0 = qb * 32; q0row = b * SEQ + p0; }
    else { const int t2 = task - 8192; qb = t2 & 7; head = (t2 >> 3) & 7; b = t2 >> 6; p0 = qb * 32; q0row = TL + b * NCTX + p0; }
    const int hk = head >> 2;
    bf16x8 qf[4];
#pragma unroll
    for (int s = 0; s < 4; ++s) qf[s] = *(const bf16x8*)(P + (size_t)(q0row + r) * PW + head * 64 + 16 * s + 8 * h);
    float m = p.in[I_attn_sink][l * 8 + head] * LOG2E, lpart = (h == 0) ? 1.0f : 0.0f;
    f32x16 o[2];
#pragma unroll
    for (int d = 0; d < 2; ++d)
#pragma unroll
        for (int i = 0; i < 16; ++i) o[d][i] = 0.f;
    const int kb_lo = max(p0 - 128, 0), kb_hi = min(p0 + 128, SEQ - 32);
    const int nwin = latent ? ((kb_hi - kb_lo) >> 5) + 1 : 0, nblk = nwin + 8;
    const bf16_t* kwin = P + (size_t)(b * SEQ + r) * PW + KOFF + hk * 64 + 8 * h;
    const bf16_t* vwin = VT + ((size_t)(b * 2 + hk) * 64 + r) * VTS + 4 * h;
    const bf16_t* kctx = P + (size_t)(TL + b * NCTX + r) * PW + KOFF + hk * 64 + 8 * h;
    const bf16_t* vctx = VTC + ((size_t)(b * 2 + hk) * 64 + r) * NCTX + 4 * h;
    AttnFrags f0, f1, f2;
#define ATT_LOAD(F_, jj) do { const int j_ = min((jj), nblk - 1); \
        if (j_ < nwin) { const int kb_ = kb_lo + 32 * j_; attn_load(F_, kwin + (size_t)kb_ * PW, vwin + kb_, (size_t)32 * VTS); } \
        else { const int kb_ = 32 * (j_ - nwin); attn_load(F_, kctx + (size_t)kb_ * PW, vctx + kb_, (size_t)32 * NCTX); } } while (0)
#define ATT_COMP(F_, jj) do { const int j_ = (jj); if (j_ < nblk) { int mm_ = 0, kq_ = 0; \
        if (j_ < nwin) { const int kb_ = kb_lo + 32 * j_; mm_ = (kb_ == p0 - 128 || kb_ == p0 + 128) ? 1 : 0; kq_ = kb_ - (p0 + r); } \
        attn_block(qf, F_, mm_, kq_, lane, m, lpart, o); } } while (0)
    ATT_LOAD(f0, 0); ATT_LOAD(f1, 1);
#pragma unroll 1
    for (int j = 0; j < nblk; j += 3) {
        ATT_LOAD(f2, j + 2); ATT_COMP(f0, j);
        ATT_LOAD(f0, j + 3); ATT_COMP(f1, j + 1);
        ATT_LOAD(f1, j + 4); ATT_COMP(f2, j + 2);
    }
#undef ATT_LOAD
#undef ATT_COMP
    const float inv = 1.0f / (lpart + __shfl_xor(lpart, 32));
    bf16_t* yrow = Y + (size_t)(q0row + r) * D + head * 64;
#pragma unroll
    for (int d = 0; d < 2; ++d)
#pragma unroll
        for (int g = 0; g < 4; ++g) {
            u32x2 w; w.x = pk2(o[d][4 * g] * inv, o[d][4 * g + 1] * inv); w.y = pk2(o[d][4 * g + 2] * inv, o[d][4 * g + 3] * inv);
            *(u32x2*)(yrow + 32 * d + 8 * g + 4 * h) = w;
        }
}

DI void sgu_unit(const Params& p, const Frame& F, int l, int chunk) {
    constexpr int VS = 136;
    LAS float* part = (LAS float*)F.lds;
    LAS float* rq = part + 512;
    LAS bf16_t* vnT = (LAS bf16_t*)(F.lds + 4096);
    const bf16_t* VsT = (const bf16_t*)(p.ws + WS_VST) + (size_t)chunk * 256 * 128;
    const bf16_t* P = (const bf16_t*)(p.ws + WS_P);
    bf16_t* Y = (bf16_t*)(p.ws + WS_Y);
    __syncthreads();
    { const int q = F.tid & 127, part_i = F.tid >> 7; float ss = 0.f;
        for (int c = part_i * 64; c < part_i * 64 + 64; ++c) { const float v = bf2f(VsT[c * 128 + q]); ss += v * v; }
        part[part_i * 128 + q] = ss; }
    __syncthreads();
    if (F.tid < 128) rq[F.tid] = rsqrtf((part[F.tid] + part[128 + F.tid] + part[256 + F.tid] + part[384 + F.tid]) * (1.0f / 256.0f) + EPS);
    __syncthreads();
    for (int i = F.tid; i < 256 * 16; i += NTHREADS) {
        const int c = i >> 4, q8 = (i & 15) * 8;
        const u32x4 v = *(const u32x4*)(VsT + c * 128 + q8);
        u32x4 o;
#pragma unroll
        for (int j = 0; j < 4; ++j) o[j] = pk2(bflo(v[j]) * rq[q8 + 2 * j], bfhi(v[j]) * rq[q8 + 2 * j + 1]);
        *(LAS u32x4*)(vnT + c * VS + q8) = o;
    }
    __syncthreads();
    const int lane = F.lane, r = lane & 31, h = lane >> 5, g = F.wave >> 1, ph = F.wave & 1;
    const bf16_t* Wg = (const bf16_t*)(p.ws + WS_SGUW) + ((size_t)l * 4 + g) * 128 * 128;
#pragma unroll 1
    for (int pb = 0; pb < 2; ++pb) {
        const int p0 = 64 * ph + 32 * pb;
#pragma unroll 1
        for (int cb = 0; cb < 2; ++cb) {
            const int c0 = 64 * g + 32 * cb;
            f32x16 acc;
#pragma unroll
            for (int i = 0; i < 16; ++i) acc[i] = 0.f;
#pragma unroll
            for (int s = 0; s < 8; ++s) {
                const bf16x8 a = *(const LAS bf16x8*)(vnT + (c0 + r) * VS + 16 * s + 8 * h);
                const bf16x8 b = *(const bf16x8*)(Wg + (size_t)(p0 + r) * 128 + 16 * s + 8 * h);
                acc = MFMA32(a, b, acc);
            }
            const int row = chunk * 128 + p0 + r;
            const float bias = p.in[I_sgu_b][(l * 4 + g) * 128 + p0 + r];
#pragma unroll
            for (int q4 = 0; q4 < 4; ++q4) {
                const int cc = c0 + 8 * q4 + 4 * h;
                const u32x2 u = *(const u32x2*)(P + (size_t)row * PW + SUOFF + cc);
                u32x2 w;
                w.x = pk2(bflo(u.x) * (acc[4 * q4] + bias), bfhi(u.x) * (acc[4 * q4 + 1] + bias));
                w.y = pk2(bflo(u.y) * (acc[4 * q4 + 2] + bias), bfhi(u.y) * (acc[4 * q4 + 3] + bias));
                *(u32x2*)(Y + (size_t)row * D + 768 + cc) = w;
            }
        }
    }
}

DI void phase_mix(const Params& p, const Frame& F, int l, int ctr_slot = 0) {
    const int nrows = (l == 0) ? T : TL;
    const bf16_t* P = (const bf16_t*)(p.ws + WS_P);
    bf16_t* Y = (bf16_t*)(p.ws + WS_Y);
    for (int i = F.gtid; i < nrows * 32; i += F.ngt) {
        const int row = i >> 5, ck = i & 31, g = ck >> 3, half = 1 << g;
        int base, t, len;
        if (row < TL) { base = row & ~(SEQ - 1); t = row & (SEQ - 1); len = SEQ; } else { const int rc = row - TL; base = TL + (rc & ~(NCTX - 1)); t = rc & (NCTX - 1); len = NCTX; }
        const int lo = max(t - half, 0), hi = min(t + half, len);
        float s[8];
#pragma unroll
        for (int j = 0; j < 8; ++j) s[j] = 0.f;
        for (int tt = lo; tt < hi; ++tt) {
            const u32x4 v = *(const u32x4*)(P + (size_t)(base + tt) * PW + POOLOFF + ck * 8);
#pragma unroll
            for (int j = 0; j < 4; ++j) { s[2 * j] += bflo(v[j]); s[2 * j + 1] += bfhi(v[j]); }
        }
        const float inv = 1.0f / (float)(hi - lo);
        const u32x4 z = *(const u32x4*)(P + (size_t)row * PW + POOLOFF + ck * 8);
        u32x4 o;
#pragma unroll
        for (int j = 0; j < 4; ++j) o[j] = pk2(s[2 * j] * inv - bflo(z[j]), s[2 * j + 1] * inv - bfhi(z[j]));
        *(u32x4*)(Y + (size_t)row * D + 512 + ck * 8) = o;
    }
    const int nchunk = (l == 0) ? T / 128 : TL / 128;
    for (int ch = F.bid; ch < nchunk; ch += F.nb) sgu_unit(p, F, l, ch);
    const int ntask = (l == 0) ? 8192 + 512 : 8192;
    unsigned* ctr = (unsigned*)(p.ws + WS_CTL) + 16384 + 64 * (l + 2 * ctr_slot);
    for (;;) {
        unsigned t = 0;
        if (F.lane == 0) t = atomicAdd(ctr, 1u);
        const int task = (int)__builtin_amdgcn_readfirstlane(t);
        if (task >= ntask) break;
        attn_task(p, l, task, F.lane);
    }
}

DI void g2_simple(const Params& p, const Frame& F, int l, int row_lo, int nrows) {
    const bf16_t* H = (const bf16_t*)(p.ws + WS_H);
    const bf16_t* Yb = (const bf16_t*)(p.ws + WS_Y);
    const bf16_t* Wg = (const bf16_t*)(p.ws + WS_WIN) + (size_t)l * INW * D + (size_t)GATEOFF * D;
    const bf16_t* Wb = (const bf16_t*)(p.ws + WS_WBR) + (size_t)l * D * D;
    bf16_t* M = (bf16_t*)(p.ws + WS_MERGED);
    const int nit = (nrows / 64) * (D / 32);
    for (int it = F.gw; it < nit; it += F.ngw) {
        const int mt = it / (D / 32), nt = it % (D / 32), m0 = row_lo + mt * 64, n0 = nt * 32;
        f32x16 tot[2][1]; zero_acc(tot);
#pragma unroll 1
        for (int i = 0; i < 3; ++i) {
            const int koff = (i == 0) ? 0 : (i == 1 ? 512 : 768), kk = (i == 0) ? 512 : 256;
            f32x16 g[2][1], pr[2][1]; zero_acc(g); zero_acc(pr);
            wave_gemm<2, 1>(H, D, Wg + (size_t)i * D * D, D, D, m0, n0, g, F.lane);
            wave_gemm<2, 1>(Yb + koff, D, Wb + koff, D, kk, m0, n0, pr, F.lane);
#pragma unroll
            for (int a = 0; a < 2; ++a)
#pragma unroll
                for (int r = 0; r < 16; ++r) tot[a][0][r] += sigmoidf_(g[a][0][r]) * pr[a][0][r];
        }
        const int h = F.lane >> 5, col = n0 + (F.lane & 31);
#pragma unroll
        for (int a = 0; a < 2; ++a)
#pragma unroll
            for (int r = 0; r < 16; ++r) M[(size_t)(m0 + 32 * a + crow(r, h)) * D + col] = (bf16_t)f2bf(tot[a][0][r]);
    }
}
struct SchedG2 {
    int G, c; const char *H, *Y, *Wg, *Wb;
    DI bool next(int i, pg8::Unit& u) const {
        const int tile = (i / 6) * G + c; if (tile >= (TL / 256) * 4) return false;
        const int sub = i % 6, br = sub >> 1;
        pg8::tile_of(tile, TL / 256, 4, u.pm, u.pn); u.sub = sub;
        if ((sub & 1) == 0) { u.nt = 16; u.a = H + (size_t)u.pm * 256 * D * 2; u.b = Wg + ((size_t)br * D + u.pn * 256) * D * 2; }
        else { const int koff = (br == 0) ? 0 : (br == 1 ? 512 : 768); u.nt = (br == 0) ? 8 : 4;
               u.a = Y + ((size_t)u.pm * 256 * D + koff) * 2; u.b = Wb + ((size_t)u.pn * 256 * D + koff) * 2; }
        return true;
    }
};
struct EpiG2 {
    static constexpr bool PERM = true;
    bf16_t* scr; bf16_t* M;
    DI void operator()(const f32x4 (&acc)[2][2][4][2], const pg8::Unit& u, int wr, int wc, int fr, int fq) const {
#pragma unroll
        for (int ai = 0; ai < 2; ++ai)
#pragma unroll
            for (int m = 0; m < 4; ++m) {
                const int rl = 128 * ai + 64 * wr + 16 * m + fr;
#pragma unroll
                for (int bj = 0; bj < 2; ++bj) {
                    const int cl = 128 * bj + 32 * wc + 8 * fq;
                    float v[8];
#pragma unroll
                    for (int j = 0; j < 4; ++j) { v[j] = acc[ai][bj][m][0][j]; v[4 + j] = acc[ai][bj][m][1][j]; }
                    u32x4* sp = (u32x4*)(scr + rl * 256 + cl);
                    if ((u.sub & 1) == 0) {
                        u32x4 o;
#pragma unroll
                        for (int j2 = 0; j2 < 4; ++j2) o[j2] = pk2(sigmoidf_(v[2 * j2]), sigmoidf_(v[2 * j2 + 1]));
                        *sp = o;
                    } else {
                        const u32x4 g = *sp;
                        u32x4* mp = (u32x4*)(M + (size_t)(u.pm * 256 + rl) * D + u.pn * 256 + cl);
                        float o[8];
#pragma unroll
                        for (int j2 = 0; j2 < 4; ++j2) { o[2 * j2] = bflo(g[j2]) * v[2 * j2]; o[2 * j2 + 1] = bfhi(g[j2]) * v[2 * j2 + 1]; }
                        if (u.sub > 1) { const u32x4 old = *mp;
#pragma unroll
                            for (int j2 = 0; j2 < 4; ++j2) { o[2 * j2] += bflo(old[j2]); o[2 * j2 + 1] += bfhi(old[j2]); } }
                        u32x4 w;
#pragma unroll
                        for (int j2 = 0; j2 < 4; ++j2) w[j2] = pk2(o[2 * j2], o[2 * j2 + 1]);
                        *mp = w;
                    }
                }
                asm volatile("" ::: "memory");
            }
    }
};
DI void phase_g2(const Params& p, const Frame& F, int l) {
    SchedG2 S{F.nb, F.bid, (const char*)(p.ws + WS_H), (const char*)(p.ws + WS_Y),
              (const char*)(p.ws + WS_WIN) + ((size_t)l * INW + GATEOFF) * D * 2, (const char*)(p.ws + WS_WBR) + (size_t)l * D * D * 2};
    EpiG2 E{(bf16_t*)(p.ws + WS_IDX) + (size_t)F.bid * 65536, (bf16_t*)(p.ws + WS_MERGED)};
    pg8::gemm_phase(F.lds, F.tid, S, E);
    if (l == 0) g2_simple(p, F, l, TL, TC);
}

DI void g3_simple(const Params& p, const Frame& F, int l, int row_lo, int nrows) {
    const bf16_t* M = (const bf16_t*)(p.ws + WS_MERGED);
    const bf16_t* W = (const bf16_t*)(p.ws + WS_WOUT) + (size_t)l * D * D;
    const int nit = (nrows / 64) * (D / 64);
    for (int it = F.gw; it < nit; it += F.ngw) {
        const int mt = it / (D / 64), nt = it % (D / 64), m0 = row_lo + mt * 64, n0 = nt * 64;
        f32x16 acc[2][2]; zero_acc(acc);
        wave_gemm<2, 2>(M, D, W, D, D, m0, n0, acc, F.lane);
        const int h = F.lane >> 5;
#pragma unroll
        for (int a = 0; a < 2; ++a)
#pragma unroll
            for (int j = 0; j < 2; ++j) {
                const int col = n0 + 32 * j + (F.lane & 31);
#pragma unroll
                for (int r = 0; r < 16; ++r) {
                    const int row = m0 + 32 * a + crow(r, h);
                    const float xs = (l == 0) ? xin_ptr(p, row)[col] : xrow_ptr(p, row)[col];
                    xrow_ptr(p, row)[col] = xs + mod_vec(p, l, row, 2)[col] * acc[a][j][r];
                }
            }
    }
}
struct EpiG3 {
    static constexpr bool PERM = false;
    const float* xsrc; float* xdst; const float* mod;
    DI void operator()(const f32x4 (&acc)[2][2][4][2], const pg8::Unit& u, int wr, int wc, int fr, int fq) const {
        const int col0 = u.pn * 256 + wc * 32 + 4 * fq;
        const float* gt = mod + (size_t)(u.pm >> 4) * NMOD + 2 * D;
#pragma unroll
        for (int ai = 0; ai < 2; ++ai)
#pragma unroll
            for (int m = 0; m < 4; ++m) {
                const size_t off = (size_t)(u.pm * 256 + wr * 64 + fr + 128 * ai + 16 * m) * D;
#pragma unroll
                for (int bj = 0; bj < 2; ++bj)
#pragma unroll
                    for (int n = 0; n < 2; ++n) {
                        const int c = col0 + 128 * bj + 16 * n;
                        const f32x4 xv = *(const f32x4*)(xsrc + off + c), gv = *(const f32x4*)(gt + c);
                        *(f32x4*)(xdst + off + c) = xv + gv * acc[ai][bj][m][n];
                    }
                asm volatile("" ::: "memory");
            }
    }
};
DI void phase_g3(const Params& p, const Frame& F, int l) {
    SchedGrid S{TL / 256, D / 256, F.nb, F.bid, (const char*)(p.ws + WS_MERGED), (const char*)(p.ws + WS_WOUT) + (size_t)l * D * D * 2};
    EpiG3 E{(l == 0) ? p.in[I_x] : p.out, p.out, (const float*)(p.ws + WS_MOD) + (size_t)l * 9 * NMOD};
    pg8::gemm_phase(F.lds, F.tid, S, E);
    if (l == 0) g3_simple(p, F, l, TL, TC);
}

DI void g45_simple(const Params& p, const Frame& F, int l, int row_lo, int nrows) {
    const bf16_t* H = (const bf16_t*)(p.ws + WS_H);
    const bf16_t* W = (const bf16_t*)(p.ws + WS_WFOLD) + (size_t)l * 2048 * D;
    _Float16* ST = (_Float16*)(p.ws + WS_ST);
    const int nit = (2048 / 64) * (nrows / 64);
    for (int it = F.gw; it < nit; it += F.ngw) {
        const int nt = it / 32, mt = it % 32, m0 = mt * 64, n0 = row_lo + nt * 64;
        f32x16 acc[2][2]; zero_acc(acc);
        wave_gemm<2, 2>(W, D, H, D, D, m0, n0, acc, F.lane);
        const int h = F.lane >> 5;
#pragma unroll
        for (int a = 0; a < 2; ++a)
#pragma unroll
            for (int j = 0; j < 2; ++j)
#pragma unroll
                for (int r = 0; r < 16; ++r) ST[(size_t)(m0 + 32 * a + crow(r, h)) * T + n0 + 32 * j + (F.lane & 31)] = (_Float16)acc[a][j][r];
    }
}
struct EpiG45 {
    static constexpr bool PERM = true;
    unsigned short* ST;
    DI void operator()(const f32x4 (&acc)[2][2][4][2], const pg8::Unit& u, int wr, int wc, int fr, int fq) const {
        const int col0 = u.pn * 256 + wc * 32 + 8 * fq;
#pragma unroll
        for (int ai = 0; ai < 2; ++ai)
#pragma unroll
            for (int m = 0; m < 4; ++m) {
                unsigned short* rowp = ST + (size_t)(u.pm * 256 + wr * 64 + fr + 128 * ai + 16 * m) * T + col0;
#pragma unroll
                for (int bj = 0; bj < 2; ++bj) {
                    u32x4 w;
                    w.x = pkh2(acc[ai][bj][m][0][0], acc[ai][bj][m][0][1]); w.y = pkh2(acc[ai][bj][m][0][2], acc[ai][bj][m][0][3]);
                    w.z = pkh2(acc[ai][bj][m][1][0], acc[ai][bj][m][1][1]); w.w = pkh2(acc[ai][bj][m][1][2], acc[ai][bj][m][1][3]);
                    *(u32x4*)(rowp + 128 * bj) = w;
                }
            }
    }
};
DI void phase_g45(const Params& p, const Frame& F, int l) {
    SchedGrid S{2048 / 256, TL / 256, F.nb, F.bid, (const char*)(p.ws + WS_WFOLD) + (size_t)l * 2048 * D * 2, (const char*)(p.ws + WS_H)};
    EpiG45 E{(unsigned short*)(p.ws + WS_ST)};
    pg8::gemm_phase(F.lds, F.tid, S, E);
    if (l == 0) g45_simple(p, F, l, TL, TC);
}

DI unsigned fkey(float f) { const unsigned u = __builtin_bit_cast(unsigned, f); return (u & 0x80000000u) ? ~u : (u | 0x80000000u); }
DI float fkey_inv(unsigned k) { const unsigned u = (k & 0x80000000u) ? (k & 0x7fffffffu) : ~k; return __builtin_bit_cast(float, u); }
#define INSERT16(L, x) do { unsigned x_ = (x); _Pragma("unroll") for (int k_ = 0; k_ < 16; ++k_) { const unsigned hi_ = max(L[k_], x_); x_ = min(L[k_], x_); L[k_] = hi_; } } while (0)

DI void phase_sel(const Params& p, const Frame& F, int l) {
    const _Float16* ST = (const _Float16*)(p.ws + WS_ST);
    unsigned short* IDX = (unsigned short*)(p.ws + WS_IDX);
    float* GW = (float*)(p.ws + WS_GW);
    float* SU = (float*)(p.ws + WS_SU);
    const float* TSC = (const float*)(p.ws + WS_TSCALE) + (size_t)l * 2 * NEXP;
    LAS unsigned char* ib = (LAS unsigned char*)F.lds;
    const int ntok = (l == 0) ? T : TL;
    for (int i0 = F.bid * NTHREADS; i0 < ntok * 8; i0 += F.nb * NTHREADS) {
        const int i = i0 + F.tid;
        const int tok = i % ntok, head = i / ntok;
        unsigned la[16], lb[16];
#pragma unroll
        for (int k = 0; k < 16; ++k) { la[k] = 0u; lb[k] = 0u; }
        const _Float16* s0 = ST + (size_t)(head * 256) * T + tok;
#pragma unroll 1
        for (int k0 = 0; k0 < 256; k0 += 32) {
            float buf[32];
#pragma unroll
            for (int j = 0; j < 32; ++j) buf[j] = (float)s0[(size_t)(k0 + j) * T];
            if (k0 < 128) {
#pragma unroll
                for (int j = 0; j < 32; ++j) { const unsigned key = (fkey(buf[j]) & ~127u) | (unsigned)(127 - ((k0 + j) & 127)); INSERT16(la, key); }
            } else {
#pragma unroll
                for (int j = 0; j < 32; ++j) { const unsigned key = (fkey(buf[j]) & ~127u) | (unsigned)(127 - ((k0 + j) & 127)); INSERT16(lb, key); }
            }
        }
        float va[16], vb[16];
#pragma unroll
        for (int k = 0; k < 16; ++k) {
            va[k] = fkey_inv(la[k] & ~127u); vb[k] = fkey_inv(lb[k] & ~127u);
            ib[k * NTHREADS + F.tid] = (unsigned char)(127u - (la[k] & 127u));
            ib[(16 + k) * NTHREADS + F.tid] = (unsigned char)(127u - (lb[k] & 127u));
        }
        unsigned lc[16];
#pragma unroll
        for (int k = 0; k < 16; ++k) lc[k] = 0u;
#pragma unroll
        for (int a = 0; a < 16; ++a)
#pragma unroll
            for (int b = 0; b < 16; ++b)
                if ((a + 1) * (b + 1) <= 16) { const unsigned key = (fkey(va[a] + vb[b]) & ~255u) | (unsigned)(255 - (a * 16 + b)); INSERT16(lc, key); }
        float e[16], sum = 0.f; const float v0 = fkey_inv(lc[0] & ~255u);
#pragma unroll
        for (int k = 0; k < 16; ++k) { e[k] = __expf(fkey_inv(lc[k] & ~255u) - v0); sum += e[k]; }
        const float inv = 1.0f / sum;
        asm volatile("s_waitcnt lgkmcnt(0)" ::: "memory");
#pragma unroll
        for (int k = 0; k < 16; ++k) {
            const unsigned pos = 255u - (lc[k] & 255u), a = pos >> 4, b = pos & 15u;
            const unsigned ea = ib[a * NTHREADS + F.tid], eb = ib[(16 + b) * NTHREADS + F.tid];
            const unsigned ex = ea * 128u + eb;
            IDX[(size_t)tok * 128 + head * 16 + k] = (unsigned short)ex;
            GW[(size_t)tok * 128 + head * 16 + k] = e[k] * inv * TSC[NEXP + ex];
            SU[(size_t)tok * 128 + head * 16 + k] = TSC[ex];
        }
        asm volatile("s_waitcnt lgkmcnt(0)" ::: "memory");
    }
}

DI float dot16_fp8(const u32x4 q, const float (&hx)[16]) {
    f32x2 a = {0.f, 0.f};
#pragma unroll
    for (int j = 0; j < 4; ++j) {
        const f32x2 lo = __builtin_amdgcn_cvt_pk_f32_fp8((int)q[j], false), hi = __builtin_amdgcn_cvt_pk_f32_fp8((int)q[j], true);
        a += lo * (f32x2){hx[4 * j], hx[4 * j + 1]}; a += hi * (f32x2){hx[4 * j + 2], hx[4 * j + 3]};
    }
    return a.x + a.y;
}
DI void phase_peer_u(const Params& p, const Frame& F, int l, bool dummy = false) {
    const int ntok = (l == 0) ? T : TL, lane = F.lane;
    const int slice = F.bid & 7, sw = (F.bid >> 3) * NWAVES + F.wave, nsw = (F.nb >> 3) * NWAVES;
    const unsigned char* H8 = p.ws + WS_H8;
    const float* HS = (const float*)(p.ws + WS_HS);
    const unsigned char* UT = p.ws + WS_UTAB + (size_t)l * NEXP * D;
    const unsigned short* IDX = (const unsigned short*)(p.ws + WS_IDX);
    float* GW = (float*)(p.ws + WS_GW);
    float* CO = dummy ? (float*)(p.ws + WS_ST) : GW;
    const float* SU = (const float*)(p.ws + WS_SU);
    LAS unsigned* list = (LAS unsigned*)(F.lds + F.wave * 1024);
    const int c = lane & 15, kg = lane >> 4;
    int ev0 = 0, ev1 = 0; float gv0 = 0.f, gv1 = 0.f, sv0 = 0.f, sv1 = 0.f;
    if (sw < ntok) { const size_t o = (size_t)sw * 128 + lane; ev0 = IDX[o]; ev1 = IDX[o + 64]; gv0 = GW[o]; gv1 = GW[o + 64]; sv0 = SU[o]; sv1 = SU[o + 64]; }
    for (int tok = sw; tok < ntok; tok += nsw) {
        int nev0 = 0, nev1 = 0; float ngv0 = 0.f, ngv1 = 0.f, nsv0 = 0.f, nsv1 = 0.f;
        if (tok + nsw < ntok) { const size_t o = (size_t)(tok + nsw) * 128 + lane; nev0 = IDX[o]; nev1 = IDX[o + 64]; ngv0 = GW[o]; ngv1 = GW[o + 64]; nsv0 = SU[o]; nsv1 = SU[o + 64]; }
        const bool in0 = (ev0 >> 11) == slice, in1 = (ev1 >> 11) == slice;
        const unsigned long long m0 = __ballot(in0), m1 = __ballot(in1);
        const int n0 = __builtin_popcountll(m0), n = n0 + __builtin_popcountll(m1);
        const int r0 = __builtin_amdgcn_mbcnt_hi((unsigned)(m0 >> 32), __builtin_amdgcn_mbcnt_lo((unsigned)m0, 0));
        const int r1 = __builtin_amdgcn_mbcnt_hi((unsigned)(m1 >> 32), __builtin_amdgcn_mbcnt_lo((unsigned)m1, 0));
        if (in0) list[r0] = ((unsigned)lane << 16) | (unsigned)ev0;
        if (in1) list[n0 + r1] = ((unsigned)(64 + lane) << 16) | (unsigned)ev1;
        if (n > 0) {
            u32x4 hb[16];
            const unsigned char* hp = H8 + (size_t)tok * D + 16 * kg;
#pragma unroll
            for (int kk = 0; kk < 16; ++kk) hb[kk] = *(const u32x4*)(hp + 64 * kk);
            const float hs = HS[tok];
#pragma unroll 1
            for (int b = 0; 16 * b < n; ++b) {
                const unsigned ent = list[min(16 * b + c, n - 1)];
                const unsigned char* rp = UT + (size_t)(ent & 0xffffu) * D + 16 * kg;
                u32x4 a[16];
#pragma unroll
                for (int kk = 0; kk < 16; ++kk) a[kk] = *(const u32x4*)(rp + 64 * kk);
                f32x4 acc = {0.f, 0.f, 0.f, 0.f};
#pragma unroll
                for (int kk = 0; kk < 16; ++kk) {
                    const long alo = (long)(((unsigned long long)a[kk].y << 32) | a[kk].x), ahi = (long)(((unsigned long long)a[kk].w << 32) | a[kk].z);
                    const long blo = (long)(((unsigned long long)hb[kk].y << 32) | hb[kk].x), bhi = (long)(((unsigned long long)hb[kk].w << 32) | hb[kk].z);
                    acc = __builtin_amdgcn_mfma_f32_16x16x32_fp8_fp8(alo, blo, acc, 0, 0, 0);
                    acc = __builtin_amdgcn_mfma_f32_16x16x32_fp8_fp8(ahi, bhi, acc, 0, 0, 0);
                }
                const int my = 16 * b + 4 * kg + (c & 3);
                const unsigned ent2 = list[min(my, n - 1)];
                const int slot = (int)(ent2 >> 16);
                const float ga = __shfl(gv0, slot & 63), gb = __shfl(gv1, slot & 63), sa = __shfl(sv0, slot & 63), sb = __shfl(sv1, slot & 63);
                const float gate = (slot < 64) ? ga : gb, su = (slot < 64) ? sa : sb;
                const float val = ((c & 3) == 0) ? acc[0] : ((c & 3) == 1) ? acc[1] : ((c & 3) == 2) ? acc[2] : acc[3];
                if (c < 4 && my < n) CO[(size_t)tok * 128 + slot] = gate * gelu_tanh(val * hs * su);
            }
        }
        ev0 = nev0; ev1 = nev1; gv0 = ngv0; gv1 = ngv1; sv0 = nsv0; sv1 = nsv1;
    }
}
DI void phase_peer_v(const Params& p, const Frame& F, int l, bool dummy = false) {
    const int ntok = (l == 0) ? T : TL, lane = F.lane;
    const int slice = F.bid & 7, sw = (F.bid >> 3) * NWAVES + F.wave, nsw = (F.nb >> 3) * NWAVES;
    const unsigned char* VT8 = p.ws + WS_VTAB + (size_t)l * NEXP * D + 128 * slice + 16 * (lane & 7);
    const unsigned short* IDX = (const unsigned short*)(p.ws + WS_IDX);
    const float* CF = (const float*)(p.ws + WS_GW);
    const int b5 = lane >> 5, b4 = (lane >> 4) & 1, b3 = (lane >> 3) & 1;
    for (int tok = sw; tok < ntok; tok += nsw) {
        f32x2 a[8];
#pragma unroll
        for (int j = 0; j < 8; ++j) a[j] = (f32x2){0.f, 0.f};
        const unsigned short* ip = IDX + (size_t)tok * 128 + (lane >> 3);
        const float* cp = CF + (size_t)tok * 128 + (lane >> 3);
#pragma unroll
        for (int i = 0; i < 16; ++i) {
            const int e = ip[8 * i]; const float cf = cp[8 * i];
            const u32x4 q = *(const u32x4*)(VT8 + (size_t)e * D);
            const f32x2 c2 = {cf, cf};
#pragma unroll
            for (int j = 0; j < 4; ++j) {
                a[2 * j] += c2 * __builtin_amdgcn_cvt_pk_f32_fp8((int)q[j], false);
                a[2 * j + 1] += c2 * __builtin_amdgcn_cvt_pk_f32_fp8((int)q[j], true);
            }
        }
        f32x2 k4[4];
#pragma unroll
        for (int j = 0; j < 4; ++j) { const f32x2 keep = b5 ? a[4 + j] : a[j], send = b5 ? a[j] : a[4 + j];
            k4[j] = keep + (f32x2){__shfl_xor(send.x, 32), __shfl_xor(send.y, 32)}; }
        f32x2 k2[2];
#pragma unroll
        for (int j = 0; j < 2; ++j) { const f32x2 keep = b4 ? k4[2 + j] : k4[j], send = b4 ? k4[j] : k4[2 + j];
            k2[j] = keep + (f32x2){__shfl_xor(send.x, 16), __shfl_xor(send.y, 16)}; }
        f32x2 k1;
        { const f32x2 keep = b3 ? k2[1] : k2[0], send = b3 ? k2[0] : k2[1];
            k1 = keep + (f32x2){__shfl_xor(send.x, 8), __shfl_xor(send.y, 8)}; }
        const int col = 128 * slice + 16 * (lane & 7) + 8 * b5 + 4 * b4 + 2 * b3;
        f32x2* xp = (f32x2*)(xrow_ptr(p, tok) + col);
        f32x2* xo = dummy ? (f32x2*)((float*)(p.ws + WS_ST) + (size_t)tok * D + col) : xp;
        const f32x2 gt = *(const f32x2*)(mod_vec(p, l, tok, 5) + col);
        *xo = *xp + gt * k1;
    }
}

#define XB_TMO      128
#define XB_XCNT(j)  (256  + 64 * (j))
#define XB_XSUB(j)  (1280 + 64 * (j))
#define XB_XGEN(j)  (2304 + 64 * (j))
#define XB_TOP      3328
#define XB_TOPGEN   3392
#define XCD_BAR_WORDS 3456
#define XB_SPIN_CAP (1u << 18)
DI unsigned xb_ld(unsigned* p)              { return __hip_atomic_load(p, __ATOMIC_RELAXED, __HIP_MEMORY_SCOPE_AGENT); }
DI unsigned xb_add(unsigned* p, unsigned v) { return __hip_atomic_fetch_add(p, v, __ATOMIC_RELAXED, __HIP_MEMORY_SCOPE_AGENT); }
DI unsigned xb_xcc_id() { return (unsigned)__builtin_amdgcn_s_getreg((3 << 11) | 20) & 0xFu; }
#define XB_SPIN(cond, bar) do { unsigned _sp = 0; while (cond) { __builtin_amdgcn_s_sleep(1); \
    if ((++_sp & 255u) == 0u) { if (xb_ld(&(bar)[XB_TMO])) break; if (_sp > XB_SPIN_CAP) { atomicAdd(&(bar)[XB_TMO], 1u); break; } } } } while (0)
struct XcdBarrier { unsigned* bar; unsigned x; volatile LAS unsigned* st; };
DI XcdBarrier xcd_barrier_post(unsigned* bar, volatile LAS unsigned* st) {
    XcdBarrier b; b.bar = bar; b.x = xb_xcc_id(); b.st = st;
    if (threadIdx.x == 0) (void)xb_add(&bar[XB_XCNT(b.x)], 1u);
    return b;
}
DI void xcd_barrier_complete(unsigned* bar, unsigned x, unsigned& nloc, unsigned& nx) {
    const unsigned G = gridDim.x * gridDim.y * gridDim.z;
    unsigned sum, cnt, mine, sp = 0u;
    for (;;) {
        sum = 0u; cnt = 0u; mine = 0u;
#pragma unroll
        for (unsigned j = 0; j < 16; ++j) { const unsigned c = xb_ld(&bar[XB_XCNT(j)]); sum += c; cnt += (c > 0u) ? 1u : 0u; mine = (j == x) ? c : mine; }
        if (sum == G) break;
        __builtin_amdgcn_s_sleep(1);
        if ((++sp & 255u) == 0u) { if (xb_ld(&bar[XB_TMO])) break; if (sp > XB_SPIN_CAP) { atomicAdd(&bar[XB_TMO], 1u); break; } }
    }
    nloc = mine > 0u ? mine : 1u; nx = cnt > 0u ? cnt : 1u;
}
DI void xcd_barrier(const XcdBarrier& b) {
    asm volatile("s_waitcnt vmcnt(0)" ::: "memory");
    __syncthreads();
    if (threadIdx.x == 0) {
        unsigned* bar = b.bar;
        __builtin_amdgcn_s_waitcnt(0);
        unsigned nloc = b.st[0], nx = b.st[1];
        if (nloc == 0u) { xcd_barrier_complete(bar, b.x, nloc, nx); b.st[0] = nloc; b.st[1] = nx; }
        const unsigned old = xb_add(&bar[XB_XSUB(b.x)], 1u);
        const unsigned gen = old / nloc;
        if (old + 1u == (gen + 1u) * nloc) {
            __builtin_amdgcn_fence(__ATOMIC_RELEASE, "agent");
            asm volatile("s_waitcnt vmcnt(0)" ::: "memory");
            const unsigned og = xb_add(&bar[XB_TOP], 1u);
            const unsigned tg = og / nx;
            if (og + 1u == (tg + 1u) * nx) xb_add(&bar[XB_TOPGEN], 1u);
            else XB_SPIN(xb_ld(&bar[XB_TOPGEN]) == tg, bar);
            __builtin_amdgcn_fence(__ATOMIC_ACQUIRE, "agent");
            xb_add(&bar[XB_XGEN(b.x)], 1u);
            asm volatile("s_waitcnt vmcnt(0)" ::: "memory");
        } else {
            XB_SPIN(xb_ld(&bar[XB_XGEN(b.x)]) == gen, bar);
            __builtin_amdgcn_fence(__ATOMIC_ACQUIRE, "agent");
            asm volatile("s_waitcnt vmcnt(0)" ::: "memory");
        }
    }
    __syncthreads();
}
constexpr int LDS_BAR_OFF = 135168;

constexpr int NPHASE = 22;
template <int PH> DI void run_phase(const Params& p, const Frame& F) {
    if constexpr (PH == 0) phase_prep(p, F);
    else if constexpr (PH == 1) phase_norm(p, F, 0, 0, true, T);
    else if constexpr (PH == 2) phase_g1(p, F, 0);
    else if constexpr (PH == 3) phase_mix(p, F, 0);
    else if constexpr (PH == 4) phase_g2(p, F, 0);
    else if constexpr (PH == 5) phase_g3(p, F, 0);
    else if constexpr (PH == 6) phase_norm(p, F, 0, 1, false, T);
    else if constexpr (PH == 7) phase_g45(p, F, 0);
    else if constexpr (PH == 8) phase_sel(p, F, 0);
    else if constexpr (PH == 9) phase_peer_u(p, F, 0);
    else if constexpr (PH == 10) phase_peer_v(p, F, 0);
    else if constexpr (PH == 11) phase_norm(p, F, 1, 0, false, T);
    else if constexpr (PH == 12) phase_g1(p, F, 1);
    else if constexpr (PH == 13) phase_mix(p, F, 1);
    else if constexpr (PH == 14) phase_g2(p, F, 1);
    else if constexpr (PH == 15) phase_g3(p, F, 1);
    else if constexpr (PH == 16) phase_norm(p, F, 1, 1, false, TL);
    else if constexpr (PH == 17) phase_g45(p, F, 1);
    else if constexpr (PH == 18) phase_sel(p, F, 1);
    else if constexpr (PH == 19) phase_peer_u(p, F, 1);
    else if constexpr (PH == 20) phase_peer_v(p, F, 1);
    else if constexpr (PH == 21) phase_final(p, F);
}
DI Frame make_frame(unsigned char* lds_raw) {
    Frame F;
    F.lds = (LAS unsigned char*)lds_raw;
    int tid = threadIdx.x; asm volatile("" : "+v"(tid));
    int bid = blockIdx.x, nb = gridDim.x; asm volatile("" : "+s"(bid), "+s"(nb));
    F.tid = tid; F.lane = tid & 63; F.wave = __builtin_amdgcn_readfirstlane(tid >> 6); F.bid = bid; F.nb = nb;
    F.gw = bid * NWAVES + F.wave; F.ngw = nb * NWAVES; F.gtid = bid * NTHREADS + tid; F.ngt = nb * NTHREADS;
    return F;
}
template <int PH> DI void run_phase_fresh(unsigned char* lds_raw) {
#if defined(__HIP_DEVICE_COMPILE__)
    const __attribute__((address_space(4))) unsigned long long* pp = (const __attribute__((address_space(4))) unsigned long long*)__builtin_amdgcn_kernarg_segment_ptr();
    asm volatile("" : "+s"(pp));
    Params p;
#pragma unroll
    for (int i = 0; i < N_IN; ++i) p.in[i] = (const float*)(const __attribute__((address_space(1))) float*)pp[i];
    p.out = (float*)(__attribute__((address_space(1))) float*)pp[N_IN]; p.ws = (unsigned char*)(__attribute__((address_space(1))) unsigned char*)pp[N_IN + 1]; p.ph_lo = 0; p.ph_hi = 0;
#else
    Params p{};
#endif
    const Frame F = make_frame(lds_raw);
    run_phase<PH>(p, F);
}
template <int PH> __global__ void __launch_bounds__(NTHREADS, 2) phase_kernel(Params p) {
    extern __shared__ __attribute__((aligned(16))) unsigned char lds_raw[];
    run_phase_fresh<PH>(lds_raw);
}
template <int PH> DI void run_all(unsigned char* lds_raw, cg::grid_group& grid, const XcdBarrier& bar) {
    if constexpr (PH < NPHASE) {
        if constexpr (PH == PROBE_PH) {
            if constexpr (PH == 9 || PH == 19 || PH == 10 || PH == 20 || PH == 3 || PH == 13) {
#if defined(__HIP_DEVICE_COMPILE__)
                const __attribute__((address_space(4))) unsigned long long* pp = (const __attribute__((address_space(4))) unsigned long long*)__builtin_amdgcn_kernarg_segment_ptr();
                asm volatile("" : "+s"(pp));
                Params p;
#pragma unroll
                for (int i = 0; i < N_IN; ++i) p.in[i] = (const float*)(const __attribute__((address_space(1))) float*)pp[i];
                p.out = (float*)(__attribute__((address_space(1))) float*)pp[N_IN]; p.ws = (unsigned char*)(__attribute__((address_space(1))) unsigned char*)pp[N_IN + 1]; p.ph_lo = 0; p.ph_hi = 0;
                const Frame F = make_frame(lds_raw);
                if constexpr (PH == 3 || PH == 13) phase_mix(p, F, PH == 3 ? 0 : 1, 1);
                else if constexpr (PH == 9 || PH == 19) phase_peer_u(p, F, PH == 9 ? 0 : 1, true); else phase_peer_v(p, F, PH == 10 ? 0 : 1, true);
#endif
            } else run_phase_fresh<PH>(lds_raw);
            xcd_barrier(bar);
        }
        run_phase_fresh<PH>(lds_raw);
        if constexpr (PH == 0) grid.sync();
        else if constexpr (PH + 1 < NPHASE) { xcd_barrier(bar); if constexpr (PROBE_SYNC) xcd_barrier(bar); }
        run_all<PH + 1>(lds_raw, grid, bar);
    }
}
__global__ void __launch_bounds__(NTHREADS, 2) mega(Params p) {
    extern __shared__ __attribute__((aligned(16))) unsigned char lds_raw[];
    cg::grid_group grid = cg::this_grid();
    volatile LAS unsigned* st = (volatile LAS unsigned*)((LAS unsigned char*)lds_raw + LDS_BAR_OFF);
    if (threadIdx.x < 2) st[threadIdx.x] = 0u;
    __syncthreads();
    const XcdBarrier bar = xcd_barrier_post((unsigned*)(p.ws + WS_CTL), st);
    run_all<0>(lds_raw, grid, bar);
}

extern "C" void kernel_launch(void* const* d_in, const int* in_sizes, int n_in, void* d_out, int out_size, void* d_ws, size_t ws_size, hipStream_t stream) {
    static int grid = 0;
    if (grid == 0) {
        if (n_in != 23 || out_size != TL * D || ws_size < WS_END) { fprintf(stderr, "kernel_launch: unexpected shapes (n_in %d out %d ws %zu)\n", n_in, out_size, ws_size); grid = -1; return; }
        int dev = 0, cus = 0, per_cu = 0;
        (void)hipGetDevice(&dev);
        (void)hipDeviceGetAttribute(&cus, hipDeviceAttributeMultiprocessorCount, dev);
        (void)hipFuncSetAttribute((const void*)mega, hipFuncAttributeMaxDynamicSharedMemorySize, LDS_BYTES);
        (void)hipOccupancyMaxActiveBlocksPerMultiprocessor(&per_cu, (const void*)mega, NTHREADS, LDS_BYTES);
        if (per_cu < 1) { fprintf(stderr, "kernel_launch: occupancy query reports %d blocks per CU\n", per_cu); grid = -1; return; }
        grid = cus & ~7;
        if (grid < 8) { fprintf(stderr, "kernel_launch: needs at least 8 CUs\n"); grid = -1; return; }
    }
    if (grid < 0) return;
    (void)hipMemsetAsync((char*)d_ws + WS_CTL, 0, CTL_ZERO_BYTES, stream);
    Params p{};
    for (int i = 0; i < N_IN; ++i) p.in[i] = (const float*)d_in[i];
    p.out = (float*)d_out; p.ws = (unsigned char*)d_ws;
    void* args[] = {&p};
    hipError_t e = hipLaunchCooperativeKernel((const void*)mega, dim3(grid), dim3(NTHREADS), args, LDS_BYTES, stream);
    if (e != hipSuccess) fprintf(stderr, "cooperative launch failed: %s (grid %d)\n", hipGetErrorString(e), grid);
}
```

```cpp
#include <hip/hip_runtime.h>
#include <hip/hip_cooperative_groups.h>
#include <stdint.h>
#include <stdio.h>
namespace cg = cooperative_groups;

#ifndef PROBE_PH
#define PROBE_PH -1
#endif
#ifndef PROBE_SYNC
#define PROBE_SYNC 0
#endif
#ifndef MK_SINGLE
#define MK_SINGLE 0
#endif

#define LAS __attribute__((address_space(3)))
typedef unsigned short bf16_t;
typedef short bf16x8 __attribute__((ext_vector_type(8)));
typedef short s16x4 __attribute__((ext_vector_type(4)));
typedef float f32x4 __attribute__((ext_vector_type(4)));
typedef float f32x2 __attribute__((ext_vector_type(2)));
typedef float f32x16 __attribute__((ext_vector_type(16)));
typedef unsigned u32x4 __attribute__((ext_vector_type(4)));
typedef unsigned u32x2 __attribute__((ext_vector_type(2)));
typedef __bf16 bf16x2_t __attribute__((ext_vector_type(2)));
typedef _Float16 f16x2_t __attribute__((ext_vector_type(2)));
#define DI __device__ __forceinline__
DI unsigned pkh2(float lo, float hi) { f16x2_t v = {(_Float16)lo, (_Float16)hi}; return __builtin_bit_cast(unsigned, v); }
#define MFMA32(a, b, c) __builtin_amdgcn_mfma_f32_32x32x16_bf16((a), (b), (c), 0, 0, 0)

constexpr int D = 1024, NB = 8, SEQ = 4096, NCTX = 256, DEPTH = 2;
constexpr int TL = NB * SEQ, TC = NB * NCTX, T = TL + TC;
constexpr int INW = 4608, NMOD = 6 * D, PW = 1600, PN = 1536;
constexpr int VTS = SEQ + 64;
constexpr int QOFF = 0, KOFF = 512, VOFF = 640, POOLOFF = 768, SUOFF = 1024, SVOFF = 1280, GATEOFF = 1536;
constexpr int NEXP = 16384;
constexpr float EPS = 1e-6f;
constexpr float LOG2E = 1.4426950408889634f;
constexpr float QSCALE = 0.125f * LOG2E;

constexpr size_t MiB = 1u << 20;
constexpr size_t WS_CTL = 0, WS_MOD = 1 * MiB, CTL_ZERO_BYTES = 2 * MiB;
constexpr size_t WS_ROPE = 2 * MiB, WS_SGUW = 2 * MiB + 65536, WS_TSCALE = 3 * MiB;
constexpr size_t WS_WIN = 4 * MiB, WS_WBR = 22 * MiB, WS_WOUT = 26 * MiB, WS_WFOLD = 30 * MiB;
constexpr size_t WS_XCTX = 38 * MiB, WS_UTAB = 46 * MiB, WS_VTAB = 78 * MiB;
constexpr size_t WS_IDX = 110 * MiB, WS_GW = 120 * MiB;
constexpr size_t WS_H = 142 * MiB;
constexpr size_t WS_P = 210 * MiB, WS_Y = 318 * MiB, WS_MERGED = 386 * MiB, WS_VT = 454 * MiB, WS_VTC = 463 * MiB, WS_VST = 464 * MiB;
constexpr size_t WS_ST = 210 * MiB, WS_H8 = 346 * MiB, WS_HS = 380 * MiB, WS_SU = 482 * MiB;
constexpr size_t WS_END = 512 * MiB;
static_assert(WS_ST + (size_t)2048 * T * 2 <= WS_H8 && WS_H8 + (size_t)T * D <= WS_HS, "ST / H8 fit");
static_assert(WS_VST + (size_t)272 * 256 * 128 * 2 <= WS_SU && WS_VT + (size_t)NB * 2 * 64 * VTS * 2 <= WS_VTC, "VsT / VT fit");
static_assert(WS_H + (size_t)T * D * 2 <= WS_P, "H fits");
static_assert(WS_P + (size_t)T * PW * 2 <= WS_Y && WS_Y + (size_t)T * D * 2 <= WS_MERGED && WS_MERGED + (size_t)T * D * 2 <= WS_VT, "P/Y/MERGED fit");
static_assert(WS_IDX + (size_t)T * 128 * 2 <= WS_GW && WS_GW + (size_t)T * 128 * 4 <= WS_H && WS_SU + (size_t)T * 128 * 4 <= WS_END && WS_HS + (size_t)T * 4 <= WS_SU, "idx/gw/su fit");

constexpr int LDS_BYTES = 147456;
constexpr int NTHREADS = 512, NWAVES = 8;

enum { I_x, I_c, I_ctx, I_c_ctx, I_w_mod, I_b_mod, I_g_mix, I_g_ffn, I_w_in, I_attn_sink, I_pool_w, I_pool_scale, I_sgu_w, I_sgu_b, I_w_br_attn, I_w_br_pool, I_w_br_sgu, I_w_out, I_peer_wq, I_peer_subkeys, I_peer_u, I_peer_v, I_g_final, N_IN };
struct Params {
    const float* in[N_IN];
    float* out; unsigned char* ws;
    int ph_lo, ph_hi;
};

DI unsigned f2bf(float f) { unsigned u = __builtin_bit_cast(unsigned, f); return (u + 0x7fffu + ((u >> 16) & 1u)) >> 16; }
DI unsigned pk2(float lo, float hi) { return f2bf(lo) | (f2bf(hi) << 16); }
DI float bf2f(unsigned short u) { return __builtin_bit_cast(float, (unsigned)u << 16); }
DI float bflo(unsigned w) { return __builtin_bit_cast(float, w << 16); }
DI float bfhi(unsigned w) { return __builtin_bit_cast(float, w & 0xffff0000u); }
DI int crow(int reg, int h) { return (reg & 3) + 8 * (reg >> 2) + 4 * h; }
DI float wave_sum(float v) {
#pragma unroll
    for (int o = 1; o < 64; o <<= 1) v += __shfl_xor(v, o);
    return v;
}
DI float sigmoidf_(float x) { return 1.0f / (1.0f + __expf(-x)); }
DI float gelu_tanh(float x) { const float u = 0.7978845608028654f * (x + 0.044715f * x * x * x); return x / (1.0f + __expf(-2.0f * u)); }
DI float silu_(float x) { return x / (1.0f + __expf(-x)); }

struct Frame {
    int tid, lane, wave, gw, ngw, gtid, ngt, bid, nb;
    LAS unsigned char* lds;
};

template <int NM, int NN>
DI void wave_gemm(const bf16_t* __restrict__ A, int lda, const bf16_t* __restrict__ Bt, int ldb, int K, int m0, int n0, f32x16 (&acc)[NM][NN], int lane) {
    const int r = lane & 31, h = lane >> 5;
    const bf16_t* ap = A + (size_t)(m0 + r) * lda + 8 * h;
    const bf16_t* bp = Bt + (size_t)(n0 + r) * ldb + 8 * h;
    for (int k0 = 0; k0 < K; k0 += 64) {
        bf16x8 a[4][NM], b[4][NN];
#pragma unroll
        for (int s = 0; s < 4; ++s) {
#pragma unroll
            for (int i = 0; i < NM; ++i) a[s][i] = *(const bf16x8*)(ap + (size_t)(32 * i) * lda + k0 + 16 * s);
#pragma unroll
            for (int j = 0; j < NN; ++j) b[s][j] = *(const bf16x8*)(bp + (size_t)(32 * j) * ldb + k0 + 16 * s);
        }
#pragma unroll
        for (int s = 0; s < 4; ++s)
#pragma unroll
            for (int i = 0; i < NM; ++i)
#pragma unroll
                for (int j = 0; j < NN; ++j) acc[i][j] = MFMA32(a[s][i], b[s][j], acc[i][j]);
    }
}
template <int NM, int NN> DI void zero_acc(f32x16 (&acc)[NM][NN]) {
#pragma unroll
    for (int i = 0; i < NM; ++i)
#pragma unroll
        for (int j = 0; j < NN; ++j)
#pragma unroll
            for (int r = 0; r < 16; ++r) acc[i][j][r] = 0.f;
}

namespace pg8 {
constexpr int BM = 256, BK = 64, HALF = 128, HTB = HALF * BK * 2, STAGE_BYTES = 8 * HTB, NXCD = 8, WGM = 8, LD = 1024;
DI int lds_byte(int r, int c) { const int st = (r >> 4) * 2 + (c >> 5), rr = r & 15, cc = c & 31, ob = rr * 64 + cc * 2; return st * 1024 + (ob ^ (((ob >> 9) & 1) << 5)); }
DI void stage_rc(int b, int& R, int& C) { const int st = b / 1024, sb = b % 1024, swz = sb ^ (((sb >> 9) & 1) << 5); R = (st >> 1) * 16 + swz / 64; C = (st & 1) * 32 + (swz % 64) / 2; }
DI int perm32(int rho) { const int n = rho >> 4, i = rho & 15; return 8 * (i >> 2) + 4 * n + (i & 3); }
struct Unit { int pm, pn, sub, nt; const char* a; const char* b; };
DI void tile_of(int L, int nM, int nN, int& pm, int& pn) {
    const int nwg = nM * nN; int wgid = L;
    { const int q = nwg / NXCD, r = nwg % NXCD, xcd = wgid % NXCD, off = wgid / NXCD; wgid = (xcd < r ? xcd * (q + 1) : r * (q + 1) + (xcd - r) * q) + off; }
    const int nig = WGM * nN, gid = wgid / nig, fm = gid * WGM, gsz = (nM - fm) < WGM ? (nM - fm) : WGM;
    pm = fm + ((wgid % nig) % gsz); pn = (wgid % nig) / gsz;
}
template <class Epi, class Sched>
DI void gemm_phase(LAS unsigned char* lds, const int tid, const Sched& S, const Epi& E) {
    const int wid = __builtin_amdgcn_readfirstlane(tid >> 6), lane = tid & 63, wr = wid >> 2, wc = wid & 3, fr = lane & 15, fq = lane >> 4;
    unsigned voffA[2], voffB[2];
#pragma unroll
    for (int i = 0; i < 2; ++i) { int R, C; stage_rc(tid * 16 + i * 8192, R, C); const int Rb = Epi::PERM ? ((R & ~31) + perm32(R & 31)) : R;
        voffA[i] = (unsigned)(R * LD + C) * 2u; voffB[i] = (unsigned)(Rb * LD + C) * 2u; }
    const size_t kstep = (size_t)(BK * 2);
    const size_t hstep = (size_t)HALF * LD * 2;
    const unsigned ldsw = (unsigned)wid * 1024u;
    const int aoff = lds_byte(wr * 64 + fr, fq * 8), boff = lds_byte(wc * 32 + fr, fq * 8);
#define PG8_SA(b, h) (((b) * 2 + (h)) * HTB)
#define PG8_SB(b, h) ((4 + (b) * 2 + (h)) * HTB)
#define PG8_STAGE(bufoff, gbase, voff) do { _Pragma("unroll") for (int _i = 0; _i < 2; ++_i) \
        __builtin_amdgcn_global_load_lds((const unsigned*)((const char*)(gbase) + (voff)[_i]), (LAS unsigned*)(lds + (bufoff) + ldsw + _i * 8192), 16, 0, 0); } while (0)
#define PG8_LDA(dst, b, h) do { _Pragma("unroll") for (int m = 0; m < 4; ++m) _Pragma("unroll") for (int k = 0; k < 2; ++k) dst[m][k] = *(const LAS bf16x8*)(lds + PG8_SA(b, h) + aoff + m * 2048 + k * 1024); } while (0)
#define PG8_LDB(dst, b, h) do { _Pragma("unroll") for (int n = 0; n < 2; ++n) _Pragma("unroll") for (int k = 0; k < 2; ++k) dst[n][k] = *(const LAS bf16x8*)(lds + PG8_SB(b, h) + boff + n * 2048 + k * 1024); } while (0)
#define PG8_MMA(ai, bj, At, Bt) do { __builtin_amdgcn_s_setprio(1); _Pragma("unroll") for (int m = 0; m < 4; ++m) _Pragma("unroll") for (int n = 0; n < 2; ++n) _Pragma("unroll") for (int k = 0; k < 2; ++k) \
        acc[ai][bj][m][n] = __builtin_amdgcn_mfma_f32_16x16x32_bf16(Bt[n][k], At[m][k], acc[ai][bj][m][n], 0, 0, 0); __builtin_amdgcn_s_setprio(0); } while (0)
#define PG8_WAIT_V(n) asm volatile("s_waitcnt vmcnt(" #n ")" ::: "memory")
#define PG8_WAIT_L(n) asm volatile("s_waitcnt lgkmcnt(" #n ")" ::: "memory")
#define PG8_BAR __builtin_amdgcn_s_barrier()
#define PG8_SCHED __builtin_amdgcn_sched_barrier(0)
    Unit cur, nxt; int ui = 0;
    if (!S.next(0, cur)) return;
    f32x4 acc[2][2][4][2];
#pragma unroll
    for (int a = 0; a < 2; ++a)
#pragma unroll
        for (int b = 0; b < 2; ++b)
#pragma unroll
            for (int m = 0; m < 4; ++m)
#pragma unroll
                for (int n = 0; n < 2; ++n) acc[a][b][m][n] = (f32x4){0.f, 0.f, 0.f, 0.f};
    bf16x8 At[4][2], B0[2][2], B1[2][2];
    const char* cA = cur.a; const char* cB = cur.b;
    PG8_STAGE(PG8_SB(0, 0), cB, voffB); PG8_STAGE(PG8_SB(0, 1), cB + hstep, voffB); PG8_STAGE(PG8_SA(0, 0), cA, voffA); PG8_STAGE(PG8_SA(0, 1), cA + hstep, voffA);
    if (wr == 1) PG8_BAR;
    PG8_WAIT_V(2); PG8_BAR;
    PG8_STAGE(PG8_SB(1, 0), cB + kstep, voffB); PG8_STAGE(PG8_SA(1, 0), cA + kstep, voffA); PG8_STAGE(PG8_SB(1, 1), cB + hstep + kstep, voffB);
    PG8_WAIT_V(6); PG8_BAR;
    for (;;) {
        const bool has_next = S.next(ui + 1, nxt);
        const char* nA = has_next ? nxt.a : cA; const char* nB = has_next ? nxt.b : cB;
        const int nt = cur.nt;
        for (int t = 0; t < nt; t += 2) {
            const bool last = (t == nt - 2);
            const char* a1 = cA + (size_t)(t + 1) * kstep;
            const char* a2 = last ? nA : cA + (size_t)(t + 2) * kstep; const char* b2 = last ? nB : cB + (size_t)(t + 2) * kstep;
            const char* a3 = a2 + kstep; const char* b3 = b2 + kstep;
            PG8_LDB(B0, 0, 0); PG8_LDB(B1, 0, 1); PG8_SCHED; PG8_LDA(At, 0, 0); PG8_STAGE(PG8_SA(1, 1), a1 + hstep, voffA);
            PG8_WAIT_V(8); PG8_WAIT_L(0); PG8_BAR; PG8_MMA(0, 0, At, B0); PG8_MMA(0, 1, At, B1); PG8_BAR; PG8_SCHED;
            PG8_LDA(At, 0, 1); PG8_STAGE(PG8_SB(0, 0), b2, voffB); PG8_STAGE(PG8_SB(0, 1), b2 + hstep, voffB); PG8_STAGE(PG8_SA(0, 0), a2, voffA);
            PG8_WAIT_V(8); PG8_WAIT_L(0); PG8_BAR; PG8_MMA(1, 0, At, B0); PG8_MMA(1, 1, At, B1); PG8_BAR; PG8_SCHED;
            PG8_LDB(B0, 1, 0); PG8_LDB(B1, 1, 1); PG8_SCHED; PG8_LDA(At, 1, 0); PG8_STAGE(PG8_SA(0, 1), a2 + hstep, voffA);
            PG8_WAIT_V(8); PG8_WAIT_L(0); PG8_BAR; PG8_MMA(0, 0, At, B0); PG8_MMA(0, 1, At, B1); PG8_BAR; PG8_SCHED;
            PG8_LDA(At, 1, 1); PG8_STAGE(PG8_SB(1, 0), b3, voffB); PG8_STAGE(PG8_SB(1, 1), b3 + hstep, voffB); PG8_STAGE(PG8_SA(1, 0), a3, voffA);
            PG8_WAIT_V(8); PG8_WAIT_L(0); PG8_BAR; PG8_MMA(1, 0, At, B0); PG8_MMA(1, 1, At, B1); PG8_BAR; PG8_SCHED;
        }
        if (wr == 0) PG8_BAR;
        E(acc, cur, wr, wc, fr, fq);
        if (!has_next) break;
#pragma unroll
        for (int a = 0; a < 2; ++a)
#pragma unroll
            for (int b = 0; b < 2; ++b)
#pragma unroll
                for (int m = 0; m < 4; ++m)
#pragma unroll
                    for (int n = 0; n < 2; ++n) acc[a][b][m][n] = (f32x4){0.f, 0.f, 0.f, 0.f};
        cur = nxt; cA = nA; cB = nB; ++ui;
        if (wr == 1) PG8_BAR;
    }
    PG8_WAIT_V(0);
    PG8_BAR;
#undef PG8_SA
#undef PG8_SB
#undef PG8_STAGE
#undef PG8_LDA
#undef PG8_LDB
#undef PG8_MMA
#undef PG8_WAIT_V
#undef PG8_WAIT_L
#undef PG8_BAR
#undef PG8_SCHED
}
}

DI void transpose_item(const float* W, int K, int N, bf16_t* WT, int ldd, int row_off, int col_off, LAS float* scr, int item, int lane) {
    const int nblk = N / 32, kb = item / nblk, nb = item % nblk, k0 = 64 * kb, n0 = 32 * nb;
#pragma unroll 8
    for (int i = 0; i < 32; ++i) { const int kk = 2 * i + (lane >> 5); scr[kk * 33 + (lane & 31)] = W[(size_t)(k0 + kk) * N + n0 + (lane & 31)]; }
    asm volatile("s_waitcnt lgkmcnt(0)" ::: "memory");
    const int c = lane & 7;
#pragma unroll
    for (int j = 0; j < 4; ++j) { const int n = (lane >> 3) + 8 * j; const LAS float* s = scr + (8 * c) * 33 + n;
        u32x4 o; o.x = pk2(s[0 * 33], s[1 * 33]); o.y = pk2(s[2 * 33], s[3 * 33]); o.z = pk2(s[4 * 33], s[5 * 33]); o.w = pk2(s[6 * 33], s[7 * 33]);
        *(u32x4*)(WT + (size_t)(row_off + n0 + n) * ldd + col_off + k0 + 8 * c) = o; }
    asm volatile("s_waitcnt lgkmcnt(0)" ::: "memory");
}

DI void convert_tables(const Params& p, const Frame& F) {
    for (int it = F.gw; it < 4 * NEXP; it += F.ngw) {
        const int e = it & (NEXP - 1), tbl = (it >> 14) & 1, l = it >> 15;
        const f32x4* src = (const f32x4*)((tbl ? p.in[I_peer_v] : p.in[I_peer_u]) + ((size_t)l * NEXP + e) * D) + 4 * F.lane;
        f32x4 v[4]; float am = 0.f;
#pragma unroll
        for (int j = 0; j < 4; ++j) { v[j] = src[j]; am = fmaxf(am, fmaxf(fmaxf(fabsf(v[j].x), fabsf(v[j].y)), fmaxf(fabsf(v[j].z), fabsf(v[j].w)))); }
#pragma unroll
        for (int o = 1; o < 64; o <<= 1) am = fmaxf(am, __shfl_xor(am, o));
        const float sc = (am > 0.f) ? exp2f(floorf(log2f(224.0f / am))) : 1.0f;
        u32x4 q;
#pragma unroll
        for (int j = 0; j < 4; ++j) { int w = 0; w = __builtin_amdgcn_cvt_pk_fp8_f32(v[j].x * sc, v[j].y * sc, w, false); w = __builtin_amdgcn_cvt_pk_fp8_f32(v[j].z * sc, v[j].w * sc, w, true); q[j] = (unsigned)w; }
        *(u32x4*)(p.ws + (tbl ? WS_VTAB : WS_UTAB) + ((size_t)l * NEXP + e) * D + 16 * F.lane) = q;
        if (F.lane == 0) ((float*)(p.ws + WS_TSCALE))[(l * 2 + tbl) * NEXP + e] = 1.0f / sc;
    }
}

DI void phase_prep(const Params& p, const Frame& F) {
    unsigned char* ws = p.ws;
    {
        LAS float* wq = (LAS float*)F.lds;
        for (int it = F.bid; it < 2 * 16 * 16; it += F.nb) {
            const int cc = it & 15, hp = (it >> 4) & 15, l = it >> 8;
            const float* src = p.in[I_peer_wq] + (size_t)l * D * 2048 + hp * 128;
            __syncthreads();
            for (int e = F.tid; e < 64 * 128; e += NTHREADS) { const int ci = e >> 7, d = e & 127; wq[d * 65 + ci] = src[(size_t)(cc * 64 + ci) * 2048 + d]; }
            __syncthreads();
            const int ci = F.tid & 63, kg = F.tid >> 6;
            const float* sk = p.in[I_peer_subkeys] + ((size_t)(l * 16 + hp) * 128 + 16 * kg) * 128;
            float acc[16];
#pragma unroll
            for (int k = 0; k < 16; ++k) acc[k] = 0.f;
            for (int d = 0; d < 128; ++d) { const float w = wq[d * 65 + ci];
#pragma unroll
                for (int k = 0; k < 16; ++k) acc[k] += w * sk[k * 128 + d]; }
            bf16_t* dst = (bf16_t*)(ws + WS_WFOLD) + ((size_t)l * 2048 + hp * 128 + 16 * kg) * D + cc * 64 + ci;
#pragma unroll
            for (int k = 0; k < 16; ++k) dst[(size_t)k * D] = (bf16_t)f2bf(acc[k]);
        }
        __syncthreads();
    }
    {
        LAS float* scr = (LAS float*)(F.lds + F.wave * 16384);
        constexpr int I_IN = (D / 64) * (INW / 32), I_BA = (512 / 64) * (D / 32), I_BS = (256 / 64) * (D / 32), I_O = (D / 64) * (D / 32);
        constexpr int PER_L = I_IN + I_BA + I_BS + I_O;
        for (int it = F.gw; it < 2 * PER_L; it += F.ngw) {
            const int l = it / PER_L; int r = it % PER_L;
            if (r < I_IN) { transpose_item(p.in[I_w_in] + (size_t)l * D * INW, D, INW, (bf16_t*)(ws + WS_WIN) + (size_t)l * INW * D, D, 0, 0, scr, r, F.lane); continue; } r -= I_IN;
            if (r < I_BA) { transpose_item(p.in[I_w_br_attn] + (size_t)l * 512 * D, 512, D, (bf16_t*)(ws + WS_WBR) + (size_t)l * D * D, D, 0, 0, scr, r, F.lane); continue; } r -= I_BA;
            if (r < I_BS) { transpose_item(p.in[I_w_br_sgu] + (size_t)l * 256 * D, 256, D, (bf16_t*)(ws + WS_WBR) + (size_t)l * D * D, D, 0, 768, scr, r, F.lane); continue; } r -= I_BS;
            transpose_item(p.in[I_w_out] + (size_t)l * D * D, D, D, (bf16_t*)(ws + WS_WOUT) + (size_t)l * D * D, D, 0, 0, scr, r, F.lane);
        }
    }
    for (int i = F.gtid; i < 2 * 256 * D; i += F.ngt) {
        const int n = i & 1023, rc = (i >> 10) & 255, l = i >> 18, g = rc >> 6;
        const float* pw = p.in[I_pool_w] + ((size_t)l * 256 + rc) * 64;
        const float* ps = p.in[I_pool_scale] + l * 256 + 64 * g;
        const float* wb = p.in[I_w_br_pool] + ((size_t)l * 256 + 64 * g) * D + n;
        float a = 0.f;
        for (int e = 0; e < 64; ++e) a += pw[e] * ps[e] * wb[(size_t)e * D];
        ((bf16_t*)(ws + WS_WBR))[(size_t)l * D * D + (size_t)n * D + 512 + rc] = (bf16_t)f2bf(a);
    }
    for (int i = F.gtid; i < 2 * 4 * 128 * 128; i += F.ngt) ((bf16_t*)(ws + WS_SGUW))[i] = (bf16_t)f2bf(p.in[I_sgu_w][i]);
    for (int i = F.gtid; i < 64 * 16; i += F.ngt) {
        const int pos = i >> 4, fi = i & 15;
        const float inv = powf(10000.0f, -(float)fi / 16.0f);
        const float ang = (float)pos * inv;
        ((f32x2*)(ws + WS_ROPE))[i] = (f32x2){cosf(ang), sinf(ang)};
    }
    convert_tables(p, F);
    {
        float* MOD = (float*)(ws + WS_MOD);
        LAS float* scd = (LAS float*)F.lds;
        LAS float* red = scd + 9 * D;
        __syncthreads();
        for (int e = F.tid; e < 9 * D; e += NTHREADS) { const int r = e >> 10, k = e & 1023; scd[e] = silu_((r < 8) ? p.in[I_c][r * D + k] : p.in[I_c_ctx][k]); }
        __syncthreads();
        for (int it = F.bid; it < 2 * 96; it += F.nb) {
            const int cgp = it % 96, l = it / 96, col = cgp * 64 + F.lane;
            float acc[9];
#pragma unroll
            for (int r = 0; r < 9; ++r) acc[r] = 0.f;
            const float* wp = p.in[I_w_mod] + ((size_t)l * D + F.wave * 128) * NMOD + col;
#pragma unroll 4
            for (int k = 0; k < 128; ++k) {
                const float w = wp[(size_t)k * NMOD];
#pragma unroll
                for (int r = 0; r < 9; ++r) acc[r] += scd[r * D + F.wave * 128 + k] * w;
            }
#pragma unroll
            for (int r = 0; r < 9; ++r) red[(F.wave * 9 + r) * 64 + F.lane] = acc[r];
            __syncthreads();
            for (int e = F.tid; e < 9 * 64; e += NTHREADS) {
                const int r = e >> 6, ln = e & 63; float s = p.in[I_b_mod][l * NMOD + cgp * 64 + ln];
#pragma unroll
                for (int w = 0; w < 8; ++w) s += red[(w * 9 + r) * 64 + ln];
                MOD[((size_t)l * 9 + r) * NMOD + cgp * 64 + ln] = s;
            }
            __syncthreads();
        }
    }
}

DI const float* mod_vec(const Params& p, int l, int row, int j) {
    const int r = row < TL ? row / SEQ : 8;
    return (const float*)(p.ws + WS_MOD) + ((size_t)l * 9 + r) * NMOD + j * D;
}
DI float* xrow_ptr(const Params& p, int row) { return row < TL ? p.out + (size_t)row * D : (float*)(p.ws + WS_XCTX) + (size_t)(row - TL) * D; }
DI const float* xin_ptr(const Params& p, int row) { return row < TL ? p.in[I_x] + (size_t)row * D : p.in[I_ctx] + (size_t)(row - TL) * D; }

DI void modulate_row_wave(const float* src, const float* g, const float* sh, const float* sc, bf16_t* dst, int lane, unsigned char* h8 = nullptr, float* hs = nullptr) {
    f32x4 v[4]; float ss = 0.f;
#pragma unroll
    for (int j = 0; j < 4; ++j) { v[j] = ((const f32x4*)src)[lane + 64 * j]; ss += v[j].x * v[j].x + v[j].y * v[j].y + v[j].z * v[j].z + v[j].w * v[j].w; }
    const float rinv = rsqrtf(wave_sum(ss) * (1.0f / D) + EPS);
    float am = 0.f;
#pragma unroll
    for (int j = 0; j < 4; ++j) {
        const f32x4 gg = ((const f32x4*)g)[lane + 64 * j], s1 = ((const f32x4*)sh)[lane + 64 * j], s2 = ((const f32x4*)sc)[lane + 64 * j];
        const f32x4 o = v[j] * rinv * gg * (s2 + 1.0f) + s1;
        u32x2 w; w.x = pk2(o.x, o.y); w.y = pk2(o.z, o.w);
        ((u32x2*)dst)[lane + 64 * j] = w;
        v[j] = o; am = fmaxf(am, fmaxf(fmaxf(fabsf(o.x), fabsf(o.y)), fmaxf(fabsf(o.z), fabsf(o.w))));
    }
    if (h8) {
#pragma unroll
        for (int o = 1; o < 64; o <<= 1) am = fmaxf(am, __shfl_xor(am, o));
        const float scl = (am > 0.f) ? exp2f(floorf(log2f(224.0f / am))) : 1.0f;
#pragma unroll
        for (int j = 0; j < 4; ++j) { int w = 0; w = __builtin_amdgcn_cvt_pk_fp8_f32(v[j].x * scl, v[j].y * scl, w, false); w = __builtin_amdgcn_cvt_pk_fp8_f32(v[j].z * scl, v[j].w * scl, w, true);
            ((unsigned*)h8)[lane + 64 * j] = (unsigned)w; }
        if (lane == 0) *hs = 1.0f / scl;
    }
}

DI void phase_norm(const Params& p, const Frame& F, int l, int which  , bool from_input, int nrows) {
    const float* g = (which == 0 ? p.in[I_g_mix] : p.in[I_g_ffn]) + l * D;
    for (int row = F.gw; row < nrows; row += F.ngw) {
        const float* src = from_input ? xin_ptr(p, row) : xrow_ptr(p, row);
        modulate_row_wave(src, g, mod_vec(p, l, row, which * 3 + 0), mod_vec(p, l, row, which * 3 + 1), (bf16_t*)(p.ws + WS_H) + (size_t)row * D, F.lane,
                          nullptr, nullptr);
    }
}
DI void phase_final(const Params& p, const Frame& F) {
    for (int row = F.gw; row < TL; row += F.ngw) {
        f32x4* xr = (f32x4*)(p.out + (size_t)row * D);
        f32x4 v[4]; float ss = 0.f;
#pragma unroll
        for (int j = 0; j < 4; ++j) { v[j] = xr[F.lane + 64 * j]; ss += v[j].x * v[j].x + v[j].y * v[j].y + v[j].z * v[j].z + v[j].w * v[j].w; }
        const float rinv = rsqrtf(wave_sum(ss) * (1.0f / D) + EPS);
#pragma unroll
        for (int j = 0; j < 4; ++j) xr[F.lane + 64 * j] = v[j] * rinv * ((const f32x4*)p.in[I_g_final])[F.lane + 64 * j];
    }
}

DI void g1_epilogue(const Params& p, int l, const f32x16& acc, int row0, int col0, int lane) {
    const int h = lane >> 5, w = lane & 31, col = col0 + w;
    bf16_t* P = (bf16_t*)(p.ws + WS_P);
    if (col0 < VOFF) {
        const float sc = (col0 < KOFF) ? QSCALE : 1.0f;
        const int axis = (col0 >> 5) & 1, fi = w & 15;
        const f32x2* tab = (const f32x2*)(p.ws + WS_ROPE);
#pragma unroll
        for (int r = 0; r < 16; ++r) {
            const int row = row0 + crow(r, h);
            const float own = acc[r], oth = __shfl_xor(own, 16);
            float o = own;
            if (row < TL) {
                const int t = row & (SEQ - 1), pos = axis ? (t & 63) : (t >> 6);
                const f32x2 cs = tab[pos * 16 + fi];
                o = (w < 16) ? (own * cs.x - oth * cs.y) : (own * cs.x + oth * cs.y);
            }
            P[(size_t)row * PW + col] = (bf16_t)f2bf(o * sc);
        }
    } else if (col0 < POOLOFF) {
        const int hk = (col - VOFF) >> 6, d = (col - VOFF) & 63;
#pragma unroll
        for (int r = 0; r < 16; ++r) {
            const int row = row0 + crow(r, h);
            const bf16_t v = (bf16_t)f2bf(acc[r]);
            if (row < TL) { const int b = row / SEQ, t = row & (SEQ - 1); ((bf16_t*)(p.ws + WS_VT))[((size_t)(b * 2 + hk) * 64 + d) * VTS + t] = v; }
            else { const int rc = row - TL, b = rc / NCTX, j = rc & (NCTX - 1); ((bf16_t*)(p.ws + WS_VTC))[((size_t)(b * 2 + hk) * 64 + d) * NCTX + j] = v; }
        }
    } else if (col0 < SUOFF) {
#pragma unroll
        for (int r = 0; r < 16; ++r) { const int row = row0 + crow(r, h); P[(size_t)row * PW + col] = (bf16_t)f2bf(acc[r]); }
    } else if (col0 < SVOFF) {
#pragma unroll
        for (int r = 0; r < 16; ++r) { const int row = row0 + crow(r, h); P[(size_t)row * PW + col] = (bf16_t)f2bf(gelu_tanh(acc[r])); }
    } else {
        const int c = col - SVOFF;
#pragma unroll
        for (int r = 0; r < 16; ++r) { const int row = row0 + crow(r, h); const int chunk = row >> 7, q = row & 127;
            ((bf16_t*)(p.ws + WS_VST))[((size_t)chunk * 256 + c) * 128 + q] = (bf16_t)f2bf(gelu_tanh(acc[r])); }
    }
}

DI void g1_simple(const Params& p, const Frame& F, int l, int row_lo, int nrows, int ct_lo, int nct) {
    const bf16_t* H = (const bf16_t*)(p.ws + WS_H);
    const bf16_t* W = (const bf16_t*)(p.ws + WS_WIN) + (size_t)l * INW * D;
    const int nit = (nrows / 64) * nct;
    for (int it = F.gw; it < nit; it += F.ngw) {
        const int mt = it / nct, nt = ct_lo + it % nct, m0 = row_lo + mt * 64;
        f32x16 acc[2][1]; zero_acc(acc);
        wave_gemm<2, 1>(H, D, W, D, D, m0, nt * 32, acc, F.lane);
#pragma unroll 1
        for (int i = 0; i < 2; ++i) g1_epilogue(p, l, i == 0 ? acc[0][0] : acc[1][0], m0 + 32 * i, nt * 32, F.lane);
    }
}

struct EpiG1 {
    static constexpr bool PERM = true;
    unsigned char* ws;
    DI void operator()(const f32x4 (&acc)[2][2][4][2], const pg8::Unit& u, int wr, int wc, int fr, int fq) const {
        bf16_t* P = (bf16_t*)(ws + WS_P);
        const int rbase = u.pm * 256 + wr * 64 + fr;
#pragma unroll
        for (int ai = 0; ai < 2; ++ai)
#pragma unroll
            for (int m = 0; m < 4; ++m) {
                const int row = rbase + 128 * ai + 16 * m;
#pragma unroll
                for (int bj = 0; bj < 2; ++bj) {
                    const int c0 = u.pn * 256 + 128 * bj + 32 * wc + 8 * fq;
                    float v[8];
#pragma unroll
                    for (int j = 0; j < 4; ++j) { v[j] = acc[ai][bj][m][0][j]; v[4 + j] = acc[ai][bj][m][1][j]; }
                    if (c0 < VOFF) {
                        const float sc = (c0 < KOFF) ? QSCALE : 1.0f;
                        const int t = row & (SEQ - 1), pos = (wc & 1) ? (t & 63) : (t >> 6);
                        const f32x4* tab = (const f32x4*)(ws + WS_ROPE) + (pos * 16 + 8 * (fq & 1)) / 2;
                        u32x4 o;
#pragma unroll
                        for (int j2 = 0; j2 < 4; ++j2) {
                            const f32x4 cs = tab[j2];
                            const float o0 = __shfl_xor(v[2 * j2], 32), o1 = __shfl_xor(v[2 * j2 + 1], 32);
                            const float r0 = (fq < 2) ? (v[2 * j2] * cs.x - o0 * cs.y) : (v[2 * j2] * cs.x + o0 * cs.y);
                            const float r1 = (fq < 2) ? (v[2 * j2 + 1] * cs.z - o1 * cs.w) : (v[2 * j2 + 1] * cs.z + o1 * cs.w);
                            o[j2] = pk2(r0 * sc, r1 * sc);
                        }
                        *(u32x4*)(P + (size_t)row * PW + c0) = o;
                    } else if (c0 < POOLOFF) {
                        const int hk = wc >> 1, d0 = 32 * (wc & 1) + 8 * fq, b = row / SEQ, t = row & (SEQ - 1);
                        bf16_t* vt = (bf16_t*)(ws + WS_VT) + ((size_t)(b * 2 + hk) * 64 + d0) * VTS + t;
#pragma unroll
                        for (int j = 0; j < 8; ++j) vt[(size_t)j * VTS] = (bf16_t)f2bf(v[j]);
                    } else if (c0 < SUOFF) {
                        u32x4 o;
#pragma unroll
                        for (int j2 = 0; j2 < 4; ++j2) o[j2] = pk2(v[2 * j2], v[2 * j2 + 1]);
                        *(u32x4*)(P + (size_t)row * PW + c0) = o;
                    } else if (c0 < SVOFF) {
                        u32x4 o;
#pragma unroll
                        for (int j2 = 0; j2 < 4; ++j2) o[j2] = pk2(gelu_tanh(v[2 * j2]), gelu_tanh(v[2 * j2 + 1]));
                        *(u32x4*)(P + (size_t)row * PW + c0) = o;
                    } else {
                        const int c = c0 - SVOFF, chunk = row >> 7, q = row & 127;
                        bf16_t* vs = (bf16_t*)(ws + WS_VST) + ((size_t)chunk * 256 + c) * 128 + q;
#pragma unroll
                        for (int j = 0; j < 8; ++j) vs[j * 128] = (bf16_t)f2bf(gelu_tanh(v[j]));
                    }
                }
                asm volatile("" ::: "memory");
            }
    }
};
struct SchedGrid {
    int nM, nN, G, c; const char* A; const char* B;
    DI bool next(int i, pg8::Unit& u) const {
        const int L = i * G + c; if (L >= nM * nN) return false;
        pg8::tile_of(L, nM, nN, u.pm, u.pn); u.sub = 0; u.nt = D / 64;
        u.a = A + (size_t)u.pm * 256 * D * 2; u.b = B + (size_t)u.pn * 256 * D * 2; return true;
    }
};

DI void phase_g1(const Params& p, const Frame& F, int l) {
    SchedGrid S{TL / 256, PN / 256, F.nb, F.bid, (const char*)(p.ws + WS_H), (const char*)(p.ws + WS_WIN) + (size_t)l * INW * D * 2};
    EpiG1 E{p.ws};
    pg8::gemm_phase(F.lds, F.tid, S, E);
    if (l == 0) g1_simple(p, F, l, TL, TC, 0, PN / 32);
    else g1_simple(p, F, l, TL, TC, 16, 8);
}

DI bf16x8 pack8(const f32x16& x, int s) {
    u32x4 pk;
#pragma unroll
    for (int j = 0; j < 4; ++j) { f32x2 v = {x[8 * s + 2 * j], x[8 * s + 2 * j + 1]}; pk[j] = __builtin_bit_cast(unsigned, __builtin_convertvector(v, bf16x2_t)); }
    return __builtin_bit_cast(bf16x8, pk);
}

struct AttnFrags { bf16x8 kf[4]; s16x4 vf[2][4]; };
DI void attn_load(AttnFrags& f, const bf16_t* kptr, const bf16_t* vptr, size_t vstride_d32) {
#pragma unroll
    for (int s = 0; s < 4; ++s) f.kf[s] = *(const bf16x8*)(kptr + 16 * s);
#pragma unroll
    for (int d = 0; d < 2; ++d)
#pragma unroll
        for (int q = 0; q < 4; ++q) f.vf[d][q] = *(const s16x4*)(vptr + (size_t)d * vstride_d32 + 8 * q);
}
DI void attn_block(const bf16x8 (&qf)[4], const AttnFrags& f, int mask_mode, int kq_off, int lane, float& m, float& lpart, f32x16 (&o)[2]) {
    const int h = lane >> 5;
    f32x16 st;
#pragma unroll
    for (int r = 0; r < 16; ++r) st[r] = 0.f;
#pragma unroll
    for (int s = 0; s < 4; ++s) st = MFMA32(f.kf[s], qf[s], st);
    if (mask_mode) {
#pragma unroll
        for (int r = 0; r < 16; ++r) { const int dlt = kq_off + crow(r, h); if (dlt > 128 || dlt < -128) st[r] = -1e30f; }
    }
    float bm = st[0];
#pragma unroll
    for (int r = 1; r < 16; ++r) bm = fmaxf(bm, st[r]);
    bm = fmaxf(bm, __shfl_xor(bm, 32));
    const float mn = fmaxf(m, bm), alpha = exp2f(m - mn);
    m = mn;
    float ps = 0.f;
#pragma unroll
    for (int r = 0; r < 16; ++r) { st[r] = exp2f(st[r] - mn); ps += st[r]; }
    lpart = lpart * alpha + ps;
#pragma unroll
    for (int d = 0; d < 2; ++d)
#pragma unroll
        for (int r = 0; r < 16; ++r) o[d][r] *= alpha;
    const bf16x8 pf0 = pack8(st, 0), pf1 = pack8(st, 1);
#pragma unroll
    for (int d = 0; d < 2; ++d) {
        const bf16x8 v0 = __builtin_shufflevector(f.vf[d][0], f.vf[d][1], 0, 1, 2, 3, 4, 5, 6, 7), v1 = __builtin_shufflevector(f.vf[d][2], f.vf[d][3], 0, 1, 2, 3, 4, 5, 6, 7);
        o[d] = MFMA32(v0, pf0, o[d]);
        o[d] = MFMA32(v1, pf1, o[d]);
    }
}

DI void attn_task(const Params& p, int l, int task, int lane) {
    const int r = lane & 31, h = lane >> 5;
    const bf16_t* P = (const bf16_t*)(p.ws + WS_P);
    const bf16_t* VT = (const bf16_t*)(p.ws + WS_VT);
    const bf16_t* VTC = (const bf16_t*)(p.ws + WS_VTC);
    bf16_t* Y = (bf16_t*)(p.ws + WS_Y);
    const bool latent = task < 8192;
    int b, head, qb, q0row, p0;
    if (latent) { qb = task & 127; head = (task >> 7) & 7; b = task >> 10; p0 = qb * 32; q0row = b * SEQ + p0; }
    else { const int t2 = task - 8192; qb = t2 & 7; head = (t2 >> 3) & 7; b = t2 >> 6; p0 = qb * 32; q0row = TL + b * NCTX + p0; }
    const int hk = head >> 2;
    bf16x8 qf[4];
#pragma unroll
    for (int s = 0; s < 4; ++s) qf[s] = *(const bf16x8*)(P + (size_t)(q0row + r) * PW + head * 64 + 16 * s + 8 * h);
    float m = p.in[I_attn_sink][l * 8 + head] * LOG2E, lpart = (h == 0) ? 1.0f : 0.0f;
    f32x16 o[2];
#pragma unroll
    for (int d = 0; d < 2; ++d)
#pragma unroll
        for (int i = 0; i < 16; ++i) o[d][i] = 0.f;
    const int kb_lo = max(p0 - 128, 0), kb_hi = min(p0 + 128, SEQ - 32);
    const int nwin = latent ? ((kb_hi - kb_lo) >> 5) + 1 : 0, nblk = nwin + 8;
    const bf16_t* kwin = P + (size_t)(b * SEQ + r) * PW + KOFF + hk * 64 + 8 * h;
    const bf16_t* vwin = VT + ((size_t)(b * 2 + hk) * 64 + r) * VTS + 4 * h;
    const bf16_t* kctx = P + (size_t)(TL + b * NCTX + r) * PW + KOFF + hk * 64 + 8 * h;
    const bf16_t* vctx = VTC + ((size_t)(b * 2 + hk) * 64 + r) * NCTX + 4 * h;
    AttnFrags f0, f1, f2;
#define ATT_LOAD(F_, jj) do { const int j_ = min((jj), nblk - 1); \
        if (j_ < nwin) { const int kb_ = kb_lo + 32 * j_; attn_load(F_, kwin + (size_t)kb_ * PW, vwin + kb_, (size_t)32 * VTS); } \
        else { const int kb_ = 32 * (j_ - nwin); attn_load(F_, kctx + (size_t)kb_ * PW, vctx + kb_, (size_t)32 * NCTX); } } while (0)
#define ATT_COMP(F_, jj) do { const int j_ = (jj); if (j_ < nblk) { int mm_ = 0, kq_ = 0; \
        if (j_ < nwin) { const int kb_ = kb_lo + 32 * j_; mm_ = (kb_ == p0 - 128 || kb_ == p0 + 128) ? 1 : 0; kq_ = kb_ - (p0 + r); } \
        attn_block(qf, F_, mm_, kq_, lane, m, lpart, o); } } while (0)
    ATT_LOAD(f0, 0); ATT_LOAD(f1, 1);
#pragma unroll 1
    for (int j = 0; j < nblk; j += 3) {
        ATT_LOAD(f2, j + 2); ATT_COMP(f0, j);
        ATT_LOAD(f0, j + 3); ATT_COMP(f1, j + 1);
        ATT_LOAD(f1, j + 4); ATT_COMP(f2, j + 2);
    }
#undef ATT_LOAD
#undef ATT_COMP
    const float inv = 1.0f / (lpart + __shfl_xor(lpart, 32));
    bf16_t* yrow = Y + (size_t)(q0row + r) * D + head * 64;
#pragma unroll
    for (int d = 0; d < 2; ++d)
#pragma unroll
        for (int g = 0; g < 4; ++g) {
            u32x2 w; w.x = pk2(o[d][4 * g] * inv, o[d][4 * g + 1] * inv); w.y = pk2(o[d][4 * g + 2] * inv, o[d][4 * g + 3] * inv);
            *(u32x2*)(yrow + 32 * d + 8 * g + 4 * h) = w;
        }
}

DI void sgu_unit(const Params& p, const Frame& F, int l, int chunk) {
    constexpr int VS = 136;
    LAS float* part = (LAS float*)F.lds;
    LAS float* rq = part + 512;
    LAS bf16_t* vnT = (LAS bf16_t*)(F.lds + 4096);
    const bf16_t* VsT = (const bf16_t*)(p.ws + WS_VST) + (size_t)chunk * 256 * 128;
    const bf16_t* P = (const bf16_t*)(p.ws + WS_P);
    bf16_t* Y = (bf16_t*)(p.ws + WS_Y);
    __syncthreads();
    { const int q = F.tid & 127, part_i = F.tid >> 7; float ss = 0.f;
        for (int c = part_i * 64; c < part_i * 64 + 64; ++c) { const float v = bf2f(VsT[c * 128 + q]); ss += v * v; }
        part[part_i * 128 + q] = ss; }
    __syncthreads();
    if (F.tid < 128) rq[F.tid] = rsqrtf((part[F.tid] + part[128 + F.tid] + part[256 + F.tid] + part[384 + F.tid]) * (1.0f / 256.0f) + EPS);
    __syncthreads();
    for (int i = F.tid; i < 256 * 16; i += NTHREADS) {
        const int c = i >> 4, q8 = (i & 15) * 8;
        const u32x4 v = *(const u32x4*)(VsT + c * 128 + q8);
        u32x4 o;
#pragma unroll
        for (int j = 0; j < 4; ++j) o[j] = pk2(bflo(v[j]) * rq[q8 + 2 * j], bfhi(v[j]) * rq[q8 + 2 * j + 1]);
        *(LAS u32x4*)(vnT + c * VS + q8) = o;
    }
    __syncthreads();
    const int lane = F.lane, r = lane & 31, h = lane >> 5, g = F.wave >> 1, ph = F.wave & 1;
    const bf16_t* Wg = (const bf16_t*)(p.ws + WS_SGUW) + ((size_t)l * 4 + g) * 128 * 128;
#pragma unroll 1
    for (int pb = 0; pb < 2; ++pb) {
        const int p0 = 64 * ph + 32 * pb;
#pragma unroll 1
        for (int cb = 0; cb < 2; ++cb) {
            const int c0 = 64 * g + 32 * cb;
            f32x16 acc;
#pragma unroll
            for (int i = 0; i < 16; ++i) acc[i] = 0.f;
#pragma unroll
            for (int s = 0; s < 8; ++s) {
                const bf16x8 a = *(const LAS bf16x8*)(vnT + (c0 + r) * VS + 16 * s + 8 * h);
                const bf16x8 b = *(const bf16x8*)(Wg + (size_t)(p0 + r) * 128 + 16 * s + 8 * h);
                acc = MFMA32(a, b, acc);
            }
            const int row = chunk * 128 + p0 + r;
            const float bias = p.in[I_sgu_b][(l * 4 + g) * 128 + p0 + r];
#pragma unroll
            for (int q4 = 0; q4 < 4; ++q4) {
                const int cc = c0 + 8 * q4 + 4 * h;
                const u32x2 u = *(const u32x2*)(P + (size_t)row * PW + SUOFF + cc);
                u32x2 w;
                w.x = pk2(bflo(u.x) * (acc[4 * q4] + bias), bfhi(u.x) * (acc[4 * q4 + 1] + bias));
                w.y = pk2(bflo(u.y) * (acc[4 * q4 + 2] + bias), bfhi(u.y) * (acc[4 * q4 + 3] + bias));
                *(u32x2*)(Y + (size_t)row * D + 768 + cc) = w;
            }
        }
    }
}

DI void phase_mix(const Params& p, const Frame& F, int l, int ctr_slot = 0) {
    const int nrows = (l == 0) ? T : TL;
    const bf16_t* P = (const bf16_t*)(p.ws + WS_P);
    bf16_t* Y = (bf16_t*)(p.ws + WS_Y);
    for (int i = F.gtid; i < nrows * 32; i += F.ngt) {
        const int row = i >> 5, ck = i & 31, g = ck >> 3, half = 1 << g;
        int base, t, len;
        if (row < TL) { base = row & ~(SEQ - 1); t = row & (SEQ - 1); len = SEQ; } else { const int rc = row - TL; base = TL + (rc & ~(NCTX - 1)); t = rc & (NCTX - 1); len = NCTX; }
        const int lo = max(t - half, 0), hi = min(t + half, len);
        float s[8];
#pragma unroll
        for (int j = 0; j < 8; ++j) s[j] = 0.f;
        for (int tt = lo; tt < hi; ++tt) {
            const u32x4 v = *(const u32x4*)(P + (size_t)(base + tt) * PW + POOLOFF + ck * 8);
#pragma unroll
            for (int j = 0; j < 4; ++j) { s[2 * j] += bflo(v[j]); s[2 * j + 1] += bfhi(v[j]); }
        }
        const float inv = 1.0f / (float)(hi - lo);
        const u32x4 z = *(const u32x4*)(P + (size_t)row * PW + POOLOFF + ck * 8);
        u32x4 o;
#pragma unroll
        for (int j = 0; j < 4; ++j) o[j] = pk2(s[2 * j] * inv - bflo(z[j]), s[2 * j + 1] * inv - bfhi(z[j]));
        *(u32x4*)(Y + (size_t)row * D + 512 + ck * 8) = o;
    }
    const int nchunk = (l == 0) ? T / 128 : TL / 128;
    for (int ch = F.bid; ch < nchunk; ch += F.nb) sgu_unit(p, F, l, ch);
    const int ntask = (l == 0) ? 8192 + 512 : 8192;
    unsigned* ctr = (unsigned*)(p.ws + WS_CTL) + 16384 + 64 * (l + 2 * ctr_slot);
    for (;;) {
        unsigned t = 0;
        if (F.lane == 0) t = atomicAdd(ctr, 1u);
        const int task = (int)__builtin_amdgcn_readfirstlane(t);
        if (task >= ntask) break;
        attn_task(p, l, task, F.lane);
    }
}

DI void g2_simple(const Params& p, const Frame& F, int l, int row_lo, int nrows) {
    const bf16_t* H = (const bf16_t*)(p.ws + WS_H);
    const bf16_t* Yb = (const bf16_t*)(p.ws + WS_Y);
    const bf16_t* Wg = (const bf16_t*)(p.ws + WS_WIN) + (size_t)l * INW * D + (size_t)GATEOFF * D;
    const bf16_t* Wb = (const bf16_t*)(p.ws + WS_WBR) + (size_t)l * D * D;
    bf16_t* M = (bf16_t*)(p.ws + WS_MERGED);
    const int nit = (nrows / 64) * (D / 32);
    for (int it = F.gw; it < nit; it += F.ngw) {
        const int mt = it / (D / 32), nt = it % (D / 32), m0 = row_lo + mt * 64, n0 = nt * 32;
        f32x16 tot[2][1]; zero_acc(tot);
#pragma unroll 1
        for (int i = 0; i < 3; ++i) {
            const int koff = (i == 0) ? 0 : (i == 1 ? 512 : 768), kk = (i == 0) ? 512 : 256;
            f32x16 g[2][1], pr[2][1]; zero_acc(g); zero_acc(pr);
            wave_gemm<2, 1>(H, D, Wg + (size_t)i * D * D, D, D, m0, n0, g, F.lane);
            wave_gemm<2, 1>(Yb + koff, D, Wb + koff, D, kk, m0, n0, pr, F.lane);
#pragma unroll
            for (int a = 0; a < 2; ++a)
#pragma unroll
                for (int r = 0; r < 16; ++r) tot[a][0][r] += sigmoidf_(g[a][0][r]) * pr[a][0][r];
        }
        const int h = F.lane >> 5, col = n0 + (F.lane & 31);
#pragma unroll
        for (int a = 0; a < 2; ++a)
#pragma unroll
            for (int r = 0; r < 16; ++r) M[(size_t)(m0 + 32 * a + crow(r, h)) * D + col] = (bf16_t)f2bf(tot[a][0][r]);
    }
}
struct SchedG2 {
    int G, c; const char *H, *Y, *Wg, *Wb;
    DI bool next(int i, pg8::Unit& u) const {
        const int tile = (i / 6) * G + c; if (tile >= (TL / 256) * 4) return false;
        const int sub = i % 6, br = sub >> 1;
        pg8::tile_of(tile, TL / 256, 4, u.pm, u.pn); u.sub = sub;
        if ((sub & 1) == 0) { u.nt = 16; u.a = H + (size_t)u.pm * 256 * D * 2; u.b = Wg + ((size_t)br * D + u.pn * 256) * D * 2; }
        else { const int koff = (br == 0) ? 0 : (br == 1 ? 512 : 768); u.nt = (br == 0) ? 8 : 4;
               u.a = Y + ((size_t)u.pm * 256 * D + koff) * 2; u.b = Wb + ((size_t)u.pn * 256 * D + koff) * 2; }
        return true;
    }
};
struct EpiG2 {
    static constexpr bool PERM = true;
    bf16_t* scr; bf16_t* M;
    DI void operator()(const f32x4 (&acc)[2][2][4][2], const pg8::Unit& u, int wr, int wc, int fr, int fq) const {
#pragma unroll
        for (int ai = 0; ai < 2; ++ai)
#pragma unroll
            for (int m = 0; m < 4; ++m) {
                const int rl = 128 * ai + 64 * wr + 16 * m + fr;
#pragma unroll
                for (int bj = 0; bj < 2; ++bj) {
                    const int cl = 128 * bj + 32 * wc + 8 * fq;
                    float v[8];
#pragma unroll
                    for (int j = 0; j < 4; ++j) { v[j] = acc[ai][bj][m][0][j]; v[4 + j] = acc[ai][bj][m][1][j]; }
                    u32x4* sp = (u32x4*)(scr + rl * 256 + cl);
                    if ((u.sub & 1) == 0) {
                        u32x4 o;
#pragma unroll
                        for (int j2 = 0; j2 < 4; ++j2) o[j2] = pk2(sigmoidf_(v[2 * j2]), sigmoidf_(v[2 * j2 + 1]));
                        *sp = o;
                    } else {
                        const u32x4 g = *sp;
                        u32x4* mp = (u32x4*)(M + (size_t)(u.pm * 256 + rl) * D + u.pn * 256 + cl);
                        float o[8];
#pragma unroll
                        for (int j2 = 0; j2 < 4; ++j2) { o[2 * j2] = bflo(g[j2]) * v[2 * j2]; o[2 * j2 + 1] = bfhi(g[j2]) * v[2 * j2 + 1]; }
                        if (u.sub > 1) { const u32x4 old = *mp;
#pragma unroll
                            for (int j2 = 0; j2 < 4; ++j2) { o[2 * j2] += bflo(old[j2]); o[2 * j2 + 1] += bfhi(old[j2]); } }
                        u32x4 w;
#pragma unroll
                        for (int j2 = 0; j2 < 4; ++j2) w[j2] = pk2(o[2 * j2], o[2 * j2 + 1]);
                        *mp = w;
                    }
                }
                asm volatile("" ::: "memory");
            }
    }
};
DI void phase_g2(const Params& p, const Frame& F, int l) {
    SchedG2 S{F.nb, F.bid, (const char*)(p.ws + WS_H), (const char*)(p.ws + WS_Y),
              (const char*)(p.ws + WS_WIN) + ((size_t)l * INW + GATEOFF) * D * 2, (const char*)(p.ws + WS_WBR) + (size_t)l * D * D * 2};
    EpiG2 E{(bf16_t*)(p.ws + WS_IDX) + (size_t)F.bid * 65536, (bf16_t*)(p.ws + WS_MERGED)};
    pg8::gemm_phase(F.lds, F.tid, S, E);
    if (l == 0) g2_simple(p, F, l, TL, TC);
}

DI void g3_simple(const Params& p, const Frame& F, int l, int row_lo, int nrows) {
    const bf16_t* M = (const bf16_t*)(p.ws + WS_MERGED);
    const bf16_t* W = (const bf16_t*)(p.ws + WS_WOUT) + (size_t)l * D * D;
    const int nit = (nrows / 64) * (D / 64);
    for (int it = F.gw; it < nit; it += F.ngw) {
        const int mt = it / (D / 64), nt = it % (D / 64), m0 = row_lo + mt * 64, n0 = nt * 64;
        f32x16 acc[2][2]; zero_acc(acc);
        wave_gemm<2, 2>(M, D, W, D, D, m0, n0, acc, F.lane);
        const int h = F.lane >> 5;
#pragma unroll
        for (int a = 0; a < 2; ++a)
#pragma unroll
            for (int j = 0; j < 2; ++j) {
                const int col = n0 + 32 * j + (F.lane & 31);
#pragma unroll
                for (int r = 0; r < 16; ++r) {
                    const int row = m0 + 32 * a + crow(r, h);
                    const float xs = (l == 0) ? xin_ptr(p, row)[col] : xrow_ptr(p, row)[col];
                    xrow_ptr(p, row)[col] = xs + mod_vec(p, l, row, 2)[col] * acc[a][j][r];
                }
            }
    }
}
struct EpiG3 {
    static constexpr bool PERM = false;
    const float* xsrc; float* xdst; const float* mod;
    DI void operator()(const f32x4 (&acc)[2][2][4][2], const pg8::Unit& u, int wr, int wc, int fr, int fq) const {
        const int col0 = u.pn * 256 + wc * 32 + 4 * fq;
        const float* gt = mod + (size_t)(u.pm >> 4) * NMOD + 2 * D;
#pragma unroll
        for (int ai = 0; ai < 2; ++ai)
#pragma unroll
            for (int m = 0; m < 4; ++m) {
                const size_t off = (size_t)(u.pm * 256 + wr * 64 + fr + 128 * ai + 16 * m) * D;
#pragma unroll
                for (int bj = 0; bj < 2; ++bj)
#pragma unroll
                    for (int n = 0; n < 2; ++n) {
                        const int c = col0 + 128 * bj + 16 * n;
                        const f32x4 xv = *(const f32x4*)(xsrc + off + c), gv = *(const f32x4*)(gt + c);
                        *(f32x4*)(xdst + off + c) = xv + gv * acc[ai][bj][m][n];
                    }
                asm volatile("" ::: "memory");
            }
    }
};
DI void phase_g3(const Params& p, const Frame& F, int l) {
    SchedGrid S{TL / 256, D / 256, F.nb, F.bid, (const char*)(p.ws + WS_MERGED), (const char*)(p.ws + WS_WOUT) + (size_t)l * D * D * 2};
    EpiG3 E{(l == 0) ? p.in[I_x] : p.out, p.out, (const float*)(p.ws + WS_MOD) + (size_t)l * 9 * NMOD};
    pg8::gemm_phase(F.lds, F.tid, S, E);
    if (l == 0) g3_simple(p, F, l, TL, TC);
}

DI void g45_simple(const Params& p, const Frame& F, int l, int row_lo, int nrows) {
    const bf16_t* H = (const bf16_t*)(p.ws + WS_H);
    const bf16_t* W = (const bf16_t*)(p.ws + WS_WFOLD) + (size_t)l * 2048 * D;
    _Float16* ST = (_Float16*)(p.ws + WS_ST);
    const int nit = (2048 / 64) * (nrows / 64);
    for (int it = F.gw; it < nit; it += F.ngw) {
        const int nt = it / 32, mt = it % 32, m0 = mt * 64, n0 = row_lo + nt * 64;
        f32x16 acc[2][2]; zero_acc(acc);
        wave_gemm<2, 2>(W, D, H, D, D, m0, n0, acc, F.lane);
        const int h = F.lane >> 5;
#pragma unroll
        for (int a = 0; a < 2; ++a)
#pragma unroll
            for (int j = 0; j < 2; ++j)
#pragma unroll
                for (int r = 0; r < 16; ++r) ST[(size_t)(m0 + 32 * a + crow(r, h)) * T + n0 + 32 * j + (F.lane & 31)] = (_Float16)acc[a][j][r];
    }
}
struct EpiG45 {
    static constexpr bool PERM = true;
    unsigned short* ST;
    DI void operator()(const f32x4 (&acc)[2][2][4][2], const pg8::Unit& u, int wr, int wc, int fr, int fq) const {
        const int col0 = u.pn * 256 + wc * 32 + 8 * fq;
#pragma unroll
        for (int ai = 0; ai < 2; ++ai)
#pragma unroll
            for (int m = 0; m < 4; ++m) {
                unsigned short* rowp = ST + (size_t)(u.pm * 256 + wr * 64 + fr + 128 * ai + 16 * m) * T + col0;
#pragma unroll
                for (int bj = 0; bj < 2; ++bj) {
                    u32x4 w;
                    w.x = pkh2(acc[ai][bj][m][0][0], acc[ai][bj][m][0][1]); w.y = pkh2(acc[ai][bj][m][0][2], acc[ai][bj][m][0][3]);
                    w.z = pkh2(acc[ai][bj][m][1][0], acc[ai][bj][m][1][1]); w.w = pkh2(acc[ai][bj][m][1][2], acc[ai][bj][m][1][3]);
                    *(u32x4*)(rowp + 128 * bj) = w;
                }
            }
    }
};
DI void phase_g45(const Params& p, const Frame& F, int l) {
    SchedGrid S{2048 / 256, TL / 256, F.nb, F.bid, (const char*)(p.ws + WS_WFOLD) + (size_t)l * 2048 * D * 2, (const char*)(p.ws + WS_H)};
    EpiG45 E{(unsigned short*)(p.ws + WS_ST)};
    pg8::gemm_phase(F.lds, F.tid, S, E);
    if (l == 0) g45_simple(p, F, l, TL, TC);
}

DI unsigned fkey(float f) { const unsigned u = __builtin_bit_cast(unsigned, f); return (u & 0x80000000u) ? ~u : (u | 0x80000000u); }
DI float fkey_inv(unsigned k) { const unsigned u = (k & 0x80000000u) ? (k & 0x7fffffffu) : ~k; return __builtin_bit_cast(float, u); }
#define INSERT16(L, x) do { unsigned x_ = (x); _Pragma("unroll") for (int k_ = 0; k_ < 16; ++k_) { const unsigned hi_ = max(L[k_], x_); x_ = min(L[k_], x_); L[k_] = hi_; } } while (0)

DI void phase_sel(const Params& p, const Frame& F, int l) {
    const _Float16* ST = (const _Float16*)(p.ws + WS_ST);
    unsigned short* IDX = (unsigned short*)(p.ws + WS_IDX);
    float* GW = (float*)(p.ws + WS_GW);
    float* SU = (float*)(p.ws + WS_SU);
    const float* TSC = (const float*)(p.ws + WS_TSCALE) + (size_t)l * 2 * NEXP;
    LAS unsigned char* ib = (LAS unsigned char*)F.lds;
    const int ntok = (l == 0) ? T : TL;
    for (int i0 = F.bid * NTHREADS; i0 < ntok * 8; i0 += F.nb * NTHREADS) {
        const int i = i0 + F.tid;
        const int tok = i % ntok, head = i / ntok;
        unsigned la[16], lb[16];
#pragma unroll
        for (int k = 0; k < 16; ++k) { la[k] = 0u; lb[k] = 0u; }
        const _Float16* s0 = ST + (size_t)(head * 256) * T + tok;
#pragma unroll 1
        for (int k0 = 0; k0 < 256; k0 += 32) {
            float buf[32];
#pragma unroll
            for (int j = 0; j < 32; ++j) buf[j] = (float)s0[(size_t)(k0 + j) * T];
            if (k0 < 128) {
#pragma unroll
                for (int j = 0; j < 32; ++j) { const unsigned key = (fkey(buf[j]) & ~127u) | (unsigned)(127 - ((k0 + j) & 127)); INSERT16(la, key); }
            } else {
#pragma unroll
                for (int j = 0; j < 32; ++j) { const unsigned key = (fkey(buf[j]) & ~127u) | (unsigned)(127 - ((k0 + j) & 127)); INSERT16(lb, key); }
            }
        }
        float va[16], vb[16];
#pragma unroll
        for (int k = 0; k < 16; ++k) {
            va[k] = fkey_inv(la[k] & ~127u); vb[k] = fkey_inv(lb[k] & ~127u);
            ib[k * NTHREADS + F.tid] = (unsigned char)(127u - (la[k] & 127u));
            ib[(16 + k) * NTHREADS + F.tid] = (unsigned char)(127u - (lb[k] & 127u));
        }
        unsigned lc[16];
#pragma unroll
        for (int k = 0; k < 16; ++k) lc[k] = 0u;
#pragma unroll
        for (int a = 0; a < 16; ++a)
#pragma unroll
            for (int b = 0; b < 16; ++b)
                if ((a + 1) * (b + 1) <= 16) { const unsigned key = (fkey(va[a] + vb[b]) & ~255u) | (unsigned)(255 - (a * 16 + b)); INSERT16(lc, key); }
        float e[16], sum = 0.f; const float v0 = fkey_inv(lc[0] & ~255u);
#pragma unroll
        for (int k = 0; k < 16; ++k) { e[k] = __expf(fkey_inv(lc[k] & ~255u) - v0); sum += e[k]; }
        const float inv = 1.0f / sum;
        asm volatile("s_waitcnt lgkmcnt(0)" ::: "memory");
#pragma unroll
        for (int k = 0; k < 16; ++k) {
            const unsigned pos = 255u - (lc[k] & 255u), a = pos >> 4, b = pos & 15u;
            const unsigned ea = ib[a * NTHREADS + F.tid], eb = ib[(16 + b) * NTHREADS + F.tid];
            const unsigned ex = ea * 128u + eb;
            IDX[(size_t)tok * 128 + head * 16 + k] = (unsigned short)ex;
            GW[(size_t)tok * 128 + head * 16 + k] = e[k] * inv * TSC[NEXP + ex];
            SU[(size_t)tok * 128 + head * 16 + k] = TSC[ex];
        }
        asm volatile("s_waitcnt lgkmcnt(0)" ::: "memory");
    }
}

DI float dpp_xor1(float v) { return __builtin_bit_cast(float, __builtin_amdgcn_mov_dpp(__builtin_bit_cast(int, v), 0xB1, 0xF, 0xF, true)); }
DI float dpp_xor2(float v) { return __builtin_bit_cast(float, __builtin_amdgcn_mov_dpp(__builtin_bit_cast(int, v), 0x4E, 0xF, 0xF, true)); }
DI float dpp_hmir(float v) { return __builtin_bit_cast(float, __builtin_amdgcn_mov_dpp(__builtin_bit_cast(int, v), 0x141, 0xF, 0xF, true)); }
DI float dot16_fp8(const u32x4 q, const float (&hx)[16]) {
    f32x2 a = {0.f, 0.f};
#pragma unroll
    for (int j = 0; j < 4; ++j) {
        const f32x2 lo = __builtin_amdgcn_cvt_pk_f32_fp8((int)q[j], false), hi = __builtin_amdgcn_cvt_pk_f32_fp8((int)q[j], true);
        a += lo * (f32x2){hx[4 * j], hx[4 * j + 1]}; a += hi * (f32x2){hx[4 * j + 2], hx[4 * j + 3]};
    }
    return a.x + a.y;
}
#define PEER_EXPERT(id, i) ((int)(((id)[(i) >> 3][((i) >> 1) & 3] >> (16 * ((i) & 1))) & 0xffffu))

struct PeerURows { u32x4 q[16]; u32x4 h0, h1; };
DI void peer_u_rows(PeerURows& R, const u32x4 (&id)[2], const unsigned char* ut, const bf16_t* hrow) {
    R.h0 = *(const u32x4*)(hrow); R.h1 = *(const u32x4*)(hrow + 8);
#pragma unroll
    for (int i = 0; i < 16; ++i) R.q[i] = *(const u32x4*)(ut + (size_t)PEER_EXPERT(id, i) * D);
}
DI void peer_u_compute(const PeerURows& R, float* part, int lane) {
    float hx[16];
#pragma unroll
    for (int j = 0; j < 4; ++j) { hx[2 * j] = bflo(R.h0[j]); hx[2 * j + 1] = bfhi(R.h0[j]); hx[8 + 2 * j] = bflo(R.h1[j]); hx[8 + 2 * j + 1] = bfhi(R.h1[j]); }
    float d[16];
#pragma unroll
    for (int i = 0; i < 16; ++i) d[i] = dot16_fp8(R.q[i], hx);
    const bool b2 = (lane & 4) != 0, b1 = (lane & 2) != 0, b0 = (lane & 1) != 0;
    float k8[8];
#pragma unroll
    for (int i = 0; i < 8; ++i) { const float keep = b2 ? d[8 + i] : d[i], send = b2 ? d[i] : d[8 + i]; k8[i] = keep + dpp_hmir(send); }
    float k4[4];
#pragma unroll
    for (int i = 0; i < 4; ++i) { const float keep = b1 ? k8[4 + i] : k8[i], send = b1 ? k8[i] : k8[4 + i]; k4[i] = keep + dpp_xor2(send); }
    f32x2 k2;
    { const float keep0 = b0 ? k4[2] : k4[0], send0 = b0 ? k4[0] : k4[2], keep1 = b0 ? k4[3] : k4[1], send1 = b0 ? k4[1] : k4[3];
      k2.x = keep0 + dpp_xor1(send0); k2.y = keep1 + dpp_xor1(send1); }
    *(f32x2*)(part + 16 * (lane >> 3) + (b2 ? 8 : 0) + (b1 ? 4 : 0) + (b0 ? 2 : 0)) = k2;
}
DI void phase_peer_u(const Params& p, const Frame& F, int l) {
    const int ntok = (l == 0) ? T : TL, lane = F.lane;
    const int slice = F.bid & 7, sw = (F.bid >> 3) * NWAVES + F.wave, nsw = (F.nb >> 3) * NWAVES;
    const unsigned char* ut = p.ws + WS_UTAB + (size_t)l * NEXP * D + 128 * slice + 16 * (lane & 7);
    const bf16_t* Hs = (const bf16_t*)(p.ws + WS_H) + 128 * slice + 16 * (lane & 7);
    const unsigned short* IDXg = (const unsigned short*)(p.ws + WS_IDX) + 16 * (lane >> 3);
    float* PART = (float*)(p.ws + WS_ST) + (size_t)slice * T * 128;
    const int last = ntok - 1;
    u32x4 sa[2], sb[2]; PeerURows ra, rb;
#define U_SEL(S_, t_) do { const unsigned short* ip_ = IDXg + (size_t)min((t_), last) * 128; S_[0] = *(const u32x4*)ip_; S_[1] = *(const u32x4*)(ip_ + 8); } while (0)
#define U_ROWS(R_, S_, t_) peer_u_rows(R_, S_, ut, Hs + (size_t)min((t_), last) * D)
    U_SEL(sa, sw); U_SEL(sb, sw + nsw);
    U_ROWS(ra, sa, sw);
#pragma unroll 1
    for (int tok = sw; tok < ntok; tok += 2 * nsw) {
        U_SEL(sa, tok + 2 * nsw); U_ROWS(rb, sb, tok + nsw);
        peer_u_compute(ra, PART + (size_t)tok * 128, lane);
        U_SEL(sb, tok + 3 * nsw); U_ROWS(ra, sa, tok + 2 * nsw);
        if (tok + nsw < ntok) peer_u_compute(rb, PART + (size_t)(tok + nsw) * 128, lane);
    }
#undef U_SEL
#undef U_ROWS
}
DI void phase_peer_c(const Params& p, const Frame& F, int l, bool dummy = false) {
    const int ntok = (l == 0) ? T : TL;
    const float* PART = (const float*)(p.ws + WS_ST);
    float* GW = (float*)(p.ws + WS_GW);
    float* CO = dummy ? (float*)(p.ws + WS_H8) : GW;
    const float* SU = (const float*)(p.ws + WS_SU);
    for (int i = F.gtid; i < ntok * 128; i += F.ngt) {
        float s = 0.f;
#pragma unroll
        for (int sl = 0; sl < 8; ++sl) s += PART[(size_t)sl * T * 128 + i];
        CO[i] = GW[i] * gelu_tanh(s * SU[i]);
    }
}
struct PeerVRows { u32x4 q[16]; f32x4 cf[4]; };
DI void peer_v_rows(PeerVRows& R, const u32x4 (&id)[2], const unsigned char* vt, const float* cp) {
    R.cf[0] = *(const f32x4*)cp; R.cf[1] = *(const f32x4*)(cp + 4); R.cf[2] = *(const f32x4*)(cp + 8); R.cf[3] = *(const f32x4*)(cp + 12);
#pragma unroll
    for (int i = 0; i < 16; ++i) R.q[i] = *(const u32x4*)(vt + (size_t)PEER_EXPERT(id, i) * D);
}
DI void peer_v_compute(const PeerVRows& R, float* xsrc, float* xdst, const float* gt2, int lane) {
    f32x2 a[8];
#pragma unroll
    for (int j = 0; j < 8; ++j) a[j] = (f32x2){0.f, 0.f};
#pragma unroll
    for (int i = 0; i < 16; ++i) {
        const float c = R.cf[i >> 2][i & 3]; const f32x2 c2 = {c, c};
#pragma unroll
        for (int j = 0; j < 4; ++j) {
            a[2 * j] += c2 * __builtin_amdgcn_cvt_pk_f32_fp8((int)R.q[i][j], false);
            a[2 * j + 1] += c2 * __builtin_amdgcn_cvt_pk_f32_fp8((int)R.q[i][j], true);
        }
    }
    const int b5 = lane >> 5, b4 = (lane >> 4) & 1, b3 = (lane >> 3) & 1;
    f32x2 k4[4];
#pragma unroll
    for (int j = 0; j < 4; ++j) { const f32x2 keep = b5 ? a[4 + j] : a[j], send = b5 ? a[j] : a[4 + j];
        k4[j] = keep + (f32x2){__shfl_xor(send.x, 32), __shfl_xor(send.y, 32)}; }
    f32x2 k2[2];
#pragma unroll
    for (int j = 0; j < 2; ++j) { const f32x2 keep = b4 ? k4[2 + j] : k4[j], send = b4 ? k4[j] : k4[2 + j];
        k2[j] = keep + (f32x2){__shfl_xor(send.x, 16), __shfl_xor(send.y, 16)}; }
    f32x2 k1;
    { const f32x2 keep = b3 ? k2[1] : k2[0], send = b3 ? k2[0] : k2[1];
        k1 = keep + (f32x2){__shfl_xor(send.x, 8), __shfl_xor(send.y, 8)}; }
    const int co = 16 * (lane & 7) + 8 * b5 + 4 * b4 + 2 * b3;
    *(f32x2*)(xdst + co) = *(const f32x2*)(xsrc + co) + *(const f32x2*)(gt2 + co) * k1;
}
DI void phase_peer_v(const Params& p, const Frame& F, int l, bool dummy = false) {
    const int ntok = (l == 0) ? T : TL, lane = F.lane;
    const int slice = F.bid & 7, sw = (F.bid >> 3) * NWAVES + F.wave, nsw = (F.nb >> 3) * NWAVES;
    const unsigned char* vt = p.ws + WS_VTAB + (size_t)l * NEXP * D + 128 * slice + 16 * (lane & 7);
    const unsigned short* IDXg = (const unsigned short*)(p.ws + WS_IDX) + 16 * (lane >> 3);
    const float* CFg = (const float*)(p.ws + WS_GW) + 16 * (lane >> 3);
    const int last = ntok - 1;
    u32x4 sa[2], sb[2]; PeerVRows ra, rb;
#define V_SEL(S_, t_) do { const unsigned short* ip_ = IDXg + (size_t)min((t_), last) * 128; S_[0] = *(const u32x4*)ip_; S_[1] = *(const u32x4*)(ip_ + 8); } while (0)
#define V_ROWS(R_, S_, t_) peer_v_rows(R_, S_, vt, CFg + (size_t)min((t_), last) * 128)
#define V_DO(R_, t_) do { const int t2_ = (t_); float* xs_ = xrow_ptr(p, t2_) + 128 * slice; \
        float* xd_ = dummy ? (float*)(p.ws + WS_ST) + (size_t)t2_ * D + 128 * slice : xs_; \
        peer_v_compute(R_, xs_, xd_, mod_vec(p, l, t2_, 5) + 128 * slice, lane); } while (0)
    V_SEL(sa, sw); V_SEL(sb, sw + nsw);
    V_ROWS(ra, sa, sw);
#pragma unroll 1
    for (int tok = sw; tok < ntok; tok += 2 * nsw) {
        V_SEL(sa, tok + 2 * nsw); V_ROWS(rb, sb, tok + nsw);
        V_DO(ra, tok);
        V_SEL(sb, tok + 3 * nsw); V_ROWS(ra, sa, tok + 2 * nsw);
        if (tok + nsw < ntok) V_DO(rb, tok + nsw);
    }
#undef V_SEL
#undef V_ROWS
#undef V_DO
}

#define XB_TMO      128
#define XB_XCNT(j)  (256  + 64 * (j))
#define XB_XSUB(j)  (1280 + 64 * (j))
#define XB_XGEN(j)  (2304 + 64 * (j))
#define XB_TOP      3328
#define XB_TOPGEN   3392
#define XCD_BAR_WORDS 3456
#define XB_SPIN_CAP (1u << 18)
DI unsigned xb_ld(unsigned* p)              { return __hip_atomic_load(p, __ATOMIC_RELAXED, __HIP_MEMORY_SCOPE_AGENT); }
DI unsigned xb_add(unsigned* p, unsigned v) { return __hip_atomic_fetch_add(p, v, __ATOMIC_RELAXED, __HIP_MEMORY_SCOPE_AGENT); }
DI unsigned xb_xcc_id() { return (unsigned)__builtin_amdgcn_s_getreg((3 << 11) | 20) & 0xFu; }
#define XB_SPIN(cond, bar) do { unsigned _sp = 0; while (cond) { __builtin_amdgcn_s_sleep(1); \
    if ((++_sp & 255u) == 0u) { if (xb_ld(&(bar)[XB_TMO])) break; if (_sp > XB_SPIN_CAP) { atomicAdd(&(bar)[XB_TMO], 1u); break; } } } } while (0)
struct XcdBarrier { unsigned* bar; unsigned x; volatile LAS unsigned* st; };
DI XcdBarrier xcd_barrier_post(unsigned* bar, volatile LAS unsigned* st) {
    XcdBarrier b; b.bar = bar; b.x = xb_xcc_id(); b.st = st;
    if (threadIdx.x == 0) (void)xb_add(&bar[XB_XCNT(b.x)], 1u);
    return b;
}
DI void xcd_barrier_complete(unsigned* bar, unsigned x, unsigned& nloc, unsigned& nx) {
    const unsigned G = gridDim.x * gridDim.y * gridDim.z;
    unsigned sum, cnt, mine, sp = 0u;
    for (;;) {
        sum = 0u; cnt = 0u; mine = 0u;
#pragma unroll
        for (unsigned j = 0; j < 16; ++j) { const unsigned c = xb_ld(&bar[XB_XCNT(j)]); sum += c; cnt += (c > 0u) ? 1u : 0u; mine = (j == x) ? c : mine; }
        if (sum == G) break;
        __builtin_amdgcn_s_sleep(1);
        if ((++sp & 255u) == 0u) { if (xb_ld(&bar[XB_TMO])) break; if (sp > XB_SPIN_CAP) { atomicAdd(&bar[XB_TMO], 1u); break; } }
    }
    nloc = mine > 0u ? mine : 1u; nx = cnt > 0u ? cnt : 1u;
}
DI void xcd_barrier(const XcdBarrier& b) {
    asm volatile("s_waitcnt vmcnt(0)" ::: "memory");
    __syncthreads();
    if (threadIdx.x == 0) {
        unsigned* bar = b.bar;
        __builtin_amdgcn_s_waitcnt(0);
        unsigned nloc = b.st[0], nx = b.st[1];
        if (nloc == 0u) { xcd_barrier_complete(bar, b.x, nloc, nx); b.st[0] = nloc; b.st[1] = nx; }
        const unsigned old = xb_add(&bar[XB_XSUB(b.x)], 1u);
        const unsigned gen = old / nloc;
        if (old + 1u == (gen + 1u) * nloc) {
            __builtin_amdgcn_fence(__ATOMIC_RELEASE, "agent");
            asm volatile("s_waitcnt vmcnt(0)" ::: "memory");
            const unsigned og = xb_add(&bar[XB_TOP], 1u);
            const unsigned tg = og / nx;
            if (og + 1u == (tg + 1u) * nx) xb_add(&bar[XB_TOPGEN], 1u);
            else XB_SPIN(xb_ld(&bar[XB_TOPGEN]) == tg, bar);
            __builtin_amdgcn_fence(__ATOMIC_ACQUIRE, "agent");
            xb_add(&bar[XB_XGEN(b.x)], 1u);
            asm volatile("s_waitcnt vmcnt(0)" ::: "memory");
        } else {
            XB_SPIN(xb_ld(&bar[XB_XGEN(b.x)]) == gen, bar);
            __builtin_amdgcn_fence(__ATOMIC_ACQUIRE, "agent");
            asm volatile("s_waitcnt vmcnt(0)" ::: "memory");
        }
    }
    __syncthreads();
}
constexpr int LDS_BAR_OFF = 135168;

constexpr int NPHASE = 24;
template <int PH> DI void run_phase(const Params& p, const Frame& F) {
    if constexpr (PH == 0) phase_prep(p, F);
    else if constexpr (PH == 1) phase_norm(p, F, 0, 0, true, T);
    else if constexpr (PH == 2) phase_g1(p, F, 0);
    else if constexpr (PH == 3) phase_mix(p, F, 0);
    else if constexpr (PH == 4) phase_g2(p, F, 0);
    else if constexpr (PH == 5) phase_g3(p, F, 0);
    else if constexpr (PH == 6) phase_norm(p, F, 0, 1, false, T);
    else if constexpr (PH == 7) phase_g45(p, F, 0);
    else if constexpr (PH == 8) phase_sel(p, F, 0);
    else if constexpr (PH == 9) phase_peer_u(p, F, 0);
    else if constexpr (PH == 10) phase_peer_c(p, F, 0);
    else if constexpr (PH == 11) phase_peer_v(p, F, 0);
    else if constexpr (PH == 12) phase_norm(p, F, 1, 0, false, T);
    else if constexpr (PH == 13) phase_g1(p, F, 1);
    else if constexpr (PH == 14) phase_mix(p, F, 1);
    else if constexpr (PH == 15) phase_g2(p, F, 1);
    else if constexpr (PH == 16) phase_g3(p, F, 1);
    else if constexpr (PH == 17) phase_norm(p, F, 1, 1, false, TL);
    else if constexpr (PH == 18) phase_g45(p, F, 1);
    else if constexpr (PH == 19) phase_sel(p, F, 1);
    else if constexpr (PH == 20) phase_peer_u(p, F, 1);
    else if constexpr (PH == 21) phase_peer_c(p, F, 1);
    else if constexpr (PH == 22) phase_peer_v(p, F, 1);
    else if constexpr (PH == 23) phase_final(p, F);
}
DI Frame make_frame(unsigned char* lds_raw) {
    Frame F;
    F.lds = (LAS unsigned char*)lds_raw;
    int tid = threadIdx.x; asm volatile("" : "+v"(tid));
    int bid = blockIdx.x, nb = gridDim.x; asm volatile("" : "+s"(bid), "+s"(nb));
    F.tid = tid; F.lane = tid & 63; F.wave = __builtin_amdgcn_readfirstlane(tid >> 6); F.bid = bid; F.nb = nb;
    F.gw = bid * NWAVES + F.wave; F.ngw = nb * NWAVES; F.gtid = bid * NTHREADS + tid; F.ngt = nb * NTHREADS;
    return F;
}
template <int PH> DI void run_phase_fresh(unsigned char* lds_raw) {
#if defined(__HIP_DEVICE_COMPILE__)
    const __attribute__((address_space(4))) unsigned long long* pp = (const __attribute__((address_space(4))) unsigned long long*)__builtin_amdgcn_kernarg_segment_ptr();
    asm volatile("" : "+s"(pp));
    Params p;
#pragma unroll
    for (int i = 0; i < N_IN; ++i) p.in[i] = (const float*)(const __attribute__((address_space(1))) float*)pp[i];
    p.out = (float*)(__attribute__((address_space(1))) float*)pp[N_IN]; p.ws = (unsigned char*)(__attribute__((address_space(1))) unsigned char*)pp[N_IN + 1]; p.ph_lo = 0; p.ph_hi = 0;
#else
    Params p{};
#endif
    const Frame F = make_frame(lds_raw);
    run_phase<PH>(p, F);
}
template <int PH> __global__ void __launch_bounds__(NTHREADS, 2) phase_kernel(Params p) {
    extern __shared__ __attribute__((aligned(16))) unsigned char lds_raw[];
    run_phase_fresh<PH>(lds_raw);
}
template <int PH> DI void run_all(unsigned char* lds_raw, cg::grid_group& grid, const XcdBarrier& bar) {
    if constexpr (PH < NPHASE) {
        if constexpr (PH == PROBE_PH) {
            if constexpr (PH == 10 || PH == 21 || PH == 11 || PH == 22 || PH == 3 || PH == 14) {
#if defined(__HIP_DEVICE_COMPILE__)
                const __attribute__((address_space(4))) unsigned long long* pp = (const __attribute__((address_space(4))) unsigned long long*)__builtin_amdgcn_kernarg_segment_ptr();
                asm volatile("" : "+s"(pp));
                Params p;
#pragma unroll
                for (int i = 0; i < N_IN; ++i) p.in[i] = (const float*)(const __attribute__((address_space(1))) float*)pp[i];
                p.out = (float*)(__attribute__((address_space(1))) float*)pp[N_IN]; p.ws = (unsigned char*)(__attribute__((address_space(1))) unsigned char*)pp[N_IN + 1]; p.ph_lo = 0; p.ph_hi = 0;
                const Frame F = make_frame(lds_raw);
                if constexpr (PH == 3 || PH == 14) phase_mix(p, F, PH == 3 ? 0 : 1, 1);
                else if constexpr (PH == 10 || PH == 21) phase_peer_c(p, F, PH == 10 ? 0 : 1, true); else phase_peer_v(p, F, PH == 11 ? 0 : 1, true);
#endif
            } else run_phase_fresh<PH>(lds_raw);
            xcd_barrier(bar);
        }
        run_phase_fresh<PH>(lds_raw);
        if constexpr (PH == 0) grid.sync();
        else if constexpr (PH + 1 < NPHASE) { xcd_barrier(bar); if constexpr (PROBE_SYNC) xcd_barrier(bar); }
        run_all<PH + 1>(lds_raw, grid, bar);
    }
}
__global__ void __launch_bounds__(NTHREADS, 2) mega(Params p) {
    extern __shared__ __attribute__((aligned(16))) unsigned char lds_raw[];
    cg::grid_group grid = cg::this_grid();
    volatile LAS unsigned* st = (volatile LAS unsigned*)((LAS unsigned char*)lds_raw + LDS_BAR_OFF);
    if (threadIdx.x < 2) st[threadIdx.x] = 0u;
    __syncthreads();
    const XcdBarrier bar = xcd_barrier_post((unsigned*)(p.ws + WS_CTL), st);
    run_all<0>(lds_raw, grid, bar);
}

extern "C" void kernel_launch(void* const* d_in, const int* in_sizes, int n_in, void* d_out, int out_size, void* d_ws, size_t ws_size, hipStream_t stream) {
    static int grid = 0;
    if (grid == 0) {
        if (n_in != 23 || out_size != TL * D || ws_size < WS_END) { fprintf(stderr, "kernel_launch: unexpected shapes (n_in %d out %d ws %zu)\n", n_in, out_size, ws_size); grid = -1; return; }
        int dev = 0, cus = 0, per_cu = 0;
        (void)hipGetDevice(&dev);
        (void)hipDeviceGetAttribute(&cus, hipDeviceAttributeMultiprocessorCount, dev);
        (void)hipFuncSetAttribute((const void*)mega, hipFuncAttributeMaxDynamicSharedMemorySize, LDS_BYTES);
        (void)hipOccupancyMaxActiveBlocksPerMultiprocessor(&per_cu, (const void*)mega, NTHREADS, LDS_BYTES);
        if (per_cu < 1) { fprintf(stderr, "kernel_launch: occupancy query reports %d blocks per CU\n", per_cu); grid = -1; return; }
        grid = cus & ~7;
        if (grid < 8) { fprintf(stderr, "kernel_launch: needs at least 8 CUs\n"); grid = -1; return; }
    }
    if (grid < 0) return;
    (void)hipMemsetAsync((char*)d_ws + WS_CTL, 0, CTL_ZERO_BYTES, stream);
    Params p{};
    for (int i = 0; i < N_IN; ++i) p.in[i] = (const float*)d_in[i];
    p.out = (float*)d_out; p.ws = (unsigned char*)d_ws;
    void* args[] = {&p};
    hipError_t e = hipLaunchCooperativeKernel((const void*)mega, dim3(grid), dim3(NTHREADS), args, LDS_BYTES, stream);
    if (e != hipSuccess) fprintf(stderr, "cooperative launch failed: %s (grid %d)\n", hipGetErrorString(e), grid);
}
```

```cpp
#include <hip/hip_runtime.h>
#include <hip/hip_cooperative_groups.h>
#include <stdint.h>
#include <stdio.h>
namespace cg = cooperative_groups;

#ifndef PROBE_PH
#define PROBE_PH -1
#endif
#ifndef PROBE_SYNC
#define PROBE_SYNC 0
#endif
#ifndef MK_SINGLE
#define MK_SINGLE 0
#endif

#define LAS __attribute__((address_space(3)))
typedef unsigned short bf16_t;
typedef short bf16x8 __attribute__((ext_vector_type(8)));
typedef short s16x4 __attribute__((ext_vector_type(4)));
typedef float f32x4 __attribute__((ext_vector_type(4)));
typedef float f32x2 __attribute__((ext_vector_type(2)));
typedef float f32x16 __attribute__((ext_vector_type(16)));
typedef unsigned u32x4 __attribute__((ext_vector_type(4)));
typedef unsigned u32x2 __attribute__((ext_vector_type(2)));
typedef __bf16 bf16x2_t __attribute__((ext_vector_type(2)));
typedef _Float16 f16x2_t __attribute__((ext_vector_type(2)));
#define DI __device__ __forceinline__
DI unsigned pkh2(float lo, float hi) { f16x2_t v = {(_Float16)lo, (_Float16)hi}; return __builtin_bit_cast(unsigned, v); }
#define MFMA32(a, b, c) __builtin_amdgcn_mfma_f32_32x32x16_bf16((a), (b), (c), 0, 0, 0)

constexpr int D = 1024, NB = 8, SEQ = 4096, NCTX = 256, DEPTH = 2;
constexpr int TL = NB * SEQ, TC = NB * NCTX, T = TL + TC;
constexpr int INW = 4608, NMOD = 6 * D, PW = 1600, PN = 1536;
constexpr int VTS = SEQ + 64;
constexpr int QOFF = 0, KOFF = 512, VOFF = 640, POOLOFF = 768, SUOFF = 1024, SVOFF = 1280, GATEOFF = 1536;
constexpr int NEXP = 16384;
constexpr float EPS = 1e-6f;
constexpr float LOG2E = 1.4426950408889634f;
constexpr float QSCALE = 0.125f * LOG2E;

constexpr size_t MiB = 1u << 20;
constexpr size_t WS_CTL = 0, WS_MOD = 1 * MiB, CTL_ZERO_BYTES = 2 * MiB;
constexpr size_t WS_ROPE = 2 * MiB, WS_SGUW = 2 * MiB + 65536, WS_TSCALE = 3 * MiB;
constexpr size_t WS_WIN = 4 * MiB, WS_WBR = 22 * MiB, WS_WOUT = 26 * MiB, WS_WFOLD = 30 * MiB;
constexpr size_t WS_XCTX = 38 * MiB, WS_UTAB = 46 * MiB, WS_VTAB = 78 * MiB;
constexpr size_t WS_IDX = 110 * MiB, WS_GW = 120 * MiB;
constexpr size_t WS_H = 142 * MiB;
constexpr size_t WS_P = 210 * MiB, WS_Y = 318 * MiB, WS_MERGED = 386 * MiB, WS_VT = 454 * MiB, WS_VTC = 463 * MiB, WS_VST = 464 * MiB;
constexpr size_t WS_ST = 210 * MiB, WS_H8 = 346 * MiB, WS_HS = 380 * MiB, WS_SU = 482 * MiB;
constexpr size_t WS_END = 512 * MiB;
static_assert(WS_ST + (size_t)2048 * T * 2 <= WS_H8 && WS_H8 + (size_t)T * D <= WS_HS, "ST / H8 fit");
static_assert(WS_VST + (size_t)272 * 256 * 128 * 2 <= WS_SU && WS_VT + (size_t)NB * 2 * 64 * VTS * 2 <= WS_VTC, "VsT / VT fit");
static_assert(WS_H + (size_t)T * D * 2 <= WS_P, "H fits");
static_assert(WS_P + (size_t)T * PW * 2 <= WS_Y && WS_Y + (size_t)T * D * 2 <= WS_MERGED && WS_MERGED + (size_t)T * D * 2 <= WS_VT, "P/Y/MERGED fit");
static_assert(WS_IDX + (size_t)T * 128 * 2 <= WS_GW && WS_GW + (size_t)T * 128 * 4 <= WS_H && WS_SU + (size_t)T * 128 * 4 <= WS_END && WS_HS + (size_t)T * 4 <= WS_SU, "idx/gw/su fit");

constexpr int LDS_BYTES = 147456;
constexpr int NTHREADS = 512, NWAVES = 8;

enum { I_x, I_c, I_ctx, I_c_ctx, I_w_mod, I_b_mod, I_g_mix, I_g_ffn, I_w_in, I_attn_sink, I_pool_w, I_pool_scale, I_sgu_w, I_sgu_b, I_w_br_attn, I_w_br_pool, I_w_br_sgu, I_w_out, I_peer_wq, I_peer_subkeys, I_peer_u, I_peer_v, I_g_final, N_IN };
struct Params {
    const float* in[N_IN];
    float* out; unsigned char* ws;
    int ph_lo, ph_hi;
};

DI unsigned f2bf(float f) { unsigned u = __builtin_bit_cast(unsigned, f); return (u + 0x7fffu + ((u >> 16) & 1u)) >> 16; }
DI unsigned pk2(float lo, float hi) { return f2bf(lo) | (f2bf(hi) << 16); }
DI float bf2f(unsigned short u) { return __builtin_bit_cast(float, (unsigned)u << 16); }
DI float bflo(unsigned w) { return __builtin_bit_cast(float, w << 16); }
DI float bfhi(unsigned w) { return __builtin_bit_cast(float, w & 0xffff0000u); }
DI int crow(int reg, int h) { return (reg & 3) + 8 * (reg >> 2) + 4 * h; }
DI float wave_sum(float v) {
#pragma unroll
    for (int o = 1; o < 64; o <<= 1) v += __shfl_xor(v, o);
    return v;
}
DI float sigmoidf_(float x) { return 1.0f / (1.0f + __expf(-x)); }
DI float gelu_tanh(float x) { const float u = 0.7978845608028654f * (x + 0.044715f * x * x * x); return x / (1.0f + __expf(-2.0f * u)); }
DI float silu_(float x) { return x / (1.0f + __expf(-x)); }

struct Frame {
    int tid, lane, wave, gw, ngw, gtid, ngt, bid, nb;
    LAS unsigned char* lds;
};

template <int NM, int NN>
DI void wave_gemm(const bf16_t* __restrict__ A, int lda, const bf16_t* __restrict__ Bt, int ldb, int K, int m0, int n0, f32x16 (&acc)[NM][NN], int lane) {
    const int r = lane & 31, h = lane >> 5;
    const bf16_t* ap = A + (size_t)(m0 + r) * lda + 8 * h;
    const bf16_t* bp = Bt + (size_t)(n0 + r) * ldb + 8 * h;
    for (int k0 = 0; k0 < K; k0 += 64) {
        bf16x8 a[4][NM], b[4][NN];
#pragma unroll
        for (int s = 0; s < 4; ++s) {
#pragma unroll
            for (int i = 0; i < NM; ++i) a[s][i] = *(const bf16x8*)(ap + (size_t)(32 * i) * lda + k0 + 16 * s);
#pragma unroll
            for (int j = 0; j < NN; ++j) b[s][j] = *(const bf16x8*)(bp + (size_t)(32 * j) * ldb + k0 + 16 * s);
        }
#pragma unroll
        for (int s = 0; s < 4; ++s)
#pragma unroll
            for (int i = 0; i < NM; ++i)
#pragma unroll
                for (int j = 0; j < NN; ++j) acc[i][j] = MFMA32(a[s][i], b[s][j], acc[i][j]);
    }
}
template <int NM, int NN> DI void zero_acc(f32x16 (&acc)[NM][NN]) {
#pragma unroll
    for (int i = 0; i < NM; ++i)
#pragma unroll
        for (int j = 0; j < NN; ++j)
#pragma unroll
            for (int r = 0; r < 16; ++r) acc[i][j][r] = 0.f;
}

namespace pg8 {
constexpr int BM = 256, BK = 64, HALF = 128, HTB = HALF * BK * 2, STAGE_BYTES = 8 * HTB, NXCD = 8, WGM = 8, LD = 1024;
DI int lds_byte(int r, int c) { const int st = (r >> 4) * 2 + (c >> 5), rr = r & 15, cc = c & 31, ob = rr * 64 + cc * 2; return st * 1024 + (ob ^ (((ob >> 9) & 1) << 5)); }
DI void stage_rc(int b, int& R, int& C) { const int st = b / 1024, sb = b % 1024, swz = sb ^ (((sb >> 9) & 1) << 5); R = (st >> 1) * 16 + swz / 64; C = (st & 1) * 32 + (swz % 64) / 2; }
DI int perm32(int rho) { const int n = rho >> 4, i = rho & 15; return 8 * (i >> 2) + 4 * n + (i & 3); }
struct Unit { int pm, pn, sub, nt; const char* a; const char* b; };
DI void tile_of(int L, int nM, int nN, int& pm, int& pn) {
    const int nwg = nM * nN; int wgid = L;
    { const int q = nwg / NXCD, r = nwg % NXCD, xcd = wgid % NXCD, off = wgid / NXCD; wgid = (xcd < r ? xcd * (q + 1) : r * (q + 1) + (xcd - r) * q) + off; }
    const int nig = WGM * nN, gid = wgid / nig, fm = gid * WGM, gsz = (nM - fm) < WGM ? (nM - fm) : WGM;
    pm = fm + ((wgid % nig) % gsz); pn = (wgid % nig) / gsz;
}
template <class Epi, class Sched>
DI void gemm_phase(LAS unsigned char* lds, const int tid, const Sched& S, const Epi& E) {
    const int wid = __builtin_amdgcn_readfirstlane(tid >> 6), lane = tid & 63, wr = wid >> 2, wc = wid & 3, fr = lane & 15, fq = lane >> 4;
    unsigned voffA[2], voffB[2];
#pragma unroll
    for (int i = 0; i < 2; ++i) { int R, C; stage_rc(tid * 16 + i * 8192, R, C); const int Rb = Epi::PERM ? ((R & ~31) + perm32(R & 31)) : R;
        voffA[i] = (unsigned)(R * LD + C) * 2u; voffB[i] = (unsigned)(Rb * LD + C) * 2u; }
    const size_t kstep = (size_t)(BK * 2);
    const size_t hstep = (size_t)HALF * LD * 2;
    const unsigned ldsw = (unsigned)wid * 1024u;
    const int aoff = lds_byte(wr * 64 + fr, fq * 8), boff = lds_byte(wc * 32 + fr, fq * 8);
#define PG8_SA(b, h) (((b) * 2 + (h)) * HTB)
#define PG8_SB(b, h) ((4 + (b) * 2 + (h)) * HTB)
#define PG8_STAGE(bufoff, gbase, voff) do { _Pragma("unroll") for (int _i = 0; _i < 2; ++_i) \
        __builtin_amdgcn_global_load_lds((const unsigned*)((const char*)(gbase) + (voff)[_i]), (LAS unsigned*)(lds + (bufoff) + ldsw + _i * 8192), 16, 0, 0); } while (0)
#define PG8_LDA(dst, b, h) do { _Pragma("unroll") for (int m = 0; m < 4; ++m) _Pragma("unroll") for (int k = 0; k < 2; ++k) dst[m][k] = *(const LAS bf16x8*)(lds + PG8_SA(b, h) + aoff + m * 2048 + k * 1024); } while (0)
#define PG8_LDB(dst, b, h) do { _Pragma("unroll") for (int n = 0; n < 2; ++n) _Pragma("unroll") for (int k = 0; k < 2; ++k) dst[n][k] = *(const LAS bf16x8*)(lds + PG8_SB(b, h) + boff + n * 2048 + k * 1024); } while (0)
#define PG8_MMA(ai, bj, At, Bt) do { __builtin_amdgcn_s_setprio(1); _Pragma("unroll") for (int m = 0; m < 4; ++m) _Pragma("unroll") for (int n = 0; n < 2; ++n) _Pragma("unroll") for (int k = 0; k < 2; ++k) \
        acc[ai][bj][m][n] = __builtin_amdgcn_mfma_f32_16x16x32_bf16(Bt[n][k], At[m][k], acc[ai][bj][m][n], 0, 0, 0); __builtin_amdgcn_s_setprio(0); } while (0)
#define PG8_WAIT_V(n) asm volatile("s_waitcnt vmcnt(" #n ")" ::: "memory")
#define PG8_WAIT_L(n) asm volatile("s_waitcnt lgkmcnt(" #n ")" ::: "memory")
#define PG8_BAR __builtin_amdgcn_s_barrier()
#define PG8_SCHED __builtin_amdgcn_sched_barrier(0)
    Unit cur, nxt; int ui = 0;
    if (!S.next(0, cur)) return;
    f32x4 acc[2][2][4][2];
#pragma unroll
    for (int a = 0; a < 2; ++a)
#pragma unroll
        for (int b = 0; b < 2; ++b)
#pragma unroll
            for (int m = 0; m < 4; ++m)
#pragma unroll
                for (int n = 0; n < 2; ++n) acc[a][b][m][n] = (f32x4){0.f, 0.f, 0.f, 0.f};
    bf16x8 At[4][2], B0[2][2], B1[2][2];
    const char* cA = cur.a; const char* cB = cur.b;
    PG8_STAGE(PG8_SB(0, 0), cB, voffB); PG8_STAGE(PG8_SB(0, 1), cB + hstep, voffB); PG8_STAGE(PG8_SA(0, 0), cA, voffA); PG8_STAGE(PG8_SA(0, 1), cA + hstep, voffA);
    if (wr == 1) PG8_BAR;
    PG8_WAIT_V(2); PG8_BAR;
    PG8_STAGE(PG8_SB(1, 0), cB + kstep, voffB); PG8_STAGE(PG8_SA(1, 0), cA + kstep, voffA); PG8_STAGE(PG8_SB(1, 1), cB + hstep + kstep, voffB);
    PG8_WAIT_V(6); PG8_BAR;
    for (;;) {
        const bool has_next = S.next(ui + 1, nxt);
        const char* nA = has_next ? nxt.a : cA; const char* nB = has_next ? nxt.b : cB;
        const int nt = cur.nt;
        for (int t = 0; t < nt; t += 2) {
            const bool last = (t == nt - 2);
            const char* a1 = cA + (size_t)(t + 1) * kstep;
            const char* a2 = last ? nA : cA + (size_t)(t + 2) * kstep; const char* b2 = last ? nB : cB + (size_t)(t + 2) * kstep;
            const char* a3 = a2 + kstep; const char* b3 = b2 + kstep;
            PG8_LDB(B0, 0, 0); PG8_LDB(B1, 0, 1); PG8_SCHED; PG8_LDA(At, 0, 0); PG8_STAGE(PG8_SA(1, 1), a1 + hstep, voffA);
            PG8_WAIT_V(8); PG8_WAIT_L(0); PG8_BAR; PG8_MMA(0, 0, At, B0); PG8_MMA(0, 1, At, B1); PG8_BAR; PG8_SCHED;
            PG8_LDA(At, 0, 1); PG8_STAGE(PG8_SB(0, 0), b2, voffB); PG8_STAGE(PG8_SB(0, 1), b2 + hstep, voffB); PG8_STAGE(PG8_SA(0, 0), a2, voffA);
            PG8_WAIT_V(8); PG8_WAIT_L(0); PG8_BAR; PG8_MMA(1, 0, At, B0); PG8_MMA(1, 1, At, B1); PG8_BAR; PG8_SCHED;
            PG8_LDB(B0, 1, 0); PG8_LDB(B1, 1, 1); PG8_SCHED; PG8_LDA(At, 1, 0); PG8_STAGE(PG8_SA(0, 1), a2 + hstep, voffA);
            PG8_WAIT_V(8); PG8_WAIT_L(0); PG8_BAR; PG8_MMA(0, 0, At, B0); PG8_MMA(0, 1, At, B1); PG8_BAR; PG8_SCHED;
            PG8_LDA(At, 1, 1); PG8_STAGE(PG8_SB(1, 0), b3, voffB); PG8_STAGE(PG8_SB(1, 1), b3 + hstep, voffB); PG8_STAGE(PG8_SA(1, 0), a3, voffA);
            PG8_WAIT_V(8); PG8_WAIT_L(0); PG8_BAR; PG8_MMA(1, 0, At, B0); PG8_MMA(1, 1, At, B1); PG8_BAR; PG8_SCHED;
        }
        if (wr == 0) PG8_BAR;
        E(acc, cur, wr, wc, fr, fq);
        if (!has_next) break;
        if (!E.keeps(cur)) {
#pragma unroll
        for (int a = 0; a < 2; ++a)
#pragma unroll
            for (int b = 0; b < 2; ++b)
#pragma unroll
                for (int m = 0; m < 4; ++m)
#pragma unroll
                    for (int n = 0; n < 2; ++n) acc[a][b][m][n] = (f32x4){0.f, 0.f, 0.f, 0.f};
        }
        cur = nxt; cA = nA; cB = nB; ++ui;
        if (wr == 1) PG8_BAR;
    }
    PG8_WAIT_V(0);
    PG8_BAR;
#undef PG8_SA
#undef PG8_SB
#undef PG8_STAGE
#undef PG8_LDA
#undef PG8_LDB
#undef PG8_MMA
#undef PG8_WAIT_V
#undef PG8_WAIT_L
#undef PG8_BAR
#undef PG8_SCHED
}
}

DI void transpose_item(const float* W, int K, int N, bf16_t* WT, int ldd, int row_off, int col_off, LAS float* scr, int item, int lane) {
    const int nblk = N / 32, kb = item / nblk, nb = item % nblk, k0 = 64 * kb, n0 = 32 * nb;
#pragma unroll 8
    for (int i = 0; i < 32; ++i) { const int kk = 2 * i + (lane >> 5); scr[kk * 33 + (lane & 31)] = W[(size_t)(k0 + kk) * N + n0 + (lane & 31)]; }
    asm volatile("s_waitcnt lgkmcnt(0)" ::: "memory");
    const int c = lane & 7;
#pragma unroll
    for (int j = 0; j < 4; ++j) { const int n = (lane >> 3) + 8 * j; const LAS float* s = scr + (8 * c) * 33 + n;
        u32x4 o; o.x = pk2(s[0 * 33], s[1 * 33]); o.y = pk2(s[2 * 33], s[3 * 33]); o.z = pk2(s[4 * 33], s[5 * 33]); o.w = pk2(s[6 * 33], s[7 * 33]);
        *(u32x4*)(WT + (size_t)(row_off + n0 + n) * ldd + col_off + k0 + 8 * c) = o; }
    asm volatile("s_waitcnt lgkmcnt(0)" ::: "memory");
}

DI void convert_tables(const Params& p, const Frame& F) {
    for (int it0 = 2 * F.gw; it0 < 4 * NEXP; it0 += 2 * F.ngw) {
        f32x4 v[2][4];
#pragma unroll
        for (int u = 0; u < 2; ++u) {
            const int it = it0 + u, e = it & (NEXP - 1), tbl = (it >> 14) & 1, l = it >> 15;
            const f32x4* src = (const f32x4*)((tbl ? p.in[I_peer_v] : p.in[I_peer_u]) + ((size_t)l * NEXP + e) * D) + 4 * F.lane;
#pragma unroll
            for (int j = 0; j < 4; ++j) v[u][j] = src[j];
        }
#pragma unroll
        for (int u = 0; u < 2; ++u) {
            const int it = it0 + u, e = it & (NEXP - 1), tbl = (it >> 14) & 1, l = it >> 15;
            float am = 0.f;
#pragma unroll
            for (int j = 0; j < 4; ++j) am = fmaxf(am, fmaxf(fmaxf(fabsf(v[u][j].x), fabsf(v[u][j].y)), fmaxf(fabsf(v[u][j].z), fabsf(v[u][j].w))));
#pragma unroll
            for (int o = 1; o < 64; o <<= 1) am = fmaxf(am, __shfl_xor(am, o));
            const float sc = (am > 0.f) ? exp2f(floorf(log2f(224.0f / am))) : 1.0f;
            u32x4 q;
#pragma unroll
            for (int j = 0; j < 4; ++j) { int w = 0; w = __builtin_amdgcn_cvt_pk_fp8_f32(v[u][j].x * sc, v[u][j].y * sc, w, false); w = __builtin_amdgcn_cvt_pk_fp8_f32(v[u][j].z * sc, v[u][j].w * sc, w, true); q[j] = (unsigned)w; }
            *(u32x4*)(p.ws + (tbl ? WS_VTAB : WS_UTAB) + ((size_t)l * NEXP + e) * D + 16 * F.lane) = q;
            if (F.lane == 0) ((float*)(p.ws + WS_TSCALE))[(l * 2 + tbl) * NEXP + e] = 1.0f / sc;
        }
    }
}

DI void phase_prep(const Params& p, const Frame& F) {
    unsigned char* ws = p.ws;
    {
        LAS float* wq = (LAS float*)F.lds;
        LAS float* skl = wq + 128 * 65;
        for (int it = F.bid; it < 2 * 16 * 16; it += F.nb) {
            const int cc = it & 15, hp = (it >> 4) & 15, l = it >> 8;
            const float* src = p.in[I_peer_wq] + (size_t)l * D * 2048 + hp * 128;
            const float* sks = p.in[I_peer_subkeys] + (size_t)(l * 16 + hp) * 128 * 128;
            __syncthreads();
            for (int e = F.tid; e < 64 * 128; e += NTHREADS) { const int ci = e >> 7, d = e & 127; wq[d * 65 + ci] = src[(size_t)(cc * 64 + ci) * 2048 + d]; }
            for (int e = F.tid; e < 128 * 32; e += NTHREADS) { const int key = e >> 5, d4 = (e & 31) * 4; *(LAS f32x4*)(skl + key * 132 + d4) = *(const f32x4*)(sks + key * 128 + d4); }
            __syncthreads();
            const int ci = F.tid & 63, kg = F.tid >> 6;
            float acc[16];
#pragma unroll
            for (int k = 0; k < 16; ++k) acc[k] = 0.f;
#pragma unroll 2
            for (int d = 0; d < 128; d += 4) {
                const float w0 = wq[d * 65 + ci], w1 = wq[(d + 1) * 65 + ci], w2 = wq[(d + 2) * 65 + ci], w3 = wq[(d + 3) * 65 + ci];
#pragma unroll
                for (int k = 0; k < 16; ++k) { const f32x4 s = *(const LAS f32x4*)(skl + (16 * kg + k) * 132 + d); acc[k] += w0 * s.x + w1 * s.y + w2 * s.z + w3 * s.w; }
            }
            bf16_t* dst = (bf16_t*)(ws + WS_WFOLD) + ((size_t)l * 2048 + hp * 128 + 16 * kg) * D + cc * 64 + ci;
#pragma unroll
            for (int k = 0; k < 16; ++k) dst[(size_t)k * D] = (bf16_t)f2bf(acc[k]);
        }
        __syncthreads();
    }
    {
        LAS float* scr = (LAS float*)(F.lds + F.wave * 16384);
        constexpr int I_IN = (D / 64) * (INW / 32), I_BA = (512 / 64) * (D / 32), I_BS = (256 / 64) * (D / 32), I_O = (D / 64) * (D / 32);
        constexpr int PER_L = I_IN + I_BA + I_BS + I_O;
        for (int it = F.gw; it < 2 * PER_L; it += F.ngw) {
            const int l = it / PER_L; int r = it % PER_L;
            if (r < I_IN) { transpose_item(p.in[I_w_in] + (size_t)l * D * INW, D, INW, (bf16_t*)(ws + WS_WIN) + (size_t)l * INW * D, D, 0, 0, scr, r, F.lane); continue; } r -= I_IN;
            if (r < I_BA) { transpose_item(p.in[I_w_br_attn] + (size_t)l * 512 * D, 512, D, (bf16_t*)(ws + WS_WBR) + (size_t)l * D * D, D, 0, 0, scr, r, F.lane); continue; } r -= I_BA;
            if (r < I_BS) { transpose_item(p.in[I_w_br_sgu] + (size_t)l * 256 * D, 256, D, (bf16_t*)(ws + WS_WBR) + (size_t)l * D * D, D, 0, 768, scr, r, F.lane); continue; } r -= I_BS;
            transpose_item(p.in[I_w_out] + (size_t)l * D * D, D, D, (bf16_t*)(ws + WS_WOUT) + (size_t)l * D * D, D, 0, 0, scr, r, F.lane);
        }
    }
    for (int i = F.gtid; i < 2 * 256 * D; i += F.ngt) {
        const int n = i & 1023, rc = (i >> 10) & 255, l = i >> 18, g = rc >> 6;
        const float* pw = p.in[I_pool_w] + ((size_t)l * 256 + rc) * 64;
        const float* ps = p.in[I_pool_scale] + l * 256 + 64 * g;
        const float* wb = p.in[I_w_br_pool] + ((size_t)l * 256 + 64 * g) * D + n;
        float a = 0.f;
#pragma unroll 16
        for (int e = 0; e < 64; ++e) a += pw[e] * ps[e] * wb[(size_t)e * D];
        ((bf16_t*)(ws + WS_WBR))[(size_t)l * D * D + (size_t)n * D + 512 + rc] = (bf16_t)f2bf(a);
    }
    for (int i = F.gtid; i < 2 * 4 * 128 * 128; i += F.ngt) ((bf16_t*)(ws + WS_SGUW))[i] = (bf16_t)f2bf(p.in[I_sgu_w][i]);
    for (int i = F.gtid; i < 64 * 16; i += F.ngt) {
        const int pos = i >> 4, fi = i & 15;
        const float inv = powf(10000.0f, -(float)fi / 16.0f);
        const float ang = (float)pos * inv;
        ((f32x2*)(ws + WS_ROPE))[i] = (f32x2){cosf(ang), sinf(ang)};
    }
    convert_tables(p, F);
    {
        float* MOD = (float*)(ws + WS_MOD);
        LAS float* scd = (LAS float*)F.lds;
        LAS float* red = scd + 9 * D;
        __syncthreads();
        for (int e = F.tid; e < 9 * D; e += NTHREADS) { const int r = e >> 10, k = e & 1023; scd[e] = silu_((r < 8) ? p.in[I_c][r * D + k] : p.in[I_c_ctx][k]); }
        __syncthreads();
        for (int it = F.bid; it < 2 * 96; it += F.nb) {
            const int cgp = it % 96, l = it / 96, col = cgp * 64 + F.lane;
            float acc[9];
#pragma unroll
            for (int r = 0; r < 9; ++r) acc[r] = 0.f;
            const float* wp = p.in[I_w_mod] + ((size_t)l * D + F.wave * 128) * NMOD + col;
#pragma unroll 16
            for (int k = 0; k < 128; ++k) {
                const float w = wp[(size_t)k * NMOD];
#pragma unroll
                for (int r = 0; r < 9; ++r) acc[r] += scd[r * D + F.wave * 128 + k] * w;
            }
#pragma unroll
            for (int r = 0; r < 9; ++r) red[(F.wave * 9 + r) * 64 + F.lane] = acc[r];
            __syncthreads();
            for (int e = F.tid; e < 9 * 64; e += NTHREADS) {
                const int r = e >> 6, ln = e & 63; float s = p.in[I_b_mod][l * NMOD + cgp * 64 + ln];
#pragma unroll
                for (int w = 0; w < 8; ++w) s += red[(w * 9 + r) * 64 + ln];
                MOD[((size_t)l * 9 + r) * NMOD + cgp * 64 + ln] = s;
            }
            __syncthreads();
        }
    }
}

DI const float* mod_vec(const Params& p, int l, int row, int j) {
    const int r = row < TL ? row / SEQ : 8;
    return (const float*)(p.ws + WS_MOD) + ((size_t)l * 9 + r) * NMOD + j * D;
}
DI float* xrow_ptr(const Params& p, int row) { return row < TL ? p.out + (size_t)row * D : (float*)(p.ws + WS_XCTX) + (size_t)(row - TL) * D; }
DI const float* xin_ptr(const Params& p, int row) { return row < TL ? p.in[I_x] + (size_t)row * D : p.in[I_ctx] + (size_t)(row - TL) * D; }

DI void modulate_row_wave(const float* src, const float* g, const float* sh, const float* sc, bf16_t* dst, int lane, unsigned char* h8 = nullptr, float* hs = nullptr) {
    f32x4 v[4]; float ss = 0.f;
#pragma unroll
    for (int j = 0; j < 4; ++j) { v[j] = ((const f32x4*)src)[lane + 64 * j]; ss += v[j].x * v[j].x + v[j].y * v[j].y + v[j].z * v[j].z + v[j].w * v[j].w; }
    const float rinv = rsqrtf(wave_sum(ss) * (1.0f / D) + EPS);
    float am = 0.f;
#pragma unroll
    for (int j = 0; j < 4; ++j) {
        const f32x4 gg = ((const f32x4*)g)[lane + 64 * j], s1 = ((const f32x4*)sh)[lane + 64 * j], s2 = ((const f32x4*)sc)[lane + 64 * j];
        const f32x4 o = v[j] * rinv * gg * (s2 + 1.0f) + s1;
        u32x2 w; w.x = pk2(o.x, o.y); w.y = pk2(o.z, o.w);
        ((u32x2*)dst)[lane + 64 * j] = w;
        v[j] = o; am = fmaxf(am, fmaxf(fmaxf(fabsf(o.x), fabsf(o.y)), fmaxf(fabsf(o.z), fabsf(o.w))));
    }
    if (h8) {
#pragma unroll
        for (int o = 1; o < 64; o <<= 1) am = fmaxf(am, __shfl_xor(am, o));
        const float scl = (am > 0.f) ? exp2f(floorf(log2f(224.0f / am))) : 1.0f;
#pragma unroll
        for (int j = 0; j < 4; ++j) { int w = 0; w = __builtin_amdgcn_cvt_pk_fp8_f32(v[j].x * scl, v[j].y * scl, w, false); w = __builtin_amdgcn_cvt_pk_fp8_f32(v[j].z * scl, v[j].w * scl, w, true);
            ((unsigned*)h8)[lane + 64 * j] = (unsigned)w; }
        if (lane == 0) *hs = 1.0f / scl;
    }
}

DI void phase_norm(const Params& p, const Frame& F, int l, int which  , bool from_input, int nrows) {
    const float* g = (which == 0 ? p.in[I_g_mix] : p.in[I_g_ffn]) + l * D;
    for (int row = F.gw; row < nrows; row += F.ngw) {
        const float* src = from_input ? xin_ptr(p, row) : xrow_ptr(p, row);
        modulate_row_wave(src, g, mod_vec(p, l, row, which * 3 + 0), mod_vec(p, l, row, which * 3 + 1), (bf16_t*)(p.ws + WS_H) + (size_t)row * D, F.lane,
                          nullptr, nullptr);
    }
}
DI void phase_final(const Params& p, const Frame& F) {
    for (int row = F.gw; row < TL; row += F.ngw) {
        f32x4* xr = (f32x4*)(p.out + (size_t)row * D);
        f32x4 v[4]; float ss = 0.f;
#pragma unroll
        for (int j = 0; j < 4; ++j) { v[j] = xr[F.lane + 64 * j]; ss += v[j].x * v[j].x + v[j].y * v[j].y + v[j].z * v[j].z + v[j].w * v[j].w; }
        const float rinv = rsqrtf(wave_sum(ss) * (1.0f / D) + EPS);
#pragma unroll
        for (int j = 0; j < 4; ++j) xr[F.lane + 64 * j] = v[j] * rinv * ((const f32x4*)p.in[I_g_final])[F.lane + 64 * j];
    }
}

DI void g1_epilogue(const Params& p, int l, const f32x16& acc, int row0, int col0, int lane) {
    const int h = lane >> 5, w = lane & 31, col = col0 + w;
    bf16_t* P = (bf16_t*)(p.ws + WS_P);
    if (col0 < VOFF) {
        const float sc = (col0 < KOFF) ? QSCALE : 1.0f;
        const int axis = (col0 >> 5) & 1, fi = w & 15;
        const f32x2* tab = (const f32x2*)(p.ws + WS_ROPE);
#pragma unroll
        for (int r = 0; r < 16; ++r) {
            const int row = row0 + crow(r, h);
            const float own = acc[r], oth = __shfl_xor(own, 16);
            float o = own;
            if (row < TL) {
                const int t = row & (SEQ - 1), pos = axis ? (t & 63) : (t >> 6);
                const f32x2 cs = tab[pos * 16 + fi];
                o = (w < 16) ? (own * cs.x - oth * cs.y) : (own * cs.x + oth * cs.y);
            }
            P[(size_t)row * PW + col] = (bf16_t)f2bf(o * sc);
        }
    } else if (col0 < POOLOFF) {
        const int hk = (col - VOFF) >> 6, d = (col - VOFF) & 63;
#pragma unroll
        for (int r = 0; r < 16; ++r) {
            const int row = row0 + crow(r, h);
            const bf16_t v = (bf16_t)f2bf(acc[r]);
            if (row < TL) { const int b = row / SEQ, t = row & (SEQ - 1); ((bf16_t*)(p.ws + WS_VT))[((size_t)(b * 2 + hk) * 64 + d) * VTS + t] = v; }
            else { const int rc = row - TL, b = rc / NCTX, j = rc & (NCTX - 1); ((bf16_t*)(p.ws + WS_VTC))[((size_t)(b * 2 + hk) * 64 + d) * NCTX + j] = v; }
        }
    } else if (col0 < SUOFF) {
#pragma unroll
        for (int r = 0; r < 16; ++r) { const int row = row0 + crow(r, h); P[(size_t)row * PW + col] = (bf16_t)f2bf(acc[r]); }
    } else if (col0 < SVOFF) {
#pragma unroll
        for (int r = 0; r < 16; ++r) { const int row = row0 + crow(r, h); P[(size_t)row * PW + col] = (bf16_t)f2bf(gelu_tanh(acc[r])); }
    } else {
        const int c = col - SVOFF;
#pragma unroll
        for (int r = 0; r < 16; ++r) { const int row = row0 + crow(r, h); const int chunk = row >> 7, q = row & 127;
            ((bf16_t*)(p.ws + WS_VST))[((size_t)chunk * 256 + c) * 128 + q] = (bf16_t)f2bf(gelu_tanh(acc[r])); }
    }
}

DI void g1_simple(const Params& p, const Frame& F, int l, int row_lo, int nrows, int ct_lo, int nct) {
    const bf16_t* H = (const bf16_t*)(p.ws + WS_H);
    const bf16_t* W = (const bf16_t*)(p.ws + WS_WIN) + (size_t)l * INW * D;
    const int nit = (nrows / 64) * nct;
    for (int it = F.gw; it < nit; it += F.ngw) {
        const int mt = it / nct, nt = ct_lo + it % nct, m0 = row_lo + mt * 64;
        f32x16 acc[2][1]; zero_acc(acc);
        wave_gemm<2, 1>(H, D, W, D, D, m0, nt * 32, acc, F.lane);
#pragma unroll 1
        for (int i = 0; i < 2; ++i) g1_epilogue(p, l, i == 0 ? acc[0][0] : acc[1][0], m0 + 32 * i, nt * 32, F.lane);
    }
}

DI float lane_xor32(float v, bool hi) { const auto r = __builtin_amdgcn_permlane32_swap(__builtin_bit_cast(unsigned, v), __builtin_bit_cast(unsigned, v), false, false);
    return __builtin_bit_cast(float, hi ? r[0] : r[1]); }
struct EpiG1 {
    DI bool keeps(const pg8::Unit&) const { return false; }
    static constexpr bool PERM = true;
    unsigned char* ws;
    DI void operator()(const f32x4 (&acc)[2][2][4][2], const pg8::Unit& u, int wr, int wc, int fr, int fq) const {
        bf16_t* P = (bf16_t*)(ws + WS_P);
        const int rbase = u.pm * 256 + wr * 64 + fr;
        const bool hi = fq >= 2;
#pragma unroll
        for (int ai = 0; ai < 2; ++ai) {
            f32x4 cs[4][4];
            if (u.pn < 3) {
#pragma unroll
                for (int m = 0; m < 4; ++m) {
                    const int t = (rbase + 128 * ai + 16 * m) & (SEQ - 1), pos = (wc & 1) ? (t & 63) : (t >> 6);
                    const f32x4* tab = (const f32x4*)(ws + WS_ROPE) + (pos * 16 + 8 * (fq & 1)) / 2;
#pragma unroll
                    for (int j2 = 0; j2 < 4; ++j2) cs[m][j2] = tab[j2];
                }
            }
#pragma unroll
            for (int m = 0; m < 4; ++m) {
                const int row = rbase + 128 * ai + 16 * m;
#pragma unroll
                for (int bj = 0; bj < 2; ++bj) {
                    const int c0 = u.pn * 256 + 128 * bj + 32 * wc + 8 * fq;
                    float v[8];
#pragma unroll
                    for (int j = 0; j < 4; ++j) { v[j] = acc[ai][bj][m][0][j]; v[4 + j] = acc[ai][bj][m][1][j]; }
                    if (c0 < VOFF) {
                        const float sc = (c0 < KOFF) ? QSCALE : 1.0f;
                        u32x4 o;
#pragma unroll
                        for (int j2 = 0; j2 < 4; ++j2) {
                            const f32x4 c4 = cs[m][j2];
                            const float o0 = lane_xor32(v[2 * j2], hi), o1 = lane_xor32(v[2 * j2 + 1], hi);
                            const float r0 = hi ? (v[2 * j2] * c4.x + o0 * c4.y) : (v[2 * j2] * c4.x - o0 * c4.y);
                            const float r1 = hi ? (v[2 * j2 + 1] * c4.z + o1 * c4.w) : (v[2 * j2 + 1] * c4.z - o1 * c4.w);
                            o[j2] = pk2(r0 * sc, r1 * sc);
                        }
                        *(u32x4*)(P + (size_t)row * PW + c0) = o;
                    } else if (c0 < POOLOFF) {
                        const int hk = wc >> 1, d0 = 32 * (wc & 1) + 8 * fq, b = row / SEQ, t = row & (SEQ - 1);
                        bf16_t* vt = (bf16_t*)(ws + WS_VT) + ((size_t)(b * 2 + hk) * 64 + d0) * VTS + t;
#pragma unroll
                        for (int j = 0; j < 8; ++j) vt[(size_t)j * VTS] = (bf16_t)f2bf(v[j]);
                    } else if (c0 < SUOFF) {
                        u32x4 o;
#pragma unroll
                        for (int j2 = 0; j2 < 4; ++j2) o[j2] = pk2(v[2 * j2], v[2 * j2 + 1]);
                        *(u32x4*)(P + (size_t)row * PW + c0) = o;
                    } else if (c0 < SVOFF) {
                        u32x4 o;
#pragma unroll
                        for (int j2 = 0; j2 < 4; ++j2) o[j2] = pk2(gelu_tanh(v[2 * j2]), gelu_tanh(v[2 * j2 + 1]));
                        *(u32x4*)(P + (size_t)row * PW + c0) = o;
                    } else {
                        const int c = c0 - SVOFF, chunk = row >> 7, q = row & 127;
                        bf16_t* vs = (bf16_t*)(ws + WS_VST) + ((size_t)chunk * 256 + c) * 128 + q;
#pragma unroll
                        for (int j = 0; j < 8; ++j) vs[j * 128] = (bf16_t)f2bf(gelu_tanh(v[j]));
                    }
                }
            }
            asm volatile("" ::: "memory");
        }
    }
};
struct SchedGrid {
    int nM, nN, G, c; const char* A; const char* B;
    DI bool next(int i, pg8::Unit& u) const {
        const int L = i * G + c; if (L >= nM * nN) return false;
        pg8::tile_of(L, nM, nN, u.pm, u.pn); u.sub = 0; u.nt = D / 64;
        u.a = A + (size_t)u.pm * 256 * D * 2; u.b = B + (size_t)u.pn * 256 * D * 2; return true;
    }
};

DI void phase_g1(const Params& p, const Frame& F, int l) {
    SchedGrid S{TL / 256, PN / 256, F.nb, F.bid, (const char*)(p.ws + WS_H), (const char*)(p.ws + WS_WIN) + (size_t)l * INW * D * 2};
    EpiG1 E{p.ws};
    pg8::gemm_phase(F.lds, F.tid, S, E);
    if (l == 0) g1_simple(p, F, l, TL, TC, 0, PN / 32);
    else g1_simple(p, F, l, TL, TC, 16, 8);
}

DI bf16x8 pack8(const f32x16& x, int s) {
    u32x4 pk;
#pragma unroll
    for (int j = 0; j < 4; ++j) { f32x2 v = {x[8 * s + 2 * j], x[8 * s + 2 * j + 1]}; pk[j] = __builtin_bit_cast(unsigned, __builtin_convertvector(v, bf16x2_t)); }
    return __builtin_bit_cast(bf16x8, pk);
}

DI float lane_x32(float v, bool hi) { const auto r = __builtin_amdgcn_permlane32_swap(__builtin_bit_cast(unsigned, v), __builtin_bit_cast(unsigned, v), false, false);
    return __builtin_bit_cast(float, hi ? r[0] : r[1]); }
struct AttnFrags { bf16x8 kf[4]; s16x4 vf[2][4]; };
DI void attn_load(AttnFrags& f, const bf16_t* kptr, const bf16_t* vptr, size_t vstride_d32) {
#pragma unroll
    for (int s = 0; s < 4; ++s) f.kf[s] = *(const bf16x8*)(kptr + 16 * s);
#pragma unroll
    for (int d = 0; d < 2; ++d)
#pragma unroll
        for (int q = 0; q < 4; ++q) f.vf[d][q] = *(const s16x4*)(vptr + (size_t)d * vstride_d32 + 8 * q);
}
DI void attn_block(const bf16x8 (&qf)[4], const AttnFrags& f, int mask_mode, int kq_off, int lane, float& m, float& lpart, f32x16 (&o)[2]) {
    const int h = lane >> 5;
    f32x16 st;
#pragma unroll
    for (int r = 0; r < 16; ++r) st[r] = 0.f;
#pragma unroll
    for (int s = 0; s < 4; ++s) st = MFMA32(f.kf[s], qf[s], st);
    if (mask_mode) {
#pragma unroll
        for (int r = 0; r < 16; ++r) { const int dlt = kq_off + crow(r, h); if (dlt > 128 || dlt < -128) st[r] = -1e30f; }
    }
    float bm = st[0];
#pragma unroll
    for (int r = 1; r < 16; ++r) bm = fmaxf(bm, st[r]);
    bm = fmaxf(bm, lane_x32(bm, h != 0));
    const float mn = fmaxf(m, bm);
    if (__builtin_amdgcn_ballot_w64(mn > m) != 0ull) {
        const float alpha = __builtin_amdgcn_exp2f(m - mn);
        lpart *= alpha;
#pragma unroll
        for (int d = 0; d < 2; ++d)
#pragma unroll
            for (int r = 0; r < 16; ++r) o[d][r] *= alpha;
        m = mn;
    }
    float ps = 0.f;
#pragma unroll
    for (int r = 0; r < 16; ++r) { st[r] = __builtin_amdgcn_exp2f(st[r] - m); ps += st[r]; }
    lpart += ps;
    const bf16x8 pf0 = pack8(st, 0), pf1 = pack8(st, 1);
#pragma unroll
    for (int d = 0; d < 2; ++d) {
        const bf16x8 v0 = __builtin_shufflevector(f.vf[d][0], f.vf[d][1], 0, 1, 2, 3, 4, 5, 6, 7), v1 = __builtin_shufflevector(f.vf[d][2], f.vf[d][3], 0, 1, 2, 3, 4, 5, 6, 7);
        o[d] = MFMA32(v0, pf0, o[d]);
        o[d] = MFMA32(v1, pf1, o[d]);
    }
}

DI void attn_task(const Params& p, int l, int task, int lane) {
    const int r = lane & 31, h = lane >> 5;
    const bf16_t* P = (const bf16_t*)(p.ws + WS_P);
    const bf16_t* VT = (const bf16_t*)(p.ws + WS_VT);
    const bf16_t* VTC = (const bf16_t*)(p.ws + WS_VTC);
    bf16_t* Y = (bf16_t*)(p.ws + WS_Y);
    const bool latent = task < 8192;
    int b, head, qb, q0row, p0;
    if (latent) { qb = task & 127; head = (task >> 7) & 7; b = task >> 10; p0 = qb * 32; q0row = b * SEQ + p0; }
    else { const int t2 = task - 8192; qb = t2 & 7; head = (t2 >> 3) & 7; b = t2 >> 6; p0 = qb * 32; q0row = TL + b * NCTX + p0; }
    const int hk = head >> 2;
    bf16x8 qf[4];
#pragma unroll
    for (int s = 0; s < 4; ++s) qf[s] = *(const bf16x8*)(P + (size_t)(q0row + r) * PW + head * 64 + 16 * s + 8 * h);
    float m = p.in[I_attn_sink][l * 8 + head] * LOG2E, lpart = (h == 0) ? 1.0f : 0.0f;
    f32x16 o[2];
#pragma unroll
    for (int d = 0; d < 2; ++d)
#pragma unroll
        for (int i = 0; i < 16; ++i) o[d][i] = 0.f;
    const int kb_lo = max(p0 - 128, 0), kb_hi = min(p0 + 128, SEQ - 32);
    const int nwin = latent ? ((kb_hi - kb_lo) >> 5) + 1 : 0, nblk = nwin + 8;
    const bf16_t* kwin = P + (size_t)(b * SEQ + r) * PW + KOFF + hk * 64 + 8 * h;
    const bf16_t* vwin = VT + ((size_t)(b * 2 + hk) * 64 + r) * VTS + 4 * h;
    const bf16_t* kctx = P + (size_t)(TL + b * NCTX + r) * PW + KOFF + hk * 64 + 8 * h;
    const bf16_t* vctx = VTC + ((size_t)(b * 2 + hk) * 64 + r) * NCTX + 4 * h;
    AttnFrags f0, f1, f2;
#define ATT_LOAD(F_, jj) do { const int j_ = min((jj), nblk - 1); \
        if (j_ < nwin) { const int kb_ = kb_lo + 32 * j_; attn_load(F_, kwin + (size_t)kb_ * PW, vwin + kb_, (size_t)32 * VTS); } \
        else { const int kb_ = 32 * (j_ - nwin); attn_load(F_, kctx + (size_t)kb_ * PW, vctx + kb_, (size_t)32 * NCTX); } } while (0)
#define ATT_COMP(F_, jj) do { const int j_ = (jj); if (j_ < nblk) { int mm_ = 0, kq_ = 0; \
        if (j_ < nwin) { const int kb_ = kb_lo + 32 * j_; mm_ = (kb_ == p0 - 128 || kb_ == p0 + 128) ? 1 : 0; kq_ = kb_ - (p0 + r); } \
        attn_block(qf, F_, mm_, kq_, lane, m, lpart, o); } } while (0)
    ATT_LOAD(f0, 0); ATT_LOAD(f1, 1);
#pragma unroll 1
    for (int j = 0; j < nblk; j += 3) {
        ATT_LOAD(f2, j + 2); ATT_COMP(f0, j);
        ATT_LOAD(f0, j + 3); ATT_COMP(f1, j + 1);
        ATT_LOAD(f1, j + 4); ATT_COMP(f2, j + 2);
    }
#undef ATT_LOAD
#undef ATT_COMP
    const float inv = 1.0f / (lpart + lane_x32(lpart, h != 0));
    bf16_t* yrow = Y + (size_t)(q0row + r) * D + head * 64;
#pragma unroll
    for (int d = 0; d < 2; ++d)
#pragma unroll
        for (int g = 0; g < 4; ++g) {
            u32x2 w; w.x = pk2(o[d][4 * g] * inv, o[d][4 * g + 1] * inv); w.y = pk2(o[d][4 * g + 2] * inv, o[d][4 * g + 3] * inv);
            *(u32x2*)(yrow + 32 * d + 8 * g + 4 * h) = w;
        }
}

DI void sgu_unit(const Params& p, const Frame& F, int l, int chunk) {
    constexpr int VS = 136;
    LAS float* part = (LAS float*)F.lds;
    LAS float* rq = part + 512;
    LAS bf16_t* vnT = (LAS bf16_t*)(F.lds + 4096);
    const bf16_t* VsT = (const bf16_t*)(p.ws + WS_VST) + (size_t)chunk * 256 * 128;
    const bf16_t* P = (const bf16_t*)(p.ws + WS_P);
    bf16_t* Y = (bf16_t*)(p.ws + WS_Y);
    __syncthreads();
    { const int q = F.tid & 127, part_i = F.tid >> 7; float ss = 0.f;
        for (int c = part_i * 64; c < part_i * 64 + 64; ++c) { const float v = bf2f(VsT[c * 128 + q]); ss += v * v; }
        part[part_i * 128 + q] = ss; }
    __syncthreads();
    if (F.tid < 128) rq[F.tid] = rsqrtf((part[F.tid] + part[128 + F.tid] + part[256 + F.tid] + part[384 + F.tid]) * (1.0f / 256.0f) + EPS);
    __syncthreads();
    for (int i = F.tid; i < 256 * 16; i += NTHREADS) {
        const int c = i >> 4, q8 = (i & 15) * 8;
        const u32x4 v = *(const u32x4*)(VsT + c * 128 + q8);
        u32x4 o;
#pragma unroll
        for (int j = 0; j < 4; ++j) o[j] = pk2(bflo(v[j]) * rq[q8 + 2 * j], bfhi(v[j]) * rq[q8 + 2 * j + 1]);
        *(LAS u32x4*)(vnT + c * VS + q8) = o;
    }
    __syncthreads();
    const int lane = F.lane, r = lane & 31, h = lane >> 5, g = F.wave >> 1, ph = F.wave & 1;
    const bf16_t* Wg = (const bf16_t*)(p.ws + WS_SGUW) + ((size_t)l * 4 + g) * 128 * 128;
#pragma unroll 1
    for (int pb = 0; pb < 2; ++pb) {
        const int p0 = 64 * ph + 32 * pb;
#pragma unroll 1
        for (int cb = 0; cb < 2; ++cb) {
            const int c0 = 64 * g + 32 * cb;
            f32x16 acc;
#pragma unroll
            for (int i = 0; i < 16; ++i) acc[i] = 0.f;
#pragma unroll
            for (int s = 0; s < 8; ++s) {
                const bf16x8 a = *(const LAS bf16x8*)(vnT + (c0 + r) * VS + 16 * s + 8 * h);
                const bf16x8 b = *(const bf16x8*)(Wg + (size_t)(p0 + r) * 128 + 16 * s + 8 * h);
                acc = MFMA32(a, b, acc);
            }
            const int row = chunk * 128 + p0 + r;
            const float bias = p.in[I_sgu_b][(l * 4 + g) * 128 + p0 + r];
#pragma unroll
            for (int q4 = 0; q4 < 4; ++q4) {
                const int cc = c0 + 8 * q4 + 4 * h;
                const u32x2 u = *(const u32x2*)(P + (size_t)row * PW + SUOFF + cc);
                u32x2 w;
                w.x = pk2(bflo(u.x) * (acc[4 * q4] + bias), bfhi(u.x) * (acc[4 * q4 + 1] + bias));
                w.y = pk2(bflo(u.y) * (acc[4 * q4 + 2] + bias), bfhi(u.y) * (acc[4 * q4 + 3] + bias));
                *(u32x2*)(Y + (size_t)row * D + 768 + cc) = w;
            }
        }
    }
}

DI void phase_mix(const Params& p, const Frame& F, int l, int ctr_slot = 0) {
    const int nrows = (l == 0) ? T : TL;
    const bf16_t* P = (const bf16_t*)(p.ws + WS_P);
    bf16_t* Y = (bf16_t*)(p.ws + WS_Y);
    for (int i = F.gtid; i < nrows * 32; i += F.ngt) {
        const int row = i >> 5, ck = i & 31, g = ck >> 3, half = 1 << g;
        int base, t, len;
        if (row < TL) { base = row & ~(SEQ - 1); t = row & (SEQ - 1); len = SEQ; } else { const int rc = row - TL; base = TL + (rc & ~(NCTX - 1)); t = rc & (NCTX - 1); len = NCTX; }
        const int lo = max(t - half, 0), hi = min(t + half, len);
        float s[8];
#pragma unroll
        for (int j = 0; j < 8; ++j) s[j] = 0.f;
        for (int tt = lo; tt < hi; ++tt) {
            const u32x4 v = *(const u32x4*)(P + (size_t)(base + tt) * PW + POOLOFF + ck * 8);
#pragma unroll
            for (int j = 0; j < 4; ++j) { s[2 * j] += bflo(v[j]); s[2 * j + 1] += bfhi(v[j]); }
        }
        const float inv = 1.0f / (float)(hi - lo);
        const u32x4 z = *(const u32x4*)(P + (size_t)row * PW + POOLOFF + ck * 8);
        u32x4 o;
#pragma unroll
        for (int j = 0; j < 4; ++j) o[j] = pk2(s[2 * j] * inv - bflo(z[j]), s[2 * j + 1] * inv - bfhi(z[j]));
        *(u32x4*)(Y + (size_t)row * D + 512 + ck * 8) = o;
    }
    const int nchunk = (l == 0) ? T / 128 : TL / 128;
    for (int ch = F.bid; ch < nchunk; ch += F.nb) sgu_unit(p, F, l, ch);
    const int ntask = (l == 0) ? 8192 + 512 : 8192;
    unsigned* ctr = (unsigned*)(p.ws + WS_CTL) + 16384 + 64 * (l + 2 * ctr_slot);
    for (;;) {
        unsigned t = 0;
        if (F.lane == 0) t = atomicAdd(ctr, 1u);
        const int task = (int)__builtin_amdgcn_readfirstlane(t);
        if (task >= ntask) break;
        attn_task(p, l, task, F.lane);
    }
}

DI void g2_simple(const Params& p, const Frame& F, int l, int row_lo, int nrows) {
    const bf16_t* H = (const bf16_t*)(p.ws + WS_H);
    const bf16_t* Yb = (const bf16_t*)(p.ws + WS_Y);
    const bf16_t* Wg = (const bf16_t*)(p.ws + WS_WIN) + (size_t)l * INW * D + (size_t)GATEOFF * D;
    const bf16_t* Wb = (const bf16_t*)(p.ws + WS_WBR) + (size_t)l * D * D;
    bf16_t* M = (bf16_t*)(p.ws + WS_MERGED);
    const int nit = (nrows / 64) * (D / 32);
    for (int it = F.gw; it < nit; it += F.ngw) {
        const int mt = it / (D / 32), nt = it % (D / 32), m0 = row_lo + mt * 64, n0 = nt * 32;
        f32x16 tot[2][1]; zero_acc(tot);
#pragma unroll 1
        for (int i = 0; i < 3; ++i) {
            const int koff = (i == 0) ? 0 : (i == 1 ? 512 : 768), kk = (i == 0) ? 512 : 256;
            f32x16 g[2][1], pr[2][1]; zero_acc(g); zero_acc(pr);
            wave_gemm<2, 1>(H, D, Wg + (size_t)i * D * D, D, D, m0, n0, g, F.lane);
            wave_gemm<2, 1>(Yb + koff, D, Wb + koff, D, kk, m0, n0, pr, F.lane);
#pragma unroll
            for (int a = 0; a < 2; ++a)
#pragma unroll
                for (int r = 0; r < 16; ++r) tot[a][0][r] += sigmoidf_(g[a][0][r]) * pr[a][0][r];
        }
        const int h = F.lane >> 5, col = n0 + (F.lane & 31);
#pragma unroll
        for (int a = 0; a < 2; ++a)
#pragma unroll
            for (int r = 0; r < 16; ++r) M[(size_t)(m0 + 32 * a + crow(r, h)) * D + col] = (bf16_t)f2bf(tot[a][0][r]);
    }
}
struct SchedG2 {
    int G, c; const char *H, *Y, *Wg, *Wb;
    DI bool next(int i, pg8::Unit& u) const {
        const int tile = (i / 6) * G + c; if (tile >= (TL / 256) * 4) return false;
        const int sub = i % 6, br = sub >> 1;
        pg8::tile_of(tile, TL / 256, 4, u.pm, u.pn); u.sub = sub;
        if ((sub & 1) == 0) { u.nt = 16; u.a = H + (size_t)u.pm * 256 * D * 2; u.b = Wg + ((size_t)br * D + u.pn * 256) * D * 2; }
        else { const int koff = (br == 0) ? 0 : (br == 1 ? 512 : 768); u.nt = (br == 0) ? 8 : 4;
               u.a = Y + ((size_t)u.pm * 256 * D + koff) * 2; u.b = Wb + ((size_t)u.pn * 256 * D + koff) * 2; }
        return true;
    }
};
struct EpiG2 {
    static constexpr bool PERM = true;
    bf16_t* scr; bf16_t* M;
    DI bool keeps(const pg8::Unit& u) const { return (u.sub & 1) == 0; }
    DI void operator()(f32x4 (&acc)[2][2][4][2], const pg8::Unit& u, int wr, int wc, int fr, int fq) const {
        const bool gate = (u.sub & 1) == 0, first = u.sub == 0;
#pragma unroll
        for (int ai = 0; ai < 2; ++ai) {
            u32x4 ld[4][2];
            if (!first) {
#pragma unroll
                for (int m = 0; m < 4; ++m)
#pragma unroll
                    for (int bj = 0; bj < 2; ++bj) {
                        const int rl = 128 * ai + 64 * wr + 16 * m + fr, cl = 128 * bj + 32 * wc + 8 * fq;
                        ld[m][bj] = gate ? *(const u32x4*)(M + (size_t)(u.pm * 256 + rl) * D + u.pn * 256 + cl) : *(const u32x4*)(scr + rl * 256 + cl);
                    }
            }
#pragma unroll
            for (int m = 0; m < 4; ++m)
#pragma unroll
                for (int bj = 0; bj < 2; ++bj) {
                    const int rl = 128 * ai + 64 * wr + 16 * m + fr, cl = 128 * bj + 32 * wc + 8 * fq;
                    if (gate) {
                        u32x4 o;
#pragma unroll
                        for (int j2 = 0; j2 < 4; ++j2) {
                            const int n = j2 >> 1, e = 2 * (j2 & 1);
                            const unsigned w = pk2(fmaxf(sigmoidf_(acc[ai][bj][m][n][e]), 1e-20f), fmaxf(sigmoidf_(acc[ai][bj][m][n][e + 1]), 1e-20f));
                            o[j2] = w;
                            const float t0 = first ? 0.f : bflo(ld[m][bj][j2]), t1 = first ? 0.f : bfhi(ld[m][bj][j2]);
                            acc[ai][bj][m][n][e] = t0 * __builtin_amdgcn_rcpf(bflo(w)); acc[ai][bj][m][n][e + 1] = t1 * __builtin_amdgcn_rcpf(bfhi(w));
                        }
                        *(u32x4*)(scr + rl * 256 + cl) = o;
                    } else {
                        u32x4 w;
#pragma unroll
                        for (int j2 = 0; j2 < 4; ++j2) { const int n = j2 >> 1, e = 2 * (j2 & 1);
                            w[j2] = pk2(acc[ai][bj][m][n][e] * bflo(ld[m][bj][j2]), acc[ai][bj][m][n][e + 1] * bfhi(ld[m][bj][j2])); }
                        *(u32x4*)(M + (size_t)(u.pm * 256 + rl) * D + u.pn * 256 + cl) = w;
                    }
                }
            asm volatile("" ::: "memory");
        }
    }
};
DI void phase_g2(const Params& p, const Frame& F, int l) {
    SchedG2 S{F.nb, F.bid, (const char*)(p.ws + WS_H), (const char*)(p.ws + WS_Y),
              (const char*)(p.ws + WS_WIN) + ((size_t)l * INW + GATEOFF) * D * 2, (const char*)(p.ws + WS_WBR) + (size_t)l * D * D * 2};
    EpiG2 E{(bf16_t*)(p.ws + WS_IDX) + (size_t)F.bid * 65536, (bf16_t*)(p.ws + WS_MERGED)};
    pg8::gemm_phase(F.lds, F.tid, S, E);
    if (l == 0) g2_simple(p, F, l, TL, TC);
}

DI void g3_simple(const Params& p, const Frame& F, int l, int row_lo, int nrows) {
    const bf16_t* M = (const bf16_t*)(p.ws + WS_MERGED);
    const bf16_t* W = (const bf16_t*)(p.ws + WS_WOUT) + (size_t)l * D * D;
    const int nit = (nrows / 64) * (D / 64);
    for (int it = F.gw; it < nit; it += F.ngw) {
        const int mt = it / (D / 64), nt = it % (D / 64), m0 = row_lo + mt * 64, n0 = nt * 64;
        f32x16 acc[2][2]; zero_acc(acc);
        wave_gemm<2, 2>(M, D, W, D, D, m0, n0, acc, F.lane);
        const int h = F.lane >> 5;
#pragma unroll
        for (int a = 0; a < 2; ++a)
#pragma unroll
            for (int j = 0; j < 2; ++j) {
                const int col = n0 + 32 * j + (F.lane & 31);
#pragma unroll
                for (int r = 0; r < 16; ++r) {
                    const int row = m0 + 32 * a + crow(r, h);
                    const float xs = (l == 0) ? xin_ptr(p, row)[col] : xrow_ptr(p, row)[col];
                    xrow_ptr(p, row)[col] = xs + mod_vec(p, l, row, 2)[col] * acc[a][j][r];
                }
            }
    }
}
struct EpiG3 {
    DI bool keeps(const pg8::Unit&) const { return false; }
    static constexpr bool PERM = false;
    const float* xsrc; float* xdst; const float* mod;
    DI void operator()(const f32x4 (&acc)[2][2][4][2], const pg8::Unit& u, int wr, int wc, int fr, int fq) const {
        const int col0 = u.pn * 256 + wc * 32 + 4 * fq;
        const float* gt = mod + (size_t)(u.pm >> 4) * NMOD + 2 * D;
        f32x4 gv[2][2];
#pragma unroll
        for (int bj = 0; bj < 2; ++bj)
#pragma unroll
            for (int n = 0; n < 2; ++n) gv[bj][n] = *(const f32x4*)(gt + col0 + 128 * bj + 16 * n);
#pragma unroll
        for (int ai = 0; ai < 2; ++ai) {
            f32x4 xv[4][2][2];
#pragma unroll
            for (int m = 0; m < 4; ++m)
#pragma unroll
                for (int bj = 0; bj < 2; ++bj)
#pragma unroll
                    for (int n = 0; n < 2; ++n) xv[m][bj][n] = *(const f32x4*)(xsrc + (size_t)(u.pm * 256 + wr * 64 + fr + 128 * ai + 16 * m) * D + col0 + 128 * bj + 16 * n);
#pragma unroll
            for (int m = 0; m < 4; ++m)
#pragma unroll
                for (int bj = 0; bj < 2; ++bj)
#pragma unroll
                    for (int n = 0; n < 2; ++n)
                        *(f32x4*)(xdst + (size_t)(u.pm * 256 + wr * 64 + fr + 128 * ai + 16 * m) * D + col0 + 128 * bj + 16 * n) = xv[m][bj][n] + gv[bj][n] * acc[ai][bj][m][n];
            asm volatile("" ::: "memory");
        }
    }
};
DI void phase_g3(const Params& p, const Frame& F, int l) {
    SchedGrid S{TL / 256, D / 256, F.nb, F.bid, (const char*)(p.ws + WS_MERGED), (const char*)(p.ws + WS_WOUT) + (size_t)l * D * D * 2};
    EpiG3 E{(l == 0) ? p.in[I_x] : p.out, p.out, (const float*)(p.ws + WS_MOD) + (size_t)l * 9 * NMOD};
    pg8::gemm_phase(F.lds, F.tid, S, E);
    if (l == 0) g3_simple(p, F, l, TL, TC);
}

DI void g45_simple(const Params& p, const Frame& F, int l, int row_lo, int nrows) {
    const bf16_t* H = (const bf16_t*)(p.ws + WS_H);
    const bf16_t* W = (const bf16_t*)(p.ws + WS_WFOLD) + (size_t)l * 2048 * D;
    _Float16* ST = (_Float16*)(p.ws + WS_ST);
    const int nit = (2048 / 64) * (nrows / 64);
    for (int it = F.gw; it < nit; it += F.ngw) {
        const int nt = it / 32, mt = it % 32, m0 = mt * 64, n0 = row_lo + nt * 64;
        f32x16 acc[2][2]; zero_acc(acc);
        wave_gemm<2, 2>(W, D, H, D, D, m0, n0, acc, F.lane);
        const int h = F.lane >> 5;
#pragma unroll
        for (int a = 0; a < 2; ++a)
#pragma unroll
            for (int j = 0; j < 2; ++j)
#pragma unroll
                for (int r = 0; r < 16; ++r) ST[(size_t)(m0 + 32 * a + crow(r, h)) * T + n0 + 32 * j + (F.lane & 31)] = (_Float16)acc[a][j][r];
    }
}
struct EpiG45 {
    DI bool keeps(const pg8::Unit&) const { return false; }
    static constexpr bool PERM = true;
    unsigned short* ST;
    DI void operator()(const f32x4 (&acc)[2][2][4][2], const pg8::Unit& u, int wr, int wc, int fr, int fq) const {
        const int col0 = u.pn * 256 + wc * 32 + 8 * fq;
#pragma unroll
        for (int ai = 0; ai < 2; ++ai)
#pragma unroll
            for (int m = 0; m < 4; ++m) {
                unsigned short* rowp = ST + (size_t)(u.pm * 256 + wr * 64 + fr + 128 * ai + 16 * m) * T + col0;
#pragma unroll
                for (int bj = 0; bj < 2; ++bj) {
                    u32x4 w;
                    w.x = pkh2(acc[ai][bj][m][0][0], acc[ai][bj][m][0][1]); w.y = pkh2(acc[ai][bj][m][0][2], acc[ai][bj][m][0][3]);
                    w.z = pkh2(acc[ai][bj][m][1][0], acc[ai][bj][m][1][1]); w.w = pkh2(acc[ai][bj][m][1][2], acc[ai][bj][m][1][3]);
                    *(u32x4*)(rowp + 128 * bj) = w;
                }
            }
    }
};
DI void phase_g45(const Params& p, const Frame& F, int l) {
    SchedGrid S{2048 / 256, TL / 256, F.nb, F.bid, (const char*)(p.ws + WS_WFOLD) + (size_t)l * 2048 * D * 2, (const char*)(p.ws + WS_H)};
    EpiG45 E{(unsigned short*)(p.ws + WS_ST)};
    pg8::gemm_phase(F.lds, F.tid, S, E);
    if (l == 0) g45_simple(p, F, l, TL, TC);
}

DI unsigned fkey(float f) { const unsigned u = __builtin_bit_cast(unsigned, f); return (u & 0x80000000u) ? ~u : (u | 0x80000000u); }
DI float fkey_inv(unsigned k) { const unsigned u = (k & 0x80000000u) ? (k & 0x7fffffffu) : ~k; return __builtin_bit_cast(float, u); }
#define INSERT16(L, x) do { unsigned x_ = (x); _Pragma("unroll") for (int k_ = 0; k_ < 16; ++k_) { const unsigned hi_ = max(L[k_], x_); x_ = min(L[k_], x_); L[k_] = hi_; } } while (0)
#define CEX(a, b) do { const unsigned hi_ = max(a, b), lo_ = min(a, b); a = hi_; b = lo_; } while (0)
DI void sort16_desc(unsigned (&v)[16]) {
#pragma unroll
    for (int k = 2; k <= 16; k <<= 1)
#pragma unroll
        for (int j = k >> 1; j > 0; j >>= 1)
#pragma unroll
            for (int i = 0; i < 16; ++i) {
                const int q = i ^ j;
                if (q > i) { if ((i & k) == 0) CEX(v[i], v[q]); else CEX(v[q], v[i]); }
            }
}
DI void merge16_desc(unsigned (&L)[16], const unsigned (&N)[16]) {
#pragma unroll
    for (int i = 0; i < 16; ++i) L[i] = max(L[i], N[15 - i]);
#pragma unroll
    for (int j = 8; j > 0; j >>= 1)
#pragma unroll
        for (int i = 0; i < 16; ++i) { const int q = i ^ j; if (q > i) CEX(L[i], L[q]); }
}
DI void phase_sel(const Params& p, const Frame& F, int l) {
    const _Float16* ST = (const _Float16*)(p.ws + WS_ST);
    unsigned short* IDX = (unsigned short*)(p.ws + WS_IDX);
    float* GW = (float*)(p.ws + WS_GW);
    float* SU = (float*)(p.ws + WS_SU);
    const float* TSC = (const float*)(p.ws + WS_TSCALE) + (size_t)l * 2 * NEXP;
    LAS unsigned char* ib = (LAS unsigned char*)F.lds;
    const int ntok = (l == 0) ? T : TL;
    for (int i0 = F.bid * NTHREADS; i0 < ntok * 8; i0 += F.nb * NTHREADS) {
        const int i = i0 + F.tid;
        const int tok = i % ntok, head = i / ntok;
        unsigned la[16], lb[16];
#pragma unroll
        for (int k = 0; k < 16; ++k) { la[k] = 0u; lb[k] = 0u; }
        const _Float16* s0 = ST + (size_t)(head * 256) * T + tok;
#define SEL_LOAD(B_, k0_) do { _Pragma("unroll") for (int j = 0; j < 32; ++j) B_[j] = s0[(size_t)((k0_) + j) * T]; } while (0)
#define SEL_INS(L_, B_, k0_) do { _Pragma("unroll") for (int h_ = 0; h_ < 2; ++h_) { unsigned nk_[16]; \
        _Pragma("unroll") for (int j = 0; j < 16; ++j) nk_[j] = (fkey((float)B_[16 * h_ + j]) & ~127u) | (unsigned)(127 - (((k0_) + 16 * h_ + j) & 127)); \
        sort16_desc(nk_); merge16_desc(L_, nk_); } } while (0)
        _Float16 bufa[32], bufb[32];
        SEL_LOAD(bufa, 0);
        SEL_LOAD(bufb, 32);  SEL_INS(la, bufa, 0);
        SEL_LOAD(bufa, 64);  SEL_INS(la, bufb, 32);
        SEL_LOAD(bufb, 96);  SEL_INS(la, bufa, 64);
        SEL_LOAD(bufa, 128); SEL_INS(la, bufb, 96);
        SEL_LOAD(bufb, 160); SEL_INS(lb, bufa, 128);
        SEL_LOAD(bufa, 192); SEL_INS(lb, bufb, 160);
        SEL_LOAD(bufb, 224); SEL_INS(lb, bufa, 192);
        SEL_INS(lb, bufb, 224);
#undef SEL_LOAD
#undef SEL_INS
        float va[16], vb[16];
#pragma unroll
        for (int k = 0; k < 16; ++k) {
            va[k] = fkey_inv(la[k] & ~127u); vb[k] = fkey_inv(lb[k] & ~127u);
            ib[k * NTHREADS + F.tid] = (unsigned char)(127u - (la[k] & 127u));
            ib[(16 + k) * NTHREADS + F.tid] = (unsigned char)(127u - (lb[k] & 127u));
        }
        unsigned lc[16];
#pragma unroll
        for (int k = 0; k < 16; ++k) lc[k] = 0u;
#pragma unroll
        for (int a = 0; a < 16; ++a)
#pragma unroll
            for (int b = 0; b < 16; ++b)
                if ((a + 1) * (b + 1) <= 16) { const unsigned key = (fkey(va[a] + vb[b]) & ~255u) | (unsigned)(255 - (a * 16 + b)); INSERT16(lc, key); }
        float e[16], sum = 0.f; const float v0 = fkey_inv(lc[0] & ~255u);
#pragma unroll
        for (int k = 0; k < 16; ++k) { e[k] = __expf(fkey_inv(lc[k] & ~255u) - v0); sum += e[k]; }
        const float inv = 1.0f / sum;
        asm volatile("s_waitcnt lgkmcnt(0)" ::: "memory");
#pragma unroll
        for (int k = 0; k < 16; ++k) {
            const unsigned pos = 255u - (lc[k] & 255u), a = pos >> 4, b = pos & 15u;
            const unsigned ea = ib[a * NTHREADS + F.tid], eb = ib[(16 + b) * NTHREADS + F.tid];
            const unsigned ex = ea * 128u + eb;
            IDX[(size_t)tok * 128 + head * 16 + k] = (unsigned short)ex;
            GW[(size_t)tok * 128 + head * 16 + k] = e[k] * inv * TSC[NEXP + ex];
            SU[(size_t)tok * 128 + head * 16 + k] = TSC[ex];
        }
        asm volatile("s_waitcnt lgkmcnt(0)" ::: "memory");
    }
}

DI float dpp_xor1(float v) { return __builtin_bit_cast(float, __builtin_amdgcn_mov_dpp(__builtin_bit_cast(int, v), 0xB1, 0xF, 0xF, true)); }
DI float dpp_xor2(float v) { return __builtin_bit_cast(float, __builtin_amdgcn_mov_dpp(__builtin_bit_cast(int, v), 0x4E, 0xF, 0xF, true)); }
DI float dpp_hmir(float v) { return __builtin_bit_cast(float, __builtin_amdgcn_mov_dpp(__builtin_bit_cast(int, v), 0x141, 0xF, 0xF, true)); }
DI float dot16_fp8(const u32x4 q, const float (&hx)[16]) {
    f32x2 a = {0.f, 0.f};
#pragma unroll
    for (int j = 0; j < 4; ++j) {
        const f32x2 lo = __builtin_amdgcn_cvt_pk_f32_fp8((int)q[j], false), hi = __builtin_amdgcn_cvt_pk_f32_fp8((int)q[j], true);
        a += lo * (f32x2){hx[4 * j], hx[4 * j + 1]}; a += hi * (f32x2){hx[4 * j + 2], hx[4 * j + 3]};
    }
    return a.x + a.y;
}
#define PEER_EXPERT(id, i) ((int)(((id)[(i) >> 3][((i) >> 1) & 3] >> (16 * ((i) & 1))) & 0xffffu))

struct PeerURows { u32x4 q[16]; u32x4 h0, h1; };
DI void peer_u_rows(PeerURows& R, const u32x4 (&id)[2], const unsigned char* ut, const bf16_t* hrow) {
    R.h0 = *(const u32x4*)(hrow); R.h1 = *(const u32x4*)(hrow + 8);
#pragma unroll
    for (int i = 0; i < 16; ++i) R.q[i] = *(const u32x4*)(ut + (size_t)PEER_EXPERT(id, i) * D);
}
DI void peer_u_compute(const PeerURows& R, float* part, int lane) {
    float hx[16];
#pragma unroll
    for (int j = 0; j < 4; ++j) { hx[2 * j] = bflo(R.h0[j]); hx[2 * j + 1] = bfhi(R.h0[j]); hx[8 + 2 * j] = bflo(R.h1[j]); hx[8 + 2 * j + 1] = bfhi(R.h1[j]); }
    float d[16];
#pragma unroll
    for (int i = 0; i < 16; ++i) d[i] = dot16_fp8(R.q[i], hx);
    const bool b2 = (lane & 4) != 0, b1 = (lane & 2) != 0, b0 = (lane & 1) != 0;
    float k8[8];
#pragma unroll
    for (int i = 0; i < 8; ++i) { const float keep = b2 ? d[8 + i] : d[i], send = b2 ? d[i] : d[8 + i]; k8[i] = keep + dpp_hmir(send); }
    float k4[4];
#pragma unroll
    for (int i = 0; i < 4; ++i) { const float keep = b1 ? k8[4 + i] : k8[i], send = b1 ? k8[i] : k8[4 + i]; k4[i] = keep + dpp_xor2(send); }
    f32x2 k2;
    { const float keep0 = b0 ? k4[2] : k4[0], send0 = b0 ? k4[0] : k4[2], keep1 = b0 ? k4[3] : k4[1], send1 = b0 ? k4[1] : k4[3];
      k2.x = keep0 + dpp_xor1(send0); k2.y = keep1 + dpp_xor1(send1); }
    *(f32x2*)(part + 16 * (lane >> 3) + (b2 ? 8 : 0) + (b1 ? 4 : 0) + (b0 ? 2 : 0)) = k2;
}
DI void phase_peer_u(const Params& p, const Frame& F, int l) {
    const int ntok = (l == 0) ? T : TL, lane = F.lane;
    const int slice = F.bid & 7, sw = (F.bid >> 3) * NWAVES + F.wave, nsw = (F.nb >> 3) * NWAVES;
    const unsigned char* ut = p.ws + WS_UTAB + (size_t)l * NEXP * D + 128 * slice + 16 * (lane & 7);
    const bf16_t* Hs = (const bf16_t*)(p.ws + WS_H) + 128 * slice + 16 * (lane & 7);
    const unsigned short* IDXg = (const unsigned short*)(p.ws + WS_IDX) + 16 * (lane >> 3);
    float* PART = (float*)(p.ws + WS_ST) + (size_t)slice * T * 128;
    const int last = ntok - 1;
    u32x4 sa[2], sb[2]; PeerURows ra, rb;
#define U_SEL(S_, t_) do { const unsigned short* ip_ = IDXg + (size_t)min((t_), last) * 128; S_[0] = *(const u32x4*)ip_; S_[1] = *(const u32x4*)(ip_ + 8); } while (0)
#define U_ROWS(R_, S_, t_) peer_u_rows(R_, S_, ut, Hs + (size_t)min((t_), last) * D)
    U_SEL(sa, sw); U_SEL(sb, sw + nsw);
    U_ROWS(ra, sa, sw);
#pragma unroll 1
    for (int tok = sw; tok < ntok; tok += 2 * nsw) {
        U_SEL(sa, tok + 2 * nsw); U_ROWS(rb, sb, tok + nsw);
        peer_u_compute(ra, PART + (size_t)tok * 128, lane);
        U_SEL(sb, tok + 3 * nsw); U_ROWS(ra, sa, tok + 2 * nsw);
        if (tok + nsw < ntok) peer_u_compute(rb, PART + (size_t)(tok + nsw) * 128, lane);
    }
#undef U_SEL
#undef U_ROWS
}
DI void phase_peer_c(const Params& p, const Frame& F, int l, bool dummy = false) {
    const int ntok = (l == 0) ? T : TL;
    const float* PART = (const float*)(p.ws + WS_ST);
    float* GW = (float*)(p.ws + WS_GW);
    float* CO = dummy ? (float*)(p.ws + WS_H8) : GW;
    const float* SU = (const float*)(p.ws + WS_SU);
    for (int i = F.gtid; i < ntok * 128; i += F.ngt) {
        float s = 0.f;
#pragma unroll
        for (int sl = 0; sl < 8; ++sl) s += PART[(size_t)sl * T * 128 + i];
        CO[i] = GW[i] * gelu_tanh(s * SU[i]);
    }
}
struct PeerVRows { u32x4 q[16]; f32x4 cf[4]; f32x2 xv, gv; };
DI void peer_v_rows(PeerVRows& R, const u32x4 (&id)[2], const unsigned char* vt, const float* cp, const float* xs, const float* gt2) {
    R.cf[0] = *(const f32x4*)cp; R.cf[1] = *(const f32x4*)(cp + 4); R.cf[2] = *(const f32x4*)(cp + 8); R.cf[3] = *(const f32x4*)(cp + 12);
    R.xv = *(const f32x2*)xs; R.gv = *(const f32x2*)gt2;
#pragma unroll
    for (int i = 0; i < 16; ++i) R.q[i] = *(const u32x4*)(vt + (size_t)PEER_EXPERT(id, i) * D);
}
DI float xchg32(float v, bool hi) { const auto r = __builtin_amdgcn_permlane32_swap(__builtin_bit_cast(unsigned, v), __builtin_bit_cast(unsigned, v), false, false);
    return __builtin_bit_cast(float, hi ? r[0] : r[1]); }
DI float xchg16(float v, bool hi) { const auto r = __builtin_amdgcn_permlane16_swap(__builtin_bit_cast(unsigned, v), __builtin_bit_cast(unsigned, v), false, false);
    return __builtin_bit_cast(float, hi ? r[0] : r[1]); }
DI float xchg8(float v) { return __builtin_bit_cast(float, __builtin_amdgcn_mov_dpp(__builtin_bit_cast(int, v), 0x128, 0xF, 0xF, true)); }
DI void peer_v_compute(const PeerVRows& R, float* xdst, int lane) {
    f32x2 a[8];
#pragma unroll
    for (int j = 0; j < 8; ++j) a[j] = (f32x2){0.f, 0.f};
#pragma unroll
    for (int i = 0; i < 16; ++i) {
        const float c = R.cf[i >> 2][i & 3]; const f32x2 c2 = {c, c};
#pragma unroll
        for (int j = 0; j < 4; ++j) {
            a[2 * j] += c2 * __builtin_amdgcn_cvt_pk_f32_fp8((int)R.q[i][j], false);
            a[2 * j + 1] += c2 * __builtin_amdgcn_cvt_pk_f32_fp8((int)R.q[i][j], true);
        }
    }
    const bool b5 = (lane & 32) != 0, b4 = (lane & 16) != 0, b3 = (lane & 8) != 0;
    f32x2 k4[4];
#pragma unroll
    for (int j = 0; j < 4; ++j) { const f32x2 keep = b5 ? a[4 + j] : a[j], send = b5 ? a[j] : a[4 + j];
        k4[j] = keep + (f32x2){xchg32(send.x, b5), xchg32(send.y, b5)}; }
    f32x2 k2[2];
#pragma unroll
    for (int j = 0; j < 2; ++j) { const f32x2 keep = b4 ? k4[2 + j] : k4[j], send = b4 ? k4[j] : k4[2 + j];
        k2[j] = keep + (f32x2){xchg16(send.x, b4), xchg16(send.y, b4)}; }
    f32x2 k1;
    { const f32x2 keep = b3 ? k2[1] : k2[0], send = b3 ? k2[0] : k2[1];
        k1 = keep + (f32x2){xchg8(send.x), xchg8(send.y)}; }
    *(f32x2*)xdst = R.xv + R.gv * k1;
}
DI void phase_peer_v(const Params& p, const Frame& F, int l, bool dummy = false) {
    const int ntok = (l == 0) ? T : TL, lane = F.lane;
    const int slice = F.bid & 7, sw = (F.bid >> 3) * NWAVES + F.wave, nsw = (F.nb >> 3) * NWAVES;
    const unsigned char* vt = p.ws + WS_VTAB + (size_t)l * NEXP * D + 128 * slice + 16 * (lane & 7);
    const unsigned short* IDXg = (const unsigned short*)(p.ws + WS_IDX) + 16 * (lane >> 3);
    const float* CFg = (const float*)(p.ws + WS_GW) + 16 * (lane >> 3);
    const int last = ntok - 1;
    u32x4 sa[2], sb[2]; PeerVRows ra, rb;
#define V_SEL(S_, t_) do { const unsigned short* ip_ = IDXg + (size_t)min((t_), last) * 128; S_[0] = *(const u32x4*)ip_; S_[1] = *(const u32x4*)(ip_ + 8); } while (0)
    const int co = 128 * slice + 16 * (lane & 7) + ((lane & 32) ? 8 : 0) + ((lane & 16) ? 4 : 0) + ((lane & 8) ? 2 : 0);
#define V_ROWS(R_, S_, t_) do { const int t1_ = min((t_), last); peer_v_rows(R_, S_, vt, CFg + (size_t)t1_ * 128, xrow_ptr(p, t1_) + co, mod_vec(p, l, t1_, 5) + co); } while (0)
#define V_DO(R_, t_) do { const int t2_ = (t_); float* xd_ = (dummy ? (float*)(p.ws + WS_ST) + (size_t)t2_ * D : xrow_ptr(p, t2_)) + co; peer_v_compute(R_, xd_, lane); } while (0)
    V_SEL(sa, sw); V_SEL(sb, sw + nsw);
    V_ROWS(ra, sa, sw);
#pragma unroll 1
    for (int tok = sw; tok < ntok; tok += 2 * nsw) {
        V_SEL(sa, tok + 2 * nsw); V_ROWS(rb, sb, tok + nsw);
        V_DO(ra, tok);
        V_SEL(sb, tok + 3 * nsw); V_ROWS(ra, sa, tok + 2 * nsw);
        if (tok + nsw < ntok) V_DO(rb, tok + nsw);
    }
#undef V_SEL
#undef V_ROWS
#undef V_DO
}

#define XB_TMO      128
#define XB_XCNT(j)  (256  + 64 * (j))
#define XB_XSUB(j)  (1280 + 64 * (j))
#define XB_XGEN(j)  (2304 + 64 * (j))
#define XB_TOP      3328
#define XB_TOPGEN   3392
#define XCD_BAR_WORDS 3456
#define XB_SPIN_CAP (1u << 18)
DI unsigned xb_ld(unsigned* p)              { return __hip_atomic_load(p, __ATOMIC_RELAXED, __HIP_MEMORY_SCOPE_AGENT); }
DI unsigned xb_add(unsigned* p, unsigned v) { return __hip_atomic_fetch_add(p, v, __ATOMIC_RELAXED, __HIP_MEMORY_SCOPE_AGENT); }
DI unsigned xb_xcc_id() { return (unsigned)__builtin_amdgcn_s_getreg((3 << 11) | 20) & 0xFu; }
#define XB_SPIN(cond, bar) do { unsigned _sp = 0; while (cond) { __builtin_amdgcn_s_sleep(1); \
    if ((++_sp & 255u) == 0u) { if (xb_ld(&(bar)[XB_TMO])) break; if (_sp > XB_SPIN_CAP) { atomicAdd(&(bar)[XB_TMO], 1u); break; } } } } while (0)
struct XcdBarrier { unsigned* bar; unsigned x; volatile LAS unsigned* st; };
DI XcdBarrier xcd_barrier_post(unsigned* bar, volatile LAS unsigned* st) {
    XcdBarrier b; b.bar = bar; b.x = xb_xcc_id(); b.st = st;
    if (threadIdx.x == 0) (void)xb_add(&bar[XB_XCNT(b.x)], 1u);
    return b;
}
DI void xcd_barrier_complete(unsigned* bar, unsigned x, unsigned& nloc, unsigned& nx) {
    const unsigned G = gridDim.x * gridDim.y * gridDim.z;
    unsigned sum, cnt, mine, sp = 0u;
    for (;;) {
        sum = 0u; cnt = 0u; mine = 0u;
#pragma unroll
        for (unsigned j = 0; j < 16; ++j) { const unsigned c = xb_ld(&bar[XB_XCNT(j)]); sum += c; cnt += (c > 0u) ? 1u : 0u; mine = (j == x) ? c : mine; }
        if (sum == G) break;
        __builtin_amdgcn_s_sleep(1);
        if ((++sp & 255u) == 0u) { if (xb_ld(&bar[XB_TMO])) break; if (sp > XB_SPIN_CAP) { atomicAdd(&bar[XB_TMO], 1u); break; } }
    }
    nloc = mine > 0u ? mine : 1u; nx = cnt > 0u ? cnt : 1u;
}
DI void xcd_barrier(const XcdBarrier& b) {
    asm volatile("s_waitcnt vmcnt(0)" ::: "memory");
    __syncthreads();
    if (threadIdx.x == 0) {
        unsigned* bar = b.bar;
        __builtin_amdgcn_s_waitcnt(0);
        unsigned nloc = b.st[0], nx = b.st[1];
        if (nloc == 0u) { xcd_barrier_complete(bar, b.x, nloc, nx); b.st[0] = nloc; b.st[1] = nx; }
        const unsigned old = xb_add(&bar[XB_XSUB(b.x)], 1u);
        const unsigned gen = old / nloc;
        if (old + 1u == (gen + 1u) * nloc) {
            __builtin_amdgcn_fence(__ATOMIC_RELEASE, "agent");
            asm volatile("s_waitcnt vmcnt(0)" ::: "memory");
            const unsigned og = xb_add(&bar[XB_TOP], 1u);
            const unsigned tg = og / nx;
            if (og + 1u == (tg + 1u) * nx) xb_add(&bar[XB_TOPGEN], 1u);
            else XB_SPIN(xb_ld(&bar[XB_TOPGEN]) == tg, bar);
            __builtin_amdgcn_fence(__ATOMIC_ACQUIRE, "agent");
            xb_add(&bar[XB_XGEN(b.x)], 1u);
            asm volatile("s_waitcnt vmcnt(0)" ::: "memory");
        } else {
            XB_SPIN(xb_ld(&bar[XB_XGEN(b.x)]) == gen, bar);
            __builtin_amdgcn_fence(__ATOMIC_ACQUIRE, "agent");
            asm volatile("s_waitcnt vmcnt(0)" ::: "memory");
        }
    }
    __syncthreads();
}
constexpr int LDS_BAR_OFF = 135168;

constexpr int NPHASE = 24;
template <int PH> DI void run_phase(const Params& p, const Frame& F) {
    if constexpr (PH == 0) phase_prep(p, F);
    else if constexpr (PH == 1) phase_norm(p, F, 0, 0, true, T);
    else if constexpr (PH == 2) phase_g1(p, F, 0);
    else if constexpr (PH == 3) phase_mix(p, F, 0);
    else if constexpr (PH == 4) phase_g2(p, F, 0);
    else if constexpr (PH == 5) phase_g3(p, F, 0);
    else if constexpr (PH == 6) phase_norm(p, F, 0, 1, false, T);
    else if constexpr (PH == 7) phase_g45(p, F, 0);
    else if constexpr (PH == 8) phase_sel(p, F, 0);
    else if constexpr (PH == 9) phase_peer_u(p, F, 0);
    else if constexpr (PH == 10) phase_peer_c(p, F, 0);
    else if constexpr (PH == 11) phase_peer_v(p, F, 0);
    else if constexpr (PH == 12) phase_norm(p, F, 1, 0, false, T);
    else if constexpr (PH == 13) phase_g1(p, F, 1);
    else if constexpr (PH == 14) phase_mix(p, F, 1);
    else if constexpr (PH == 15) phase_g2(p, F, 1);
    else if constexpr (PH == 16) phase_g3(p, F, 1);
    else if constexpr (PH == 17) phase_norm(p, F, 1, 1, false, TL);
    else if constexpr (PH == 18) phase_g45(p, F, 1);
    else if constexpr (PH == 19) phase_sel(p, F, 1);
    else if constexpr (PH == 20) phase_peer_u(p, F, 1);
    else if constexpr (PH == 21) phase_peer_c(p, F, 1);
    else if constexpr (PH == 22) phase_peer_v(p, F, 1);
    else if constexpr (PH == 23) phase_final(p, F);
}
DI Frame make_frame(unsigned char* lds_raw) {
    Frame F;
    F.lds = (LAS unsigned char*)lds_raw;
    int tid = threadIdx.x; asm volatile("" : "+v"(tid));
    int bid = blockIdx.x, nb = gridDim.x; asm volatile("" : "+s"(bid), "+s"(nb));
    F.tid = tid; F.lane = tid & 63; F.wave = __builtin_amdgcn_readfirstlane(tid >> 6); F.bid = bid; F.nb = nb;
    F.gw = bid * NWAVES + F.wave; F.ngw = nb * NWAVES; F.gtid = bid * NTHREADS + tid; F.ngt = nb * NTHREADS;
    return F;
}
template <int PH> DI void run_phase_fresh(unsigned char* lds_raw) {
#if defined(__HIP_DEVICE_COMPILE__)
    const __attribute__((address_space(4))) unsigned long long* pp = (const __attribute__((address_space(4))) unsigned long long*)__builtin_amdgcn_kernarg_segment_ptr();
    asm volatile("" : "+s"(pp));
    Params p;
#pragma unroll
    for (int i = 0; i < N_IN; ++i) p.in[i] = (const float*)(const __attribute__((address_space(1))) float*)pp[i];
    p.out = (float*)(__attribute__((address_space(1))) float*)pp[N_IN]; p.ws = (unsigned char*)(__attribute__((address_space(1))) unsigned char*)pp[N_IN + 1]; p.ph_lo = 0; p.ph_hi = 0;
#else
    Params p{};
#endif
    const Frame F = make_frame(lds_raw);
    run_phase<PH>(p, F);
}
template <int PH> __global__ void __launch_bounds__(NTHREADS, 2) phase_kernel(Params p) {
    extern __shared__ __attribute__((aligned(16))) unsigned char lds_raw[];
    run_phase_fresh<PH>(lds_raw);
}
template <int PH> DI void run_all(unsigned char* lds_raw, cg::grid_group& grid, const XcdBarrier& bar) {
    if constexpr (PH < NPHASE) {
        if constexpr (PH == PROBE_PH) {
            if constexpr (PH == 10 || PH == 21 || PH == 11 || PH == 22 || PH == 3 || PH == 14) {
#if defined(__HIP_DEVICE_COMPILE__)
                const __attribute__((address_space(4))) unsigned long long* pp = (const __attribute__((address_space(4))) unsigned long long*)__builtin_amdgcn_kernarg_segment_ptr();
                asm volatile("" : "+s"(pp));
                Params p;
#pragma unroll
                for (int i = 0; i < N_IN; ++i) p.in[i] = (const float*)(const __attribute__((address_space(1))) float*)pp[i];
                p.out = (float*)(__attribute__((address_space(1))) float*)pp[N_IN]; p.ws = (unsigned char*)(__attribute__((address_space(1))) unsigned char*)pp[N_IN + 1]; p.ph_lo = 0; p.ph_hi = 0;
                const Frame F = make_frame(lds_raw);
                if constexpr (PH == 3 || PH == 14) phase_mix(p, F, PH == 3 ? 0 : 1, 1);
                else if constexpr (PH == 10 || PH == 21) phase_peer_c(p, F, PH == 10 ? 0 : 1, true); else phase_peer_v(p, F, PH == 11 ? 0 : 1, true);
#endif
            } else run_phase_fresh<PH>(lds_raw);
            xcd_barrier(bar);
        }
        run_phase_fresh<PH>(lds_raw);
        if constexpr (PH == 0) grid.sync();
        else if constexpr (PH + 1 < NPHASE) { xcd_barrier(bar); if constexpr (PROBE_SYNC) xcd_barrier(bar); }
        run_all<PH + 1>(lds_raw, grid, bar);
    }
}
__global__ void __launch_bounds__(NTHREADS, 2) mega(Params p) {
    extern __shared__ __attribute__((aligned(16))) unsigned char lds_raw[];
    cg::grid_group grid = cg::this_grid();
    volatile LAS unsigned* st = (volatile LAS unsigned*)((LAS unsigned char*)lds_raw + LDS_BAR_OFF);
    if (threadIdx.x < 2) st[threadIdx.x] = 0u;
    __syncthreads();
    const XcdBarrier bar = xcd_barrier_post((unsigned*)(p.ws + WS_CTL), st);
    run_all<0>(lds_raw, grid, bar);
}

extern "C" void kernel_launch(void* const* d_in, const int* in_sizes, int n_in, void* d_out, int out_size, void* d_ws, size_t ws_size, hipStream_t stream) {
    static int grid = 0;
    if (grid == 0) {
        if (n_in != 23 || out_size != TL * D || ws_size < WS_END) { fprintf(stderr, "kernel_launch: unexpected shapes (n_in %d out %d ws %zu)\n", n_in, out_size, ws_size); grid = -1; return; }
        int dev = 0, cus = 0, per_cu = 0;
        (void)hipGetDevice(&dev);
        (void)hipDeviceGetAttribute(&cus, hipDeviceAttributeMultiprocessorCount, dev);
        (void)hipFuncSetAttribute((const void*)mega, hipFuncAttributeMaxDynamicSharedMemorySize, LDS_BYTES);
        (void)hipOccupancyMaxActiveBlocksPerMultiprocessor(&per_cu, (const void*)mega, NTHREADS, LDS_BYTES);
        if (per_cu < 1) { fprintf(stderr, "kernel_launch: occupancy query reports %d blocks per CU\n", per_cu); grid = -1; return; }
        grid = cus & ~7;
        if (grid < 8) { fprintf(stderr, "kernel_launch: needs at least 8 CUs\n"); grid = -1; return; }
    }
    if (grid < 0) return;
    (void)hipMemsetAsync((char*)d_ws + WS_CTL, 0, CTL_ZERO_BYTES, stream);
    Params p{};
    for (int i = 0; i < N_IN; ++i) p.in[i] = (const float*)d_in[i];
    p.out = (float*)d_out; p.ws = (unsigned char*)d_ws;
    void* args[] = {&p};
    hipError_t e = hipLaunchCooperativeKernel((const void*)mega, dim3(grid), dim3(NTHREADS), args, LDS_BYTES, stream);
    if (e != hipSuccess) fprintf(stderr, "cooperative launch failed: %s (grid %d)\n", hipGetErrorString(e), grid);
}
```

```cpp
#include <hip/hip_runtime.h>
#include <hip/hip_cooperative_groups.h>
#include <stdint.h>
#include <stdio.h>
namespace cg = cooperative_groups;

#ifndef PROBE_PH
#define PROBE_PH -1
#endif
#ifndef PROBE_SYNC
#define PROBE_SYNC 0
#endif
#ifndef MK_SINGLE
#define MK_SINGLE 0
#endif

#define LAS __attribute__((address_space(3)))
typedef unsigned short bf16_t;
typedef short bf16x8 __attribute__((ext_vector_type(8)));
typedef short s16x4 __attribute__((ext_vector_type(4)));
typedef float f32x4 __attribute__((ext_vector_type(4)));
typedef float f32x2 __attribute__((ext_vector_type(2)));
typedef float f32x16 __attribute__((ext_vector_type(16)));
typedef unsigned u32x4 __attribute__((ext_vector_type(4)));
typedef unsigned u32x2 __attribute__((ext_vector_type(2)));
typedef __bf16 bf16x2_t __attribute__((ext_vector_type(2)));
typedef _Float16 f16x2_t __attribute__((ext_vector_type(2)));
#define DI __device__ __forceinline__
DI unsigned pkh2(float lo, float hi) { f16x2_t v = {(_Float16)lo, (_Float16)hi}; return __builtin_bit_cast(unsigned, v); }
#define MFMA32(a, b, c) __builtin_amdgcn_mfma_f32_32x32x16_bf16((a), (b), (c), 0, 0, 0)

constexpr int D = 1024, NB = 8, SEQ = 4096, NCTX = 256, DEPTH = 2;
constexpr int TL = NB * SEQ, TC = NB * NCTX, T = TL + TC;
constexpr int INW = 4608, NMOD = 6 * D, PW = 1600, PN = 1536;
constexpr int VTS = SEQ + 64;
constexpr int QOFF = 0, KOFF = 512, VOFF = 640, POOLOFF = 768, SUOFF = 1024, SVOFF = 1280, GATEOFF = 1536;
constexpr int NEXP = 16384;
constexpr float EPS = 1e-6f;
constexpr float LOG2E = 1.4426950408889634f;
constexpr float QSCALE = 0.125f * LOG2E;

constexpr size_t MiB = 1u << 20;
constexpr size_t WS_CTL = 0, WS_MOD = 1 * MiB, CTL_ZERO_BYTES = 2 * MiB;
constexpr size_t WS_ROPE = 2 * MiB, WS_SGUW = 2 * MiB + 65536, WS_TSCALE = 3 * MiB;
constexpr size_t WS_WIN = 4 * MiB, WS_WBR = 22 * MiB, WS_WOUT = 26 * MiB, WS_WFOLD = 30 * MiB;
constexpr size_t WS_XCTX = 38 * MiB, WS_UTAB = 46 * MiB, WS_VTAB = 78 * MiB;
constexpr size_t WS_IDX = 110 * MiB, WS_GW = 120 * MiB;
constexpr size_t WS_H = 142 * MiB;
constexpr size_t WS_P = 210 * MiB, WS_Y = 318 * MiB, WS_MERGED = 386 * MiB, WS_VT = 454 * MiB, WS_VTC = 463 * MiB, WS_VST = 464 * MiB;
constexpr size_t WS_ST = 210 * MiB, WS_H8 = 346 * MiB, WS_HS = 380 * MiB, WS_SU = 482 * MiB;
constexpr size_t WS_END = 512 * MiB;
static_assert(WS_ST + (size_t)2048 * T * 2 <= WS_H8 && WS_H8 + (size_t)T * D <= WS_HS, "ST / H8 fit");
static_assert(WS_VST + (size_t)272 * 256 * 128 * 2 <= WS_SU && WS_VT + (size_t)NB * 2 * 64 * VTS * 2 <= WS_VTC, "VsT / VT fit");
static_assert(WS_H + (size_t)T * D * 2 <= WS_P, "H fits");
static_assert(WS_P + (size_t)T * PW * 2 <= WS_Y && WS_Y + (size_t)T * D * 2 <= WS_MERGED && WS_MERGED + (size_t)T * D * 2 <= WS_VT, "P/Y/MERGED fit");
static_assert(WS_IDX + (size_t)T * 128 * 2 <= WS_GW && WS_GW + (size_t)T * 128 * 4 <= WS_H && WS_SU + (size_t)T * 128 * 4 <= WS_END && WS_HS + (size_t)T * 4 <= WS_SU, "idx/gw/su fit");

constexpr int LDS_BYTES = 163840;
constexpr int LDS_BAR_OFF = LDS_BYTES - 64;
constexpr int NTHREADS = 512, NWAVES = 8;

enum { I_x, I_c, I_ctx, I_c_ctx, I_w_mod, I_b_mod, I_g_mix, I_g_ffn, I_w_in, I_attn_sink, I_pool_w, I_pool_scale, I_sgu_w, I_sgu_b, I_w_br_attn, I_w_br_pool, I_w_br_sgu, I_w_out, I_peer_wq, I_peer_subkeys, I_peer_u, I_peer_v, I_g_final, N_IN };
struct Params {
    const float* in[N_IN];
    float* out; unsigned char* ws;
    int ph_lo, ph_hi;
};

DI unsigned f2bf(float f) { unsigned u = __builtin_bit_cast(unsigned, f); return (u + 0x7fffu + ((u >> 16) & 1u)) >> 16; }
DI unsigned pk2(float lo, float hi) { return f2bf(lo) | (f2bf(hi) << 16); }
DI float bf2f(unsigned short u) { return __builtin_bit_cast(float, (unsigned)u << 16); }
DI float bflo(unsigned w) { return __builtin_bit_cast(float, w << 16); }
DI float bfhi(unsigned w) { return __builtin_bit_cast(float, w & 0xffff0000u); }
DI int crow(int reg, int h) { return (reg & 3) + 8 * (reg >> 2) + 4 * h; }
DI float wave_sum(float v) {
#pragma unroll
    for (int o = 1; o < 64; o <<= 1) v += __shfl_xor(v, o);
    return v;
}
DI float sigmoidf_(float x) { return 1.0f / (1.0f + __expf(-x)); }
DI float gelu_tanh(float x) { const float u = 0.7978845608028654f * (x + 0.044715f * x * x * x); return x / (1.0f + __expf(-2.0f * u)); }
DI float silu_(float x) { return x / (1.0f + __expf(-x)); }

struct Frame {
    int tid, lane, wave, gw, ngw, gtid, ngt, bid, nb;
    LAS unsigned char* lds;
};

template <int NM, int NN>
DI void wave_gemm(const bf16_t* __restrict__ A, int lda, const bf16_t* __restrict__ Bt, int ldb, int K, int m0, int n0, f32x16 (&acc)[NM][NN], int lane) {
    const int r = lane & 31, h = lane >> 5;
    const bf16_t* ap = A + (size_t)(m0 + r) * lda + 8 * h;
    const bf16_t* bp = Bt + (size_t)(n0 + r) * ldb + 8 * h;
    for (int k0 = 0; k0 < K; k0 += 64) {
        bf16x8 a[4][NM], b[4][NN];
#pragma unroll
        for (int s = 0; s < 4; ++s) {
#pragma unroll
            for (int i = 0; i < NM; ++i) a[s][i] = *(const bf16x8*)(ap + (size_t)(32 * i) * lda + k0 + 16 * s);
#pragma unroll
            for (int j = 0; j < NN; ++j) b[s][j] = *(const bf16x8*)(bp + (size_t)(32 * j) * ldb + k0 + 16 * s);
        }
#pragma unroll
        for (int s = 0; s < 4; ++s)
#pragma unroll
            for (int i = 0; i < NM; ++i)
#pragma unroll
                for (int j = 0; j < NN; ++j) acc[i][j] = MFMA32(a[s][i], b[s][j], acc[i][j]);
    }
}
template <int NM, int NN> DI void zero_acc(f32x16 (&acc)[NM][NN]) {
#pragma unroll
    for (int i = 0; i < NM; ++i)
#pragma unroll
        for (int j = 0; j < NN; ++j)
#pragma unroll
            for (int r = 0; r < 16; ++r) acc[i][j][r] = 0.f;
}

namespace pg8 {
constexpr int BM = 256, BK = 64, HALF = 128, HTB = HALF * BK * 2, STAGE_BYTES = 8 * HTB, NXCD = 8, WGM = 8, LD = 1024;
DI int lds_byte(int r, int c) { const int st = (r >> 4) * 2 + (c >> 5), rr = r & 15, cc = c & 31, ob = rr * 64 + cc * 2; return st * 1024 + (ob ^ (((ob >> 9) & 1) << 5)); }
DI void stage_rc(int b, int& R, int& C) { const int st = b / 1024, sb = b % 1024, swz = sb ^ (((sb >> 9) & 1) << 5); R = (st >> 1) * 16 + swz / 64; C = (st & 1) * 32 + (swz % 64) / 2; }
DI int perm32(int rho) { const int n = rho >> 4, i = rho & 15; return 8 * (i >> 2) + 4 * n + (i & 3); }
struct Unit { int pm, pn, sub, nt; const char* a; const char* b; };
DI void tile_of(int L, int nM, int nN, int& pm, int& pn) {
    const int nwg = nM * nN; int wgid = L;
    { const int q = nwg / NXCD, r = nwg % NXCD, xcd = wgid % NXCD, off = wgid / NXCD; wgid = (xcd < r ? xcd * (q + 1) : r * (q + 1) + (xcd - r) * q) + off; }
    const int nig = WGM * nN, gid = wgid / nig, fm = gid * WGM, gsz = (nM - fm) < WGM ? (nM - fm) : WGM;
    pm = fm + ((wgid % nig) % gsz); pn = (wgid % nig) / gsz;
}
template <class Epi, class Sched>
DI void gemm_phase(LAS unsigned char* lds, const int tid, const Sched& S, const Epi& E) {
    const int wid = __builtin_amdgcn_readfirstlane(tid >> 6), lane = tid & 63, wr = wid >> 2, wc = wid & 3, fr = lane & 15, fq = lane >> 4;
    unsigned voffA[2], voffB[2];
#pragma unroll
    for (int i = 0; i < 2; ++i) { int R, C; stage_rc(tid * 16 + i * 8192, R, C); const int Rb = Epi::PERM ? ((R & ~31) + perm32(R & 31)) : R;
        voffA[i] = (unsigned)(R * LD + C) * 2u; voffB[i] = (unsigned)(Rb * LD + C) * 2u; }
    const size_t kstep = (size_t)(BK * 2);
    const size_t hstep = (size_t)HALF * LD * 2;
    const unsigned ldsw = (unsigned)wid * 1024u;
    const int aoff = lds_byte(wr * 64 + fr, fq * 8), boff = lds_byte(wc * 32 + fr, fq * 8);
#define PG8_SA(b, h) (((b) * 2 + (h)) * HTB)
#define PG8_SB(b, h) ((4 + (b) * 2 + (h)) * HTB)
#define PG8_STAGE(bufoff, gbase, voff) do { _Pragma("unroll") for (int _i = 0; _i < 2; ++_i) \
        __builtin_amdgcn_global_load_lds((const unsigned*)((const char*)(gbase) + (voff)[_i]), (LAS unsigned*)(lds + (bufoff) + ldsw + _i * 8192), 16, 0, 0); } while (0)
#define PG8_LDA(dst, b, h) do { _Pragma("unroll") for (int m = 0; m < 4; ++m) _Pragma("unroll") for (int k = 0; k < 2; ++k) dst[m][k] = *(const LAS bf16x8*)(lds + PG8_SA(b, h) + aoff + m * 2048 + k * 1024); } while (0)
#define PG8_LDB(dst, b, h) do { _Pragma("unroll") for (int n = 0; n < 2; ++n) _Pragma("unroll") for (int k = 0; k < 2; ++k) dst[n][k] = *(const LAS bf16x8*)(lds + PG8_SB(b, h) + boff + n * 2048 + k * 1024); } while (0)
#define PG8_MMA(ai, bj, At, Bt) do { __builtin_amdgcn_s_setprio(1); _Pragma("unroll") for (int m = 0; m < 4; ++m) _Pragma("unroll") for (int n = 0; n < 2; ++n) _Pragma("unroll") for (int k = 0; k < 2; ++k) \
        acc[ai][bj][m][n] = __builtin_amdgcn_mfma_f32_16x16x32_bf16(Bt[n][k], At[m][k], acc[ai][bj][m][n], 0, 0, 0); __builtin_amdgcn_s_setprio(0); } while (0)
#define PG8_WAIT_V(n) asm volatile("s_waitcnt vmcnt(" #n ")" ::: "memory")
#define PG8_WAIT_L(n) asm volatile("s_waitcnt lgkmcnt(" #n ")" ::: "memory")
#define PG8_BAR __builtin_amdgcn_s_barrier()
#define PG8_SCHED __builtin_amdgcn_sched_barrier(0)
    Unit cur, nxt; int ui = 0;
    if (!S.next(0, cur)) return;
    f32x4 acc[2][2][4][2];
#pragma unroll
    for (int a = 0; a < 2; ++a)
#pragma unroll
        for (int b = 0; b < 2; ++b)
#pragma unroll
            for (int m = 0; m < 4; ++m)
#pragma unroll
                for (int n = 0; n < 2; ++n) acc[a][b][m][n] = (f32x4){0.f, 0.f, 0.f, 0.f};
    bf16x8 At[4][2], B0[2][2], B1[2][2];
    const char* cA = cur.a; const char* cB = cur.b;
    PG8_STAGE(PG8_SB(0, 0), cB, voffB); PG8_STAGE(PG8_SB(0, 1), cB + hstep, voffB); PG8_STAGE(PG8_SA(0, 0), cA, voffA); PG8_STAGE(PG8_SA(0, 1), cA + hstep, voffA);
    if (wr == 1) PG8_BAR;
    PG8_WAIT_V(2); PG8_BAR;
    PG8_STAGE(PG8_SB(1, 0), cB + kstep, voffB); PG8_STAGE(PG8_SA(1, 0), cA + kstep, voffA); PG8_STAGE(PG8_SB(1, 1), cB + hstep + kstep, voffB);
    PG8_WAIT_V(6); PG8_BAR;
    for (;;) {
        const bool has_next = S.next(ui + 1, nxt);
        const char* nA = has_next ? nxt.a : cA; const char* nB = has_next ? nxt.b : cB;
        const int nt = cur.nt;
        for (int t = 0; t < nt; t += 2) {
            const bool last = (t == nt - 2);
            const char* a1 = cA + (size_t)(t + 1) * kstep;
            const char* a2 = last ? nA : cA + (size_t)(t + 2) * kstep; const char* b2 = last ? nB : cB + (size_t)(t + 2) * kstep;
            const char* a3 = a2 + kstep; const char* b3 = b2 + kstep;
            PG8_LDB(B0, 0, 0); PG8_LDB(B1, 0, 1); PG8_SCHED; PG8_LDA(At, 0, 0); PG8_STAGE(PG8_SA(1, 1), a1 + hstep, voffA);
            PG8_WAIT_V(8); PG8_WAIT_L(0); PG8_BAR; PG8_MMA(0, 0, At, B0); PG8_MMA(0, 1, At, B1); PG8_BAR; PG8_SCHED;
            PG8_LDA(At, 0, 1); PG8_STAGE(PG8_SB(0, 0), b2, voffB); PG8_STAGE(PG8_SB(0, 1), b2 + hstep, voffB); PG8_STAGE(PG8_SA(0, 0), a2, voffA);
            PG8_WAIT_V(8); PG8_WAIT_L(0); PG8_BAR; PG8_MMA(1, 0, At, B0); PG8_MMA(1, 1, At, B1); PG8_BAR; PG8_SCHED;
            PG8_LDB(B0, 1, 0); PG8_LDB(B1, 1, 1); PG8_SCHED; PG8_LDA(At, 1, 0); PG8_STAGE(PG8_SA(0, 1), a2 + hstep, voffA);
            PG8_WAIT_V(8); PG8_WAIT_L(0); PG8_BAR; PG8_MMA(0, 0, At, B0); PG8_MMA(0, 1, At, B1); PG8_BAR; PG8_SCHED;
            PG8_LDA(At, 1, 1); PG8_STAGE(PG8_SB(1, 0), b3, voffB); PG8_STAGE(PG8_SB(1, 1), b3 + hstep, voffB); PG8_STAGE(PG8_SA(1, 0), a3, voffA);
            PG8_WAIT_V(8); PG8_WAIT_L(0); PG8_BAR; PG8_MMA(1, 0, At, B0); PG8_MMA(1, 1, At, B1); PG8_BAR; PG8_SCHED;
        }
        if (wr == 0) PG8_BAR;
        E(acc, cur, wr, wc, fr, fq);
        if (!has_next) break;
        if (!E.keeps(cur)) {
#pragma unroll
        for (int a = 0; a < 2; ++a)
#pragma unroll
            for (int b = 0; b < 2; ++b)
#pragma unroll
                for (int m = 0; m < 4; ++m)
#pragma unroll
                    for (int n = 0; n < 2; ++n) acc[a][b][m][n] = (f32x4){0.f, 0.f, 0.f, 0.f};
        }
        cur = nxt; cA = nA; cB = nB; ++ui;
        if (wr == 1) PG8_BAR;
    }
    PG8_WAIT_V(0);
    PG8_BAR;
#undef PG8_SA
#undef PG8_SB
#undef PG8_STAGE
#undef PG8_LDA
#undef PG8_LDB
#undef PG8_MMA
#undef PG8_WAIT_V
#undef PG8_WAIT_L
#undef PG8_BAR
#undef PG8_SCHED
}
}

DI void transpose_item(const float* W, int K, int N, bf16_t* WT, int ldd, int row_off, int col_off, LAS float* scr, int item, int lane) {
    const int nblk = N / 32, kb = item / nblk, nb = item % nblk, k0 = 64 * kb, n0 = 32 * nb;
#pragma unroll 8
    for (int i = 0; i < 32; ++i) { const int kk = 2 * i + (lane >> 5); scr[kk * 33 + (lane & 31)] = W[(size_t)(k0 + kk) * N + n0 + (lane & 31)]; }
    asm volatile("s_waitcnt lgkmcnt(0)" ::: "memory");
    const int c = lane & 7;
#pragma unroll
    for (int j = 0; j < 4; ++j) { const int n = (lane >> 3) + 8 * j; const LAS float* s = scr + (8 * c) * 33 + n;
        u32x4 o; o.x = pk2(s[0 * 33], s[1 * 33]); o.y = pk2(s[2 * 33], s[3 * 33]); o.z = pk2(s[4 * 33], s[5 * 33]); o.w = pk2(s[6 * 33], s[7 * 33]);
        *(u32x4*)(WT + (size_t)(row_off + n0 + n) * ldd + col_off + k0 + 8 * c) = o; }
    asm volatile("s_waitcnt lgkmcnt(0)" ::: "memory");
}

DI void convert_tables(const Params& p, const Frame& F) {
    for (int it0 = 2 * F.gw; it0 < 4 * NEXP; it0 += 2 * F.ngw) {
        f32x4 v[2][4];
#pragma unroll
        for (int u = 0; u < 2; ++u) {
            const int it = it0 + u, e = it & (NEXP - 1), tbl = (it >> 14) & 1, l = it >> 15;
            const f32x4* src = (const f32x4*)((tbl ? p.in[I_peer_v] : p.in[I_peer_u]) + ((size_t)l * NEXP + e) * D) + 4 * F.lane;
#pragma unroll
            for (int j = 0; j < 4; ++j) v[u][j] = src[j];
        }
#pragma unroll
        for (int u = 0; u < 2; ++u) {
            const int it = it0 + u, e = it & (NEXP - 1), tbl = (it >> 14) & 1, l = it >> 15;
            float am = 0.f;
#pragma unroll
            for (int j = 0; j < 4; ++j) am = fmaxf(am, fmaxf(fmaxf(fabsf(v[u][j].x), fabsf(v[u][j].y)), fmaxf(fabsf(v[u][j].z), fabsf(v[u][j].w))));
#pragma unroll
            for (int o = 1; o < 64; o <<= 1) am = fmaxf(am, __shfl_xor(am, o));
            const float sc = (am > 0.f) ? exp2f(floorf(log2f(224.0f / am))) : 1.0f;
            u32x4 q;
#pragma unroll
            for (int j = 0; j < 4; ++j) { int w = 0; w = __builtin_amdgcn_cvt_pk_fp8_f32(v[u][j].x * sc, v[u][j].y * sc, w, false); w = __builtin_amdgcn_cvt_pk_fp8_f32(v[u][j].z * sc, v[u][j].w * sc, w, true); q[j] = (unsigned)w; }
            *(u32x4*)(p.ws + (tbl ? WS_VTAB : WS_UTAB) + ((size_t)l * NEXP + e) * D + 16 * F.lane) = q;
            if (F.lane == 0) ((float*)(p.ws + WS_TSCALE))[(l * 2 + tbl) * NEXP + e] = 1.0f / sc;
        }
    }
}

DI void phase_prep(const Params& p, const Frame& F) {
    unsigned char* ws = p.ws;
    {
        LAS float* wq = (LAS float*)F.lds;
        LAS float* skl = wq + 128 * 65;
        for (int it = F.bid; it < 2 * 16 * 16; it += F.nb) {
            const int cc = it & 15, hp = (it >> 4) & 15, l = it >> 8;
            const float* src = p.in[I_peer_wq] + (size_t)l * D * 2048 + hp * 128;
            const float* sks = p.in[I_peer_subkeys] + (size_t)(l * 16 + hp) * 128 * 128;
            __syncthreads();
            for (int e = F.tid; e < 64 * 128; e += NTHREADS) { const int ci = e >> 7, d = e & 127; wq[d * 65 + ci] = src[(size_t)(cc * 64 + ci) * 2048 + d]; }
            for (int e = F.tid; e < 128 * 32; e += NTHREADS) { const int key = e >> 5, d4 = (e & 31) * 4; *(LAS f32x4*)(skl + key * 132 + d4) = *(const f32x4*)(sks + key * 128 + d4); }
            __syncthreads();
            const int ci = F.tid & 63, kg = F.tid >> 6;
            float acc[16];
#pragma unroll
            for (int k = 0; k < 16; ++k) acc[k] = 0.f;
#pragma unroll 2
            for (int d = 0; d < 128; d += 4) {
                const float w0 = wq[d * 65 + ci], w1 = wq[(d + 1) * 65 + ci], w2 = wq[(d + 2) * 65 + ci], w3 = wq[(d + 3) * 65 + ci];
#pragma unroll
                for (int k = 0; k < 16; ++k) { const f32x4 s = *(const LAS f32x4*)(skl + (16 * kg + k) * 132 + d); acc[k] += w0 * s.x + w1 * s.y + w2 * s.z + w3 * s.w; }
            }
            bf16_t* dst = (bf16_t*)(ws + WS_WFOLD) + ((size_t)l * 2048 + hp * 128 + 16 * kg) * D + cc * 64 + ci;
#pragma unroll
            for (int k = 0; k < 16; ++k) dst[(size_t)k * D] = (bf16_t)f2bf(acc[k]);
        }
        __syncthreads();
    }
    {
        LAS float* scr = (LAS float*)(F.lds + F.wave * 16384);
        constexpr int I_IN = (D / 64) * (INW / 32), I_BA = (512 / 64) * (D / 32), I_BS = (256 / 64) * (D / 32), I_O = (D / 64) * (D / 32);
        constexpr int PER_L = I_IN + I_BA + I_BS + I_O;
        for (int it = F.gw; it < 2 * PER_L; it += F.ngw) {
            const int l = it / PER_L; int r = it % PER_L;
            if (r < I_IN) { transpose_item(p.in[I_w_in] + (size_t)l * D * INW, D, INW, (bf16_t*)(ws + WS_WIN) + (size_t)l * INW * D, D, 0, 0, scr, r, F.lane); continue; } r -= I_IN;
            if (r < I_BA) { transpose_item(p.in[I_w_br_attn] + (size_t)l * 512 * D, 512, D, (bf16_t*)(ws + WS_WBR) + (size_t)l * D * D, D, 0, 0, scr, r, F.lane); continue; } r -= I_BA;
            if (r < I_BS) { transpose_item(p.in[I_w_br_sgu] + (size_t)l * 256 * D, 256, D, (bf16_t*)(ws + WS_WBR) + (size_t)l * D * D, D, 0, 768, scr, r, F.lane); continue; } r -= I_BS;
            transpose_item(p.in[I_w_out] + (size_t)l * D * D, D, D, (bf16_t*)(ws + WS_WOUT) + (size_t)l * D * D, D, 0, 0, scr, r, F.lane);
        }
    }
    for (int i = F.gtid; i < 2 * 256 * D; i += F.ngt) {
        const int n = i & 1023, rc = (i >> 10) & 255, l = i >> 18, g = rc >> 6;
        const float* pw = p.in[I_pool_w] + ((size_t)l * 256 + rc) * 64;
        const float* ps = p.in[I_pool_scale] + l * 256 + 64 * g;
        const float* wb = p.in[I_w_br_pool] + ((size_t)l * 256 + 64 * g) * D + n;
        float a = 0.f;
#pragma unroll 16
        for (int e = 0; e < 64; ++e) a += pw[e] * ps[e] * wb[(size_t)e * D];
        ((bf16_t*)(ws + WS_WBR))[(size_t)l * D * D + (size_t)n * D + 512 + rc] = (bf16_t)f2bf(a);
    }
    for (int i = F.gtid; i < 2 * 4 * 128 * 128; i += F.ngt) ((bf16_t*)(ws + WS_SGUW))[i] = (bf16_t)f2bf(p.in[I_sgu_w][i]);
    for (int i = F.gtid; i < 64 * 16; i += F.ngt) {
        const int pos = i >> 4, fi = i & 15;
        const float inv = powf(10000.0f, -(float)fi / 16.0f);
        const float ang = (float)pos * inv;
        ((f32x2*)(ws + WS_ROPE))[i] = (f32x2){cosf(ang), sinf(ang)};
    }
    convert_tables(p, F);
    {
        float* MOD = (float*)(ws + WS_MOD);
        LAS float* scd = (LAS float*)F.lds;
        LAS float* red = scd + 9 * D;
        __syncthreads();
        for (int e = F.tid; e < 9 * D; e += NTHREADS) { const int r = e >> 10, k = e & 1023; scd[e] = silu_((r < 8) ? p.in[I_c][r * D + k] : p.in[I_c_ctx][k]); }
        __syncthreads();
        for (int it = F.bid; it < 2 * 96; it += F.nb) {
            const int cgp = it % 96, l = it / 96, col = cgp * 64 + F.lane;
            float acc[9];
#pragma unroll
            for (int r = 0; r < 9; ++r) acc[r] = 0.f;
            const float* wp = p.in[I_w_mod] + ((size_t)l * D + F.wave * 128) * NMOD + col;
#pragma unroll 16
            for (int k = 0; k < 128; ++k) {
                const float w = wp[(size_t)k * NMOD];
#pragma unroll
                for (int r = 0; r < 9; ++r) acc[r] += scd[r * D + F.wave * 128 + k] * w;
            }
#pragma unroll
            for (int r = 0; r < 9; ++r) red[(F.wave * 9 + r) * 64 + F.lane] = acc[r];
            __syncthreads();
            for (int e = F.tid; e < 9 * 64; e += NTHREADS) {
                const int r = e >> 6, ln = e & 63; float s = p.in[I_b_mod][l * NMOD + cgp * 64 + ln];
#pragma unroll
                for (int w = 0; w < 8; ++w) s += red[(w * 9 + r) * 64 + ln];
                MOD[((size_t)l * 9 + r) * NMOD + cgp * 64 + ln] = s;
            }
            __syncthreads();
        }
    }
}

DI const float* mod_vec(const Params& p, int l, int row, int j) {
    const int r = row < TL ? row / SEQ : 8;
    return (const float*)(p.ws + WS_MOD) + ((size_t)l * 9 + r) * NMOD + j * D;
}
DI float* xrow_ptr(const Params& p, int row) { return row < TL ? p.out + (size_t)row * D : (float*)(p.ws + WS_XCTX) + (size_t)(row - TL) * D; }
DI const float* xin_ptr(const Params& p, int row) { return row < TL ? p.in[I_x] + (size_t)row * D : p.in[I_ctx] + (size_t)(row - TL) * D; }

DI void modulate_row_wave(const float* src, const float* g, const float* sh, const float* sc, bf16_t* dst, int lane, unsigned char* h8 = nullptr, float* hs = nullptr) {
    f32x4 v[4]; float ss = 0.f;
#pragma unroll
    for (int j = 0; j < 4; ++j) { v[j] = ((const f32x4*)src)[lane + 64 * j]; ss += v[j].x * v[j].x + v[j].y * v[j].y + v[j].z * v[j].z + v[j].w * v[j].w; }
    const float rinv = rsqrtf(wave_sum(ss) * (1.0f / D) + EPS);
    float am = 0.f;
#pragma unroll
    for (int j = 0; j < 4; ++j) {
        const f32x4 gg = ((const f32x4*)g)[lane + 64 * j], s1 = ((const f32x4*)sh)[lane + 64 * j], s2 = ((const f32x4*)sc)[lane + 64 * j];
        const f32x4 o = v[j] * rinv * gg * (s2 + 1.0f) + s1;
        u32x2 w; w.x = pk2(o.x, o.y); w.y = pk2(o.z, o.w);
        ((u32x2*)dst)[lane + 64 * j] = w;
        v[j] = o; am = fmaxf(am, fmaxf(fmaxf(fabsf(o.x), fabsf(o.y)), fmaxf(fabsf(o.z), fabsf(o.w))));
    }
    if (h8) {
#pragma unroll
        for (int o = 1; o < 64; o <<= 1) am = fmaxf(am, __shfl_xor(am, o));
        const float scl = (am > 0.f) ? exp2f(floorf(log2f(224.0f / am))) : 1.0f;
#pragma unroll
        for (int j = 0; j < 4; ++j) { int w = 0; w = __builtin_amdgcn_cvt_pk_fp8_f32(v[j].x * scl, v[j].y * scl, w, false); w = __builtin_amdgcn_cvt_pk_fp8_f32(v[j].z * scl, v[j].w * scl, w, true);
            ((unsigned*)h8)[lane + 64 * j] = (unsigned)w; }
        if (lane == 0) *hs = 1.0f / scl;
    }
}

DI void phase_norm(const Params& p, const Frame& F, int l, int which  , bool from_input, int nrows) {
    const float* g = (which == 0 ? p.in[I_g_mix] : p.in[I_g_ffn]) + l * D;
    for (int row = F.gw; row < nrows; row += F.ngw) {
        const float* src = from_input ? xin_ptr(p, row) : xrow_ptr(p, row);
        modulate_row_wave(src, g, mod_vec(p, l, row, which * 3 + 0), mod_vec(p, l, row, which * 3 + 1), (bf16_t*)(p.ws + WS_H) + (size_t)row * D, F.lane,
                          nullptr, nullptr);
    }
}
DI void phase_final(const Params& p, const Frame& F) {
    for (int row = F.gw; row < TL; row += F.ngw) {
        f32x4* xr = (f32x4*)(p.out + (size_t)row * D);
        f32x4 v[4]; float ss = 0.f;
#pragma unroll
        for (int j = 0; j < 4; ++j) { v[j] = xr[F.lane + 64 * j]; ss += v[j].x * v[j].x + v[j].y * v[j].y + v[j].z * v[j].z + v[j].w * v[j].w; }
        const float rinv = rsqrtf(wave_sum(ss) * (1.0f / D) + EPS);
#pragma unroll
        for (int j = 0; j < 4; ++j) xr[F.lane + 64 * j] = v[j] * rinv * ((const f32x4*)p.in[I_g_final])[F.lane + 64 * j];
    }
}

DI void g1_epilogue(const Params& p, int l, const f32x16& acc, int row0, int col0, int lane) {
    const int h = lane >> 5, w = lane & 31, col = col0 + w;
    bf16_t* P = (bf16_t*)(p.ws + WS_P);
    if (col0 < VOFF) {
        const float sc = (col0 < KOFF) ? QSCALE : 1.0f;
        const int axis = (col0 >> 5) & 1, fi = w & 15;
        const f32x2* tab = (const f32x2*)(p.ws + WS_ROPE);
#pragma unroll
        for (int r = 0; r < 16; ++r) {
            const int row = row0 + crow(r, h);
            const float own = acc[r], oth = __shfl_xor(own, 16);
            float o = own;
            if (row < TL) {
                const int t = row & (SEQ - 1), pos = axis ? (t & 63) : (t >> 6);
                const f32x2 cs = tab[pos * 16 + fi];
                o = (w < 16) ? (own * cs.x - oth * cs.y) : (own * cs.x + oth * cs.y);
            }
            P[(size_t)row * PW + col] = (bf16_t)f2bf(o * sc);
        }
    } else if (col0 < POOLOFF) {
        const int hk = (col - VOFF) >> 6, d = (col - VOFF) & 63;
#pragma unroll
        for (int r = 0; r < 16; ++r) {
            const int row = row0 + crow(r, h);
            const bf16_t v = (bf16_t)f2bf(acc[r]);
            if (row < TL) { const int b = row / SEQ, t = row & (SEQ - 1); ((bf16_t*)(p.ws + WS_VT))[((size_t)(b * 2 + hk) * 64 + d) * VTS + t] = v; }
            else { const int rc = row - TL, b = rc / NCTX, j = rc & (NCTX - 1); ((bf16_t*)(p.ws + WS_VTC))[((size_t)(b * 2 + hk) * 64 + d) * NCTX + j] = v; }
        }
    } else if (col0 < SUOFF) {
#pragma unroll
        for (int r = 0; r < 16; ++r) { const int row = row0 + crow(r, h); P[(size_t)row * PW + col] = (bf16_t)f2bf(acc[r]); }
    } else if (col0 < SVOFF) {
#pragma unroll
        for (int r = 0; r < 16; ++r) { const int row = row0 + crow(r, h); P[(size_t)row * PW + col] = (bf16_t)f2bf(gelu_tanh(acc[r])); }
    } else {
        const int c = col - SVOFF;
#pragma unroll
        for (int r = 0; r < 16; ++r) { const int row = row0 + crow(r, h); const int chunk = row >> 7, q = row & 127;
            ((bf16_t*)(p.ws + WS_VST))[((size_t)chunk * 256 + c) * 128 + q] = (bf16_t)f2bf(gelu_tanh(acc[r])); }
    }
}

DI void g1_simple(const Params& p, const Frame& F, int l, int row_lo, int nrows, int ct_lo, int nct) {
    const bf16_t* H = (const bf16_t*)(p.ws + WS_H);
    const bf16_t* W = (const bf16_t*)(p.ws + WS_WIN) + (size_t)l * INW * D;
    const int nit = (nrows / 64) * nct;
    for (int it = F.gw; it < nit; it += F.ngw) {
        const int mt = it / nct, nt = ct_lo + it % nct, m0 = row_lo + mt * 64;
        f32x16 acc[2][1]; zero_acc(acc);
        wave_gemm<2, 1>(H, D, W, D, D, m0, nt * 32, acc, F.lane);
#pragma unroll 1
        for (int i = 0; i < 2; ++i) g1_epilogue(p, l, i == 0 ? acc[0][0] : acc[1][0], m0 + 32 * i, nt * 32, F.lane);
    }
}

DI float lane_xor32(float v, bool hi) { const auto r = __builtin_amdgcn_permlane32_swap(__builtin_bit_cast(unsigned, v), __builtin_bit_cast(unsigned, v), false, false);
    return __builtin_bit_cast(float, hi ? r[0] : r[1]); }
struct EpiG1 {
    DI bool keeps(const pg8::Unit&) const { return false; }
    static constexpr bool PERM = true;
    unsigned char* ws;
    DI void operator()(const f32x4 (&acc)[2][2][4][2], const pg8::Unit& u, int wr, int wc, int fr, int fq) const {
        bf16_t* P = (bf16_t*)(ws + WS_P);
        const int rbase = u.pm * 256 + wr * 64 + fr;
        const bool hi = fq >= 2;
#pragma unroll
        for (int ai = 0; ai < 2; ++ai) {
            f32x4 cs[4][4];
            const bool lat = u.pm < TL / 256;
            if (u.pn < 3 && lat) {
#pragma unroll
                for (int m = 0; m < 4; ++m) {
                    const int t = (rbase + 128 * ai + 16 * m) & (SEQ - 1), pos = (wc & 1) ? (t & 63) : (t >> 6);
                    const f32x4* tab = (const f32x4*)(ws + WS_ROPE) + (pos * 16 + 8 * (fq & 1)) / 2;
#pragma unroll
                    for (int j2 = 0; j2 < 4; ++j2) cs[m][j2] = tab[j2];
                }
            }
#pragma unroll
            for (int m = 0; m < 4; ++m) {
                const int row = rbase + 128 * ai + 16 * m;
#pragma unroll
                for (int bj = 0; bj < 2; ++bj) {
                    const int c0 = u.pn * 256 + 128 * bj + 32 * wc + 8 * fq;
                    float v[8];
#pragma unroll
                    for (int j = 0; j < 4; ++j) { v[j] = acc[ai][bj][m][0][j]; v[4 + j] = acc[ai][bj][m][1][j]; }
                    if (c0 < VOFF) {
                        const float sc = (c0 < KOFF) ? QSCALE : 1.0f;
                        u32x4 o;
#pragma unroll
                        for (int j2 = 0; j2 < 4; ++j2) {
                            const f32x4 c4 = cs[m][j2];
                            const float o0 = lane_xor32(v[2 * j2], hi), o1 = lane_xor32(v[2 * j2 + 1], hi);
                            float r0 = hi ? (v[2 * j2] * c4.x + o0 * c4.y) : (v[2 * j2] * c4.x - o0 * c4.y);
                            float r1 = hi ? (v[2 * j2 + 1] * c4.z + o1 * c4.w) : (v[2 * j2 + 1] * c4.z - o1 * c4.w);
                            if (!lat) { r0 = v[2 * j2]; r1 = v[2 * j2 + 1]; }
                            o[j2] = pk2(r0 * sc, r1 * sc);
                        }
                        *(u32x4*)(P + (size_t)row * PW + c0) = o;
                    } else if (c0 < POOLOFF) {
                        const int hk = wc >> 1, d0 = 32 * (wc & 1) + 8 * fq;
                        if (lat) { const int b = row / SEQ, t = row & (SEQ - 1);
                            bf16_t* vt = (bf16_t*)(ws + WS_VT) + ((size_t)(b * 2 + hk) * 64 + d0) * VTS + t;
#pragma unroll
                            for (int j = 0; j < 8; ++j) vt[(size_t)j * VTS] = (bf16_t)f2bf(v[j]);
                        } else { const int rc = row - TL, b = rc / NCTX, jc = rc & (NCTX - 1);
                            bf16_t* vt = (bf16_t*)(ws + WS_VTC) + ((size_t)(b * 2 + hk) * 64 + d0) * NCTX + jc;
#pragma unroll
                            for (int j = 0; j < 8; ++j) vt[(size_t)j * NCTX] = (bf16_t)f2bf(v[j]);
                        }
                    } else if (c0 < SUOFF) {
                        u32x4 o;
#pragma unroll
                        for (int j2 = 0; j2 < 4; ++j2) o[j2] = pk2(v[2 * j2], v[2 * j2 + 1]);
                        *(u32x4*)(P + (size_t)row * PW + c0) = o;
                    } else if (c0 < SVOFF) {
                        u32x4 o;
#pragma unroll
                        for (int j2 = 0; j2 < 4; ++j2) o[j2] = pk2(gelu_tanh(v[2 * j2]), gelu_tanh(v[2 * j2 + 1]));
                        *(u32x4*)(P + (size_t)row * PW + c0) = o;
                    } else {
                        const int c = c0 - SVOFF, chunk = row >> 7, q = row & 127;
                        bf16_t* vs = (bf16_t*)(ws + WS_VST) + ((size_t)chunk * 256 + c) * 128 + q;
#pragma unroll
                        for (int j = 0; j < 8; ++j) vs[j * 128] = (bf16_t)f2bf(gelu_tanh(v[j]));
                    }
                }
            }
            asm volatile("" ::: "memory");
        }
    }
};
struct SchedGrid {
    int nM, nN, G, c; const char* A; const char* B;
    int n_extra, ex_pm0, ex_pn;
    DI bool next(int i, pg8::Unit& u) const {
        const int L = i * G + c, n = nM * nN; if (L >= n + n_extra) return false;
        if (L < n) pg8::tile_of(L, nM, nN, u.pm, u.pn); else { u.pm = ex_pm0 + (L - n); u.pn = ex_pn; }
        u.sub = 0; u.nt = D / 64;
        u.a = A + (size_t)u.pm * 256 * D * 2; u.b = B + (size_t)u.pn * 256 * D * 2; return true;
    }
};

DI void phase_g1(const Params& p, const Frame& F, int l) {
    SchedGrid S{(l == 0 ? T : TL) / 256, PN / 256, F.nb, F.bid, (const char*)(p.ws + WS_H), (const char*)(p.ws + WS_WIN) + (size_t)l * INW * D * 2,
                (l == 0) ? 0 : TC / 256, TL / 256, 2};
    EpiG1 E{p.ws};
    pg8::gemm_phase(F.lds, F.tid, S, E);
}

DI bf16x8 pack8(const f32x16& x, int s) {
    u32x4 pk;
#pragma unroll
    for (int j = 0; j < 4; ++j) { f32x2 v = {x[8 * s + 2 * j], x[8 * s + 2 * j + 1]}; pk[j] = __builtin_bit_cast(unsigned, __builtin_convertvector(v, bf16x2_t)); }
    return __builtin_bit_cast(bf16x8, pk);
}

DI float lane_x32(float v, bool hi) { const auto r = __builtin_amdgcn_permlane32_swap(__builtin_bit_cast(unsigned, v), __builtin_bit_cast(unsigned, v), false, false);
    return __builtin_bit_cast(float, hi ? r[0] : r[1]); }
struct AttnFrags { bf16x8 kf[4]; s16x4 vf[2][4]; };
DI void attn_load(AttnFrags& f, const bf16_t* kptr, const bf16_t* vptr, size_t vstride_d32) {
#pragma unroll
    for (int s = 0; s < 4; ++s) f.kf[s] = *(const bf16x8*)(kptr + 16 * s);
#pragma unroll
    for (int d = 0; d < 2; ++d)
#pragma unroll
        for (int q = 0; q < 4; ++q) f.vf[d][q] = *(const s16x4*)(vptr + (size_t)d * vstride_d32 + 8 * q);
}
DI void attn_block(const bf16x8 (&qf)[4], const AttnFrags& f, int mask_mode, int kq_off, int lane, float& m, float& lpart, f32x16 (&o)[2]) {
    const int h = lane >> 5;
    f32x16 st;
#pragma unroll
    for (int r = 0; r < 16; ++r) st[r] = 0.f;
#pragma unroll
    for (int s = 0; s < 4; ++s) st = MFMA32(f.kf[s], qf[s], st);
    if (mask_mode) {
#pragma unroll
        for (int r = 0; r < 16; ++r) { const int dlt = kq_off + crow(r, h); if (dlt > 128 || dlt < -128) st[r] = -1e30f; }
    }
    float bm = st[0];
#pragma unroll
    for (int r = 1; r < 16; ++r) bm = fmaxf(bm, st[r]);
    bm = fmaxf(bm, lane_x32(bm, h != 0));
    const float mn = fmaxf(m, bm);
    if (__builtin_amdgcn_ballot_w64(mn > m) != 0ull) {
        const float alpha = __builtin_amdgcn_exp2f(m - mn);
        lpart *= alpha;
#pragma unroll
        for (int d = 0; d < 2; ++d)
#pragma unroll
            for (int r = 0; r < 16; ++r) o[d][r] *= alpha;
        m = mn;
    }
    float ps = 0.f;
#pragma unroll
    for (int r = 0; r < 16; ++r) { st[r] = __builtin_amdgcn_exp2f(st[r] - m); ps += st[r]; }
    lpart += ps;
    const bf16x8 pf0 = pack8(st, 0), pf1 = pack8(st, 1);
#pragma unroll
    for (int d = 0; d < 2; ++d) {
        const bf16x8 v0 = __builtin_shufflevector(f.vf[d][0], f.vf[d][1], 0, 1, 2, 3, 4, 5, 6, 7), v1 = __builtin_shufflevector(f.vf[d][2], f.vf[d][3], 0, 1, 2, 3, 4, 5, 6, 7);
        o[d] = MFMA32(v0, pf0, o[d]);
        o[d] = MFMA32(v1, pf1, o[d]);
    }
}

DI void attn_task(const Params& p, int l, int task, int lane) {
    const int r = lane & 31, h = lane >> 5;
    const bf16_t* P = (const bf16_t*)(p.ws + WS_P);
    const bf16_t* VT = (const bf16_t*)(p.ws + WS_VT);
    const bf16_t* VTC = (const bf16_t*)(p.ws + WS_VTC);
    bf16_t* Y = (bf16_t*)(p.ws + WS_Y);
    const bool latent = task < 8192;
    int b, head, qb, q0row, p0;
    if (latent) { qb = task & 127; head = (task >> 7) & 7; b = task >> 10; p0 = qb * 32; q0row = b * SEQ + p0; }
    else { const int t2 = task - 8192; qb = t2 & 7; head = (t2 >> 3) & 7; b = t2 >> 6; p0 = qb * 32; q0row = TL + b * NCTX + p0; }
    const int hk = head >> 2;
    bf16x8 qf[4];
#pragma unroll
    for (int s = 0; s < 4; ++s) qf[s] = *(const bf16x8*)(P + (size_t)(q0row + r) * PW + head * 64 + 16 * s + 8 * h);
    float m = p.in[I_attn_sink][l * 8 + head] * LOG2E, lpart = (h == 0) ? 1.0f : 0.0f;
    f32x16 o[2];
#pragma unroll
    for (int d = 0; d < 2; ++d)
#pragma unroll
        for (int i = 0; i < 16; ++i) o[d][i] = 0.f;
    const int kb_lo = max(p0 - 128, 0), kb_hi = min(p0 + 128, SEQ - 32);
    const int nwin = latent ? ((kb_hi - kb_lo) >> 5) + 1 : 0, nblk = nwin + 8;
    const bf16_t* kwin = P + (size_t)(b * SEQ + r) * PW + KOFF + hk * 64 + 8 * h;
    const bf16_t* vwin = VT + ((size_t)(b * 2 + hk) * 64 + r) * VTS + 4 * h;
    const bf16_t* kctx = P + (size_t)(TL + b * NCTX + r) * PW + KOFF + hk * 64 + 8 * h;
    const bf16_t* vctx = VTC + ((size_t)(b * 2 + hk) * 64 + r) * NCTX + 4 * h;
    AttnFrags f0, f1, f2;
#define ATT_LOAD(F_, jj) do { const int j_ = min((jj), nblk - 1); \
        if (j_ < nwin) { const int kb_ = kb_lo + 32 * j_; attn_load(F_, kwin + (size_t)kb_ * PW, vwin + kb_, (size_t)32 * VTS); } \
        else { const int kb_ = 32 * (j_ - nwin); attn_load(F_, kctx + (size_t)kb_ * PW, vctx + kb_, (size_t)32 * NCTX); } } while (0)
#define ATT_COMP(F_, jj) do { const int j_ = (jj); if (j_ < nblk) { int mm_ = 0, kq_ = 0; \
        if (j_ < nwin) { const int kb_ = kb_lo + 32 * j_; mm_ = (kb_ == p0 - 128 || kb_ == p0 + 128) ? 1 : 0; kq_ = kb_ - (p0 + r); } \
        attn_block(qf, F_, mm_, kq_, lane, m, lpart, o); } } while (0)
    ATT_LOAD(f0, 0); ATT_LOAD(f1, 1);
#pragma unroll 1
    for (int j = 0; j < nblk; j += 3) {
        ATT_LOAD(f2, j + 2); ATT_COMP(f0, j);
        ATT_LOAD(f0, j + 3); ATT_COMP(f1, j + 1);
        ATT_LOAD(f1, j + 4); ATT_COMP(f2, j + 2);
    }
#undef ATT_LOAD
#undef ATT_COMP
    const float inv = 1.0f / (lpart + lane_x32(lpart, h != 0));
    bf16_t* yrow = Y + (size_t)(q0row + r) * D + head * 64;
#pragma unroll
    for (int d = 0; d < 2; ++d)
#pragma unroll
        for (int g = 0; g < 4; ++g) {
            u32x2 w; w.x = pk2(o[d][4 * g] * inv, o[d][4 * g + 1] * inv); w.y = pk2(o[d][4 * g + 2] * inv, o[d][4 * g + 3] * inv);
            *(u32x2*)(yrow + 32 * d + 8 * g + 4 * h) = w;
        }
}

constexpr int AKP = 144, AVWP = 648, AVCP = 520;
constexpr int ALDS_KW = 0, ALDS_VW = ALDS_KW + 320 * AKP, ALDS_KC = ALDS_VW + 64 * AVWP, ALDS_VC = ALDS_KC + 256 * AKP, ALDS_END = ALDS_VC + 64 * AVCP;
static_assert(ALDS_END <= LDS_BAR_OFF && (ALDS_VW % 16) == 0 && (ALDS_KC % 16) == 0 && (ALDS_VC % 8) == 0, "attention LDS map");
DI void attn_lds_frags(AttnFrags& f, const LAS unsigned char* kp, const LAS unsigned char* vp, int vpitch32) {
#pragma unroll
    for (int s = 0; s < 4; ++s) f.kf[s] = *(const LAS bf16x8*)(kp + 32 * s);
#pragma unroll
    for (int d = 0; d < 2; ++d)
#pragma unroll
        for (int q = 0; q < 4; ++q) f.vf[d][q] = *(const LAS s16x4*)(vp + d * vpitch32 + 16 * q);
}
DI void attn_unit(const Params& p, const Frame& F, int l, int unit) {
    const int lane = F.lane, r = lane & 31, h = lane >> 5, tid = F.tid;
    const bf16_t* P = (const bf16_t*)(p.ws + WS_P);
    const bf16_t* VT = (const bf16_t*)(p.ws + WS_VT);
    const bf16_t* VTC = (const bf16_t*)(p.ws + WS_VTC);
    bf16_t* Y = (bf16_t*)(p.ws + WS_Y);
    const bool latent = unit < 1024;
    int b, hk, p0, q0row;
    if (latent) { const int pb = unit & 63; hk = (unit >> 6) & 1; b = unit >> 7; p0 = pb * 64; q0row = b * SEQ + p0; }
    else { const int u2 = unit - 1024, pb = u2 & 3; hk = (u2 >> 2) & 1; b = u2 >> 3; p0 = pb * 64; q0row = TL + b * NCTX + p0; }
    const int w0 = p0 - 128;
    __syncthreads();
    if (latent) {
        for (int i = tid; i < 320 * 8; i += NTHREADS) {
            const int row = i >> 3, ck = i & 7, pos = w0 + row;
            if (pos >= 0 && pos < SEQ) *(LAS u32x4*)(F.lds + ALDS_KW + row * AKP + 16 * ck) = *(const u32x4*)(P + (size_t)(b * SEQ + pos) * PW + KOFF + hk * 64 + 8 * ck);
        }
        for (int i = tid; i < 64 * 40; i += NTHREADS) {
            const int d = i / 40, ck = i % 40, pos = w0 + 8 * ck;
            if (pos >= 0 && pos < SEQ) { const u32x4 v = *(const u32x4*)(VT + ((size_t)(b * 2 + hk) * 64 + d) * VTS + pos);
                LAS u32x2* dst = (LAS u32x2*)(F.lds + ALDS_VW + d * AVWP + 16 * ck); dst[0] = (u32x2){v.x, v.y}; dst[1] = (u32x2){v.z, v.w}; }
        }
    }
    for (int i = tid; i < 256 * 8; i += NTHREADS) {
        const int row = i >> 3, ck = i & 7;
        *(LAS u32x4*)(F.lds + ALDS_KC + row * AKP + 16 * ck) = *(const u32x4*)(P + (size_t)(TL + b * NCTX + row) * PW + KOFF + hk * 64 + 8 * ck);
    }
    for (int i = tid; i < 64 * 32; i += NTHREADS) {
        const int d = i >> 5, ck = i & 31;
        const u32x4 v = *(const u32x4*)(VTC + ((size_t)(b * 2 + hk) * 64 + d) * NCTX + 8 * ck);
        LAS u32x2* dst = (LAS u32x2*)(F.lds + ALDS_VC + d * AVCP + 16 * ck); dst[0] = (u32x2){v.x, v.y}; dst[1] = (u32x2){v.z, v.w};
    }
    const int head = 4 * hk + (F.wave & 3), ph = F.wave >> 2, pw = p0 + 32 * ph, qrow = q0row + 32 * ph;
    bf16x8 qf[4];
#pragma unroll
    for (int s = 0; s < 4; ++s) qf[s] = *(const bf16x8*)(P + (size_t)(qrow + r) * PW + head * 64 + 16 * s + 8 * h);
    float m = p.in[I_attn_sink][l * 8 + head] * LOG2E, lpart = (h == 0) ? 1.0f : 0.0f;
    f32x16 o[2];
#pragma unroll
    for (int d = 0; d < 2; ++d)
#pragma unroll
        for (int i = 0; i < 16; ++i) o[d][i] = 0.f;
    __syncthreads();
    if (latent) {
#pragma unroll 1
        for (int j = 0; j < 9; ++j) {
            const int kb = pw - 128 + 32 * j;
            if (kb < 0 || kb >= SEQ) continue;
            const int krow = kb - w0;
            AttnFrags f;
            attn_lds_frags(f, F.lds + ALDS_KW + (krow + r) * AKP + 16 * h, F.lds + ALDS_VW + r * AVWP + 2 * krow + 8 * h, 32 * AVWP);
            attn_block(qf, f, (j == 0 || j == 8) ? 1 : 0, kb - (pw + r), lane, m, lpart, o);
        }
    }
#pragma unroll 1
    for (int j = 0; j < 8; ++j) {
        AttnFrags f;
        attn_lds_frags(f, F.lds + ALDS_KC + (32 * j + r) * AKP + 16 * h, F.lds + ALDS_VC + r * AVCP + 64 * j + 8 * h, 32 * AVCP);
        attn_block(qf, f, 0, 0, lane, m, lpart, o);
    }
    const float inv = 1.0f / (lpart + lane_x32(lpart, h != 0));
    bf16_t* yrow = Y + (size_t)(qrow + r) * D + head * 64;
#pragma unroll
    for (int d = 0; d < 2; ++d)
#pragma unroll
        for (int g = 0; g < 4; ++g) {
            u32x2 w; w.x = pk2(o[d][4 * g] * inv, o[d][4 * g + 1] * inv); w.y = pk2(o[d][4 * g + 2] * inv, o[d][4 * g + 3] * inv);
            *(u32x2*)(yrow + 32 * d + 8 * g + 4 * h) = w;
        }
}

DI void sgu_unit(const Params& p, const Frame& F, int l, int chunk) {
    constexpr int VS = 136;
    LAS float* part = (LAS float*)F.lds;
    LAS float* rq = part + 512;
    LAS bf16_t* vnT = (LAS bf16_t*)(F.lds + 4096);
    const bf16_t* VsT = (const bf16_t*)(p.ws + WS_VST) + (size_t)chunk * 256 * 128;
    const bf16_t* P = (const bf16_t*)(p.ws + WS_P);
    bf16_t* Y = (bf16_t*)(p.ws + WS_Y);
    __syncthreads();
    { const int q = F.tid & 127, part_i = F.tid >> 7; float ss = 0.f;
        for (int c = part_i * 64; c < part_i * 64 + 64; ++c) { const float v = bf2f(VsT[c * 128 + q]); ss += v * v; }
        part[part_i * 128 + q] = ss; }
    __syncthreads();
    if (F.tid < 128) rq[F.tid] = rsqrtf((part[F.tid] + part[128 + F.tid] + part[256 + F.tid] + part[384 + F.tid]) * (1.0f / 256.0f) + EPS);
    __syncthreads();
    for (int i = F.tid; i < 256 * 16; i += NTHREADS) {
        const int c = i >> 4, q8 = (i & 15) * 8;
        const u32x4 v = *(const u32x4*)(VsT + c * 128 + q8);
        u32x4 o;
#pragma unroll
        for (int j = 0; j < 4; ++j) o[j] = pk2(bflo(v[j]) * rq[q8 + 2 * j], bfhi(v[j]) * rq[q8 + 2 * j + 1]);
        *(LAS u32x4*)(vnT + c * VS + q8) = o;
    }
    __syncthreads();
    const int lane = F.lane, r = lane & 31, h = lane >> 5, g = F.wave >> 1, ph = F.wave & 1;
    const bf16_t* Wg = (const bf16_t*)(p.ws + WS_SGUW) + ((size_t)l * 4 + g) * 128 * 128;
#pragma unroll 1
    for (int pb = 0; pb < 2; ++pb) {
        const int p0 = 64 * ph + 32 * pb;
#pragma unroll 1
        for (int cb = 0; cb < 2; ++cb) {
            const int c0 = 64 * g + 32 * cb;
            f32x16 acc;
#pragma unroll
            for (int i = 0; i < 16; ++i) acc[i] = 0.f;
#pragma unroll
            for (int s = 0; s < 8; ++s) {
                const bf16x8 a = *(const LAS bf16x8*)(vnT + (c0 + r) * VS + 16 * s + 8 * h);
                const bf16x8 b = *(const bf16x8*)(Wg + (size_t)(p0 + r) * 128 + 16 * s + 8 * h);
                acc = MFMA32(a, b, acc);
            }
            const int row = chunk * 128 + p0 + r;
            const float bias = p.in[I_sgu_b][(l * 4 + g) * 128 + p0 + r];
#pragma unroll
            for (int q4 = 0; q4 < 4; ++q4) {
                const int cc = c0 + 8 * q4 + 4 * h;
                const u32x2 u = *(const u32x2*)(P + (size_t)row * PW + SUOFF + cc);
                u32x2 w;
                w.x = pk2(bflo(u.x) * (acc[4 * q4] + bias), bfhi(u.x) * (acc[4 * q4 + 1] + bias));
                w.y = pk2(bflo(u.y) * (acc[4 * q4 + 2] + bias), bfhi(u.y) * (acc[4 * q4 + 3] + bias));
                *(u32x2*)(Y + (size_t)row * D + 768 + cc) = w;
            }
        }
    }
}

DI void phase_mix(const Params& p, const Frame& F, int l, int ctr_slot = 0) {
    (void)ctr_slot;
    const int nrows = (l == 0) ? T : TL;
    const bf16_t* P = (const bf16_t*)(p.ws + WS_P);
    bf16_t* Y = (bf16_t*)(p.ws + WS_Y);
    for (int i = F.gtid; i < nrows * 32; i += F.ngt) {
        const int row = i >> 5, ck = i & 31, g = ck >> 3, half = 1 << g;
        int base, t, len;
        if (row < TL) { base = row & ~(SEQ - 1); t = row & (SEQ - 1); len = SEQ; } else { const int rc = row - TL; base = TL + (rc & ~(NCTX - 1)); t = rc & (NCTX - 1); len = NCTX; }
        const int lo = max(t - half, 0), hi = min(t + half, len);
        float s[8];
#pragma unroll
        for (int j = 0; j < 8; ++j) s[j] = 0.f;
        for (int tt = lo; tt < hi; ++tt) {
            const u32x4 v = *(const u32x4*)(P + (size_t)(base + tt) * PW + POOLOFF + ck * 8);
#pragma unroll
            for (int j = 0; j < 4; ++j) { s[2 * j] += bflo(v[j]); s[2 * j + 1] += bfhi(v[j]); }
        }
        const float inv = 1.0f / (float)(hi - lo);
        const u32x4 z = *(const u32x4*)(P + (size_t)row * PW + POOLOFF + ck * 8);
        u32x4 o;
#pragma unroll
        for (int j = 0; j < 4; ++j) o[j] = pk2(s[2 * j] * inv - bflo(z[j]), s[2 * j + 1] * inv - bfhi(z[j]));
        *(u32x4*)(Y + (size_t)row * D + 512 + ck * 8) = o;
    }
    const int nchunk = (l == 0) ? T / 128 : TL / 128;
    for (int ch = F.bid; ch < nchunk; ch += F.nb) sgu_unit(p, F, l, ch);
    const int nunit = (l == 0) ? 1024 + 64 : 1024;
    for (int u = F.nb - 1 - F.bid; u < nunit; u += F.nb) attn_unit(p, F, l, u);
}

DI void g2_simple(const Params& p, const Frame& F, int l, int row_lo, int nrows) {
    const bf16_t* H = (const bf16_t*)(p.ws + WS_H);
    const bf16_t* Yb = (const bf16_t*)(p.ws + WS_Y);
    const bf16_t* Wg = (const bf16_t*)(p.ws + WS_WIN) + (size_t)l * INW * D + (size_t)GATEOFF * D;
    const bf16_t* Wb = (const bf16_t*)(p.ws + WS_WBR) + (size_t)l * D * D;
    bf16_t* M = (bf16_t*)(p.ws + WS_MERGED);
    const int nit = (nrows / 64) * (D / 32);
    for (int it = F.gw; it < nit; it += F.ngw) {
        const int mt = it / (D / 32), nt = it % (D / 32), m0 = row_lo + mt * 64, n0 = nt * 32;
        f32x16 tot[2][1]; zero_acc(tot);
#pragma unroll 1
        for (int i = 0; i < 3; ++i) {
            const int koff = (i == 0) ? 0 : (i == 1 ? 512 : 768), kk = (i == 0) ? 512 : 256;
            f32x16 g[2][1], pr[2][1]; zero_acc(g); zero_acc(pr);
            wave_gemm<2, 1>(H, D, Wg + (size_t)i * D * D, D, D, m0, n0, g, F.lane);
            wave_gemm<2, 1>(Yb + koff, D, Wb + koff, D, kk, m0, n0, pr, F.lane);
#pragma unroll
            for (int a = 0; a < 2; ++a)
#pragma unroll
                for (int r = 0; r < 16; ++r) tot[a][0][r] += sigmoidf_(g[a][0][r]) * pr[a][0][r];
        }
        const int h = F.lane >> 5, col = n0 + (F.lane & 31);
#pragma unroll
        for (int a = 0; a < 2; ++a)
#pragma unroll
            for (int r = 0; r < 16; ++r) M[(size_t)(m0 + 32 * a + crow(r, h)) * D + col] = (bf16_t)f2bf(tot[a][0][r]);
    }
}
struct SchedG2 {
    int G, c; const char *H, *Y, *Wg, *Wb; int nM;
    DI bool next(int i, pg8::Unit& u) const {
        const int tile = (i / 6) * G + c; if (tile >= nM * 4) return false;
        const int sub = i % 6, br = sub >> 1;
        pg8::tile_of(tile, nM, 4, u.pm, u.pn); u.sub = sub;
        if ((sub & 1) == 0) { u.nt = 16; u.a = H + (size_t)u.pm * 256 * D * 2; u.b = Wg + ((size_t)br * D + u.pn * 256) * D * 2; }
        else { const int koff = (br == 0) ? 0 : (br == 1 ? 512 : 768); u.nt = (br == 0) ? 8 : 4;
               u.a = Y + ((size_t)u.pm * 256 * D + koff) * 2; u.b = Wb + ((size_t)u.pn * 256 * D + koff) * 2; }
        return true;
    }
};
struct EpiG2 {
    static constexpr bool PERM = true;
    bf16_t* scr; bf16_t* M;
    DI bool keeps(const pg8::Unit& u) const { return (u.sub & 1) == 0; }
    DI void operator()(f32x4 (&acc)[2][2][4][2], const pg8::Unit& u, int wr, int wc, int fr, int fq) const {
        const bool gate = (u.sub & 1) == 0, first = u.sub == 0;
#pragma unroll
        for (int ai = 0; ai < 2; ++ai) {
            u32x4 ld[4][2];
            if (!first) {
#pragma unroll
                for (int m = 0; m < 4; ++m)
#pragma unroll
                    for (int bj = 0; bj < 2; ++bj) {
                        const int rl = 128 * ai + 64 * wr + 16 * m + fr, cl = 128 * bj + 32 * wc + 8 * fq;
                        ld[m][bj] = gate ? *(const u32x4*)(M + (size_t)(u.pm * 256 + rl) * D + u.pn * 256 + cl) : *(const u32x4*)(scr + rl * 256 + cl);
                    }
            }
#pragma unroll
            for (int m = 0; m < 4; ++m)
#pragma unroll
                for (int bj = 0; bj < 2; ++bj) {
                    const int rl = 128 * ai + 64 * wr + 16 * m + fr, cl = 128 * bj + 32 * wc + 8 * fq;
                    if (gate) {
                        u32x4 o;
#pragma unroll
                        for (int j2 = 0; j2 < 4; ++j2) {
                            const int n = j2 >> 1, e = 2 * (j2 & 1);
                            const unsigned w = pk2(fmaxf(sigmoidf_(acc[ai][bj][m][n][e]), 1e-20f), fmaxf(sigmoidf_(acc[ai][bj][m][n][e + 1]), 1e-20f));
                            o[j2] = w;
                            const float t0 = first ? 0.f : bflo(ld[m][bj][j2]), t1 = first ? 0.f : bfhi(ld[m][bj][j2]);
                            acc[ai][bj][m][n][e] = t0 * __builtin_amdgcn_rcpf(bflo(w)); acc[ai][bj][m][n][e + 1] = t1 * __builtin_amdgcn_rcpf(bfhi(w));
                        }
                        *(u32x4*)(scr + rl * 256 + cl) = o;
                    } else {
                        u32x4 w;
#pragma unroll
                        for (int j2 = 0; j2 < 4; ++j2) { const int n = j2 >> 1, e = 2 * (j2 & 1);
                            w[j2] = pk2(acc[ai][bj][m][n][e] * bflo(ld[m][bj][j2]), acc[ai][bj][m][n][e + 1] * bfhi(ld[m][bj][j2])); }
                        *(u32x4*)(M + (size_t)(u.pm * 256 + rl) * D + u.pn * 256 + cl) = w;
                    }
                }
            asm volatile("" ::: "memory");
        }
    }
};
DI void phase_g2(const Params& p, const Frame& F, int l) {
    SchedG2 S{F.nb, F.bid, (const char*)(p.ws + WS_H), (const char*)(p.ws + WS_Y),
              (const char*)(p.ws + WS_WIN) + ((size_t)l * INW + GATEOFF) * D * 2, (const char*)(p.ws + WS_WBR) + (size_t)l * D * D * 2, (l == 0 ? T : TL) / 256};
    EpiG2 E{(bf16_t*)(p.ws + WS_IDX) + (size_t)F.bid * 65536, (bf16_t*)(p.ws + WS_MERGED)};
    pg8::gemm_phase(F.lds, F.tid, S, E);
}

DI void g3_simple(const Params& p, const Frame& F, int l, int row_lo, int nrows) {
    const bf16_t* M = (const bf16_t*)(p.ws + WS_MERGED);
    const bf16_t* W = (const bf16_t*)(p.ws + WS_WOUT) + (size_t)l * D * D;
    const int nit = (nrows / 64) * (D / 64);
    for (int it = F.gw; it < nit; it += F.ngw) {
        const int mt = it / (D / 64), nt = it % (D / 64), m0 = row_lo + mt * 64, n0 = nt * 64;
        f32x16 acc[2][2]; zero_acc(acc);
        wave_gemm<2, 2>(M, D, W, D, D, m0, n0, acc, F.lane);
        const int h = F.lane >> 5;
#pragma unroll
        for (int a = 0; a < 2; ++a)
#pragma unroll
            for (int j = 0; j < 2; ++j) {
                const int col = n0 + 32 * j + (F.lane & 31);
#pragma unroll
                for (int r = 0; r < 16; ++r) {
                    const int row = m0 + 32 * a + crow(r, h);
                    const float xs = (l == 0) ? xin_ptr(p, row)[col] : xrow_ptr(p, row)[col];
                    xrow_ptr(p, row)[col] = xs + mod_vec(p, l, row, 2)[col] * acc[a][j][r];
                }
            }
    }
}
struct EpiG3 {
    DI bool keeps(const pg8::Unit&) const { return false; }
    static constexpr bool PERM = false;
    const float* xsrc; float* xdst; const float* csrc; float* cdst; const float* mod;
    DI void operator()(const f32x4 (&acc)[2][2][4][2], const pg8::Unit& u, int wr, int wc, int fr, int fq) const {
        const int col0 = u.pn * 256 + wc * 32 + 4 * fq;
        const bool lat = u.pm < TL / 256;
        const float* gt = mod + (size_t)(lat ? (u.pm >> 4) : 8) * NMOD + 2 * D;
        const float* xs = lat ? xsrc + (size_t)u.pm * 256 * D : csrc + (size_t)(u.pm - TL / 256) * 256 * D;
        float* xd = lat ? xdst + (size_t)u.pm * 256 * D : cdst + (size_t)(u.pm - TL / 256) * 256 * D;
        f32x4 gv[2][2];
#pragma unroll
        for (int bj = 0; bj < 2; ++bj)
#pragma unroll
            for (int n = 0; n < 2; ++n) gv[bj][n] = *(const f32x4*)(gt + col0 + 128 * bj + 16 * n);
#pragma unroll
        for (int ai = 0; ai < 2; ++ai) {
            f32x4 xv[4][2][2];
#pragma unroll
            for (int m = 0; m < 4; ++m)
#pragma unroll
                for (int bj = 0; bj < 2; ++bj)
#pragma unroll
                    for (int n = 0; n < 2; ++n) xv[m][bj][n] = *(const f32x4*)(xs + (size_t)(wr * 64 + fr + 128 * ai + 16 * m) * D + col0 + 128 * bj + 16 * n);
#pragma unroll
            for (int m = 0; m < 4; ++m)
#pragma unroll
                for (int bj = 0; bj < 2; ++bj)
#pragma unroll
                    for (int n = 0; n < 2; ++n)
                        *(f32x4*)(xd + (size_t)(wr * 64 + fr + 128 * ai + 16 * m) * D + col0 + 128 * bj + 16 * n) = xv[m][bj][n] + gv[bj][n] * acc[ai][bj][m][n];
            asm volatile("" ::: "memory");
        }
    }
};
DI void phase_g3(const Params& p, const Frame& F, int l) {
    SchedGrid S{(l == 0 ? T : TL) / 256, D / 256, F.nb, F.bid, (const char*)(p.ws + WS_MERGED), (const char*)(p.ws + WS_WOUT) + (size_t)l * D * D * 2, 0, 0, 0};
    float* xc = (float*)(p.ws + WS_XCTX);
    EpiG3 E{(l == 0) ? p.in[I_x] : p.out, p.out, (l == 0) ? p.in[I_ctx] : xc, xc, (const float*)(p.ws + WS_MOD) + (size_t)l * 9 * NMOD};
    pg8::gemm_phase(F.lds, F.tid, S, E);
}

DI void g45_simple(const Params& p, const Frame& F, int l, int row_lo, int nrows) {
    const bf16_t* H = (const bf16_t*)(p.ws + WS_H);
    const bf16_t* W = (const bf16_t*)(p.ws + WS_WFOLD) + (size_t)l * 2048 * D;
    _Float16* ST = (_Float16*)(p.ws + WS_ST);
    const int nit = (2048 / 64) * (nrows / 64);
    for (int it = F.gw; it < nit; it += F.ngw) {
        const int nt = it / 32, mt = it % 32, m0 = mt * 64, n0 = row_lo + nt * 64;
        f32x16 acc[2][2]; zero_acc(acc);
        wave_gemm<2, 2>(W, D, H, D, D, m0, n0, acc, F.lane);
        const int h = F.lane >> 5;
#pragma unroll
        for (int a = 0; a < 2; ++a)
#pragma unroll
            for (int j = 0; j < 2; ++j)
#pragma unroll
                for (int r = 0; r < 16; ++r) ST[(size_t)(m0 + 32 * a + crow(r, h)) * T + n0 + 32 * j + (F.lane & 31)] = (_Float16)acc[a][j][r];
    }
}
struct EpiG45 {
    DI bool keeps(const pg8::Unit&) const { return false; }
    static constexpr bool PERM = true;
    unsigned short* ST;
    DI void operator()(const f32x4 (&acc)[2][2][4][2], const pg8::Unit& u, int wr, int wc, int fr, int fq) const {
        const int col0 = u.pn * 256 + wc * 32 + 8 * fq;
#pragma unroll
        for (int ai = 0; ai < 2; ++ai)
#pragma unroll
            for (int m = 0; m < 4; ++m) {
                unsigned short* rowp = ST + (size_t)(u.pm * 256 + wr * 64 + fr + 128 * ai + 16 * m) * T + col0;
#pragma unroll
                for (int bj = 0; bj < 2; ++bj) {
                    u32x4 w;
                    w.x = pkh2(acc[ai][bj][m][0][0], acc[ai][bj][m][0][1]); w.y = pkh2(acc[ai][bj][m][0][2], acc[ai][bj][m][0][3]);
                    w.z = pkh2(acc[ai][bj][m][1][0], acc[ai][bj][m][1][1]); w.w = pkh2(acc[ai][bj][m][1][2], acc[ai][bj][m][1][3]);
                    *(u32x4*)(rowp + 128 * bj) = w;
                }
            }
    }
};
DI void phase_g45(const Params& p, const Frame& F, int l) {
    SchedGrid S{2048 / 256, (l == 0 ? T : TL) / 256, F.nb, F.bid, (const char*)(p.ws + WS_WFOLD) + (size_t)l * 2048 * D * 2, (const char*)(p.ws + WS_H), 0, 0, 0};
    EpiG45 E{(unsigned short*)(p.ws + WS_ST)};
    pg8::gemm_phase(F.lds, F.tid, S, E);
}

DI unsigned fkey(float f) { const unsigned u = __builtin_bit_cast(unsigned, f); return (u & 0x80000000u) ? ~u : (u | 0x80000000u); }
DI float fkey_inv(unsigned k) { const unsigned u = (k & 0x80000000u) ? (k & 0x7fffffffu) : ~k; return __builtin_bit_cast(float, u); }
#define INSERT16(L, x) do { unsigned x_ = (x); _Pragma("unroll") for (int k_ = 0; k_ < 16; ++k_) { const unsigned hi_ = max(L[k_], x_); x_ = min(L[k_], x_); L[k_] = hi_; } } while (0)
#define CEX(a, b) do { const unsigned hi_ = max(a, b), lo_ = min(a, b); a = hi_; b = lo_; } while (0)
DI void sort16_desc(unsigned (&v)[16]) {
#pragma unroll
    for (int k = 2; k <= 16; k <<= 1)
#pragma unroll
        for (int j = k >> 1; j > 0; j >>= 1)
#pragma unroll
            for (int i = 0; i < 16; ++i) {
                const int q = i ^ j;
                if (q > i) { if ((i & k) == 0) CEX(v[i], v[q]); else CEX(v[q], v[i]); }
            }
}
DI void merge16_desc(unsigned (&L)[16], const unsigned (&N)[16]) {
#pragma unroll
    for (int i = 0; i < 16; ++i) L[i] = max(L[i], N[15 - i]);
#pragma unroll
    for (int j = 8; j > 0; j >>= 1)
#pragma unroll
        for (int i = 0; i < 16; ++i) { const int q = i ^ j; if (q > i) CEX(L[i], L[q]); }
}
DI void phase_sel(const Params& p, const Frame& F, int l) {
    const _Float16* ST = (const _Float16*)(p.ws + WS_ST);
    unsigned short* IDX = (unsigned short*)(p.ws + WS_IDX);
    float* GW = (float*)(p.ws + WS_GW);
    float* SU = (float*)(p.ws + WS_SU);
    const float* TSC = (const float*)(p.ws + WS_TSCALE) + (size_t)l * 2 * NEXP;
    LAS unsigned char* ib = (LAS unsigned char*)F.lds;
    const int ntok = (l == 0) ? T : TL;
    for (int i0 = F.bid * NTHREADS; i0 < ntok * 8; i0 += F.nb * NTHREADS) {
        const int i = i0 + F.tid;
        const int tok = i % ntok, head = i / ntok;
        unsigned la[16], lb[16];
#pragma unroll
        for (int k = 0; k < 16; ++k) { la[k] = 0u; lb[k] = 0u; }
        const _Float16* s0 = ST + (size_t)(head * 256) * T + tok;
#define SEL_LOAD(B_, k0_) do { _Pragma("unroll") for (int j = 0; j < 32; ++j) B_[j] = s0[(size_t)((k0_) + j) * T]; } while (0)
#define SEL_INS(L_, B_, k0_) do { _Pragma("unroll") for (int h_ = 0; h_ < 2; ++h_) { unsigned nk_[16]; \
        _Pragma("unroll") for (int j = 0; j < 16; ++j) nk_[j] = (fkey((float)B_[16 * h_ + j]) & ~127u) | (unsigned)(127 - (((k0_) + 16 * h_ + j) & 127)); \
        sort16_desc(nk_); merge16_desc(L_, nk_); } } while (0)
        _Float16 bufa[32], bufb[32];
        SEL_LOAD(bufa, 0);
        SEL_LOAD(bufb, 32);  SEL_INS(la, bufa, 0);
        SEL_LOAD(bufa, 64);  SEL_INS(la, bufb, 32);
        SEL_LOAD(bufb, 96);  SEL_INS(la, bufa, 64);
        SEL_LOAD(bufa, 128); SEL_INS(la, bufb, 96);
        SEL_LOAD(bufb, 160); SEL_INS(lb, bufa, 128);
        SEL_LOAD(bufa, 192); SEL_INS(lb, bufb, 160);
        SEL_LOAD(bufb, 224); SEL_INS(lb, bufa, 192);
        SEL_INS(lb, bufb, 224);
#undef SEL_LOAD
#undef SEL_INS
        float va[16], vb[16];
#pragma unroll
        for (int k = 0; k < 16; ++k) {
            va[k] = fkey_inv(la[k] & ~127u); vb[k] = fkey_inv(lb[k] & ~127u);
            ib[k * NTHREADS + F.tid] = (unsigned char)(127u - (la[k] & 127u));
            ib[(16 + k) * NTHREADS + F.tid] = (unsigned char)(127u - (lb[k] & 127u));
        }
        unsigned lc[16];
#pragma unroll
        for (int k = 0; k < 16; ++k) lc[k] = 0u;
#pragma unroll
        for (int a = 0; a < 16; ++a)
#pragma unroll
            for (int b = 0; b < 16; ++b)
                if ((a + 1) * (b + 1) <= 16) { const unsigned key = (fkey(va[a] + vb[b]) & ~255u) | (unsigned)(255 - (a * 16 + b)); INSERT16(lc, key); }
        float e[16], sum = 0.f; const float v0 = fkey_inv(lc[0] & ~255u);
#pragma unroll
        for (int k = 0; k < 16; ++k) { e[k] = __expf(fkey_inv(lc[k] & ~255u) - v0); sum += e[k]; }
        const float inv = 1.0f / sum;
        asm volatile("s_waitcnt lgkmcnt(0)" ::: "memory");
#pragma unroll
        for (int k = 0; k < 16; ++k) {
            const unsigned pos = 255u - (lc[k] & 255u), a = pos >> 4, b = pos & 15u;
            const unsigned ea = ib[a * NTHREADS + F.tid], eb = ib[(16 + b) * NTHREADS + F.tid];
            const unsigned ex = ea * 128u + eb;
            IDX[(size_t)tok * 128 + head * 16 + k] = (unsigned short)ex;
            GW[(size_t)tok * 128 + head * 16 + k] = e[k] * inv * TSC[NEXP + ex];
            SU[(size_t)tok * 128 + head * 16 + k] = TSC[ex];
        }
        asm volatile("s_waitcnt lgkmcnt(0)" ::: "memory");
    }
}

DI float dpp_xor1(float v) { return __builtin_bit_cast(float, __builtin_amdgcn_mov_dpp(__builtin_bit_cast(int, v), 0xB1, 0xF, 0xF, true)); }
DI float dpp_xor2(float v) { return __builtin_bit_cast(float, __builtin_amdgcn_mov_dpp(__builtin_bit_cast(int, v), 0x4E, 0xF, 0xF, true)); }
DI float dpp_hmir(float v) { return __builtin_bit_cast(float, __builtin_amdgcn_mov_dpp(__builtin_bit_cast(int, v), 0x141, 0xF, 0xF, true)); }
DI float dot16_fp8(const u32x4 q, const float (&hx)[16]) {
    f32x2 a = {0.f, 0.f};
#pragma unroll
    for (int j = 0; j < 4; ++j) {
        const f32x2 lo = __builtin_amdgcn_cvt_pk_f32_fp8((int)q[j], false), hi = __builtin_amdgcn_cvt_pk_f32_fp8((int)q[j], true);
        a += lo * (f32x2){hx[4 * j], hx[4 * j + 1]}; a += hi * (f32x2){hx[4 * j + 2], hx[4 * j + 3]};
    }
    return a.x + a.y;
}
#define PEER_EXPERT(id, i) ((int)(((id)[(i) >> 3][((i) >> 1) & 3] >> (16 * ((i) & 1))) & 0xffffu))

struct PeerURows { u32x4 q[16]; u32x4 h0, h1; };
DI void peer_u_rows(PeerURows& R, const u32x4 (&id)[2], const unsigned char* ut, const bf16_t* hrow) {
    R.h0 = *(const u32x4*)(hrow); R.h1 = *(const u32x4*)(hrow + 8);
#pragma unroll
    for (int i = 0; i < 16; ++i) R.q[i] = *(const u32x4*)(ut + (size_t)PEER_EXPERT(id, i) * D);
}
DI void peer_u_compute(const PeerURows& R, float* part, int lane) {
    float hx[16];
#pragma unroll
    for (int j = 0; j < 4; ++j) { hx[2 * j] = bflo(R.h0[j]); hx[2 * j + 1] = bfhi(R.h0[j]); hx[8 + 2 * j] = bflo(R.h1[j]); hx[8 + 2 * j + 1] = bfhi(R.h1[j]); }
    float d[16];
#pragma unroll
    for (int i = 0; i < 16; ++i) d[i] = dot16_fp8(R.q[i], hx);
    const bool b2 = (lane & 4) != 0, b1 = (lane & 2) != 0, b0 = (lane & 1) != 0;
    float k8[8];
#pragma unroll
    for (int i = 0; i < 8; ++i) { const float keep = b2 ? d[8 + i] : d[i], send = b2 ? d[i] : d[8 + i]; k8[i] = keep + dpp_hmir(send); }
    float k4[4];
#pragma unroll
    for (int i = 0; i < 4; ++i) { const float keep = b1 ? k8[4 + i] : k8[i], send = b1 ? k8[i] : k8[4 + i]; k4[i] = keep + dpp_xor2(send); }
    f32x2 k2;
    { const float keep0 = b0 ? k4[2] : k4[0], send0 = b0 ? k4[0] : k4[2], keep1 = b0 ? k4[3] : k4[1], send1 = b0 ? k4[1] : k4[3];
      k2.x = keep0 + dpp_xor1(send0); k2.y = keep1 + dpp_xor1(send1); }
    *(f32x2*)(part + 16 * (lane >> 3) + (b2 ? 8 : 0) + (b1 ? 4 : 0) + (b0 ? 2 : 0)) = k2;
}
DI void phase_peer_u(const Params& p, const Frame& F, int l) {
    const int ntok = (l == 0) ? T : TL, lane = F.lane;
    const int slice = F.bid & 7, sw = (F.bid >> 3) * NWAVES + F.wave, nsw = (F.nb >> 3) * NWAVES;
    const unsigned char* ut = p.ws + WS_UTAB + (size_t)l * NEXP * D + 128 * slice + 16 * (lane & 7);
    const bf16_t* Hs = (const bf16_t*)(p.ws + WS_H) + 128 * slice + 16 * (lane & 7);
    const unsigned short* IDXg = (const unsigned short*)(p.ws + WS_IDX) + 16 * (lane >> 3);
    float* PART = (float*)(p.ws + WS_ST) + (size_t)slice * T * 128;
    const int last = ntok - 1;
    u32x4 sa[2], sb[2]; PeerURows ra, rb;
#define U_SEL(S_, t_) do { const unsigned short* ip_ = IDXg + (size_t)min((t_), last) * 128; S_[0] = *(const u32x4*)ip_; S_[1] = *(const u32x4*)(ip_ + 8); } while (0)
#define U_ROWS(R_, S_, t_) peer_u_rows(R_, S_, ut, Hs + (size_t)min((t_), last) * D)
    U_SEL(sa, sw); U_SEL(sb, sw + nsw);
    U_ROWS(ra, sa, sw);
#pragma unroll 1
    for (int tok = sw; tok < ntok; tok += 2 * nsw) {
        U_SEL(sa, tok + 2 * nsw); U_ROWS(rb, sb, tok + nsw);
        peer_u_compute(ra, PART + (size_t)tok * 128, lane);
        U_SEL(sb, tok + 3 * nsw); U_ROWS(ra, sa, tok + 2 * nsw);
        if (tok + nsw < ntok) peer_u_compute(rb, PART + (size_t)(tok + nsw) * 128, lane);
    }
#undef U_SEL
#undef U_ROWS
}
DI void phase_peer_c(const Params& p, const Frame& F, int l, bool dummy = false) {
    const int ntok = (l == 0) ? T : TL;
    const float* PART = (const float*)(p.ws + WS_ST);
    float* GW = (float*)(p.ws + WS_GW);
    float* CO = dummy ? (float*)(p.ws + WS_H8) : GW;
    const float* SU = (const float*)(p.ws + WS_SU);
    for (int i = F.gtid; i < ntok * 128; i += F.ngt) {
        float s = 0.f;
#pragma unroll
        for (int sl = 0; sl < 8; ++sl) s += PART[(size_t)sl * T * 128 + i];
        CO[i] = GW[i] * gelu_tanh(s * SU[i]);
    }
}
struct PeerVRows { u32x4 q[16]; f32x4 cf[4]; f32x2 xv, gv; };
DI void peer_v_rows(PeerVRows& R, const u32x4 (&id)[2], const unsigned char* vt, const float* cp, const float* xs, const float* gt2) {
    R.cf[0] = *(const f32x4*)cp; R.cf[1] = *(const f32x4*)(cp + 4); R.cf[2] = *(const f32x4*)(cp + 8); R.cf[3] = *(const f32x4*)(cp + 12);
    R.xv = *(const f32x2*)xs; R.gv = *(const f32x2*)gt2;
#pragma unroll
    for (int i = 0; i < 16; ++i) R.q[i] = *(const u32x4*)(vt + (size_t)PEER_EXPERT(id, i) * D);
}
DI float xchg32(float v, bool hi) { const auto r = __builtin_amdgcn_permlane32_swap(__builtin_bit_cast(unsigned, v), __builtin_bit_cast(unsigned, v), false, false);
    return __builtin_bit_cast(float, hi ? r[0] : r[1]); }
DI float xchg16(float v, bool hi) { const auto r = __builtin_amdgcn_permlane16_swap(__builtin_bit_cast(unsigned, v), __builtin_bit_cast(unsigned, v), false, false);
    return __builtin_bit_cast(float, hi ? r[0] : r[1]); }
DI float xchg8(float v) { return __builtin_bit_cast(float, __builtin_amdgcn_mov_dpp(__builtin_bit_cast(int, v), 0x128, 0xF, 0xF, true)); }
DI void peer_v_compute(const PeerVRows& R, float* xdst, int lane) {
    f32x2 a[8];
#pragma unroll
    for (int j = 0; j < 8; ++j) a[j] = (f32x2){0.f, 0.f};
#pragma unroll
    for (int i = 0; i < 16; ++i) {
        const float c = R.cf[i >> 2][i & 3]; const f32x2 c2 = {c, c};
#pragma unroll
        for (int j = 0; j < 4; ++j) {
            a[2 * j] += c2 * __builtin_amdgcn_cvt_pk_f32_fp8((int)R.q[i][j], false);
            a[2 * j + 1] += c2 * __builtin_amdgcn_cvt_pk_f32_fp8((int)R.q[i][j], true);
        }
    }
    const bool b5 = (lane & 32) != 0, b4 = (lane & 16) != 0, b3 = (lane & 8) != 0;
    f32x2 k4[4];
#pragma unroll
    for (int j = 0; j < 4; ++j) { const f32x2 keep = b5 ? a[4 + j] : a[j], send = b5 ? a[j] : a[4 + j];
        k4[j] = keep + (f32x2){xchg32(send.x, b5), xchg32(send.y, b5)}; }
    f32x2 k2[2];
#pragma unroll
    for (int j = 0; j < 2; ++j) { const f32x2 keep = b4 ? k4[2 + j] : k4[j], send = b4 ? k4[j] : k4[2 + j];
        k2[j] = keep + (f32x2){xchg16(send.x, b4), xchg16(send.y, b4)}; }
    f32x2 k1;
    { const f32x2 keep = b3 ? k2[1] : k2[0], send = b3 ? k2[0] : k2[1];
        k1 = keep + (f32x2){xchg8(send.x), xchg8(send.y)}; }
    *(f32x2*)xdst = R.xv + R.gv * k1;
}
DI void phase_peer_v(const Params& p, const Frame& F, int l, bool dummy = false) {
    const int ntok = (l == 0) ? T : TL, lane = F.lane;
    const int slice = F.bid & 7, sw = (F.bid >> 3) * NWAVES + F.wave, nsw = (F.nb >> 3) * NWAVES;
    const unsigned char* vt = p.ws + WS_VTAB + (size_t)l * NEXP * D + 128 * slice + 16 * (lane & 7);
    const unsigned short* IDXg = (const unsigned short*)(p.ws + WS_IDX) + 16 * (lane >> 3);
    const float* CFg = (const float*)(p.ws + WS_GW) + 16 * (lane >> 3);
    const int last = ntok - 1;
    u32x4 sa[2], sb[2]; PeerVRows ra, rb;
#define V_SEL(S_, t_) do { const unsigned short* ip_ = IDXg + (size_t)min((t_), last) * 128; S_[0] = *(const u32x4*)ip_; S_[1] = *(const u32x4*)(ip_ + 8); } while (0)
    const int co = 128 * slice + 16 * (lane & 7) + ((lane & 32) ? 8 : 0) + ((lane & 16) ? 4 : 0) + ((lane & 8) ? 2 : 0);
#define V_ROWS(R_, S_, t_) do { const int t1_ = min((t_), last); peer_v_rows(R_, S_, vt, CFg + (size_t)t1_ * 128, xrow_ptr(p, t1_) + co, mod_vec(p, l, t1_, 5) + co); } while (0)
#define V_DO(R_, t_) do { const int t2_ = (t_); float* xd_ = (dummy ? (float*)(p.ws + WS_ST) + (size_t)t2_ * D : xrow_ptr(p, t2_)) + co; peer_v_compute(R_, xd_, lane); } while (0)
    V_SEL(sa, sw); V_SEL(sb, sw + nsw);
    V_ROWS(ra, sa, sw);
#pragma unroll 1
    for (int tok = sw; tok < ntok; tok += 2 * nsw) {
        V_SEL(sa, tok + 2 * nsw); V_ROWS(rb, sb, tok + nsw);
        V_DO(ra, tok);
        V_SEL(sb, tok + 3 * nsw); V_ROWS(ra, sa, tok + 2 * nsw);
        if (tok + nsw < ntok) V_DO(rb, tok + nsw);
    }
#undef V_SEL
#undef V_ROWS
#undef V_DO
}

#define XB_TMO      128
#define XB_XCNT(j)  (256  + 64 * (j))
#define XB_XSUB(j)  (1280 + 64 * (j))
#define XB_XGEN(j)  (2304 + 64 * (j))
#define XB_TOP      3328
#define XB_TOPGEN   3392
#define XCD_BAR_WORDS 3456
#define XB_SPIN_CAP (1u << 18)
DI unsigned xb_ld(unsigned* p)              { return __hip_atomic_load(p, __ATOMIC_RELAXED, __HIP_MEMORY_SCOPE_AGENT); }
DI unsigned xb_add(unsigned* p, unsigned v) { return __hip_atomic_fetch_add(p, v, __ATOMIC_RELAXED, __HIP_MEMORY_SCOPE_AGENT); }
DI unsigned xb_xcc_id() { return (unsigned)__builtin_amdgcn_s_getreg((3 << 11) | 20) & 0xFu; }
#define XB_SPIN(cond, bar) do { unsigned _sp = 0; while (cond) { __builtin_amdgcn_s_sleep(1); \
    if ((++_sp & 255u) == 0u) { if (xb_ld(&(bar)[XB_TMO])) break; if (_sp > XB_SPIN_CAP) { atomicAdd(&(bar)[XB_TMO], 1u); break; } } } } while (0)
struct XcdBarrier { unsigned* bar; unsigned x; volatile LAS unsigned* st; };
DI XcdBarrier xcd_barrier_post(unsigned* bar, volatile LAS unsigned* st) {
    XcdBarrier b; b.bar = bar; b.x = xb_xcc_id(); b.st = st;
    if (threadIdx.x == 0) (void)xb_add(&bar[XB_XCNT(b.x)], 1u);
    return b;
}
DI void xcd_barrier_complete(unsigned* bar, unsigned x, unsigned& nloc, unsigned& nx) {
    const unsigned G = gridDim.x * gridDim.y * gridDim.z;
    unsigned sum, cnt, mine, sp = 0u;
    for (;;) {
        sum = 0u; cnt = 0u; mine = 0u;
#pragma unroll
        for (unsigned j = 0; j < 16; ++j) { const unsigned c = xb_ld(&bar[XB_XCNT(j)]); sum += c; cnt += (c > 0u) ? 1u : 0u; mine = (j == x) ? c : mine; }
        if (sum == G) break;
        __builtin_amdgcn_s_sleep(1);
        if ((++sp & 255u) == 0u) { if (xb_ld(&bar[XB_TMO])) break; if (sp > XB_SPIN_CAP) { atomicAdd(&bar[XB_TMO], 1u); break; } }
    }
    nloc = mine > 0u ? mine : 1u; nx = cnt > 0u ? cnt : 1u;
}
DI void xcd_barrier(const XcdBarrier& b) {
    asm volatile("s_waitcnt vmcnt(0)" ::: "memory");
    __syncthreads();
    if (threadIdx.x == 0) {
        unsigned* bar = b.bar;
        __builtin_amdgcn_s_waitcnt(0);
        unsigned nloc = b.st[0], nx = b.st[1];
        if (nloc == 0u) { xcd_barrier_complete(bar, b.x, nloc, nx); b.st[0] = nloc; b.st[1] = nx; }
        const unsigned old = xb_add(&bar[XB_XSUB(b.x)], 1u);
        const unsigned gen = old / nloc;
        if (old + 1u == (gen + 1u) * nloc) {
            __builtin_amdgcn_fence(__ATOMIC_RELEASE, "agent");
            asm volatile("s_waitcnt vmcnt(0)" ::: "memory");
            const unsigned og = xb_add(&bar[XB_TOP], 1u);
            const unsigned tg = og / nx;
            if (og + 1u == (tg + 1u) * nx) xb_add(&bar[XB_TOPGEN], 1u);
            else XB_SPIN(xb_ld(&bar[XB_TOPGEN]) == tg, bar);
            __builtin_amdgcn_fence(__ATOMIC_ACQUIRE, "agent");
            xb_add(&bar[XB_XGEN(b.x)], 1u);
            asm volatile("s_waitcnt vmcnt(0)" ::: "memory");
        } else {
            XB_SPIN(xb_ld(&bar[XB_XGEN(b.x)]) == gen, bar);
            __builtin_amdgcn_fence(__ATOMIC_ACQUIRE, "agent");
            asm volatile("s_waitcnt vmcnt(0)" ::: "memory");
        }
    }
    __syncthreads();
}

constexpr int NPHASE = 24;
template <int PH> DI void run_phase(const Params& p, const Frame& F) {
    if constexpr (PH == 0) phase_prep(p, F);
    else if constexpr (PH == 1) phase_norm(p, F, 0, 0, true, T);
    else if constexpr (PH == 2) phase_g1(p, F, 0);
    else if constexpr (PH == 3) phase_mix(p, F, 0);
    else if constexpr (PH == 4) phase_g2(p, F, 0);
    else if constexpr (PH == 5) phase_g3(p, F, 0);
    else if constexpr (PH == 6) phase_norm(p, F, 0, 1, false, T);
    else if constexpr (PH == 7) phase_g45(p, F, 0);
    else if constexpr (PH == 8) phase_sel(p, F, 0);
    else if constexpr (PH == 9) phase_peer_u(p, F, 0);
    else if constexpr (PH == 10) phase_peer_c(p, F, 0);
    else if constexpr (PH == 11) phase_peer_v(p, F, 0);
    else if constexpr (PH == 12) phase_norm(p, F, 1, 0, false, T);
    else if constexpr (PH == 13) phase_g1(p, F, 1);
    else if constexpr (PH == 14) phase_mix(p, F, 1);
    else if constexpr (PH == 15) phase_g2(p, F, 1);
    else if constexpr (PH == 16) phase_g3(p, F, 1);
    else if constexpr (PH == 17) phase_norm(p, F, 1, 1, false, TL);
    else if constexpr (PH == 18) phase_g45(p, F, 1);
    else if constexpr (PH == 19) phase_sel(p, F, 1);
    else if constexpr (PH == 20) phase_peer_u(p, F, 1);
    else if constexpr (PH == 21) phase_peer_c(p, F, 1);
    else if constexpr (PH == 22) phase_peer_v(p, F, 1);
    else if constexpr (PH == 23) phase_final(p, F);
}
DI Frame make_frame(unsigned char* lds_raw) {
    Frame F;
    F.lds = (LAS unsigned char*)lds_raw;
    int tid = threadIdx.x; asm volatile("" : "+v"(tid));
    int bid = blockIdx.x, nb = gridDim.x; asm volatile("" : "+s"(bid), "+s"(nb));
    F.tid = tid; F.lane = tid & 63; F.wave = __builtin_amdgcn_readfirstlane(tid >> 6); F.bid = bid; F.nb = nb;
    F.gw = bid * NWAVES + F.wave; F.ngw = nb * NWAVES; F.gtid = bid * NTHREADS + tid; F.ngt = nb * NTHREADS;
    return F;
}
template <int PH> DI void run_phase_fresh(unsigned char* lds_raw) {
#if defined(__HIP_DEVICE_COMPILE__)
    const __attribute__((address_space(4))) unsigned long long* pp = (const __attribute__((address_space(4))) unsigned long long*)__builtin_amdgcn_kernarg_segment_ptr();
    asm volatile("" : "+s"(pp));
    Params p;
#pragma unroll
    for (int i = 0; i < N_IN; ++i) p.in[i] = (const float*)(const __attribute__((address_space(1))) float*)pp[i];
    p.out = (float*)(__attribute__((address_space(1))) float*)pp[N_IN]; p.ws = (unsigned char*)(__attribute__((address_space(1))) unsigned char*)pp[N_IN + 1]; p.ph_lo = 0; p.ph_hi = 0;
#else
    Params p{};
#endif
    const Frame F = make_frame(lds_raw);
    run_phase<PH>(p, F);
}
template <int PH> __global__ void __launch_bounds__(NTHREADS, 2) phase_kernel(Params p) {
    extern __shared__ __attribute__((aligned(16))) unsigned char lds_raw[];
    run_phase_fresh<PH>(lds_raw);
}
template <int PH> DI void run_all(unsigned char* lds_raw, cg::grid_group& grid, const XcdBarrier& bar) {
    if constexpr (PH < NPHASE) {
        if constexpr (PH == PROBE_PH) {
            if constexpr (PH == 10 || PH == 21 || PH == 11 || PH == 22 || PH == 3 || PH == 14) {
#if defined(__HIP_DEVICE_COMPILE__)
                const __attribute__((address_space(4))) unsigned long long* pp = (const __attribute__((address_space(4))) unsigned long long*)__builtin_amdgcn_kernarg_segment_ptr();
                asm volatile("" : "+s"(pp));
                Params p;
#pragma unroll
                for (int i = 0; i < N_IN; ++i) p.in[i] = (const float*)(const __attribute__((address_space(1))) float*)pp[i];
                p.out = (float*)(__attribute__((address_space(1))) float*)pp[N_IN]; p.ws = (unsigned char*)(__attribute__((address_space(1))) unsigned char*)pp[N_IN + 1]; p.ph_lo = 0; p.ph_hi = 0;
                const Frame F = make_frame(lds_raw);
                if constexpr (PH == 3 || PH == 14) phase_mix(p, F, PH == 3 ? 0 : 1, 1);
                else if constexpr (PH == 10 || PH == 21) phase_peer_c(p, F, PH == 10 ? 0 : 1, true); else phase_peer_v(p, F, PH == 11 ? 0 : 1, true);
#endif
            } else run_phase_fresh<PH>(lds_raw);
            xcd_barrier(bar);
        }
        run_phase_fresh<PH>(lds_raw);
        if constexpr (PH == 0) grid.sync();
        else if constexpr (PH + 1 < NPHASE) { xcd_barrier(bar); if constexpr (PROBE_SYNC) xcd_barrier(bar); }
        run_all<PH + 1>(lds_raw, grid, bar);
    }
}
__global__ void __launch_bounds__(NTHREADS, 2) mega(Params p) {
    extern __shared__ __attribute__((aligned(16))) unsigned char lds_raw[];
    cg::grid_group grid = cg::this_grid();
    volatile LAS unsigned* st = (volatile LAS unsigned*)((LAS unsigned char*)lds_raw + LDS_BAR_OFF);
    if (threadIdx.x < 2) st[threadIdx.x] = 0u;
    __syncthreads();
    const XcdBarrier bar = xcd_barrier_post((unsigned*)(p.ws + WS_CTL), st);
    run_all<0>(lds_raw, grid, bar);
}

extern "C" void kernel_launch(void* const* d_in, const int* in_sizes, int n_in, void* d_out, int out_size, void* d_ws, size_t ws_size, hipStream_t stream) {
    static int grid = 0;
    if (grid == 0) {
        if (n_in != 23 || out_size != TL * D || ws_size < WS_END) { fprintf(stderr, "kernel_launch: unexpected shapes (n_in %d out %d ws %zu)\n", n_in, out_size, ws_size); grid = -1; return; }
        int dev = 0, cus = 0, per_cu = 0;
        (void)hipGetDevice(&dev);
        (void)hipDeviceGetAttribute(&cus, hipDeviceAttributeMultiprocessorCount, dev);
        (void)hipFuncSetAttribute((const void*)mega, hipFuncAttributeMaxDynamicSharedMemorySize, LDS_BYTES);
        (void)hipOccupancyMaxActiveBlocksPerMultiprocessor(&per_cu, (const void*)mega, NTHREADS, LDS_BYTES);
        if (per_cu < 1) { fprintf(stderr, "kernel_launch: occupancy query reports %d blocks per CU\n", per_cu); grid = -1; return; }
        grid = cus & ~7;
        if (grid < 8) { fprintf(stderr, "kernel_launch: needs at least 8 CUs\n"); grid = -1; return; }
    }
    if (grid < 0) return;
    (void)hipMemsetAsync((char*)d_ws + WS_CTL, 0, CTL_ZERO_BYTES, stream);
    Params p{};
    for (int i = 0; i < N_IN; ++i) p.in[i] = (const float*)d_in[i];
    p.out = (float*)d_out; p.ws = (unsigned char*)d_ws;
    void* args[] = {&p};
    hipError_t e = hipLaunchCooperativeKernel((const void*)mega, dim3(grid), dim3(NTHREADS), args, LDS_BYTES, stream);
    if (e != hipSuccess) fprintf(stderr, "cooperative launch failed: %s (grid %d)\n", hipGetErrorString(e), grid);
}
```

```cpp
#include <hip/hip_runtime.h>
#include <hip/hip_cooperative_groups.h>
#include <stdint.h>
#include <stdio.h>
namespace cg = cooperative_groups;

#ifndef PROBE_PH
#define PROBE_PH -1
#endif
#ifndef PROBE_SYNC
#define PROBE_SYNC 0
#endif
#ifndef MK_SINGLE
#define MK_SINGLE 0
#endif

#define LAS __attribute__((address_space(3)))
typedef unsigned short bf16_t;
typedef short bf16x8 __attribute__((ext_vector_type(8)));
typedef short s16x4 __attribute__((ext_vector_type(4)));
typedef float f32x4 __attribute__((ext_vector_type(4)));
typedef float f32x2 __attribute__((ext_vector_type(2)));
typedef float f32x16 __attribute__((ext_vector_type(16)));
typedef unsigned u32x4 __attribute__((ext_vector_type(4)));
typedef unsigned u32x2 __attribute__((ext_vector_type(2)));
typedef __bf16 bf16x2_t __attribute__((ext_vector_type(2)));
typedef _Float16 f16x2_t __attribute__((ext_vector_type(2)));
#define DI __device__ __forceinline__
DI unsigned pkh2(float lo, float hi) { f16x2_t v = {(_Float16)lo, (_Float16)hi}; return __builtin_bit_cast(unsigned, v); }
#define MFMA32(a, b, c) __builtin_amdgcn_mfma_f32_32x32x16_bf16((a), (b), (c), 0, 0, 0)

constexpr int D = 1024, NB = 8, SEQ = 4096, NCTX = 256, DEPTH = 2;
constexpr int TL = NB * SEQ, TC = NB * NCTX, T = TL + TC;
constexpr int INW = 4608, NMOD = 6 * D, PW = 1600, PN = 1536;
constexpr int VTS = SEQ + 64;
constexpr int QOFF = 0, KOFF = 512, VOFF = 640, POOLOFF = 768, SUOFF = 1024, SVOFF = 1280, GATEOFF = 1536;
constexpr int NEXP = 16384;
constexpr float EPS = 1e-6f;
constexpr float LOG2E = 1.4426950408889634f;
constexpr float QSCALE = 0.125f * LOG2E;

constexpr size_t MiB = 1u << 20;
constexpr size_t WS_CTL = 0, WS_MOD = 1 * MiB, CTL_ZERO_BYTES = 2 * MiB;
constexpr size_t WS_ROPE = 2 * MiB, WS_SGUW = 2 * MiB + 65536, WS_TSCALE = 3 * MiB;
constexpr size_t WS_WIN = 4 * MiB, WS_WBR = 22 * MiB, WS_WOUT = 26 * MiB, WS_WFOLD = 30 * MiB;
constexpr size_t WS_XCTX = 38 * MiB, WS_UTAB = 46 * MiB, WS_VTAB = 78 * MiB;
constexpr size_t WS_IDX = 110 * MiB, WS_GW = 120 * MiB;
constexpr size_t WS_H = 142 * MiB;
constexpr size_t WS_P = 210 * MiB, WS_Y = 318 * MiB, WS_MERGED = 386 * MiB, WS_VT = 454 * MiB, WS_VTC = 463 * MiB, WS_VST = 464 * MiB;
constexpr size_t WS_MP = 482 * MiB;
constexpr size_t WS_ST = 210 * MiB, WS_H8 = 346 * MiB, WS_HS = 380 * MiB, WS_SU = 482 * MiB;
constexpr size_t WS_END = 512 * MiB;
static_assert(WS_ST + (size_t)2048 * T * 2 <= WS_H8 && WS_H8 + (size_t)T * D <= WS_HS, "ST / H8 fit");
static_assert(WS_VST + (size_t)272 * 256 * 128 * 2 <= WS_SU && WS_VT + (size_t)NB * 2 * 64 * VTS * 2 <= WS_VTC, "VsT / VT fit");
static_assert(WS_H + (size_t)T * D * 2 <= WS_P, "H fits");
static_assert(WS_P + (size_t)T * PW * 2 <= WS_Y && WS_Y + (size_t)T * D * 2 <= WS_MERGED && WS_MERGED + (size_t)T * D * 2 <= WS_VT, "P/Y/MERGED fit");
static_assert(WS_IDX + (size_t)T * 128 * 2 <= WS_GW && WS_GW + (size_t)T * 128 * 4 <= WS_H && WS_SU + (size_t)T * 128 * 4 <= WS_END && WS_HS + (size_t)T * 4 <= WS_SU, "idx/gw/su fit");

constexpr int LDS_BYTES = 163840;
constexpr int LDS_BAR_OFF = LDS_BYTES - 64;
constexpr int NTHREADS = 512, NWAVES = 8;

enum { I_x, I_c, I_ctx, I_c_ctx, I_w_mod, I_b_mod, I_g_mix, I_g_ffn, I_w_in, I_attn_sink, I_pool_w, I_pool_scale, I_sgu_w, I_sgu_b, I_w_br_attn, I_w_br_pool, I_w_br_sgu, I_w_out, I_peer_wq, I_peer_subkeys, I_peer_u, I_peer_v, I_g_final, N_IN };
struct Params {
    const float* in[N_IN];
    float* out; unsigned char* ws;
    int ph_lo, ph_hi;
};

DI unsigned pk2(float lo, float hi) { f32x2 v = {lo, hi}; return __builtin_bit_cast(unsigned, __builtin_convertvector(v, bf16x2_t)); }
DI unsigned f2bf(float f) { return pk2(f, 0.f) & 0xffffu; }
DI float bf2f(unsigned short u) { return __builtin_bit_cast(float, (unsigned)u << 16); }
DI float bflo(unsigned w) { return __builtin_bit_cast(float, w << 16); }
DI float bfhi(unsigned w) { return __builtin_bit_cast(float, w & 0xffff0000u); }
DI int crow(int reg, int h) { return (reg & 3) + 8 * (reg >> 2) + 4 * h; }
DI float wave_sum(float v) {
#pragma unroll
    for (int o = 1; o < 64; o <<= 1) v += __shfl_xor(v, o);
    return v;
}
DI float sigmoidf_(float x) { return 1.0f / (1.0f + __expf(-x)); }
DI float gelu_tanh(float x) { const float u = 0.7978845608028654f * (x + 0.044715f * x * x * x); return x / (1.0f + __expf(-2.0f * u)); }
DI float silu_(float x) { return x / (1.0f + __expf(-x)); }

struct Frame {
    int tid, lane, wave, gw, ngw, gtid, ngt, bid, nb;
    LAS unsigned char* lds;
};

template <int NM, int NN>
DI void wave_gemm(const bf16_t* __restrict__ A, int lda, const bf16_t* __restrict__ Bt, int ldb, int K, int m0, int n0, f32x16 (&acc)[NM][NN], int lane) {
    const int r = lane & 31, h = lane >> 5;
    const bf16_t* ap = A + (size_t)(m0 + r) * lda + 8 * h;
    const bf16_t* bp = Bt + (size_t)(n0 + r) * ldb + 8 * h;
    for (int k0 = 0; k0 < K; k0 += 64) {
        bf16x8 a[4][NM], b[4][NN];
#pragma unroll
        for (int s = 0; s < 4; ++s) {
#pragma unroll
            for (int i = 0; i < NM; ++i) a[s][i] = *(const bf16x8*)(ap + (size_t)(32 * i) * lda + k0 + 16 * s);
#pragma unroll
            for (int j = 0; j < NN; ++j) b[s][j] = *(const bf16x8*)(bp + (size_t)(32 * j) * ldb + k0 + 16 * s);
        }
#pragma unroll
        for (int s = 0; s < 4; ++s)
#pragma unroll
            for (int i = 0; i < NM; ++i)
#pragma unroll
                for (int j = 0; j < NN; ++j) acc[i][j] = MFMA32(a[s][i], b[s][j], acc[i][j]);
    }
}
template <int NM, int NN> DI void zero_acc(f32x16 (&acc)[NM][NN]) {
#pragma unroll
    for (int i = 0; i < NM; ++i)
#pragma unroll
        for (int j = 0; j < NN; ++j)
#pragma unroll
            for (int r = 0; r < 16; ++r) acc[i][j][r] = 0.f;
}

namespace pg8 {
constexpr int BM = 256, BK = 64, HALF = 128, HTB = HALF * BK * 2, STAGE_BYTES = 8 * HTB, NXCD = 8, WGM = 8, LD = 1024;
DI int lds_byte(int r, int c) { const int st = (r >> 4) * 2 + (c >> 5), rr = r & 15, cc = c & 31, ob = rr * 64 + cc * 2; return st * 1024 + (ob ^ (((ob >> 9) & 1) << 5)); }
DI void stage_rc(int b, int& R, int& C) { const int st = b / 1024, sb = b % 1024, swz = sb ^ (((sb >> 9) & 1) << 5); R = (st >> 1) * 16 + swz / 64; C = (st & 1) * 32 + (swz % 64) / 2; }
DI int perm32(int rho) { const int n = rho >> 4, i = rho & 15; return 8 * (i >> 2) + 4 * n + (i & 3); }
struct Unit { int pm, pn, sub, nt, mode; const char* a; const char* b; };
DI void tile_of(int L, int nM, int nN, int& pm, int& pn) {
    const int nwg = nM * nN; int wgid = L;
    { const int q = nwg / NXCD, r = nwg % NXCD, xcd = wgid % NXCD, off = wgid / NXCD; wgid = (xcd < r ? xcd * (q + 1) : r * (q + 1) + (xcd - r) * q) + off; }
    const int nig = WGM * nN, gid = wgid / nig, fm = gid * WGM, gsz = (nM - fm) < WGM ? (nM - fm) : WGM;
    pm = fm + ((wgid % nig) % gsz); pn = (wgid % nig) / gsz;
}
template <class Epi, class Sched>
DI void gemm_phase(LAS unsigned char* lds, const int tid, const Sched& S, const Epi& E) {
    const int wid = __builtin_amdgcn_readfirstlane(tid >> 6), lane = tid & 63, wr = wid >> 2, wc = wid & 3, fr = lane & 15, fq = lane >> 4;
    unsigned voffA[2], voffB[2];
#pragma unroll
    for (int i = 0; i < 2; ++i) { int R, C; stage_rc(tid * 16 + i * 8192, R, C); const int Rb = Epi::PERM ? ((R & ~31) + perm32(R & 31)) : R;
        voffA[i] = (unsigned)(R * LD + C) * 2u; voffB[i] = (unsigned)(Rb * LD + C) * 2u; }
    const size_t kstep = (size_t)(BK * 2);
    const size_t hstep = (size_t)HALF * LD * 2;
    const unsigned ldsw = (unsigned)wid * 1024u;
    const int aoff = lds_byte(wr * 64 + fr, fq * 8), boff = lds_byte(wc * 32 + fr, fq * 8);
#define PG8_SA(b, h) (((b) * 2 + (h)) * HTB)
#define PG8_SB(b, h) ((4 + (b) * 2 + (h)) * HTB)
#define PG8_STAGE(bufoff, gbase, voff) do { _Pragma("unroll") for (int _i = 0; _i < 2; ++_i) \
        __builtin_amdgcn_global_load_lds((const unsigned*)((const char*)(gbase) + (voff)[_i]), (LAS unsigned*)(lds + (bufoff) + ldsw + _i * 8192), 16, 0, 0); } while (0)
#define PG8_LDA(dst, b, h) do { _Pragma("unroll") for (int m = 0; m < 4; ++m) _Pragma("unroll") for (int k = 0; k < 2; ++k) dst[m][k] = *(const LAS bf16x8*)(lds + PG8_SA(b, h) + aoff + m * 2048 + k * 1024); } while (0)
#define PG8_LDB(dst, b, h) do { _Pragma("unroll") for (int n = 0; n < 2; ++n) _Pragma("unroll") for (int k = 0; k < 2; ++k) dst[n][k] = *(const LAS bf16x8*)(lds + PG8_SB(b, h) + boff + n * 2048 + k * 1024); } while (0)
#define PG8_MMA(ai, bj, At, Bt) do { __builtin_amdgcn_s_setprio(1); _Pragma("unroll") for (int m = 0; m < 4; ++m) _Pragma("unroll") for (int n = 0; n < 2; ++n) _Pragma("unroll") for (int k = 0; k < 2; ++k) \
        acc[ai][bj][m][n] = __builtin_amdgcn_mfma_f32_16x16x32_bf16(Bt[n][k], At[m][k], acc[ai][bj][m][n], 0, 0, 0); __builtin_amdgcn_s_setprio(0); } while (0)
#define PG8_WAIT_V(n) asm volatile("s_waitcnt vmcnt(" #n ")" ::: "memory")
#define PG8_WAIT_L(n) asm volatile("s_waitcnt lgkmcnt(" #n ")" ::: "memory")
#define PG8_BAR __builtin_amdgcn_s_barrier()
#define PG8_SCHED __builtin_amdgcn_sched_barrier(0)
    Unit cur, nxt; int ui = 0;
    if (!S.next(0, cur)) return;
    f32x4 acc[2][2][4][2];
#pragma unroll
    for (int a = 0; a < 2; ++a)
#pragma unroll
        for (int b = 0; b < 2; ++b)
#pragma unroll
            for (int m = 0; m < 4; ++m)
#pragma unroll
                for (int n = 0; n < 2; ++n) acc[a][b][m][n] = (f32x4){0.f, 0.f, 0.f, 0.f};
    bf16x8 At[4][2], B0[2][2], B1[2][2];
    const char* cA = cur.a; const char* cB = cur.b;
    PG8_STAGE(PG8_SB(0, 0), cB, voffB); PG8_STAGE(PG8_SB(0, 1), cB + hstep, voffB); PG8_STAGE(PG8_SA(0, 0), cA, voffA); PG8_STAGE(PG8_SA(0, 1), cA + hstep, voffA);
    if (wr == 1) PG8_BAR;
    PG8_WAIT_V(2); PG8_BAR;
    PG8_STAGE(PG8_SB(1, 0), cB + kstep, voffB); PG8_STAGE(PG8_SA(1, 0), cA + kstep, voffA); PG8_STAGE(PG8_SB(1, 1), cB + hstep + kstep, voffB);
    PG8_WAIT_V(6); PG8_BAR;
    for (;;) {
        const bool has_next = S.next(ui + 1, nxt);
        const char* nA = has_next ? nxt.a : cA; const char* nB = has_next ? nxt.b : cB;
        const int nt = cur.nt;
        for (int t = 0; t < nt; t += 2) {
            const bool last = (t == nt - 2);
            const char* a1 = cA + (size_t)(t + 1) * kstep;
            const char* a2 = last ? nA : cA + (size_t)(t + 2) * kstep; const char* b2 = last ? nB : cB + (size_t)(t + 2) * kstep;
            const char* a3 = a2 + kstep; const char* b3 = b2 + kstep;
            PG8_LDB(B0, 0, 0); PG8_LDB(B1, 0, 1); PG8_SCHED; PG8_LDA(At, 0, 0); PG8_STAGE(PG8_SA(1, 1), a1 + hstep, voffA);
            PG8_WAIT_V(8); PG8_WAIT_L(0); PG8_BAR; PG8_MMA(0, 0, At, B0); PG8_MMA(0, 1, At, B1); PG8_BAR; PG8_SCHED;
            PG8_LDA(At, 0, 1); PG8_STAGE(PG8_SB(0, 0), b2, voffB); PG8_STAGE(PG8_SB(0, 1), b2 + hstep, voffB); PG8_STAGE(PG8_SA(0, 0), a2, voffA);
            PG8_WAIT_V(8); PG8_WAIT_L(0); PG8_BAR; PG8_MMA(1, 0, At, B0); PG8_MMA(1, 1, At, B1); PG8_BAR; PG8_SCHED;
            PG8_LDB(B0, 1, 0); PG8_LDB(B1, 1, 1); PG8_SCHED; PG8_LDA(At, 1, 0); PG8_STAGE(PG8_SA(0, 1), a2 + hstep, voffA);
            PG8_WAIT_V(8); PG8_WAIT_L(0); PG8_BAR; PG8_MMA(0, 0, At, B0); PG8_MMA(0, 1, At, B1); PG8_BAR; PG8_SCHED;
            PG8_LDA(At, 1, 1); PG8_STAGE(PG8_SB(1, 0), b3, voffB); PG8_STAGE(PG8_SB(1, 1), b3 + hstep, voffB); PG8_STAGE(PG8_SA(1, 0), a3, voffA);
            PG8_WAIT_V(8); PG8_WAIT_L(0); PG8_BAR; PG8_MMA(1, 0, At, B0); PG8_MMA(1, 1, At, B1); PG8_BAR; PG8_SCHED;
        }
        if (wr == 0) PG8_BAR;
        E(acc, cur, wr, wc, fr, fq);
        if (!has_next) break;
        if (!E.keeps(cur)) {
#pragma unroll
        for (int a = 0; a < 2; ++a)
#pragma unroll
            for (int b = 0; b < 2; ++b)
#pragma unroll
                for (int m = 0; m < 4; ++m)
#pragma unroll
                    for (int n = 0; n < 2; ++n) acc[a][b][m][n] = (f32x4){0.f, 0.f, 0.f, 0.f};
        }
        cur = nxt; cA = nA; cB = nB; ++ui;
        if (wr == 1) PG8_BAR;
    }
    PG8_WAIT_V(0);
    PG8_BAR;
#undef PG8_SA
#undef PG8_SB
#undef PG8_STAGE
#undef PG8_LDA
#undef PG8_LDB
#undef PG8_MMA
#undef PG8_WAIT_V
#undef PG8_WAIT_L
#undef PG8_BAR
#undef PG8_SCHED
}
}

DI void transpose_item(const float* W, int K, int N, bf16_t* WT, int ldd, int row_off, int col_off, LAS float* scr, int item, int lane) {
    const int nblk = N / 32, kb = item / nblk, nb = item % nblk, k0 = 64 * kb, n0 = 32 * nb;
#pragma unroll 8
    for (int i = 0; i < 32; ++i) { const int kk = 2 * i + (lane >> 5); scr[kk * 33 + (lane & 31)] = W[(size_t)(k0 + kk) * N + n0 + (lane & 31)]; }
    asm volatile("s_waitcnt lgkmcnt(0)" ::: "memory");
    const int c = lane & 7;
#pragma unroll
    for (int j = 0; j < 4; ++j) { const int n = (lane >> 3) + 8 * j; const LAS float* s = scr + (8 * c) * 33 + n;
        u32x4 o; o.x = pk2(s[0 * 33], s[1 * 33]); o.y = pk2(s[2 * 33], s[3 * 33]); o.z = pk2(s[4 * 33], s[5 * 33]); o.w = pk2(s[6 * 33], s[7 * 33]);
        *(u32x4*)(WT + (size_t)(row_off + n0 + n) * ldd + col_off + k0 + 8 * c) = o; }
    asm volatile("s_waitcnt lgkmcnt(0)" ::: "memory");
}

DI void convert_tables(const Params& p, const Frame& F) {
    for (int it0 = 4 * F.gw; it0 < 4 * NEXP; it0 += 4 * F.ngw) {
        f32x4 v[4][4];
#pragma unroll
        for (int u = 0; u < 4; ++u) {
            const int it = it0 + u, e = it & (NEXP - 1), tbl = (it >> 14) & 1, l = it >> 15;
            const f32x4* src = (const f32x4*)((tbl ? p.in[I_peer_v] : p.in[I_peer_u]) + ((size_t)l * NEXP + e) * D) + 4 * F.lane;
#pragma unroll
            for (int j = 0; j < 4; ++j) v[u][j] = src[j];
        }
#pragma unroll
        for (int u = 0; u < 4; ++u) {
            const int it = it0 + u, e = it & (NEXP - 1), tbl = (it >> 14) & 1, l = it >> 15;
            float am = 0.f;
#pragma unroll
            for (int j = 0; j < 4; ++j) am = fmaxf(am, fmaxf(fmaxf(fabsf(v[u][j].x), fabsf(v[u][j].y)), fmaxf(fabsf(v[u][j].z), fabsf(v[u][j].w))));
#pragma unroll
            for (int o = 1; o < 64; o <<= 1) am = fmaxf(am, __shfl_xor(am, o));
            const float sc = (am > 0.f) ? exp2f(floorf(log2f(224.0f / am))) : 1.0f;
            u32x4 q;
#pragma unroll
            for (int j = 0; j < 4; ++j) { int w = 0; w = __builtin_amdgcn_cvt_pk_fp8_f32(v[u][j].x * sc, v[u][j].y * sc, w, false); w = __builtin_amdgcn_cvt_pk_fp8_f32(v[u][j].z * sc, v[u][j].w * sc, w, true); q[j] = (unsigned)w; }
            *(u32x4*)(p.ws + (tbl ? WS_VTAB : WS_UTAB) + ((size_t)l * NEXP + e) * D + 16 * F.lane) = q;
            if (F.lane == 0) ((float*)(p.ws + WS_TSCALE))[(l * 2 + tbl) * NEXP + e] = 1.0f / sc;
        }
    }
}

DI void phase_prep(const Params& p, const Frame& F) {
    unsigned char* ws = p.ws;
    {
        LAS float* wq = (LAS float*)F.lds;
        LAS float* skl = wq + 128 * 65;
        for (int it = F.bid; it < 2 * 16 * 16; it += F.nb) {
            const int cc = it & 15, hp = (it >> 4) & 15, l = it >> 8;
            const float* src = p.in[I_peer_wq] + (size_t)l * D * 2048 + hp * 128;
            const float* sks = p.in[I_peer_subkeys] + (size_t)(l * 16 + hp) * 128 * 128;
            __syncthreads();
            for (int e = F.tid; e < 64 * 128; e += NTHREADS) { const int ci = e >> 7, d = e & 127; wq[d * 65 + ci] = src[(size_t)(cc * 64 + ci) * 2048 + d]; }
            for (int e = F.tid; e < 128 * 32; e += NTHREADS) { const int key = e >> 5, d4 = (e & 31) * 4; *(LAS f32x4*)(skl + key * 132 + d4) = *(const f32x4*)(sks + key * 128 + d4); }
            __syncthreads();
            const int ci = F.tid & 63, kg = F.tid >> 6;
            float acc[16];
#pragma unroll
            for (int k = 0; k < 16; ++k) acc[k] = 0.f;
#pragma unroll 2
            for (int d = 0; d < 128; d += 4) {
                const float w0 = wq[d * 65 + ci], w1 = wq[(d + 1) * 65 + ci], w2 = wq[(d + 2) * 65 + ci], w3 = wq[(d + 3) * 65 + ci];
#pragma unroll
                for (int k = 0; k < 16; ++k) { const f32x4 s = *(const LAS f32x4*)(skl + (16 * kg + k) * 132 + d); acc[k] += w0 * s.x + w1 * s.y + w2 * s.z + w3 * s.w; }
            }
            bf16_t* dst = (bf16_t*)(ws + WS_WFOLD) + ((size_t)l * 2048 + hp * 128 + 16 * kg) * D + cc * 64 + ci;
#pragma unroll
            for (int k = 0; k < 16; ++k) dst[(size_t)k * D] = (bf16_t)f2bf(acc[k]);
        }
        __syncthreads();
    }
    {
        LAS float* scr = (LAS float*)(F.lds + F.wave * 16384);
        constexpr int I_IN = (D / 64) * (INW / 32), I_BA = (512 / 64) * (D / 32), I_BS = (256 / 64) * (D / 32), I_O = (D / 64) * (D / 32);
        constexpr int PER_L = I_IN + I_BA + I_BS + I_O;
        for (int it = F.gw; it < 2 * PER_L; it += F.ngw) {
            const int l = it / PER_L; int r = it % PER_L;
            if (r < I_IN) { transpose_item(p.in[I_w_in] + (size_t)l * D * INW, D, INW, (bf16_t*)(ws + WS_WIN) + (size_t)l * INW * D, D, 0, 0, scr, r, F.lane); continue; } r -= I_IN;
            if (r < I_BA) { transpose_item(p.in[I_w_br_attn] + (size_t)l * 512 * D, 512, D, (bf16_t*)(ws + WS_WBR) + (size_t)l * D * D, D, 0, 0, scr, r, F.lane); continue; } r -= I_BA;
            if (r < I_BS) { transpose_item(p.in[I_w_br_sgu] + (size_t)l * 256 * D, 256, D, (bf16_t*)(ws + WS_WBR) + (size_t)l * D * D, D, 0, 768, scr, r, F.lane); continue; } r -= I_BS;
            transpose_item(p.in[I_w_out] + (size_t)l * D * D, D, D, (bf16_t*)(ws + WS_WOUT) + (size_t)l * D * D, D, 0, 0, scr, r, F.lane);
        }
    }
    for (int i = F.gtid; i < 2 * 256 * D; i += F.ngt) {
        const int n = i & 1023, rc = (i >> 10) & 255, l = i >> 18, g = rc >> 6;
        const float* pw = p.in[I_pool_w] + ((size_t)l * 256 + rc) * 64;
        const float* ps = p.in[I_pool_scale] + l * 256 + 64 * g;
        const float* wb = p.in[I_w_br_pool] + ((size_t)l * 256 + 64 * g) * D + n;
        float a = 0.f;
#pragma unroll 16
        for (int e = 0; e < 64; ++e) a += pw[e] * ps[e] * wb[(size_t)e * D];
        ((bf16_t*)(ws + WS_WBR))[(size_t)l * D * D + (size_t)n * D + 512 + rc] = (bf16_t)f2bf(a);
    }
    for (int i = F.gtid; i < 2 * 4 * 128 * 128; i += F.ngt) ((bf16_t*)(ws + WS_SGUW))[i] = (bf16_t)f2bf(p.in[I_sgu_w][i]);
    for (int i = F.gtid; i < 64 * 16; i += F.ngt) {
        const int pos = i >> 4, fi = i & 15;
        const float inv = powf(10000.0f, -(float)fi / 16.0f);
        const float ang = (float)pos * inv;
        ((f32x2*)(ws + WS_ROPE))[i] = (f32x2){cosf(ang), sinf(ang)};
    }
    convert_tables(p, F);
    {
        float* MOD = (float*)(ws + WS_MOD);
        LAS float* scd = (LAS float*)F.lds;
        LAS float* red = scd + 9 * D;
        __syncthreads();
        for (int e = F.tid; e < 9 * D; e += NTHREADS) { const int r = e >> 10, k = e & 1023; scd[e] = silu_((r < 8) ? p.in[I_c][r * D + k] : p.in[I_c_ctx][k]); }
        __syncthreads();
        for (int it = F.bid; it < 2 * 96; it += F.nb) {
            const int cgp = it % 96, l = it / 96, col = cgp * 64 + F.lane;
            float acc[9];
#pragma unroll
            for (int r = 0; r < 9; ++r) acc[r] = 0.f;
            const float* wp = p.in[I_w_mod] + ((size_t)l * D + F.wave * 128) * NMOD + col;
#pragma unroll 16
            for (int k = 0; k < 128; ++k) {
                const float w = wp[(size_t)k * NMOD];
#pragma unroll
                for (int r = 0; r < 9; ++r) acc[r] += scd[r * D + F.wave * 128 + k] * w;
            }
#pragma unroll
            for (int r = 0; r < 9; ++r) red[(F.wave * 9 + r) * 64 + F.lane] = acc[r];
            __syncthreads();
            for (int e = F.tid; e < 9 * 64; e += NTHREADS) {
                const int r = e >> 6, ln = e & 63; float s = p.in[I_b_mod][l * NMOD + cgp * 64 + ln];
#pragma unroll
                for (int w = 0; w < 8; ++w) s += red[(w * 9 + r) * 64 + ln];
                MOD[((size_t)l * 9 + r) * NMOD + cgp * 64 + ln] = s;
            }
            __syncthreads();
        }
    }
}

DI const float* mod_vec(const Params& p, int l, int row, int j) {
    const int r = row < TL ? row / SEQ : 8;
    return (const float*)(p.ws + WS_MOD) + ((size_t)l * 9 + r) * NMOD + j * D;
}
DI float* xrow_ptr(const Params& p, int row) { return row < TL ? p.out + (size_t)row * D : (float*)(p.ws + WS_XCTX) + (size_t)(row - TL) * D; }
DI const float* xin_ptr(const Params& p, int row) { return row < TL ? p.in[I_x] + (size_t)row * D : p.in[I_ctx] + (size_t)(row - TL) * D; }

DI void modulate_row_wave(const float* src, const float* g, const float* sh, const float* sc, bf16_t* dst, int lane, unsigned char* h8 = nullptr, float* hs = nullptr) {
    f32x4 v[4]; float ss = 0.f;
#pragma unroll
    for (int j = 0; j < 4; ++j) { v[j] = ((const f32x4*)src)[lane + 64 * j]; ss += v[j].x * v[j].x + v[j].y * v[j].y + v[j].z * v[j].z + v[j].w * v[j].w; }
    const float rinv = rsqrtf(wave_sum(ss) * (1.0f / D) + EPS);
    float am = 0.f;
#pragma unroll
    for (int j = 0; j < 4; ++j) {
        const f32x4 gg = ((const f32x4*)g)[lane + 64 * j], s1 = ((const f32x4*)sh)[lane + 64 * j], s2 = ((const f32x4*)sc)[lane + 64 * j];
        const f32x4 o = v[j] * rinv * gg * (s2 + 1.0f) + s1;
        u32x2 w; w.x = pk2(o.x, o.y); w.y = pk2(o.z, o.w);
        ((u32x2*)dst)[lane + 64 * j] = w;
        v[j] = o; am = fmaxf(am, fmaxf(fmaxf(fabsf(o.x), fabsf(o.y)), fmaxf(fabsf(o.z), fabsf(o.w))));
    }
    if (h8) {
#pragma unroll
        for (int o = 1; o < 64; o <<= 1) am = fmaxf(am, __shfl_xor(am, o));
        const float scl = (am > 0.f) ? exp2f(floorf(log2f(224.0f / am))) : 1.0f;
#pragma unroll
        for (int j = 0; j < 4; ++j) { int w = 0; w = __builtin_amdgcn_cvt_pk_fp8_f32(v[j].x * scl, v[j].y * scl, w, false); w = __builtin_amdgcn_cvt_pk_fp8_f32(v[j].z * scl, v[j].w * scl, w, true);
            ((unsigned*)h8)[lane + 64 * j] = (unsigned)w; }
        if (lane == 0) *hs = 1.0f / scl;
    }
}

DI void phase_norm(const Params& p, const Frame& F, int l, int which  , bool from_input, int nrows) {
    const float* g = (which == 0 ? p.in[I_g_mix] : p.in[I_g_ffn]) + l * D;
    for (int row = F.gw; row < nrows; row += F.ngw) {
        const float* src = from_input ? xin_ptr(p, row) : xrow_ptr(p, row);
        modulate_row_wave(src, g, mod_vec(p, l, row, which * 3 + 0), mod_vec(p, l, row, which * 3 + 1), (bf16_t*)(p.ws + WS_H) + (size_t)row * D, F.lane,
                          nullptr, nullptr);
    }
}
DI void phase_final(const Params& p, const Frame& F) {
    for (int row = F.gw; row < TL; row += F.ngw) {
        f32x4* xr = (f32x4*)(p.out + (size_t)row * D);
        f32x4 v[4]; float ss = 0.f;
#pragma unroll
        for (int j = 0; j < 4; ++j) { v[j] = xr[F.lane + 64 * j]; ss += v[j].x * v[j].x + v[j].y * v[j].y + v[j].z * v[j].z + v[j].w * v[j].w; }
        const float rinv = rsqrtf(wave_sum(ss) * (1.0f / D) + EPS);
#pragma unroll
        for (int j = 0; j < 4; ++j) xr[F.lane + 64 * j] = v[j] * rinv * ((const f32x4*)p.in[I_g_final])[F.lane + 64 * j];
    }
}

DI void g1_epilogue(const Params& p, int l, const f32x16& acc, int row0, int col0, int lane) {
    const int h = lane >> 5, w = lane & 31, col = col0 + w;
    bf16_t* P = (bf16_t*)(p.ws + WS_P);
    if (col0 < VOFF) {
        const float sc = (col0 < KOFF) ? QSCALE : 1.0f;
        const int axis = (col0 >> 5) & 1, fi = w & 15;
        const f32x2* tab = (const f32x2*)(p.ws + WS_ROPE);
#pragma unroll
        for (int r = 0; r < 16; ++r) {
            const int row = row0 + crow(r, h);
            const float own = acc[r], oth = __shfl_xor(own, 16);
            float o = own;
            if (row < TL) {
                const int t = row & (SEQ - 1), pos = axis ? (t & 63) : (t >> 6);
                const f32x2 cs = tab[pos * 16 + fi];
                o = (w < 16) ? (own * cs.x - oth * cs.y) : (own * cs.x + oth * cs.y);
            }
            P[(size_t)row * PW + col] = (bf16_t)f2bf(o * sc);
        }
    } else if (col0 < POOLOFF) {
        const int hk = (col - VOFF) >> 6, d = (col - VOFF) & 63;
#pragma unroll
        for (int r = 0; r < 16; ++r) {
            const int row = row0 + crow(r, h);
            const bf16_t v = (bf16_t)f2bf(acc[r]);
            if (row < TL) { const int b = row / SEQ, t = row & (SEQ - 1); ((bf16_t*)(p.ws + WS_VT))[((size_t)(b * 2 + hk) * 64 + d) * VTS + t] = v; }
            else { const int rc = row - TL, b = rc / NCTX, j = rc & (NCTX - 1); ((bf16_t*)(p.ws + WS_VTC))[((size_t)(b * 2 + hk) * 64 + d) * NCTX + j] = v; }
        }
    } else if (col0 < SUOFF) {
#pragma unroll
        for (int r = 0; r < 16; ++r) { const int row = row0 + crow(r, h); P[(size_t)row * PW + col] = (bf16_t)f2bf(acc[r]); }
    } else if (col0 < SVOFF) {
#pragma unroll
        for (int r = 0; r < 16; ++r) { const int row = row0 + crow(r, h); P[(size_t)row * PW + col] = (bf16_t)f2bf(gelu_tanh(acc[r])); }
    } else {
        const int c = col - SVOFF;
#pragma unroll
        for (int r = 0; r < 16; ++r) { const int row = row0 + crow(r, h); const int chunk = row >> 7, q = row & 127;
            ((bf16_t*)(p.ws + WS_VST))[((size_t)chunk * 256 + c) * 128 + q] = (bf16_t)f2bf(gelu_tanh(acc[r])); }
    }
}

DI void g1_simple(const Params& p, const Frame& F, int l, int row_lo, int nrows, int ct_lo, int nct) {
    const bf16_t* H = (const bf16_t*)(p.ws + WS_H);
    const bf16_t* W = (const bf16_t*)(p.ws + WS_WIN) + (size_t)l * INW * D;
    const int nit = (nrows / 64) * nct;
    for (int it = F.gw; it < nit; it += F.ngw) {
        const int mt = it / nct, nt = ct_lo + it % nct, m0 = row_lo + mt * 64;
        f32x16 acc[2][1]; zero_acc(acc);
        wave_gemm<2, 1>(H, D, W, D, D, m0, nt * 32, acc, F.lane);
#pragma unroll 1
        for (int i = 0; i < 2; ++i) g1_epilogue(p, l, i == 0 ? acc[0][0] : acc[1][0], m0 + 32 * i, nt * 32, F.lane);
    }
}

DI float lane_xor32(float v, bool hi) { const auto r = __builtin_amdgcn_permlane32_swap(__builtin_bit_cast(unsigned, v), __builtin_bit_cast(unsigned, v), false, false);
    return __builtin_bit_cast(float, hi ? r[0] : r[1]); }
struct EpiG1 {
    DI bool keeps(const pg8::Unit&) const { return false; }
    static constexpr bool PERM = true;
    unsigned char* ws;
    DI void operator()(const f32x4 (&acc)[2][2][4][2], const pg8::Unit& u, int wr, int wc, int fr, int fq) const {
        bf16_t* P = (bf16_t*)(ws + WS_P);
        const int rbase = u.pm * 256 + wr * 64 + fr;
        const bool hi = fq >= 2;
#pragma unroll
        for (int ai = 0; ai < 2; ++ai) {
            f32x4 cs[4][4];
            const bool lat = u.pm < TL / 256;
            if (u.pn < 3 && lat) {
#pragma unroll
                for (int m = 0; m < 4; ++m) {
                    const int t = (rbase + 128 * ai + 16 * m) & (SEQ - 1), pos = (wc & 1) ? (t & 63) : (t >> 6);
                    const f32x4* tab = (const f32x4*)(ws + WS_ROPE) + (pos * 16 + 8 * (fq & 1)) / 2;
#pragma unroll
                    for (int j2 = 0; j2 < 4; ++j2) cs[m][j2] = tab[j2];
                }
            }
#pragma unroll
            for (int m = 0; m < 4; ++m) {
                const int row = rbase + 128 * ai + 16 * m;
#pragma unroll
                for (int bj = 0; bj < 2; ++bj) {
                    const int c0 = u.pn * 256 + 128 * bj + 32 * wc + 8 * fq;
                    float v[8];
#pragma unroll
                    for (int j = 0; j < 4; ++j) { v[j] = acc[ai][bj][m][0][j]; v[4 + j] = acc[ai][bj][m][1][j]; }
                    if (c0 < VOFF) {
                        const float sc = (c0 < KOFF) ? QSCALE : 1.0f;
                        u32x4 o;
#pragma unroll
                        for (int j2 = 0; j2 < 4; ++j2) {
                            const f32x4 c4 = cs[m][j2];
                            const float o0 = lane_xor32(v[2 * j2], hi), o1 = lane_xor32(v[2 * j2 + 1], hi);
                            float r0 = hi ? (v[2 * j2] * c4.x + o0 * c4.y) : (v[2 * j2] * c4.x - o0 * c4.y);
                            float r1 = hi ? (v[2 * j2 + 1] * c4.z + o1 * c4.w) : (v[2 * j2 + 1] * c4.z - o1 * c4.w);
                            if (!lat) { r0 = v[2 * j2]; r1 = v[2 * j2 + 1]; }
                            o[j2] = pk2(r0 * sc, r1 * sc);
                        }
                        *(u32x4*)(P + (size_t)row * PW + c0) = o;
                    } else if (c0 < POOLOFF) {
                        const int hk = wc >> 1, d0 = 32 * (wc & 1) + 8 * fq;
                        if (lat) { const int b = row / SEQ, t = row & (SEQ - 1);
                            bf16_t* vt = (bf16_t*)(ws + WS_VT) + ((size_t)(b * 2 + hk) * 64 + d0) * VTS + t;
#pragma unroll
                            for (int j = 0; j < 8; ++j) vt[(size_t)j * VTS] = (bf16_t)f2bf(v[j]);
                        } else { const int rc = row - TL, b = rc / NCTX, jc = rc & (NCTX - 1);
                            bf16_t* vt = (bf16_t*)(ws + WS_VTC) + ((size_t)(b * 2 + hk) * 64 + d0) * NCTX + jc;
#pragma unroll
                            for (int j = 0; j < 8; ++j) vt[(size_t)j * NCTX] = (bf16_t)f2bf(v[j]);
                        }
                    } else if (c0 < SUOFF) {
                        u32x4 o;
#pragma unroll
                        for (int j2 = 0; j2 < 4; ++j2) o[j2] = pk2(v[2 * j2], v[2 * j2 + 1]);
                        *(u32x4*)(P + (size_t)row * PW + c0) = o;
                    } else if (c0 < SVOFF) {
                        u32x4 o;
#pragma unroll
                        for (int j2 = 0; j2 < 4; ++j2) o[j2] = pk2(gelu_tanh(v[2 * j2]), gelu_tanh(v[2 * j2 + 1]));
                        *(u32x4*)(P + (size_t)row * PW + c0) = o;
                    } else {
                        const int c = c0 - SVOFF, chunk = row >> 7, q = row & 127;
                        bf16_t* vs = (bf16_t*)(ws + WS_VST) + ((size_t)chunk * 256 + c) * 128 + q;
#pragma unroll
                        for (int j = 0; j < 8; ++j) vs[j * 128] = (bf16_t)f2bf(gelu_tanh(v[j]));
                    }
                }
            }
            asm volatile("" ::: "memory");
        }
    }
};
struct SchedGrid {
    int nM, nN, G, c; const char* A; const char* B;
    int n_extra, ex_pm0, ex_pn;
    DI bool next(int i, pg8::Unit& u) const {
        const int L = i * G + c, n = nM * nN; if (L >= n + n_extra) return false;
        if (L < n) pg8::tile_of(L, nM, nN, u.pm, u.pn); else { u.pm = ex_pm0 + (L - n); u.pn = ex_pn; }
        u.sub = 0; u.nt = D / 64; u.mode = 0;
        u.a = A + (size_t)u.pm * 256 * D * 2; u.b = B + (size_t)u.pn * 256 * D * 2; return true;
    }
};

DI void phase_g1(const Params& p, const Frame& F, int l) {
    SchedGrid S{(l == 0 ? T : TL) / 256, PN / 256, F.nb, F.bid, (const char*)(p.ws + WS_H), (const char*)(p.ws + WS_WIN) + (size_t)l * INW * D * 2,
                (l == 0) ? 0 : TC / 256, TL / 256, 2};
    EpiG1 E{p.ws};
    pg8::gemm_phase(F.lds, F.tid, S, E);
}

DI bf16x8 pack8(const f32x16& x, int s) {
    u32x4 pk;
#pragma unroll
    for (int j = 0; j < 4; ++j) { f32x2 v = {x[8 * s + 2 * j], x[8 * s + 2 * j + 1]}; pk[j] = __builtin_bit_cast(unsigned, __builtin_convertvector(v, bf16x2_t)); }
    return __builtin_bit_cast(bf16x8, pk);
}

DI float lane_x32(float v, bool hi) { const auto r = __builtin_amdgcn_permlane32_swap(__builtin_bit_cast(unsigned, v), __builtin_bit_cast(unsigned, v), false, false);
    return __builtin_bit_cast(float, hi ? r[0] : r[1]); }
struct AttnFrags { bf16x8 kf[4]; s16x4 vf[2][4]; };
DI void attn_load(AttnFrags& f, const bf16_t* kptr, const bf16_t* vptr, size_t vstride_d32) {
#pragma unroll
    for (int s = 0; s < 4; ++s) f.kf[s] = *(const bf16x8*)(kptr + 16 * s);
#pragma unroll
    for (int d = 0; d < 2; ++d)
#pragma unroll
        for (int q = 0; q < 4; ++q) f.vf[d][q] = *(const s16x4*)(vptr + (size_t)d * vstride_d32 + 8 * q);
}
DI void attn_block(const bf16x8 (&qf)[4], const AttnFrags& f, int mask_mode, int kq_off, int lane, float& m, float& lpart, f32x16 (&o)[2]) {
    const int h = lane >> 5;
    f32x16 st;
#pragma unroll
    for (int r = 0; r < 16; ++r) st[r] = 0.f;
#pragma unroll
    for (int s = 0; s < 4; ++s) st = MFMA32(f.kf[s], qf[s], st);
    if (mask_mode) {
#pragma unroll
        for (int r = 0; r < 16; ++r) { const int dlt = kq_off + crow(r, h); if (dlt > 128 || dlt < -128) st[r] = -1e30f; }
    }
    float bm = st[0];
#pragma unroll
    for (int r = 1; r < 16; ++r) bm = fmaxf(bm, st[r]);
    bm = fmaxf(bm, lane_x32(bm, h != 0));
    const float mn = fmaxf(m, bm);
    if (__builtin_amdgcn_ballot_w64(mn > m) != 0ull) {
        const float alpha = __builtin_amdgcn_exp2f(m - mn);
        lpart *= alpha;
#pragma unroll
        for (int d = 0; d < 2; ++d)
#pragma unroll
            for (int r = 0; r < 16; ++r) o[d][r] *= alpha;
        m = mn;
    }
    float ps = 0.f;
#pragma unroll
    for (int r = 0; r < 16; ++r) { st[r] = __builtin_amdgcn_exp2f(st[r] - m); ps += st[r]; }
    lpart += ps;
    const bf16x8 pf0 = pack8(st, 0), pf1 = pack8(st, 1);
#pragma unroll
    for (int d = 0; d < 2; ++d) {
        const bf16x8 v0 = __builtin_shufflevector(f.vf[d][0], f.vf[d][1], 0, 1, 2, 3, 4, 5, 6, 7), v1 = __builtin_shufflevector(f.vf[d][2], f.vf[d][3], 0, 1, 2, 3, 4, 5, 6, 7);
        o[d] = MFMA32(v0, pf0, o[d]);
        o[d] = MFMA32(v1, pf1, o[d]);
    }
}

DI void attn_task(const Params& p, int l, int task, int lane) {
    const int r = lane & 31, h = lane >> 5;
    const bf16_t* P = (const bf16_t*)(p.ws + WS_P);
    const bf16_t* VT = (const bf16_t*)(p.ws + WS_VT);
    const bf16_t* VTC = (const bf16_t*)(p.ws + WS_VTC);
    bf16_t* Y = (bf16_t*)(p.ws + WS_Y);
    const bool latent = task < 8192;
    int b, head, qb, q0row, p0;
    if (latent) { qb = task & 127; head = (task >> 7) & 7; b = task >> 10; p0 = qb * 32; q0row = b * SEQ + p0; }
    else { const int t2 = task - 8192; qb = t2 & 7; head = (t2 >> 3) & 7; b = t2 >> 6; p0 = qb * 32; q0row = TL + b * NCTX + p0; }
    const int hk = head >> 2;
    bf16x8 qf[4];
#pragma unroll
    for (int s = 0; s < 4; ++s) qf[s] = *(const bf16x8*)(P + (size_t)(q0row + r) * PW + head * 64 + 16 * s + 8 * h);
    float m = p.in[I_attn_sink][l * 8 + head] * LOG2E, lpart = (h == 0) ? 1.0f : 0.0f;
    f32x16 o[2];
#pragma unroll
    for (int d = 0; d < 2; ++d)
#pragma unroll
        for (int i = 0; i < 16; ++i) o[d][i] = 0.f;
    const int kb_lo = max(p0 - 128, 0), kb_hi = min(p0 + 128, SEQ - 32);
    const int nwin = latent ? ((kb_hi - kb_lo) >> 5) + 1 : 0, nblk = nwin + 8;
    const bf16_t* kwin = P + (size_t)(b * SEQ + r) * PW + KOFF + hk * 64 + 8 * h;
    const bf16_t* vwin = VT + ((size_t)(b * 2 + hk) * 64 + r) * VTS + 4 * h;
    const bf16_t* kctx = P + (size_t)(TL + b * NCTX + r) * PW + KOFF + hk * 64 + 8 * h;
    const bf16_t* vctx = VTC + ((size_t)(b * 2 + hk) * 64 + r) * NCTX + 4 * h;
    AttnFrags f0, f1, f2;
#define ATT_LOAD(F_, jj) do { const int j_ = min((jj), nblk - 1); \
        if (j_ < nwin) { const int kb_ = kb_lo + 32 * j_; attn_load(F_, kwin + (size_t)kb_ * PW, vwin + kb_, (size_t)32 * VTS); } \
        else { const int kb_ = 32 * (j_ - nwin); attn_load(F_, kctx + (size_t)kb_ * PW, vctx + kb_, (size_t)32 * NCTX); } } while (0)
#define ATT_COMP(F_, jj) do { const int j_ = (jj); if (j_ < nblk) { int mm_ = 0, kq_ = 0; \
        if (j_ < nwin) { const int kb_ = kb_lo + 32 * j_; mm_ = (kb_ == p0 - 128 || kb_ == p0 + 128) ? 1 : 0; kq_ = kb_ - (p0 + r); } \
        attn_block(qf, F_, mm_, kq_, lane, m, lpart, o); } } while (0)
    ATT_LOAD(f0, 0); ATT_LOAD(f1, 1);
#pragma unroll 1
    for (int j = 0; j < nblk; j += 3) {
        ATT_LOAD(f2, j + 2); ATT_COMP(f0, j);
        ATT_LOAD(f0, j + 3); ATT_COMP(f1, j + 1);
        ATT_LOAD(f1, j + 4); ATT_COMP(f2, j + 2);
    }
#undef ATT_LOAD
#undef ATT_COMP
    const float inv = 1.0f / (lpart + lane_x32(lpart, h != 0));
    bf16_t* yrow = Y + (size_t)(q0row + r) * D + head * 64;
#pragma unroll
    for (int d = 0; d < 2; ++d)
#pragma unroll
        for (int g = 0; g < 4; ++g) {
            u32x2 w; w.x = pk2(o[d][4 * g] * inv, o[d][4 * g + 1] * inv); w.y = pk2(o[d][4 * g + 2] * inv, o[d][4 * g + 3] * inv);
            *(u32x2*)(yrow + 32 * d + 8 * g + 4 * h) = w;
        }
}

constexpr int AKP = 144, AVWP = 648, AVCP = 520;
constexpr int ALDS_KW = 0, ALDS_VW = ALDS_KW + 320 * AKP, ALDS_KC = ALDS_VW + 64 * AVWP, ALDS_VC = ALDS_KC + 256 * AKP, ALDS_END = ALDS_VC + 64 * AVCP;
static_assert(ALDS_END <= LDS_BAR_OFF && (ALDS_VW % 16) == 0 && (ALDS_KC % 16) == 0 && (ALDS_VC % 8) == 0, "attention LDS map");
DI void attn_lds_frags(AttnFrags& f, const LAS unsigned char* kp, const LAS unsigned char* vp, int vpitch32) {
#pragma unroll
    for (int s = 0; s < 4; ++s) f.kf[s] = *(const LAS bf16x8*)(kp + 32 * s);
#pragma unroll
    for (int d = 0; d < 2; ++d)
#pragma unroll
        for (int q = 0; q < 4; ++q) f.vf[d][q] = *(const LAS s16x4*)(vp + d * vpitch32 + 16 * q);
}
DI void attn_unit(const Params& p, const Frame& F, int l, int unit) {
    const int lane = F.lane, r = lane & 31, h = lane >> 5, tid = F.tid;
    const bf16_t* P = (const bf16_t*)(p.ws + WS_P);
    const bf16_t* VT = (const bf16_t*)(p.ws + WS_VT);
    const bf16_t* VTC = (const bf16_t*)(p.ws + WS_VTC);
    bf16_t* Y = (bf16_t*)(p.ws + WS_Y);
    const bool latent = unit < 1024;
    int b, hk, p0, q0row;
    if (latent) { const int pb = unit & 63; hk = (unit >> 6) & 1; b = unit >> 7; p0 = pb * 64; q0row = b * SEQ + p0; }
    else { const int u2 = unit - 1024, pb = u2 & 3; hk = (u2 >> 2) & 1; b = u2 >> 3; p0 = pb * 64; q0row = TL + b * NCTX + p0; }
    const int w0 = p0 - 128;
    __syncthreads();
    if (latent) {
        for (int i = tid; i < 320 * 8; i += NTHREADS) {
            const int row = i >> 3, ck = i & 7, pos = w0 + row;
            if (pos >= 0 && pos < SEQ) *(LAS u32x4*)(F.lds + ALDS_KW + row * AKP + 16 * ck) = *(const u32x4*)(P + (size_t)(b * SEQ + pos) * PW + KOFF + hk * 64 + 8 * ck);
        }
        for (int i = tid; i < 64 * 40; i += NTHREADS) {
            const int d = i / 40, ck = i % 40, pos = w0 + 8 * ck;
            if (pos >= 0 && pos < SEQ) { const u32x4 v = *(const u32x4*)(VT + ((size_t)(b * 2 + hk) * 64 + d) * VTS + pos);
                LAS u32x2* dst = (LAS u32x2*)(F.lds + ALDS_VW + d * AVWP + 16 * ck); dst[0] = (u32x2){v.x, v.y}; dst[1] = (u32x2){v.z, v.w}; }
        }
    }
    for (int i = tid; i < 256 * 8; i += NTHREADS) {
        const int row = i >> 3, ck = i & 7;
        *(LAS u32x4*)(F.lds + ALDS_KC + row * AKP + 16 * ck) = *(const u32x4*)(P + (size_t)(TL + b * NCTX + row) * PW + KOFF + hk * 64 + 8 * ck);
    }
    for (int i = tid; i < 64 * 32; i += NTHREADS) {
        const int d = i >> 5, ck = i & 31;
        const u32x4 v = *(const u32x4*)(VTC + ((size_t)(b * 2 + hk) * 64 + d) * NCTX + 8 * ck);
        LAS u32x2* dst = (LAS u32x2*)(F.lds + ALDS_VC + d * AVCP + 16 * ck); dst[0] = (u32x2){v.x, v.y}; dst[1] = (u32x2){v.z, v.w};
    }
    const int head = 4 * hk + (F.wave & 3), ph = F.wave >> 2, pw = p0 + 32 * ph, qrow = q0row + 32 * ph;
    bf16x8 qf[4];
#pragma unroll
    for (int s = 0; s < 4; ++s) qf[s] = *(const bf16x8*)(P + (size_t)(qrow + r) * PW + head * 64 + 16 * s + 8 * h);
    float m = p.in[I_attn_sink][l * 8 + head] * LOG2E, lpart = (h == 0) ? 1.0f : 0.0f;
    f32x16 o[2];
#pragma unroll
    for (int d = 0; d < 2; ++d)
#pragma unroll
        for (int i = 0; i < 16; ++i) o[d][i] = 0.f;
    __syncthreads();
    if (latent) {
#pragma unroll 1
        for (int j = 0; j < 9; ++j) {
            const int kb = pw - 128 + 32 * j;
            if (kb < 0 || kb >= SEQ) continue;
            const int krow = kb - w0;
            AttnFrags f;
            attn_lds_frags(f, F.lds + ALDS_KW + (krow + r) * AKP + 16 * h, F.lds + ALDS_VW + r * AVWP + 2 * krow + 8 * h, 32 * AVWP);
            attn_block(qf, f, (j == 0 || j == 8) ? 1 : 0, kb - (pw + r), lane, m, lpart, o);
        }
    }
#pragma unroll 1
    for (int j = 0; j < 8; ++j) {
        AttnFrags f;
        attn_lds_frags(f, F.lds + ALDS_KC + (32 * j + r) * AKP + 16 * h, F.lds + ALDS_VC + r * AVCP + 64 * j + 8 * h, 32 * AVCP);
        attn_block(qf, f, 0, 0, lane, m, lpart, o);
    }
    const float inv = 1.0f / (lpart + lane_x32(lpart, h != 0));
    bf16_t* yrow = Y + (size_t)(qrow + r) * D + head * 64;
#pragma unroll
    for (int d = 0; d < 2; ++d)
#pragma unroll
        for (int g = 0; g < 4; ++g) {
            u32x2 w; w.x = pk2(o[d][4 * g] * inv, o[d][4 * g + 1] * inv); w.y = pk2(o[d][4 * g + 2] * inv, o[d][4 * g + 3] * inv);
            *(u32x2*)(yrow + 32 * d + 8 * g + 4 * h) = w;
        }
}

DI void sgu_unit(const Params& p, const Frame& F, int l, int chunk) {
    constexpr int VS = 136;
    LAS float* part = (LAS float*)F.lds;
    LAS float* rq = part + 512;
    LAS bf16_t* vnT = (LAS bf16_t*)(F.lds + 4096);
    const bf16_t* VsT = (const bf16_t*)(p.ws + WS_VST) + (size_t)chunk * 256 * 128;
    const bf16_t* P = (const bf16_t*)(p.ws + WS_P);
    bf16_t* Y = (bf16_t*)(p.ws + WS_Y);
    __syncthreads();
    { const int q = F.tid & 127, part_i = F.tid >> 7; float ss = 0.f;
        for (int c = part_i * 64; c < part_i * 64 + 64; ++c) { const float v = bf2f(VsT[c * 128 + q]); ss += v * v; }
        part[part_i * 128 + q] = ss; }
    __syncthreads();
    if (F.tid < 128) rq[F.tid] = rsqrtf((part[F.tid] + part[128 + F.tid] + part[256 + F.tid] + part[384 + F.tid]) * (1.0f / 256.0f) + EPS);
    __syncthreads();
    for (int i = F.tid; i < 256 * 16; i += NTHREADS) {
        const int c = i >> 4, q8 = (i & 15) * 8;
        const u32x4 v = *(const u32x4*)(VsT + c * 128 + q8);
        u32x4 o;
#pragma unroll
        for (int j = 0; j < 4; ++j) o[j] = pk2(bflo(v[j]) * rq[q8 + 2 * j], bfhi(v[j]) * rq[q8 + 2 * j + 1]);
        *(LAS u32x4*)(vnT + c * VS + q8) = o;
    }
    __syncthreads();
    const int lane = F.lane, r = lane & 31, h = lane >> 5, g = F.wave >> 1, ph = F.wave & 1;
    const bf16_t* Wg = (const bf16_t*)(p.ws + WS_SGUW) + ((size_t)l * 4 + g) * 128 * 128;
#pragma unroll 1
    for (int pb = 0; pb < 2; ++pb) {
        const int p0 = 64 * ph + 32 * pb;
#pragma unroll 1
        for (int cb = 0; cb < 2; ++cb) {
            const int c0 = 64 * g + 32 * cb;
            f32x16 acc;
#pragma unroll
            for (int i = 0; i < 16; ++i) acc[i] = 0.f;
#pragma unroll
            for (int s = 0; s < 8; ++s) {
                const bf16x8 a = *(const LAS bf16x8*)(vnT + (c0 + r) * VS + 16 * s + 8 * h);
                const bf16x8 b = *(const bf16x8*)(Wg + (size_t)(p0 + r) * 128 + 16 * s + 8 * h);
                acc = MFMA32(a, b, acc);
            }
            const int row = chunk * 128 + p0 + r;
            const float bias = p.in[I_sgu_b][(l * 4 + g) * 128 + p0 + r];
#pragma unroll
            for (int q4 = 0; q4 < 4; ++q4) {
                const int cc = c0 + 8 * q4 + 4 * h;
                const u32x2 u = *(const u32x2*)(P + (size_t)row * PW + SUOFF + cc);
                u32x2 w;
                w.x = pk2(bflo(u.x) * (acc[4 * q4] + bias), bfhi(u.x) * (acc[4 * q4 + 1] + bias));
                w.y = pk2(bflo(u.y) * (acc[4 * q4 + 2] + bias), bfhi(u.y) * (acc[4 * q4 + 3] + bias));
                *(u32x2*)(Y + (size_t)row * D + 768 + cc) = w;
            }
        }
    }
}

DI void phase_mix(const Params& p, const Frame& F, int l, int ctr_slot = 0) {
    (void)ctr_slot;
    const int nrows = (l == 0) ? T : TL;
    const bf16_t* P = (const bf16_t*)(p.ws + WS_P);
    bf16_t* Y = (bf16_t*)(p.ws + WS_Y);
    for (int i = F.gtid; i < nrows * 32; i += F.ngt) {
        const int row = i >> 5, ck = i & 31, g = ck >> 3, half = 1 << g;
        int base, t, len;
        if (row < TL) { base = row & ~(SEQ - 1); t = row & (SEQ - 1); len = SEQ; } else { const int rc = row - TL; base = TL + (rc & ~(NCTX - 1)); t = rc & (NCTX - 1); len = NCTX; }
        const int lo = max(t - half, 0), hi = min(t + half, len);
        float s[8];
#pragma unroll
        for (int j = 0; j < 8; ++j) s[j] = 0.f;
        for (int tt = lo; tt < hi; ++tt) {
            const u32x4 v = *(const u32x4*)(P + (size_t)(base + tt) * PW + POOLOFF + ck * 8);
#pragma unroll
            for (int j = 0; j < 4; ++j) { s[2 * j] += bflo(v[j]); s[2 * j + 1] += bfhi(v[j]); }
        }
        const float inv = 1.0f / (float)(hi - lo);
        const u32x4 z = *(const u32x4*)(P + (size_t)row * PW + POOLOFF + ck * 8);
        u32x4 o;
#pragma unroll
        for (int j = 0; j < 4; ++j) o[j] = pk2(s[2 * j] * inv - bflo(z[j]), s[2 * j + 1] * inv - bfhi(z[j]));
        *(u32x4*)(Y + (size_t)row * D + 512 + ck * 8) = o;
    }
    const int nchunk = (l == 0) ? T / 128 : TL / 128;
    for (int ch = F.bid; ch < nchunk; ch += F.nb) sgu_unit(p, F, l, ch);
    const int nunit = (l == 0) ? 1024 + 64 : 1024;
    for (int u = F.nb - 1 - F.bid; u < nunit; u += F.nb) attn_unit(p, F, l, u);
}

DI void g2_simple(const Params& p, const Frame& F, int l, int row_lo, int nrows) {
    const bf16_t* H = (const bf16_t*)(p.ws + WS_H);
    const bf16_t* Yb = (const bf16_t*)(p.ws + WS_Y);
    const bf16_t* Wg = (const bf16_t*)(p.ws + WS_WIN) + (size_t)l * INW * D + (size_t)GATEOFF * D;
    const bf16_t* Wb = (const bf16_t*)(p.ws + WS_WBR) + (size_t)l * D * D;
    bf16_t* M = (bf16_t*)(p.ws + WS_MERGED);
    const int nit = (nrows / 64) * (D / 32);
    for (int it = F.gw; it < nit; it += F.ngw) {
        const int mt = it / (D / 32), nt = it % (D / 32), m0 = row_lo + mt * 64, n0 = nt * 32;
        f32x16 tot[2][1]; zero_acc(tot);
#pragma unroll 1
        for (int i = 0; i < 3; ++i) {
            const int koff = (i == 0) ? 0 : (i == 1 ? 512 : 768), kk = (i == 0) ? 512 : 256;
            f32x16 g[2][1], pr[2][1]; zero_acc(g); zero_acc(pr);
            wave_gemm<2, 1>(H, D, Wg + (size_t)i * D * D, D, D, m0, n0, g, F.lane);
            wave_gemm<2, 1>(Yb + koff, D, Wb + koff, D, kk, m0, n0, pr, F.lane);
#pragma unroll
            for (int a = 0; a < 2; ++a)
#pragma unroll
                for (int r = 0; r < 16; ++r) tot[a][0][r] += sigmoidf_(g[a][0][r]) * pr[a][0][r];
        }
        const int h = F.lane >> 5, col = n0 + (F.lane & 31);
#pragma unroll
        for (int a = 0; a < 2; ++a)
#pragma unroll
            for (int r = 0; r < 16; ++r) M[(size_t)(m0 + 32 * a + crow(r, h)) * D + col] = (bf16_t)f2bf(tot[a][0][r]);
    }
}
struct SchedG2 {
    int G, c; const char *H, *Y, *Wg, *Wb; int npair;
    DI void fill(pg8::Unit& u, int sub, int br) const {
        u.sub = sub;
        if ((sub & 1) == 0) { u.nt = 16; u.a = H + (size_t)u.pm * 256 * D * 2; u.b = Wg + ((size_t)br * D + u.pn * 256) * D * 2; }
        else { const int koff = (br == 0) ? 0 : (br == 1 ? 512 : 768); u.nt = (br == 0) ? 8 : 4;
               u.a = Y + ((size_t)u.pm * 256 * D + koff) * 2; u.b = Wb + ((size_t)u.pn * 256 * D + koff) * 2; }
    }
    DI bool next(int i, pg8::Unit& u) const {
        constexpr int NLAT = (TL / 256) * 4;
        const int nl = (NLAT - c + G - 1) / G;
        if (i < 6 * nl) { const int tile = (i / 6) * G + c, sub = i % 6; pg8::tile_of(tile, TL / 256, 4, u.pm, u.pn); u.mode = 0; fill(u, sub, sub >> 1); return true; }
        const int e = i - 6 * nl, j = (e >> 1) * G + c;
        if (j >= npair) return false;
        const int ctile = j / 3, br = j % 3;
        u.pm = TL / 256 + (ctile >> 2); u.pn = ctile & 3; u.mode = 1 + br; fill(u, e & 1, br); return true;
    }
};
struct EpiG2 {
    static constexpr bool PERM = true;
    bf16_t* scr; bf16_t* M; bf16_t* MP;
    DI bool keeps(const pg8::Unit& u) const { return (u.sub & 1) == 0; }
    DI void operator()(f32x4 (&acc)[2][2][4][2], const pg8::Unit& u, int wr, int wc, int fr, int fq) const {
        const bool gate = (u.sub & 1) == 0, first = u.sub == 0 && gate;
        bf16_t* Mo = (u.mode == 0) ? M + (size_t)u.pm * 256 * D : MP + ((size_t)(u.mode - 1) * TC + (size_t)(u.pm - TL / 256) * 256) * D;
#pragma unroll
        for (int ai = 0; ai < 2; ++ai) {
            u32x4 ld[4][2];
            if (!first) {
#pragma unroll
                for (int m = 0; m < 4; ++m)
#pragma unroll
                    for (int bj = 0; bj < 2; ++bj) {
                        const int rl = 128 * ai + 64 * wr + 16 * m + fr, cl = 128 * bj + 32 * wc + 8 * fq;
                        ld[m][bj] = gate ? *(const u32x4*)(Mo + (size_t)rl * D + u.pn * 256 + cl) : *(const u32x4*)(scr + rl * 256 + cl);
                    }
            }
#pragma unroll
            for (int m = 0; m < 4; ++m)
#pragma unroll
                for (int bj = 0; bj < 2; ++bj) {
                    const int rl = 128 * ai + 64 * wr + 16 * m + fr, cl = 128 * bj + 32 * wc + 8 * fq;
                    if (gate) {
                        u32x4 o;
#pragma unroll
                        for (int j2 = 0; j2 < 4; ++j2) {
                            const int n = j2 >> 1, e = 2 * (j2 & 1);
                            const unsigned w = pk2(fmaxf(sigmoidf_(acc[ai][bj][m][n][e]), 1e-20f), fmaxf(sigmoidf_(acc[ai][bj][m][n][e + 1]), 1e-20f));
                            o[j2] = w;
                            const float t0 = first ? 0.f : bflo(ld[m][bj][j2]), t1 = first ? 0.f : bfhi(ld[m][bj][j2]);
                            acc[ai][bj][m][n][e] = t0 * __builtin_amdgcn_rcpf(bflo(w)); acc[ai][bj][m][n][e + 1] = t1 * __builtin_amdgcn_rcpf(bfhi(w));
                        }
                        *(u32x4*)(scr + rl * 256 + cl) = o;
                    } else {
                        u32x4 w;
#pragma unroll
                        for (int j2 = 0; j2 < 4; ++j2) { const int n = j2 >> 1, e = 2 * (j2 & 1);
                            w[j2] = pk2(acc[ai][bj][m][n][e] * bflo(ld[m][bj][j2]), acc[ai][bj][m][n][e + 1] * bfhi(ld[m][bj][j2])); }
                        *(u32x4*)(Mo + (size_t)rl * D + u.pn * 256 + cl) = w;
                    }
                }
            asm volatile("" ::: "memory");
        }
    }
};
DI void phase_g2(const Params& p, const Frame& F, int l) {
    SchedG2 S{F.nb, F.bid, (const char*)(p.ws + WS_H), (const char*)(p.ws + WS_Y),
              (const char*)(p.ws + WS_WIN) + ((size_t)l * INW + GATEOFF) * D * 2, (const char*)(p.ws + WS_WBR) + (size_t)l * D * D * 2, (l == 0) ? (TC / 256) * 4 * 3 : 0};
    EpiG2 E{(bf16_t*)(p.ws + WS_IDX) + (size_t)F.bid * 65536, (bf16_t*)(p.ws + WS_MERGED), (bf16_t*)(p.ws + WS_MP)};
    pg8::gemm_phase(F.lds, F.tid, S, E);
}
DI void phase_g2sum(const Params& p, const Frame& F) {
    const u32x4* mp = (const u32x4*)(p.ws + WS_MP);
    u32x4* mo = (u32x4*)((bf16_t*)(p.ws + WS_MERGED) + (size_t)TL * D);
    constexpr int NV = TC * D / 8;
    for (int i = F.gtid; i < NV; i += F.ngt) {
        const u32x4 a = mp[i], b = mp[NV + i], c = mp[2 * NV + i];
        u32x4 o;
#pragma unroll
        for (int j = 0; j < 4; ++j) o[j] = pk2(bflo(a[j]) + bflo(b[j]) + bflo(c[j]), bfhi(a[j]) + bfhi(b[j]) + bfhi(c[j]));
        mo[i] = o;
    }
}

DI void g3_simple(const Params& p, const Frame& F, int l, int row_lo, int nrows) {
    const bf16_t* M = (const bf16_t*)(p.ws + WS_MERGED);
    const bf16_t* W = (const bf16_t*)(p.ws + WS_WOUT) + (size_t)l * D * D;
    const int nit = (nrows / 64) * (D / 64);
    for (int it = F.gw; it < nit; it += F.ngw) {
        const int mt = it / (D / 64), nt = it % (D / 64), m0 = row_lo + mt * 64, n0 = nt * 64;
        f32x16 acc[2][2]; zero_acc(acc);
        wave_gemm<2, 2>(M, D, W, D, D, m0, n0, acc, F.lane);
        const int h = F.lane >> 5;
#pragma unroll
        for (int a = 0; a < 2; ++a)
#pragma unroll
            for (int j = 0; j < 2; ++j) {
                const int col = n0 + 32 * j + (F.lane & 31);
#pragma unroll
                for (int r = 0; r < 16; ++r) {
                    const int row = m0 + 32 * a + crow(r, h);
                    const float xs = (l == 0) ? xin_ptr(p, row)[col] : xrow_ptr(p, row)[col];
                    xrow_ptr(p, row)[col] = xs + mod_vec(p, l, row, 2)[col] * acc[a][j][r];
                }
            }
    }
}
struct EpiG3 {
    DI bool keeps(const pg8::Unit&) const { return false; }
    static constexpr bool PERM = false;
    const float* xsrc; float* xdst; const float* csrc; float* cdst; const float* mod;
    DI void operator()(const f32x4 (&acc)[2][2][4][2], const pg8::Unit& u, int wr, int wc, int fr, int fq) const {
        const int col0 = u.pn * 256 + wc * 32 + 4 * fq;
        const bool lat = u.pm < TL / 256;
        const float* gt = mod + (size_t)(lat ? (u.pm >> 4) : 8) * NMOD + 2 * D;
        const float* xs = lat ? xsrc + (size_t)u.pm * 256 * D : csrc + (size_t)(u.pm - TL / 256) * 256 * D;
        float* xd = lat ? xdst + (size_t)u.pm * 256 * D : cdst + (size_t)(u.pm - TL / 256) * 256 * D;
        f32x4 gv[2][2];
#pragma unroll
        for (int bj = 0; bj < 2; ++bj)
#pragma unroll
            for (int n = 0; n < 2; ++n) gv[bj][n] = *(const f32x4*)(gt + col0 + 128 * bj + 16 * n);
#pragma unroll
        for (int ai = 0; ai < 2; ++ai) {
            f32x4 xv[4][2][2];
#pragma unroll
            for (int m = 0; m < 4; ++m)
#pragma unroll
                for (int bj = 0; bj < 2; ++bj)
#pragma unroll
                    for (int n = 0; n < 2; ++n) xv[m][bj][n] = *(const f32x4*)(xs + (size_t)(wr * 64 + fr + 128 * ai + 16 * m) * D + col0 + 128 * bj + 16 * n);
#pragma unroll
            for (int m = 0; m < 4; ++m)
#pragma unroll
                for (int bj = 0; bj < 2; ++bj)
#pragma unroll
                    for (int n = 0; n < 2; ++n)
                        *(f32x4*)(xd + (size_t)(wr * 64 + fr + 128 * ai + 16 * m) * D + col0 + 128 * bj + 16 * n) = xv[m][bj][n] + gv[bj][n] * acc[ai][bj][m][n];
            asm volatile("" ::: "memory");
        }
    }
};
DI void phase_g3(const Params& p, const Frame& F, int l) {
    SchedGrid S{(l == 0 ? T : TL) / 256, D / 256, F.nb, F.bid, (const char*)(p.ws + WS_MERGED), (const char*)(p.ws + WS_WOUT) + (size_t)l * D * D * 2, 0, 0, 0};
    float* xc = (float*)(p.ws + WS_XCTX);
    EpiG3 E{(l == 0) ? p.in[I_x] : p.out, p.out, (l == 0) ? p.in[I_ctx] : xc, xc, (const float*)(p.ws + WS_MOD) + (size_t)l * 9 * NMOD};
    pg8::gemm_phase(F.lds, F.tid, S, E);
}

DI void g45_simple(const Params& p, const Frame& F, int l, int row_lo, int nrows) {
    const bf16_t* H = (const bf16_t*)(p.ws + WS_H);
    const bf16_t* W = (const bf16_t*)(p.ws + WS_WFOLD) + (size_t)l * 2048 * D;
    _Float16* ST = (_Float16*)(p.ws + WS_ST);
    const int nit = (2048 / 64) * (nrows / 64);
    for (int it = F.gw; it < nit; it += F.ngw) {
        const int nt = it / 32, mt = it % 32, m0 = mt * 64, n0 = row_lo + nt * 64;
        f32x16 acc[2][2]; zero_acc(acc);
        wave_gemm<2, 2>(W, D, H, D, D, m0, n0, acc, F.lane);
        const int h = F.lane >> 5;
#pragma unroll
        for (int a = 0; a < 2; ++a)
#pragma unroll
            for (int j = 0; j < 2; ++j)
#pragma unroll
                for (int r = 0; r < 16; ++r) ST[(size_t)(m0 + 32 * a + crow(r, h)) * T + n0 + 32 * j + (F.lane & 31)] = (_Float16)acc[a][j][r];
    }
}
struct EpiG45 {
    DI bool keeps(const pg8::Unit&) const { return false; }
    static constexpr bool PERM = true;
    unsigned short* ST;
    DI void operator()(const f32x4 (&acc)[2][2][4][2], const pg8::Unit& u, int wr, int wc, int fr, int fq) const {
        const int col0 = u.pn * 256 + wc * 32 + 8 * fq;
#pragma unroll
        for (int ai = 0; ai < 2; ++ai)
#pragma unroll
            for (int m = 0; m < 4; ++m) {
                unsigned short* rowp = ST + (size_t)(u.pm * 256 + wr * 64 + fr + 128 * ai + 16 * m) * T + col0;
#pragma unroll
                for (int bj = 0; bj < 2; ++bj) {
                    u32x4 w;
                    w.x = pkh2(acc[ai][bj][m][0][0], acc[ai][bj][m][0][1]); w.y = pkh2(acc[ai][bj][m][0][2], acc[ai][bj][m][0][3]);
                    w.z = pkh2(acc[ai][bj][m][1][0], acc[ai][bj][m][1][1]); w.w = pkh2(acc[ai][bj][m][1][2], acc[ai][bj][m][1][3]);
                    *(u32x4*)(rowp + 128 * bj) = w;
                }
            }
    }
};
DI void phase_g45(const Params& p, const Frame& F, int l) {
    SchedGrid S{2048 / 256, (l == 0 ? T : TL) / 256, F.nb, F.bid, (const char*)(p.ws + WS_WFOLD) + (size_t)l * 2048 * D * 2, (const char*)(p.ws + WS_H), 0, 0, 0};
    EpiG45 E{(unsigned short*)(p.ws + WS_ST)};
    pg8::gemm_phase(F.lds, F.tid, S, E);
}

DI unsigned fkey(float f) { const unsigned u = __builtin_bit_cast(unsigned, f); return (u & 0x80000000u) ? ~u : (u | 0x80000000u); }
DI float fkey_inv(unsigned k) { const unsigned u = (k & 0x80000000u) ? (k & 0x7fffffffu) : ~k; return __builtin_bit_cast(float, u); }
#define INSERT16(L, x) do { unsigned x_ = (x); _Pragma("unroll") for (int k_ = 0; k_ < 16; ++k_) { const unsigned hi_ = max(L[k_], x_); x_ = min(L[k_], x_); L[k_] = hi_; } } while (0)
#define CEX(a, b) do { const unsigned hi_ = max(a, b), lo_ = min(a, b); a = hi_; b = lo_; } while (0)
DI void sort16_desc(unsigned (&v)[16]) {
#pragma unroll
    for (int k = 2; k <= 16; k <<= 1)
#pragma unroll
        for (int j = k >> 1; j > 0; j >>= 1)
#pragma unroll
            for (int i = 0; i < 16; ++i) {
                const int q = i ^ j;
                if (q > i) { if ((i & k) == 0) CEX(v[i], v[q]); else CEX(v[q], v[i]); }
            }
}
DI void merge16_desc(unsigned (&L)[16], const unsigned (&N)[16]) {
#pragma unroll
    for (int i = 0; i < 16; ++i) L[i] = max(L[i], N[15 - i]);
#pragma unroll
    for (int j = 8; j > 0; j >>= 1)
#pragma unroll
        for (int i = 0; i < 16; ++i) { const int q = i ^ j; if (q > i) CEX(L[i], L[q]); }
}
DI void phase_sel(const Params& p, const Frame& F, int l) {
    const _Float16* ST = (const _Float16*)(p.ws + WS_ST);
    unsigned short* IDX = (unsigned short*)(p.ws + WS_IDX);
    float* GW = (float*)(p.ws + WS_GW);
    float* SU = (float*)(p.ws + WS_SU);
    const float* TSC = (const float*)(p.ws + WS_TSCALE) + (size_t)l * 2 * NEXP;
    LAS unsigned char* ib = (LAS unsigned char*)F.lds;
    const int ntok = (l == 0) ? T : TL;
    for (int i0 = F.bid * NTHREADS; i0 < ntok * 8; i0 += F.nb * NTHREADS) {
        const int i = i0 + F.tid;
        const int tok = i % ntok, head = i / ntok;
        unsigned la[16], lb[16];
#pragma unroll
        for (int k = 0; k < 16; ++k) { la[k] = 0u; lb[k] = 0u; }
        const _Float16* s0 = ST + (size_t)(head * 256) * T + tok;
#define SEL_LOAD(B_, k0_) do { _Pragma("unroll") for (int j = 0; j < 32; ++j) B_[j] = s0[(size_t)((k0_) + j) * T]; } while (0)
#define SEL_INS(L_, B_, k0_) do { _Pragma("unroll") for (int h_ = 0; h_ < 2; ++h_) { unsigned nk_[16]; \
        _Pragma("unroll") for (int j = 0; j < 16; ++j) nk_[j] = (fkey((float)B_[16 * h_ + j]) & ~127u) | (unsigned)(127 - (((k0_) + 16 * h_ + j) & 127)); \
        sort16_desc(nk_); merge16_desc(L_, nk_); } } while (0)
        _Float16 bufa[32], bufb[32];
        SEL_LOAD(bufa, 0);
        SEL_LOAD(bufb, 32);  SEL_INS(la, bufa, 0);
        SEL_LOAD(bufa, 64);  SEL_INS(la, bufb, 32);
        SEL_LOAD(bufb, 96);  SEL_INS(la, bufa, 64);
        SEL_LOAD(bufa, 128); SEL_INS(la, bufb, 96);
        SEL_LOAD(bufb, 160); SEL_INS(lb, bufa, 128);
        SEL_LOAD(bufa, 192); SEL_INS(lb, bufb, 160);
        SEL_LOAD(bufb, 224); SEL_INS(lb, bufa, 192);
        SEL_INS(lb, bufb, 224);
#undef SEL_LOAD
#undef SEL_INS
        float va[16], vb[16];
#pragma unroll
        for (int k = 0; k < 16; ++k) {
            va[k] = fkey_inv(la[k] & ~127u); vb[k] = fkey_inv(lb[k] & ~127u);
            ib[k * NTHREADS + F.tid] = (unsigned char)(127u - (la[k] & 127u));
            ib[(16 + k) * NTHREADS + F.tid] = (unsigned char)(127u - (lb[k] & 127u));
        }
        unsigned lc[16];
#pragma unroll
        for (int k = 0; k < 16; ++k) lc[k] = 0u;
#pragma unroll
        for (int a = 0; a < 16; ++a)
#pragma unroll
            for (int b = 0; b < 16; ++b)
                if ((a + 1) * (b + 1) <= 16) { const unsigned key = (fkey(va[a] + vb[b]) & ~255u) | (unsigned)(255 - (a * 16 + b)); INSERT16(lc, key); }
        float e[16], sum = 0.f; const float v0 = fkey_inv(lc[0] & ~255u);
#pragma unroll
        for (int k = 0; k < 16; ++k) { e[k] = __expf(fkey_inv(lc[k] & ~255u) - v0); sum += e[k]; }
        const float inv = 1.0f / sum;
        asm volatile("s_waitcnt lgkmcnt(0)" ::: "memory");
#pragma unroll
        for (int k = 0; k < 16; ++k) {
            const unsigned pos = 255u - (lc[k] & 255u), a = pos >> 4, b = pos & 15u;
            const unsigned ea = ib[a * NTHREADS + F.tid], eb = ib[(16 + b) * NTHREADS + F.tid];
            const unsigned ex = ea * 128u + eb;
            IDX[(size_t)tok * 128 + head * 16 + k] = (unsigned short)ex;
            GW[(size_t)tok * 128 + head * 16 + k] = e[k] * inv * TSC[NEXP + ex];
            SU[(size_t)tok * 128 + head * 16 + k] = TSC[ex];
        }
        asm volatile("s_waitcnt lgkmcnt(0)" ::: "memory");
    }
}

DI float dpp_xor1(float v) { return __builtin_bit_cast(float, __builtin_amdgcn_mov_dpp(__builtin_bit_cast(int, v), 0xB1, 0xF, 0xF, true)); }
DI float dpp_xor2(float v) { return __builtin_bit_cast(float, __builtin_amdgcn_mov_dpp(__builtin_bit_cast(int, v), 0x4E, 0xF, 0xF, true)); }
DI float dpp_hmir(float v) { return __builtin_bit_cast(float, __builtin_amdgcn_mov_dpp(__builtin_bit_cast(int, v), 0x141, 0xF, 0xF, true)); }
DI float dot16_fp8(const u32x4 q, const float (&hx)[16]) {
    f32x2 a = {0.f, 0.f};
#pragma unroll
    for (int j = 0; j < 4; ++j) {
        const f32x2 lo = __builtin_amdgcn_cvt_pk_f32_fp8((int)q[j], false), hi = __builtin_amdgcn_cvt_pk_f32_fp8((int)q[j], true);
        a += lo * (f32x2){hx[4 * j], hx[4 * j + 1]}; a += hi * (f32x2){hx[4 * j + 2], hx[4 * j + 3]};
    }
    return a.x + a.y;
}
#define PEER_EXPERT(id, i) ((int)(((id)[(i) >> 3][((i) >> 1) & 3] >> (16 * ((i) & 1))) & 0xffffu))

struct PeerURows { u32x4 q[16]; u32x4 h0, h1; };
DI void peer_u_rows(PeerURows& R, const u32x4 (&id)[2], const unsigned char* ut, const bf16_t* hrow) {
    R.h0 = *(const u32x4*)(hrow); R.h1 = *(const u32x4*)(hrow + 8);
#pragma unroll
    for (int i = 0; i < 16; ++i) R.q[i] = *(const u32x4*)(ut + (size_t)PEER_EXPERT(id, i) * D);
}
DI void peer_u_compute(const PeerURows& R, float* part, int lane) {
    float hx[16];
#pragma unroll
    for (int j = 0; j < 4; ++j) { hx[2 * j] = bflo(R.h0[j]); hx[2 * j + 1] = bfhi(R.h0[j]); hx[8 + 2 * j] = bflo(R.h1[j]); hx[8 + 2 * j + 1] = bfhi(R.h1[j]); }
    float d[16];
#pragma unroll
    for (int i = 0; i < 16; ++i) d[i] = dot16_fp8(R.q[i], hx);
    const bool b2 = (lane & 4) != 0, b1 = (lane & 2) != 0, b0 = (lane & 1) != 0;
    float k8[8];
#pragma unroll
    for (int i = 0; i < 8; ++i) { const float keep = b2 ? d[8 + i] : d[i], send = b2 ? d[i] : d[8 + i]; k8[i] = keep + dpp_hmir(send); }
    float k4[4];
#pragma unroll
    for (int i = 0; i < 4; ++i) { const float keep = b1 ? k8[4 + i] : k8[i], send = b1 ? k8[i] : k8[4 + i]; k4[i] = keep + dpp_xor2(send); }
    f32x2 k2;
    { const float keep0 = b0 ? k4[2] : k4[0], send0 = b0 ? k4[0] : k4[2], keep1 = b0 ? k4[3] : k4[1], send1 = b0 ? k4[1] : k4[3];
      k2.x = keep0 + dpp_xor1(send0); k2.y = keep1 + dpp_xor1(send1); }
    *(f32x2*)(part + 16 * (lane >> 3) + (b2 ? 8 : 0) + (b1 ? 4 : 0) + (b0 ? 2 : 0)) = k2;
}
DI void phase_peer_u(const Params& p, const Frame& F, int l) {
    const int ntok = (l == 0) ? T : TL, lane = F.lane;
    const int slice = F.bid & 7, sw = (F.bid >> 3) * NWAVES + F.wave, nsw = (F.nb >> 3) * NWAVES;
    const unsigned char* ut = p.ws + WS_UTAB + (size_t)l * NEXP * D + 128 * slice + 16 * (lane & 7);
    const bf16_t* Hs = (const bf16_t*)(p.ws + WS_H) + 128 * slice + 16 * (lane & 7);
    const unsigned short* IDXg = (const unsigned short*)(p.ws + WS_IDX) + 16 * (lane >> 3);
    float* PART = (float*)(p.ws + WS_ST) + (size_t)slice * T * 128;
    const int last = ntok - 1;
    u32x4 sa[2], sb[2]; PeerURows ra, rb;
#define U_SEL(S_, t_) do { const unsigned short* ip_ = IDXg + (size_t)min((t_), last) * 128; S_[0] = *(const u32x4*)ip_; S_[1] = *(const u32x4*)(ip_ + 8); } while (0)
#define U_ROWS(R_, S_, t_) peer_u_rows(R_, S_, ut, Hs + (size_t)min((t_), last) * D)
    U_SEL(sa, sw); U_SEL(sb, sw + nsw);
    U_ROWS(ra, sa, sw);
#pragma unroll 1
    for (int tok = sw; tok < ntok; tok += 2 * nsw) {
        U_SEL(sa, tok + 2 * nsw); U_ROWS(rb, sb, tok + nsw);
        peer_u_compute(ra, PART + (size_t)tok * 128, lane);
        U_SEL(sb, tok + 3 * nsw); U_ROWS(ra, sa, tok + 2 * nsw);
        if (tok + nsw < ntok) peer_u_compute(rb, PART + (size_t)(tok + nsw) * 128, lane);
    }
#undef U_SEL
#undef U_ROWS
}
DI void phase_peer_c(const Params& p, const Frame& F, int l, bool dummy = false) {
    const int ntok = (l == 0) ? T : TL;
    const float* PART = (const float*)(p.ws + WS_ST);
    float* GW = (float*)(p.ws + WS_GW);
    float* CO = dummy ? (float*)(p.ws + WS_H8) : GW;
    const float* SU = (const float*)(p.ws + WS_SU);
    for (int i = F.gtid; i < ntok * 128; i += F.ngt) {
        float s = 0.f;
#pragma unroll
        for (int sl = 0; sl < 8; ++sl) s += PART[(size_t)sl * T * 128 + i];
        CO[i] = GW[i] * gelu_tanh(s * SU[i]);
    }
}
struct PeerVRows { u32x4 q[16]; f32x4 cf[4]; f32x2 xv, gv; };
DI void peer_v_rows(PeerVRows& R, const u32x4 (&id)[2], const unsigned char* vt, const float* cp, const float* xs, const float* gt2) {
    R.cf[0] = *(const f32x4*)cp; R.cf[1] = *(const f32x4*)(cp + 4); R.cf[2] = *(const f32x4*)(cp + 8); R.cf[3] = *(const f32x4*)(cp + 12);
    R.xv = *(const f32x2*)xs; R.gv = *(const f32x2*)gt2;
#pragma unroll
    for (int i = 0; i < 16; ++i) R.q[i] = *(const u32x4*)(vt + (size_t)PEER_EXPERT(id, i) * D);
}
DI float xchg32(float v, bool hi) { const auto r = __builtin_amdgcn_permlane32_swap(__builtin_bit_cast(unsigned, v), __builtin_bit_cast(unsigned, v), false, false);
    return __builtin_bit_cast(float, hi ? r[0] : r[1]); }
DI float xchg16(float v, bool hi) { const auto r = __builtin_amdgcn_permlane16_swap(__builtin_bit_cast(unsigned, v), __builtin_bit_cast(unsigned, v), false, false);
    return __builtin_bit_cast(float, hi ? r[0] : r[1]); }
DI float xchg8(float v) { return __builtin_bit_cast(float, __builtin_amdgcn_mov_dpp(__builtin_bit_cast(int, v), 0x128, 0xF, 0xF, true)); }
DI void peer_v_compute(const PeerVRows& R, float* xdst, int lane) {
    f32x2 a[8];
#pragma unroll
    for (int j = 0; j < 8; ++j) a[j] = (f32x2){0.f, 0.f};
#pragma unroll
    for (int i = 0; i < 16; ++i) {
        const float c = R.cf[i >> 2][i & 3]; const f32x2 c2 = {c, c};
#pragma unroll
        for (int j = 0; j < 4; ++j) {
            a[2 * j] += c2 * __builtin_amdgcn_cvt_pk_f32_fp8((int)R.q[i][j], false);
            a[2 * j + 1] += c2 * __builtin_amdgcn_cvt_pk_f32_fp8((int)R.q[i][j], true);
        }
    }
    const bool b5 = (lane & 32) != 0, b4 = (lane & 16) != 0, b3 = (lane & 8) != 0;
    f32x2 k4[4];
#pragma unroll
    for (int j = 0; j < 4; ++j) { const f32x2 keep = b5 ? a[4 + j] : a[j], send = b5 ? a[j] : a[4 + j];
        k4[j] = keep + (f32x2){xchg32(send.x, b5), xchg32(send.y, b5)}; }
    f32x2 k2[2];
#pragma unroll
    for (int j = 0; j < 2; ++j) { const f32x2 keep = b4 ? k4[2 + j] : k4[j], send = b4 ? k4[j] : k4[2 + j];
        k2[j] = keep + (f32x2){xchg16(send.x, b4), xchg16(send.y, b4)}; }
    f32x2 k1;
    { const f32x2 keep = b3 ? k2[1] : k2[0], send = b3 ? k2[0] : k2[1];
        k1 = keep + (f32x2){xchg8(send.x), xchg8(send.y)}; }
    *(f32x2*)xdst = R.xv + R.gv * k1;
}
DI void phase_peer_v(const Params& p, const Frame& F, int l, bool dummy = false) {
    const int ntok = (l == 0) ? T : TL, lane = F.lane;
    const int slice = F.bid & 7, sw = (F.bid >> 3) * NWAVES + F.wave, nsw = (F.nb >> 3) * NWAVES;
    const unsigned char* vt = p.ws + WS_VTAB + (size_t)l * NEXP * D + 128 * slice + 16 * (lane & 7);
    const unsigned short* IDXg = (const unsigned short*)(p.ws + WS_IDX) + 16 * (lane >> 3);
    const float* CFg = (const float*)(p.ws + WS_GW) + 16 * (lane >> 3);
    const int last = ntok - 1;
    u32x4 sa[2], sb[2]; PeerVRows ra, rb;
#define V_SEL(S_, t_) do { const unsigned short* ip_ = IDXg + (size_t)min((t_), last) * 128; S_[0] = *(const u32x4*)ip_; S_[1] = *(const u32x4*)(ip_ + 8); } while (0)
    const int co = 128 * slice + 16 * (lane & 7) + ((lane & 32) ? 8 : 0) + ((lane & 16) ? 4 : 0) + ((lane & 8) ? 2 : 0);
#define V_ROWS(R_, S_, t_) do { const int t1_ = min((t_), last); peer_v_rows(R_, S_, vt, CFg + (size_t)t1_ * 128, xrow_ptr(p, t1_) + co, mod_vec(p, l, t1_, 5) + co); } while (0)
#define V_DO(R_, t_) do { const int t2_ = (t_); float* xd_ = (dummy ? (float*)(p.ws + WS_ST) + (size_t)t2_ * D : xrow_ptr(p, t2_)) + co; peer_v_compute(R_, xd_, lane); } while (0)
    V_SEL(sa, sw); V_SEL(sb, sw + nsw);
    V_ROWS(ra, sa, sw);
#pragma unroll 1
    for (int tok = sw; tok < ntok; tok += 2 * nsw) {
        V_SEL(sa, tok + 2 * nsw); V_ROWS(rb, sb, tok + nsw);
        V_DO(ra, tok);
        V_SEL(sb, tok + 3 * nsw); V_ROWS(ra, sa, tok + 2 * nsw);
        if (tok + nsw < ntok) V_DO(rb, tok + nsw);
    }
#undef V_SEL
#undef V_ROWS
#undef V_DO
}

#define XB_TMO      128
#define XB_XCNT(j)  (256  + 64 * (j))
#define XB_XSUB(j)  (1280 + 64 * (j))
#define XB_XGEN(j)  (2304 + 64 * (j))
#define XB_TOP      3328
#define XB_TOPGEN   3392
#define XCD_BAR_WORDS 3456
#define XB_SPIN_CAP (1u << 18)
DI unsigned xb_ld(unsigned* p)              { return __hip_atomic_load(p, __ATOMIC_RELAXED, __HIP_MEMORY_SCOPE_AGENT); }
DI unsigned xb_add(unsigned* p, unsigned v) { return __hip_atomic_fetch_add(p, v, __ATOMIC_RELAXED, __HIP_MEMORY_SCOPE_AGENT); }
DI unsigned xb_xcc_id() { return (unsigned)__builtin_amdgcn_s_getreg((3 << 11) | 20) & 0xFu; }
#define XB_SPIN(cond, bar) do { unsigned _sp = 0; while (cond) { __builtin_amdgcn_s_sleep(1); \
    if ((++_sp & 255u) == 0u) { if (xb_ld(&(bar)[XB_TMO])) break; if (_sp > XB_SPIN_CAP) { atomicAdd(&(bar)[XB_TMO], 1u); break; } } } } while (0)
struct XcdBarrier { unsigned* bar; unsigned x; volatile LAS unsigned* st; };
DI XcdBarrier xcd_barrier_post(unsigned* bar, volatile LAS unsigned* st) {
    XcdBarrier b; b.bar = bar; b.x = xb_xcc_id(); b.st = st;
    if (threadIdx.x == 0) (void)xb_add(&bar[XB_XCNT(b.x)], 1u);
    return b;
}
DI void xcd_barrier_complete(unsigned* bar, unsigned x, unsigned& nloc, unsigned& nx) {
    const unsigned G = gridDim.x * gridDim.y * gridDim.z;
    unsigned sum, cnt, mine, sp = 0u;
    for (;;) {
        sum = 0u; cnt = 0u; mine = 0u;
#pragma unroll
        for (unsigned j = 0; j < 16; ++j) { const unsigned c = xb_ld(&bar[XB_XCNT(j)]); sum += c; cnt += (c > 0u) ? 1u : 0u; mine = (j == x) ? c : mine; }
        if (sum == G) break;
        __builtin_amdgcn_s_sleep(1);
        if ((++sp & 255u) == 0u) { if (xb_ld(&bar[XB_TMO])) break; if (sp > XB_SPIN_CAP) { atomicAdd(&bar[XB_TMO], 1u); break; } }
    }
    nloc = mine > 0u ? mine : 1u; nx = cnt > 0u ? cnt : 1u;
}
DI void xcd_barrier(const XcdBarrier& b) {
    asm volatile("s_waitcnt vmcnt(0)" ::: "memory");
    __syncthreads();
    if (threadIdx.x == 0) {
        unsigned* bar = b.bar;
        __builtin_amdgcn_s_waitcnt(0);
        unsigned nloc = b.st[0], nx = b.st[1];
        if (nloc == 0u) { xcd_barrier_complete(bar, b.x, nloc, nx); b.st[0] = nloc; b.st[1] = nx; }
        const unsigned old = xb_add(&bar[XB_XSUB(b.x)], 1u);
        const unsigned gen = old / nloc;
        if (old + 1u == (gen + 1u) * nloc) {
            __builtin_amdgcn_fence(__ATOMIC_RELEASE, "agent");
            asm volatile("s_waitcnt vmcnt(0)" ::: "memory");
            const unsigned og = xb_add(&bar[XB_TOP], 1u);
            const unsigned tg = og / nx;
            if (og + 1u == (tg + 1u) * nx) xb_add(&bar[XB_TOPGEN], 1u);
            else XB_SPIN(xb_ld(&bar[XB_TOPGEN]) == tg, bar);
            __builtin_amdgcn_fence(__ATOMIC_ACQUIRE, "agent");
            xb_add(&bar[XB_XGEN(b.x)], 1u);
            asm volatile("s_waitcnt vmcnt(0)" ::: "memory");
        } else {
            XB_SPIN(xb_ld(&bar[XB_XGEN(b.x)]) == gen, bar);
            __builtin_amdgcn_fence(__ATOMIC_ACQUIRE, "agent");
            asm volatile("s_waitcnt vmcnt(0)" ::: "memory");
        }
    }
    __syncthreads();
}

constexpr int NPHASE = 25;
template <int PH> DI void run_phase(const Params& p, const Frame& F) {
    if constexpr (PH == 0) phase_prep(p, F);
    else if constexpr (PH == 1) phase_norm(p, F, 0, 0, true, T);
    else if constexpr (PH == 2) phase_g1(p, F, 0);
    else if constexpr (PH == 3) phase_mix(p, F, 0);
    else if constexpr (PH == 4) phase_g2(p, F, 0);
    else if constexpr (PH == 5) phase_g2sum(p, F);
    else if constexpr (PH == 6) phase_g3(p, F, 0);
    else if constexpr (PH == 7) phase_norm(p, F, 0, 1, false, T);
    else if constexpr (PH == 8) phase_g45(p, F, 0);
    else if constexpr (PH == 9) phase_sel(p, F, 0);
    else if constexpr (PH == 10) phase_peer_u(p, F, 0);
    else if constexpr (PH == 11) phase_peer_c(p, F, 0);
    else if constexpr (PH == 12) phase_peer_v(p, F, 0);
    else if constexpr (PH == 13) phase_norm(p, F, 1, 0, false, T);
    else if constexpr (PH == 14) phase_g1(p, F, 1);
    else if constexpr (PH == 15) phase_mix(p, F, 1);
    else if constexpr (PH == 16) phase_g2(p, F, 1);
    else if constexpr (PH == 17) phase_g3(p, F, 1);
    else if constexpr (PH == 18) phase_norm(p, F, 1, 1, false, TL);
    else if constexpr (PH == 19) phase_g45(p, F, 1);
    else if constexpr (PH == 20) phase_sel(p, F, 1);
    else if constexpr (PH == 21) phase_peer_u(p, F, 1);
    else if constexpr (PH == 22) phase_peer_c(p, F, 1);
    else if constexpr (PH == 23) phase_peer_v(p, F, 1);
    else if constexpr (PH == 24) phase_final(p, F);
}
DI Frame make_frame(unsigned char* lds_raw) {
    Frame F;
    F.lds = (LAS unsigned char*)lds_raw;
    int tid = threadIdx.x; asm volatile("" : "+v"(tid));
    int bid = blockIdx.x, nb = gridDim.x; asm volatile("" : "+s"(bid), "+s"(nb));
    F.tid = tid; F.lane = tid & 63; F.wave = __builtin_amdgcn_readfirstlane(tid >> 6); F.bid = bid; F.nb = nb;
    F.gw = bid * NWAVES + F.wave; F.ngw = nb * NWAVES; F.gtid = bid * NTHREADS + tid; F.ngt = nb * NTHREADS;
    return F;
}
template <int PH> DI void run_phase_fresh(unsigned char* lds_raw) {
#if defined(__HIP_DEVICE_COMPILE__)
    const __attribute__((address_space(4))) unsigned long long* pp = (const __attribute__((address_space(4))) unsigned long long*)__builtin_amdgcn_kernarg_segment_ptr();
    asm volatile("" : "+s"(pp));
    Params p;
#pragma unroll
    for (int i = 0; i < N_IN; ++i) p.in[i] = (const float*)(const __attribute__((address_space(1))) float*)pp[i];
    p.out = (float*)(__attribute__((address_space(1))) float*)pp[N_IN]; p.ws = (unsigned char*)(__attribute__((address_space(1))) unsigned char*)pp[N_IN + 1]; p.ph_lo = 0; p.ph_hi = 0;
#else
    Params p{};
#endif
    const Frame F = make_frame(lds_raw);
    run_phase<PH>(p, F);
}
template <int PH> __global__ void __launch_bounds__(NTHREADS, 2) phase_kernel(Params p) {
    extern __shared__ __attribute__((aligned(16))) unsigned char lds_raw[];
    run_phase_fresh<PH>(lds_raw);
}
template <int PH> DI void run_all(unsigned char* lds_raw, cg::grid_group& grid, const XcdBarrier& bar) {
    if constexpr (PH < NPHASE) {
        if constexpr (PH == PROBE_PH) {
            if constexpr (PH == 11 || PH == 22 || PH == 12 || PH == 23) {
#if defined(__HIP_DEVICE_COMPILE__)
                const __attribute__((address_space(4))) unsigned long long* pp = (const __attribute__((address_space(4))) unsigned long long*)__builtin_amdgcn_kernarg_segment_ptr();
                asm volatile("" : "+s"(pp));
                Params p;
#pragma unroll
                for (int i = 0; i < N_IN; ++i) p.in[i] = (const float*)(const __attribute__((address_space(1))) float*)pp[i];
                p.out = (float*)(__attribute__((address_space(1))) float*)pp[N_IN]; p.ws = (unsigned char*)(__attribute__((address_space(1))) unsigned char*)pp[N_IN + 1]; p.ph_lo = 0; p.ph_hi = 0;
                const Frame F = make_frame(lds_raw);
                if constexpr (PH == 11 || PH == 22) phase_peer_c(p, F, PH == 11 ? 0 : 1, true); else phase_peer_v(p, F, PH == 12 ? 0 : 1, true);
#endif
            } else run_phase_fresh<PH>(lds_raw);
            xcd_barrier(bar);
        }
        run_phase_fresh<PH>(lds_raw);
        if constexpr (PH + 1 < NPHASE) { xcd_barrier(bar); if constexpr (PROBE_SYNC) xcd_barrier(bar); }
        run_all<PH + 1>(lds_raw, grid, bar);
    }
}
__global__ void __launch_bounds__(NTHREADS, 2) mega(Params p) {
    extern __shared__ __attribute__((aligned(16))) unsigned char lds_raw[];
    cg::grid_group grid = cg::this_grid();
    volatile LAS unsigned* st = (volatile LAS unsigned*)((LAS unsigned char*)lds_raw + LDS_BAR_OFF);
    if (threadIdx.x < 2) st[threadIdx.x] = 0u;
    __syncthreads();
    const XcdBarrier bar = xcd_barrier_post((unsigned*)(p.ws + WS_CTL), st);
    if (p.ph_lo != 0) grid.sync();
    run_all<0>(lds_raw, grid, bar);
}

extern "C" void kernel_launch(void* const* d_in, const int* in_sizes, int n_in, void* d_out, int out_size, void* d_ws, size_t ws_size, hipStream_t stream) {
    static int grid = 0;
    if (grid == 0) {
        if (n_in != 23 || out_size != TL * D || ws_size < WS_END) { fprintf(stderr, "kernel_launch: unexpected shapes (n_in %d out %d ws %zu)\n", n_in, out_size, ws_size); grid = -1; return; }
        int dev = 0, cus = 0, per_cu = 0;
        (void)hipGetDevice(&dev);
        (void)hipDeviceGetAttribute(&cus, hipDeviceAttributeMultiprocessorCount, dev);
        (void)hipFuncSetAttribute((const void*)mega, hipFuncAttributeMaxDynamicSharedMemorySize, LDS_BYTES);
        (void)hipOccupancyMaxActiveBlocksPerMultiprocessor(&per_cu, (const void*)mega, NTHREADS, LDS_BYTES);
        if (per_cu < 1) { fprintf(stderr, "kernel_launch: occupancy query reports %d blocks per CU\n", per_cu); grid = -1; return; }
        grid = cus & ~7;
        if (grid < 8) { fprintf(stderr, "kernel_launch: needs at least 8 CUs\n"); grid = -1; return; }
    }
    if (grid < 0) return;
    (void)hipMemsetAsync((char*)d_ws + WS_CTL, 0, CTL_ZERO_BYTES, stream);
    Params p{};
    for (int i = 0; i < N_IN; ++i) p.in[i] = (const float*)d_in[i];
    p.out = (float*)d_out; p.ws = (unsigned char*)d_ws;
    void* args[] = {&p};
    hipError_t e = hipLaunchCooperativeKernel((const void*)mega, dim3(grid), dim3(NTHREADS), args, LDS_BYTES, stream);
    if (e != hipSuccess) fprintf(stderr, "cooperative launch failed: %s (grid %d)\n", hipGetErrorString(e), grid);
}
```

```cpp
#include <hip/hip_runtime.h>
#include <hip/hip_cooperative_groups.h>
#include <stdint.h>
#include <stdio.h>
namespace cg = cooperative_groups;

#ifndef PROBE_PH
#define PROBE_PH -1
#endif
#ifndef PROBE_SYNC
#define PROBE_SYNC 0
#endif
#ifndef MK_SINGLE
#define MK_SINGLE 0
#endif

#define LAS __attribute__((address_space(3)))
typedef unsigned short bf16_t;
typedef short bf16x8 __attribute__((ext_vector_type(8)));
typedef short s16x4 __attribute__((ext_vector_type(4)));
typedef float f32x4 __attribute__((ext_vector_type(4)));
typedef float f32x2 __attribute__((ext_vector_type(2)));
typedef float f32x16 __attribute__((ext_vector_type(16)));
typedef unsigned u32x4 __attribute__((ext_vector_type(4)));
typedef unsigned u32x2 __attribute__((ext_vector_type(2)));
typedef __bf16 bf16x2_t __attribute__((ext_vector_type(2)));
typedef _Float16 f16x2_t __attribute__((ext_vector_type(2)));
#define DI __device__ __forceinline__
DI unsigned pkh2(float lo, float hi) { f16x2_t v = {(_Float16)lo, (_Float16)hi}; return __builtin_bit_cast(unsigned, v); }
#define MFMA32(a, b, c) __builtin_amdgcn_mfma_f32_32x32x16_bf16((a), (b), (c), 0, 0, 0)

constexpr int D = 1024, NB = 8, SEQ = 4096, NCTX = 256, DEPTH = 2;
constexpr int TL = NB * SEQ, TC = NB * NCTX, T = TL + TC;
constexpr int INW = 4608, NMOD = 6 * D, PW = 1600, PN = 1536;
constexpr int VTS = SEQ + 64;
constexpr int QOFF = 0, KOFF = 512, VOFF = 640, POOLOFF = 768, SUOFF = 1024, SVOFF = 1280, GATEOFF = 1536;
constexpr int NEXP = 16384;
constexpr float EPS = 1e-6f;
constexpr float LOG2E = 1.4426950408889634f;
constexpr float QSCALE = 0.125f * LOG2E;

constexpr size_t MiB = 1u << 20;
constexpr size_t WS_CTL = 0, WS_MOD = 1 * MiB, CTL_ZERO_BYTES = 2 * MiB;
constexpr size_t WS_ROPE = 2 * MiB, WS_SGUW = 2 * MiB + 65536, WS_TSCALE = 3 * MiB;
constexpr size_t WS_WIN = 4 * MiB, WS_WBR = 22 * MiB, WS_WOUT = 26 * MiB, WS_WFOLD = 30 * MiB;
constexpr size_t WS_XCTX = 38 * MiB, WS_UTAB = 46 * MiB, WS_VTAB = 78 * MiB;
constexpr size_t WS_IDX = 110 * MiB, WS_GW = 120 * MiB;
constexpr size_t WS_H = 142 * MiB;
constexpr size_t WS_P = 210 * MiB, WS_Y = 318 * MiB, WS_MERGED = 386 * MiB, WS_VT = 454 * MiB, WS_VTC = 463 * MiB, WS_VST = 464 * MiB;
constexpr size_t WS_MP = 482 * MiB;
constexpr size_t WS_ST = 210 * MiB, WS_H8 = 346 * MiB, WS_HS = 380 * MiB, WS_SU = 482 * MiB;
constexpr size_t WS_END = 512 * MiB;
static_assert(WS_ST + (size_t)2048 * T * 2 <= WS_H8 && WS_H8 + (size_t)T * D <= WS_HS, "ST / H8 fit");
static_assert(WS_VST + (size_t)272 * 256 * 128 * 2 <= WS_SU && WS_VT + (size_t)NB * 2 * 64 * VTS * 2 <= WS_VTC, "VsT / VT fit");
static_assert(WS_H + (size_t)T * D * 2 <= WS_P, "H fits");
static_assert(WS_P + (size_t)T * PW * 2 <= WS_Y && WS_Y + (size_t)T * D * 2 <= WS_MERGED && WS_MERGED + (size_t)T * D * 2 <= WS_VT, "P/Y/MERGED fit");
static_assert(WS_IDX + (size_t)T * 128 * 2 <= WS_GW && WS_GW + (size_t)T * 128 * 4 <= WS_H && WS_SU + (size_t)T * 128 * 4 <= WS_END && WS_HS + (size_t)T * 4 <= WS_SU, "idx/gw/su fit");

constexpr int LDS_BYTES = 163840;
constexpr int LDS_BAR_OFF = LDS_BYTES - 64;
constexpr int NTHREADS = 512, NWAVES = 8;

enum { I_x, I_c, I_ctx, I_c_ctx, I_w_mod, I_b_mod, I_g_mix, I_g_ffn, I_w_in, I_attn_sink, I_pool_w, I_pool_scale, I_sgu_w, I_sgu_b, I_w_br_attn, I_w_br_pool, I_w_br_sgu, I_w_out, I_peer_wq, I_peer_subkeys, I_peer_u, I_peer_v, I_g_final, N_IN };
struct Params {
    const float* in[N_IN];
    float* out; unsigned char* ws;
    int ph_lo, ph_hi;
};

DI unsigned pk2(float lo, float hi) { f32x2 v = {lo, hi}; return __builtin_bit_cast(unsigned, __builtin_convertvector(v, bf16x2_t)); }
DI unsigned f2bf(float f) { return pk2(f, 0.f) & 0xffffu; }
DI float bf2f(unsigned short u) { return __builtin_bit_cast(float, (unsigned)u << 16); }
DI float bflo(unsigned w) { return __builtin_bit_cast(float, w << 16); }
DI float bfhi(unsigned w) { return __builtin_bit_cast(float, w & 0xffff0000u); }
DI int crow(int reg, int h) { return (reg & 3) + 8 * (reg >> 2) + 4 * h; }
DI float wave_sum(float v) {
#pragma unroll
    for (int o = 1; o < 64; o <<= 1) v += __shfl_xor(v, o);
    return v;
}
DI float sigmoidf_(float x) { return 1.0f / (1.0f + __expf(-x)); }
DI float gelu_tanh(float x) { const float u = 0.7978845608028654f * (x + 0.044715f * x * x * x); return x / (1.0f + __expf(-2.0f * u)); }
DI float silu_(float x) { return x / (1.0f + __expf(-x)); }

struct Frame {
    int tid, lane, wave, gw, ngw, gtid, ngt, bid, nb;
    LAS unsigned char* lds;
};

template <int NM, int NN>
DI void wave_gemm(const bf16_t* __restrict__ A, int lda, const bf16_t* __restrict__ Bt, int ldb, int K, int m0, int n0, f32x16 (&acc)[NM][NN], int lane) {
    const int r = lane & 31, h = lane >> 5;
    const bf16_t* ap = A + (size_t)(m0 + r) * lda + 8 * h;
    const bf16_t* bp = Bt + (size_t)(n0 + r) * ldb + 8 * h;
    for (int k0 = 0; k0 < K; k0 += 64) {
        bf16x8 a[4][NM], b[4][NN];
#pragma unroll
        for (int s = 0; s < 4; ++s) {
#pragma unroll
            for (int i = 0; i < NM; ++i) a[s][i] = *(const bf16x8*)(ap + (size_t)(32 * i) * lda + k0 + 16 * s);
#pragma unroll
            for (int j = 0; j < NN; ++j) b[s][j] = *(const bf16x8*)(bp + (size_t)(32 * j) * ldb + k0 + 16 * s);
        }
#pragma unroll
        for (int s = 0; s < 4; ++s)
#pragma unroll
            for (int i = 0; i < NM; ++i)
#pragma unroll
                for (int j = 0; j < NN; ++j) acc[i][j] = MFMA32(a[s][i], b[s][j], acc[i][j]);
    }
}
template <int NM, int NN> DI void zero_acc(f32x16 (&acc)[NM][NN]) {
#pragma unroll
    for (int i = 0; i < NM; ++i)
#pragma unroll
        for (int j = 0; j < NN; ++j)
#pragma unroll
            for (int r = 0; r < 16; ++r) acc[i][j][r] = 0.f;
}

namespace pg8 {
constexpr int BM = 256, BK = 64, HALF = 128, HTB = HALF * BK * 2, STAGE_BYTES = 8 * HTB, NXCD = 8, WGM = 8, LD = 1024;
DI int lds_byte(int r, int c) { const int st = (r >> 4) * 2 + (c >> 5), rr = r & 15, cc = c & 31, ob = rr * 64 + cc * 2; return st * 1024 + (ob ^ (((ob >> 9) & 1) << 5)); }
DI void stage_rc(int b, int& R, int& C) { const int st = b / 1024, sb = b % 1024, swz = sb ^ (((sb >> 9) & 1) << 5); R = (st >> 1) * 16 + swz / 64; C = (st & 1) * 32 + (swz % 64) / 2; }
DI int perm32(int rho) { const int n = rho >> 4, i = rho & 15; return 8 * (i >> 2) + 4 * n + (i & 3); }
struct Unit { int pm, pn, sub, nt, mode; const char* a; const char* b; };
DI void tile_of(int L, int nM, int nN, int& pm, int& pn) {
    const int nwg = nM * nN; int wgid = L;
    { const int q = nwg / NXCD, r = nwg % NXCD, xcd = wgid % NXCD, off = wgid / NXCD; wgid = (xcd < r ? xcd * (q + 1) : r * (q + 1) + (xcd - r) * q) + off; }
    const int nig = WGM * nN, gid = wgid / nig, fm = gid * WGM, gsz = (nM - fm) < WGM ? (nM - fm) : WGM;
    pm = fm + ((wgid % nig) % gsz); pn = (wgid % nig) / gsz;
}
template <class Epi, class Sched>
DI void gemm_phase(LAS unsigned char* lds, const int tid, const Sched& S, const Epi& E) {
    const int wid = __builtin_amdgcn_readfirstlane(tid >> 6), lane = tid & 63, wr = wid >> 2, wc = wid & 3, fr = lane & 15, fq = lane >> 4;
    unsigned voffA[2], voffB[2];
#pragma unroll
    for (int i = 0; i < 2; ++i) { int R, C; stage_rc(tid * 16 + i * 8192, R, C); const int Rb = Epi::PERM ? ((R & ~31) + perm32(R & 31)) : R;
        voffA[i] = (unsigned)(R * LD + C) * 2u; voffB[i] = (unsigned)(Rb * LD + C) * 2u; }
    const size_t kstep = (size_t)(BK * 2);
    const size_t hstep = (size_t)HALF * LD * 2;
    const unsigned ldsw = (unsigned)wid * 1024u;
    const int aoff = lds_byte(wr * 64 + fr, fq * 8), boff = lds_byte(wc * 32 + fr, fq * 8);
#define PG8_SA(b, h) (((b) * 2 + (h)) * HTB)
#define PG8_SB(b, h) ((4 + (b) * 2 + (h)) * HTB)
#define PG8_STAGE(bufoff, gbase, voff) do { _Pragma("unroll") for (int _i = 0; _i < 2; ++_i) \
        __builtin_amdgcn_global_load_lds((const unsigned*)((const char*)(gbase) + (voff)[_i]), (LAS unsigned*)(lds + (bufoff) + ldsw + _i * 8192), 16, 0, 0); } while (0)
#define PG8_LDA(dst, b, h) do { _Pragma("unroll") for (int m = 0; m < 4; ++m) _Pragma("unroll") for (int k = 0; k < 2; ++k) dst[m][k] = *(const LAS bf16x8*)(lds + PG8_SA(b, h) + aoff + m * 2048 + k * 1024); } while (0)
#define PG8_LDB(dst, b, h) do { _Pragma("unroll") for (int n = 0; n < 2; ++n) _Pragma("unroll") for (int k = 0; k < 2; ++k) dst[n][k] = *(const LAS bf16x8*)(lds + PG8_SB(b, h) + boff + n * 2048 + k * 1024); } while (0)
#define PG8_MMA(ai, bj, At, Bt) do { __builtin_amdgcn_s_setprio(1); _Pragma("unroll") for (int m = 0; m < 4; ++m) _Pragma("unroll") for (int n = 0; n < 2; ++n) _Pragma("unroll") for (int k = 0; k < 2; ++k) \
        acc[ai][bj][m][n] = __builtin_amdgcn_mfma_f32_16x16x32_bf16(Bt[n][k], At[m][k], acc[ai][bj][m][n], 0, 0, 0); __builtin_amdgcn_s_setprio(0); } while (0)
#define PG8_WAIT_V(n) asm volatile("s_waitcnt vmcnt(" #n ")" ::: "memory")
#define PG8_WAIT_L(n) asm volatile("s_waitcnt lgkmcnt(" #n ")" ::: "memory")
#define PG8_BAR __builtin_amdgcn_s_barrier()
#define PG8_SCHED __builtin_amdgcn_sched_barrier(0)
    Unit cur, nxt; int ui = 0;
    if (!S.next(0, cur)) return;
    f32x4 acc[2][2][4][2];
#pragma unroll
    for (int a = 0; a < 2; ++a)
#pragma unroll
        for (int b = 0; b < 2; ++b)
#pragma unroll
            for (int m = 0; m < 4; ++m)
#pragma unroll
                for (int n = 0; n < 2; ++n) acc[a][b][m][n] = (f32x4){0.f, 0.f, 0.f, 0.f};
    bf16x8 At[4][2], B0[2][2], B1[2][2];
    const char* cA = cur.a; const char* cB = cur.b;
    PG8_STAGE(PG8_SB(0, 0), cB, voffB); PG8_STAGE(PG8_SB(0, 1), cB + hstep, voffB); PG8_STAGE(PG8_SA(0, 0), cA, voffA); PG8_STAGE(PG8_SA(0, 1), cA + hstep, voffA);
    if (wr == 1) PG8_BAR;
    PG8_WAIT_V(2); PG8_BAR;
    PG8_STAGE(PG8_SB(1, 0), cB + kstep, voffB); PG8_STAGE(PG8_SA(1, 0), cA + kstep, voffA); PG8_STAGE(PG8_SB(1, 1), cB + hstep + kstep, voffB);
    PG8_WAIT_V(6); PG8_BAR;
    for (;;) {
        const bool has_next = S.next(ui + 1, nxt);
        const char* nA = has_next ? nxt.a : cA; const char* nB = has_next ? nxt.b : cB;
        const int nt = cur.nt;
        for (int t = 0; t < nt; t += 2) {
            const bool last = (t == nt - 2);
            const char* a1 = cA + (size_t)(t + 1) * kstep;
            const char* a2 = last ? nA : cA + (size_t)(t + 2) * kstep; const char* b2 = last ? nB : cB + (size_t)(t + 2) * kstep;
            const char* a3 = a2 + kstep; const char* b3 = b2 + kstep;
            PG8_LDB(B0, 0, 0); PG8_LDB(B1, 0, 1); PG8_SCHED; PG8_LDA(At, 0, 0); PG8_STAGE(PG8_SA(1, 1), a1 + hstep, voffA);
            PG8_WAIT_V(8); PG8_WAIT_L(0); PG8_BAR; PG8_MMA(0, 0, At, B0); PG8_MMA(0, 1, At, B1); PG8_BAR; PG8_SCHED;
            PG8_LDA(At, 0, 1); PG8_STAGE(PG8_SB(0, 0), b2, voffB); PG8_STAGE(PG8_SB(0, 1), b2 + hstep, voffB); PG8_STAGE(PG8_SA(0, 0), a2, voffA);
            PG8_WAIT_V(8); PG8_WAIT_L(0); PG8_BAR; PG8_MMA(1, 0, At, B0); PG8_MMA(1, 1, At, B1); PG8_BAR; PG8_SCHED;
            PG8_LDB(B0, 1, 0); PG8_LDB(B1, 1, 1); PG8_SCHED; PG8_LDA(At, 1, 0); PG8_STAGE(PG8_SA(0, 1), a2 + hstep, voffA);
            PG8_WAIT_V(8); PG8_WAIT_L(0); PG8_BAR; PG8_MMA(0, 0, At, B0); PG8_MMA(0, 1, At, B1); PG8_BAR; PG8_SCHED;
            PG8_LDA(At, 1, 1); PG8_STAGE(PG8_SB(1, 0), b3, voffB); PG8_STAGE(PG8_SB(1, 1), b3 + hstep, voffB); PG8_STAGE(PG8_SA(1, 0), a3, voffA);
            PG8_WAIT_V(8); PG8_WAIT_L(0); PG8_BAR; PG8_MMA(1, 0, At, B0); PG8_MMA(1, 1, At, B1); PG8_BAR; PG8_SCHED;
        }
        if (wr == 0) PG8_BAR;
        E(acc, cur, wr, wc, fr, fq);
        if (!has_next) break;
        if (!E.keeps(cur)) {
#pragma unroll
        for (int a = 0; a < 2; ++a)
#pragma unroll
            for (int b = 0; b < 2; ++b)
#pragma unroll
                for (int m = 0; m < 4; ++m)
#pragma unroll
                    for (int n = 0; n < 2; ++n) acc[a][b][m][n] = (f32x4){0.f, 0.f, 0.f, 0.f};
        }
        cur = nxt; cA = nA; cB = nB; ++ui;
        if (wr == 1) PG8_BAR;
    }
    PG8_WAIT_V(0);
    PG8_BAR;
#undef PG8_SA
#undef PG8_SB
#undef PG8_STAGE
#undef PG8_LDA
#undef PG8_LDB
#undef PG8_MMA
#undef PG8_WAIT_V
#undef PG8_WAIT_L
#undef PG8_BAR
#undef PG8_SCHED
}
}

DI void transpose_item(const float* W, int K, int N, bf16_t* WT, int ldd, int row_off, int col_off, LAS float* scr, int item, int lane) {
    const int nblk = N / 32, kb = item / nblk, nb = item % nblk, k0 = 64 * kb, n0 = 32 * nb;
#pragma unroll 8
    for (int i = 0; i < 32; ++i) { const int kk = 2 * i + (lane >> 5); scr[kk * 33 + (lane & 31)] = W[(size_t)(k0 + kk) * N + n0 + (lane & 31)]; }
    asm volatile("s_waitcnt lgkmcnt(0)" ::: "memory");
    const int c = lane & 7;
#pragma unroll
    for (int j = 0; j < 4; ++j) { const int n = (lane >> 3) + 8 * j; const LAS float* s = scr + (8 * c) * 33 + n;
        u32x4 o; o.x = pk2(s[0 * 33], s[1 * 33]); o.y = pk2(s[2 * 33], s[3 * 33]); o.z = pk2(s[4 * 33], s[5 * 33]); o.w = pk2(s[6 * 33], s[7 * 33]);
        *(u32x4*)(WT + (size_t)(row_off + n0 + n) * ldd + col_off + k0 + 8 * c) = o; }
    asm volatile("s_waitcnt lgkmcnt(0)" ::: "memory");
}

DI void convert_tables(const Params& p, const Frame& F) {
    for (int it0 = 4 * F.gw; it0 < 4 * NEXP; it0 += 4 * F.ngw) {
        f32x4 v[4][4];
#pragma unroll
        for (int u = 0; u < 4; ++u) {
            const int it = it0 + u, e = it & (NEXP - 1), tbl = (it >> 14) & 1, l = it >> 15;
            const f32x4* src = (const f32x4*)((tbl ? p.in[I_peer_v] : p.in[I_peer_u]) + ((size_t)l * NEXP + e) * D) + 4 * F.lane;
#pragma unroll
            for (int j = 0; j < 4; ++j) v[u][j] = src[j];
        }
#pragma unroll
        for (int u = 0; u < 4; ++u) {
            const int it = it0 + u, e = it & (NEXP - 1), tbl = (it >> 14) & 1, l = it >> 15;
            float am = 0.f;
#pragma unroll
            for (int j = 0; j < 4; ++j) am = fmaxf(am, fmaxf(fmaxf(fabsf(v[u][j].x), fabsf(v[u][j].y)), fmaxf(fabsf(v[u][j].z), fabsf(v[u][j].w))));
#pragma unroll
            for (int o = 1; o < 64; o <<= 1) am = fmaxf(am, __shfl_xor(am, o));
            const float sc = (am > 0.f) ? exp2f(floorf(log2f(224.0f / am))) : 1.0f;
            u32x4 q;
#pragma unroll
            for (int j = 0; j < 4; ++j) { int w = 0; w = __builtin_amdgcn_cvt_pk_fp8_f32(v[u][j].x * sc, v[u][j].y * sc, w, false); w = __builtin_amdgcn_cvt_pk_fp8_f32(v[u][j].z * sc, v[u][j].w * sc, w, true); q[j] = (unsigned)w; }
            *(u32x4*)(p.ws + (tbl ? WS_VTAB : WS_UTAB) + ((size_t)l * NEXP + e) * D + 16 * F.lane) = q;
            if (F.lane == 0) ((float*)(p.ws + WS_TSCALE))[(l * 2 + tbl) * NEXP + e] = 1.0f / sc;
        }
    }
}

DI void phase_prep(const Params& p, const Frame& F) {
    unsigned char* ws = p.ws;
    {
        LAS float* wq = (LAS float*)F.lds;
        LAS float* skl = wq + 128 * 65;
        for (int it = F.bid; it < 2 * 16 * 16; it += F.nb) {
            const int cc = it & 15, hp = (it >> 4) & 15, l = it >> 8;
            const float* src = p.in[I_peer_wq] + (size_t)l * D * 2048 + hp * 128;
            const float* sks = p.in[I_peer_subkeys] + (size_t)(l * 16 + hp) * 128 * 128;
            __syncthreads();
            { float tw[16]; f32x4 ts[8];
#pragma unroll
              for (int it = 0; it < 16; ++it) { const int e = F.tid + it * NTHREADS, ci = e >> 7, d = e & 127; tw[it] = src[(size_t)(cc * 64 + ci) * 2048 + d]; }
#pragma unroll
              for (int it = 0; it < 8; ++it) { const int e = F.tid + it * NTHREADS, key = e >> 5, d4 = (e & 31) * 4; ts[it] = *(const f32x4*)(sks + key * 128 + d4); }
#pragma unroll
              for (int it = 0; it < 16; ++it) { const int e = F.tid + it * NTHREADS, ci = e >> 7, d = e & 127; wq[d * 65 + ci] = tw[it]; }
#pragma unroll
              for (int it = 0; it < 8; ++it) { const int e = F.tid + it * NTHREADS, key = e >> 5, d4 = (e & 31) * 4; *(LAS f32x4*)(skl + key * 132 + d4) = ts[it]; } }
            __syncthreads();
            const int ci = F.tid & 63, kg = F.tid >> 6;
            float acc[16];
#pragma unroll
            for (int k = 0; k < 16; ++k) acc[k] = 0.f;
#pragma unroll 2
            for (int d = 0; d < 128; d += 4) {
                const float w0 = wq[d * 65 + ci], w1 = wq[(d + 1) * 65 + ci], w2 = wq[(d + 2) * 65 + ci], w3 = wq[(d + 3) * 65 + ci];
#pragma unroll
                for (int k = 0; k < 16; ++k) { const f32x4 s = *(const LAS f32x4*)(skl + (16 * kg + k) * 132 + d); acc[k] += w0 * s.x + w1 * s.y + w2 * s.z + w3 * s.w; }
            }
            bf16_t* dst = (bf16_t*)(ws + WS_WFOLD) + ((size_t)l * 2048 + hp * 128 + 16 * kg) * D + cc * 64 + ci;
#pragma unroll
            for (int k = 0; k < 16; ++k) dst[(size_t)k * D] = (bf16_t)f2bf(acc[k]);
        }
        __syncthreads();
    }
    {
        LAS float* scr = (LAS float*)(F.lds + F.wave * 16384);
        constexpr int I_IN = (D / 64) * (INW / 32), I_BA = (512 / 64) * (D / 32), I_BS = (256 / 64) * (D / 32), I_O = (D / 64) * (D / 32);
        constexpr int PER_L = I_IN + I_BA + I_BS + I_O;
        for (int it = F.gw; it < 2 * PER_L; it += F.ngw) {
            const int l = it / PER_L; int r = it % PER_L;
            if (r < I_IN) { transpose_item(p.in[I_w_in] + (size_t)l * D * INW, D, INW, (bf16_t*)(ws + WS_WIN) + (size_t)l * INW * D, D, 0, 0, scr, r, F.lane); continue; } r -= I_IN;
            if (r < I_BA) { transpose_item(p.in[I_w_br_attn] + (size_t)l * 512 * D, 512, D, (bf16_t*)(ws + WS_WBR) + (size_t)l * D * D, D, 0, 0, scr, r, F.lane); continue; } r -= I_BA;
            if (r < I_BS) { transpose_item(p.in[I_w_br_sgu] + (size_t)l * 256 * D, 256, D, (bf16_t*)(ws + WS_WBR) + (size_t)l * D * D, D, 0, 768, scr, r, F.lane); continue; } r -= I_BS;
            transpose_item(p.in[I_w_out] + (size_t)l * D * D, D, D, (bf16_t*)(ws + WS_WOUT) + (size_t)l * D * D, D, 0, 0, scr, r, F.lane);
        }
    }
    for (int i = F.gtid; i < 2 * 256 * D; i += F.ngt) {
        const int n = i & 1023, rc = (i >> 10) & 255, l = i >> 18, g = rc >> 6;
        const float* pw = p.in[I_pool_w] + ((size_t)l * 256 + rc) * 64;
        const float* ps = p.in[I_pool_scale] + l * 256 + 64 * g;
        const float* wb = p.in[I_w_br_pool] + ((size_t)l * 256 + 64 * g) * D + n;
        float a = 0.f;
#pragma unroll 16
        for (int e = 0; e < 64; ++e) a += pw[e] * ps[e] * wb[(size_t)e * D];
        ((bf16_t*)(ws + WS_WBR))[(size_t)l * D * D + (size_t)n * D + 512 + rc] = (bf16_t)f2bf(a);
    }
    for (int i = F.gtid; i < 2 * 4 * 128 * 128; i += F.ngt) ((bf16_t*)(ws + WS_SGUW))[i] = (bf16_t)f2bf(p.in[I_sgu_w][i]);
    for (int i = F.gtid; i < 64 * 16; i += F.ngt) {
        const int pos = i >> 4, fi = i & 15;
        const float inv = powf(10000.0f, -(float)fi / 16.0f);
        const float ang = (float)pos * inv;
        ((f32x2*)(ws + WS_ROPE))[i] = (f32x2){cosf(ang), sinf(ang)};
    }
    convert_tables(p, F);
    {
        float* MOD = (float*)(ws + WS_MOD);
        LAS float* scd = (LAS float*)F.lds;
        LAS float* red = scd + 9 * D;
        __syncthreads();
        { float tc[18];
#pragma unroll
          for (int it = 0; it < 18; ++it) { const int e = F.tid + it * NTHREADS, r = e >> 10, k = e & 1023; tc[it] = (r < 8) ? p.in[I_c][r * D + k] : p.in[I_c_ctx][k]; }
#pragma unroll
          for (int it = 0; it < 18; ++it) scd[F.tid + it * NTHREADS] = silu_(tc[it]); }
        __syncthreads();
        for (int it = F.bid; it < 2 * 96; it += F.nb) {
            const int cgp = it % 96, l = it / 96, col = cgp * 64 + F.lane;
            float acc[9];
#pragma unroll
            for (int r = 0; r < 9; ++r) acc[r] = 0.f;
            const float* wp = p.in[I_w_mod] + ((size_t)l * D + F.wave * 128) * NMOD + col;
#pragma unroll 16
            for (int k = 0; k < 128; ++k) {
                const float w = wp[(size_t)k * NMOD];
#pragma unroll
                for (int r = 0; r < 9; ++r) acc[r] += scd[r * D + F.wave * 128 + k] * w;
            }
#pragma unroll
            for (int r = 0; r < 9; ++r) red[(F.wave * 9 + r) * 64 + F.lane] = acc[r];
            __syncthreads();
            for (int e = F.tid; e < 9 * 64; e += NTHREADS) {
                const int r = e >> 6, ln = e & 63; float s = p.in[I_b_mod][l * NMOD + cgp * 64 + ln];
#pragma unroll
                for (int w = 0; w < 8; ++w) s += red[(w * 9 + r) * 64 + ln];
                MOD[((size_t)l * 9 + r) * NMOD + cgp * 64 + ln] = s;
            }
            __syncthreads();
        }
    }
}

DI const float* mod_vec(const Params& p, int l, int row, int j) {
    const int r = row < TL ? row / SEQ : 8;
    return (const float*)(p.ws + WS_MOD) + ((size_t)l * 9 + r) * NMOD + j * D;
}
DI float* xrow_ptr(const Params& p, int row) { return row < TL ? p.out + (size_t)row * D : (float*)(p.ws + WS_XCTX) + (size_t)(row - TL) * D; }
DI const float* xin_ptr(const Params& p, int row) { return row < TL ? p.in[I_x] + (size_t)row * D : p.in[I_ctx] + (size_t)(row - TL) * D; }

DI void modulate_row_wave(const float* src, const float* g, const float* sh, const float* sc, bf16_t* dst, int lane, unsigned char* h8 = nullptr, float* hs = nullptr) {
    f32x4 v[4]; float ss = 0.f;
#pragma unroll
    for (int j = 0; j < 4; ++j) { v[j] = ((const f32x4*)src)[lane + 64 * j]; ss += v[j].x * v[j].x + v[j].y * v[j].y + v[j].z * v[j].z + v[j].w * v[j].w; }
    const float rinv = rsqrtf(wave_sum(ss) * (1.0f / D) + EPS);
    float am = 0.f;
#pragma unroll
    for (int j = 0; j < 4; ++j) {
        const f32x4 gg = ((const f32x4*)g)[lane + 64 * j], s1 = ((const f32x4*)sh)[lane + 64 * j], s2 = ((const f32x4*)sc)[lane + 64 * j];
        const f32x4 o = v[j] * rinv * gg * (s2 + 1.0f) + s1;
        u32x2 w; w.x = pk2(o.x, o.y); w.y = pk2(o.z, o.w);
        ((u32x2*)dst)[lane + 64 * j] = w;
        v[j] = o; am = fmaxf(am, fmaxf(fmaxf(fabsf(o.x), fabsf(o.y)), fmaxf(fabsf(o.z), fabsf(o.w))));
    }
    if (h8) {
#pragma unroll
        for (int o = 1; o < 64; o <<= 1) am = fmaxf(am, __shfl_xor(am, o));
        const float scl = (am > 0.f) ? exp2f(floorf(log2f(224.0f / am))) : 1.0f;
#pragma unroll
        for (int j = 0; j < 4; ++j) { int w = 0; w = __builtin_amdgcn_cvt_pk_fp8_f32(v[j].x * scl, v[j].y * scl, w, false); w = __builtin_amdgcn_cvt_pk_fp8_f32(v[j].z * scl, v[j].w * scl, w, true);
            ((unsigned*)h8)[lane + 64 * j] = (unsigned)w; }
        if (lane == 0) *hs = 1.0f / scl;
    }
}

DI void phase_norm(const Params& p, const Frame& F, int l, int which  , bool from_input, int nrows) {
    const float* g = (which == 0 ? p.in[I_g_mix] : p.in[I_g_ffn]) + l * D;
    const int lane = F.lane;
    f32x4 gg[4];
#pragma unroll
    for (int j = 0; j < 4; ++j) gg[j] = ((const f32x4*)g)[lane + 64 * j];
    for (int row0 = 2 * F.gw; row0 < nrows; row0 += 2 * F.ngw) {
        f32x4 v[2][4], s1[2][4], s2[2][4];
#pragma unroll
        for (int u = 0; u < 2; ++u) {
            const int row = row0 + u;
            const float* src = from_input ? xin_ptr(p, row) : xrow_ptr(p, row);
            const float* sh = mod_vec(p, l, row, which * 3 + 0); const float* sc = mod_vec(p, l, row, which * 3 + 1);
#pragma unroll
            for (int j = 0; j < 4; ++j) { v[u][j] = ((const f32x4*)src)[lane + 64 * j]; s1[u][j] = ((const f32x4*)sh)[lane + 64 * j]; s2[u][j] = ((const f32x4*)sc)[lane + 64 * j]; }
        }
#pragma unroll
        for (int u = 0; u < 2; ++u) {
            float ss = 0.f;
#pragma unroll
            for (int j = 0; j < 4; ++j) ss += v[u][j].x * v[u][j].x + v[u][j].y * v[u][j].y + v[u][j].z * v[u][j].z + v[u][j].w * v[u][j].w;
            const float rinv = rsqrtf(wave_sum(ss) * (1.0f / D) + EPS);
            bf16_t* dst = (bf16_t*)(p.ws + WS_H) + (size_t)(row0 + u) * D;
#pragma unroll
            for (int j = 0; j < 4; ++j) {
                const f32x4 o = v[u][j] * rinv * gg[j] * (s2[u][j] + 1.0f) + s1[u][j];
                u32x2 w; w.x = pk2(o.x, o.y); w.y = pk2(o.z, o.w);
                ((u32x2*)dst)[lane + 64 * j] = w;
            }
        }
    }
}
DI void phase_final(const Params& p, const Frame& F) {
    f32x4 gg[4];
#pragma unroll
    for (int j = 0; j < 4; ++j) gg[j] = ((const f32x4*)p.in[I_g_final])[F.lane + 64 * j];
    for (int row0 = 2 * F.gw; row0 < TL; row0 += 2 * F.ngw) {
        f32x4 v[2][4];
#pragma unroll
        for (int u = 0; u < 2; ++u)
#pragma unroll
            for (int j = 0; j < 4; ++j) v[u][j] = ((const f32x4*)(p.out + (size_t)(row0 + u) * D))[F.lane + 64 * j];
#pragma unroll
        for (int u = 0; u < 2; ++u) {
            float ss = 0.f;
#pragma unroll
            for (int j = 0; j < 4; ++j) ss += v[u][j].x * v[u][j].x + v[u][j].y * v[u][j].y + v[u][j].z * v[u][j].z + v[u][j].w * v[u][j].w;
            const float rinv = rsqrtf(wave_sum(ss) * (1.0f / D) + EPS);
            f32x4* xr = (f32x4*)(p.out + (size_t)(row0 + u) * D);
#pragma unroll
            for (int j = 0; j < 4; ++j) xr[F.lane + 64 * j] = v[u][j] * rinv * gg[j];
        }
    }
}

DI void g1_epilogue(const Params& p, int l, const f32x16& acc, int row0, int col0, int lane) {
    const int h = lane >> 5, w = lane & 31, col = col0 + w;
    bf16_t* P = (bf16_t*)(p.ws + WS_P);
    if (col0 < VOFF) {
        const float sc = (col0 < KOFF) ? QSCALE : 1.0f;
        const int axis = (col0 >> 5) & 1, fi = w & 15;
        const f32x2* tab = (const f32x2*)(p.ws + WS_ROPE);
#pragma unroll
        for (int r = 0; r < 16; ++r) {
            const int row = row0 + crow(r, h);
            const float own = acc[r], oth = __shfl_xor(own, 16);
            float o = own;
            if (row < TL) {
                const int t = row & (SEQ - 1), pos = axis ? (t & 63) : (t >> 6);
                const f32x2 cs = tab[pos * 16 + fi];
                o = (w < 16) ? (own * cs.x - oth * cs.y) : (own * cs.x + oth * cs.y);
            }
            P[(size_t)row * PW + col] = (bf16_t)f2bf(o * sc);
        }
    } else if (col0 < POOLOFF) {
        const int hk = (col - VOFF) >> 6, d = (col - VOFF) & 63;
#pragma unroll
        for (int r = 0; r < 16; ++r) {
            const int row = row0 + crow(r, h);
            const bf16_t v = (bf16_t)f2bf(acc[r]);
            if (row < TL) { const int b = row / SEQ, t = row & (SEQ - 1); ((bf16_t*)(p.ws + WS_VT))[((size_t)(b * 2 + hk) * 64 + d) * VTS + t] = v; }
            else { const int rc = row - TL, b = rc / NCTX, j = rc & (NCTX - 1); ((bf16_t*)(p.ws + WS_VTC))[((size_t)(b * 2 + hk) * 64 + d) * NCTX + j] = v; }
        }
    } else if (col0 < SUOFF) {
#pragma unroll
        for (int r = 0; r < 16; ++r) { const int row = row0 + crow(r, h); P[(size_t)row * PW + col] = (bf16_t)f2bf(acc[r]); }
    } else if (col0 < SVOFF) {
#pragma unroll
        for (int r = 0; r < 16; ++r) { const int row = row0 + crow(r, h); P[(size_t)row * PW + col] = (bf16_t)f2bf(gelu_tanh(acc[r])); }
    } else {
        const int c = col - SVOFF;
#pragma unroll
        for (int r = 0; r < 16; ++r) { const int row = row0 + crow(r, h); const int chunk = row >> 7, q = row & 127;
            ((bf16_t*)(p.ws + WS_VST))[((size_t)chunk * 256 + c) * 128 + q] = (bf16_t)f2bf(gelu_tanh(acc[r])); }
    }
}

DI void g1_simple(const Params& p, const Frame& F, int l, int row_lo, int nrows, int ct_lo, int nct) {
    const bf16_t* H = (const bf16_t*)(p.ws + WS_H);
    const bf16_t* W = (const bf16_t*)(p.ws + WS_WIN) + (size_t)l * INW * D;
    const int nit = (nrows / 64) * nct;
    for (int it = F.gw; it < nit; it += F.ngw) {
        const int mt = it / nct, nt = ct_lo + it % nct, m0 = row_lo + mt * 64;
        f32x16 acc[2][1]; zero_acc(acc);
        wave_gemm<2, 1>(H, D, W, D, D, m0, nt * 32, acc, F.lane);
#pragma unroll 1
        for (int i = 0; i < 2; ++i) g1_epilogue(p, l, i == 0 ? acc[0][0] : acc[1][0], m0 + 32 * i, nt * 32, F.lane);
    }
}

DI float lane_xor32(float v, bool hi) { const auto r = __builtin_amdgcn_permlane32_swap(__builtin_bit_cast(unsigned, v), __builtin_bit_cast(unsigned, v), false, false);
    return __builtin_bit_cast(float, hi ? r[0] : r[1]); }
struct EpiG1 {
    DI bool keeps(const pg8::Unit&) const { return false; }
    static constexpr bool PERM = true;
    unsigned char* ws;
    DI void operator()(const f32x4 (&acc)[2][2][4][2], const pg8::Unit& u, int wr, int wc, int fr, int fq) const {
        bf16_t* P = (bf16_t*)(ws + WS_P);
        const int rbase = u.pm * 256 + wr * 64 + fr;
        const bool hi = fq >= 2;
#pragma unroll
        for (int ai = 0; ai < 2; ++ai) {
            f32x4 cs[4][4];
            const bool lat = u.pm < TL / 256;
            if (u.pn < 3 && lat) {
#pragma unroll
                for (int m = 0; m < 4; ++m) {
                    const int t = (rbase + 128 * ai + 16 * m) & (SEQ - 1), pos = (wc & 1) ? (t & 63) : (t >> 6);
                    const f32x4* tab = (const f32x4*)(ws + WS_ROPE) + (pos * 16 + 8 * (fq & 1)) / 2;
#pragma unroll
                    for (int j2 = 0; j2 < 4; ++j2) cs[m][j2] = tab[j2];
                }
            }
#pragma unroll
            for (int m = 0; m < 4; ++m) {
                const int row = rbase + 128 * ai + 16 * m;
#pragma unroll
                for (int bj = 0; bj < 2; ++bj) {
                    const int c0 = u.pn * 256 + 128 * bj + 32 * wc + 8 * fq;
                    float v[8];
#pragma unroll
                    for (int j = 0; j < 4; ++j) { v[j] = acc[ai][bj][m][0][j]; v[4 + j] = acc[ai][bj][m][1][j]; }
                    if (c0 < VOFF) {
                        const float sc = (c0 < KOFF) ? QSCALE : 1.0f;
                        u32x4 o;
#pragma unroll
                        for (int j2 = 0; j2 < 4; ++j2) {
                            const f32x4 c4 = cs[m][j2];
                            const float o0 = lane_xor32(v[2 * j2], hi), o1 = lane_xor32(v[2 * j2 + 1], hi);
                            float r0 = hi ? (v[2 * j2] * c4.x + o0 * c4.y) : (v[2 * j2] * c4.x - o0 * c4.y);
                            float r1 = hi ? (v[2 * j2 + 1] * c4.z + o1 * c4.w) : (v[2 * j2 + 1] * c4.z - o1 * c4.w);
                            if (!lat) { r0 = v[2 * j2]; r1 = v[2 * j2 + 1]; }
                            o[j2] = pk2(r0 * sc, r1 * sc);
                        }
                        *(u32x4*)(P + (size_t)row * PW + c0) = o;
                    } else if (c0 < POOLOFF) {
                        const int hk = wc >> 1, d0 = 32 * (wc & 1) + 8 * fq;
                        if (lat) { const int b = row / SEQ, t = row & (SEQ - 1);
                            bf16_t* vt = (bf16_t*)(ws + WS_VT) + ((size_t)(b * 2 + hk) * 64 + d0) * VTS + t;
#pragma unroll
                            for (int j = 0; j < 8; ++j) vt[(size_t)j * VTS] = (bf16_t)f2bf(v[j]);
                        } else { const int rc = row - TL, b = rc / NCTX, jc = rc & (NCTX - 1);
                            bf16_t* vt = (bf16_t*)(ws + WS_VTC) + ((size_t)(b * 2 + hk) * 64 + d0) * NCTX + jc;
#pragma unroll
                            for (int j = 0; j < 8; ++j) vt[(size_t)j * NCTX] = (bf16_t)f2bf(v[j]);
                        }
                    } else if (c0 < SUOFF) {
                        u32x4 o;
#pragma unroll
                        for (int j2 = 0; j2 < 4; ++j2) o[j2] = pk2(v[2 * j2], v[2 * j2 + 1]);
                        *(u32x4*)(P + (size_t)row * PW + c0) = o;
                    } else if (c0 < SVOFF) {
                        u32x4 o;
#pragma unroll
                        for (int j2 = 0; j2 < 4; ++j2) o[j2] = pk2(gelu_tanh(v[2 * j2]), gelu_tanh(v[2 * j2 + 1]));
                        *(u32x4*)(P + (size_t)row * PW + c0) = o;
                    } else {
                        const int c = c0 - SVOFF, chunk = row >> 7, q = row & 127;
                        bf16_t* vs = (bf16_t*)(ws + WS_VST) + ((size_t)chunk * 256 + c) * 128 + q;
#pragma unroll
                        for (int j = 0; j < 8; ++j) vs[j * 128] = (bf16_t)f2bf(gelu_tanh(v[j]));
                    }
                }
            }
            asm volatile("" ::: "memory");
        }
    }
};
struct SchedGrid {
    int nM, nN, G, c; const char* A; const char* B;
    int n_extra, ex_pm0, ex_pn;
    DI bool next(int i, pg8::Unit& u) const {
        const int L = i * G + c, n = nM * nN; if (L >= n + n_extra) return false;
        if (L < n) pg8::tile_of(L, nM, nN, u.pm, u.pn); else { u.pm = ex_pm0 + (L - n); u.pn = ex_pn; }
        u.sub = 0; u.nt = D / 64; u.mode = 0;
        u.a = A + (size_t)u.pm * 256 * D * 2; u.b = B + (size_t)u.pn * 256 * D * 2; return true;
    }
};

DI void phase_g1(const Params& p, const Frame& F, int l) {
    SchedGrid S{(l == 0 ? T : TL) / 256, PN / 256, F.nb, F.bid, (const char*)(p.ws + WS_H), (const char*)(p.ws + WS_WIN) + (size_t)l * INW * D * 2,
                (l == 0) ? 0 : TC / 256, TL / 256, 2};
    EpiG1 E{p.ws};
    pg8::gemm_phase(F.lds, F.tid, S, E);
}

DI bf16x8 pack8(const f32x16& x, int s) {
    u32x4 pk;
#pragma unroll
    for (int j = 0; j < 4; ++j) { f32x2 v = {x[8 * s + 2 * j], x[8 * s + 2 * j + 1]}; pk[j] = __builtin_bit_cast(unsigned, __builtin_convertvector(v, bf16x2_t)); }
    return __builtin_bit_cast(bf16x8, pk);
}

DI float lane_x32(float v, bool hi) { const auto r = __builtin_amdgcn_permlane32_swap(__builtin_bit_cast(unsigned, v), __builtin_bit_cast(unsigned, v), false, false);
    return __builtin_bit_cast(float, hi ? r[0] : r[1]); }
struct AttnFrags { bf16x8 kf[4]; s16x4 vf[2][4]; };
DI void attn_load(AttnFrags& f, const bf16_t* kptr, const bf16_t* vptr, size_t vstride_d32) {
#pragma unroll
    for (int s = 0; s < 4; ++s) f.kf[s] = *(const bf16x8*)(kptr + 16 * s);
#pragma unroll
    for (int d = 0; d < 2; ++d)
#pragma unroll
        for (int q = 0; q < 4; ++q) f.vf[d][q] = *(const s16x4*)(vptr + (size_t)d * vstride_d32 + 8 * q);
}
DI void attn_block(const bf16x8 (&qf)[4], const AttnFrags& f, int mask_mode, int kq_off, int lane, float& m, float& lpart, f32x16 (&o)[2]) {
    const int h = lane >> 5;
    f32x16 st;
#pragma unroll
    for (int r = 0; r < 16; ++r) st[r] = 0.f;
#pragma unroll
    for (int s = 0; s < 4; ++s) st = MFMA32(f.kf[s], qf[s], st);
    if (mask_mode) {
#pragma unroll
        for (int r = 0; r < 16; ++r) { const int dlt = kq_off + crow(r, h); if (dlt > 128 || dlt < -128) st[r] = -1e30f; }
    }
    float bm = st[0];
#pragma unroll
    for (int r = 1; r < 16; ++r) bm = fmaxf(bm, st[r]);
    bm = fmaxf(bm, lane_x32(bm, h != 0));
    const float mn = fmaxf(m, bm);
    if (__builtin_amdgcn_ballot_w64(mn > m) != 0ull) {
        const float alpha = __builtin_amdgcn_exp2f(m - mn);
        lpart *= alpha;
#pragma unroll
        for (int d = 0; d < 2; ++d)
#pragma unroll
            for (int r = 0; r < 16; ++r) o[d][r] *= alpha;
        m = mn;
    }
    float ps = 0.f;
#pragma unroll
    for (int r = 0; r < 16; ++r) { st[r] = __builtin_amdgcn_exp2f(st[r] - m); ps += st[r]; }
    lpart += ps;
    const bf16x8 pf0 = pack8(st, 0), pf1 = pack8(st, 1);
#pragma unroll
    for (int d = 0; d < 2; ++d) {
        const bf16x8 v0 = __builtin_shufflevector(f.vf[d][0], f.vf[d][1], 0, 1, 2, 3, 4, 5, 6, 7), v1 = __builtin_shufflevector(f.vf[d][2], f.vf[d][3], 0, 1, 2, 3, 4, 5, 6, 7);
        o[d] = MFMA32(v0, pf0, o[d]);
        o[d] = MFMA32(v1, pf1, o[d]);
    }
}

DI void attn_task(const Params& p, int l, int task, int lane) {
    const int r = lane & 31, h = lane >> 5;
    const bf16_t* P = (const bf16_t*)(p.ws + WS_P);
    const bf16_t* VT = (const bf16_t*)(p.ws + WS_VT);
    const bf16_t* VTC = (const bf16_t*)(p.ws + WS_VTC);
    bf16_t* Y = (bf16_t*)(p.ws + WS_Y);
    const bool latent = task < 8192;
    int b, head, qb, q0row, p0;
    if (latent) { qb = task & 127; head = (task >> 7) & 7; b = task >> 10; p0 = qb * 32; q0row = b * SEQ + p0; }
    else { const int t2 = task - 8192; qb = t2 & 7; head = (t2 >> 3) & 7; b = t2 >> 6; p0 = qb * 32; q0row = TL + b * NCTX + p0; }
    const int hk = head >> 2;
    bf16x8 qf[4];
#pragma unroll
    for (int s = 0; s < 4; ++s) qf[s] = *(const bf16x8*)(P + (size_t)(q0row + r) * PW + head * 64 + 16 * s + 8 * h);
    float m = p.in[I_attn_sink][l * 8 + head] * LOG2E, lpart = (h == 0) ? 1.0f : 0.0f;
    f32x16 o[2];
#pragma unroll
    for (int d = 0; d < 2; ++d)
#pragma unroll
        for (int i = 0; i < 16; ++i) o[d][i] = 0.f;
    const int kb_lo = max(p0 - 128, 0), kb_hi = min(p0 + 128, SEQ - 32);
    const int nwin = latent ? ((kb_hi - kb_lo) >> 5) + 1 : 0, nblk = nwin + 8;
    const bf16_t* kwin = P + (size_t)(b * SEQ + r) * PW + KOFF + hk * 64 + 8 * h;
    const bf16_t* vwin = VT + ((size_t)(b * 2 + hk) * 64 + r) * VTS + 4 * h;
    const bf16_t* kctx = P + (size_t)(TL + b * NCTX + r) * PW + KOFF + hk * 64 + 8 * h;
    const bf16_t* vctx = VTC + ((size_t)(b * 2 + hk) * 64 + r) * NCTX + 4 * h;
    AttnFrags f0, f1, f2;
#define ATT_LOAD(F_, jj) do { const int j_ = min((jj), nblk - 1); \
        if (j_ < nwin) { const int kb_ = kb_lo + 32 * j_; attn_load(F_, kwin + (size_t)kb_ * PW, vwin + kb_, (size_t)32 * VTS); } \
        else { const int kb_ = 32 * (j_ - nwin); attn_load(F_, kctx + (size_t)kb_ * PW, vctx + kb_, (size_t)32 * NCTX); } } while (0)
#define ATT_COMP(F_, jj) do { const int j_ = (jj); if (j_ < nblk) { int mm_ = 0, kq_ = 0; \
        if (j_ < nwin) { const int kb_ = kb_lo + 32 * j_; mm_ = (kb_ == p0 - 128 || kb_ == p0 + 128) ? 1 : 0; kq_ = kb_ - (p0 + r); } \
        attn_block(qf, F_, mm_, kq_, lane, m, lpart, o); } } while (0)
    ATT_LOAD(f0, 0); ATT_LOAD(f1, 1);
#pragma unroll 1
    for (int j = 0; j < nblk; j += 3) {
        ATT_LOAD(f2, j + 2); ATT_COMP(f0, j);
        ATT_LOAD(f0, j + 3); ATT_COMP(f1, j + 1);
        ATT_LOAD(f1, j + 4); ATT_COMP(f2, j + 2);
    }
#undef ATT_LOAD
#undef ATT_COMP
    const float inv = 1.0f / (lpart + lane_x32(lpart, h != 0));
    bf16_t* yrow = Y + (size_t)(q0row + r) * D + head * 64;
#pragma unroll
    for (int d = 0; d < 2; ++d)
#pragma unroll
        for (int g = 0; g < 4; ++g) {
            u32x2 w; w.x = pk2(o[d][4 * g] * inv, o[d][4 * g + 1] * inv); w.y = pk2(o[d][4 * g + 2] * inv, o[d][4 * g + 3] * inv);
            *(u32x2*)(yrow + 32 * d + 8 * g + 4 * h) = w;
        }
}

constexpr int AKP = 144, AVWP = 648, AVCP = 520;
constexpr int ALDS_KW = 0, ALDS_VW = ALDS_KW + 320 * AKP, ALDS_KC = ALDS_VW + 64 * AVWP, ALDS_VC = ALDS_KC + 256 * AKP, ALDS_END = ALDS_VC + 64 * AVCP;
static_assert(ALDS_END <= LDS_BAR_OFF && (ALDS_VW % 16) == 0 && (ALDS_KC % 16) == 0 && (ALDS_VC % 8) == 0, "attention LDS map");
DI void attn_lds_frags(AttnFrags& f, const LAS unsigned char* kp, const LAS unsigned char* vp, int vpitch32) {
#pragma unroll
    for (int s = 0; s < 4; ++s) f.kf[s] = *(const LAS bf16x8*)(kp + 32 * s);
#pragma unroll
    for (int d = 0; d < 2; ++d)
#pragma unroll
        for (int q = 0; q < 4; ++q) f.vf[d][q] = *(const LAS s16x4*)(vp + d * vpitch32 + 16 * q);
}
DI void attn_unit(const Params& p, const Frame& F, int l, int unit) {
    const int lane = F.lane, r = lane & 31, h = lane >> 5, tid = F.tid;
    const bf16_t* P = (const bf16_t*)(p.ws + WS_P);
    const bf16_t* VT = (const bf16_t*)(p.ws + WS_VT);
    const bf16_t* VTC = (const bf16_t*)(p.ws + WS_VTC);
    bf16_t* Y = (bf16_t*)(p.ws + WS_Y);
    const bool latent = unit < 1024;
    int b, hk, p0, q0row;
    if (latent) { const int pb = unit & 63; hk = (unit >> 6) & 1; b = unit >> 7; p0 = pb * 64; q0row = b * SEQ + p0; }
    else { const int u2 = unit - 1024, pb = u2 & 3; hk = (u2 >> 2) & 1; b = u2 >> 3; p0 = pb * 64; q0row = TL + b * NCTX + p0; }
    const int w0 = p0 - 128;
    u32x4 kw[5], vw[5], kc[4], vc[4];
    if (latent) {
#pragma unroll
        for (int it = 0; it < 5; ++it) {
            const int i = tid + it * NTHREADS, row = i >> 3, ck = i & 7, pos = min(max(w0 + row, 0), SEQ - 1);
            kw[it] = *(const u32x4*)(P + (size_t)(b * SEQ + pos) * PW + KOFF + hk * 64 + 8 * ck);
            const int d = i / 40, cv = i % 40, pv = min(max(w0 + 8 * cv, 0), SEQ - 8);
            vw[it] = *(const u32x4*)(VT + ((size_t)(b * 2 + hk) * 64 + d) * VTS + pv);
        }
    }
#pragma unroll
    for (int it = 0; it < 4; ++it) {
        const int i = tid + it * NTHREADS;
        kc[it] = *(const u32x4*)(P + (size_t)(TL + b * NCTX + (i >> 3)) * PW + KOFF + hk * 64 + 8 * (i & 7));
        vc[it] = *(const u32x4*)(VTC + ((size_t)(b * 2 + hk) * 64 + (i >> 5)) * NCTX + 8 * (i & 31));
    }
    __syncthreads();
    if (latent) {
#pragma unroll
        for (int it = 0; it < 5; ++it) {
            const int i = tid + it * NTHREADS, row = i >> 3, ck = i & 7;
            *(LAS u32x4*)(F.lds + ALDS_KW + row * AKP + 16 * ck) = kw[it];
            const int d = i / 40, cv = i % 40;
            LAS u32x2* dst = (LAS u32x2*)(F.lds + ALDS_VW + d * AVWP + 16 * cv); dst[0] = (u32x2){vw[it].x, vw[it].y}; dst[1] = (u32x2){vw[it].z, vw[it].w};
        }
    }
#pragma unroll
    for (int it = 0; it < 4; ++it) {
        const int i = tid + it * NTHREADS;
        *(LAS u32x4*)(F.lds + ALDS_KC + (i >> 3) * AKP + 16 * (i & 7)) = kc[it];
        LAS u32x2* dst = (LAS u32x2*)(F.lds + ALDS_VC + (i >> 5) * AVCP + 16 * (i & 31)); dst[0] = (u32x2){vc[it].x, vc[it].y}; dst[1] = (u32x2){vc[it].z, vc[it].w};
    }
    const int head = 4 * hk + (F.wave & 3), ph = F.wave >> 2, pw = p0 + 32 * ph, qrow = q0row + 32 * ph;
    bf16x8 qf[4];
#pragma unroll
    for (int s = 0; s < 4; ++s) qf[s] = *(const bf16x8*)(P + (size_t)(qrow + r) * PW + head * 64 + 16 * s + 8 * h);
    float m = p.in[I_attn_sink][l * 8 + head] * LOG2E, lpart = (h == 0) ? 1.0f : 0.0f;
    f32x16 o[2];
#pragma unroll
    for (int d = 0; d < 2; ++d)
#pragma unroll
        for (int i = 0; i < 16; ++i) o[d][i] = 0.f;
    __syncthreads();
    if (latent) {
#pragma unroll 1
        for (int j = 0; j < 9; ++j) {
            const int kb = pw - 128 + 32 * j;
            if (kb < 0 || kb >= SEQ) continue;
            const int krow = kb - w0;
            AttnFrags f;
            attn_lds_frags(f, F.lds + ALDS_KW + (krow + r) * AKP + 16 * h, F.lds + ALDS_VW + r * AVWP + 2 * krow + 8 * h, 32 * AVWP);
            attn_block(qf, f, (j == 0 || j == 8) ? 1 : 0, kb - (pw + r), lane, m, lpart, o);
        }
    }
#pragma unroll 1
    for (int j = 0; j < 8; ++j) {
        AttnFrags f;
        attn_lds_frags(f, F.lds + ALDS_KC + (32 * j + r) * AKP + 16 * h, F.lds + ALDS_VC + r * AVCP + 64 * j + 8 * h, 32 * AVCP);
        attn_block(qf, f, 0, 0, lane, m, lpart, o);
    }
    const float inv = 1.0f / (lpart + lane_x32(lpart, h != 0));
    bf16_t* yrow = Y + (size_t)(qrow + r) * D + head * 64;
#pragma unroll
    for (int d = 0; d < 2; ++d)
#pragma unroll
        for (int g = 0; g < 4; ++g) {
            u32x2 w; w.x = pk2(o[d][4 * g] * inv, o[d][4 * g + 1] * inv); w.y = pk2(o[d][4 * g + 2] * inv, o[d][4 * g + 3] * inv);
            *(u32x2*)(yrow + 32 * d + 8 * g + 4 * h) = w;
        }
}

DI void sgu_unit(const Params& p, const Frame& F, int l, int chunk) {
    constexpr int VS = 136;
    LAS float* part = (LAS float*)F.lds;
    LAS float* rq = part + 512;
    LAS bf16_t* vnT = (LAS bf16_t*)(F.lds + 4096);
    const bf16_t* VsT = (const bf16_t*)(p.ws + WS_VST) + (size_t)chunk * 256 * 128;
    const bf16_t* P = (const bf16_t*)(p.ws + WS_P);
    bf16_t* Y = (bf16_t*)(p.ws + WS_Y);
    __syncthreads();
    { const int q = F.tid & 127, part_i = F.tid >> 7; float ss = 0.f;
#pragma unroll 16
        for (int c = part_i * 64; c < part_i * 64 + 64; ++c) { const float v = bf2f(VsT[c * 128 + q]); ss += v * v; }
        part[part_i * 128 + q] = ss; }
    __syncthreads();
    if (F.tid < 128) rq[F.tid] = rsqrtf((part[F.tid] + part[128 + F.tid] + part[256 + F.tid] + part[384 + F.tid]) * (1.0f / 256.0f) + EPS);
    __syncthreads();
#pragma unroll
    for (int it = 0; it < 8; ++it) {
        const int i = F.tid + it * NTHREADS;
        const int c = i >> 4, q8 = (i & 15) * 8;
        const u32x4 v = *(const u32x4*)(VsT + c * 128 + q8);
        u32x4 o;
#pragma unroll
        for (int j = 0; j < 4; ++j) o[j] = pk2(bflo(v[j]) * rq[q8 + 2 * j], bfhi(v[j]) * rq[q8 + 2 * j + 1]);
        *(LAS u32x4*)(vnT + c * VS + q8) = o;
    }
    __syncthreads();
    const int lane = F.lane, r = lane & 31, h = lane >> 5, g = F.wave >> 1, ph = F.wave & 1;
    const bf16_t* Wg = (const bf16_t*)(p.ws + WS_SGUW) + ((size_t)l * 4 + g) * 128 * 128;
#pragma unroll 1
    for (int pb = 0; pb < 2; ++pb) {
        const int p0 = 64 * ph + 32 * pb;
        const int row = chunk * 128 + p0 + r;
        bf16x8 wf[8];
#pragma unroll
        for (int s = 0; s < 8; ++s) wf[s] = *(const bf16x8*)(Wg + (size_t)(p0 + r) * 128 + 16 * s + 8 * h);
        u32x2 uu[2][4];
#pragma unroll
        for (int cb = 0; cb < 2; ++cb)
#pragma unroll
            for (int q4 = 0; q4 < 4; ++q4) uu[cb][q4] = *(const u32x2*)(P + (size_t)row * PW + SUOFF + 64 * g + 32 * cb + 8 * q4 + 4 * h);
        const float bias = p.in[I_sgu_b][(l * 4 + g) * 128 + p0 + r];
#pragma unroll
        for (int cb = 0; cb < 2; ++cb) {
            const int c0 = 64 * g + 32 * cb;
            f32x16 acc;
#pragma unroll
            for (int i = 0; i < 16; ++i) acc[i] = 0.f;
#pragma unroll
            for (int s = 0; s < 8; ++s) {
                const bf16x8 a = *(const LAS bf16x8*)(vnT + (c0 + r) * VS + 16 * s + 8 * h);
                acc = MFMA32(a, wf[s], acc);
            }
#pragma unroll
            for (int q4 = 0; q4 < 4; ++q4) {
                const int cc = c0 + 8 * q4 + 4 * h;
                const u32x2 u = uu[cb][q4];
                u32x2 w;
                w.x = pk2(bflo(u.x) * (acc[4 * q4] + bias), bfhi(u.x) * (acc[4 * q4 + 1] + bias));
                w.y = pk2(bflo(u.y) * (acc[4 * q4 + 2] + bias), bfhi(u.y) * (acc[4 * q4 + 3] + bias));
                *(u32x2*)(Y + (size_t)row * D + 768 + cc) = w;
            }
        }
    }
}

DI void phase_mix(const Params& p, const Frame& F, int l, int ctr_slot = 0) {
    (void)ctr_slot;
    const int nrows = (l == 0) ? T : TL;
    const bf16_t* P = (const bf16_t*)(p.ws + WS_P);
    bf16_t* Y = (bf16_t*)(p.ws + WS_Y);
    for (int i0 = F.bid * NTHREADS; i0 < 4 * nrows * 8; i0 += F.nb * NTHREADS) {
        const int i = i0 + F.tid, g = i / (nrows * 8), rem = i - g * (nrows * 8), row = rem >> 3, ck = g * 8 + (rem & 7);
        int base, t, len;
        if (row < TL) { base = row & ~(SEQ - 1); t = row & (SEQ - 1); len = SEQ; } else { const int rc = row - TL; base = TL + (rc & ~(NCTX - 1)); t = rc & (NCTX - 1); len = NCTX; }
        float s[8];
#pragma unroll
        for (int j = 0; j < 8; ++j) s[j] = 0.f;
        const bf16_t* zc = P + POOLOFF + ck * 8;
#define POOL_WIN(HALF) do { _Pragma("unroll") for (int dt = -(HALF); dt < (HALF); ++dt) { const int tt = t + dt; const bool ok = tt >= 0 && tt < len; \
            const u32x4 v = *(const u32x4*)(zc + (size_t)(base + (ok ? tt : t)) * PW); const float w = ok ? 1.f : 0.f; \
            _Pragma("unroll") for (int j = 0; j < 4; ++j) { s[2 * j] += w * bflo(v[j]); s[2 * j + 1] += w * bfhi(v[j]); } } } while (0)
        int half;
        if (g == 0) { POOL_WIN(1); half = 1; } else if (g == 1) { POOL_WIN(2); half = 2; } else if (g == 2) { POOL_WIN(4); half = 4; } else { POOL_WIN(8); half = 8; }
#undef POOL_WIN
        const int lo = max(t - half, 0), hi = min(t + half, len);
        const float inv = 1.0f / (float)(hi - lo);
        const u32x4 z = *(const u32x4*)(zc + (size_t)row * PW);
        u32x4 o;
#pragma unroll
        for (int j = 0; j < 4; ++j) o[j] = pk2(s[2 * j] * inv - bflo(z[j]), s[2 * j + 1] * inv - bfhi(z[j]));
        *(u32x4*)(Y + (size_t)row * D + 512 + ck * 8) = o;
    }
    const int nchunk = (l == 0) ? T / 128 : TL / 128;
    for (int ch = F.bid; ch < nchunk; ch += F.nb) sgu_unit(p, F, l, ch);
    const int nunit = (l == 0) ? 1024 + 64 : 1024;
    for (int u = F.nb - 1 - F.bid; u < nunit; u += F.nb) attn_unit(p, F, l, u);
}

DI void g2_simple(const Params& p, const Frame& F, int l, int row_lo, int nrows) {
    const bf16_t* H = (const bf16_t*)(p.ws + WS_H);
    const bf16_t* Yb = (const bf16_t*)(p.ws + WS_Y);
    const bf16_t* Wg = (const bf16_t*)(p.ws + WS_WIN) + (size_t)l * INW * D + (size_t)GATEOFF * D;
    const bf16_t* Wb = (const bf16_t*)(p.ws + WS_WBR) + (size_t)l * D * D;
    bf16_t* M = (bf16_t*)(p.ws + WS_MERGED);
    const int nit = (nrows / 64) * (D / 32);
    for (int it = F.gw; it < nit; it += F.ngw) {
        const int mt = it / (D / 32), nt = it % (D / 32), m0 = row_lo + mt * 64, n0 = nt * 32;
        f32x16 tot[2][1]; zero_acc(tot);
#pragma unroll 1
        for (int i = 0; i < 3; ++i) {
            const int koff = (i == 0) ? 0 : (i == 1 ? 512 : 768), kk = (i == 0) ? 512 : 256;
            f32x16 g[2][1], pr[2][1]; zero_acc(g); zero_acc(pr);
            wave_gemm<2, 1>(H, D, Wg + (size_t)i * D * D, D, D, m0, n0, g, F.lane);
            wave_gemm<2, 1>(Yb + koff, D, Wb + koff, D, kk, m0, n0, pr, F.lane);
#pragma unroll
            for (int a = 0; a < 2; ++a)
#pragma unroll
                for (int r = 0; r < 16; ++r) tot[a][0][r] += sigmoidf_(g[a][0][r]) * pr[a][0][r];
        }
        const int h = F.lane >> 5, col = n0 + (F.lane & 31);
#pragma unroll
        for (int a = 0; a < 2; ++a)
#pragma unroll
            for (int r = 0; r < 16; ++r) M[(size_t)(m0 + 32 * a + crow(r, h)) * D + col] = (bf16_t)f2bf(tot[a][0][r]);
    }
}
struct SchedG2 {
    int G, c; const char *H, *Y, *Wg, *Wb; int npair;
    DI void fill(pg8::Unit& u, int sub, int br) const {
        u.sub = sub;
        if ((sub & 1) == 0) { u.nt = 16; u.a = H + (size_t)u.pm * 256 * D * 2; u.b = Wg + ((size_t)br * D + u.pn * 256) * D * 2; }
        else { const int koff = (br == 0) ? 0 : (br == 1 ? 512 : 768); u.nt = (br == 0) ? 8 : 4;
               u.a = Y + ((size_t)u.pm * 256 * D + koff) * 2; u.b = Wb + ((size_t)u.pn * 256 * D + koff) * 2; }
    }
    DI bool next(int i, pg8::Unit& u) const {
        constexpr int NLAT = (TL / 256) * 4;
        const int nl = (NLAT - c + G - 1) / G;
        if (i < 6 * nl) { const int tile = (i / 6) * G + c, sub = i % 6; pg8::tile_of(tile, TL / 256, 4, u.pm, u.pn); u.mode = 0; fill(u, sub, sub >> 1); return true; }
        const int e = i - 6 * nl, j = (e >> 1) * G + c;
        if (j >= npair) return false;
        const int ctile = j / 3, br = j % 3;
        u.pm = TL / 256 + (ctile >> 2); u.pn = ctile & 3; u.mode = 1 + br; fill(u, e & 1, br); return true;
    }
};
struct EpiG2 {
    static constexpr bool PERM = true;
    bf16_t* scr; bf16_t* M; bf16_t* MP;
    DI bool keeps(const pg8::Unit& u) const { return (u.sub & 1) == 0; }
    DI void operator()(f32x4 (&acc)[2][2][4][2], const pg8::Unit& u, int wr, int wc, int fr, int fq) const {
        const bool gate = (u.sub & 1) == 0, first = u.sub == 0 && gate;
        bf16_t* Mo = (u.mode == 0) ? M + (size_t)u.pm * 256 * D : MP + ((size_t)(u.mode - 1) * TC + (size_t)(u.pm - TL / 256) * 256) * D;
#pragma unroll
        for (int ai = 0; ai < 2; ++ai) {
            u32x4 ld[4][2];
            if (!first) {
#pragma unroll
                for (int m = 0; m < 4; ++m)
#pragma unroll
                    for (int bj = 0; bj < 2; ++bj) {
                        const int rl = 128 * ai + 64 * wr + 16 * m + fr, cl = 128 * bj + 32 * wc + 8 * fq;
                        ld[m][bj] = gate ? *(const u32x4*)(Mo + (size_t)rl * D + u.pn * 256 + cl) : *(const u32x4*)(scr + rl * 256 + cl);
                    }
            }
#pragma unroll
            for (int m = 0; m < 4; ++m)
#pragma unroll
                for (int bj = 0; bj < 2; ++bj) {
                    const int rl = 128 * ai + 64 * wr + 16 * m + fr, cl = 128 * bj + 32 * wc + 8 * fq;
                    if (gate) {
                        u32x4 o;
#pragma unroll
                        for (int j2 = 0; j2 < 4; ++j2) {
                            const int n = j2 >> 1, e = 2 * (j2 & 1);
                            const unsigned w = pk2(fmaxf(sigmoidf_(acc[ai][bj][m][n][e]), 1e-20f), fmaxf(sigmoidf_(acc[ai][bj][m][n][e + 1]), 1e-20f));
                            o[j2] = w;
                            const float t0 = first ? 0.f : bflo(ld[m][bj][j2]), t1 = first ? 0.f : bfhi(ld[m][bj][j2]);
                            acc[ai][bj][m][n][e] = t0 * __builtin_amdgcn_rcpf(bflo(w)); acc[ai][bj][m][n][e + 1] = t1 * __builtin_amdgcn_rcpf(bfhi(w));
                        }
                        *(u32x4*)(scr + rl * 256 + cl) = o;
                    } else {
                        u32x4 w;
#pragma unroll
                        for (int j2 = 0; j2 < 4; ++j2) { const int n = j2 >> 1, e = 2 * (j2 & 1);
                            w[j2] = pk2(acc[ai][bj][m][n][e] * bflo(ld[m][bj][j2]), acc[ai][bj][m][n][e + 1] * bfhi(ld[m][bj][j2])); }
                        *(u32x4*)(Mo + (size_t)rl * D + u.pn * 256 + cl) = w;
                    }
                }
            asm volatile("" ::: "memory");
        }
    }
};
DI void phase_g2(const Params& p, const Frame& F, int l) {
    SchedG2 S{F.nb, F.bid, (const char*)(p.ws + WS_H), (const char*)(p.ws + WS_Y),
              (const char*)(p.ws + WS_WIN) + ((size_t)l * INW + GATEOFF) * D * 2, (const char*)(p.ws + WS_WBR) + (size_t)l * D * D * 2, (l == 0) ? (TC / 256) * 4 * 3 : 0};
    EpiG2 E{(bf16_t*)(p.ws + WS_IDX) + (size_t)F.bid * 65536, (bf16_t*)(p.ws + WS_MERGED), (bf16_t*)(p.ws + WS_MP)};
    pg8::gemm_phase(F.lds, F.tid, S, E);
}
DI void phase_g2sum(const Params& p, const Frame& F) {
    const u32x4* mp = (const u32x4*)(p.ws + WS_MP);
    u32x4* mo = (u32x4*)((bf16_t*)(p.ws + WS_MERGED) + (size_t)TL * D);
    constexpr int NV = TC * D / 8;
    for (int i = F.gtid; i < NV; i += F.ngt) {
        const u32x4 a = mp[i], b = mp[NV + i], c = mp[2 * NV + i];
        u32x4 o;
#pragma unroll
        for (int j = 0; j < 4; ++j) o[j] = pk2(bflo(a[j]) + bflo(b[j]) + bflo(c[j]), bfhi(a[j]) + bfhi(b[j]) + bfhi(c[j]));
        mo[i] = o;
    }
}

DI void g3_simple(const Params& p, const Frame& F, int l, int row_lo, int nrows) {
    const bf16_t* M = (const bf16_t*)(p.ws + WS_MERGED);
    const bf16_t* W = (const bf16_t*)(p.ws + WS_WOUT) + (size_t)l * D * D;
    const int nit = (nrows / 64) * (D / 64);
    for (int it = F.gw; it < nit; it += F.ngw) {
        const int mt = it / (D / 64), nt = it % (D / 64), m0 = row_lo + mt * 64, n0 = nt * 64;
        f32x16 acc[2][2]; zero_acc(acc);
        wave_gemm<2, 2>(M, D, W, D, D, m0, n0, acc, F.lane);
        const int h = F.lane >> 5;
#pragma unroll
        for (int a = 0; a < 2; ++a)
#pragma unroll
            for (int j = 0; j < 2; ++j) {
                const int col = n0 + 32 * j + (F.lane & 31);
#pragma unroll
                for (int r = 0; r < 16; ++r) {
                    const int row = m0 + 32 * a + crow(r, h);
                    const float xs = (l == 0) ? xin_ptr(p, row)[col] : xrow_ptr(p, row)[col];
                    xrow_ptr(p, row)[col] = xs + mod_vec(p, l, row, 2)[col] * acc[a][j][r];
                }
            }
    }
}
struct EpiG3 {
    DI bool keeps(const pg8::Unit&) const { return false; }
    static constexpr bool PERM = false;
    const float* xsrc; float* xdst; const float* csrc; float* cdst; const float* mod;
    DI void operator()(const f32x4 (&acc)[2][2][4][2], const pg8::Unit& u, int wr, int wc, int fr, int fq) const {
        const int col0 = u.pn * 256 + wc * 32 + 4 * fq;
        const bool lat = u.pm < TL / 256;
        const float* gt = mod + (size_t)(lat ? (u.pm >> 4) : 8) * NMOD + 2 * D;
        const float* xs = lat ? xsrc + (size_t)u.pm * 256 * D : csrc + (size_t)(u.pm - TL / 256) * 256 * D;
        float* xd = lat ? xdst + (size_t)u.pm * 256 * D : cdst + (size_t)(u.pm - TL / 256) * 256 * D;
        f32x4 gv[2][2];
#pragma unroll
        for (int bj = 0; bj < 2; ++bj)
#pragma unroll
            for (int n = 0; n < 2; ++n) gv[bj][n] = *(const f32x4*)(gt + col0 + 128 * bj + 16 * n);
#pragma unroll
        for (int ai = 0; ai < 2; ++ai) {
            f32x4 xv[4][2][2];
#pragma unroll
            for (int m = 0; m < 4; ++m)
#pragma unroll
                for (int bj = 0; bj < 2; ++bj)
#pragma unroll
                    for (int n = 0; n < 2; ++n) xv[m][bj][n] = *(const f32x4*)(xs + (size_t)(wr * 64 + fr + 128 * ai + 16 * m) * D + col0 + 128 * bj + 16 * n);
#pragma unroll
            for (int m = 0; m < 4; ++m)
#pragma unroll
                for (int bj = 0; bj < 2; ++bj)
#pragma unroll
                    for (int n = 0; n < 2; ++n)
                        *(f32x4*)(xd + (size_t)(wr * 64 + fr + 128 * ai + 16 * m) * D + col0 + 128 * bj + 16 * n) = xv[m][bj][n] + gv[bj][n] * acc[ai][bj][m][n];
            asm volatile("" ::: "memory");
        }
    }
};
DI void phase_g3(const Params& p, const Frame& F, int l) {
    SchedGrid S{(l == 0 ? T : TL) / 256, D / 256, F.nb, F.bid, (const char*)(p.ws + WS_MERGED), (const char*)(p.ws + WS_WOUT) + (size_t)l * D * D * 2, 0, 0, 0};
    float* xc = (float*)(p.ws + WS_XCTX);
    EpiG3 E{(l == 0) ? p.in[I_x] : p.out, p.out, (l == 0) ? p.in[I_ctx] : xc, xc, (const float*)(p.ws + WS_MOD) + (size_t)l * 9 * NMOD};
    pg8::gemm_phase(F.lds, F.tid, S, E);
}

DI void g45_simple(const Params& p, const Frame& F, int l, int row_lo, int nrows) {
    const bf16_t* H = (const bf16_t*)(p.ws + WS_H);
    const bf16_t* W = (const bf16_t*)(p.ws + WS_WFOLD) + (size_t)l * 2048 * D;
    _Float16* ST = (_Float16*)(p.ws + WS_ST);
    const int nit = (2048 / 64) * (nrows / 64);
    for (int it = F.gw; it < nit; it += F.ngw) {
        const int nt = it / 32, mt = it % 32, m0 = mt * 64, n0 = row_lo + nt * 64;
        f32x16 acc[2][2]; zero_acc(acc);
        wave_gemm<2, 2>(W, D, H, D, D, m0, n0, acc, F.lane);
        const int h = F.lane >> 5;
#pragma unroll
        for (int a = 0; a < 2; ++a)
#pragma unroll
            for (int j = 0; j < 2; ++j)
#pragma unroll
                for (int r = 0; r < 16; ++r) ST[(size_t)(m0 + 32 * a + crow(r, h)) * T + n0 + 32 * j + (F.lane & 31)] = (_Float16)acc[a][j][r];
    }
}
struct EpiG45 {
    DI bool keeps(const pg8::Unit&) const { return false; }
    static constexpr bool PERM = true;
    unsigned short* ST;
    DI void operator()(const f32x4 (&acc)[2][2][4][2], const pg8::Unit& u, int wr, int wc, int fr, int fq) const {
        const int col0 = u.pn * 256 + wc * 32 + 8 * fq;
#pragma unroll
        for (int ai = 0; ai < 2; ++ai)
#pragma unroll
            for (int m = 0; m < 4; ++m) {
                unsigned short* rowp = ST + (size_t)(u.pm * 256 + wr * 64 + fr + 128 * ai + 16 * m) * T + col0;
#pragma unroll
                for (int bj = 0; bj < 2; ++bj) {
                    u32x4 w;
                    w.x = pkh2(acc[ai][bj][m][0][0], acc[ai][bj][m][0][1]); w.y = pkh2(acc[ai][bj][m][0][2], acc[ai][bj][m][0][3]);
                    w.z = pkh2(acc[ai][bj][m][1][0], acc[ai][bj][m][1][1]); w.w = pkh2(acc[ai][bj][m][1][2], acc[ai][bj][m][1][3]);
                    *(u32x4*)(rowp + 128 * bj) = w;
                }
            }
    }
};
DI void phase_g45(const Params& p, const Frame& F, int l) {
    SchedGrid S{2048 / 256, (l == 0 ? T : TL) / 256, F.nb, F.bid, (const char*)(p.ws + WS_WFOLD) + (size_t)l * 2048 * D * 2, (const char*)(p.ws + WS_H), 0, 0, 0};
    EpiG45 E{(unsigned short*)(p.ws + WS_ST)};
    pg8::gemm_phase(F.lds, F.tid, S, E);
}

DI unsigned fkey(float f) { const unsigned u = __builtin_bit_cast(unsigned, f); return (u & 0x80000000u) ? ~u : (u | 0x80000000u); }
DI float fkey_inv(unsigned k) { const unsigned u = (k & 0x80000000u) ? (k & 0x7fffffffu) : ~k; return __builtin_bit_cast(float, u); }
#define INSERT16(L, x) do { unsigned x_ = (x); _Pragma("unroll") for (int k_ = 0; k_ < 16; ++k_) { const unsigned hi_ = max(L[k_], x_); x_ = min(L[k_], x_); L[k_] = hi_; } } while (0)
#define CEX(a, b) do { const unsigned hi_ = max(a, b), lo_ = min(a, b); a = hi_; b = lo_; } while (0)
DI void sort16_desc(unsigned (&v)[16]) {
#pragma unroll
    for (int k = 2; k <= 16; k <<= 1)
#pragma unroll
        for (int j = k >> 1; j > 0; j >>= 1)
#pragma unroll
            for (int i = 0; i < 16; ++i) {
                const int q = i ^ j;
                if (q > i) { if ((i & k) == 0) CEX(v[i], v[q]); else CEX(v[q], v[i]); }
            }
}
DI void merge16_desc(unsigned (&L)[16], const unsigned (&N)[16]) {
#pragma unroll
    for (int i = 0; i < 16; ++i) L[i] = max(L[i], N[15 - i]);
#pragma unroll
    for (int j = 8; j > 0; j >>= 1)
#pragma unroll
        for (int i = 0; i < 16; ++i) { const int q = i ^ j; if (q > i) CEX(L[i], L[q]); }
}
DI void phase_sel(const Params& p, const Frame& F, int l) {
    const _Float16* ST = (const _Float16*)(p.ws + WS_ST);
    unsigned short* IDX = (unsigned short*)(p.ws + WS_IDX);
    float* GW = (float*)(p.ws + WS_GW);
    float* SU = (float*)(p.ws + WS_SU);
    const float* TSC = (const float*)(p.ws + WS_TSCALE) + (size_t)l * 2 * NEXP;
    LAS unsigned char* ib = (LAS unsigned char*)F.lds;
    const int ntok = (l == 0) ? T : TL;
    for (int i0 = F.bid * NTHREADS; i0 < ntok * 8; i0 += F.nb * NTHREADS) {
        const int i = i0 + F.tid;
        const int tok = i % ntok, head = i / ntok;
        unsigned la[16], lb[16];
#pragma unroll
        for (int k = 0; k < 16; ++k) { la[k] = 0u; lb[k] = 0u; }
        const _Float16* s0 = ST + (size_t)(head * 256) * T + tok;
#define SEL_LOAD(B_, k0_) do { _Pragma("unroll") for (int j = 0; j < 32; ++j) B_[j] = s0[(size_t)((k0_) + j) * T]; } while (0)
#define SEL_INS(L_, B_, k0_) do { _Pragma("unroll") for (int h_ = 0; h_ < 2; ++h_) { unsigned nk_[16]; \
        _Pragma("unroll") for (int j = 0; j < 16; ++j) nk_[j] = (fkey((float)B_[16 * h_ + j]) & ~127u) | (unsigned)(127 - (((k0_) + 16 * h_ + j) & 127)); \
        sort16_desc(nk_); merge16_desc(L_, nk_); } } while (0)
        _Float16 bufa[32], bufb[32];
        SEL_LOAD(bufa, 0);
        SEL_LOAD(bufb, 32);  SEL_INS(la, bufa, 0);
        SEL_LOAD(bufa, 64);  SEL_INS(la, bufb, 32);
        SEL_LOAD(bufb, 96);  SEL_INS(la, bufa, 64);
        SEL_LOAD(bufa, 128); SEL_INS(la, bufb, 96);
        SEL_LOAD(bufb, 160); SEL_INS(lb, bufa, 128);
        SEL_LOAD(bufa, 192); SEL_INS(lb, bufb, 160);
        SEL_LOAD(bufb, 224); SEL_INS(lb, bufa, 192);
        SEL_INS(lb, bufb, 224);
#undef SEL_LOAD
#undef SEL_INS
        float va[16], vb[16];
#pragma unroll
        for (int k = 0; k < 16; ++k) {
            va[k] = fkey_inv(la[k] & ~127u); vb[k] = fkey_inv(lb[k] & ~127u);
            ib[k * NTHREADS + F.tid] = (unsigned char)(127u - (la[k] & 127u));
            ib[(16 + k) * NTHREADS + F.tid] = (unsigned char)(127u - (lb[k] & 127u));
        }
        unsigned lc[16];
#pragma unroll
        for (int k = 0; k < 16; ++k) lc[k] = 0u;
#pragma unroll
        for (int a = 0; a < 16; ++a)
#pragma unroll
            for (int b = 0; b < 16; ++b)
                if ((a + 1) * (b + 1) <= 16) { const unsigned key = (fkey(va[a] + vb[b]) & ~255u) | (unsigned)(255 - (a * 16 + b)); INSERT16(lc, key); }
        float e[16], sum = 0.f; const float v0 = fkey_inv(lc[0] & ~255u);
#pragma unroll
        for (int k = 0; k < 16; ++k) { e[k] = __expf(fkey_inv(lc[k] & ~255u) - v0); sum += e[k]; }
        const float inv = 1.0f / sum;
        asm volatile("s_waitcnt lgkmcnt(0)" ::: "memory");
#pragma unroll
        for (int k = 0; k < 16; ++k) {
            const unsigned pos = 255u - (lc[k] & 255u), a = pos >> 4, b = pos & 15u;
            const unsigned ea = ib[a * NTHREADS + F.tid], eb = ib[(16 + b) * NTHREADS + F.tid];
            const unsigned ex = ea * 128u + eb;
            IDX[(size_t)tok * 128 + head * 16 + k] = (unsigned short)ex;
            GW[(size_t)tok * 128 + head * 16 + k] = e[k] * inv * TSC[NEXP + ex];
            SU[(size_t)tok * 128 + head * 16 + k] = TSC[ex];
        }
        asm volatile("s_waitcnt lgkmcnt(0)" ::: "memory");
    }
}

DI float dpp_xor1(float v) { return __builtin_bit_cast(float, __builtin_amdgcn_mov_dpp(__builtin_bit_cast(int, v), 0xB1, 0xF, 0xF, true)); }
DI float dpp_xor2(float v) { return __builtin_bit_cast(float, __builtin_amdgcn_mov_dpp(__builtin_bit_cast(int, v), 0x4E, 0xF, 0xF, true)); }
DI float dpp_hmir(float v) { return __builtin_bit_cast(float, __builtin_amdgcn_mov_dpp(__builtin_bit_cast(int, v), 0x141, 0xF, 0xF, true)); }
DI float dot16_fp8(const u32x4 q, const float (&hx)[16]) {
    f32x2 a = {0.f, 0.f};
#pragma unroll
    for (int j = 0; j < 4; ++j) {
        const f32x2 lo = __builtin_amdgcn_cvt_pk_f32_fp8((int)q[j], false), hi = __builtin_amdgcn_cvt_pk_f32_fp8((int)q[j], true);
        a += lo * (f32x2){hx[4 * j], hx[4 * j + 1]}; a += hi * (f32x2){hx[4 * j + 2], hx[4 * j + 3]};
    }
    return a.x + a.y;
}
#define PEER_EXPERT(id, i) ((int)(((id)[(i) >> 3][((i) >> 1) & 3] >> (16 * ((i) & 1))) & 0xffffu))

struct PeerURows { u32x4 q[16]; u32x4 h0, h1; };
DI void peer_u_rows(PeerURows& R, const u32x4 (&id)[2], const unsigned char* ut, const bf16_t* hrow) {
    R.h0 = *(const u32x4*)(hrow); R.h1 = *(const u32x4*)(hrow + 8);
#pragma unroll
    for (int i = 0; i < 16; ++i) R.q[i] = *(const u32x4*)(ut + (size_t)PEER_EXPERT(id, i) * D);
}
DI void peer_u_compute(const PeerURows& R, float* part, int lane) {
    float hx[16];
#pragma unroll
    for (int j = 0; j < 4; ++j) { hx[2 * j] = bflo(R.h0[j]); hx[2 * j + 1] = bfhi(R.h0[j]); hx[8 + 2 * j] = bflo(R.h1[j]); hx[8 + 2 * j + 1] = bfhi(R.h1[j]); }
    float d[16];
#pragma unroll
    for (int i = 0; i < 16; ++i) d[i] = dot16_fp8(R.q[i], hx);
    const bool b2 = (lane & 4) != 0, b1 = (lane & 2) != 0, b0 = (lane & 1) != 0;
    float k8[8];
#pragma unroll
    for (int i = 0; i < 8; ++i) { const float keep = b2 ? d[8 + i] : d[i], send = b2 ? d[i] : d[8 + i]; k8[i] = keep + dpp_hmir(send); }
    float k4[4];
#pragma unroll
    for (int i = 0; i < 4; ++i) { const float keep = b1 ? k8[4 + i] : k8[i], send = b1 ? k8[i] : k8[4 + i]; k4[i] = keep + dpp_xor2(send); }
    f32x2 k2;
    { const float keep0 = b0 ? k4[2] : k4[0], send0 = b0 ? k4[0] : k4[2], keep1 = b0 ? k4[3] : k4[1], send1 = b0 ? k4[1] : k4[3];
      k2.x = keep0 + dpp_xor1(send0); k2.y = keep1 + dpp_xor1(send1); }
    *(f32x2*)(part + 16 * (lane >> 3) + (b2 ? 8 : 0) + (b1 ? 4 : 0) + (b0 ? 2 : 0)) = k2;
}
DI void phase_peer_u(const Params& p, const Frame& F, int l) {
    const int ntok = (l == 0) ? T : TL, lane = F.lane;
    const int slice = F.bid & 7, sw = (F.bid >> 3) * NWAVES + F.wave, nsw = (F.nb >> 3) * NWAVES;
    const unsigned char* ut = p.ws + WS_UTAB + (size_t)l * NEXP * D + 128 * slice + 16 * (lane & 7);
    const bf16_t* Hs = (const bf16_t*)(p.ws + WS_H) + 128 * slice + 16 * (lane & 7);
    const unsigned short* IDXg = (const unsigned short*)(p.ws + WS_IDX) + 16 * (lane >> 3);
    float* PART = (float*)(p.ws + WS_ST) + (size_t)slice * T * 128;
    const int last = ntok - 1;
    u32x4 sa[2], sb[2]; PeerURows ra, rb;
#define U_SEL(S_, t_) do { const unsigned short* ip_ = IDXg + (size_t)min((t_), last) * 128; S_[0] = *(const u32x4*)ip_; S_[1] = *(const u32x4*)(ip_ + 8); } while (0)
#define U_ROWS(R_, S_, t_) peer_u_rows(R_, S_, ut, Hs + (size_t)min((t_), last) * D)
    U_SEL(sa, sw); U_SEL(sb, sw + nsw);
    U_ROWS(ra, sa, sw);
#pragma unroll 1
    for (int tok = sw; tok < ntok; tok += 2 * nsw) {
        U_SEL(sa, tok + 2 * nsw); U_ROWS(rb, sb, tok + nsw);
        peer_u_compute(ra, PART + (size_t)tok * 128, lane);
        U_SEL(sb, tok + 3 * nsw); U_ROWS(ra, sa, tok + 2 * nsw);
        if (tok + nsw < ntok) peer_u_compute(rb, PART + (size_t)(tok + nsw) * 128, lane);
    }
#undef U_SEL
#undef U_ROWS
}
DI void phase_peer_c(const Params& p, const Frame& F, int l, bool dummy = false) {
    const int ntok = (l == 0) ? T : TL;
    const float* PART = (const float*)(p.ws + WS_ST);
    float* GW = (float*)(p.ws + WS_GW);
    float* CO = dummy ? (float*)(p.ws + WS_H8) : GW;
    const float* SU = (const float*)(p.ws + WS_SU);
    for (int i0 = F.gtid; i0 < ntok * 128; i0 += 4 * F.ngt) {
        float s[4], gw[4], su[4];
#pragma unroll
        for (int u = 0; u < 4; ++u) {
            const int i = min(i0 + u * F.ngt, ntok * 128 - 1);
            s[u] = 0.f;
#pragma unroll
            for (int sl = 0; sl < 8; ++sl) s[u] += PART[(size_t)sl * T * 128 + i];
            gw[u] = GW[i]; su[u] = SU[i];
        }
#pragma unroll
        for (int u = 0; u < 4; ++u) { const int i = i0 + u * F.ngt; if (i < ntok * 128) CO[i] = gw[u] * gelu_tanh(s[u] * su[u]); }
    }
}
struct PeerVRows { u32x4 q[16]; f32x4 cf[4]; f32x2 xv, gv; };
DI void peer_v_rows(PeerVRows& R, const u32x4 (&id)[2], const unsigned char* vt, const float* cp, const float* xs, const float* gt2) {
    R.cf[0] = *(const f32x4*)cp; R.cf[1] = *(const f32x4*)(cp + 4); R.cf[2] = *(const f32x4*)(cp + 8); R.cf[3] = *(const f32x4*)(cp + 12);
    R.xv = *(const f32x2*)xs; R.gv = *(const f32x2*)gt2;
#pragma unroll
    for (int i = 0; i < 16; ++i) R.q[i] = *(const u32x4*)(vt + (size_t)PEER_EXPERT(id, i) * D);
}
DI float xchg32(float v, bool hi) { const auto r = __builtin_amdgcn_permlane32_swap(__builtin_bit_cast(unsigned, v), __builtin_bit_cast(unsigned, v), false, false);
    return __builtin_bit_cast(float, hi ? r[0] : r[1]); }
DI float xchg16(float v, bool hi) { const auto r = __builtin_amdgcn_permlane16_swap(__builtin_bit_cast(unsigned, v), __builtin_bit_cast(unsigned, v), false, false);
    return __builtin_bit_cast(float, hi ? r[0] : r[1]); }
DI float xchg8(float v) { return __builtin_bit_cast(float, __builtin_amdgcn_mov_dpp(__builtin_bit_cast(int, v), 0x128, 0xF, 0xF, true)); }
DI void peer_v_compute(const PeerVRows& R, float* xdst, int lane) {
    f32x2 a[8];
#pragma unroll
    for (int j = 0; j < 8; ++j) a[j] = (f32x2){0.f, 0.f};
#pragma unroll
    for (int i = 0; i < 16; ++i) {
        const float c = R.cf[i >> 2][i & 3]; const f32x2 c2 = {c, c};
#pragma unroll
        for (int j = 0; j < 4; ++j) {
            a[2 * j] += c2 * __builtin_amdgcn_cvt_pk_f32_fp8((int)R.q[i][j], false);
            a[2 * j + 1] += c2 * __builtin_amdgcn_cvt_pk_f32_fp8((int)R.q[i][j], true);
        }
    }
    const bool b5 = (lane & 32) != 0, b4 = (lane & 16) != 0, b3 = (lane & 8) != 0;
    f32x2 k4[4];
#pragma unroll
    for (int j = 0; j < 4; ++j) { const f32x2 keep = b5 ? a[4 + j] : a[j], send = b5 ? a[j] : a[4 + j];
        k4[j] = keep + (f32x2){xchg32(send.x, b5), xchg32(send.y, b5)}; }
    f32x2 k2[2];
#pragma unroll
    for (int j = 0; j < 2; ++j) { const f32x2 keep = b4 ? k4[2 + j] : k4[j], send = b4 ? k4[j] : k4[2 + j];
        k2[j] = keep + (f32x2){xchg16(send.x, b4), xchg16(send.y, b4)}; }
    f32x2 k1;
    { const f32x2 keep = b3 ? k2[1] : k2[0], send = b3 ? k2[0] : k2[1];
        k1 = keep + (f32x2){xchg8(send.x), xchg8(send.y)}; }
    *(f32x2*)xdst = R.xv + R.gv * k1;
}
DI void phase_peer_v(const Params& p, const Frame& F, int l, bool dummy = false) {
    const int ntok = (l == 0) ? T : TL, lane = F.lane;
    const int slice = F.bid & 7, sw = (F.bid >> 3) * NWAVES + F.wave, nsw = (F.nb >> 3) * NWAVES;
    const unsigned char* vt = p.ws + WS_VTAB + (size_t)l * NEXP * D + 128 * slice + 16 * (lane & 7);
    const unsigned short* IDXg = (const unsigned short*)(p.ws + WS_IDX) + 16 * (lane >> 3);
    const float* CFg = (const float*)(p.ws + WS_GW) + 16 * (lane >> 3);
    const int last = ntok - 1;
    u32x4 sa[2], sb[2]; PeerVRows ra, rb;
#define V_SEL(S_, t_) do { const unsigned short* ip_ = IDXg + (size_t)min((t_), last) * 128; S_[0] = *(const u32x4*)ip_; S_[1] = *(const u32x4*)(ip_ + 8); } while (0)
    const int co = 128 * slice + 16 * (lane & 7) + ((lane & 32) ? 8 : 0) + ((lane & 16) ? 4 : 0) + ((lane & 8) ? 2 : 0);
#define V_ROWS(R_, S_, t_) do { const int t1_ = min((t_), last); peer_v_rows(R_, S_, vt, CFg + (size_t)t1_ * 128, xrow_ptr(p, t1_) + co, mod_vec(p, l, t1_, 5) + co); } while (0)
#define V_DO(R_, t_) do { const int t2_ = (t_); float* xd_ = (dummy ? (float*)(p.ws + WS_ST) + (size_t)t2_ * D : xrow_ptr(p, t2_)) + co; peer_v_compute(R_, xd_, lane); } while (0)
    V_SEL(sa, sw); V_SEL(sb, sw + nsw);
    V_ROWS(ra, sa, sw);
#pragma unroll 1
    for (int tok = sw; tok < ntok; tok += 2 * nsw) {
        V_SEL(sa, tok + 2 * nsw); V_ROWS(rb, sb, tok + nsw);
        V_DO(ra, tok);
        V_SEL(sb, tok + 3 * nsw); V_ROWS(ra, sa, tok + 2 * nsw);
        if (tok + nsw < ntok) V_DO(rb, tok + nsw);
    }
#undef V_SEL
#undef V_ROWS
#undef V_DO
}

#define XB_TMO      128
#define XB_XCNT(j)  (256  + 64 * (j))
#define XB_XSUB(j)  (1280 + 64 * (j))
#define XB_XGEN(j)  (2304 + 64 * (j))
#define XB_TOP      3328
#define XB_TOPGEN   3392
#define XCD_BAR_WORDS 3456
#define XB_SPIN_CAP (1u << 18)
DI unsigned xb_ld(unsigned* p)              { return __hip_atomic_load(p, __ATOMIC_RELAXED, __HIP_MEMORY_SCOPE_AGENT); }
DI unsigned xb_add(unsigned* p, unsigned v) { return __hip_atomic_fetch_add(p, v, __ATOMIC_RELAXED, __HIP_MEMORY_SCOPE_AGENT); }
DI unsigned xb_xcc_id() { return (unsigned)__builtin_amdgcn_s_getreg((3 << 11) | 20) & 0xFu; }
#define XB_SPIN(cond, bar) do { unsigned _sp = 0; while (cond) { __builtin_amdgcn_s_sleep(1); \
    if ((++_sp & 255u) == 0u) { if (xb_ld(&(bar)[XB_TMO])) break; if (_sp > XB_SPIN_CAP) { atomicAdd(&(bar)[XB_TMO], 1u); break; } } } } while (0)
struct XcdBarrier { unsigned* bar; unsigned x; volatile LAS unsigned* st; };
DI XcdBarrier xcd_barrier_post(unsigned* bar, volatile LAS unsigned* st) {
    XcdBarrier b; b.bar = bar; b.x = xb_xcc_id(); b.st = st;
    if (threadIdx.x == 0) (void)xb_add(&bar[XB_XCNT(b.x)], 1u);
    return b;
}
DI void xcd_barrier_complete(unsigned* bar, unsigned x, unsigned& nloc, unsigned& nx) {
    const unsigned G = gridDim.x * gridDim.y * gridDim.z;
    unsigned sum, cnt, mine, sp = 0u;
    for (;;) {
        sum = 0u; cnt = 0u; mine = 0u;
#pragma unroll
        for (unsigned j = 0; j < 16; ++j) { const unsigned c = xb_ld(&bar[XB_XCNT(j)]); sum += c; cnt += (c > 0u) ? 1u : 0u; mine = (j == x) ? c : mine; }
        if (sum == G) break;
        __builtin_amdgcn_s_sleep(1);
        if ((++sp & 255u) == 0u) { if (xb_ld(&bar[XB_TMO])) break; if (sp > XB_SPIN_CAP) { atomicAdd(&bar[XB_TMO], 1u); break; } }
    }
    nloc = mine > 0u ? mine : 1u; nx = cnt > 0u ? cnt : 1u;
}
DI void xcd_barrier(const XcdBarrier& b) {
    asm volatile("s_waitcnt vmcnt(0)" ::: "memory");
    __syncthreads();
    if (threadIdx.x == 0) {
        unsigned* bar = b.bar;
        __builtin_amdgcn_s_waitcnt(0);
        unsigned nloc = b.st[0], nx = b.st[1];
        if (nloc == 0u) { xcd_barrier_complete(bar, b.x, nloc, nx); b.st[0] = nloc; b.st[1] = nx; }
        const unsigned old = xb_add(&bar[XB_XSUB(b.x)], 1u);
        const unsigned gen = old / nloc;
        if (old + 1u == (gen + 1u) * nloc) {
            __builtin_amdgcn_fence(__ATOMIC_RELEASE, "agent");
            asm volatile("s_waitcnt vmcnt(0)" ::: "memory");
            const unsigned og = xb_add(&bar[XB_TOP], 1u);
            const unsigned tg = og / nx;
            if (og + 1u == (tg + 1u) * nx) xb_add(&bar[XB_TOPGEN], 1u);
            else XB_SPIN(xb_ld(&bar[XB_TOPGEN]) == tg, bar);
            __builtin_amdgcn_fence(__ATOMIC_ACQUIRE, "agent");
            xb_add(&bar[XB_XGEN(b.x)], 1u);
            asm volatile("s_waitcnt vmcnt(0)" ::: "memory");
        } else {
            XB_SPIN(xb_ld(&bar[XB_XGEN(b.x)]) == gen, bar);
            __builtin_amdgcn_fence(__ATOMIC_ACQUIRE, "agent");
            asm volatile("s_waitcnt vmcnt(0)" ::: "memory");
        }
    }
    __syncthreads();
}

constexpr int NPHASE = 25;
template <int PH> DI void run_phase(const Params& p, const Frame& F) {
    if constexpr (PH == 0) phase_prep(p, F);
    else if constexpr (PH == 1) phase_norm(p, F, 0, 0, true, T);
    else if constexpr (PH == 2) phase_g1(p, F, 0);
    else if constexpr (PH == 3) phase_mix(p, F, 0);
    else if constexpr (PH == 4) phase_g2(p, F, 0);
    else if constexpr (PH == 5) phase_g2sum(p, F);
    else if constexpr (PH == 6) phase_g3(p, F, 0);
    else if constexpr (PH == 7) phase_norm(p, F, 0, 1, false, T);
    else if constexpr (PH == 8) phase_g45(p, F, 0);
    else if constexpr (PH == 9) phase_sel(p, F, 0);
    else if constexpr (PH == 10) phase_peer_u(p, F, 0);
    else if constexpr (PH == 11) phase_peer_c(p, F, 0);
    else if constexpr (PH == 12) phase_peer_v(p, F, 0);
    else if constexpr (PH == 13) phase_norm(p, F, 1, 0, false, T);
    else if constexpr (PH == 14) phase_g1(p, F, 1);
    else if constexpr (PH == 15) phase_mix(p, F, 1);
    else if constexpr (PH == 16) phase_g2(p, F, 1);
    else if constexpr (PH == 17) phase_g3(p, F, 1);
    else if constexpr (PH == 18) phase_norm(p, F, 1, 1, false, TL);
    else if constexpr (PH == 19) phase_g45(p, F, 1);
    else if constexpr (PH == 20) phase_sel(p, F, 1);
    else if constexpr (PH == 21) phase_peer_u(p, F, 1);
    else if constexpr (PH == 22) phase_peer_c(p, F, 1);
    else if constexpr (PH == 23) phase_peer_v(p, F, 1);
    else if constexpr (PH == 24) phase_final(p, F);
}
DI Frame make_frame(unsigned char* lds_raw) {
    Frame F;
    F.lds = (LAS unsigned char*)lds_raw;
    int tid = threadIdx.x; asm volatile("" : "+v"(tid));
    int bid = blockIdx.x, nb = gridDim.x; asm volatile("" : "+s"(bid), "+s"(nb));
    F.tid = tid; F.lane = tid & 63; F.wave = __builtin_amdgcn_readfirstlane(tid >> 6); F.bid = bid; F.nb = nb;
    F.gw = bid * NWAVES + F.wave; F.ngw = nb * NWAVES; F.gtid = bid * NTHREADS + tid; F.ngt = nb * NTHREADS;
    return F;
}
template <int PH> DI void run_phase_fresh(unsigned char* lds_raw) {
#if defined(__HIP_DEVICE_COMPILE__)
    const __attribute__((address_space(4))) unsigned long long* pp = (const __attribute__((address_space(4))) unsigned long long*)__builtin_amdgcn_kernarg_segment_ptr();
    asm volatile("" : "+s"(pp));
    Params p;
#pragma unroll
    for (int i = 0; i < N_IN; ++i) p.in[i] = (const float*)(const __attribute__((address_space(1))) float*)pp[i];
    p.out = (float*)(__attribute__((address_space(1))) float*)pp[N_IN]; p.ws = (unsigned char*)(__attribute__((address_space(1))) unsigned char*)pp[N_IN + 1]; p.ph_lo = 0; p.ph_hi = 0;
#else
    Params p{};
#endif
    const Frame F = make_frame(lds_raw);
    run_phase<PH>(p, F);
}
template <int PH> __global__ void __launch_bounds__(NTHREADS, 2) phase_kernel(Params p) {
    extern __shared__ __attribute__((aligned(16))) unsigned char lds_raw[];
    run_phase_fresh<PH>(lds_raw);
}
template <int PH> DI void run_all(unsigned char* lds_raw, cg::grid_group& grid, const XcdBarrier& bar) {
    if constexpr (PH < NPHASE) {
        if constexpr (PH == PROBE_PH) {
            if constexpr (PH == 11 || PH == 22 || PH == 12 || PH == 23) {
#if defined(__HIP_DEVICE_COMPILE__)
                const __attribute__((address_space(4))) unsigned long long* pp = (const __attribute__((address_space(4))) unsigned long long*)__builtin_amdgcn_kernarg_segment_ptr();
                asm volatile("" : "+s"(pp));
                Params p;
#pragma unroll
                for (int i = 0; i < N_IN; ++i) p.in[i] = (const float*)(const __attribute__((address_space(1))) float*)pp[i];
                p.out = (float*)(__attribute__((address_space(1))) float*)pp[N_IN]; p.ws = (unsigned char*)(__attribute__((address_space(1))) unsigned char*)pp[N_IN + 1]; p.ph_lo = 0; p.ph_hi = 0;
                const Frame F = make_frame(lds_raw);
                if constexpr (PH == 11 || PH == 22) phase_peer_c(p, F, PH == 11 ? 0 : 1, true); else phase_peer_v(p, F, PH == 12 ? 0 : 1, true);
#endif
            } else run_phase_fresh<PH>(lds_raw);
            xcd_barrier(bar);
        }
        run_phase_fresh<PH>(lds_raw);
        if constexpr (PH + 1 < NPHASE) { xcd_barrier(bar); if constexpr (PROBE_SYNC) xcd_barrier(bar); }
        run_all<PH + 1>(lds_raw, grid, bar);
    }
}
__global__ void __launch_bounds__(NTHREADS, 2) mega(Params p) {
    extern __shared__ __attribute__((aligned(16))) unsigned char lds_raw[];
    cg::grid_group grid = cg::this_grid();
    volatile LAS unsigned* st = (volatile LAS unsigned*)((LAS unsigned char*)lds_raw + LDS_BAR_OFF);
    if (threadIdx.x < 2) st[threadIdx.x] = 0u;
    __syncthreads();
    const XcdBarrier bar = xcd_barrier_post((unsigned*)(p.ws + WS_CTL), st);
    if (p.ph_lo != 0) grid.sync();
    run_all<0>(lds_raw, grid, bar);
}

extern "C" void kernel_launch(void* const* d_in, const int* in_sizes, int n_in, void* d_out, int out_size, void* d_ws, size_t ws_size, hipStream_t stream) {
    static int grid = 0;
    if (grid == 0) {
        if (n_in != 23 || out_size != TL * D || ws_size < WS_END) { fprintf(stderr, "kernel_launch: unexpected shapes (n_in %d out %d ws %zu)\n", n_in, out_size, ws_size); grid = -1; return; }
        int dev = 0, cus = 0, per_cu = 0;
        (void)hipGetDevice(&dev);
        (void)hipDeviceGetAttribute(&cus, hipDeviceAttributeMultiprocessorCount, dev);
        (void)hipFuncSetAttribute((const void*)mega, hipFuncAttributeMaxDynamicSharedMemorySize, LDS_BYTES);
        (void)hipOccupancyMaxActiveBlocksPerMultiprocessor(&per_cu, (const void*)mega, NTHREADS, LDS_BYTES);
        if (per_cu < 1) { fprintf(stderr, "kernel_launch: occupancy query reports %d blocks per CU\n", per_cu); grid = -1; return; }
        grid = cus & ~7;
        if (grid < 8) { fprintf(stderr, "kernel_launch: needs at least 8 CUs\n"); grid = -1; return; }
    }
    if (grid < 0) return;
    (void)hipMemsetAsync((char*)d_ws + WS_CTL, 0, CTL_ZERO_BYTES, stream);
    Params p{};
    for (int i = 0; i < N_IN; ++i) p.in[i] = (const float*)d_in[i];
    p.out = (float*)d_out; p.ws = (unsigned char*)d_ws;
    void* args[] = {&p};
    hipError_t e = hipLaunchCooperativeKernel((const void*)mega, dim3(grid), dim3(NTHREADS), args, LDS_BYTES, stream);
    if (e != hipSuccess) fprintf(stderr, "cooperative launch failed: %s (grid %d)\n", hipGetErrorString(e), grid);
}
```

```cpp
#include <hip/hip_runtime.h>
#include <hip/hip_cooperative_groups.h>
#include <stdint.h>
#include <stdio.h>
namespace cg = cooperative_groups;

#ifndef PROBE_PH
#define PROBE_PH -1
#endif
#ifndef PROBE_SYNC
#define PROBE_SYNC 0
#endif
#ifndef MK_SINGLE
#define MK_SINGLE 0
#endif

#define LAS __attribute__((address_space(3)))
typedef unsigned short bf16_t;
typedef short bf16x8 __attribute__((ext_vector_type(8)));
typedef short s16x4 __attribute__((ext_vector_type(4)));
typedef float f32x4 __attribute__((ext_vector_type(4)));
typedef float f32x2 __attribute__((ext_vector_type(2)));
typedef float f32x16 __attribute__((ext_vector_type(16)));
typedef unsigned u32x4 __attribute__((ext_vector_type(4)));
typedef unsigned u32x2 __attribute__((ext_vector_type(2)));
typedef __bf16 bf16x2_t __attribute__((ext_vector_type(2)));
typedef _Float16 f16x2_t __attribute__((ext_vector_type(2)));
#define DI __device__ __forceinline__
DI unsigned pkh2(float lo, float hi) { f16x2_t v = {(_Float16)lo, (_Float16)hi}; return __builtin_bit_cast(unsigned, v); }
#define MFMA32(a, b, c) __builtin_amdgcn_mfma_f32_32x32x16_bf16((a), (b), (c), 0, 0, 0)

constexpr int D = 1024, NB = 8, SEQ = 4096, NCTX = 256, DEPTH = 2;
constexpr int TL = NB * SEQ, TC = NB * NCTX, T = TL + TC;
constexpr int INW = 4608, NMOD = 6 * D, PW = 1600, PN = 1536;
constexpr int VTS = SEQ + 64;
constexpr int QOFF = 0, KOFF = 512, VOFF = 640, POOLOFF = 768, SUOFF = 1024, SVOFF = 1280, GATEOFF = 1536;
constexpr int NEXP = 16384;
constexpr float EPS = 1e-6f;
constexpr float LOG2E = 1.4426950408889634f;
constexpr float QSCALE = 0.125f * LOG2E;

constexpr size_t MiB = 1u << 20;
constexpr size_t WS_CTL = 0, WS_MOD = 1 * MiB, CTL_ZERO_BYTES = 2 * MiB;
constexpr size_t WS_ROPE = 2 * MiB, WS_SGUW = 2 * MiB + 65536, WS_TSCALE = 3 * MiB;
constexpr size_t WS_WIN = 4 * MiB, WS_WBR = 22 * MiB, WS_WOUT = 26 * MiB, WS_WFOLD = 30 * MiB;
constexpr size_t WS_XCTX = 38 * MiB, WS_UTAB = 46 * MiB, WS_VTAB = 78 * MiB;
constexpr size_t WS_IDX = 110 * MiB, WS_GW = 120 * MiB;
constexpr size_t WS_H = 142 * MiB;
constexpr size_t WS_P = 210 * MiB, WS_Y = 318 * MiB, WS_MERGED = 386 * MiB, WS_VT = 454 * MiB, WS_VTC = 463 * MiB, WS_VST = 464 * MiB;
constexpr size_t WS_MP = 482 * MiB;
constexpr size_t WS_ST = 210 * MiB, WS_H8 = 346 * MiB, WS_HS = 380 * MiB, WS_SU = 482 * MiB;
constexpr size_t WS_END = 512 * MiB;
static_assert(WS_ST + (size_t)2048 * T * 2 <= WS_H8 && WS_H8 + (size_t)T * D <= WS_HS, "ST / H8 fit");
static_assert(WS_VST + (size_t)272 * 256 * 128 * 2 <= WS_SU && WS_VT + (size_t)NB * 2 * 64 * VTS * 2 <= WS_VTC, "VsT / VT fit");
static_assert(WS_H + (size_t)T * D * 2 <= WS_P, "H fits");
static_assert(WS_P + (size_t)T * PW * 2 <= WS_Y && WS_Y + (size_t)T * D * 2 <= WS_MERGED && WS_MERGED + (size_t)T * D * 2 <= WS_VT, "P/Y/MERGED fit");
static_assert(WS_IDX + (size_t)T * 128 * 2 <= WS_GW && WS_GW + (size_t)T * 128 * 4 <= WS_H && WS_SU + (size_t)T * 128 * 4 <= WS_END && WS_HS + (size_t)T * 4 <= WS_SU, "idx/gw/su fit");

constexpr int LDS_BYTES = 163840;
constexpr int LDS_BAR_OFF = LDS_BYTES - 64;
constexpr int NTHREADS = 512, NWAVES = 8;

enum { I_x, I_c, I_ctx, I_c_ctx, I_w_mod, I_b_mod, I_g_mix, I_g_ffn, I_w_in, I_attn_sink, I_pool_w, I_pool_scale, I_sgu_w, I_sgu_b, I_w_br_attn, I_w_br_pool, I_w_br_sgu, I_w_out, I_peer_wq, I_peer_subkeys, I_peer_u, I_peer_v, I_g_final, N_IN };
struct Params {
    const float* in[N_IN];
    float* out; unsigned char* ws;
    int ph_lo, ph_hi;
};

DI unsigned pk2(float lo, float hi) { f32x2 v = {lo, hi}; return __builtin_bit_cast(unsigned, __builtin_convertvector(v, bf16x2_t)); }
DI unsigned f2bf(float f) { return pk2(f, 0.f) & 0xffffu; }
DI float bf2f(unsigned short u) { return __builtin_bit_cast(float, (unsigned)u << 16); }
DI float bflo(unsigned w) { return __builtin_bit_cast(float, w << 16); }
DI float bfhi(unsigned w) { return __builtin_bit_cast(float, w & 0xffff0000u); }
DI int crow(int reg, int h) { return (reg & 3) + 8 * (reg >> 2) + 4 * h; }
DI float wave_sum(float v) {
#pragma unroll
    for (int o = 1; o < 64; o <<= 1) v += __shfl_xor(v, o);
    return v;
}
DI float sigmoidf_(float x) { return __builtin_amdgcn_rcpf(1.0f + __expf(-x)); }
DI float gelu_tanh(float x) { const float u = 0.7978845608028654f * (x + 0.044715f * x * x * x); return x * __builtin_amdgcn_rcpf(1.0f + __expf(-2.0f * u)); }
DI float silu_(float x) { return x * __builtin_amdgcn_rcpf(1.0f + __expf(-x)); }

struct Frame {
    int tid, lane, wave, gw, ngw, gtid, ngt, bid, nb;
    LAS unsigned char* lds;
};

template <int NM, int NN>
DI void wave_gemm(const bf16_t* __restrict__ A, int lda, const bf16_t* __restrict__ Bt, int ldb, int K, int m0, int n0, f32x16 (&acc)[NM][NN], int lane) {
    const int r = lane & 31, h = lane >> 5;
    const bf16_t* ap = A + (size_t)(m0 + r) * lda + 8 * h;
    const bf16_t* bp = Bt + (size_t)(n0 + r) * ldb + 8 * h;
    for (int k0 = 0; k0 < K; k0 += 64) {
        bf16x8 a[4][NM], b[4][NN];
#pragma unroll
        for (int s = 0; s < 4; ++s) {
#pragma unroll
            for (int i = 0; i < NM; ++i) a[s][i] = *(const bf16x8*)(ap + (size_t)(32 * i) * lda + k0 + 16 * s);
#pragma unroll
            for (int j = 0; j < NN; ++j) b[s][j] = *(const bf16x8*)(bp + (size_t)(32 * j) * ldb + k0 + 16 * s);
        }
#pragma unroll
        for (int s = 0; s < 4; ++s)
#pragma unroll
            for (int i = 0; i < NM; ++i)
#pragma unroll
                for (int j = 0; j < NN; ++j) acc[i][j] = MFMA32(a[s][i], b[s][j], acc[i][j]);
    }
}
template <int NM, int NN> DI void zero_acc(f32x16 (&acc)[NM][NN]) {
#pragma unroll
    for (int i = 0; i < NM; ++i)
#pragma unroll
        for (int j = 0; j < NN; ++j)
#pragma unroll
            for (int r = 0; r < 16; ++r) acc[i][j][r] = 0.f;
}

namespace pg8 {
constexpr int BM = 256, BK = 64, HALF = 128, HTB = HALF * BK * 2, STAGE_BYTES = 8 * HTB, NXCD = 8, WGM = 8, LD = 1024;
DI int lds_byte(int r, int c) { const int st = (r >> 4) * 2 + (c >> 5), rr = r & 15, cc = c & 31, ob = rr * 64 + cc * 2; return st * 1024 + (ob ^ (((ob >> 9) & 1) << 5)); }
DI void stage_rc(int b, int& R, int& C) { const int st = b / 1024, sb = b % 1024, swz = sb ^ (((sb >> 9) & 1) << 5); R = (st >> 1) * 16 + swz / 64; C = (st & 1) * 32 + (swz % 64) / 2; }
DI int perm32(int rho) { const int n = rho >> 4, i = rho & 15; return 8 * (i >> 2) + 4 * n + (i & 3); }
struct Unit { int pm, pn, sub, nt, mode; const char* a; const char* b; };
DI void tile_of(int L, int nM, int nN, int& pm, int& pn) {
    const int nwg = nM * nN; int wgid = L;
    { const int q = nwg / NXCD, r = nwg % NXCD, xcd = wgid % NXCD, off = wgid / NXCD; wgid = (xcd < r ? xcd * (q + 1) : r * (q + 1) + (xcd - r) * q) + off; }
    const int nig = WGM * nN, gid = wgid / nig, fm = gid * WGM, gsz = (nM - fm) < WGM ? (nM - fm) : WGM;
    pm = fm + ((wgid % nig) % gsz); pn = (wgid % nig) / gsz;
}
template <class Epi, class Sched>
DI void gemm_phase(LAS unsigned char* lds, const int tid, const Sched& S, const Epi& E) {
    const int wid = __builtin_amdgcn_readfirstlane(tid >> 6), lane = tid & 63, wr = wid >> 2, wc = wid & 3, fr = lane & 15, fq = lane >> 4;
    unsigned voffA[2], voffB[2];
#pragma unroll
    for (int i = 0; i < 2; ++i) { int R, C; stage_rc(tid * 16 + i * 8192, R, C); const int Rb = Epi::PERM ? ((R & ~31) + perm32(R & 31)) : R;
        voffA[i] = (unsigned)(R * LD + C) * 2u; voffB[i] = (unsigned)(Rb * LD + C) * 2u; }
    const size_t kstep = (size_t)(BK * 2);
    const size_t hstep = (size_t)HALF * LD * 2;
    const unsigned ldsw = (unsigned)wid * 1024u;
    const int aoff = lds_byte(wr * 64 + fr, fq * 8), boff = lds_byte(wc * 32 + fr, fq * 8);
#define PG8_SA(b, h) (((b) * 2 + (h)) * HTB)
#define PG8_SB(b, h) ((4 + (b) * 2 + (h)) * HTB)
#define PG8_STAGE(bufoff, gbase, voff) do { _Pragma("unroll") for (int _i = 0; _i < 2; ++_i) \
        __builtin_amdgcn_global_load_lds((const unsigned*)((const char*)(gbase) + (voff)[_i]), (LAS unsigned*)(lds + (bufoff) + ldsw + _i * 8192), 16, 0, 0); } while (0)
#define PG8_LDA(dst, b, h) do { _Pragma("unroll") for (int m = 0; m < 4; ++m) _Pragma("unroll") for (int k = 0; k < 2; ++k) dst[m][k] = *(const LAS bf16x8*)(lds + PG8_SA(b, h) + aoff + m * 2048 + k * 1024); } while (0)
#define PG8_LDB(dst, b, h) do { _Pragma("unroll") for (int n = 0; n < 2; ++n) _Pragma("unroll") for (int k = 0; k < 2; ++k) dst[n][k] = *(const LAS bf16x8*)(lds + PG8_SB(b, h) + boff + n * 2048 + k * 1024); } while (0)
#define PG8_MMA(ai, bj, At, Bt) do { __builtin_amdgcn_s_setprio(1); _Pragma("unroll") for (int m = 0; m < 4; ++m) _Pragma("unroll") for (int n = 0; n < 2; ++n) _Pragma("unroll") for (int k = 0; k < 2; ++k) \
        acc[ai][bj][m][n] = __builtin_amdgcn_mfma_f32_16x16x32_bf16(Bt[n][k], At[m][k], acc[ai][bj][m][n], 0, 0, 0); __builtin_amdgcn_s_setprio(0); } while (0)
#define PG8_WAIT_V(n) asm volatile("s_waitcnt vmcnt(" #n ")" ::: "memory")
#define PG8_WAIT_L(n) asm volatile("s_waitcnt lgkmcnt(" #n ")" ::: "memory")
#define PG8_BAR __builtin_amdgcn_s_barrier()
#define PG8_SCHED __builtin_amdgcn_sched_barrier(0)
    Unit cur, nxt; int ui = 0;
    if (!S.next(0, cur)) return;
    f32x4 acc[2][2][4][2];
#pragma unroll
    for (int a = 0; a < 2; ++a)
#pragma unroll
        for (int b = 0; b < 2; ++b)
#pragma unroll
            for (int m = 0; m < 4; ++m)
#pragma unroll
                for (int n = 0; n < 2; ++n) acc[a][b][m][n] = (f32x4){0.f, 0.f, 0.f, 0.f};
    bf16x8 At[4][2], B0[2][2], B1[2][2];
    const char* cA = cur.a; const char* cB = cur.b;
    PG8_STAGE(PG8_SB(0, 0), cB, voffB); PG8_STAGE(PG8_SB(0, 1), cB + hstep, voffB); PG8_STAGE(PG8_SA(0, 0), cA, voffA); PG8_STAGE(PG8_SA(0, 1), cA + hstep, voffA);
    if (wr == 1) PG8_BAR;
    PG8_WAIT_V(2); PG8_BAR;
    PG8_STAGE(PG8_SB(1, 0), cB + kstep, voffB); PG8_STAGE(PG8_SA(1, 0), cA + kstep, voffA); PG8_STAGE(PG8_SB(1, 1), cB + hstep + kstep, voffB);
    PG8_WAIT_V(6); PG8_BAR;
    for (;;) {
        const bool has_next = S.next(ui + 1, nxt);
        const char* nA = has_next ? nxt.a : cA; const char* nB = has_next ? nxt.b : cB;
        const int nt = cur.nt;
        for (int t = 0; t < nt; t += 2) {
            const bool last = (t == nt - 2);
            const char* a1 = cA + (size_t)(t + 1) * kstep;
            const char* a2 = last ? nA : cA + (size_t)(t + 2) * kstep; const char* b2 = last ? nB : cB + (size_t)(t + 2) * kstep;
            const char* a3 = a2 + kstep; const char* b3 = b2 + kstep;
            PG8_LDB(B0, 0, 0); PG8_LDB(B1, 0, 1); PG8_SCHED; PG8_LDA(At, 0, 0); PG8_STAGE(PG8_SA(1, 1), a1 + hstep, voffA);
            PG8_WAIT_V(8); PG8_WAIT_L(0); PG8_BAR; PG8_MMA(0, 0, At, B0); PG8_MMA(0, 1, At, B1); PG8_BAR; PG8_SCHED;
            PG8_LDA(At, 0, 1); PG8_STAGE(PG8_SB(0, 0), b2, voffB); PG8_STAGE(PG8_SB(0, 1), b2 + hstep, voffB); PG8_STAGE(PG8_SA(0, 0), a2, voffA);
            PG8_WAIT_V(8); PG8_WAIT_L(0); PG8_BAR; PG8_MMA(1, 0, At, B0); PG8_MMA(1, 1, At, B1); PG8_BAR; PG8_SCHED;
            PG8_LDB(B0, 1, 0); PG8_LDB(B1, 1, 1); PG8_SCHED; PG8_LDA(At, 1, 0); PG8_STAGE(PG8_SA(0, 1), a2 + hstep, voffA);
            PG8_WAIT_V(8); PG8_WAIT_L(0); PG8_BAR; PG8_MMA(0, 0, At, B0); PG8_MMA(0, 1, At, B1); PG8_BAR; PG8_SCHED;
            PG8_LDA(At, 1, 1); PG8_STAGE(PG8_SB(1, 0), b3, voffB); PG8_STAGE(PG8_SB(1, 1), b3 + hstep, voffB); PG8_STAGE(PG8_SA(1, 0), a3, voffA);
            PG8_WAIT_V(8); PG8_WAIT_L(0); PG8_BAR; PG8_MMA(1, 0, At, B0); PG8_MMA(1, 1, At, B1); PG8_BAR; PG8_SCHED;
        }
        if (wr == 0) PG8_BAR;
        E(acc, cur, wr, wc, fr, fq);
        if (!has_next) break;
        if (!E.keeps(cur)) {
#pragma unroll
        for (int a = 0; a < 2; ++a)
#pragma unroll
            for (int b = 0; b < 2; ++b)
#pragma unroll
                for (int m = 0; m < 4; ++m)
#pragma unroll
                    for (int n = 0; n < 2; ++n) acc[a][b][m][n] = (f32x4){0.f, 0.f, 0.f, 0.f};
        }
        cur = nxt; cA = nA; cB = nB; ++ui;
        if (wr == 1) PG8_BAR;
    }
    PG8_WAIT_V(0);
    PG8_BAR;
#undef PG8_SA
#undef PG8_SB
#undef PG8_STAGE
#undef PG8_LDA
#undef PG8_LDB
#undef PG8_MMA
#undef PG8_WAIT_V
#undef PG8_WAIT_L
#undef PG8_BAR
#undef PG8_SCHED
}
}

DI void transpose_item(const float* W, int K, int N, bf16_t* WT, int ldd, int row_off, int col_off, LAS float* scr, int item, int lane) {
    const int nblk = N / 32, kb = item / nblk, nb = item % nblk, k0 = 64 * kb, n0 = 32 * nb;
#pragma unroll 8
    for (int i = 0; i < 32; ++i) { const int kk = 2 * i + (lane >> 5); scr[kk * 33 + (lane & 31)] = W[(size_t)(k0 + kk) * N + n0 + (lane & 31)]; }
    asm volatile("s_waitcnt lgkmcnt(0)" ::: "memory");
    const int c = lane & 7;
#pragma unroll
    for (int j = 0; j < 4; ++j) { const int n = (lane >> 3) + 8 * j; const LAS float* s = scr + (8 * c) * 33 + n;
        u32x4 o; o.x = pk2(s[0 * 33], s[1 * 33]); o.y = pk2(s[2 * 33], s[3 * 33]); o.z = pk2(s[4 * 33], s[5 * 33]); o.w = pk2(s[6 * 33], s[7 * 33]);
        *(u32x4*)(WT + (size_t)(row_off + n0 + n) * ldd + col_off + k0 + 8 * c) = o; }
    asm volatile("s_waitcnt lgkmcnt(0)" ::: "memory");
}

DI void convert_tables(const Params& p, const Frame& F) {
    for (int it0 = 4 * F.gw; it0 < 4 * NEXP; it0 += 4 * F.ngw) {
        f32x4 v[4][4];
#pragma unroll
        for (int u = 0; u < 4; ++u) {
            const int it = it0 + u, e = it & (NEXP - 1), tbl = (it >> 14) & 1, l = it >> 15;
            const f32x4* src = (const f32x4*)((tbl ? p.in[I_peer_v] : p.in[I_peer_u]) + ((size_t)l * NEXP + e) * D) + 4 * F.lane;
#pragma unroll
            for (int j = 0; j < 4; ++j) v[u][j] = src[j];
        }
#pragma unroll
        for (int u = 0; u < 4; ++u) {
            const int it = it0 + u, e = it & (NEXP - 1), tbl = (it >> 14) & 1, l = it >> 15;
            float am = 0.f;
#pragma unroll
            for (int j = 0; j < 4; ++j) am = fmaxf(am, fmaxf(fmaxf(fabsf(v[u][j].x), fabsf(v[u][j].y)), fmaxf(fabsf(v[u][j].z), fabsf(v[u][j].w))));
#pragma unroll
            for (int o = 1; o < 64; o <<= 1) am = fmaxf(am, __shfl_xor(am, o));
            const float sc = (am > 0.f) ? exp2f(floorf(log2f(224.0f / am))) : 1.0f;
            u32x4 q;
#pragma unroll
            for (int j = 0; j < 4; ++j) { int w = 0; w = __builtin_amdgcn_cvt_pk_fp8_f32(v[u][j].x * sc, v[u][j].y * sc, w, false); w = __builtin_amdgcn_cvt_pk_fp8_f32(v[u][j].z * sc, v[u][j].w * sc, w, true); q[j] = (unsigned)w; }
            *(u32x4*)(p.ws + (tbl ? WS_VTAB : WS_UTAB) + ((size_t)l * NEXP + e) * D + 16 * F.lane) = q;
            if (F.lane == 0) ((float*)(p.ws + WS_TSCALE))[(l * 2 + tbl) * NEXP + e] = 1.0f / sc;
        }
    }
}

DI void phase_prep(const Params& p, const Frame& F) {
    unsigned char* ws = p.ws;
    {
        LAS float* wq = (LAS float*)F.lds;
        LAS float* skl = wq + 128 * 65;
        for (int it = F.bid; it < 2 * 16 * 16; it += F.nb) {
            const int cc = it & 15, hp = (it >> 4) & 15, l = it >> 8;
            const float* src = p.in[I_peer_wq] + (size_t)l * D * 2048 + hp * 128;
            const float* sks = p.in[I_peer_subkeys] + (size_t)(l * 16 + hp) * 128 * 128;
            __syncthreads();
            { float tw[16]; f32x4 ts[8];
#pragma unroll
              for (int it = 0; it < 16; ++it) { const int e = F.tid + it * NTHREADS, ci = e >> 7, d = e & 127; tw[it] = src[(size_t)(cc * 64 + ci) * 2048 + d]; }
#pragma unroll
              for (int it = 0; it < 8; ++it) { const int e = F.tid + it * NTHREADS, key = e >> 5, d4 = (e & 31) * 4; ts[it] = *(const f32x4*)(sks + key * 128 + d4); }
#pragma unroll
              for (int it = 0; it < 16; ++it) { const int e = F.tid + it * NTHREADS, ci = e >> 7, d = e & 127; wq[d * 65 + ci] = tw[it]; }
#pragma unroll
              for (int it = 0; it < 8; ++it) { const int e = F.tid + it * NTHREADS, key = e >> 5, d4 = (e & 31) * 4; *(LAS f32x4*)(skl + key * 132 + d4) = ts[it]; } }
            __syncthreads();
            const int ci = F.tid & 63, kg = F.tid >> 6;
            float acc[16];
#pragma unroll
            for (int k = 0; k < 16; ++k) acc[k] = 0.f;
#pragma unroll 2
            for (int d = 0; d < 128; d += 4) {
                const float w0 = wq[d * 65 + ci], w1 = wq[(d + 1) * 65 + ci], w2 = wq[(d + 2) * 65 + ci], w3 = wq[(d + 3) * 65 + ci];
#pragma unroll
                for (int k = 0; k < 16; ++k) { const f32x4 s = *(const LAS f32x4*)(skl + (16 * kg + k) * 132 + d); acc[k] += w0 * s.x + w1 * s.y + w2 * s.z + w3 * s.w; }
            }
            bf16_t* dst = (bf16_t*)(ws + WS_WFOLD) + ((size_t)l * 2048 + hp * 128 + 16 * kg) * D + cc * 64 + ci;
#pragma unroll
            for (int k = 0; k < 16; ++k) dst[(size_t)k * D] = (bf16_t)f2bf(acc[k]);
        }
        __syncthreads();
    }
    {
        LAS float* scr = (LAS float*)(F.lds + F.wave * 16384);
        constexpr int I_IN = (D / 64) * (INW / 32), I_BA = (512 / 64) * (D / 32), I_BS = (256 / 64) * (D / 32), I_O = (D / 64) * (D / 32);
        constexpr int PER_L = I_IN + I_BA + I_BS + I_O;
        for (int it = F.gw; it < 2 * PER_L; it += F.ngw) {
            const int l = it / PER_L; int r = it % PER_L;
            if (r < I_IN) { transpose_item(p.in[I_w_in] + (size_t)l * D * INW, D, INW, (bf16_t*)(ws + WS_WIN) + (size_t)l * INW * D, D, 0, 0, scr, r, F.lane); continue; } r -= I_IN;
            if (r < I_BA) { transpose_item(p.in[I_w_br_attn] + (size_t)l * 512 * D, 512, D, (bf16_t*)(ws + WS_WBR) + (size_t)l * D * D, D, 0, 0, scr, r, F.lane); continue; } r -= I_BA;
            if (r < I_BS) { transpose_item(p.in[I_w_br_sgu] + (size_t)l * 256 * D, 256, D, (bf16_t*)(ws + WS_WBR) + (size_t)l * D * D, D, 0, 768, scr, r, F.lane); continue; } r -= I_BS;
            transpose_item(p.in[I_w_out] + (size_t)l * D * D, D, D, (bf16_t*)(ws + WS_WOUT) + (size_t)l * D * D, D, 0, 0, scr, r, F.lane);
        }
    }
    for (int i = F.gtid; i < 2 * 256 * D; i += F.ngt) {
        const int n = i & 1023, rc = (i >> 10) & 255, l = i >> 18, g = rc >> 6;
        const float* pw = p.in[I_pool_w] + ((size_t)l * 256 + rc) * 64;
        const float* ps = p.in[I_pool_scale] + l * 256 + 64 * g;
        const float* wb = p.in[I_w_br_pool] + ((size_t)l * 256 + 64 * g) * D + n;
        float a = 0.f;
#pragma unroll 16
        for (int e = 0; e < 64; ++e) a += pw[e] * ps[e] * wb[(size_t)e * D];
        ((bf16_t*)(ws + WS_WBR))[(size_t)l * D * D + (size_t)n * D + 512 + rc] = (bf16_t)f2bf(a);
    }
    for (int i = F.gtid; i < 2 * 4 * 128 * 128; i += F.ngt) ((bf16_t*)(ws + WS_SGUW))[i] = (bf16_t)f2bf(p.in[I_sgu_w][i]);
    for (int i = F.gtid; i < 64 * 16; i += F.ngt) {
        const int pos = i >> 4, fi = i & 15;
        const float inv = powf(10000.0f, -(float)fi / 16.0f);
        const float ang = (float)pos * inv;
        ((f32x2*)(ws + WS_ROPE))[i] = (f32x2){cosf(ang), sinf(ang)};
    }
    convert_tables(p, F);
    {
        float* MOD = (float*)(ws + WS_MOD);
        LAS float* scd = (LAS float*)F.lds;
        LAS float* red = scd + 9 * D;
        __syncthreads();
        { float tc[18];
#pragma unroll
          for (int it = 0; it < 18; ++it) { const int e = F.tid + it * NTHREADS, r = e >> 10, k = e & 1023; tc[it] = (r < 8) ? p.in[I_c][r * D + k] : p.in[I_c_ctx][k]; }
#pragma unroll
          for (int it = 0; it < 18; ++it) scd[F.tid + it * NTHREADS] = silu_(tc[it]); }
        __syncthreads();
        for (int it = F.bid; it < 2 * 96; it += F.nb) {
            const int cgp = it % 96, l = it / 96, col = cgp * 64 + F.lane;
            float acc[9];
#pragma unroll
            for (int r = 0; r < 9; ++r) acc[r] = 0.f;
            const float* wp = p.in[I_w_mod] + ((size_t)l * D + F.wave * 128) * NMOD + col;
#pragma unroll 16
            for (int k = 0; k < 128; ++k) {
                const float w = wp[(size_t)k * NMOD];
#pragma unroll
                for (int r = 0; r < 9; ++r) acc[r] += scd[r * D + F.wave * 128 + k] * w;
            }
#pragma unroll
            for (int r = 0; r < 9; ++r) red[(F.wave * 9 + r) * 64 + F.lane] = acc[r];
            __syncthreads();
            for (int e = F.tid; e < 9 * 64; e += NTHREADS) {
                const int r = e >> 6, ln = e & 63; float s = p.in[I_b_mod][l * NMOD + cgp * 64 + ln];
#pragma unroll
                for (int w = 0; w < 8; ++w) s += red[(w * 9 + r) * 64 + ln];
                MOD[((size_t)l * 9 + r) * NMOD + cgp * 64 + ln] = s;
            }
            __syncthreads();
        }
    }
}

DI const float* mod_vec(const Params& p, int l, int row, int j) {
    const int r = row < TL ? row / SEQ : 8;
    return (const float*)(p.ws + WS_MOD) + ((size_t)l * 9 + r) * NMOD + j * D;
}
DI float* xrow_ptr(const Params& p, int row) { return row < TL ? p.out + (size_t)row * D : (float*)(p.ws + WS_XCTX) + (size_t)(row - TL) * D; }
DI const float* xin_ptr(const Params& p, int row) { return row < TL ? p.in[I_x] + (size_t)row * D : p.in[I_ctx] + (size_t)(row - TL) * D; }

DI void modulate_row_wave(const float* src, const float* g, const float* sh, const float* sc, bf16_t* dst, int lane, unsigned char* h8 = nullptr, float* hs = nullptr) {
    f32x4 v[4]; float ss = 0.f;
#pragma unroll
    for (int j = 0; j < 4; ++j) { v[j] = ((const f32x4*)src)[lane + 64 * j]; ss += v[j].x * v[j].x + v[j].y * v[j].y + v[j].z * v[j].z + v[j].w * v[j].w; }
    const float rinv = rsqrtf(wave_sum(ss) * (1.0f / D) + EPS);
    float am = 0.f;
#pragma unroll
    for (int j = 0; j < 4; ++j) {
        const f32x4 gg = ((const f32x4*)g)[lane + 64 * j], s1 = ((const f32x4*)sh)[lane + 64 * j], s2 = ((const f32x4*)sc)[lane + 64 * j];
        const f32x4 o = v[j] * rinv * gg * (s2 + 1.0f) + s1;
        u32x2 w; w.x = pk2(o.x, o.y); w.y = pk2(o.z, o.w);
        ((u32x2*)dst)[lane + 64 * j] = w;
        v[j] = o; am = fmaxf(am, fmaxf(fmaxf(fabsf(o.x), fabsf(o.y)), fmaxf(fabsf(o.z), fabsf(o.w))));
    }
    if (h8) {
#pragma unroll
        for (int o = 1; o < 64; o <<= 1) am = fmaxf(am, __shfl_xor(am, o));
        const float scl = (am > 0.f) ? exp2f(floorf(log2f(224.0f / am))) : 1.0f;
#pragma unroll
        for (int j = 0; j < 4; ++j) { int w = 0; w = __builtin_amdgcn_cvt_pk_fp8_f32(v[j].x * scl, v[j].y * scl, w, false); w = __builtin_amdgcn_cvt_pk_fp8_f32(v[j].z * scl, v[j].w * scl, w, true);
            ((unsigned*)h8)[lane + 64 * j] = (unsigned)w; }
        if (lane == 0) *hs = 1.0f / scl;
    }
}

DI void phase_norm(const Params& p, const Frame& F, int l, int which  , bool from_input, int nrows) {
    const float* g = (which == 0 ? p.in[I_g_mix] : p.in[I_g_ffn]) + l * D;
    const int lane = F.lane;
    f32x4 gg[4];
#pragma unroll
    for (int j = 0; j < 4; ++j) gg[j] = ((const f32x4*)g)[lane + 64 * j];
    for (int row0 = 2 * F.gw; row0 < nrows; row0 += 2 * F.ngw) {
        f32x4 v[2][4], s1[2][4], s2[2][4];
#pragma unroll
        for (int u = 0; u < 2; ++u) {
            const int row = row0 + u;
            const float* src = from_input ? xin_ptr(p, row) : xrow_ptr(p, row);
            const float* sh = mod_vec(p, l, row, which * 3 + 0); const float* sc = mod_vec(p, l, row, which * 3 + 1);
#pragma unroll
            for (int j = 0; j < 4; ++j) { v[u][j] = ((const f32x4*)src)[lane + 64 * j]; s1[u][j] = ((const f32x4*)sh)[lane + 64 * j]; s2[u][j] = ((const f32x4*)sc)[lane + 64 * j]; }
        }
#pragma unroll
        for (int u = 0; u < 2; ++u) {
            float ss = 0.f;
#pragma unroll
            for (int j = 0; j < 4; ++j) ss += v[u][j].x * v[u][j].x + v[u][j].y * v[u][j].y + v[u][j].z * v[u][j].z + v[u][j].w * v[u][j].w;
            const float rinv = rsqrtf(wave_sum(ss) * (1.0f / D) + EPS);
            bf16_t* dst = (bf16_t*)(p.ws + WS_H) + (size_t)(row0 + u) * D;
#pragma unroll
            for (int j = 0; j < 4; ++j) {
                const f32x4 o = v[u][j] * rinv * gg[j] * (s2[u][j] + 1.0f) + s1[u][j];
                u32x2 w; w.x = pk2(o.x, o.y); w.y = pk2(o.z, o.w);
                ((u32x2*)dst)[lane + 64 * j] = w;
            }
        }
    }
}
DI void phase_final(const Params& p, const Frame& F) {
    f32x4 gg[4];
#pragma unroll
    for (int j = 0; j < 4; ++j) gg[j] = ((const f32x4*)p.in[I_g_final])[F.lane + 64 * j];
    for (int row0 = 2 * F.gw; row0 < TL; row0 += 2 * F.ngw) {
        f32x4 v[2][4];
#pragma unroll
        for (int u = 0; u < 2; ++u)
#pragma unroll
            for (int j = 0; j < 4; ++j) v[u][j] = ((const f32x4*)(p.out + (size_t)(row0 + u) * D))[F.lane + 64 * j];
#pragma unroll
        for (int u = 0; u < 2; ++u) {
            float ss = 0.f;
#pragma unroll
            for (int j = 0; j < 4; ++j) ss += v[u][j].x * v[u][j].x + v[u][j].y * v[u][j].y + v[u][j].z * v[u][j].z + v[u][j].w * v[u][j].w;
            const float rinv = rsqrtf(wave_sum(ss) * (1.0f / D) + EPS);
            f32x4* xr = (f32x4*)(p.out + (size_t)(row0 + u) * D);
#pragma unroll
            for (int j = 0; j < 4; ++j) xr[F.lane + 64 * j] = v[u][j] * rinv * gg[j];
        }
    }
}

DI void g1_epilogue(const Params& p, int l, const f32x16& acc, int row0, int col0, int lane) {
    const int h = lane >> 5, w = lane & 31, col = col0 + w;
    bf16_t* P = (bf16_t*)(p.ws + WS_P);
    if (col0 < VOFF) {
        const float sc = (col0 < KOFF) ? QSCALE : 1.0f;
        const int axis = (col0 >> 5) & 1, fi = w & 15;
        const f32x2* tab = (const f32x2*)(p.ws + WS_ROPE);
#pragma unroll
        for (int r = 0; r < 16; ++r) {
            const int row = row0 + crow(r, h);
            const float own = acc[r], oth = __shfl_xor(own, 16);
            float o = own;
            if (row < TL) {
                const int t = row & (SEQ - 1), pos = axis ? (t & 63) : (t >> 6);
                const f32x2 cs = tab[pos * 16 + fi];
                o = (w < 16) ? (own * cs.x - oth * cs.y) : (own * cs.x + oth * cs.y);
            }
            P[(size_t)row * PW + col] = (bf16_t)f2bf(o * sc);
        }
    } else if (col0 < POOLOFF) {
        const int hk = (col - VOFF) >> 6, d = (col - VOFF) & 63;
#pragma unroll
        for (int r = 0; r < 16; ++r) {
            const int row = row0 + crow(r, h);
            const bf16_t v = (bf16_t)f2bf(acc[r]);
            if (row < TL) { const int b = row / SEQ, t = row & (SEQ - 1); ((bf16_t*)(p.ws + WS_VT))[((size_t)(b * 2 + hk) * 64 + d) * VTS + t] = v; }
            else { const int rc = row - TL, b = rc / NCTX, j = rc & (NCTX - 1); ((bf16_t*)(p.ws + WS_VTC))[((size_t)(b * 2 + hk) * 64 + d) * NCTX + j] = v; }
        }
    } else if (col0 < SUOFF) {
#pragma unroll
        for (int r = 0; r < 16; ++r) { const int row = row0 + crow(r, h); P[(size_t)row * PW + col] = (bf16_t)f2bf(acc[r]); }
    } else if (col0 < SVOFF) {
#pragma unroll
        for (int r = 0; r < 16; ++r) { const int row = row0 + crow(r, h); P[(size_t)row * PW + col] = (bf16_t)f2bf(gelu_tanh(acc[r])); }
    } else {
        const int c = col - SVOFF;
#pragma unroll
        for (int r = 0; r < 16; ++r) { const int row = row0 + crow(r, h); const int chunk = row >> 7, q = row & 127;
            ((bf16_t*)(p.ws + WS_VST))[((size_t)chunk * 256 + c) * 128 + q] = (bf16_t)f2bf(gelu_tanh(acc[r])); }
    }
}

DI void g1_simple(const Params& p, const Frame& F, int l, int row_lo, int nrows, int ct_lo, int nct) {
    const bf16_t* H = (const bf16_t*)(p.ws + WS_H);
    const bf16_t* W = (const bf16_t*)(p.ws + WS_WIN) + (size_t)l * INW * D;
    const int nit = (nrows / 64) * nct;
    for (int it = F.gw; it < nit; it += F.ngw) {
        const int mt = it / nct, nt = ct_lo + it % nct, m0 = row_lo + mt * 64;
        f32x16 acc[2][1]; zero_acc(acc);
        wave_gemm<2, 1>(H, D, W, D, D, m0, nt * 32, acc, F.lane);
#pragma unroll 1
        for (int i = 0; i < 2; ++i) g1_epilogue(p, l, i == 0 ? acc[0][0] : acc[1][0], m0 + 32 * i, nt * 32, F.lane);
    }
}

DI float lane_xor32(float v, bool hi) { const auto r = __builtin_amdgcn_permlane32_swap(__builtin_bit_cast(unsigned, v), __builtin_bit_cast(unsigned, v), false, false);
    return __builtin_bit_cast(float, hi ? r[0] : r[1]); }
struct EpiG1 {
    DI bool keeps(const pg8::Unit&) const { return false; }
    static constexpr bool PERM = true;
    unsigned char* ws;
    DI void operator()(const f32x4 (&acc)[2][2][4][2], const pg8::Unit& u, int wr, int wc, int fr, int fq) const {
        bf16_t* P = (bf16_t*)(ws + WS_P);
        const int rbase = u.pm * 256 + wr * 64 + fr;
        const bool hi = fq >= 2;
#pragma unroll
        for (int ai = 0; ai < 2; ++ai) {
            f32x4 cs[4][4];
            const bool lat = u.pm < TL / 256;
            if (u.pn < 3 && lat) {
#pragma unroll
                for (int m = 0; m < 4; ++m) {
                    const int t = (rbase + 128 * ai + 16 * m) & (SEQ - 1), pos = (wc & 1) ? (t & 63) : (t >> 6);
                    const f32x4* tab = (const f32x4*)(ws + WS_ROPE) + (pos * 16 + 8 * (fq & 1)) / 2;
#pragma unroll
                    for (int j2 = 0; j2 < 4; ++j2) cs[m][j2] = tab[j2];
                }
            }
#pragma unroll
            for (int m = 0; m < 4; ++m) {
                const int row = rbase + 128 * ai + 16 * m;
#pragma unroll
                for (int bj = 0; bj < 2; ++bj) {
                    const int c0 = u.pn * 256 + 128 * bj + 32 * wc + 8 * fq;
                    float v[8];
#pragma unroll
                    for (int j = 0; j < 4; ++j) { v[j] = acc[ai][bj][m][0][j]; v[4 + j] = acc[ai][bj][m][1][j]; }
                    if (c0 < VOFF) {
                        const float sc = (c0 < KOFF) ? QSCALE : 1.0f;
                        u32x4 o;
#pragma unroll
                        for (int j2 = 0; j2 < 4; ++j2) {
                            const f32x4 c4 = cs[m][j2];
                            const float o0 = lane_xor32(v[2 * j2], hi), o1 = lane_xor32(v[2 * j2 + 1], hi);
                            float r0 = hi ? (v[2 * j2] * c4.x + o0 * c4.y) : (v[2 * j2] * c4.x - o0 * c4.y);
                            float r1 = hi ? (v[2 * j2 + 1] * c4.z + o1 * c4.w) : (v[2 * j2 + 1] * c4.z - o1 * c4.w);
                            if (!lat) { r0 = v[2 * j2]; r1 = v[2 * j2 + 1]; }
                            o[j2] = pk2(r0 * sc, r1 * sc);
                        }
                        *(u32x4*)(P + (size_t)row * PW + c0) = o;
                    } else if (c0 < POOLOFF) {
                        const int hk = wc >> 1, d0 = 32 * (wc & 1) + 8 * fq;
                        if (lat) { const int b = row / SEQ, t = row & (SEQ - 1);
                            bf16_t* vt = (bf16_t*)(ws + WS_VT) + ((size_t)(b * 2 + hk) * 64 + d0) * VTS + t;
#pragma unroll
                            for (int j = 0; j < 8; ++j) vt[(size_t)j * VTS] = (bf16_t)f2bf(v[j]);
                        } else { const int rc = row - TL, b = rc / NCTX, jc = rc & (NCTX - 1);
                            bf16_t* vt = (bf16_t*)(ws + WS_VTC) + ((size_t)(b * 2 + hk) * 64 + d0) * NCTX + jc;
#pragma unroll
                            for (int j = 0; j < 8; ++j) vt[(size_t)j * NCTX] = (bf16_t)f2bf(v[j]);
                        }
                    } else if (c0 < SUOFF) {
                        u32x4 o;
#pragma unroll
                        for (int j2 = 0; j2 < 4; ++j2) o[j2] = pk2(v[2 * j2], v[2 * j2 + 1]);
                        *(u32x4*)(P + (size_t)row * PW + c0) = o;
                    } else if (c0 < SVOFF) {
                        u32x4 o;
#pragma unroll
                        for (int j2 = 0; j2 < 4; ++j2) o[j2] = pk2(gelu_tanh(v[2 * j2]), gelu_tanh(v[2 * j2 + 1]));
                        *(u32x4*)(P + (size_t)row * PW + c0) = o;
                    } else {
                        const int c = c0 - SVOFF, chunk = row >> 7, q = row & 127;
                        bf16_t* vs = (bf16_t*)(ws + WS_VST) + ((size_t)chunk * 256 + c) * 128 + q;
#pragma unroll
                        for (int j = 0; j < 8; ++j) vs[j * 128] = (bf16_t)f2bf(gelu_tanh(v[j]));
                    }
                }
            }
            asm volatile("" ::: "memory");
        }
    }
};
struct SchedGrid {
    int nM, nN, G, c; const char* A; const char* B;
    int n_extra, ex_pm0, ex_pn;
    DI bool next(int i, pg8::Unit& u) const {
        const int L = i * G + c, n = nM * nN; if (L >= n + n_extra) return false;
        if (L < n) pg8::tile_of(L, nM, nN, u.pm, u.pn); else { u.pm = ex_pm0 + (L - n); u.pn = ex_pn; }
        u.sub = 0; u.nt = D / 64; u.mode = 0;
        u.a = A + (size_t)u.pm * 256 * D * 2; u.b = B + (size_t)u.pn * 256 * D * 2; return true;
    }
};

DI void phase_g1(const Params& p, const Frame& F, int l) {
    SchedGrid S{(l == 0 ? T : TL) / 256, PN / 256, F.nb, F.bid, (const char*)(p.ws + WS_H), (const char*)(p.ws + WS_WIN) + (size_t)l * INW * D * 2,
                (l == 0) ? 0 : TC / 256, TL / 256, 2};
    EpiG1 E{p.ws};
    pg8::gemm_phase(F.lds, F.tid, S, E);
}

DI bf16x8 pack8(const f32x16& x, int s) {
    u32x4 pk;
#pragma unroll
    for (int j = 0; j < 4; ++j) { f32x2 v = {x[8 * s + 2 * j], x[8 * s + 2 * j + 1]}; pk[j] = __builtin_bit_cast(unsigned, __builtin_convertvector(v, bf16x2_t)); }
    return __builtin_bit_cast(bf16x8, pk);
}

DI float lane_x32(float v, bool hi) { const auto r = __builtin_amdgcn_permlane32_swap(__builtin_bit_cast(unsigned, v), __builtin_bit_cast(unsigned, v), false, false);
    return __builtin_bit_cast(float, hi ? r[0] : r[1]); }
struct AttnFrags { bf16x8 kf[4]; s16x4 vf[2][4]; };
DI void attn_load(AttnFrags& f, const bf16_t* kptr, const bf16_t* vptr, size_t vstride_d32) {
#pragma unroll
    for (int s = 0; s < 4; ++s) f.kf[s] = *(const bf16x8*)(kptr + 16 * s);
#pragma unroll
    for (int d = 0; d < 2; ++d)
#pragma unroll
        for (int q = 0; q < 4; ++q) f.vf[d][q] = *(const s16x4*)(vptr + (size_t)d * vstride_d32 + 8 * q);
}
DI void attn_block(const bf16x8 (&qf)[4], const AttnFrags& f, int mask_mode, int kq_off, int lane, float& m, float& lpart, f32x16 (&o)[2]) {
    const int h = lane >> 5;
    f32x16 st;
#pragma unroll
    for (int r = 0; r < 16; ++r) st[r] = 0.f;
#pragma unroll
    for (int s = 0; s < 4; ++s) st = MFMA32(f.kf[s], qf[s], st);
    if (mask_mode) {
#pragma unroll
        for (int r = 0; r < 16; ++r) { const int dlt = kq_off + crow(r, h); if (dlt > 128 || dlt < -128) st[r] = -1e30f; }
    }
    float bm = st[0];
#pragma unroll
    for (int r = 1; r < 16; ++r) bm = fmaxf(bm, st[r]);
    bm = fmaxf(bm, lane_x32(bm, h != 0));
    const float mn = fmaxf(m, bm);
    if (__builtin_amdgcn_ballot_w64(mn > m) != 0ull) {
        const float alpha = __builtin_amdgcn_exp2f(m - mn);
        lpart *= alpha;
#pragma unroll
        for (int d = 0; d < 2; ++d)
#pragma unroll
            for (int r = 0; r < 16; ++r) o[d][r] *= alpha;
        m = mn;
    }
    float ps = 0.f;
#pragma unroll
    for (int r = 0; r < 16; ++r) { st[r] = __builtin_amdgcn_exp2f(st[r] - m); ps += st[r]; }
    lpart += ps;
    const bf16x8 pf0 = pack8(st, 0), pf1 = pack8(st, 1);
#pragma unroll
    for (int d = 0; d < 2; ++d) {
        const bf16x8 v0 = __builtin_shufflevector(f.vf[d][0], f.vf[d][1], 0, 1, 2, 3, 4, 5, 6, 7), v1 = __builtin_shufflevector(f.vf[d][2], f.vf[d][3], 0, 1, 2, 3, 4, 5, 6, 7);
        o[d] = MFMA32(v0, pf0, o[d]);
        o[d] = MFMA32(v1, pf1, o[d]);
    }
}

DI void attn_task(const Params& p, int l, int task, int lane) {
    const int r = lane & 31, h = lane >> 5;
    const bf16_t* P = (const bf16_t*)(p.ws + WS_P);
    const bf16_t* VT = (const bf16_t*)(p.ws + WS_VT);
    const bf16_t* VTC = (const bf16_t*)(p.ws + WS_VTC);
    bf16_t* Y = (bf16_t*)(p.ws + WS_Y);
    const bool latent = task < 8192;
    int b, head, qb, q0row, p0;
    if (latent) { qb = task & 127; head = (task >> 7) & 7; b = task >> 10; p0 = qb * 32; q0row = b * SEQ + p0; }
    else { const int t2 = task - 8192; qb = t2 & 7; head = (t2 >> 3) & 7; b = t2 >> 6; p0 = qb * 32; q0row = TL + b * NCTX + p0; }
    const int hk = head >> 2;
    bf16x8 qf[4];
#pragma unroll
    for (int s = 0; s < 4; ++s) qf[s] = *(const bf16x8*)(P + (size_t)(q0row + r) * PW + head * 64 + 16 * s + 8 * h);
    float m = p.in[I_attn_sink][l * 8 + head] * LOG2E, lpart = (h == 0) ? 1.0f : 0.0f;
    f32x16 o[2];
#pragma unroll
    for (int d = 0; d < 2; ++d)
#pragma unroll
        for (int i = 0; i < 16; ++i) o[d][i] = 0.f;
    const int kb_lo = max(p0 - 128, 0), kb_hi = min(p0 + 128, SEQ - 32);
    const int nwin = latent ? ((kb_hi - kb_lo) >> 5) + 1 : 0, nblk = nwin + 8;
    const bf16_t* kwin = P + (size_t)(b * SEQ + r) * PW + KOFF + hk * 64 + 8 * h;
    const bf16_t* vwin = VT + ((size_t)(b * 2 + hk) * 64 + r) * VTS + 4 * h;
    const bf16_t* kctx = P + (size_t)(TL + b * NCTX + r) * PW + KOFF + hk * 64 + 8 * h;
    const bf16_t* vctx = VTC + ((size_t)(b * 2 + hk) * 64 + r) * NCTX + 4 * h;
    AttnFrags f0, f1, f2;
#define ATT_LOAD(F_, jj) do { const int j_ = min((jj), nblk - 1); \
        if (j_ < nwin) { const int kb_ = kb_lo + 32 * j_; attn_load(F_, kwin + (size_t)kb_ * PW, vwin + kb_, (size_t)32 * VTS); } \
        else { const int kb_ = 32 * (j_ - nwin); attn_load(F_, kctx + (size_t)kb_ * PW, vctx + kb_, (size_t)32 * NCTX); } } while (0)
#define ATT_COMP(F_, jj) do { const int j_ = (jj); if (j_ < nblk) { int mm_ = 0, kq_ = 0; \
        if (j_ < nwin) { const int kb_ = kb_lo + 32 * j_; mm_ = (kb_ == p0 - 128 || kb_ == p0 + 128) ? 1 : 0; kq_ = kb_ - (p0 + r); } \
        attn_block(qf, F_, mm_, kq_, lane, m, lpart, o); } } while (0)
    ATT_LOAD(f0, 0); ATT_LOAD(f1, 1);
#pragma unroll 1
    for (int j = 0; j < nblk; j += 3) {
        ATT_LOAD(f2, j + 2); ATT_COMP(f0, j);
        ATT_LOAD(f0, j + 3); ATT_COMP(f1, j + 1);
        ATT_LOAD(f1, j + 4); ATT_COMP(f2, j + 2);
    }
#undef ATT_LOAD
#undef ATT_COMP
    const float inv = 1.0f / (lpart + lane_x32(lpart, h != 0));
    bf16_t* yrow = Y + (size_t)(q0row + r) * D + head * 64;
#pragma unroll
    for (int d = 0; d < 2; ++d)
#pragma unroll
        for (int g = 0; g < 4; ++g) {
            u32x2 w; w.x = pk2(o[d][4 * g] * inv, o[d][4 * g + 1] * inv); w.y = pk2(o[d][4 * g + 2] * inv, o[d][4 * g + 3] * inv);
            *(u32x2*)(yrow + 32 * d + 8 * g + 4 * h) = w;
        }
}

constexpr int AKP = 144, AVWP = 648, AVCP = 520;
constexpr int ALDS_KW = 0, ALDS_VW = ALDS_KW + 320 * AKP, ALDS_KC = ALDS_VW + 64 * AVWP, ALDS_VC = ALDS_KC + 256 * AKP, ALDS_END = ALDS_VC + 64 * AVCP;
static_assert(ALDS_END <= LDS_BAR_OFF && (ALDS_VW % 16) == 0 && (ALDS_KC % 16) == 0 && (ALDS_VC % 8) == 0, "attention LDS map");
DI void attn_lds_frags(AttnFrags& f, const LAS unsigned char* kp, const LAS unsigned char* vp, int vpitch32) {
#pragma unroll
    for (int s = 0; s < 4; ++s) f.kf[s] = *(const LAS bf16x8*)(kp + 32 * s);
#pragma unroll
    for (int d = 0; d < 2; ++d)
#pragma unroll
        for (int q = 0; q < 4; ++q) f.vf[d][q] = *(const LAS s16x4*)(vp + d * vpitch32 + 16 * q);
}
DI void attn_unit(const Params& p, const Frame& F, int l, int unit) {
    const int lane = F.lane, r = lane & 31, h = lane >> 5, tid = F.tid;
    const bf16_t* P = (const bf16_t*)(p.ws + WS_P);
    const bf16_t* VT = (const bf16_t*)(p.ws + WS_VT);
    const bf16_t* VTC = (const bf16_t*)(p.ws + WS_VTC);
    bf16_t* Y = (bf16_t*)(p.ws + WS_Y);
    const bool latent = unit < 1024;
    int b, hk, p0, q0row;
    if (latent) { const int pb = unit & 63; hk = (unit >> 6) & 1; b = unit >> 7; p0 = pb * 64; q0row = b * SEQ + p0; }
    else { const int u2 = unit - 1024, pb = u2 & 3; hk = (u2 >> 2) & 1; b = u2 >> 3; p0 = pb * 64; q0row = TL + b * NCTX + p0; }
    const int w0 = p0 - 128;
    u32x4 kw[5], vw[5], kc[4], vc[4];
    if (latent) {
#pragma unroll
        for (int it = 0; it < 5; ++it) {
            const int i = tid + it * NTHREADS, row = i >> 3, ck = i & 7, pos = min(max(w0 + row, 0), SEQ - 1);
            kw[it] = *(const u32x4*)(P + (size_t)(b * SEQ + pos) * PW + KOFF + hk * 64 + 8 * ck);
            const int d = i / 40, cv = i % 40, pv = min(max(w0 + 8 * cv, 0), SEQ - 8);
            vw[it] = *(const u32x4*)(VT + ((size_t)(b * 2 + hk) * 64 + d) * VTS + pv);
        }
    }
#pragma unroll
    for (int it = 0; it < 4; ++it) {
        const int i = tid + it * NTHREADS;
        kc[it] = *(const u32x4*)(P + (size_t)(TL + b * NCTX + (i >> 3)) * PW + KOFF + hk * 64 + 8 * (i & 7));
        vc[it] = *(const u32x4*)(VTC + ((size_t)(b * 2 + hk) * 64 + (i >> 5)) * NCTX + 8 * (i & 31));
    }
    __syncthreads();
    if (latent) {
#pragma unroll
        for (int it = 0; it < 5; ++it) {
            const int i = tid + it * NTHREADS, row = i >> 3, ck = i & 7;
            *(LAS u32x4*)(F.lds + ALDS_KW + row * AKP + 16 * ck) = kw[it];
            const int d = i / 40, cv = i % 40;
            LAS u32x2* dst = (LAS u32x2*)(F.lds + ALDS_VW + d * AVWP + 16 * cv); dst[0] = (u32x2){vw[it].x, vw[it].y}; dst[1] = (u32x2){vw[it].z, vw[it].w};
        }
    }
#pragma unroll
    for (int it = 0; it < 4; ++it) {
        const int i = tid + it * NTHREADS;
        *(LAS u32x4*)(F.lds + ALDS_KC + (i >> 3) * AKP + 16 * (i & 7)) = kc[it];
        LAS u32x2* dst = (LAS u32x2*)(F.lds + ALDS_VC + (i >> 5) * AVCP + 16 * (i & 31)); dst[0] = (u32x2){vc[it].x, vc[it].y}; dst[1] = (u32x2){vc[it].z, vc[it].w};
    }
    const int head = 4 * hk + (F.wave & 3), ph = F.wave >> 2, pw = p0 + 32 * ph, qrow = q0row + 32 * ph;
    bf16x8 qf[4];
#pragma unroll
    for (int s = 0; s < 4; ++s) qf[s] = *(const bf16x8*)(P + (size_t)(qrow + r) * PW + head * 64 + 16 * s + 8 * h);
    float m = p.in[I_attn_sink][l * 8 + head] * LOG2E, lpart = (h == 0) ? 1.0f : 0.0f;
    f32x16 o[2];
#pragma unroll
    for (int d = 0; d < 2; ++d)
#pragma unroll
        for (int i = 0; i < 16; ++i) o[d][i] = 0.f;
    __syncthreads();
    if (latent) {
#pragma unroll 1
        for (int j = 0; j < 9; ++j) {
            const int kb = pw - 128 + 32 * j;
            if (kb < 0 || kb >= SEQ) continue;
            const int krow = kb - w0;
            AttnFrags f;
            attn_lds_frags(f, F.lds + ALDS_KW + (krow + r) * AKP + 16 * h, F.lds + ALDS_VW + r * AVWP + 2 * krow + 8 * h, 32 * AVWP);
            attn_block(qf, f, (j == 0 || j == 8) ? 1 : 0, kb - (pw + r), lane, m, lpart, o);
        }
    }
#pragma unroll 1
    for (int j = 0; j < 8; ++j) {
        AttnFrags f;
        attn_lds_frags(f, F.lds + ALDS_KC + (32 * j + r) * AKP + 16 * h, F.lds + ALDS_VC + r * AVCP + 64 * j + 8 * h, 32 * AVCP);
        attn_block(qf, f, 0, 0, lane, m, lpart, o);
    }
    const float inv = 1.0f / (lpart + lane_x32(lpart, h != 0));
    bf16_t* yrow = Y + (size_t)(qrow + r) * D + head * 64;
#pragma unroll
    for (int d = 0; d < 2; ++d)
#pragma unroll
        for (int g = 0; g < 4; ++g) {
            u32x2 w; w.x = pk2(o[d][4 * g] * inv, o[d][4 * g + 1] * inv); w.y = pk2(o[d][4 * g + 2] * inv, o[d][4 * g + 3] * inv);
            *(u32x2*)(yrow + 32 * d + 8 * g + 4 * h) = w;
        }
}

DI void sgu_unit(const Params& p, const Frame& F, int l, int chunk) {
    constexpr int VS = 136;
    LAS float* part = (LAS float*)F.lds;
    LAS float* rq = part + 512;
    LAS bf16_t* vnT = (LAS bf16_t*)(F.lds + 4096);
    const bf16_t* VsT = (const bf16_t*)(p.ws + WS_VST) + (size_t)chunk * 256 * 128;
    const bf16_t* P = (const bf16_t*)(p.ws + WS_P);
    bf16_t* Y = (bf16_t*)(p.ws + WS_Y);
    __syncthreads();
    { const int q = F.tid & 127, part_i = F.tid >> 7; float ss = 0.f;
#pragma unroll 16
        for (int c = part_i * 64; c < part_i * 64 + 64; ++c) { const float v = bf2f(VsT[c * 128 + q]); ss += v * v; }
        part[part_i * 128 + q] = ss; }
    __syncthreads();
    if (F.tid < 128) rq[F.tid] = rsqrtf((part[F.tid] + part[128 + F.tid] + part[256 + F.tid] + part[384 + F.tid]) * (1.0f / 256.0f) + EPS);
    __syncthreads();
#pragma unroll
    for (int it = 0; it < 8; ++it) {
        const int i = F.tid + it * NTHREADS;
        const int c = i >> 4, q8 = (i & 15) * 8;
        const u32x4 v = *(const u32x4*)(VsT + c * 128 + q8);
        u32x4 o;
#pragma unroll
        for (int j = 0; j < 4; ++j) o[j] = pk2(bflo(v[j]) * rq[q8 + 2 * j], bfhi(v[j]) * rq[q8 + 2 * j + 1]);
        *(LAS u32x4*)(vnT + c * VS + q8) = o;
    }
    __syncthreads();
    const int lane = F.lane, r = lane & 31, h = lane >> 5, g = F.wave >> 1, ph = F.wave & 1;
    const bf16_t* Wg = (const bf16_t*)(p.ws + WS_SGUW) + ((size_t)l * 4 + g) * 128 * 128;
#pragma unroll 1
    for (int pb = 0; pb < 2; ++pb) {
        const int p0 = 64 * ph + 32 * pb;
        const int row = chunk * 128 + p0 + r;
        bf16x8 wf[8];
#pragma unroll
        for (int s = 0; s < 8; ++s) wf[s] = *(const bf16x8*)(Wg + (size_t)(p0 + r) * 128 + 16 * s + 8 * h);
        u32x2 uu[2][4];
#pragma unroll
        for (int cb = 0; cb < 2; ++cb)
#pragma unroll
            for (int q4 = 0; q4 < 4; ++q4) uu[cb][q4] = *(const u32x2*)(P + (size_t)row * PW + SUOFF + 64 * g + 32 * cb + 8 * q4 + 4 * h);
        const float bias = p.in[I_sgu_b][(l * 4 + g) * 128 + p0 + r];
#pragma unroll
        for (int cb = 0; cb < 2; ++cb) {
            const int c0 = 64 * g + 32 * cb;
            f32x16 acc;
#pragma unroll
            for (int i = 0; i < 16; ++i) acc[i] = 0.f;
#pragma unroll
            for (int s = 0; s < 8; ++s) {
                const bf16x8 a = *(const LAS bf16x8*)(vnT + (c0 + r) * VS + 16 * s + 8 * h);
                acc = MFMA32(a, wf[s], acc);
            }
#pragma unroll
            for (int q4 = 0; q4 < 4; ++q4) {
                const int cc = c0 + 8 * q4 + 4 * h;
                const u32x2 u = uu[cb][q4];
                u32x2 w;
                w.x = pk2(bflo(u.x) * (acc[4 * q4] + bias), bfhi(u.x) * (acc[4 * q4 + 1] + bias));
                w.y = pk2(bflo(u.y) * (acc[4 * q4 + 2] + bias), bfhi(u.y) * (acc[4 * q4 + 3] + bias));
                *(u32x2*)(Y + (size_t)row * D + 768 + cc) = w;
            }
        }
    }
}

DI void phase_mix(const Params& p, const Frame& F, int l, int ctr_slot = 0) {
    (void)ctr_slot;
    const int nrows = (l == 0) ? T : TL;
    const bf16_t* P = (const bf16_t*)(p.ws + WS_P);
    bf16_t* Y = (bf16_t*)(p.ws + WS_Y);
    for (int i0 = F.bid * NTHREADS; i0 < 4 * nrows * 8; i0 += F.nb * NTHREADS) {
        const int i = i0 + F.tid, g = i / (nrows * 8), rem = i - g * (nrows * 8), row = rem >> 3, ck = g * 8 + (rem & 7);
        int base, t, len;
        if (row < TL) { base = row & ~(SEQ - 1); t = row & (SEQ - 1); len = SEQ; } else { const int rc = row - TL; base = TL + (rc & ~(NCTX - 1)); t = rc & (NCTX - 1); len = NCTX; }
        float s[8];
#pragma unroll
        for (int j = 0; j < 8; ++j) s[j] = 0.f;
        const bf16_t* zc = P + POOLOFF + ck * 8;
#define POOL_WIN(HALF) do { _Pragma("unroll") for (int dt = -(HALF); dt < (HALF); ++dt) { const int tt = t + dt; const bool ok = tt >= 0 && tt < len; \
            const u32x4 v = *(const u32x4*)(zc + (size_t)(base + (ok ? tt : t)) * PW); const float w = ok ? 1.f : 0.f; \
            _Pragma("unroll") for (int j = 0; j < 4; ++j) { s[2 * j] += w * bflo(v[j]); s[2 * j + 1] += w * bfhi(v[j]); } } } while (0)
        int half;
        if (g == 0) { POOL_WIN(1); half = 1; } else if (g == 1) { POOL_WIN(2); half = 2; } else if (g == 2) { POOL_WIN(4); half = 4; } else { POOL_WIN(8); half = 8; }
#undef POOL_WIN
        const int lo = max(t - half, 0), hi = min(t + half, len);
        const float inv = 1.0f / (float)(hi - lo);
        const u32x4 z = *(const u32x4*)(zc + (size_t)row * PW);
        u32x4 o;
#pragma unroll
        for (int j = 0; j < 4; ++j) o[j] = pk2(s[2 * j] * inv - bflo(z[j]), s[2 * j + 1] * inv - bfhi(z[j]));
        *(u32x4*)(Y + (size_t)row * D + 512 + ck * 8) = o;
    }
    const int nchunk = (l == 0) ? T / 128 : TL / 128;
    for (int ch = F.bid; ch < nchunk; ch += F.nb) sgu_unit(p, F, l, ch);
    const int nunit = (l == 0) ? 1024 + 64 : 1024;
    for (int u = F.nb - 1 - F.bid; u < nunit; u += F.nb) attn_unit(p, F, l, u);
}

DI void g2_simple(const Params& p, const Frame& F, int l, int row_lo, int nrows) {
    const bf16_t* H = (const bf16_t*)(p.ws + WS_H);
    const bf16_t* Yb = (const bf16_t*)(p.ws + WS_Y);
    const bf16_t* Wg = (const bf16_t*)(p.ws + WS_WIN) + (size_t)l * INW * D + (size_t)GATEOFF * D;
    const bf16_t* Wb = (const bf16_t*)(p.ws + WS_WBR) + (size_t)l * D * D;
    bf16_t* M = (bf16_t*)(p.ws + WS_MERGED);
    const int nit = (nrows / 64) * (D / 32);
    for (int it = F.gw; it < nit; it += F.ngw) {
        const int mt = it / (D / 32), nt = it % (D / 32), m0 = row_lo + mt * 64, n0 = nt * 32;
        f32x16 tot[2][1]; zero_acc(tot);
#pragma unroll 1
        for (int i = 0; i < 3; ++i) {
            const int koff = (i == 0) ? 0 : (i == 1 ? 512 : 768), kk = (i == 0) ? 512 : 256;
            f32x16 g[2][1], pr[2][1]; zero_acc(g); zero_acc(pr);
            wave_gemm<2, 1>(H, D, Wg + (size_t)i * D * D, D, D, m0, n0, g, F.lane);
            wave_gemm<2, 1>(Yb + koff, D, Wb + koff, D, kk, m0, n0, pr, F.lane);
#pragma unroll
            for (int a = 0; a < 2; ++a)
#pragma unroll
                for (int r = 0; r < 16; ++r) tot[a][0][r] += sigmoidf_(g[a][0][r]) * pr[a][0][r];
        }
        const int h = F.lane >> 5, col = n0 + (F.lane & 31);
#pragma unroll
        for (int a = 0; a < 2; ++a)
#pragma unroll
            for (int r = 0; r < 16; ++r) M[(size_t)(m0 + 32 * a + crow(r, h)) * D + col] = (bf16_t)f2bf(tot[a][0][r]);
    }
}
struct SchedG2 {
    int G, c; const char *H, *Y, *Wg, *Wb; int npair;
    DI void fill(pg8::Unit& u, int sub, int br) const {
        u.sub = sub;
        if ((sub & 1) == 0) { u.nt = 16; u.a = H + (size_t)u.pm * 256 * D * 2; u.b = Wg + ((size_t)br * D + u.pn * 256) * D * 2; }
        else { const int koff = (br == 0) ? 0 : (br == 1 ? 512 : 768); u.nt = (br == 0) ? 8 : 4;
               u.a = Y + ((size_t)u.pm * 256 * D + koff) * 2; u.b = Wb + ((size_t)u.pn * 256 * D + koff) * 2; }
    }
    DI bool next(int i, pg8::Unit& u) const {
        constexpr int NLAT = (TL / 256) * 4;
        const int nl = (NLAT - c + G - 1) / G;
        if (i < 6 * nl) { const int tile = (i / 6) * G + c, sub = i % 6; pg8::tile_of(tile, TL / 256, 4, u.pm, u.pn); u.mode = 0; fill(u, sub, sub >> 1); return true; }
        const int e = i - 6 * nl, j = (e >> 1) * G + c;
        if (j >= npair) return false;
        const int ctile = j / 3, br = j % 3;
        u.pm = TL / 256 + (ctile >> 2); u.pn = ctile & 3; u.mode = 1 + br; fill(u, e & 1, br); return true;
    }
};
struct EpiG2 {
    static constexpr bool PERM = true;
    bf16_t* scr; bf16_t* M; bf16_t* MP;
    DI bool keeps(const pg8::Unit& u) const { return (u.sub & 1) == 0; }
    DI void operator()(f32x4 (&acc)[2][2][4][2], const pg8::Unit& u, int wr, int wc, int fr, int fq) const {
        const bool gate = (u.sub & 1) == 0, first = u.sub == 0 && gate;
        bf16_t* Mo = (u.mode == 0) ? M + (size_t)u.pm * 256 * D : MP + ((size_t)(u.mode - 1) * TC + (size_t)(u.pm - TL / 256) * 256) * D;
#pragma unroll
        for (int ai = 0; ai < 2; ++ai) {
            u32x4 ld[4][2];
            if (!first) {
#pragma unroll
                for (int m = 0; m < 4; ++m)
#pragma unroll
                    for (int bj = 0; bj < 2; ++bj) {
                        const int rl = 128 * ai + 64 * wr + 16 * m + fr, cl = 128 * bj + 32 * wc + 8 * fq;
                        ld[m][bj] = gate ? *(const u32x4*)(Mo + (size_t)rl * D + u.pn * 256 + cl) : *(const u32x4*)(scr + rl * 256 + cl);
                    }
            }
#pragma unroll
            for (int m = 0; m < 4; ++m)
#pragma unroll
                for (int bj = 0; bj < 2; ++bj) {
                    const int rl = 128 * ai + 64 * wr + 16 * m + fr, cl = 128 * bj + 32 * wc + 8 * fq;
                    if (gate) {
                        u32x4 o;
#pragma unroll
                        for (int j2 = 0; j2 < 4; ++j2) {
                            const int n = j2 >> 1, e = 2 * (j2 & 1);
                            const unsigned w = pk2(fmaxf(sigmoidf_(acc[ai][bj][m][n][e]), 1e-20f), fmaxf(sigmoidf_(acc[ai][bj][m][n][e + 1]), 1e-20f));
                            o[j2] = w;
                            const float t0 = first ? 0.f : bflo(ld[m][bj][j2]), t1 = first ? 0.f : bfhi(ld[m][bj][j2]);
                            acc[ai][bj][m][n][e] = t0 * __builtin_amdgcn_rcpf(bflo(w)); acc[ai][bj][m][n][e + 1] = t1 * __builtin_amdgcn_rcpf(bfhi(w));
                        }
                        *(u32x4*)(scr + rl * 256 + cl) = o;
                    } else {
                        u32x4 w;
#pragma unroll
                        for (int j2 = 0; j2 < 4; ++j2) { const int n = j2 >> 1, e = 2 * (j2 & 1);
                            w[j2] = pk2(acc[ai][bj][m][n][e] * bflo(ld[m][bj][j2]), acc[ai][bj][m][n][e + 1] * bfhi(ld[m][bj][j2])); }
                        *(u32x4*)(Mo + (size_t)rl * D + u.pn * 256 + cl) = w;
                    }
                }
            asm volatile("" ::: "memory");
        }
    }
};
DI void phase_g2(const Params& p, const Frame& F, int l) {
    SchedG2 S{F.nb, F.bid, (const char*)(p.ws + WS_H), (const char*)(p.ws + WS_Y),
              (const char*)(p.ws + WS_WIN) + ((size_t)l * INW + GATEOFF) * D * 2, (const char*)(p.ws + WS_WBR) + (size_t)l * D * D * 2, (l == 0) ? (TC / 256) * 4 * 3 : 0};
    EpiG2 E{(bf16_t*)(p.ws + WS_IDX) + (size_t)F.bid * 65536, (bf16_t*)(p.ws + WS_MERGED), (bf16_t*)(p.ws + WS_MP)};
    pg8::gemm_phase(F.lds, F.tid, S, E);
}
DI void phase_g2sum(const Params& p, const Frame& F) {
    const u32x4* mp = (const u32x4*)(p.ws + WS_MP);
    u32x4* mo = (u32x4*)((bf16_t*)(p.ws + WS_MERGED) + (size_t)TL * D);
    constexpr int NV = TC * D / 8;
    for (int i = F.gtid; i < NV; i += F.ngt) {
        const u32x4 a = mp[i], b = mp[NV + i], c = mp[2 * NV + i];
        u32x4 o;
#pragma unroll
        for (int j = 0; j < 4; ++j) o[j] = pk2(bflo(a[j]) + bflo(b[j]) + bflo(c[j]), bfhi(a[j]) + bfhi(b[j]) + bfhi(c[j]));
        mo[i] = o;
    }
}

DI void g3_simple(const Params& p, const Frame& F, int l, int row_lo, int nrows) {
    const bf16_t* M = (const bf16_t*)(p.ws + WS_MERGED);
    const bf16_t* W = (const bf16_t*)(p.ws + WS_WOUT) + (size_t)l * D * D;
    const int nit = (nrows / 64) * (D / 64);
    for (int it = F.gw; it < nit; it += F.ngw) {
        const int mt = it / (D / 64), nt = it % (D / 64), m0 = row_lo + mt * 64, n0 = nt * 64;
        f32x16 acc[2][2]; zero_acc(acc);
        wave_gemm<2, 2>(M, D, W, D, D, m0, n0, acc, F.lane);
        const int h = F.lane >> 5;
#pragma unroll
        for (int a = 0; a < 2; ++a)
#pragma unroll
            for (int j = 0; j < 2; ++j) {
                const int col = n0 + 32 * j + (F.lane & 31);
#pragma unroll
                for (int r = 0; r < 16; ++r) {
                    const int row = m0 + 32 * a + crow(r, h);
                    const float xs = (l == 0) ? xin_ptr(p, row)[col] : xrow_ptr(p, row)[col];
                    xrow_ptr(p, row)[col] = xs + mod_vec(p, l, row, 2)[col] * acc[a][j][r];
                }
            }
    }
}
struct EpiG3 {
    DI bool keeps(const pg8::Unit&) const { return false; }
    static constexpr bool PERM = false;
    const float* xsrc; float* xdst; const float* csrc; float* cdst; const float* mod;
    DI void operator()(const f32x4 (&acc)[2][2][4][2], const pg8::Unit& u, int wr, int wc, int fr, int fq) const {
        const int col0 = u.pn * 256 + wc * 32 + 4 * fq;
        const bool lat = u.pm < TL / 256;
        const float* gt = mod + (size_t)(lat ? (u.pm >> 4) : 8) * NMOD + 2 * D;
        const float* xs = lat ? xsrc + (size_t)u.pm * 256 * D : csrc + (size_t)(u.pm - TL / 256) * 256 * D;
        float* xd = lat ? xdst + (size_t)u.pm * 256 * D : cdst + (size_t)(u.pm - TL / 256) * 256 * D;
        f32x4 gv[2][2];
#pragma unroll
        for (int bj = 0; bj < 2; ++bj)
#pragma unroll
            for (int n = 0; n < 2; ++n) gv[bj][n] = *(const f32x4*)(gt + col0 + 128 * bj + 16 * n);
#pragma unroll
        for (int ai = 0; ai < 2; ++ai) {
            f32x4 xv[4][2][2];
#pragma unroll
            for (int m = 0; m < 4; ++m)
#pragma unroll
                for (int bj = 0; bj < 2; ++bj)
#pragma unroll
                    for (int n = 0; n < 2; ++n) xv[m][bj][n] = *(const f32x4*)(xs + (size_t)(wr * 64 + fr + 128 * ai + 16 * m) * D + col0 + 128 * bj + 16 * n);
#pragma unroll
            for (int m = 0; m < 4; ++m)
#pragma unroll
                for (int bj = 0; bj < 2; ++bj)
#pragma unroll
                    for (int n = 0; n < 2; ++n)
                        *(f32x4*)(xd + (size_t)(wr * 64 + fr + 128 * ai + 16 * m) * D + col0 + 128 * bj + 16 * n) = xv[m][bj][n] + gv[bj][n] * acc[ai][bj][m][n];
            asm volatile("" ::: "memory");
        }
    }
};
DI void phase_g3(const Params& p, const Frame& F, int l) {
    SchedGrid S{(l == 0 ? T : TL) / 256, D / 256, F.nb, F.bid, (const char*)(p.ws + WS_MERGED), (const char*)(p.ws + WS_WOUT) + (size_t)l * D * D * 2, 0, 0, 0};
    float* xc = (float*)(p.ws + WS_XCTX);
    EpiG3 E{(l == 0) ? p.in[I_x] : p.out, p.out, (l == 0) ? p.in[I_ctx] : xc, xc, (const float*)(p.ws + WS_MOD) + (size_t)l * 9 * NMOD};
    pg8::gemm_phase(F.lds, F.tid, S, E);
}

DI void g45_simple(const Params& p, const Frame& F, int l, int row_lo, int nrows) {
    const bf16_t* H = (const bf16_t*)(p.ws + WS_H);
    const bf16_t* W = (const bf16_t*)(p.ws + WS_WFOLD) + (size_t)l * 2048 * D;
    _Float16* ST = (_Float16*)(p.ws + WS_ST);
    const int nit = (2048 / 64) * (nrows / 64);
    for (int it = F.gw; it < nit; it += F.ngw) {
        const int nt = it / 32, mt = it % 32, m0 = mt * 64, n0 = row_lo + nt * 64;
        f32x16 acc[2][2]; zero_acc(acc);
        wave_gemm<2, 2>(W, D, H, D, D, m0, n0, acc, F.lane);
        const int h = F.lane >> 5;
#pragma unroll
        for (int a = 0; a < 2; ++a)
#pragma unroll
            for (int j = 0; j < 2; ++j)
#pragma unroll
                for (int r = 0; r < 16; ++r) ST[(size_t)(m0 + 32 * a + crow(r, h)) * T + n0 + 32 * j + (F.lane & 31)] = (_Float16)acc[a][j][r];
    }
}
struct EpiG45 {
    DI bool keeps(const pg8::Unit&) const { return false; }
    static constexpr bool PERM = true;
    unsigned short* ST;
    DI void operator()(const f32x4 (&acc)[2][2][4][2], const pg8::Unit& u, int wr, int wc, int fr, int fq) const {
        const int col0 = u.pn * 256 + wc * 32 + 8 * fq;
#pragma unroll
        for (int ai = 0; ai < 2; ++ai)
#pragma unroll
            for (int m = 0; m < 4; ++m) {
                unsigned short* rowp = ST + (size_t)(u.pm * 256 + wr * 64 + fr + 128 * ai + 16 * m) * T + col0;
#pragma unroll
                for (int bj = 0; bj < 2; ++bj) {
                    u32x4 w;
                    w.x = pkh2(acc[ai][bj][m][0][0], acc[ai][bj][m][0][1]); w.y = pkh2(acc[ai][bj][m][0][2], acc[ai][bj][m][0][3]);
                    w.z = pkh2(acc[ai][bj][m][1][0], acc[ai][bj][m][1][1]); w.w = pkh2(acc[ai][bj][m][1][2], acc[ai][bj][m][1][3]);
                    *(u32x4*)(rowp + 128 * bj) = w;
                }
            }
    }
};
DI void phase_g45(const Params& p, const Frame& F, int l) {
    SchedGrid S{2048 / 256, (l == 0 ? T : TL) / 256, F.nb, F.bid, (const char*)(p.ws + WS_WFOLD) + (size_t)l * 2048 * D * 2, (const char*)(p.ws + WS_H), 0, 0, 0};
    EpiG45 E{(unsigned short*)(p.ws + WS_ST)};
    pg8::gemm_phase(F.lds, F.tid, S, E);
}

DI unsigned fkey(float f) { const unsigned u = __builtin_bit_cast(unsigned, f); return (u & 0x80000000u) ? ~u : (u | 0x80000000u); }
DI float fkey_inv(unsigned k) { const unsigned u = (k & 0x80000000u) ? (k & 0x7fffffffu) : ~k; return __builtin_bit_cast(float, u); }
#define INSERT16(L, x) do { unsigned x_ = (x); _Pragma("unroll") for (int k_ = 0; k_ < 16; ++k_) { const unsigned hi_ = max(L[k_], x_); x_ = min(L[k_], x_); L[k_] = hi_; } } while (0)
#define CEX(a, b) do { const unsigned hi_ = max(a, b), lo_ = min(a, b); a = hi_; b = lo_; } while (0)
DI void sort16_desc(unsigned (&v)[16]) {
#pragma unroll
    for (int k = 2; k <= 16; k <<= 1)
#pragma unroll
        for (int j = k >> 1; j > 0; j >>= 1)
#pragma unroll
            for (int i = 0; i < 16; ++i) {
                const int q = i ^ j;
                if (q > i) { if ((i & k) == 0) CEX(v[i], v[q]); else CEX(v[q], v[i]); }
            }
}
DI void merge16_desc(unsigned (&L)[16], const unsigned (&N)[16]) {
#pragma unroll
    for (int i = 0; i < 16; ++i) L[i] = max(L[i], N[15 - i]);
#pragma unroll
    for (int j = 8; j > 0; j >>= 1)
#pragma unroll
        for (int i = 0; i < 16; ++i) { const int q = i ^ j; if (q > i) CEX(L[i], L[q]); }
}
DI void phase_sel(const Params& p, const Frame& F, int l) {
    const _Float16* ST = (const _Float16*)(p.ws + WS_ST);
    unsigned short* IDX = (unsigned short*)(p.ws + WS_IDX);
    float* GW = (float*)(p.ws + WS_GW);
    float* SU = (float*)(p.ws + WS_SU);
    const float* TSC = (const float*)(p.ws + WS_TSCALE) + (size_t)l * 2 * NEXP;
    LAS unsigned char* ib = (LAS unsigned char*)F.lds;
    const int ntok = (l == 0) ? T : TL;
    for (int i0 = F.bid * NTHREADS; i0 < ntok * 8; i0 += F.nb * NTHREADS) {
        const int i = i0 + F.tid;
        const int tok = i % ntok, head = i / ntok;
        unsigned la[16], lb[16];
#pragma unroll
        for (int k = 0; k < 16; ++k) { la[k] = 0u; lb[k] = 0u; }
        const _Float16* s0 = ST + (size_t)(head * 256) * T + tok;
#define SEL_LOAD(B_, k0_) do { _Pragma("unroll") for (int j = 0; j < 16; ++j) B_[j] = sp[(size_t)((k0_) + j) * T]; } while (0)
#define SEL_GRP(L_, B_, k0_) do { unsigned nk_[16]; \
        _Pragma("unroll") for (int j = 0; j < 16; ++j) nk_[j] = (fkey((float)B_[j]) & ~127u) | (unsigned)(127 - ((k0_) + j)); \
        sort16_desc(nk_); merge16_desc(L_, nk_); } while (0)
#define SEL_HALF(L_, base_) do { const _Float16* sp = s0 + (size_t)(base_) * T; _Float16 bufa[16], bufb[16]; \
        SEL_LOAD(bufa, 0); \
        _Pragma("unroll 1") for (int k0 = 0; k0 < 128; k0 += 32) { \
            SEL_LOAD(bufb, k0 + 16); SEL_GRP(L_, bufa, k0); \
            SEL_LOAD(bufa, (k0 + 32) & 127); SEL_GRP(L_, bufb, k0 + 16); } } while (0)
        SEL_HALF(la, 0);
        SEL_HALF(lb, 128);
#undef SEL_LOAD
#undef SEL_GRP
#undef SEL_HALF
        float va[16], vb[16];
#pragma unroll
        for (int k = 0; k < 16; ++k) {
            va[k] = fkey_inv(la[k] & ~127u); vb[k] = fkey_inv(lb[k] & ~127u);
            ib[k * NTHREADS + F.tid] = (unsigned char)(127u - (la[k] & 127u));
            ib[(16 + k) * NTHREADS + F.tid] = (unsigned char)(127u - (lb[k] & 127u));
        }
        unsigned lc[16];
#pragma unroll
        for (int k = 0; k < 16; ++k) lc[k] = 0u;
#pragma unroll
        for (int a = 0; a < 16; ++a)
#pragma unroll
            for (int b = 0; b < 16; ++b)
                if ((a + 1) * (b + 1) <= 16) { const unsigned key = (fkey(va[a] + vb[b]) & ~255u) | (unsigned)(255 - (a * 16 + b)); INSERT16(lc, key); }
        float e[16], sum = 0.f; const float v0 = fkey_inv(lc[0] & ~255u);
#pragma unroll
        for (int k = 0; k < 16; ++k) { e[k] = __expf(fkey_inv(lc[k] & ~255u) - v0); sum += e[k]; }
        const float inv = 1.0f / sum;
        asm volatile("s_waitcnt lgkmcnt(0)" ::: "memory");
#pragma unroll
        for (int k = 0; k < 16; ++k) {
            const unsigned pos = 255u - (lc[k] & 255u), a = pos >> 4, b = pos & 15u;
            const unsigned ea = ib[a * NTHREADS + F.tid], eb = ib[(16 + b) * NTHREADS + F.tid];
            const unsigned ex = ea * 128u + eb;
            IDX[(size_t)tok * 128 + head * 16 + k] = (unsigned short)ex;
            GW[(size_t)tok * 128 + head * 16 + k] = e[k] * inv * TSC[NEXP + ex];
            SU[(size_t)tok * 128 + head * 16 + k] = TSC[ex];
        }
        asm volatile("s_waitcnt lgkmcnt(0)" ::: "memory");
    }
}

DI float dpp_xor1(float v) { return __builtin_bit_cast(float, __builtin_amdgcn_mov_dpp(__builtin_bit_cast(int, v), 0xB1, 0xF, 0xF, true)); }
DI float dpp_xor2(float v) { return __builtin_bit_cast(float, __builtin_amdgcn_mov_dpp(__builtin_bit_cast(int, v), 0x4E, 0xF, 0xF, true)); }
DI float dpp_hmir(float v) { return __builtin_bit_cast(float, __builtin_amdgcn_mov_dpp(__builtin_bit_cast(int, v), 0x141, 0xF, 0xF, true)); }
DI float dot16_fp8(const u32x4 q, const float (&hx)[16]) {
    f32x2 a = {0.f, 0.f};
#pragma unroll
    for (int j = 0; j < 4; ++j) {
        const f32x2 lo = __builtin_amdgcn_cvt_pk_f32_fp8((int)q[j], false), hi = __builtin_amdgcn_cvt_pk_f32_fp8((int)q[j], true);
        a += lo * (f32x2){hx[4 * j], hx[4 * j + 1]}; a += hi * (f32x2){hx[4 * j + 2], hx[4 * j + 3]};
    }
    return a.x + a.y;
}
#define PEER_EXPERT(id, i) ((int)(((id)[(i) >> 3][((i) >> 1) & 3] >> (16 * ((i) & 1))) & 0xffffu))

struct PeerURows { u32x4 q[16]; u32x4 h0, h1; };
DI void peer_u_rows(PeerURows& R, const u32x4 (&id)[2], const unsigned char* ut, const bf16_t* hrow) {
    R.h0 = *(const u32x4*)(hrow); R.h1 = *(const u32x4*)(hrow + 8);
#pragma unroll
    for (int i = 0; i < 16; ++i) R.q[i] = *(const u32x4*)(ut + (size_t)PEER_EXPERT(id, i) * D);
}
DI void peer_u_compute(const PeerURows& R, float* part, int lane) {
    float hx[16];
#pragma unroll
    for (int j = 0; j < 4; ++j) { hx[2 * j] = bflo(R.h0[j]); hx[2 * j + 1] = bfhi(R.h0[j]); hx[8 + 2 * j] = bflo(R.h1[j]); hx[8 + 2 * j + 1] = bfhi(R.h1[j]); }
    float d[16];
#pragma unroll
    for (int i = 0; i < 16; ++i) d[i] = dot16_fp8(R.q[i], hx);
    const bool b2 = (lane & 4) != 0, b1 = (lane & 2) != 0, b0 = (lane & 1) != 0;
    float k8[8];
#pragma unroll
    for (int i = 0; i < 8; ++i) { const float keep = b2 ? d[8 + i] : d[i], send = b2 ? d[i] : d[8 + i]; k8[i] = keep + dpp_hmir(send); }
    float k4[4];
#pragma unroll
    for (int i = 0; i < 4; ++i) { const float keep = b1 ? k8[4 + i] : k8[i], send = b1 ? k8[i] : k8[4 + i]; k4[i] = keep + dpp_xor2(send); }
    f32x2 k2;
    { const float keep0 = b0 ? k4[2] : k4[0], send0 = b0 ? k4[0] : k4[2], keep1 = b0 ? k4[3] : k4[1], send1 = b0 ? k4[1] : k4[3];
      k2.x = keep0 + dpp_xor1(send0); k2.y = keep1 + dpp_xor1(send1); }
    *(f32x2*)(part + 16 * (lane >> 3) + (b2 ? 8 : 0) + (b1 ? 4 : 0) + (b0 ? 2 : 0)) = k2;
}
DI void phase_peer_u(const Params& p, const Frame& F, int l) {
    const int ntok = (l == 0) ? T : TL, lane = F.lane;
    const int slice = F.bid & 7, sw = (F.bid >> 3) * NWAVES + F.wave, nsw = (F.nb >> 3) * NWAVES;
    const unsigned char* ut = p.ws + WS_UTAB + (size_t)l * NEXP * D + 128 * slice + 16 * (lane & 7);
    const bf16_t* Hs = (const bf16_t*)(p.ws + WS_H) + 128 * slice + 16 * (lane & 7);
    const unsigned short* IDXg = (const unsigned short*)(p.ws + WS_IDX) + 16 * (lane >> 3);
    float* PART = (float*)(p.ws + WS_ST) + (size_t)slice * T * 128;
    const int last = ntok - 1;
    u32x4 sa[2], sb[2]; PeerURows ra, rb;
#define U_SEL(S_, t_) do { const unsigned short* ip_ = IDXg + (size_t)min((t_), last) * 128; S_[0] = *(const u32x4*)ip_; S_[1] = *(const u32x4*)(ip_ + 8); } while (0)
#define U_ROWS(R_, S_, t_) peer_u_rows(R_, S_, ut, Hs + (size_t)min((t_), last) * D)
    U_SEL(sa, sw); U_SEL(sb, sw + nsw);
    U_ROWS(ra, sa, sw);
#pragma unroll 1
    for (int tok = sw; tok < ntok; tok += 2 * nsw) {
        U_SEL(sa, tok + 2 * nsw); U_ROWS(rb, sb, tok + nsw);
        peer_u_compute(ra, PART + (size_t)tok * 128, lane);
        U_SEL(sb, tok + 3 * nsw); U_ROWS(ra, sa, tok + 2 * nsw);
        if (tok + nsw < ntok) peer_u_compute(rb, PART + (size_t)(tok + nsw) * 128, lane);
    }
#undef U_SEL
#undef U_ROWS
}
DI void phase_peer_c(const Params& p, const Frame& F, int l, bool dummy = false) {
    const int ntok = (l == 0) ? T : TL;
    const float* PART = (const float*)(p.ws + WS_ST);
    float* GW = (float*)(p.ws + WS_GW);
    float* CO = dummy ? (float*)(p.ws + WS_H8) : GW;
    const float* SU = (const float*)(p.ws + WS_SU);
    for (int i0 = F.gtid; i0 < ntok * 128; i0 += 4 * F.ngt) {
        float s[4], gw[4], su[4];
#pragma unroll
        for (int u = 0; u < 4; ++u) {
            const int i = min(i0 + u * F.ngt, ntok * 128 - 1);
            s[u] = 0.f;
#pragma unroll
            for (int sl = 0; sl < 8; ++sl) s[u] += PART[(size_t)sl * T * 128 + i];
            gw[u] = GW[i]; su[u] = SU[i];
        }
#pragma unroll
        for (int u = 0; u < 4; ++u) { const int i = i0 + u * F.ngt; if (i < ntok * 128) CO[i] = gw[u] * gelu_tanh(s[u] * su[u]); }
    }
}
struct PeerVRows { u32x4 q[16]; f32x4 cf[4]; f32x2 xv, gv; };
DI void peer_v_rows(PeerVRows& R, const u32x4 (&id)[2], const unsigned char* vt, const float* cp, const float* xs, const float* gt2) {
    R.cf[0] = *(const f32x4*)cp; R.cf[1] = *(const f32x4*)(cp + 4); R.cf[2] = *(const f32x4*)(cp + 8); R.cf[3] = *(const f32x4*)(cp + 12);
    R.xv = *(const f32x2*)xs; R.gv = *(const f32x2*)gt2;
#pragma unroll
    for (int i = 0; i < 16; ++i) R.q[i] = *(const u32x4*)(vt + (size_t)PEER_EXPERT(id, i) * D);
}
DI float xchg32(float v, bool hi) { const auto r = __builtin_amdgcn_permlane32_swap(__builtin_bit_cast(unsigned, v), __builtin_bit_cast(unsigned, v), false, false);
    return __builtin_bit_cast(float, hi ? r[0] : r[1]); }
DI float xchg16(float v, bool hi) { const auto r = __builtin_amdgcn_permlane16_swap(__builtin_bit_cast(unsigned, v), __builtin_bit_cast(unsigned, v), false, false);
    return __builtin_bit_cast(float, hi ? r[0] : r[1]); }
DI float xchg8(float v) { return __builtin_bit_cast(float, __builtin_amdgcn_mov_dpp(__builtin_bit_cast(int, v), 0x128, 0xF, 0xF, true)); }
DI void peer_v_compute(const PeerVRows& R, float* xdst, int lane) {
    f32x2 a[8];
#pragma unroll
    for (int j = 0; j < 8; ++j) a[j] = (f32x2){0.f, 0.f};
#pragma unroll
    for (int i = 0; i < 16; ++i) {
        const float c = R.cf[i >> 2][i & 3]; const f32x2 c2 = {c, c};
#pragma unroll
        for (int j = 0; j < 4; ++j) {
            a[2 * j] += c2 * __builtin_amdgcn_cvt_pk_f32_fp8((int)R.q[i][j], false);
            a[2 * j + 1] += c2 * __builtin_amdgcn_cvt_pk_f32_fp8((int)R.q[i][j], true);
        }
    }
    const bool b5 = (lane & 32) != 0, b4 = (lane & 16) != 0, b3 = (lane & 8) != 0;
    f32x2 k4[4];
#pragma unroll
    for (int j = 0; j < 4; ++j) { const f32x2 keep = b5 ? a[4 + j] : a[j], send = b5 ? a[j] : a[4 + j];
        k4[j] = keep + (f32x2){xchg32(send.x, b5), xchg32(send.y, b5)}; }
    f32x2 k2[2];
#pragma unroll
    for (int j = 0; j < 2; ++j) { const f32x2 keep = b4 ? k4[2 + j] : k4[j], send = b4 ? k4[j] : k4[2 + j];
        k2[j] = keep + (f32x2){xchg16(send.x, b4), xchg16(send.y, b4)}; }
    f32x2 k1;
    { const f32x2 keep = b3 ? k2[1] : k2[0], send = b3 ? k2[0] : k2[1];
        k1 = keep + (f32x2){xchg8(send.x), xchg8(send.y)}; }
    *(f32x2*)xdst = R.xv + R.gv * k1;
}
DI void phase_peer_v(const Params& p, const Frame& F, int l, bool dummy = false) {
    const int ntok = (l == 0) ? T : TL, lane = F.lane;
    const int slice = F.bid & 7, sw = (F.bid >> 3) * NWAVES + F.wave, nsw = (F.nb >> 3) * NWAVES;
    const unsigned char* vt = p.ws + WS_VTAB + (size_t)l * NEXP * D + 128 * slice + 16 * (lane & 7);
    const unsigned short* IDXg = (const unsigned short*)(p.ws + WS_IDX) + 16 * (lane >> 3);
    const float* CFg = (const float*)(p.ws + WS_GW) + 16 * (lane >> 3);
    const int last = ntok - 1;
    u32x4 sa[2], sb[2]; PeerVRows ra, rb;
#define V_SEL(S_, t_) do { const unsigned short* ip_ = IDXg + (size_t)min((t_), last) * 128; S_[0] = *(const u32x4*)ip_; S_[1] = *(const u32x4*)(ip_ + 8); } while (0)
    const int co = 128 * slice + 16 * (lane & 7) + ((lane & 32) ? 8 : 0) + ((lane & 16) ? 4 : 0) + ((lane & 8) ? 2 : 0);
#define V_ROWS(R_, S_, t_) do { const int t1_ = min((t_), last); peer_v_rows(R_, S_, vt, CFg + (size_t)t1_ * 128, xrow_ptr(p, t1_) + co, mod_vec(p, l, t1_, 5) + co); } while (0)
#define V_DO(R_, t_) do { const int t2_ = (t_); float* xd_ = (dummy ? (float*)(p.ws + WS_ST) + (size_t)t2_ * D : xrow_ptr(p, t2_)) + co; peer_v_compute(R_, xd_, lane); } while (0)
    V_SEL(sa, sw); V_SEL(sb, sw + nsw);
    V_ROWS(ra, sa, sw);
#pragma unroll 1
    for (int tok = sw; tok < ntok; tok += 2 * nsw) {
        V_SEL(sa, tok + 2 * nsw); V_ROWS(rb, sb, tok + nsw);
        V_DO(ra, tok);
        V_SEL(sb, tok + 3 * nsw); V_ROWS(ra, sa, tok + 2 * nsw);
        if (tok + nsw < ntok) V_DO(rb, tok + nsw);
    }
#undef V_SEL
#undef V_ROWS
#undef V_DO
}

#define XB_TMO      128
#define XB_XCNT(j)  (256  + 64 * (j))
#define XB_XSUB(j)  (1280 + 64 * (j))
#define XB_XGEN(j)  (2304 + 64 * (j))
#define XB_TOP      3328
#define XB_TOPGEN   3392
#define XCD_BAR_WORDS 3456
#define XB_SPIN_CAP (1u << 18)
DI unsigned xb_ld(unsigned* p)              { return __hip_atomic_load(p, __ATOMIC_RELAXED, __HIP_MEMORY_SCOPE_AGENT); }
DI unsigned xb_add(unsigned* p, unsigned v) { return __hip_atomic_fetch_add(p, v, __ATOMIC_RELAXED, __HIP_MEMORY_SCOPE_AGENT); }
DI unsigned xb_xcc_id() { return (unsigned)__builtin_amdgcn_s_getreg((3 << 11) | 20) & 0xFu; }
#define XB_SPIN(cond, bar) do { unsigned _sp = 0; while (cond) { __builtin_amdgcn_s_sleep(1); \
    if ((++_sp & 255u) == 0u) { if (xb_ld(&(bar)[XB_TMO])) break; if (_sp > XB_SPIN_CAP) { atomicAdd(&(bar)[XB_TMO], 1u); break; } } } } while (0)
struct XcdBarrier { unsigned* bar; unsigned x; volatile LAS unsigned* st; };
DI XcdBarrier xcd_barrier_post(unsigned* bar, volatile LAS unsigned* st) {
    XcdBarrier b; b.bar = bar; b.x = xb_xcc_id(); b.st = st;
    if (threadIdx.x == 0) (void)xb_add(&bar[XB_XCNT(b.x)], 1u);
    return b;
}
DI void xcd_barrier_complete(unsigned* bar, unsigned x, unsigned& nloc, unsigned& nx) {
    const unsigned G = gridDim.x * gridDim.y * gridDim.z;
    unsigned sum, cnt, mine, sp = 0u;
    for (;;) {
        sum = 0u; cnt = 0u; mine = 0u;
#pragma unroll
        for (unsigned j = 0; j < 16; ++j) { const unsigned c = xb_ld(&bar[XB_XCNT(j)]); sum += c; cnt += (c > 0u) ? 1u : 0u; mine = (j == x) ? c : mine; }
        if (sum == G) break;
        __builtin_amdgcn_s_sleep(1);
        if ((++sp & 255u) == 0u) { if (xb_ld(&bar[XB_TMO])) break; if (sp > XB_SPIN_CAP) { atomicAdd(&bar[XB_TMO], 1u); break; } }
    }
    nloc = mine > 0u ? mine : 1u; nx = cnt > 0u ? cnt : 1u;
}
DI void xcd_barrier(const XcdBarrier& b) {
    asm volatile("s_waitcnt vmcnt(0)" ::: "memory");
    __syncthreads();
    if (threadIdx.x == 0) {
        unsigned* bar = b.bar;
        __builtin_amdgcn_s_waitcnt(0);
        unsigned nloc = b.st[0], nx = b.st[1];
        if (nloc == 0u) { xcd_barrier_complete(bar, b.x, nloc, nx); b.st[0] = nloc; b.st[1] = nx; }
        const unsigned old = xb_add(&bar[XB_XSUB(b.x)], 1u);
        const unsigned gen = old / nloc;
        if (old + 1u == (gen + 1u) * nloc) {
            __builtin_amdgcn_fence(__ATOMIC_RELEASE, "agent");
            asm volatile("s_waitcnt vmcnt(0)" ::: "memory");
            const unsigned og = xb_add(&bar[XB_TOP], 1u);
            const unsigned tg = og / nx;
            if (og + 1u == (tg + 1u) * nx) xb_add(&bar[XB_TOPGEN], 1u);
            else XB_SPIN(xb_ld(&bar[XB_TOPGEN]) == tg, bar);
            __builtin_amdgcn_fence(__ATOMIC_ACQUIRE, "agent");
            xb_add(&bar[XB_XGEN(b.x)], 1u);
            asm volatile("s_waitcnt vmcnt(0)" ::: "memory");
        } else {
            XB_SPIN(xb_ld(&bar[XB_XGEN(b.x)]) == gen, bar);
            __builtin_amdgcn_fence(__ATOMIC_ACQUIRE, "agent");
            asm volatile("s_waitcnt vmcnt(0)" ::: "memory");
        }
    }
    __syncthreads();
}

constexpr int NPHASE = 25;
template <int PH> DI void run_phase(const Params& p, const Frame& F) {
    if constexpr (PH == 0) phase_prep(p, F);
    else if constexpr (PH == 1) phase_norm(p, F, 0, 0, true, T);
    else if constexpr (PH == 2) phase_g1(p, F, 0);
    else if constexpr (PH == 3) phase_mix(p, F, 0);
    else if constexpr (PH == 4) phase_g2(p, F, 0);
    else if constexpr (PH == 5) phase_g2sum(p, F);
    else if constexpr (PH == 6) phase_g3(p, F, 0);
    else if constexpr (PH == 7) phase_norm(p, F, 0, 1, false, T);
    else if constexpr (PH == 8) phase_g45(p, F, 0);
    else if constexpr (PH == 9) phase_sel(p, F, 0);
    else if constexpr (PH == 10) phase_peer_u(p, F, 0);
    else if constexpr (PH == 11) phase_peer_c(p, F, 0);
    else if constexpr (PH == 12) phase_peer_v(p, F, 0);
    else if constexpr (PH == 13) phase_norm(p, F, 1, 0, false, T);
    else if constexpr (PH == 14) phase_g1(p, F, 1);
    else if constexpr (PH == 15) phase_mix(p, F, 1);
    else if constexpr (PH == 16) phase_g2(p, F, 1);
    else if constexpr (PH == 17) phase_g3(p, F, 1);
    else if constexpr (PH == 18) phase_norm(p, F, 1, 1, false, TL);
    else if constexpr (PH == 19) phase_g45(p, F, 1);
    else if constexpr (PH == 20) phase_sel(p, F, 1);
    else if constexpr (PH == 21) phase_peer_u(p, F, 1);
    else if constexpr (PH == 22) phase_peer_c(p, F, 1);
    else if constexpr (PH == 23) phase_peer_v(p, F, 1);
    else if constexpr (PH == 24) phase_final(p, F);
}
DI Frame make_frame(unsigned char* lds_raw) {
    Frame F;
    F.lds = (LAS unsigned char*)lds_raw;
    int tid = threadIdx.x; asm volatile("" : "+v"(tid));
    int bid = blockIdx.x, nb = gridDim.x; asm volatile("" : "+s"(bid), "+s"(nb));
    F.tid = tid; F.lane = tid & 63; F.wave = __builtin_amdgcn_readfirstlane(tid >> 6); F.bid = bid; F.nb = nb;
    F.gw = bid * NWAVES + F.wave; F.ngw = nb * NWAVES; F.gtid = bid * NTHREADS + tid; F.ngt = nb * NTHREADS;
    return F;
}
template <int PH> DI void run_phase_fresh(unsigned char* lds_raw) {
#if defined(__HIP_DEVICE_COMPILE__)
    const __attribute__((address_space(4))) unsigned long long* pp = (const __attribute__((address_space(4))) unsigned long long*)__builtin_amdgcn_kernarg_segment_ptr();
    asm volatile("" : "+s"(pp));
    Params p;
#pragma unroll
    for (int i = 0; i < N_IN; ++i) p.in[i] = (const float*)(const __attribute__((address_space(1))) float*)pp[i];
    p.out = (float*)(__attribute__((address_space(1))) float*)pp[N_IN]; p.ws = (unsigned char*)(__attribute__((address_space(1))) unsigned char*)pp[N_IN + 1]; p.ph_lo = 0; p.ph_hi = 0;
#else
    Params p{};
#endif
    const Frame F = make_frame(lds_raw);
    run_phase<PH>(p, F);
}
template <int PH> __global__ void __launch_bounds__(NTHREADS, 2) phase_kernel(Params p) {
    extern __shared__ __attribute__((aligned(16))) unsigned char lds_raw[];
    run_phase_fresh<PH>(lds_raw);
}
template <int PH> DI void run_all(unsigned char* lds_raw, cg::grid_group& grid, const XcdBarrier& bar) {
    if constexpr (PH < NPHASE) {
        if constexpr (PH == PROBE_PH) {
            if constexpr (PH == 11 || PH == 22 || PH == 12 || PH == 23) {
#if defined(__HIP_DEVICE_COMPILE__)
                const __attribute__((address_space(4))) unsigned long long* pp = (const __attribute__((address_space(4))) unsigned long long*)__builtin_amdgcn_kernarg_segment_ptr();
                asm volatile("" : "+s"(pp));
                Params p;
#pragma unroll
                for (int i = 0; i < N_IN; ++i) p.in[i] = (const float*)(const __attribute__((address_space(1))) float*)pp[i];
                p.out = (float*)(__attribute__((address_space(1))) float*)pp[N_IN]; p.ws = (unsigned char*)(__attribute__((address_space(1))) unsigned char*)pp[N_IN + 1]; p.ph_lo = 0; p.ph_hi = 0;
                const Frame F = make_frame(lds_raw);
                if constexpr (PH == 11 || PH == 22) phase_peer_c(p, F, PH == 11 ? 0 : 1, true); else phase_peer_v(p, F, PH == 12 ? 0 : 1, true);
#endif
            } else run_phase_fresh<PH>(lds_raw);
            xcd_barrier(bar);
        }
        run_phase_fresh<PH>(lds_raw);
        if constexpr (PH + 1 < NPHASE) { xcd_barrier(bar); if constexpr (PROBE_SYNC) xcd_barrier(bar); }
        run_all<PH + 1>(lds_raw, grid, bar);
    }
}
__global__ void __launch_bounds__(NTHREADS, 2) mega(Params p) {
    extern __shared__ __attribute__((aligned(16))) unsigned char lds_raw[];
    cg::grid_group grid = cg::this_grid();
    volatile LAS unsigned* st = (volatile LAS unsigned*)((LAS unsigned char*)lds_raw + LDS_BAR_OFF);
    if (threadIdx.x < 2) st[threadIdx.x] = 0u;
    __syncthreads();
    const XcdBarrier bar = xcd_barrier_post((unsigned*)(p.ws + WS_CTL), st);
    if (p.ph_lo != 0) grid.sync();
    run_all<0>(lds_raw, grid, bar);
}

extern "C" void kernel_launch(void* const* d_in, const int* in_sizes, int n_in, void* d_out, int out_size, void* d_ws, size_t ws_size, hipStream_t stream) {
    static int grid = 0;
    if (grid == 0) {
        if (n_in != 23 || out_size != TL * D || ws_size < WS_END) { fprintf(stderr, "kernel_launch: unexpected shapes (n_in %d out %d ws %zu)\n", n_in, out_size, ws_size); grid = -1; return; }
        int dev = 0, cus = 0, per_cu = 0;
        (void)hipGetDevice(&dev);
        (void)hipDeviceGetAttribute(&cus, hipDeviceAttributeMultiprocessorCount, dev);
        (void)hipFuncSetAttribute((const void*)mega, hipFuncAttributeMaxDynamicSharedMemorySize, LDS_BYTES);
        (void)hipOccupancyMaxActiveBlocksPerMultiprocessor(&per_cu, (const void*)mega, NTHREADS, LDS_BYTES);
        if (per_cu < 1) { fprintf(stderr, "kernel_launch: occupancy query reports %d blocks per CU\n", per_cu); grid = -1; return; }
        grid = cus & ~7;
        if (grid < 8) { fprintf(stderr, "kernel_launch: needs at least 8 CUs\n"); grid = -1; return; }
    }
    if (grid < 0) return;
    (void)hipMemsetAsync((char*)d_ws + WS_CTL, 0, CTL_ZERO_BYTES, stream);
    Params p{};
    for (int i = 0; i < N_IN; ++i) p.in[i] = (const float*)d_in[i];
    p.out = (float*)d_out; p.ws = (unsigned char*)d_ws;
    void* args[] = {&p};
    hipError_t e = hipLaunchCooperativeKernel((const void*)mega, dim3(grid), dim3(NTHREADS), args, LDS_BYTES, stream);
    if (e != hipSuccess) fprintf(stderr, "cooperative launch failed: %s (grid %d)\n", hipGetErrorString(e), grid);
}
```

```cpp
#include <hip/hip_runtime.h>
#include <hip/hip_cooperative_groups.h>
#include <stdint.h>
#include <stdio.h>
namespace cg = cooperative_groups;

#ifndef PROBE_PH
#define PROBE_PH -1
#endif
#ifndef PROBE_SYNC
#define PROBE_SYNC 0
#endif
#ifndef MK_SINGLE
#define MK_SINGLE 0
#endif

#define LAS __attribute__((address_space(3)))
typedef unsigned short bf16_t;
typedef short bf16x8 __attribute__((ext_vector_type(8)));
typedef short s16x4 __attribute__((ext_vector_type(4)));
typedef float f32x4 __attribute__((ext_vector_type(4)));
typedef float f32x2 __attribute__((ext_vector_type(2)));
typedef float f32x16 __attribute__((ext_vector_type(16)));
typedef unsigned u32x4 __attribute__((ext_vector_type(4)));
typedef unsigned u32x2 __attribute__((ext_vector_type(2)));
typedef __bf16 bf16x2_t __attribute__((ext_vector_type(2)));
typedef _Float16 f16x2_t __attribute__((ext_vector_type(2)));
#define DI __device__ __forceinline__
DI unsigned pkh2(float lo, float hi) { f16x2_t v = {(_Float16)lo, (_Float16)hi}; return __builtin_bit_cast(unsigned, v); }
#define MFMA32(a, b, c) __builtin_amdgcn_mfma_f32_32x32x16_bf16((a), (b), (c), 0, 0, 0)

constexpr int D = 1024, NB = 8, SEQ = 4096, NCTX = 256, DEPTH = 2;
constexpr int TL = NB * SEQ, TC = NB * NCTX, T = TL + TC;
constexpr int INW = 4608, NMOD = 6 * D, PW = 1600, PN = 1536;
constexpr int VTS = SEQ + 64;
constexpr int QOFF = 0, KOFF = 512, VOFF = 640, POOLOFF = 768, SUOFF = 1024, SVOFF = 1280, GATEOFF = 1536;
constexpr int NEXP = 16384;
constexpr float EPS = 1e-6f;
constexpr float LOG2E = 1.4426950408889634f;
constexpr float QSCALE = 0.125f * LOG2E;

constexpr size_t MiB = 1u << 20;
constexpr size_t WS_CTL = 0, WS_MOD = 1 * MiB, CTL_ZERO_BYTES = 2 * MiB;
constexpr size_t WS_ROPE = 2 * MiB, WS_SGUW = 2 * MiB + 65536, WS_TSCALE = 3 * MiB;
constexpr size_t WS_WIN = 4 * MiB, WS_WBR = 22 * MiB, WS_WOUT = 26 * MiB, WS_WFOLD = 30 * MiB;
constexpr size_t WS_XCTX = 38 * MiB, WS_UTAB = 46 * MiB, WS_VTAB = 78 * MiB;
constexpr size_t WS_IDX = 110 * MiB, WS_GW = 120 * MiB;
constexpr size_t WS_H = 142 * MiB;
constexpr size_t WS_P = 210 * MiB, WS_Y = 318 * MiB, WS_MERGED = 386 * MiB, WS_VT = 454 * MiB, WS_VTC = 463 * MiB, WS_VST = 464 * MiB;
constexpr size_t WS_MP = 482 * MiB;
constexpr size_t WS_ST = 210 * MiB, WS_H8 = 346 * MiB, WS_HS = 380 * MiB, WS_SU = 482 * MiB;
constexpr size_t WS_END = 512 * MiB;
static_assert(WS_ST + (size_t)2048 * T * 2 <= WS_H8 && WS_H8 + (size_t)T * D <= WS_HS, "ST / H8 fit");
static_assert(WS_VST + (size_t)272 * 256 * 128 * 2 <= WS_SU && WS_VT + (size_t)NB * 2 * 64 * VTS * 2 <= WS_VTC, "VsT / VT fit");
static_assert(WS_H + (size_t)T * D * 2 <= WS_P, "H fits");
static_assert(WS_P + (size_t)T * PW * 2 <= WS_Y && WS_Y + (size_t)T * D * 2 <= WS_MERGED && WS_MERGED + (size_t)T * D * 2 <= WS_VT, "P/Y/MERGED fit");
static_assert(WS_IDX + (size_t)T * 128 * 2 <= WS_GW && WS_GW + (size_t)T * 128 * 4 <= WS_H && WS_SU + (size_t)T * 128 * 4 <= WS_END && WS_HS + (size_t)T * 4 <= WS_SU, "idx/gw/su fit");

constexpr int LDS_BYTES = 163840;
constexpr int LDS_BAR_OFF = LDS_BYTES - 64;
constexpr int NTHREADS = 512, NWAVES = 8;

enum { I_x, I_c, I_ctx, I_c_ctx, I_w_mod, I_b_mod, I_g_mix, I_g_ffn, I_w_in, I_attn_sink, I_pool_w, I_pool_scale, I_sgu_w, I_sgu_b, I_w_br_attn, I_w_br_pool, I_w_br_sgu, I_w_out, I_peer_wq, I_peer_subkeys, I_peer_u, I_peer_v, I_g_final, N_IN };
struct Params {
    const float* in[N_IN];
    float* out; unsigned char* ws;
    int ph_lo, ph_hi;
};

DI unsigned pk2(float lo, float hi) { f32x2 v = {lo, hi}; return __builtin_bit_cast(unsigned, __builtin_convertvector(v, bf16x2_t)); }
DI unsigned f2bf(float f) { return pk2(f, 0.f) & 0xffffu; }
DI float bf2f(unsigned short u) { return __builtin_bit_cast(float, (unsigned)u << 16); }
DI float bflo(unsigned w) { return __builtin_bit_cast(float, w << 16); }
DI float bfhi(unsigned w) { return __builtin_bit_cast(float, w & 0xffff0000u); }
DI int crow(int reg, int h) { return (reg & 3) + 8 * (reg >> 2) + 4 * h; }
DI float wave_sum(float v) {
#pragma unroll
    for (int o = 1; o < 64; o <<= 1) v += __shfl_xor(v, o);
    return v;
}
DI float sigmoidf_(float x) { return __builtin_amdgcn_rcpf(1.0f + __expf(-x)); }
DI float gelu_tanh(float x) { const float u = 0.7978845608028654f * (x + 0.044715f * x * x * x); return x * __builtin_amdgcn_rcpf(1.0f + __expf(-2.0f * u)); }
DI float silu_(float x) { return x * __builtin_amdgcn_rcpf(1.0f + __expf(-x)); }

struct Frame {
    int tid, lane, wave, gw, ngw, gtid, ngt, bid, nb;
    LAS unsigned char* lds;
};

template <int NM, int NN>
DI void wave_gemm(const bf16_t* __restrict__ A, int lda, const bf16_t* __restrict__ Bt, int ldb, int K, int m0, int n0, f32x16 (&acc)[NM][NN], int lane) {
    const int r = lane & 31, h = lane >> 5;
    const bf16_t* ap = A + (size_t)(m0 + r) * lda + 8 * h;
    const bf16_t* bp = Bt + (size_t)(n0 + r) * ldb + 8 * h;
    for (int k0 = 0; k0 < K; k0 += 64) {
        bf16x8 a[4][NM], b[4][NN];
#pragma unroll
        for (int s = 0; s < 4; ++s) {
#pragma unroll
            for (int i = 0; i < NM; ++i) a[s][i] = *(const bf16x8*)(ap + (size_t)(32 * i) * lda + k0 + 16 * s);
#pragma unroll
            for (int j = 0; j < NN; ++j) b[s][j] = *(const bf16x8*)(bp + (size_t)(32 * j) * ldb + k0 + 16 * s);
        }
#pragma unroll
        for (int s = 0; s < 4; ++s)
#pragma unroll
            for (int i = 0; i < NM; ++i)
#pragma unroll
                for (int j = 0; j < NN; ++j) acc[i][j] = MFMA32(a[s][i], b[s][j], acc[i][j]);
    }
}
template <int NM, int NN> DI void zero_acc(f32x16 (&acc)[NM][NN]) {
#pragma unroll
    for (int i = 0; i < NM; ++i)
#pragma unroll
        for (int j = 0; j < NN; ++j)
#pragma unroll
            for (int r = 0; r < 16; ++r) acc[i][j][r] = 0.f;
}

namespace pg8 {
constexpr int BM = 256, BK = 64, HALF = 128, HTB = HALF * BK * 2, STAGE_BYTES = 8 * HTB, NXCD = 8, WGM = 8, LD = 1024;
DI int lds_byte(int r, int c) { const int st = (r >> 4) * 2 + (c >> 5), rr = r & 15, cc = c & 31, ob = rr * 64 + cc * 2; return st * 1024 + (ob ^ (((ob >> 9) & 1) << 5)); }
DI void stage_rc(int b, int& R, int& C) { const int st = b / 1024, sb = b % 1024, swz = sb ^ (((sb >> 9) & 1) << 5); R = (st >> 1) * 16 + swz / 64; C = (st & 1) * 32 + (swz % 64) / 2; }
DI int perm32(int rho) { const int n = rho >> 4, i = rho & 15; return 8 * (i >> 2) + 4 * n + (i & 3); }
struct Unit { int pm, pn, sub, nt, mode; const char* a; const char* b; };
DI void tile_of(int L, int nM, int nN, int& pm, int& pn) {
    const int nwg = nM * nN; int wgid = L;
    { const int q = nwg / NXCD, r = nwg % NXCD, xcd = wgid % NXCD, off = wgid / NXCD; wgid = (xcd < r ? xcd * (q + 1) : r * (q + 1) + (xcd - r) * q) + off; }
    const int nig = WGM * nN, gid = wgid / nig, fm = gid * WGM, gsz = (nM - fm) < WGM ? (nM - fm) : WGM;
    pm = fm + ((wgid % nig) % gsz); pn = (wgid % nig) / gsz;
}
template <class Epi, class Sched>
DI void gemm_phase(LAS unsigned char* lds, const int tid, const Sched& S, const Epi& E) {
    const int wid = __builtin_amdgcn_readfirstlane(tid >> 6), lane = tid & 63, wr = wid >> 2, wc = wid & 3, fr = lane & 15, fq = lane >> 4;
    unsigned voffA[2], voffB[2];
#pragma unroll
    for (int i = 0; i < 2; ++i) { int R, C; stage_rc(tid * 16 + i * 8192, R, C); const int Rb = Epi::PERM ? ((R & ~31) + perm32(R & 31)) : R;
        voffA[i] = (unsigned)(R * LD + C) * 2u; voffB[i] = (unsigned)(Rb * LD + C) * 2u; }
    const size_t kstep = (size_t)(BK * 2);
    const size_t hstep = (size_t)HALF * LD * 2;
    const unsigned ldsw = (unsigned)wid * 1024u;
    const int aoff = lds_byte(wr * 64 + fr, fq * 8), boff = lds_byte(wc * 32 + fr, fq * 8);
#define PG8_SA(b, h) (((b) * 2 + (h)) * HTB)
#define PG8_SB(b, h) ((4 + (b) * 2 + (h)) * HTB)
#define PG8_STAGE(bufoff, gbase, voff) do { _Pragma("unroll") for (int _i = 0; _i < 2; ++_i) \
        __builtin_amdgcn_global_load_lds((const unsigned*)((const char*)(gbase) + (voff)[_i]), (LAS unsigned*)(lds + (bufoff) + ldsw + _i * 8192), 16, 0, 0); } while (0)
#define PG8_LDA(dst, b, h) do { _Pragma("unroll") for (int m = 0; m < 4; ++m) _Pragma("unroll") for (int k = 0; k < 2; ++k) dst[m][k] = *(const LAS bf16x8*)(lds + PG8_SA(b, h) + aoff + m * 2048 + k * 1024); } while (0)
#define PG8_LDB(dst, b, h) do { _Pragma("unroll") for (int n = 0; n < 2; ++n) _Pragma("unroll") for (int k = 0; k < 2; ++k) dst[n][k] = *(const LAS bf16x8*)(lds + PG8_SB(b, h) + boff + n * 2048 + k * 1024); } while (0)
#define PG8_MMA(ai, bj, At, Bt) do { __builtin_amdgcn_s_setprio(1); _Pragma("unroll") for (int m = 0; m < 4; ++m) _Pragma("unroll") for (int n = 0; n < 2; ++n) _Pragma("unroll") for (int k = 0; k < 2; ++k) \
        acc[ai][bj][m][n] = __builtin_amdgcn_mfma_f32_16x16x32_bf16(Bt[n][k], At[m][k], acc[ai][bj][m][n], 0, 0, 0); __builtin_amdgcn_s_setprio(0); } while (0)
#define PG8_WAIT_V(n) asm volatile("s_waitcnt vmcnt(" #n ")" ::: "memory")
#define PG8_WAIT_L(n) asm volatile("s_waitcnt lgkmcnt(" #n ")" ::: "memory")
#define PG8_BAR __builtin_amdgcn_s_barrier()
#define PG8_SCHED __builtin_amdgcn_sched_barrier(0)
    Unit cur, nxt; int ui = 0;
    if (!S.next(0, cur)) return;
    f32x4 acc[2][2][4][2];
#pragma unroll
    for (int a = 0; a < 2; ++a)
#pragma unroll
        for (int b = 0; b < 2; ++b)
#pragma unroll
            for (int m = 0; m < 4; ++m)
#pragma unroll
                for (int n = 0; n < 2; ++n) acc[a][b][m][n] = (f32x4){0.f, 0.f, 0.f, 0.f};
    bf16x8 At[4][2], B0[2][2], B1[2][2];
    const char* cA = cur.a; const char* cB = cur.b;
    PG8_STAGE(PG8_SB(0, 0), cB, voffB); PG8_STAGE(PG8_SB(0, 1), cB + hstep, voffB); PG8_STAGE(PG8_SA(0, 0), cA, voffA); PG8_STAGE(PG8_SA(0, 1), cA + hstep, voffA);
    if (wr == 1) PG8_BAR;
    PG8_WAIT_V(2); PG8_BAR;
    PG8_STAGE(PG8_SB(1, 0), cB + kstep, voffB); PG8_STAGE(PG8_SA(1, 0), cA + kstep, voffA); PG8_STAGE(PG8_SB(1, 1), cB + hstep + kstep, voffB);
    PG8_WAIT_V(6); PG8_BAR;
    for (;;) {
        const bool has_next = S.next(ui + 1, nxt);
        const char* nA = has_next ? nxt.a : cA; const char* nB = has_next ? nxt.b : cB;
        const int nt = cur.nt;
        for (int t = 0; t < nt; t += 2) {
            const bool last = (t == nt - 2);
            const char* a1 = cA + (size_t)(t + 1) * kstep;
            const char* a2 = last ? nA : cA + (size_t)(t + 2) * kstep; const char* b2 = last ? nB : cB + (size_t)(t + 2) * kstep;
            const char* a3 = a2 + kstep; const char* b3 = b2 + kstep;
            PG8_LDB(B0, 0, 0); PG8_LDB(B1, 0, 1); PG8_SCHED; PG8_LDA(At, 0, 0); PG8_STAGE(PG8_SA(1, 1), a1 + hstep, voffA);
            PG8_WAIT_V(8); PG8_WAIT_L(0); PG8_BAR; PG8_MMA(0, 0, At, B0); PG8_MMA(0, 1, At, B1); PG8_BAR; PG8_SCHED;
            PG8_LDA(At, 0, 1); PG8_STAGE(PG8_SB(0, 0), b2, voffB); PG8_STAGE(PG8_SB(0, 1), b2 + hstep, voffB); PG8_STAGE(PG8_SA(0, 0), a2, voffA);
            PG8_WAIT_V(8); PG8_WAIT_L(0); PG8_BAR; PG8_MMA(1, 0, At, B0); PG8_MMA(1, 1, At, B1); PG8_BAR; PG8_SCHED;
            PG8_LDB(B0, 1, 0); PG8_LDB(B1, 1, 1); PG8_SCHED; PG8_LDA(At, 1, 0); PG8_STAGE(PG8_SA(0, 1), a2 + hstep, voffA);
            PG8_WAIT_V(8); PG8_WAIT_L(0); PG8_BAR; PG8_MMA(0, 0, At, B0); PG8_MMA(0, 1, At, B1); PG8_BAR; PG8_SCHED;
            PG8_LDA(At, 1, 1); PG8_STAGE(PG8_SB(1, 0), b3, voffB); PG8_STAGE(PG8_SB(1, 1), b3 + hstep, voffB); PG8_STAGE(PG8_SA(1, 0), a3, voffA);
            PG8_WAIT_V(8); PG8_WAIT_L(0); PG8_BAR; PG8_MMA(1, 0, At, B0); PG8_MMA(1, 1, At, B1); PG8_BAR; PG8_SCHED;
        }
        if (wr == 0) PG8_BAR;
        E(acc, cur, wr, wc, fr, fq);
        if (!has_next) break;
        if (!E.keeps(cur)) {
#pragma unroll
        for (int a = 0; a < 2; ++a)
#pragma unroll
            for (int b = 0; b < 2; ++b)
#pragma unroll
                for (int m = 0; m < 4; ++m)
#pragma unroll
                    for (int n = 0; n < 2; ++n) acc[a][b][m][n] = (f32x4){0.f, 0.f, 0.f, 0.f};
        }
        cur = nxt; cA = nA; cB = nB; ++ui;
        if (wr == 1) PG8_BAR;
    }
    PG8_WAIT_V(0);
    PG8_BAR;
#undef PG8_SA
#undef PG8_SB
#undef PG8_STAGE
#undef PG8_LDA
#undef PG8_LDB
#undef PG8_MMA
#undef PG8_WAIT_V
#undef PG8_WAIT_L
#undef PG8_BAR
#undef PG8_SCHED
}
}

DI void transpose_item(const float* W, int K, int N, bf16_t* WT, int ldd, int row_off, int col_off, LAS float* scr, int item, int lane) {
    const int nblk = N / 32, kb = item / nblk, nb = item % nblk, k0 = 64 * kb, n0 = 32 * nb;
#pragma unroll 8
    for (int i = 0; i < 32; ++i) { const int kk = 2 * i + (lane >> 5); scr[kk * 33 + (lane & 31)] = W[(size_t)(k0 + kk) * N + n0 + (lane & 31)]; }
    asm volatile("s_waitcnt lgkmcnt(0)" ::: "memory");
    const int c = lane & 7;
#pragma unroll
    for (int j = 0; j < 4; ++j) { const int n = (lane >> 3) + 8 * j; const LAS float* s = scr + (8 * c) * 33 + n;
        u32x4 o; o.x = pk2(s[0 * 33], s[1 * 33]); o.y = pk2(s[2 * 33], s[3 * 33]); o.z = pk2(s[4 * 33], s[5 * 33]); o.w = pk2(s[6 * 33], s[7 * 33]);
        *(u32x4*)(WT + (size_t)(row_off + n0 + n) * ldd + col_off + k0 + 8 * c) = o; }
    asm volatile("s_waitcnt lgkmcnt(0)" ::: "memory");
}

DI void convert_tables(const Params& p, const Frame& F) {
    for (int it0 = 4 * F.gw; it0 < 4 * NEXP; it0 += 4 * F.ngw) {
        f32x4 v[4][4];
#pragma unroll
        for (int u = 0; u < 4; ++u) {
            const int it = it0 + u, e = it & (NEXP - 1), tbl = (it >> 14) & 1, l = it >> 15;
            const f32x4* src = (const f32x4*)((tbl ? p.in[I_peer_v] : p.in[I_peer_u]) + ((size_t)l * NEXP + e) * D) + 4 * F.lane;
#pragma unroll
            for (int j = 0; j < 4; ++j) v[u][j] = src[j];
        }
#pragma unroll
        for (int u = 0; u < 4; ++u) {
            const int it = it0 + u, e = it & (NEXP - 1), tbl = (it >> 14) & 1, l = it >> 15;
            float am = 0.f;
#pragma unroll
            for (int j = 0; j < 4; ++j) am = fmaxf(am, fmaxf(fmaxf(fabsf(v[u][j].x), fabsf(v[u][j].y)), fmaxf(fabsf(v[u][j].z), fabsf(v[u][j].w))));
#pragma unroll
            for (int o = 1; o < 64; o <<= 1) am = fmaxf(am, __shfl_xor(am, o));
            const float sc = (am > 0.f) ? exp2f(floorf(log2f(224.0f / am))) : 1.0f;
            u32x4 q;
#pragma unroll
            for (int j = 0; j < 4; ++j) { int w = 0; w = __builtin_amdgcn_cvt_pk_fp8_f32(v[u][j].x * sc, v[u][j].y * sc, w, false); w = __builtin_amdgcn_cvt_pk_fp8_f32(v[u][j].z * sc, v[u][j].w * sc, w, true); q[j] = (unsigned)w; }
            *(u32x4*)(p.ws + (tbl ? WS_VTAB : WS_UTAB) + ((size_t)l * NEXP + e) * D + 16 * F.lane) = q;
            if (F.lane == 0) ((float*)(p.ws + WS_TSCALE))[(l * 2 + tbl) * NEXP + e] = 1.0f / sc;
        }
    }
}

DI void phase_prep(const Params& p, const Frame& F) {
    unsigned char* ws = p.ws;
    {
        LAS float* wq = (LAS float*)F.lds;
        LAS float* skl = wq + 128 * 65;
        for (int it = F.bid; it < 2 * 16 * 16; it += F.nb) {
            const int cc = it & 15, hp = (it >> 4) & 15, l = it >> 8;
            const float* src = p.in[I_peer_wq] + (size_t)l * D * 2048 + hp * 128;
            const float* sks = p.in[I_peer_subkeys] + (size_t)(l * 16 + hp) * 128 * 128;
            __syncthreads();
            { float tw[16]; f32x4 ts[8];
#pragma unroll
              for (int it = 0; it < 16; ++it) { const int e = F.tid + it * NTHREADS, ci = e >> 7, d = e & 127; tw[it] = src[(size_t)(cc * 64 + ci) * 2048 + d]; }
#pragma unroll
              for (int it = 0; it < 8; ++it) { const int e = F.tid + it * NTHREADS, key = e >> 5, d4 = (e & 31) * 4; ts[it] = *(const f32x4*)(sks + key * 128 + d4); }
#pragma unroll
              for (int it = 0; it < 16; ++it) { const int e = F.tid + it * NTHREADS, ci = e >> 7, d = e & 127; wq[d * 65 + ci] = tw[it]; }
#pragma unroll
              for (int it = 0; it < 8; ++it) { const int e = F.tid + it * NTHREADS, key = e >> 5, d4 = (e & 31) * 4; *(LAS f32x4*)(skl + key * 132 + d4) = ts[it]; } }
            __syncthreads();
            const int ci = F.tid & 63, kg = F.tid >> 6;
            float acc[16];
#pragma unroll
            for (int k = 0; k < 16; ++k) acc[k] = 0.f;
#pragma unroll 2
            for (int d = 0; d < 128; d += 4) {
                const float w0 = wq[d * 65 + ci], w1 = wq[(d + 1) * 65 + ci], w2 = wq[(d + 2) * 65 + ci], w3 = wq[(d + 3) * 65 + ci];
#pragma unroll
                for (int k = 0; k < 16; ++k) { const f32x4 s = *(const LAS f32x4*)(skl + (16 * kg + k) * 132 + d); acc[k] += w0 * s.x + w1 * s.y + w2 * s.z + w3 * s.w; }
            }
            bf16_t* dst = (bf16_t*)(ws + WS_WFOLD) + ((size_t)l * 2048 + hp * 128 + 16 * kg) * D + cc * 64 + ci;
#pragma unroll
            for (int k = 0; k < 16; ++k) dst[(size_t)k * D] = (bf16_t)f2bf(acc[k]);
        }
        __syncthreads();
    }
    {
        LAS float* scr = (LAS float*)(F.lds + F.wave * 16384);
        constexpr int I_IN = (D / 64) * (INW / 32), I_BA = (512 / 64) * (D / 32), I_BS = (256 / 64) * (D / 32), I_O = (D / 64) * (D / 32);
        constexpr int PER_L = I_IN + I_BA + I_BS + I_O;
        for (int it = F.gw; it < 2 * PER_L; it += F.ngw) {
            const int l = it / PER_L; int r = it % PER_L;
            if (r < I_IN) { transpose_item(p.in[I_w_in] + (size_t)l * D * INW, D, INW, (bf16_t*)(ws + WS_WIN) + (size_t)l * INW * D, D, 0, 0, scr, r, F.lane); continue; } r -= I_IN;
            if (r < I_BA) { transpose_item(p.in[I_w_br_attn] + (size_t)l * 512 * D, 512, D, (bf16_t*)(ws + WS_WBR) + (size_t)l * D * D, D, 0, 0, scr, r, F.lane); continue; } r -= I_BA;
            if (r < I_BS) { transpose_item(p.in[I_w_br_sgu] + (size_t)l * 256 * D, 256, D, (bf16_t*)(ws + WS_WBR) + (size_t)l * D * D, D, 0, 768, scr, r, F.lane); continue; } r -= I_BS;
            transpose_item(p.in[I_w_out] + (size_t)l * D * D, D, D, (bf16_t*)(ws + WS_WOUT) + (size_t)l * D * D, D, 0, 0, scr, r, F.lane);
        }
    }
    for (int i = F.gtid; i < 2 * 256 * D; i += F.ngt) {
        const int n = i & 1023, rc = (i >> 10) & 255, l = i >> 18, g = rc >> 6;
        const float* pw = p.in[I_pool_w] + ((size_t)l * 256 + rc) * 64;
        const float* ps = p.in[I_pool_scale] + l * 256 + 64 * g;
        const float* wb = p.in[I_w_br_pool] + ((size_t)l * 256 + 64 * g) * D + n;
        float a = 0.f;
#pragma unroll 16
        for (int e = 0; e < 64; ++e) a += pw[e] * ps[e] * wb[(size_t)e * D];
        ((bf16_t*)(ws + WS_WBR))[(size_t)l * D * D + (size_t)n * D + 512 + rc] = (bf16_t)f2bf(a);
    }
    for (int i = F.gtid; i < 2 * 4 * 128 * 128; i += F.ngt) ((bf16_t*)(ws + WS_SGUW))[i] = (bf16_t)f2bf(p.in[I_sgu_w][i]);
    for (int i = F.gtid; i < 64 * 16; i += F.ngt) {
        const int pos = i >> 4, fi = i & 15;
        const float inv = powf(10000.0f, -(float)fi / 16.0f);
        const float ang = (float)pos * inv;
        ((f32x2*)(ws + WS_ROPE))[i] = (f32x2){cosf(ang), sinf(ang)};
    }
    convert_tables(p, F);
    {
        float* MOD = (float*)(ws + WS_MOD);
        LAS float* scd = (LAS float*)F.lds;
        LAS float* red = scd + 9 * D;
        __syncthreads();
        { float tc[18];
#pragma unroll
          for (int it = 0; it < 18; ++it) { const int e = F.tid + it * NTHREADS, r = e >> 10, k = e & 1023; tc[it] = (r < 8) ? p.in[I_c][r * D + k] : p.in[I_c_ctx][k]; }
#pragma unroll
          for (int it = 0; it < 18; ++it) scd[F.tid + it * NTHREADS] = silu_(tc[it]); }
        __syncthreads();
        for (int it = F.bid; it < 2 * 96; it += F.nb) {
            const int cgp = it % 96, l = it / 96, col = cgp * 64 + F.lane;
            float acc[9];
#pragma unroll
            for (int r = 0; r < 9; ++r) acc[r] = 0.f;
            const float* wp = p.in[I_w_mod] + ((size_t)l * D + F.wave * 128) * NMOD + col;
#pragma unroll 16
            for (int k = 0; k < 128; ++k) {
                const float w = wp[(size_t)k * NMOD];
#pragma unroll
                for (int r = 0; r < 9; ++r) acc[r] += scd[r * D + F.wave * 128 + k] * w;
            }
#pragma unroll
            for (int r = 0; r < 9; ++r) red[(F.wave * 9 + r) * 64 + F.lane] = acc[r];
            __syncthreads();
            for (int e = F.tid; e < 9 * 64; e += NTHREADS) {
                const int r = e >> 6, ln = e & 63; float s = p.in[I_b_mod][l * NMOD + cgp * 64 + ln];
#pragma unroll
                for (int w = 0; w < 8; ++w) s += red[(w * 9 + r) * 64 + ln];
                MOD[((size_t)l * 9 + r) * NMOD + cgp * 64 + ln] = s;
            }
            __syncthreads();
        }
    }
}

DI const float* mod_vec(const Params& p, int l, int row, int j) {
    const int r = row < TL ? row / SEQ : 8;
    return (const float*)(p.ws + WS_MOD) + ((size_t)l * 9 + r) * NMOD + j * D;
}
DI float* xrow_ptr(const Params& p, int row) { return row < TL ? p.out + (size_t)row * D : (float*)(p.ws + WS_XCTX) + (size_t)(row - TL) * D; }
DI const float* xin_ptr(const Params& p, int row) { return row < TL ? p.in[I_x] + (size_t)row * D : p.in[I_ctx] + (size_t)(row - TL) * D; }

DI void phase_norm(const Params& p, const Frame& F, int l, int which  , bool from_input, int nrows) {
    const float* g = (which == 0 ? p.in[I_g_mix] : p.in[I_g_ffn]) + l * D;
    const int lane = F.lane;
    f32x4 gg[4];
#pragma unroll
    for (int j = 0; j < 4; ++j) gg[j] = ((const f32x4*)g)[lane + 64 * j];
    for (int row0 = 2 * F.gw; row0 < nrows; row0 += 2 * F.ngw) {
        f32x4 v[2][4], s1[2][4], s2[2][4];
#pragma unroll
        for (int u = 0; u < 2; ++u) {
            const int row = row0 + u;
            const float* src = from_input ? xin_ptr(p, row) : xrow_ptr(p, row);
            const float* sh = mod_vec(p, l, row, which * 3 + 0); const float* sc = mod_vec(p, l, row, which * 3 + 1);
#pragma unroll
            for (int j = 0; j < 4; ++j) { v[u][j] = ((const f32x4*)src)[lane + 64 * j]; s1[u][j] = ((const f32x4*)sh)[lane + 64 * j]; s2[u][j] = ((const f32x4*)sc)[lane + 64 * j]; }
        }
#pragma unroll
        for (int u = 0; u < 2; ++u) {
            float ss = 0.f;
#pragma unroll
            for (int j = 0; j < 4; ++j) ss += v[u][j].x * v[u][j].x + v[u][j].y * v[u][j].y + v[u][j].z * v[u][j].z + v[u][j].w * v[u][j].w;
            const float rinv = rsqrtf(wave_sum(ss) * (1.0f / D) + EPS);
            bf16_t* dst = (bf16_t*)(p.ws + WS_H) + (size_t)(row0 + u) * D;
#pragma unroll
            for (int j = 0; j < 4; ++j) {
                const f32x4 o = v[u][j] * rinv * gg[j] * (s2[u][j] + 1.0f) + s1[u][j];
                u32x2 w; w.x = pk2(o.x, o.y); w.y = pk2(o.z, o.w);
                ((u32x2*)dst)[lane + 64 * j] = w;
            }
        }
    }
}
DI void phase_final(const Params& p, const Frame& F) {
    f32x4 gg[4];
#pragma unroll
    for (int j = 0; j < 4; ++j) gg[j] = ((const f32x4*)p.in[I_g_final])[F.lane + 64 * j];
    for (int row0 = 2 * F.gw; row0 < TL; row0 += 2 * F.ngw) {
        f32x4 v[2][4];
#pragma unroll
        for (int u = 0; u < 2; ++u)
#pragma unroll
            for (int j = 0; j < 4; ++j) v[u][j] = ((const f32x4*)(p.out + (size_t)(row0 + u) * D))[F.lane + 64 * j];
#pragma unroll
        for (int u = 0; u < 2; ++u) {
            float ss = 0.f;
#pragma unroll
            for (int j = 0; j < 4; ++j) ss += v[u][j].x * v[u][j].x + v[u][j].y * v[u][j].y + v[u][j].z * v[u][j].z + v[u][j].w * v[u][j].w;
            const float rinv = rsqrtf(wave_sum(ss) * (1.0f / D) + EPS);
            f32x4* xr = (f32x4*)(p.out + (size_t)(row0 + u) * D);
#pragma unroll
            for (int j = 0; j < 4; ++j) xr[F.lane + 64 * j] = v[u][j] * rinv * gg[j];
        }
    }
}

DI float lane_xor32(float v, bool hi) { const auto r = __builtin_amdgcn_permlane32_swap(__builtin_bit_cast(unsigned, v), __builtin_bit_cast(unsigned, v), false, false);
    return __builtin_bit_cast(float, hi ? r[0] : r[1]); }
struct EpiG1 {
    DI bool keeps(const pg8::Unit&) const { return false; }
    static constexpr bool PERM = true;
    unsigned char* ws;
    DI void operator()(const f32x4 (&acc)[2][2][4][2], const pg8::Unit& u, int wr, int wc, int fr, int fq) const {
        bf16_t* P = (bf16_t*)(ws + WS_P);
        const int rbase = u.pm * 256 + wr * 64 + fr;
        const bool hi = fq >= 2;
#pragma unroll
        for (int ai = 0; ai < 2; ++ai) {
            f32x4 cs[4][4];
            const bool lat = u.pm < TL / 256;
            if (u.pn < 3 && lat) {
#pragma unroll
                for (int m = 0; m < 4; ++m) {
                    const int t = (rbase + 128 * ai + 16 * m) & (SEQ - 1), pos = (wc & 1) ? (t & 63) : (t >> 6);
                    const f32x4* tab = (const f32x4*)(ws + WS_ROPE) + (pos * 16 + 8 * (fq & 1)) / 2;
#pragma unroll
                    for (int j2 = 0; j2 < 4; ++j2) cs[m][j2] = tab[j2];
                }
            }
#pragma unroll
            for (int m = 0; m < 4; ++m) {
                const int row = rbase + 128 * ai + 16 * m;
#pragma unroll
                for (int bj = 0; bj < 2; ++bj) {
                    const int c0 = u.pn * 256 + 128 * bj + 32 * wc + 8 * fq;
                    float v[8];
#pragma unroll
                    for (int j = 0; j < 4; ++j) { v[j] = acc[ai][bj][m][0][j]; v[4 + j] = acc[ai][bj][m][1][j]; }
                    if (c0 < VOFF) {
                        const float sc = (c0 < KOFF) ? QSCALE : 1.0f;
                        u32x4 o;
#pragma unroll
                        for (int j2 = 0; j2 < 4; ++j2) {
                            const f32x4 c4 = cs[m][j2];
                            const float o0 = lane_xor32(v[2 * j2], hi), o1 = lane_xor32(v[2 * j2 + 1], hi);
                            float r0 = hi ? (v[2 * j2] * c4.x + o0 * c4.y) : (v[2 * j2] * c4.x - o0 * c4.y);
                            float r1 = hi ? (v[2 * j2 + 1] * c4.z + o1 * c4.w) : (v[2 * j2 + 1] * c4.z - o1 * c4.w);
                            if (!lat) { r0 = v[2 * j2]; r1 = v[2 * j2 + 1]; }
                            o[j2] = pk2(r0 * sc, r1 * sc);
                        }
                        *(u32x4*)(P + (size_t)row * PW + c0) = o;
                    } else if (c0 < POOLOFF) {
                        const int hk = wc >> 1, d0 = 32 * (wc & 1) + 8 * fq;
                        if (lat) { const int b = row / SEQ, t = row & (SEQ - 1);
                            bf16_t* vt = (bf16_t*)(ws + WS_VT) + ((size_t)(b * 2 + hk) * 64 + d0) * VTS + t;
#pragma unroll
                            for (int j = 0; j < 8; ++j) vt[(size_t)j * VTS] = (bf16_t)f2bf(v[j]);
                        } else { const int rc = row - TL, b = rc / NCTX, jc = rc & (NCTX - 1);
                            bf16_t* vt = (bf16_t*)(ws + WS_VTC) + ((size_t)(b * 2 + hk) * 64 + d0) * NCTX + jc;
#pragma unroll
                            for (int j = 0; j < 8; ++j) vt[(size_t)j * NCTX] = (bf16_t)f2bf(v[j]);
                        }
                    } else if (c0 < SUOFF) {
                        u32x4 o;
#pragma unroll
                        for (int j2 = 0; j2 < 4; ++j2) o[j2] = pk2(v[2 * j2], v[2 * j2 + 1]);
                        *(u32x4*)(P + (size_t)row * PW + c0) = o;
                    } else if (c0 < SVOFF) {
                        u32x4 o;
#pragma unroll
                        for (int j2 = 0; j2 < 4; ++j2) o[j2] = pk2(gelu_tanh(v[2 * j2]), gelu_tanh(v[2 * j2 + 1]));
                        *(u32x4*)(P + (size_t)row * PW + c0) = o;
                    } else {
                        const int c = c0 - SVOFF, chunk = row >> 7, q = row & 127;
                        bf16_t* vs = (bf16_t*)(ws + WS_VST) + ((size_t)chunk * 256 + c) * 128 + q;
#pragma unroll
                        for (int j = 0; j < 8; ++j) vs[j * 128] = (bf16_t)f2bf(gelu_tanh(v[j]));
                    }
                }
            }
            asm volatile("" ::: "memory");
        }
    }
};
struct SchedGrid {
    int nM, nN, G, c; const char* A; const char* B;
    int n_extra, ex_pm0, ex_pn;
    DI bool next(int i, pg8::Unit& u) const {
        const int L = i * G + c, n = nM * nN; if (L >= n + n_extra) return false;
        if (L < n) pg8::tile_of(L, nM, nN, u.pm, u.pn); else { u.pm = ex_pm0 + (L - n); u.pn = ex_pn; }
        u.sub = 0; u.nt = D / 64; u.mode = 0;
        u.a = A + (size_t)u.pm * 256 * D * 2; u.b = B + (size_t)u.pn * 256 * D * 2; return true;
    }
};

DI void phase_g1(const Params& p, const Frame& F, int l) {
    SchedGrid S{(l == 0 ? T : TL) / 256, PN / 256, F.nb, F.bid, (const char*)(p.ws + WS_H), (const char*)(p.ws + WS_WIN) + (size_t)l * INW * D * 2,
                (l == 0) ? 0 : TC / 256, TL / 256, 2};
    EpiG1 E{p.ws};
    pg8::gemm_phase(F.lds, F.tid, S, E);
}

DI bf16x8 pack8(const f32x16& x, int s) {
    u32x4 pk;
#pragma unroll
    for (int j = 0; j < 4; ++j) { f32x2 v = {x[8 * s + 2 * j], x[8 * s + 2 * j + 1]}; pk[j] = __builtin_bit_cast(unsigned, __builtin_convertvector(v, bf16x2_t)); }
    return __builtin_bit_cast(bf16x8, pk);
}

DI float lane_x32(float v, bool hi) { const auto r = __builtin_amdgcn_permlane32_swap(__builtin_bit_cast(unsigned, v), __builtin_bit_cast(unsigned, v), false, false);
    return __builtin_bit_cast(float, hi ? r[0] : r[1]); }
struct AttnFrags { bf16x8 kf[4]; s16x4 vf[2][4]; };
DI void attn_block(const bf16x8 (&qf)[4], const AttnFrags& f, int mask_mode, int kq_off, int lane, float& m, float& lpart, f32x16 (&o)[2]) {
    const int h = lane >> 5;
    f32x16 st;
#pragma unroll
    for (int r = 0; r < 16; ++r) st[r] = 0.f;
#pragma unroll
    for (int s = 0; s < 4; ++s) st = MFMA32(f.kf[s], qf[s], st);
    if (mask_mode) {
#pragma unroll
        for (int r = 0; r < 16; ++r) { const int dlt = kq_off + crow(r, h); if (dlt > 128 || dlt < -128) st[r] = -1e30f; }
    }
    float bm = st[0];
#pragma unroll
    for (int r = 1; r < 16; ++r) bm = fmaxf(bm, st[r]);
    bm = fmaxf(bm, lane_x32(bm, h != 0));
    const float mn = fmaxf(m, bm);
    if (__builtin_amdgcn_ballot_w64(mn > m) != 0ull) {
        const float alpha = __builtin_amdgcn_exp2f(m - mn);
        lpart *= alpha;
#pragma unroll
        for (int d = 0; d < 2; ++d)
#pragma unroll
            for (int r = 0; r < 16; ++r) o[d][r] *= alpha;
        m = mn;
    }
    float ps = 0.f;
#pragma unroll
    for (int r = 0; r < 16; ++r) { st[r] = __builtin_amdgcn_exp2f(st[r] - m); ps += st[r]; }
    lpart += ps;
    const bf16x8 pf0 = pack8(st, 0), pf1 = pack8(st, 1);
#pragma unroll
    for (int d = 0; d < 2; ++d) {
        const bf16x8 v0 = __builtin_shufflevector(f.vf[d][0], f.vf[d][1], 0, 1, 2, 3, 4, 5, 6, 7), v1 = __builtin_shufflevector(f.vf[d][2], f.vf[d][3], 0, 1, 2, 3, 4, 5, 6, 7);
        o[d] = MFMA32(v0, pf0, o[d]);
        o[d] = MFMA32(v1, pf1, o[d]);
    }
}

constexpr int AKP = 144, AVWP = 648, AVCP = 520;
constexpr int ALDS_KW = 0, ALDS_VW = ALDS_KW + 320 * AKP, ALDS_KC = ALDS_VW + 64 * AVWP, ALDS_VC = ALDS_KC + 256 * AKP, ALDS_END = ALDS_VC + 64 * AVCP;
static_assert(ALDS_END <= LDS_BAR_OFF && (ALDS_VW % 16) == 0 && (ALDS_KC % 16) == 0 && (ALDS_VC % 8) == 0, "attention LDS map");
DI void attn_lds_frags(AttnFrags& f, const LAS unsigned char* kp, const LAS unsigned char* vp, int vpitch32) {
#pragma unroll
    for (int s = 0; s < 4; ++s) f.kf[s] = *(const LAS bf16x8*)(kp + 32 * s);
#pragma unroll
    for (int d = 0; d < 2; ++d)
#pragma unroll
        for (int q = 0; q < 4; ++q) f.vf[d][q] = *(const LAS s16x4*)(vp + d * vpitch32 + 16 * q);
}
DI void attn_unit(const Params& p, const Frame& F, int l, int unit) {
    const int lane = F.lane, r = lane & 31, h = lane >> 5, tid = F.tid;
    const bf16_t* P = (const bf16_t*)(p.ws + WS_P);
    const bf16_t* VT = (const bf16_t*)(p.ws + WS_VT);
    const bf16_t* VTC = (const bf16_t*)(p.ws + WS_VTC);
    bf16_t* Y = (bf16_t*)(p.ws + WS_Y);
    const bool latent = unit < 1024;
    int b, hk, p0, q0row;
    if (latent) { const int pb = unit & 63; hk = (unit >> 6) & 1; b = unit >> 7; p0 = pb * 64; q0row = b * SEQ + p0; }
    else { const int u2 = unit - 1024, pb = u2 & 3; hk = (u2 >> 2) & 1; b = u2 >> 3; p0 = pb * 64; q0row = TL + b * NCTX + p0; }
    const int w0 = p0 - 128;
    u32x4 kw[5], vw[5], kc[4], vc[4];
    if (latent) {
#pragma unroll
        for (int it = 0; it < 5; ++it) {
            const int i = tid + it * NTHREADS, row = i >> 3, ck = i & 7, pos = min(max(w0 + row, 0), SEQ - 1);
            kw[it] = *(const u32x4*)(P + (size_t)(b * SEQ + pos) * PW + KOFF + hk * 64 + 8 * ck);
            const int d = i / 40, cv = i % 40, pv = min(max(w0 + 8 * cv, 0), SEQ - 8);
            vw[it] = *(const u32x4*)(VT + ((size_t)(b * 2 + hk) * 64 + d) * VTS + pv);
        }
    }
#pragma unroll
    for (int it = 0; it < 4; ++it) {
        const int i = tid + it * NTHREADS;
        kc[it] = *(const u32x4*)(P + (size_t)(TL + b * NCTX + (i >> 3)) * PW + KOFF + hk * 64 + 8 * (i & 7));
        vc[it] = *(const u32x4*)(VTC + ((size_t)(b * 2 + hk) * 64 + (i >> 5)) * NCTX + 8 * (i & 31));
    }
    __syncthreads();
    if (latent) {
#pragma unroll
        for (int it = 0; it < 5; ++it) {
            const int i = tid + it * NTHREADS, row = i >> 3, ck = i & 7;
            *(LAS u32x4*)(F.lds + ALDS_KW + row * AKP + 16 * ck) = kw[it];
            const int d = i / 40, cv = i % 40;
            LAS u32x2* dst = (LAS u32x2*)(F.lds + ALDS_VW + d * AVWP + 16 * cv); dst[0] = (u32x2){vw[it].x, vw[it].y}; dst[1] = (u32x2){vw[it].z, vw[it].w};
        }
    }
#pragma unroll
    for (int it = 0; it < 4; ++it) {
        const int i = tid + it * NTHREADS;
        *(LAS u32x4*)(F.lds + ALDS_KC + (i >> 3) * AKP + 16 * (i & 7)) = kc[it];
        LAS u32x2* dst = (LAS u32x2*)(F.lds + ALDS_VC + (i >> 5) * AVCP + 16 * (i & 31)); dst[0] = (u32x2){vc[it].x, vc[it].y}; dst[1] = (u32x2){vc[it].z, vc[it].w};
    }
    const int head = 4 * hk + (F.wave & 3), ph = F.wave >> 2, pw = p0 + 32 * ph, qrow = q0row + 32 * ph;
    bf16x8 qf[4];
#pragma unroll
    for (int s = 0; s < 4; ++s) qf[s] = *(const bf16x8*)(P + (size_t)(qrow + r) * PW + head * 64 + 16 * s + 8 * h);
    float m = p.in[I_attn_sink][l * 8 + head] * LOG2E, lpart = (h == 0) ? 1.0f : 0.0f;
    f32x16 o[2];
#pragma unroll
    for (int d = 0; d < 2; ++d)
#pragma unroll
        for (int i = 0; i < 16; ++i) o[d][i] = 0.f;
    __syncthreads();
    if (latent) {
#pragma unroll 1
        for (int j = 0; j < 9; ++j) {
            const int kb = pw - 128 + 32 * j;
            if (kb < 0 || kb >= SEQ) continue;
            const int krow = kb - w0;
            AttnFrags f;
            attn_lds_frags(f, F.lds + ALDS_KW + (krow + r) * AKP + 16 * h, F.lds + ALDS_VW + r * AVWP + 2 * krow + 8 * h, 32 * AVWP);
            attn_block(qf, f, (j == 0 || j == 8) ? 1 : 0, kb - (pw + r), lane, m, lpart, o);
        }
    }
#pragma unroll 1
    for (int j = 0; j < 8; ++j) {
        AttnFrags f;
        attn_lds_frags(f, F.lds + ALDS_KC + (32 * j + r) * AKP + 16 * h, F.lds + ALDS_VC + r * AVCP + 64 * j + 8 * h, 32 * AVCP);
        attn_block(qf, f, 0, 0, lane, m, lpart, o);
    }
    const float inv = 1.0f / (lpart + lane_x32(lpart, h != 0));
    bf16_t* yrow = Y + (size_t)(qrow + r) * D + head * 64;
#pragma unroll
    for (int d = 0; d < 2; ++d)
#pragma unroll
        for (int g = 0; g < 4; ++g) {
            u32x2 w; w.x = pk2(o[d][4 * g] * inv, o[d][4 * g + 1] * inv); w.y = pk2(o[d][4 * g + 2] * inv, o[d][4 * g + 3] * inv);
            *(u32x2*)(yrow + 32 * d + 8 * g + 4 * h) = w;
        }
}

DI void sgu_unit(const Params& p, const Frame& F, int l, int chunk) {
    constexpr int VS = 136;
    LAS float* part = (LAS float*)F.lds;
    LAS float* rq = part + 512;
    LAS bf16_t* vnT = (LAS bf16_t*)(F.lds + 4096);
    const bf16_t* VsT = (const bf16_t*)(p.ws + WS_VST) + (size_t)chunk * 256 * 128;
    const bf16_t* P = (const bf16_t*)(p.ws + WS_P);
    bf16_t* Y = (bf16_t*)(p.ws + WS_Y);
    __syncthreads();
    { const int q = F.tid & 127, part_i = F.tid >> 7; float ss = 0.f;
#pragma unroll 16
        for (int c = part_i * 64; c < part_i * 64 + 64; ++c) { const float v = bf2f(VsT[c * 128 + q]); ss += v * v; }
        part[part_i * 128 + q] = ss; }
    __syncthreads();
    if (F.tid < 128) rq[F.tid] = rsqrtf((part[F.tid] + part[128 + F.tid] + part[256 + F.tid] + part[384 + F.tid]) * (1.0f / 256.0f) + EPS);
    __syncthreads();
#pragma unroll
    for (int it = 0; it < 8; ++it) {
        const int i = F.tid + it * NTHREADS;
        const int c = i >> 4, q8 = (i & 15) * 8;
        const u32x4 v = *(const u32x4*)(VsT + c * 128 + q8);
        u32x4 o;
#pragma unroll
        for (int j = 0; j < 4; ++j) o[j] = pk2(bflo(v[j]) * rq[q8 + 2 * j], bfhi(v[j]) * rq[q8 + 2 * j + 1]);
        *(LAS u32x4*)(vnT + c * VS + q8) = o;
    }
    __syncthreads();
    const int lane = F.lane, r = lane & 31, h = lane >> 5, g = F.wave >> 1, ph = F.wave & 1;
    const bf16_t* Wg = (const bf16_t*)(p.ws + WS_SGUW) + ((size_t)l * 4 + g) * 128 * 128;
#pragma unroll 1
    for (int pb = 0; pb < 2; ++pb) {
        const int p0 = 64 * ph + 32 * pb;
        const int row = chunk * 128 + p0 + r;
        bf16x8 wf[8];
#pragma unroll
        for (int s = 0; s < 8; ++s) wf[s] = *(const bf16x8*)(Wg + (size_t)(p0 + r) * 128 + 16 * s + 8 * h);
        u32x2 uu[2][4];
#pragma unroll
        for (int cb = 0; cb < 2; ++cb)
#pragma unroll
            for (int q4 = 0; q4 < 4; ++q4) uu[cb][q4] = *(const u32x2*)(P + (size_t)row * PW + SUOFF + 64 * g + 32 * cb + 8 * q4 + 4 * h);
        const float bias = p.in[I_sgu_b][(l * 4 + g) * 128 + p0 + r];
#pragma unroll
        for (int cb = 0; cb < 2; ++cb) {
            const int c0 = 64 * g + 32 * cb;
            f32x16 acc;
#pragma unroll
            for (int i = 0; i < 16; ++i) acc[i] = 0.f;
#pragma unroll
            for (int s = 0; s < 8; ++s) {
                const bf16x8 a = *(const LAS bf16x8*)(vnT + (c0 + r) * VS + 16 * s + 8 * h);
                acc = MFMA32(a, wf[s], acc);
            }
#pragma unroll
            for (int q4 = 0; q4 < 4; ++q4) {
                const int cc = c0 + 8 * q4 + 4 * h;
                const u32x2 u = uu[cb][q4];
                u32x2 w;
                w.x = pk2(bflo(u.x) * (acc[4 * q4] + bias), bfhi(u.x) * (acc[4 * q4 + 1] + bias));
                w.y = pk2(bflo(u.y) * (acc[4 * q4 + 2] + bias), bfhi(u.y) * (acc[4 * q4 + 3] + bias));
                *(u32x2*)(Y + (size_t)row * D + 768 + cc) = w;
            }
        }
    }
}

DI void phase_mix(const Params& p, const Frame& F, int l, int ctr_slot = 0) {
    (void)ctr_slot;
    const int nrows = (l == 0) ? T : TL;
    const bf16_t* P = (const bf16_t*)(p.ws + WS_P);
    bf16_t* Y = (bf16_t*)(p.ws + WS_Y);
    for (int i0 = F.bid * NTHREADS; i0 < 4 * nrows * 8; i0 += F.nb * NTHREADS) {
        const int i = i0 + F.tid, g = i / (nrows * 8), rem = i - g * (nrows * 8), row = rem >> 3, ck = g * 8 + (rem & 7);
        int base, t, len;
        if (row < TL) { base = row & ~(SEQ - 1); t = row & (SEQ - 1); len = SEQ; } else { const int rc = row - TL; base = TL + (rc & ~(NCTX - 1)); t = rc & (NCTX - 1); len = NCTX; }
        float s[8];
#pragma unroll
        for (int j = 0; j < 8; ++j) s[j] = 0.f;
        const bf16_t* zc = P + POOLOFF + ck * 8;
#define POOL_WIN(HALF) do { _Pragma("unroll") for (int dt = -(HALF); dt < (HALF); ++dt) { const int tt = t + dt; const bool ok = tt >= 0 && tt < len; \
            const u32x4 v = *(const u32x4*)(zc + (size_t)(base + (ok ? tt : t)) * PW); const float w = ok ? 1.f : 0.f; \
            _Pragma("unroll") for (int j = 0; j < 4; ++j) { s[2 * j] += w * bflo(v[j]); s[2 * j + 1] += w * bfhi(v[j]); } } } while (0)
        int half;
        if (g == 0) { POOL_WIN(1); half = 1; } else if (g == 1) { POOL_WIN(2); half = 2; } else if (g == 2) { POOL_WIN(4); half = 4; } else { POOL_WIN(8); half = 8; }
#undef POOL_WIN
        const int lo = max(t - half, 0), hi = min(t + half, len);
        const float inv = 1.0f / (float)(hi - lo);
        const u32x4 z = *(const u32x4*)(zc + (size_t)row * PW);
        u32x4 o;
#pragma unroll
        for (int j = 0; j < 4; ++j) o[j] = pk2(s[2 * j] * inv - bflo(z[j]), s[2 * j + 1] * inv - bfhi(z[j]));
        *(u32x4*)(Y + (size_t)row * D + 512 + ck * 8) = o;
    }
    const int nchunk = (l == 0) ? T / 128 : TL / 128;
    for (int ch = F.bid; ch < nchunk; ch += F.nb) sgu_unit(p, F, l, ch);
    const int nunit = (l == 0) ? 1024 + 64 : 1024;
    for (int u = F.nb - 1 - F.bid; u < nunit; u += F.nb) attn_unit(p, F, l, u);
}

struct SchedG2 {
    int G, c; const char *H, *Y, *Wg, *Wb; int npair;
    DI void fill(pg8::Unit& u, int sub, int br) const {
        u.sub = sub;
        if ((sub & 1) == 0) { u.nt = 16; u.a = H + (size_t)u.pm * 256 * D * 2; u.b = Wg + ((size_t)br * D + u.pn * 256) * D * 2; }
        else { const int koff = (br == 0) ? 0 : (br == 1 ? 512 : 768); u.nt = (br == 0) ? 8 : 4;
               u.a = Y + ((size_t)u.pm * 256 * D + koff) * 2; u.b = Wb + ((size_t)u.pn * 256 * D + koff) * 2; }
    }
    DI bool next(int i, pg8::Unit& u) const {
        constexpr int NLAT = (TL / 256) * 4;
        const int nl = (NLAT - c + G - 1) / G;
        if (i < 6 * nl) { const int tile = (i / 6) * G + c, sub = i % 6; pg8::tile_of(tile, TL / 256, 4, u.pm, u.pn); u.mode = 0; fill(u, sub, sub >> 1); return true; }
        const int e = i - 6 * nl, j = (e >> 1) * G + c;
        if (j >= npair) return false;
        const int ctile = j / 3, br = j % 3;
        u.pm = TL / 256 + (ctile >> 2); u.pn = ctile & 3; u.mode = 1 + br; fill(u, e & 1, br); return true;
    }
};
struct EpiG2 {
    static constexpr bool PERM = true;
    bf16_t* scr; bf16_t* M; bf16_t* MP;
    DI bool keeps(const pg8::Unit& u) const { return (u.sub & 1) == 0; }
    DI void operator()(f32x4 (&acc)[2][2][4][2], const pg8::Unit& u, int wr, int wc, int fr, int fq) const {
        const bool gate = (u.sub & 1) == 0, first = u.sub == 0 && gate;
        bf16_t* Mo = (u.mode == 0) ? M + (size_t)u.pm * 256 * D : MP + ((size_t)(u.mode - 1) * TC + (size_t)(u.pm - TL / 256) * 256) * D;
#pragma unroll
        for (int ai = 0; ai < 2; ++ai) {
            u32x4 ld[4][2];
            if (!first) {
#pragma unroll
                for (int m = 0; m < 4; ++m)
#pragma unroll
                    for (int bj = 0; bj < 2; ++bj) {
                        const int rl = 128 * ai + 64 * wr + 16 * m + fr, cl = 128 * bj + 32 * wc + 8 * fq;
                        ld[m][bj] = gate ? *(const u32x4*)(Mo + (size_t)rl * D + u.pn * 256 + cl) : *(const u32x4*)(scr + rl * 256 + cl);
                    }
            }
#pragma unroll
            for (int m = 0; m < 4; ++m)
#pragma unroll
                for (int bj = 0; bj < 2; ++bj) {
                    const int rl = 128 * ai + 64 * wr + 16 * m + fr, cl = 128 * bj + 32 * wc + 8 * fq;
                    if (gate) {
                        u32x4 o;
#pragma unroll
                        for (int j2 = 0; j2 < 4; ++j2) {
                            const int n = j2 >> 1, e = 2 * (j2 & 1);
                            const unsigned w = pk2(fmaxf(sigmoidf_(acc[ai][bj][m][n][e]), 1e-20f), fmaxf(sigmoidf_(acc[ai][bj][m][n][e + 1]), 1e-20f));
                            o[j2] = w;
                            const float t0 = first ? 0.f : bflo(ld[m][bj][j2]), t1 = first ? 0.f : bfhi(ld[m][bj][j2]);
                            acc[ai][bj][m][n][e] = t0 * __builtin_amdgcn_rcpf(bflo(w)); acc[ai][bj][m][n][e + 1] = t1 * __builtin_amdgcn_rcpf(bfhi(w));
                        }
                        *(u32x4*)(scr + rl * 256 + cl) = o;
                    } else {
                        u32x4 w;
#pragma unroll
                        for (int j2 = 0; j2 < 4; ++j2) { const int n = j2 >> 1, e = 2 * (j2 & 1);
                            w[j2] = pk2(acc[ai][bj][m][n][e] * bflo(ld[m][bj][j2]), acc[ai][bj][m][n][e + 1] * bfhi(ld[m][bj][j2])); }
                        *(u32x4*)(Mo + (size_t)rl * D + u.pn * 256 + cl) = w;
                    }
                }
            asm volatile("" ::: "memory");
        }
    }
};
DI void phase_g2(const Params& p, const Frame& F, int l) {
    SchedG2 S{F.nb, F.bid, (const char*)(p.ws + WS_H), (const char*)(p.ws + WS_Y),
              (const char*)(p.ws + WS_WIN) + ((size_t)l * INW + GATEOFF) * D * 2, (const char*)(p.ws + WS_WBR) + (size_t)l * D * D * 2, (l == 0) ? (TC / 256) * 4 * 3 : 0};
    EpiG2 E{(bf16_t*)(p.ws + WS_IDX) + (size_t)F.bid * 65536, (bf16_t*)(p.ws + WS_MERGED), (bf16_t*)(p.ws + WS_MP)};
    pg8::gemm_phase(F.lds, F.tid, S, E);
}
DI void phase_g2sum(const Params& p, const Frame& F) {
    const u32x4* mp = (const u32x4*)(p.ws + WS_MP);
    u32x4* mo = (u32x4*)((bf16_t*)(p.ws + WS_MERGED) + (size_t)TL * D);
    constexpr int NV = TC * D / 8;
    for (int i = F.gtid; i < NV; i += F.ngt) {
        const u32x4 a = mp[i], b = mp[NV + i], c = mp[2 * NV + i];
        u32x4 o;
#pragma unroll
        for (int j = 0; j < 4; ++j) o[j] = pk2(bflo(a[j]) + bflo(b[j]) + bflo(c[j]), bfhi(a[j]) + bfhi(b[j]) + bfhi(c[j]));
        mo[i] = o;
    }
}

struct EpiG3 {
    DI bool keeps(const pg8::Unit&) const { return false; }
    static constexpr bool PERM = false;
    const float* xsrc; float* xdst; const float* csrc; float* cdst; const float* mod;
    DI void operator()(const f32x4 (&acc)[2][2][4][2], const pg8::Unit& u, int wr, int wc, int fr, int fq) const {
        const int col0 = u.pn * 256 + wc * 32 + 4 * fq;
        const bool lat = u.pm < TL / 256;
        const float* gt = mod + (size_t)(lat ? (u.pm >> 4) : 8) * NMOD + 2 * D;
        const float* xs = lat ? xsrc + (size_t)u.pm * 256 * D : csrc + (size_t)(u.pm - TL / 256) * 256 * D;
        float* xd = lat ? xdst + (size_t)u.pm * 256 * D : cdst + (size_t)(u.pm - TL / 256) * 256 * D;
        f32x4 gv[2][2];
#pragma unroll
        for (int bj = 0; bj < 2; ++bj)
#pragma unroll
            for (int n = 0; n < 2; ++n) gv[bj][n] = *(const f32x4*)(gt + col0 + 128 * bj + 16 * n);
#pragma unroll
        for (int ai = 0; ai < 2; ++ai) {
            f32x4 xv[4][2][2];
#pragma unroll
            for (int m = 0; m < 4; ++m)
#pragma unroll
                for (int bj = 0; bj < 2; ++bj)
#pragma unroll
                    for (int n = 0; n < 2; ++n) xv[m][bj][n] = *(const f32x4*)(xs + (size_t)(wr * 64 + fr + 128 * ai + 16 * m) * D + col0 + 128 * bj + 16 * n);
#pragma unroll
            for (int m = 0; m < 4; ++m)
#pragma unroll
                for (int bj = 0; bj < 2; ++bj)
#pragma unroll
                    for (int n = 0; n < 2; ++n)
                        *(f32x4*)(xd + (size_t)(wr * 64 + fr + 128 * ai + 16 * m) * D + col0 + 128 * bj + 16 * n) = xv[m][bj][n] + gv[bj][n] * acc[ai][bj][m][n];
            asm volatile("" ::: "memory");
        }
    }
};
DI void phase_g3(const Params& p, const Frame& F, int l) {
    SchedGrid S{(l == 0 ? T : TL) / 256, D / 256, F.nb, F.bid, (const char*)(p.ws + WS_MERGED), (const char*)(p.ws + WS_WOUT) + (size_t)l * D * D * 2, 0, 0, 0};
    float* xc = (float*)(p.ws + WS_XCTX);
    EpiG3 E{(l == 0) ? p.in[I_x] : p.out, p.out, (l == 0) ? p.in[I_ctx] : xc, xc, (const float*)(p.ws + WS_MOD) + (size_t)l * 9 * NMOD};
    pg8::gemm_phase(F.lds, F.tid, S, E);
}

struct EpiG45 {
    DI bool keeps(const pg8::Unit&) const { return false; }
    static constexpr bool PERM = true;
    unsigned short* ST;
    DI void operator()(const f32x4 (&acc)[2][2][4][2], const pg8::Unit& u, int wr, int wc, int fr, int fq) const {
        const int col0 = u.pn * 256 + wc * 32 + 8 * fq;
#pragma unroll
        for (int ai = 0; ai < 2; ++ai)
#pragma unroll
            for (int m = 0; m < 4; ++m) {
                unsigned short* rowp = ST + (size_t)(u.pm * 256 + wr * 64 + fr + 128 * ai + 16 * m) * T + col0;
#pragma unroll
                for (int bj = 0; bj < 2; ++bj) {
                    u32x4 w;
                    w.x = pkh2(acc[ai][bj][m][0][0], acc[ai][bj][m][0][1]); w.y = pkh2(acc[ai][bj][m][0][2], acc[ai][bj][m][0][3]);
                    w.z = pkh2(acc[ai][bj][m][1][0], acc[ai][bj][m][1][1]); w.w = pkh2(acc[ai][bj][m][1][2], acc[ai][bj][m][1][3]);
                    *(u32x4*)(rowp + 128 * bj) = w;
                }
            }
    }
};
DI void phase_g45(const Params& p, const Frame& F, int l) {
    SchedGrid S{2048 / 256, (l == 0 ? T : TL) / 256, F.nb, F.bid, (const char*)(p.ws + WS_WFOLD) + (size_t)l * 2048 * D * 2, (const char*)(p.ws + WS_H), 0, 0, 0};
    EpiG45 E{(unsigned short*)(p.ws + WS_ST)};
    pg8::gemm_phase(F.lds, F.tid, S, E);
}

DI unsigned fkey(float f) { const unsigned u = __builtin_bit_cast(unsigned, f); return (u & 0x80000000u) ? ~u : (u | 0x80000000u); }
DI float fkey_inv(unsigned k) { const unsigned u = (k & 0x80000000u) ? (k & 0x7fffffffu) : ~k; return __builtin_bit_cast(float, u); }
#define INSERT16(L, x) do { unsigned x_ = (x); _Pragma("unroll") for (int k_ = 0; k_ < 16; ++k_) { const unsigned hi_ = max(L[k_], x_); x_ = min(L[k_], x_); L[k_] = hi_; } } while (0)
#define CEX(a, b) do { const unsigned hi_ = max(a, b), lo_ = min(a, b); a = hi_; b = lo_; } while (0)
DI void sort16_desc(unsigned (&v)[16]) {
#pragma unroll
    for (int k = 2; k <= 16; k <<= 1)
#pragma unroll
        for (int j = k >> 1; j > 0; j >>= 1)
#pragma unroll
            for (int i = 0; i < 16; ++i) {
                const int q = i ^ j;
                if (q > i) { if ((i & k) == 0) CEX(v[i], v[q]); else CEX(v[q], v[i]); }
            }
}
DI void merge16_desc(unsigned (&L)[16], const unsigned (&N)[16]) {
#pragma unroll
    for (int i = 0; i < 16; ++i) L[i] = max(L[i], N[15 - i]);
#pragma unroll
    for (int j = 8; j > 0; j >>= 1)
#pragma unroll
        for (int i = 0; i < 16; ++i) { const int q = i ^ j; if (q > i) CEX(L[i], L[q]); }
}
DI void phase_sel(const Params& p, const Frame& F, int l) {
    const _Float16* ST = (const _Float16*)(p.ws + WS_ST);
    unsigned short* IDX = (unsigned short*)(p.ws + WS_IDX);
    float* GW = (float*)(p.ws + WS_GW);
    float* SU = (float*)(p.ws + WS_SU);
    const float* TSC = (const float*)(p.ws + WS_TSCALE) + (size_t)l * 2 * NEXP;
    LAS unsigned char* ib = (LAS unsigned char*)F.lds;
    const int ntok = (l == 0) ? T : TL;
    for (int i0 = F.bid * NTHREADS; i0 < ntok * 8; i0 += F.nb * NTHREADS) {
        const int i = i0 + F.tid;
        const int tok = i % ntok, head = i / ntok;
        unsigned la[16], lb[16];
#pragma unroll
        for (int k = 0; k < 16; ++k) { la[k] = 0u; lb[k] = 0u; }
        const _Float16* s0 = ST + (size_t)(head * 256) * T + tok;
#define SEL_LOAD(B_, k0_) do { _Pragma("unroll") for (int j = 0; j < 32; ++j) B_[j] = sp[(size_t)((k0_) + j) * T]; } while (0)
#define SEL_GRP(L_, B_, o_, k0_) do { unsigned nk_[16]; \
        _Pragma("unroll") for (int j = 0; j < 16; ++j) nk_[j] = (fkey((float)B_[(o_) + j]) & ~127u) | (unsigned)(127 - ((k0_) + j)); \
        sort16_desc(nk_); merge16_desc(L_, nk_); } while (0)
#define SEL_HALF(L_, base_) do { const _Float16* sp = s0 + (size_t)(base_) * T; _Float16 bufa[32], bufb[32]; \
        SEL_LOAD(bufa, 0); \
        _Pragma("unroll 1") for (int k0 = 0; k0 < 128; k0 += 64) { \
            SEL_LOAD(bufb, k0 + 32); SEL_GRP(L_, bufa, 0, k0); SEL_GRP(L_, bufa, 16, k0 + 16); \
            SEL_LOAD(bufa, (k0 + 64) & 127); SEL_GRP(L_, bufb, 0, k0 + 32); SEL_GRP(L_, bufb, 16, k0 + 48); } } while (0)
        SEL_HALF(la, 0);
        SEL_HALF(lb, 128);
#undef SEL_LOAD
#undef SEL_GRP
#undef SEL_HALF
        float va[16], vb[16];
#pragma unroll
        for (int k = 0; k < 16; ++k) {
            va[k] = fkey_inv(la[k] & ~127u); vb[k] = fkey_inv(lb[k] & ~127u);
            ib[k * NTHREADS + F.tid] = (unsigned char)(127u - (la[k] & 127u));
            ib[(16 + k) * NTHREADS + F.tid] = (unsigned char)(127u - (lb[k] & 127u));
        }
        unsigned lc[16];
#pragma unroll
        for (int k = 0; k < 16; ++k) lc[k] = 0u;
#pragma unroll
        for (int a = 0; a < 16; ++a)
#pragma unroll
            for (int b = 0; b < 16; ++b)
                if ((a + 1) * (b + 1) <= 16) { const unsigned key = (fkey(va[a] + vb[b]) & ~255u) | (unsigned)(255 - (a * 16 + b)); INSERT16(lc, key); }
        float e[16], sum = 0.f; const float v0 = fkey_inv(lc[0] & ~255u);
#pragma unroll
        for (int k = 0; k < 16; ++k) { e[k] = __expf(fkey_inv(lc[k] & ~255u) - v0); sum += e[k]; }
        const float inv = 1.0f / sum;
        asm volatile("s_waitcnt lgkmcnt(0)" ::: "memory");
#pragma unroll
        for (int k = 0; k < 16; ++k) {
            const unsigned pos = 255u - (lc[k] & 255u), a = pos >> 4, b = pos & 15u;
            const unsigned ea = ib[a * NTHREADS + F.tid], eb = ib[(16 + b) * NTHREADS + F.tid];
            const unsigned ex = ea * 128u + eb;
            IDX[(size_t)tok * 128 + head * 16 + k] = (unsigned short)ex;
            GW[(size_t)tok * 128 + head * 16 + k] = e[k] * inv * TSC[NEXP + ex];
            SU[(size_t)tok * 128 + head * 16 + k] = TSC[ex];
        }
        asm volatile("s_waitcnt lgkmcnt(0)" ::: "memory");
    }
}

DI float dpp_xor1(float v) { return __builtin_bit_cast(float, __builtin_amdgcn_mov_dpp(__builtin_bit_cast(int, v), 0xB1, 0xF, 0xF, true)); }
DI float dpp_xor2(float v) { return __builtin_bit_cast(float, __builtin_amdgcn_mov_dpp(__builtin_bit_cast(int, v), 0x4E, 0xF, 0xF, true)); }
DI float dpp_hmir(float v) { return __builtin_bit_cast(float, __builtin_amdgcn_mov_dpp(__builtin_bit_cast(int, v), 0x141, 0xF, 0xF, true)); }
DI float dot16_fp8(const u32x4 q, const float (&hx)[16]) {
    f32x2 a = {0.f, 0.f};
#pragma unroll
    for (int j = 0; j < 4; ++j) {
        const f32x2 lo = __builtin_amdgcn_cvt_pk_f32_fp8((int)q[j], false), hi = __builtin_amdgcn_cvt_pk_f32_fp8((int)q[j], true);
        a += lo * (f32x2){hx[4 * j], hx[4 * j + 1]}; a += hi * (f32x2){hx[4 * j + 2], hx[4 * j + 3]};
    }
    return a.x + a.y;
}
#define PEER_EXPERT(id, i) ((int)(((id)[(i) >> 3][((i) >> 1) & 3] >> (16 * ((i) & 1))) & 0xffffu))

struct PeerURows { u32x4 q[16]; u32x4 h0, h1; };
DI void peer_u_rows(PeerURows& R, const u32x4 (&id)[2], const unsigned char* ut, const bf16_t* hrow) {
    R.h0 = *(const u32x4*)(hrow); R.h1 = *(const u32x4*)(hrow + 8);
#pragma unroll
    for (int i = 0; i < 16; ++i) R.q[i] = *(const u32x4*)(ut + (size_t)PEER_EXPERT(id, i) * D);
}
DI void peer_u_compute(const PeerURows& R, float* part, int lane) {
    float hx[16];
#pragma unroll
    for (int j = 0; j < 4; ++j) { hx[2 * j] = bflo(R.h0[j]); hx[2 * j + 1] = bfhi(R.h0[j]); hx[8 + 2 * j] = bflo(R.h1[j]); hx[8 + 2 * j + 1] = bfhi(R.h1[j]); }
    float d[16];
#pragma unroll
    for (int i = 0; i < 16; ++i) d[i] = dot16_fp8(R.q[i], hx);
    const bool b2 = (lane & 4) != 0, b1 = (lane & 2) != 0, b0 = (lane & 1) != 0;
    float k8[8];
#pragma unroll
    for (int i = 0; i < 8; ++i) { const float keep = b2 ? d[8 + i] : d[i], send = b2 ? d[i] : d[8 + i]; k8[i] = keep + dpp_hmir(send); }
    float k4[4];
#pragma unroll
    for (int i = 0; i < 4; ++i) { const float keep = b1 ? k8[4 + i] : k8[i], send = b1 ? k8[i] : k8[4 + i]; k4[i] = keep + dpp_xor2(send); }
    f32x2 k2;
    { const float keep0 = b0 ? k4[2] : k4[0], send0 = b0 ? k4[0] : k4[2], keep1 = b0 ? k4[3] : k4[1], send1 = b0 ? k4[1] : k4[3];
      k2.x = keep0 + dpp_xor1(send0); k2.y = keep1 + dpp_xor1(send1); }
    *(f32x2*)(part + 16 * (lane >> 3) + (b2 ? 8 : 0) + (b1 ? 4 : 0) + (b0 ? 2 : 0)) = k2;
}
DI void phase_peer_u(const Params& p, const Frame& F, int l) {
    const int ntok = (l == 0) ? T : TL, lane = F.lane;
    const int slice = F.bid & 7, sw = (F.bid >> 3) * NWAVES + F.wave, nsw = (F.nb >> 3) * NWAVES;
    const unsigned char* ut = p.ws + WS_UTAB + (size_t)l * NEXP * D + 128 * slice + 16 * (lane & 7);
    const bf16_t* Hs = (const bf16_t*)(p.ws + WS_H) + 128 * slice + 16 * (lane & 7);
    const unsigned short* IDXg = (const unsigned short*)(p.ws + WS_IDX) + 16 * (lane >> 3);
    float* PART = (float*)(p.ws + WS_ST) + (size_t)slice * T * 128;
    const int last = ntok - 1;
    u32x4 sa[2], sb[2]; PeerURows ra, rb;
#define U_SEL(S_, t_) do { const unsigned short* ip_ = IDXg + (size_t)min((t_), last) * 128; S_[0] = *(const u32x4*)ip_; S_[1] = *(const u32x4*)(ip_ + 8); } while (0)
#define U_ROWS(R_, S_, t_) peer_u_rows(R_, S_, ut, Hs + (size_t)min((t_), last) * D)
    U_SEL(sa, sw); U_SEL(sb, sw + nsw);
    U_ROWS(ra, sa, sw);
#pragma unroll 1
    for (int tok = sw; tok < ntok; tok += 2 * nsw) {
        U_SEL(sa, tok + 2 * nsw); U_ROWS(rb, sb, tok + nsw);
        peer_u_compute(ra, PART + (size_t)tok * 128, lane);
        U_SEL(sb, tok + 3 * nsw); U_ROWS(ra, sa, tok + 2 * nsw);
        if (tok + nsw < ntok) peer_u_compute(rb, PART + (size_t)(tok + nsw) * 128, lane);
    }
#undef U_SEL
#undef U_ROWS
}
DI void phase_peer_c(const Params& p, const Frame& F, int l, bool dummy = false) {
    const int ntok = (l == 0) ? T : TL;
    const float* PART = (const float*)(p.ws + WS_ST);
    float* GW = (float*)(p.ws + WS_GW);
    float* CO = dummy ? (float*)(p.ws + WS_H8) : GW;
    const float* SU = (const float*)(p.ws + WS_SU);
    for (int i0 = F.gtid; i0 < ntok * 128; i0 += 4 * F.ngt) {
        float s[4], gw[4], su[4];
#pragma unroll
        for (int u = 0; u < 4; ++u) {
            const int i = min(i0 + u * F.ngt, ntok * 128 - 1);
            s[u] = 0.f;
#pragma unroll
            for (int sl = 0; sl < 8; ++sl) s[u] += PART[(size_t)sl * T * 128 + i];
            gw[u] = GW[i]; su[u] = SU[i];
        }
#pragma unroll
        for (int u = 0; u < 4; ++u) { const int i = i0 + u * F.ngt; if (i < ntok * 128) CO[i] = gw[u] * gelu_tanh(s[u] * su[u]); }
    }
}
struct PeerVRows { u32x4 q[16]; f32x4 cf[4]; f32x2 xv, gv; };
DI void peer_v_rows(PeerVRows& R, const u32x4 (&id)[2], const unsigned char* vt, const float* cp, const float* xs, const float* gt2) {
    R.cf[0] = *(const f32x4*)cp; R.cf[1] = *(const f32x4*)(cp + 4); R.cf[2] = *(const f32x4*)(cp + 8); R.cf[3] = *(const f32x4*)(cp + 12);
    R.xv = *(const f32x2*)xs; R.gv = *(const f32x2*)gt2;
#pragma unroll
    for (int i = 0; i < 16; ++i) R.q[i] = *(const u32x4*)(vt + (size_t)PEER_EXPERT(id, i) * D);
}
DI float xchg32(float v, bool hi) { const auto r = __builtin_amdgcn_permlane32_swap(__builtin_bit_cast(unsigned, v), __builtin_bit_cast(unsigned, v), false, false);
    return __builtin_bit_cast(float, hi ? r[0] : r[1]); }
DI float xchg16(float v, bool hi) { const auto r = __builtin_amdgcn_permlane16_swap(__builtin_bit_cast(unsigned, v), __builtin_bit_cast(unsigned, v), false, false);
    return __builtin_bit_cast(float, hi ? r[0] : r[1]); }
DI float xchg8(float v) { return __builtin_bit_cast(float, __builtin_amdgcn_mov_dpp(__builtin_bit_cast(int, v), 0x128, 0xF, 0xF, true)); }
DI void peer_v_compute(const PeerVRows& R, float* xdst, int lane) {
    f32x2 a[8];
#pragma unroll
    for (int j = 0; j < 8; ++j) a[j] = (f32x2){0.f, 0.f};
#pragma unroll
    for (int i = 0; i < 16; ++i) {
        const float c = R.cf[i >> 2][i & 3]; const f32x2 c2 = {c, c};
#pragma unroll
        for (int j = 0; j < 4; ++j) {
            a[2 * j] += c2 * __builtin_amdgcn_cvt_pk_f32_fp8((int)R.q[i][j], false);
            a[2 * j + 1] += c2 * __builtin_amdgcn_cvt_pk_f32_fp8((int)R.q[i][j], true);
        }
    }
    const bool b5 = (lane & 32) != 0, b4 = (lane & 16) != 0, b3 = (lane & 8) != 0;
    f32x2 k4[4];
#pragma unroll
    for (int j = 0; j < 4; ++j) { const f32x2 keep = b5 ? a[4 + j] : a[j], send = b5 ? a[j] : a[4 + j];
        k4[j] = keep + (f32x2){xchg32(send.x, b5), xchg32(send.y, b5)}; }
    f32x2 k2[2];
#pragma unroll
    for (int j = 0; j < 2; ++j) { const f32x2 keep = b4 ? k4[2 + j] : k4[j], send = b4 ? k4[j] : k4[2 + j];
        k2[j] = keep + (f32x2){xchg16(send.x, b4), xchg16(send.y, b4)}; }
    f32x2 k1;
    { const f32x2 keep = b3 ? k2[1] : k2[0], send = b3 ? k2[0] : k2[1];
        k1 = keep + (f32x2){xchg8(send.x), xchg8(send.y)}; }
    *(f32x2*)xdst = R.xv + R.gv * k1;
}
DI void phase_peer_v(const Params& p, const Frame& F, int l, bool dummy = false) {
    const int ntok = (l == 0) ? T : TL, lane = F.lane;
    const int slice = F.bid & 7, sw = (F.bid >> 3) * NWAVES + F.wave, nsw = (F.nb >> 3) * NWAVES;
    const unsigned char* vt = p.ws + WS_VTAB + (size_t)l * NEXP * D + 128 * slice + 16 * (lane & 7);
    const unsigned short* IDXg = (const unsigned short*)(p.ws + WS_IDX) + 16 * (lane >> 3);
    const float* CFg = (const float*)(p.ws + WS_GW) + 16 * (lane >> 3);
    const int last = ntok - 1;
    u32x4 sa[2], sb[2]; PeerVRows ra, rb;
#define V_SEL(S_, t_) do { const unsigned short* ip_ = IDXg + (size_t)min((t_), last) * 128; S_[0] = *(const u32x4*)ip_; S_[1] = *(const u32x4*)(ip_ + 8); } while (0)
    const int co = 128 * slice + 16 * (lane & 7) + ((lane & 32) ? 8 : 0) + ((lane & 16) ? 4 : 0) + ((lane & 8) ? 2 : 0);
#define V_ROWS(R_, S_, t_) do { const int t1_ = min((t_), last); peer_v_rows(R_, S_, vt, CFg + (size_t)t1_ * 128, xrow_ptr(p, t1_) + co, mod_vec(p, l, t1_, 5) + co); } while (0)
#define V_DO(R_, t_) do { const int t2_ = (t_); float* xd_ = (dummy ? (float*)(p.ws + WS_ST) + (size_t)t2_ * D : xrow_ptr(p, t2_)) + co; peer_v_compute(R_, xd_, lane); } while (0)
    V_SEL(sa, sw); V_SEL(sb, sw + nsw);
    V_ROWS(ra, sa, sw);
#pragma unroll 1
    for (int tok = sw; tok < ntok; tok += 2 * nsw) {
        V_SEL(sa, tok + 2 * nsw); V_ROWS(rb, sb, tok + nsw);
        V_DO(ra, tok);
        V_SEL(sb, tok + 3 * nsw); V_ROWS(ra, sa, tok + 2 * nsw);
        if (tok + nsw < ntok) V_DO(rb, tok + nsw);
    }
#undef V_SEL
#undef V_ROWS
#undef V_DO
}

#define XB_TMO      128
#define XB_XCNT(j)  (256  + 64 * (j))
#define XB_XSUB(j)  (1280 + 64 * (j))
#define XB_XGEN(j)  (2304 + 64 * (j))
#define XB_TOP      3328
#define XB_TOPGEN   3392
#define XCD_BAR_WORDS 3456
#define XB_SPIN_CAP (1u << 18)
DI unsigned xb_ld(unsigned* p)              { return __hip_atomic_load(p, __ATOMIC_RELAXED, __HIP_MEMORY_SCOPE_AGENT); }
DI unsigned xb_add(unsigned* p, unsigned v) { return __hip_atomic_fetch_add(p, v, __ATOMIC_RELAXED, __HIP_MEMORY_SCOPE_AGENT); }
DI unsigned xb_xcc_id() { return (unsigned)__builtin_amdgcn_s_getreg((3 << 11) | 20) & 0xFu; }
#define XB_SPIN(cond, bar) do { unsigned _sp = 0; while (cond) { __builtin_amdgcn_s_sleep(1); \
    if ((++_sp & 255u) == 0u) { if (xb_ld(&(bar)[XB_TMO])) break; if (_sp > XB_SPIN_CAP) { atomicAdd(&(bar)[XB_TMO], 1u); break; } } } } while (0)
struct XcdBarrier { unsigned* bar; unsigned x; volatile LAS unsigned* st; };
DI XcdBarrier xcd_barrier_post(unsigned* bar, volatile LAS unsigned* st) {
    XcdBarrier b; b.bar = bar; b.x = xb_xcc_id(); b.st = st;
    if (threadIdx.x == 0) (void)xb_add(&bar[XB_XCNT(b.x)], 1u);
    return b;
}
DI void xcd_barrier_complete(unsigned* bar, unsigned x, unsigned& nloc, unsigned& nx) {
    const unsigned G = gridDim.x * gridDim.y * gridDim.z;
    unsigned sum, cnt, mine, sp = 0u;
    for (;;) {
        sum = 0u; cnt = 0u; mine = 0u;
#pragma unroll
        for (unsigned j = 0; j < 16; ++j) { const unsigned c = xb_ld(&bar[XB_XCNT(j)]); sum += c; cnt += (c > 0u) ? 1u : 0u; mine = (j == x) ? c : mine; }
        if (sum == G) break;
        __builtin_amdgcn_s_sleep(1);
        if ((++sp & 255u) == 0u) { if (xb_ld(&bar[XB_TMO])) break; if (sp > XB_SPIN_CAP) { atomicAdd(&bar[XB_TMO], 1u); break; } }
    }
    nloc = mine > 0u ? mine : 1u; nx = cnt > 0u ? cnt : 1u;
}
DI void xcd_barrier(const XcdBarrier& b) {
    asm volatile("s_waitcnt vmcnt(0)" ::: "memory");
    __syncthreads();
    if (threadIdx.x == 0) {
        unsigned* bar = b.bar;
        __builtin_amdgcn_s_waitcnt(0);
        unsigned nloc = b.st[0], nx = b.st[1];
        if (nloc == 0u) { xcd_barrier_complete(bar, b.x, nloc, nx); b.st[0] = nloc; b.st[1] = nx; }
        const unsigned old = xb_add(&bar[XB_XSUB(b.x)], 1u);
        const unsigned gen = old / nloc;
        if (old + 1u == (gen + 1u) * nloc) {
            __builtin_amdgcn_fence(__ATOMIC_RELEASE, "agent");
            asm volatile("s_waitcnt vmcnt(0)" ::: "memory");
            const unsigned og = xb_add(&bar[XB_TOP], 1u);
            const unsigned tg = og / nx;
            if (og + 1u == (tg + 1u) * nx) xb_add(&bar[XB_TOPGEN], 1u);
            else XB_SPIN(xb_ld(&bar[XB_TOPGEN]) == tg, bar);
            __builtin_amdgcn_fence(__ATOMIC_ACQUIRE, "agent");
            xb_add(&bar[XB_XGEN(b.x)], 1u);
            asm volatile("s_waitcnt vmcnt(0)" ::: "memory");
        } else {
            XB_SPIN(xb_ld(&bar[XB_XGEN(b.x)]) == gen, bar);
            __builtin_amdgcn_fence(__ATOMIC_ACQUIRE, "agent");
            asm volatile("s_waitcnt vmcnt(0)" ::: "memory");
        }
    }
    __syncthreads();
}

constexpr int NPHASE = 25;
template <int PH> DI void run_phase(const Params& p, const Frame& F) {
    if constexpr (PH == 0) phase_prep(p, F);
    else if constexpr (PH == 1) phase_norm(p, F, 0, 0, true, T);
    else if constexpr (PH == 2) phase_g1(p, F, 0);
    else if constexpr (PH == 3) phase_mix(p, F, 0);
    else if constexpr (PH == 4) phase_g2(p, F, 0);
    else if constexpr (PH == 5) phase_g2sum(p, F);
    else if constexpr (PH == 6) phase_g3(p, F, 0);
    else if constexpr (PH == 7) phase_norm(p, F, 0, 1, false, T);
    else if constexpr (PH == 8) phase_g45(p, F, 0);
    else if constexpr (PH == 9) phase_sel(p, F, 0);
    else if constexpr (PH == 10) phase_peer_u(p, F, 0);
    else if constexpr (PH == 11) phase_peer_c(p, F, 0);
    else if constexpr (PH == 12) phase_peer_v(p, F, 0);
    else if constexpr (PH == 13) phase_norm(p, F, 1, 0, false, T);
    else if constexpr (PH == 14) phase_g1(p, F, 1);
    else if constexpr (PH == 15) phase_mix(p, F, 1);
    else if constexpr (PH == 16) phase_g2(p, F, 1);
    else if constexpr (PH == 17) phase_g3(p, F, 1);
    else if constexpr (PH == 18) phase_norm(p, F, 1, 1, false, TL);
    else if constexpr (PH == 19) phase_g45(p, F, 1);
    else if constexpr (PH == 20) phase_sel(p, F, 1);
    else if constexpr (PH == 21) phase_peer_u(p, F, 1);
    else if constexpr (PH == 22) phase_peer_c(p, F, 1);
    else if constexpr (PH == 23) phase_peer_v(p, F, 1);
    else if constexpr (PH == 24) phase_final(p, F);
}
DI Frame make_frame(unsigned char* lds_raw) {
    Frame F;
    F.lds = (LAS unsigned char*)lds_raw;
    int tid = threadIdx.x; asm volatile("" : "+v"(tid));
    int bid = blockIdx.x, nb = gridDim.x; asm volatile("" : "+s"(bid), "+s"(nb));
    F.tid = tid; F.lane = tid & 63; F.wave = __builtin_amdgcn_readfirstlane(tid >> 6); F.bid = bid; F.nb = nb;
    F.gw = bid * NWAVES + F.wave; F.ngw = nb * NWAVES; F.gtid = bid * NTHREADS + tid; F.ngt = nb * NTHREADS;
    return F;
}
template <int PH> DI void run_phase_fresh(unsigned char* lds_raw) {
#if defined(__HIP_DEVICE_COMPILE__)
    const __attribute__((address_space(4))) unsigned long long* pp = (const __attribute__((address_space(4))) unsigned long long*)__builtin_amdgcn_kernarg_segment_ptr();
    asm volatile("" : "+s"(pp));
    Params p;
#pragma unroll
    for (int i = 0; i < N_IN; ++i) p.in[i] = (const float*)(const __attribute__((address_space(1))) float*)pp[i];
    p.out = (float*)(__attribute__((address_space(1))) float*)pp[N_IN]; p.ws = (unsigned char*)(__attribute__((address_space(1))) unsigned char*)pp[N_IN + 1]; p.ph_lo = 0; p.ph_hi = 0;
#else
    Params p{};
#endif
    const Frame F = make_frame(lds_raw);
    run_phase<PH>(p, F);
}
template <int PH> __global__ void __launch_bounds__(NTHREADS, 2) phase_kernel(Params p) {
    extern __shared__ __attribute__((aligned(16))) unsigned char lds_raw[];
    run_phase_fresh<PH>(lds_raw);
}
template <int PH> DI void run_all(unsigned char* lds_raw, cg::grid_group& grid, const XcdBarrier& bar) {
    if constexpr (PH < NPHASE) {
        if constexpr (PH == PROBE_PH) {
            if constexpr (PH == 11 || PH == 22 || PH == 12 || PH == 23) {
#if defined(__HIP_DEVICE_COMPILE__)
                const __attribute__((address_space(4))) unsigned long long* pp = (const __attribute__((address_space(4))) unsigned long long*)__builtin_amdgcn_kernarg_segment_ptr();
                asm volatile("" : "+s"(pp));
                Params p;
#pragma unroll
                for (int i = 0; i < N_IN; ++i) p.in[i] = (const float*)(const __attribute__((address_space(1))) float*)pp[i];
                p.out = (float*)(__attribute__((address_space(1))) float*)pp[N_IN]; p.ws = (unsigned char*)(__attribute__((address_space(1))) unsigned char*)pp[N_IN + 1]; p.ph_lo = 0; p.ph_hi = 0;
                const Frame F = make_frame(lds_raw);
                if constexpr (PH == 11 || PH == 22) phase_peer_c(p, F, PH == 11 ? 0 : 1, true); else phase_peer_v(p, F, PH == 12 ? 0 : 1, true);
#endif
            } else run_phase_fresh<PH>(lds_raw);
            xcd_barrier(bar);
        }
        run_phase_fresh<PH>(lds_raw);
        if constexpr (PH + 1 < NPHASE) { xcd_barrier(bar); if constexpr (PROBE_SYNC) xcd_barrier(bar); }
        run_all<PH + 1>(lds_raw, grid, bar);
    }
}
__global__ void __launch_bounds__(NTHREADS, 2) mega(Params p) {
    extern __shared__ __attribute__((aligned(16))) unsigned char lds_raw[];
    cg::grid_group grid = cg::this_grid();
    volatile LAS unsigned* st = (volatile LAS unsigned*)((LAS unsigned char*)lds_raw + LDS_BAR_OFF);
    if (threadIdx.x < 2) st[threadIdx.x] = 0u;
    __syncthreads();
    const XcdBarrier bar = xcd_barrier_post((unsigned*)(p.ws + WS_CTL), st);
    if (p.ph_lo != 0) grid.sync();
    run_all<0>(lds_raw, grid, bar);
}

extern "C" void kernel_launch(void* const* d_in, const int* in_sizes, int n_in, void* d_out, int out_size, void* d_ws, size_t ws_size, hipStream_t stream) {
    static int grid = 0;
    if (grid == 0) {
        if (n_in != 23 || out_size != TL * D || ws_size < WS_END) { fprintf(stderr, "kernel_launch: unexpected shapes (n_in %d out %d ws %zu)\n", n_in, out_size, ws_size); grid = -1; return; }
        int dev = 0, cus = 0, per_cu = 0;
        (void)hipGetDevice(&dev);
        (void)hipDeviceGetAttribute(&cus, hipDeviceAttributeMultiprocessorCount, dev);
        (void)hipFuncSetAttribute((const void*)mega, hipFuncAttributeMaxDynamicSharedMemorySize, LDS_BYTES);
        (void)hipOccupancyMaxActiveBlocksPerMultiprocessor(&per_cu, (const void*)mega, NTHREADS, LDS_BYTES);
        if (per_cu < 1) { fprintf(stderr, "kernel_launch: occupancy query reports %d blocks per CU\n", per_cu); grid = -1; return; }
        grid = cus & ~7;
        if (grid < 8) { fprintf(stderr, "kernel_launch: needs at least 8 CUs\n"); grid = -1; return; }
    }
    if (grid < 0) return;
    (void)hipMemsetAsync((char*)d_ws + WS_CTL, 0, CTL_ZERO_BYTES, stream);
    Params p{};
    for (int i = 0; i < N_IN; ++i) p.in[i] = (const float*)d_in[i];
    p.out = (float*)d_out; p.ws = (unsigned char*)d_ws;
    void* args[] = {&p};
    hipError_t e = hipLaunchCooperativeKernel((const void*)mega, dim3(grid), dim3(NTHREADS), args, LDS_BYTES, stream);
    if (e != hipSuccess) fprintf(stderr, "cooperative launch failed: %s (grid %d)\n", hipGetErrorString(e), grid);
}
```

```cpp
#include <hip/hip_runtime.h>
#include <hip/hip_cooperative_groups.h>
#include <stdint.h>
#include <stdio.h>
namespace cg = cooperative_groups;

#ifndef PROBE_PH
#define PROBE_PH -1
#endif
#ifndef PROBE_SYNC
#define PROBE_SYNC 0
#endif
#ifndef MK_SINGLE
#define MK_SINGLE 0
#endif

#define LAS __attribute__((address_space(3)))
typedef unsigned short bf16_t;
typedef short bf16x8 __attribute__((ext_vector_type(8)));
typedef short s16x4 __attribute__((ext_vector_type(4)));
typedef float f32x4 __attribute__((ext_vector_type(4)));
typedef float f32x2 __attribute__((ext_vector_type(2)));
typedef float f32x16 __attribute__((ext_vector_type(16)));
typedef unsigned u32x4 __attribute__((ext_vector_type(4)));
typedef unsigned u32x2 __attribute__((ext_vector_type(2)));
typedef __bf16 bf16x2_t __attribute__((ext_vector_type(2)));
typedef _Float16 f16x2_t __attribute__((ext_vector_type(2)));
#define DI __device__ __forceinline__
DI unsigned pkh2(float lo, float hi) { f16x2_t v = {(_Float16)lo, (_Float16)hi}; return __builtin_bit_cast(unsigned, v); }
#define MFMA32(a, b, c) __builtin_amdgcn_mfma_f32_32x32x16_bf16((a), (b), (c), 0, 0, 0)

constexpr int D = 1024, NB = 8, SEQ = 4096, NCTX = 256, DEPTH = 2;
constexpr int TL = NB * SEQ, TC = NB * NCTX, T = TL + TC;
constexpr int INW = 4608, NMOD = 6 * D, PW = 1600, PN = 1536;
constexpr int VTS = SEQ + 64;
constexpr int QOFF = 0, KOFF = 512, VOFF = 640, POOLOFF = 768, SUOFF = 1024, SVOFF = 1280, GATEOFF = 1536;
constexpr int NEXP = 16384;
constexpr float EPS = 1e-6f;
constexpr float LOG2E = 1.4426950408889634f;
constexpr float QSCALE = 0.125f * LOG2E;

constexpr size_t MiB = 1u << 20;
constexpr size_t WS_CTL = 0, WS_MOD = 1 * MiB, CTL_ZERO_BYTES = 2 * MiB;
constexpr size_t WS_ROPE = 2 * MiB, WS_SGUW = 2 * MiB + 65536, WS_TSCALE = 3 * MiB;
constexpr size_t WS_WIN = 4 * MiB, WS_WBR = 22 * MiB, WS_WOUT = 26 * MiB, WS_WFOLD = 30 * MiB;
constexpr size_t WS_XCTX = 38 * MiB, WS_UTAB = 46 * MiB, WS_VTAB = 78 * MiB;
constexpr size_t WS_IDX = 110 * MiB, WS_GW = 120 * MiB;
constexpr size_t WS_H = 142 * MiB;
constexpr size_t WS_P = 210 * MiB, WS_Y = 318 * MiB, WS_MERGED = 386 * MiB, WS_VT = 454 * MiB, WS_VTC = 463 * MiB, WS_VST = 464 * MiB;
constexpr size_t WS_MP = 482 * MiB;
constexpr size_t WS_ST = 210 * MiB, WS_H8 = 346 * MiB, WS_HS = 380 * MiB, WS_SU = 482 * MiB;
constexpr size_t WS_END = 512 * MiB;
static_assert(WS_ST + (size_t)2048 * T * 2 <= WS_H8 && WS_H8 + (size_t)T * D <= WS_HS, "ST / H8 fit");
static_assert(WS_VST + (size_t)272 * 256 * 128 * 2 <= WS_SU && WS_VT + (size_t)NB * 2 * 64 * VTS * 2 <= WS_VTC, "VsT / VT fit");
static_assert(WS_H + (size_t)T * D * 2 <= WS_P, "H fits");
static_assert(WS_P + (size_t)T * PW * 2 <= WS_Y && WS_Y + (size_t)T * D * 2 <= WS_MERGED && WS_MERGED + (size_t)T * D * 2 <= WS_VT, "P/Y/MERGED fit");
static_assert(WS_IDX + (size_t)T * 128 * 2 <= WS_GW && WS_GW + (size_t)T * 128 * 4 <= WS_H && WS_SU + (size_t)T * 128 * 4 <= WS_END && WS_HS + (size_t)T * 4 <= WS_SU, "idx/gw/su fit");

constexpr int LDS_BYTES = 163840;
constexpr int LDS_BAR_OFF = LDS_BYTES - 64;
constexpr int NTHREADS = 512, NWAVES = 8;

enum { I_x, I_c, I_ctx, I_c_ctx, I_w_mod, I_b_mod, I_g_mix, I_g_ffn, I_w_in, I_attn_sink, I_pool_w, I_pool_scale, I_sgu_w, I_sgu_b, I_w_br_attn, I_w_br_pool, I_w_br_sgu, I_w_out, I_peer_wq, I_peer_subkeys, I_peer_u, I_peer_v, I_g_final, N_IN };
struct Params {
    const float* in[N_IN];
    float* out; unsigned char* ws;
    int ph_lo, ph_hi;
};

DI unsigned pk2(float lo, float hi) { f32x2 v = {lo, hi}; return __builtin_bit_cast(unsigned, __builtin_convertvector(v, bf16x2_t)); }
DI unsigned f2bf(float f) { return pk2(f, 0.f) & 0xffffu; }
DI float bf2f(unsigned short u) { return __builtin_bit_cast(float, (unsigned)u << 16); }
DI float bflo(unsigned w) { return __builtin_bit_cast(float, w << 16); }
DI float bfhi(unsigned w) { return __builtin_bit_cast(float, w & 0xffff0000u); }
DI int crow(int reg, int h) { return (reg & 3) + 8 * (reg >> 2) + 4 * h; }
DI float wave_sum(float v) {
#pragma unroll
    for (int o = 1; o < 64; o <<= 1) v += __shfl_xor(v, o);
    return v;
}
DI float sigmoidf_(float x) { return __builtin_amdgcn_rcpf(1.0f + __expf(-x)); }
DI float gelu_tanh(float x) { const float u = 0.7978845608028654f * (x + 0.044715f * x * x * x); return x * __builtin_amdgcn_rcpf(1.0f + __expf(-2.0f * u)); }
DI float silu_(float x) { return x * __builtin_amdgcn_rcpf(1.0f + __expf(-x)); }

struct Frame {
    int tid, lane, wave, gw, ngw, gtid, ngt, bid, nb;
    LAS unsigned char* lds;
};

template <int NM, int NN>
DI void wave_gemm(const bf16_t* __restrict__ A, int lda, const bf16_t* __restrict__ Bt, int ldb, int K, int m0, int n0, f32x16 (&acc)[NM][NN], int lane) {
    const int r = lane & 31, h = lane >> 5;
    const bf16_t* ap = A + (size_t)(m0 + r) * lda + 8 * h;
    const bf16_t* bp = Bt + (size_t)(n0 + r) * ldb + 8 * h;
    for (int k0 = 0; k0 < K; k0 += 64) {
        bf16x8 a[4][NM], b[4][NN];
#pragma unroll
        for (int s = 0; s < 4; ++s) {
#pragma unroll
            for (int i = 0; i < NM; ++i) a[s][i] = *(const bf16x8*)(ap + (size_t)(32 * i) * lda + k0 + 16 * s);
#pragma unroll
            for (int j = 0; j < NN; ++j) b[s][j] = *(const bf16x8*)(bp + (size_t)(32 * j) * ldb + k0 + 16 * s);
        }
#pragma unroll
        for (int s = 0; s < 4; ++s)
#pragma unroll
            for (int i = 0; i < NM; ++i)
#pragma unroll
                for (int j = 0; j < NN; ++j) acc[i][j] = MFMA32(a[s][i], b[s][j], acc[i][j]);
    }
}
template <int NM, int NN> DI void zero_acc(f32x16 (&acc)[NM][NN]) {
#pragma unroll
    for (int i = 0; i < NM; ++i)
#pragma unroll
        for (int j = 0; j < NN; ++j)
#pragma unroll
            for (int r = 0; r < 16; ++r) acc[i][j][r] = 0.f;
}

namespace pg8 {
constexpr int BM = 256, BK = 64, HALF = 128, HTB = HALF * BK * 2, STAGE_BYTES = 8 * HTB, NXCD = 8, WGM = 8, LD = 1024;
DI int lds_byte(int r, int c) { const int st = (r >> 4) * 2 + (c >> 5), rr = r & 15, cc = c & 31, ob = rr * 64 + cc * 2; return st * 1024 + (ob ^ (((ob >> 9) & 1) << 5)); }
DI void stage_rc(int b, int& R, int& C) { const int st = b / 1024, sb = b % 1024, swz = sb ^ (((sb >> 9) & 1) << 5); R = (st >> 1) * 16 + swz / 64; C = (st & 1) * 32 + (swz % 64) / 2; }
DI int perm32(int rho) { const int n = rho >> 4, i = rho & 15; return 8 * (i >> 2) + 4 * n + (i & 3); }
struct Unit { int pm, pn, sub, nt, mode; const char* a; const char* b; };
DI void tile_of(int L, int nM, int nN, int& pm, int& pn) {
    const int nwg = nM * nN; int wgid = L;
    { const int q = nwg / NXCD, r = nwg % NXCD, xcd = wgid % NXCD, off = wgid / NXCD; wgid = (xcd < r ? xcd * (q + 1) : r * (q + 1) + (xcd - r) * q) + off; }
    const int nig = WGM * nN, gid = wgid / nig, fm = gid * WGM, gsz = (nM - fm) < WGM ? (nM - fm) : WGM;
    pm = fm + ((wgid % nig) % gsz); pn = (wgid % nig) / gsz;
}
template <class Epi, class Sched>
DI void gemm_phase(LAS unsigned char* lds, const int tid, const Sched& S, const Epi& E) {
    const int wid = __builtin_amdgcn_readfirstlane(tid >> 6), lane = tid & 63, wr = wid >> 2, wc = wid & 3, fr = lane & 15, fq = lane >> 4;
    unsigned voffA[2], voffB[2];
#pragma unroll
    for (int i = 0; i < 2; ++i) { int R, C; stage_rc(tid * 16 + i * 8192, R, C); const int Rb = Epi::PERM ? ((R & ~31) + perm32(R & 31)) : R;
        voffA[i] = (unsigned)(R * LD + C) * 2u; voffB[i] = (unsigned)(Rb * LD + C) * 2u; }
    const size_t kstep = (size_t)(BK * 2);
    const size_t hstep = (size_t)HALF * LD * 2;
    const unsigned ldsw = (unsigned)wid * 1024u;
    const int aoff = lds_byte(wr * 64 + fr, fq * 8), boff = lds_byte(wc * 32 + fr, fq * 8);
#define PG8_SA(b, h) (((b) * 2 + (h)) * HTB)
#define PG8_SB(b, h) ((4 + (b) * 2 + (h)) * HTB)
#define PG8_STAGE(bufoff, gbase, voff) do { _Pragma("unroll") for (int _i = 0; _i < 2; ++_i) \
        __builtin_amdgcn_global_load_lds((const unsigned*)((const char*)(gbase) + (voff)[_i]), (LAS unsigned*)(lds + (bufoff) + ldsw + _i * 8192), 16, 0, 0); } while (0)
#define PG8_LDA(dst, b, h) do { _Pragma("unroll") for (int m = 0; m < 4; ++m) _Pragma("unroll") for (int k = 0; k < 2; ++k) dst[m][k] = *(const LAS bf16x8*)(lds + PG8_SA(b, h) + aoff + m * 2048 + k * 1024); } while (0)
#define PG8_LDB(dst, b, h) do { _Pragma("unroll") for (int n = 0; n < 2; ++n) _Pragma("unroll") for (int k = 0; k < 2; ++k) dst[n][k] = *(const LAS bf16x8*)(lds + PG8_SB(b, h) + boff + n * 2048 + k * 1024); } while (0)
#define PG8_MMA(ai, bj, At, Bt) do { __builtin_amdgcn_s_setprio(1); _Pragma("unroll") for (int m = 0; m < 4; ++m) _Pragma("unroll") for (int n = 0; n < 2; ++n) _Pragma("unroll") for (int k = 0; k < 2; ++k) \
        acc[ai][bj][m][n] = __builtin_amdgcn_mfma_f32_16x16x32_bf16(Bt[n][k], At[m][k], acc[ai][bj][m][n], 0, 0, 0); __builtin_amdgcn_s_setprio(0); } while (0)
#define PG8_WAIT_V(n) asm volatile("s_waitcnt vmcnt(" #n ")" ::: "memory")
#define PG8_WAIT_L(n) asm volatile("s_waitcnt lgkmcnt(" #n ")" ::: "memory")
#define PG8_BAR __builtin_amdgcn_s_barrier()
#define PG8_SCHED __builtin_amdgcn_sched_barrier(0)
    Unit cur, nxt; int ui = 0;
    if (!S.next(0, cur)) return;
    f32x4 acc[2][2][4][2];
#pragma unroll
    for (int a = 0; a < 2; ++a)
#pragma unroll
        for (int b = 0; b < 2; ++b)
#pragma unroll
            for (int m = 0; m < 4; ++m)
#pragma unroll
                for (int n = 0; n < 2; ++n) acc[a][b][m][n] = (f32x4){0.f, 0.f, 0.f, 0.f};
    bf16x8 At[4][2], B0[2][2], B1[2][2];
    const char* cA = cur.a; const char* cB = cur.b;
    PG8_STAGE(PG8_SB(0, 0), cB, voffB); PG8_STAGE(PG8_SB(0, 1), cB + hstep, voffB); PG8_STAGE(PG8_SA(0, 0), cA, voffA); PG8_STAGE(PG8_SA(0, 1), cA + hstep, voffA);
    if (wr == 1) PG8_BAR;
    PG8_WAIT_V(2); PG8_BAR;
    PG8_STAGE(PG8_SB(1, 0), cB + kstep, voffB); PG8_STAGE(PG8_SA(1, 0), cA + kstep, voffA); PG8_STAGE(PG8_SB(1, 1), cB + hstep + kstep, voffB);
    PG8_WAIT_V(6); PG8_BAR;
    for (;;) {
        const bool has_next = S.next(ui + 1, nxt);
        const char* nA = has_next ? nxt.a : cA; const char* nB = has_next ? nxt.b : cB;
        const int nt = cur.nt;
        for (int t = 0; t < nt; t += 2) {
            const bool last = (t == nt - 2);
            const char* a1 = cA + (size_t)(t + 1) * kstep;
            const char* a2 = last ? nA : cA + (size_t)(t + 2) * kstep; const char* b2 = last ? nB : cB + (size_t)(t + 2) * kstep;
            const char* a3 = a2 + kstep; const char* b3 = b2 + kstep;
            PG8_LDB(B0, 0, 0); PG8_LDB(B1, 0, 1); PG8_SCHED; PG8_LDA(At, 0, 0); PG8_STAGE(PG8_SA(1, 1), a1 + hstep, voffA);
            PG8_WAIT_V(8); PG8_WAIT_L(0); PG8_BAR; PG8_MMA(0, 0, At, B0); PG8_MMA(0, 1, At, B1); PG8_BAR; PG8_SCHED;
            PG8_LDA(At, 0, 1); PG8_STAGE(PG8_SB(0, 0), b2, voffB); PG8_STAGE(PG8_SB(0, 1), b2 + hstep, voffB); PG8_STAGE(PG8_SA(0, 0), a2, voffA);
            PG8_WAIT_V(8); PG8_WAIT_L(0); PG8_BAR; PG8_MMA(1, 0, At, B0); PG8_MMA(1, 1, At, B1); PG8_BAR; PG8_SCHED;
            PG8_LDB(B0, 1, 0); PG8_LDB(B1, 1, 1); PG8_SCHED; PG8_LDA(At, 1, 0); PG8_STAGE(PG8_SA(0, 1), a2 + hstep, voffA);
            PG8_WAIT_V(8); PG8_WAIT_L(0); PG8_BAR; PG8_MMA(0, 0, At, B0); PG8_MMA(0, 1, At, B1); PG8_BAR; PG8_SCHED;
            PG8_LDA(At, 1, 1); PG8_STAGE(PG8_SB(1, 0), b3, voffB); PG8_STAGE(PG8_SB(1, 1), b3 + hstep, voffB); PG8_STAGE(PG8_SA(1, 0), a3, voffA);
            PG8_WAIT_V(8); PG8_WAIT_L(0); PG8_BAR; PG8_MMA(1, 0, At, B0); PG8_MMA(1, 1, At, B1); PG8_BAR; PG8_SCHED;
        }
        if (wr == 0) PG8_BAR;
        E(acc, cur, wr, wc, fr, fq);
        if (!has_next) break;
        if (!E.keeps(cur)) {
#pragma unroll
        for (int a = 0; a < 2; ++a)
#pragma unroll
            for (int b = 0; b < 2; ++b)
#pragma unroll
                for (int m = 0; m < 4; ++m)
#pragma unroll
                    for (int n = 0; n < 2; ++n) acc[a][b][m][n] = (f32x4){0.f, 0.f, 0.f, 0.f};
        }
        cur = nxt; cA = nA; cB = nB; ++ui;
        if (wr == 1) PG8_BAR;
    }
    PG8_WAIT_V(0);
    PG8_BAR;
#undef PG8_SA
#undef PG8_SB
#undef PG8_STAGE
#undef PG8_LDA
#undef PG8_LDB
#undef PG8_MMA
#undef PG8_WAIT_V
#undef PG8_WAIT_L
#undef PG8_BAR
#undef PG8_SCHED
}
}

DI void transpose_item(const float* W, int K, int N, bf16_t* WT, int ldd, int row_off, int col_off, LAS float* scr, int item, int lane) {
    const int nblk = N / 32, kb = item / nblk, nb = item % nblk, k0 = 64 * kb, n0 = 32 * nb;
#pragma unroll 8
    for (int i = 0; i < 32; ++i) { const int kk = 2 * i + (lane >> 5); scr[kk * 33 + (lane & 31)] = W[(size_t)(k0 + kk) * N + n0 + (lane & 31)]; }
    asm volatile("s_waitcnt lgkmcnt(0)" ::: "memory");
    const int c = lane & 7;
#pragma unroll
    for (int j = 0; j < 4; ++j) { const int n = (lane >> 3) + 8 * j; const LAS float* s = scr + (8 * c) * 33 + n;
        u32x4 o; o.x = pk2(s[0 * 33], s[1 * 33]); o.y = pk2(s[2 * 33], s[3 * 33]); o.z = pk2(s[4 * 33], s[5 * 33]); o.w = pk2(s[6 * 33], s[7 * 33]);
        *(u32x4*)(WT + (size_t)(row_off + n0 + n) * ldd + col_off + k0 + 8 * c) = o; }
    asm volatile("s_waitcnt lgkmcnt(0)" ::: "memory");
}

DI void convert_tables(const Params& p, const Frame& F) {
    for (int it0 = 4 * F.gw; it0 < 4 * NEXP; it0 += 4 * F.ngw) {
        f32x4 v[4][4];
#pragma unroll
        for (int u = 0; u < 4; ++u) {
            const int it = it0 + u, e = it & (NEXP - 1), tbl = (it >> 14) & 1, l = it >> 15;
            const f32x4* src = (const f32x4*)((tbl ? p.in[I_peer_v] : p.in[I_peer_u]) + ((size_t)l * NEXP + e) * D) + 4 * F.lane;
#pragma unroll
            for (int j = 0; j < 4; ++j) v[u][j] = src[j];
        }
#pragma unroll
        for (int u = 0; u < 4; ++u) {
            const int it = it0 + u, e = it & (NEXP - 1), tbl = (it >> 14) & 1, l = it >> 15;
            float am = 0.f;
#pragma unroll
            for (int j = 0; j < 4; ++j) am = fmaxf(am, fmaxf(fmaxf(fabsf(v[u][j].x), fabsf(v[u][j].y)), fmaxf(fabsf(v[u][j].z), fabsf(v[u][j].w))));
#pragma unroll
            for (int o = 1; o < 64; o <<= 1) am = fmaxf(am, __shfl_xor(am, o));
            const float sc = (am > 0.f) ? (tbl ? exp2f(floorf(log2f(224.0f / am))) : 127.0f / am) : 1.0f;
            u32x4 q;
            if (tbl) {
#pragma unroll
                for (int j = 0; j < 4; ++j) { int w = 0; w = __builtin_amdgcn_cvt_pk_fp8_f32(v[u][j].x * sc, v[u][j].y * sc, w, false); w = __builtin_amdgcn_cvt_pk_fp8_f32(v[u][j].z * sc, v[u][j].w * sc, w, true); q[j] = (unsigned)w; }
            } else {
#pragma unroll
                for (int j = 0; j < 4; ++j) {
                    const int b0 = (int)__builtin_rintf(v[u][j].x * sc), b1 = (int)__builtin_rintf(v[u][j].y * sc), b2 = (int)__builtin_rintf(v[u][j].z * sc), b3 = (int)__builtin_rintf(v[u][j].w * sc);
                    q[j] = (unsigned)(b0 & 0xff) | ((unsigned)(b1 & 0xff) << 8) | ((unsigned)(b2 & 0xff) << 16) | ((unsigned)b3 << 24);
                }
            }
            *(u32x4*)(p.ws + (tbl ? WS_VTAB : WS_UTAB) + ((size_t)l * NEXP + e) * D + 16 * F.lane) = q;
            if (F.lane == 0) ((float*)(p.ws + WS_TSCALE))[(l * 2 + tbl) * NEXP + e] = 1.0f / sc;
        }
    }
}

DI void phase_prep(const Params& p, const Frame& F) {
    unsigned char* ws = p.ws;
    {
        LAS float* wq = (LAS float*)F.lds;
        LAS float* skl = wq + 128 * 65;
        for (int it = F.bid; it < 2 * 16 * 16; it += F.nb) {
            const int cc = it & 15, hp = (it >> 4) & 15, l = it >> 8;
            const float* src = p.in[I_peer_wq] + (size_t)l * D * 2048 + hp * 128;
            const float* sks = p.in[I_peer_subkeys] + (size_t)(l * 16 + hp) * 128 * 128;
            __syncthreads();
            { float tw[16]; f32x4 ts[8];
#pragma unroll
              for (int it = 0; it < 16; ++it) { const int e = F.tid + it * NTHREADS, ci = e >> 7, d = e & 127; tw[it] = src[(size_t)(cc * 64 + ci) * 2048 + d]; }
#pragma unroll
              for (int it = 0; it < 8; ++it) { const int e = F.tid + it * NTHREADS, key = e >> 5, d4 = (e & 31) * 4; ts[it] = *(const f32x4*)(sks + key * 128 + d4); }
#pragma unroll
              for (int it = 0; it < 16; ++it) { const int e = F.tid + it * NTHREADS, ci = e >> 7, d = e & 127; wq[d * 65 + ci] = tw[it]; }
#pragma unroll
              for (int it = 0; it < 8; ++it) { const int e = F.tid + it * NTHREADS, key = e >> 5, d4 = (e & 31) * 4; *(LAS f32x4*)(skl + key * 132 + d4) = ts[it]; } }
            __syncthreads();
            const int ci = F.tid & 63, kg = F.tid >> 6;
            float acc[16];
#pragma unroll
            for (int k = 0; k < 16; ++k) acc[k] = 0.f;
#pragma unroll 2
            for (int d = 0; d < 128; d += 4) {
                const float w0 = wq[d * 65 + ci], w1 = wq[(d + 1) * 65 + ci], w2 = wq[(d + 2) * 65 + ci], w3 = wq[(d + 3) * 65 + ci];
#pragma unroll
                for (int k = 0; k < 16; ++k) { const f32x4 s = *(const LAS f32x4*)(skl + (16 * kg + k) * 132 + d); acc[k] += w0 * s.x + w1 * s.y + w2 * s.z + w3 * s.w; }
            }
            bf16_t* dst = (bf16_t*)(ws + WS_WFOLD) + ((size_t)l * 2048 + hp * 128 + 16 * kg) * D + cc * 64 + ci;
#pragma unroll
            for (int k = 0; k < 16; ++k) dst[(size_t)k * D] = (bf16_t)f2bf(acc[k]);
        }
        __syncthreads();
    }
    {
        LAS float* scr = (LAS float*)(F.lds + F.wave * 16384);
        constexpr int I_IN = (D / 64) * (INW / 32), I_BA = (512 / 64) * (D / 32), I_BS = (256 / 64) * (D / 32), I_O = (D / 64) * (D / 32);
        constexpr int PER_L = I_IN + I_BA + I_BS + I_O;
        for (int it = F.gw; it < 2 * PER_L; it += F.ngw) {
            const int l = it / PER_L; int r = it % PER_L;
            if (r < I_IN) { transpose_item(p.in[I_w_in] + (size_t)l * D * INW, D, INW, (bf16_t*)(ws + WS_WIN) + (size_t)l * INW * D, D, 0, 0, scr, r, F.lane); continue; } r -= I_IN;
            if (r < I_BA) { transpose_item(p.in[I_w_br_attn] + (size_t)l * 512 * D, 512, D, (bf16_t*)(ws + WS_WBR) + (size_t)l * D * D, D, 0, 0, scr, r, F.lane); continue; } r -= I_BA;
            if (r < I_BS) { transpose_item(p.in[I_w_br_sgu] + (size_t)l * 256 * D, 256, D, (bf16_t*)(ws + WS_WBR) + (size_t)l * D * D, D, 0, 768, scr, r, F.lane); continue; } r -= I_BS;
            transpose_item(p.in[I_w_out] + (size_t)l * D * D, D, D, (bf16_t*)(ws + WS_WOUT) + (size_t)l * D * D, D, 0, 0, scr, r, F.lane);
        }
    }
    for (int i = F.gtid; i < 2 * 256 * D; i += F.ngt) {
        const int n = i & 1023, rc = (i >> 10) & 255, l = i >> 18, g = rc >> 6;
        const float* pw = p.in[I_pool_w] + ((size_t)l * 256 + rc) * 64;
        const float* ps = p.in[I_pool_scale] + l * 256 + 64 * g;
        const float* wb = p.in[I_w_br_pool] + ((size_t)l * 256 + 64 * g) * D + n;
        float a = 0.f;
#pragma unroll 16
        for (int e = 0; e < 64; ++e) a += pw[e] * ps[e] * wb[(size_t)e * D];
        ((bf16_t*)(ws + WS_WBR))[(size_t)l * D * D + (size_t)n * D + 512 + rc] = (bf16_t)f2bf(a);
    }
    for (int i = F.gtid; i < 2 * 4 * 128 * 128; i += F.ngt) ((bf16_t*)(ws + WS_SGUW))[i] = (bf16_t)f2bf(p.in[I_sgu_w][i]);
    for (int i = F.gtid; i < 64 * 16; i += F.ngt) {
        const int pos = i >> 4, fi = i & 15;
        const float inv = powf(10000.0f, -(float)fi / 16.0f);
        const float ang = (float)pos * inv;
        ((f32x2*)(ws + WS_ROPE))[i] = (f32x2){cosf(ang), sinf(ang)};
    }
    convert_tables(p, F);
    {
        float* MOD = (float*)(ws + WS_MOD);
        LAS float* scd = (LAS float*)F.lds;
        LAS float* red = scd + 9 * D;
        __syncthreads();
        { float tc[18];
#pragma unroll
          for (int it = 0; it < 18; ++it) { const int e = F.tid + it * NTHREADS, r = e >> 10, k = e & 1023; tc[it] = (r < 8) ? p.in[I_c][r * D + k] : p.in[I_c_ctx][k]; }
#pragma unroll
          for (int it = 0; it < 18; ++it) scd[F.tid + it * NTHREADS] = silu_(tc[it]); }
        __syncthreads();
        for (int it = F.bid; it < 2 * 96; it += F.nb) {
            const int cgp = it % 96, l = it / 96, col = cgp * 64 + F.lane;
            float acc[9];
#pragma unroll
            for (int r = 0; r < 9; ++r) acc[r] = 0.f;
            const float* wp = p.in[I_w_mod] + ((size_t)l * D + F.wave * 128) * NMOD + col;
#pragma unroll 16
            for (int k = 0; k < 128; ++k) {
                const float w = wp[(size_t)k * NMOD];
#pragma unroll
                for (int r = 0; r < 9; ++r) acc[r] += scd[r * D + F.wave * 128 + k] * w;
            }
#pragma unroll
            for (int r = 0; r < 9; ++r) red[(F.wave * 9 + r) * 64 + F.lane] = acc[r];
            __syncthreads();
            for (int e = F.tid; e < 9 * 64; e += NTHREADS) {
                const int r = e >> 6, ln = e & 63; float s = p.in[I_b_mod][l * NMOD + cgp * 64 + ln];
#pragma unroll
                for (int w = 0; w < 8; ++w) s += red[(w * 9 + r) * 64 + ln];
                MOD[((size_t)l * 9 + r) * NMOD + cgp * 64 + ln] = s;
            }
            __syncthreads();
        }
    }
}

DI const float* mod_vec(const Params& p, int l, int row, int j) {
    const int r = row < TL ? row / SEQ : 8;
    return (const float*)(p.ws + WS_MOD) + ((size_t)l * 9 + r) * NMOD + j * D;
}
DI float* xrow_ptr(const Params& p, int row) { return row < TL ? p.out + (size_t)row * D : (float*)(p.ws + WS_XCTX) + (size_t)(row - TL) * D; }
DI const float* xin_ptr(const Params& p, int row) { return row < TL ? p.in[I_x] + (size_t)row * D : p.in[I_ctx] + (size_t)(row - TL) * D; }

DI void phase_norm(const Params& p, const Frame& F, int l, int which  , bool from_input, int nrows) {
    const float* g = (which == 0 ? p.in[I_g_mix] : p.in[I_g_ffn]) + l * D;
    const int lane = F.lane;
    f32x4 gg[4];
#pragma unroll
    for (int j = 0; j < 4; ++j) gg[j] = ((const f32x4*)g)[lane + 64 * j];
    for (int row0 = 2 * F.gw; row0 < nrows; row0 += 2 * F.ngw) {
        f32x4 v[2][4], s1[2][4], s2[2][4];
#pragma unroll
        for (int u = 0; u < 2; ++u) {
            const int row = row0 + u;
            const float* src = from_input ? xin_ptr(p, row) : xrow_ptr(p, row);
            const float* sh = mod_vec(p, l, row, which * 3 + 0); const float* sc = mod_vec(p, l, row, which * 3 + 1);
#pragma unroll
            for (int j = 0; j < 4; ++j) { v[u][j] = ((const f32x4*)src)[lane + 64 * j]; s1[u][j] = ((const f32x4*)sh)[lane + 64 * j]; s2[u][j] = ((const f32x4*)sc)[lane + 64 * j]; }
        }
#pragma unroll
        for (int u = 0; u < 2; ++u) {
            float ss = 0.f;
#pragma unroll
            for (int j = 0; j < 4; ++j) ss += v[u][j].x * v[u][j].x + v[u][j].y * v[u][j].y + v[u][j].z * v[u][j].z + v[u][j].w * v[u][j].w;
            const float rinv = rsqrtf(wave_sum(ss) * (1.0f / D) + EPS);
            bf16_t* dst = (bf16_t*)(p.ws + WS_H) + (size_t)(row0 + u) * D;
            float am = 0.f;
#pragma unroll
            for (int j = 0; j < 4; ++j) {
                const f32x4 o = v[u][j] * rinv * gg[j] * (s2[u][j] + 1.0f) + s1[u][j];
                u32x2 w; w.x = pk2(o.x, o.y); w.y = pk2(o.z, o.w);
                ((u32x2*)dst)[lane + 64 * j] = w;
                v[u][j] = o; am = fmaxf(am, fmaxf(fmaxf(fabsf(o.x), fabsf(o.y)), fmaxf(fabsf(o.z), fabsf(o.w))));
            }
            if (which) {
#pragma unroll
                for (int o2 = 1; o2 < 64; o2 <<= 1) am = fmaxf(am, __shfl_xor(am, o2));
                const float sc = (am > 0.f) ? 127.0f / am : 1.0f;
                unsigned* h8 = (unsigned*)(p.ws + WS_H8 + (size_t)(row0 + u) * D);
#pragma unroll
                for (int j = 0; j < 4; ++j) {
                    const int b0 = (int)__builtin_rintf(v[u][j].x * sc), b1 = (int)__builtin_rintf(v[u][j].y * sc), b2 = (int)__builtin_rintf(v[u][j].z * sc), b3 = (int)__builtin_rintf(v[u][j].w * sc);
                    h8[lane + 64 * j] = (unsigned)(b0 & 0xff) | ((unsigned)(b1 & 0xff) << 8) | ((unsigned)(b2 & 0xff) << 16) | ((unsigned)b3 << 24);
                }
                if (lane == 0) ((float*)(p.ws + WS_HS))[row0 + u] = (am > 0.f) ? am * (1.0f / 127.0f) : 1.0f;
            }
        }
    }
}
DI void phase_final(const Params& p, const Frame& F) {
    f32x4 gg[4];
#pragma unroll
    for (int j = 0; j < 4; ++j) gg[j] = ((const f32x4*)p.in[I_g_final])[F.lane + 64 * j];
    for (int row0 = 2 * F.gw; row0 < TL; row0 += 2 * F.ngw) {
        f32x4 v[2][4];
#pragma unroll
        for (int u = 0; u < 2; ++u)
#pragma unroll
            for (int j = 0; j < 4; ++j) v[u][j] = ((const f32x4*)(p.out + (size_t)(row0 + u) * D))[F.lane + 64 * j];
#pragma unroll
        for (int u = 0; u < 2; ++u) {
            float ss = 0.f;
#pragma unroll
            for (int j = 0; j < 4; ++j) ss += v[u][j].x * v[u][j].x + v[u][j].y * v[u][j].y + v[u][j].z * v[u][j].z + v[u][j].w * v[u][j].w;
            const float rinv = rsqrtf(wave_sum(ss) * (1.0f / D) + EPS);
            f32x4* xr = (f32x4*)(p.out + (size_t)(row0 + u) * D);
#pragma unroll
            for (int j = 0; j < 4; ++j) xr[F.lane + 64 * j] = v[u][j] * rinv * gg[j];
        }
    }
}

DI float lane_xor32(float v, bool hi) { const auto r = __builtin_amdgcn_permlane32_swap(__builtin_bit_cast(unsigned, v), __builtin_bit_cast(unsigned, v), false, false);
    return __builtin_bit_cast(float, hi ? r[0] : r[1]); }
struct EpiG1 {
    DI bool keeps(const pg8::Unit&) const { return false; }
    static constexpr bool PERM = true;
    unsigned char* ws;
    DI void operator()(const f32x4 (&acc)[2][2][4][2], const pg8::Unit& u, int wr, int wc, int fr, int fq) const {
        bf16_t* P = (bf16_t*)(ws + WS_P);
        const int rbase = u.pm * 256 + wr * 64 + fr;
        const bool hi = fq >= 2;
#pragma unroll
        for (int ai = 0; ai < 2; ++ai) {
            f32x4 cs[4][4];
            const bool lat = u.pm < TL / 256;
            if (u.pn < 3 && lat) {
#pragma unroll
                for (int m = 0; m < 4; ++m) {
                    const int t = (rbase + 128 * ai + 16 * m) & (SEQ - 1), pos = (wc & 1) ? (t & 63) : (t >> 6);
                    const f32x4* tab = (const f32x4*)(ws + WS_ROPE) + (pos * 16 + 8 * (fq & 1)) / 2;
#pragma unroll
                    for (int j2 = 0; j2 < 4; ++j2) cs[m][j2] = tab[j2];
                }
            }
#pragma unroll
            for (int m = 0; m < 4; ++m) {
                const int row = rbase + 128 * ai + 16 * m;
#pragma unroll
                for (int bj = 0; bj < 2; ++bj) {
                    const int c0 = u.pn * 256 + 128 * bj + 32 * wc + 8 * fq;
                    float v[8];
#pragma unroll
                    for (int j = 0; j < 4; ++j) { v[j] = acc[ai][bj][m][0][j]; v[4 + j] = acc[ai][bj][m][1][j]; }
                    if (c0 < VOFF) {
                        const float sc = (c0 < KOFF) ? QSCALE : 1.0f;
                        u32x4 o;
#pragma unroll
                        for (int j2 = 0; j2 < 4; ++j2) {
                            const f32x4 c4 = cs[m][j2];
                            const float o0 = lane_xor32(v[2 * j2], hi), o1 = lane_xor32(v[2 * j2 + 1], hi);
                            float r0 = hi ? (v[2 * j2] * c4.x + o0 * c4.y) : (v[2 * j2] * c4.x - o0 * c4.y);
                            float r1 = hi ? (v[2 * j2 + 1] * c4.z + o1 * c4.w) : (v[2 * j2 + 1] * c4.z - o1 * c4.w);
                            if (!lat) { r0 = v[2 * j2]; r1 = v[2 * j2 + 1]; }
                            o[j2] = pk2(r0 * sc, r1 * sc);
                        }
                        *(u32x4*)(P + (size_t)row * PW + c0) = o;
                    } else if (c0 < POOLOFF) {
                        const int hk = wc >> 1, d0 = 32 * (wc & 1) + 8 * fq;
                        if (lat) { const int b = row / SEQ, t = row & (SEQ - 1);
                            bf16_t* vt = (bf16_t*)(ws + WS_VT) + ((size_t)(b * 2 + hk) * 64 + d0) * VTS + t;
#pragma unroll
                            for (int j = 0; j < 8; ++j) vt[(size_t)j * VTS] = (bf16_t)f2bf(v[j]);
                        } else { const int rc = row - TL, b = rc / NCTX, jc = rc & (NCTX - 1);
                            bf16_t* vt = (bf16_t*)(ws + WS_VTC) + ((size_t)(b * 2 + hk) * 64 + d0) * NCTX + jc;
#pragma unroll
                            for (int j = 0; j < 8; ++j) vt[(size_t)j * NCTX] = (bf16_t)f2bf(v[j]);
                        }
                    } else if (c0 < SUOFF) {
                        u32x4 o;
#pragma unroll
                        for (int j2 = 0; j2 < 4; ++j2) o[j2] = pk2(v[2 * j2], v[2 * j2 + 1]);
                        *(u32x4*)(P + (size_t)row * PW + c0) = o;
                    } else if (c0 < SVOFF) {
                        u32x4 o;
#pragma unroll
                        for (int j2 = 0; j2 < 4; ++j2) o[j2] = pk2(gelu_tanh(v[2 * j2]), gelu_tanh(v[2 * j2 + 1]));
                        *(u32x4*)(P + (size_t)row * PW + c0) = o;
                    } else {
                        const int c = c0 - SVOFF, chunk = row >> 7, q = row & 127;
                        bf16_t* vs = (bf16_t*)(ws + WS_VST) + ((size_t)chunk * 256 + c) * 128 + q;
#pragma unroll
                        for (int j = 0; j < 8; ++j) vs[j * 128] = (bf16_t)f2bf(gelu_tanh(v[j]));
                    }
                }
            }
            asm volatile("" ::: "memory");
        }
    }
};
struct SchedGrid {
    int nM, nN, G, c; const char* A; const char* B;
    int n_extra, ex_pm0, ex_pn;
    DI bool next(int i, pg8::Unit& u) const {
        const int L = i * G + c, n = nM * nN; if (L >= n + n_extra) return false;
        if (L < n) pg8::tile_of(L, nM, nN, u.pm, u.pn); else { u.pm = ex_pm0 + (L - n); u.pn = ex_pn; }
        u.sub = 0; u.nt = D / 64; u.mode = 0;
        u.a = A + (size_t)u.pm * 256 * D * 2; u.b = B + (size_t)u.pn * 256 * D * 2; return true;
    }
};

DI void phase_g1(const Params& p, const Frame& F, int l) {
    SchedGrid S{(l == 0 ? T : TL) / 256, PN / 256, F.nb, F.bid, (const char*)(p.ws + WS_H), (const char*)(p.ws + WS_WIN) + (size_t)l * INW * D * 2,
                (l == 0) ? 0 : TC / 256, TL / 256, 2};
    EpiG1 E{p.ws};
    pg8::gemm_phase(F.lds, F.tid, S, E);
}

DI bf16x8 pack8(const f32x16& x, int s) {
    u32x4 pk;
#pragma unroll
    for (int j = 0; j < 4; ++j) { f32x2 v = {x[8 * s + 2 * j], x[8 * s + 2 * j + 1]}; pk[j] = __builtin_bit_cast(unsigned, __builtin_convertvector(v, bf16x2_t)); }
    return __builtin_bit_cast(bf16x8, pk);
}

DI float lane_x32(float v, bool hi) { const auto r = __builtin_amdgcn_permlane32_swap(__builtin_bit_cast(unsigned, v), __builtin_bit_cast(unsigned, v), false, false);
    return __builtin_bit_cast(float, hi ? r[0] : r[1]); }
struct AttnFrags { bf16x8 kf[4]; s16x4 vf[2][4]; };
DI void attn_block(const bf16x8 (&qf)[4], const AttnFrags& f, int mask_mode, int kq_off, int lane, float& m, float& lpart, f32x16 (&o)[2]) {
    const int h = lane >> 5;
    f32x16 st;
#pragma unroll
    for (int r = 0; r < 16; ++r) st[r] = 0.f;
#pragma unroll
    for (int s = 0; s < 4; ++s) st = MFMA32(f.kf[s], qf[s], st);
    if (mask_mode) {
#pragma unroll
        for (int r = 0; r < 16; ++r) { const int dlt = kq_off + crow(r, h); if (dlt > 128 || dlt < -128) st[r] = -1e30f; }
    }
    float bm = st[0];
#pragma unroll
    for (int r = 1; r < 16; ++r) bm = fmaxf(bm, st[r]);
    bm = fmaxf(bm, lane_x32(bm, h != 0));
    const float mn = fmaxf(m, bm);
    if (__builtin_amdgcn_ballot_w64(mn > m) != 0ull) {
        const float alpha = __builtin_amdgcn_exp2f(m - mn);
        lpart *= alpha;
#pragma unroll
        for (int d = 0; d < 2; ++d)
#pragma unroll
            for (int r = 0; r < 16; ++r) o[d][r] *= alpha;
        m = mn;
    }
    float ps = 0.f;
#pragma unroll
    for (int r = 0; r < 16; ++r) { st[r] = __builtin_amdgcn_exp2f(st[r] - m); ps += st[r]; }
    lpart += ps;
    const bf16x8 pf0 = pack8(st, 0), pf1 = pack8(st, 1);
#pragma unroll
    for (int d = 0; d < 2; ++d) {
        const bf16x8 v0 = __builtin_shufflevector(f.vf[d][0], f.vf[d][1], 0, 1, 2, 3, 4, 5, 6, 7), v1 = __builtin_shufflevector(f.vf[d][2], f.vf[d][3], 0, 1, 2, 3, 4, 5, 6, 7);
        o[d] = MFMA32(v0, pf0, o[d]);
        o[d] = MFMA32(v1, pf1, o[d]);
    }
}

constexpr int AKP = 144, AVWP = 648, AVCP = 520;
constexpr int ALDS_KW = 0, ALDS_VW = ALDS_KW + 320 * AKP, ALDS_KC = ALDS_VW + 64 * AVWP, ALDS_VC = ALDS_KC + 256 * AKP, ALDS_END = ALDS_VC + 64 * AVCP;
static_assert(ALDS_END <= LDS_BAR_OFF && (ALDS_VW % 16) == 0 && (ALDS_KC % 16) == 0 && (ALDS_VC % 8) == 0, "attention LDS map");
DI void attn_lds_frags(AttnFrags& f, const LAS unsigned char* kp, const LAS unsigned char* vp, int vpitch32) {
#pragma unroll
    for (int s = 0; s < 4; ++s) f.kf[s] = *(const LAS bf16x8*)(kp + 32 * s);
#pragma unroll
    for (int d = 0; d < 2; ++d)
#pragma unroll
        for (int q = 0; q < 4; ++q) f.vf[d][q] = *(const LAS s16x4*)(vp + d * vpitch32 + 16 * q);
}
DI void attn_unit(const Params& p, const Frame& F, int l, int unit) {
    const int lane = F.lane, r = lane & 31, h = lane >> 5, tid = F.tid;
    const bf16_t* P = (const bf16_t*)(p.ws + WS_P);
    const bf16_t* VT = (const bf16_t*)(p.ws + WS_VT);
    const bf16_t* VTC = (const bf16_t*)(p.ws + WS_VTC);
    bf16_t* Y = (bf16_t*)(p.ws + WS_Y);
    const bool latent = unit < 1024;
    int b, hk, p0, q0row;
    if (latent) { const int pb = unit & 63; hk = (unit >> 6) & 1; b = unit >> 7; p0 = pb * 64; q0row = b * SEQ + p0; }
    else { const int u2 = unit - 1024, pb = u2 & 3; hk = (u2 >> 2) & 1; b = u2 >> 3; p0 = pb * 64; q0row = TL + b * NCTX + p0; }
    const int w0 = p0 - 128;
    u32x4 kw[5], vw[5], kc[4], vc[4];
    if (latent) {
#pragma unroll
        for (int it = 0; it < 5; ++it) {
            const int i = tid + it * NTHREADS, row = i >> 3, ck = i & 7, pos = min(max(w0 + row, 0), SEQ - 1);
            kw[it] = *(const u32x4*)(P + (size_t)(b * SEQ + pos) * PW + KOFF + hk * 64 + 8 * ck);
            const int d = i / 40, cv = i % 40, pv = min(max(w0 + 8 * cv, 0), SEQ - 8);
            vw[it] = *(const u32x4*)(VT + ((size_t)(b * 2 + hk) * 64 + d) * VTS + pv);
        }
    }
#pragma unroll
    for (int it = 0; it < 4; ++it) {
        const int i = tid + it * NTHREADS;
        kc[it] = *(const u32x4*)(P + (size_t)(TL + b * NCTX + (i >> 3)) * PW + KOFF + hk * 64 + 8 * (i & 7));
        vc[it] = *(const u32x4*)(VTC + ((size_t)(b * 2 + hk) * 64 + (i >> 5)) * NCTX + 8 * (i & 31));
    }
    __syncthreads();
    if (latent) {
#pragma unroll
        for (int it = 0; it < 5; ++it) {
            const int i = tid + it * NTHREADS, row = i >> 3, ck = i & 7;
            *(LAS u32x4*)(F.lds + ALDS_KW + row * AKP + 16 * ck) = kw[it];
            const int d = i / 40, cv = i % 40;
            LAS u32x2* dst = (LAS u32x2*)(F.lds + ALDS_VW + d * AVWP + 16 * cv); dst[0] = (u32x2){vw[it].x, vw[it].y}; dst[1] = (u32x2){vw[it].z, vw[it].w};
        }
    }
#pragma unroll
    for (int it = 0; it < 4; ++it) {
        const int i = tid + it * NTHREADS;
        *(LAS u32x4*)(F.lds + ALDS_KC + (i >> 3) * AKP + 16 * (i & 7)) = kc[it];
        LAS u32x2* dst = (LAS u32x2*)(F.lds + ALDS_VC + (i >> 5) * AVCP + 16 * (i & 31)); dst[0] = (u32x2){vc[it].x, vc[it].y}; dst[1] = (u32x2){vc[it].z, vc[it].w};
    }
    const int head = 4 * hk + (F.wave & 3), ph = F.wave >> 2, pw = p0 + 32 * ph, qrow = q0row + 32 * ph;
    bf16x8 qf[4];
#pragma unroll
    for (int s = 0; s < 4; ++s) qf[s] = *(const bf16x8*)(P + (size_t)(qrow + r) * PW + head * 64 + 16 * s + 8 * h);
    float m = p.in[I_attn_sink][l * 8 + head] * LOG2E, lpart = (h == 0) ? 1.0f : 0.0f;
    f32x16 o[2];
#pragma unroll
    for (int d = 0; d < 2; ++d)
#pragma unroll
        for (int i = 0; i < 16; ++i) o[d][i] = 0.f;
    __syncthreads();
    if (latent) {
#pragma unroll 1
        for (int j = 0; j < 9; ++j) {
            const int kb = pw - 128 + 32 * j;
            if (kb < 0 || kb >= SEQ) continue;
            const int krow = kb - w0;
            AttnFrags f;
            attn_lds_frags(f, F.lds + ALDS_KW + (krow + r) * AKP + 16 * h, F.lds + ALDS_VW + r * AVWP + 2 * krow + 8 * h, 32 * AVWP);
            attn_block(qf, f, (j == 0 || j == 8) ? 1 : 0, kb - (pw + r), lane, m, lpart, o);
        }
    }
#pragma unroll 1
    for (int j = 0; j < 8; ++j) {
        AttnFrags f;
        attn_lds_frags(f, F.lds + ALDS_KC + (32 * j + r) * AKP + 16 * h, F.lds + ALDS_VC + r * AVCP + 64 * j + 8 * h, 32 * AVCP);
        attn_block(qf, f, 0, 0, lane, m, lpart, o);
    }
    const float inv = 1.0f / (lpart + lane_x32(lpart, h != 0));
    bf16_t* yrow = Y + (size_t)(qrow + r) * D + head * 64;
#pragma unroll
    for (int d = 0; d < 2; ++d)
#pragma unroll
        for (int g = 0; g < 4; ++g) {
            u32x2 w; w.x = pk2(o[d][4 * g] * inv, o[d][4 * g + 1] * inv); w.y = pk2(o[d][4 * g + 2] * inv, o[d][4 * g + 3] * inv);
            *(u32x2*)(yrow + 32 * d + 8 * g + 4 * h) = w;
        }
}

DI void sgu_unit(const Params& p, const Frame& F, int l, int chunk) {
    constexpr int VS = 136;
    LAS float* part = (LAS float*)F.lds;
    LAS float* rq = part + 512;
    LAS bf16_t* vnT = (LAS bf16_t*)(F.lds + 4096);
    const bf16_t* VsT = (const bf16_t*)(p.ws + WS_VST) + (size_t)chunk * 256 * 128;
    const bf16_t* P = (const bf16_t*)(p.ws + WS_P);
    bf16_t* Y = (bf16_t*)(p.ws + WS_Y);
    __syncthreads();
    { const int q = F.tid & 127, part_i = F.tid >> 7; float ss = 0.f;
#pragma unroll 16
        for (int c = part_i * 64; c < part_i * 64 + 64; ++c) { const float v = bf2f(VsT[c * 128 + q]); ss += v * v; }
        part[part_i * 128 + q] = ss; }
    __syncthreads();
    if (F.tid < 128) rq[F.tid] = rsqrtf((part[F.tid] + part[128 + F.tid] + part[256 + F.tid] + part[384 + F.tid]) * (1.0f / 256.0f) + EPS);
    __syncthreads();
#pragma unroll
    for (int it = 0; it < 8; ++it) {
        const int i = F.tid + it * NTHREADS;
        const int c = i >> 4, q8 = (i & 15) * 8;
        const u32x4 v = *(const u32x4*)(VsT + c * 128 + q8);
        u32x4 o;
#pragma unroll
        for (int j = 0; j < 4; ++j) o[j] = pk2(bflo(v[j]) * rq[q8 + 2 * j], bfhi(v[j]) * rq[q8 + 2 * j + 1]);
        *(LAS u32x4*)(vnT + c * VS + q8) = o;
    }
    __syncthreads();
    const int lane = F.lane, r = lane & 31, h = lane >> 5, g = F.wave >> 1, ph = F.wave & 1;
    const bf16_t* Wg = (const bf16_t*)(p.ws + WS_SGUW) + ((size_t)l * 4 + g) * 128 * 128;
#pragma unroll 1
    for (int pb = 0; pb < 2; ++pb) {
        const int p0 = 64 * ph + 32 * pb;
        const int row = chunk * 128 + p0 + r;
        bf16x8 wf[8];
#pragma unroll
        for (int s = 0; s < 8; ++s) wf[s] = *(const bf16x8*)(Wg + (size_t)(p0 + r) * 128 + 16 * s + 8 * h);
        u32x2 uu[2][4];
#pragma unroll
        for (int cb = 0; cb < 2; ++cb)
#pragma unroll
            for (int q4 = 0; q4 < 4; ++q4) uu[cb][q4] = *(const u32x2*)(P + (size_t)row * PW + SUOFF + 64 * g + 32 * cb + 8 * q4 + 4 * h);
        const float bias = p.in[I_sgu_b][(l * 4 + g) * 128 + p0 + r];
#pragma unroll
        for (int cb = 0; cb < 2; ++cb) {
            const int c0 = 64 * g + 32 * cb;
            f32x16 acc;
#pragma unroll
            for (int i = 0; i < 16; ++i) acc[i] = 0.f;
#pragma unroll
            for (int s = 0; s < 8; ++s) {
                const bf16x8 a = *(const LAS bf16x8*)(vnT + (c0 + r) * VS + 16 * s + 8 * h);
                acc = MFMA32(a, wf[s], acc);
            }
#pragma unroll
            for (int q4 = 0; q4 < 4; ++q4) {
                const int cc = c0 + 8 * q4 + 4 * h;
                const u32x2 u = uu[cb][q4];
                u32x2 w;
                w.x = pk2(bflo(u.x) * (acc[4 * q4] + bias), bfhi(u.x) * (acc[4 * q4 + 1] + bias));
                w.y = pk2(bflo(u.y) * (acc[4 * q4 + 2] + bias), bfhi(u.y) * (acc[4 * q4 + 3] + bias));
                *(u32x2*)(Y + (size_t)row * D + 768 + cc) = w;
            }
        }
    }
}

DI void phase_mix(const Params& p, const Frame& F, int l, int ctr_slot = 0) {
    (void)ctr_slot;
    const int nrows = (l == 0) ? T : TL;
    const bf16_t* P = (const bf16_t*)(p.ws + WS_P);
    bf16_t* Y = (bf16_t*)(p.ws + WS_Y);
    for (int i0 = F.bid * NTHREADS; i0 < 4 * nrows * 8; i0 += F.nb * NTHREADS) {
        const int i = i0 + F.tid, g = i / (nrows * 8), rem = i - g * (nrows * 8), row = rem >> 3, ck = g * 8 + (rem & 7);
        int base, t, len;
        if (row < TL) { base = row & ~(SEQ - 1); t = row & (SEQ - 1); len = SEQ; } else { const int rc = row - TL; base = TL + (rc & ~(NCTX - 1)); t = rc & (NCTX - 1); len = NCTX; }
        float s[8];
#pragma unroll
        for (int j = 0; j < 8; ++j) s[j] = 0.f;
        const bf16_t* zc = P + POOLOFF + ck * 8;
#define POOL_WIN(HALF) do { _Pragma("unroll") for (int dt = -(HALF); dt < (HALF); ++dt) { const int tt = t + dt; const bool ok = tt >= 0 && tt < len; \
            const u32x4 v = *(const u32x4*)(zc + (size_t)(base + (ok ? tt : t)) * PW); const float w = ok ? 1.f : 0.f; \
            _Pragma("unroll") for (int j = 0; j < 4; ++j) { s[2 * j] += w * bflo(v[j]); s[2 * j + 1] += w * bfhi(v[j]); } } } while (0)
        int half;
        if (g == 0) { POOL_WIN(1); half = 1; } else if (g == 1) { POOL_WIN(2); half = 2; } else if (g == 2) { POOL_WIN(4); half = 4; } else { POOL_WIN(8); half = 8; }
#undef POOL_WIN
        const int lo = max(t - half, 0), hi = min(t + half, len);
        const float inv = 1.0f / (float)(hi - lo);
        const u32x4 z = *(const u32x4*)(zc + (size_t)row * PW);
        u32x4 o;
#pragma unroll
        for (int j = 0; j < 4; ++j) o[j] = pk2(s[2 * j] * inv - bflo(z[j]), s[2 * j + 1] * inv - bfhi(z[j]));
        *(u32x4*)(Y + (size_t)row * D + 512 + ck * 8) = o;
    }
    const int nchunk = (l == 0) ? T / 128 : TL / 128;
    for (int ch = F.bid; ch < nchunk; ch += F.nb) sgu_unit(p, F, l, ch);
    const int nunit = (l == 0) ? 1024 + 64 : 1024;
    for (int u = F.nb - 1 - F.bid; u < nunit; u += F.nb) attn_unit(p, F, l, u);
}

struct SchedG2 {
    int G, c; const char *H, *Y, *Wg, *Wb; int npair;
    DI void fill(pg8::Unit& u, int sub, int br) const {
        u.sub = sub;
        if ((sub & 1) == 0) { u.nt = 16; u.a = H + (size_t)u.pm * 256 * D * 2; u.b = Wg + ((size_t)br * D + u.pn * 256) * D * 2; }
        else { const int koff = (br == 0) ? 0 : (br == 1 ? 512 : 768); u.nt = (br == 0) ? 8 : 4;
               u.a = Y + ((size_t)u.pm * 256 * D + koff) * 2; u.b = Wb + ((size_t)u.pn * 256 * D + koff) * 2; }
    }
    DI bool next(int i, pg8::Unit& u) const {
        constexpr int NLAT = (TL / 256) * 4;
        const int nl = (NLAT - c + G - 1) / G;
        if (i < 6 * nl) { const int tile = (i / 6) * G + c, sub = i % 6; pg8::tile_of(tile, TL / 256, 4, u.pm, u.pn); u.mode = 0; fill(u, sub, sub >> 1); return true; }
        const int e = i - 6 * nl, j = (e >> 1) * G + c;
        if (j >= npair) return false;
        const int ctile = j / 3, br = j % 3;
        u.pm = TL / 256 + (ctile >> 2); u.pn = ctile & 3; u.mode = 1 + br; fill(u, e & 1, br); return true;
    }
};
struct EpiG2 {
    static constexpr bool PERM = true;
    bf16_t* scr; bf16_t* M; bf16_t* MP;
    DI bool keeps(const pg8::Unit& u) const { return (u.sub & 1) == 0; }
    DI void operator()(f32x4 (&acc)[2][2][4][2], const pg8::Unit& u, int wr, int wc, int fr, int fq) const {
        const bool gate = (u.sub & 1) == 0, first = u.sub == 0 && gate;
        bf16_t* Mo = (u.mode == 0) ? M + (size_t)u.pm * 256 * D : MP + ((size_t)(u.mode - 1) * TC + (size_t)(u.pm - TL / 256) * 256) * D;
#pragma unroll
        for (int ai = 0; ai < 2; ++ai) {
            u32x4 ld[4][2];
            if (!first) {
#pragma unroll
                for (int m = 0; m < 4; ++m)
#pragma unroll
                    for (int bj = 0; bj < 2; ++bj) {
                        const int rl = 128 * ai + 64 * wr + 16 * m + fr, cl = 128 * bj + 32 * wc + 8 * fq;
                        ld[m][bj] = gate ? *(const u32x4*)(Mo + (size_t)rl * D + u.pn * 256 + cl) : *(const u32x4*)(scr + rl * 256 + cl);
                    }
            }
#pragma unroll
            for (int m = 0; m < 4; ++m)
#pragma unroll
                for (int bj = 0; bj < 2; ++bj) {
                    const int rl = 128 * ai + 64 * wr + 16 * m + fr, cl = 128 * bj + 32 * wc + 8 * fq;
                    if (gate) {
                        u32x4 o;
#pragma unroll
                        for (int j2 = 0; j2 < 4; ++j2) {
                            const int n = j2 >> 1, e = 2 * (j2 & 1);
                            const unsigned w = pk2(fmaxf(sigmoidf_(acc[ai][bj][m][n][e]), 1e-20f), fmaxf(sigmoidf_(acc[ai][bj][m][n][e + 1]), 1e-20f));
                            o[j2] = w;
                            const float t0 = first ? 0.f : bflo(ld[m][bj][j2]), t1 = first ? 0.f : bfhi(ld[m][bj][j2]);
                            acc[ai][bj][m][n][e] = t0 * __builtin_amdgcn_rcpf(bflo(w)); acc[ai][bj][m][n][e + 1] = t1 * __builtin_amdgcn_rcpf(bfhi(w));
                        }
                        *(u32x4*)(scr + rl * 256 + cl) = o;
                    } else {
                        u32x4 w;
#pragma unroll
                        for (int j2 = 0; j2 < 4; ++j2) { const int n = j2 >> 1, e = 2 * (j2 & 1);
                            w[j2] = pk2(acc[ai][bj][m][n][e] * bflo(ld[m][bj][j2]), acc[ai][bj][m][n][e + 1] * bfhi(ld[m][bj][j2])); }
                        *(u32x4*)(Mo + (size_t)rl * D + u.pn * 256 + cl) = w;
                    }
                }
            asm volatile("" ::: "memory");
        }
    }
};
DI void phase_g2(const Params& p, const Frame& F, int l) {
    SchedG2 S{F.nb, F.bid, (const char*)(p.ws + WS_H), (const char*)(p.ws + WS_Y),
              (const char*)(p.ws + WS_WIN) + ((size_t)l * INW + GATEOFF) * D * 2, (const char*)(p.ws + WS_WBR) + (size_t)l * D * D * 2, (l == 0) ? (TC / 256) * 4 * 3 : 0};
    EpiG2 E{(bf16_t*)(p.ws + WS_IDX) + (size_t)F.bid * 65536, (bf16_t*)(p.ws + WS_MERGED), (bf16_t*)(p.ws + WS_MP)};
    pg8::gemm_phase(F.lds, F.tid, S, E);
}
DI void phase_g2sum(const Params& p, const Frame& F) {
    const u32x4* mp = (const u32x4*)(p.ws + WS_MP);
    u32x4* mo = (u32x4*)((bf16_t*)(p.ws + WS_MERGED) + (size_t)TL * D);
    constexpr int NV = TC * D / 8;
    for (int i = F.gtid; i < NV; i += F.ngt) {
        const u32x4 a = mp[i], b = mp[NV + i], c = mp[2 * NV + i];
        u32x4 o;
#pragma unroll
        for (int j = 0; j < 4; ++j) o[j] = pk2(bflo(a[j]) + bflo(b[j]) + bflo(c[j]), bfhi(a[j]) + bfhi(b[j]) + bfhi(c[j]));
        mo[i] = o;
    }
}

struct EpiG3 {
    DI bool keeps(const pg8::Unit&) const { return false; }
    static constexpr bool PERM = false;
    const float* xsrc; float* xdst; const float* csrc; float* cdst; const float* mod;
    DI void operator()(const f32x4 (&acc)[2][2][4][2], const pg8::Unit& u, int wr, int wc, int fr, int fq) const {
        const int col0 = u.pn * 256 + wc * 32 + 4 * fq;
        const bool lat = u.pm < TL / 256;
        const float* gt = mod + (size_t)(lat ? (u.pm >> 4) : 8) * NMOD + 2 * D;
        const float* xs = lat ? xsrc + (size_t)u.pm * 256 * D : csrc + (size_t)(u.pm - TL / 256) * 256 * D;
        float* xd = lat ? xdst + (size_t)u.pm * 256 * D : cdst + (size_t)(u.pm - TL / 256) * 256 * D;
        f32x4 gv[2][2];
#pragma unroll
        for (int bj = 0; bj < 2; ++bj)
#pragma unroll
            for (int n = 0; n < 2; ++n) gv[bj][n] = *(const f32x4*)(gt + col0 + 128 * bj + 16 * n);
#pragma unroll
        for (int ai = 0; ai < 2; ++ai) {
            f32x4 xv[4][2][2];
#pragma unroll
            for (int m = 0; m < 4; ++m)
#pragma unroll
                for (int bj = 0; bj < 2; ++bj)
#pragma unroll
                    for (int n = 0; n < 2; ++n) xv[m][bj][n] = *(const f32x4*)(xs + (size_t)(wr * 64 + fr + 128 * ai + 16 * m) * D + col0 + 128 * bj + 16 * n);
#pragma unroll
            for (int m = 0; m < 4; ++m)
#pragma unroll
                for (int bj = 0; bj < 2; ++bj)
#pragma unroll
                    for (int n = 0; n < 2; ++n)
                        *(f32x4*)(xd + (size_t)(wr * 64 + fr + 128 * ai + 16 * m) * D + col0 + 128 * bj + 16 * n) = xv[m][bj][n] + gv[bj][n] * acc[ai][bj][m][n];
            asm volatile("" ::: "memory");
        }
    }
};
DI void phase_g3(const Params& p, const Frame& F, int l) {
    SchedGrid S{(l == 0 ? T : TL) / 256, D / 256, F.nb, F.bid, (const char*)(p.ws + WS_MERGED), (const char*)(p.ws + WS_WOUT) + (size_t)l * D * D * 2, 0, 0, 0};
    float* xc = (float*)(p.ws + WS_XCTX);
    EpiG3 E{(l == 0) ? p.in[I_x] : p.out, p.out, (l == 0) ? p.in[I_ctx] : xc, xc, (const float*)(p.ws + WS_MOD) + (size_t)l * 9 * NMOD};
    pg8::gemm_phase(F.lds, F.tid, S, E);
}

struct EpiG45 {
    DI bool keeps(const pg8::Unit&) const { return false; }
    static constexpr bool PERM = true;
    unsigned short* ST;
    DI void operator()(const f32x4 (&acc)[2][2][4][2], const pg8::Unit& u, int wr, int wc, int fr, int fq) const {
        const int col0 = u.pn * 256 + wc * 32 + 8 * fq;
#pragma unroll
        for (int ai = 0; ai < 2; ++ai)
#pragma unroll
            for (int m = 0; m < 4; ++m) {
                unsigned short* rowp = ST + (size_t)(u.pm * 256 + wr * 64 + fr + 128 * ai + 16 * m) * T + col0;
#pragma unroll
                for (int bj = 0; bj < 2; ++bj) {
                    u32x4 w;
                    w.x = pkh2(acc[ai][bj][m][0][0], acc[ai][bj][m][0][1]); w.y = pkh2(acc[ai][bj][m][0][2], acc[ai][bj][m][0][3]);
                    w.z = pkh2(acc[ai][bj][m][1][0], acc[ai][bj][m][1][1]); w.w = pkh2(acc[ai][bj][m][1][2], acc[ai][bj][m][1][3]);
                    *(u32x4*)(rowp + 128 * bj) = w;
                }
            }
    }
};
DI void phase_g45(const Params& p, const Frame& F, int l) {
    SchedGrid S{2048 / 256, (l == 0 ? T : TL) / 256, F.nb, F.bid, (const char*)(p.ws + WS_WFOLD) + (size_t)l * 2048 * D * 2, (const char*)(p.ws + WS_H), 0, 0, 0};
    EpiG45 E{(unsigned short*)(p.ws + WS_ST)};
    pg8::gemm_phase(F.lds, F.tid, S, E);
}

DI unsigned fkey(float f) { const unsigned u = __builtin_bit_cast(unsigned, f); return (u & 0x80000000u) ? ~u : (u | 0x80000000u); }
DI float fkey_inv(unsigned k) { const unsigned u = (k & 0x80000000u) ? (k & 0x7fffffffu) : ~k; return __builtin_bit_cast(float, u); }
#define INSERT16(L, x) do { unsigned x_ = (x); _Pragma("unroll") for (int k_ = 0; k_ < 16; ++k_) { const unsigned hi_ = max(L[k_], x_); x_ = min(L[k_], x_); L[k_] = hi_; } } while (0)
#define CEX(a, b) do { const unsigned hi_ = max(a, b), lo_ = min(a, b); a = hi_; b = lo_; } while (0)
DI void sort16_desc(unsigned (&v)[16]) {
#pragma unroll
    for (int k = 2; k <= 16; k <<= 1)
#pragma unroll
        for (int j = k >> 1; j > 0; j >>= 1)
#pragma unroll
            for (int i = 0; i < 16; ++i) {
                const int q = i ^ j;
                if (q > i) { if ((i & k) == 0) CEX(v[i], v[q]); else CEX(v[q], v[i]); }
            }
}
DI void merge16_desc(unsigned (&L)[16], const unsigned (&N)[16]) {
#pragma unroll
    for (int i = 0; i < 16; ++i) L[i] = max(L[i], N[15 - i]);
#pragma unroll
    for (int j = 8; j > 0; j >>= 1)
#pragma unroll
        for (int i = 0; i < 16; ++i) { const int q = i ^ j; if (q > i) CEX(L[i], L[q]); }
}
DI void phase_sel(const Params& p, const Frame& F, int l) {
    const _Float16* ST = (const _Float16*)(p.ws + WS_ST);
    unsigned short* IDX = (unsigned short*)(p.ws + WS_IDX);
    float* GW = (float*)(p.ws + WS_GW);
    float* SU = (float*)(p.ws + WS_SU);
    const float* TSC = (const float*)(p.ws + WS_TSCALE) + (size_t)l * 2 * NEXP;
    LAS unsigned char* ib = (LAS unsigned char*)F.lds;
    const int ntok = (l == 0) ? T : TL;
    for (int i0 = F.bid * NTHREADS; i0 < ntok * 8; i0 += F.nb * NTHREADS) {
        const int i = i0 + F.tid;
        const int tok = i % ntok, head = i / ntok;
        unsigned la[16], lb[16];
#pragma unroll
        for (int k = 0; k < 16; ++k) { la[k] = 0u; lb[k] = 0u; }
        const _Float16* s0 = ST + (size_t)(head * 256) * T + tok;
#define SEL_LOAD(B_, k0_) do { _Pragma("unroll") for (int j = 0; j < 32; ++j) B_[j] = sp[(size_t)((k0_) + j) * T]; } while (0)
#define SEL_GRP(L_, B_, o_, k0_) do { unsigned nk_[16]; \
        _Pragma("unroll") for (int j = 0; j < 16; ++j) nk_[j] = (fkey((float)B_[(o_) + j]) & ~127u) | (unsigned)(127 - ((k0_) + j)); \
        sort16_desc(nk_); merge16_desc(L_, nk_); } while (0)
#define SEL_HALF(L_, base_) do { const _Float16* sp = s0 + (size_t)(base_) * T; _Float16 bufa[32], bufb[32]; \
        SEL_LOAD(bufa, 0); \
        _Pragma("unroll 1") for (int k0 = 0; k0 < 128; k0 += 64) { \
            SEL_LOAD(bufb, k0 + 32); SEL_GRP(L_, bufa, 0, k0); SEL_GRP(L_, bufa, 16, k0 + 16); \
            SEL_LOAD(bufa, (k0 + 64) & 127); SEL_GRP(L_, bufb, 0, k0 + 32); SEL_GRP(L_, bufb, 16, k0 + 48); } } while (0)
        SEL_HALF(la, 0);
        SEL_HALF(lb, 128);
#undef SEL_LOAD
#undef SEL_GRP
#undef SEL_HALF
        float va[16], vb[16];
#pragma unroll
        for (int k = 0; k < 16; ++k) {
            va[k] = fkey_inv(la[k] & ~127u); vb[k] = fkey_inv(lb[k] & ~127u);
            ib[k * NTHREADS + F.tid] = (unsigned char)(127u - (la[k] & 127u));
            ib[(16 + k) * NTHREADS + F.tid] = (unsigned char)(127u - (lb[k] & 127u));
        }
        unsigned lc[16];
#pragma unroll
        for (int k = 0; k < 16; ++k) lc[k] = 0u;
#pragma unroll
        for (int a = 0; a < 16; ++a)
#pragma unroll
            for (int b = 0; b < 16; ++b)
                if ((a + 1) * (b + 1) <= 16) { const unsigned key = (fkey(va[a] + vb[b]) & ~255u) | (unsigned)(255 - (a * 16 + b)); INSERT16(lc, key); }
        float e[16], sum = 0.f; const float v0 = fkey_inv(lc[0] & ~255u);
#pragma unroll
        for (int k = 0; k < 16; ++k) { e[k] = __expf(fkey_inv(lc[k] & ~255u) - v0); sum += e[k]; }
        const float inv = 1.0f / sum;
        asm volatile("s_waitcnt lgkmcnt(0)" ::: "memory");
        unsigned exs[16]; float gws[16], sus[16];
#pragma unroll
        for (int k = 0; k < 16; ++k) {
            const unsigned pos = 255u - (lc[k] & 255u), a = pos >> 4, b = pos & 15u;
            const unsigned ea = ib[a * NTHREADS + F.tid], eb = ib[(16 + b) * NTHREADS + F.tid];
            exs[k] = ea * 128u + eb;
        }
#pragma unroll
        for (int k = 0; k < 16; ++k) { gws[k] = e[k] * inv * TSC[NEXP + exs[k]]; sus[k] = TSC[exs[k]]; }
        { const size_t o = (size_t)tok * 128 + head * 16;
#pragma unroll
          for (int q = 0; q < 2; ++q) { u32x4 w;
#pragma unroll
              for (int j = 0; j < 4; ++j) w[j] = exs[8 * q + 2 * j] | (exs[8 * q + 2 * j + 1] << 16);
              *(u32x4*)(IDX + o + 8 * q) = w; }
#pragma unroll
          for (int q = 0; q < 4; ++q) { *(f32x4*)(GW + o + 4 * q) = (f32x4){gws[4 * q], gws[4 * q + 1], gws[4 * q + 2], gws[4 * q + 3]};
                                        *(f32x4*)(SU + o + 4 * q) = (f32x4){sus[4 * q], sus[4 * q + 1], sus[4 * q + 2], sus[4 * q + 3]}; } }
        asm volatile("s_waitcnt lgkmcnt(0)" ::: "memory");
    }
}

DI float dpp_xor1(float v) { return __builtin_bit_cast(float, __builtin_amdgcn_mov_dpp(__builtin_bit_cast(int, v), 0xB1, 0xF, 0xF, true)); }
DI float dpp_xor2(float v) { return __builtin_bit_cast(float, __builtin_amdgcn_mov_dpp(__builtin_bit_cast(int, v), 0x4E, 0xF, 0xF, true)); }
DI float dpp_hmir(float v) { return __builtin_bit_cast(float, __builtin_amdgcn_mov_dpp(__builtin_bit_cast(int, v), 0x141, 0xF, 0xF, true)); }
DI float dot16_fp8(const u32x4 q, const float (&hx)[16]) {
    f32x2 a = {0.f, 0.f};
#pragma unroll
    for (int j = 0; j < 4; ++j) {
        const f32x2 lo = __builtin_amdgcn_cvt_pk_f32_fp8((int)q[j], false), hi = __builtin_amdgcn_cvt_pk_f32_fp8((int)q[j], true);
        a += lo * (f32x2){hx[4 * j], hx[4 * j + 1]}; a += hi * (f32x2){hx[4 * j + 2], hx[4 * j + 3]};
    }
    return a.x + a.y;
}
#define PEER_EXPERT(id, i) ((int)(((id)[(i) >> 3][((i) >> 1) & 3] >> (16 * ((i) & 1))) & 0xffffu))

DI int dpp_xor1i(int v) { return __builtin_amdgcn_mov_dpp(v, 0xB1, 0xF, 0xF, true); }
DI int dpp_xor2i(int v) { return __builtin_amdgcn_mov_dpp(v, 0x4E, 0xF, 0xF, true); }
DI int dpp_hmiri(int v) { return __builtin_amdgcn_mov_dpp(v, 0x141, 0xF, 0xF, true); }
struct PeerURows { u32x4 q[16]; u32x4 h; };
DI void peer_u_rows(PeerURows& R, const u32x4 (&id)[2], const unsigned char* ut, const unsigned char* hrow) {
    R.h = *(const u32x4*)(hrow);
#pragma unroll
    for (int i = 0; i < 16; ++i) R.q[i] = *(const u32x4*)(ut + (size_t)PEER_EXPERT(id, i) * D);
}
DI void peer_u_compute(const PeerURows& R, float* part, int lane) {
    int d[16];
#pragma unroll
    for (int i = 0; i < 16; ++i) { int a = 0;
#pragma unroll
        for (int j = 0; j < 4; ++j) a = __builtin_amdgcn_sdot4((int)R.q[i][j], (int)R.h[j], a, false);
        d[i] = a; }
    const bool b2 = (lane & 4) != 0, b1 = (lane & 2) != 0, b0 = (lane & 1) != 0;
    int k8[8];
#pragma unroll
    for (int i = 0; i < 8; ++i) { const int keep = b2 ? d[8 + i] : d[i], send = b2 ? d[i] : d[8 + i]; k8[i] = keep + dpp_hmiri(send); }
    int k4[4];
#pragma unroll
    for (int i = 0; i < 4; ++i) { const int keep = b1 ? k8[4 + i] : k8[i], send = b1 ? k8[i] : k8[4 + i]; k4[i] = keep + dpp_xor2i(send); }
    f32x2 k2;
    { const int keep0 = b0 ? k4[2] : k4[0], send0 = b0 ? k4[0] : k4[2], keep1 = b0 ? k4[3] : k4[1], send1 = b0 ? k4[1] : k4[3];
      k2.x = (float)(keep0 + dpp_xor1i(send0)); k2.y = (float)(keep1 + dpp_xor1i(send1)); }
    *(f32x2*)(part + 16 * (lane >> 3) + (b2 ? 8 : 0) + (b1 ? 4 : 0) + (b0 ? 2 : 0)) = k2;
}
DI void phase_peer_u(const Params& p, const Frame& F, int l) {
    const int ntok = (l == 0) ? T : TL, lane = F.lane;
    const int slice = F.bid & 7, sw = (F.bid >> 3) * NWAVES + F.wave, nsw = (F.nb >> 3) * NWAVES;
    const unsigned char* ut = p.ws + WS_UTAB + (size_t)l * NEXP * D + 128 * slice + 16 * (lane & 7);
    const unsigned char* Hs = p.ws + WS_H8 + 128 * slice + 16 * (lane & 7);
    const unsigned short* IDXg = (const unsigned short*)(p.ws + WS_IDX) + 16 * (lane >> 3);
    float* PART = (float*)(p.ws + WS_ST) + (size_t)slice * T * 128;
    const int last = ntok - 1;
    u32x4 sa[2], sb[2]; PeerURows ra, rb;
#define U_SEL(S_, t_) do { const unsigned short* ip_ = IDXg + (size_t)min((t_), last) * 128; S_[0] = *(const u32x4*)ip_; S_[1] = *(const u32x4*)(ip_ + 8); } while (0)
#define U_ROWS(R_, S_, t_) peer_u_rows(R_, S_, ut, Hs + (size_t)min((t_), last) * D)
    U_SEL(sa, sw); U_SEL(sb, sw + nsw);
    U_ROWS(ra, sa, sw);
#pragma unroll 1
    for (int tok = sw; tok < ntok; tok += 2 * nsw) {
        U_SEL(sa, tok + 2 * nsw); U_ROWS(rb, sb, tok + nsw);
        peer_u_compute(ra, PART + (size_t)tok * 128, lane);
        U_SEL(sb, tok + 3 * nsw); U_ROWS(ra, sa, tok + 2 * nsw);
        if (tok + nsw < ntok) peer_u_compute(rb, PART + (size_t)(tok + nsw) * 128, lane);
    }
#undef U_SEL
#undef U_ROWS
}
DI void phase_peer_c(const Params& p, const Frame& F, int l, bool dummy = false) {
    const int ntok = (l == 0) ? T : TL;
    const float* PART = (const float*)(p.ws + WS_ST);
    float* GW = (float*)(p.ws + WS_GW);
    float* CO = dummy ? (float*)(p.ws + WS_H8) : GW;
    const float* SU = (const float*)(p.ws + WS_SU);
    const float* HS = (const float*)(p.ws + WS_HS);
    for (int i0 = F.gtid; i0 < ntok * 128; i0 += 4 * F.ngt) {
        float s[4], gw[4], su[4];
#pragma unroll
        for (int u = 0; u < 4; ++u) {
            const int i = min(i0 + u * F.ngt, ntok * 128 - 1);
            s[u] = 0.f;
#pragma unroll
            for (int sl = 0; sl < 8; ++sl) s[u] += PART[(size_t)sl * T * 128 + i];
            gw[u] = GW[i]; su[u] = SU[i] * HS[i >> 7];
        }
#pragma unroll
        for (int u = 0; u < 4; ++u) { const int i = i0 + u * F.ngt; if (i < ntok * 128) CO[i] = gw[u] * gelu_tanh(s[u] * su[u]); }
    }
}
struct PeerVRows { u32x4 q[16]; f32x4 cf[4]; f32x2 xv, gv; };
DI void peer_v_rows(PeerVRows& R, const u32x4 (&id)[2], const unsigned char* vt, const float* cp, const float* xs, const float* gt2) {
    R.cf[0] = *(const f32x4*)cp; R.cf[1] = *(const f32x4*)(cp + 4); R.cf[2] = *(const f32x4*)(cp + 8); R.cf[3] = *(const f32x4*)(cp + 12);
    R.xv = *(const f32x2*)xs; R.gv = *(const f32x2*)gt2;
#pragma unroll
    for (int i = 0; i < 16; ++i) R.q[i] = *(const u32x4*)(vt + (size_t)PEER_EXPERT(id, i) * D);
}
DI float xchg32(float v, bool hi) { const auto r = __builtin_amdgcn_permlane32_swap(__builtin_bit_cast(unsigned, v), __builtin_bit_cast(unsigned, v), false, false);
    return __builtin_bit_cast(float, hi ? r[0] : r[1]); }
DI float xchg16(float v, bool hi) { const auto r = __builtin_amdgcn_permlane16_swap(__builtin_bit_cast(unsigned, v), __builtin_bit_cast(unsigned, v), false, false);
    return __builtin_bit_cast(float, hi ? r[0] : r[1]); }
DI float xchg8(float v) { return __builtin_bit_cast(float, __builtin_amdgcn_mov_dpp(__builtin_bit_cast(int, v), 0x128, 0xF, 0xF, true)); }
DI void peer_v_compute(const PeerVRows& R, float* xdst, int lane) {
    f32x2 a[8];
#pragma unroll
    for (int j = 0; j < 8; ++j) a[j] = (f32x2){0.f, 0.f};
#pragma unroll
    for (int i = 0; i < 16; ++i) {
        const float c = R.cf[i >> 2][i & 3]; const f32x2 c2 = {c, c};
#pragma unroll
        for (int j = 0; j < 4; ++j) {
            a[2 * j] += c2 * __builtin_amdgcn_cvt_pk_f32_fp8((int)R.q[i][j], false);
            a[2 * j + 1] += c2 * __builtin_amdgcn_cvt_pk_f32_fp8((int)R.q[i][j], true);
        }
    }
    const bool b5 = (lane & 32) != 0, b4 = (lane & 16) != 0, b3 = (lane & 8) != 0;
    f32x2 k4[4];
#pragma unroll
    for (int j = 0; j < 4; ++j) { const f32x2 keep = b5 ? a[4 + j] : a[j], send = b5 ? a[j] : a[4 + j];
        k4[j] = keep + (f32x2){xchg32(send.x, b5), xchg32(send.y, b5)}; }
    f32x2 k2[2];
#pragma unroll
    for (int j = 0; j < 2; ++j) { const f32x2 keep = b4 ? k4[2 + j] : k4[j], send = b4 ? k4[j] : k4[2 + j];
        k2[j] = keep + (f32x2){xchg16(send.x, b4), xchg16(send.y, b4)}; }
    f32x2 k1;
    { const f32x2 keep = b3 ? k2[1] : k2[0], send = b3 ? k2[0] : k2[1];
        k1 = keep + (f32x2){xchg8(send.x), xchg8(send.y)}; }
    *(f32x2*)xdst = R.xv + R.gv * k1;
}
DI void phase_peer_v(const Params& p, const Frame& F, int l, bool dummy = false) {
    const int ntok = (l == 0) ? T : TL, lane = F.lane;
    const int slice = F.bid & 7, sw = (F.bid >> 3) * NWAVES + F.wave, nsw = (F.nb >> 3) * NWAVES;
    const unsigned char* vt = p.ws + WS_VTAB + (size_t)l * NEXP * D + 128 * slice + 16 * (lane & 7);
    const unsigned short* IDXg = (const unsigned short*)(p.ws + WS_IDX) + 16 * (lane >> 3);
    const float* CFg = (const float*)(p.ws + WS_GW) + 16 * (lane >> 3);
    const int last = ntok - 1;
    u32x4 sa[2], sb[2]; PeerVRows ra, rb;
#define V_SEL(S_, t_) do { const unsigned short* ip_ = IDXg + (size_t)min((t_), last) * 128; S_[0] = *(const u32x4*)ip_; S_[1] = *(const u32x4*)(ip_ + 8); } while (0)
    const int co = 128 * slice + 16 * (lane & 7) + ((lane & 32) ? 8 : 0) + ((lane & 16) ? 4 : 0) + ((lane & 8) ? 2 : 0);
#define V_ROWS(R_, S_, t_) do { const int t1_ = min((t_), last); peer_v_rows(R_, S_, vt, CFg + (size_t)t1_ * 128, xrow_ptr(p, t1_) + co, mod_vec(p, l, t1_, 5) + co); } while (0)
#define V_DO(R_, t_) do { const int t2_ = (t_); float* xd_ = (dummy ? (float*)(p.ws + WS_ST) + (size_t)t2_ * D : xrow_ptr(p, t2_)) + co; peer_v_compute(R_, xd_, lane); } while (0)
    V_SEL(sa, sw); V_SEL(sb, sw + nsw);
    V_ROWS(ra, sa, sw);
#pragma unroll 1
    for (int tok = sw; tok < ntok; tok += 2 * nsw) {
        V_SEL(sa, tok + 2 * nsw); V_ROWS(rb, sb, tok + nsw);
        V_DO(ra, tok);
        V_SEL(sb, tok + 3 * nsw); V_ROWS(ra, sa, tok + 2 * nsw);
        if (tok + nsw < ntok) V_DO(rb, tok + nsw);
    }
#undef V_SEL
#undef V_ROWS
#undef V_DO
}

#define XB_TMO      128
#define XB_XCNT(j)  (256  + 64 * (j))
#define XB_XSUB(j)  (1280 + 64 * (j))
#define XB_XGEN(j)  (2304 + 64 * (j))
#define XB_TOP      3328
#define XB_TOPGEN   3392
#define XCD_BAR_WORDS 3456
#define XB_SPIN_CAP (1u << 18)
DI unsigned xb_ld(unsigned* p)              { return __hip_atomic_load(p, __ATOMIC_RELAXED, __HIP_MEMORY_SCOPE_AGENT); }
DI unsigned xb_add(unsigned* p, unsigned v) { return __hip_atomic_fetch_add(p, v, __ATOMIC_RELAXED, __HIP_MEMORY_SCOPE_AGENT); }
DI unsigned xb_xcc_id() { return (unsigned)__builtin_amdgcn_s_getreg((3 << 11) | 20) & 0xFu; }
#define XB_SPIN(cond, bar) do { unsigned _sp = 0; while (cond) { __builtin_amdgcn_s_sleep(1); \
    if ((++_sp & 255u) == 0u) { if (xb_ld(&(bar)[XB_TMO])) break; if (_sp > XB_SPIN_CAP) { atomicAdd(&(bar)[XB_TMO], 1u); break; } } } } while (0)
struct XcdBarrier { unsigned* bar; unsigned x; volatile LAS unsigned* st; };
DI XcdBarrier xcd_barrier_post(unsigned* bar, volatile LAS unsigned* st) {
    XcdBarrier b; b.bar = bar; b.x = xb_xcc_id(); b.st = st;
    if (threadIdx.x == 0) (void)xb_add(&bar[XB_XCNT(b.x)], 1u);
    return b;
}
DI void xcd_barrier_complete(unsigned* bar, unsigned x, unsigned& nloc, unsigned& nx) {
    const unsigned G = gridDim.x * gridDim.y * gridDim.z;
    unsigned sum, cnt, mine, sp = 0u;
    for (;;) {
        sum = 0u; cnt = 0u; mine = 0u;
#pragma unroll
        for (unsigned j = 0; j < 16; ++j) { const unsigned c = xb_ld(&bar[XB_XCNT(j)]); sum += c; cnt += (c > 0u) ? 1u : 0u; mine = (j == x) ? c : mine; }
        if (sum == G) break;
        __builtin_amdgcn_s_sleep(1);
        if ((++sp & 255u) == 0u) { if (xb_ld(&bar[XB_TMO])) break; if (sp > XB_SPIN_CAP) { atomicAdd(&bar[XB_TMO], 1u); break; } }
    }
    nloc = mine > 0u ? mine : 1u; nx = cnt > 0u ? cnt : 1u;
}
DI void xcd_barrier(const XcdBarrier& b) {
    asm volatile("s_waitcnt vmcnt(0)" ::: "memory");
    __syncthreads();
    if (threadIdx.x == 0) {
        unsigned* bar = b.bar;
        __builtin_amdgcn_s_waitcnt(0);
        unsigned nloc = b.st[0], nx = b.st[1];
        if (nloc == 0u) { xcd_barrier_complete(bar, b.x, nloc, nx); b.st[0] = nloc; b.st[1] = nx; }
        const unsigned old = xb_add(&bar[XB_XSUB(b.x)], 1u);
        const unsigned gen = old / nloc;
        if (old + 1u == (gen + 1u) * nloc) {
            __builtin_amdgcn_fence(__ATOMIC_RELEASE, "agent");
            asm volatile("s_waitcnt vmcnt(0)" ::: "memory");
            const unsigned og = xb_add(&bar[XB_TOP], 1u);
            const unsigned tg = og / nx;
            if (og + 1u == (tg + 1u) * nx) xb_add(&bar[XB_TOPGEN], 1u);
            else XB_SPIN(xb_ld(&bar[XB_TOPGEN]) == tg, bar);
            __builtin_amdgcn_fence(__ATOMIC_ACQUIRE, "agent");
            xb_add(&bar[XB_XGEN(b.x)], 1u);
            asm volatile("s_waitcnt vmcnt(0)" ::: "memory");
        } else {
            XB_SPIN(xb_ld(&bar[XB_XGEN(b.x)]) == gen, bar);
            __builtin_amdgcn_fence(__ATOMIC_ACQUIRE, "agent");
            asm volatile("s_waitcnt vmcnt(0)" ::: "memory");
        }
    }
    __syncthreads();
}

constexpr int NPHASE = 25;
template <int PH> DI void run_phase(const Params& p, const Frame& F) {
    if constexpr (PH == 0) phase_prep(p, F);
    else if constexpr (PH == 1) phase_norm(p, F, 0, 0, true, T);
    else if constexpr (PH == 2) phase_g1(p, F, 0);
    else if constexpr (PH == 3) phase_mix(p, F, 0);
    else if constexpr (PH == 4) phase_g2(p, F, 0);
    else if constexpr (PH == 5) phase_g2sum(p, F);
    else if constexpr (PH == 6) phase_g3(p, F, 0);
    else if constexpr (PH == 7) phase_norm(p, F, 0, 1, false, T);
    else if constexpr (PH == 8) phase_g45(p, F, 0);
    else if constexpr (PH == 9) phase_sel(p, F, 0);
    else if constexpr (PH == 10) phase_peer_u(p, F, 0);
    else if constexpr (PH == 11) phase_peer_c(p, F, 0);
    else if constexpr (PH == 12) phase_peer_v(p, F, 0);
    else if constexpr (PH == 13) phase_norm(p, F, 1, 0, false, T);
    else if constexpr (PH == 14) phase_g1(p, F, 1);
    else if constexpr (PH == 15) phase_mix(p, F, 1);
    else if constexpr (PH == 16) phase_g2(p, F, 1);
    else if constexpr (PH == 17) phase_g3(p, F, 1);
    else if constexpr (PH == 18) phase_norm(p, F, 1, 1, false, TL);
    else if constexpr (PH == 19) phase_g45(p, F, 1);
    else if constexpr (PH == 20) phase_sel(p, F, 1);
    else if constexpr (PH == 21) phase_peer_u(p, F, 1);
    else if constexpr (PH == 22) phase_peer_c(p, F, 1);
    else if constexpr (PH == 23) phase_peer_v(p, F, 1);
    else if constexpr (PH == 24) phase_final(p, F);
}
DI Frame make_frame(unsigned char* lds_raw) {
    Frame F;
    F.lds = (LAS unsigned char*)lds_raw;
    int tid = threadIdx.x; asm volatile("" : "+v"(tid));
    int bid = blockIdx.x, nb = gridDim.x; asm volatile("" : "+s"(bid), "+s"(nb));
    F.tid = tid; F.lane = tid & 63; F.wave = __builtin_amdgcn_readfirstlane(tid >> 6); F.bid = bid; F.nb = nb;
    F.gw = bid * NWAVES + F.wave; F.ngw = nb * NWAVES; F.gtid = bid * NTHREADS + tid; F.ngt = nb * NTHREADS;
    return F;
}
template <int PH> DI void run_phase_fresh(unsigned char* lds_raw) {
#if defined(__HIP_DEVICE_COMPILE__)
    const __attribute__((address_space(4))) unsigned long long* pp = (const __attribute__((address_space(4))) unsigned long long*)__builtin_amdgcn_kernarg_segment_ptr();
    asm volatile("" : "+s"(pp));
    Params p;
#pragma unroll
    for (int i = 0; i < N_IN; ++i) p.in[i] = (const float*)(const __attribute__((address_space(1))) float*)pp[i];
    p.out = (float*)(__attribute__((address_space(1))) float*)pp[N_IN]; p.ws = (unsigned char*)(__attribute__((address_space(1))) unsigned char*)pp[N_IN + 1]; p.ph_lo = 0; p.ph_hi = 0;
#else
    Params p{};
#endif
    const Frame F = make_frame(lds_raw);
    run_phase<PH>(p, F);
}
template <int PH> __global__ void __launch_bounds__(NTHREADS, 2) phase_kernel(Params p) {
    extern __shared__ __attribute__((aligned(16))) unsigned char lds_raw[];
    run_phase_fresh<PH>(lds_raw);
}
template <int PH> DI void run_all(unsigned char* lds_raw, cg::grid_group& grid, const XcdBarrier& bar) {
    if constexpr (PH < NPHASE) {
        if constexpr (PH == PROBE_PH) {
            if constexpr (PH == 11 || PH == 22 || PH == 12 || PH == 23) {
#if defined(__HIP_DEVICE_COMPILE__)
                const __attribute__((address_space(4))) unsigned long long* pp = (const __attribute__((address_space(4))) unsigned long long*)__builtin_amdgcn_kernarg_segment_ptr();
                asm volatile("" : "+s"(pp));
                Params p;
#pragma unroll
                for (int i = 0; i < N_IN; ++i) p.in[i] = (const float*)(const __attribute__((address_space(1))) float*)pp[i];
                p.out = (float*)(__attribute__((address_space(1))) float*)pp[N_IN]; p.ws = (unsigned char*)(__attribute__((address_space(1))) unsigned char*)pp[N_IN + 1]; p.ph_lo = 0; p.ph_hi = 0;
                const Frame F = make_frame(lds_raw);
                if constexpr (PH == 11 || PH == 22) phase_peer_c(p, F, PH == 11 ? 0 : 1, true); else phase_peer_v(p, F, PH == 12 ? 0 : 1, true);
#endif
            } else run_phase_fresh<PH>(lds_raw);
            xcd_barrier(bar);
        }
        run_phase_fresh<PH>(lds_raw);
        if constexpr (PH + 1 < NPHASE) { xcd_barrier(bar); if constexpr (PROBE_SYNC) xcd_barrier(bar); }
        run_all<PH + 1>(lds_raw, grid, bar);
    }
}
__global__ void __launch_bounds__(NTHREADS, 2) mega(Params p) {
    extern __shared__ __attribute__((aligned(16))) unsigned char lds_raw[];
    cg::grid_group grid = cg::this_grid();
    volatile LAS unsigned* st = (volatile LAS unsigned*)((LAS unsigned char*)lds_raw + LDS_BAR_OFF);
    if (threadIdx.x < 2) st[threadIdx.x] = 0u;
    __syncthreads();
    const XcdBarrier bar = xcd_barrier_post((unsigned*)(p.ws + WS_CTL), st);
    if (p.ph_lo != 0) grid.sync();
    run_all<0>(lds_raw, grid, bar);
}

extern "C" void kernel_launch(void* const* d_in, const int* in_sizes, int n_in, void* d_out, int out_size, void* d_ws, size_t ws_size, hipStream_t stream) {
    static int grid = 0;
    if (grid == 0) {
        if (n_in != 23 || out_size != TL * D || ws_size < WS_END) { fprintf(stderr, "kernel_launch: unexpected shapes (n_in %d out %d ws %zu)\n", n_in, out_size, ws_size); grid = -1; return; }
        int dev = 0, cus = 0, per_cu = 0;
        (void)hipGetDevice(&dev);
        (void)hipDeviceGetAttribute(&cus, hipDeviceAttributeMultiprocessorCount, dev);
        (void)hipFuncSetAttribute((const void*)mega, hipFuncAttributeMaxDynamicSharedMemorySize, LDS_BYTES);
        (void)hipOccupancyMaxActiveBlocksPerMultiprocessor(&per_cu, (const void*)mega, NTHREADS, LDS_BYTES);
        if (per_cu < 1) { fprintf(stderr, "kernel_launch: occupancy query reports %d blocks per CU\n", per_cu); grid = -1; return; }
        grid = cus & ~7;
        if (grid < 8) { fprintf(stderr, "kernel_launch: needs at least 8 CUs\n"); grid = -1; return; }
    }
    if (grid < 0) return;
    (void)hipMemsetAsync((char*)d_ws + WS_CTL, 0, CTL_ZERO_BYTES, stream);
    Params p{};
    for (int i = 0; i < N_IN; ++i) p.in[i] = (const float*)d_in[i];
    p.out = (float*)d_out; p.ws = (unsigned char*)d_ws;
    void* args[] = {&p};
    hipError_t e = hipLaunchCooperativeKernel((const void*)mega, dim3(grid), dim3(NTHREADS), args, LDS_BYTES, stream);
    if (e != hipSuccess) fprintf(stderr, "cooperative launch failed: %s (grid %d)\n", hipGetErrorString(e), grid);
}
```

```cpp
#include <hip/hip_runtime.h>
#include <hip/hip_cooperative_groups.h>
#include <stdint.h>
#include <stdio.h>
namespace cg = cooperative_groups;

#ifndef PROBE_PH
#define PROBE_PH -1
#endif
#ifndef PROBE_SYNC
#define PROBE_SYNC 0
#endif
#ifndef MK_SINGLE
#define MK_SINGLE 0
#endif

#define LAS __attribute__((address_space(3)))
typedef unsigned short bf16_t;
typedef short bf16x8 __attribute__((ext_vector_type(8)));
typedef short s16x4 __attribute__((ext_vector_type(4)));
typedef float f32x4 __attribute__((ext_vector_type(4)));
typedef float f32x2 __attribute__((ext_vector_type(2)));
typedef float f32x16 __attribute__((ext_vector_type(16)));
typedef unsigned u32x4 __attribute__((ext_vector_type(4)));
typedef unsigned u32x2 __attribute__((ext_vector_type(2)));
typedef __bf16 bf16x2_t __attribute__((ext_vector_type(2)));
typedef _Float16 f16x2_t __attribute__((ext_vector_type(2)));
#define DI __device__ __forceinline__
DI unsigned pkh2(float lo, float hi) { f16x2_t v = {(_Float16)lo, (_Float16)hi}; return __builtin_bit_cast(unsigned, v); }
#define MFMA32(a, b, c) __builtin_amdgcn_mfma_f32_32x32x16_bf16((a), (b), (c), 0, 0, 0)

constexpr int D = 1024, NB = 8, SEQ = 4096, NCTX = 256, DEPTH = 2;
constexpr int TL = NB * SEQ, TC = NB * NCTX, T = TL + TC;
constexpr int INW = 4608, NMOD = 6 * D, PW = 1600, PN = 1536;
constexpr int VTS = SEQ + 64;
constexpr int QOFF = 0, KOFF = 512, VOFF = 640, POOLOFF = 768, SUOFF = 1024, SVOFF = 1280, GATEOFF = 1536;
constexpr int NEXP = 16384;
constexpr float EPS = 1e-6f;
constexpr float LOG2E = 1.4426950408889634f;
constexpr float QSCALE = 0.125f * LOG2E;

constexpr size_t MiB = 1u << 20;
constexpr size_t WS_CTL = 0, WS_MOD = 1 * MiB, CTL_ZERO_BYTES = 2 * MiB;
constexpr size_t WS_ROPE = 2 * MiB, WS_SGUW = 2 * MiB + 65536, WS_TSCALE = 3 * MiB;
constexpr size_t WS_WIN = 4 * MiB, WS_WBR = 22 * MiB, WS_WOUT = 26 * MiB, WS_WFOLD = 30 * MiB;
constexpr size_t WS_XCTX = 38 * MiB, WS_UTAB = 46 * MiB, WS_VTAB = 78 * MiB;
constexpr size_t WS_IDX = 110 * MiB, WS_GW = 120 * MiB;
constexpr size_t WS_H = 142 * MiB;
constexpr size_t WS_P = 210 * MiB, WS_Y = 318 * MiB, WS_MERGED = 386 * MiB, WS_VT = 454 * MiB, WS_VTC = 463 * MiB, WS_VST = 464 * MiB;
constexpr size_t WS_MP = 482 * MiB;
constexpr size_t WS_ST = 210 * MiB, WS_H8 = 346 * MiB, WS_HS = 380 * MiB, WS_SU = 482 * MiB;
constexpr size_t WS_END = 512 * MiB;
static_assert(WS_ST + (size_t)2048 * T * 2 <= WS_H8 && WS_H8 + (size_t)T * D <= WS_HS, "ST / H8 fit");
static_assert(WS_VST + (size_t)272 * 256 * 128 * 2 <= WS_SU && WS_VT + (size_t)NB * 2 * 64 * VTS * 2 <= WS_VTC, "VsT / VT fit");
static_assert(WS_H + (size_t)T * D * 2 <= WS_P, "H fits");
static_assert(WS_P + (size_t)T * PW * 2 <= WS_Y && WS_Y + (size_t)T * D * 2 <= WS_MERGED && WS_MERGED + (size_t)T * D * 2 <= WS_VT, "P/Y/MERGED fit");
static_assert(WS_IDX + (size_t)T * 128 * 2 <= WS_GW && WS_GW + (size_t)T * 128 * 4 <= WS_H && WS_SU + (size_t)T * 128 * 4 <= WS_END && WS_HS + (size_t)T * 4 <= WS_SU, "idx/gw/su fit");

constexpr int LDS_BYTES = 163840;
constexpr int LDS_BAR_OFF = LDS_BYTES - 64;
constexpr int NTHREADS = 512, NWAVES = 8;

enum { I_x, I_c, I_ctx, I_c_ctx, I_w_mod, I_b_mod, I_g_mix, I_g_ffn, I_w_in, I_attn_sink, I_pool_w, I_pool_scale, I_sgu_w, I_sgu_b, I_w_br_attn, I_w_br_pool, I_w_br_sgu, I_w_out, I_peer_wq, I_peer_subkeys, I_peer_u, I_peer_v, I_g_final, N_IN };
struct Params {
    const float* in[N_IN];
    float* out; unsigned char* ws;
    int ph_lo, ph_hi;
};

DI unsigned pk2(float lo, float hi) { f32x2 v = {lo, hi}; return __builtin_bit_cast(unsigned, __builtin_convertvector(v, bf16x2_t)); }
DI unsigned f2bf(float f) { return pk2(f, 0.f) & 0xffffu; }
DI float bf2f(unsigned short u) { return __builtin_bit_cast(float, (unsigned)u << 16); }
DI float bflo(unsigned w) { return __builtin_bit_cast(float, w << 16); }
DI float bfhi(unsigned w) { return __builtin_bit_cast(float, w & 0xffff0000u); }
DI int crow(int reg, int h) { return (reg & 3) + 8 * (reg >> 2) + 4 * h; }
DI float wave_sum(float v) {
#pragma unroll
    for (int o = 1; o < 64; o <<= 1) v += __shfl_xor(v, o);
    return v;
}
DI float sigmoidf_(float x) { return __builtin_amdgcn_rcpf(1.0f + __expf(-x)); }
DI float gelu_tanh(float x) { const float u = 0.7978845608028654f * (x + 0.044715f * x * x * x); return x * __builtin_amdgcn_rcpf(1.0f + __expf(-2.0f * u)); }
DI float silu_(float x) { return x * __builtin_amdgcn_rcpf(1.0f + __expf(-x)); }

struct Frame {
    int tid, lane, wave, gw, ngw, gtid, ngt, bid, nb;
    LAS unsigned char* lds;
};

template <int NM, int NN>
DI void wave_gemm(const bf16_t* __restrict__ A, int lda, const bf16_t* __restrict__ Bt, int ldb, int K, int m0, int n0, f32x16 (&acc)[NM][NN], int lane) {
    const int r = lane & 31, h = lane >> 5;
    const bf16_t* ap = A + (size_t)(m0 + r) * lda + 8 * h;
    const bf16_t* bp = Bt + (size_t)(n0 + r) * ldb + 8 * h;
    for (int k0 = 0; k0 < K; k0 += 64) {
        bf16x8 a[4][NM], b[4][NN];
#pragma unroll
        for (int s = 0; s < 4; ++s) {
#pragma unroll
            for (int i = 0; i < NM; ++i) a[s][i] = *(const bf16x8*)(ap + (size_t)(32 * i) * lda + k0 + 16 * s);
#pragma unroll
            for (int j = 0; j < NN; ++j) b[s][j] = *(const bf16x8*)(bp + (size_t)(32 * j) * ldb + k0 + 16 * s);
        }
#pragma unroll
        for (int s = 0; s < 4; ++s)
#pragma unroll
            for (int i = 0; i < NM; ++i)
#pragma unroll
                for (int j = 0; j < NN; ++j) acc[i][j] = MFMA32(a[s][i], b[s][j], acc[i][j]);
    }
}
template <int NM, int NN> DI void zero_acc(f32x16 (&acc)[NM][NN]) {
#pragma unroll
    for (int i = 0; i < NM; ++i)
#pragma unroll
        for (int j = 0; j < NN; ++j)
#pragma unroll
            for (int r = 0; r < 16; ++r) acc[i][j][r] = 0.f;
}

namespace pg8 {
constexpr int BM = 256, BK = 64, HALF = 128, HTB = HALF * BK * 2, STAGE_BYTES = 8 * HTB, NXCD = 8, WGM = 8, LD = 1024;
DI int lds_byte(int r, int c) { const int st = (r >> 4) * 2 + (c >> 5), rr = r & 15, cc = c & 31, ob = rr * 64 + cc * 2; return st * 1024 + (ob ^ (((ob >> 9) & 1) << 5)); }
DI void stage_rc(int b, int& R, int& C) { const int st = b / 1024, sb = b % 1024, swz = sb ^ (((sb >> 9) & 1) << 5); R = (st >> 1) * 16 + swz / 64; C = (st & 1) * 32 + (swz % 64) / 2; }
DI int perm32(int rho) { const int n = rho >> 4, i = rho & 15; return 8 * (i >> 2) + 4 * n + (i & 3); }
struct Unit { int pm, pn, sub, nt, mode; const char* a; const char* b; };
DI void tile_of(int L, int nM, int nN, int& pm, int& pn) {
    const int nwg = nM * nN; int wgid = L;
    { const int q = nwg / NXCD, r = nwg % NXCD, xcd = wgid % NXCD, off = wgid / NXCD; wgid = (xcd < r ? xcd * (q + 1) : r * (q + 1) + (xcd - r) * q) + off; }
    const int nig = WGM * nN, gid = wgid / nig, fm = gid * WGM, gsz = (nM - fm) < WGM ? (nM - fm) : WGM;
    pm = fm + ((wgid % nig) % gsz); pn = (wgid % nig) / gsz;
}
template <class Epi, class Sched>
DI void gemm_phase(LAS unsigned char* lds, const int tid, const Sched& S, const Epi& E) {
    const int wid = __builtin_amdgcn_readfirstlane(tid >> 6), lane = tid & 63, wr = wid >> 2, wc = wid & 3, fr = lane & 15, fq = lane >> 4;
    unsigned voffA[2], voffB[2];
#pragma unroll
    for (int i = 0; i < 2; ++i) { int R, C; stage_rc(tid * 16 + i * 8192, R, C); const int Rb = Epi::PERM ? ((R & ~31) + perm32(R & 31)) : R;
        voffA[i] = (unsigned)(R * LD + C) * 2u; voffB[i] = (unsigned)(Rb * LD + C) * 2u; }
    const size_t kstep = (size_t)(BK * 2);
    const size_t hstep = (size_t)HALF * LD * 2;
    const unsigned ldsw = (unsigned)wid * 1024u;
    const int aoff = lds_byte(wr * 64 + fr, fq * 8), boff = lds_byte(wc * 32 + fr, fq * 8);
#define PG8_SA(b, h) (((b) * 2 + (h)) * HTB)
#define PG8_SB(b, h) ((4 + (b) * 2 + (h)) * HTB)
#define PG8_STAGE(bufoff, gbase, voff) do { _Pragma("unroll") for (int _i = 0; _i < 2; ++_i) \
        __builtin_amdgcn_global_load_lds((const unsigned*)((const char*)(gbase) + (voff)[_i]), (LAS unsigned*)(lds + (bufoff) + ldsw + _i * 8192), 16, 0, 0); } while (0)
#define PG8_LDA(dst, b, h) do { _Pragma("unroll") for (int m = 0; m < 4; ++m) _Pragma("unroll") for (int k = 0; k < 2; ++k) dst[m][k] = *(const LAS bf16x8*)(lds + PG8_SA(b, h) + aoff + m * 2048 + k * 1024); } while (0)
#define PG8_LDB(dst, b, h) do { _Pragma("unroll") for (int n = 0; n < 2; ++n) _Pragma("unroll") for (int k = 0; k < 2; ++k) dst[n][k] = *(const LAS bf16x8*)(lds + PG8_SB(b, h) + boff + n * 2048 + k * 1024); } while (0)
#define PG8_MMA(ai, bj, At, Bt) do { __builtin_amdgcn_s_setprio(1); _Pragma("unroll") for (int m = 0; m < 4; ++m) _Pragma("unroll") for (int n = 0; n < 2; ++n) _Pragma("unroll") for (int k = 0; k < 2; ++k) \
        acc[ai][bj][m][n] = __builtin_amdgcn_mfma_f32_16x16x32_bf16(Bt[n][k], At[m][k], acc[ai][bj][m][n], 0, 0, 0); __builtin_amdgcn_s_setprio(0); } while (0)
#define PG8_WAIT_V(n) asm volatile("s_waitcnt vmcnt(" #n ")" ::: "memory")
#define PG8_WAIT_L(n) asm volatile("s_waitcnt lgkmcnt(" #n ")" ::: "memory")
#define PG8_BAR __builtin_amdgcn_s_barrier()
#define PG8_SCHED __builtin_amdgcn_sched_barrier(0)
    Unit cur, nxt; int ui = 0;
    if (!S.next(0, cur)) return;
    f32x4 acc[2][2][4][2];
#pragma unroll
    for (int a = 0; a < 2; ++a)
#pragma unroll
        for (int b = 0; b < 2; ++b)
#pragma unroll
            for (int m = 0; m < 4; ++m)
#pragma unroll
                for (int n = 0; n < 2; ++n) acc[a][b][m][n] = (f32x4){0.f, 0.f, 0.f, 0.f};
    bf16x8 At[4][2], B0[2][2], B1[2][2];
    const char* cA = cur.a; const char* cB = cur.b;
    PG8_STAGE(PG8_SB(0, 0), cB, voffB); PG8_STAGE(PG8_SB(0, 1), cB + hstep, voffB); PG8_STAGE(PG8_SA(0, 0), cA, voffA); PG8_STAGE(PG8_SA(0, 1), cA + hstep, voffA);
    if (wr == 1) PG8_BAR;
    PG8_WAIT_V(2); PG8_BAR;
    PG8_STAGE(PG8_SB(1, 0), cB + kstep, voffB); PG8_STAGE(PG8_SA(1, 0), cA + kstep, voffA); PG8_STAGE(PG8_SB(1, 1), cB + hstep + kstep, voffB);
    PG8_WAIT_V(6); PG8_BAR;
    for (;;) {
        const bool has_next = S.next(ui + 1, nxt);
        const char* nA = has_next ? nxt.a : cA; const char* nB = has_next ? nxt.b : cB;
        const int nt = cur.nt;
        for (int t = 0; t < nt; t += 2) {
            const bool last = (t == nt - 2);
            const char* a1 = cA + (size_t)(t + 1) * kstep;
            const char* a2 = last ? nA : cA + (size_t)(t + 2) * kstep; const char* b2 = last ? nB : cB + (size_t)(t + 2) * kstep;
            const char* a3 = a2 + kstep; const char* b3 = b2 + kstep;
            PG8_LDB(B0, 0, 0); PG8_LDB(B1, 0, 1); PG8_SCHED; PG8_LDA(At, 0, 0); PG8_STAGE(PG8_SA(1, 1), a1 + hstep, voffA);
            PG8_WAIT_V(8); PG8_WAIT_L(0); PG8_BAR; PG8_MMA(0, 0, At, B0); PG8_MMA(0, 1, At, B1); PG8_BAR; PG8_SCHED;
            PG8_LDA(At, 0, 1); PG8_STAGE(PG8_SB(0, 0), b2, voffB); PG8_STAGE(PG8_SB(0, 1), b2 + hstep, voffB); PG8_STAGE(PG8_SA(0, 0), a2, voffA);
            PG8_WAIT_V(8); PG8_WAIT_L(0); PG8_BAR; PG8_MMA(1, 0, At, B0); PG8_MMA(1, 1, At, B1); PG8_BAR; PG8_SCHED;
            PG8_LDB(B0, 1, 0); PG8_LDB(B1, 1, 1); PG8_SCHED; PG8_LDA(At, 1, 0); PG8_STAGE(PG8_SA(0, 1), a2 + hstep, voffA);
            PG8_WAIT_V(8); PG8_WAIT_L(0); PG8_BAR; PG8_MMA(0, 0, At, B0); PG8_MMA(0, 1, At, B1); PG8_BAR; PG8_SCHED;
            PG8_LDA(At, 1, 1); PG8_STAGE(PG8_SB(1, 0), b3, voffB); PG8_STAGE(PG8_SB(1, 1), b3 + hstep, voffB); PG8_STAGE(PG8_SA(1, 0), a3, voffA);
            PG8_WAIT_V(8); PG8_WAIT_L(0); PG8_BAR; PG8_MMA(1, 0, At, B0); PG8_MMA(1, 1, At, B1); PG8_BAR; PG8_SCHED;
        }
        if (wr == 0) PG8_BAR;
        E(acc, cur, wr, wc, fr, fq);
        if (!has_next) break;
        if (!E.keeps(cur)) {
#pragma unroll
        for (int a = 0; a < 2; ++a)
#pragma unroll
            for (int b = 0; b < 2; ++b)
#pragma unroll
                for (int m = 0; m < 4; ++m)
#pragma unroll
                    for (int n = 0; n < 2; ++n) acc[a][b][m][n] = (f32x4){0.f, 0.f, 0.f, 0.f};
        }
        cur = nxt; cA = nA; cB = nB; ++ui;
        if (wr == 1) PG8_BAR;
    }
    PG8_WAIT_V(0);
    PG8_BAR;
#undef PG8_SA
#undef PG8_SB
#undef PG8_STAGE
#undef PG8_LDA
#undef PG8_LDB
#undef PG8_MMA
#undef PG8_WAIT_V
#undef PG8_WAIT_L
#undef PG8_BAR
#undef PG8_SCHED
}
}

DI void transpose_item(const float* W, int K, int N, bf16_t* WT, int ldd, int row_off, int col_off, LAS float* scr, int item, int lane) {
    const int nblk = N / 32, kb = item / nblk, nb = item % nblk, k0 = 64 * kb, n0 = 32 * nb;
#pragma unroll 8
    for (int i = 0; i < 32; ++i) { const int kk = 2 * i + (lane >> 5); scr[kk * 33 + (lane & 31)] = W[(size_t)(k0 + kk) * N + n0 + (lane & 31)]; }
    asm volatile("s_waitcnt lgkmcnt(0)" ::: "memory");
    const int c = lane & 7;
#pragma unroll
    for (int j = 0; j < 4; ++j) { const int n = (lane >> 3) + 8 * j; const LAS float* s = scr + (8 * c) * 33 + n;
        u32x4 o; o.x = pk2(s[0 * 33], s[1 * 33]); o.y = pk2(s[2 * 33], s[3 * 33]); o.z = pk2(s[4 * 33], s[5 * 33]); o.w = pk2(s[6 * 33], s[7 * 33]);
        *(u32x4*)(WT + (size_t)(row_off + n0 + n) * ldd + col_off + k0 + 8 * c) = o; }
    asm volatile("s_waitcnt lgkmcnt(0)" ::: "memory");
}

DI void convert_tables(const Params& p, const Frame& F) {
    for (int it0 = 4 * F.gw; it0 < 4 * NEXP; it0 += 4 * F.ngw) {
        f32x4 v[4][4];
#pragma unroll
        for (int u = 0; u < 4; ++u) {
            const int it = it0 + u, e = it & (NEXP - 1), tbl = (it >> 14) & 1, l = it >> 15;
            const f32x4* src = (const f32x4*)((tbl ? p.in[I_peer_v] : p.in[I_peer_u]) + ((size_t)l * NEXP + e) * D) + 4 * F.lane;
#pragma unroll
            for (int j = 0; j < 4; ++j) v[u][j] = src[j];
        }
#pragma unroll
        for (int u = 0; u < 4; ++u) {
            const int it = it0 + u, e = it & (NEXP - 1), tbl = (it >> 14) & 1, l = it >> 15;
            float am = 0.f;
#pragma unroll
            for (int j = 0; j < 4; ++j) am = fmaxf(am, fmaxf(fmaxf(fabsf(v[u][j].x), fabsf(v[u][j].y)), fmaxf(fabsf(v[u][j].z), fabsf(v[u][j].w))));
#pragma unroll
            for (int o = 1; o < 64; o <<= 1) am = fmaxf(am, __shfl_xor(am, o));
            const float sc = (am > 0.f) ? (tbl ? exp2f(floorf(log2f(224.0f / am))) : 127.0f / am) : 1.0f;
            u32x4 q;
            if (tbl) {
#pragma unroll
                for (int j = 0; j < 4; ++j) { int w = 0; w = __builtin_amdgcn_cvt_pk_fp8_f32(v[u][j].x * sc, v[u][j].y * sc, w, false); w = __builtin_amdgcn_cvt_pk_fp8_f32(v[u][j].z * sc, v[u][j].w * sc, w, true); q[j] = (unsigned)w; }
            } else {
#pragma unroll
                for (int j = 0; j < 4; ++j) {
                    const int b0 = (int)__builtin_rintf(v[u][j].x * sc), b1 = (int)__builtin_rintf(v[u][j].y * sc), b2 = (int)__builtin_rintf(v[u][j].z * sc), b3 = (int)__builtin_rintf(v[u][j].w * sc);
                    q[j] = (unsigned)(b0 & 0xff) | ((unsigned)(b1 & 0xff) << 8) | ((unsigned)(b2 & 0xff) << 16) | ((unsigned)b3 << 24);
                }
            }
            *(u32x4*)(p.ws + (tbl ? WS_VTAB : WS_UTAB) + ((size_t)l * NEXP + e) * D + 16 * F.lane) = q;
            if (F.lane == 0) ((float*)(p.ws + WS_TSCALE))[(l * 2 + tbl) * NEXP + e] = 1.0f / sc;
        }
    }
}

DI void phase_prep(const Params& p, const Frame& F) {
    unsigned char* ws = p.ws;
    {
        LAS float* wq = (LAS float*)F.lds;
        LAS float* skl = wq + 128 * 65;
        for (int it = F.bid; it < 2 * 16 * 16; it += F.nb) {
            const int cc = it & 15, hp = (it >> 4) & 15, l = it >> 8;
            const float* src = p.in[I_peer_wq] + (size_t)l * D * 2048 + hp * 128;
            const float* sks = p.in[I_peer_subkeys] + (size_t)(l * 16 + hp) * 128 * 128;
            __syncthreads();
            { float tw[16]; f32x4 ts[8];
#pragma unroll
              for (int it = 0; it < 16; ++it) { const int e = F.tid + it * NTHREADS, ci = e >> 7, d = e & 127; tw[it] = src[(size_t)(cc * 64 + ci) * 2048 + d]; }
#pragma unroll
              for (int it = 0; it < 8; ++it) { const int e = F.tid + it * NTHREADS, key = e >> 5, d4 = (e & 31) * 4; ts[it] = *(const f32x4*)(sks + key * 128 + d4); }
#pragma unroll
              for (int it = 0; it < 16; ++it) { const int e = F.tid + it * NTHREADS, ci = e >> 7, d = e & 127; wq[d * 65 + ci] = tw[it]; }
#pragma unroll
              for (int it = 0; it < 8; ++it) { const int e = F.tid + it * NTHREADS, key = e >> 5, d4 = (e & 31) * 4; *(LAS f32x4*)(skl + key * 132 + d4) = ts[it]; } }
            __syncthreads();
            const int ci = F.tid & 63, kg = F.tid >> 6;
            float acc[16];
#pragma unroll
            for (int k = 0; k < 16; ++k) acc[k] = 0.f;
#pragma unroll 2
            for (int d = 0; d < 128; d += 4) {
                const float w0 = wq[d * 65 + ci], w1 = wq[(d + 1) * 65 + ci], w2 = wq[(d + 2) * 65 + ci], w3 = wq[(d + 3) * 65 + ci];
#pragma unroll
                for (int k = 0; k < 16; ++k) { const f32x4 s = *(const LAS f32x4*)(skl + (16 * kg + k) * 132 + d); acc[k] += w0 * s.x + w1 * s.y + w2 * s.z + w3 * s.w; }
            }
            bf16_t* dst = (bf16_t*)(ws + WS_WFOLD) + ((size_t)l * 2048 + hp * 128 + 16 * kg) * D + cc * 64 + ci;
#pragma unroll
            for (int k = 0; k < 16; ++k) dst[(size_t)k * D] = (bf16_t)f2bf(acc[k]);
        }
        __syncthreads();
    }
    {
        LAS float* scr = (LAS float*)(F.lds + F.wave * 16384);
        constexpr int I_IN = (D / 64) * (INW / 32), I_BA = (512 / 64) * (D / 32), I_BS = (256 / 64) * (D / 32), I_O = (D / 64) * (D / 32);
        constexpr int PER_L = I_IN + I_BA + I_BS + I_O;
        for (int it = F.gw; it < 2 * PER_L; it += F.ngw) {
            const int l = it / PER_L; int r = it % PER_L;
            if (r < I_IN) { transpose_item(p.in[I_w_in] + (size_t)l * D * INW, D, INW, (bf16_t*)(ws + WS_WIN) + (size_t)l * INW * D, D, 0, 0, scr, r, F.lane); continue; } r -= I_IN;
            if (r < I_BA) { transpose_item(p.in[I_w_br_attn] + (size_t)l * 512 * D, 512, D, (bf16_t*)(ws + WS_WBR) + (size_t)l * D * D, D, 0, 0, scr, r, F.lane); continue; } r -= I_BA;
            if (r < I_BS) { transpose_item(p.in[I_w_br_sgu] + (size_t)l * 256 * D, 256, D, (bf16_t*)(ws + WS_WBR) + (size_t)l * D * D, D, 0, 768, scr, r, F.lane); continue; } r -= I_BS;
            transpose_item(p.in[I_w_out] + (size_t)l * D * D, D, D, (bf16_t*)(ws + WS_WOUT) + (size_t)l * D * D, D, 0, 0, scr, r, F.lane);
        }
    }
    for (int i = F.gtid; i < 2 * 256 * D; i += F.ngt) {
        const int n = i & 1023, rc = (i >> 10) & 255, l = i >> 18, g = rc >> 6;
        const float* pw = p.in[I_pool_w] + ((size_t)l * 256 + rc) * 64;
        const float* ps = p.in[I_pool_scale] + l * 256 + 64 * g;
        const float* wb = p.in[I_w_br_pool] + ((size_t)l * 256 + 64 * g) * D + n;
        float a = 0.f;
#pragma unroll 16
        for (int e = 0; e < 64; ++e) a += pw[e] * ps[e] * wb[(size_t)e * D];
        ((bf16_t*)(ws + WS_WBR))[(size_t)l * D * D + (size_t)n * D + 512 + rc] = (bf16_t)f2bf(a);
    }
    for (int i = F.gtid; i < 2 * 4 * 128 * 128; i += F.ngt) ((bf16_t*)(ws + WS_SGUW))[i] = (bf16_t)f2bf(p.in[I_sgu_w][i]);
    for (int i = F.gtid; i < 64 * 16; i += F.ngt) {
        const int pos = i >> 4, fi = i & 15;
        const float inv = powf(10000.0f, -(float)fi / 16.0f);
        const float ang = (float)pos * inv;
        ((f32x2*)(ws + WS_ROPE))[i] = (f32x2){cosf(ang), sinf(ang)};
    }
    convert_tables(p, F);
    {
        float* MOD = (float*)(ws + WS_MOD);
        LAS float* scd = (LAS float*)F.lds;
        LAS float* red = scd + 9 * D;
        __syncthreads();
        { float tc[18];
#pragma unroll
          for (int it = 0; it < 18; ++it) { const int e = F.tid + it * NTHREADS, r = e >> 10, k = e & 1023; tc[it] = (r < 8) ? p.in[I_c][r * D + k] : p.in[I_c_ctx][k]; }
#pragma unroll
          for (int it = 0; it < 18; ++it) scd[F.tid + it * NTHREADS] = silu_(tc[it]); }
        __syncthreads();
        for (int it = F.bid; it < 2 * 96; it += F.nb) {
            const int cgp = it % 96, l = it / 96, col = cgp * 64 + F.lane;
            float acc[9];
#pragma unroll
            for (int r = 0; r < 9; ++r) acc[r] = 0.f;
            const float* wp = p.in[I_w_mod] + ((size_t)l * D + F.wave * 128) * NMOD + col;
#pragma unroll 16
            for (int k = 0; k < 128; ++k) {
                const float w = wp[(size_t)k * NMOD];
#pragma unroll
                for (int r = 0; r < 9; ++r) acc[r] += scd[r * D + F.wave * 128 + k] * w;
            }
#pragma unroll
            for (int r = 0; r < 9; ++r) red[(F.wave * 9 + r) * 64 + F.lane] = acc[r];
            __syncthreads();
            for (int e = F.tid; e < 9 * 64; e += NTHREADS) {
                const int r = e >> 6, ln = e & 63; float s = p.in[I_b_mod][l * NMOD + cgp * 64 + ln];
#pragma unroll
                for (int w = 0; w < 8; ++w) s += red[(w * 9 + r) * 64 + ln];
                MOD[((size_t)l * 9 + r) * NMOD + cgp * 64 + ln] = s;
            }
            __syncthreads();
        }
    }
}

DI const float* mod_vec(const Params& p, int l, int row, int j) {
    const int r = row < TL ? row / SEQ : 8;
    return (const float*)(p.ws + WS_MOD) + ((size_t)l * 9 + r) * NMOD + j * D;
}
DI float* xrow_ptr(const Params& p, int row) { return row < TL ? p.out + (size_t)row * D : (float*)(p.ws + WS_XCTX) + (size_t)(row - TL) * D; }
DI const float* xin_ptr(const Params& p, int row) { return row < TL ? p.in[I_x] + (size_t)row * D : p.in[I_ctx] + (size_t)(row - TL) * D; }

DI void phase_norm(const Params& p, const Frame& F, int l, int which  , bool from_input, int nrows) {
    const float* g = (which == 0 ? p.in[I_g_mix] : p.in[I_g_ffn]) + l * D;
    const int lane = F.lane;
    f32x4 gg[4];
#pragma unroll
    for (int j = 0; j < 4; ++j) gg[j] = ((const f32x4*)g)[lane + 64 * j];
    for (int row0 = 2 * F.gw; row0 < nrows; row0 += 2 * F.ngw) {
        f32x4 v[2][4], s1[2][4], s2[2][4];
#pragma unroll
        for (int u = 0; u < 2; ++u) {
            const int row = row0 + u;
            const float* src = from_input ? xin_ptr(p, row) : xrow_ptr(p, row);
            const float* sh = mod_vec(p, l, row, which * 3 + 0); const float* sc = mod_vec(p, l, row, which * 3 + 1);
#pragma unroll
            for (int j = 0; j < 4; ++j) { v[u][j] = ((const f32x4*)src)[lane + 64 * j]; s1[u][j] = ((const f32x4*)sh)[lane + 64 * j]; s2[u][j] = ((const f32x4*)sc)[lane + 64 * j]; }
        }
#pragma unroll
        for (int u = 0; u < 2; ++u) {
            float ss = 0.f;
#pragma unroll
            for (int j = 0; j < 4; ++j) ss += v[u][j].x * v[u][j].x + v[u][j].y * v[u][j].y + v[u][j].z * v[u][j].z + v[u][j].w * v[u][j].w;
            const float rinv = rsqrtf(wave_sum(ss) * (1.0f / D) + EPS);
            bf16_t* dst = (bf16_t*)(p.ws + WS_H) + (size_t)(row0 + u) * D;
            float am = 0.f;
#pragma unroll
            for (int j = 0; j < 4; ++j) {
                const f32x4 o = v[u][j] * rinv * gg[j] * (s2[u][j] + 1.0f) + s1[u][j];
                u32x2 w; w.x = pk2(o.x, o.y); w.y = pk2(o.z, o.w);
                ((u32x2*)dst)[lane + 64 * j] = w;
                v[u][j] = o; am = fmaxf(am, fmaxf(fmaxf(fabsf(o.x), fabsf(o.y)), fmaxf(fabsf(o.z), fabsf(o.w))));
            }
            if (which) {
#pragma unroll
                for (int o2 = 1; o2 < 64; o2 <<= 1) am = fmaxf(am, __shfl_xor(am, o2));
                const float sc = (am > 0.f) ? 127.0f / am : 1.0f;
                unsigned* h8 = (unsigned*)(p.ws + WS_H8 + (size_t)(row0 + u) * D);
#pragma unroll
                for (int j = 0; j < 4; ++j) {
                    const int b0 = (int)__builtin_rintf(v[u][j].x * sc), b1 = (int)__builtin_rintf(v[u][j].y * sc), b2 = (int)__builtin_rintf(v[u][j].z * sc), b3 = (int)__builtin_rintf(v[u][j].w * sc);
                    h8[lane + 64 * j] = (unsigned)(b0 & 0xff) | ((unsigned)(b1 & 0xff) << 8) | ((unsigned)(b2 & 0xff) << 16) | ((unsigned)b3 << 24);
                }
                if (lane == 0) ((float*)(p.ws + WS_HS))[row0 + u] = (am > 0.f) ? am * (1.0f / 127.0f) : 1.0f;
            }
        }
    }
}
DI void phase_final(const Params& p, const Frame& F) {
    f32x4 gg[4];
#pragma unroll
    for (int j = 0; j < 4; ++j) gg[j] = ((const f32x4*)p.in[I_g_final])[F.lane + 64 * j];
    for (int row0 = 2 * F.gw; row0 < TL; row0 += 2 * F.ngw) {
        f32x4 v[2][4];
#pragma unroll
        for (int u = 0; u < 2; ++u)
#pragma unroll
            for (int j = 0; j < 4; ++j) v[u][j] = ((const f32x4*)(p.out + (size_t)(row0 + u) * D))[F.lane + 64 * j];
#pragma unroll
        for (int u = 0; u < 2; ++u) {
            float ss = 0.f;
#pragma unroll
            for (int j = 0; j < 4; ++j) ss += v[u][j].x * v[u][j].x + v[u][j].y * v[u][j].y + v[u][j].z * v[u][j].z + v[u][j].w * v[u][j].w;
            const float rinv = rsqrtf(wave_sum(ss) * (1.0f / D) + EPS);
            f32x4* xr = (f32x4*)(p.out + (size_t)(row0 + u) * D);
#pragma unroll
            for (int j = 0; j < 4; ++j) xr[F.lane + 64 * j] = v[u][j] * rinv * gg[j];
        }
    }
}

DI float lane_xor32(float v, bool hi) { const auto r = __builtin_amdgcn_permlane32_swap(__builtin_bit_cast(unsigned, v), __builtin_bit_cast(unsigned, v), false, false);
    return __builtin_bit_cast(float, hi ? r[0] : r[1]); }
struct EpiG1 {
    DI bool keeps(const pg8::Unit&) const { return false; }
    static constexpr bool PERM = true;
    unsigned char* ws;
    DI void operator()(const f32x4 (&acc)[2][2][4][2], const pg8::Unit& u, int wr, int wc, int fr, int fq) const {
        bf16_t* P = (bf16_t*)(ws + WS_P);
        const int rbase = u.pm * 256 + wr * 64 + fr;
        const bool hi = fq >= 2;
#pragma unroll
        for (int ai = 0; ai < 2; ++ai) {
            f32x4 cs[4][4];
            const bool lat = u.pm < TL / 256;
            if (u.pn < 3 && lat) {
#pragma unroll
                for (int m = 0; m < 4; ++m) {
                    const int t = (rbase + 128 * ai + 16 * m) & (SEQ - 1), pos = (wc & 1) ? (t & 63) : (t >> 6);
                    const f32x4* tab = (const f32x4*)(ws + WS_ROPE) + (pos * 16 + 8 * (fq & 1)) / 2;
#pragma unroll
                    for (int j2 = 0; j2 < 4; ++j2) cs[m][j2] = tab[j2];
                }
            }
#pragma unroll
            for (int m = 0; m < 4; ++m) {
                const int row = rbase + 128 * ai + 16 * m;
#pragma unroll
                for (int bj = 0; bj < 2; ++bj) {
                    const int c0 = u.pn * 256 + 128 * bj + 32 * wc + 8 * fq;
                    float v[8];
#pragma unroll
                    for (int j = 0; j < 4; ++j) { v[j] = acc[ai][bj][m][0][j]; v[4 + j] = acc[ai][bj][m][1][j]; }
                    if (c0 < VOFF) {
                        const float sc = (c0 < KOFF) ? QSCALE : 1.0f;
                        u32x4 o;
#pragma unroll
                        for (int j2 = 0; j2 < 4; ++j2) {
                            const f32x4 c4 = cs[m][j2];
                            const float o0 = lane_xor32(v[2 * j2], hi), o1 = lane_xor32(v[2 * j2 + 1], hi);
                            float r0 = hi ? (v[2 * j2] * c4.x + o0 * c4.y) : (v[2 * j2] * c4.x - o0 * c4.y);
                            float r1 = hi ? (v[2 * j2 + 1] * c4.z + o1 * c4.w) : (v[2 * j2 + 1] * c4.z - o1 * c4.w);
                            if (!lat) { r0 = v[2 * j2]; r1 = v[2 * j2 + 1]; }
                            o[j2] = pk2(r0 * sc, r1 * sc);
                        }
                        *(u32x4*)(P + (size_t)row * PW + c0) = o;
                    } else if (c0 < POOLOFF) {
                        const int hk = wc >> 1, d0 = 32 * (wc & 1) + 8 * fq;
                        if (lat) { const int b = row / SEQ, t = row & (SEQ - 1);
                            bf16_t* vt = (bf16_t*)(ws + WS_VT) + ((size_t)(b * 2 + hk) * 64 + d0) * VTS + t;
#pragma unroll
                            for (int j = 0; j < 8; ++j) vt[(size_t)j * VTS] = (bf16_t)f2bf(v[j]);
                        } else { const int rc = row - TL, b = rc / NCTX, jc = rc & (NCTX - 1);
                            bf16_t* vt = (bf16_t*)(ws + WS_VTC) + ((size_t)(b * 2 + hk) * 64 + d0) * NCTX + jc;
#pragma unroll
                            for (int j = 0; j < 8; ++j) vt[(size_t)j * NCTX] = (bf16_t)f2bf(v[j]);
                        }
                    } else if (c0 < SUOFF) {
                        u32x4 o;
#pragma unroll
                        for (int j2 = 0; j2 < 4; ++j2) o[j2] = pk2(v[2 * j2], v[2 * j2 + 1]);
                        *(u32x4*)(P + (size_t)row * PW + c0) = o;
                    } else if (c0 < SVOFF) {
                        u32x4 o;
#pragma unroll
                        for (int j2 = 0; j2 < 4; ++j2) o[j2] = pk2(gelu_tanh(v[2 * j2]), gelu_tanh(v[2 * j2 + 1]));
                        *(u32x4*)(P + (size_t)row * PW + c0) = o;
                    } else {
                        const int c = c0 - SVOFF, chunk = row >> 7, q = row & 127;
                        bf16_t* vs = (bf16_t*)(ws + WS_VST) + ((size_t)chunk * 256 + c) * 128 + q;
#pragma unroll
                        for (int j = 0; j < 8; ++j) vs[j * 128] = (bf16_t)f2bf(gelu_tanh(v[j]));
                    }
                }
            }
            asm volatile("" ::: "memory");
        }
    }
};
struct SchedGrid {
    int nM, nN, G, c; const char* A; const char* B;
    int n_extra, ex_pm0, ex_pn;
    DI bool next(int i, pg8::Unit& u) const {
        const int L = i * G + c, n = nM * nN; if (L >= n + n_extra) return false;
        if (L < n) pg8::tile_of(L, nM, nN, u.pm, u.pn); else { u.pm = ex_pm0 + (L - n); u.pn = ex_pn; }
        u.sub = 0; u.nt = D / 64; u.mode = 0;
        u.a = A + (size_t)u.pm * 256 * D * 2; u.b = B + (size_t)u.pn * 256 * D * 2; return true;
    }
};

DI void phase_g1(const Params& p, const Frame& F, int l) {
    SchedGrid S{(l == 0 ? T : TL) / 256, PN / 256, F.nb, F.bid, (const char*)(p.ws + WS_H), (const char*)(p.ws + WS_WIN) + (size_t)l * INW * D * 2,
                (l == 0) ? 0 : TC / 256, TL / 256, 2};
    EpiG1 E{p.ws};
    pg8::gemm_phase(F.lds, F.tid, S, E);
}

DI bf16x8 pack8(const f32x16& x, int s) {
    u32x4 pk;
#pragma unroll
    for (int j = 0; j < 4; ++j) { f32x2 v = {x[8 * s + 2 * j], x[8 * s + 2 * j + 1]}; pk[j] = __builtin_bit_cast(unsigned, __builtin_convertvector(v, bf16x2_t)); }
    return __builtin_bit_cast(bf16x8, pk);
}

DI float lane_x32(float v, bool hi) { const auto r = __builtin_amdgcn_permlane32_swap(__builtin_bit_cast(unsigned, v), __builtin_bit_cast(unsigned, v), false, false);
    return __builtin_bit_cast(float, hi ? r[0] : r[1]); }
struct AttnFrags { bf16x8 kf[4]; s16x4 vf[2][4]; };
DI void attn_block(const bf16x8 (&qf)[4], const AttnFrags& f, int mask_mode, int kq_off, int lane, float& m, float& lpart, f32x16 (&o)[2]) {
    const int h = lane >> 5;
    f32x16 st;
#pragma unroll
    for (int r = 0; r < 16; ++r) st[r] = 0.f;
#pragma unroll
    for (int s = 0; s < 4; ++s) st = MFMA32(f.kf[s], qf[s], st);
    if (mask_mode) {
#pragma unroll
        for (int r = 0; r < 16; ++r) { const int dlt = kq_off + crow(r, h); if (dlt > 128 || dlt < -128) st[r] = -1e30f; }
    }
    float bm = st[0];
#pragma unroll
    for (int r = 1; r < 16; ++r) bm = fmaxf(bm, st[r]);
    bm = fmaxf(bm, lane_x32(bm, h != 0));
    const float mn = fmaxf(m, bm);
    if (__builtin_amdgcn_ballot_w64(mn > m) != 0ull) {
        const float alpha = __builtin_amdgcn_exp2f(m - mn);
        lpart *= alpha;
#pragma unroll
        for (int d = 0; d < 2; ++d)
#pragma unroll
            for (int r = 0; r < 16; ++r) o[d][r] *= alpha;
        m = mn;
    }
    float ps = 0.f;
#pragma unroll
    for (int r = 0; r < 16; ++r) { st[r] = __builtin_amdgcn_exp2f(st[r] - m); ps += st[r]; }
    lpart += ps;
    const bf16x8 pf0 = pack8(st, 0), pf1 = pack8(st, 1);
#pragma unroll
    for (int d = 0; d < 2; ++d) {
        const bf16x8 v0 = __builtin_shufflevector(f.vf[d][0], f.vf[d][1], 0, 1, 2, 3, 4, 5, 6, 7), v1 = __builtin_shufflevector(f.vf[d][2], f.vf[d][3], 0, 1, 2, 3, 4, 5, 6, 7);
        o[d] = MFMA32(v0, pf0, o[d]);
        o[d] = MFMA32(v1, pf1, o[d]);
    }
}

constexpr int AKP = 144, AVWP = 648, AVCP = 520;
constexpr int ALDS_KW = 0, ALDS_VW = ALDS_KW + 320 * AKP, ALDS_KC = ALDS_VW + 64 * AVWP, ALDS_VC = ALDS_KC + 256 * AKP, ALDS_END = ALDS_VC + 64 * AVCP;
static_assert(ALDS_END <= LDS_BAR_OFF && (ALDS_VW % 16) == 0 && (ALDS_KC % 16) == 0 && (ALDS_VC % 8) == 0, "attention LDS map");
DI void attn_lds_frags(AttnFrags& f, const LAS unsigned char* kp, const LAS unsigned char* vp, int vpitch32) {
#pragma unroll
    for (int s = 0; s < 4; ++s) f.kf[s] = *(const LAS bf16x8*)(kp + 32 * s);
#pragma unroll
    for (int d = 0; d < 2; ++d)
#pragma unroll
        for (int q = 0; q < 4; ++q) f.vf[d][q] = *(const LAS s16x4*)(vp + d * vpitch32 + 16 * q);
}
DI void attn_unit(const Params& p, const Frame& F, int l, int unit) {
    const int lane = F.lane, r = lane & 31, h = lane >> 5, tid = F.tid;
    const bf16_t* P = (const bf16_t*)(p.ws + WS_P);
    const bf16_t* VT = (const bf16_t*)(p.ws + WS_VT);
    const bf16_t* VTC = (const bf16_t*)(p.ws + WS_VTC);
    bf16_t* Y = (bf16_t*)(p.ws + WS_Y);
    const bool latent = unit < 1024;
    int b, hk, p0, q0row;
    if (latent) { const int pb = unit & 63; hk = (unit >> 6) & 1; b = unit >> 7; p0 = pb * 64; q0row = b * SEQ + p0; }
    else { const int u2 = unit - 1024, pb = u2 & 3; hk = (u2 >> 2) & 1; b = u2 >> 3; p0 = pb * 64; q0row = TL + b * NCTX + p0; }
    const int w0 = p0 - 128;
    u32x4 kw[5], vw[5], kc[4], vc[4];
    if (latent) {
#pragma unroll
        for (int it = 0; it < 5; ++it) {
            const int i = tid + it * NTHREADS, row = i >> 3, ck = i & 7, pos = min(max(w0 + row, 0), SEQ - 1);
            kw[it] = *(const u32x4*)(P + (size_t)(b * SEQ + pos) * PW + KOFF + hk * 64 + 8 * ck);
            const int d = i / 40, cv = i % 40, pv = min(max(w0 + 8 * cv, 0), SEQ - 8);
            vw[it] = *(const u32x4*)(VT + ((size_t)(b * 2 + hk) * 64 + d) * VTS + pv);
        }
    }
#pragma unroll
    for (int it = 0; it < 4; ++it) {
        const int i = tid + it * NTHREADS;
        kc[it] = *(const u32x4*)(P + (size_t)(TL + b * NCTX + (i >> 3)) * PW + KOFF + hk * 64 + 8 * (i & 7));
        vc[it] = *(const u32x4*)(VTC + ((size_t)(b * 2 + hk) * 64 + (i >> 5)) * NCTX + 8 * (i & 31));
    }
    __syncthreads();
    if (latent) {
#pragma unroll
        for (int it = 0; it < 5; ++it) {
            const int i = tid + it * NTHREADS, row = i >> 3, ck = i & 7;
            *(LAS u32x4*)(F.lds + ALDS_KW + row * AKP + 16 * ck) = kw[it];
            const int d = i / 40, cv = i % 40;
            LAS u32x2* dst = (LAS u32x2*)(F.lds + ALDS_VW + d * AVWP + 16 * cv); dst[0] = (u32x2){vw[it].x, vw[it].y}; dst[1] = (u32x2){vw[it].z, vw[it].w};
        }
    }
#pragma unroll
    for (int it = 0; it < 4; ++it) {
        const int i = tid + it * NTHREADS;
        *(LAS u32x4*)(F.lds + ALDS_KC + (i >> 3) * AKP + 16 * (i & 7)) = kc[it];
        LAS u32x2* dst = (LAS u32x2*)(F.lds + ALDS_VC + (i >> 5) * AVCP + 16 * (i & 31)); dst[0] = (u32x2){vc[it].x, vc[it].y}; dst[1] = (u32x2){vc[it].z, vc[it].w};
    }
    const int head = 4 * hk + (F.wave & 3), ph = F.wave >> 2, pw = p0 + 32 * ph, qrow = q0row + 32 * ph;
    bf16x8 qf[4];
#pragma unroll
    for (int s = 0; s < 4; ++s) qf[s] = *(const bf16x8*)(P + (size_t)(qrow + r) * PW + head * 64 + 16 * s + 8 * h);
    float m = p.in[I_attn_sink][l * 8 + head] * LOG2E, lpart = (h == 0) ? 1.0f : 0.0f;
    f32x16 o[2];
#pragma unroll
    for (int d = 0; d < 2; ++d)
#pragma unroll
        for (int i = 0; i < 16; ++i) o[d][i] = 0.f;
    __syncthreads();
    if (latent) {
#pragma unroll 1
        for (int j = 0; j < 9; ++j) {
            const int kb = pw - 128 + 32 * j;
            if (kb < 0 || kb >= SEQ) continue;
            const int krow = kb - w0;
            AttnFrags f;
            attn_lds_frags(f, F.lds + ALDS_KW + (krow + r) * AKP + 16 * h, F.lds + ALDS_VW + r * AVWP + 2 * krow + 8 * h, 32 * AVWP);
            attn_block(qf, f, (j == 0 || j == 8) ? 1 : 0, kb - (pw + r), lane, m, lpart, o);
        }
    }
#pragma unroll 1
    for (int j = 0; j < 8; ++j) {
        AttnFrags f;
        attn_lds_frags(f, F.lds + ALDS_KC + (32 * j + r) * AKP + 16 * h, F.lds + ALDS_VC + r * AVCP + 64 * j + 8 * h, 32 * AVCP);
        attn_block(qf, f, 0, 0, lane, m, lpart, o);
    }
    const float inv = 1.0f / (lpart + lane_x32(lpart, h != 0));
    bf16_t* yrow = Y + (size_t)(qrow + r) * D + head * 64;
#pragma unroll
    for (int d = 0; d < 2; ++d)
#pragma unroll
        for (int g = 0; g < 4; ++g) {
            u32x2 w; w.x = pk2(o[d][4 * g] * inv, o[d][4 * g + 1] * inv); w.y = pk2(o[d][4 * g + 2] * inv, o[d][4 * g + 3] * inv);
            *(u32x2*)(yrow + 32 * d + 8 * g + 4 * h) = w;
        }
}

DI void sgu_unit(const Params& p, const Frame& F, int l, int chunk) {
    constexpr int VS = 136;
    LAS float* part = (LAS float*)F.lds;
    LAS float* rq = part + 512;
    LAS bf16_t* vnT = (LAS bf16_t*)(F.lds + 4096);
    const bf16_t* VsT = (const bf16_t*)(p.ws + WS_VST) + (size_t)chunk * 256 * 128;
    const bf16_t* P = (const bf16_t*)(p.ws + WS_P);
    bf16_t* Y = (bf16_t*)(p.ws + WS_Y);
    __syncthreads();
    { const int q = F.tid & 127, part_i = F.tid >> 7; float ss = 0.f;
#pragma unroll 16
        for (int c = part_i * 64; c < part_i * 64 + 64; ++c) { const float v = bf2f(VsT[c * 128 + q]); ss += v * v; }
        part[part_i * 128 + q] = ss; }
    __syncthreads();
    if (F.tid < 128) rq[F.tid] = rsqrtf((part[F.tid] + part[128 + F.tid] + part[256 + F.tid] + part[384 + F.tid]) * (1.0f / 256.0f) + EPS);
    __syncthreads();
#pragma unroll
    for (int it = 0; it < 8; ++it) {
        const int i = F.tid + it * NTHREADS;
        const int c = i >> 4, q8 = (i & 15) * 8;
        const u32x4 v = *(const u32x4*)(VsT + c * 128 + q8);
        u32x4 o;
#pragma unroll
        for (int j = 0; j < 4; ++j) o[j] = pk2(bflo(v[j]) * rq[q8 + 2 * j], bfhi(v[j]) * rq[q8 + 2 * j + 1]);
        *(LAS u32x4*)(vnT + c * VS + q8) = o;
    }
    __syncthreads();
    const int lane = F.lane, r = lane & 31, h = lane >> 5, g = F.wave >> 1, ph = F.wave & 1;
    const bf16_t* Wg = (const bf16_t*)(p.ws + WS_SGUW) + ((size_t)l * 4 + g) * 128 * 128;
#pragma unroll 1
    for (int pb = 0; pb < 2; ++pb) {
        const int p0 = 64 * ph + 32 * pb;
        const int row = chunk * 128 + p0 + r;
        bf16x8 wf[8];
#pragma unroll
        for (int s = 0; s < 8; ++s) wf[s] = *(const bf16x8*)(Wg + (size_t)(p0 + r) * 128 + 16 * s + 8 * h);
        u32x2 uu[2][4];
#pragma unroll
        for (int cb = 0; cb < 2; ++cb)
#pragma unroll
            for (int q4 = 0; q4 < 4; ++q4) uu[cb][q4] = *(const u32x2*)(P + (size_t)row * PW + SUOFF + 64 * g + 32 * cb + 8 * q4 + 4 * h);
        const float bias = p.in[I_sgu_b][(l * 4 + g) * 128 + p0 + r];
#pragma unroll
        for (int cb = 0; cb < 2; ++cb) {
            const int c0 = 64 * g + 32 * cb;
            f32x16 acc;
#pragma unroll
            for (int i = 0; i < 16; ++i) acc[i] = 0.f;
#pragma unroll
            for (int s = 0; s < 8; ++s) {
                const bf16x8 a = *(const LAS bf16x8*)(vnT + (c0 + r) * VS + 16 * s + 8 * h);
                acc = MFMA32(a, wf[s], acc);
            }
#pragma unroll
            for (int q4 = 0; q4 < 4; ++q4) {
                const int cc = c0 + 8 * q4 + 4 * h;
                const u32x2 u = uu[cb][q4];
                u32x2 w;
                w.x = pk2(bflo(u.x) * (acc[4 * q4] + bias), bfhi(u.x) * (acc[4 * q4 + 1] + bias));
                w.y = pk2(bflo(u.y) * (acc[4 * q4 + 2] + bias), bfhi(u.y) * (acc[4 * q4 + 3] + bias));
                *(u32x2*)(Y + (size_t)row * D + 768 + cc) = w;
            }
        }
    }
}

DI void phase_mix(const Params& p, const Frame& F, int l, int ctr_slot = 0) {
    (void)ctr_slot;
    const int nrows = (l == 0) ? T : TL;
    const bf16_t* P = (const bf16_t*)(p.ws + WS_P);
    bf16_t* Y = (bf16_t*)(p.ws + WS_Y);
    for (int i0 = F.bid * NTHREADS; i0 < 4 * nrows * 8; i0 += F.nb * NTHREADS) {
        const int i = i0 + F.tid, g = i / (nrows * 8), rem = i - g * (nrows * 8), row = rem >> 3, ck = g * 8 + (rem & 7);
        int base, t, len;
        if (row < TL) { base = row & ~(SEQ - 1); t = row & (SEQ - 1); len = SEQ; } else { const int rc = row - TL; base = TL + (rc & ~(NCTX - 1)); t = rc & (NCTX - 1); len = NCTX; }
        float s[8];
#pragma unroll
        for (int j = 0; j < 8; ++j) s[j] = 0.f;
        const bf16_t* zc = P + POOLOFF + ck * 8;
#define POOL_WIN(HALF) do { _Pragma("unroll") for (int dt = -(HALF); dt < (HALF); ++dt) { const int tt = t + dt; const bool ok = tt >= 0 && tt < len; \
            const u32x4 v = *(const u32x4*)(zc + (size_t)(base + (ok ? tt : t)) * PW); const float w = ok ? 1.f : 0.f; \
            _Pragma("unroll") for (int j = 0; j < 4; ++j) { s[2 * j] += w * bflo(v[j]); s[2 * j + 1] += w * bfhi(v[j]); } } } while (0)
        int half;
        if (g == 0) { POOL_WIN(1); half = 1; } else if (g == 1) { POOL_WIN(2); half = 2; } else if (g == 2) { POOL_WIN(4); half = 4; } else { POOL_WIN(8); half = 8; }
#undef POOL_WIN
        const int lo = max(t - half, 0), hi = min(t + half, len);
        const float inv = 1.0f / (float)(hi - lo);
        const u32x4 z = *(const u32x4*)(zc + (size_t)row * PW);
        u32x4 o;
#pragma unroll
        for (int j = 0; j < 4; ++j) o[j] = pk2(s[2 * j] * inv - bflo(z[j]), s[2 * j + 1] * inv - bfhi(z[j]));
        *(u32x4*)(Y + (size_t)row * D + 512 + ck * 8) = o;
    }
    const int nchunk = (l == 0) ? T / 128 : TL / 128;
    for (int ch = F.bid; ch < nchunk; ch += F.nb) sgu_unit(p, F, l, ch);
    const int nunit = (l == 0) ? 1024 + 64 : 1024;
    for (int u = F.nb - 1 - F.bid; u < nunit; u += F.nb) attn_unit(p, F, l, u);
}

struct SchedG2 {
    int G, c; const char *H, *Y, *Wg, *Wb; int npair;
    DI void fill(pg8::Unit& u, int sub, int br) const {
        u.sub = sub;
        if ((sub & 1) == 0) { u.nt = 16; u.a = H + (size_t)u.pm * 256 * D * 2; u.b = Wg + ((size_t)br * D + u.pn * 256) * D * 2; }
        else { const int koff = (br == 0) ? 0 : (br == 1 ? 512 : 768); u.nt = (br == 0) ? 8 : 4;
               u.a = Y + ((size_t)u.pm * 256 * D + koff) * 2; u.b = Wb + ((size_t)u.pn * 256 * D + koff) * 2; }
    }
    DI bool next(int i, pg8::Unit& u) const {
        constexpr int NLAT = (TL / 256) * 4;
        const int nl = (NLAT - c + G - 1) / G;
        if (i < 6 * nl) { const int tile = (i / 6) * G + c, sub = i % 6; pg8::tile_of(tile, TL / 256, 4, u.pm, u.pn); u.mode = 0; fill(u, sub, sub >> 1); return true; }
        const int e = i - 6 * nl, j = (e >> 1) * G + c;
        if (j >= npair) return false;
        const int ctile = j / 3, br = j % 3;
        u.pm = TL / 256 + (ctile >> 2); u.pn = ctile & 3; u.mode = 1 + br; fill(u, e & 1, br); return true;
    }
};
struct EpiG2 {
    static constexpr bool PERM = true;
    bf16_t* scr; bf16_t* M; bf16_t* MP;
    DI bool keeps(const pg8::Unit& u) const { return (u.sub & 1) == 0; }
    DI void operator()(f32x4 (&acc)[2][2][4][2], const pg8::Unit& u, int wr, int wc, int fr, int fq) const {
        const bool gate = (u.sub & 1) == 0, first = u.sub == 0 && gate;
        bf16_t* Mo = (u.mode == 0) ? M + (size_t)u.pm * 256 * D : MP + ((size_t)(u.mode - 1) * TC + (size_t)(u.pm - TL / 256) * 256) * D;
#pragma unroll
        for (int ai = 0; ai < 2; ++ai) {
            u32x4 ld[4][2];
            if (!first) {
#pragma unroll
                for (int m = 0; m < 4; ++m)
#pragma unroll
                    for (int bj = 0; bj < 2; ++bj) {
                        const int rl = 128 * ai + 64 * wr + 16 * m + fr, cl = 128 * bj + 32 * wc + 8 * fq;
                        ld[m][bj] = gate ? *(const u32x4*)(Mo + (size_t)rl * D + u.pn * 256 + cl) : *(const u32x4*)(scr + rl * 256 + cl);
                    }
            }
#pragma unroll
            for (int m = 0; m < 4; ++m)
#pragma unroll
                for (int bj = 0; bj < 2; ++bj) {
                    const int rl = 128 * ai + 64 * wr + 16 * m + fr, cl = 128 * bj + 32 * wc + 8 * fq;
                    if (gate) {
                        u32x4 o;
#pragma unroll
                        for (int j2 = 0; j2 < 4; ++j2) {
                            const int n = j2 >> 1, e = 2 * (j2 & 1);
                            const unsigned w = pk2(fmaxf(sigmoidf_(acc[ai][bj][m][n][e]), 1e-20f), fmaxf(sigmoidf_(acc[ai][bj][m][n][e + 1]), 1e-20f));
                            o[j2] = w;
                            const float t0 = first ? 0.f : bflo(ld[m][bj][j2]), t1 = first ? 0.f : bfhi(ld[m][bj][j2]);
                            acc[ai][bj][m][n][e] = t0 * __builtin_amdgcn_rcpf(bflo(w)); acc[ai][bj][m][n][e + 1] = t1 * __builtin_amdgcn_rcpf(bfhi(w));
                        }
                        *(u32x4*)(scr + rl * 256 + cl) = o;
                    } else {
                        u32x4 w;
#pragma unroll
                        for (int j2 = 0; j2 < 4; ++j2) { const int n = j2 >> 1, e = 2 * (j2 & 1);
                            w[j2] = pk2(acc[ai][bj][m][n][e] * bflo(ld[m][bj][j2]), acc[ai][bj][m][n][e + 1] * bfhi(ld[m][bj][j2])); }
                        *(u32x4*)(Mo + (size_t)rl * D + u.pn * 256 + cl) = w;
                    }
                }
            asm volatile("" ::: "memory");
        }
    }
};
DI void phase_g2(const Params& p, const Frame& F, int l) {
    SchedG2 S{F.nb, F.bid, (const char*)(p.ws + WS_H), (const char*)(p.ws + WS_Y),
              (const char*)(p.ws + WS_WIN) + ((size_t)l * INW + GATEOFF) * D * 2, (const char*)(p.ws + WS_WBR) + (size_t)l * D * D * 2, (l == 0) ? (TC / 256) * 4 * 3 : 0};
    EpiG2 E{(bf16_t*)(p.ws + WS_IDX) + (size_t)F.bid * 65536, (bf16_t*)(p.ws + WS_MERGED), (bf16_t*)(p.ws + WS_MP)};
    pg8::gemm_phase(F.lds, F.tid, S, E);
}
DI void phase_g2sum(const Params& p, const Frame& F) {
    const u32x4* mp = (const u32x4*)(p.ws + WS_MP);
    u32x4* mo = (u32x4*)((bf16_t*)(p.ws + WS_MERGED) + (size_t)TL * D);
    constexpr int NV = TC * D / 8;
    for (int i = F.gtid; i < NV; i += F.ngt) {
        const u32x4 a = mp[i], b = mp[NV + i], c = mp[2 * NV + i];
        u32x4 o;
#pragma unroll
        for (int j = 0; j < 4; ++j) o[j] = pk2(bflo(a[j]) + bflo(b[j]) + bflo(c[j]), bfhi(a[j]) + bfhi(b[j]) + bfhi(c[j]));
        mo[i] = o;
    }
}

struct EpiG3 {
    DI bool keeps(const pg8::Unit&) const { return false; }
    static constexpr bool PERM = false;
    const float* xsrc; float* xdst; const float* csrc; float* cdst; const float* mod;
    DI void operator()(const f32x4 (&acc)[2][2][4][2], const pg8::Unit& u, int wr, int wc, int fr, int fq) const {
        const int col0 = u.pn * 256 + wc * 32 + 4 * fq;
        const bool lat = u.pm < TL / 256;
        const float* gt = mod + (size_t)(lat ? (u.pm >> 4) : 8) * NMOD + 2 * D;
        const float* xs = lat ? xsrc + (size_t)u.pm * 256 * D : csrc + (size_t)(u.pm - TL / 256) * 256 * D;
        float* xd = lat ? xdst + (size_t)u.pm * 256 * D : cdst + (size_t)(u.pm - TL / 256) * 256 * D;
        f32x4 gv[2][2];
#pragma unroll
        for (int bj = 0; bj < 2; ++bj)
#pragma unroll
            for (int n = 0; n < 2; ++n) gv[bj][n] = *(const f32x4*)(gt + col0 + 128 * bj + 16 * n);
#pragma unroll
        for (int ai = 0; ai < 2; ++ai) {
            f32x4 xv[4][2][2];
#pragma unroll
            for (int m = 0; m < 4; ++m)
#pragma unroll
                for (int bj = 0; bj < 2; ++bj)
#pragma unroll
                    for (int n = 0; n < 2; ++n) xv[m][bj][n] = *(const f32x4*)(xs + (size_t)(wr * 64 + fr + 128 * ai + 16 * m) * D + col0 + 128 * bj + 16 * n);
#pragma unroll
            for (int m = 0; m < 4; ++m)
#pragma unroll
                for (int bj = 0; bj < 2; ++bj)
#pragma unroll
                    for (int n = 0; n < 2; ++n)
                        *(f32x4*)(xd + (size_t)(wr * 64 + fr + 128 * ai + 16 * m) * D + col0 + 128 * bj + 16 * n) = xv[m][bj][n] + gv[bj][n] * acc[ai][bj][m][n];
            asm volatile("" ::: "memory");
        }
    }
};
DI void phase_g3(const Params& p, const Frame& F, int l) {
    SchedGrid S{(l == 0 ? T : TL) / 256, D / 256, F.nb, F.bid, (const char*)(p.ws + WS_MERGED), (const char*)(p.ws + WS_WOUT) + (size_t)l * D * D * 2, 0, 0, 0};
    float* xc = (float*)(p.ws + WS_XCTX);
    EpiG3 E{(l == 0) ? p.in[I_x] : p.out, p.out, (l == 0) ? p.in[I_ctx] : xc, xc, (const float*)(p.ws + WS_MOD) + (size_t)l * 9 * NMOD};
    pg8::gemm_phase(F.lds, F.tid, S, E);
}

struct EpiG45 {
    DI bool keeps(const pg8::Unit&) const { return false; }
    static constexpr bool PERM = true;
    unsigned short* ST;
    DI void operator()(const f32x4 (&acc)[2][2][4][2], const pg8::Unit& u, int wr, int wc, int fr, int fq) const {
        const int col0 = u.pn * 256 + wc * 32 + 8 * fq;
#pragma unroll
        for (int ai = 0; ai < 2; ++ai)
#pragma unroll
            for (int m = 0; m < 4; ++m) {
                unsigned short* rowp = ST + (size_t)(u.pm * 256 + wr * 64 + fr + 128 * ai + 16 * m) * T + col0;
#pragma unroll
                for (int bj = 0; bj < 2; ++bj) {
                    u32x4 w;
                    w.x = pkh2(acc[ai][bj][m][0][0], acc[ai][bj][m][0][1]); w.y = pkh2(acc[ai][bj][m][0][2], acc[ai][bj][m][0][3]);
                    w.z = pkh2(acc[ai][bj][m][1][0], acc[ai][bj][m][1][1]); w.w = pkh2(acc[ai][bj][m][1][2], acc[ai][bj][m][1][3]);
                    *(u32x4*)(rowp + 128 * bj) = w;
                }
            }
    }
};
DI void phase_g45(const Params& p, const Frame& F, int l) {
    SchedGrid S{2048 / 256, (l == 0 ? T : TL) / 256, F.nb, F.bid, (const char*)(p.ws + WS_WFOLD) + (size_t)l * 2048 * D * 2, (const char*)(p.ws + WS_H), 0, 0, 0};
    EpiG45 E{(unsigned short*)(p.ws + WS_ST)};
    pg8::gemm_phase(F.lds, F.tid, S, E);
}

DI unsigned fkey(float f) { const unsigned u = __builtin_bit_cast(unsigned, f); return (u & 0x80000000u) ? ~u : (u | 0x80000000u); }
DI float fkey_inv(unsigned k) { const unsigned u = (k & 0x80000000u) ? (k & 0x7fffffffu) : ~k; return __builtin_bit_cast(float, u); }
#define INSERT16(L, x) do { unsigned x_ = (x); _Pragma("unroll") for (int k_ = 0; k_ < 16; ++k_) { const unsigned hi_ = max(L[k_], x_); x_ = min(L[k_], x_); L[k_] = hi_; } } while (0)
#define CEX(a, b) do { const unsigned hi_ = max(a, b), lo_ = min(a, b); a = hi_; b = lo_; } while (0)
DI void sort16_desc(unsigned (&v)[16]) {
#pragma unroll
    for (int k = 2; k <= 16; k <<= 1)
#pragma unroll
        for (int j = k >> 1; j > 0; j >>= 1)
#pragma unroll
            for (int i = 0; i < 16; ++i) {
                const int q = i ^ j;
                if (q > i) { if ((i & k) == 0) CEX(v[i], v[q]); else CEX(v[q], v[i]); }
            }
}
DI void merge16_desc(unsigned (&L)[16], const unsigned (&N)[16]) {
#pragma unroll
    for (int i = 0; i < 16; ++i) L[i] = max(L[i], N[15 - i]);
#pragma unroll
    for (int j = 8; j > 0; j >>= 1)
#pragma unroll
        for (int i = 0; i < 16; ++i) { const int q = i ^ j; if (q > i) CEX(L[i], L[q]); }
}
DI void phase_sel(const Params& p, const Frame& F, int l) {
    const _Float16* ST = (const _Float16*)(p.ws + WS_ST);
    unsigned short* IDX = (unsigned short*)(p.ws + WS_IDX);
    float* GW = (float*)(p.ws + WS_GW);
    float* SU = (float*)(p.ws + WS_SU);
    const float* TSC = (const float*)(p.ws + WS_TSCALE) + (size_t)l * 2 * NEXP;
    LAS unsigned char* ib = (LAS unsigned char*)F.lds;
    const int ntok = (l == 0) ? T : TL;
    for (int i0 = F.bid * NTHREADS; i0 < ntok * 8; i0 += F.nb * NTHREADS) {
        const int i = i0 + F.tid;
        const int tok = i % ntok, head = i / ntok;
        unsigned la[16], lb[16];
#pragma unroll
        for (int k = 0; k < 16; ++k) { la[k] = 0u; lb[k] = 0u; }
        const _Float16* s0 = ST + (size_t)(head * 256) * T + tok;
#define SEL_LOAD(B_, k0_) do { _Pragma("unroll") for (int j = 0; j < 32; ++j) B_[j] = sp[(size_t)((k0_) + j) * T]; } while (0)
#define SEL_GRP(L_, B_, o_, k0_) do { unsigned nk_[16]; \
        _Pragma("unroll") for (int j = 0; j < 16; ++j) nk_[j] = (fkey((float)B_[(o_) + j]) & ~127u) | (unsigned)(127 - ((k0_) + j)); \
        sort16_desc(nk_); merge16_desc(L_, nk_); } while (0)
#define SEL_HALF(L_, base_) do { const _Float16* sp = s0 + (size_t)(base_) * T; _Float16 bufa[32], bufb[32]; \
        SEL_LOAD(bufa, 0); \
        _Pragma("unroll 1") for (int k0 = 0; k0 < 128; k0 += 64) { \
            SEL_LOAD(bufb, k0 + 32); SEL_GRP(L_, bufa, 0, k0); SEL_GRP(L_, bufa, 16, k0 + 16); \
            SEL_LOAD(bufa, (k0 + 64) & 127); SEL_GRP(L_, bufb, 0, k0 + 32); SEL_GRP(L_, bufb, 16, k0 + 48); } } while (0)
        SEL_HALF(la, 0);
        SEL_HALF(lb, 128);
#undef SEL_LOAD
#undef SEL_GRP
#undef SEL_HALF
        float va[16], vb[16];
#pragma unroll
        for (int k = 0; k < 16; ++k) {
            va[k] = fkey_inv(la[k] & ~127u); vb[k] = fkey_inv(lb[k] & ~127u);
            ib[k * NTHREADS + F.tid] = (unsigned char)(127u - (la[k] & 127u));
            ib[(16 + k) * NTHREADS + F.tid] = (unsigned char)(127u - (lb[k] & 127u));
        }
        unsigned lc[16];
#pragma unroll
        for (int k = 0; k < 16; ++k) lc[k] = 0u;
#pragma unroll
        for (int a = 0; a < 16; ++a)
#pragma unroll
            for (int b = 0; b < 16; ++b)
                if ((a + 1) * (b + 1) <= 16) { const unsigned key = (fkey(va[a] + vb[b]) & ~255u) | (unsigned)(255 - (a * 16 + b)); INSERT16(lc, key); }
        float e[16], sum = 0.f; const float v0 = fkey_inv(lc[0] & ~255u);
#pragma unroll
        for (int k = 0; k < 16; ++k) { e[k] = __expf(fkey_inv(lc[k] & ~255u) - v0); sum += e[k]; }
        const float inv = 1.0f / sum;
        asm volatile("s_waitcnt lgkmcnt(0)" ::: "memory");
        unsigned exs[16]; float gws[16], sus[16];
#pragma unroll
        for (int k = 0; k < 16; ++k) {
            const unsigned pos = 255u - (lc[k] & 255u), a = pos >> 4, b = pos & 15u;
            const unsigned ea = ib[a * NTHREADS + F.tid], eb = ib[(16 + b) * NTHREADS + F.tid];
            exs[k] = ea * 128u + eb;
        }
#pragma unroll
        for (int k = 0; k < 16; ++k) { gws[k] = e[k] * inv * TSC[NEXP + exs[k]]; sus[k] = TSC[exs[k]]; }
        { const size_t o = (size_t)tok * 128 + head * 16;
#pragma unroll
          for (int q = 0; q < 2; ++q) { u32x4 w;
#pragma unroll
              for (int j = 0; j < 4; ++j) w[j] = exs[8 * q + 2 * j] | (exs[8 * q + 2 * j + 1] << 16);
              *(u32x4*)(IDX + o + 8 * q) = w; }
#pragma unroll
          for (int q = 0; q < 4; ++q) { *(f32x4*)(GW + o + 4 * q) = (f32x4){gws[4 * q], gws[4 * q + 1], gws[4 * q + 2], gws[4 * q + 3]};
                                        *(f32x4*)(SU + o + 4 * q) = (f32x4){sus[4 * q], sus[4 * q + 1], sus[4 * q + 2], sus[4 * q + 3]}; } }
        asm volatile("s_waitcnt lgkmcnt(0)" ::: "memory");
    }
}

DI float dpp_xor1(float v) { return __builtin_bit_cast(float, __builtin_amdgcn_mov_dpp(__builtin_bit_cast(int, v), 0xB1, 0xF, 0xF, true)); }
DI float dpp_xor2(float v) { return __builtin_bit_cast(float, __builtin_amdgcn_mov_dpp(__builtin_bit_cast(int, v), 0x4E, 0xF, 0xF, true)); }
DI float dpp_hmir(float v) { return __builtin_bit_cast(float, __builtin_amdgcn_mov_dpp(__builtin_bit_cast(int, v), 0x141, 0xF, 0xF, true)); }
DI float dot16_fp8(const u32x4 q, const float (&hx)[16]) {
    f32x2 a = {0.f, 0.f};
#pragma unroll
    for (int j = 0; j < 4; ++j) {
        const f32x2 lo = __builtin_amdgcn_cvt_pk_f32_fp8((int)q[j], false), hi = __builtin_amdgcn_cvt_pk_f32_fp8((int)q[j], true);
        a += lo * (f32x2){hx[4 * j], hx[4 * j + 1]}; a += hi * (f32x2){hx[4 * j + 2], hx[4 * j + 3]};
    }
    return a.x + a.y;
}
#define PEER_EXPERT(id, i) ((int)(((id)[(i) >> 3][((i) >> 1) & 3] >> (16 * ((i) & 1))) & 0xffffu))

DI int dpp_xor1i(int v) { return __builtin_amdgcn_mov_dpp(v, 0xB1, 0xF, 0xF, true); }
DI int dpp_xor2i(int v) { return __builtin_amdgcn_mov_dpp(v, 0x4E, 0xF, 0xF, true); }
DI int dpp_hmiri(int v) { return __builtin_amdgcn_mov_dpp(v, 0x141, 0xF, 0xF, true); }
struct PeerURows { u32x4 q[16]; u32x4 h; };
DI void peer_u_rows(PeerURows& R, const u32x4 (&id)[2], const unsigned char* ut, const unsigned char* hrow) {
    R.h = *(const u32x4*)(hrow);
#pragma unroll
    for (int i = 0; i < 16; ++i) R.q[i] = *(const u32x4*)(ut + (size_t)PEER_EXPERT(id, i) * D);
}
DI void peer_u_compute(const PeerURows& R, bf16_t* part, int lane) {
    int d[16];
#pragma unroll
    for (int i = 0; i < 16; ++i) { int a = 0;
#pragma unroll
        for (int j = 0; j < 4; ++j) a = __builtin_amdgcn_sdot4((int)R.q[i][j], (int)R.h[j], a, false);
        d[i] = a; }
    const bool b2 = (lane & 4) != 0, b1 = (lane & 2) != 0, b0 = (lane & 1) != 0;
    int k8[8];
#pragma unroll
    for (int i = 0; i < 8; ++i) { const int keep = b2 ? d[8 + i] : d[i], send = b2 ? d[i] : d[8 + i]; k8[i] = keep + dpp_hmiri(send); }
    int k4[4];
#pragma unroll
    for (int i = 0; i < 4; ++i) { const int keep = b1 ? k8[4 + i] : k8[i], send = b1 ? k8[i] : k8[4 + i]; k4[i] = keep + dpp_xor2i(send); }
    f32x2 k2;
    { const int keep0 = b0 ? k4[2] : k4[0], send0 = b0 ? k4[0] : k4[2], keep1 = b0 ? k4[3] : k4[1], send1 = b0 ? k4[1] : k4[3];
      k2.x = (float)(keep0 + dpp_xor1i(send0)); k2.y = (float)(keep1 + dpp_xor1i(send1)); }
    *(unsigned*)(part + 16 * (lane >> 3) + (b2 ? 8 : 0) + (b1 ? 4 : 0) + (b0 ? 2 : 0)) = pk2(k2.x, k2.y);
}
DI void phase_peer_u(const Params& p, const Frame& F, int l) {
    const int ntok = (l == 0) ? T : TL, lane = F.lane;
    const int slice = F.bid & 7, sw = (F.bid >> 3) * NWAVES + F.wave, nsw = (F.nb >> 3) * NWAVES;
    const unsigned char* ut = p.ws + WS_UTAB + (size_t)l * NEXP * D + 128 * slice + 16 * (lane & 7);
    const unsigned char* Hs = p.ws + WS_H8 + 128 * slice + 16 * (lane & 7);
    const unsigned short* IDXg = (const unsigned short*)(p.ws + WS_IDX) + 16 * (lane >> 3);
    bf16_t* PART = (bf16_t*)(p.ws + WS_ST) + (size_t)slice * T * 128;
    const int last = ntok - 1;
    u32x4 sa[2], sb[2]; PeerURows ra, rb;
#define U_SEL(S_, t_) do { const unsigned short* ip_ = IDXg + (size_t)min((t_), last) * 128; S_[0] = *(const u32x4*)ip_; S_[1] = *(const u32x4*)(ip_ + 8); } while (0)
#define U_ROWS(R_, S_, t_) peer_u_rows(R_, S_, ut, Hs + (size_t)min((t_), last) * D)
    U_SEL(sa, sw); U_SEL(sb, sw + nsw);
    U_ROWS(ra, sa, sw);
#pragma unroll 1
    for (int tok = sw; tok < ntok; tok += 2 * nsw) {
        U_SEL(sa, tok + 2 * nsw); U_ROWS(rb, sb, tok + nsw);
        peer_u_compute(ra, PART + (size_t)tok * 128, lane);
        U_SEL(sb, tok + 3 * nsw); U_ROWS(ra, sa, tok + 2 * nsw);
        if (tok + nsw < ntok) peer_u_compute(rb, PART + (size_t)(tok + nsw) * 128, lane);
    }
#undef U_SEL
#undef U_ROWS
}
DI void phase_peer_c(const Params& p, const Frame& F, int l, bool dummy = false) {
    const int ntok = (l == 0) ? T : TL;
    const bf16_t* PART = (const bf16_t*)(p.ws + WS_ST);
    float* GW = (float*)(p.ws + WS_GW);
    float* CO = dummy ? (float*)(p.ws + WS_H8) : GW;
    const float* SU = (const float*)(p.ws + WS_SU);
    const float* HS = (const float*)(p.ws + WS_HS);
    for (int i0 = F.gtid; i0 < ntok * 128; i0 += 4 * F.ngt) {
        float s[4], gw[4], su[4];
#pragma unroll
        for (int u = 0; u < 4; ++u) {
            const int i = min(i0 + u * F.ngt, ntok * 128 - 1);
            s[u] = 0.f;
#pragma unroll
            for (int sl = 0; sl < 8; ++sl) s[u] += bf2f(PART[(size_t)sl * T * 128 + i]);
            gw[u] = GW[i]; su[u] = SU[i] * HS[i >> 7];
        }
#pragma unroll
        for (int u = 0; u < 4; ++u) { const int i = i0 + u * F.ngt; if (i < ntok * 128) CO[i] = gw[u] * gelu_tanh(s[u] * su[u]); }
    }
}
struct PeerVRows { u32x4 q[16]; f32x4 cf[4]; f32x2 xv, gv; };
DI void peer_v_rows(PeerVRows& R, const u32x4 (&id)[2], const unsigned char* vt, const float* cp, const float* xs, const float* gt2) {
    R.cf[0] = *(const f32x4*)cp; R.cf[1] = *(const f32x4*)(cp + 4); R.cf[2] = *(const f32x4*)(cp + 8); R.cf[3] = *(const f32x4*)(cp + 12);
    R.xv = *(const f32x2*)xs; R.gv = *(const f32x2*)gt2;
#pragma unroll
    for (int i = 0; i < 16; ++i) R.q[i] = *(const u32x4*)(vt + (size_t)PEER_EXPERT(id, i) * D);
}
DI float xchg32(float v, bool hi) { const auto r = __builtin_amdgcn_permlane32_swap(__builtin_bit_cast(unsigned, v), __builtin_bit_cast(unsigned, v), false, false);
    return __builtin_bit_cast(float, hi ? r[0] : r[1]); }
DI float xchg16(float v, bool hi) { const auto r = __builtin_amdgcn_permlane16_swap(__builtin_bit_cast(unsigned, v), __builtin_bit_cast(unsigned, v), false, false);
    return __builtin_bit_cast(float, hi ? r[0] : r[1]); }
DI float xchg8(float v) { return __builtin_bit_cast(float, __builtin_amdgcn_mov_dpp(__builtin_bit_cast(int, v), 0x128, 0xF, 0xF, true)); }
DI void peer_v_compute(const PeerVRows& R, float* xdst, int lane) {
    f32x2 a[8];
#pragma unroll
    for (int j = 0; j < 8; ++j) a[j] = (f32x2){0.f, 0.f};
#pragma unroll
    for (int i = 0; i < 16; ++i) {
        const float c = R.cf[i >> 2][i & 3]; const f32x2 c2 = {c, c};
#pragma unroll
        for (int j = 0; j < 4; ++j) {
            a[2 * j] += c2 * __builtin_amdgcn_cvt_pk_f32_fp8((int)R.q[i][j], false);
            a[2 * j + 1] += c2 * __builtin_amdgcn_cvt_pk_f32_fp8((int)R.q[i][j], true);
        }
    }
    const bool b5 = (lane & 32) != 0, b4 = (lane & 16) != 0, b3 = (lane & 8) != 0;
    f32x2 k4[4];
#pragma unroll
    for (int j = 0; j < 4; ++j) { const f32x2 keep = b5 ? a[4 + j] : a[j], send = b5 ? a[j] : a[4 + j];
        k4[j] = keep + (f32x2){xchg32(send.x, b5), xchg32(send.y, b5)}; }
    f32x2 k2[2];
#pragma unroll
    for (int j = 0; j < 2; ++j) { const f32x2 keep = b4 ? k4[2 + j] : k4[j], send = b4 ? k4[j] : k4[2 + j];
        k2[j] = keep + (f32x2){xchg16(send.x, b4), xchg16(send.y, b4)}; }
    f32x2 k1;
    { const f32x2 keep = b3 ? k2[1] : k2[0], send = b3 ? k2[0] : k2[1];
        k1 = keep + (f32x2){xchg8(send.x), xchg8(send.y)}; }
    *(f32x2*)xdst = R.xv + R.gv * k1;
}
DI void phase_peer_v(const Params& p, const Frame& F, int l, bool dummy = false) {
    const int ntok = (l == 0) ? T : TL, lane = F.lane;
    const int slice = F.bid & 7, sw = (F.bid >> 3) * NWAVES + F.wave, nsw = (F.nb >> 3) * NWAVES;
    const unsigned char* vt = p.ws + WS_VTAB + (size_t)l * NEXP * D + 128 * slice + 16 * (lane & 7);
    const unsigned short* IDXg = (const unsigned short*)(p.ws + WS_IDX) + 16 * (lane >> 3);
    const float* CFg = (const float*)(p.ws + WS_GW) + 16 * (lane >> 3);
    const int last = ntok - 1;
    u32x4 sa[2], sb[2]; PeerVRows ra, rb;
#define V_SEL(S_, t_) do { const unsigned short* ip_ = IDXg + (size_t)min((t_), last) * 128; S_[0] = *(const u32x4*)ip_; S_[1] = *(const u32x4*)(ip_ + 8); } while (0)
    const int co = 128 * slice + 16 * (lane & 7) + ((lane & 32) ? 8 : 0) + ((lane & 16) ? 4 : 0) + ((lane & 8) ? 2 : 0);
#define V_ROWS(R_, S_, t_) do { const int t1_ = min((t_), last); peer_v_rows(R_, S_, vt, CFg + (size_t)t1_ * 128, xrow_ptr(p, t1_) + co, mod_vec(p, l, t1_, 5) + co); } while (0)
#define V_DO(R_, t_) do { const int t2_ = (t_); float* xd_ = (dummy ? (float*)(p.ws + WS_ST) + (size_t)t2_ * D : xrow_ptr(p, t2_)) + co; peer_v_compute(R_, xd_, lane); } while (0)
    V_SEL(sa, sw); V_SEL(sb, sw + nsw);
    V_ROWS(ra, sa, sw);
#pragma unroll 1
    for (int tok = sw; tok < ntok; tok += 2 * nsw) {
        V_SEL(sa, tok + 2 * nsw); V_ROWS(rb, sb, tok + nsw);
        V_DO(ra, tok);
        V_SEL(sb, tok + 3 * nsw); V_ROWS(ra, sa, tok + 2 * nsw);
        if (tok + nsw < ntok) V_DO(rb, tok + nsw);
    }
#undef V_SEL
#undef V_ROWS
#undef V_DO
}

#define XB_TMO      128
#define XB_XCNT(j)  (256  + 64 * (j))
#define XB_XSUB(j)  (1280 + 64 * (j))
#define XB_XGEN(j)  (2304 + 64 * (j))
#define XB_TOP      3328
#define XB_TOPGEN   3392
#define XCD_BAR_WORDS 3456
#define XB_SPIN_CAP (1u << 18)
DI unsigned xb_ld(unsigned* p)              { return __hip_atomic_load(p, __ATOMIC_RELAXED, __HIP_MEMORY_SCOPE_AGENT); }
DI unsigned xb_add(unsigned* p, unsigned v) { return __hip_atomic_fetch_add(p, v, __ATOMIC_RELAXED, __HIP_MEMORY_SCOPE_AGENT); }
DI unsigned xb_xcc_id() { return (unsigned)__builtin_amdgcn_s_getreg((3 << 11) | 20) & 0xFu; }
#define XB_SPIN(cond, bar) do { unsigned _sp = 0; while (cond) { __builtin_amdgcn_s_sleep(1); \
    if ((++_sp & 255u) == 0u) { if (xb_ld(&(bar)[XB_TMO])) break; if (_sp > XB_SPIN_CAP) { atomicAdd(&(bar)[XB_TMO], 1u); break; } } } } while (0)
struct XcdBarrier { unsigned* bar; unsigned x; volatile LAS unsigned* st; };
DI XcdBarrier xcd_barrier_post(unsigned* bar, volatile LAS unsigned* st) {
    XcdBarrier b; b.bar = bar; b.x = xb_xcc_id(); b.st = st;
    if (threadIdx.x == 0) (void)xb_add(&bar[XB_XCNT(b.x)], 1u);
    return b;
}
DI void xcd_barrier_complete(unsigned* bar, unsigned x, unsigned& nloc, unsigned& nx) {
    const unsigned G = gridDim.x * gridDim.y * gridDim.z;
    unsigned sum, cnt, mine, sp = 0u;
    for (;;) {
        sum = 0u; cnt = 0u; mine = 0u;
#pragma unroll
        for (unsigned j = 0; j < 16; ++j) { const unsigned c = xb_ld(&bar[XB_XCNT(j)]); sum += c; cnt += (c > 0u) ? 1u : 0u; mine = (j == x) ? c : mine; }
        if (sum == G) break;
        __builtin_amdgcn_s_sleep(1);
        if ((++sp & 255u) == 0u) { if (xb_ld(&bar[XB_TMO])) break; if (sp > XB_SPIN_CAP) { atomicAdd(&bar[XB_TMO], 1u); break; } }
    }
    nloc = mine > 0u ? mine : 1u; nx = cnt > 0u ? cnt : 1u;
}
DI void xcd_barrier(const XcdBarrier& b) {
    asm volatile("s_waitcnt vmcnt(0)" ::: "memory");
    __syncthreads();
    if (threadIdx.x == 0) {
        unsigned* bar = b.bar;
        __builtin_amdgcn_s_waitcnt(0);
        unsigned nloc = b.st[0], nx = b.st[1];
        if (nloc == 0u) { xcd_barrier_complete(bar, b.x, nloc, nx); b.st[0] = nloc; b.st[1] = nx; }
        const unsigned old = xb_add(&bar[XB_XSUB(b.x)], 1u);
        const unsigned gen = old / nloc;
        if (old + 1u == (gen + 1u) * nloc) {
            __builtin_amdgcn_fence(__ATOMIC_RELEASE, "agent");
            asm volatile("s_waitcnt vmcnt(0)" ::: "memory");
            const unsigned og = xb_add(&bar[XB_TOP], 1u);
            const unsigned tg = og / nx;
            if (og + 1u == (tg + 1u) * nx) xb_add(&bar[XB_TOPGEN], 1u);
            else XB_SPIN(xb_ld(&bar[XB_TOPGEN]) == tg, bar);
            __builtin_amdgcn_fence(__ATOMIC_ACQUIRE, "agent");
            xb_add(&bar[XB_XGEN(b.x)], 1u);
            asm volatile("s_waitcnt vmcnt(0)" ::: "memory");
        } else {
            XB_SPIN(xb_ld(&bar[XB_XGEN(b.x)]) == gen, bar);
            __builtin_amdgcn_fence(__ATOMIC_ACQUIRE, "agent");
            asm volatile("s_waitcnt vmcnt(0)" ::: "memory");
        }
    }
    __syncthreads();
}

constexpr int NPHASE = 25;
template <int PH> DI void run_phase(const Params& p, const Frame& F) {
    if constexpr (PH == 0) phase_prep(p, F);
    else if constexpr (PH == 1) phase_norm(p, F, 0, 0, true, T);
    else if constexpr (PH == 2) phase_g1(p, F, 0);
    else if constexpr (PH == 3) phase_mix(p, F, 0);
    else if constexpr (PH == 4) phase_g2(p, F, 0);
    else if constexpr (PH == 5) phase_g2sum(p, F);
    else if constexpr (PH == 6) phase_g3(p, F, 0);
    else if constexpr (PH == 7) phase_norm(p, F, 0, 1, false, T);
    else if constexpr (PH == 8) phase_g45(p, F, 0);
    else if constexpr (PH == 9) phase_sel(p, F, 0);
    else if constexpr (PH == 10) phase_peer_u(p, F, 0);
    else if constexpr (PH == 11) phase_peer_c(p, F, 0);
    else if constexpr (PH == 12) phase_peer_v(p, F, 0);
    else if constexpr (PH == 13) phase_norm(p, F, 1, 0, false, T);
    else if constexpr (PH == 14) phase_g1(p, F, 1);
    else if constexpr (PH == 15) phase_mix(p, F, 1);
    else if constexpr (PH == 16) phase_g2(p, F, 1);
    else if constexpr (PH == 17) phase_g3(p, F, 1);
    else if constexpr (PH == 18) phase_norm(p, F, 1, 1, false, TL);
    else if constexpr (PH == 19) phase_g45(p, F, 1);
    else if constexpr (PH == 20) phase_sel(p, F, 1);
    else if constexpr (PH == 21) phase_peer_u(p, F, 1);
    else if constexpr (PH == 22) phase_peer_c(p, F, 1);
    else if constexpr (PH == 23) phase_peer_v(p, F, 1);
    else if constexpr (PH == 24) phase_final(p, F);
}
DI Frame make_frame(unsigned char* lds_raw) {
    Frame F;
    F.lds = (LAS unsigned char*)lds_raw;
    int tid = threadIdx.x; asm volatile("" : "+v"(tid));
    int bid = blockIdx.x, nb = gridDim.x; asm volatile("" : "+s"(bid), "+s"(nb));
    F.tid = tid; F.lane = tid & 63; F.wave = __builtin_amdgcn_readfirstlane(tid >> 6); F.bid = bid; F.nb = nb;
    F.gw = bid * NWAVES + F.wave; F.ngw = nb * NWAVES; F.gtid = bid * NTHREADS + tid; F.ngt = nb * NTHREADS;
    return F;
}
template <int PH> DI void run_phase_fresh(unsigned char* lds_raw) {
#if defined(__HIP_DEVICE_COMPILE__)
    const __attribute__((address_space(4))) unsigned long long* pp = (const __attribute__((address_space(4))) unsigned long long*)__builtin_amdgcn_kernarg_segment_ptr();
    asm volatile("" : "+s"(pp));
    Params p;
#pragma unroll
    for (int i = 0; i < N_IN; ++i) p.in[i] = (const float*)(const __attribute__((address_space(1))) float*)pp[i];
    p.out = (float*)(__attribute__((address_space(1))) float*)pp[N_IN]; p.ws = (unsigned char*)(__attribute__((address_space(1))) unsigned char*)pp[N_IN + 1]; p.ph_lo = 0; p.ph_hi = 0;
#else
    Params p{};
#endif
    const Frame F = make_frame(lds_raw);
    run_phase<PH>(p, F);
}
template <int PH> __global__ void __launch_bounds__(NTHREADS, 2) phase_kernel(Params p) {
    extern __shared__ __attribute__((aligned(16))) unsigned char lds_raw[];
    run_phase_fresh<PH>(lds_raw);
}
template <int PH> DI void run_all(unsigned char* lds_raw, cg::grid_group& grid, const XcdBarrier& bar) {
    if constexpr (PH < NPHASE) {
        if constexpr (PH == PROBE_PH) {
            if constexpr (PH == 11 || PH == 22 || PH == 12 || PH == 23) {
#if defined(__HIP_DEVICE_COMPILE__)
                const __attribute__((address_space(4))) unsigned long long* pp = (const __attribute__((address_space(4))) unsigned long long*)__builtin_amdgcn_kernarg_segment_ptr();
                asm volatile("" : "+s"(pp));
                Params p;
#pragma unroll
                for (int i = 0; i < N_IN; ++i) p.in[i] = (const float*)(const __attribute__((address_space(1))) float*)pp[i];
                p.out = (float*)(__attribute__((address_space(1))) float*)pp[N_IN]; p.ws = (unsigned char*)(__attribute__((address_space(1))) unsigned char*)pp[N_IN + 1]; p.ph_lo = 0; p.ph_hi = 0;
                const Frame F = make_frame(lds_raw);
                if constexpr (PH == 11 || PH == 22) phase_peer_c(p, F, PH == 11 ? 0 : 1, true); else phase_peer_v(p, F, PH == 12 ? 0 : 1, true);
#endif
            } else run_phase_fresh<PH>(lds_raw);
            xcd_barrier(bar);
        }
        run_phase_fresh<PH>(lds_raw);
        if constexpr (PH + 1 < NPHASE) { xcd_barrier(bar); if constexpr (PROBE_SYNC) xcd_barrier(bar); }
        run_all<PH + 1>(lds_raw, grid, bar);
    }
}
__global__ void __launch_bounds__(NTHREADS, 2) mega(Params p) {
    extern __shared__ __attribute__((aligned(16))) unsigned char lds_raw[];
    cg::grid_group grid = cg::this_grid();
    volatile LAS unsigned* st = (volatile LAS unsigned*)((LAS unsigned char*)lds_raw + LDS_BAR_OFF);
    if (threadIdx.x < 2) st[threadIdx.x] = 0u;
    __syncthreads();
    const XcdBarrier bar = xcd_barrier_post((unsigned*)(p.ws + WS_CTL), st);
    if (p.ph_lo != 0) grid.sync();
    run_all<0>(lds_raw, grid, bar);
}

extern "C" void kernel_launch(void* const* d_in, const int* in_sizes, int n_in, void* d_out, int out_size, void* d_ws, size_t ws_size, hipStream_t stream) {
    static int grid = 0;
    if (grid == 0) {
        if (n_in != 23 || out_size != TL * D || ws_size < WS_END) { fprintf(stderr, "kernel_launch: unexpected shapes (n_in %d out %d ws %zu)\n", n_in, out_size, ws_size); grid = -1; return; }
        int dev = 0, cus = 0, per_cu = 0;
        (void)hipGetDevice(&dev);
        (void)hipDeviceGetAttribute(&cus, hipDeviceAttributeMultiprocessorCount, dev);
        (void)hipFuncSetAttribute((const void*)mega, hipFuncAttributeMaxDynamicSharedMemorySize, LDS_BYTES);
        (void)hipOccupancyMaxActiveBlocksPerMultiprocessor(&per_cu, (const void*)mega, NTHREADS, LDS_BYTES);
        if (per_cu < 1) { fprintf(stderr, "kernel_launch: occupancy query reports %d blocks per CU\n", per_cu); grid = -1; return; }
        grid = cus & ~7;
        if (grid < 8) { fprintf(stderr, "kernel_launch: needs at least 8 CUs\n"); grid = -1; return; }
    }
    if (grid < 0) return;
    (void)hipMemsetAsync((char*)d_ws + WS_CTL, 0, CTL_ZERO_BYTES, stream);
    Params p{};
    for (int i = 0; i < N_IN; ++i) p.in[i] = (const float*)d_in[i];
    p.out = (float*)d_out; p.ws = (unsigned char*)d_ws;
    void* args[] = {&p};
    hipError_t e = hipLaunchCooperativeKernel((const void*)mega, dim3(grid), dim3(NTHREADS), args, LDS_BYTES, stream);
    if (e != hipSuccess) fprintf(stderr, "cooperative launch failed: %s (grid %d)\n", hipGetErrorString(e), grid);
}
```

```cpp
#include <hip/hip_runtime.h>
#include <hip/hip_cooperative_groups.h>
#include <stdint.h>
#include <stdio.h>
namespace cg = cooperative_groups;

#ifndef PROBE_PH
#define PROBE_PH -1
#endif
#ifndef PROBE_SYNC
#define PROBE_SYNC 0
#endif
#ifndef MK_SINGLE
#define MK_SINGLE 0
#endif

#define LAS __attribute__((address_space(3)))
typedef unsigned short bf16_t;
typedef short bf16x8 __attribute__((ext_vector_type(8)));
typedef short s16x4 __attribute__((ext_vector_type(4)));
typedef float f32x4 __attribute__((ext_vector_type(4)));
typedef float f32x2 __attribute__((ext_vector_type(2)));
typedef float f32x16 __attribute__((ext_vector_type(16)));
typedef unsigned u32x4 __attribute__((ext_vector_type(4)));
typedef unsigned u32x2 __attribute__((ext_vector_type(2)));
typedef __bf16 bf16x2_t __attribute__((ext_vector_type(2)));
typedef _Float16 f16x2_t __attribute__((ext_vector_type(2)));
#define DI __device__ __forceinline__
DI unsigned pkh2(float lo, float hi) { f16x2_t v = {(_Float16)lo, (_Float16)hi}; return __builtin_bit_cast(unsigned, v); }
#define MFMA32(a, b, c) __builtin_amdgcn_mfma_f32_32x32x16_bf16((a), (b), (c), 0, 0, 0)

constexpr int D = 1024, NB = 8, SEQ = 4096, NCTX = 256, DEPTH = 2;
constexpr int TL = NB * SEQ, TC = NB * NCTX, T = TL + TC;
constexpr int INW = 4608, NMOD = 6 * D, PW = 1600, PN = 1536;
constexpr int VTS = SEQ + 64;
constexpr int QOFF = 0, KOFF = 512, VOFF = 640, POOLOFF = 768, SUOFF = 1024, SVOFF = 1280, GATEOFF = 1536;
constexpr int NEXP = 16384;
constexpr float EPS = 1e-6f;
constexpr float LOG2E = 1.4426950408889634f;
constexpr float QSCALE = 0.125f * LOG2E;

constexpr size_t MiB = 1u << 20;
constexpr size_t WS_CTL = 0, WS_MOD = 1 * MiB, CTL_ZERO_BYTES = 2 * MiB;
constexpr size_t WS_ROPE = 2 * MiB, WS_SGUW = 2 * MiB + 65536, WS_TSCALE = 3 * MiB;
constexpr size_t WS_WIN = 4 * MiB, WS_WBR = 22 * MiB, WS_WOUT = 26 * MiB, WS_WFOLD = 30 * MiB;
constexpr size_t WS_XCTX = 38 * MiB, WS_UTAB = 46 * MiB, WS_VTAB = 78 * MiB;
constexpr size_t WS_IDX = 110 * MiB, WS_GW = 120 * MiB;
constexpr size_t WS_H = 142 * MiB;
constexpr size_t WS_P = 210 * MiB, WS_Y = 318 * MiB, WS_MERGED = 386 * MiB, WS_VT = 454 * MiB, WS_VTC = 463 * MiB, WS_VST = 464 * MiB;
constexpr size_t WS_MP = 482 * MiB;
constexpr size_t WS_ST = 210 * MiB, WS_H8 = 346 * MiB, WS_HS = 380 * MiB, WS_SU = 482 * MiB;
constexpr size_t WS_END = 512 * MiB;
static_assert(WS_ST + (size_t)2048 * T * 2 <= WS_H8 && WS_H8 + (size_t)T * D <= WS_HS, "ST / H8 fit");
static_assert(WS_VST + (size_t)272 * 256 * 128 * 2 <= WS_SU && WS_VT + (size_t)NB * 2 * 64 * VTS * 2 <= WS_VTC, "VsT / VT fit");
static_assert(WS_H + (size_t)T * D * 2 <= WS_P, "H fits");
static_assert(WS_P + (size_t)T * PW * 2 <= WS_Y && WS_Y + (size_t)T * D * 2 <= WS_MERGED && WS_MERGED + (size_t)T * D * 2 <= WS_VT, "P/Y/MERGED fit");
static_assert(WS_IDX + (size_t)T * 128 * 2 <= WS_GW && WS_GW + (size_t)T * 128 * 4 <= WS_H && WS_SU + (size_t)T * 128 * 4 <= WS_END && WS_HS + (size_t)T * 4 <= WS_SU, "idx/gw/su fit");

constexpr int LDS_BYTES = 163840;
constexpr int LDS_BAR_OFF = LDS_BYTES - 64;
constexpr int NTHREADS = 512, NWAVES = 8;

enum { I_x, I_c, I_ctx, I_c_ctx, I_w_mod, I_b_mod, I_g_mix, I_g_ffn, I_w_in, I_attn_sink, I_pool_w, I_pool_scale, I_sgu_w, I_sgu_b, I_w_br_attn, I_w_br_pool, I_w_br_sgu, I_w_out, I_peer_wq, I_peer_subkeys, I_peer_u, I_peer_v, I_g_final, N_IN };
struct Params {
    const float* in[N_IN];
    float* out; unsigned char* ws;
    int ph_lo, ph_hi;
};

DI unsigned pk2(float lo, float hi) { f32x2 v = {lo, hi}; return __builtin_bit_cast(unsigned, __builtin_convertvector(v, bf16x2_t)); }
DI unsigned f2bf(float f) { return pk2(f, 0.f) & 0xffffu; }
DI float bf2f(unsigned short u) { return __builtin_bit_cast(float, (unsigned)u << 16); }
DI float bflo(unsigned w) { return __builtin_bit_cast(float, w << 16); }
DI float bfhi(unsigned w) { return __builtin_bit_cast(float, w & 0xffff0000u); }
DI int crow(int reg, int h) { return (reg & 3) + 8 * (reg >> 2) + 4 * h; }
DI float wave_sum(float v) {
#pragma unroll
    for (int o = 1; o < 64; o <<= 1) v += __shfl_xor(v, o);
    return v;
}
DI float sigmoidf_(float x) { return __builtin_amdgcn_rcpf(1.0f + __expf(-x)); }
DI float gelu_tanh(float x) { const float u = 0.7978845608028654f * (x + 0.044715f * x * x * x); return x * __builtin_amdgcn_rcpf(1.0f + __expf(-2.0f * u)); }
DI float silu_(float x) { return x * __builtin_amdgcn_rcpf(1.0f + __expf(-x)); }

struct Frame {
    int tid, lane, wave, gw, ngw, gtid, ngt, bid, nb;
    LAS unsigned char* lds;
};

template <int NM, int NN>
DI void wave_gemm(const bf16_t* __restrict__ A, int lda, const bf16_t* __restrict__ Bt, int ldb, int K, int m0, int n0, f32x16 (&acc)[NM][NN], int lane) {
    const int r = lane & 31, h = lane >> 5;
    const bf16_t* ap = A + (size_t)(m0 + r) * lda + 8 * h;
    const bf16_t* bp = Bt + (size_t)(n0 + r) * ldb + 8 * h;
    for (int k0 = 0; k0 < K; k0 += 64) {
        bf16x8 a[4][NM], b[4][NN];
#pragma unroll
        for (int s = 0; s < 4; ++s) {
#pragma unroll
            for (int i = 0; i < NM; ++i) a[s][i] = *(const bf16x8*)(ap + (size_t)(32 * i) * lda + k0 + 16 * s);
#pragma unroll
            for (int j = 0; j < NN; ++j) b[s][j] = *(const bf16x8*)(bp + (size_t)(32 * j) * ldb + k0 + 16 * s);
        }
#pragma unroll
        for (int s = 0; s < 4; ++s)
#pragma unroll
            for (int i = 0; i < NM; ++i)
#pragma unroll
                for (int j = 0; j < NN; ++j) acc[i][j] = MFMA32(a[s][i], b[s][j], acc[i][j]);
    }
}
template <int NM, int NN> DI void zero_acc(f32x16 (&acc)[NM][NN]) {
#pragma unroll
    for (int i = 0; i < NM; ++i)
#pragma unroll
        for (int j = 0; j < NN; ++j)
#pragma unroll
            for (int r = 0; r < 16; ++r) acc[i][j][r] = 0.f;
}

namespace pg8 {
constexpr int BM = 256, BK = 64, HALF = 128, HTB = HALF * BK * 2, STAGE_BYTES = 8 * HTB, NXCD = 8, WGM = 8, LD = 1024;
DI int lds_byte(int r, int c) { const int st = (r >> 4) * 2 + (c >> 5), rr = r & 15, cc = c & 31, ob = rr * 64 + cc * 2; return st * 1024 + (ob ^ (((ob >> 9) & 1) << 5)); }
DI void stage_rc(int b, int& R, int& C) { const int st = b / 1024, sb = b % 1024, swz = sb ^ (((sb >> 9) & 1) << 5); R = (st >> 1) * 16 + swz / 64; C = (st & 1) * 32 + (swz % 64) / 2; }
DI int perm32(int rho) { const int n = rho >> 4, i = rho & 15; return 8 * (i >> 2) + 4 * n + (i & 3); }
struct Unit { int pm, pn, sub, nt, mode; const char* a; const char* b; };
DI void tile_of(int L, int nM, int nN, int& pm, int& pn) {
    const int nwg = nM * nN; int wgid = L;
    { const int q = nwg / NXCD, r = nwg % NXCD, xcd = wgid % NXCD, off = wgid / NXCD; wgid = (xcd < r ? xcd * (q + 1) : r * (q + 1) + (xcd - r) * q) + off; }
    const int nig = WGM * nN, gid = wgid / nig, fm = gid * WGM, gsz = (nM - fm) < WGM ? (nM - fm) : WGM;
    pm = fm + ((wgid % nig) % gsz); pn = (wgid % nig) / gsz;
}
template <class Epi, class Sched>
DI void gemm_phase(LAS unsigned char* lds, const int tid, const Sched& S, const Epi& E) {
    const int wid = __builtin_amdgcn_readfirstlane(tid >> 6), lane = tid & 63, wr = wid >> 2, wc = wid & 3, fr = lane & 15, fq = lane >> 4;
    unsigned voffA[2], voffB[2];
#pragma unroll
    for (int i = 0; i < 2; ++i) { int R, C; stage_rc(tid * 16 + i * 8192, R, C); const int Rb = Epi::PERM ? ((R & ~31) + perm32(R & 31)) : R;
        voffA[i] = (unsigned)(R * LD + C) * 2u; voffB[i] = (unsigned)(Rb * LD + C) * 2u; }
    const size_t kstep = (size_t)(BK * 2);
    const size_t hstep = (size_t)HALF * LD * 2;
    const unsigned ldsw = (unsigned)wid * 1024u;
    const int aoff = lds_byte(wr * 64 + fr, fq * 8), boff = lds_byte(wc * 32 + fr, fq * 8);
#define PG8_SA(b, h) (((b) * 2 + (h)) * HTB)
#define PG8_SB(b, h) ((4 + (b) * 2 + (h)) * HTB)
#define PG8_STAGE(bufoff, gbase, voff) do { _Pragma("unroll") for (int _i = 0; _i < 2; ++_i) \
        __builtin_amdgcn_global_load_lds((const unsigned*)((const char*)(gbase) + (voff)[_i]), (LAS unsigned*)(lds + (bufoff) + ldsw + _i * 8192), 16, 0, 0); } while (0)
#define PG8_LDA(dst, b, h) do { _Pragma("unroll") for (int m = 0; m < 4; ++m) _Pragma("unroll") for (int k = 0; k < 2; ++k) dst[m][k] = *(const LAS bf16x8*)(lds + PG8_SA(b, h) + aoff + m * 2048 + k * 1024); } while (0)
#define PG8_LDB(dst, b, h) do { _Pragma("unroll") for (int n = 0; n < 2; ++n) _Pragma("unroll") for (int k = 0; k < 2; ++k) dst[n][k] = *(const LAS bf16x8*)(lds + PG8_SB(b, h) + boff + n * 2048 + k * 1024); } while (0)
#define PG8_MMA(ai, bj, At, Bt) do { __builtin_amdgcn_s_setprio(1); _Pragma("unroll") for (int m = 0; m < 4; ++m) _Pragma("unroll") for (int n = 0; n < 2; ++n) _Pragma("unroll") for (int k = 0; k < 2; ++k) \
        acc[ai][bj][m][n] = __builtin_amdgcn_mfma_f32_16x16x32_bf16(Bt[n][k], At[m][k], acc[ai][bj][m][n], 0, 0, 0); __builtin_amdgcn_s_setprio(0); } while (0)
#define PG8_WAIT_V(n) asm volatile("s_waitcnt vmcnt(" #n ")" ::: "memory")
#define PG8_WAIT_L(n) asm volatile("s_waitcnt lgkmcnt(" #n ")" ::: "memory")
#define PG8_BAR __builtin_amdgcn_s_barrier()
#define PG8_SCHED __builtin_amdgcn_sched_barrier(0)
    Unit cur, nxt; int ui = 0;
    if (!S.next(0, cur)) return;
    f32x4 acc[2][2][4][2];
#pragma unroll
    for (int a = 0; a < 2; ++a)
#pragma unroll
        for (int b = 0; b < 2; ++b)
#pragma unroll
            for (int m = 0; m < 4; ++m)
#pragma unroll
                for (int n = 0; n < 2; ++n) acc[a][b][m][n] = (f32x4){0.f, 0.f, 0.f, 0.f};
    bf16x8 At[4][2], B0[2][2], B1[2][2];
    const char* cA = cur.a; const char* cB = cur.b;
    PG8_STAGE(PG8_SB(0, 0), cB, voffB); PG8_STAGE(PG8_SB(0, 1), cB + hstep, voffB); PG8_STAGE(PG8_SA(0, 0), cA, voffA); PG8_STAGE(PG8_SA(0, 1), cA + hstep, voffA);
    if (wr == 1) PG8_BAR;
    PG8_WAIT_V(2); PG8_BAR;
    PG8_STAGE(PG8_SB(1, 0), cB + kstep, voffB); PG8_STAGE(PG8_SA(1, 0), cA + kstep, voffA); PG8_STAGE(PG8_SB(1, 1), cB + hstep + kstep, voffB);
    PG8_WAIT_V(6); PG8_BAR;
    for (;;) {
        const bool has_next = S.next(ui + 1, nxt);
        const char* nA = has_next ? nxt.a : cA; const char* nB = has_next ? nxt.b : cB;
        const int nt = cur.nt;
        for (int t = 0; t < nt; t += 2) {
            const bool last = (t == nt - 2);
            const char* a1 = cA + (size_t)(t + 1) * kstep;
            const char* a2 = last ? nA : cA + (size_t)(t + 2) * kstep; const char* b2 = last ? nB : cB + (size_t)(t + 2) * kstep;
            const char* a3 = a2 + kstep; const char* b3 = b2 + kstep;
            PG8_LDB(B0, 0, 0); PG8_LDB(B1, 0, 1); PG8_SCHED; PG8_LDA(At, 0, 0); PG8_STAGE(PG8_SA(1, 1), a1 + hstep, voffA);
            PG8_WAIT_V(8); PG8_WAIT_L(0); PG8_BAR; PG8_MMA(0, 0, At, B0); PG8_MMA(0, 1, At, B1); PG8_BAR; PG8_SCHED;
            PG8_LDA(At, 0, 1); PG8_STAGE(PG8_SB(0, 0), b2, voffB); PG8_STAGE(PG8_SB(0, 1), b2 + hstep, voffB); PG8_STAGE(PG8_SA(0, 0), a2, voffA);
            PG8_WAIT_V(8); PG8_WAIT_L(0); PG8_BAR; PG8_MMA(1, 0, At, B0); PG8_MMA(1, 1, At, B1); PG8_BAR; PG8_SCHED;
            PG8_LDB(B0, 1, 0); PG8_LDB(B1, 1, 1); PG8_SCHED; PG8_LDA(At, 1, 0); PG8_STAGE(PG8_SA(0, 1), a2 + hstep, voffA);
            PG8_WAIT_V(8); PG8_WAIT_L(0); PG8_BAR; PG8_MMA(0, 0, At, B0); PG8_MMA(0, 1, At, B1); PG8_BAR; PG8_SCHED;
            PG8_LDA(At, 1, 1); PG8_STAGE(PG8_SB(1, 0), b3, voffB); PG8_STAGE(PG8_SB(1, 1), b3 + hstep, voffB); PG8_STAGE(PG8_SA(1, 0), a3, voffA);
            PG8_WAIT_V(8); PG8_WAIT_L(0); PG8_BAR; PG8_MMA(1, 0, At, B0); PG8_MMA(1, 1, At, B1); PG8_BAR; PG8_SCHED;
        }
        if (wr == 0) PG8_BAR;
        E(acc, cur, wr, wc, fr, fq);
        if (!has_next) break;
        if (!E.keeps(cur)) {
#pragma unroll
        for (int a = 0; a < 2; ++a)
#pragma unroll
            for (int b = 0; b < 2; ++b)
#pragma unroll
                for (int m = 0; m < 4; ++m)
#pragma unroll
                    for (int n = 0; n < 2; ++n) acc[a][b][m][n] = (f32x4){0.f, 0.f, 0.f, 0.f};
        }
        cur = nxt; cA = nA; cB = nB; ++ui;
        if (wr == 1) PG8_BAR;
    }
    PG8_WAIT_V(0);
    PG8_BAR;
#undef PG8_SA
#undef PG8_SB
#undef PG8_STAGE
#undef PG8_LDA
#undef PG8_LDB
#undef PG8_MMA
#undef PG8_WAIT_V
#undef PG8_WAIT_L
#undef PG8_BAR
#undef PG8_SCHED
}
}

DI void transpose_item(const float* W, int K, int N, bf16_t* WT, int ldd, int row_off, int col_off, LAS float* scr, int item, int lane) {
    const int nblk = N / 32, kb = item / nblk, nb = item % nblk, k0 = 64 * kb, n0 = 32 * nb;
#pragma unroll 8
    for (int i = 0; i < 32; ++i) { const int kk = 2 * i + (lane >> 5); scr[kk * 33 + (lane & 31)] = W[(size_t)(k0 + kk) * N + n0 + (lane & 31)]; }
    asm volatile("s_waitcnt lgkmcnt(0)" ::: "memory");
    const int c = lane & 7;
#pragma unroll
    for (int j = 0; j < 4; ++j) { const int n = (lane >> 3) + 8 * j; const LAS float* s = scr + (8 * c) * 33 + n;
        u32x4 o; o.x = pk2(s[0 * 33], s[1 * 33]); o.y = pk2(s[2 * 33], s[3 * 33]); o.z = pk2(s[4 * 33], s[5 * 33]); o.w = pk2(s[6 * 33], s[7 * 33]);
        *(u32x4*)(WT + (size_t)(row_off + n0 + n) * ldd + col_off + k0 + 8 * c) = o; }
    asm volatile("s_waitcnt lgkmcnt(0)" ::: "memory");
}

DI void convert_tables(const Params& p, const Frame& F) {
    for (int it0 = 4 * F.gw; it0 < 4 * NEXP; it0 += 4 * F.ngw) {
        f32x4 v[4][4];
#pragma unroll
        for (int u = 0; u < 4; ++u) {
            const int it = it0 + u, e = it & (NEXP - 1), tbl = (it >> 14) & 1, l = it >> 15;
            const f32x4* src = (const f32x4*)((tbl ? p.in[I_peer_v] : p.in[I_peer_u]) + ((size_t)l * NEXP + e) * D) + 4 * F.lane;
#pragma unroll
            for (int j = 0; j < 4; ++j) v[u][j] = src[j];
        }
#pragma unroll
        for (int u = 0; u < 4; ++u) {
            const int it = it0 + u, e = it & (NEXP - 1), tbl = (it >> 14) & 1, l = it >> 15;
            float am = 0.f;
#pragma unroll
            for (int j = 0; j < 4; ++j) am = fmaxf(am, fmaxf(fmaxf(fabsf(v[u][j].x), fabsf(v[u][j].y)), fmaxf(fabsf(v[u][j].z), fabsf(v[u][j].w))));
#pragma unroll
            for (int o = 1; o < 64; o <<= 1) am = fmaxf(am, __shfl_xor(am, o));
            const float sc = (am > 0.f) ? (tbl ? 6.0f / am : 127.0f / am) : 1.0f;
            if (tbl) {
                u32x2 q4;
#pragma unroll
                for (int d = 0; d < 2; ++d) { unsigned w = 0;
                    w = __builtin_amdgcn_cvt_scalef32_pk_fp4_f32(w, v[u][2 * d][0] * sc, v[u][2 * d][1] * sc, 1.0f, 0);
                    w = __builtin_amdgcn_cvt_scalef32_pk_fp4_f32(w, v[u][2 * d][2] * sc, v[u][2 * d][3] * sc, 1.0f, 1);
                    w = __builtin_amdgcn_cvt_scalef32_pk_fp4_f32(w, v[u][2 * d + 1][0] * sc, v[u][2 * d + 1][1] * sc, 1.0f, 2);
                    w = __builtin_amdgcn_cvt_scalef32_pk_fp4_f32(w, v[u][2 * d + 1][2] * sc, v[u][2 * d + 1][3] * sc, 1.0f, 3);
                    q4[d] = w; }
                *(u32x2*)(p.ws + WS_VTAB + ((size_t)l * NEXP + e) * (D / 2) + 8 * F.lane) = q4;
            } else {
                u32x4 q;
#pragma unroll
                for (int j = 0; j < 4; ++j) {
                    const int b0 = (int)__builtin_rintf(v[u][j].x * sc), b1 = (int)__builtin_rintf(v[u][j].y * sc), b2 = (int)__builtin_rintf(v[u][j].z * sc), b3 = (int)__builtin_rintf(v[u][j].w * sc);
                    q[j] = (unsigned)(b0 & 0xff) | ((unsigned)(b1 & 0xff) << 8) | ((unsigned)(b2 & 0xff) << 16) | ((unsigned)b3 << 24);
                }
                *(u32x4*)(p.ws + WS_UTAB + ((size_t)l * NEXP + e) * D + 16 * F.lane) = q;
            }
            if (F.lane == 0) ((float*)(p.ws + WS_TSCALE))[(l * 2 + tbl) * NEXP + e] = 1.0f / sc;
        }
    }
}

DI void phase_prep(const Params& p, const Frame& F) {
    unsigned char* ws = p.ws;
    {
        LAS float* wq = (LAS float*)F.lds;
        LAS float* skl = wq + 128 * 65;
        for (int it = F.bid; it < 2 * 16 * 16; it += F.nb) {
            const int cc = it & 15, hp = (it >> 4) & 15, l = it >> 8;
            const float* src = p.in[I_peer_wq] + (size_t)l * D * 2048 + hp * 128;
            const float* sks = p.in[I_peer_subkeys] + (size_t)(l * 16 + hp) * 128 * 128;
            __syncthreads();
            { float tw[16]; f32x4 ts[8];
#pragma unroll
              for (int it = 0; it < 16; ++it) { const int e = F.tid + it * NTHREADS, ci = e >> 7, d = e & 127; tw[it] = src[(size_t)(cc * 64 + ci) * 2048 + d]; }
#pragma unroll
              for (int it = 0; it < 8; ++it) { const int e = F.tid + it * NTHREADS, key = e >> 5, d4 = (e & 31) * 4; ts[it] = *(const f32x4*)(sks + key * 128 + d4); }
#pragma unroll
              for (int it = 0; it < 16; ++it) { const int e = F.tid + it * NTHREADS, ci = e >> 7, d = e & 127; wq[d * 65 + ci] = tw[it]; }
#pragma unroll
              for (int it = 0; it < 8; ++it) { const int e = F.tid + it * NTHREADS, key = e >> 5, d4 = (e & 31) * 4; *(LAS f32x4*)(skl + key * 132 + d4) = ts[it]; } }
            __syncthreads();
            const int ci = F.tid & 63, kg = F.tid >> 6;
            float acc[16];
#pragma unroll
            for (int k = 0; k < 16; ++k) acc[k] = 0.f;
#pragma unroll 2
            for (int d = 0; d < 128; d += 4) {
                const float w0 = wq[d * 65 + ci], w1 = wq[(d + 1) * 65 + ci], w2 = wq[(d + 2) * 65 + ci], w3 = wq[(d + 3) * 65 + ci];
#pragma unroll
                for (int k = 0; k < 16; ++k) { const f32x4 s = *(const LAS f32x4*)(skl + (16 * kg + k) * 132 + d); acc[k] += w0 * s.x + w1 * s.y + w2 * s.z + w3 * s.w; }
            }
            bf16_t* dst = (bf16_t*)(ws + WS_WFOLD) + ((size_t)l * 2048 + hp * 128 + 16 * kg) * D + cc * 64 + ci;
#pragma unroll
            for (int k = 0; k < 16; ++k) dst[(size_t)k * D] = (bf16_t)f2bf(acc[k]);
        }
        __syncthreads();
    }
    {
        LAS float* scr = (LAS float*)(F.lds + F.wave * 16384);
        constexpr int I_IN = (D / 64) * (INW / 32), I_BA = (512 / 64) * (D / 32), I_BS = (256 / 64) * (D / 32), I_O = (D / 64) * (D / 32);
        constexpr int PER_L = I_IN + I_BA + I_BS + I_O;
        for (int it = F.gw; it < 2 * PER_L; it += F.ngw) {
            const int l = it / PER_L; int r = it % PER_L;
            if (r < I_IN) { transpose_item(p.in[I_w_in] + (size_t)l * D * INW, D, INW, (bf16_t*)(ws + WS_WIN) + (size_t)l * INW * D, D, 0, 0, scr, r, F.lane); continue; } r -= I_IN;
            if (r < I_BA) { transpose_item(p.in[I_w_br_attn] + (size_t)l * 512 * D, 512, D, (bf16_t*)(ws + WS_WBR) + (size_t)l * D * D, D, 0, 0, scr, r, F.lane); continue; } r -= I_BA;
            if (r < I_BS) { transpose_item(p.in[I_w_br_sgu] + (size_t)l * 256 * D, 256, D, (bf16_t*)(ws + WS_WBR) + (size_t)l * D * D, D, 0, 768, scr, r, F.lane); continue; } r -= I_BS;
            transpose_item(p.in[I_w_out] + (size_t)l * D * D, D, D, (bf16_t*)(ws + WS_WOUT) + (size_t)l * D * D, D, 0, 0, scr, r, F.lane);
        }
    }
    for (int i = F.gtid; i < 2 * 256 * D; i += F.ngt) {
        const int n = i & 1023, rc = (i >> 10) & 255, l = i >> 18, g = rc >> 6;
        const float* pw = p.in[I_pool_w] + ((size_t)l * 256 + rc) * 64;
        const float* ps = p.in[I_pool_scale] + l * 256 + 64 * g;
        const float* wb = p.in[I_w_br_pool] + ((size_t)l * 256 + 64 * g) * D + n;
        float a = 0.f;
#pragma unroll 16
        for (int e = 0; e < 64; ++e) a += pw[e] * ps[e] * wb[(size_t)e * D];
        ((bf16_t*)(ws + WS_WBR))[(size_t)l * D * D + (size_t)n * D + 512 + rc] = (bf16_t)f2bf(a);
    }
    for (int i = F.gtid; i < 2 * 4 * 128 * 128; i += F.ngt) ((bf16_t*)(ws + WS_SGUW))[i] = (bf16_t)f2bf(p.in[I_sgu_w][i]);
    for (int i = F.gtid; i < 64 * 16; i += F.ngt) {
        const int pos = i >> 4, fi = i & 15;
        const float inv = powf(10000.0f, -(float)fi / 16.0f);
        const float ang = (float)pos * inv;
        ((f32x2*)(ws + WS_ROPE))[i] = (f32x2){cosf(ang), sinf(ang)};
    }
    convert_tables(p, F);
    {
        float* MOD = (float*)(ws + WS_MOD);
        LAS float* scd = (LAS float*)F.lds;
        LAS float* red = scd + 9 * D;
        __syncthreads();
        { float tc[18];
#pragma unroll
          for (int it = 0; it < 18; ++it) { const int e = F.tid + it * NTHREADS, r = e >> 10, k = e & 1023; tc[it] = (r < 8) ? p.in[I_c][r * D + k] : p.in[I_c_ctx][k]; }
#pragma unroll
          for (int it = 0; it < 18; ++it) scd[F.tid + it * NTHREADS] = silu_(tc[it]); }
        __syncthreads();
        for (int it = F.bid; it < 2 * 96; it += F.nb) {
            const int cgp = it % 96, l = it / 96, col = cgp * 64 + F.lane;
            float acc[9];
#pragma unroll
            for (int r = 0; r < 9; ++r) acc[r] = 0.f;
            const float* wp = p.in[I_w_mod] + ((size_t)l * D + F.wave * 128) * NMOD + col;
#pragma unroll 16
            for (int k = 0; k < 128; ++k) {
                const float w = wp[(size_t)k * NMOD];
#pragma unroll
                for (int r = 0; r < 9; ++r) acc[r] += scd[r * D + F.wave * 128 + k] * w;
            }
#pragma unroll
            for (int r = 0; r < 9; ++r) red[(F.wave * 9 + r) * 64 + F.lane] = acc[r];
            __syncthreads();
            for (int e = F.tid; e < 9 * 64; e += NTHREADS) {
                const int r = e >> 6, ln = e & 63; float s = p.in[I_b_mod][l * NMOD + cgp * 64 + ln];
#pragma unroll
                for (int w = 0; w < 8; ++w) s += red[(w * 9 + r) * 64 + ln];
                MOD[((size_t)l * 9 + r) * NMOD + cgp * 64 + ln] = s;
            }
            __syncthreads();
        }
    }
}

DI const float* mod_vec(const Params& p, int l, int row, int j) {
    const int r = row < TL ? row / SEQ : 8;
    return (const float*)(p.ws + WS_MOD) + ((size_t)l * 9 + r) * NMOD + j * D;
}
DI float* xrow_ptr(const Params& p, int row) { return row < TL ? p.out + (size_t)row * D : (float*)(p.ws + WS_XCTX) + (size_t)(row - TL) * D; }
DI const float* xin_ptr(const Params& p, int row) { return row < TL ? p.in[I_x] + (size_t)row * D : p.in[I_ctx] + (size_t)(row - TL) * D; }

DI void phase_norm(const Params& p, const Frame& F, int l, int which  , bool from_input, int nrows) {
    const float* g = (which == 0 ? p.in[I_g_mix] : p.in[I_g_ffn]) + l * D;
    const int lane = F.lane;
    f32x4 gg[4];
#pragma unroll
    for (int j = 0; j < 4; ++j) gg[j] = ((const f32x4*)g)[lane + 64 * j];
    for (int row0 = 2 * F.gw; row0 < nrows; row0 += 2 * F.ngw) {
        f32x4 v[2][4], s1[2][4], s2[2][4];
#pragma unroll
        for (int u = 0; u < 2; ++u) {
            const int row = row0 + u;
            const float* src = from_input ? xin_ptr(p, row) : xrow_ptr(p, row);
            const float* sh = mod_vec(p, l, row, which * 3 + 0); const float* sc = mod_vec(p, l, row, which * 3 + 1);
#pragma unroll
            for (int j = 0; j < 4; ++j) { v[u][j] = ((const f32x4*)src)[lane + 64 * j]; s1[u][j] = ((const f32x4*)sh)[lane + 64 * j]; s2[u][j] = ((const f32x4*)sc)[lane + 64 * j]; }
        }
#pragma unroll
        for (int u = 0; u < 2; ++u) {
            float ss = 0.f;
#pragma unroll
            for (int j = 0; j < 4; ++j) ss += v[u][j].x * v[u][j].x + v[u][j].y * v[u][j].y + v[u][j].z * v[u][j].z + v[u][j].w * v[u][j].w;
            const float rinv = rsqrtf(wave_sum(ss) * (1.0f / D) + EPS);
            bf16_t* dst = (bf16_t*)(p.ws + WS_H) + (size_t)(row0 + u) * D;
            float am = 0.f;
#pragma unroll
            for (int j = 0; j < 4; ++j) {
                const f32x4 o = v[u][j] * rinv * gg[j] * (s2[u][j] + 1.0f) + s1[u][j];
                u32x2 w; w.x = pk2(o.x, o.y); w.y = pk2(o.z, o.w);
                ((u32x2*)dst)[lane + 64 * j] = w;
                v[u][j] = o; am = fmaxf(am, fmaxf(fmaxf(fabsf(o.x), fabsf(o.y)), fmaxf(fabsf(o.z), fabsf(o.w))));
            }
            if (which) {
#pragma unroll
                for (int o2 = 1; o2 < 64; o2 <<= 1) am = fmaxf(am, __shfl_xor(am, o2));
                const float sc = (am > 0.f) ? 127.0f / am : 1.0f;
                unsigned* h8 = (unsigned*)(p.ws + WS_H8 + (size_t)(row0 + u) * D);
#pragma unroll
                for (int j = 0; j < 4; ++j) {
                    const int b0 = (int)__builtin_rintf(v[u][j].x * sc), b1 = (int)__builtin_rintf(v[u][j].y * sc), b2 = (int)__builtin_rintf(v[u][j].z * sc), b3 = (int)__builtin_rintf(v[u][j].w * sc);
                    h8[lane + 64 * j] = (unsigned)(b0 & 0xff) | ((unsigned)(b1 & 0xff) << 8) | ((unsigned)(b2 & 0xff) << 16) | ((unsigned)b3 << 24);
                }
                if (lane == 0) ((float*)(p.ws + WS_HS))[row0 + u] = (am > 0.f) ? am * (1.0f / 127.0f) : 1.0f;
            }
        }
    }
}
DI void phase_final(const Params& p, const Frame& F) {
    f32x4 gg[4];
#pragma unroll
    for (int j = 0; j < 4; ++j) gg[j] = ((const f32x4*)p.in[I_g_final])[F.lane + 64 * j];
    for (int row0 = 2 * F.gw; row0 < TL; row0 += 2 * F.ngw) {
        f32x4 v[2][4];
#pragma unroll
        for (int u = 0; u < 2; ++u)
#pragma unroll
            for (int j = 0; j < 4; ++j) v[u][j] = ((const f32x4*)(p.out + (size_t)(row0 + u) * D))[F.lane + 64 * j];
#pragma unroll
        for (int u = 0; u < 2; ++u) {
            float ss = 0.f;
#pragma unroll
            for (int j = 0; j < 4; ++j) ss += v[u][j].x * v[u][j].x + v[u][j].y * v[u][j].y + v[u][j].z * v[u][j].z + v[u][j].w * v[u][j].w;
            const float rinv = rsqrtf(wave_sum(ss) * (1.0f / D) + EPS);
            f32x4* xr = (f32x4*)(p.out + (size_t)(row0 + u) * D);
#pragma unroll
            for (int j = 0; j < 4; ++j) xr[F.lane + 64 * j] = v[u][j] * rinv * gg[j];
        }
    }
}

DI float lane_xor32(float v, bool hi) { const auto r = __builtin_amdgcn_permlane32_swap(__builtin_bit_cast(unsigned, v), __builtin_bit_cast(unsigned, v), false, false);
    return __builtin_bit_cast(float, hi ? r[0] : r[1]); }
struct EpiG1 {
    DI bool keeps(const pg8::Unit&) const { return false; }
    static constexpr bool PERM = true;
    unsigned char* ws;
    DI void operator()(const f32x4 (&acc)[2][2][4][2], const pg8::Unit& u, int wr, int wc, int fr, int fq) const {
        bf16_t* P = (bf16_t*)(ws + WS_P);
        const int rbase = u.pm * 256 + wr * 64 + fr;
        const bool hi = fq >= 2;
#pragma unroll
        for (int ai = 0; ai < 2; ++ai) {
            f32x4 cs[4][4];
            const bool lat = u.pm < TL / 256;
            if (u.pn < 3 && lat) {
#pragma unroll
                for (int m = 0; m < 4; ++m) {
                    const int t = (rbase + 128 * ai + 16 * m) & (SEQ - 1), pos = (wc & 1) ? (t & 63) : (t >> 6);
                    const f32x4* tab = (const f32x4*)(ws + WS_ROPE) + (pos * 16 + 8 * (fq & 1)) / 2;
#pragma unroll
                    for (int j2 = 0; j2 < 4; ++j2) cs[m][j2] = tab[j2];
                }
            }
#pragma unroll
            for (int m = 0; m < 4; ++m) {
                const int row = rbase + 128 * ai + 16 * m;
#pragma unroll
                for (int bj = 0; bj < 2; ++bj) {
                    const int c0 = u.pn * 256 + 128 * bj + 32 * wc + 8 * fq;
                    float v[8];
#pragma unroll
                    for (int j = 0; j < 4; ++j) { v[j] = acc[ai][bj][m][0][j]; v[4 + j] = acc[ai][bj][m][1][j]; }
                    if (c0 < VOFF) {
                        const float sc = (c0 < KOFF) ? QSCALE : 1.0f;
                        u32x4 o;
#pragma unroll
                        for (int j2 = 0; j2 < 4; ++j2) {
                            const f32x4 c4 = cs[m][j2];
                            const float o0 = lane_xor32(v[2 * j2], hi), o1 = lane_xor32(v[2 * j2 + 1], hi);
                            float r0 = hi ? (v[2 * j2] * c4.x + o0 * c4.y) : (v[2 * j2] * c4.x - o0 * c4.y);
                            float r1 = hi ? (v[2 * j2 + 1] * c4.z + o1 * c4.w) : (v[2 * j2 + 1] * c4.z - o1 * c4.w);
                            if (!lat) { r0 = v[2 * j2]; r1 = v[2 * j2 + 1]; }
                            o[j2] = pk2(r0 * sc, r1 * sc);
                        }
                        *(u32x4*)(P + (size_t)row * PW + c0) = o;
                    } else if (c0 < POOLOFF) {
                        const int hk = wc >> 1, d0 = 32 * (wc & 1) + 8 * fq;
                        if (lat) { const int b = row / SEQ, t = row & (SEQ - 1);
                            bf16_t* vt = (bf16_t*)(ws + WS_VT) + ((size_t)(b * 2 + hk) * 64 + d0) * VTS + t;
#pragma unroll
                            for (int j = 0; j < 8; ++j) vt[(size_t)j * VTS] = (bf16_t)f2bf(v[j]);
                        } else { const int rc = row - TL, b = rc / NCTX, jc = rc & (NCTX - 1);
                            bf16_t* vt = (bf16_t*)(ws + WS_VTC) + ((size_t)(b * 2 + hk) * 64 + d0) * NCTX + jc;
#pragma unroll
                            for (int j = 0; j < 8; ++j) vt[(size_t)j * NCTX] = (bf16_t)f2bf(v[j]);
                        }
                    } else if (c0 < SUOFF) {
                        u32x4 o;
#pragma unroll
                        for (int j2 = 0; j2 < 4; ++j2) o[j2] = pk2(v[2 * j2], v[2 * j2 + 1]);
                        *(u32x4*)(P + (size_t)row * PW + c0) = o;
                    } else if (c0 < SVOFF) {
                        u32x4 o;
#pragma unroll
                        for (int j2 = 0; j2 < 4; ++j2) o[j2] = pk2(gelu_tanh(v[2 * j2]), gelu_tanh(v[2 * j2 + 1]));
                        *(u32x4*)(P + (size_t)row * PW + c0) = o;
                    } else {
                        const int c = c0 - SVOFF, chunk = row >> 7, q = row & 127;
                        bf16_t* vs = (bf16_t*)(ws + WS_VST) + ((size_t)chunk * 256 + c) * 128 + q;
#pragma unroll
                        for (int j = 0; j < 8; ++j) vs[j * 128] = (bf16_t)f2bf(gelu_tanh(v[j]));
                    }
                }
            }
            asm volatile("" ::: "memory");
        }
    }
};
struct SchedGrid {
    int nM, nN, G, c; const char* A; const char* B;
    int n_extra, ex_pm0, ex_pn;
    DI bool next(int i, pg8::Unit& u) const {
        const int L = i * G + c, n = nM * nN; if (L >= n + n_extra) return false;
        if (L < n) pg8::tile_of(L, nM, nN, u.pm, u.pn); else { u.pm = ex_pm0 + (L - n); u.pn = ex_pn; }
        u.sub = 0; u.nt = D / 64; u.mode = 0;
        u.a = A + (size_t)u.pm * 256 * D * 2; u.b = B + (size_t)u.pn * 256 * D * 2; return true;
    }
};

DI void phase_g1(const Params& p, const Frame& F, int l) {
    SchedGrid S{(l == 0 ? T : TL) / 256, PN / 256, F.nb, F.bid, (const char*)(p.ws + WS_H), (const char*)(p.ws + WS_WIN) + (size_t)l * INW * D * 2,
                (l == 0) ? 0 : TC / 256, TL / 256, 2};
    EpiG1 E{p.ws};
    pg8::gemm_phase(F.lds, F.tid, S, E);
}

DI bf16x8 pack8(const f32x16& x, int s) {
    u32x4 pk;
#pragma unroll
    for (int j = 0; j < 4; ++j) { f32x2 v = {x[8 * s + 2 * j], x[8 * s + 2 * j + 1]}; pk[j] = __builtin_bit_cast(unsigned, __builtin_convertvector(v, bf16x2_t)); }
    return __builtin_bit_cast(bf16x8, pk);
}

DI float lane_x32(float v, bool hi) { const auto r = __builtin_amdgcn_permlane32_swap(__builtin_bit_cast(unsigned, v), __builtin_bit_cast(unsigned, v), false, false);
    return __builtin_bit_cast(float, hi ? r[0] : r[1]); }
struct AttnFrags { bf16x8 kf[4]; s16x4 vf[2][4]; };
DI void attn_block(const bf16x8 (&qf)[4], const AttnFrags& f, int mask_mode, int kq_off, int lane, float& m, float& lpart, f32x16 (&o)[2]) {
    const int h = lane >> 5;
    f32x16 st;
#pragma unroll
    for (int r = 0; r < 16; ++r) st[r] = 0.f;
#pragma unroll
    for (int s = 0; s < 4; ++s) st = MFMA32(f.kf[s], qf[s], st);
    if (mask_mode) {
#pragma unroll
        for (int r = 0; r < 16; ++r) { const int dlt = kq_off + crow(r, h); if (dlt > 128 || dlt < -128) st[r] = -1e30f; }
    }
    float bm = st[0];
#pragma unroll
    for (int r = 1; r < 16; ++r) bm = fmaxf(bm, st[r]);
    bm = fmaxf(bm, lane_x32(bm, h != 0));
    const float mn = fmaxf(m, bm);
    if (__builtin_amdgcn_ballot_w64(mn > m) != 0ull) {
        const float alpha = __builtin_amdgcn_exp2f(m - mn);
        lpart *= alpha;
#pragma unroll
        for (int d = 0; d < 2; ++d)
#pragma unroll
            for (int r = 0; r < 16; ++r) o[d][r] *= alpha;
        m = mn;
    }
    float ps = 0.f;
#pragma unroll
    for (int r = 0; r < 16; ++r) { st[r] = __builtin_amdgcn_exp2f(st[r] - m); ps += st[r]; }
    lpart += ps;
    const bf16x8 pf0 = pack8(st, 0), pf1 = pack8(st, 1);
#pragma unroll
    for (int d = 0; d < 2; ++d) {
        const bf16x8 v0 = __builtin_shufflevector(f.vf[d][0], f.vf[d][1], 0, 1, 2, 3, 4, 5, 6, 7), v1 = __builtin_shufflevector(f.vf[d][2], f.vf[d][3], 0, 1, 2, 3, 4, 5, 6, 7);
        o[d] = MFMA32(v0, pf0, o[d]);
        o[d] = MFMA32(v1, pf1, o[d]);
    }
}

constexpr int AKP = 144, AVWP = 648, AVCP = 520;
constexpr int ALDS_KW = 0, ALDS_VW = ALDS_KW + 320 * AKP, ALDS_KC = ALDS_VW + 64 * AVWP, ALDS_VC = ALDS_KC + 256 * AKP, ALDS_END = ALDS_VC + 64 * AVCP;
static_assert(ALDS_END <= LDS_BAR_OFF && (ALDS_VW % 16) == 0 && (ALDS_KC % 16) == 0 && (ALDS_VC % 8) == 0, "attention LDS map");
DI void attn_lds_frags(AttnFrags& f, const LAS unsigned char* kp, const LAS unsigned char* vp, int vpitch32) {
#pragma unroll
    for (int s = 0; s < 4; ++s) f.kf[s] = *(const LAS bf16x8*)(kp + 32 * s);
#pragma unroll
    for (int d = 0; d < 2; ++d)
#pragma unroll
        for (int q = 0; q < 4; ++q) f.vf[d][q] = *(const LAS s16x4*)(vp + d * vpitch32 + 16 * q);
}
DI void attn_unit(const Params& p, const Frame& F, int l, int unit) {
    const int lane = F.lane, r = lane & 31, h = lane >> 5, tid = F.tid;
    const bf16_t* P = (const bf16_t*)(p.ws + WS_P);
    const bf16_t* VT = (const bf16_t*)(p.ws + WS_VT);
    const bf16_t* VTC = (const bf16_t*)(p.ws + WS_VTC);
    bf16_t* Y = (bf16_t*)(p.ws + WS_Y);
    const bool latent = unit < 1024;
    int b, hk, p0, q0row;
    if (latent) { const int pb = unit & 63; hk = (unit >> 6) & 1; b = unit >> 7; p0 = pb * 64; q0row = b * SEQ + p0; }
    else { const int u2 = unit - 1024, pb = u2 & 3; hk = (u2 >> 2) & 1; b = u2 >> 3; p0 = pb * 64; q0row = TL + b * NCTX + p0; }
    const int w0 = p0 - 128;
    u32x4 kw[5], vw[5], kc[4], vc[4];
    if (latent) {
#pragma unroll
        for (int it = 0; it < 5; ++it) {
            const int i = tid + it * NTHREADS, row = i >> 3, ck = i & 7, pos = min(max(w0 + row, 0), SEQ - 1);
            kw[it] = *(const u32x4*)(P + (size_t)(b * SEQ + pos) * PW + KOFF + hk * 64 + 8 * ck);
            const int d = i / 40, cv = i % 40, pv = min(max(w0 + 8 * cv, 0), SEQ - 8);
            vw[it] = *(const u32x4*)(VT + ((size_t)(b * 2 + hk) * 64 + d) * VTS + pv);
        }
    }
#pragma unroll
    for (int it = 0; it < 4; ++it) {
        const int i = tid + it * NTHREADS;
        kc[it] = *(const u32x4*)(P + (size_t)(TL + b * NCTX + (i >> 3)) * PW + KOFF + hk * 64 + 8 * (i & 7));
        vc[it] = *(const u32x4*)(VTC + ((size_t)(b * 2 + hk) * 64 + (i >> 5)) * NCTX + 8 * (i & 31));
    }
    __syncthreads();
    if (latent) {
#pragma unroll
        for (int it = 0; it < 5; ++it) {
            const int i = tid + it * NTHREADS, row = i >> 3, ck = i & 7;
            *(LAS u32x4*)(F.lds + ALDS_KW + row * AKP + 16 * ck) = kw[it];
            const int d = i / 40, cv = i % 40;
            LAS u32x2* dst = (LAS u32x2*)(F.lds + ALDS_VW + d * AVWP + 16 * cv); dst[0] = (u32x2){vw[it].x, vw[it].y}; dst[1] = (u32x2){vw[it].z, vw[it].w};
        }
    }
#pragma unroll
    for (int it = 0; it < 4; ++it) {
        const int i = tid + it * NTHREADS;
        *(LAS u32x4*)(F.lds + ALDS_KC + (i >> 3) * AKP + 16 * (i & 7)) = kc[it];
        LAS u32x2* dst = (LAS u32x2*)(F.lds + ALDS_VC + (i >> 5) * AVCP + 16 * (i & 31)); dst[0] = (u32x2){vc[it].x, vc[it].y}; dst[1] = (u32x2){vc[it].z, vc[it].w};
    }
    const int head = 4 * hk + (F.wave & 3), ph = F.wave >> 2, pw = p0 + 32 * ph, qrow = q0row + 32 * ph;
    bf16x8 qf[4];
#pragma unroll
    for (int s = 0; s < 4; ++s) qf[s] = *(const bf16x8*)(P + (size_t)(qrow + r) * PW + head * 64 + 16 * s + 8 * h);
    float m = p.in[I_attn_sink][l * 8 + head] * LOG2E, lpart = (h == 0) ? 1.0f : 0.0f;
    f32x16 o[2];
#pragma unroll
    for (int d = 0; d < 2; ++d)
#pragma unroll
        for (int i = 0; i < 16; ++i) o[d][i] = 0.f;
    __syncthreads();
    if (latent) {
#pragma unroll 1
        for (int j = 0; j < 9; ++j) {
            const int kb = pw - 128 + 32 * j;
            if (kb < 0 || kb >= SEQ) continue;
            const int krow = kb - w0;
            AttnFrags f;
            attn_lds_frags(f, F.lds + ALDS_KW + (krow + r) * AKP + 16 * h, F.lds + ALDS_VW + r * AVWP + 2 * krow + 8 * h, 32 * AVWP);
            attn_block(qf, f, (j == 0 || j == 8) ? 1 : 0, kb - (pw + r), lane, m, lpart, o);
        }
    }
#pragma unroll 1
    for (int j = 0; j < 8; ++j) {
        AttnFrags f;
        attn_lds_frags(f, F.lds + ALDS_KC + (32 * j + r) * AKP + 16 * h, F.lds + ALDS_VC + r * AVCP + 64 * j + 8 * h, 32 * AVCP);
        attn_block(qf, f, 0, 0, lane, m, lpart, o);
    }
    const float inv = 1.0f / (lpart + lane_x32(lpart, h != 0));
    bf16_t* yrow = Y + (size_t)(qrow + r) * D + head * 64;
#pragma unroll
    for (int d = 0; d < 2; ++d)
#pragma unroll
        for (int g = 0; g < 4; ++g) {
            u32x2 w; w.x = pk2(o[d][4 * g] * inv, o[d][4 * g + 1] * inv); w.y = pk2(o[d][4 * g + 2] * inv, o[d][4 * g + 3] * inv);
            *(u32x2*)(yrow + 32 * d + 8 * g + 4 * h) = w;
        }
}

DI void sgu_unit(const Params& p, const Frame& F, int l, int chunk) {
    constexpr int VS = 136;
    LAS float* part = (LAS float*)F.lds;
    LAS float* rq = part + 512;
    LAS bf16_t* vnT = (LAS bf16_t*)(F.lds + 4096);
    const bf16_t* VsT = (const bf16_t*)(p.ws + WS_VST) + (size_t)chunk * 256 * 128;
    const bf16_t* P = (const bf16_t*)(p.ws + WS_P);
    bf16_t* Y = (bf16_t*)(p.ws + WS_Y);
    __syncthreads();
    { const int q = F.tid & 127, part_i = F.tid >> 7; float ss = 0.f;
#pragma unroll 16
        for (int c = part_i * 64; c < part_i * 64 + 64; ++c) { const float v = bf2f(VsT[c * 128 + q]); ss += v * v; }
        part[part_i * 128 + q] = ss; }
    __syncthreads();
    if (F.tid < 128) rq[F.tid] = rsqrtf((part[F.tid] + part[128 + F.tid] + part[256 + F.tid] + part[384 + F.tid]) * (1.0f / 256.0f) + EPS);
    __syncthreads();
#pragma unroll
    for (int it = 0; it < 8; ++it) {
        const int i = F.tid + it * NTHREADS;
        const int c = i >> 4, q8 = (i & 15) * 8;
        const u32x4 v = *(const u32x4*)(VsT + c * 128 + q8);
        u32x4 o;
#pragma unroll
        for (int j = 0; j < 4; ++j) o[j] = pk2(bflo(v[j]) * rq[q8 + 2 * j], bfhi(v[j]) * rq[q8 + 2 * j + 1]);
        *(LAS u32x4*)(vnT + c * VS + q8) = o;
    }
    __syncthreads();
    const int lane = F.lane, r = lane & 31, h = lane >> 5, g = F.wave >> 1, ph = F.wave & 1;
    const bf16_t* Wg = (const bf16_t*)(p.ws + WS_SGUW) + ((size_t)l * 4 + g) * 128 * 128;
#pragma unroll 1
    for (int pb = 0; pb < 2; ++pb) {
        const int p0 = 64 * ph + 32 * pb;
        const int row = chunk * 128 + p0 + r;
        bf16x8 wf[8];
#pragma unroll
        for (int s = 0; s < 8; ++s) wf[s] = *(const bf16x8*)(Wg + (size_t)(p0 + r) * 128 + 16 * s + 8 * h);
        u32x2 uu[2][4];
#pragma unroll
        for (int cb = 0; cb < 2; ++cb)
#pragma unroll
            for (int q4 = 0; q4 < 4; ++q4) uu[cb][q4] = *(const u32x2*)(P + (size_t)row * PW + SUOFF + 64 * g + 32 * cb + 8 * q4 + 4 * h);
        const float bias = p.in[I_sgu_b][(l * 4 + g) * 128 + p0 + r];
#pragma unroll
        for (int cb = 0; cb < 2; ++cb) {
            const int c0 = 64 * g + 32 * cb;
            f32x16 acc;
#pragma unroll
            for (int i = 0; i < 16; ++i) acc[i] = 0.f;
#pragma unroll
            for (int s = 0; s < 8; ++s) {
                const bf16x8 a = *(const LAS bf16x8*)(vnT + (c0 + r) * VS + 16 * s + 8 * h);
                acc = MFMA32(a, wf[s], acc);
            }
#pragma unroll
            for (int q4 = 0; q4 < 4; ++q4) {
                const int cc = c0 + 8 * q4 + 4 * h;
                const u32x2 u = uu[cb][q4];
                u32x2 w;
                w.x = pk2(bflo(u.x) * (acc[4 * q4] + bias), bfhi(u.x) * (acc[4 * q4 + 1] + bias));
                w.y = pk2(bflo(u.y) * (acc[4 * q4 + 2] + bias), bfhi(u.y) * (acc[4 * q4 + 3] + bias));
                *(u32x2*)(Y + (size_t)row * D + 768 + cc) = w;
            }
        }
    }
}

DI void phase_mix(const Params& p, const Frame& F, int l, int ctr_slot = 0) {
    (void)ctr_slot;
    const int nrows = (l == 0) ? T : TL;
    const bf16_t* P = (const bf16_t*)(p.ws + WS_P);
    bf16_t* Y = (bf16_t*)(p.ws + WS_Y);
    for (int i0 = F.bid * NTHREADS; i0 < 4 * nrows * 8; i0 += F.nb * NTHREADS) {
        const int i = i0 + F.tid, g = i / (nrows * 8), rem = i - g * (nrows * 8), row = rem >> 3, ck = g * 8 + (rem & 7);
        int base, t, len;
        if (row < TL) { base = row & ~(SEQ - 1); t = row & (SEQ - 1); len = SEQ; } else { const int rc = row - TL; base = TL + (rc & ~(NCTX - 1)); t = rc & (NCTX - 1); len = NCTX; }
        float s[8];
#pragma unroll
        for (int j = 0; j < 8; ++j) s[j] = 0.f;
        const bf16_t* zc = P + POOLOFF + ck * 8;
#define POOL_WIN(HALF) do { _Pragma("unroll") for (int dt = -(HALF); dt < (HALF); ++dt) { const int tt = t + dt; const bool ok = tt >= 0 && tt < len; \
            const u32x4 v = *(const u32x4*)(zc + (size_t)(base + (ok ? tt : t)) * PW); const float w = ok ? 1.f : 0.f; \
            _Pragma("unroll") for (int j = 0; j < 4; ++j) { s[2 * j] += w * bflo(v[j]); s[2 * j + 1] += w * bfhi(v[j]); } } } while (0)
        int half;
        if (g == 0) { POOL_WIN(1); half = 1; } else if (g == 1) { POOL_WIN(2); half = 2; } else if (g == 2) { POOL_WIN(4); half = 4; } else { POOL_WIN(8); half = 8; }
#undef POOL_WIN
        const int lo = max(t - half, 0), hi = min(t + half, len);
        const float inv = 1.0f / (float)(hi - lo);
        const u32x4 z = *(const u32x4*)(zc + (size_t)row * PW);
        u32x4 o;
#pragma unroll
        for (int j = 0; j < 4; ++j) o[j] = pk2(s[2 * j] * inv - bflo(z[j]), s[2 * j + 1] * inv - bfhi(z[j]));
        *(u32x4*)(Y + (size_t)row * D + 512 + ck * 8) = o;
    }
    const int nchunk = (l == 0) ? T / 128 : TL / 128;
    for (int ch = F.bid; ch < nchunk; ch += F.nb) sgu_unit(p, F, l, ch);
    const int nunit = (l == 0) ? 1024 + 64 : 1024;
    for (int u = F.nb - 1 - F.bid; u < nunit; u += F.nb) attn_unit(p, F, l, u);
}

struct SchedG2 {
    int G, c; const char *H, *Y, *Wg, *Wb; int npair;
    DI void fill(pg8::Unit& u, int sub, int br) const {
        u.sub = sub;
        if ((sub & 1) == 0) { u.nt = 16; u.a = H + (size_t)u.pm * 256 * D * 2; u.b = Wg + ((size_t)br * D + u.pn * 256) * D * 2; }
        else { const int koff = (br == 0) ? 0 : (br == 1 ? 512 : 768); u.nt = (br == 0) ? 8 : 4;
               u.a = Y + ((size_t)u.pm * 256 * D + koff) * 2; u.b = Wb + ((size_t)u.pn * 256 * D + koff) * 2; }
    }
    DI bool next(int i, pg8::Unit& u) const {
        constexpr int NLAT = (TL / 256) * 4;
        const int nl = (NLAT - c + G - 1) / G;
        if (i < 6 * nl) { const int tile = (i / 6) * G + c, sub = i % 6; pg8::tile_of(tile, TL / 256, 4, u.pm, u.pn); u.mode = 0; fill(u, sub, sub >> 1); return true; }
        const int e = i - 6 * nl, j = (e >> 1) * G + c;
        if (j >= npair) return false;
        const int ctile = j / 3, br = j % 3;
        u.pm = TL / 256 + (ctile >> 2); u.pn = ctile & 3; u.mode = 1 + br; fill(u, e & 1, br); return true;
    }
};
struct EpiG2 {
    static constexpr bool PERM = true;
    bf16_t* scr; bf16_t* M; bf16_t* MP;
    DI bool keeps(const pg8::Unit& u) const { return (u.sub & 1) == 0; }
    DI void operator()(f32x4 (&acc)[2][2][4][2], const pg8::Unit& u, int wr, int wc, int fr, int fq) const {
        const bool gate = (u.sub & 1) == 0, first = u.sub == 0 && gate;
        bf16_t* Mo = (u.mode == 0) ? M + (size_t)u.pm * 256 * D : MP + ((size_t)(u.mode - 1) * TC + (size_t)(u.pm - TL / 256) * 256) * D;
#pragma unroll
        for (int ai = 0; ai < 2; ++ai) {
            u32x4 ld[4][2];
            if (!first) {
#pragma unroll
                for (int m = 0; m < 4; ++m)
#pragma unroll
                    for (int bj = 0; bj < 2; ++bj) {
                        const int rl = 128 * ai + 64 * wr + 16 * m + fr, cl = 128 * bj + 32 * wc + 8 * fq;
                        ld[m][bj] = gate ? *(const u32x4*)(Mo + (size_t)rl * D + u.pn * 256 + cl) : *(const u32x4*)(scr + rl * 256 + cl);
                    }
            }
#pragma unroll
            for (int m = 0; m < 4; ++m)
#pragma unroll
                for (int bj = 0; bj < 2; ++bj) {
                    const int rl = 128 * ai + 64 * wr + 16 * m + fr, cl = 128 * bj + 32 * wc + 8 * fq;
                    if (gate) {
                        u32x4 o;
#pragma unroll
                        for (int j2 = 0; j2 < 4; ++j2) {
                            const int n = j2 >> 1, e = 2 * (j2 & 1);
                            const unsigned w = pk2(fmaxf(sigmoidf_(acc[ai][bj][m][n][e]), 1e-20f), fmaxf(sigmoidf_(acc[ai][bj][m][n][e + 1]), 1e-20f));
                            o[j2] = w;
                            const float t0 = first ? 0.f : bflo(ld[m][bj][j2]), t1 = first ? 0.f : bfhi(ld[m][bj][j2]);
                            acc[ai][bj][m][n][e] = t0 * __builtin_amdgcn_rcpf(bflo(w)); acc[ai][bj][m][n][e + 1] = t1 * __builtin_amdgcn_rcpf(bfhi(w));
                        }
                        *(u32x4*)(scr + rl * 256 + cl) = o;
                    } else {
                        u32x4 w;
#pragma unroll
                        for (int j2 = 0; j2 < 4; ++j2) { const int n = j2 >> 1, e = 2 * (j2 & 1);
                            w[j2] = pk2(acc[ai][bj][m][n][e] * bflo(ld[m][bj][j2]), acc[ai][bj][m][n][e + 1] * bfhi(ld[m][bj][j2])); }
                        *(u32x4*)(Mo + (size_t)rl * D + u.pn * 256 + cl) = w;
                    }
                }
            asm volatile("" ::: "memory");
        }
    }
};
DI void phase_g2(const Params& p, const Frame& F, int l) {
    SchedG2 S{F.nb, F.bid, (const char*)(p.ws + WS_H), (const char*)(p.ws + WS_Y),
              (const char*)(p.ws + WS_WIN) + ((size_t)l * INW + GATEOFF) * D * 2, (const char*)(p.ws + WS_WBR) + (size_t)l * D * D * 2, (l == 0) ? (TC / 256) * 4 * 3 : 0};
    EpiG2 E{(bf16_t*)(p.ws + WS_IDX) + (size_t)F.bid * 65536, (bf16_t*)(p.ws + WS_MERGED), (bf16_t*)(p.ws + WS_MP)};
    pg8::gemm_phase(F.lds, F.tid, S, E);
}
DI void phase_g2sum(const Params& p, const Frame& F) {
    const u32x4* mp = (const u32x4*)(p.ws + WS_MP);
    u32x4* mo = (u32x4*)((bf16_t*)(p.ws + WS_MERGED) + (size_t)TL * D);
    constexpr int NV = TC * D / 8;
    for (int i = F.gtid; i < NV; i += F.ngt) {
        const u32x4 a = mp[i], b = mp[NV + i], c = mp[2 * NV + i];
        u32x4 o;
#pragma unroll
        for (int j = 0; j < 4; ++j) o[j] = pk2(bflo(a[j]) + bflo(b[j]) + bflo(c[j]), bfhi(a[j]) + bfhi(b[j]) + bfhi(c[j]));
        mo[i] = o;
    }
}

struct EpiG3 {
    DI bool keeps(const pg8::Unit&) const { return false; }
    static constexpr bool PERM = false;
    const float* xsrc; float* xdst; const float* csrc; float* cdst; const float* mod;
    DI void operator()(const f32x4 (&acc)[2][2][4][2], const pg8::Unit& u, int wr, int wc, int fr, int fq) const {
        const int col0 = u.pn * 256 + wc * 32 + 4 * fq;
        const bool lat = u.pm < TL / 256;
        const float* gt = mod + (size_t)(lat ? (u.pm >> 4) : 8) * NMOD + 2 * D;
        const float* xs = lat ? xsrc + (size_t)u.pm * 256 * D : csrc + (size_t)(u.pm - TL / 256) * 256 * D;
        float* xd = lat ? xdst + (size_t)u.pm * 256 * D : cdst + (size_t)(u.pm - TL / 256) * 256 * D;
        f32x4 gv[2][2];
#pragma unroll
        for (int bj = 0; bj < 2; ++bj)
#pragma unroll
            for (int n = 0; n < 2; ++n) gv[bj][n] = *(const f32x4*)(gt + col0 + 128 * bj + 16 * n);
#pragma unroll
        for (int ai = 0; ai < 2; ++ai) {
            f32x4 xv[4][2][2];
#pragma unroll
            for (int m = 0; m < 4; ++m)
#pragma unroll
                for (int bj = 0; bj < 2; ++bj)
#pragma unroll
                    for (int n = 0; n < 2; ++n) xv[m][bj][n] = *(const f32x4*)(xs + (size_t)(wr * 64 + fr + 128 * ai + 16 * m) * D + col0 + 128 * bj + 16 * n);
#pragma unroll
            for (int m = 0; m < 4; ++m)
#pragma unroll
                for (int bj = 0; bj < 2; ++bj)
#pragma unroll
                    for (int n = 0; n < 2; ++n)
                        *(f32x4*)(xd + (size_t)(wr * 64 + fr + 128 * ai + 16 * m) * D + col0 + 128 * bj + 16 * n) = xv[m][bj][n] + gv[bj][n] * acc[ai][bj][m][n];
            asm volatile("" ::: "memory");
        }
    }
};
DI void phase_g3(const Params& p, const Frame& F, int l) {
    SchedGrid S{(l == 0 ? T : TL) / 256, D / 256, F.nb, F.bid, (const char*)(p.ws + WS_MERGED), (const char*)(p.ws + WS_WOUT) + (size_t)l * D * D * 2, 0, 0, 0};
    float* xc = (float*)(p.ws + WS_XCTX);
    EpiG3 E{(l == 0) ? p.in[I_x] : p.out, p.out, (l == 0) ? p.in[I_ctx] : xc, xc, (const float*)(p.ws + WS_MOD) + (size_t)l * 9 * NMOD};
    pg8::gemm_phase(F.lds, F.tid, S, E);
}

struct EpiG45 {
    DI bool keeps(const pg8::Unit&) const { return false; }
    static constexpr bool PERM = true;
    unsigned short* ST;
    DI void operator()(const f32x4 (&acc)[2][2][4][2], const pg8::Unit& u, int wr, int wc, int fr, int fq) const {
        const int col0 = u.pn * 256 + wc * 32 + 8 * fq;
#pragma unroll
        for (int ai = 0; ai < 2; ++ai)
#pragma unroll
            for (int m = 0; m < 4; ++m) {
                unsigned short* rowp = ST + (size_t)(u.pm * 256 + wr * 64 + fr + 128 * ai + 16 * m) * T + col0;
#pragma unroll
                for (int bj = 0; bj < 2; ++bj) {
                    u32x4 w;
                    w.x = pkh2(acc[ai][bj][m][0][0], acc[ai][bj][m][0][1]); w.y = pkh2(acc[ai][bj][m][0][2], acc[ai][bj][m][0][3]);
                    w.z = pkh2(acc[ai][bj][m][1][0], acc[ai][bj][m][1][1]); w.w = pkh2(acc[ai][bj][m][1][2], acc[ai][bj][m][1][3]);
                    *(u32x4*)(rowp + 128 * bj) = w;
                }
            }
    }
};
DI void phase_g45(const Params& p, const Frame& F, int l) {
    SchedGrid S{2048 / 256, (l == 0 ? T : TL) / 256, F.nb, F.bid, (const char*)(p.ws + WS_WFOLD) + (size_t)l * 2048 * D * 2, (const char*)(p.ws + WS_H), 0, 0, 0};
    EpiG45 E{(unsigned short*)(p.ws + WS_ST)};
    pg8::gemm_phase(F.lds, F.tid, S, E);
}

DI unsigned fkey(float f) { const unsigned u = __builtin_bit_cast(unsigned, f); return (u & 0x80000000u) ? ~u : (u | 0x80000000u); }
DI float fkey_inv(unsigned k) { const unsigned u = (k & 0x80000000u) ? (k & 0x7fffffffu) : ~k; return __builtin_bit_cast(float, u); }
#define INSERT16(L, x) do { unsigned x_ = (x); _Pragma("unroll") for (int k_ = 0; k_ < 16; ++k_) { const unsigned hi_ = max(L[k_], x_); x_ = min(L[k_], x_); L[k_] = hi_; } } while (0)
#define CEX(a, b) do { const unsigned hi_ = max(a, b), lo_ = min(a, b); a = hi_; b = lo_; } while (0)
DI void sort16_desc(unsigned (&v)[16]) {
#pragma unroll
    for (int k = 2; k <= 16; k <<= 1)
#pragma unroll
        for (int j = k >> 1; j > 0; j >>= 1)
#pragma unroll
            for (int i = 0; i < 16; ++i) {
                const int q = i ^ j;
                if (q > i) { if ((i & k) == 0) CEX(v[i], v[q]); else CEX(v[q], v[i]); }
            }
}
DI void merge16_desc(unsigned (&L)[16], const unsigned (&N)[16]) {
#pragma unroll
    for (int i = 0; i < 16; ++i) L[i] = max(L[i], N[15 - i]);
#pragma unroll
    for (int j = 8; j > 0; j >>= 1)
#pragma unroll
        for (int i = 0; i < 16; ++i) { const int q = i ^ j; if (q > i) CEX(L[i], L[q]); }
}
DI void phase_sel(const Params& p, const Frame& F, int l) {
    const _Float16* ST = (const _Float16*)(p.ws + WS_ST);
    unsigned short* IDX = (unsigned short*)(p.ws + WS_IDX);
    float* GW = (float*)(p.ws + WS_GW);
    float* SU = (float*)(p.ws + WS_SU);
    const float* TSC = (const float*)(p.ws + WS_TSCALE) + (size_t)l * 2 * NEXP;
    LAS unsigned char* ib = (LAS unsigned char*)F.lds;
    const int ntok = (l == 0) ? T : TL;
    for (int i0 = F.bid * NTHREADS; i0 < ntok * 8; i0 += F.nb * NTHREADS) {
        const int i = i0 + F.tid;
        const int tok = i % ntok, head = i / ntok;
        unsigned la[16], lb[16];
#pragma unroll
        for (int k = 0; k < 16; ++k) { la[k] = 0u; lb[k] = 0u; }
        const _Float16* s0 = ST + (size_t)(head * 256) * T + tok;
#define SEL_LOAD(B_, k0_) do { _Pragma("unroll") for (int j = 0; j < 32; ++j) B_[j] = sp[(size_t)((k0_) + j) * T]; } while (0)
#define SEL_GRP(L_, B_, o_, k0_) do { unsigned nk_[16]; \
        _Pragma("unroll") for (int j = 0; j < 16; ++j) nk_[j] = (fkey((float)B_[(o_) + j]) & ~127u) | (unsigned)(127 - ((k0_) + j)); \
        sort16_desc(nk_); merge16_desc(L_, nk_); } while (0)
#define SEL_HALF(L_, base_) do { const _Float16* sp = s0 + (size_t)(base_) * T; _Float16 bufa[32], bufb[32]; \
        SEL_LOAD(bufa, 0); \
        _Pragma("unroll 1") for (int k0 = 0; k0 < 128; k0 += 64) { \
            SEL_LOAD(bufb, k0 + 32); SEL_GRP(L_, bufa, 0, k0); SEL_GRP(L_, bufa, 16, k0 + 16); \
            SEL_LOAD(bufa, (k0 + 64) & 127); SEL_GRP(L_, bufb, 0, k0 + 32); SEL_GRP(L_, bufb, 16, k0 + 48); } } while (0)
        SEL_HALF(la, 0);
        SEL_HALF(lb, 128);
#undef SEL_LOAD
#undef SEL_GRP
#undef SEL_HALF
        float va[16], vb[16];
#pragma unroll
        for (int k = 0; k < 16; ++k) {
            va[k] = fkey_inv(la[k] & ~127u); vb[k] = fkey_inv(lb[k] & ~127u);
            ib[k * NTHREADS + F.tid] = (unsigned char)(127u - (la[k] & 127u));
            ib[(16 + k) * NTHREADS + F.tid] = (unsigned char)(127u - (lb[k] & 127u));
        }
        unsigned lc[16];
#pragma unroll
        for (int k = 0; k < 16; ++k) lc[k] = 0u;
#pragma unroll
        for (int a = 0; a < 16; ++a)
#pragma unroll
            for (int b = 0; b < 16; ++b)
                if ((a + 1) * (b + 1) <= 16) { const unsigned key = (fkey(va[a] + vb[b]) & ~255u) | (unsigned)(255 - (a * 16 + b)); INSERT16(lc, key); }
        float e[16], sum = 0.f; const float v0 = fkey_inv(lc[0] & ~255u);
#pragma unroll
        for (int k = 0; k < 16; ++k) { e[k] = __expf(fkey_inv(lc[k] & ~255u) - v0); sum += e[k]; }
        const float inv = 1.0f / sum;
        asm volatile("s_waitcnt lgkmcnt(0)" ::: "memory");
        unsigned exs[16]; float gws[16], sus[16];
#pragma unroll
        for (int k = 0; k < 16; ++k) {
            const unsigned pos = 255u - (lc[k] & 255u), a = pos >> 4, b = pos & 15u;
            const unsigned ea = ib[a * NTHREADS + F.tid], eb = ib[(16 + b) * NTHREADS + F.tid];
            exs[k] = ea * 128u + eb;
        }
#pragma unroll
        for (int k = 0; k < 16; ++k) { gws[k] = e[k] * inv * TSC[NEXP + exs[k]]; sus[k] = TSC[exs[k]]; }
        { const size_t o = (size_t)tok * 128 + head * 16;
#pragma unroll
          for (int q = 0; q < 2; ++q) { u32x4 w;
#pragma unroll
              for (int j = 0; j < 4; ++j) w[j] = exs[8 * q + 2 * j] | (exs[8 * q + 2 * j + 1] << 16);
              *(u32x4*)(IDX + o + 8 * q) = w; }
#pragma unroll
          for (int q = 0; q < 4; ++q) { *(f32x4*)(GW + o + 4 * q) = (f32x4){gws[4 * q], gws[4 * q + 1], gws[4 * q + 2], gws[4 * q + 3]};
                                        *(f32x4*)(SU + o + 4 * q) = (f32x4){sus[4 * q], sus[4 * q + 1], sus[4 * q + 2], sus[4 * q + 3]}; } }
        asm volatile("s_waitcnt lgkmcnt(0)" ::: "memory");
    }
}

DI float dpp_xor1(float v) { return __builtin_bit_cast(float, __builtin_amdgcn_mov_dpp(__builtin_bit_cast(int, v), 0xB1, 0xF, 0xF, true)); }
DI float dpp_xor2(float v) { return __builtin_bit_cast(float, __builtin_amdgcn_mov_dpp(__builtin_bit_cast(int, v), 0x4E, 0xF, 0xF, true)); }
DI float dpp_hmir(float v) { return __builtin_bit_cast(float, __builtin_amdgcn_mov_dpp(__builtin_bit_cast(int, v), 0x141, 0xF, 0xF, true)); }
DI float dot16_fp8(const u32x4 q, const float (&hx)[16]) {
    f32x2 a = {0.f, 0.f};
#pragma unroll
    for (int j = 0; j < 4; ++j) {
        const f32x2 lo = __builtin_amdgcn_cvt_pk_f32_fp8((int)q[j], false), hi = __builtin_amdgcn_cvt_pk_f32_fp8((int)q[j], true);
        a += lo * (f32x2){hx[4 * j], hx[4 * j + 1]}; a += hi * (f32x2){hx[4 * j + 2], hx[4 * j + 3]};
    }
    return a.x + a.y;
}
#define PEER_EXPERT(id, i) ((int)(((id)[(i) >> 3][((i) >> 1) & 3] >> (16 * ((i) & 1))) & 0xffffu))

DI int dpp_xor1i(int v) { return __builtin_amdgcn_mov_dpp(v, 0xB1, 0xF, 0xF, true); }
DI int dpp_xor2i(int v) { return __builtin_amdgcn_mov_dpp(v, 0x4E, 0xF, 0xF, true); }
DI int dpp_hmiri(int v) { return __builtin_amdgcn_mov_dpp(v, 0x141, 0xF, 0xF, true); }
struct PeerURows { u32x4 q[16]; u32x4 h; };
DI void peer_u_rows(PeerURows& R, const u32x4 (&id)[2], const unsigned char* ut, const unsigned char* hrow) {
    R.h = *(const u32x4*)(hrow);
#pragma unroll
    for (int i = 0; i < 16; ++i) R.q[i] = *(const u32x4*)(ut + (size_t)PEER_EXPERT(id, i) * D);
}
DI void peer_u_compute(const PeerURows& R, float* part, int lane) {
    int d[16];
#pragma unroll
    for (int i = 0; i < 16; ++i) { int a = 0;
#pragma unroll
        for (int j = 0; j < 4; ++j) a = __builtin_amdgcn_sdot4((int)R.q[i][j], (int)R.h[j], a, false);
        d[i] = a; }
    const bool b2 = (lane & 4) != 0, b1 = (lane & 2) != 0, b0 = (lane & 1) != 0;
    int k8[8];
#pragma unroll
    for (int i = 0; i < 8; ++i) { const int keep = b2 ? d[8 + i] : d[i], send = b2 ? d[i] : d[8 + i]; k8[i] = keep + dpp_hmiri(send); }
    int k4[4];
#pragma unroll
    for (int i = 0; i < 4; ++i) { const int keep = b1 ? k8[4 + i] : k8[i], send = b1 ? k8[i] : k8[4 + i]; k4[i] = keep + dpp_xor2i(send); }
    f32x2 k2;
    { const int keep0 = b0 ? k4[2] : k4[0], send0 = b0 ? k4[0] : k4[2], keep1 = b0 ? k4[3] : k4[1], send1 = b0 ? k4[1] : k4[3];
      k2.x = (float)(keep0 + dpp_xor1i(send0)); k2.y = (float)(keep1 + dpp_xor1i(send1)); }
    *(f32x2*)(part + 16 * (lane >> 3) + (b2 ? 8 : 0) + (b1 ? 4 : 0) + (b0 ? 2 : 0)) = k2;
}
DI void phase_peer_u(const Params& p, const Frame& F, int l) {
    const int ntok = (l == 0) ? T : TL, lane = F.lane;
    const int slice = F.bid & 7, sw = (F.bid >> 3) * NWAVES + F.wave, nsw = (F.nb >> 3) * NWAVES;
    const unsigned char* ut = p.ws + WS_UTAB + (size_t)l * NEXP * D + 128 * slice + 16 * (lane & 7);
    const unsigned char* Hs = p.ws + WS_H8 + 128 * slice + 16 * (lane & 7);
    const unsigned short* IDXg = (const unsigned short*)(p.ws + WS_IDX) + 16 * (lane >> 3);
    float* PART = (float*)(p.ws + WS_ST) + (size_t)slice * T * 128;
    const int last = ntok - 1;
    u32x4 sa[2], sb[2]; PeerURows ra, rb;
#define U_SEL(S_, t_) do { const unsigned short* ip_ = IDXg + (size_t)min((t_), last) * 128; S_[0] = *(const u32x4*)ip_; S_[1] = *(const u32x4*)(ip_ + 8); } while (0)
#define U_ROWS(R_, S_, t_) peer_u_rows(R_, S_, ut, Hs + (size_t)min((t_), last) * D)
    U_SEL(sa, sw); U_SEL(sb, sw + nsw);
    U_ROWS(ra, sa, sw);
#pragma unroll 1
    for (int tok = sw; tok < ntok; tok += 2 * nsw) {
        U_SEL(sa, tok + 2 * nsw); U_ROWS(rb, sb, tok + nsw);
        peer_u_compute(ra, PART + (size_t)tok * 128, lane);
        U_SEL(sb, tok + 3 * nsw); U_ROWS(ra, sa, tok + 2 * nsw);
        if (tok + nsw < ntok) peer_u_compute(rb, PART + (size_t)(tok + nsw) * 128, lane);
    }
#undef U_SEL
#undef U_ROWS
}
DI void phase_peer_c(const Params& p, const Frame& F, int l, bool dummy = false) {
    const int ntok = (l == 0) ? T : TL;
    const float* PART = (const float*)(p.ws + WS_ST);
    float* GW = (float*)(p.ws + WS_GW);
    float* CO = dummy ? (float*)(p.ws + WS_H8) : GW;
    const float* SU = (const float*)(p.ws + WS_SU);
    const float* HS = (const float*)(p.ws + WS_HS);
    for (int i0 = F.gtid; i0 < ntok * 128; i0 += 4 * F.ngt) {
        float s[4], gw[4], su[4];
#pragma unroll
        for (int u = 0; u < 4; ++u) {
            const int i = min(i0 + u * F.ngt, ntok * 128 - 1);
            s[u] = 0.f;
#pragma unroll
            for (int sl = 0; sl < 8; ++sl) s[u] += PART[(size_t)sl * T * 128 + i];
            gw[u] = GW[i]; su[u] = SU[i] * HS[i >> 7];
        }
#pragma unroll
        for (int u = 0; u < 4; ++u) { const int i = i0 + u * F.ngt; if (i < ntok * 128) CO[i] = gw[u] * gelu_tanh(s[u] * su[u]); }
    }
}
struct PeerVRows { u32x4 q[16]; f32x4 cf[4]; f32x4 xv, gv; };
DI void peer_v_rows(PeerVRows& R, const u32x4 (&id)[2], const unsigned char* vt, const float* cp, const float* xs, const float* gt2) {
    R.cf[0] = *(const f32x4*)cp; R.cf[1] = *(const f32x4*)(cp + 4); R.cf[2] = *(const f32x4*)(cp + 8); R.cf[3] = *(const f32x4*)(cp + 12);
    R.xv = *(const f32x4*)xs; R.gv = *(const f32x4*)gt2;
#pragma unroll
    for (int i = 0; i < 16; ++i) R.q[i] = *(const u32x4*)(vt + (size_t)PEER_EXPERT(id, i) * (D / 2));
}
DI float xchg32(float v, bool hi) { const auto r = __builtin_amdgcn_permlane32_swap(__builtin_bit_cast(unsigned, v), __builtin_bit_cast(unsigned, v), false, false);
    return __builtin_bit_cast(float, hi ? r[0] : r[1]); }
DI float xchg16(float v, bool hi) { const auto r = __builtin_amdgcn_permlane16_swap(__builtin_bit_cast(unsigned, v), __builtin_bit_cast(unsigned, v), false, false);
    return __builtin_bit_cast(float, hi ? r[0] : r[1]); }
DI float xchg8(float v) { return __builtin_bit_cast(float, __builtin_amdgcn_mov_dpp(__builtin_bit_cast(int, v), 0x128, 0xF, 0xF, true)); }
DI void peer_v_compute(const PeerVRows& R, float* xdst, int lane) {
    f32x2 a[16];
#pragma unroll
    for (int j = 0; j < 16; ++j) a[j] = (f32x2){0.f, 0.f};
#pragma unroll
    for (int i = 0; i < 16; ++i) {
        const float c = R.cf[i >> 2][i & 3]; const f32x2 c2 = {c, c};
#pragma unroll
        for (int d = 0; d < 4; ++d) {
            a[4 * d + 0] += c2 * __builtin_amdgcn_cvt_scalef32_pk_f32_fp4(R.q[i][d], 1.0f, 0);
            a[4 * d + 1] += c2 * __builtin_amdgcn_cvt_scalef32_pk_f32_fp4(R.q[i][d], 1.0f, 1);
            a[4 * d + 2] += c2 * __builtin_amdgcn_cvt_scalef32_pk_f32_fp4(R.q[i][d], 1.0f, 2);
            a[4 * d + 3] += c2 * __builtin_amdgcn_cvt_scalef32_pk_f32_fp4(R.q[i][d], 1.0f, 3);
        }
    }
    const bool b5 = (lane & 32) != 0, b4 = (lane & 16) != 0, b3 = (lane & 8) != 0;
    f32x2 k8[8];
#pragma unroll
    for (int j = 0; j < 8; ++j) { const f32x2 keep = b5 ? a[8 + j] : a[j], send = b5 ? a[j] : a[8 + j];
        k8[j] = keep + (f32x2){xchg32(send.x, b5), xchg32(send.y, b5)}; }
    f32x2 k4[4];
#pragma unroll
    for (int j = 0; j < 4; ++j) { const f32x2 keep = b4 ? k8[4 + j] : k8[j], send = b4 ? k8[j] : k8[4 + j];
        k4[j] = keep + (f32x2){xchg16(send.x, b4), xchg16(send.y, b4)}; }
    f32x2 k2[2];
#pragma unroll
    for (int j = 0; j < 2; ++j) { const f32x2 keep = b3 ? k4[2 + j] : k4[j], send = b3 ? k4[j] : k4[2 + j];
        k2[j] = keep + (f32x2){xchg8(send.x), xchg8(send.y)}; }
    *(f32x4*)xdst = R.xv + R.gv * (f32x4){k2[0].x, k2[0].y, k2[1].x, k2[1].y};
}
DI void phase_peer_v(const Params& p, const Frame& F, int l, bool dummy = false) {
    const int ntok = (l == 0) ? T : TL, lane = F.lane, half = ntok >> 1;
    const int grp = F.bid & 7, cs = grp & 3, th = grp >> 2, sw = (F.bid >> 3) * NWAVES + F.wave, nsw = (F.nb >> 3) * NWAVES;
    const unsigned char* vt = p.ws + WS_VTAB + (size_t)l * NEXP * (D / 2) + 128 * cs + 16 * (lane & 7);
    const unsigned short* IDXg = (const unsigned short*)(p.ws + WS_IDX) + 16 * (lane >> 3);
    const float* CFg = (const float*)(p.ws + WS_GW) + 16 * (lane >> 3);
    const int t0 = th * half, tend = t0 + half, last = tend - 1;
    u32x4 sa[2], sb[2]; PeerVRows ra, rb;
#define V_SEL(S_, t_) do { const unsigned short* ip_ = IDXg + (size_t)min((t_), last) * 128; S_[0] = *(const u32x4*)ip_; S_[1] = *(const u32x4*)(ip_ + 8); } while (0)
    const int co = 256 * cs + 32 * (lane & 7) + ((lane & 32) ? 16 : 0) + ((lane & 16) ? 8 : 0) + ((lane & 8) ? 4 : 0);
#define V_ROWS(R_, S_, t_) do { const int t1_ = min((t_), last); peer_v_rows(R_, S_, vt, CFg + (size_t)t1_ * 128, xrow_ptr(p, t1_) + co, mod_vec(p, l, t1_, 5) + co); } while (0)
#define V_DO(R_, t_) do { const int t2_ = (t_); float* xd_ = (dummy ? (float*)(p.ws + WS_ST) + (size_t)t2_ * D : xrow_ptr(p, t2_)) + co; peer_v_compute(R_, xd_, lane); } while (0)
    V_SEL(sa, t0 + sw); V_SEL(sb, t0 + sw + nsw);
    V_ROWS(ra, sa, t0 + sw);
#pragma unroll 1
    for (int tok = t0 + sw; tok < tend; tok += 2 * nsw) {
        V_SEL(sa, tok + 2 * nsw); V_ROWS(rb, sb, tok + nsw);
        V_DO(ra, tok);
        V_SEL(sb, tok + 3 * nsw); V_ROWS(ra, sa, tok + 2 * nsw);
        if (tok + nsw < tend) V_DO(rb, tok + nsw);
    }
#undef V_SEL
#undef V_ROWS
#undef V_DO
}

#define XB_TMO      128
#define XB_XCNT(j)  (256  + 64 * (j))
#define XB_XSUB(j)  (1280 + 64 * (j))
#define XB_XGEN(j)  (2304 + 64 * (j))
#define XB_TOP      3328
#define XB_TOPGEN   3392
#define XCD_BAR_WORDS 3456
#define XB_SPIN_CAP (1u << 18)
DI unsigned xb_ld(unsigned* p)              { return __hip_atomic_load(p, __ATOMIC_RELAXED, __HIP_MEMORY_SCOPE_AGENT); }
DI unsigned xb_add(unsigned* p, unsigned v) { return __hip_atomic_fetch_add(p, v, __ATOMIC_RELAXED, __HIP_MEMORY_SCOPE_AGENT); }
DI unsigned xb_xcc_id() { return (unsigned)__builtin_amdgcn_s_getreg((3 << 11) | 20) & 0xFu; }
#define XB_SPIN(cond, bar) do { unsigned _sp = 0; while (cond) { __builtin_amdgcn_s_sleep(1); \
    if ((++_sp & 255u) == 0u) { if (xb_ld(&(bar)[XB_TMO])) break; if (_sp > XB_SPIN_CAP) { atomicAdd(&(bar)[XB_TMO], 1u); break; } } } } while (0)
struct XcdBarrier { unsigned* bar; unsigned x; volatile LAS unsigned* st; };
DI XcdBarrier xcd_barrier_post(unsigned* bar, volatile LAS unsigned* st) {
    XcdBarrier b; b.bar = bar; b.x = xb_xcc_id(); b.st = st;
    if (threadIdx.x == 0) (void)xb_add(&bar[XB_XCNT(b.x)], 1u);
    return b;
}
DI void xcd_barrier_complete(unsigned* bar, unsigned x, unsigned& nloc, unsigned& nx) {
    const unsigned G = gridDim.x * gridDim.y * gridDim.z;
    unsigned sum, cnt, mine, sp = 0u;
    for (;;) {
        sum = 0u; cnt = 0u; mine = 0u;
#pragma unroll
        for (unsigned j = 0; j < 16; ++j) { const unsigned c = xb_ld(&bar[XB_XCNT(j)]); sum += c; cnt += (c > 0u) ? 1u : 0u; mine = (j == x) ? c : mine; }
        if (sum == G) break;
        __builtin_amdgcn_s_sleep(1);
        if ((++sp & 255u) == 0u) { if (xb_ld(&bar[XB_TMO])) break; if (sp > XB_SPIN_CAP) { atomicAdd(&bar[XB_TMO], 1u); break; } }
    }
    nloc = mine > 0u ? mine : 1u; nx = cnt > 0u ? cnt : 1u;
}
DI void xcd_barrier(const XcdBarrier& b) {
    asm volatile("s_waitcnt vmcnt(0)" ::: "memory");
    __syncthreads();
    if (threadIdx.x == 0) {
        unsigned* bar = b.bar;
        __builtin_amdgcn_s_waitcnt(0);
        unsigned nloc = b.st[0], nx = b.st[1];
        if (nloc == 0u) { xcd_barrier_complete(bar, b.x, nloc, nx); b.st[0] = nloc; b.st[1] = nx; }
        const unsigned old = xb_add(&bar[XB_XSUB(b.x)], 1u);
        const unsigned gen = old / nloc;
        if (old + 1u == (gen + 1u) * nloc) {
            __builtin_amdgcn_fence(__ATOMIC_RELEASE, "agent");
            asm volatile("s_waitcnt vmcnt(0)" ::: "memory");
            const unsigned og = xb_add(&bar[XB_TOP], 1u);
            const unsigned tg = og / nx;
            if (og + 1u == (tg + 1u) * nx) xb_add(&bar[XB_TOPGEN], 1u);
            else XB_SPIN(xb_ld(&bar[XB_TOPGEN]) == tg, bar);
            __builtin_amdgcn_fence(__ATOMIC_ACQUIRE, "agent");
            xb_add(&bar[XB_XGEN(b.x)], 1u);
            asm volatile("s_waitcnt vmcnt(0)" ::: "memory");
        } else {
            XB_SPIN(xb_ld(&bar[XB_XGEN(b.x)]) == gen, bar);
            __builtin_amdgcn_fence(__ATOMIC_ACQUIRE, "agent");
            asm volatile("s_waitcnt vmcnt(0)" ::: "memory");
        }
    }
    __syncthreads();
}

constexpr int NPHASE = 25;
template <int PH> DI void run_phase(const Params& p, const Frame& F) {
    if constexpr (PH == 0) phase_prep(p, F);
    else if constexpr (PH == 1) phase_norm(p, F, 0, 0, true, T);
    else if constexpr (PH == 2) phase_g1(p, F, 0);
    else if constexpr (PH == 3) phase_mix(p, F, 0);
    else if constexpr (PH == 4) phase_g2(p, F, 0);
    else if constexpr (PH == 5) phase_g2sum(p, F);
    else if constexpr (PH == 6) phase_g3(p, F, 0);
    else if constexpr (PH == 7) phase_norm(p, F, 0, 1, false, T);
    else if constexpr (PH == 8) phase_g45(p, F, 0);
    else if constexpr (PH == 9) phase_sel(p, F, 0);
    else if constexpr (PH == 10) phase_peer_u(p, F, 0);
    else if constexpr (PH == 11) phase_peer_c(p, F, 0);
    else if constexpr (PH == 12) phase_peer_v(p, F, 0);
    else if constexpr (PH == 13) phase_norm(p, F, 1, 0, false, T);
    else if constexpr (PH == 14) phase_g1(p, F, 1);
    else if constexpr (PH == 15) phase_mix(p, F, 1);
    else if constexpr (PH == 16) phase_g2(p, F, 1);
    else if constexpr (PH == 17) phase_g3(p, F, 1);
    else if constexpr (PH == 18) phase_norm(p, F, 1, 1, false, TL);
    else if constexpr (PH == 19) phase_g45(p, F, 1);
    else if constexpr (PH == 20) phase_sel(p, F, 1);
    else if constexpr (PH == 21) phase_peer_u(p, F, 1);
    else if constexpr (PH == 22) phase_peer_c(p, F, 1);
    else if constexpr (PH == 23) phase_peer_v(p, F, 1);
    else if constexpr (PH == 24) phase_final(p, F);
}
DI Frame make_frame(unsigned char* lds_raw) {
    Frame F;
    F.lds = (LAS unsigned char*)lds_raw;
    int tid = threadIdx.x; asm volatile("" : "+v"(tid));
    int bid = blockIdx.x, nb = gridDim.x; asm volatile("" : "+s"(bid), "+s"(nb));
    F.tid = tid; F.lane = tid & 63; F.wave = __builtin_amdgcn_readfirstlane(tid >> 6); F.bid = bid; F.nb = nb;
    F.gw = bid * NWAVES + F.wave; F.ngw = nb * NWAVES; F.gtid = bid * NTHREADS + tid; F.ngt = nb * NTHREADS;
    return F;
}
template <int PH> DI void run_phase_fresh(unsigned char* lds_raw) {
#if defined(__HIP_DEVICE_COMPILE__)
    const __attribute__((address_space(4))) unsigned long long* pp = (const __attribute__((address_space(4))) unsigned long long*)__builtin_amdgcn_kernarg_segment_ptr();
    asm volatile("" : "+s"(pp));
    Params p;
#pragma unroll
    for (int i = 0; i < N_IN; ++i) p.in[i] = (const float*)(const __attribute__((address_space(1))) float*)pp[i];
    p.out = (float*)(__attribute__((address_space(1))) float*)pp[N_IN]; p.ws = (unsigned char*)(__attribute__((address_space(1))) unsigned char*)pp[N_IN + 1]; p.ph_lo = 0; p.ph_hi = 0;
#else
    Params p{};
#endif
    const Frame F = make_frame(lds_raw);
    run_phase<PH>(p, F);
}
template <int PH> __global__ void __launch_bounds__(NTHREADS, 2) phase_kernel(Params p) {
    extern __shared__ __attribute__((aligned(16))) unsigned char lds_raw[];
    run_phase_fresh<PH>(lds_raw);
}
template <int PH> DI void run_all(unsigned char* lds_raw, cg::grid_group& grid, const XcdBarrier& bar) {
    if constexpr (PH < NPHASE) {
        if constexpr (PH == PROBE_PH) {
            if constexpr (PH == 11 || PH == 22 || PH == 12 || PH == 23) {
#if defined(__HIP_DEVICE_COMPILE__)
                const __attribute__((address_space(4))) unsigned long long* pp = (const __attribute__((address_space(4))) unsigned long long*)__builtin_amdgcn_kernarg_segment_ptr();
                asm volatile("" : "+s"(pp));
                Params p;
#pragma unroll
                for (int i = 0; i < N_IN; ++i) p.in[i] = (const float*)(const __attribute__((address_space(1))) float*)pp[i];
                p.out = (float*)(__attribute__((address_space(1))) float*)pp[N_IN]; p.ws = (unsigned char*)(__attribute__((address_space(1))) unsigned char*)pp[N_IN + 1]; p.ph_lo = 0; p.ph_hi = 0;
                const Frame F = make_frame(lds_raw);
                if constexpr (PH == 11 || PH == 22) phase_peer_c(p, F, PH == 11 ? 0 : 1, true); else phase_peer_v(p, F, PH == 12 ? 0 : 1, true);
#endif
            } else run_phase_fresh<PH>(lds_raw);
            xcd_barrier(bar);
        }
        run_phase_fresh<PH>(lds_raw);
        if constexpr (PH + 1 < NPHASE) { xcd_barrier(bar); if constexpr (PROBE_SYNC) xcd_barrier(bar); }
        run_all<PH + 1>(lds_raw, grid, bar);
    }
}
__global__ void __launch_bounds__(NTHREADS, 2) mega(Params p) {
    extern __shared__ __attribute__((aligned(16))) unsigned char lds_raw[];
    cg::grid_group grid = cg::this_grid();
    volatile LAS unsigned* st = (volatile LAS unsigned*)((LAS unsigned char*)lds_raw + LDS_BAR_OFF);
    if (threadIdx.x < 2) st[threadIdx.x] = 0u;
    __syncthreads();
    const XcdBarrier bar = xcd_barrier_post((unsigned*)(p.ws + WS_CTL), st);
    if (p.ph_lo != 0) grid.sync();
    run_all<0>(lds_raw, grid, bar);
}

extern "C" void kernel_launch(void* const* d_in, const int* in_sizes, int n_in, void* d_out, int out_size, void* d_ws, size_t ws_size, hipStream_t stream) {
    static int grid = 0;
    if (grid == 0) {
        if (n_in != 23 || out_size != TL * D || ws_size < WS_END) { fprintf(stderr, "kernel_launch: unexpected shapes (n_in %d out %d ws %zu)\n", n_in, out_size, ws_size); grid = -1; return; }
        int dev = 0, cus = 0, per_cu = 0;
        (void)hipGetDevice(&dev);
        (void)hipDeviceGetAttribute(&cus, hipDeviceAttributeMultiprocessorCount, dev);
        (void)hipFuncSetAttribute((const void*)mega, hipFuncAttributeMaxDynamicSharedMemorySize, LDS_BYTES);
        (void)hipOccupancyMaxActiveBlocksPerMultiprocessor(&per_cu, (const void*)mega, NTHREADS, LDS_BYTES);
        if (per_cu < 1) { fprintf(stderr, "kernel_launch: occupancy query reports %d blocks per CU\n", per_cu); grid = -1; return; }
        grid = cus & ~7;
        if (grid < 8) { fprintf(stderr, "kernel_launch: needs at least 8 CUs\n"); grid = -1; return; }
    }
    if (grid < 0) return;
    (void)hipMemsetAsync((char*)d_ws + WS_CTL, 0, CTL_ZERO_BYTES, stream);
    Params p{};
    for (int i = 0; i < N_IN; ++i) p.in[i] = (const float*)d_in[i];
    p.out = (float*)d_out; p.ws = (unsigned char*)d_ws;
    void* args[] = {&p};
    hipError_t e = hipLaunchCooperativeKernel((const void*)mega, dim3(grid), dim3(NTHREADS), args, LDS_BYTES, stream);
    if (e != hipSuccess) fprintf(stderr, "cooperative launch failed: %s (grid %d)\n", hipGetErrorString(e), grid);
}
```

```cpp
#include <hip/hip_runtime.h>
#include <hip/hip_cooperative_groups.h>
#include <stdint.h>
#include <stdio.h>
namespace cg = cooperative_groups;

#ifndef PROBE_PH
#define PROBE_PH -1
#endif
#ifndef PROBE_SYNC
#define PROBE_SYNC 0
#endif
#ifndef MK_SINGLE
#define MK_SINGLE 0
#endif

#define LAS __attribute__((address_space(3)))
typedef unsigned short bf16_t;
typedef short bf16x8 __attribute__((ext_vector_type(8)));
typedef short s16x4 __attribute__((ext_vector_type(4)));
typedef float f32x4 __attribute__((ext_vector_type(4)));
typedef float f32x2 __attribute__((ext_vector_type(2)));
typedef float f32x16 __attribute__((ext_vector_type(16)));
typedef unsigned u32x4 __attribute__((ext_vector_type(4)));
typedef unsigned u32x2 __attribute__((ext_vector_type(2)));
typedef __bf16 bf16x2_t __attribute__((ext_vector_type(2)));
typedef _Float16 f16x2_t __attribute__((ext_vector_type(2)));
#define DI __device__ __forceinline__
DI unsigned pkh2(float lo, float hi) { f16x2_t v = {(_Float16)lo, (_Float16)hi}; return __builtin_bit_cast(unsigned, v); }
#define MFMA32(a, b, c) __builtin_amdgcn_mfma_f32_32x32x16_bf16((a), (b), (c), 0, 0, 0)

constexpr int D = 1024, NB = 8, SEQ = 4096, NCTX = 256, DEPTH = 2;
constexpr int TL = NB * SEQ, TC = NB * NCTX, T = TL + TC;
constexpr int INW = 4608, NMOD = 6 * D, PW = 1600, PN = 1536;
constexpr int VTS = SEQ + 64;
constexpr int QOFF = 0, KOFF = 512, VOFF = 640, POOLOFF = 768, SUOFF = 1024, SVOFF = 1280, GATEOFF = 1536;
constexpr int NEXP = 16384;
constexpr float EPS = 1e-6f;
constexpr float LOG2E = 1.4426950408889634f;
constexpr float QSCALE = 0.125f * LOG2E;

constexpr size_t MiB = 1u << 20;
constexpr size_t WS_CTL = 0, WS_MOD = 1 * MiB, CTL_ZERO_BYTES = 2 * MiB;
constexpr size_t WS_ROPE = 2 * MiB, WS_SGUW = 2 * MiB + 65536, WS_TSCALE = 3 * MiB;
constexpr size_t WS_WIN = 4 * MiB, WS_WBR = 22 * MiB, WS_WOUT = 26 * MiB, WS_WFOLD = 30 * MiB;
constexpr size_t WS_XCTX = 38 * MiB, WS_UTAB = 46 * MiB, WS_VTAB = 78 * MiB;
constexpr size_t WS_IDX = 110 * MiB, WS_GW = 120 * MiB;
constexpr size_t WS_H = 142 * MiB;
constexpr size_t WS_P = 210 * MiB, WS_Y = 318 * MiB, WS_MERGED = 386 * MiB, WS_VT = 454 * MiB, WS_VTC = 463 * MiB, WS_VST = 464 * MiB;
constexpr size_t WS_MP = 482 * MiB;
constexpr size_t WS_ST = 210 * MiB, WS_H8 = 346 * MiB, WS_HS = 380 * MiB, WS_SU = 482 * MiB;
constexpr size_t WS_END = 512 * MiB;
static_assert(WS_ST + (size_t)2048 * T * 2 <= WS_H8 && WS_H8 + (size_t)T * D <= WS_HS, "ST / H8 fit");
static_assert(WS_VST + (size_t)272 * 256 * 128 * 2 <= WS_SU && WS_VT + (size_t)NB * 2 * 64 * VTS * 2 <= WS_VTC, "VsT / VT fit");
static_assert(WS_H + (size_t)T * D * 2 <= WS_P, "H fits");
static_assert(WS_P + (size_t)T * PW * 2 <= WS_Y && WS_Y + (size_t)T * D * 2 <= WS_MERGED && WS_MERGED + (size_t)T * D * 2 <= WS_VT, "P/Y/MERGED fit");
static_assert(WS_IDX + (size_t)T * 128 * 2 <= WS_GW && WS_GW + (size_t)T * 128 * 4 <= WS_H && WS_SU + (size_t)T * 128 * 4 <= WS_END && WS_HS + (size_t)T * 4 <= WS_SU, "idx/gw/su fit");

constexpr int LDS_BYTES = 163840;
constexpr int LDS_BAR_OFF = LDS_BYTES - 64;
constexpr int NTHREADS = 512, NWAVES = 8;

enum { I_x, I_c, I_ctx, I_c_ctx, I_w_mod, I_b_mod, I_g_mix, I_g_ffn, I_w_in, I_attn_sink, I_pool_w, I_pool_scale, I_sgu_w, I_sgu_b, I_w_br_attn, I_w_br_pool, I_w_br_sgu, I_w_out, I_peer_wq, I_peer_subkeys, I_peer_u, I_peer_v, I_g_final, N_IN };
struct Params {
    const float* in[N_IN];
    float* out; unsigned char* ws;
    int ph_lo, ph_hi;
};

DI unsigned pk2(float lo, float hi) { f32x2 v = {lo, hi}; return __builtin_bit_cast(unsigned, __builtin_convertvector(v, bf16x2_t)); }
DI unsigned f2bf(float f) { return pk2(f, 0.f) & 0xffffu; }
DI float bf2f(unsigned short u) { return __builtin_bit_cast(float, (unsigned)u << 16); }
DI float bflo(unsigned w) { return __builtin_bit_cast(float, w << 16); }
DI float bfhi(unsigned w) { return __builtin_bit_cast(float, w & 0xffff0000u); }
DI int crow(int reg, int h) { return (reg & 3) + 8 * (reg >> 2) + 4 * h; }
DI int dpp_x1(int v) { return __builtin_amdgcn_mov_dpp(v, 0xB1, 0xF, 0xF, true); }
DI float wave_sum(float v) {
#pragma unroll
    for (int o = 1; o < 64; o <<= 1) v += __shfl_xor(v, o);
    return v;
}
DI float sigmoidf_(float x) { return __builtin_amdgcn_rcpf(1.0f + __expf(-x)); }
DI float gelu_tanh(float x) { const float u = 0.7978845608028654f * (x + 0.044715f * x * x * x); return x * __builtin_amdgcn_rcpf(1.0f + __expf(-2.0f * u)); }
DI float silu_(float x) { return x * __builtin_amdgcn_rcpf(1.0f + __expf(-x)); }

struct Frame {
    int tid, lane, wave, gw, ngw, gtid, ngt, bid, nb;
    LAS unsigned char* lds;
};

template <int NM, int NN>
DI void wave_gemm(const bf16_t* __restrict__ A, int lda, const bf16_t* __restrict__ Bt, int ldb, int K, int m0, int n0, f32x16 (&acc)[NM][NN], int lane) {
    const int r = lane & 31, h = lane >> 5;
    const bf16_t* ap = A + (size_t)(m0 + r) * lda + 8 * h;
    const bf16_t* bp = Bt + (size_t)(n0 + r) * ldb + 8 * h;
    for (int k0 = 0; k0 < K; k0 += 64) {
        bf16x8 a[4][NM], b[4][NN];
#pragma unroll
        for (int s = 0; s < 4; ++s) {
#pragma unroll
            for (int i = 0; i < NM; ++i) a[s][i] = *(const bf16x8*)(ap + (size_t)(32 * i) * lda + k0 + 16 * s);
#pragma unroll
            for (int j = 0; j < NN; ++j) b[s][j] = *(const bf16x8*)(bp + (size_t)(32 * j) * ldb + k0 + 16 * s);
        }
#pragma unroll
        for (int s = 0; s < 4; ++s)
#pragma unroll
            for (int i = 0; i < NM; ++i)
#pragma unroll
                for (int j = 0; j < NN; ++j) acc[i][j] = MFMA32(a[s][i], b[s][j], acc[i][j]);
    }
}
template <int NM, int NN> DI void zero_acc(f32x16 (&acc)[NM][NN]) {
#pragma unroll
    for (int i = 0; i < NM; ++i)
#pragma unroll
        for (int j = 0; j < NN; ++j)
#pragma unroll
            for (int r = 0; r < 16; ++r) acc[i][j][r] = 0.f;
}

namespace pg8 {
constexpr int BM = 256, BK = 64, HALF = 128, HTB = HALF * BK * 2, STAGE_BYTES = 8 * HTB, NXCD = 8, WGM = 8, LD = 1024;
DI int lds_byte(int r, int c) { const int st = (r >> 4) * 2 + (c >> 5), rr = r & 15, cc = c & 31, ob = rr * 64 + cc * 2; return st * 1024 + (ob ^ (((ob >> 9) & 1) << 5)); }
DI void stage_rc(int b, int& R, int& C) { const int st = b / 1024, sb = b % 1024, swz = sb ^ (((sb >> 9) & 1) << 5); R = (st >> 1) * 16 + swz / 64; C = (st & 1) * 32 + (swz % 64) / 2; }
DI int perm32(int rho) { const int n = rho >> 4, i = rho & 15; return 8 * (i >> 2) + 4 * n + (i & 3); }
struct Unit { int pm, pn, sub, nt, mode; const char* a; const char* b; };
DI void tile_of(int L, int nM, int nN, int& pm, int& pn) {
    const int nwg = nM * nN; int wgid = L;
    { const int q = nwg / NXCD, r = nwg % NXCD, xcd = wgid % NXCD, off = wgid / NXCD; wgid = (xcd < r ? xcd * (q + 1) : r * (q + 1) + (xcd - r) * q) + off; }
    const int nig = WGM * nN, gid = wgid / nig, fm = gid * WGM, gsz = (nM - fm) < WGM ? (nM - fm) : WGM;
    pm = fm + ((wgid % nig) % gsz); pn = (wgid % nig) / gsz;
}
template <class Epi, class Sched>
DI void gemm_phase(LAS unsigned char* lds, const int tid, const Sched& S, const Epi& E) {
    const int wid = __builtin_amdgcn_readfirstlane(tid >> 6), lane = tid & 63, wr = wid >> 2, wc = wid & 3, fr = lane & 15, fq = lane >> 4;
    unsigned voffA[2], voffB[2];
#pragma unroll
    for (int i = 0; i < 2; ++i) { int R, C; stage_rc(tid * 16 + i * 8192, R, C); const int Rb = Epi::PERM ? ((R & ~31) + perm32(R & 31)) : R;
        voffA[i] = (unsigned)(R * LD + C) * 2u; voffB[i] = (unsigned)(Rb * LD + C) * 2u; }
    const size_t kstep = (size_t)(BK * 2);
    const size_t hstep = (size_t)HALF * LD * 2;
    const unsigned ldsw = (unsigned)wid * 1024u;
    const int aoff = lds_byte(wr * 64 + fr, fq * 8), boff = lds_byte(wc * 32 + fr, fq * 8);
#define PG8_SA(b, h) (((b) * 2 + (h)) * HTB)
#define PG8_SB(b, h) ((4 + (b) * 2 + (h)) * HTB)
#define PG8_STAGE(bufoff, gbase, voff) do { _Pragma("unroll") for (int _i = 0; _i < 2; ++_i) \
        __builtin_amdgcn_global_load_lds((const unsigned*)((const char*)(gbase) + (voff)[_i]), (LAS unsigned*)(lds + (bufoff) + ldsw + _i * 8192), 16, 0, 0); } while (0)
#define PG8_LDA(dst, b, h) do { _Pragma("unroll") for (int m = 0; m < 4; ++m) _Pragma("unroll") for (int k = 0; k < 2; ++k) dst[m][k] = *(const LAS bf16x8*)(lds + PG8_SA(b, h) + aoff + m * 2048 + k * 1024); } while (0)
#define PG8_LDB(dst, b, h) do { _Pragma("unroll") for (int n = 0; n < 2; ++n) _Pragma("unroll") for (int k = 0; k < 2; ++k) dst[n][k] = *(const LAS bf16x8*)(lds + PG8_SB(b, h) + boff + n * 2048 + k * 1024); } while (0)
#define PG8_MMA(ai, bj, At, Bt) do { __builtin_amdgcn_s_setprio(1); _Pragma("unroll") for (int m = 0; m < 4; ++m) _Pragma("unroll") for (int n = 0; n < 2; ++n) _Pragma("unroll") for (int k = 0; k < 2; ++k) \
        acc[ai][bj][m][n] = __builtin_amdgcn_mfma_f32_16x16x32_bf16(Bt[n][k], At[m][k], acc[ai][bj][m][n], 0, 0, 0); __builtin_amdgcn_s_setprio(0); } while (0)
#define PG8_WAIT_V(n) asm volatile("s_waitcnt vmcnt(" #n ")" ::: "memory")
#define PG8_WAIT_L(n) asm volatile("s_waitcnt lgkmcnt(" #n ")" ::: "memory")
#define PG8_BAR __builtin_amdgcn_s_barrier()
#define PG8_SCHED __builtin_amdgcn_sched_barrier(0)
    Unit cur, nxt; int ui = 0;
    if (!S.next(0, cur)) return;
    f32x4 acc[2][2][4][2];
#pragma unroll
    for (int a = 0; a < 2; ++a)
#pragma unroll
        for (int b = 0; b < 2; ++b)
#pragma unroll
            for (int m = 0; m < 4; ++m)
#pragma unroll
                for (int n = 0; n < 2; ++n) acc[a][b][m][n] = (f32x4){0.f, 0.f, 0.f, 0.f};
    bf16x8 At[4][2], B0[2][2], B1[2][2];
    const char* cA = cur.a; const char* cB = cur.b;
    PG8_STAGE(PG8_SB(0, 0), cB, voffB); PG8_STAGE(PG8_SB(0, 1), cB + hstep, voffB); PG8_STAGE(PG8_SA(0, 0), cA, voffA); PG8_STAGE(PG8_SA(0, 1), cA + hstep, voffA);
    if (wr == 1) PG8_BAR;
    PG8_WAIT_V(2); PG8_BAR;
    PG8_STAGE(PG8_SB(1, 0), cB + kstep, voffB); PG8_STAGE(PG8_SA(1, 0), cA + kstep, voffA); PG8_STAGE(PG8_SB(1, 1), cB + hstep + kstep, voffB);
    PG8_WAIT_V(6); PG8_BAR;
    for (;;) {
        const bool has_next = S.next(ui + 1, nxt);
        const char* nA = has_next ? nxt.a : cA; const char* nB = has_next ? nxt.b : cB;
        const int nt = cur.nt;
        for (int t = 0; t < nt; t += 2) {
            const bool last = (t == nt - 2);
            const char* a1 = cA + (size_t)(t + 1) * kstep;
            const char* a2 = last ? nA : cA + (size_t)(t + 2) * kstep; const char* b2 = last ? nB : cB + (size_t)(t + 2) * kstep;
            const char* a3 = a2 + kstep; const char* b3 = b2 + kstep;
            PG8_LDB(B0, 0, 0); PG8_LDB(B1, 0, 1); PG8_SCHED; PG8_LDA(At, 0, 0); PG8_STAGE(PG8_SA(1, 1), a1 + hstep, voffA);
            PG8_WAIT_V(8); PG8_WAIT_L(0); PG8_BAR; PG8_MMA(0, 0, At, B0); PG8_MMA(0, 1, At, B1); PG8_BAR; PG8_SCHED;
            PG8_LDA(At, 0, 1); PG8_STAGE(PG8_SB(0, 0), b2, voffB); PG8_STAGE(PG8_SB(0, 1), b2 + hstep, voffB); PG8_STAGE(PG8_SA(0, 0), a2, voffA);
            PG8_WAIT_V(8); PG8_WAIT_L(0); PG8_BAR; PG8_MMA(1, 0, At, B0); PG8_MMA(1, 1, At, B1); PG8_BAR; PG8_SCHED;
            PG8_LDB(B0, 1, 0); PG8_LDB(B1, 1, 1); PG8_SCHED; PG8_LDA(At, 1, 0); PG8_STAGE(PG8_SA(0, 1), a2 + hstep, voffA);
            PG8_WAIT_V(8); PG8_WAIT_L(0); PG8_BAR; PG8_MMA(0, 0, At, B0); PG8_MMA(0, 1, At, B1); PG8_BAR; PG8_SCHED;
            PG8_LDA(At, 1, 1); PG8_STAGE(PG8_SB(1, 0), b3, voffB); PG8_STAGE(PG8_SB(1, 1), b3 + hstep, voffB); PG8_STAGE(PG8_SA(1, 0), a3, voffA);
            PG8_WAIT_V(8); PG8_WAIT_L(0); PG8_BAR; PG8_MMA(1, 0, At, B0); PG8_MMA(1, 1, At, B1); PG8_BAR; PG8_SCHED;
        }
        if (wr == 0) PG8_BAR;
        E(acc, cur, wr, wc, fr, fq);
        if (!has_next) break;
        if (!E.keeps(cur)) {
#pragma unroll
        for (int a = 0; a < 2; ++a)
#pragma unroll
            for (int b = 0; b < 2; ++b)
#pragma unroll
                for (int m = 0; m < 4; ++m)
#pragma unroll
                    for (int n = 0; n < 2; ++n) acc[a][b][m][n] = (f32x4){0.f, 0.f, 0.f, 0.f};
        }
        cur = nxt; cA = nA; cB = nB; ++ui;
        if (wr == 1) PG8_BAR;
    }
    PG8_WAIT_V(0);
    PG8_BAR;
#undef PG8_SA
#undef PG8_SB
#undef PG8_STAGE
#undef PG8_LDA
#undef PG8_LDB
#undef PG8_MMA
#undef PG8_WAIT_V
#undef PG8_WAIT_L
#undef PG8_BAR
#undef PG8_SCHED
}
}

DI void transpose_item(const float* W, int K, int N, bf16_t* WT, int ldd, int row_off, int col_off, LAS float* scr, int item, int lane) {
    const int nblk = N / 32, kb = item / nblk, nb = item % nblk, k0 = 64 * kb, n0 = 32 * nb;
#pragma unroll 8
    for (int i = 0; i < 32; ++i) { const int kk = 2 * i + (lane >> 5); scr[kk * 33 + (lane & 31)] = W[(size_t)(k0 + kk) * N + n0 + (lane & 31)]; }
    asm volatile("s_waitcnt lgkmcnt(0)" ::: "memory");
    const int c = lane & 7;
#pragma unroll
    for (int j = 0; j < 4; ++j) { const int n = (lane >> 3) + 8 * j; const LAS float* s = scr + (8 * c) * 33 + n;
        u32x4 o; o.x = pk2(s[0 * 33], s[1 * 33]); o.y = pk2(s[2 * 33], s[3 * 33]); o.z = pk2(s[4 * 33], s[5 * 33]); o.w = pk2(s[6 * 33], s[7 * 33]);
        *(u32x4*)(WT + (size_t)(row_off + n0 + n) * ldd + col_off + k0 + 8 * c) = o; }
    asm volatile("s_waitcnt lgkmcnt(0)" ::: "memory");
}

DI void convert_tables(const Params& p, const Frame& F) {
    for (int it0 = 4 * F.gw; it0 < 4 * NEXP; it0 += 4 * F.ngw) {
        f32x4 v[4][4];
#pragma unroll
        for (int u = 0; u < 4; ++u) {
            const int it = it0 + u, e = it & (NEXP - 1), tbl = (it >> 14) & 1, l = it >> 15;
            const f32x4* src = (const f32x4*)((tbl ? p.in[I_peer_v] : p.in[I_peer_u]) + ((size_t)l * NEXP + e) * D) + 4 * F.lane;
#pragma unroll
            for (int j = 0; j < 4; ++j) v[u][j] = src[j];
        }
#pragma unroll
        for (int u = 0; u < 4; ++u) {
            const int it = it0 + u, e = it & (NEXP - 1), tbl = (it >> 14) & 1, l = it >> 15;
            float am = 0.f;
#pragma unroll
            for (int j = 0; j < 4; ++j) am = fmaxf(am, fmaxf(fmaxf(fabsf(v[u][j].x), fabsf(v[u][j].y)), fmaxf(fabsf(v[u][j].z), fabsf(v[u][j].w))));
#pragma unroll
            for (int o = 1; o < 64; o <<= 1) am = fmaxf(am, __shfl_xor(am, o));
            float sc;
            if (tbl) sc = (am > 0.f) ? 6.0f / am : 1.0f;
            else {
                float ss = 0.f;
#pragma unroll
                for (int j = 0; j < 4; ++j) ss += v[u][j].x * v[u][j].x + v[u][j].y * v[u][j].y + v[u][j].z * v[u][j].z + v[u][j].w * v[u][j].w;
                const float rms = sqrtf(wave_sum(ss) * (1.0f / D));
                const float step = fminf(am * (1.0f / 7.0f), 0.41f * rms);
                sc = (step > 0.f) ? 1.0f / step : 1.0f;
            }
            if (tbl) {
                u32x2 q4;
#pragma unroll
                for (int d = 0; d < 2; ++d) { unsigned w = 0;
                    w = __builtin_amdgcn_cvt_scalef32_pk_fp4_f32(w, v[u][2 * d][0] * sc, v[u][2 * d][1] * sc, 1.0f, 0);
                    w = __builtin_amdgcn_cvt_scalef32_pk_fp4_f32(w, v[u][2 * d][2] * sc, v[u][2 * d][3] * sc, 1.0f, 1);
                    w = __builtin_amdgcn_cvt_scalef32_pk_fp4_f32(w, v[u][2 * d + 1][0] * sc, v[u][2 * d + 1][1] * sc, 1.0f, 2);
                    w = __builtin_amdgcn_cvt_scalef32_pk_fp4_f32(w, v[u][2 * d + 1][2] * sc, v[u][2 * d + 1][3] * sc, 1.0f, 3);
                    q4[d] = w; }
                *(u32x2*)(p.ws + WS_VTAB + ((size_t)l * NEXP + e) * (D / 2) + 8 * F.lane) = q4;
            } else {
                u32x2 q4;
#pragma unroll
                for (int d = 0; d < 2; ++d) { unsigned w = 0;
#pragma unroll
                    for (int b = 0; b < 4; ++b) { const int j = 2 * d + (b >> 1), e2 = 2 * (b & 1);
                        const int n0 = (int)fminf(fmaxf(__builtin_rintf(v[u][j][e2] * sc), -8.0f), 7.0f) + 8, n1 = (int)fminf(fmaxf(__builtin_rintf(v[u][j][e2 + 1] * sc), -8.0f), 7.0f) + 8;
                        w |= (unsigned)(n0 | (n1 << 4)) << (8 * b); }
                    q4[d] = w; }
                *(u32x2*)(p.ws + WS_UTAB + ((size_t)l * NEXP + e) * (D / 2) + 8 * F.lane) = q4;
            }
            if (F.lane == 0) ((float*)(p.ws + WS_TSCALE))[(l * 2 + tbl) * NEXP + e] = 1.0f / sc;
        }
    }
}

DI void phase_prep(const Params& p, const Frame& F) {
    unsigned char* ws = p.ws;
    {
        LAS float* wq = (LAS float*)F.lds;
        LAS float* skl = wq + 128 * 65;
        for (int it = F.bid; it < 2 * 16 * 16; it += F.nb) {
            const int cc = it & 15, hp = (it >> 4) & 15, l = it >> 8;
            const float* src = p.in[I_peer_wq] + (size_t)l * D * 2048 + hp * 128;
            const float* sks = p.in[I_peer_subkeys] + (size_t)(l * 16 + hp) * 128 * 128;
            __syncthreads();
            { float tw[16]; f32x4 ts[8];
#pragma unroll
              for (int it = 0; it < 16; ++it) { const int e = F.tid + it * NTHREADS, ci = e >> 7, d = e & 127; tw[it] = src[(size_t)(cc * 64 + ci) * 2048 + d]; }
#pragma unroll
              for (int it = 0; it < 8; ++it) { const int e = F.tid + it * NTHREADS, key = e >> 5, d4 = (e & 31) * 4; ts[it] = *(const f32x4*)(sks + key * 128 + d4); }
#pragma unroll
              for (int it = 0; it < 16; ++it) { const int e = F.tid + it * NTHREADS, ci = e >> 7, d = e & 127; wq[d * 65 + ci] = tw[it]; }
#pragma unroll
              for (int it = 0; it < 8; ++it) { const int e = F.tid + it * NTHREADS, key = e >> 5, d4 = (e & 31) * 4; *(LAS f32x4*)(skl + key * 132 + d4) = ts[it]; } }
            __syncthreads();
            const int ci = F.tid & 63, kg = F.tid >> 6;
            float acc[16];
#pragma unroll
            for (int k = 0; k < 16; ++k) acc[k] = 0.f;
#pragma unroll 2
            for (int d = 0; d < 128; d += 4) {
                const float w0 = wq[d * 65 + ci], w1 = wq[(d + 1) * 65 + ci], w2 = wq[(d + 2) * 65 + ci], w3 = wq[(d + 3) * 65 + ci];
#pragma unroll
                for (int k = 0; k < 16; ++k) { const f32x4 s = *(const LAS f32x4*)(skl + (16 * kg + k) * 132 + d); acc[k] += w0 * s.x + w1 * s.y + w2 * s.z + w3 * s.w; }
            }
            bf16_t* dst = (bf16_t*)(ws + WS_WFOLD) + ((size_t)l * 2048 + hp * 128 + 16 * kg) * D + cc * 64 + ci;
#pragma unroll
            for (int k = 0; k < 16; ++k) dst[(size_t)k * D] = (bf16_t)f2bf(acc[k]);
        }
        __syncthreads();
    }
    {
        LAS float* scr = (LAS float*)(F.lds + F.wave * 16384);
        constexpr int I_IN = (D / 64) * (INW / 32), I_BA = (512 / 64) * (D / 32), I_BS = (256 / 64) * (D / 32), I_O = (D / 64) * (D / 32);
        constexpr int PER_L = I_IN + I_BA + I_BS + I_O;
        for (int it = F.gw; it < 2 * PER_L; it += F.ngw) {
            const int l = it / PER_L; int r = it % PER_L;
            if (r < I_IN) { transpose_item(p.in[I_w_in] + (size_t)l * D * INW, D, INW, (bf16_t*)(ws + WS_WIN) + (size_t)l * INW * D, D, 0, 0, scr, r, F.lane); continue; } r -= I_IN;
            if (r < I_BA) { transpose_item(p.in[I_w_br_attn] + (size_t)l * 512 * D, 512, D, (bf16_t*)(ws + WS_WBR) + (size_t)l * D * D, D, 0, 0, scr, r, F.lane); continue; } r -= I_BA;
            if (r < I_BS) { transpose_item(p.in[I_w_br_sgu] + (size_t)l * 256 * D, 256, D, (bf16_t*)(ws + WS_WBR) + (size_t)l * D * D, D, 0, 768, scr, r, F.lane); continue; } r -= I_BS;
            transpose_item(p.in[I_w_out] + (size_t)l * D * D, D, D, (bf16_t*)(ws + WS_WOUT) + (size_t)l * D * D, D, 0, 0, scr, r, F.lane);
        }
    }
    for (int i = F.gtid; i < 2 * 256 * D; i += F.ngt) {
        const int n = i & 1023, rc = (i >> 10) & 255, l = i >> 18, g = rc >> 6;
        const float* pw = p.in[I_pool_w] + ((size_t)l * 256 + rc) * 64;
        const float* ps = p.in[I_pool_scale] + l * 256 + 64 * g;
        const float* wb = p.in[I_w_br_pool] + ((size_t)l * 256 + 64 * g) * D + n;
        float a = 0.f;
#pragma unroll 16
        for (int e = 0; e < 64; ++e) a += pw[e] * ps[e] * wb[(size_t)e * D];
        ((bf16_t*)(ws + WS_WBR))[(size_t)l * D * D + (size_t)n * D + 512 + rc] = (bf16_t)f2bf(a);
    }
    for (int i = F.gtid; i < 2 * 4 * 128 * 128; i += F.ngt) ((bf16_t*)(ws + WS_SGUW))[i] = (bf16_t)f2bf(p.in[I_sgu_w][i]);
    for (int i = F.gtid; i < 64 * 16; i += F.ngt) {
        const int pos = i >> 4, fi = i & 15;
        const float inv = powf(10000.0f, -(float)fi / 16.0f);
        const float ang = (float)pos * inv;
        ((f32x2*)(ws + WS_ROPE))[i] = (f32x2){cosf(ang), sinf(ang)};
    }
    convert_tables(p, F);
    {
        float* MOD = (float*)(ws + WS_MOD);
        LAS float* scd = (LAS float*)F.lds;
        LAS float* red = scd + 9 * D;
        __syncthreads();
        { float tc[18];
#pragma unroll
          for (int it = 0; it < 18; ++it) { const int e = F.tid + it * NTHREADS, r = e >> 10, k = e & 1023; tc[it] = (r < 8) ? p.in[I_c][r * D + k] : p.in[I_c_ctx][k]; }
#pragma unroll
          for (int it = 0; it < 18; ++it) scd[F.tid + it * NTHREADS] = silu_(tc[it]); }
        __syncthreads();
        for (int it = F.bid; it < 2 * 96; it += F.nb) {
            const int cgp = it % 96, l = it / 96, col = cgp * 64 + F.lane;
            float acc[9];
#pragma unroll
            for (int r = 0; r < 9; ++r) acc[r] = 0.f;
            const float* wp = p.in[I_w_mod] + ((size_t)l * D + F.wave * 128) * NMOD + col;
#pragma unroll 16
            for (int k = 0; k < 128; ++k) {
                const float w = wp[(size_t)k * NMOD];
#pragma unroll
                for (int r = 0; r < 9; ++r) acc[r] += scd[r * D + F.wave * 128 + k] * w;
            }
#pragma unroll
            for (int r = 0; r < 9; ++r) red[(F.wave * 9 + r) * 64 + F.lane] = acc[r];
            __syncthreads();
            for (int e = F.tid; e < 9 * 64; e += NTHREADS) {
                const int r = e >> 6, ln = e & 63; float s = p.in[I_b_mod][l * NMOD + cgp * 64 + ln];
#pragma unroll
                for (int w = 0; w < 8; ++w) s += red[(w * 9 + r) * 64 + ln];
                MOD[((size_t)l * 9 + r) * NMOD + cgp * 64 + ln] = s;
            }
            __syncthreads();
        }
    }
}

DI const float* mod_vec(const Params& p, int l, int row, int j) {
    const int r = row < TL ? row / SEQ : 8;
    return (const float*)(p.ws + WS_MOD) + ((size_t)l * 9 + r) * NMOD + j * D;
}
DI float* xrow_ptr(const Params& p, int row) { return row < TL ? p.out + (size_t)row * D : (float*)(p.ws + WS_XCTX) + (size_t)(row - TL) * D; }
DI const float* xin_ptr(const Params& p, int row) { return row < TL ? p.in[I_x] + (size_t)row * D : p.in[I_ctx] + (size_t)(row - TL) * D; }

DI void phase_norm(const Params& p, const Frame& F, int l, int which  , bool from_input, int nrows) {
    const float* g = (which == 0 ? p.in[I_g_mix] : p.in[I_g_ffn]) + l * D;
    const int lane = F.lane;
    f32x4 gg[4];
#pragma unroll
    for (int j = 0; j < 4; ++j) gg[j] = ((const f32x4*)g)[lane + 64 * j];
    for (int row0 = 2 * F.gw; row0 < nrows; row0 += 2 * F.ngw) {
        f32x4 v[2][4], s1[2][4], s2[2][4];
#pragma unroll
        for (int u = 0; u < 2; ++u) {
            const int row = row0 + u;
            const float* src = from_input ? xin_ptr(p, row) : xrow_ptr(p, row);
            const float* sh = mod_vec(p, l, row, which * 3 + 0); const float* sc = mod_vec(p, l, row, which * 3 + 1);
#pragma unroll
            for (int j = 0; j < 4; ++j) { v[u][j] = ((const f32x4*)src)[lane + 64 * j]; s1[u][j] = ((const f32x4*)sh)[lane + 64 * j]; s2[u][j] = ((const f32x4*)sc)[lane + 64 * j]; }
        }
#pragma unroll
        for (int u = 0; u < 2; ++u) {
            float ss = 0.f;
#pragma unroll
            for (int j = 0; j < 4; ++j) ss += v[u][j].x * v[u][j].x + v[u][j].y * v[u][j].y + v[u][j].z * v[u][j].z + v[u][j].w * v[u][j].w;
            const float rinv = rsqrtf(wave_sum(ss) * (1.0f / D) + EPS);
            bf16_t* dst = (bf16_t*)(p.ws + WS_H) + (size_t)(row0 + u) * D;
            float am = 0.f;
#pragma unroll
            for (int j = 0; j < 4; ++j) {
                const f32x4 o = v[u][j] * rinv * gg[j] * (s2[u][j] + 1.0f) + s1[u][j];
                u32x2 w; w.x = pk2(o.x, o.y); w.y = pk2(o.z, o.w);
                ((u32x2*)dst)[lane + 64 * j] = w;
                v[u][j] = o; am = fmaxf(am, fmaxf(fmaxf(fabsf(o.x), fabsf(o.y)), fmaxf(fabsf(o.z), fabsf(o.w))));
            }
            if (which) {
#pragma unroll
                for (int o2 = 1; o2 < 64; o2 <<= 1) am = fmaxf(am, __shfl_xor(am, o2));
                const float sc = (am > 0.f) ? 127.0f / am : 1.0f;
                unsigned* h8 = (unsigned*)(p.ws + WS_H8 + (size_t)(row0 + u) * D);
                const bool odd = (lane & 1) != 0;
#pragma unroll
                for (int j = 0; j < 4; ++j) {
                    const int b0 = (int)__builtin_rintf(v[u][j].x * sc), b1 = (int)__builtin_rintf(v[u][j].y * sc), b2 = (int)__builtin_rintf(v[u][j].z * sc), b3 = (int)__builtin_rintf(v[u][j].w * sc);
                    const int p0 = dpp_x1(b0), p1 = dpp_x1(b1), p2 = dpp_x1(b2), p3 = dpp_x1(b3);
                    const int w0 = odd ? p1 : b0, w1 = odd ? p3 : b2, w2 = odd ? b1 : p0, w3 = odd ? b3 : p2;
                    h8[lane + 64 * j] = (unsigned)(w0 & 0xff) | ((unsigned)(w1 & 0xff) << 8) | ((unsigned)(w2 & 0xff) << 16) | ((unsigned)w3 << 24);
                }
                if (lane == 0) ((float*)(p.ws + WS_HS))[row0 + u] = (am > 0.f) ? am * (1.0f / 127.0f) : 1.0f;
            }
        }
    }
}
DI void phase_final(const Params& p, const Frame& F) {
    f32x4 gg[4];
#pragma unroll
    for (int j = 0; j < 4; ++j) gg[j] = ((const f32x4*)p.in[I_g_final])[F.lane + 64 * j];
    for (int row0 = 2 * F.gw; row0 < TL; row0 += 2 * F.ngw) {
        f32x4 v[2][4];
#pragma unroll
        for (int u = 0; u < 2; ++u)
#pragma unroll
            for (int j = 0; j < 4; ++j) v[u][j] = ((const f32x4*)(p.out + (size_t)(row0 + u) * D))[F.lane + 64 * j];
#pragma unroll
        for (int u = 0; u < 2; ++u) {
            float ss = 0.f;
#pragma unroll
            for (int j = 0; j < 4; ++j) ss += v[u][j].x * v[u][j].x + v[u][j].y * v[u][j].y + v[u][j].z * v[u][j].z + v[u][j].w * v[u][j].w;
            const float rinv = rsqrtf(wave_sum(ss) * (1.0f / D) + EPS);
            f32x4* xr = (f32x4*)(p.out + (size_t)(row0 + u) * D);
#pragma unroll
            for (int j = 0; j < 4; ++j) xr[F.lane + 64 * j] = v[u][j] * rinv * gg[j];
        }
    }
}

DI float lane_xor32(float v, bool hi) { const auto r = __builtin_amdgcn_permlane32_swap(__builtin_bit_cast(unsigned, v), __builtin_bit_cast(unsigned, v), false, false);
    return __builtin_bit_cast(float, hi ? r[0] : r[1]); }
struct EpiG1 {
    DI bool keeps(const pg8::Unit&) const { return false; }
    static constexpr bool PERM = true;
    unsigned char* ws;
    DI void operator()(const f32x4 (&acc)[2][2][4][2], const pg8::Unit& u, int wr, int wc, int fr, int fq) const {
        bf16_t* P = (bf16_t*)(ws + WS_P);
        const int rbase = u.pm * 256 + wr * 64 + fr;
        const bool hi = fq >= 2;
#pragma unroll
        for (int ai = 0; ai < 2; ++ai) {
            f32x4 cs[4][4];
            const bool lat = u.pm < TL / 256;
            if (u.pn < 3 && lat) {
#pragma unroll
                for (int m = 0; m < 4; ++m) {
                    const int t = (rbase + 128 * ai + 16 * m) & (SEQ - 1), pos = (wc & 1) ? (t & 63) : (t >> 6);
                    const f32x4* tab = (const f32x4*)(ws + WS_ROPE) + (pos * 16 + 8 * (fq & 1)) / 2;
#pragma unroll
                    for (int j2 = 0; j2 < 4; ++j2) cs[m][j2] = tab[j2];
                }
            }
#pragma unroll
            for (int m = 0; m < 4; ++m) {
                const int row = rbase + 128 * ai + 16 * m;
#pragma unroll
                for (int bj = 0; bj < 2; ++bj) {
                    const int c0 = u.pn * 256 + 128 * bj + 32 * wc + 8 * fq;
                    float v[8];
#pragma unroll
                    for (int j = 0; j < 4; ++j) { v[j] = acc[ai][bj][m][0][j]; v[4 + j] = acc[ai][bj][m][1][j]; }
                    if (c0 < VOFF) {
                        const float sc = (c0 < KOFF) ? QSCALE : 1.0f;
                        u32x4 o;
#pragma unroll
                        for (int j2 = 0; j2 < 4; ++j2) {
                            const f32x4 c4 = cs[m][j2];
                            const float o0 = lane_xor32(v[2 * j2], hi), o1 = lane_xor32(v[2 * j2 + 1], hi);
                            float r0 = hi ? (v[2 * j2] * c4.x + o0 * c4.y) : (v[2 * j2] * c4.x - o0 * c4.y);
                            float r1 = hi ? (v[2 * j2 + 1] * c4.z + o1 * c4.w) : (v[2 * j2 + 1] * c4.z - o1 * c4.w);
                            if (!lat) { r0 = v[2 * j2]; r1 = v[2 * j2 + 1]; }
                            o[j2] = pk2(r0 * sc, r1 * sc);
                        }
                        *(u32x4*)(P + (size_t)row * PW + c0) = o;
                    } else if (c0 < POOLOFF) {
                        const int hk = wc >> 1, d0 = 32 * (wc & 1) + 8 * fq;
                        if (lat) { const int b = row / SEQ, t = row & (SEQ - 1);
                            bf16_t* vt = (bf16_t*)(ws + WS_VT) + ((size_t)(b * 2 + hk) * 64 + d0) * VTS + t;
#pragma unroll
                            for (int j = 0; j < 8; ++j) vt[(size_t)j * VTS] = (bf16_t)f2bf(v[j]);
                        } else { const int rc = row - TL, b = rc / NCTX, jc = rc & (NCTX - 1);
                            bf16_t* vt = (bf16_t*)(ws + WS_VTC) + ((size_t)(b * 2 + hk) * 64 + d0) * NCTX + jc;
#pragma unroll
                            for (int j = 0; j < 8; ++j) vt[(size_t)j * NCTX] = (bf16_t)f2bf(v[j]);
                        }
                    } else if (c0 < SUOFF) {
                        u32x4 o;
#pragma unroll
                        for (int j2 = 0; j2 < 4; ++j2) o[j2] = pk2(v[2 * j2], v[2 * j2 + 1]);
                        *(u32x4*)(P + (size_t)row * PW + c0) = o;
                    } else if (c0 < SVOFF) {
                        u32x4 o;
#pragma unroll
                        for (int j2 = 0; j2 < 4; ++j2) o[j2] = pk2(gelu_tanh(v[2 * j2]), gelu_tanh(v[2 * j2 + 1]));
                        *(u32x4*)(P + (size_t)row * PW + c0) = o;
                    } else {
                        const int c = c0 - SVOFF, chunk = row >> 7, q = row & 127;
                        bf16_t* vs = (bf16_t*)(ws + WS_VST) + ((size_t)chunk * 256 + c) * 128 + q;
#pragma unroll
                        for (int j = 0; j < 8; ++j) vs[j * 128] = (bf16_t)f2bf(gelu_tanh(v[j]));
                    }
                }
            }
            asm volatile("" ::: "memory");
        }
    }
};
struct SchedGrid {
    int nM, nN, G, c; const char* A; const char* B;
    int n_extra, ex_pm0, ex_pn;
    DI bool next(int i, pg8::Unit& u) const {
        const int L = i * G + c, n = nM * nN; if (L >= n + n_extra) return false;
        if (L < n) pg8::tile_of(L, nM, nN, u.pm, u.pn); else { u.pm = ex_pm0 + (L - n); u.pn = ex_pn; }
        u.sub = 0; u.nt = D / 64; u.mode = 0;
        u.a = A + (size_t)u.pm * 256 * D * 2; u.b = B + (size_t)u.pn * 256 * D * 2; return true;
    }
};

DI void phase_g1(const Params& p, const Frame& F, int l) {
    SchedGrid S{(l == 0 ? T : TL) / 256, PN / 256, F.nb, F.bid, (const char*)(p.ws + WS_H), (const char*)(p.ws + WS_WIN) + (size_t)l * INW * D * 2,
                (l == 0) ? 0 : TC / 256, TL / 256, 2};
    EpiG1 E{p.ws};
    pg8::gemm_phase(F.lds, F.tid, S, E);
}

DI bf16x8 pack8(const f32x16& x, int s) {
    u32x4 pk;
#pragma unroll
    for (int j = 0; j < 4; ++j) { f32x2 v = {x[8 * s + 2 * j], x[8 * s + 2 * j + 1]}; pk[j] = __builtin_bit_cast(unsigned, __builtin_convertvector(v, bf16x2_t)); }
    return __builtin_bit_cast(bf16x8, pk);
}

DI float lane_x32(float v, bool hi) { const auto r = __builtin_amdgcn_permlane32_swap(__builtin_bit_cast(unsigned, v), __builtin_bit_cast(unsigned, v), false, false);
    return __builtin_bit_cast(float, hi ? r[0] : r[1]); }
struct AttnFrags { bf16x8 kf[4]; s16x4 vf[2][4]; };
DI void attn_block(const bf16x8 (&qf)[4], const AttnFrags& f, int mask_mode, int kq_off, int lane, float& m, float& lpart, f32x16 (&o)[2]) {
    const int h = lane >> 5;
    f32x16 st;
#pragma unroll
    for (int r = 0; r < 16; ++r) st[r] = 0.f;
#pragma unroll
    for (int s = 0; s < 4; ++s) st = MFMA32(f.kf[s], qf[s], st);
    if (mask_mode) {
#pragma unroll
        for (int r = 0; r < 16; ++r) { const int dlt = kq_off + crow(r, h); if (dlt > 128 || dlt < -128) st[r] = -1e30f; }
    }
    float bm = st[0];
#pragma unroll
    for (int r = 1; r < 16; ++r) bm = fmaxf(bm, st[r]);
    bm = fmaxf(bm, lane_x32(bm, h != 0));
    const float mn = fmaxf(m, bm);
    if (__builtin_amdgcn_ballot_w64(mn > m) != 0ull) {
        const float alpha = __builtin_amdgcn_exp2f(m - mn);
        lpart *= alpha;
#pragma unroll
        for (int d = 0; d < 2; ++d)
#pragma unroll
            for (int r = 0; r < 16; ++r) o[d][r] *= alpha;
        m = mn;
    }
    float ps = 0.f;
#pragma unroll
    for (int r = 0; r < 16; ++r) { st[r] = __builtin_amdgcn_exp2f(st[r] - m); ps += st[r]; }
    lpart += ps;
    const bf16x8 pf0 = pack8(st, 0), pf1 = pack8(st, 1);
#pragma unroll
    for (int d = 0; d < 2; ++d) {
        const bf16x8 v0 = __builtin_shufflevector(f.vf[d][0], f.vf[d][1], 0, 1, 2, 3, 4, 5, 6, 7), v1 = __builtin_shufflevector(f.vf[d][2], f.vf[d][3], 0, 1, 2, 3, 4, 5, 6, 7);
        o[d] = MFMA32(v0, pf0, o[d]);
        o[d] = MFMA32(v1, pf1, o[d]);
    }
}

constexpr int AKP = 144, AVWP = 648, AVCP = 520;
constexpr int ALDS_KW = 0, ALDS_VW = ALDS_KW + 320 * AKP, ALDS_KC = ALDS_VW + 64 * AVWP, ALDS_VC = ALDS_KC + 256 * AKP, ALDS_END = ALDS_VC + 64 * AVCP;
static_assert(ALDS_END <= LDS_BAR_OFF && (ALDS_VW % 16) == 0 && (ALDS_KC % 16) == 0 && (ALDS_VC % 8) == 0, "attention LDS map");
DI void attn_lds_frags(AttnFrags& f, const LAS unsigned char* kp, const LAS unsigned char* vp, int vpitch32) {
#pragma unroll
    for (int s = 0; s < 4; ++s) f.kf[s] = *(const LAS bf16x8*)(kp + 32 * s);
#pragma unroll
    for (int d = 0; d < 2; ++d)
#pragma unroll
        for (int q = 0; q < 4; ++q) f.vf[d][q] = *(const LAS s16x4*)(vp + d * vpitch32 + 16 * q);
}
DI void attn_unit(const Params& p, const Frame& F, int l, int unit) {
    const int lane = F.lane, r = lane & 31, h = lane >> 5, tid = F.tid;
    const bf16_t* P = (const bf16_t*)(p.ws + WS_P);
    const bf16_t* VT = (const bf16_t*)(p.ws + WS_VT);
    const bf16_t* VTC = (const bf16_t*)(p.ws + WS_VTC);
    bf16_t* Y = (bf16_t*)(p.ws + WS_Y);
    const bool latent = unit < 1024;
    int b, hk, p0, q0row;
    if (latent) { const int pb = unit & 63; hk = (unit >> 6) & 1; b = unit >> 7; p0 = pb * 64; q0row = b * SEQ + p0; }
    else { const int u2 = unit - 1024, pb = u2 & 3; hk = (u2 >> 2) & 1; b = u2 >> 3; p0 = pb * 64; q0row = TL + b * NCTX + p0; }
    const int w0 = p0 - 128;
    u32x4 kw[5], vw[5], kc[4], vc[4];
    if (latent) {
#pragma unroll
        for (int it = 0; it < 5; ++it) {
            const int i = tid + it * NTHREADS, row = i >> 3, ck = i & 7, pos = min(max(w0 + row, 0), SEQ - 1);
            kw[it] = *(const u32x4*)(P + (size_t)(b * SEQ + pos) * PW + KOFF + hk * 64 + 8 * ck);
            const int d = i / 40, cv = i % 40, pv = min(max(w0 + 8 * cv, 0), SEQ - 8);
            vw[it] = *(const u32x4*)(VT + ((size_t)(b * 2 + hk) * 64 + d) * VTS + pv);
        }
    }
#pragma unroll
    for (int it = 0; it < 4; ++it) {
        const int i = tid + it * NTHREADS;
        kc[it] = *(const u32x4*)(P + (size_t)(TL + b * NCTX + (i >> 3)) * PW + KOFF + hk * 64 + 8 * (i & 7));
        vc[it] = *(const u32x4*)(VTC + ((size_t)(b * 2 + hk) * 64 + (i >> 5)) * NCTX + 8 * (i & 31));
    }
    __syncthreads();
    if (latent) {
#pragma unroll
        for (int it = 0; it < 5; ++it) {
            const int i = tid + it * NTHREADS, row = i >> 3, ck = i & 7;
            *(LAS u32x4*)(F.lds + ALDS_KW + row * AKP + 16 * ck) = kw[it];
            const int d = i / 40, cv = i % 40;
            LAS u32x2* dst = (LAS u32x2*)(F.lds + ALDS_VW + d * AVWP + 16 * cv); dst[0] = (u32x2){vw[it].x, vw[it].y}; dst[1] = (u32x2){vw[it].z, vw[it].w};
        }
    }
#pragma unroll
    for (int it = 0; it < 4; ++it) {
        const int i = tid + it * NTHREADS;
        *(LAS u32x4*)(F.lds + ALDS_KC + (i >> 3) * AKP + 16 * (i & 7)) = kc[it];
        LAS u32x2* dst = (LAS u32x2*)(F.lds + ALDS_VC + (i >> 5) * AVCP + 16 * (i & 31)); dst[0] = (u32x2){vc[it].x, vc[it].y}; dst[1] = (u32x2){vc[it].z, vc[it].w};
    }
    const int head = 4 * hk + (F.wave & 3), ph = F.wave >> 2, pw = p0 + 32 * ph, qrow = q0row + 32 * ph;
    bf16x8 qf[4];
#pragma unroll
    for (int s = 0; s < 4; ++s) qf[s] = *(const bf16x8*)(P + (size_t)(qrow + r) * PW + head * 64 + 16 * s + 8 * h);
    float m = p.in[I_attn_sink][l * 8 + head] * LOG2E, lpart = (h == 0) ? 1.0f : 0.0f;
    f32x16 o[2];
#pragma unroll
    for (int d = 0; d < 2; ++d)
#pragma unroll
        for (int i = 0; i < 16; ++i) o[d][i] = 0.f;
    __syncthreads();
    if (latent) {
#pragma unroll 1
        for (int j = 0; j < 9; ++j) {
            const int kb = pw - 128 + 32 * j;
            if (kb < 0 || kb >= SEQ) continue;
            const int krow = kb - w0;
            AttnFrags f;
            attn_lds_frags(f, F.lds + ALDS_KW + (krow + r) * AKP + 16 * h, F.lds + ALDS_VW + r * AVWP + 2 * krow + 8 * h, 32 * AVWP);
            attn_block(qf, f, (j == 0 || j == 8) ? 1 : 0, kb - (pw + r), lane, m, lpart, o);
        }
    }
#pragma unroll 1
    for (int j = 0; j < 8; ++j) {
        AttnFrags f;
        attn_lds_frags(f, F.lds + ALDS_KC + (32 * j + r) * AKP + 16 * h, F.lds + ALDS_VC + r * AVCP + 64 * j + 8 * h, 32 * AVCP);
        attn_block(qf, f, 0, 0, lane, m, lpart, o);
    }
    const float inv = 1.0f / (lpart + lane_x32(lpart, h != 0));
    bf16_t* yrow = Y + (size_t)(qrow + r) * D + head * 64;
#pragma unroll
    for (int d = 0; d < 2; ++d)
#pragma unroll
        for (int g = 0; g < 4; ++g) {
            u32x2 w; w.x = pk2(o[d][4 * g] * inv, o[d][4 * g + 1] * inv); w.y = pk2(o[d][4 * g + 2] * inv, o[d][4 * g + 3] * inv);
            *(u32x2*)(yrow + 32 * d + 8 * g + 4 * h) = w;
        }
}

DI void sgu_unit(const Params& p, const Frame& F, int l, int chunk) {
    constexpr int VS = 136;
    LAS float* part = (LAS float*)F.lds;
    LAS float* rq = part + 512;
    LAS bf16_t* vnT = (LAS bf16_t*)(F.lds + 4096);
    const bf16_t* VsT = (const bf16_t*)(p.ws + WS_VST) + (size_t)chunk * 256 * 128;
    const bf16_t* P = (const bf16_t*)(p.ws + WS_P);
    bf16_t* Y = (bf16_t*)(p.ws + WS_Y);
    __syncthreads();
    { const int q = F.tid & 127, part_i = F.tid >> 7; float ss = 0.f;
#pragma unroll 16
        for (int c = part_i * 64; c < part_i * 64 + 64; ++c) { const float v = bf2f(VsT[c * 128 + q]); ss += v * v; }
        part[part_i * 128 + q] = ss; }
    __syncthreads();
    if (F.tid < 128) rq[F.tid] = rsqrtf((part[F.tid] + part[128 + F.tid] + part[256 + F.tid] + part[384 + F.tid]) * (1.0f / 256.0f) + EPS);
    __syncthreads();
#pragma unroll
    for (int it = 0; it < 8; ++it) {
        const int i = F.tid + it * NTHREADS;
        const int c = i >> 4, q8 = (i & 15) * 8;
        const u32x4 v = *(const u32x4*)(VsT + c * 128 + q8);
        u32x4 o;
#pragma unroll
        for (int j = 0; j < 4; ++j) o[j] = pk2(bflo(v[j]) * rq[q8 + 2 * j], bfhi(v[j]) * rq[q8 + 2 * j + 1]);
        *(LAS u32x4*)(vnT + c * VS + q8) = o;
    }
    __syncthreads();
    const int lane = F.lane, r = lane & 31, h = lane >> 5, g = F.wave >> 1, ph = F.wave & 1;
    const bf16_t* Wg = (const bf16_t*)(p.ws + WS_SGUW) + ((size_t)l * 4 + g) * 128 * 128;
#pragma unroll 1
    for (int pb = 0; pb < 2; ++pb) {
        const int p0 = 64 * ph + 32 * pb;
        const int row = chunk * 128 + p0 + r;
        bf16x8 wf[8];
#pragma unroll
        for (int s = 0; s < 8; ++s) wf[s] = *(const bf16x8*)(Wg + (size_t)(p0 + r) * 128 + 16 * s + 8 * h);
        u32x2 uu[2][4];
#pragma unroll
        for (int cb = 0; cb < 2; ++cb)
#pragma unroll
            for (int q4 = 0; q4 < 4; ++q4) uu[cb][q4] = *(const u32x2*)(P + (size_t)row * PW + SUOFF + 64 * g + 32 * cb + 8 * q4 + 4 * h);
        const float bias = p.in[I_sgu_b][(l * 4 + g) * 128 + p0 + r];
#pragma unroll
        for (int cb = 0; cb < 2; ++cb) {
            const int c0 = 64 * g + 32 * cb;
            f32x16 acc;
#pragma unroll
            for (int i = 0; i < 16; ++i) acc[i] = 0.f;
#pragma unroll
            for (int s = 0; s < 8; ++s) {
                const bf16x8 a = *(const LAS bf16x8*)(vnT + (c0 + r) * VS + 16 * s + 8 * h);
                acc = MFMA32(a, wf[s], acc);
            }
#pragma unroll
            for (int q4 = 0; q4 < 4; ++q4) {
                const int cc = c0 + 8 * q4 + 4 * h;
                const u32x2 u = uu[cb][q4];
                u32x2 w;
                w.x = pk2(bflo(u.x) * (acc[4 * q4] + bias), bfhi(u.x) * (acc[4 * q4 + 1] + bias));
                w.y = pk2(bflo(u.y) * (acc[4 * q4 + 2] + bias), bfhi(u.y) * (acc[4 * q4 + 3] + bias));
                *(u32x2*)(Y + (size_t)row * D + 768 + cc) = w;
            }
        }
    }
}

DI void phase_mix(const Params& p, const Frame& F, int l, int ctr_slot = 0) {
    (void)ctr_slot;
    const int nrows = (l == 0) ? T : TL;
    const bf16_t* P = (const bf16_t*)(p.ws + WS_P);
    bf16_t* Y = (bf16_t*)(p.ws + WS_Y);
    for (int i0 = F.bid * NTHREADS; i0 < 4 * nrows * 8; i0 += F.nb * NTHREADS) {
        const int i = i0 + F.tid, g = i / (nrows * 8), rem = i - g * (nrows * 8), row = rem >> 3, ck = g * 8 + (rem & 7);
        int base, t, len;
        if (row < TL) { base = row & ~(SEQ - 1); t = row & (SEQ - 1); len = SEQ; } else { const int rc = row - TL; base = TL + (rc & ~(NCTX - 1)); t = rc & (NCTX - 1); len = NCTX; }
        float s[8];
#pragma unroll
        for (int j = 0; j < 8; ++j) s[j] = 0.f;
        const bf16_t* zc = P + POOLOFF + ck * 8;
#define POOL_WIN(HALF) do { _Pragma("unroll") for (int dt = -(HALF); dt < (HALF); ++dt) { const int tt = t + dt; const bool ok = tt >= 0 && tt < len; \
            const u32x4 v = *(const u32x4*)(zc + (size_t)(base + (ok ? tt : t)) * PW); const float w = ok ? 1.f : 0.f; \
            _Pragma("unroll") for (int j = 0; j < 4; ++j) { s[2 * j] += w * bflo(v[j]); s[2 * j + 1] += w * bfhi(v[j]); } } } while (0)
        int half;
        if (g == 0) { POOL_WIN(1); half = 1; } else if (g == 1) { POOL_WIN(2); half = 2; } else if (g == 2) { POOL_WIN(4); half = 4; } else { POOL_WIN(8); half = 8; }
#undef POOL_WIN
        const int lo = max(t - half, 0), hi = min(t + half, len);
        const float inv = 1.0f / (float)(hi - lo);
        const u32x4 z = *(const u32x4*)(zc + (size_t)row * PW);
        u32x4 o;
#pragma unroll
        for (int j = 0; j < 4; ++j) o[j] = pk2(s[2 * j] * inv - bflo(z[j]), s[2 * j + 1] * inv - bfhi(z[j]));
        *(u32x4*)(Y + (size_t)row * D + 512 + ck * 8) = o;
    }
    const int nchunk = (l == 0) ? T / 128 : TL / 128;
    for (int ch = F.bid; ch < nchunk; ch += F.nb) sgu_unit(p, F, l, ch);
    const int nunit = (l == 0) ? 1024 + 64 : 1024;
    for (int u = F.nb - 1 - F.bid; u < nunit; u += F.nb) attn_unit(p, F, l, u);
}

struct SchedG2 {
    int G, c; const char *H, *Y, *Wg, *Wb; int npair;
    DI void fill(pg8::Unit& u, int sub, int br) const {
        u.sub = sub;
        if ((sub & 1) == 0) { u.nt = 16; u.a = H + (size_t)u.pm * 256 * D * 2; u.b = Wg + ((size_t)br * D + u.pn * 256) * D * 2; }
        else { const int koff = (br == 0) ? 0 : (br == 1 ? 512 : 768); u.nt = (br == 0) ? 8 : 4;
               u.a = Y + ((size_t)u.pm * 256 * D + koff) * 2; u.b = Wb + ((size_t)u.pn * 256 * D + koff) * 2; }
    }
    DI bool next(int i, pg8::Unit& u) const {
        constexpr int NLAT = (TL / 256) * 4;
        const int nl = (NLAT - c + G - 1) / G;
        if (i < 6 * nl) { const int tile = (i / 6) * G + c, sub = i % 6; pg8::tile_of(tile, TL / 256, 4, u.pm, u.pn); u.mode = 0; fill(u, sub, sub >> 1); return true; }
        const int e = i - 6 * nl, j = (e >> 1) * G + c;
        if (j >= npair) return false;
        const int ctile = j / 3, br = j % 3;
        u.pm = TL / 256 + (ctile >> 2); u.pn = ctile & 3; u.mode = 1 + br; fill(u, e & 1, br); return true;
    }
};
struct EpiG2 {
    static constexpr bool PERM = true;
    bf16_t* scr; bf16_t* M; bf16_t* MP;
    DI bool keeps(const pg8::Unit& u) const { return (u.sub & 1) == 0; }
    DI void operator()(f32x4 (&acc)[2][2][4][2], const pg8::Unit& u, int wr, int wc, int fr, int fq) const {
        const bool gate = (u.sub & 1) == 0, first = u.sub == 0 && gate;
        bf16_t* Mo = (u.mode == 0) ? M + (size_t)u.pm * 256 * D : MP + ((size_t)(u.mode - 1) * TC + (size_t)(u.pm - TL / 256) * 256) * D;
#pragma unroll
        for (int ai = 0; ai < 2; ++ai) {
            u32x4 ld[4][2];
            if (!first) {
#pragma unroll
                for (int m = 0; m < 4; ++m)
#pragma unroll
                    for (int bj = 0; bj < 2; ++bj) {
                        const int rl = 128 * ai + 64 * wr + 16 * m + fr, cl = 128 * bj + 32 * wc + 8 * fq;
                        ld[m][bj] = gate ? *(const u32x4*)(Mo + (size_t)rl * D + u.pn * 256 + cl) : *(const u32x4*)(scr + rl * 256 + cl);
                    }
            }
#pragma unroll
            for (int m = 0; m < 4; ++m)
#pragma unroll
                for (int bj = 0; bj < 2; ++bj) {
                    const int rl = 128 * ai + 64 * wr + 16 * m + fr, cl = 128 * bj + 32 * wc + 8 * fq;
                    if (gate) {
                        u32x4 o;
#pragma unroll
                        for (int j2 = 0; j2 < 4; ++j2) {
                            const int n = j2 >> 1, e = 2 * (j2 & 1);
                            const unsigned w = pk2(fmaxf(sigmoidf_(acc[ai][bj][m][n][e]), 1e-20f), fmaxf(sigmoidf_(acc[ai][bj][m][n][e + 1]), 1e-20f));
                            o[j2] = w;
                            const float t0 = first ? 0.f : bflo(ld[m][bj][j2]), t1 = first ? 0.f : bfhi(ld[m][bj][j2]);
                            acc[ai][bj][m][n][e] = t0 * __builtin_amdgcn_rcpf(bflo(w)); acc[ai][bj][m][n][e + 1] = t1 * __builtin_amdgcn_rcpf(bfhi(w));
                        }
                        *(u32x4*)(scr + rl * 256 + cl) = o;
                    } else {
                        u32x4 w;
#pragma unroll
                        for (int j2 = 0; j2 < 4; ++j2) { const int n = j2 >> 1, e = 2 * (j2 & 1);
                            w[j2] = pk2(acc[ai][bj][m][n][e] * bflo(ld[m][bj][j2]), acc[ai][bj][m][n][e + 1] * bfhi(ld[m][bj][j2])); }
                        *(u32x4*)(Mo + (size_t)rl * D + u.pn * 256 + cl) = w;
                    }
                }
            asm volatile("" ::: "memory");
        }
    }
};
DI void phase_g2(const Params& p, const Frame& F, int l) {
    SchedG2 S{F.nb, F.bid, (const char*)(p.ws + WS_H), (const char*)(p.ws + WS_Y),
              (const char*)(p.ws + WS_WIN) + ((size_t)l * INW + GATEOFF) * D * 2, (const char*)(p.ws + WS_WBR) + (size_t)l * D * D * 2, (l == 0) ? (TC / 256) * 4 * 3 : 0};
    EpiG2 E{(bf16_t*)(p.ws + WS_IDX) + (size_t)F.bid * 65536, (bf16_t*)(p.ws + WS_MERGED), (bf16_t*)(p.ws + WS_MP)};
    pg8::gemm_phase(F.lds, F.tid, S, E);
}
DI void phase_g2sum(const Params& p, const Frame& F) {
    const u32x4* mp = (const u32x4*)(p.ws + WS_MP);
    u32x4* mo = (u32x4*)((bf16_t*)(p.ws + WS_MERGED) + (size_t)TL * D);
    constexpr int NV = TC * D / 8;
    for (int i = F.gtid; i < NV; i += F.ngt) {
        const u32x4 a = mp[i], b = mp[NV + i], c = mp[2 * NV + i];
        u32x4 o;
#pragma unroll
        for (int j = 0; j < 4; ++j) o[j] = pk2(bflo(a[j]) + bflo(b[j]) + bflo(c[j]), bfhi(a[j]) + bfhi(b[j]) + bfhi(c[j]));
        mo[i] = o;
    }
}

struct EpiG3 {
    DI bool keeps(const pg8::Unit&) const { return false; }
    static constexpr bool PERM = false;
    const float* xsrc; float* xdst; const float* csrc; float* cdst; const float* mod;
    DI void operator()(const f32x4 (&acc)[2][2][4][2], const pg8::Unit& u, int wr, int wc, int fr, int fq) const {
        const int col0 = u.pn * 256 + wc * 32 + 4 * fq;
        const bool lat = u.pm < TL / 256;
        const float* gt = mod + (size_t)(lat ? (u.pm >> 4) : 8) * NMOD + 2 * D;
        const float* xs = lat ? xsrc + (size_t)u.pm * 256 * D : csrc + (size_t)(u.pm - TL / 256) * 256 * D;
        float* xd = lat ? xdst + (size_t)u.pm * 256 * D : cdst + (size_t)(u.pm - TL / 256) * 256 * D;
        f32x4 gv[2][2];
#pragma unroll
        for (int bj = 0; bj < 2; ++bj)
#pragma unroll
            for (int n = 0; n < 2; ++n) gv[bj][n] = *(const f32x4*)(gt + col0 + 128 * bj + 16 * n);
#pragma unroll
        for (int ai = 0; ai < 2; ++ai) {
            f32x4 xv[4][2][2];
#pragma unroll
            for (int m = 0; m < 4; ++m)
#pragma unroll
                for (int bj = 0; bj < 2; ++bj)
#pragma unroll
                    for (int n = 0; n < 2; ++n) xv[m][bj][n] = *(const f32x4*)(xs + (size_t)(wr * 64 + fr + 128 * ai + 16 * m) * D + col0 + 128 * bj + 16 * n);
#pragma unroll
            for (int m = 0; m < 4; ++m)
#pragma unroll
                for (int bj = 0; bj < 2; ++bj)
#pragma unroll
                    for (int n = 0; n < 2; ++n)
                        *(f32x4*)(xd + (size_t)(wr * 64 + fr + 128 * ai + 16 * m) * D + col0 + 128 * bj + 16 * n) = xv[m][bj][n] + gv[bj][n] * acc[ai][bj][m][n];
            asm volatile("" ::: "memory");
        }
    }
};
DI void phase_g3(const Params& p, const Frame& F, int l) {
    SchedGrid S{(l == 0 ? T : TL) / 256, D / 256, F.nb, F.bid, (const char*)(p.ws + WS_MERGED), (const char*)(p.ws + WS_WOUT) + (size_t)l * D * D * 2, 0, 0, 0};
    float* xc = (float*)(p.ws + WS_XCTX);
    EpiG3 E{(l == 0) ? p.in[I_x] : p.out, p.out, (l == 0) ? p.in[I_ctx] : xc, xc, (const float*)(p.ws + WS_MOD) + (size_t)l * 9 * NMOD};
    pg8::gemm_phase(F.lds, F.tid, S, E);
}

struct EpiG45 {
    DI bool keeps(const pg8::Unit&) const { return false; }
    static constexpr bool PERM = true;
    unsigned short* ST;
    DI void operator()(const f32x4 (&acc)[2][2][4][2], const pg8::Unit& u, int wr, int wc, int fr, int fq) const {
        const int col0 = u.pn * 256 + wc * 32 + 8 * fq;
#pragma unroll
        for (int ai = 0; ai < 2; ++ai)
#pragma unroll
            for (int m = 0; m < 4; ++m) {
                unsigned short* rowp = ST + (size_t)(u.pm * 256 + wr * 64 + fr + 128 * ai + 16 * m) * T + col0;
#pragma unroll
                for (int bj = 0; bj < 2; ++bj) {
                    u32x4 w;
                    w.x = pkh2(acc[ai][bj][m][0][0], acc[ai][bj][m][0][1]); w.y = pkh2(acc[ai][bj][m][0][2], acc[ai][bj][m][0][3]);
                    w.z = pkh2(acc[ai][bj][m][1][0], acc[ai][bj][m][1][1]); w.w = pkh2(acc[ai][bj][m][1][2], acc[ai][bj][m][1][3]);
                    *(u32x4*)(rowp + 128 * bj) = w;
                }
            }
    }
};
DI void phase_g45(const Params& p, const Frame& F, int l) {
    SchedGrid S{2048 / 256, (l == 0 ? T : TL) / 256, F.nb, F.bid, (const char*)(p.ws + WS_WFOLD) + (size_t)l * 2048 * D * 2, (const char*)(p.ws + WS_H), 0, 0, 0};
    EpiG45 E{(unsigned short*)(p.ws + WS_ST)};
    pg8::gemm_phase(F.lds, F.tid, S, E);
}

DI unsigned fkey(float f) { const unsigned u = __builtin_bit_cast(unsigned, f); return (u & 0x80000000u) ? ~u : (u | 0x80000000u); }
DI float fkey_inv(unsigned k) { const unsigned u = (k & 0x80000000u) ? (k & 0x7fffffffu) : ~k; return __builtin_bit_cast(float, u); }
#define INSERT16(L, x) do { unsigned x_ = (x); _Pragma("unroll") for (int k_ = 0; k_ < 16; ++k_) { const unsigned hi_ = max(L[k_], x_); x_ = min(L[k_], x_); L[k_] = hi_; } } while (0)
#define CEX(a, b) do { const unsigned hi_ = max(a, b), lo_ = min(a, b); a = hi_; b = lo_; } while (0)
DI void sort16_desc(unsigned (&v)[16]) {
#pragma unroll
    for (int k = 2; k <= 16; k <<= 1)
#pragma unroll
        for (int j = k >> 1; j > 0; j >>= 1)
#pragma unroll
            for (int i = 0; i < 16; ++i) {
                const int q = i ^ j;
                if (q > i) { if ((i & k) == 0) CEX(v[i], v[q]); else CEX(v[q], v[i]); }
            }
}
DI void merge16_desc(unsigned (&L)[16], const unsigned (&N)[16]) {
#pragma unroll
    for (int i = 0; i < 16; ++i) L[i] = max(L[i], N[15 - i]);
#pragma unroll
    for (int j = 8; j > 0; j >>= 1)
#pragma unroll
        for (int i = 0; i < 16; ++i) { const int q = i ^ j; if (q > i) CEX(L[i], L[q]); }
}
DI void phase_sel(const Params& p, const Frame& F, int l) {
    const _Float16* ST = (const _Float16*)(p.ws + WS_ST);
    unsigned short* IDX = (unsigned short*)(p.ws + WS_IDX);
    float* GW = (float*)(p.ws + WS_GW);
    float* SU = (float*)(p.ws + WS_SU);
    const float* TSC = (const float*)(p.ws + WS_TSCALE) + (size_t)l * 2 * NEXP;
    LAS unsigned char* ib = (LAS unsigned char*)F.lds;
    const int ntok = (l == 0) ? T : TL;
    for (int i0 = F.bid * NTHREADS; i0 < ntok * 8; i0 += F.nb * NTHREADS) {
        const int i = i0 + F.tid;
        const int tok = i % ntok, head = i / ntok;
        unsigned la[16], lb[16];
#pragma unroll
        for (int k = 0; k < 16; ++k) { la[k] = 0u; lb[k] = 0u; }
        const _Float16* s0 = ST + (size_t)(head * 256) * T + tok;
#define SEL_LOAD(B_, k0_) do { _Pragma("unroll") for (int j = 0; j < 32; ++j) B_[j] = sp[(size_t)((k0_) + j) * T]; } while (0)
#define SEL_GRP(L_, B_, o_, k0_) do { unsigned nk_[16]; \
        _Pragma("unroll") for (int j = 0; j < 16; ++j) nk_[j] = (fkey((float)B_[(o_) + j]) & ~127u) | (unsigned)(127 - ((k0_) + j)); \
        sort16_desc(nk_); merge16_desc(L_, nk_); } while (0)
#define SEL_HALF(L_, base_) do { const _Float16* sp = s0 + (size_t)(base_) * T; _Float16 bufa[32], bufb[32]; \
        SEL_LOAD(bufa, 0); \
        _Pragma("unroll 1") for (int k0 = 0; k0 < 128; k0 += 64) { \
            SEL_LOAD(bufb, k0 + 32); SEL_GRP(L_, bufa, 0, k0); SEL_GRP(L_, bufa, 16, k0 + 16); \
            SEL_LOAD(bufa, (k0 + 64) & 127); SEL_GRP(L_, bufb, 0, k0 + 32); SEL_GRP(L_, bufb, 16, k0 + 48); } } while (0)
        SEL_HALF(la, 0);
        SEL_HALF(lb, 128);
#undef SEL_LOAD
#undef SEL_GRP
#undef SEL_HALF
        float va[16], vb[16];
#pragma unroll
        for (int k = 0; k < 16; ++k) {
            va[k] = fkey_inv(la[k] & ~127u); vb[k] = fkey_inv(lb[k] & ~127u);
            ib[k * NTHREADS + F.tid] = (unsigned char)(127u - (la[k] & 127u));
            ib[(16 + k) * NTHREADS + F.tid] = (unsigned char)(127u - (lb[k] & 127u));
        }
        unsigned lc[16];
#pragma unroll
        for (int k = 0; k < 16; ++k) lc[k] = 0u;
#pragma unroll
        for (int a = 0; a < 16; ++a)
#pragma unroll
            for (int b = 0; b < 16; ++b)
                if ((a + 1) * (b + 1) <= 16) { const unsigned key = (fkey(va[a] + vb[b]) & ~255u) | (unsigned)(255 - (a * 16 + b)); INSERT16(lc, key); }
        float e[16], sum = 0.f; const float v0 = fkey_inv(lc[0] & ~255u);
#pragma unroll
        for (int k = 0; k < 16; ++k) { e[k] = __expf(fkey_inv(lc[k] & ~255u) - v0); sum += e[k]; }
        const float inv = 1.0f / sum;
        asm volatile("s_waitcnt lgkmcnt(0)" ::: "memory");
        unsigned exs[16]; float gws[16], sus[16];
#pragma unroll
        for (int k = 0; k < 16; ++k) {
            const unsigned pos = 255u - (lc[k] & 255u), a = pos >> 4, b = pos & 15u;
            const unsigned ea = ib[a * NTHREADS + F.tid], eb = ib[(16 + b) * NTHREADS + F.tid];
            exs[k] = ea * 128u + eb;
        }
#pragma unroll
        for (int k = 0; k < 16; ++k) { gws[k] = e[k] * inv * TSC[NEXP + exs[k]]; sus[k] = TSC[exs[k]]; }
        { const size_t o = (size_t)tok * 128 + head * 16;
#pragma unroll
          for (int q = 0; q < 2; ++q) { u32x4 w;
#pragma unroll
              for (int j = 0; j < 4; ++j) w[j] = exs[8 * q + 2 * j] | (exs[8 * q + 2 * j + 1] << 16);
              *(u32x4*)(IDX + o + 8 * q) = w; }
#pragma unroll
          for (int q = 0; q < 4; ++q) { *(f32x4*)(GW + o + 4 * q) = (f32x4){gws[4 * q], gws[4 * q + 1], gws[4 * q + 2], gws[4 * q + 3]};
                                        *(f32x4*)(SU + o + 4 * q) = (f32x4){sus[4 * q], sus[4 * q + 1], sus[4 * q + 2], sus[4 * q + 3]}; } }
        asm volatile("s_waitcnt lgkmcnt(0)" ::: "memory");
    }
}

DI float dpp_xor1(float v) { return __builtin_bit_cast(float, __builtin_amdgcn_mov_dpp(__builtin_bit_cast(int, v), 0xB1, 0xF, 0xF, true)); }
DI float dpp_xor2(float v) { return __builtin_bit_cast(float, __builtin_amdgcn_mov_dpp(__builtin_bit_cast(int, v), 0x4E, 0xF, 0xF, true)); }
DI float dpp_hmir(float v) { return __builtin_bit_cast(float, __builtin_amdgcn_mov_dpp(__builtin_bit_cast(int, v), 0x141, 0xF, 0xF, true)); }
DI float dot16_fp8(const u32x4 q, const float (&hx)[16]) {
    f32x2 a = {0.f, 0.f};
#pragma unroll
    for (int j = 0; j < 4; ++j) {
        const f32x2 lo = __builtin_amdgcn_cvt_pk_f32_fp8((int)q[j], false), hi = __builtin_amdgcn_cvt_pk_f32_fp8((int)q[j], true);
        a += lo * (f32x2){hx[4 * j], hx[4 * j + 1]}; a += hi * (f32x2){hx[4 * j + 2], hx[4 * j + 3]};
    }
    return a.x + a.y;
}
#define PEER_EXPERT(id, i) ((int)(((id)[(i) >> 3][((i) >> 1) & 3] >> (16 * ((i) & 1))) & 0xffffu))

DI int dpp_xor1i(int v) { return __builtin_amdgcn_mov_dpp(v, 0xB1, 0xF, 0xF, true); }
DI int dpp_xor2i(int v) { return __builtin_amdgcn_mov_dpp(v, 0x4E, 0xF, 0xF, true); }
DI int dpp_hmiri(int v) { return __builtin_amdgcn_mov_dpp(v, 0x141, 0xF, 0xF, true); }
struct PeerURows { u32x4 q[16]; u32x4 h[2]; };
DI void peer_u_rows(PeerURows& R, const u32x4 (&id)[2], const unsigned char* ut, const unsigned char* hrow) {
    R.h[0] = *(const u32x4*)(hrow); R.h[1] = *(const u32x4*)(hrow + 16);
#pragma unroll
    for (int i = 0; i < 16; ++i) R.q[i] = *(const u32x4*)(ut + (size_t)PEER_EXPERT(id, i) * (D / 2));
}
DI void peer_u_compute(const PeerURows& R, float* part, int lane) {
    int hsum = 0;
#pragma unroll
    for (int g = 0; g < 2; ++g)
#pragma unroll
        for (int j = 0; j < 4; ++j) hsum = __builtin_amdgcn_sdot4((int)R.h[g][j], 0x01010101, hsum, false);
    int d[16];
#pragma unroll
    for (int i = 0; i < 16; ++i) { int a = 0;
#pragma unroll
        for (int dw = 0; dw < 4; ++dw) {
            const unsigned w = R.q[i][dw];
            a = __builtin_amdgcn_sdot4((int)(w & 0x0f0f0f0fu), (int)R.h[dw >> 1][2 * (dw & 1)], a, false);
            a = __builtin_amdgcn_sdot4((int)((w >> 4) & 0x0f0f0f0fu), (int)R.h[dw >> 1][2 * (dw & 1) + 1], a, false);
        }
        d[i] = a - 8 * hsum; }
    const bool b2 = (lane & 4) != 0, b1 = (lane & 2) != 0, b0 = (lane & 1) != 0;
    int k8[8];
#pragma unroll
    for (int i = 0; i < 8; ++i) { const int keep = b2 ? d[8 + i] : d[i], send = b2 ? d[i] : d[8 + i]; k8[i] = keep + dpp_hmiri(send); }
    int k4[4];
#pragma unroll
    for (int i = 0; i < 4; ++i) { const int keep = b1 ? k8[4 + i] : k8[i], send = b1 ? k8[i] : k8[4 + i]; k4[i] = keep + dpp_xor2i(send); }
    f32x2 k2;
    { const int keep0 = b0 ? k4[2] : k4[0], send0 = b0 ? k4[0] : k4[2], keep1 = b0 ? k4[3] : k4[1], send1 = b0 ? k4[1] : k4[3];
      k2.x = (float)(keep0 + dpp_xor1i(send0)); k2.y = (float)(keep1 + dpp_xor1i(send1)); }
    *(f32x2*)(part + 16 * (lane >> 3) + (b2 ? 8 : 0) + (b1 ? 4 : 0) + (b0 ? 2 : 0)) = k2;
}
DI void phase_peer_u(const Params& p, const Frame& F, int l) {
    const int ntok = (l == 0) ? T : TL, lane = F.lane, half = ntok >> 1;
    const int grp = F.bid & 7, cs = grp & 3, th = grp >> 2, sw = (F.bid >> 3) * NWAVES + F.wave, nsw = (F.nb >> 3) * NWAVES;
    const unsigned char* ut = p.ws + WS_UTAB + (size_t)l * NEXP * (D / 2) + 128 * cs + 16 * (lane & 7);
    const unsigned char* Hs = p.ws + WS_H8 + 256 * cs + 32 * (lane & 7);
    const unsigned short* IDXg = (const unsigned short*)(p.ws + WS_IDX) + 16 * (lane >> 3);
    float* PART = (float*)(p.ws + WS_ST) + (size_t)cs * T * 128;
    const int t0 = th * half, tend = t0 + half, last = tend - 1;
    u32x4 sa[2], sb[2]; PeerURows ra, rb;
#define U_SEL(S_, t_) do { const unsigned short* ip_ = IDXg + (size_t)min((t_), last) * 128; S_[0] = *(const u32x4*)ip_; S_[1] = *(const u32x4*)(ip_ + 8); } while (0)
#define U_ROWS(R_, S_, t_) peer_u_rows(R_, S_, ut, Hs + (size_t)min((t_), last) * D)
    U_SEL(sa, t0 + sw); U_SEL(sb, t0 + sw + nsw);
    U_ROWS(ra, sa, t0 + sw);
#pragma unroll 1
    for (int tok = t0 + sw; tok < tend; tok += 2 * nsw) {
        U_SEL(sa, tok + 2 * nsw); U_ROWS(rb, sb, tok + nsw);
        peer_u_compute(ra, PART + (size_t)tok * 128, lane);
        U_SEL(sb, tok + 3 * nsw); U_ROWS(ra, sa, tok + 2 * nsw);
        if (tok + nsw < tend) peer_u_compute(rb, PART + (size_t)(tok + nsw) * 128, lane);
    }
#undef U_SEL
#undef U_ROWS
}
DI void phase_peer_c(const Params& p, const Frame& F, int l, bool dummy = false) {
    const int ntok = (l == 0) ? T : TL;
    const float* PART = (const float*)(p.ws + WS_ST);
    float* GW = (float*)(p.ws + WS_GW);
    float* CO = dummy ? (float*)(p.ws + WS_H8) : GW;
    const float* SU = (const float*)(p.ws + WS_SU);
    const float* HS = (const float*)(p.ws + WS_HS);
    for (int i0 = F.gtid; i0 < ntok * 128; i0 += 4 * F.ngt) {
        float s[4], gw[4], su[4];
#pragma unroll
        for (int u = 0; u < 4; ++u) {
            const int i = min(i0 + u * F.ngt, ntok * 128 - 1);
            s[u] = 0.f;
#pragma unroll
            for (int sl = 0; sl < 4; ++sl) s[u] += PART[(size_t)sl * T * 128 + i];
            gw[u] = GW[i]; su[u] = SU[i] * HS[i >> 7];
        }
#pragma unroll
        for (int u = 0; u < 4; ++u) { const int i = i0 + u * F.ngt; if (i < ntok * 128) CO[i] = gw[u] * gelu_tanh(s[u] * su[u]); }
    }
}
struct PeerVRows { u32x4 q[16]; f32x4 cf[4]; f32x4 xv, gv; };
DI void peer_v_rows(PeerVRows& R, const u32x4 (&id)[2], const unsigned char* vt, const float* cp, const float* xs, const float* gt2) {
    R.cf[0] = *(const f32x4*)cp; R.cf[1] = *(const f32x4*)(cp + 4); R.cf[2] = *(const f32x4*)(cp + 8); R.cf[3] = *(const f32x4*)(cp + 12);
    R.xv = *(const f32x4*)xs; R.gv = *(const f32x4*)gt2;
#pragma unroll
    for (int i = 0; i < 16; ++i) R.q[i] = *(const u32x4*)(vt + (size_t)PEER_EXPERT(id, i) * (D / 2));
}
DI float xchg32(float v, bool hi) { const auto r = __builtin_amdgcn_permlane32_swap(__builtin_bit_cast(unsigned, v), __builtin_bit_cast(unsigned, v), false, false);
    return __builtin_bit_cast(float, hi ? r[0] : r[1]); }
DI float xchg16(float v, bool hi) { const auto r = __builtin_amdgcn_permlane16_swap(__builtin_bit_cast(unsigned, v), __builtin_bit_cast(unsigned, v), false, false);
    return __builtin_bit_cast(float, hi ? r[0] : r[1]); }
DI float xchg8(float v) { return __builtin_bit_cast(float, __builtin_amdgcn_mov_dpp(__builtin_bit_cast(int, v), 0x128, 0xF, 0xF, true)); }
DI void peer_v_compute(const PeerVRows& R, float* xdst, int lane) {
    f32x2 a[16];
#pragma unroll
    for (int j = 0; j < 16; ++j) a[j] = (f32x2){0.f, 0.f};
#pragma unroll
    for (int i = 0; i < 16; ++i) {
        const float c = R.cf[i >> 2][i & 3]; const f32x2 c2 = {c, c};
#pragma unroll
        for (int d = 0; d < 4; ++d) {
            a[4 * d + 0] += c2 * __builtin_amdgcn_cvt_scalef32_pk_f32_fp4(R.q[i][d], 1.0f, 0);
            a[4 * d + 1] += c2 * __builtin_amdgcn_cvt_scalef32_pk_f32_fp4(R.q[i][d], 1.0f, 1);
            a[4 * d + 2] += c2 * __builtin_amdgcn_cvt_scalef32_pk_f32_fp4(R.q[i][d], 1.0f, 2);
            a[4 * d + 3] += c2 * __builtin_amdgcn_cvt_scalef32_pk_f32_fp4(R.q[i][d], 1.0f, 3);
        }
    }
    const bool b5 = (lane & 32) != 0, b4 = (lane & 16) != 0, b3 = (lane & 8) != 0;
    f32x2 k8[8];
#pragma unroll
    for (int j = 0; j < 8; ++j) { const f32x2 keep = b5 ? a[8 + j] : a[j], send = b5 ? a[j] : a[8 + j];
        k8[j] = keep + (f32x2){xchg32(send.x, b5), xchg32(send.y, b5)}; }
    f32x2 k4[4];
#pragma unroll
    for (int j = 0; j < 4; ++j) { const f32x2 keep = b4 ? k8[4 + j] : k8[j], send = b4 ? k8[j] : k8[4 + j];
        k4[j] = keep + (f32x2){xchg16(send.x, b4), xchg16(send.y, b4)}; }
    f32x2 k2[2];
#pragma unroll
    for (int j = 0; j < 2; ++j) { const f32x2 keep = b3 ? k4[2 + j] : k4[j], send = b3 ? k4[j] : k4[2 + j];
        k2[j] = keep + (f32x2){xchg8(send.x), xchg8(send.y)}; }
    *(f32x4*)xdst = R.xv + R.gv * (f32x4){k2[0].x, k2[0].y, k2[1].x, k2[1].y};
}
DI void phase_peer_v(const Params& p, const Frame& F, int l, bool dummy = false) {
    const int ntok = (l == 0) ? T : TL, lane = F.lane, half = ntok >> 1;
    const int grp = F.bid & 7, cs = grp & 3, th = grp >> 2, sw = (F.bid >> 3) * NWAVES + F.wave, nsw = (F.nb >> 3) * NWAVES;
    const unsigned char* vt = p.ws + WS_VTAB + (size_t)l * NEXP * (D / 2) + 128 * cs + 16 * (lane & 7);
    const unsigned short* IDXg = (const unsigned short*)(p.ws + WS_IDX) + 16 * (lane >> 3);
    const float* CFg = (const float*)(p.ws + WS_GW) + 16 * (lane >> 3);
    const int t0 = th * half, tend = t0 + half, last = tend - 1;
    u32x4 sa[2], sb[2]; PeerVRows ra, rb;
#define V_SEL(S_, t_) do { const unsigned short* ip_ = IDXg + (size_t)min((t_), last) * 128; S_[0] = *(const u32x4*)ip_; S_[1] = *(const u32x4*)(ip_ + 8); } while (0)
    const int co = 256 * cs + 32 * (lane & 7) + ((lane & 32) ? 16 : 0) + ((lane & 16) ? 8 : 0) + ((lane & 8) ? 4 : 0);
#define V_ROWS(R_, S_, t_) do { const int t1_ = min((t_), last); peer_v_rows(R_, S_, vt, CFg + (size_t)t1_ * 128, xrow_ptr(p, t1_) + co, mod_vec(p, l, t1_, 5) + co); } while (0)
#define V_DO(R_, t_) do { const int t2_ = (t_); float* xd_ = (dummy ? (float*)(p.ws + WS_ST) + (size_t)t2_ * D : xrow_ptr(p, t2_)) + co; peer_v_compute(R_, xd_, lane); } while (0)
    V_SEL(sa, t0 + sw); V_SEL(sb, t0 + sw + nsw);
    V_ROWS(ra, sa, t0 + sw);
#pragma unroll 1
    for (int tok = t0 + sw; tok < tend; tok += 2 * nsw) {
        V_SEL(sa, tok + 2 * nsw); V_ROWS(rb, sb, tok + nsw);
        V_DO(ra, tok);
        V_SEL(sb, tok + 3 * nsw); V_ROWS(ra, sa, tok + 2 * nsw);
        if (tok + nsw < tend) V_DO(rb, tok + nsw);
    }
#undef V_SEL
#undef V_ROWS
#undef V_DO
}

#define XB_TMO      128
#define XB_XCNT(j)  (256  + 64 * (j))
#define XB_XSUB(j)  (1280 + 64 * (j))
#define XB_XGEN(j)  (2304 + 64 * (j))
#define XB_TOP      3328
#define XB_TOPGEN   3392
#define XCD_BAR_WORDS 3456
#define XB_SPIN_CAP (1u << 18)
DI unsigned xb_ld(unsigned* p)              { return __hip_atomic_load(p, __ATOMIC_RELAXED, __HIP_MEMORY_SCOPE_AGENT); }
DI unsigned xb_add(unsigned* p, unsigned v) { return __hip_atomic_fetch_add(p, v, __ATOMIC_RELAXED, __HIP_MEMORY_SCOPE_AGENT); }
DI unsigned xb_xcc_id() { return (unsigned)__builtin_amdgcn_s_getreg((3 << 11) | 20) & 0xFu; }
#define XB_SPIN(cond, bar) do { unsigned _sp = 0; while (cond) { __builtin_amdgcn_s_sleep(1); \
    if ((++_sp & 255u) == 0u) { if (xb_ld(&(bar)[XB_TMO])) break; if (_sp > XB_SPIN_CAP) { atomicAdd(&(bar)[XB_TMO], 1u); break; } } } } while (0)
struct XcdBarrier { unsigned* bar; unsigned x; volatile LAS unsigned* st; };
DI XcdBarrier xcd_barrier_post(unsigned* bar, volatile LAS unsigned* st) {
    XcdBarrier b; b.bar = bar; b.x = xb_xcc_id(); b.st = st;
    if (threadIdx.x == 0) (void)xb_add(&bar[XB_XCNT(b.x)], 1u);
    return b;
}
DI void xcd_barrier_complete(unsigned* bar, unsigned x, unsigned& nloc, unsigned& nx) {
    const unsigned G = gridDim.x * gridDim.y * gridDim.z;
    unsigned sum, cnt, mine, sp = 0u;
    for (;;) {
        sum = 0u; cnt = 0u; mine = 0u;
#pragma unroll
        for (unsigned j = 0; j < 16; ++j) { const unsigned c = xb_ld(&bar[XB_XCNT(j)]); sum += c; cnt += (c > 0u) ? 1u : 0u; mine = (j == x) ? c : mine; }
        if (sum == G) break;
        __builtin_amdgcn_s_sleep(1);
        if ((++sp & 255u) == 0u) { if (xb_ld(&bar[XB_TMO])) break; if (sp > XB_SPIN_CAP) { atomicAdd(&bar[XB_TMO], 1u); break; } }
    }
    nloc = mine > 0u ? mine : 1u; nx = cnt > 0u ? cnt : 1u;
}
DI void xcd_barrier(const XcdBarrier& b) {
    asm volatile("s_waitcnt vmcnt(0)" ::: "memory");
    __syncthreads();
    if (threadIdx.x == 0) {
        unsigned* bar = b.bar;
        __builtin_amdgcn_s_waitcnt(0);
        unsigned nloc = b.st[0], nx = b.st[1];
        if (nloc == 0u) { xcd_barrier_complete(bar, b.x, nloc, nx); b.st[0] = nloc; b.st[1] = nx; }
        const unsigned old = xb_add(&bar[XB_XSUB(b.x)], 1u);
        const unsigned gen = old / nloc;
        if (old + 1u == (gen + 1u) * nloc) {
            __builtin_amdgcn_fence(__ATOMIC_RELEASE, "agent");
            asm volatile("s_waitcnt vmcnt(0)" ::: "memory");
            const unsigned og = xb_add(&bar[XB_TOP], 1u);
            const unsigned tg = og / nx;
            if (og + 1u == (tg + 1u) * nx) xb_add(&bar[XB_TOPGEN], 1u);
            else XB_SPIN(xb_ld(&bar[XB_TOPGEN]) == tg, bar);
            __builtin_amdgcn_fence(__ATOMIC_ACQUIRE, "agent");
            xb_add(&bar[XB_XGEN(b.x)], 1u);
            asm volatile("s_waitcnt vmcnt(0)" ::: "memory");
        } else {
            XB_SPIN(xb_ld(&bar[XB_XGEN(b.x)]) == gen, bar);
            __builtin_amdgcn_fence(__ATOMIC_ACQUIRE, "agent");
            asm volatile("s_waitcnt vmcnt(0)" ::: "memory");
        }
    }
    __syncthreads();
}

constexpr int NPHASE = 25;
template <int PH> DI void run_phase(const Params& p, const Frame& F) {
    if constexpr (PH == 0) phase_prep(p, F);
    else if constexpr (PH == 1) phase_norm(p, F, 0, 0, true, T);
    else if constexpr (PH == 2) phase_g1(p, F, 0);
    else if constexpr (PH == 3) phase_mix(p, F, 0);
    else if constexpr (PH == 4) phase_g2(p, F, 0);
    else if constexpr (PH == 5) phase_g2sum(p, F);
    else if constexpr (PH == 6) phase_g3(p, F, 0);
    else if constexpr (PH == 7) phase_norm(p, F, 0, 1, false, T);
    else if constexpr (PH == 8) phase_g45(p, F, 0);
    else if constexpr (PH == 9) phase_sel(p, F, 0);
    else if constexpr (PH == 10) phase_peer_u(p, F, 0);
    else if constexpr (PH == 11) phase_peer_c(p, F, 0);
    else if constexpr (PH == 12) phase_peer_v(p, F, 0);
    else if constexpr (PH == 13) phase_norm(p, F, 1, 0, false, T);
    else if constexpr (PH == 14) phase_g1(p, F, 1);
    else if constexpr (PH == 15) phase_mix(p, F, 1);
    else if constexpr (PH == 16) phase_g2(p, F, 1);
    else if constexpr (PH == 17) phase_g3(p, F, 1);
    else if constexpr (PH == 18) phase_norm(p, F, 1, 1, false, TL);
    else if constexpr (PH == 19) phase_g45(p, F, 1);
    else if constexpr (PH == 20) phase_sel(p, F, 1);
    else if constexpr (PH == 21) phase_peer_u(p, F, 1);
    else if constexpr (PH == 22) phase_peer_c(p, F, 1);
    else if constexpr (PH == 23) phase_peer_v(p, F, 1);
    else if constexpr (PH == 24) phase_final(p, F);
}
DI Frame make_frame(unsigned char* lds_raw) {
    Frame F;
    F.lds = (LAS unsigned char*)lds_raw;
    int tid = threadIdx.x; asm volatile("" : "+v"(tid));
    int bid = blockIdx.x, nb = gridDim.x; asm volatile("" : "+s"(bid), "+s"(nb));
    F.tid = tid; F.lane = tid & 63; F.wave = __builtin_amdgcn_readfirstlane(tid >> 6); F.bid = bid; F.nb = nb;
    F.gw = bid * NWAVES + F.wave; F.ngw = nb * NWAVES; F.gtid = bid * NTHREADS + tid; F.ngt = nb * NTHREADS;
    return F;
}
template <int PH> DI void run_phase_fresh(unsigned char* lds_raw) {
#if defined(__HIP_DEVICE_COMPILE__)
    const __attribute__((address_space(4))) unsigned long long* pp = (const __attribute__((address_space(4))) unsigned long long*)__builtin_amdgcn_kernarg_segment_ptr();
    asm volatile("" : "+s"(pp));
    Params p;
#pragma unroll
    for (int i = 0; i < N_IN; ++i) p.in[i] = (const float*)(const __attribute__((address_space(1))) float*)pp[i];
    p.out = (float*)(__attribute__((address_space(1))) float*)pp[N_IN]; p.ws = (unsigned char*)(__attribute__((address_space(1))) unsigned char*)pp[N_IN + 1]; p.ph_lo = 0; p.ph_hi = 0;
#else
    Params p{};
#endif
    const Frame F = make_frame(lds_raw);
    run_phase<PH>(p, F);
}
template <int PH> __global__ void __launch_bounds__(NTHREADS, 2) phase_kernel(Params p) {
    extern __shared__ __attribute__((aligned(16))) unsigned char lds_raw[];
    run_phase_fresh<PH>(lds_raw);
}
template <int PH> DI void run_all(unsigned char* lds_raw, cg::grid_group& grid, const XcdBarrier& bar) {
    if constexpr (PH < NPHASE) {
        if constexpr (PH == PROBE_PH) {
            if constexpr (PH == 11 || PH == 22 || PH == 12 || PH == 23) {
#if defined(__HIP_DEVICE_COMPILE__)
                const __attribute__((address_space(4))) unsigned long long* pp = (const __attribute__((address_space(4))) unsigned long long*)__builtin_amdgcn_kernarg_segment_ptr();
                asm volatile("" : "+s"(pp));
                Params p;
#pragma unroll
                for (int i = 0; i < N_IN; ++i) p.in[i] = (const float*)(const __attribute__((address_space(1))) float*)pp[i];
                p.out = (float*)(__attribute__((address_space(1))) float*)pp[N_IN]; p.ws = (unsigned char*)(__attribute__((address_space(1))) unsigned char*)pp[N_IN + 1]; p.ph_lo = 0; p.ph_hi = 0;
                const Frame F = make_frame(lds_raw);
                if constexpr (PH == 11 || PH == 22) phase_peer_c(p, F, PH == 11 ? 0 : 1, true); else phase_peer_v(p, F, PH == 12 ? 0 : 1, true);
#endif
            } else run_phase_fresh<PH>(lds_raw);
            xcd_barrier(bar);
        }
        run_phase_fresh<PH>(lds_raw);
        if constexpr (PH + 1 < NPHASE) { xcd_barrier(bar); if constexpr (PROBE_SYNC) xcd_barrier(bar); }
        run_all<PH + 1>(lds_raw, grid, bar);
    }
}
__global__ void __launch_bounds__(NTHREADS, 2) mega(Params p) {
    extern __shared__ __attribute__((aligned(16))) unsigned char lds_raw[];
    cg::grid_group grid = cg::this_grid();
    volatile LAS unsigned* st = (volatile LAS unsigned*)((LAS unsigned char*)lds_raw + LDS_BAR_OFF);
    if (threadIdx.x < 2) st[threadIdx.x] = 0u;
    __syncthreads();
    const XcdBarrier bar = xcd_barrier_post((unsigned*)(p.ws + WS_CTL), st);
    if (p.ph_lo != 0) grid.sync();
    run_all<0>(lds_raw, grid, bar);
}

extern "C" void kernel_launch(void* const* d_in, const int* in_sizes, int n_in, void* d_out, int out_size, void* d_ws, size_t ws_size, hipStream_t stream) {
    static int grid = 0;
    if (grid == 0) {
        if (n_in != 23 || out_size != TL * D || ws_size < WS_END) { fprintf(stderr, "kernel_launch: unexpected shapes (n_in %d out %d ws %zu)\n", n_in, out_size, ws_size); grid = -1; return; }
        int dev = 0, cus = 0, per_cu = 0;
        (void)hipGetDevice(&dev);
        (void)hipDeviceGetAttribute(&cus, hipDeviceAttributeMultiprocessorCount, dev);
        (void)hipFuncSetAttribute((const void*)mega, hipFuncAttributeMaxDynamicSharedMemorySize, LDS_BYTES);
        (void)hipOccupancyMaxActiveBlocksPerMultiprocessor(&per_cu, (const void*)mega, NTHREADS, LDS_BYTES);
        if (per_cu < 1) { fprintf(stderr, "kernel_launch: occupancy query reports %d blocks per CU\n", per_cu); grid = -1; return; }
        grid = cus & ~7;
        if (grid < 8) { fprintf(stderr, "kernel_launch: needs at least 8 CUs\n"); grid = -1; return; }
    }
    if (grid < 0) return;
    (void)hipMemsetAsync((char*)d_ws + WS_CTL, 0, CTL_ZERO_BYTES, stream);
    Params p{};
    for (int i = 0; i < N_IN; ++i) p.in[i] = (const float*)d_in[i];
    p.out = (float*)d_out; p.ws = (unsigned char*)d_ws;
    void* args[] = {&p};
    hipError_t e = hipLaunchCooperativeKernel((const void*)mega, dim3(grid), dim3(NTHREADS), args, LDS_BYTES, stream);
    if (e != hipSuccess) fprintf(stderr, "cooperative launch failed: %s (grid %d)\n", hipGetErrorString(e), grid);
}
```

```cpp
#include <hip/hip_runtime.h>
#include <hip/hip_cooperative_groups.h>
#include <stdint.h>
#include <stdio.h>
namespace cg = cooperative_groups;

#ifndef PROBE_PH
#define PROBE_PH -1
#endif
#ifndef PROBE_SYNC
#define PROBE_SYNC 0
#endif
#ifndef MK_SINGLE
#define MK_SINGLE 0
#endif

#define LAS __attribute__((address_space(3)))
typedef unsigned short bf16_t;
typedef short bf16x8 __attribute__((ext_vector_type(8)));
typedef short s16x4 __attribute__((ext_vector_type(4)));
typedef float f32x4 __attribute__((ext_vector_type(4)));
typedef float f32x2 __attribute__((ext_vector_type(2)));
typedef float f32x16 __attribute__((ext_vector_type(16)));
typedef unsigned u32x4 __attribute__((ext_vector_type(4)));
typedef unsigned u32x2 __attribute__((ext_vector_type(2)));
typedef __bf16 bf16x2_t __attribute__((ext_vector_type(2)));
typedef _Float16 f16x2_t __attribute__((ext_vector_type(2)));
#define DI __device__ __forceinline__
DI unsigned pkh2(float lo, float hi) { f16x2_t v = {(_Float16)lo, (_Float16)hi}; return __builtin_bit_cast(unsigned, v); }
#define MFMA32(a, b, c) __builtin_amdgcn_mfma_f32_32x32x16_bf16((a), (b), (c), 0, 0, 0)

constexpr int D = 1024, NB = 8, SEQ = 4096, NCTX = 256, DEPTH = 2;
constexpr int TL = NB * SEQ, TC = NB * NCTX, T = TL + TC;
constexpr int INW = 4608, NMOD = 6 * D, PW = 1600, PN = 1536;
constexpr int VTS = SEQ + 64;
constexpr int QOFF = 0, KOFF = 512, VOFF = 640, POOLOFF = 768, SUOFF = 1024, SVOFF = 1280, GATEOFF = 1536;
constexpr int NEXP = 16384;
constexpr float EPS = 1e-6f;
constexpr float LOG2E = 1.4426950408889634f;
constexpr float QSCALE = 0.125f * LOG2E;

constexpr size_t MiB = 1u << 20;
constexpr size_t WS_CTL = 0, WS_MOD = 1 * MiB, CTL_ZERO_BYTES = 2 * MiB;
constexpr size_t WS_ROPE = 2 * MiB, WS_SGUW = 2 * MiB + 65536, WS_TSCALE = 3 * MiB;
constexpr size_t WS_WIN = 4 * MiB, WS_WBR = 22 * MiB, WS_WOUT = 26 * MiB, WS_WFOLD = 30 * MiB;
constexpr size_t WS_XCTX = 38 * MiB, WS_UTAB = 46 * MiB, WS_VTAB = 78 * MiB;
constexpr size_t WS_IDX = 110 * MiB, WS_GW = 120 * MiB;
constexpr size_t WS_H = 142 * MiB;
constexpr size_t WS_P = 210 * MiB, WS_Y = 318 * MiB, WS_MERGED = 386 * MiB, WS_VT = 454 * MiB, WS_VTC = 463 * MiB, WS_VST = 464 * MiB;
constexpr size_t WS_MP = 482 * MiB;
constexpr size_t WS_ST = 210 * MiB, WS_H8 = 346 * MiB, WS_HS = 380 * MiB, WS_SU = 482 * MiB;
constexpr size_t WS_END = 512 * MiB;
static_assert(WS_ST + (size_t)2048 * T * 2 <= WS_H8 && WS_H8 + (size_t)T * D <= WS_HS, "ST / H8 fit");
static_assert(WS_VST + (size_t)272 * 256 * 128 * 2 <= WS_SU && WS_VT + (size_t)NB * 2 * 64 * VTS * 2 <= WS_VTC, "VsT / VT fit");
static_assert(WS_H + (size_t)T * D * 2 <= WS_P, "H fits");
static_assert(WS_P + (size_t)T * PW * 2 <= WS_Y && WS_Y + (size_t)T * D * 2 <= WS_MERGED && WS_MERGED + (size_t)T * D * 2 <= WS_VT, "P/Y/MERGED fit");
static_assert(WS_IDX + (size_t)T * 128 * 2 <= WS_GW && WS_GW + (size_t)T * 128 * 4 <= WS_H && WS_SU + (size_t)T * 128 * 4 <= WS_END && WS_HS + (size_t)T * 4 <= WS_SU, "idx/gw/su fit");

constexpr int LDS_BYTES = 163840;
constexpr int LDS_BAR_OFF = LDS_BYTES - 64;
constexpr int NTHREADS = 512, NWAVES = 8;

enum { I_x, I_c, I_ctx, I_c_ctx, I_w_mod, I_b_mod, I_g_mix, I_g_ffn, I_w_in, I_attn_sink, I_pool_w, I_pool_scale, I_sgu_w, I_sgu_b, I_w_br_attn, I_w_br_pool, I_w_br_sgu, I_w_out, I_peer_wq, I_peer_subkeys, I_peer_u, I_peer_v, I_g_final, N_IN };
struct Params {
    const float* in[N_IN];
    float* out; unsigned char* ws;
    int ph_lo, ph_hi;
};

DI unsigned pk2(float lo, float hi) { f32x2 v = {lo, hi}; return __builtin_bit_cast(unsigned, __builtin_convertvector(v, bf16x2_t)); }
DI unsigned f2bf(float f) { return pk2(f, 0.f) & 0xffffu; }
DI float bf2f(unsigned short u) { return __builtin_bit_cast(float, (unsigned)u << 16); }
DI float bflo(unsigned w) { return __builtin_bit_cast(float, w << 16); }
DI float bfhi(unsigned w) { return __builtin_bit_cast(float, w & 0xffff0000u); }
DI int crow(int reg, int h) { return (reg & 3) + 8 * (reg >> 2) + 4 * h; }
DI int dpp_x1(int v) { return __builtin_amdgcn_mov_dpp(v, 0xB1, 0xF, 0xF, true); }
DI float wave_sum(float v) {
#pragma unroll
    for (int o = 1; o < 64; o <<= 1) v += __shfl_xor(v, o);
    return v;
}
DI float sigmoidf_(float x) { return __builtin_amdgcn_rcpf(1.0f + __expf(-x)); }
DI float gelu_tanh(float x) { const float u = 0.7978845608028654f * (x + 0.044715f * x * x * x); return x * __builtin_amdgcn_rcpf(1.0f + __expf(-2.0f * u)); }
DI float silu_(float x) { return x * __builtin_amdgcn_rcpf(1.0f + __expf(-x)); }

struct Frame {
    int tid, lane, wave, gw, ngw, gtid, ngt, bid, nb;
    LAS unsigned char* lds;
};

template <int NM, int NN>
DI void wave_gemm(const bf16_t* __restrict__ A, int lda, const bf16_t* __restrict__ Bt, int ldb, int K, int m0, int n0, f32x16 (&acc)[NM][NN], int lane) {
    const int r = lane & 31, h = lane >> 5;
    const bf16_t* ap = A + (size_t)(m0 + r) * lda + 8 * h;
    const bf16_t* bp = Bt + (size_t)(n0 + r) * ldb + 8 * h;
    for (int k0 = 0; k0 < K; k0 += 64) {
        bf16x8 a[4][NM], b[4][NN];
#pragma unroll
        for (int s = 0; s < 4; ++s) {
#pragma unroll
            for (int i = 0; i < NM; ++i) a[s][i] = *(const bf16x8*)(ap + (size_t)(32 * i) * lda + k0 + 16 * s);
#pragma unroll
            for (int j = 0; j < NN; ++j) b[s][j] = *(const bf16x8*)(bp + (size_t)(32 * j) * ldb + k0 + 16 * s);
        }
#pragma unroll
        for (int s = 0; s < 4; ++s)
#pragma unroll
            for (int i = 0; i < NM; ++i)
#pragma unroll
                for (int j = 0; j < NN; ++j) acc[i][j] = MFMA32(a[s][i], b[s][j], acc[i][j]);
    }
}
template <int NM, int NN> DI void zero_acc(f32x16 (&acc)[NM][NN]) {
#pragma unroll
    for (int i = 0; i < NM; ++i)
#pragma unroll
        for (int j = 0; j < NN; ++j)
#pragma unroll
            for (int r = 0; r < 16; ++r) acc[i][j][r] = 0.f;
}

namespace pg8 {
constexpr int BM = 256, BK = 64, HALF = 128, HTB = HALF * BK * 2, STAGE_BYTES = 8 * HTB, NXCD = 8, WGM = 8, LD = 1024;
DI int lds_byte(int r, int c) { const int st = (r >> 4) * 2 + (c >> 5), rr = r & 15, cc = c & 31, ob = rr * 64 + cc * 2; return st * 1024 + (ob ^ (((ob >> 9) & 1) << 5)); }
DI void stage_rc(int b, int& R, int& C) { const int st = b / 1024, sb = b % 1024, swz = sb ^ (((sb >> 9) & 1) << 5); R = (st >> 1) * 16 + swz / 64; C = (st & 1) * 32 + (swz % 64) / 2; }
DI int perm32(int rho) { const int n = rho >> 4, i = rho & 15; return 8 * (i >> 2) + 4 * n + (i & 3); }
struct Unit { int pm, pn, sub, nt, mode; const char* a; const char* b; };
DI void tile_of(int L, int nM, int nN, int& pm, int& pn) {
    const int nwg = nM * nN; int wgid = L;
    { const int q = nwg / NXCD, r = nwg % NXCD, xcd = wgid % NXCD, off = wgid / NXCD; wgid = (xcd < r ? xcd * (q + 1) : r * (q + 1) + (xcd - r) * q) + off; }
    const int nig = WGM * nN, gid = wgid / nig, fm = gid * WGM, gsz = (nM - fm) < WGM ? (nM - fm) : WGM;
    pm = fm + ((wgid % nig) % gsz); pn = (wgid % nig) / gsz;
}
template <class Epi, class Sched>
DI void gemm_phase(LAS unsigned char* lds, const int tid, const Sched& S, const Epi& E) {
    const int wid = __builtin_amdgcn_readfirstlane(tid >> 6), lane = tid & 63, wr = wid >> 2, wc = wid & 3, fr = lane & 15, fq = lane >> 4;
    unsigned voffA[2], voffB[2];
#pragma unroll
    for (int i = 0; i < 2; ++i) { int R, C; stage_rc(tid * 16 + i * 8192, R, C); const int Rb = Epi::PERM ? ((R & ~31) + perm32(R & 31)) : R;
        voffA[i] = (unsigned)(R * LD + C) * 2u; voffB[i] = (unsigned)(Rb * LD + C) * 2u; }
    const size_t kstep = (size_t)(BK * 2);
    const size_t hstep = (size_t)HALF * LD * 2;
    const unsigned ldsw = (unsigned)wid * 1024u;
    const int aoff = lds_byte(wr * 64 + fr, fq * 8), boff = lds_byte(wc * 32 + fr, fq * 8);
#define PG8_SA(b, h) (((b) * 2 + (h)) * HTB)
#define PG8_SB(b, h) ((4 + (b) * 2 + (h)) * HTB)
#define PG8_STAGE(bufoff, gbase, voff) do { _Pragma("unroll") for (int _i = 0; _i < 2; ++_i) \
        __builtin_amdgcn_global_load_lds((const unsigned*)((const char*)(gbase) + (voff)[_i]), (LAS unsigned*)(lds + (bufoff) + ldsw + _i * 8192), 16, 0, 0); } while (0)
#define PG8_LDA(dst, b, h) do { _Pragma("unroll") for (int m = 0; m < 4; ++m) _Pragma("unroll") for (int k = 0; k < 2; ++k) dst[m][k] = *(const LAS bf16x8*)(lds + PG8_SA(b, h) + aoff + m * 2048 + k * 1024); } while (0)
#define PG8_LDB(dst, b, h) do { _Pragma("unroll") for (int n = 0; n < 2; ++n) _Pragma("unroll") for (int k = 0; k < 2; ++k) dst[n][k] = *(const LAS bf16x8*)(lds + PG8_SB(b, h) + boff + n * 2048 + k * 1024); } while (0)
#define PG8_MMA(ai, bj, At, Bt) do { __builtin_amdgcn_s_setprio(1); _Pragma("unroll") for (int m = 0; m < 4; ++m) _Pragma("unroll") for (int n = 0; n < 2; ++n) _Pragma("unroll") for (int k = 0; k < 2; ++k) \
        acc[ai][bj][m][n] = __builtin_amdgcn_mfma_f32_16x16x32_bf16(Bt[n][k], At[m][k], acc[ai][bj][m][n], 0, 0, 0); __builtin_amdgcn_s_setprio(0); } while (0)
#define PG8_WAIT_V(n) asm volatile("s_waitcnt vmcnt(" #n ")" ::: "memory")
#define PG8_WAIT_L(n) asm volatile("s_waitcnt lgkmcnt(" #n ")" ::: "memory")
#define PG8_BAR __builtin_amdgcn_s_barrier()
#define PG8_SCHED __builtin_amdgcn_sched_barrier(0)
    Unit cur, nxt; int ui = 0;
    if (!S.next(0, cur)) return;
    f32x4 acc[2][2][4][2];
#pragma unroll
    for (int a = 0; a < 2; ++a)
#pragma unroll
        for (int b = 0; b < 2; ++b)
#pragma unroll
            for (int m = 0; m < 4; ++m)
#pragma unroll
                for (int n = 0; n < 2; ++n) acc[a][b][m][n] = (f32x4){0.f, 0.f, 0.f, 0.f};
    bf16x8 At[4][2], B0[2][2], B1[2][2];
    const char* cA = cur.a; const char* cB = cur.b;
    PG8_STAGE(PG8_SB(0, 0), cB, voffB); PG8_STAGE(PG8_SB(0, 1), cB + hstep, voffB); PG8_STAGE(PG8_SA(0, 0), cA, voffA); PG8_STAGE(PG8_SA(0, 1), cA + hstep, voffA);
    if (wr == 1) PG8_BAR;
    PG8_WAIT_V(2); PG8_BAR;
    PG8_STAGE(PG8_SB(1, 0), cB + kstep, voffB); PG8_STAGE(PG8_SA(1, 0), cA + kstep, voffA); PG8_STAGE(PG8_SB(1, 1), cB + hstep + kstep, voffB);
    PG8_WAIT_V(6); PG8_BAR;
    for (;;) {
        const bool has_next = S.next(ui + 1, nxt);
        const char* nA = has_next ? nxt.a : cA; const char* nB = has_next ? nxt.b : cB;
        const int nt = cur.nt;
        for (int t = 0; t < nt; t += 2) {
            const bool last = (t == nt - 2);
            const char* a1 = cA + (size_t)(t + 1) * kstep;
            const char* a2 = last ? nA : cA + (size_t)(t + 2) * kstep; const char* b2 = last ? nB : cB + (size_t)(t + 2) * kstep;
            const char* a3 = a2 + kstep; const char* b3 = b2 + kstep;
            PG8_LDB(B0, 0, 0); PG8_LDB(B1, 0, 1); PG8_SCHED; PG8_LDA(At, 0, 0); PG8_STAGE(PG8_SA(1, 1), a1 + hstep, voffA);
            PG8_WAIT_V(8); PG8_WAIT_L(0); PG8_BAR; PG8_MMA(0, 0, At, B0); PG8_MMA(0, 1, At, B1); PG8_BAR; PG8_SCHED;
            PG8_LDA(At, 0, 1); PG8_STAGE(PG8_SB(0, 0), b2, voffB); PG8_STAGE(PG8_SB(0, 1), b2 + hstep, voffB); PG8_STAGE(PG8_SA(0, 0), a2, voffA);
            PG8_WAIT_V(8); PG8_WAIT_L(0); PG8_BAR; PG8_MMA(1, 0, At, B0); PG8_MMA(1, 1, At, B1); PG8_BAR; PG8_SCHED;
            PG8_LDB(B0, 1, 0); PG8_LDB(B1, 1, 1); PG8_SCHED; PG8_LDA(At, 1, 0); PG8_STAGE(PG8_SA(0, 1), a2 + hstep, voffA);
            PG8_WAIT_V(8); PG8_WAIT_L(0); PG8_BAR; PG8_MMA(0, 0, At, B0); PG8_MMA(0, 1, At, B1); PG8_BAR; PG8_SCHED;
            PG8_LDA(At, 1, 1); PG8_STAGE(PG8_SB(1, 0), b3, voffB); PG8_STAGE(PG8_SB(1, 1), b3 + hstep, voffB); PG8_STAGE(PG8_SA(1, 0), a3, voffA);
            PG8_WAIT_V(8); PG8_WAIT_L(0); PG8_BAR; PG8_MMA(1, 0, At, B0); PG8_MMA(1, 1, At, B1); PG8_BAR; PG8_SCHED;
        }
        if (wr == 0) PG8_BAR;
        E(acc, cur, wr, wc, fr, fq);
        if (!has_next) break;
        if (!E.keeps(cur)) {
#pragma unroll
        for (int a = 0; a < 2; ++a)
#pragma unroll
            for (int b = 0; b < 2; ++b)
#pragma unroll
                for (int m = 0; m < 4; ++m)
#pragma unroll
                    for (int n = 0; n < 2; ++n) acc[a][b][m][n] = (f32x4){0.f, 0.f, 0.f, 0.f};
        }
        cur = nxt; cA = nA; cB = nB; ++ui;
        if (wr == 1) PG8_BAR;
    }
    PG8_WAIT_V(0);
    PG8_BAR;
#undef PG8_SA
#undef PG8_SB
#undef PG8_STAGE
#undef PG8_LDA
#undef PG8_LDB
#undef PG8_MMA
#undef PG8_WAIT_V
#undef PG8_WAIT_L
#undef PG8_BAR
#undef PG8_SCHED
}
}

DI void transpose_item(const float* W, int K, int N, bf16_t* WT, int ldd, int row_off, int col_off, LAS float* scr, int item, int lane) {
    const int nblk = N / 32, kb = item / nblk, nb = item % nblk, k0 = 64 * kb, n0 = 32 * nb;
#pragma unroll 8
    for (int i = 0; i < 32; ++i) { const int kk = 2 * i + (lane >> 5); scr[kk * 33 + (lane & 31)] = W[(size_t)(k0 + kk) * N + n0 + (lane & 31)]; }
    asm volatile("s_waitcnt lgkmcnt(0)" ::: "memory");
    const int c = lane & 7;
#pragma unroll
    for (int j = 0; j < 4; ++j) { const int n = (lane >> 3) + 8 * j; const LAS float* s = scr + (8 * c) * 33 + n;
        u32x4 o; o.x = pk2(s[0 * 33], s[1 * 33]); o.y = pk2(s[2 * 33], s[3 * 33]); o.z = pk2(s[4 * 33], s[5 * 33]); o.w = pk2(s[6 * 33], s[7 * 33]);
        *(u32x4*)(WT + (size_t)(row_off + n0 + n) * ldd + col_off + k0 + 8 * c) = o; }
    asm volatile("s_waitcnt lgkmcnt(0)" ::: "memory");
}

DI void convert_tables(const Params& p, const Frame& F) {
    for (int it0 = 4 * F.gw; it0 < 4 * NEXP; it0 += 4 * F.ngw) {
        f32x4 v[4][4];
#pragma unroll
        for (int u = 0; u < 4; ++u) {
            const int it = it0 + u, e = it & (NEXP - 1), tbl = (it >> 14) & 1, l = it >> 15;
            const f32x4* src = (const f32x4*)((tbl ? p.in[I_peer_v] : p.in[I_peer_u]) + ((size_t)l * NEXP + e) * D) + 4 * F.lane;
#pragma unroll
            for (int j = 0; j < 4; ++j) v[u][j] = src[j];
        }
#pragma unroll
        for (int u = 0; u < 4; ++u) {
            const int it = it0 + u, e = it & (NEXP - 1), tbl = (it >> 14) & 1, l = it >> 15;
            float am = 0.f;
#pragma unroll
            for (int j = 0; j < 4; ++j) am = fmaxf(am, fmaxf(fmaxf(fabsf(v[u][j].x), fabsf(v[u][j].y)), fmaxf(fabsf(v[u][j].z), fabsf(v[u][j].w))));
#pragma unroll
            for (int o = 1; o < 64; o <<= 1) am = fmaxf(am, __shfl_xor(am, o));
            float sc;
            if (tbl) sc = (am > 0.f) ? 6.0f / am : 1.0f;
            else {
                float ss = 0.f;
#pragma unroll
                for (int j = 0; j < 4; ++j) ss += v[u][j].x * v[u][j].x + v[u][j].y * v[u][j].y + v[u][j].z * v[u][j].z + v[u][j].w * v[u][j].w;
                const float rms = sqrtf(wave_sum(ss) * (1.0f / D));
                const float step = fminf(am * (1.0f / 7.0f), 0.41f * rms);
                sc = (step > 0.f) ? 1.0f / step : 1.0f;
            }
            if (tbl) {
                u32x2 q4;
#pragma unroll
                for (int d = 0; d < 2; ++d) { unsigned w = 0;
                    w = __builtin_amdgcn_cvt_scalef32_pk_fp4_f32(w, v[u][2 * d][0] * sc, v[u][2 * d][1] * sc, 1.0f, 0);
                    w = __builtin_amdgcn_cvt_scalef32_pk_fp4_f32(w, v[u][2 * d][2] * sc, v[u][2 * d][3] * sc, 1.0f, 1);
                    w = __builtin_amdgcn_cvt_scalef32_pk_fp4_f32(w, v[u][2 * d + 1][0] * sc, v[u][2 * d + 1][1] * sc, 1.0f, 2);
                    w = __builtin_amdgcn_cvt_scalef32_pk_fp4_f32(w, v[u][2 * d + 1][2] * sc, v[u][2 * d + 1][3] * sc, 1.0f, 3);
                    q4[d] = w; }
                *(u32x2*)(p.ws + WS_VTAB + ((size_t)l * NEXP + e) * (D / 2) + 8 * F.lane) = q4;
            } else {
                u32x2 q4;
#pragma unroll
                for (int d = 0; d < 2; ++d) { unsigned w = 0;
#pragma unroll
                    for (int b = 0; b < 4; ++b) { const int j = 2 * d + (b >> 1), e2 = 2 * (b & 1);
                        const int n0 = (int)fminf(fmaxf(__builtin_rintf(v[u][j][e2] * sc), -8.0f), 7.0f) + 8, n1 = (int)fminf(fmaxf(__builtin_rintf(v[u][j][e2 + 1] * sc), -8.0f), 7.0f) + 8;
                        w |= (unsigned)(n0 | (n1 << 4)) << (8 * b); }
                    q4[d] = w; }
                *(u32x2*)(p.ws + WS_UTAB + ((size_t)l * NEXP + e) * (D / 2) + 8 * F.lane) = q4;
            }
            if (F.lane == 0) ((float*)(p.ws + WS_TSCALE))[(l * 2 + tbl) * NEXP + e] = 1.0f / sc;
        }
    }
}

DI void phase_prep(const Params& p, const Frame& F) {
    unsigned char* ws = p.ws;
    {
        LAS float* wq = (LAS float*)F.lds;
        LAS float* skl = wq + 128 * 65;
        for (int it = F.bid; it < 2 * 16 * 16; it += F.nb) {
            const int cc = it & 15, hp = (it >> 4) & 15, l = it >> 8;
            const float* src = p.in[I_peer_wq] + (size_t)l * D * 2048 + hp * 128;
            const float* sks = p.in[I_peer_subkeys] + (size_t)(l * 16 + hp) * 128 * 128;
            __syncthreads();
            { float tw[16]; f32x4 ts[8];
#pragma unroll
              for (int it = 0; it < 16; ++it) { const int e = F.tid + it * NTHREADS, ci = e >> 7, d = e & 127; tw[it] = src[(size_t)(cc * 64 + ci) * 2048 + d]; }
#pragma unroll
              for (int it = 0; it < 8; ++it) { const int e = F.tid + it * NTHREADS, key = e >> 5, d4 = (e & 31) * 4; ts[it] = *(const f32x4*)(sks + key * 128 + d4); }
#pragma unroll
              for (int it = 0; it < 16; ++it) { const int e = F.tid + it * NTHREADS, ci = e >> 7, d = e & 127; wq[d * 65 + ci] = tw[it]; }
#pragma unroll
              for (int it = 0; it < 8; ++it) { const int e = F.tid + it * NTHREADS, key = e >> 5, d4 = (e & 31) * 4; *(LAS f32x4*)(skl + key * 132 + d4) = ts[it]; } }
            __syncthreads();
            const int ci = F.tid & 63, kg = F.tid >> 6;
            float acc[16];
#pragma unroll
            for (int k = 0; k < 16; ++k) acc[k] = 0.f;
#pragma unroll 2
            for (int d = 0; d < 128; d += 4) {
                const float w0 = wq[d * 65 + ci], w1 = wq[(d + 1) * 65 + ci], w2 = wq[(d + 2) * 65 + ci], w3 = wq[(d + 3) * 65 + ci];
#pragma unroll
                for (int k = 0; k < 16; ++k) { const f32x4 s = *(const LAS f32x4*)(skl + (16 * kg + k) * 132 + d); acc[k] += w0 * s.x + w1 * s.y + w2 * s.z + w3 * s.w; }
            }
            bf16_t* dst = (bf16_t*)(ws + WS_WFOLD) + ((size_t)l * 2048 + hp * 128 + 16 * kg) * D + cc * 64 + ci;
#pragma unroll
            for (int k = 0; k < 16; ++k) dst[(size_t)k * D] = (bf16_t)f2bf(acc[k]);
        }
        __syncthreads();
    }
    {
        LAS float* scr = (LAS float*)(F.lds + F.wave * 16384);
        constexpr int I_IN = (D / 64) * (INW / 32), I_BA = (512 / 64) * (D / 32), I_BS = (256 / 64) * (D / 32), I_O = (D / 64) * (D / 32);
        constexpr int PER_L = I_IN + I_BA + I_BS + I_O;
        for (int it = F.gw; it < 2 * PER_L; it += F.ngw) {
            const int l = it / PER_L; int r = it % PER_L;
            if (r < I_IN) { transpose_item(p.in[I_w_in] + (size_t)l * D * INW, D, INW, (bf16_t*)(ws + WS_WIN) + (size_t)l * INW * D, D, 0, 0, scr, r, F.lane); continue; } r -= I_IN;
            if (r < I_BA) { transpose_item(p.in[I_w_br_attn] + (size_t)l * 512 * D, 512, D, (bf16_t*)(ws + WS_WBR) + (size_t)l * D * D, D, 0, 0, scr, r, F.lane); continue; } r -= I_BA;
            if (r < I_BS) { transpose_item(p.in[I_w_br_sgu] + (size_t)l * 256 * D, 256, D, (bf16_t*)(ws + WS_WBR) + (size_t)l * D * D, D, 0, 768, scr, r, F.lane); continue; } r -= I_BS;
            transpose_item(p.in[I_w_out] + (size_t)l * D * D, D, D, (bf16_t*)(ws + WS_WOUT) + (size_t)l * D * D, D, 0, 0, scr, r, F.lane);
        }
    }
    for (int i = F.gtid; i < 2 * 256 * D; i += F.ngt) {
        const int n = i & 1023, rc = (i >> 10) & 255, l = i >> 18, g = rc >> 6;
        const float* pw = p.in[I_pool_w] + ((size_t)l * 256 + rc) * 64;
        const float* ps = p.in[I_pool_scale] + l * 256 + 64 * g;
        const float* wb = p.in[I_w_br_pool] + ((size_t)l * 256 + 64 * g) * D + n;
        float a = 0.f;
#pragma unroll 16
        for (int e = 0; e < 64; ++e) a += pw[e] * ps[e] * wb[(size_t)e * D];
        ((bf16_t*)(ws + WS_WBR))[(size_t)l * D * D + (size_t)n * D + 512 + rc] = (bf16_t)f2bf(a);
    }
    for (int i = F.gtid; i < 2 * 4 * 128 * 128; i += F.ngt) ((bf16_t*)(ws + WS_SGUW))[i] = (bf16_t)f2bf(p.in[I_sgu_w][i]);
    for (int i = F.gtid; i < 64 * 16; i += F.ngt) {
        const int pos = i >> 4, fi = i & 15;
        const float inv = powf(10000.0f, -(float)fi / 16.0f);
        const float ang = (float)pos * inv;
        ((f32x2*)(ws + WS_ROPE))[i] = (f32x2){cosf(ang), sinf(ang)};
    }
    convert_tables(p, F);
    {
        float* MOD = (float*)(ws + WS_MOD);
        LAS float* scd = (LAS float*)F.lds;
        LAS float* red = scd + 9 * D;
        __syncthreads();
        { float tc[18];
#pragma unroll
          for (int it = 0; it < 18; ++it) { const int e = F.tid + it * NTHREADS, r = e >> 10, k = e & 1023; tc[it] = (r < 8) ? p.in[I_c][r * D + k] : p.in[I_c_ctx][k]; }
#pragma unroll
          for (int it = 0; it < 18; ++it) scd[F.tid + it * NTHREADS] = silu_(tc[it]); }
        __syncthreads();
        for (int it = F.bid; it < 2 * 96; it += F.nb) {
            const int cgp = it % 96, l = it / 96, col = cgp * 64 + F.lane;
            float acc[9];
#pragma unroll
            for (int r = 0; r < 9; ++r) acc[r] = 0.f;
            const float* wp = p.in[I_w_mod] + ((size_t)l * D + F.wave * 128) * NMOD + col;
#pragma unroll 16
            for (int k = 0; k < 128; ++k) {
                const float w = wp[(size_t)k * NMOD];
#pragma unroll
                for (int r = 0; r < 9; ++r) acc[r] += scd[r * D + F.wave * 128 + k] * w;
            }
#pragma unroll
            for (int r = 0; r < 9; ++r) red[(F.wave * 9 + r) * 64 + F.lane] = acc[r];
            __syncthreads();
            for (int e = F.tid; e < 9 * 64; e += NTHREADS) {
                const int r = e >> 6, ln = e & 63; float s = p.in[I_b_mod][l * NMOD + cgp * 64 + ln];
#pragma unroll
                for (int w = 0; w < 8; ++w) s += red[(w * 9 + r) * 64 + ln];
                MOD[((size_t)l * 9 + r) * NMOD + cgp * 64 + ln] = s;
            }
            __syncthreads();
        }
    }
}

DI const float* mod_vec(const Params& p, int l, int row, int j) {
    const int r = row < TL ? row / SEQ : 8;
    return (const float*)(p.ws + WS_MOD) + ((size_t)l * 9 + r) * NMOD + j * D;
}
DI float* xrow_ptr(const Params& p, int row) { return row < TL ? p.out + (size_t)row * D : (float*)(p.ws + WS_XCTX) + (size_t)(row - TL) * D; }
DI const float* xin_ptr(const Params& p, int row) { return row < TL ? p.in[I_x] + (size_t)row * D : p.in[I_ctx] + (size_t)(row - TL) * D; }

DI void phase_norm(const Params& p, const Frame& F, int l, int which  , bool from_input, int nrows) {
    const float* g = (which == 0 ? p.in[I_g_mix] : p.in[I_g_ffn]) + l * D;
    const int lane = F.lane;
    f32x4 gg[4];
#pragma unroll
    for (int j = 0; j < 4; ++j) gg[j] = ((const f32x4*)g)[lane + 64 * j];
    for (int row0 = 2 * F.gw; row0 < nrows; row0 += 2 * F.ngw) {
        f32x4 v[2][4], s1[2][4], s2[2][4];
#pragma unroll
        for (int u = 0; u < 2; ++u) {
            const int row = row0 + u;
            const float* src = from_input ? xin_ptr(p, row) : xrow_ptr(p, row);
            const float* sh = mod_vec(p, l, row, which * 3 + 0); const float* sc = mod_vec(p, l, row, which * 3 + 1);
#pragma unroll
            for (int j = 0; j < 4; ++j) { v[u][j] = ((const f32x4*)src)[lane + 64 * j]; s1[u][j] = ((const f32x4*)sh)[lane + 64 * j]; s2[u][j] = ((const f32x4*)sc)[lane + 64 * j]; }
        }
#pragma unroll
        for (int u = 0; u < 2; ++u) {
            float ss = 0.f;
#pragma unroll
            for (int j = 0; j < 4; ++j) ss += v[u][j].x * v[u][j].x + v[u][j].y * v[u][j].y + v[u][j].z * v[u][j].z + v[u][j].w * v[u][j].w;
            const float rinv = rsqrtf(wave_sum(ss) * (1.0f / D) + EPS);
            bf16_t* dst = (bf16_t*)(p.ws + WS_H) + (size_t)(row0 + u) * D;
            float am = 0.f;
#pragma unroll
            for (int j = 0; j < 4; ++j) {
                const f32x4 o = v[u][j] * rinv * gg[j] * (s2[u][j] + 1.0f) + s1[u][j];
                u32x2 w; w.x = pk2(o.x, o.y); w.y = pk2(o.z, o.w);
                ((u32x2*)dst)[lane + 64 * j] = w;
                v[u][j] = o; am = fmaxf(am, fmaxf(fmaxf(fabsf(o.x), fabsf(o.y)), fmaxf(fabsf(o.z), fabsf(o.w))));
            }
            if (which) {
#pragma unroll
                for (int o2 = 1; o2 < 64; o2 <<= 1) am = fmaxf(am, __shfl_xor(am, o2));
                const float sc = (am > 0.f) ? 127.0f / am : 1.0f;
                unsigned* h8 = (unsigned*)(p.ws + WS_H8 + (size_t)(row0 + u) * D);
                const bool odd = (lane & 1) != 0;
#pragma unroll
                for (int j = 0; j < 4; ++j) {
                    const int b0 = (int)__builtin_rintf(v[u][j].x * sc), b1 = (int)__builtin_rintf(v[u][j].y * sc), b2 = (int)__builtin_rintf(v[u][j].z * sc), b3 = (int)__builtin_rintf(v[u][j].w * sc);
                    const int p0 = dpp_x1(b0), p1 = dpp_x1(b1), p2 = dpp_x1(b2), p3 = dpp_x1(b3);
                    const int w0 = odd ? p1 : b0, w1 = odd ? p3 : b2, w2 = odd ? b1 : p0, w3 = odd ? b3 : p2;
                    h8[lane + 64 * j] = (unsigned)(w0 & 0xff) | ((unsigned)(w1 & 0xff) << 8) | ((unsigned)(w2 & 0xff) << 16) | ((unsigned)w3 << 24);
                }
                if (lane == 0) ((float*)(p.ws + WS_HS))[row0 + u] = (am > 0.f) ? am * (1.0f / 127.0f) : 1.0f;
            }
        }
    }
}
DI void phase_final(const Params& p, const Frame& F) {
    f32x4 gg[4];
#pragma unroll
    for (int j = 0; j < 4; ++j) gg[j] = ((const f32x4*)p.in[I_g_final])[F.lane + 64 * j];
    for (int row0 = 2 * F.gw; row0 < TL; row0 += 2 * F.ngw) {
        f32x4 v[2][4];
#pragma unroll
        for (int u = 0; u < 2; ++u)
#pragma unroll
            for (int j = 0; j < 4; ++j) v[u][j] = ((const f32x4*)(p.out + (size_t)(row0 + u) * D))[F.lane + 64 * j];
#pragma unroll
        for (int u = 0; u < 2; ++u) {
            float ss = 0.f;
#pragma unroll
            for (int j = 0; j < 4; ++j) ss += v[u][j].x * v[u][j].x + v[u][j].y * v[u][j].y + v[u][j].z * v[u][j].z + v[u][j].w * v[u][j].w;
            const float rinv = rsqrtf(wave_sum(ss) * (1.0f / D) + EPS);
            f32x4* xr = (f32x4*)(p.out + (size_t)(row0 + u) * D);
#pragma unroll
            for (int j = 0; j < 4; ++j) xr[F.lane + 64 * j] = v[u][j] * rinv * gg[j];
        }
    }
}

DI float lane_xor32(float v, bool hi) { const auto r = __builtin_amdgcn_permlane32_swap(__builtin_bit_cast(unsigned, v), __builtin_bit_cast(unsigned, v), false, false);
    return __builtin_bit_cast(float, hi ? r[0] : r[1]); }
struct EpiG1 {
    DI bool keeps(const pg8::Unit&) const { return false; }
    static constexpr bool PERM = true;
    unsigned char* ws;
    DI void operator()(const f32x4 (&acc)[2][2][4][2], const pg8::Unit& u, int wr, int wc, int fr, int fq) const {
        bf16_t* P = (bf16_t*)(ws + WS_P);
        const int rbase = u.pm * 256 + wr * 64 + fr;
        const bool hi = fq >= 2;
#pragma unroll
        for (int ai = 0; ai < 2; ++ai) {
            f32x4 cs[4][4];
            const bool lat = u.pm < TL / 256;
            if (u.pn < 3 && lat) {
#pragma unroll
                for (int m = 0; m < 4; ++m) {
                    const int t = (rbase + 128 * ai + 16 * m) & (SEQ - 1), pos = (wc & 1) ? (t & 63) : (t >> 6);
                    const f32x4* tab = (const f32x4*)(ws + WS_ROPE) + (pos * 16 + 8 * (fq & 1)) / 2;
#pragma unroll
                    for (int j2 = 0; j2 < 4; ++j2) cs[m][j2] = tab[j2];
                }
            }
#pragma unroll
            for (int m = 0; m < 4; ++m) {
                const int row = rbase + 128 * ai + 16 * m;
#pragma unroll
                for (int bj = 0; bj < 2; ++bj) {
                    const int c0 = u.pn * 256 + 128 * bj + 32 * wc + 8 * fq;
                    float v[8];
#pragma unroll
                    for (int j = 0; j < 4; ++j) { v[j] = acc[ai][bj][m][0][j]; v[4 + j] = acc[ai][bj][m][1][j]; }
                    if (c0 < VOFF) {
                        const float sc = (c0 < KOFF) ? QSCALE : 1.0f;
                        u32x4 o;
#pragma unroll
                        for (int j2 = 0; j2 < 4; ++j2) {
                            const f32x4 c4 = cs[m][j2];
                            const float o0 = lane_xor32(v[2 * j2], hi), o1 = lane_xor32(v[2 * j2 + 1], hi);
                            float r0 = hi ? (v[2 * j2] * c4.x + o0 * c4.y) : (v[2 * j2] * c4.x - o0 * c4.y);
                            float r1 = hi ? (v[2 * j2 + 1] * c4.z + o1 * c4.w) : (v[2 * j2 + 1] * c4.z - o1 * c4.w);
                            if (!lat) { r0 = v[2 * j2]; r1 = v[2 * j2 + 1]; }
                            o[j2] = pk2(r0 * sc, r1 * sc);
                        }
                        *(u32x4*)(P + (size_t)row * PW + c0) = o;
                    } else if (c0 < POOLOFF) {
                        const int hk = wc >> 1, d0 = 32 * (wc & 1) + 8 * fq;
                        if (lat) { const int b = row / SEQ, t = row & (SEQ - 1);
                            bf16_t* vt = (bf16_t*)(ws + WS_VT) + ((size_t)(b * 2 + hk) * 64 + d0) * VTS + t;
#pragma unroll
                            for (int j = 0; j < 8; ++j) vt[(size_t)j * VTS] = (bf16_t)f2bf(v[j]);
                        } else { const int rc = row - TL, b = rc / NCTX, jc = rc & (NCTX - 1);
                            bf16_t* vt = (bf16_t*)(ws + WS_VTC) + ((size_t)(b * 2 + hk) * 64 + d0) * NCTX + jc;
#pragma unroll
                            for (int j = 0; j < 8; ++j) vt[(size_t)j * NCTX] = (bf16_t)f2bf(v[j]);
                        }
                    } else if (c0 < SUOFF) {
                        u32x4 o;
#pragma unroll
                        for (int j2 = 0; j2 < 4; ++j2) o[j2] = pk2(v[2 * j2], v[2 * j2 + 1]);
                        *(u32x4*)(P + (size_t)row * PW + c0) = o;
                    } else if (c0 < SVOFF) {
                        u32x4 o;
#pragma unroll
                        for (int j2 = 0; j2 < 4; ++j2) o[j2] = pk2(gelu_tanh(v[2 * j2]), gelu_tanh(v[2 * j2 + 1]));
                        *(u32x4*)(P + (size_t)row * PW + c0) = o;
                    } else {
                        const int c = c0 - SVOFF, chunk = row >> 7, q = row & 127;
                        bf16_t* vs = (bf16_t*)(ws + WS_VST) + ((size_t)chunk * 256 + c) * 128 + q;
#pragma unroll
                        for (int j = 0; j < 8; ++j) vs[j * 128] = (bf16_t)f2bf(gelu_tanh(v[j]));
                    }
                }
            }
            asm volatile("" ::: "memory");
        }
    }
};
struct SchedGrid {
    int nM, nN, G, c; const char* A; const char* B;
    int n_extra, ex_pm0, ex_pn;
    DI bool next(int i, pg8::Unit& u) const {
        const int L = i * G + c, n = nM * nN; if (L >= n + n_extra) return false;
        if (L < n) pg8::tile_of(L, nM, nN, u.pm, u.pn); else { u.pm = ex_pm0 + (L - n); u.pn = ex_pn; }
        u.sub = 0; u.nt = D / 64; u.mode = 0;
        u.a = A + (size_t)u.pm * 256 * D * 2; u.b = B + (size_t)u.pn * 256 * D * 2; return true;
    }
};

DI void phase_g1(const Params& p, const Frame& F, int l) {
    SchedGrid S{(l == 0 ? T : TL) / 256, PN / 256, F.nb, F.bid, (const char*)(p.ws + WS_H), (const char*)(p.ws + WS_WIN) + (size_t)l * INW * D * 2,
                (l == 0) ? 0 : TC / 256, TL / 256, 2};
    EpiG1 E{p.ws};
    pg8::gemm_phase(F.lds, F.tid, S, E);
}

DI bf16x8 pack8(const f32x16& x, int s) {
    u32x4 pk;
#pragma unroll
    for (int j = 0; j < 4; ++j) { f32x2 v = {x[8 * s + 2 * j], x[8 * s + 2 * j + 1]}; pk[j] = __builtin_bit_cast(unsigned, __builtin_convertvector(v, bf16x2_t)); }
    return __builtin_bit_cast(bf16x8, pk);
}

DI float lane_x32(float v, bool hi) { const auto r = __builtin_amdgcn_permlane32_swap(__builtin_bit_cast(unsigned, v), __builtin_bit_cast(unsigned, v), false, false);
    return __builtin_bit_cast(float, hi ? r[0] : r[1]); }
struct AttnFrags { bf16x8 kf[4]; s16x4 vf[2][4]; };
DI void attn_block(const bf16x8 (&qf)[4], const AttnFrags& f, int mask_mode, int kq_off, int lane, float& m, float& lpart, f32x16 (&o)[2]) {
    const int h = lane >> 5;
    f32x16 st;
#pragma unroll
    for (int r = 0; r < 16; ++r) st[r] = 0.f;
#pragma unroll
    for (int s = 0; s < 4; ++s) st = MFMA32(f.kf[s], qf[s], st);
    if (mask_mode) {
#pragma unroll
        for (int r = 0; r < 16; ++r) { const int dlt = kq_off + crow(r, h); if (dlt > 128 || dlt < -128) st[r] = -1e30f; }
    }
    float bm = st[0];
#pragma unroll
    for (int r = 1; r < 16; ++r) bm = fmaxf(bm, st[r]);
    bm = fmaxf(bm, lane_x32(bm, h != 0));
    const float mn = fmaxf(m, bm);
    if (__builtin_amdgcn_ballot_w64(mn > m) != 0ull) {
        const float alpha = __builtin_amdgcn_exp2f(m - mn);
        lpart *= alpha;
#pragma unroll
        for (int d = 0; d < 2; ++d)
#pragma unroll
            for (int r = 0; r < 16; ++r) o[d][r] *= alpha;
        m = mn;
    }
    float ps = 0.f;
#pragma unroll
    for (int r = 0; r < 16; ++r) { st[r] = __builtin_amdgcn_exp2f(st[r] - m); ps += st[r]; }
    lpart += ps;
    const bf16x8 pf0 = pack8(st, 0), pf1 = pack8(st, 1);
#pragma unroll
    for (int d = 0; d < 2; ++d) {
        const bf16x8 v0 = __builtin_shufflevector(f.vf[d][0], f.vf[d][1], 0, 1, 2, 3, 4, 5, 6, 7), v1 = __builtin_shufflevector(f.vf[d][2], f.vf[d][3], 0, 1, 2, 3, 4, 5, 6, 7);
        o[d] = MFMA32(v0, pf0, o[d]);
        o[d] = MFMA32(v1, pf1, o[d]);
    }
}

constexpr int AKP = 144, AVWP = 648, AVCP = 520;
constexpr int ALDS_KW = 0, ALDS_VW = ALDS_KW + 320 * AKP, ALDS_KC = ALDS_VW + 64 * AVWP, ALDS_VC = ALDS_KC + 256 * AKP, ALDS_END = ALDS_VC + 64 * AVCP;
static_assert(ALDS_END <= LDS_BAR_OFF && (ALDS_VW % 16) == 0 && (ALDS_KC % 16) == 0 && (ALDS_VC % 8) == 0, "attention LDS map");
DI void attn_lds_frags(AttnFrags& f, const LAS unsigned char* kp, const LAS unsigned char* vp, int vpitch32) {
#pragma unroll
    for (int s = 0; s < 4; ++s) f.kf[s] = *(const LAS bf16x8*)(kp + 32 * s);
#pragma unroll
    for (int d = 0; d < 2; ++d)
#pragma unroll
        for (int q = 0; q < 4; ++q) f.vf[d][q] = *(const LAS s16x4*)(vp + d * vpitch32 + 16 * q);
}
DI void attn_unit(const Params& p, const Frame& F, int l, int unit) {
    const int lane = F.lane, r = lane & 31, h = lane >> 5, tid = F.tid;
    const bf16_t* P = (const bf16_t*)(p.ws + WS_P);
    const bf16_t* VT = (const bf16_t*)(p.ws + WS_VT);
    const bf16_t* VTC = (const bf16_t*)(p.ws + WS_VTC);
    bf16_t* Y = (bf16_t*)(p.ws + WS_Y);
    const bool latent = unit < 1024;
    int b, hk, p0, q0row;
    if (latent) { const int pb = unit & 63; hk = (unit >> 6) & 1; b = unit >> 7; p0 = pb * 64; q0row = b * SEQ + p0; }
    else { const int u2 = unit - 1024, pb = u2 & 3; hk = (u2 >> 2) & 1; b = u2 >> 3; p0 = pb * 64; q0row = TL + b * NCTX + p0; }
    const int w0 = p0 - 128;
    u32x4 kw[5], vw[5], kc[4], vc[4];
    if (latent) {
#pragma unroll
        for (int it = 0; it < 5; ++it) {
            const int i = tid + it * NTHREADS, row = i >> 3, ck = i & 7, pos = min(max(w0 + row, 0), SEQ - 1);
            kw[it] = *(const u32x4*)(P + (size_t)(b * SEQ + pos) * PW + KOFF + hk * 64 + 8 * ck);
            const int d = i / 40, cv = i % 40, pv = min(max(w0 + 8 * cv, 0), SEQ - 8);
            vw[it] = *(const u32x4*)(VT + ((size_t)(b * 2 + hk) * 64 + d) * VTS + pv);
        }
    }
#pragma unroll
    for (int it = 0; it < 4; ++it) {
        const int i = tid + it * NTHREADS;
        kc[it] = *(const u32x4*)(P + (size_t)(TL + b * NCTX + (i >> 3)) * PW + KOFF + hk * 64 + 8 * (i & 7));
        vc[it] = *(const u32x4*)(VTC + ((size_t)(b * 2 + hk) * 64 + (i >> 5)) * NCTX + 8 * (i & 31));
    }
    __syncthreads();
    if (latent) {
#pragma unroll
        for (int it = 0; it < 5; ++it) {
            const int i = tid + it * NTHREADS, row = i >> 3, ck = i & 7;
            *(LAS u32x4*)(F.lds + ALDS_KW + row * AKP + 16 * ck) = kw[it];
            const int d = i / 40, cv = i % 40;
            LAS u32x2* dst = (LAS u32x2*)(F.lds + ALDS_VW + d * AVWP + 16 * cv); dst[0] = (u32x2){vw[it].x, vw[it].y}; dst[1] = (u32x2){vw[it].z, vw[it].w};
        }
    }
#pragma unroll
    for (int it = 0; it < 4; ++it) {
        const int i = tid + it * NTHREADS;
        *(LAS u32x4*)(F.lds + ALDS_KC + (i >> 3) * AKP + 16 * (i & 7)) = kc[it];
        LAS u32x2* dst = (LAS u32x2*)(F.lds + ALDS_VC + (i >> 5) * AVCP + 16 * (i & 31)); dst[0] = (u32x2){vc[it].x, vc[it].y}; dst[1] = (u32x2){vc[it].z, vc[it].w};
    }
    const int head = 4 * hk + (F.wave & 3), ph = F.wave >> 2, pw = p0 + 32 * ph, qrow = q0row + 32 * ph;
    bf16x8 qf[4];
#pragma unroll
    for (int s = 0; s < 4; ++s) qf[s] = *(const bf16x8*)(P + (size_t)(qrow + r) * PW + head * 64 + 16 * s + 8 * h);
    float m = p.in[I_attn_sink][l * 8 + head] * LOG2E, lpart = (h == 0) ? 1.0f : 0.0f;
    f32x16 o[2];
#pragma unroll
    for (int d = 0; d < 2; ++d)
#pragma unroll
        for (int i = 0; i < 16; ++i) o[d][i] = 0.f;
    __syncthreads();
    if (latent) {
#pragma unroll 1
        for (int j = 0; j < 9; ++j) {
            const int kb = pw - 128 + 32 * j;
            if (kb < 0 || kb >= SEQ) continue;
            const int krow = kb - w0;
            AttnFrags f;
            attn_lds_frags(f, F.lds + ALDS_KW + (krow + r) * AKP + 16 * h, F.lds + ALDS_VW + r * AVWP + 2 * krow + 8 * h, 32 * AVWP);
            attn_block(qf, f, (j == 0 || j == 8) ? 1 : 0, kb - (pw + r), lane, m, lpart, o);
        }
    }
#pragma unroll 1
    for (int j = 0; j < 8; ++j) {
        AttnFrags f;
        attn_lds_frags(f, F.lds + ALDS_KC + (32 * j + r) * AKP + 16 * h, F.lds + ALDS_VC + r * AVCP + 64 * j + 8 * h, 32 * AVCP);
        attn_block(qf, f, 0, 0, lane, m, lpart, o);
    }
    const float inv = 1.0f / (lpart + lane_x32(lpart, h != 0));
    bf16_t* yrow = Y + (size_t)(qrow + r) * D + head * 64;
#pragma unroll
    for (int d = 0; d < 2; ++d)
#pragma unroll
        for (int g = 0; g < 4; ++g) {
            u32x2 w; w.x = pk2(o[d][4 * g] * inv, o[d][4 * g + 1] * inv); w.y = pk2(o[d][4 * g + 2] * inv, o[d][4 * g + 3] * inv);
            *(u32x2*)(yrow + 32 * d + 8 * g + 4 * h) = w;
        }
}

DI void sgu_unit(const Params& p, const Frame& F, int l, int chunk) {
    constexpr int VS = 136;
    LAS float* part = (LAS float*)F.lds;
    LAS float* rq = part + 512;
    LAS bf16_t* vnT = (LAS bf16_t*)(F.lds + 4096);
    const bf16_t* VsT = (const bf16_t*)(p.ws + WS_VST) + (size_t)chunk * 256 * 128;
    const bf16_t* P = (const bf16_t*)(p.ws + WS_P);
    bf16_t* Y = (bf16_t*)(p.ws + WS_Y);
    __syncthreads();
    { const int q = F.tid & 127, part_i = F.tid >> 7; float ss = 0.f;
#pragma unroll 16
        for (int c = part_i * 64; c < part_i * 64 + 64; ++c) { const float v = bf2f(VsT[c * 128 + q]); ss += v * v; }
        part[part_i * 128 + q] = ss; }
    __syncthreads();
    if (F.tid < 128) rq[F.tid] = rsqrtf((part[F.tid] + part[128 + F.tid] + part[256 + F.tid] + part[384 + F.tid]) * (1.0f / 256.0f) + EPS);
    __syncthreads();
#pragma unroll
    for (int it = 0; it < 8; ++it) {
        const int i = F.tid + it * NTHREADS;
        const int c = i >> 4, q8 = (i & 15) * 8;
        const u32x4 v = *(const u32x4*)(VsT + c * 128 + q8);
        u32x4 o;
#pragma unroll
        for (int j = 0; j < 4; ++j) o[j] = pk2(bflo(v[j]) * rq[q8 + 2 * j], bfhi(v[j]) * rq[q8 + 2 * j + 1]);
        *(LAS u32x4*)(vnT + c * VS + q8) = o;
    }
    __syncthreads();
    const int lane = F.lane, r = lane & 31, h = lane >> 5, g = F.wave >> 1, ph = F.wave & 1;
    const bf16_t* Wg = (const bf16_t*)(p.ws + WS_SGUW) + ((size_t)l * 4 + g) * 128 * 128;
#pragma unroll 1
    for (int pb = 0; pb < 2; ++pb) {
        const int p0 = 64 * ph + 32 * pb;
        const int row = chunk * 128 + p0 + r;
        bf16x8 wf[8];
#pragma unroll
        for (int s = 0; s < 8; ++s) wf[s] = *(const bf16x8*)(Wg + (size_t)(p0 + r) * 128 + 16 * s + 8 * h);
        u32x2 uu[2][4];
#pragma unroll
        for (int cb = 0; cb < 2; ++cb)
#pragma unroll
            for (int q4 = 0; q4 < 4; ++q4) uu[cb][q4] = *(const u32x2*)(P + (size_t)row * PW + SUOFF + 64 * g + 32 * cb + 8 * q4 + 4 * h);
        const float bias = p.in[I_sgu_b][(l * 4 + g) * 128 + p0 + r];
#pragma unroll
        for (int cb = 0; cb < 2; ++cb) {
            const int c0 = 64 * g + 32 * cb;
            f32x16 acc;
#pragma unroll
            for (int i = 0; i < 16; ++i) acc[i] = 0.f;
#pragma unroll
            for (int s = 0; s < 8; ++s) {
                const bf16x8 a = *(const LAS bf16x8*)(vnT + (c0 + r) * VS + 16 * s + 8 * h);
                acc = MFMA32(a, wf[s], acc);
            }
#pragma unroll
            for (int q4 = 0; q4 < 4; ++q4) {
                const int cc = c0 + 8 * q4 + 4 * h;
                const u32x2 u = uu[cb][q4];
                u32x2 w;
                w.x = pk2(bflo(u.x) * (acc[4 * q4] + bias), bfhi(u.x) * (acc[4 * q4 + 1] + bias));
                w.y = pk2(bflo(u.y) * (acc[4 * q4 + 2] + bias), bfhi(u.y) * (acc[4 * q4 + 3] + bias));
                *(u32x2*)(Y + (size_t)row * D + 768 + cc) = w;
            }
        }
    }
}

DI void phase_mix(const Params& p, const Frame& F, int l, int ctr_slot = 0) {
    (void)ctr_slot;
    const int nrows = (l == 0) ? T : TL;
    const bf16_t* P = (const bf16_t*)(p.ws + WS_P);
    bf16_t* Y = (bf16_t*)(p.ws + WS_Y);
    for (int i0 = F.bid * NTHREADS; i0 < 4 * nrows * 8; i0 += F.nb * NTHREADS) {
        const int i = i0 + F.tid, g = i / (nrows * 8), rem = i - g * (nrows * 8), row = rem >> 3, ck = g * 8 + (rem & 7);
        int base, t, len;
        if (row < TL) { base = row & ~(SEQ - 1); t = row & (SEQ - 1); len = SEQ; } else { const int rc = row - TL; base = TL + (rc & ~(NCTX - 1)); t = rc & (NCTX - 1); len = NCTX; }
        float s[8];
#pragma unroll
        for (int j = 0; j < 8; ++j) s[j] = 0.f;
        const bf16_t* zc = P + POOLOFF + ck * 8;
#define POOL_WIN(HALF) do { _Pragma("unroll") for (int dt = -(HALF); dt < (HALF); ++dt) { const int tt = t + dt; const bool ok = tt >= 0 && tt < len; \
            const u32x4 v = *(const u32x4*)(zc + (size_t)(base + (ok ? tt : t)) * PW); const float w = ok ? 1.f : 0.f; \
            _Pragma("unroll") for (int j = 0; j < 4; ++j) { s[2 * j] += w * bflo(v[j]); s[2 * j + 1] += w * bfhi(v[j]); } } } while (0)
        int half;
        if (g == 0) { POOL_WIN(1); half = 1; } else if (g == 1) { POOL_WIN(2); half = 2; } else if (g == 2) { POOL_WIN(4); half = 4; } else { POOL_WIN(8); half = 8; }
#undef POOL_WIN
        const int lo = max(t - half, 0), hi = min(t + half, len);
        const float inv = 1.0f / (float)(hi - lo);
        const u32x4 z = *(const u32x4*)(zc + (size_t)row * PW);
        u32x4 o;
#pragma unroll
        for (int j = 0; j < 4; ++j) o[j] = pk2(s[2 * j] * inv - bflo(z[j]), s[2 * j + 1] * inv - bfhi(z[j]));
        *(u32x4*)(Y + (size_t)row * D + 512 + ck * 8) = o;
    }
    const int nchunk = (l == 0) ? T / 128 : TL / 128;
    for (int ch = F.bid; ch < nchunk; ch += F.nb) sgu_unit(p, F, l, ch);
    const int nunit = (l == 0) ? 1024 + 64 : 1024;
    for (int u = F.nb - 1 - F.bid; u < nunit; u += F.nb) attn_unit(p, F, l, u);
}

struct SchedG2 {
    int G, c; const char *H, *Y, *Wg, *Wb; int npair;
    DI void fill(pg8::Unit& u, int sub, int br) const {
        u.sub = sub;
        if ((sub & 1) == 0) { u.nt = 16; u.a = H + (size_t)u.pm * 256 * D * 2; u.b = Wg + ((size_t)br * D + u.pn * 256) * D * 2; }
        else { const int koff = (br == 0) ? 0 : (br == 1 ? 512 : 768); u.nt = (br == 0) ? 8 : 4;
               u.a = Y + ((size_t)u.pm * 256 * D + koff) * 2; u.b = Wb + ((size_t)u.pn * 256 * D + koff) * 2; }
    }
    DI bool next(int i, pg8::Unit& u) const {
        constexpr int NLAT = (TL / 256) * 4;
        const int nl = (NLAT - c + G - 1) / G;
        if (i < 6 * nl) { const int tile = (i / 6) * G + c, sub = i % 6; pg8::tile_of(tile, TL / 256, 4, u.pm, u.pn); u.mode = 0; fill(u, sub, sub >> 1); return true; }
        const int e = i - 6 * nl, j = (e >> 1) * G + c;
        if (j >= npair) return false;
        const int ctile = j / 3, br = j % 3;
        u.pm = TL / 256 + (ctile >> 2); u.pn = ctile & 3; u.mode = 1 + br; fill(u, e & 1, br); return true;
    }
};
struct EpiG2 {
    static constexpr bool PERM = true;
    bf16_t* scr; bf16_t* M; bf16_t* MP;
    DI bool keeps(const pg8::Unit& u) const { return (u.sub & 1) == 0; }
    DI void operator()(f32x4 (&acc)[2][2][4][2], const pg8::Unit& u, int wr, int wc, int fr, int fq) const {
        const bool gate = (u.sub & 1) == 0, first = u.sub == 0 && gate;
        bf16_t* Mo = (u.mode == 0) ? M + (size_t)u.pm * 256 * D : MP + ((size_t)(u.mode - 1) * TC + (size_t)(u.pm - TL / 256) * 256) * D;
#pragma unroll
        for (int ai = 0; ai < 2; ++ai) {
            u32x4 ld[4][2];
            if (!first) {
#pragma unroll
                for (int m = 0; m < 4; ++m)
#pragma unroll
                    for (int bj = 0; bj < 2; ++bj) {
                        const int rl = 128 * ai + 64 * wr + 16 * m + fr, cl = 128 * bj + 32 * wc + 8 * fq;
                        ld[m][bj] = gate ? *(const u32x4*)(Mo + (size_t)rl * D + u.pn * 256 + cl) : *(const u32x4*)(scr + rl * 256 + cl);
                    }
            }
#pragma unroll
            for (int m = 0; m < 4; ++m)
#pragma unroll
                for (int bj = 0; bj < 2; ++bj) {
                    const int rl = 128 * ai + 64 * wr + 16 * m + fr, cl = 128 * bj + 32 * wc + 8 * fq;
                    if (gate) {
                        u32x4 o;
#pragma unroll
                        for (int j2 = 0; j2 < 4; ++j2) {
                            const int n = j2 >> 1, e = 2 * (j2 & 1);
                            const unsigned w = pk2(fmaxf(sigmoidf_(acc[ai][bj][m][n][e]), 1e-20f), fmaxf(sigmoidf_(acc[ai][bj][m][n][e + 1]), 1e-20f));
                            o[j2] = w;
                            const float t0 = first ? 0.f : bflo(ld[m][bj][j2]), t1 = first ? 0.f : bfhi(ld[m][bj][j2]);
                            acc[ai][bj][m][n][e] = t0 * __builtin_amdgcn_rcpf(bflo(w)); acc[ai][bj][m][n][e + 1] = t1 * __builtin_amdgcn_rcpf(bfhi(w));
                        }
                        *(u32x4*)(scr + rl * 256 + cl) = o;
                    } else {
                        u32x4 w;
#pragma unroll
                        for (int j2 = 0; j2 < 4; ++j2) { const int n = j2 >> 1, e = 2 * (j2 & 1);
                            w[j2] = pk2(acc[ai][bj][m][n][e] * bflo(ld[m][bj][j2]), acc[ai][bj][m][n][e + 1] * bfhi(ld[m][bj][j2])); }
                        *(u32x4*)(Mo + (size_t)rl * D + u.pn * 256 + cl) = w;
                    }
                }
            asm volatile("" ::: "memory");
        }
    }
};
DI void phase_g2(const Params& p, const Frame& F, int l) {
    SchedG2 S{F.nb, F.bid, (const char*)(p.ws + WS_H), (const char*)(p.ws + WS_Y),
              (const char*)(p.ws + WS_WIN) + ((size_t)l * INW + GATEOFF) * D * 2, (const char*)(p.ws + WS_WBR) + (size_t)l * D * D * 2, (l == 0) ? (TC / 256) * 4 * 3 : 0};
    EpiG2 E{(bf16_t*)(p.ws + WS_IDX) + (size_t)F.bid * 65536, (bf16_t*)(p.ws + WS_MERGED), (bf16_t*)(p.ws + WS_MP)};
    pg8::gemm_phase(F.lds, F.tid, S, E);
}
DI void phase_g2sum(const Params& p, const Frame& F) {
    const u32x4* mp = (const u32x4*)(p.ws + WS_MP);
    u32x4* mo = (u32x4*)((bf16_t*)(p.ws + WS_MERGED) + (size_t)TL * D);
    constexpr int NV = TC * D / 8;
    for (int i = F.gtid; i < NV; i += F.ngt) {
        const u32x4 a = mp[i], b = mp[NV + i], c = mp[2 * NV + i];
        u32x4 o;
#pragma unroll
        for (int j = 0; j < 4; ++j) o[j] = pk2(bflo(a[j]) + bflo(b[j]) + bflo(c[j]), bfhi(a[j]) + bfhi(b[j]) + bfhi(c[j]));
        mo[i] = o;
    }
}

struct EpiG3 {
    DI bool keeps(const pg8::Unit&) const { return false; }
    static constexpr bool PERM = false;
    const float* xsrc; float* xdst; const float* csrc; float* cdst; const float* mod;
    DI void operator()(const f32x4 (&acc)[2][2][4][2], const pg8::Unit& u, int wr, int wc, int fr, int fq) const {
        const int col0 = u.pn * 256 + wc * 32 + 4 * fq;
        const bool lat = u.pm < TL / 256;
        const float* gt = mod + (size_t)(lat ? (u.pm >> 4) : 8) * NMOD + 2 * D;
        const float* xs = lat ? xsrc + (size_t)u.pm * 256 * D : csrc + (size_t)(u.pm - TL / 256) * 256 * D;
        float* xd = lat ? xdst + (size_t)u.pm * 256 * D : cdst + (size_t)(u.pm - TL / 256) * 256 * D;
        f32x4 gv[2][2];
#pragma unroll
        for (int bj = 0; bj < 2; ++bj)
#pragma unroll
            for (int n = 0; n < 2; ++n) gv[bj][n] = *(const f32x4*)(gt + col0 + 128 * bj + 16 * n);
#pragma unroll
        for (int ai = 0; ai < 2; ++ai) {
            f32x4 xv[4][2][2];
#pragma unroll
            for (int m = 0; m < 4; ++m)
#pragma unroll
                for (int bj = 0; bj < 2; ++bj)
#pragma unroll
                    for (int n = 0; n < 2; ++n) xv[m][bj][n] = *(const f32x4*)(xs + (size_t)(wr * 64 + fr + 128 * ai + 16 * m) * D + col0 + 128 * bj + 16 * n);
#pragma unroll
            for (int m = 0; m < 4; ++m)
#pragma unroll
                for (int bj = 0; bj < 2; ++bj)
#pragma unroll
                    for (int n = 0; n < 2; ++n)
                        *(f32x4*)(xd + (size_t)(wr * 64 + fr + 128 * ai + 16 * m) * D + col0 + 128 * bj + 16 * n) = xv[m][bj][n] + gv[bj][n] * acc[ai][bj][m][n];
            asm volatile("" ::: "memory");
        }
    }
};
DI void phase_g3(const Params& p, const Frame& F, int l) {
    SchedGrid S{(l == 0 ? T : TL) / 256, D / 256, F.nb, F.bid, (const char*)(p.ws + WS_MERGED), (const char*)(p.ws + WS_WOUT) + (size_t)l * D * D * 2, 0, 0, 0};
    float* xc = (float*)(p.ws + WS_XCTX);
    EpiG3 E{(l == 0) ? p.in[I_x] : p.out, p.out, (l == 0) ? p.in[I_ctx] : xc, xc, (const float*)(p.ws + WS_MOD) + (size_t)l * 9 * NMOD};
    pg8::gemm_phase(F.lds, F.tid, S, E);
}

struct EpiG45 {
    DI bool keeps(const pg8::Unit&) const { return false; }
    static constexpr bool PERM = true;
    unsigned short* ST;
    DI void operator()(const f32x4 (&acc)[2][2][4][2], const pg8::Unit& u, int wr, int wc, int fr, int fq) const {
        const int col0 = u.pn * 256 + wc * 32 + 8 * fq;
#pragma unroll
        for (int ai = 0; ai < 2; ++ai)
#pragma unroll
            for (int m = 0; m < 4; ++m) {
                unsigned short* rowp = ST + (size_t)(u.pm * 256 + wr * 64 + fr + 128 * ai + 16 * m) * T + col0;
#pragma unroll
                for (int bj = 0; bj < 2; ++bj) {
                    u32x4 w;
                    w.x = pkh2(acc[ai][bj][m][0][0], acc[ai][bj][m][0][1]); w.y = pkh2(acc[ai][bj][m][0][2], acc[ai][bj][m][0][3]);
                    w.z = pkh2(acc[ai][bj][m][1][0], acc[ai][bj][m][1][1]); w.w = pkh2(acc[ai][bj][m][1][2], acc[ai][bj][m][1][3]);
                    *(u32x4*)(rowp + 128 * bj) = w;
                }
            }
    }
};
DI void phase_g45(const Params& p, const Frame& F, int l) {
    SchedGrid S{2048 / 256, (l == 0 ? T : TL) / 256, F.nb, F.bid, (const char*)(p.ws + WS_WFOLD) + (size_t)l * 2048 * D * 2, (const char*)(p.ws + WS_H), 0, 0, 0};
    EpiG45 E{(unsigned short*)(p.ws + WS_ST)};
    pg8::gemm_phase(F.lds, F.tid, S, E);
}

DI unsigned fkey(float f) { const unsigned u = __builtin_bit_cast(unsigned, f); return (u & 0x80000000u) ? ~u : (u | 0x80000000u); }
DI float fkey_inv(unsigned k) { const unsigned u = (k & 0x80000000u) ? (k & 0x7fffffffu) : ~k; return __builtin_bit_cast(float, u); }
#define INSERT16(L, x) do { unsigned x_ = (x); _Pragma("unroll") for (int k_ = 0; k_ < 16; ++k_) { const unsigned hi_ = max(L[k_], x_); x_ = min(L[k_], x_); L[k_] = hi_; } } while (0)
#define CEX(a, b) do { const unsigned hi_ = max(a, b), lo_ = min(a, b); a = hi_; b = lo_; } while (0)
DI void sort16_desc(unsigned (&v)[16]) {
#pragma unroll
    for (int k = 2; k <= 16; k <<= 1)
#pragma unroll
        for (int j = k >> 1; j > 0; j >>= 1)
#pragma unroll
            for (int i = 0; i < 16; ++i) {
                const int q = i ^ j;
                if (q > i) { if ((i & k) == 0) CEX(v[i], v[q]); else CEX(v[q], v[i]); }
            }
}
DI void merge16_desc(unsigned (&L)[16], const unsigned (&N)[16]) {
#pragma unroll
    for (int i = 0; i < 16; ++i) L[i] = max(L[i], N[15 - i]);
#pragma unroll
    for (int j = 8; j > 0; j >>= 1)
#pragma unroll
        for (int i = 0; i < 16; ++i) { const int q = i ^ j; if (q > i) CEX(L[i], L[q]); }
}
DI void phase_sel(const Params& p, const Frame& F, int l) {
    const _Float16* ST = (const _Float16*)(p.ws + WS_ST);
    unsigned short* IDX = (unsigned short*)(p.ws + WS_IDX);
    float* GW = (float*)(p.ws + WS_GW);
    float* SU = (float*)(p.ws + WS_SU);
    const float* TSC = (const float*)(p.ws + WS_TSCALE) + (size_t)l * 2 * NEXP;
    LAS unsigned char* ib = (LAS unsigned char*)F.lds;
    const int ntok = (l == 0) ? T : TL;
    for (int i0 = F.bid * NTHREADS; i0 < ntok * 8; i0 += F.nb * NTHREADS) {
        const int i = i0 + F.tid;
        const int tok = i % ntok, head = i / ntok;
        unsigned la[16], lb[16];
#pragma unroll
        for (int k = 0; k < 16; ++k) { la[k] = 0u; lb[k] = 0u; }
        const _Float16* s0 = ST + (size_t)(head * 256) * T + tok;
#define SEL_LOAD(B_, k0_) do { _Pragma("unroll") for (int j = 0; j < 32; ++j) B_[j] = sp[(size_t)((k0_) + j) * T]; } while (0)
#define SEL_GRP(L_, B_, o_, k0_) do { unsigned nk_[16]; \
        _Pragma("unroll") for (int j = 0; j < 16; ++j) nk_[j] = (fkey((float)B_[(o_) + j]) & ~127u) | (unsigned)(127 - ((k0_) + j)); \
        sort16_desc(nk_); merge16_desc(L_, nk_); } while (0)
#define SEL_HALF(L_, base_) do { const _Float16* sp = s0 + (size_t)(base_) * T; _Float16 bufa[32], bufb[32]; \
        SEL_LOAD(bufa, 0); \
        _Pragma("unroll 1") for (int k0 = 0; k0 < 128; k0 += 64) { \
            SEL_LOAD(bufb, k0 + 32); SEL_GRP(L_, bufa, 0, k0); SEL_GRP(L_, bufa, 16, k0 + 16); \
            SEL_LOAD(bufa, (k0 + 64) & 127); SEL_GRP(L_, bufb, 0, k0 + 32); SEL_GRP(L_, bufb, 16, k0 + 48); } } while (0)
        SEL_HALF(la, 0);
        SEL_HALF(lb, 128);
#undef SEL_LOAD
#undef SEL_GRP
#undef SEL_HALF
        float va[16], vb[16];
#pragma unroll
        for (int k = 0; k < 16; ++k) {
            va[k] = fkey_inv(la[k] & ~127u); vb[k] = fkey_inv(lb[k] & ~127u);
            ib[k * NTHREADS + F.tid] = (unsigned char)(127u - (la[k] & 127u));
            ib[(16 + k) * NTHREADS + F.tid] = (unsigned char)(127u - (lb[k] & 127u));
        }
        unsigned lc[16];
#pragma unroll
        for (int k = 0; k < 16; ++k) lc[k] = 0u;
#pragma unroll
        for (int a = 0; a < 16; ++a)
#pragma unroll
            for (int b = 0; b < 16; ++b)
                if ((a + 1) * (b + 1) <= 16) { const unsigned key = (fkey(va[a] + vb[b]) & ~255u) | (unsigned)(255 - (a * 16 + b)); INSERT16(lc, key); }
        float e[16], sum = 0.f; const float v0 = fkey_inv(lc[0] & ~255u);
#pragma unroll
        for (int k = 0; k < 16; ++k) { e[k] = __expf(fkey_inv(lc[k] & ~255u) - v0); sum += e[k]; }
        const float inv = 1.0f / sum;
        asm volatile("s_waitcnt lgkmcnt(0)" ::: "memory");
        unsigned exs[16]; float gws[16], sus[16];
#pragma unroll
        for (int k = 0; k < 16; ++k) {
            const unsigned pos = 255u - (lc[k] & 255u), a = pos >> 4, b = pos & 15u;
            const unsigned ea = ib[a * NTHREADS + F.tid], eb = ib[(16 + b) * NTHREADS + F.tid];
            exs[k] = ea * 128u + eb;
        }
#pragma unroll
        for (int k = 0; k < 16; ++k) { gws[k] = e[k] * inv * TSC[NEXP + exs[k]]; sus[k] = TSC[exs[k]]; }
        { const size_t o = (size_t)tok * 128 + head * 16;
#pragma unroll
          for (int q = 0; q < 2; ++q) { u32x4 w;
#pragma unroll
              for (int j = 0; j < 4; ++j) w[j] = exs[8 * q + 2 * j] | (exs[8 * q + 2 * j + 1] << 16);
              *(u32x4*)(IDX + o + 8 * q) = w; }
#pragma unroll
          for (int q = 0; q < 4; ++q) { *(f32x4*)(GW + o + 4 * q) = (f32x4){gws[4 * q], gws[4 * q + 1], gws[4 * q + 2], gws[4 * q + 3]};
                                        *(f32x4*)(SU + o + 4 * q) = (f32x4){sus[4 * q], sus[4 * q + 1], sus[4 * q + 2], sus[4 * q + 3]}; } }
        asm volatile("s_waitcnt lgkmcnt(0)" ::: "memory");
    }
}

DI float dpp_xor1(float v) { return __builtin_bit_cast(float, __builtin_amdgcn_mov_dpp(__builtin_bit_cast(int, v), 0xB1, 0xF, 0xF, true)); }
DI float dpp_xor2(float v) { return __builtin_bit_cast(float, __builtin_amdgcn_mov_dpp(__builtin_bit_cast(int, v), 0x4E, 0xF, 0xF, true)); }
DI float dpp_hmir(float v) { return __builtin_bit_cast(float, __builtin_amdgcn_mov_dpp(__builtin_bit_cast(int, v), 0x141, 0xF, 0xF, true)); }
DI float dot16_fp8(const u32x4 q, const float (&hx)[16]) {
    f32x2 a = {0.f, 0.f};
#pragma unroll
    for (int j = 0; j < 4; ++j) {
        const f32x2 lo = __builtin_amdgcn_cvt_pk_f32_fp8((int)q[j], false), hi = __builtin_amdgcn_cvt_pk_f32_fp8((int)q[j], true);
        a += lo * (f32x2){hx[4 * j], hx[4 * j + 1]}; a += hi * (f32x2){hx[4 * j + 2], hx[4 * j + 3]};
    }
    return a.x + a.y;
}
#define PEER_EXPERT(id, i) ((int)(((id)[(i) >> 3][((i) >> 1) & 3] >> (16 * ((i) & 1))) & 0xffffu))

DI int dpp_xor1i(int v) { return __builtin_amdgcn_mov_dpp(v, 0xB1, 0xF, 0xF, true); }
DI int dpp_xor2i(int v) { return __builtin_amdgcn_mov_dpp(v, 0x4E, 0xF, 0xF, true); }
DI int dpp_hmiri(int v) { return __builtin_amdgcn_mov_dpp(v, 0x141, 0xF, 0xF, true); }
struct PeerURows { u32x4 q[16]; u32x4 h[2]; };
DI void peer_u_rows(PeerURows& R, const u32x4 (&id)[2], const unsigned char* ut, const unsigned char* hrow) {
    R.h[0] = *(const u32x4*)(hrow); R.h[1] = *(const u32x4*)(hrow + 16);
#pragma unroll
    for (int i = 0; i < 16; ++i) R.q[i] = *(const u32x4*)(ut + (size_t)PEER_EXPERT(id, i) * (D / 2));
}
DI void peer_u_compute(const PeerURows& R, float* part, int lane) {
    int hsum = 0;
#pragma unroll
    for (int g = 0; g < 2; ++g)
#pragma unroll
        for (int j = 0; j < 4; ++j) hsum = __builtin_amdgcn_sdot4((int)R.h[g][j], 0x01010101, hsum, false);
    int d[16];
#pragma unroll
    for (int i = 0; i < 16; ++i) { int a = 0;
#pragma unroll
        for (int dw = 0; dw < 4; ++dw) {
            const unsigned w = R.q[i][dw];
            a = __builtin_amdgcn_sdot4((int)(w & 0x0f0f0f0fu), (int)R.h[dw >> 1][2 * (dw & 1)], a, false);
            a = __builtin_amdgcn_sdot4((int)((w >> 4) & 0x0f0f0f0fu), (int)R.h[dw >> 1][2 * (dw & 1) + 1], a, false);
        }
        d[i] = a - 8 * hsum; }
    const bool b2 = (lane & 4) != 0, b1 = (lane & 2) != 0, b0 = (lane & 1) != 0;
    int k8[8];
#pragma unroll
    for (int i = 0; i < 8; ++i) { const int keep = b2 ? d[8 + i] : d[i], send = b2 ? d[i] : d[8 + i]; k8[i] = keep + dpp_hmiri(send); }
    int k4[4];
#pragma unroll
    for (int i = 0; i < 4; ++i) { const int keep = b1 ? k8[4 + i] : k8[i], send = b1 ? k8[i] : k8[4 + i]; k4[i] = keep + dpp_xor2i(send); }
    f32x2 k2;
    { const int keep0 = b0 ? k4[2] : k4[0], send0 = b0 ? k4[0] : k4[2], keep1 = b0 ? k4[3] : k4[1], send1 = b0 ? k4[1] : k4[3];
      k2.x = (float)(keep0 + dpp_xor1i(send0)); k2.y = (float)(keep1 + dpp_xor1i(send1)); }
    *(f32x2*)(part + 16 * (lane >> 3) + (b2 ? 8 : 0) + (b1 ? 4 : 0) + (b0 ? 2 : 0)) = k2;
}
DI void phase_peer_u(const Params& p, const Frame& F, int l) {
    const int ntok = (l == 0) ? T : TL, lane = F.lane, half = ntok >> 1;
    const int grp = F.bid & 7, cs = grp & 3, th = grp >> 2, sw = (F.bid >> 3) * NWAVES + F.wave, nsw = (F.nb >> 3) * NWAVES;
    const unsigned char* ut = p.ws + WS_UTAB + (size_t)l * NEXP * (D / 2) + 128 * cs + 16 * (lane & 7);
    const unsigned char* Hs = p.ws + WS_H8 + 256 * cs + 32 * (lane & 7);
    const unsigned short* IDXg = (const unsigned short*)(p.ws + WS_IDX) + 16 * (lane >> 3);
    float* PART = (float*)(p.ws + WS_ST) + (size_t)cs * T * 128;
    const int t0 = th * half, tend = t0 + half, last = tend - 1;
    u32x4 sa[2], sb[2]; PeerURows ra, rb;
#define U_SEL(S_, t_) do { const unsigned short* ip_ = IDXg + (size_t)min((t_), last) * 128; S_[0] = *(const u32x4*)ip_; S_[1] = *(const u32x4*)(ip_ + 8); } while (0)
#define U_ROWS(R_, S_, t_) peer_u_rows(R_, S_, ut, Hs + (size_t)min((t_), last) * D)
    U_SEL(sa, t0 + sw); U_SEL(sb, t0 + sw + nsw);
    U_ROWS(ra, sa, t0 + sw);
#pragma unroll 1
    for (int tok = t0 + sw; tok < tend; tok += 2 * nsw) {
        U_SEL(sa, tok + 2 * nsw); U_ROWS(rb, sb, tok + nsw);
        peer_u_compute(ra, PART + (size_t)tok * 128, lane);
        U_SEL(sb, tok + 3 * nsw); U_ROWS(ra, sa, tok + 2 * nsw);
        if (tok + nsw < tend) peer_u_compute(rb, PART + (size_t)(tok + nsw) * 128, lane);
    }
#undef U_SEL
#undef U_ROWS
}
DI void phase_peer_c(const Params& p, const Frame& F, int l, bool dummy = false) {
    const int ntok = (l == 0) ? T : TL;
    const float* PART = (const float*)(p.ws + WS_ST);
    float* GW = (float*)(p.ws + WS_GW);
    float* CO = dummy ? (float*)(p.ws + WS_H8) : GW;
    const float* SU = (const float*)(p.ws + WS_SU);
    const float* HS = (const float*)(p.ws + WS_HS);
    for (int i0 = F.gtid; i0 < ntok * 128; i0 += 4 * F.ngt) {
        float s[4], gw[4], su[4];
#pragma unroll
        for (int u = 0; u < 4; ++u) {
            const int i = min(i0 + u * F.ngt, ntok * 128 - 1);
            s[u] = 0.f;
#pragma unroll
            for (int sl = 0; sl < 4; ++sl) s[u] += PART[(size_t)sl * T * 128 + i];
            gw[u] = GW[i]; su[u] = SU[i] * HS[i >> 7];
        }
#pragma unroll
        for (int u = 0; u < 4; ++u) { const int i = i0 + u * F.ngt; if (i < ntok * 128) CO[i] = gw[u] * gelu_tanh(s[u] * su[u]); }
    }
}
struct PeerVRows { u32x4 q[16]; f32x4 cf[4]; f32x4 xv, gv; };
DI void peer_v_rows(PeerVRows& R, const u32x4 (&id)[2], const unsigned char* vt, const float* cp, const float* xs, const float* gt2) {
    R.cf[0] = *(const f32x4*)cp; R.cf[1] = *(const f32x4*)(cp + 4); R.cf[2] = *(const f32x4*)(cp + 8); R.cf[3] = *(const f32x4*)(cp + 12);
    R.xv = *(const f32x4*)xs; R.gv = *(const f32x4*)gt2;
#pragma unroll
    for (int i = 0; i < 16; ++i) R.q[i] = *(const u32x4*)(vt + (size_t)PEER_EXPERT(id, i) * (D / 2));
}
DI float xchg32(float v, bool hi) { const auto r = __builtin_amdgcn_permlane32_swap(__builtin_bit_cast(unsigned, v), __builtin_bit_cast(unsigned, v), false, false);
    return __builtin_bit_cast(float, hi ? r[0] : r[1]); }
DI float xchg16(float v, bool hi) { const auto r = __builtin_amdgcn_permlane16_swap(__builtin_bit_cast(unsigned, v), __builtin_bit_cast(unsigned, v), false, false);
    return __builtin_bit_cast(float, hi ? r[0] : r[1]); }
DI float xchg8(float v) { return __builtin_bit_cast(float, __builtin_amdgcn_mov_dpp(__builtin_bit_cast(int, v), 0x128, 0xF, 0xF, true)); }
typedef _Float16 h16x2 __attribute__((ext_vector_type(2)));
DI unsigned xchg32u(unsigned v, bool hi) { const auto r = __builtin_amdgcn_permlane32_swap(v, v, false, false); return hi ? r[0] : r[1]; }
DI unsigned xchg16u(unsigned v, bool hi) { const auto r = __builtin_amdgcn_permlane16_swap(v, v, false, false); return hi ? r[0] : r[1]; }
DI unsigned xchg8u(unsigned v) { return (unsigned)__builtin_amdgcn_mov_dpp((int)v, 0x128, 0xF, 0xF, true); }
DI void peer_v_compute(const PeerVRows& R, float* xdst, int lane) {
    h16x2 a[16];
#pragma unroll
    for (int j = 0; j < 16; ++j) a[j] = (h16x2){(_Float16)0.f, (_Float16)0.f};
#pragma unroll
    for (int i = 0; i < 16; ++i) {
        const _Float16 ch = (_Float16)R.cf[i >> 2][i & 3]; const h16x2 c2 = {ch, ch};
#pragma unroll
        for (int d = 0; d < 4; ++d) {
            a[4 * d + 0] += c2 * __builtin_amdgcn_cvt_scalef32_pk_f16_fp4(R.q[i][d], 1.0f, 0);
            a[4 * d + 1] += c2 * __builtin_amdgcn_cvt_scalef32_pk_f16_fp4(R.q[i][d], 1.0f, 1);
            a[4 * d + 2] += c2 * __builtin_amdgcn_cvt_scalef32_pk_f16_fp4(R.q[i][d], 1.0f, 2);
            a[4 * d + 3] += c2 * __builtin_amdgcn_cvt_scalef32_pk_f16_fp4(R.q[i][d], 1.0f, 3);
        }
    }
    const bool b5 = (lane & 32) != 0, b4 = (lane & 16) != 0, b3 = (lane & 8) != 0;
    h16x2 k8[8];
#pragma unroll
    for (int j = 0; j < 8; ++j) { const h16x2 keep = b5 ? a[8 + j] : a[j], send = b5 ? a[j] : a[8 + j];
        k8[j] = keep + __builtin_bit_cast(h16x2, xchg32u(__builtin_bit_cast(unsigned, send), b5)); }
    h16x2 k4[4];
#pragma unroll
    for (int j = 0; j < 4; ++j) { const h16x2 keep = b4 ? k8[4 + j] : k8[j], send = b4 ? k8[j] : k8[4 + j];
        k4[j] = keep + __builtin_bit_cast(h16x2, xchg16u(__builtin_bit_cast(unsigned, send), b4)); }
    h16x2 k2[2];
#pragma unroll
    for (int j = 0; j < 2; ++j) { const h16x2 keep = b3 ? k4[2 + j] : k4[j], send = b3 ? k4[j] : k4[2 + j];
        k2[j] = keep + __builtin_bit_cast(h16x2, xchg8u(__builtin_bit_cast(unsigned, send))); }
    *(f32x4*)xdst = R.xv + R.gv * (f32x4){(float)k2[0].x, (float)k2[0].y, (float)k2[1].x, (float)k2[1].y};
}
DI void phase_peer_v(const Params& p, const Frame& F, int l, bool dummy = false) {
    const int ntok = (l == 0) ? T : TL, lane = F.lane, half = ntok >> 1;
    const int grp = F.bid & 7, cs = grp & 3, th = grp >> 2, sw = (F.bid >> 3) * NWAVES + F.wave, nsw = (F.nb >> 3) * NWAVES;
    const unsigned char* vt = p.ws + WS_VTAB + (size_t)l * NEXP * (D / 2) + 128 * cs + 16 * (lane & 7);
    const unsigned short* IDXg = (const unsigned short*)(p.ws + WS_IDX) + 16 * (lane >> 3);
    const float* CFg = (const float*)(p.ws + WS_GW) + 16 * (lane >> 3);
    const int t0 = th * half, tend = t0 + half, last = tend - 1;
    u32x4 sa[2], sb[2]; PeerVRows ra, rb;
#define V_SEL(S_, t_) do { const unsigned short* ip_ = IDXg + (size_t)min((t_), last) * 128; S_[0] = *(const u32x4*)ip_; S_[1] = *(const u32x4*)(ip_ + 8); } while (0)
    const int co = 256 * cs + 32 * (lane & 7) + ((lane & 32) ? 16 : 0) + ((lane & 16) ? 8 : 0) + ((lane & 8) ? 4 : 0);
#define V_ROWS(R_, S_, t_) do { const int t1_ = min((t_), last); peer_v_rows(R_, S_, vt, CFg + (size_t)t1_ * 128, xrow_ptr(p, t1_) + co, mod_vec(p, l, t1_, 5) + co); } while (0)
#define V_DO(R_, t_) do { const int t2_ = (t_); float* xd_ = (dummy ? (float*)(p.ws + WS_ST) + (size_t)t2_ * D : xrow_ptr(p, t2_)) + co; peer_v_compute(R_, xd_, lane); } while (0)
    V_SEL(sa, t0 + sw); V_SEL(sb, t0 + sw + nsw);
    V_ROWS(ra, sa, t0 + sw);
#pragma unroll 1
    for (int tok = t0 + sw; tok < tend; tok += 2 * nsw) {
        V_SEL(sa, tok + 2 * nsw); V_ROWS(rb, sb, tok + nsw);
        V_DO(ra, tok);
        V_SEL(sb, tok + 3 * nsw); V_ROWS(ra, sa, tok + 2 * nsw);
        if (tok + nsw < tend) V_DO(rb, tok + nsw);
    }
#undef V_SEL
#undef V_ROWS
#undef V_DO
}

#define XB_TMO      128
#define XB_XCNT(j)  (256  + 64 * (j))
#define XB_XSUB(j)  (1280 + 64 * (j))
#define XB_XGEN(j)  (2304 + 64 * (j))
#define XB_TOP      3328
#define XB_TOPGEN   3392
#define XCD_BAR_WORDS 3456
#define XB_SPIN_CAP (1u << 18)
DI unsigned xb_ld(unsigned* p)              { return __hip_atomic_load(p, __ATOMIC_RELAXED, __HIP_MEMORY_SCOPE_AGENT); }
DI unsigned xb_add(unsigned* p, unsigned v) { return __hip_atomic_fetch_add(p, v, __ATOMIC_RELAXED, __HIP_MEMORY_SCOPE_AGENT); }
DI unsigned xb_xcc_id() { return (unsigned)__builtin_amdgcn_s_getreg((3 << 11) | 20) & 0xFu; }
#define XB_SPIN(cond, bar) do { unsigned _sp = 0; while (cond) { __builtin_amdgcn_s_sleep(1); \
    if ((++_sp & 255u) == 0u) { if (xb_ld(&(bar)[XB_TMO])) break; if (_sp > XB_SPIN_CAP) { atomicAdd(&(bar)[XB_TMO], 1u); break; } } } } while (0)
struct XcdBarrier { unsigned* bar; unsigned x; volatile LAS unsigned* st; };
DI XcdBarrier xcd_barrier_post(unsigned* bar, volatile LAS unsigned* st) {
    XcdBarrier b; b.bar = bar; b.x = xb_xcc_id(); b.st = st;
    if (threadIdx.x == 0) (void)xb_add(&bar[XB_XCNT(b.x)], 1u);
    return b;
}
DI void xcd_barrier_complete(unsigned* bar, unsigned x, unsigned& nloc, unsigned& nx) {
    const unsigned G = gridDim.x * gridDim.y * gridDim.z;
    unsigned sum, cnt, mine, sp = 0u;
    for (;;) {
        sum = 0u; cnt = 0u; mine = 0u;
#pragma unroll
        for (unsigned j = 0; j < 16; ++j) { const unsigned c = xb_ld(&bar[XB_XCNT(j)]); sum += c; cnt += (c > 0u) ? 1u : 0u; mine = (j == x) ? c : mine; }
        if (sum == G) break;
        __builtin_amdgcn_s_sleep(1);
        if ((++sp & 255u) == 0u) { if (xb_ld(&bar[XB_TMO])) break; if (sp > XB_SPIN_CAP) { atomicAdd(&bar[XB_TMO], 1u); break; } }
    }
    nloc = mine > 0u ? mine : 1u; nx = cnt > 0u ? cnt : 1u;
}
DI void xcd_barrier(const XcdBarrier& b) {
    asm volatile("s_waitcnt vmcnt(0)" ::: "memory");
    __syncthreads();
    if (threadIdx.x == 0) {
        unsigned* bar = b.bar;
        __builtin_amdgcn_s_waitcnt(0);
        unsigned nloc = b.st[0], nx = b.st[1];
        if (nloc == 0u) { xcd_barrier_complete(bar, b.x, nloc, nx); b.st[0] = nloc; b.st[1] = nx; }
        const unsigned old = xb_add(&bar[XB_XSUB(b.x)], 1u);
        const unsigned gen = old / nloc;
        if (old + 1u == (gen + 1u) * nloc) {
            __builtin_amdgcn_fence(__ATOMIC_RELEASE, "agent");
            asm volatile("s_waitcnt vmcnt(0)" ::: "memory");
            const unsigned og = xb_add(&bar[XB_TOP], 1u);
            const unsigned tg = og / nx;
            if (og + 1u == (tg + 1u) * nx) xb_add(&bar[XB_TOPGEN], 1u);
            else XB_SPIN(xb_ld(&bar[XB_TOPGEN]) == tg, bar);
            __builtin_amdgcn_fence(__ATOMIC_ACQUIRE, "agent");
            xb_add(&bar[XB_XGEN(b.x)], 1u);
            asm volatile("s_waitcnt vmcnt(0)" ::: "memory");
        } else {
            XB_SPIN(xb_ld(&bar[XB_XGEN(b.x)]) == gen, bar);
            __builtin_amdgcn_fence(__ATOMIC_ACQUIRE, "agent");
            asm volatile("s_waitcnt vmcnt(0)" ::: "memory");
        }
    }
    __syncthreads();
}

constexpr int NPHASE = 25;
template <int PH> DI void run_phase(const Params& p, const Frame& F) {
    if constexpr (PH == 0) phase_prep(p, F);
    else if constexpr (PH == 1) phase_norm(p, F, 0, 0, true, T);
    else if constexpr (PH == 2) phase_g1(p, F, 0);
    else if constexpr (PH == 3) phase_mix(p, F, 0);
    else if constexpr (PH == 4) phase_g2(p, F, 0);
    else if constexpr (PH == 5) phase_g2sum(p, F);
    else if constexpr (PH == 6) phase_g3(p, F, 0);
    else if constexpr (PH == 7) phase_norm(p, F, 0, 1, false, T);
    else if constexpr (PH == 8) phase_g45(p, F, 0);
    else if constexpr (PH == 9) phase_sel(p, F, 0);
    else if constexpr (PH == 10) phase_peer_u(p, F, 0);
    else if constexpr (PH == 11) phase_peer_c(p, F, 0);
    else if constexpr (PH == 12) phase_peer_v(p, F, 0);
    else if constexpr (PH == 13) phase_norm(p, F, 1, 0, false, T);
    else if constexpr (PH == 14) phase_g1(p, F, 1);
    else if constexpr (PH == 15) phase_mix(p, F, 1);
    else if constexpr (PH == 16) phase_g2(p, F, 1);
    else if constexpr (PH == 17) phase_g3(p, F, 1);
    else if constexpr (PH == 18) phase_norm(p, F, 1, 1, false, TL);
    else if constexpr (PH == 19) phase_g45(p, F, 1);
    else if constexpr (PH == 20) phase_sel(p, F, 1);
    else if constexpr (PH == 21) phase_peer_u(p, F, 1);
    else if constexpr (PH == 22) phase_peer_c(p, F, 1);
    else if constexpr (PH == 23) phase_peer_v(p, F, 1);
    else if constexpr (PH == 24) phase_final(p, F);
}
DI Frame make_frame(unsigned char* lds_raw) {
    Frame F;
    F.lds = (LAS unsigned char*)lds_raw;
    int tid = threadIdx.x; asm volatile("" : "+v"(tid));
    int bid = blockIdx.x, nb = gridDim.x; asm volatile("" : "+s"(bid), "+s"(nb));
    F.tid = tid; F.lane = tid & 63; F.wave = __builtin_amdgcn_readfirstlane(tid >> 6); F.bid = bid; F.nb = nb;
    F.gw = bid * NWAVES + F.wave; F.ngw = nb * NWAVES; F.gtid = bid * NTHREADS + tid; F.ngt = nb * NTHREADS;
    return F;
}
template <int PH> DI void run_phase_fresh(unsigned char* lds_raw) {
#if defined(__HIP_DEVICE_COMPILE__)
    const __attribute__((address_space(4))) unsigned long long* pp = (const __attribute__((address_space(4))) unsigned long long*)__builtin_amdgcn_kernarg_segment_ptr();
    asm volatile("" : "+s"(pp));
    Params p;
#pragma unroll
    for (int i = 0; i < N_IN; ++i) p.in[i] = (const float*)(const __attribute__((address_space(1))) float*)pp[i];
    p.out = (float*)(__attribute__((address_space(1))) float*)pp[N_IN]; p.ws = (unsigned char*)(__attribute__((address_space(1))) unsigned char*)pp[N_IN + 1]; p.ph_lo = 0; p.ph_hi = 0;
#else
    Params p{};
#endif
    const Frame F = make_frame(lds_raw);
    run_phase<PH>(p, F);
}
template <int PH> __global__ void __launch_bounds__(NTHREADS, 2) phase_kernel(Params p) {
    extern __shared__ __attribute__((aligned(16))) unsigned char lds_raw[];
    run_phase_fresh<PH>(lds_raw);
}
template <int PH> DI void run_all(unsigned char* lds_raw, cg::grid_group& grid, const XcdBarrier& bar) {
    if constexpr (PH < NPHASE) {
        if constexpr (PH == PROBE_PH) {
            if constexpr (PH == 11 || PH == 22 || PH == 12 || PH == 23) {
#if defined(__HIP_DEVICE_COMPILE__)
                const __attribute__((address_space(4))) unsigned long long* pp = (const __attribute__((address_space(4))) unsigned long long*)__builtin_amdgcn_kernarg_segment_ptr();
                asm volatile("" : "+s"(pp));
                Params p;
#pragma unroll
                for (int i = 0; i < N_IN; ++i) p.in[i] = (const float*)(const __attribute__((address_space(1))) float*)pp[i];
                p.out = (float*)(__attribute__((address_space(1))) float*)pp[N_IN]; p.ws = (unsigned char*)(__attribute__((address_space(1))) unsigned char*)pp[N_IN + 1]; p.ph_lo = 0; p.ph_hi = 0;
                const Frame F = make_frame(lds_raw);
                if constexpr (PH == 11 || PH == 22) phase_peer_c(p, F, PH == 11 ? 0 : 1, true); else phase_peer_v(p, F, PH == 12 ? 0 : 1, true);
#endif
            } else run_phase_fresh<PH>(lds_raw);
            xcd_barrier(bar);
        }
        run_phase_fresh<PH>(lds_raw);
        if constexpr (PH + 1 < NPHASE) { xcd_barrier(bar); if constexpr (PROBE_SYNC) xcd_barrier(bar); }
        run_all<PH + 1>(lds_raw, grid, bar);
    }
}
__global__ void __launch_bounds__(NTHREADS, 2) mega(Params p) {
    extern __shared__ __attribute__((aligned(16))) unsigned char lds_raw[];
    cg::grid_group grid = cg::this_grid();
    volatile LAS unsigned* st = (volatile LAS unsigned*)((LAS unsigned char*)lds_raw + LDS_BAR_OFF);
    if (threadIdx.x < 2) st[threadIdx.x] = 0u;
    __syncthreads();
    const XcdBarrier bar = xcd_barrier_post((unsigned*)(p.ws + WS_CTL), st);
    if (p.ph_lo != 0) grid.sync();
    run_all<0>(lds_raw, grid, bar);
}

extern "C" void kernel_launch(void* const* d_in, const int* in_sizes, int n_in, void* d_out, int out_size, void* d_ws, size_t ws_size, hipStream_t stream) {
    static int grid = 0;
    if (grid == 0) {
        if (n_in != 23 || out_size != TL * D || ws_size < WS_END) { fprintf(stderr, "kernel_launch: unexpected shapes (n_in %d out %d ws %zu)\n", n_in, out_size, ws_size); grid = -1; return; }
        int dev = 0, cus = 0, per_cu = 0;
        (void)hipGetDevice(&dev);
        (void)hipDeviceGetAttribute(&cus, hipDeviceAttributeMultiprocessorCount, dev);
        (void)hipFuncSetAttribute((const void*)mega, hipFuncAttributeMaxDynamicSharedMemorySize, LDS_BYTES);
        (void)hipOccupancyMaxActiveBlocksPerMultiprocessor(&per_cu, (const void*)mega, NTHREADS, LDS_BYTES);
        if (per_cu < 1) { fprintf(stderr, "kernel_launch: occupancy query reports %d blocks per CU\n", per_cu); grid = -1; return; }
        grid = cus & ~7;
        if (grid < 8) { fprintf(stderr, "kernel_launch: needs at least 8 CUs\n"); grid = -1; return; }
    }
    if (grid < 0) return;
    (void)hipMemsetAsync((char*)d_ws + WS_CTL, 0, CTL_ZERO_BYTES, stream);
    Params p{};
    for (int i = 0; i < N_IN; ++i) p.in[i] = (const float*)d_in[i];
    p.out = (float*)d_out; p.ws = (unsigned char*)d_ws;
    void* args[] = {&p};
    hipError_t e = hipLaunchCooperativeKernel((const void*)mega, dim3(grid), dim3(NTHREADS), args, LDS_BYTES, stream);
    if (e != hipSuccess) fprintf(stderr, "cooperative launch failed: %s (grid %d)\n", hipGetErrorString(e), grid);
}
```

```cpp
#include <hip/hip_runtime.h>
#include <hip/hip_cooperative_groups.h>
#include <stdint.h>
#include <stdio.h>
namespace cg = cooperative_groups;

#ifndef PROBE_PH
#define PROBE_PH -1
#endif
#ifndef PROBE_SYNC
#define PROBE_SYNC 0
#endif
#ifndef MK_SINGLE
#define MK_SINGLE 0
#endif

#define LAS __attribute__((address_space(3)))
typedef unsigned short bf16_t;
typedef short bf16x8 __attribute__((ext_vector_type(8)));
typedef short s16x4 __attribute__((ext_vector_type(4)));
typedef float f32x4 __attribute__((ext_vector_type(4)));
typedef float f32x2 __attribute__((ext_vector_type(2)));
typedef float f32x16 __attribute__((ext_vector_type(16)));
typedef unsigned u32x4 __attribute__((ext_vector_type(4)));
typedef unsigned u32x2 __attribute__((ext_vector_type(2)));
typedef __bf16 bf16x2_t __attribute__((ext_vector_type(2)));
typedef _Float16 f16x2_t __attribute__((ext_vector_type(2)));
#define DI __device__ __forceinline__
DI unsigned pkh2(float lo, float hi) { f16x2_t v = {(_Float16)lo, (_Float16)hi}; return __builtin_bit_cast(unsigned, v); }
#define MFMA32(a, b, c) __builtin_amdgcn_mfma_f32_32x32x16_bf16((a), (b), (c), 0, 0, 0)

constexpr int D = 1024, NB = 8, SEQ = 4096, NCTX = 256, DEPTH = 2;
constexpr int TL = NB * SEQ, TC = NB * NCTX, T = TL + TC;
constexpr int INW = 4608, NMOD = 6 * D, PW = 1600, PN = 1536;
constexpr int VTS = SEQ + 64;
constexpr int QOFF = 0, KOFF = 512, VOFF = 640, POOLOFF = 768, SUOFF = 1024, SVOFF = 1280, GATEOFF = 1536;
constexpr int NEXP = 16384;
constexpr float EPS = 1e-6f;
constexpr float LOG2E = 1.4426950408889634f;
constexpr float QSCALE = 0.125f * LOG2E;

constexpr size_t MiB = 1u << 20;
constexpr size_t WS_CTL = 0, WS_MOD = 1 * MiB, CTL_ZERO_BYTES = 2 * MiB;
constexpr size_t WS_ROPE = 2 * MiB, WS_SGUW = 2 * MiB + 65536, WS_TSCALE = 3 * MiB;
constexpr size_t WS_WIN = 4 * MiB, WS_WBR = 22 * MiB, WS_WOUT = 26 * MiB, WS_WFOLD = 30 * MiB;
constexpr size_t WS_XCTX = 38 * MiB, WS_UTAB = 46 * MiB, WS_VTAB = 78 * MiB;
constexpr size_t WS_IDX = 110 * MiB, WS_GW = 120 * MiB;
constexpr size_t WS_H = 142 * MiB;
constexpr size_t WS_P = 210 * MiB, WS_Y = 318 * MiB, WS_MERGED = 386 * MiB, WS_VT = 454 * MiB, WS_VTC = 463 * MiB, WS_VST = 464 * MiB;
constexpr size_t WS_MP = 482 * MiB;
constexpr size_t WS_ST = 210 * MiB, WS_H8 = 346 * MiB, WS_HS = 380 * MiB, WS_SU = 482 * MiB;
constexpr size_t WS_END = 512 * MiB;
static_assert(WS_ST + (size_t)2048 * T * 2 <= WS_H8 && WS_H8 + (size_t)T * D <= WS_HS, "ST / H8 fit");
static_assert(WS_VST + (size_t)272 * 256 * 128 * 2 <= WS_SU && WS_VT + (size_t)NB * 2 * 64 * VTS * 2 <= WS_VTC, "VsT / VT fit");
static_assert(WS_H + (size_t)T * D * 2 <= WS_P, "H fits");
static_assert(WS_P + (size_t)T * PW * 2 <= WS_Y && WS_Y + (size_t)T * D * 2 <= WS_MERGED && WS_MERGED + (size_t)T * D * 2 <= WS_VT, "P/Y/MERGED fit");
static_assert(WS_IDX + (size_t)T * 128 * 2 <= WS_GW && WS_GW + (size_t)T * 128 * 4 <= WS_H && WS_SU + (size_t)T * 128 * 4 <= WS_END && WS_HS + (size_t)T * 4 <= WS_SU, "idx/gw/su fit");

constexpr int LDS_BYTES = 163840;
constexpr int LDS_BAR_OFF = LDS_BYTES - 64;
constexpr int NTHREADS = 512, NWAVES = 8;

enum { I_x, I_c, I_ctx, I_c_ctx, I_w_mod, I_b_mod, I_g_mix, I_g_ffn, I_w_in, I_attn_sink, I_pool_w, I_pool_scale, I_sgu_w, I_sgu_b, I_w_br_attn, I_w_br_pool, I_w_br_sgu, I_w_out, I_peer_wq, I_peer_subkeys, I_peer_u, I_peer_v, I_g_final, N_IN };
struct Params {
    const float* in[N_IN];
    float* out; unsigned char* ws;
    int ph_lo, ph_hi;
};

DI unsigned pk2(float lo, float hi) { f32x2 v = {lo, hi}; return __builtin_bit_cast(unsigned, __builtin_convertvector(v, bf16x2_t)); }
DI unsigned f2bf(float f) { return pk2(f, 0.f) & 0xffffu; }
DI float bf2f(unsigned short u) { return __builtin_bit_cast(float, (unsigned)u << 16); }
DI float bflo(unsigned w) { return __builtin_bit_cast(float, w << 16); }
DI float bfhi(unsigned w) { return __builtin_bit_cast(float, w & 0xffff0000u); }
DI int crow(int reg, int h) { return (reg & 3) + 8 * (reg >> 2) + 4 * h; }
DI int dpp_x1(int v) { return __builtin_amdgcn_mov_dpp(v, 0xB1, 0xF, 0xF, true); }
DI float wave_sum(float v) {
#pragma unroll
    for (int o = 1; o < 64; o <<= 1) v += __shfl_xor(v, o);
    return v;
}
DI float sigmoidf_(float x) { return __builtin_amdgcn_rcpf(1.0f + __expf(-x)); }
DI float gelu_tanh(float x) { const float u = 0.7978845608028654f * (x + 0.044715f * x * x * x); return x * __builtin_amdgcn_rcpf(1.0f + __expf(-2.0f * u)); }
DI float silu_(float x) { return x * __builtin_amdgcn_rcpf(1.0f + __expf(-x)); }

struct Frame {
    int tid, lane, wave, gw, ngw, gtid, ngt, bid, nb;
    LAS unsigned char* lds;
};

template <int NM, int NN>
DI void wave_gemm(const bf16_t* __restrict__ A, int lda, const bf16_t* __restrict__ Bt, int ldb, int K, int m0, int n0, f32x16 (&acc)[NM][NN], int lane) {
    const int r = lane & 31, h = lane >> 5;
    const bf16_t* ap = A + (size_t)(m0 + r) * lda + 8 * h;
    const bf16_t* bp = Bt + (size_t)(n0 + r) * ldb + 8 * h;
    for (int k0 = 0; k0 < K; k0 += 64) {
        bf16x8 a[4][NM], b[4][NN];
#pragma unroll
        for (int s = 0; s < 4; ++s) {
#pragma unroll
            for (int i = 0; i < NM; ++i) a[s][i] = *(const bf16x8*)(ap + (size_t)(32 * i) * lda + k0 + 16 * s);
#pragma unroll
            for (int j = 0; j < NN; ++j) b[s][j] = *(const bf16x8*)(bp + (size_t)(32 * j) * ldb + k0 + 16 * s);
        }
#pragma unroll
        for (int s = 0; s < 4; ++s)
#pragma unroll
            for (int i = 0; i < NM; ++i)
#pragma unroll
                for (int j = 0; j < NN; ++j) acc[i][j] = MFMA32(a[s][i], b[s][j], acc[i][j]);
    }
}
template <int NM, int NN> DI void zero_acc(f32x16 (&acc)[NM][NN]) {
#pragma unroll
    for (int i = 0; i < NM; ++i)
#pragma unroll
        for (int j = 0; j < NN; ++j)
#pragma unroll
            for (int r = 0; r < 16; ++r) acc[i][j][r] = 0.f;
}

namespace pg8 {
constexpr int BM = 256, BK = 64, HALF = 128, HTB = HALF * BK * 2, STAGE_BYTES = 8 * HTB, NXCD = 8, WGM = 8, LD = 1024;
DI int lds_byte(int r, int c) { const int st = (r >> 4) * 2 + (c >> 5), rr = r & 15, cc = c & 31, ob = rr * 64 + cc * 2; return st * 1024 + (ob ^ (((ob >> 9) & 1) << 5)); }
DI void stage_rc(int b, int& R, int& C) { const int st = b / 1024, sb = b % 1024, swz = sb ^ (((sb >> 9) & 1) << 5); R = (st >> 1) * 16 + swz / 64; C = (st & 1) * 32 + (swz % 64) / 2; }
DI int perm32(int rho) { const int n = rho >> 4, i = rho & 15; return 8 * (i >> 2) + 4 * n + (i & 3); }
struct Unit { int pm, pn, sub, nt, mode; const char* a; const char* b; };
DI void tile_of(int L, int nM, int nN, int& pm, int& pn) {
    const int nwg = nM * nN; int wgid = L;
    { const int q = nwg / NXCD, r = nwg % NXCD, xcd = wgid % NXCD, off = wgid / NXCD; wgid = (xcd < r ? xcd * (q + 1) : r * (q + 1) + (xcd - r) * q) + off; }
    const int nig = WGM * nN, gid = wgid / nig, fm = gid * WGM, gsz = (nM - fm) < WGM ? (nM - fm) : WGM;
    pm = fm + ((wgid % nig) % gsz); pn = (wgid % nig) / gsz;
}
template <class Epi, class Sched>
DI void gemm_phase(LAS unsigned char* lds, const int tid, const Sched& S, const Epi& E) {
    const int wid = __builtin_amdgcn_readfirstlane(tid >> 6), lane = tid & 63, wr = wid >> 2, wc = wid & 3, fr = lane & 15, fq = lane >> 4;
    unsigned voffA[2], voffB[2];
#pragma unroll
    for (int i = 0; i < 2; ++i) { int R, C; stage_rc(tid * 16 + i * 8192, R, C); const int Rb = Epi::PERM ? ((R & ~31) + perm32(R & 31)) : R;
        voffA[i] = (unsigned)(R * LD + C) * 2u; voffB[i] = (unsigned)(Rb * LD + C) * 2u; }
    const size_t kstep = (size_t)(BK * 2);
    const size_t hstep = (size_t)HALF * LD * 2;
    const unsigned ldsw = (unsigned)wid * 1024u;
    const int aoff = lds_byte(wr * 64 + fr, fq * 8), boff = lds_byte(wc * 32 + fr, fq * 8);
#define PG8_SA(b, h) (((b) * 2 + (h)) * HTB)
#define PG8_SB(b, h) ((4 + (b) * 2 + (h)) * HTB)
#define PG8_STAGE(bufoff, gbase, voff) do { _Pragma("unroll") for (int _i = 0; _i < 2; ++_i) \
        __builtin_amdgcn_global_load_lds((const unsigned*)((const char*)(gbase) + (voff)[_i]), (LAS unsigned*)(lds + (bufoff) + ldsw + _i * 8192), 16, 0, 0); } while (0)
#define PG8_LDA(dst, b, h) do { _Pragma("unroll") for (int m = 0; m < 4; ++m) _Pragma("unroll") for (int k = 0; k < 2; ++k) dst[m][k] = *(const LAS bf16x8*)(lds + PG8_SA(b, h) + aoff + m * 2048 + k * 1024); } while (0)
#define PG8_LDB(dst, b, h) do { _Pragma("unroll") for (int n = 0; n < 2; ++n) _Pragma("unroll") for (int k = 0; k < 2; ++k) dst[n][k] = *(const LAS bf16x8*)(lds + PG8_SB(b, h) + boff + n * 2048 + k * 1024); } while (0)
#define PG8_MMA(ai, bj, At, Bt) do { __builtin_amdgcn_s_setprio(1); _Pragma("unroll") for (int m = 0; m < 4; ++m) _Pragma("unroll") for (int n = 0; n < 2; ++n) _Pragma("unroll") for (int k = 0; k < 2; ++k) \
        acc[ai][bj][m][n] = __builtin_amdgcn_mfma_f32_16x16x32_bf16(Bt[n][k], At[m][k], acc[ai][bj][m][n], 0, 0, 0); __builtin_amdgcn_s_setprio(0); } while (0)
#define PG8_WAIT_V(n) asm volatile("s_waitcnt vmcnt(" #n ")" ::: "memory")
#define PG8_WAIT_L(n) asm volatile("s_waitcnt lgkmcnt(" #n ")" ::: "memory")
#define PG8_BAR __builtin_amdgcn_s_barrier()
#define PG8_SCHED __builtin_amdgcn_sched_barrier(0)
    Unit cur, nxt; int ui = 0;
    if (!S.next(0, cur)) return;
    f32x4 acc[2][2][4][2];
#pragma unroll
    for (int a = 0; a < 2; ++a)
#pragma unroll
        for (int b = 0; b < 2; ++b)
#pragma unroll
            for (int m = 0; m < 4; ++m)
#pragma unroll
                for (int n = 0; n < 2; ++n) acc[a][b][m][n] = (f32x4){0.f, 0.f, 0.f, 0.f};
    bf16x8 At[4][2], B0[2][2], B1[2][2];
    const char* cA = cur.a; const char* cB = cur.b;
    PG8_STAGE(PG8_SB(0, 0), cB, voffB); PG8_STAGE(PG8_SB(0, 1), cB + hstep, voffB); PG8_STAGE(PG8_SA(0, 0), cA, voffA); PG8_STAGE(PG8_SA(0, 1), cA + hstep, voffA);
    if (wr == 1) PG8_BAR;
    PG8_WAIT_V(2); PG8_BAR;
    PG8_STAGE(PG8_SB(1, 0), cB + kstep, voffB); PG8_STAGE(PG8_SA(1, 0), cA + kstep, voffA); PG8_STAGE(PG8_SB(1, 1), cB + hstep + kstep, voffB);
    PG8_WAIT_V(6); PG8_BAR;
    for (;;) {
        const bool has_next = S.next(ui + 1, nxt);
        const char* nA = has_next ? nxt.a : cA; const char* nB = has_next ? nxt.b : cB;
        const int nt = cur.nt;
        for (int t = 0; t < nt; t += 2) {
            const bool last = (t == nt - 2);
            const char* a1 = cA + (size_t)(t + 1) * kstep;
            const char* a2 = last ? nA : cA + (size_t)(t + 2) * kstep; const char* b2 = last ? nB : cB + (size_t)(t + 2) * kstep;
            const char* a3 = a2 + kstep; const char* b3 = b2 + kstep;
            PG8_LDB(B0, 0, 0); PG8_LDB(B1, 0, 1); PG8_SCHED; PG8_LDA(At, 0, 0); PG8_STAGE(PG8_SA(1, 1), a1 + hstep, voffA);
            PG8_WAIT_V(8); PG8_WAIT_L(0); PG8_BAR; PG8_MMA(0, 0, At, B0); PG8_MMA(0, 1, At, B1); PG8_BAR; PG8_SCHED;
            PG8_LDA(At, 0, 1); PG8_STAGE(PG8_SB(0, 0), b2, voffB); PG8_STAGE(PG8_SB(0, 1), b2 + hstep, voffB); PG8_STAGE(PG8_SA(0, 0), a2, voffA);
            PG8_WAIT_V(8); PG8_WAIT_L(0); PG8_BAR; PG8_MMA(1, 0, At, B0); PG8_MMA(1, 1, At, B1); PG8_BAR; PG8_SCHED;
            PG8_LDB(B0, 1, 0); PG8_LDB(B1, 1, 1); PG8_SCHED; PG8_LDA(At, 1, 0); PG8_STAGE(PG8_SA(0, 1), a2 + hstep, voffA);
            PG8_WAIT_V(8); PG8_WAIT_L(0); PG8_BAR; PG8_MMA(0, 0, At, B0); PG8_MMA(0, 1, At, B1); PG8_BAR; PG8_SCHED;
            PG8_LDA(At, 1, 1); PG8_STAGE(PG8_SB(1, 0), b3, voffB); PG8_STAGE(PG8_SB(1, 1), b3 + hstep, voffB); PG8_STAGE(PG8_SA(1, 0), a3, voffA);
            PG8_WAIT_V(8); PG8_WAIT_L(0); PG8_BAR; PG8_MMA(1, 0, At, B0); PG8_MMA(1, 1, At, B1); PG8_BAR; PG8_SCHED;
        }
        if (wr == 0) PG8_BAR;
        E(acc, cur, wr, wc, fr, fq);
        if (!has_next) break;
        if (!E.keeps(cur)) {
#pragma unroll
        for (int a = 0; a < 2; ++a)
#pragma unroll
            for (int b = 0; b < 2; ++b)
#pragma unroll
                for (int m = 0; m < 4; ++m)
#pragma unroll
                    for (int n = 0; n < 2; ++n) acc[a][b][m][n] = (f32x4){0.f, 0.f, 0.f, 0.f};
        }
        cur = nxt; cA = nA; cB = nB; ++ui;
        if (wr == 1) PG8_BAR;
    }
    PG8_WAIT_V(0);
    PG8_BAR;
#undef PG8_SA
#undef PG8_SB
#undef PG8_STAGE
#undef PG8_LDA
#undef PG8_LDB
#undef PG8_MMA
#undef PG8_WAIT_V
#undef PG8_WAIT_L
#undef PG8_BAR
#undef PG8_SCHED
}
}

DI void transpose_item(const float* W, int K, int N, bf16_t* WT, int ldd, int row_off, int col_off, LAS float* scr, int item, int lane) {
    const int nblk = N / 32, kb = item / nblk, nb = item % nblk, k0 = 64 * kb, n0 = 32 * nb;
#pragma unroll 8
    for (int i = 0; i < 32; ++i) { const int kk = 2 * i + (lane >> 5); scr[kk * 33 + (lane & 31)] = W[(size_t)(k0 + kk) * N + n0 + (lane & 31)]; }
    asm volatile("s_waitcnt lgkmcnt(0)" ::: "memory");
    const int c = lane & 7;
#pragma unroll
    for (int j = 0; j < 4; ++j) { const int n = (lane >> 3) + 8 * j; const LAS float* s = scr + (8 * c) * 33 + n;
        u32x4 o; o.x = pk2(s[0 * 33], s[1 * 33]); o.y = pk2(s[2 * 33], s[3 * 33]); o.z = pk2(s[4 * 33], s[5 * 33]); o.w = pk2(s[6 * 33], s[7 * 33]);
        *(u32x4*)(WT + (size_t)(row_off + n0 + n) * ldd + col_off + k0 + 8 * c) = o; }
    asm volatile("s_waitcnt lgkmcnt(0)" ::: "memory");
}

DI void convert_tables(const Params& p, const Frame& F) {
    for (int it0 = 4 * F.gw; it0 < 4 * NEXP; it0 += 4 * F.ngw) {
        f32x4 v[4][4];
#pragma unroll
        for (int u = 0; u < 4; ++u) {
            const int it = it0 + u, e = it & (NEXP - 1), tbl = (it >> 14) & 1, l = it >> 15;
            const f32x4* src = (const f32x4*)((tbl ? p.in[I_peer_v] : p.in[I_peer_u]) + ((size_t)l * NEXP + e) * D) + 4 * F.lane;
#pragma unroll
            for (int j = 0; j < 4; ++j) v[u][j] = src[j];
        }
#pragma unroll
        for (int u = 0; u < 4; ++u) {
            const int it = it0 + u, e = it & (NEXP - 1), tbl = (it >> 14) & 1, l = it >> 15;
            float am = 0.f;
#pragma unroll
            for (int j = 0; j < 4; ++j) am = fmaxf(am, fmaxf(fmaxf(fabsf(v[u][j].x), fabsf(v[u][j].y)), fmaxf(fabsf(v[u][j].z), fabsf(v[u][j].w))));
#pragma unroll
            for (int o = 1; o < 64; o <<= 1) am = fmaxf(am, __shfl_xor(am, o));
            float sc;
            if (tbl) sc = (am > 0.f) ? 6.0f / am : 1.0f;
            else {
                float ss = 0.f;
#pragma unroll
                for (int j = 0; j < 4; ++j) ss += v[u][j].x * v[u][j].x + v[u][j].y * v[u][j].y + v[u][j].z * v[u][j].z + v[u][j].w * v[u][j].w;
                const float rms = sqrtf(wave_sum(ss) * (1.0f / D));
                const float step = fminf(am * (1.0f / 7.0f), 0.41f * rms);
                sc = (step > 0.f) ? 1.0f / step : 1.0f;
            }
            if (tbl) {
                u32x2 q4;
#pragma unroll
                for (int d = 0; d < 2; ++d) { unsigned w = 0;
                    w = __builtin_amdgcn_cvt_scalef32_pk_fp4_f32(w, v[u][2 * d][0] * sc, v[u][2 * d][1] * sc, 1.0f, 0);
                    w = __builtin_amdgcn_cvt_scalef32_pk_fp4_f32(w, v[u][2 * d][2] * sc, v[u][2 * d][3] * sc, 1.0f, 1);
                    w = __builtin_amdgcn_cvt_scalef32_pk_fp4_f32(w, v[u][2 * d + 1][0] * sc, v[u][2 * d + 1][1] * sc, 1.0f, 2);
                    w = __builtin_amdgcn_cvt_scalef32_pk_fp4_f32(w, v[u][2 * d + 1][2] * sc, v[u][2 * d + 1][3] * sc, 1.0f, 3);
                    q4[d] = w; }
                *(u32x2*)(p.ws + WS_VTAB + ((size_t)l * NEXP + e) * (D / 2) + 8 * F.lane) = q4;
            } else {
                u32x2 q4;
#pragma unroll
                for (int d = 0; d < 2; ++d) { unsigned w = 0;
#pragma unroll
                    for (int b = 0; b < 4; ++b) { const int j = 2 * d + (b >> 1), e2 = 2 * (b & 1);
                        const int n0 = (int)fminf(fmaxf(__builtin_rintf(v[u][j][e2] * sc), -8.0f), 7.0f) + 8, n1 = (int)fminf(fmaxf(__builtin_rintf(v[u][j][e2 + 1] * sc), -8.0f), 7.0f) + 8;
                        w |= (unsigned)(n0 | (n1 << 4)) << (8 * b); }
                    q4[d] = w; }
                *(u32x2*)(p.ws + WS_UTAB + ((size_t)l * NEXP + e) * (D / 2) + 8 * F.lane) = q4;
            }
            if (F.lane == 0) ((float*)(p.ws + WS_TSCALE))[(l * 2 + tbl) * NEXP + e] = 1.0f / sc;
        }
    }
}

DI void phase_prep(const Params& p, const Frame& F) {
    unsigned char* ws = p.ws;
    {
        LAS float* wq = (LAS float*)F.lds;
        LAS float* skl = wq + 128 * 65;
        for (int it = F.bid; it < 2 * 16 * 16; it += F.nb) {
            const int cc = it & 15, hp = (it >> 4) & 15, l = it >> 8;
            const float* src = p.in[I_peer_wq] + (size_t)l * D * 2048 + hp * 128;
            const float* sks = p.in[I_peer_subkeys] + (size_t)(l * 16 + hp) * 128 * 128;
            __syncthreads();
            { float tw[16]; f32x4 ts[8];
#pragma unroll
              for (int it = 0; it < 16; ++it) { const int e = F.tid + it * NTHREADS, ci = e >> 7, d = e & 127; tw[it] = src[(size_t)(cc * 64 + ci) * 2048 + d]; }
#pragma unroll
              for (int it = 0; it < 8; ++it) { const int e = F.tid + it * NTHREADS, key = e >> 5, d4 = (e & 31) * 4; ts[it] = *(const f32x4*)(sks + key * 128 + d4); }
#pragma unroll
              for (int it = 0; it < 16; ++it) { const int e = F.tid + it * NTHREADS, ci = e >> 7, d = e & 127; wq[d * 65 + ci] = tw[it]; }
#pragma unroll
              for (int it = 0; it < 8; ++it) { const int e = F.tid + it * NTHREADS, key = e >> 5, d4 = (e & 31) * 4; *(LAS f32x4*)(skl + key * 132 + d4) = ts[it]; } }
            __syncthreads();
            const int ci = F.tid & 63, kg = F.tid >> 6;
            float acc[16];
#pragma unroll
            for (int k = 0; k < 16; ++k) acc[k] = 0.f;
#pragma unroll 2
            for (int d = 0; d < 128; d += 4) {
                const float w0 = wq[d * 65 + ci], w1 = wq[(d + 1) * 65 + ci], w2 = wq[(d + 2) * 65 + ci], w3 = wq[(d + 3) * 65 + ci];
#pragma unroll
                for (int k = 0; k < 16; ++k) { const f32x4 s = *(const LAS f32x4*)(skl + (16 * kg + k) * 132 + d); acc[k] += w0 * s.x + w1 * s.y + w2 * s.z + w3 * s.w; }
            }
            bf16_t* dst = (bf16_t*)(ws + WS_WFOLD) + ((size_t)l * 2048 + hp * 128 + 16 * kg) * D + cc * 64 + ci;
#pragma unroll
            for (int k = 0; k < 16; ++k) dst[(size_t)k * D] = (bf16_t)f2bf(acc[k]);
        }
        __syncthreads();
    }
    {
        LAS float* scr = (LAS float*)(F.lds + F.wave * 16384);
        constexpr int I_IN = (D / 64) * (INW / 32), I_BA = (512 / 64) * (D / 32), I_BS = (256 / 64) * (D / 32), I_O = (D / 64) * (D / 32);
        constexpr int PER_L = I_IN + I_BA + I_BS + I_O;
        for (int it = F.gw; it < 2 * PER_L; it += F.ngw) {
            const int l = it / PER_L; int r = it % PER_L;
            if (r < I_IN) { transpose_item(p.in[I_w_in] + (size_t)l * D * INW, D, INW, (bf16_t*)(ws + WS_WIN) + (size_t)l * INW * D, D, 0, 0, scr, r, F.lane); continue; } r -= I_IN;
            if (r < I_BA) { transpose_item(p.in[I_w_br_attn] + (size_t)l * 512 * D, 512, D, (bf16_t*)(ws + WS_WBR) + (size_t)l * D * D, D, 0, 0, scr, r, F.lane); continue; } r -= I_BA;
            if (r < I_BS) { transpose_item(p.in[I_w_br_sgu] + (size_t)l * 256 * D, 256, D, (bf16_t*)(ws + WS_WBR) + (size_t)l * D * D, D, 0, 768, scr, r, F.lane); continue; } r -= I_BS;
            transpose_item(p.in[I_w_out] + (size_t)l * D * D, D, D, (bf16_t*)(ws + WS_WOUT) + (size_t)l * D * D, D, 0, 0, scr, r, F.lane);
        }
    }
    for (int i = F.gtid; i < 2 * 256 * D; i += F.ngt) {
        const int n = i & 1023, rc = (i >> 10) & 255, l = i >> 18, g = rc >> 6;
        const float* pw = p.in[I_pool_w] + ((size_t)l * 256 + rc) * 64;
        const float* ps = p.in[I_pool_scale] + l * 256 + 64 * g;
        const float* wb = p.in[I_w_br_pool] + ((size_t)l * 256 + 64 * g) * D + n;
        float a = 0.f;
#pragma unroll 16
        for (int e = 0; e < 64; ++e) a += pw[e] * ps[e] * wb[(size_t)e * D];
        ((bf16_t*)(ws + WS_WBR))[(size_t)l * D * D + (size_t)n * D + 512 + rc] = (bf16_t)f2bf(a);
    }
    for (int i = F.gtid; i < 2 * 4 * 128 * 128; i += F.ngt) ((bf16_t*)(ws + WS_SGUW))[i] = (bf16_t)f2bf(p.in[I_sgu_w][i]);
    for (int i = F.gtid; i < 64 * 16; i += F.ngt) {
        const int pos = i >> 4, fi = i & 15;
        const float inv = powf(10000.0f, -(float)fi / 16.0f);
        const float ang = (float)pos * inv;
        ((f32x2*)(ws + WS_ROPE))[i] = (f32x2){cosf(ang), sinf(ang)};
    }
    convert_tables(p, F);
    {
        float* MOD = (float*)(ws + WS_MOD);
        LAS float* scd = (LAS float*)F.lds;
        LAS float* red = scd + 9 * D;
        __syncthreads();
        { float tc[18];
#pragma unroll
          for (int it = 0; it < 18; ++it) { const int e = F.tid + it * NTHREADS, r = e >> 10, k = e & 1023; tc[it] = (r < 8) ? p.in[I_c][r * D + k] : p.in[I_c_ctx][k]; }
#pragma unroll
          for (int it = 0; it < 18; ++it) scd[F.tid + it * NTHREADS] = silu_(tc[it]); }
        __syncthreads();
        for (int it = F.bid; it < 2 * 96; it += F.nb) {
            const int cgp = it % 96, l = it / 96, col = cgp * 64 + F.lane;
            float acc[9];
#pragma unroll
            for (int r = 0; r < 9; ++r) acc[r] = 0.f;
            const float* wp = p.in[I_w_mod] + ((size_t)l * D + F.wave * 128) * NMOD + col;
#pragma unroll 16
            for (int k = 0; k < 128; ++k) {
                const float w = wp[(size_t)k * NMOD];
#pragma unroll
                for (int r = 0; r < 9; ++r) acc[r] += scd[r * D + F.wave * 128 + k] * w;
            }
#pragma unroll
            for (int r = 0; r < 9; ++r) red[(F.wave * 9 + r) * 64 + F.lane] = acc[r];
            __syncthreads();
            for (int e = F.tid; e < 9 * 64; e += NTHREADS) {
                const int r = e >> 6, ln = e & 63; float s = p.in[I_b_mod][l * NMOD + cgp * 64 + ln];
#pragma unroll
                for (int w = 0; w < 8; ++w) s += red[(w * 9 + r) * 64 + ln];
                MOD[((size_t)l * 9 + r) * NMOD + cgp * 64 + ln] = s;
            }
            __syncthreads();
        }
    }
}

DI const float* mod_vec(const Params& p, int l, int row, int j) {
    const int r = row < TL ? row / SEQ : 8;
    return (const float*)(p.ws + WS_MOD) + ((size_t)l * 9 + r) * NMOD + j * D;
}
DI float* xrow_ptr(const Params& p, int row) { return row < TL ? p.out + (size_t)row * D : (float*)(p.ws + WS_XCTX) + (size_t)(row - TL) * D; }
DI const float* xin_ptr(const Params& p, int row) { return row < TL ? p.in[I_x] + (size_t)row * D : p.in[I_ctx] + (size_t)(row - TL) * D; }

DI void phase_norm(const Params& p, const Frame& F, int l, int which  , bool from_input, int nrows) {
    const float* g = (which == 0 ? p.in[I_g_mix] : p.in[I_g_ffn]) + l * D;
    const int lane = F.lane;
    f32x4 gg[4];
#pragma unroll
    for (int j = 0; j < 4; ++j) gg[j] = ((const f32x4*)g)[lane + 64 * j];
    for (int row0 = 2 * F.gw; row0 < nrows; row0 += 2 * F.ngw) {
        f32x4 v[2][4], s1[2][4], s2[2][4];
#pragma unroll
        for (int u = 0; u < 2; ++u) {
            const int row = row0 + u;
            const float* src = from_input ? xin_ptr(p, row) : xrow_ptr(p, row);
            const float* sh = mod_vec(p, l, row, which * 3 + 0); const float* sc = mod_vec(p, l, row, which * 3 + 1);
#pragma unroll
            for (int j = 0; j < 4; ++j) { v[u][j] = ((const f32x4*)src)[lane + 64 * j]; s1[u][j] = ((const f32x4*)sh)[lane + 64 * j]; s2[u][j] = ((const f32x4*)sc)[lane + 64 * j]; }
        }
#pragma unroll
        for (int u = 0; u < 2; ++u) {
            float ss = 0.f;
#pragma unroll
            for (int j = 0; j < 4; ++j) ss += v[u][j].x * v[u][j].x + v[u][j].y * v[u][j].y + v[u][j].z * v[u][j].z + v[u][j].w * v[u][j].w;
            const float rinv = rsqrtf(wave_sum(ss) * (1.0f / D) + EPS);
            bf16_t* dst = (bf16_t*)(p.ws + WS_H) + (size_t)(row0 + u) * D;
            float am = 0.f;
#pragma unroll
            for (int j = 0; j < 4; ++j) {
                const f32x4 o = v[u][j] * rinv * gg[j] * (s2[u][j] + 1.0f) + s1[u][j];
                u32x2 w; w.x = pk2(o.x, o.y); w.y = pk2(o.z, o.w);
                ((u32x2*)dst)[lane + 64 * j] = w;
                v[u][j] = o; am = fmaxf(am, fmaxf(fmaxf(fabsf(o.x), fabsf(o.y)), fmaxf(fabsf(o.z), fabsf(o.w))));
            }
            if (which) {
#pragma unroll
                for (int o2 = 1; o2 < 64; o2 <<= 1) am = fmaxf(am, __shfl_xor(am, o2));
                const float sc = (am > 0.f) ? 127.0f / am : 1.0f;
                unsigned* h8 = (unsigned*)(p.ws + WS_H8 + (size_t)(row0 + u) * D);
                const bool odd = (lane & 1) != 0;
#pragma unroll
                for (int j = 0; j < 4; ++j) {
                    const int b0 = (int)__builtin_rintf(v[u][j].x * sc), b1 = (int)__builtin_rintf(v[u][j].y * sc), b2 = (int)__builtin_rintf(v[u][j].z * sc), b3 = (int)__builtin_rintf(v[u][j].w * sc);
                    const int p0 = dpp_x1(b0), p1 = dpp_x1(b1), p2 = dpp_x1(b2), p3 = dpp_x1(b3);
                    const int w0 = odd ? p1 : b0, w1 = odd ? p3 : b2, w2 = odd ? b1 : p0, w3 = odd ? b3 : p2;
                    h8[lane + 64 * j] = (unsigned)(w0 & 0xff) | ((unsigned)(w1 & 0xff) << 8) | ((unsigned)(w2 & 0xff) << 16) | ((unsigned)w3 << 24);
                }
                if (lane == 0) ((float*)(p.ws + WS_HS))[row0 + u] = (am > 0.f) ? am * (1.0f / 127.0f) : 1.0f;
            }
        }
    }
}
DI void phase_final(const Params& p, const Frame& F) {
    f32x4 gg[4];
#pragma unroll
    for (int j = 0; j < 4; ++j) gg[j] = ((const f32x4*)p.in[I_g_final])[F.lane + 64 * j];
    for (int row0 = 2 * F.gw; row0 < TL; row0 += 2 * F.ngw) {
        f32x4 v[2][4];
#pragma unroll
        for (int u = 0; u < 2; ++u)
#pragma unroll
            for (int j = 0; j < 4; ++j) v[u][j] = ((const f32x4*)(p.out + (size_t)(row0 + u) * D))[F.lane + 64 * j];
#pragma unroll
        for (int u = 0; u < 2; ++u) {
            float ss = 0.f;
#pragma unroll
            for (int j = 0; j < 4; ++j) ss += v[u][j].x * v[u][j].x + v[u][j].y * v[u][j].y + v[u][j].z * v[u][j].z + v[u][j].w * v[u][j].w;
            const float rinv = rsqrtf(wave_sum(ss) * (1.0f / D) + EPS);
            f32x4* xr = (f32x4*)(p.out + (size_t)(row0 + u) * D);
#pragma unroll
            for (int j = 0; j < 4; ++j) xr[F.lane + 64 * j] = v[u][j] * rinv * gg[j];
        }
    }
}

DI float lane_xor32(float v, bool hi) { const auto r = __builtin_amdgcn_permlane32_swap(__builtin_bit_cast(unsigned, v), __builtin_bit_cast(unsigned, v), false, false);
    return __builtin_bit_cast(float, hi ? r[0] : r[1]); }
struct EpiG1 {
    DI bool keeps(const pg8::Unit&) const { return false; }
    static constexpr bool PERM = true;
    unsigned char* ws;
    DI void operator()(const f32x4 (&acc)[2][2][4][2], const pg8::Unit& u, int wr, int wc, int fr, int fq) const {
        bf16_t* P = (bf16_t*)(ws + WS_P);
        const int rbase = u.pm * 256 + wr * 64 + fr;
        const bool hi = fq >= 2;
#pragma unroll
        for (int ai = 0; ai < 2; ++ai) {
            f32x4 cs[4][4];
            const bool lat = u.pm < TL / 256;
            if (u.pn < 3 && lat) {
#pragma unroll
                for (int m = 0; m < 4; ++m) {
                    const int t = (rbase + 128 * ai + 16 * m) & (SEQ - 1), pos = (wc & 1) ? (t & 63) : (t >> 6);
                    const f32x4* tab = (const f32x4*)(ws + WS_ROPE) + (pos * 16 + 8 * (fq & 1)) / 2;
#pragma unroll
                    for (int j2 = 0; j2 < 4; ++j2) cs[m][j2] = tab[j2];
                }
            }
#pragma unroll
            for (int m = 0; m < 4; ++m) {
                const int row = rbase + 128 * ai + 16 * m;
#pragma unroll
                for (int bj = 0; bj < 2; ++bj) {
                    const int c0 = u.pn * 256 + 128 * bj + 32 * wc + 8 * fq;
                    float v[8];
#pragma unroll
                    for (int j = 0; j < 4; ++j) { v[j] = acc[ai][bj][m][0][j]; v[4 + j] = acc[ai][bj][m][1][j]; }
                    if (c0 < VOFF) {
                        const float sc = (c0 < KOFF) ? QSCALE : 1.0f;
                        u32x4 o;
#pragma unroll
                        for (int j2 = 0; j2 < 4; ++j2) {
                            const f32x4 c4 = cs[m][j2];
                            const float o0 = lane_xor32(v[2 * j2], hi), o1 = lane_xor32(v[2 * j2 + 1], hi);
                            float r0 = hi ? (v[2 * j2] * c4.x + o0 * c4.y) : (v[2 * j2] * c4.x - o0 * c4.y);
                            float r1 = hi ? (v[2 * j2 + 1] * c4.z + o1 * c4.w) : (v[2 * j2 + 1] * c4.z - o1 * c4.w);
                            if (!lat) { r0 = v[2 * j2]; r1 = v[2 * j2 + 1]; }
                            o[j2] = pk2(r0 * sc, r1 * sc);
                        }
                        *(u32x4*)(P + (size_t)row * PW + c0) = o;
                    } else if (c0 < POOLOFF) {
                        const int hk = wc >> 1, d0 = 32 * (wc & 1) + 8 * fq;
                        if (lat) { const int b = row / SEQ, t = row & (SEQ - 1);
                            bf16_t* vt = (bf16_t*)(ws + WS_VT) + ((size_t)(b * 2 + hk) * 64 + d0) * VTS + t;
#pragma unroll
                            for (int j = 0; j < 8; ++j) vt[(size_t)j * VTS] = (bf16_t)f2bf(v[j]);
                        } else { const int rc = row - TL, b = rc / NCTX, jc = rc & (NCTX - 1);
                            bf16_t* vt = (bf16_t*)(ws + WS_VTC) + ((size_t)(b * 2 + hk) * 64 + d0) * NCTX + jc;
#pragma unroll
                            for (int j = 0; j < 8; ++j) vt[(size_t)j * NCTX] = (bf16_t)f2bf(v[j]);
                        }
                    } else if (c0 < SUOFF) {
                        u32x4 o;
#pragma unroll
                        for (int j2 = 0; j2 < 4; ++j2) o[j2] = pk2(v[2 * j2], v[2 * j2 + 1]);
                        *(u32x4*)(P + (size_t)row * PW + c0) = o;
                    } else if (c0 < SVOFF) {
                        u32x4 o;
#pragma unroll
                        for (int j2 = 0; j2 < 4; ++j2) o[j2] = pk2(gelu_tanh(v[2 * j2]), gelu_tanh(v[2 * j2 + 1]));
                        *(u32x4*)(P + (size_t)row * PW + c0) = o;
                    } else {
                        const int c = c0 - SVOFF, chunk = row >> 7, q = row & 127;
                        bf16_t* vs = (bf16_t*)(ws + WS_VST) + ((size_t)chunk * 256 + c) * 128 + q;
#pragma unroll
                        for (int j = 0; j < 8; ++j) vs[j * 128] = (bf16_t)f2bf(gelu_tanh(v[j]));
                    }
                }
            }
            asm volatile("" ::: "memory");
        }
    }
};
struct SchedGrid {
    int nM, nN, G, c; const char* A; const char* B;
    int n_extra, ex_pm0, ex_pn;
    DI bool next(int i, pg8::Unit& u) const {
        const int L = i * G + c, n = nM * nN; if (L >= n + n_extra) return false;
        if (L < n) pg8::tile_of(L, nM, nN, u.pm, u.pn); else { u.pm = ex_pm0 + (L - n); u.pn = ex_pn; }
        u.sub = 0; u.nt = D / 64; u.mode = 0;
        u.a = A + (size_t)u.pm * 256 * D * 2; u.b = B + (size_t)u.pn * 256 * D * 2; return true;
    }
};

DI void phase_g1(const Params& p, const Frame& F, int l) {
    SchedGrid S{(l == 0 ? T : TL) / 256, PN / 256, F.nb, F.bid, (const char*)(p.ws + WS_H), (const char*)(p.ws + WS_WIN) + (size_t)l * INW * D * 2,
                (l == 0) ? 0 : TC / 256, TL / 256, 2};
    EpiG1 E{p.ws};
    pg8::gemm_phase(F.lds, F.tid, S, E);
}

DI bf16x8 pack8(const f32x16& x, int s) {
    u32x4 pk;
#pragma unroll
    for (int j = 0; j < 4; ++j) { f32x2 v = {x[8 * s + 2 * j], x[8 * s + 2 * j + 1]}; pk[j] = __builtin_bit_cast(unsigned, __builtin_convertvector(v, bf16x2_t)); }
    return __builtin_bit_cast(bf16x8, pk);
}

DI float lane_x32(float v, bool hi) { const auto r = __builtin_amdgcn_permlane32_swap(__builtin_bit_cast(unsigned, v), __builtin_bit_cast(unsigned, v), false, false);
    return __builtin_bit_cast(float, hi ? r[0] : r[1]); }
struct AttnFrags { bf16x8 kf[4]; s16x4 vf[2][4]; };
DI void attn_block(const bf16x8 (&qf)[4], const AttnFrags& f, int mask_mode, int kq_off, int lane, float& m, float& lpart, f32x16 (&o)[2]) {
    const int h = lane >> 5;
    f32x16 st;
#pragma unroll
    for (int r = 0; r < 16; ++r) st[r] = 0.f;
#pragma unroll
    for (int s = 0; s < 4; ++s) st = MFMA32(f.kf[s], qf[s], st);
    if (mask_mode) {
#pragma unroll
        for (int r = 0; r < 16; ++r) { const int dlt = kq_off + crow(r, h); if (dlt > 128 || dlt < -128) st[r] = -1e30f; }
    }
    float bm = st[0];
#pragma unroll
    for (int r = 1; r < 16; ++r) bm = fmaxf(bm, st[r]);
    bm = fmaxf(bm, lane_x32(bm, h != 0));
    const float mn = fmaxf(m, bm);
    if (__builtin_amdgcn_ballot_w64(mn > m) != 0ull) {
        const float alpha = __builtin_amdgcn_exp2f(m - mn);
        lpart *= alpha;
#pragma unroll
        for (int d = 0; d < 2; ++d)
#pragma unroll
            for (int r = 0; r < 16; ++r) o[d][r] *= alpha;
        m = mn;
    }
    float ps = 0.f;
#pragma unroll
    for (int r = 0; r < 16; ++r) { st[r] = __builtin_amdgcn_exp2f(st[r] - m); ps += st[r]; }
    lpart += ps;
    const bf16x8 pf0 = pack8(st, 0), pf1 = pack8(st, 1);
#pragma unroll
    for (int d = 0; d < 2; ++d) {
        const bf16x8 v0 = __builtin_shufflevector(f.vf[d][0], f.vf[d][1], 0, 1, 2, 3, 4, 5, 6, 7), v1 = __builtin_shufflevector(f.vf[d][2], f.vf[d][3], 0, 1, 2, 3, 4, 5, 6, 7);
        o[d] = MFMA32(v0, pf0, o[d]);
        o[d] = MFMA32(v1, pf1, o[d]);
    }
}

constexpr int AKP = 144, AVWP = 648, AVCP = 520;
constexpr int ALDS_KW = 0, ALDS_VW = ALDS_KW + 320 * AKP, ALDS_KC = ALDS_VW + 64 * AVWP, ALDS_VC = ALDS_KC + 256 * AKP, ALDS_END = ALDS_VC + 64 * AVCP;
static_assert(ALDS_END <= LDS_BAR_OFF && (ALDS_VW % 16) == 0 && (ALDS_KC % 16) == 0 && (ALDS_VC % 8) == 0, "attention LDS map");
DI void attn_lds_frags(AttnFrags& f, const LAS unsigned char* kp, const LAS unsigned char* vp, int vpitch32) {
#pragma unroll
    for (int s = 0; s < 4; ++s) f.kf[s] = *(const LAS bf16x8*)(kp + 32 * s);
#pragma unroll
    for (int d = 0; d < 2; ++d)
#pragma unroll
        for (int q = 0; q < 4; ++q) f.vf[d][q] = *(const LAS s16x4*)(vp + d * vpitch32 + 16 * q);
}
DI void attn_unit(const Params& p, const Frame& F, int l, int unit) {
    const int lane = F.lane, r = lane & 31, h = lane >> 5, tid = F.tid;
    const bf16_t* P = (const bf16_t*)(p.ws + WS_P);
    const bf16_t* VT = (const bf16_t*)(p.ws + WS_VT);
    const bf16_t* VTC = (const bf16_t*)(p.ws + WS_VTC);
    bf16_t* Y = (bf16_t*)(p.ws + WS_Y);
    const bool latent = unit < 1024;
    int b, hk, p0, q0row;
    if (latent) { const int pb = unit & 63; hk = (unit >> 6) & 1; b = unit >> 7; p0 = pb * 64; q0row = b * SEQ + p0; }
    else { const int u2 = unit - 1024, pb = u2 & 3; hk = (u2 >> 2) & 1; b = u2 >> 3; p0 = pb * 64; q0row = TL + b * NCTX + p0; }
    const int w0 = p0 - 128;
    u32x4 kw[5], vw[5], kc[4], vc[4];
    if (latent) {
#pragma unroll
        for (int it = 0; it < 5; ++it) {
            const int i = tid + it * NTHREADS, row = i >> 3, ck = i & 7, pos = min(max(w0 + row, 0), SEQ - 1);
            kw[it] = *(const u32x4*)(P + (size_t)(b * SEQ + pos) * PW + KOFF + hk * 64 + 8 * ck);
            const int d = i / 40, cv = i % 40, pv = min(max(w0 + 8 * cv, 0), SEQ - 8);
            vw[it] = *(const u32x4*)(VT + ((size_t)(b * 2 + hk) * 64 + d) * VTS + pv);
        }
    }
#pragma unroll
    for (int it = 0; it < 4; ++it) {
        const int i = tid + it * NTHREADS;
        kc[it] = *(const u32x4*)(P + (size_t)(TL + b * NCTX + (i >> 3)) * PW + KOFF + hk * 64 + 8 * (i & 7));
        vc[it] = *(const u32x4*)(VTC + ((size_t)(b * 2 + hk) * 64 + (i >> 5)) * NCTX + 8 * (i & 31));
    }
    __syncthreads();
    if (latent) {
#pragma unroll
        for (int it = 0; it < 5; ++it) {
            const int i = tid + it * NTHREADS, row = i >> 3, ck = i & 7;
            *(LAS u32x4*)(F.lds + ALDS_KW + row * AKP + 16 * ck) = kw[it];
            const int d = i / 40, cv = i % 40;
            LAS u32x2* dst = (LAS u32x2*)(F.lds + ALDS_VW + d * AVWP + 16 * cv); dst[0] = (u32x2){vw[it].x, vw[it].y}; dst[1] = (u32x2){vw[it].z, vw[it].w};
        }
    }
#pragma unroll
    for (int it = 0; it < 4; ++it) {
        const int i = tid + it * NTHREADS;
        *(LAS u32x4*)(F.lds + ALDS_KC + (i >> 3) * AKP + 16 * (i & 7)) = kc[it];
        LAS u32x2* dst = (LAS u32x2*)(F.lds + ALDS_VC + (i >> 5) * AVCP + 16 * (i & 31)); dst[0] = (u32x2){vc[it].x, vc[it].y}; dst[1] = (u32x2){vc[it].z, vc[it].w};
    }
    const int head = 4 * hk + (F.wave & 3), ph = F.wave >> 2, pw = p0 + 32 * ph, qrow = q0row + 32 * ph;
    bf16x8 qf[4];
#pragma unroll
    for (int s = 0; s < 4; ++s) qf[s] = *(const bf16x8*)(P + (size_t)(qrow + r) * PW + head * 64 + 16 * s + 8 * h);
    float m = p.in[I_attn_sink][l * 8 + head] * LOG2E, lpart = (h == 0) ? 1.0f : 0.0f;
    f32x16 o[2];
#pragma unroll
    for (int d = 0; d < 2; ++d)
#pragma unroll
        for (int i = 0; i < 16; ++i) o[d][i] = 0.f;
    __syncthreads();
    if (latent) {
#pragma unroll 1
        for (int j = 0; j < 9; ++j) {
            const int kb = pw - 128 + 32 * j;
            if (kb < 0 || kb >= SEQ) continue;
            const int krow = kb - w0;
            AttnFrags f;
            attn_lds_frags(f, F.lds + ALDS_KW + (krow + r) * AKP + 16 * h, F.lds + ALDS_VW + r * AVWP + 2 * krow + 8 * h, 32 * AVWP);
            attn_block(qf, f, (j == 0 || j == 8) ? 1 : 0, kb - (pw + r), lane, m, lpart, o);
        }
    }
#pragma unroll 1
    for (int j = 0; j < 8; ++j) {
        AttnFrags f;
        attn_lds_frags(f, F.lds + ALDS_KC + (32 * j + r) * AKP + 16 * h, F.lds + ALDS_VC + r * AVCP + 64 * j + 8 * h, 32 * AVCP);
        attn_block(qf, f, 0, 0, lane, m, lpart, o);
    }
    const float inv = 1.0f / (lpart + lane_x32(lpart, h != 0));
    bf16_t* yrow = Y + (size_t)(qrow + r) * D + head * 64;
#pragma unroll
    for (int d = 0; d < 2; ++d)
#pragma unroll
        for (int g = 0; g < 4; ++g) {
            u32x2 w; w.x = pk2(o[d][4 * g] * inv, o[d][4 * g + 1] * inv); w.y = pk2(o[d][4 * g + 2] * inv, o[d][4 * g + 3] * inv);
            *(u32x2*)(yrow + 32 * d + 8 * g + 4 * h) = w;
        }
}

DI void sgu_unit(const Params& p, const Frame& F, int l, int chunk) {
    constexpr int VS = 136;
    LAS float* part = (LAS float*)F.lds;
    LAS float* rq = part + 512;
    LAS bf16_t* vnT = (LAS bf16_t*)(F.lds + 4096);
    const bf16_t* VsT = (const bf16_t*)(p.ws + WS_VST) + (size_t)chunk * 256 * 128;
    const bf16_t* P = (const bf16_t*)(p.ws + WS_P);
    bf16_t* Y = (bf16_t*)(p.ws + WS_Y);
    __syncthreads();
    { const int q = F.tid & 127, part_i = F.tid >> 7; float ss = 0.f;
#pragma unroll 16
        for (int c = part_i * 64; c < part_i * 64 + 64; ++c) { const float v = bf2f(VsT[c * 128 + q]); ss += v * v; }
        part[part_i * 128 + q] = ss; }
    __syncthreads();
    if (F.tid < 128) rq[F.tid] = rsqrtf((part[F.tid] + part[128 + F.tid] + part[256 + F.tid] + part[384 + F.tid]) * (1.0f / 256.0f) + EPS);
    __syncthreads();
#pragma unroll
    for (int it = 0; it < 8; ++it) {
        const int i = F.tid + it * NTHREADS;
        const int c = i >> 4, q8 = (i & 15) * 8;
        const u32x4 v = *(const u32x4*)(VsT + c * 128 + q8);
        u32x4 o;
#pragma unroll
        for (int j = 0; j < 4; ++j) o[j] = pk2(bflo(v[j]) * rq[q8 + 2 * j], bfhi(v[j]) * rq[q8 + 2 * j + 1]);
        *(LAS u32x4*)(vnT + c * VS + q8) = o;
    }
    __syncthreads();
    const int lane = F.lane, r = lane & 31, h = lane >> 5, g = F.wave >> 1, ph = F.wave & 1;
    const bf16_t* Wg = (const bf16_t*)(p.ws + WS_SGUW) + ((size_t)l * 4 + g) * 128 * 128;
#pragma unroll 1
    for (int pb = 0; pb < 2; ++pb) {
        const int p0 = 64 * ph + 32 * pb;
        const int row = chunk * 128 + p0 + r;
        bf16x8 wf[8];
#pragma unroll
        for (int s = 0; s < 8; ++s) wf[s] = *(const bf16x8*)(Wg + (size_t)(p0 + r) * 128 + 16 * s + 8 * h);
        u32x2 uu[2][4];
#pragma unroll
        for (int cb = 0; cb < 2; ++cb)
#pragma unroll
            for (int q4 = 0; q4 < 4; ++q4) uu[cb][q4] = *(const u32x2*)(P + (size_t)row * PW + SUOFF + 64 * g + 32 * cb + 8 * q4 + 4 * h);
        const float bias = p.in[I_sgu_b][(l * 4 + g) * 128 + p0 + r];
#pragma unroll
        for (int cb = 0; cb < 2; ++cb) {
            const int c0 = 64 * g + 32 * cb;
            f32x16 acc;
#pragma unroll
            for (int i = 0; i < 16; ++i) acc[i] = 0.f;
#pragma unroll
            for (int s = 0; s < 8; ++s) {
                const bf16x8 a = *(const LAS bf16x8*)(vnT + (c0 + r) * VS + 16 * s + 8 * h);
                acc = MFMA32(a, wf[s], acc);
            }
#pragma unroll
            for (int q4 = 0; q4 < 4; ++q4) {
                const int cc = c0 + 8 * q4 + 4 * h;
                const u32x2 u = uu[cb][q4];
                u32x2 w;
                w.x = pk2(bflo(u.x) * (acc[4 * q4] + bias), bfhi(u.x) * (acc[4 * q4 + 1] + bias));
                w.y = pk2(bflo(u.y) * (acc[4 * q4 + 2] + bias), bfhi(u.y) * (acc[4 * q4 + 3] + bias));
                *(u32x2*)(Y + (size_t)row * D + 768 + cc) = w;
            }
        }
    }
}

DI void phase_mix(const Params& p, const Frame& F, int l, int ctr_slot = 0) {
    (void)ctr_slot;
    const int nrows = (l == 0) ? T : TL;
    const bf16_t* P = (const bf16_t*)(p.ws + WS_P);
    bf16_t* Y = (bf16_t*)(p.ws + WS_Y);
    for (int i0 = F.bid * NTHREADS; i0 < 4 * nrows * 8; i0 += F.nb * NTHREADS) {
        const int i = i0 + F.tid, g = i / (nrows * 8), rem = i - g * (nrows * 8), row = rem >> 3, ck = g * 8 + (rem & 7);
        int base, t, len;
        if (row < TL) { base = row & ~(SEQ - 1); t = row & (SEQ - 1); len = SEQ; } else { const int rc = row - TL; base = TL + (rc & ~(NCTX - 1)); t = rc & (NCTX - 1); len = NCTX; }
        float s[8];
#pragma unroll
        for (int j = 0; j < 8; ++j) s[j] = 0.f;
        const bf16_t* zc = P + POOLOFF + ck * 8;
#define POOL_WIN(HALF) do { _Pragma("unroll") for (int dt = -(HALF); dt < (HALF); ++dt) { const int tt = t + dt; const bool ok = tt >= 0 && tt < len; \
            const u32x4 v = *(const u32x4*)(zc + (size_t)(base + (ok ? tt : t)) * PW); const float w = ok ? 1.f : 0.f; \
            _Pragma("unroll") for (int j = 0; j < 4; ++j) { s[2 * j] += w * bflo(v[j]); s[2 * j + 1] += w * bfhi(v[j]); } } } while (0)
        int half;
        if (g == 0) { POOL_WIN(1); half = 1; } else if (g == 1) { POOL_WIN(2); half = 2; } else if (g == 2) { POOL_WIN(4); half = 4; } else { POOL_WIN(8); half = 8; }
#undef POOL_WIN
        const int lo = max(t - half, 0), hi = min(t + half, len);
        const float inv = 1.0f / (float)(hi - lo);
        const u32x4 z = *(const u32x4*)(zc + (size_t)row * PW);
        u32x4 o;
#pragma unroll
        for (int j = 0; j < 4; ++j) o[j] = pk2(s[2 * j] * inv - bflo(z[j]), s[2 * j + 1] * inv - bfhi(z[j]));
        *(u32x4*)(Y + (size_t)row * D + 512 + ck * 8) = o;
    }
    const int nchunk = (l == 0) ? T / 128 : TL / 128;
    for (int ch = F.bid; ch < nchunk; ch += F.nb) sgu_unit(p, F, l, ch);
    const int nunit = (l == 0) ? 1024 + 64 : 1024;
    for (int u = F.nb - 1 - F.bid; u < nunit; u += F.nb) attn_unit(p, F, l, u);
}

struct SchedG2 {
    int G, c; const char *H, *Y, *Wg, *Wb; int npair;
    DI void fill(pg8::Unit& u, int sub, int br) const {
        u.sub = sub;
        if ((sub & 1) == 0) { u.nt = 16; u.a = H + (size_t)u.pm * 256 * D * 2; u.b = Wg + ((size_t)br * D + u.pn * 256) * D * 2; }
        else { const int koff = (br == 0) ? 0 : (br == 1 ? 512 : 768); u.nt = (br == 0) ? 8 : 4;
               u.a = Y + ((size_t)u.pm * 256 * D + koff) * 2; u.b = Wb + ((size_t)u.pn * 256 * D + koff) * 2; }
    }
    DI bool next(int i, pg8::Unit& u) const {
        constexpr int NLAT = (TL / 256) * 4;
        const int nl = (NLAT - c + G - 1) / G;
        if (i < 6 * nl) { const int tile = (i / 6) * G + c, sub = i % 6; pg8::tile_of(tile, TL / 256, 4, u.pm, u.pn); u.mode = 0; fill(u, sub, sub >> 1); return true; }
        const int e = i - 6 * nl, j = (e >> 1) * G + c;
        if (j >= npair) return false;
        const int ctile = j / 3, br = j % 3;
        u.pm = TL / 256 + (ctile >> 2); u.pn = ctile & 3; u.mode = 1 + br; fill(u, e & 1, br); return true;
    }
};
struct EpiG2 {
    static constexpr bool PERM = true;
    bf16_t* scr; bf16_t* M; bf16_t* MP;
    DI bool keeps(const pg8::Unit& u) const { return (u.sub & 1) == 0; }
    DI void operator()(f32x4 (&acc)[2][2][4][2], const pg8::Unit& u, int wr, int wc, int fr, int fq) const {
        const bool gate = (u.sub & 1) == 0, first = u.sub == 0 && gate;
        bf16_t* Mo = (u.mode == 0) ? M + (size_t)u.pm * 256 * D : MP + ((size_t)(u.mode - 1) * TC + (size_t)(u.pm - TL / 256) * 256) * D;
#pragma unroll
        for (int ai = 0; ai < 2; ++ai) {
            u32x4 ld[4][2];
            if (!first) {
#pragma unroll
                for (int m = 0; m < 4; ++m)
#pragma unroll
                    for (int bj = 0; bj < 2; ++bj) {
                        const int rl = 128 * ai + 64 * wr + 16 * m + fr, cl = 128 * bj + 32 * wc + 8 * fq;
                        ld[m][bj] = gate ? *(const u32x4*)(Mo + (size_t)rl * D + u.pn * 256 + cl) : *(const u32x4*)(scr + rl * 256 + cl);
                    }
            }
#pragma unroll
            for (int m = 0; m < 4; ++m)
#pragma unroll
                for (int bj = 0; bj < 2; ++bj) {
                    const int rl = 128 * ai + 64 * wr + 16 * m + fr, cl = 128 * bj + 32 * wc + 8 * fq;
                    if (gate) {
                        u32x4 o;
#pragma unroll
                        for (int j2 = 0; j2 < 4; ++j2) {
                            const int n = j2 >> 1, e = 2 * (j2 & 1);
                            const float i0 = fminf(1.0f + __expf(-acc[ai][bj][m][n][e]), 1e20f), i1 = fminf(1.0f + __expf(-acc[ai][bj][m][n][e + 1]), 1e20f);
                            o[j2] = pk2(__builtin_amdgcn_rcpf(i0), __builtin_amdgcn_rcpf(i1));
                            const float t0 = first ? 0.f : bflo(ld[m][bj][j2]), t1 = first ? 0.f : bfhi(ld[m][bj][j2]);
                            acc[ai][bj][m][n][e] = t0 * i0; acc[ai][bj][m][n][e + 1] = t1 * i1;
                        }
                        *(u32x4*)(scr + rl * 256 + cl) = o;
                    } else {
                        u32x4 w;
#pragma unroll
                        for (int j2 = 0; j2 < 4; ++j2) { const int n = j2 >> 1, e = 2 * (j2 & 1);
                            w[j2] = pk2(acc[ai][bj][m][n][e] * bflo(ld[m][bj][j2]), acc[ai][bj][m][n][e + 1] * bfhi(ld[m][bj][j2])); }
                        *(u32x4*)(Mo + (size_t)rl * D + u.pn * 256 + cl) = w;
                    }
                }
            asm volatile("" ::: "memory");
        }
    }
};
DI void phase_g2(const Params& p, const Frame& F, int l) {
    SchedG2 S{F.nb, F.bid, (const char*)(p.ws + WS_H), (const char*)(p.ws + WS_Y),
              (const char*)(p.ws + WS_WIN) + ((size_t)l * INW + GATEOFF) * D * 2, (const char*)(p.ws + WS_WBR) + (size_t)l * D * D * 2, (l == 0) ? (TC / 256) * 4 * 3 : 0};
    EpiG2 E{(bf16_t*)(p.ws + WS_IDX) + (size_t)F.bid * 65536, (bf16_t*)(p.ws + WS_MERGED), (bf16_t*)(p.ws + WS_MP)};
    pg8::gemm_phase(F.lds, F.tid, S, E);
}
DI void phase_g2sum(const Params& p, const Frame& F) {
    const u32x4* mp = (const u32x4*)(p.ws + WS_MP);
    u32x4* mo = (u32x4*)((bf16_t*)(p.ws + WS_MERGED) + (size_t)TL * D);
    constexpr int NV = TC * D / 8;
    for (int i = F.gtid; i < NV; i += F.ngt) {
        const u32x4 a = mp[i], b = mp[NV + i], c = mp[2 * NV + i];
        u32x4 o;
#pragma unroll
        for (int j = 0; j < 4; ++j) o[j] = pk2(bflo(a[j]) + bflo(b[j]) + bflo(c[j]), bfhi(a[j]) + bfhi(b[j]) + bfhi(c[j]));
        mo[i] = o;
    }
}

struct EpiG3 {
    DI bool keeps(const pg8::Unit&) const { return false; }
    static constexpr bool PERM = false;
    const float* xsrc; float* xdst; const float* csrc; float* cdst; const float* mod;
    DI void operator()(const f32x4 (&acc)[2][2][4][2], const pg8::Unit& u, int wr, int wc, int fr, int fq) const {
        const int col0 = u.pn * 256 + wc * 32 + 4 * fq;
        const bool lat = u.pm < TL / 256;
        const float* gt = mod + (size_t)(lat ? (u.pm >> 4) : 8) * NMOD + 2 * D;
        const float* xs = lat ? xsrc + (size_t)u.pm * 256 * D : csrc + (size_t)(u.pm - TL / 256) * 256 * D;
        float* xd = lat ? xdst + (size_t)u.pm * 256 * D : cdst + (size_t)(u.pm - TL / 256) * 256 * D;
        f32x4 gv[2][2];
#pragma unroll
        for (int bj = 0; bj < 2; ++bj)
#pragma unroll
            for (int n = 0; n < 2; ++n) gv[bj][n] = *(const f32x4*)(gt + col0 + 128 * bj + 16 * n);
#pragma unroll
        for (int ai = 0; ai < 2; ++ai) {
            f32x4 xv[4][2][2];
#pragma unroll
            for (int m = 0; m < 4; ++m)
#pragma unroll
                for (int bj = 0; bj < 2; ++bj)
#pragma unroll
                    for (int n = 0; n < 2; ++n) xv[m][bj][n] = *(const f32x4*)(xs + (size_t)(wr * 64 + fr + 128 * ai + 16 * m) * D + col0 + 128 * bj + 16 * n);
#pragma unroll
            for (int m = 0; m < 4; ++m)
#pragma unroll
                for (int bj = 0; bj < 2; ++bj)
#pragma unroll
                    for (int n = 0; n < 2; ++n)
                        *(f32x4*)(xd + (size_t)(wr * 64 + fr + 128 * ai + 16 * m) * D + col0 + 128 * bj + 16 * n) = xv[m][bj][n] + gv[bj][n] * acc[ai][bj][m][n];
            asm volatile("" ::: "memory");
        }
    }
};
DI void phase_g3(const Params& p, const Frame& F, int l) {
    SchedGrid S{(l == 0 ? T : TL) / 256, D / 256, F.nb, F.bid, (const char*)(p.ws + WS_MERGED), (const char*)(p.ws + WS_WOUT) + (size_t)l * D * D * 2, 0, 0, 0};
    float* xc = (float*)(p.ws + WS_XCTX);
    EpiG3 E{(l == 0) ? p.in[I_x] : p.out, p.out, (l == 0) ? p.in[I_ctx] : xc, xc, (const float*)(p.ws + WS_MOD) + (size_t)l * 9 * NMOD};
    pg8::gemm_phase(F.lds, F.tid, S, E);
}

struct EpiG45 {
    DI bool keeps(const pg8::Unit&) const { return false; }
    static constexpr bool PERM = true;
    unsigned short* ST;
    DI void operator()(const f32x4 (&acc)[2][2][4][2], const pg8::Unit& u, int wr, int wc, int fr, int fq) const {
        const int col0 = u.pn * 256 + wc * 32 + 8 * fq;
#pragma unroll
        for (int ai = 0; ai < 2; ++ai)
#pragma unroll
            for (int m = 0; m < 4; ++m) {
                unsigned short* rowp = ST + (size_t)(u.pm * 256 + wr * 64 + fr + 128 * ai + 16 * m) * T + col0;
#pragma unroll
                for (int bj = 0; bj < 2; ++bj) {
                    u32x4 w;
                    w.x = pkh2(acc[ai][bj][m][0][0], acc[ai][bj][m][0][1]); w.y = pkh2(acc[ai][bj][m][0][2], acc[ai][bj][m][0][3]);
                    w.z = pkh2(acc[ai][bj][m][1][0], acc[ai][bj][m][1][1]); w.w = pkh2(acc[ai][bj][m][1][2], acc[ai][bj][m][1][3]);
                    *(u32x4*)(rowp + 128 * bj) = w;
                }
            }
    }
};
DI void phase_g45(const Params& p, const Frame& F, int l) {
    SchedGrid S{2048 / 256, (l == 0 ? T : TL) / 256, F.nb, F.bid, (const char*)(p.ws + WS_WFOLD) + (size_t)l * 2048 * D * 2, (const char*)(p.ws + WS_H), 0, 0, 0};
    EpiG45 E{(unsigned short*)(p.ws + WS_ST)};
    pg8::gemm_phase(F.lds, F.tid, S, E);
}

DI unsigned fkey(float f) { const unsigned u = __builtin_bit_cast(unsigned, f); return (u & 0x80000000u) ? ~u : (u | 0x80000000u); }
DI float fkey_inv(unsigned k) { const unsigned u = (k & 0x80000000u) ? (k & 0x7fffffffu) : ~k; return __builtin_bit_cast(float, u); }
#define INSERT16(L, x) do { unsigned x_ = (x); _Pragma("unroll") for (int k_ = 0; k_ < 16; ++k_) { const unsigned hi_ = max(L[k_], x_); x_ = min(L[k_], x_); L[k_] = hi_; } } while (0)
#define CEX(a, b) do { const unsigned hi_ = max(a, b), lo_ = min(a, b); a = hi_; b = lo_; } while (0)
DI void sort16_desc(unsigned (&v)[16]) {
#pragma unroll
    for (int k = 2; k <= 16; k <<= 1)
#pragma unroll
        for (int j = k >> 1; j > 0; j >>= 1)
#pragma unroll
            for (int i = 0; i < 16; ++i) {
                const int q = i ^ j;
                if (q > i) { if ((i & k) == 0) CEX(v[i], v[q]); else CEX(v[q], v[i]); }
            }
}
DI void merge16_desc(unsigned (&L)[16], const unsigned (&N)[16]) {
#pragma unroll
    for (int i = 0; i < 16; ++i) L[i] = max(L[i], N[15 - i]);
#pragma unroll
    for (int j = 8; j > 0; j >>= 1)
#pragma unroll
        for (int i = 0; i < 16; ++i) { const int q = i ^ j; if (q > i) CEX(L[i], L[q]); }
}
DI void phase_sel(const Params& p, const Frame& F, int l) {
    const _Float16* ST = (const _Float16*)(p.ws + WS_ST);
    unsigned short* IDX = (unsigned short*)(p.ws + WS_IDX);
    float* GW = (float*)(p.ws + WS_GW);
    float* SU = (float*)(p.ws + WS_SU);
    const float* TSC = (const float*)(p.ws + WS_TSCALE) + (size_t)l * 2 * NEXP;
    LAS unsigned char* ib = (LAS unsigned char*)F.lds;
    const int ntok = (l == 0) ? T : TL;
    for (int i0 = F.bid * NTHREADS; i0 < ntok * 8; i0 += F.nb * NTHREADS) {
        const int i = i0 + F.tid;
        const int tok = i % ntok, head = i / ntok;
        unsigned la[16], lb[16];
#pragma unroll
        for (int k = 0; k < 16; ++k) { la[k] = 0u; lb[k] = 0u; }
        const _Float16* s0 = ST + (size_t)(head * 256) * T + tok;
#define SEL_LOAD(B_, k0_) do { _Pragma("unroll") for (int j = 0; j < 32; ++j) B_[j] = sp[(size_t)((k0_) + j) * T]; } while (0)
#define SEL_GRP(L_, B_, o_, k0_) do { unsigned nk_[16]; \
        _Pragma("unroll") for (int j = 0; j < 16; ++j) nk_[j] = (fkey((float)B_[(o_) + j]) & ~127u) | (unsigned)(127 - ((k0_) + j)); \
        sort16_desc(nk_); merge16_desc(L_, nk_); } while (0)
#define SEL_HALF(L_, base_) do { const _Float16* sp = s0 + (size_t)(base_) * T; _Float16 bufa[32], bufb[32]; \
        SEL_LOAD(bufa, 0); \
        _Pragma("unroll 1") for (int k0 = 0; k0 < 128; k0 += 64) { \
            SEL_LOAD(bufb, k0 + 32); SEL_GRP(L_, bufa, 0, k0); SEL_GRP(L_, bufa, 16, k0 + 16); \
            SEL_LOAD(bufa, (k0 + 64) & 127); SEL_GRP(L_, bufb, 0, k0 + 32); SEL_GRP(L_, bufb, 16, k0 + 48); } } while (0)
        SEL_HALF(la, 0);
        SEL_HALF(lb, 128);
#undef SEL_LOAD
#undef SEL_GRP
#undef SEL_HALF
        float va[16], vb[16];
#pragma unroll
        for (int k = 0; k < 16; ++k) {
            va[k] = fkey_inv(la[k] & ~127u); vb[k] = fkey_inv(lb[k] & ~127u);
            ib[k * NTHREADS + F.tid] = (unsigned char)(127u - (la[k] & 127u));
            ib[(16 + k) * NTHREADS + F.tid] = (unsigned char)(127u - (lb[k] & 127u));
        }
        unsigned lc[16];
#pragma unroll
        for (int k = 0; k < 16; ++k) lc[k] = 0u;
#pragma unroll
        for (int a = 0; a < 16; ++a)
#pragma unroll
            for (int b = 0; b < 16; ++b)
                if ((a + 1) * (b + 1) <= 16) { const unsigned key = (fkey(va[a] + vb[b]) & ~255u) | (unsigned)(255 - (a * 16 + b)); INSERT16(lc, key); }
        float e[16], sum = 0.f; const float v0 = fkey_inv(lc[0] & ~255u);
#pragma unroll
        for (int k = 0; k < 16; ++k) { e[k] = __expf(fkey_inv(lc[k] & ~255u) - v0); sum += e[k]; }
        const float inv = 1.0f / sum;
        asm volatile("s_waitcnt lgkmcnt(0)" ::: "memory");
        unsigned exs[16]; float gws[16], sus[16];
#pragma unroll
        for (int k = 0; k < 16; ++k) {
            const unsigned pos = 255u - (lc[k] & 255u), a = pos >> 4, b = pos & 15u;
            const unsigned ea = ib[a * NTHREADS + F.tid], eb = ib[(16 + b) * NTHREADS + F.tid];
            exs[k] = ea * 128u + eb;
        }
#pragma unroll
        for (int k = 0; k < 16; ++k) { gws[k] = e[k] * inv * TSC[NEXP + exs[k]]; sus[k] = TSC[exs[k]]; }
        { const size_t o = (size_t)tok * 128 + head * 16;
#pragma unroll
          for (int q = 0; q < 2; ++q) { u32x4 w;
#pragma unroll
              for (int j = 0; j < 4; ++j) w[j] = exs[8 * q + 2 * j] | (exs[8 * q + 2 * j + 1] << 16);
              *(u32x4*)(IDX + o + 8 * q) = w; }
#pragma unroll
          for (int q = 0; q < 4; ++q) { *(f32x4*)(GW + o + 4 * q) = (f32x4){gws[4 * q], gws[4 * q + 1], gws[4 * q + 2], gws[4 * q + 3]};
                                        *(f32x4*)(SU + o + 4 * q) = (f32x4){sus[4 * q], sus[4 * q + 1], sus[4 * q + 2], sus[4 * q + 3]}; } }
        asm volatile("s_waitcnt lgkmcnt(0)" ::: "memory");
    }
}

DI float dpp_xor1(float v) { return __builtin_bit_cast(float, __builtin_amdgcn_mov_dpp(__builtin_bit_cast(int, v), 0xB1, 0xF, 0xF, true)); }
DI float dpp_xor2(float v) { return __builtin_bit_cast(float, __builtin_amdgcn_mov_dpp(__builtin_bit_cast(int, v), 0x4E, 0xF, 0xF, true)); }
DI float dpp_hmir(float v) { return __builtin_bit_cast(float, __builtin_amdgcn_mov_dpp(__builtin_bit_cast(int, v), 0x141, 0xF, 0xF, true)); }
DI float dot16_fp8(const u32x4 q, const float (&hx)[16]) {
    f32x2 a = {0.f, 0.f};
#pragma unroll
    for (int j = 0; j < 4; ++j) {
        const f32x2 lo = __builtin_amdgcn_cvt_pk_f32_fp8((int)q[j], false), hi = __builtin_amdgcn_cvt_pk_f32_fp8((int)q[j], true);
        a += lo * (f32x2){hx[4 * j], hx[4 * j + 1]}; a += hi * (f32x2){hx[4 * j + 2], hx[4 * j + 3]};
    }
    return a.x + a.y;
}
#define PEER_EXPERT(id, i) ((int)(((id)[(i) >> 3][((i) >> 1) & 3] >> (16 * ((i) & 1))) & 0xffffu))

DI int dpp_xor1i(int v) { return __builtin_amdgcn_mov_dpp(v, 0xB1, 0xF, 0xF, true); }
DI int dpp_xor2i(int v) { return __builtin_amdgcn_mov_dpp(v, 0x4E, 0xF, 0xF, true); }
DI int dpp_hmiri(int v) { return __builtin_amdgcn_mov_dpp(v, 0x141, 0xF, 0xF, true); }
struct PeerURows { u32x4 q[16]; u32x4 h[2]; };
DI void peer_u_rows(PeerURows& R, const u32x4 (&id)[2], const unsigned char* ut, const unsigned char* hrow) {
    R.h[0] = *(const u32x4*)(hrow); R.h[1] = *(const u32x4*)(hrow + 16);
#pragma unroll
    for (int i = 0; i < 16; ++i) R.q[i] = *(const u32x4*)(ut + (size_t)PEER_EXPERT(id, i) * (D / 2));
}
DI void peer_u_compute(const PeerURows& R, float* part, int lane) {
    int hsum = 0;
#pragma unroll
    for (int g = 0; g < 2; ++g)
#pragma unroll
        for (int j = 0; j < 4; ++j) hsum = __builtin_amdgcn_sdot4((int)R.h[g][j], 0x01010101, hsum, false);
    int d[16];
#pragma unroll
    for (int i = 0; i < 16; ++i) { int a = 0;
#pragma unroll
        for (int dw = 0; dw < 4; ++dw) {
            const unsigned w = R.q[i][dw];
            a = __builtin_amdgcn_sdot4((int)(w & 0x0f0f0f0fu), (int)R.h[dw >> 1][2 * (dw & 1)], a, false);
            a = __builtin_amdgcn_sdot4((int)((w >> 4) & 0x0f0f0f0fu), (int)R.h[dw >> 1][2 * (dw & 1) + 1], a, false);
        }
        d[i] = a - 8 * hsum; }
    const bool b2 = (lane & 4) != 0, b1 = (lane & 2) != 0, b0 = (lane & 1) != 0;
    int k8[8];
#pragma unroll
    for (int i = 0; i < 8; ++i) { const int keep = b2 ? d[8 + i] : d[i], send = b2 ? d[i] : d[8 + i]; k8[i] = keep + dpp_hmiri(send); }
    int k4[4];
#pragma unroll
    for (int i = 0; i < 4; ++i) { const int keep = b1 ? k8[4 + i] : k8[i], send = b1 ? k8[i] : k8[4 + i]; k4[i] = keep + dpp_xor2i(send); }
    f32x2 k2;
    { const int keep0 = b0 ? k4[2] : k4[0], send0 = b0 ? k4[0] : k4[2], keep1 = b0 ? k4[3] : k4[1], send1 = b0 ? k4[1] : k4[3];
      k2.x = (float)(keep0 + dpp_xor1i(send0)); k2.y = (float)(keep1 + dpp_xor1i(send1)); }
    *(f32x2*)(part + 16 * (lane >> 3) + (b2 ? 8 : 0) + (b1 ? 4 : 0) + (b0 ? 2 : 0)) = k2;
}
DI void phase_peer_u(const Params& p, const Frame& F, int l) {
    const int ntok = (l == 0) ? T : TL, lane = F.lane, half = ntok >> 1;
    const int grp = F.bid & 7, cs = grp & 3, th = grp >> 2, sw = (F.bid >> 3) * NWAVES + F.wave, nsw = (F.nb >> 3) * NWAVES;
    const unsigned char* ut = p.ws + WS_UTAB + (size_t)l * NEXP * (D / 2) + 128 * cs + 16 * (lane & 7);
    const unsigned char* Hs = p.ws + WS_H8 + 256 * cs + 32 * (lane & 7);
    const unsigned short* IDXg = (const unsigned short*)(p.ws + WS_IDX) + 16 * (lane >> 3);
    float* PART = (float*)(p.ws + WS_ST) + (size_t)cs * T * 128;
    const int t0 = th * half, tend = t0 + half, last = tend - 1;
    u32x4 sa[2], sb[2]; PeerURows ra, rb;
#define U_SEL(S_, t_) do { const unsigned short* ip_ = IDXg + (size_t)min((t_), last) * 128; S_[0] = *(const u32x4*)ip_; S_[1] = *(const u32x4*)(ip_ + 8); } while (0)
#define U_ROWS(R_, S_, t_) peer_u_rows(R_, S_, ut, Hs + (size_t)min((t_), last) * D)
    U_SEL(sa, t0 + sw); U_SEL(sb, t0 + sw + nsw);
    U_ROWS(ra, sa, t0 + sw);
#pragma unroll 1
    for (int tok = t0 + sw; tok < tend; tok += 2 * nsw) {
        U_SEL(sa, tok + 2 * nsw); U_ROWS(rb, sb, tok + nsw);
        peer_u_compute(ra, PART + (size_t)tok * 128, lane);
        U_SEL(sb, tok + 3 * nsw); U_ROWS(ra, sa, tok + 2 * nsw);
        if (tok + nsw < tend) peer_u_compute(rb, PART + (size_t)(tok + nsw) * 128, lane);
    }
#undef U_SEL
#undef U_ROWS
}
DI void phase_peer_c(const Params& p, const Frame& F, int l, bool dummy = false) {
    const int ntok = (l == 0) ? T : TL;
    const float* PART = (const float*)(p.ws + WS_ST);
    float* GW = (float*)(p.ws + WS_GW);
    float* CO = dummy ? (float*)(p.ws + WS_H8) : GW;
    const float* SU = (const float*)(p.ws + WS_SU);
    const float* HS = (const float*)(p.ws + WS_HS);
    for (int i0 = F.gtid; i0 < ntok * 128; i0 += 4 * F.ngt) {
        float s[4], gw[4], su[4];
#pragma unroll
        for (int u = 0; u < 4; ++u) {
            const int i = min(i0 + u * F.ngt, ntok * 128 - 1);
            s[u] = 0.f;
#pragma unroll
            for (int sl = 0; sl < 4; ++sl) s[u] += PART[(size_t)sl * T * 128 + i];
            gw[u] = GW[i]; su[u] = SU[i] * HS[i >> 7];
        }
#pragma unroll
        for (int u = 0; u < 4; ++u) { const int i = i0 + u * F.ngt; if (i < ntok * 128) CO[i] = gw[u] * gelu_tanh(s[u] * su[u]); }
    }
}
struct PeerVRows { u32x4 q[16]; f32x4 cf[4]; f32x4 xv, gv; };
DI void peer_v_rows(PeerVRows& R, const u32x4 (&id)[2], const unsigned char* vt, const float* cp, const float* xs, const float* gt2) {
    R.cf[0] = *(const f32x4*)cp; R.cf[1] = *(const f32x4*)(cp + 4); R.cf[2] = *(const f32x4*)(cp + 8); R.cf[3] = *(const f32x4*)(cp + 12);
    R.xv = *(const f32x4*)xs; R.gv = *(const f32x4*)gt2;
#pragma unroll
    for (int i = 0; i < 16; ++i) R.q[i] = *(const u32x4*)(vt + (size_t)PEER_EXPERT(id, i) * (D / 2));
}
DI float xchg32(float v, bool hi) { const auto r = __builtin_amdgcn_permlane32_swap(__builtin_bit_cast(unsigned, v), __builtin_bit_cast(unsigned, v), false, false);
    return __builtin_bit_cast(float, hi ? r[0] : r[1]); }
DI float xchg16(float v, bool hi) { const auto r = __builtin_amdgcn_permlane16_swap(__builtin_bit_cast(unsigned, v), __builtin_bit_cast(unsigned, v), false, false);
    return __builtin_bit_cast(float, hi ? r[0] : r[1]); }
DI float xchg8(float v) { return __builtin_bit_cast(float, __builtin_amdgcn_mov_dpp(__builtin_bit_cast(int, v), 0x128, 0xF, 0xF, true)); }
typedef _Float16 h16x2 __attribute__((ext_vector_type(2)));
DI unsigned xchg32u(unsigned v, bool hi) { const auto r = __builtin_amdgcn_permlane32_swap(v, v, false, false); return hi ? r[0] : r[1]; }
DI unsigned xchg16u(unsigned v, bool hi) { const auto r = __builtin_amdgcn_permlane16_swap(v, v, false, false); return hi ? r[0] : r[1]; }
DI unsigned xchg8u(unsigned v) { return (unsigned)__builtin_amdgcn_mov_dpp((int)v, 0x128, 0xF, 0xF, true); }
DI void peer_v_compute(const PeerVRows& R, float* xdst, int lane) {
    h16x2 a[16];
#pragma unroll
    for (int j = 0; j < 16; ++j) a[j] = (h16x2){(_Float16)0.f, (_Float16)0.f};
#pragma unroll
    for (int i = 0; i < 16; ++i) {
        const _Float16 ch = (_Float16)R.cf[i >> 2][i & 3]; const h16x2 c2 = {ch, ch};
#pragma unroll
        for (int d = 0; d < 4; ++d) {
            a[4 * d + 0] += c2 * __builtin_amdgcn_cvt_scalef32_pk_f16_fp4(R.q[i][d], 1.0f, 0);
            a[4 * d + 1] += c2 * __builtin_amdgcn_cvt_scalef32_pk_f16_fp4(R.q[i][d], 1.0f, 1);
            a[4 * d + 2] += c2 * __builtin_amdgcn_cvt_scalef32_pk_f16_fp4(R.q[i][d], 1.0f, 2);
            a[4 * d + 3] += c2 * __builtin_amdgcn_cvt_scalef32_pk_f16_fp4(R.q[i][d], 1.0f, 3);
        }
    }
    const bool b5 = (lane & 32) != 0, b4 = (lane & 16) != 0, b3 = (lane & 8) != 0;
    h16x2 k8[8];
#pragma unroll
    for (int j = 0; j < 8; ++j) { const h16x2 keep = b5 ? a[8 + j] : a[j], send = b5 ? a[j] : a[8 + j];
        k8[j] = keep + __builtin_bit_cast(h16x2, xchg32u(__builtin_bit_cast(unsigned, send), b5)); }
    h16x2 k4[4];
#pragma unroll
    for (int j = 0; j < 4; ++j) { const h16x2 keep = b4 ? k8[4 + j] : k8[j], send = b4 ? k8[j] : k8[4 + j];
        k4[j] = keep + __builtin_bit_cast(h16x2, xchg16u(__builtin_bit_cast(unsigned, send), b4)); }
    h16x2 k2[2];
#pragma unroll
    for (int j = 0; j < 2; ++j) { const h16x2 keep = b3 ? k4[2 + j] : k4[j], send = b3 ? k4[j] : k4[2 + j];
        k2[j] = keep + __builtin_bit_cast(h16x2, xchg8u(__builtin_bit_cast(unsigned, send))); }
    *(f32x4*)xdst = R.xv + R.gv * (f32x4){(float)k2[0].x, (float)k2[0].y, (float)k2[1].x, (float)k2[1].y};
}
DI void phase_peer_v(const Params& p, const Frame& F, int l, bool dummy = false) {
    const int ntok = (l == 0) ? T : TL, lane = F.lane, half = ntok >> 1;
    const int grp = F.bid & 7, cs = grp & 3, th = grp >> 2, sw = (F.bid >> 3) * NWAVES + F.wave, nsw = (F.nb >> 3) * NWAVES;
    const unsigned char* vt = p.ws + WS_VTAB + (size_t)l * NEXP * (D / 2) + 128 * cs + 16 * (lane & 7);
    const unsigned short* IDXg = (const unsigned short*)(p.ws + WS_IDX) + 16 * (lane >> 3);
    const float* CFg = (const float*)(p.ws + WS_GW) + 16 * (lane >> 3);
    const int t0 = th * half, tend = t0 + half, last = tend - 1;
    u32x4 sa[2], sb[2]; PeerVRows ra, rb;
#define V_SEL(S_, t_) do { const unsigned short* ip_ = IDXg + (size_t)min((t_), last) * 128; S_[0] = *(const u32x4*)ip_; S_[1] = *(const u32x4*)(ip_ + 8); } while (0)
    const int co = 256 * cs + 32 * (lane & 7) + ((lane & 32) ? 16 : 0) + ((lane & 16) ? 8 : 0) + ((lane & 8) ? 4 : 0);
#define V_ROWS(R_, S_, t_) do { const int t1_ = min((t_), last); peer_v_rows(R_, S_, vt, CFg + (size_t)t1_ * 128, xrow_ptr(p, t1_) + co, mod_vec(p, l, t1_, 5) + co); } while (0)
#define V_DO(R_, t_) do { const int t2_ = (t_); float* xd_ = (dummy ? (float*)(p.ws + WS_ST) + (size_t)t2_ * D : xrow_ptr(p, t2_)) + co; peer_v_compute(R_, xd_, lane); } while (0)
    V_SEL(sa, t0 + sw); V_SEL(sb, t0 + sw + nsw);
    V_ROWS(ra, sa, t0 + sw);
#pragma unroll 1
    for (int tok = t0 + sw; tok < tend; tok += 2 * nsw) {
        V_SEL(sa, tok + 2 * nsw); V_ROWS(rb, sb, tok + nsw);
        V_DO(ra, tok);
        V_SEL(sb, tok + 3 * nsw); V_ROWS(ra, sa, tok + 2 * nsw);
        if (tok + nsw < tend) V_DO(rb, tok + nsw);
    }
#undef V_SEL
#undef V_ROWS
#undef V_DO
}

#define XB_TMO      128
#define XB_XCNT(j)  (256  + 64 * (j))
#define XB_XSUB(j)  (1280 + 64 * (j))
#define XB_XGEN(j)  (2304 + 64 * (j))
#define XB_TOP      3328
#define XB_TOPGEN   3392
#define XCD_BAR_WORDS 3456
#define XB_SPIN_CAP (1u << 18)
DI unsigned xb_ld(unsigned* p)              { return __hip_atomic_load(p, __ATOMIC_RELAXED, __HIP_MEMORY_SCOPE_AGENT); }
DI unsigned xb_add(unsigned* p, unsigned v) { return __hip_atomic_fetch_add(p, v, __ATOMIC_RELAXED, __HIP_MEMORY_SCOPE_AGENT); }
DI unsigned xb_xcc_id() { return (unsigned)__builtin_amdgcn_s_getreg((3 << 11) | 20) & 0xFu; }
#define XB_SPIN(cond, bar) do { unsigned _sp = 0; while (cond) { __builtin_amdgcn_s_sleep(1); \
    if ((++_sp & 255u) == 0u) { if (xb_ld(&(bar)[XB_TMO])) break; if (_sp > XB_SPIN_CAP) { atomicAdd(&(bar)[XB_TMO], 1u); break; } } } } while (0)
struct XcdBarrier { unsigned* bar; unsigned x; volatile LAS unsigned* st; };
DI XcdBarrier xcd_barrier_post(unsigned* bar, volatile LAS unsigned* st) {
    XcdBarrier b; b.bar = bar; b.x = xb_xcc_id(); b.st = st;
    if (threadIdx.x == 0) (void)xb_add(&bar[XB_XCNT(b.x)], 1u);
    return b;
}
DI void xcd_barrier_complete(unsigned* bar, unsigned x, unsigned& nloc, unsigned& nx) {
    const unsigned G = gridDim.x * gridDim.y * gridDim.z;
    unsigned sum, cnt, mine, sp = 0u;
    for (;;) {
        sum = 0u; cnt = 0u; mine = 0u;
#pragma unroll
        for (unsigned j = 0; j < 16; ++j) { const unsigned c = xb_ld(&bar[XB_XCNT(j)]); sum += c; cnt += (c > 0u) ? 1u : 0u; mine = (j == x) ? c : mine; }
        if (sum == G) break;
        __builtin_amdgcn_s_sleep(1);
        if ((++sp & 255u) == 0u) { if (xb_ld(&bar[XB_TMO])) break; if (sp > XB_SPIN_CAP) { atomicAdd(&bar[XB_TMO], 1u); break; } }
    }
    nloc = mine > 0u ? mine : 1u; nx = cnt > 0u ? cnt : 1u;
}
DI void xcd_barrier(const XcdBarrier& b) {
    asm volatile("s_waitcnt vmcnt(0)" ::: "memory");
    __syncthreads();
    if (threadIdx.x == 0) {
        unsigned* bar = b.bar;
        __builtin_amdgcn_s_waitcnt(0);
        unsigned nloc = b.st[0], nx = b.st[1];
        if (nloc == 0u) { xcd_barrier_complete(bar, b.x, nloc, nx); b.st[0] = nloc; b.st[1] = nx; }
        const unsigned old = xb_add(&bar[XB_XSUB(b.x)], 1u);
        const unsigned gen = old / nloc;
        if (old + 1u == (gen + 1u) * nloc) {
            __builtin_amdgcn_fence(__ATOMIC_RELEASE, "agent");
            asm volatile("s_waitcnt vmcnt(0)" ::: "memory");
            const unsigned og = xb_add(&bar[XB_TOP], 1u);
            const unsigned tg = og / nx;
            if (og + 1u == (tg + 1u) * nx) xb_add(&bar[XB_TOPGEN], 1u);
            else XB_SPIN(xb_ld(&bar[XB_TOPGEN]) == tg, bar);
            __builtin_amdgcn_fence(__ATOMIC_ACQUIRE, "agent");
            xb_add(&bar[XB_XGEN(b.x)], 1u);
            asm volatile("s_waitcnt vmcnt(0)" ::: "memory");
        } else {
            XB_SPIN(xb_ld(&bar[XB_XGEN(b.x)]) == gen, bar);
            __builtin_amdgcn_fence(__ATOMIC_ACQUIRE, "agent");
            asm volatile("s_waitcnt vmcnt(0)" ::: "memory");
        }
    }
    __syncthreads();
}

constexpr int NPHASE = 25;
template <int PH> DI void run_phase(const Params& p, const Frame& F) {
    if constexpr (PH == 0) phase_prep(p, F);
    else if constexpr (PH == 1) phase_norm(p, F, 0, 0, true, T);
    else if constexpr (PH == 2) phase_g1(p, F, 0);
    else if constexpr (PH == 3) phase_mix(p, F, 0);
    else if constexpr (PH == 4) phase_g2(p, F, 0);
    else if constexpr (PH == 5) phase_g2sum(p, F);
    else if constexpr (PH == 6) phase_g3(p, F, 0);
    else if constexpr (PH == 7) phase_norm(p, F, 0, 1, false, T);
    else if constexpr (PH == 8) phase_g45(p, F, 0);
    else if constexpr (PH == 9) phase_sel(p, F, 0);
    else if constexpr (PH == 10) phase_peer_u(p, F, 0);
    else if constexpr (PH == 11) phase_peer_c(p, F, 0);
    else if constexpr (PH == 12) phase_peer_v(p, F, 0);
    else if constexpr (PH == 13) phase_norm(p, F, 1, 0, false, T);
    else if constexpr (PH == 14) phase_g1(p, F, 1);
    else if constexpr (PH == 15) phase_mix(p, F, 1);
    else if constexpr (PH == 16) phase_g2(p, F, 1);
    else if constexpr (PH == 17) phase_g3(p, F, 1);
    else if constexpr (PH == 18) phase_norm(p, F, 1, 1, false, TL);
    else if constexpr (PH == 19) phase_g45(p, F, 1);
    else if constexpr (PH == 20) phase_sel(p, F, 1);
    else if constexpr (PH == 21) phase_peer_u(p, F, 1);
    else if constexpr (PH == 22) phase_peer_c(p, F, 1);
    else if constexpr (PH == 23) phase_peer_v(p, F, 1);
    else if constexpr (PH == 24) phase_final(p, F);
}
DI Frame make_frame(unsigned char* lds_raw) {
    Frame F;
    F.lds = (LAS unsigned char*)lds_raw;
    int tid = threadIdx.x; asm volatile("" : "+v"(tid));
    int bid = blockIdx.x, nb = gridDim.x; asm volatile("" : "+s"(bid), "+s"(nb));
    F.tid = tid; F.lane = tid & 63; F.wave = __builtin_amdgcn_readfirstlane(tid >> 6); F.bid = bid; F.nb = nb;
    F.gw = bid * NWAVES + F.wave; F.ngw = nb * NWAVES; F.gtid = bid * NTHREADS + tid; F.ngt = nb * NTHREADS;
    return F;
}
template <int PH> DI void run_phase_fresh(unsigned char* lds_raw) {
#if defined(__HIP_DEVICE_COMPILE__)
    const __attribute__((address_space(4))) unsigned long long* pp = (const __attribute__((address_space(4))) unsigned long long*)__builtin_amdgcn_kernarg_segment_ptr();
    asm volatile("" : "+s"(pp));
    Params p;
#pragma unroll
    for (int i = 0; i < N_IN; ++i) p.in[i] = (const float*)(const __attribute__((address_space(1))) float*)pp[i];
    p.out = (float*)(__attribute__((address_space(1))) float*)pp[N_IN]; p.ws = (unsigned char*)(__attribute__((address_space(1))) unsigned char*)pp[N_IN + 1]; p.ph_lo = 0; p.ph_hi = 0;
#else
    Params p{};
#endif
    const Frame F = make_frame(lds_raw);
    run_phase<PH>(p, F);
}
template <int PH> __global__ void __launch_bounds__(NTHREADS, 2) phase_kernel(Params p) {
    extern __shared__ __attribute__((aligned(16))) unsigned char lds_raw[];
    run_phase_fresh<PH>(lds_raw);
}
template <int PH> DI void run_all(unsigned char* lds_raw, cg::grid_group& grid, const XcdBarrier& bar) {
    if constexpr (PH < NPHASE) {
        if constexpr (PH == PROBE_PH) {
            if constexpr (PH == 11 || PH == 22 || PH == 12 || PH == 23) {
#if defined(__HIP_DEVICE_COMPILE__)
                const __attribute__((address_space(4))) unsigned long long* pp = (const __attribute__((address_space(4))) unsigned long long*)__builtin_amdgcn_kernarg_segment_ptr();
                asm volatile("" : "+s"(pp));
                Params p;
#pragma unroll
                for (int i = 0; i < N_IN; ++i) p.in[i] = (const float*)(const __attribute__((address_space(1))) float*)pp[i];
                p.out = (float*)(__attribute__((address_space(1))) float*)pp[N_IN]; p.ws = (unsigned char*)(__attribute__((address_space(1))) unsigned char*)pp[N_IN + 1]; p.ph_lo = 0; p.ph_hi = 0;
                const Frame F = make_frame(lds_raw);
                if constexpr (PH == 11 || PH == 22) phase_peer_c(p, F, PH == 11 ? 0 : 1, true); else phase_peer_v(p, F, PH == 12 ? 0 : 1, true);
#endif
            } else run_phase_fresh<PH>(lds_raw);
            xcd_barrier(bar);
        }
        run_phase_fresh<PH>(lds_raw);
        if constexpr (PH + 1 < NPHASE) { xcd_barrier(bar); if constexpr (PROBE_SYNC) xcd_barrier(bar); }
        run_all<PH + 1>(lds_raw, grid, bar);
    }
}
__global__ void __launch_bounds__(NTHREADS, 2) mega(Params p) {
    extern __shared__ __attribute__((aligned(16))) unsigned char lds_raw[];
    cg::grid_group grid = cg::this_grid();
    volatile LAS unsigned* st = (volatile LAS unsigned*)((LAS unsigned char*)lds_raw + LDS_BAR_OFF);
    if (threadIdx.x < 2) st[threadIdx.x] = 0u;
    __syncthreads();
    const XcdBarrier bar = xcd_barrier_post((unsigned*)(p.ws + WS_CTL), st);
    if (p.ph_lo != 0) grid.sync();
    run_all<0>(lds_raw, grid, bar);
}

extern "C" void kernel_launch(void* const* d_in, const int* in_sizes, int n_in, void* d_out, int out_size, void* d_ws, size_t ws_size, hipStream_t stream) {
    static int grid = 0;
    if (grid == 0) {
        if (n_in != 23 || out_size != TL * D || ws_size < WS_END) { fprintf(stderr, "kernel_launch: unexpected shapes (n_in %d out %d ws %zu)\n", n_in, out_size, ws_size); grid = -1; return; }
        int dev = 0, cus = 0, per_cu = 0;
        (void)hipGetDevice(&dev);
        (void)hipDeviceGetAttribute(&cus, hipDeviceAttributeMultiprocessorCount, dev);
        (void)hipFuncSetAttribute((const void*)mega, hipFuncAttributeMaxDynamicSharedMemorySize, LDS_BYTES);
        (void)hipOccupancyMaxActiveBlocksPerMultiprocessor(&per_cu, (const void*)mega, NTHREADS, LDS_BYTES);
        if (per_cu < 1) { fprintf(stderr, "kernel_launch: occupancy query reports %d blocks per CU\n", per_cu); grid = -1; return; }
        grid = cus & ~7;
        if (grid < 8) { fprintf(stderr, "kernel_launch: needs at least 8 CUs\n"); grid = -1; return; }
    }
    if (grid < 0) return;
    (void)hipMemsetAsync((char*)d_ws + WS_CTL, 0, CTL_ZERO_BYTES, stream);
    Params p{};
    for (int i = 0; i < N_IN; ++i) p.in[i] = (const float*)d_in[i];
    p.out = (float*)d_out; p.ws = (unsigned char*)d_ws;
    void* args[] = {&p};
    hipError_t e = hipLaunchCooperativeKernel((const void*)mega, dim3(grid), dim3(NTHREADS), args, LDS_BYTES, stream);
    if (e != hipSuccess) fprintf(stderr, "cooperative launch failed: %s (grid %d)\n", hipGetErrorString(e), grid);
}
```

```cpp
#include <hip/hip_runtime.h>
#include <hip/hip_cooperative_groups.h>
#include <stdint.h>
#include <stdio.h>
namespace cg = cooperative_groups;

#ifndef PROBE_PH
#define PROBE_PH -1
#endif
#ifndef PROBE_SYNC
#define PROBE_SYNC 0
#endif
#ifndef MK_SINGLE
#define MK_SINGLE 0
#endif

#define LAS __attribute__((address_space(3)))
typedef unsigned short bf16_t;
typedef short bf16x8 __attribute__((ext_vector_type(8)));
typedef short s16x4 __attribute__((ext_vector_type(4)));
typedef float f32x4 __attribute__((ext_vector_type(4)));
typedef float f32x2 __attribute__((ext_vector_type(2)));
typedef float f32x16 __attribute__((ext_vector_type(16)));
typedef unsigned u32x4 __attribute__((ext_vector_type(4)));
typedef unsigned u32x2 __attribute__((ext_vector_type(2)));
typedef __bf16 bf16x2_t __attribute__((ext_vector_type(2)));
typedef _Float16 f16x2_t __attribute__((ext_vector_type(2)));
#define DI __device__ __forceinline__
DI unsigned pkh2(float lo, float hi) { f16x2_t v = {(_Float16)lo, (_Float16)hi}; return __builtin_bit_cast(unsigned, v); }
#define MFMA32(a, b, c) __builtin_amdgcn_mfma_f32_32x32x16_bf16((a), (b), (c), 0, 0, 0)

constexpr int D = 1024, NB = 8, SEQ = 4096, NCTX = 256, DEPTH = 2;
constexpr int TL = NB * SEQ, TC = NB * NCTX, T = TL + TC;
constexpr int INW = 4608, NMOD = 6 * D, PW = 1600, PN = 1536;
constexpr int VTS = SEQ + 64;
constexpr int QOFF = 0, KOFF = 512, VOFF = 640, POOLOFF = 768, SUOFF = 1024, SVOFF = 1280, GATEOFF = 1536;
constexpr int NEXP = 16384;
constexpr float EPS = 1e-6f;
constexpr float LOG2E = 1.4426950408889634f;
constexpr float QSCALE = 0.125f * LOG2E;

constexpr size_t MiB = 1u << 20;
constexpr size_t WS_CTL = 0, WS_MOD = 1 * MiB, CTL_ZERO_BYTES = 2 * MiB;
constexpr size_t WS_ROPE = 2 * MiB, WS_SGUW = 2 * MiB + 65536, WS_TSCALE = 3 * MiB;
constexpr size_t WS_WIN = 4 * MiB, WS_WBR = 22 * MiB, WS_WOUT = 26 * MiB, WS_WFOLD = 30 * MiB;
constexpr size_t WS_XCTX = 38 * MiB, WS_UTAB = 46 * MiB, WS_VTAB = 78 * MiB;
constexpr size_t WS_IDX = 110 * MiB, WS_GW = 120 * MiB;
constexpr size_t WS_H = 142 * MiB;
constexpr size_t WS_P = 210 * MiB, WS_Y = 318 * MiB, WS_MERGED = 386 * MiB, WS_VT = 454 * MiB, WS_VTC = 463 * MiB, WS_VST = 464 * MiB;
constexpr size_t WS_MP = 482 * MiB;
constexpr size_t WS_ST = 210 * MiB, WS_H8 = 346 * MiB, WS_HS = 380 * MiB, WS_SU = 482 * MiB;
constexpr size_t WS_END = 512 * MiB;
static_assert(WS_ST + (size_t)2048 * T * 2 <= WS_H8 && WS_H8 + (size_t)T * D <= WS_HS, "ST / H8 fit");
static_assert(WS_VST + (size_t)272 * 256 * 128 * 2 <= WS_SU && WS_VT + (size_t)NB * 2 * 64 * VTS * 2 <= WS_VTC, "VsT / VT fit");
static_assert(WS_H + (size_t)T * D * 2 <= WS_P, "H fits");
static_assert(WS_P + (size_t)T * PW * 2 <= WS_Y && WS_Y + (size_t)T * D * 2 <= WS_MERGED && WS_MERGED + (size_t)T * D * 2 <= WS_VT, "P/Y/MERGED fit");
static_assert(WS_IDX + (size_t)T * 128 * 2 <= WS_GW && WS_GW + (size_t)T * 128 * 4 <= WS_H && WS_SU + (size_t)T * 128 * 4 <= WS_END && WS_HS + (size_t)T * 4 <= WS_SU, "idx/gw/su fit");

constexpr int LDS_BYTES = 163840;
constexpr int LDS_BAR_OFF = LDS_BYTES - 64;
constexpr int NTHREADS = 512, NWAVES = 8;

enum { I_x, I_c, I_ctx, I_c_ctx, I_w_mod, I_b_mod, I_g_mix, I_g_ffn, I_w_in, I_attn_sink, I_pool_w, I_pool_scale, I_sgu_w, I_sgu_b, I_w_br_attn, I_w_br_pool, I_w_br_sgu, I_w_out, I_peer_wq, I_peer_subkeys, I_peer_u, I_peer_v, I_g_final, N_IN };
struct Params {
    const float* in[N_IN];
    float* out; unsigned char* ws;
    int ph_lo, ph_hi;
};

DI unsigned pk2(float lo, float hi) { f32x2 v = {lo, hi}; return __builtin_bit_cast(unsigned, __builtin_convertvector(v, bf16x2_t)); }
DI unsigned f2bf(float f) { return pk2(f, 0.f) & 0xffffu; }
DI float bf2f(unsigned short u) { return __builtin_bit_cast(float, (unsigned)u << 16); }
DI float bflo(unsigned w) { return __builtin_bit_cast(float, w << 16); }
DI float bfhi(unsigned w) { return __builtin_bit_cast(float, w & 0xffff0000u); }
DI int crow(int reg, int h) { return (reg & 3) + 8 * (reg >> 2) + 4 * h; }
DI int dpp_x1(int v) { return __builtin_amdgcn_mov_dpp(v, 0xB1, 0xF, 0xF, true); }
DI float wave_sum(float v) {
#pragma unroll
    for (int o = 1; o < 64; o <<= 1) v += __shfl_xor(v, o);
    return v;
}
DI float sigmoidf_(float x) { return __builtin_amdgcn_rcpf(1.0f + __expf(-x)); }
DI float gelu_tanh(float x) { const float u = 0.7978845608028654f * (x + 0.044715f * x * x * x); return x * __builtin_amdgcn_rcpf(1.0f + __expf(-2.0f * u)); }
DI float silu_(float x) { return x * __builtin_amdgcn_rcpf(1.0f + __expf(-x)); }

struct Frame {
    int tid, lane, wave, gw, ngw, gtid, ngt, bid, nb;
    LAS unsigned char* lds;
};

template <int NM, int NN>
DI void wave_gemm(const bf16_t* __restrict__ A, int lda, const bf16_t* __restrict__ Bt, int ldb, int K, int m0, int n0, f32x16 (&acc)[NM][NN], int lane) {
    const int r = lane & 31, h = lane >> 5;
    const bf16_t* ap = A + (size_t)(m0 + r) * lda + 8 * h;
    const bf16_t* bp = Bt + (size_t)(n0 + r) * ldb + 8 * h;
    for (int k0 = 0; k0 < K; k0 += 64) {
        bf16x8 a[4][NM], b[4][NN];
#pragma unroll
        for (int s = 0; s < 4; ++s) {
#pragma unroll
            for (int i = 0; i < NM; ++i) a[s][i] = *(const bf16x8*)(ap + (size_t)(32 * i) * lda + k0 + 16 * s);
#pragma unroll
            for (int j = 0; j < NN; ++j) b[s][j] = *(const bf16x8*)(bp + (size_t)(32 * j) * ldb + k0 + 16 * s);
        }
#pragma unroll
        for (int s = 0; s < 4; ++s)
#pragma unroll
            for (int i = 0; i < NM; ++i)
#pragma unroll
                for (int j = 0; j < NN; ++j) acc[i][j] = MFMA32(a[s][i], b[s][j], acc[i][j]);
    }
}
template <int NM, int NN> DI void zero_acc(f32x16 (&acc)[NM][NN]) {
#pragma unroll
    for (int i = 0; i < NM; ++i)
#pragma unroll
        for (int j = 0; j < NN; ++j)
#pragma unroll
            for (int r = 0; r < 16; ++r) acc[i][j][r] = 0.f;
}

namespace pg8 {
constexpr int BM = 256, BK = 64, HALF = 128, HTB = HALF * BK * 2, STAGE_BYTES = 8 * HTB, NXCD = 8, WGM = 8, LD = 1024;
DI int lds_byte(int r, int c) { const int st = (r >> 4) * 2 + (c >> 5), rr = r & 15, cc = c & 31, ob = rr * 64 + cc * 2; return st * 1024 + (ob ^ (((ob >> 9) & 1) << 5)); }
DI void stage_rc(int b, int& R, int& C) { const int st = b / 1024, sb = b % 1024, swz = sb ^ (((sb >> 9) & 1) << 5); R = (st >> 1) * 16 + swz / 64; C = (st & 1) * 32 + (swz % 64) / 2; }
DI int perm32(int rho) { const int n = rho >> 4, i = rho & 15; return 8 * (i >> 2) + 4 * n + (i & 3); }
struct Unit { int pm, pn, sub, nt, mode; const char* a; const char* b; };
DI void tile_of(int L, int nM, int nN, int& pm, int& pn) {
    const int nwg = nM * nN; int wgid = L;
    { const int q = nwg / NXCD, r = nwg % NXCD, xcd = wgid % NXCD, off = wgid / NXCD; wgid = (xcd < r ? xcd * (q + 1) : r * (q + 1) + (xcd - r) * q) + off; }
    const int nig = WGM * nN, gid = wgid / nig, fm = gid * WGM, gsz = (nM - fm) < WGM ? (nM - fm) : WGM;
    pm = fm + ((wgid % nig) % gsz); pn = (wgid % nig) / gsz;
}
template <class Epi, class Sched>
DI void gemm_phase(LAS unsigned char* lds, const int tid, const Sched& S, const Epi& E) {
    const int wid = __builtin_amdgcn_readfirstlane(tid >> 6), lane = tid & 63, wr = wid >> 2, wc = wid & 3, fr = lane & 15, fq = lane >> 4;
    unsigned voffA[2], voffB[2];
#pragma unroll
    for (int i = 0; i < 2; ++i) { int R, C; stage_rc(tid * 16 + i * 8192, R, C); const int Rb = Epi::PERM ? ((R & ~31) + perm32(R & 31)) : R;
        voffA[i] = (unsigned)(R * LD + C) * 2u; voffB[i] = (unsigned)(Rb * LD + C) * 2u; }
    const size_t kstep = (size_t)(BK * 2);
    const size_t hstep = (size_t)HALF * LD * 2;
    const unsigned ldsw = (unsigned)wid * 1024u;
    const int aoff = lds_byte(wr * 64 + fr, fq * 8), boff = lds_byte(wc * 32 + fr, fq * 8);
#define PG8_SA(b, h) (((b) * 2 + (h)) * HTB)
#define PG8_SB(b, h) ((4 + (b) * 2 + (h)) * HTB)
#define PG8_STAGE(bufoff, gbase, voff) do { _Pragma("unroll") for (int _i = 0; _i < 2; ++_i) \
        __builtin_amdgcn_global_load_lds((const unsigned*)((const char*)(gbase) + (voff)[_i]), (LAS unsigned*)(lds + (bufoff) + ldsw + _i * 8192), 16, 0, 0); } while (0)
#define PG8_LDA(dst, b, h) do { _Pragma("unroll") for (int m = 0; m < 4; ++m) _Pragma("unroll") for (int k = 0; k < 2; ++k) dst[m][k] = *(const LAS bf16x8*)(lds + PG8_SA(b, h) + aoff + m * 2048 + k * 1024); } while (0)
#define PG8_LDB(dst, b, h) do { _Pragma("unroll") for (int n = 0; n < 2; ++n) _Pragma("unroll") for (int k = 0; k < 2; ++k) dst[n][k] = *(const LAS bf16x8*)(lds + PG8_SB(b, h) + boff + n * 2048 + k * 1024); } while (0)
#define PG8_MMA(ai, bj, At, Bt) do { __builtin_amdgcn_s_setprio(1); _Pragma("unroll") for (int m = 0; m < 4; ++m) _Pragma("unroll") for (int n = 0; n < 2; ++n) _Pragma("unroll") for (int k = 0; k < 2; ++k) \
        acc[ai][bj][m][n] = __builtin_amdgcn_mfma_f32_16x16x32_bf16(Bt[n][k], At[m][k], acc[ai][bj][m][n], 0, 0, 0); __builtin_amdgcn_s_setprio(0); } while (0)
#define PG8_WAIT_V(n) asm volatile("s_waitcnt vmcnt(" #n ")" ::: "memory")
#define PG8_WAIT_L(n) asm volatile("s_waitcnt lgkmcnt(" #n ")" ::: "memory")
#define PG8_BAR __builtin_amdgcn_s_barrier()
#define PG8_SCHED __builtin_amdgcn_sched_barrier(0)
    Unit cur, nxt; int ui = 0;
    if (!S.next(0, cur)) return;
    f32x4 acc[2][2][4][2];
#pragma unroll
    for (int a = 0; a < 2; ++a)
#pragma unroll
        for (int b = 0; b < 2; ++b)
#pragma unroll
            for (int m = 0; m < 4; ++m)
#pragma unroll
                for (int n = 0; n < 2; ++n) acc[a][b][m][n] = (f32x4){0.f, 0.f, 0.f, 0.f};
    bf16x8 At[4][2], B0[2][2], B1[2][2];
    const char* cA = cur.a; const char* cB = cur.b;
    PG8_STAGE(PG8_SB(0, 0), cB, voffB); PG8_STAGE(PG8_SB(0, 1), cB + hstep, voffB); PG8_STAGE(PG8_SA(0, 0), cA, voffA); PG8_STAGE(PG8_SA(0, 1), cA + hstep, voffA);
    if (wr == 1) PG8_BAR;
    PG8_WAIT_V(2); PG8_BAR;
    PG8_STAGE(PG8_SB(1, 0), cB + kstep, voffB); PG8_STAGE(PG8_SA(1, 0), cA + kstep, voffA); PG8_STAGE(PG8_SB(1, 1), cB + hstep + kstep, voffB);
    PG8_WAIT_V(6); PG8_BAR;
    for (;;) {
        const bool has_next = S.next(ui + 1, nxt);
        const char* nA = has_next ? nxt.a : cA; const char* nB = has_next ? nxt.b : cB;
        const int nt = cur.nt;
        for (int t = 0; t < nt; t += 2) {
            const bool last = (t == nt - 2);
            const char* a1 = cA + (size_t)(t + 1) * kstep;
            const char* a2 = last ? nA : cA + (size_t)(t + 2) * kstep; const char* b2 = last ? nB : cB + (size_t)(t + 2) * kstep;
            const char* a3 = a2 + kstep; const char* b3 = b2 + kstep;
            PG8_LDB(B0, 0, 0); PG8_LDB(B1, 0, 1); PG8_SCHED; PG8_LDA(At, 0, 0); PG8_STAGE(PG8_SA(1, 1), a1 + hstep, voffA);
            PG8_WAIT_V(8); PG8_WAIT_L(0); PG8_BAR; PG8_MMA(0, 0, At, B0); PG8_MMA(0, 1, At, B1); PG8_BAR; PG8_SCHED;
            PG8_LDA(At, 0, 1); PG8_STAGE(PG8_SB(0, 0), b2, voffB); PG8_STAGE(PG8_SB(0, 1), b2 + hstep, voffB); PG8_STAGE(PG8_SA(0, 0), a2, voffA);
            PG8_WAIT_V(8); PG8_WAIT_L(0); PG8_BAR; PG8_MMA(1, 0, At, B0); PG8_MMA(1, 1, At, B1); PG8_BAR; PG8_SCHED;
            PG8_LDB(B0, 1, 0); PG8_LDB(B1, 1, 1); PG8_SCHED; PG8_LDA(At, 1, 0); PG8_STAGE(PG8_SA(0, 1), a2 + hstep, voffA);
            PG8_WAIT_V(8); PG8_WAIT_L(0); PG8_BAR; PG8_MMA(0, 0, At, B0); PG8_MMA(0, 1, At, B1); PG8_BAR; PG8_SCHED;
            PG8_LDA(At, 1, 1); PG8_STAGE(PG8_SB(1, 0), b3, voffB); PG8_STAGE(PG8_SB(1, 1), b3 + hstep, voffB); PG8_STAGE(PG8_SA(1, 0), a3, voffA);
            PG8_WAIT_V(8); PG8_WAIT_L(0); PG8_BAR; PG8_MMA(1, 0, At, B0); PG8_MMA(1, 1, At, B1); PG8_BAR; PG8_SCHED;
        }
        if (wr == 0) PG8_BAR;
        E(acc, cur, wr, wc, fr, fq);
        if (!has_next) break;
        if (!E.keeps(cur)) {
#pragma unroll
        for (int a = 0; a < 2; ++a)
#pragma unroll
            for (int b = 0; b < 2; ++b)
#pragma unroll
                for (int m = 0; m < 4; ++m)
#pragma unroll
                    for (int n = 0; n < 2; ++n) acc[a][b][m][n] = (f32x4){0.f, 0.f, 0.f, 0.f};
        }
        cur = nxt; cA = nA; cB = nB; ++ui;
        if (wr == 1) PG8_BAR;
    }
    PG8_WAIT_V(0);
    PG8_BAR;
#undef PG8_SA
#undef PG8_SB
#undef PG8_STAGE
#undef PG8_LDA
#undef PG8_LDB
#undef PG8_MMA
#undef PG8_WAIT_V
#undef PG8_WAIT_L
#undef PG8_BAR
#undef PG8_SCHED
}
}

DI void transpose_item(const float* W, int K, int N, bf16_t* WT, int ldd, int row_off, int col_off, LAS float* scr, int item, int lane) {
    const int nblk = N / 32, kb = item / nblk, nb = item % nblk, k0 = 64 * kb, n0 = 32 * nb;
#pragma unroll 8
    for (int i = 0; i < 32; ++i) { const int kk = 2 * i + (lane >> 5); scr[kk * 33 + (lane & 31)] = W[(size_t)(k0 + kk) * N + n0 + (lane & 31)]; }
    asm volatile("s_waitcnt lgkmcnt(0)" ::: "memory");
    const int c = lane & 7;
#pragma unroll
    for (int j = 0; j < 4; ++j) { const int n = (lane >> 3) + 8 * j; const LAS float* s = scr + (8 * c) * 33 + n;
        u32x4 o; o.x = pk2(s[0 * 33], s[1 * 33]); o.y = pk2(s[2 * 33], s[3 * 33]); o.z = pk2(s[4 * 33], s[5 * 33]); o.w = pk2(s[6 * 33], s[7 * 33]);
        *(u32x4*)(WT + (size_t)(row_off + n0 + n) * ldd + col_off + k0 + 8 * c) = o; }
    asm volatile("s_waitcnt lgkmcnt(0)" ::: "memory");
}

DI void convert_tables(const Params& p, const Frame& F) {
    for (int it0 = 4 * F.gw; it0 < 4 * NEXP; it0 += 4 * F.ngw) {
        f32x4 v[4][4];
#pragma unroll
        for (int u = 0; u < 4; ++u) {
            const int it = it0 + u, e = it & (NEXP - 1), tbl = (it >> 14) & 1, l = it >> 15;
            const f32x4* src = (const f32x4*)((tbl ? p.in[I_peer_v] : p.in[I_peer_u]) + ((size_t)l * NEXP + e) * D) + 4 * F.lane;
#pragma unroll
            for (int j = 0; j < 4; ++j) v[u][j] = src[j];
        }
#pragma unroll
        for (int u = 0; u < 4; ++u) {
            const int it = it0 + u, e = it & (NEXP - 1), tbl = (it >> 14) & 1, l = it >> 15;
            float am = 0.f;
#pragma unroll
            for (int j = 0; j < 4; ++j) am = fmaxf(am, fmaxf(fmaxf(fabsf(v[u][j].x), fabsf(v[u][j].y)), fmaxf(fabsf(v[u][j].z), fabsf(v[u][j].w))));
#pragma unroll
            for (int o = 1; o < 64; o <<= 1) am = fmaxf(am, __shfl_xor(am, o));
            float sc;
            if (tbl) sc = (am > 0.f) ? 6.0f / am : 1.0f;
            else {
                float ss = 0.f;
#pragma unroll
                for (int j = 0; j < 4; ++j) ss += v[u][j].x * v[u][j].x + v[u][j].y * v[u][j].y + v[u][j].z * v[u][j].z + v[u][j].w * v[u][j].w;
                const float rms = sqrtf(wave_sum(ss) * (1.0f / D));
                const float step = fminf(am * (1.0f / 7.0f), 0.41f * rms);
                sc = (step > 0.f) ? 1.0f / step : 1.0f;
            }
            if (tbl) {
                u32x2 q4;
#pragma unroll
                for (int d = 0; d < 2; ++d) { unsigned w = 0;
                    w = __builtin_amdgcn_cvt_scalef32_pk_fp4_f32(w, v[u][2 * d][0] * sc, v[u][2 * d][1] * sc, 1.0f, 0);
                    w = __builtin_amdgcn_cvt_scalef32_pk_fp4_f32(w, v[u][2 * d][2] * sc, v[u][2 * d][3] * sc, 1.0f, 1);
                    w = __builtin_amdgcn_cvt_scalef32_pk_fp4_f32(w, v[u][2 * d + 1][0] * sc, v[u][2 * d + 1][1] * sc, 1.0f, 2);
                    w = __builtin_amdgcn_cvt_scalef32_pk_fp4_f32(w, v[u][2 * d + 1][2] * sc, v[u][2 * d + 1][3] * sc, 1.0f, 3);
                    q4[d] = w; }
                *(u32x2*)(p.ws + WS_VTAB + ((size_t)l * NEXP + e) * (D / 2) + 8 * F.lane) = q4;
            } else {
                u32x2 q4;
#pragma unroll
                for (int d = 0; d < 2; ++d) { unsigned w = 0;
#pragma unroll
                    for (int b = 0; b < 4; ++b) { const int j = 2 * d + (b >> 1), e2 = 2 * (b & 1);
                        const int n0 = (int)fminf(fmaxf(__builtin_rintf(v[u][j][e2] * sc), -8.0f), 7.0f) + 8, n1 = (int)fminf(fmaxf(__builtin_rintf(v[u][j][e2 + 1] * sc), -8.0f), 7.0f) + 8;
                        w |= (unsigned)(n0 | (n1 << 4)) << (8 * b); }
                    q4[d] = w; }
                *(u32x2*)(p.ws + WS_UTAB + ((size_t)l * NEXP + e) * (D / 2) + 8 * F.lane) = q4;
            }
            if (F.lane == 0) ((float*)(p.ws + WS_TSCALE))[(l * 2 + tbl) * NEXP + e] = 1.0f / sc;
        }
    }
}

DI void phase_prep(const Params& p, const Frame& F) {
    unsigned char* ws = p.ws;
    {
        LAS float* wq = (LAS float*)F.lds;
        LAS float* skl = wq + 128 * 65;
        for (int it = F.bid; it < 2 * 16 * 16; it += F.nb) {
            const int cc = it & 15, hp = (it >> 4) & 15, l = it >> 8;
            const float* src = p.in[I_peer_wq] + (size_t)l * D * 2048 + hp * 128;
            const float* sks = p.in[I_peer_subkeys] + (size_t)(l * 16 + hp) * 128 * 128;
            __syncthreads();
            { float tw[16]; f32x4 ts[8];
#pragma unroll
              for (int it = 0; it < 16; ++it) { const int e = F.tid + it * NTHREADS, ci = e >> 7, d = e & 127; tw[it] = src[(size_t)(cc * 64 + ci) * 2048 + d]; }
#pragma unroll
              for (int it = 0; it < 8; ++it) { const int e = F.tid + it * NTHREADS, key = e >> 5, d4 = (e & 31) * 4; ts[it] = *(const f32x4*)(sks + key * 128 + d4); }
#pragma unroll
              for (int it = 0; it < 16; ++it) { const int e = F.tid + it * NTHREADS, ci = e >> 7, d = e & 127; wq[d * 65 + ci] = tw[it]; }
#pragma unroll
              for (int it = 0; it < 8; ++it) { const int e = F.tid + it * NTHREADS, key = e >> 5, d4 = (e & 31) * 4; *(LAS f32x4*)(skl + key * 132 + d4) = ts[it]; } }
            __syncthreads();
            const int ci = F.tid & 63, kg = F.tid >> 6;
            float acc[16];
#pragma unroll
            for (int k = 0; k < 16; ++k) acc[k] = 0.f;
#pragma unroll 2
            for (int d = 0; d < 128; d += 4) {
                const float w0 = wq[d * 65 + ci], w1 = wq[(d + 1) * 65 + ci], w2 = wq[(d + 2) * 65 + ci], w3 = wq[(d + 3) * 65 + ci];
#pragma unroll
                for (int k = 0; k < 16; ++k) { const f32x4 s = *(const LAS f32x4*)(skl + (16 * kg + k) * 132 + d); acc[k] += w0 * s.x + w1 * s.y + w2 * s.z + w3 * s.w; }
            }
            bf16_t* dst = (bf16_t*)(ws + WS_WFOLD) + ((size_t)l * 2048 + hp * 128 + 16 * kg) * D + cc * 64 + ci;
#pragma unroll
            for (int k = 0; k < 16; ++k) dst[(size_t)k * D] = (bf16_t)f2bf(acc[k]);
        }
        __syncthreads();
    }
    {
        LAS float* scr = (LAS float*)(F.lds + F.wave * 16384);
        constexpr int I_IN = (D / 64) * (INW / 32), I_BA = (512 / 64) * (D / 32), I_BS = (256 / 64) * (D / 32), I_O = (D / 64) * (D / 32);
        constexpr int PER_L = I_IN + I_BA + I_BS + I_O;
        for (int it = F.gw; it < 2 * PER_L; it += F.ngw) {
            const int l = it / PER_L; int r = it % PER_L;
            if (r < I_IN) { transpose_item(p.in[I_w_in] + (size_t)l * D * INW, D, INW, (bf16_t*)(ws + WS_WIN) + (size_t)l * INW * D, D, 0, 0, scr, r, F.lane); continue; } r -= I_IN;
            if (r < I_BA) { transpose_item(p.in[I_w_br_attn] + (size_t)l * 512 * D, 512, D, (bf16_t*)(ws + WS_WBR) + (size_t)l * D * D, D, 0, 0, scr, r, F.lane); continue; } r -= I_BA;
            if (r < I_BS) { transpose_item(p.in[I_w_br_sgu] + (size_t)l * 256 * D, 256, D, (bf16_t*)(ws + WS_WBR) + (size_t)l * D * D, D, 0, 768, scr, r, F.lane); continue; } r -= I_BS;
            transpose_item(p.in[I_w_out] + (size_t)l * D * D, D, D, (bf16_t*)(ws + WS_WOUT) + (size_t)l * D * D, D, 0, 0, scr, r, F.lane);
        }
    }
    for (int i = F.gtid; i < 2 * 256 * D; i += F.ngt) {
        const int n = i & 1023, rc = (i >> 10) & 255, l = i >> 18, g = rc >> 6;
        const float* pw = p.in[I_pool_w] + ((size_t)l * 256 + rc) * 64;
        const float* ps = p.in[I_pool_scale] + l * 256 + 64 * g;
        const float* wb = p.in[I_w_br_pool] + ((size_t)l * 256 + 64 * g) * D + n;
        float a = 0.f;
#pragma unroll 16
        for (int e = 0; e < 64; ++e) a += pw[e] * ps[e] * wb[(size_t)e * D];
        ((bf16_t*)(ws + WS_WBR))[(size_t)l * D * D + (size_t)n * D + 512 + rc] = (bf16_t)f2bf(a);
    }
    for (int i = F.gtid; i < 2 * 4 * 128 * 128; i += F.ngt) ((bf16_t*)(ws + WS_SGUW))[i] = (bf16_t)f2bf(p.in[I_sgu_w][i]);
    for (int i = F.gtid; i < 64 * 16; i += F.ngt) {
        const int pos = i >> 4, fi = i & 15;
        const float inv = powf(10000.0f, -(float)fi / 16.0f);
        const float ang = (float)pos * inv;
        ((f32x2*)(ws + WS_ROPE))[i] = (f32x2){cosf(ang), sinf(ang)};
    }
    convert_tables(p, F);
    {
        float* MOD = (float*)(ws + WS_MOD);
        LAS float* scd = (LAS float*)F.lds;
        LAS float* red = scd + 9 * D;
        __syncthreads();
        { float tc[18];
#pragma unroll
          for (int it = 0; it < 18; ++it) { const int e = F.tid + it * NTHREADS, r = e >> 10, k = e & 1023; tc[it] = (r < 8) ? p.in[I_c][r * D + k] : p.in[I_c_ctx][k]; }
#pragma unroll
          for (int it = 0; it < 18; ++it) scd[F.tid + it * NTHREADS] = silu_(tc[it]); }
        __syncthreads();
        for (int it = F.bid; it < 2 * 96; it += F.nb) {
            const int cgp = it % 96, l = it / 96, col = cgp * 64 + F.lane;
            float acc[9];
#pragma unroll
            for (int r = 0; r < 9; ++r) acc[r] = 0.f;
            const float* wp = p.in[I_w_mod] + ((size_t)l * D + F.wave * 128) * NMOD + col;
#pragma unroll 16
            for (int k = 0; k < 128; ++k) {
                const float w = wp[(size_t)k * NMOD];
#pragma unroll
                for (int r = 0; r < 9; ++r) acc[r] += scd[r * D + F.wave * 128 + k] * w;
            }
#pragma unroll
            for (int r = 0; r < 9; ++r) red[(F.wave * 9 + r) * 64 + F.lane] = acc[r];
            __syncthreads();
            for (int e = F.tid; e < 9 * 64; e += NTHREADS) {
                const int r = e >> 6, ln = e & 63; float s = p.in[I_b_mod][l * NMOD + cgp * 64 + ln];
#pragma unroll
                for (int w = 0; w < 8; ++w) s += red[(w * 9 + r) * 64 + ln];
                MOD[((size_t)l * 9 + r) * NMOD + cgp * 64 + ln] = s;
            }
            __syncthreads();
        }
    }
}

DI const float* mod_vec(const Params& p, int l, int row, int j) {
    const int r = row < TL ? row / SEQ : 8;
    return (const float*)(p.ws + WS_MOD) + ((size_t)l * 9 + r) * NMOD + j * D;
}
DI float* xrow_ptr(const Params& p, int row) { return row < TL ? p.out + (size_t)row * D : (float*)(p.ws + WS_XCTX) + (size_t)(row - TL) * D; }
DI const float* xin_ptr(const Params& p, int row) { return row < TL ? p.in[I_x] + (size_t)row * D : p.in[I_ctx] + (size_t)(row - TL) * D; }

DI void phase_norm(const Params& p, const Frame& F, int l, int which  , bool from_input, int nrows) {
    const float* g = (which == 0 ? p.in[I_g_mix] : p.in[I_g_ffn]) + l * D;
    const int lane = F.lane;
    f32x4 gg[4];
#pragma unroll
    for (int j = 0; j < 4; ++j) gg[j] = ((const f32x4*)g)[lane + 64 * j];
    for (int row0 = 2 * F.gw; row0 < nrows; row0 += 2 * F.ngw) {
        f32x4 v[2][4], s1[2][4], s2[2][4];
#pragma unroll
        for (int u = 0; u < 2; ++u) {
            const int row = row0 + u;
            const float* src = from_input ? xin_ptr(p, row) : xrow_ptr(p, row);
            const float* sh = mod_vec(p, l, row, which * 3 + 0); const float* sc = mod_vec(p, l, row, which * 3 + 1);
#pragma unroll
            for (int j = 0; j < 4; ++j) { v[u][j] = ((const f32x4*)src)[lane + 64 * j]; s1[u][j] = ((const f32x4*)sh)[lane + 64 * j]; s2[u][j] = ((const f32x4*)sc)[lane + 64 * j]; }
        }
#pragma unroll
        for (int u = 0; u < 2; ++u) {
            float ss = 0.f;
#pragma unroll
            for (int j = 0; j < 4; ++j) ss += v[u][j].x * v[u][j].x + v[u][j].y * v[u][j].y + v[u][j].z * v[u][j].z + v[u][j].w * v[u][j].w;
            const float rinv = rsqrtf(wave_sum(ss) * (1.0f / D) + EPS);
            bf16_t* dst = (bf16_t*)(p.ws + WS_H) + (size_t)(row0 + u) * D;
            float am = 0.f;
#pragma unroll
            for (int j = 0; j < 4; ++j) {
                const f32x4 o = v[u][j] * rinv * gg[j] * (s2[u][j] + 1.0f) + s1[u][j];
                u32x2 w; w.x = pk2(o.x, o.y); w.y = pk2(o.z, o.w);
                ((u32x2*)dst)[lane + 64 * j] = w;
                v[u][j] = o; am = fmaxf(am, fmaxf(fmaxf(fabsf(o.x), fabsf(o.y)), fmaxf(fabsf(o.z), fabsf(o.w))));
            }
            if (which) {
#pragma unroll
                for (int o2 = 1; o2 < 64; o2 <<= 1) am = fmaxf(am, __shfl_xor(am, o2));
                const float sc = (am > 0.f) ? 127.0f / am : 1.0f;
                unsigned* h8 = (unsigned*)(p.ws + WS_H8 + (size_t)(row0 + u) * D);
                const bool odd = (lane & 1) != 0;
#pragma unroll
                for (int j = 0; j < 4; ++j) {
                    const int b0 = (int)__builtin_rintf(v[u][j].x * sc), b1 = (int)__builtin_rintf(v[u][j].y * sc), b2 = (int)__builtin_rintf(v[u][j].z * sc), b3 = (int)__builtin_rintf(v[u][j].w * sc);
                    const int p0 = dpp_x1(b0), p1 = dpp_x1(b1), p2 = dpp_x1(b2), p3 = dpp_x1(b3);
                    const int w0 = odd ? p1 : b0, w1 = odd ? p3 : b2, w2 = odd ? b1 : p0, w3 = odd ? b3 : p2;
                    h8[lane + 64 * j] = (unsigned)(w0 & 0xff) | ((unsigned)(w1 & 0xff) << 8) | ((unsigned)(w2 & 0xff) << 16) | ((unsigned)w3 << 24);
                }
                if (lane == 0) ((float*)(p.ws + WS_HS))[row0 + u] = (am > 0.f) ? am * (1.0f / 127.0f) : 1.0f;
            }
        }
    }
}
DI void phase_final(const Params& p, const Frame& F) {
    f32x4 gg[4];
#pragma unroll
    for (int j = 0; j < 4; ++j) gg[j] = ((const f32x4*)p.in[I_g_final])[F.lane + 64 * j];
    for (int row0 = 2 * F.gw; row0 < TL; row0 += 2 * F.ngw) {
        f32x4 v[2][4];
#pragma unroll
        for (int u = 0; u < 2; ++u)
#pragma unroll
            for (int j = 0; j < 4; ++j) v[u][j] = ((const f32x4*)(p.out + (size_t)(row0 + u) * D))[F.lane + 64 * j];
#pragma unroll
        for (int u = 0; u < 2; ++u) {
            float ss = 0.f;
#pragma unroll
            for (int j = 0; j < 4; ++j) ss += v[u][j].x * v[u][j].x + v[u][j].y * v[u][j].y + v[u][j].z * v[u][j].z + v[u][j].w * v[u][j].w;
            const float rinv = rsqrtf(wave_sum(ss) * (1.0f / D) + EPS);
            f32x4* xr = (f32x4*)(p.out + (size_t)(row0 + u) * D);
#pragma unroll
            for (int j = 0; j < 4; ++j) xr[F.lane + 64 * j] = v[u][j] * rinv * gg[j];
        }
    }
}

DI float lane_xor32(float v, bool hi) { const auto r = __builtin_amdgcn_permlane32_swap(__builtin_bit_cast(unsigned, v), __builtin_bit_cast(unsigned, v), false, false);
    return __builtin_bit_cast(float, hi ? r[0] : r[1]); }
struct EpiG1 {
    DI bool keeps(const pg8::Unit&) const { return false; }
    static constexpr bool PERM = true;
    unsigned char* ws;
    DI void operator()(const f32x4 (&acc)[2][2][4][2], const pg8::Unit& u, int wr, int wc, int fr, int fq) const {
        bf16_t* P = (bf16_t*)(ws + WS_P);
        const int rbase = u.pm * 256 + wr * 64 + fr;
        const bool hi = fq >= 2;
#pragma unroll
        for (int ai = 0; ai < 2; ++ai) {
            f32x4 cs[4][4];
            const bool lat = u.pm < TL / 256;
            if (u.pn < 3 && lat) {
#pragma unroll
                for (int m = 0; m < 4; ++m) {
                    const int t = (rbase + 128 * ai + 16 * m) & (SEQ - 1), pos = (wc & 1) ? (t & 63) : (t >> 6);
                    const f32x4* tab = (const f32x4*)(ws + WS_ROPE) + (pos * 16 + 8 * (fq & 1)) / 2;
#pragma unroll
                    for (int j2 = 0; j2 < 4; ++j2) cs[m][j2] = tab[j2];
                }
            }
#pragma unroll
            for (int m = 0; m < 4; ++m) {
                const int row = rbase + 128 * ai + 16 * m;
#pragma unroll
                for (int bj = 0; bj < 2; ++bj) {
                    const int c0 = u.pn * 256 + 128 * bj + 32 * wc + 8 * fq;
                    float v[8];
#pragma unroll
                    for (int j = 0; j < 4; ++j) { v[j] = acc[ai][bj][m][0][j]; v[4 + j] = acc[ai][bj][m][1][j]; }
                    if (c0 < VOFF) {
                        const float sc = (c0 < KOFF) ? QSCALE : 1.0f;
                        u32x4 o;
#pragma unroll
                        for (int j2 = 0; j2 < 4; ++j2) {
                            const f32x4 c4 = cs[m][j2];
                            const float o0 = lane_xor32(v[2 * j2], hi), o1 = lane_xor32(v[2 * j2 + 1], hi);
                            float r0 = hi ? (v[2 * j2] * c4.x + o0 * c4.y) : (v[2 * j2] * c4.x - o0 * c4.y);
                            float r1 = hi ? (v[2 * j2 + 1] * c4.z + o1 * c4.w) : (v[2 * j2 + 1] * c4.z - o1 * c4.w);
                            if (!lat) { r0 = v[2 * j2]; r1 = v[2 * j2 + 1]; }
                            o[j2] = pk2(r0 * sc, r1 * sc);
                        }
                        *(u32x4*)(P + (size_t)row * PW + c0) = o;
                    } else if (c0 < POOLOFF) {
                        const int hk = wc >> 1, d0 = 32 * (wc & 1) + 8 * fq;
                        if (lat) { const int b = row / SEQ, t = row & (SEQ - 1);
                            bf16_t* vt = (bf16_t*)(ws + WS_VT) + ((size_t)(b * 2 + hk) * 64 + d0) * VTS + t;
#pragma unroll
                            for (int j = 0; j < 8; ++j) vt[(size_t)j * VTS] = (bf16_t)f2bf(v[j]);
                        } else { const int rc = row - TL, b = rc / NCTX, jc = rc & (NCTX - 1);
                            bf16_t* vt = (bf16_t*)(ws + WS_VTC) + ((size_t)(b * 2 + hk) * 64 + d0) * NCTX + jc;
#pragma unroll
                            for (int j = 0; j < 8; ++j) vt[(size_t)j * NCTX] = (bf16_t)f2bf(v[j]);
                        }
                    } else if (c0 < SUOFF) {
                        u32x4 o;
#pragma unroll
                        for (int j2 = 0; j2 < 4; ++j2) o[j2] = pk2(v[2 * j2], v[2 * j2 + 1]);
                        *(u32x4*)(P + (size_t)row * PW + c0) = o;
                    } else if (c0 < SVOFF) {
                        u32x4 o;
#pragma unroll
                        for (int j2 = 0; j2 < 4; ++j2) o[j2] = pk2(gelu_tanh(v[2 * j2]), gelu_tanh(v[2 * j2 + 1]));
                        *(u32x4*)(P + (size_t)row * PW + c0) = o;
                    } else {
                        const int c = c0 - SVOFF, chunk = row >> 7, q = row & 127;
                        bf16_t* vs = (bf16_t*)(ws + WS_VST) + ((size_t)chunk * 256 + c) * 128 + q;
#pragma unroll
                        for (int j = 0; j < 8; ++j) vs[j * 128] = (bf16_t)f2bf(gelu_tanh(v[j]));
                    }
                }
            }
            asm volatile("" ::: "memory");
        }
    }
};
struct SchedGrid {
    int nM, nN, G, c; const char* A; const char* B;
    int n_extra, ex_pm0, ex_pn;
    DI bool next(int i, pg8::Unit& u) const {
        const int L = i * G + c, n = nM * nN; if (L >= n + n_extra) return false;
        if (L < n) pg8::tile_of(L, nM, nN, u.pm, u.pn); else { u.pm = ex_pm0 + (L - n); u.pn = ex_pn; }
        u.sub = 0; u.nt = D / 64; u.mode = 0;
        u.a = A + (size_t)u.pm * 256 * D * 2; u.b = B + (size_t)u.pn * 256 * D * 2; return true;
    }
};

DI void phase_g1(const Params& p, const Frame& F, int l) {
    SchedGrid S{(l == 0 ? T : TL) / 256, PN / 256, F.nb, F.bid, (const char*)(p.ws + WS_H), (const char*)(p.ws + WS_WIN) + (size_t)l * INW * D * 2,
                (l == 0) ? 0 : TC / 256, TL / 256, 2};
    EpiG1 E{p.ws};
    pg8::gemm_phase(F.lds, F.tid, S, E);
}

DI bf16x8 pack8(const f32x16& x, int s) {
    u32x4 pk;
#pragma unroll
    for (int j = 0; j < 4; ++j) { f32x2 v = {x[8 * s + 2 * j], x[8 * s + 2 * j + 1]}; pk[j] = __builtin_bit_cast(unsigned, __builtin_convertvector(v, bf16x2_t)); }
    return __builtin_bit_cast(bf16x8, pk);
}

DI float lane_x32(float v, bool hi) { const auto r = __builtin_amdgcn_permlane32_swap(__builtin_bit_cast(unsigned, v), __builtin_bit_cast(unsigned, v), false, false);
    return __builtin_bit_cast(float, hi ? r[0] : r[1]); }
struct AttnFrags { bf16x8 kf[4]; s16x4 vf[2][4]; };
DI void attn_block(const bf16x8 (&qf)[4], const AttnFrags& f, int mask_mode, int kq_off, int lane, float& m, float& lpart, f32x16 (&o)[2]) {
    const int h = lane >> 5;
    f32x16 st;
#pragma unroll
    for (int r = 0; r < 16; ++r) st[r] = 0.f;
#pragma unroll
    for (int s = 0; s < 4; ++s) st = MFMA32(f.kf[s], qf[s], st);
    if (mask_mode) {
#pragma unroll
        for (int r = 0; r < 16; ++r) { const int dlt = kq_off + crow(r, h); if (dlt > 128 || dlt < -128) st[r] = -1e30f; }
    }
    float bm = st[0];
#pragma unroll
    for (int r = 1; r < 16; ++r) bm = fmaxf(bm, st[r]);
    bm = fmaxf(bm, lane_x32(bm, h != 0));
    const float mn = fmaxf(m, bm);
    if (__builtin_amdgcn_ballot_w64(mn > m) != 0ull) {
        const float alpha = __builtin_amdgcn_exp2f(m - mn);
        lpart *= alpha;
#pragma unroll
        for (int d = 0; d < 2; ++d)
#pragma unroll
            for (int r = 0; r < 16; ++r) o[d][r] *= alpha;
        m = mn;
    }
    float ps = 0.f;
#pragma unroll
    for (int r = 0; r < 16; ++r) { st[r] = __builtin_amdgcn_exp2f(st[r] - m); ps += st[r]; }
    lpart += ps;
    const bf16x8 pf0 = pack8(st, 0), pf1 = pack8(st, 1);
#pragma unroll
    for (int d = 0; d < 2; ++d) {
        const bf16x8 v0 = __builtin_shufflevector(f.vf[d][0], f.vf[d][1], 0, 1, 2, 3, 4, 5, 6, 7), v1 = __builtin_shufflevector(f.vf[d][2], f.vf[d][3], 0, 1, 2, 3, 4, 5, 6, 7);
        o[d] = MFMA32(v0, pf0, o[d]);
        o[d] = MFMA32(v1, pf1, o[d]);
    }
}

constexpr int AKP = 144, AVWP = 648, AVCP = 520;
constexpr int ALDS_KW = 0, ALDS_VW = ALDS_KW + 320 * AKP, ALDS_KC = ALDS_VW + 64 * AVWP, ALDS_VC = ALDS_KC + 256 * AKP, ALDS_END = ALDS_VC + 64 * AVCP;
static_assert(ALDS_END <= LDS_BAR_OFF && (ALDS_VW % 16) == 0 && (ALDS_KC % 16) == 0 && (ALDS_VC % 8) == 0, "attention LDS map");
DI void attn_lds_frags(AttnFrags& f, const LAS unsigned char* kp, const LAS unsigned char* vp, int vpitch32) {
#pragma unroll
    for (int s = 0; s < 4; ++s) f.kf[s] = *(const LAS bf16x8*)(kp + 32 * s);
#pragma unroll
    for (int d = 0; d < 2; ++d)
#pragma unroll
        for (int q = 0; q < 4; ++q) f.vf[d][q] = *(const LAS s16x4*)(vp + d * vpitch32 + 16 * q);
}
DI void attn_unit(const Params& p, const Frame& F, int l, int unit) {
    const int lane = F.lane, r = lane & 31, h = lane >> 5, tid = F.tid;
    const bf16_t* P = (const bf16_t*)(p.ws + WS_P);
    const bf16_t* VT = (const bf16_t*)(p.ws + WS_VT);
    const bf16_t* VTC = (const bf16_t*)(p.ws + WS_VTC);
    bf16_t* Y = (bf16_t*)(p.ws + WS_Y);
    const bool latent = unit < 1024;
    int b, hk, p0, q0row;
    if (latent) { const int pb = unit & 63; hk = (unit >> 6) & 1; b = unit >> 7; p0 = pb * 64; q0row = b * SEQ + p0; }
    else { const int u2 = unit - 1024, pb = u2 & 3; hk = (u2 >> 2) & 1; b = u2 >> 3; p0 = pb * 64; q0row = TL + b * NCTX + p0; }
    const int w0 = p0 - 128;
    u32x4 kw[5], vw[5], kc[4], vc[4];
    if (latent) {
#pragma unroll
        for (int it = 0; it < 5; ++it) {
            const int i = tid + it * NTHREADS, row = i >> 3, ck = i & 7, pos = min(max(w0 + row, 0), SEQ - 1);
            kw[it] = *(const u32x4*)(P + (size_t)(b * SEQ + pos) * PW + KOFF + hk * 64 + 8 * ck);
            const int d = i / 40, cv = i % 40, pv = min(max(w0 + 8 * cv, 0), SEQ - 8);
            vw[it] = *(const u32x4*)(VT + ((size_t)(b * 2 + hk) * 64 + d) * VTS + pv);
        }
    }
#pragma unroll
    for (int it = 0; it < 4; ++it) {
        const int i = tid + it * NTHREADS;
        kc[it] = *(const u32x4*)(P + (size_t)(TL + b * NCTX + (i >> 3)) * PW + KOFF + hk * 64 + 8 * (i & 7));
        vc[it] = *(const u32x4*)(VTC + ((size_t)(b * 2 + hk) * 64 + (i >> 5)) * NCTX + 8 * (i & 31));
    }
    __syncthreads();
    if (latent) {
#pragma unroll
        for (int it = 0; it < 5; ++it) {
            const int i = tid + it * NTHREADS, row = i >> 3, ck = i & 7;
            *(LAS u32x4*)(F.lds + ALDS_KW + row * AKP + 16 * ck) = kw[it];
            const int d = i / 40, cv = i % 40;
            LAS u32x2* dst = (LAS u32x2*)(F.lds + ALDS_VW + d * AVWP + 16 * cv); dst[0] = (u32x2){vw[it].x, vw[it].y}; dst[1] = (u32x2){vw[it].z, vw[it].w};
        }
    }
#pragma unroll
    for (int it = 0; it < 4; ++it) {
        const int i = tid + it * NTHREADS;
        *(LAS u32x4*)(F.lds + ALDS_KC + (i >> 3) * AKP + 16 * (i & 7)) = kc[it];
        LAS u32x2* dst = (LAS u32x2*)(F.lds + ALDS_VC + (i >> 5) * AVCP + 16 * (i & 31)); dst[0] = (u32x2){vc[it].x, vc[it].y}; dst[1] = (u32x2){vc[it].z, vc[it].w};
    }
    const int head = 4 * hk + (F.wave & 3), ph = F.wave >> 2, pw = p0 + 32 * ph, qrow = q0row + 32 * ph;
    bf16x8 qf[4];
#pragma unroll
    for (int s = 0; s < 4; ++s) qf[s] = *(const bf16x8*)(P + (size_t)(qrow + r) * PW + head * 64 + 16 * s + 8 * h);
    float m = p.in[I_attn_sink][l * 8 + head] * LOG2E, lpart = (h == 0) ? 1.0f : 0.0f;
    f32x16 o[2];
#pragma unroll
    for (int d = 0; d < 2; ++d)
#pragma unroll
        for (int i = 0; i < 16; ++i) o[d][i] = 0.f;
    __syncthreads();
    if (latent) {
#pragma unroll 1
        for (int j = 0; j < 9; ++j) {
            const int kb = pw - 128 + 32 * j;
            if (kb < 0 || kb >= SEQ) continue;
            const int krow = kb - w0;
            AttnFrags f;
            attn_lds_frags(f, F.lds + ALDS_KW + (krow + r) * AKP + 16 * h, F.lds + ALDS_VW + r * AVWP + 2 * krow + 8 * h, 32 * AVWP);
            attn_block(qf, f, (j == 0 || j == 8) ? 1 : 0, kb - (pw + r), lane, m, lpart, o);
        }
    }
#pragma unroll 1
    for (int j = 0; j < 8; ++j) {
        AttnFrags f;
        attn_lds_frags(f, F.lds + ALDS_KC + (32 * j + r) * AKP + 16 * h, F.lds + ALDS_VC + r * AVCP + 64 * j + 8 * h, 32 * AVCP);
        attn_block(qf, f, 0, 0, lane, m, lpart, o);
    }
    const float inv = 1.0f / (lpart + lane_x32(lpart, h != 0));
    bf16_t* yrow = Y + (size_t)(qrow + r) * D + head * 64;
#pragma unroll
    for (int d = 0; d < 2; ++d)
#pragma unroll
        for (int g = 0; g < 4; ++g) {
            u32x2 w; w.x = pk2(o[d][4 * g] * inv, o[d][4 * g + 1] * inv); w.y = pk2(o[d][4 * g + 2] * inv, o[d][4 * g + 3] * inv);
            *(u32x2*)(yrow + 32 * d + 8 * g + 4 * h) = w;
        }
}

DI void sgu_unit(const Params& p, const Frame& F, int l, int chunk) {
    constexpr int VS = 136;
    LAS float* part = (LAS float*)F.lds;
    LAS float* rq = part + 512;
    LAS bf16_t* vnT = (LAS bf16_t*)(F.lds + 4096);
    const bf16_t* VsT = (const bf16_t*)(p.ws + WS_VST) + (size_t)chunk * 256 * 128;
    const bf16_t* P = (const bf16_t*)(p.ws + WS_P);
    bf16_t* Y = (bf16_t*)(p.ws + WS_Y);
    __syncthreads();
    { const int q = F.tid & 127, part_i = F.tid >> 7; float ss = 0.f;
#pragma unroll 16
        for (int c = part_i * 64; c < part_i * 64 + 64; ++c) { const float v = bf2f(VsT[c * 128 + q]); ss += v * v; }
        part[part_i * 128 + q] = ss; }
    __syncthreads();
    if (F.tid < 128) rq[F.tid] = rsqrtf((part[F.tid] + part[128 + F.tid] + part[256 + F.tid] + part[384 + F.tid]) * (1.0f / 256.0f) + EPS);
    __syncthreads();
#pragma unroll
    for (int it = 0; it < 8; ++it) {
        const int i = F.tid + it * NTHREADS;
        const int c = i >> 4, q8 = (i & 15) * 8;
        const u32x4 v = *(const u32x4*)(VsT + c * 128 + q8);
        u32x4 o;
#pragma unroll
        for (int j = 0; j < 4; ++j) o[j] = pk2(bflo(v[j]) * rq[q8 + 2 * j], bfhi(v[j]) * rq[q8 + 2 * j + 1]);
        *(LAS u32x4*)(vnT + c * VS + q8) = o;
    }
    __syncthreads();
    const int lane = F.lane, r = lane & 31, h = lane >> 5, g = F.wave >> 1, ph = F.wave & 1;
    const bf16_t* Wg = (const bf16_t*)(p.ws + WS_SGUW) + ((size_t)l * 4 + g) * 128 * 128;
#pragma unroll 1
    for (int pb = 0; pb < 2; ++pb) {
        const int p0 = 64 * ph + 32 * pb;
        const int row = chunk * 128 + p0 + r;
        bf16x8 wf[8];
#pragma unroll
        for (int s = 0; s < 8; ++s) wf[s] = *(const bf16x8*)(Wg + (size_t)(p0 + r) * 128 + 16 * s + 8 * h);
        u32x2 uu[2][4];
#pragma unroll
        for (int cb = 0; cb < 2; ++cb)
#pragma unroll
            for (int q4 = 0; q4 < 4; ++q4) uu[cb][q4] = *(const u32x2*)(P + (size_t)row * PW + SUOFF + 64 * g + 32 * cb + 8 * q4 + 4 * h);
        const float bias = p.in[I_sgu_b][(l * 4 + g) * 128 + p0 + r];
#pragma unroll
        for (int cb = 0; cb < 2; ++cb) {
            const int c0 = 64 * g + 32 * cb;
            f32x16 acc;
#pragma unroll
            for (int i = 0; i < 16; ++i) acc[i] = 0.f;
#pragma unroll
            for (int s = 0; s < 8; ++s) {
                const bf16x8 a = *(const LAS bf16x8*)(vnT + (c0 + r) * VS + 16 * s + 8 * h);
                acc = MFMA32(a, wf[s], acc);
            }
#pragma unroll
            for (int q4 = 0; q4 < 4; ++q4) {
                const int cc = c0 + 8 * q4 + 4 * h;
                const u32x2 u = uu[cb][q4];
                u32x2 w;
                w.x = pk2(bflo(u.x) * (acc[4 * q4] + bias), bfhi(u.x) * (acc[4 * q4 + 1] + bias));
                w.y = pk2(bflo(u.y) * (acc[4 * q4 + 2] + bias), bfhi(u.y) * (acc[4 * q4 + 3] + bias));
                *(u32x2*)(Y + (size_t)row * D + 768 + cc) = w;
            }
        }
    }
}

DI void phase_mix(const Params& p, const Frame& F, int l, int ctr_slot = 0) {
    (void)ctr_slot;
    const int nrows = (l == 0) ? T : TL;
    const bf16_t* P = (const bf16_t*)(p.ws + WS_P);
    bf16_t* Y = (bf16_t*)(p.ws + WS_Y);
    for (int i0 = F.bid * NTHREADS; i0 < 4 * nrows * 8; i0 += F.nb * NTHREADS) {
        const int i = i0 + F.tid, g = i / (nrows * 8), rem = i - g * (nrows * 8), row = rem >> 3, ck = g * 8 + (rem & 7);
        int base, t, len;
        if (row < TL) { base = row & ~(SEQ - 1); t = row & (SEQ - 1); len = SEQ; } else { const int rc = row - TL; base = TL + (rc & ~(NCTX - 1)); t = rc & (NCTX - 1); len = NCTX; }
        float s[8];
#pragma unroll
        for (int j = 0; j < 8; ++j) s[j] = 0.f;
        const bf16_t* zc = P + POOLOFF + ck * 8;
#define POOL_WIN(HALF) do { _Pragma("unroll") for (int dt = -(HALF); dt < (HALF); ++dt) { const int tt = t + dt; const bool ok = tt >= 0 && tt < len; \
            const u32x4 v = *(const u32x4*)(zc + (size_t)(base + (ok ? tt : t)) * PW); const float w = ok ? 1.f : 0.f; \
            _Pragma("unroll") for (int j = 0; j < 4; ++j) { s[2 * j] += w * bflo(v[j]); s[2 * j + 1] += w * bfhi(v[j]); } } } while (0)
        int half;
        if (g == 0) { POOL_WIN(1); half = 1; } else if (g == 1) { POOL_WIN(2); half = 2; } else if (g == 2) { POOL_WIN(4); half = 4; } else { POOL_WIN(8); half = 8; }
#undef POOL_WIN
        const int lo = max(t - half, 0), hi = min(t + half, len);
        const float inv = 1.0f / (float)(hi - lo);
        const u32x4 z = *(const u32x4*)(zc + (size_t)row * PW);
        u32x4 o;
#pragma unroll
        for (int j = 0; j < 4; ++j) o[j] = pk2(s[2 * j] * inv - bflo(z[j]), s[2 * j + 1] * inv - bfhi(z[j]));
        *(u32x4*)(Y + (size_t)row * D + 512 + ck * 8) = o;
    }
    const int nchunk = (l == 0) ? T / 128 : TL / 128;
    for (int ch = F.bid; ch < nchunk; ch += F.nb) sgu_unit(p, F, l, ch);
    const int nunit = (l == 0) ? 1024 + 64 : 1024;
    for (int u = F.nb - 1 - F.bid; u < nunit; u += F.nb) attn_unit(p, F, l, u);
}

struct SchedG2 {
    int G, c; const char *H, *Y, *Wg, *Wb; int npair;
    DI void fill(pg8::Unit& u, int sub, int br) const {
        u.sub = sub;
        if ((sub & 1) == 0) { u.nt = 16; u.a = H + (size_t)u.pm * 256 * D * 2; u.b = Wg + ((size_t)br * D + u.pn * 256) * D * 2; }
        else { const int koff = (br == 0) ? 0 : (br == 1 ? 512 : 768); u.nt = (br == 0) ? 8 : 4;
               u.a = Y + ((size_t)u.pm * 256 * D + koff) * 2; u.b = Wb + ((size_t)u.pn * 256 * D + koff) * 2; }
    }
    DI bool next(int i, pg8::Unit& u) const {
        constexpr int NLAT = (TL / 256) * 4;
        const int nl = (NLAT - c + G - 1) / G;
        if (i < 6 * nl) { const int tile = (i / 6) * G + c, sub = i % 6; pg8::tile_of(tile, TL / 256, 4, u.pm, u.pn); u.mode = 0; fill(u, sub, sub >> 1); return true; }
        const int e = i - 6 * nl, j = (e >> 1) * G + c;
        if (j >= npair) return false;
        const int ctile = j / 3, br = j % 3;
        u.pm = TL / 256 + (ctile >> 2); u.pn = ctile & 3; u.mode = 1 + br; fill(u, e & 1, br); return true;
    }
};
struct EpiG2 {
    static constexpr bool PERM = true;
    bf16_t* scr; bf16_t* M; bf16_t* MP;
    DI bool keeps(const pg8::Unit& u) const { return (u.sub & 1) == 0; }
    DI void operator()(f32x4 (&acc)[2][2][4][2], const pg8::Unit& u, int wr, int wc, int fr, int fq) const {
        const bool gate = (u.sub & 1) == 0, first = u.sub == 0 && gate;
        bf16_t* Mo = (u.mode == 0) ? M + (size_t)u.pm * 256 * D : MP + ((size_t)(u.mode - 1) * TC + (size_t)(u.pm - TL / 256) * 256) * D;
#pragma unroll
        for (int ai = 0; ai < 2; ++ai) {
            u32x4 ld[4][2];
            if (!first) {
#pragma unroll
                for (int m = 0; m < 4; ++m)
#pragma unroll
                    for (int bj = 0; bj < 2; ++bj) {
                        const int rl = 128 * ai + 64 * wr + 16 * m + fr, cl = 128 * bj + 32 * wc + 8 * fq;
                        ld[m][bj] = gate ? *(const u32x4*)(Mo + (size_t)rl * D + u.pn * 256 + cl) : *(const u32x4*)(scr + rl * 256 + cl);
                    }
            }
#pragma unroll
            for (int m = 0; m < 4; ++m)
#pragma unroll
                for (int bj = 0; bj < 2; ++bj) {
                    const int rl = 128 * ai + 64 * wr + 16 * m + fr, cl = 128 * bj + 32 * wc + 8 * fq;
                    if (gate) {
                        u32x4 o;
#pragma unroll
                        for (int j2 = 0; j2 < 4; ++j2) {
                            const int n = j2 >> 1, e = 2 * (j2 & 1);
                            const float i0 = fminf(1.0f + __expf(-acc[ai][bj][m][n][e]), 1e20f), i1 = fminf(1.0f + __expf(-acc[ai][bj][m][n][e + 1]), 1e20f);
                            o[j2] = pk2(__builtin_amdgcn_rcpf(i0), __builtin_amdgcn_rcpf(i1));
                            const float t0 = first ? 0.f : bflo(ld[m][bj][j2]), t1 = first ? 0.f : bfhi(ld[m][bj][j2]);
                            acc[ai][bj][m][n][e] = t0 * i0; acc[ai][bj][m][n][e + 1] = t1 * i1;
                        }
                        *(u32x4*)(scr + rl * 256 + cl) = o;
                    } else {
                        u32x4 w;
#pragma unroll
                        for (int j2 = 0; j2 < 4; ++j2) { const int n = j2 >> 1, e = 2 * (j2 & 1);
                            w[j2] = pk2(acc[ai][bj][m][n][e] * bflo(ld[m][bj][j2]), acc[ai][bj][m][n][e + 1] * bfhi(ld[m][bj][j2])); }
                        *(u32x4*)(Mo + (size_t)rl * D + u.pn * 256 + cl) = w;
                    }
                }
            asm volatile("" ::: "memory");
        }
    }
};
DI void phase_g2(const Params& p, const Frame& F, int l) {
    SchedG2 S{F.nb, F.bid, (const char*)(p.ws + WS_H), (const char*)(p.ws + WS_Y),
              (const char*)(p.ws + WS_WIN) + ((size_t)l * INW + GATEOFF) * D * 2, (const char*)(p.ws + WS_WBR) + (size_t)l * D * D * 2, (l == 0) ? (TC / 256) * 4 * 3 : 0};
    EpiG2 E{(bf16_t*)(p.ws + WS_IDX) + (size_t)F.bid * 65536, (bf16_t*)(p.ws + WS_MERGED), (bf16_t*)(p.ws + WS_MP)};
    pg8::gemm_phase(F.lds, F.tid, S, E);
}
DI void phase_g2sum(const Params& p, const Frame& F) {
    const u32x4* mp = (const u32x4*)(p.ws + WS_MP);
    u32x4* mo = (u32x4*)((bf16_t*)(p.ws + WS_MERGED) + (size_t)TL * D);
    constexpr int NV = TC * D / 8;
    for (int i = F.gtid; i < NV; i += F.ngt) {
        const u32x4 a = mp[i], b = mp[NV + i], c = mp[2 * NV + i];
        u32x4 o;
#pragma unroll
        for (int j = 0; j < 4; ++j) o[j] = pk2(bflo(a[j]) + bflo(b[j]) + bflo(c[j]), bfhi(a[j]) + bfhi(b[j]) + bfhi(c[j]));
        mo[i] = o;
    }
}

struct EpiG3 {
    DI bool keeps(const pg8::Unit&) const { return false; }
    static constexpr bool PERM = false;
    const float* xsrc; float* xdst; const float* csrc; float* cdst; const float* mod;
    DI void operator()(const f32x4 (&acc)[2][2][4][2], const pg8::Unit& u, int wr, int wc, int fr, int fq) const {
        const int col0 = u.pn * 256 + wc * 32 + 4 * fq;
        const bool lat = u.pm < TL / 256;
        const float* gt = mod + (size_t)(lat ? (u.pm >> 4) : 8) * NMOD + 2 * D;
        const float* xs = lat ? xsrc + (size_t)u.pm * 256 * D : csrc + (size_t)(u.pm - TL / 256) * 256 * D;
        float* xd = lat ? xdst + (size_t)u.pm * 256 * D : cdst + (size_t)(u.pm - TL / 256) * 256 * D;
        f32x4 gv[2][2];
#pragma unroll
        for (int bj = 0; bj < 2; ++bj)
#pragma unroll
            for (int n = 0; n < 2; ++n) gv[bj][n] = *(const f32x4*)(gt + col0 + 128 * bj + 16 * n);
#pragma unroll
        for (int ai = 0; ai < 2; ++ai) {
            f32x4 xv[4][2][2];
#pragma unroll
            for (int m = 0; m < 4; ++m)
#pragma unroll
                for (int bj = 0; bj < 2; ++bj)
#pragma unroll
                    for (int n = 0; n < 2; ++n) xv[m][bj][n] = *(const f32x4*)(xs + (size_t)(wr * 64 + fr + 128 * ai + 16 * m) * D + col0 + 128 * bj + 16 * n);
#pragma unroll
            for (int m = 0; m < 4; ++m)
#pragma unroll
                for (int bj = 0; bj < 2; ++bj)
#pragma unroll
                    for (int n = 0; n < 2; ++n)
                        *(f32x4*)(xd + (size_t)(wr * 64 + fr + 128 * ai + 16 * m) * D + col0 + 128 * bj + 16 * n) = xv[m][bj][n] + gv[bj][n] * acc[ai][bj][m][n];
            asm volatile("" ::: "memory");
        }
    }
};
DI void phase_g3(const Params& p, const Frame& F, int l) {
    SchedGrid S{(l == 0 ? T : TL) / 256, D / 256, F.nb, F.bid, (const char*)(p.ws + WS_MERGED), (const char*)(p.ws + WS_WOUT) + (size_t)l * D * D * 2, 0, 0, 0};
    float* xc = (float*)(p.ws + WS_XCTX);
    EpiG3 E{(l == 0) ? p.in[I_x] : p.out, p.out, (l == 0) ? p.in[I_ctx] : xc, xc, (const float*)(p.ws + WS_MOD) + (size_t)l * 9 * NMOD};
    pg8::gemm_phase(F.lds, F.tid, S, E);
}

struct EpiG45 {
    DI bool keeps(const pg8::Unit&) const { return false; }
    static constexpr bool PERM = true;
    unsigned short* ST;
    DI void operator()(const f32x4 (&acc)[2][2][4][2], const pg8::Unit& u, int wr, int wc, int fr, int fq) const {
        const int col0 = u.pn * 256 + wc * 32 + 8 * fq;
#pragma unroll
        for (int ai = 0; ai < 2; ++ai)
#pragma unroll
            for (int m = 0; m < 4; ++m) {
                unsigned short* rowp = ST + (size_t)(u.pm * 256 + wr * 64 + fr + 128 * ai + 16 * m) * T + col0;
#pragma unroll
                for (int bj = 0; bj < 2; ++bj) {
                    u32x4 w;
                    w.x = pkh2(acc[ai][bj][m][0][0], acc[ai][bj][m][0][1]); w.y = pkh2(acc[ai][bj][m][0][2], acc[ai][bj][m][0][3]);
                    w.z = pkh2(acc[ai][bj][m][1][0], acc[ai][bj][m][1][1]); w.w = pkh2(acc[ai][bj][m][1][2], acc[ai][bj][m][1][3]);
                    *(u32x4*)(rowp + 128 * bj) = w;
                }
            }
    }
};
DI void phase_g45(const Params& p, const Frame& F, int l) {
    SchedGrid S{2048 / 256, (l == 0 ? T : TL) / 256, F.nb, F.bid, (const char*)(p.ws + WS_WFOLD) + (size_t)l * 2048 * D * 2, (const char*)(p.ws + WS_H), 0, 0, 0};
    EpiG45 E{(unsigned short*)(p.ws + WS_ST)};
    pg8::gemm_phase(F.lds, F.tid, S, E);
}

DI unsigned fkey(float f) { const unsigned u = __builtin_bit_cast(unsigned, f); return (u & 0x80000000u) ? ~u : (u | 0x80000000u); }
DI float fkey_inv(unsigned k) { const unsigned u = (k & 0x80000000u) ? (k & 0x7fffffffu) : ~k; return __builtin_bit_cast(float, u); }
#define INSERT16(L, x) do { unsigned x_ = (x); _Pragma("unroll") for (int k_ = 0; k_ < 16; ++k_) { const unsigned hi_ = max(L[k_], x_); x_ = min(L[k_], x_); L[k_] = hi_; } } while (0)
#define CEX(a, b) do { const unsigned hi_ = max(a, b), lo_ = min(a, b); a = hi_; b = lo_; } while (0)
DI void sort16_desc(unsigned (&v)[16]) {
    CEX(v[0], v[1]); CEX(v[2], v[3]); CEX(v[0], v[2]); CEX(v[1], v[3]); CEX(v[1], v[2]); CEX(v[4], v[5]); CEX(v[6], v[7]); CEX(v[4], v[6]); CEX(v[5], v[7]); CEX(v[5], v[6]); CEX(v[0], v[4]); CEX(v[2], v[6]); CEX(v[2], v[4]); CEX(v[1], v[5]); CEX(v[3], v[7]); CEX(v[3], v[5]); CEX(v[1], v[2]); CEX(v[3], v[4]); CEX(v[5], v[6]); CEX(v[8], v[9]); CEX(v[10], v[11]); CEX(v[8], v[10]); CEX(v[9], v[11]); CEX(v[9], v[10]); CEX(v[12], v[13]); CEX(v[14], v[15]); CEX(v[12], v[14]); CEX(v[13], v[15]); CEX(v[13], v[14]); CEX(v[8], v[12]); CEX(v[10], v[14]); CEX(v[10], v[12]); CEX(v[9], v[13]); CEX(v[11], v[15]); CEX(v[11], v[13]); CEX(v[9], v[10]); CEX(v[11], v[12]); CEX(v[13], v[14]); CEX(v[0], v[8]); CEX(v[4], v[12]); CEX(v[4], v[8]); CEX(v[2], v[10]); CEX(v[6], v[14]); CEX(v[6], v[10]); CEX(v[2], v[4]); CEX(v[6], v[8]); CEX(v[10], v[12]); CEX(v[1], v[9]); CEX(v[5], v[13]); CEX(v[5], v[9]); CEX(v[3], v[11]); CEX(v[7], v[15]); CEX(v[7], v[11]); CEX(v[3], v[5]); CEX(v[7], v[9]); CEX(v[11], v[13]); CEX(v[1], v[2]); CEX(v[3], v[4]); CEX(v[5], v[6]); CEX(v[7], v[8]); CEX(v[9], v[10]); CEX(v[11], v[12]); CEX(v[13], v[14]);
}
DI void merge16_desc(unsigned (&L)[16], const unsigned (&N)[16]) {
#pragma unroll
    for (int i = 0; i < 16; ++i) L[i] = max(L[i], N[15 - i]);
#pragma unroll
    for (int j = 8; j > 0; j >>= 1)
#pragma unroll
        for (int i = 0; i < 16; ++i) { const int q = i ^ j; if (q > i) CEX(L[i], L[q]); }
}
DI void phase_sel(const Params& p, const Frame& F, int l) {
    const _Float16* ST = (const _Float16*)(p.ws + WS_ST);
    unsigned short* IDX = (unsigned short*)(p.ws + WS_IDX);
    float* GW = (float*)(p.ws + WS_GW);
    float* SU = (float*)(p.ws + WS_SU);
    const float* TSC = (const float*)(p.ws + WS_TSCALE) + (size_t)l * 2 * NEXP;
    LAS unsigned char* ib = (LAS unsigned char*)F.lds;
    const int ntok = (l == 0) ? T : TL;
    for (int i0 = F.bid * NTHREADS; i0 < ntok * 8; i0 += F.nb * NTHREADS) {
        const int i = i0 + F.tid;
        const int tok = i % ntok, head = i / ntok;
        unsigned la[16], lb[16];
#pragma unroll
        for (int k = 0; k < 16; ++k) { la[k] = 0u; lb[k] = 0u; }
        const _Float16* s0 = ST + (size_t)(head * 256) * T + tok;
#define SEL_LOAD(B_, k0_) do { _Pragma("unroll") for (int j = 0; j < 32; ++j) B_[j] = sp[(size_t)((k0_) + j) * T]; } while (0)
#define SEL_GRP(L_, B_, o_, k0_) do { unsigned nk_[16]; \
        _Pragma("unroll") for (int j = 0; j < 16; ++j) nk_[j] = (fkey((float)B_[(o_) + j]) & ~127u) | (unsigned)(127 - ((k0_) + j)); \
        sort16_desc(nk_); merge16_desc(L_, nk_); } while (0)
#define SEL_HALF(L_, base_) do { const _Float16* sp = s0 + (size_t)(base_) * T; _Float16 bufa[32], bufb[32]; \
        SEL_LOAD(bufa, 0); \
        _Pragma("unroll 1") for (int k0 = 0; k0 < 128; k0 += 64) { \
            SEL_LOAD(bufb, k0 + 32); SEL_GRP(L_, bufa, 0, k0); SEL_GRP(L_, bufa, 16, k0 + 16); \
            SEL_LOAD(bufa, (k0 + 64) & 127); SEL_GRP(L_, bufb, 0, k0 + 32); SEL_GRP(L_, bufb, 16, k0 + 48); } } while (0)
        SEL_HALF(la, 0);
        SEL_HALF(lb, 128);
#undef SEL_LOAD
#undef SEL_GRP
#undef SEL_HALF
        float va[16], vb[16];
#pragma unroll
        for (int k = 0; k < 16; ++k) {
            va[k] = fkey_inv(la[k] & ~127u); vb[k] = fkey_inv(lb[k] & ~127u);
            ib[k * NTHREADS + F.tid] = (unsigned char)(127u - (la[k] & 127u));
            ib[(16 + k) * NTHREADS + F.tid] = (unsigned char)(127u - (lb[k] & 127u));
        }
        unsigned lc[16];
        { lc[0] = (fkey(va[0] + vb[0]) & ~255u) | 255u; lc[1] = (fkey(va[0] + vb[1]) & ~255u) | 254u; lc[2] = (fkey(va[0] + vb[2]) & ~255u) | 253u; lc[3] = (fkey(va[0] + vb[3]) & ~255u) | 252u; lc[4] = (fkey(va[0] + vb[4]) & ~255u) | 251u; lc[5] = (fkey(va[0] + vb[5]) & ~255u) | 250u; lc[6] = (fkey(va[0] + vb[6]) & ~255u) | 249u; lc[7] = (fkey(va[0] + vb[7]) & ~255u) | 248u; lc[8] = (fkey(va[0] + vb[8]) & ~255u) | 247u; lc[9] = (fkey(va[0] + vb[9]) & ~255u) | 246u; lc[10] = (fkey(va[0] + vb[10]) & ~255u) | 245u; lc[11] = (fkey(va[0] + vb[11]) & ~255u) | 244u; lc[12] = (fkey(va[0] + vb[12]) & ~255u) | 243u; lc[13] = (fkey(va[0] + vb[13]) & ~255u) | 242u; lc[14] = (fkey(va[0] + vb[14]) & ~255u) | 241u; lc[15] = (fkey(va[0] + vb[15]) & ~255u) | 240u; }
        sort16_desc(lc);
        { unsigned cg1[16]; cg1[0] = (fkey(va[1] + vb[0]) & ~255u) | 239u; cg1[1] = (fkey(va[1] + vb[1]) & ~255u) | 238u; cg1[2] = (fkey(va[1] + vb[2]) & ~255u) | 237u; cg1[3] = (fkey(va[1] + vb[3]) & ~255u) | 236u; cg1[4] = (fkey(va[1] + vb[4]) & ~255u) | 235u; cg1[5] = (fkey(va[1] + vb[5]) & ~255u) | 234u; cg1[6] = (fkey(va[1] + vb[6]) & ~255u) | 233u; cg1[7] = (fkey(va[1] + vb[7]) & ~255u) | 232u; cg1[8] = (fkey(va[2] + vb[0]) & ~255u) | 223u; cg1[9] = (fkey(va[2] + vb[1]) & ~255u) | 222u; cg1[10] = (fkey(va[2] + vb[2]) & ~255u) | 221u; cg1[11] = (fkey(va[2] + vb[3]) & ~255u) | 220u; cg1[12] = (fkey(va[2] + vb[4]) & ~255u) | 219u; cg1[13] = (fkey(va[3] + vb[0]) & ~255u) | 207u; cg1[14] = (fkey(va[3] + vb[1]) & ~255u) | 206u; cg1[15] = (fkey(va[3] + vb[2]) & ~255u) | 205u; sort16_desc(cg1); merge16_desc(lc, cg1); }
        { unsigned cg2[16]; cg2[0] = (fkey(va[3] + vb[3]) & ~255u) | 204u; cg2[1] = (fkey(va[4] + vb[0]) & ~255u) | 191u; cg2[2] = (fkey(va[4] + vb[1]) & ~255u) | 190u; cg2[3] = (fkey(va[4] + vb[2]) & ~255u) | 189u; cg2[4] = (fkey(va[5] + vb[0]) & ~255u) | 175u; cg2[5] = (fkey(va[5] + vb[1]) & ~255u) | 174u; cg2[6] = (fkey(va[6] + vb[0]) & ~255u) | 159u; cg2[7] = (fkey(va[6] + vb[1]) & ~255u) | 158u; cg2[8] = (fkey(va[7] + vb[0]) & ~255u) | 143u; cg2[9] = (fkey(va[7] + vb[1]) & ~255u) | 142u; cg2[10] = (fkey(va[8] + vb[0]) & ~255u) | 127u; cg2[11] = (fkey(va[9] + vb[0]) & ~255u) | 111u; cg2[12] = (fkey(va[10] + vb[0]) & ~255u) | 95u; cg2[13] = (fkey(va[11] + vb[0]) & ~255u) | 79u; cg2[14] = (fkey(va[12] + vb[0]) & ~255u) | 63u; cg2[15] = (fkey(va[13] + vb[0]) & ~255u) | 47u; sort16_desc(cg2); merge16_desc(lc, cg2); }
        { const unsigned key = (fkey(va[14] + vb[0]) & ~255u) | 31u; INSERT16(lc, key); }
        { const unsigned key = (fkey(va[15] + vb[0]) & ~255u) | 15u; INSERT16(lc, key); }
        float e[16], sum = 0.f; const float v0 = fkey_inv(lc[0] & ~255u);
#pragma unroll
        for (int k = 0; k < 16; ++k) { e[k] = __expf(fkey_inv(lc[k] & ~255u) - v0); sum += e[k]; }
        const float inv = 1.0f / sum;
        asm volatile("s_waitcnt lgkmcnt(0)" ::: "memory");
        unsigned exs[16]; float gws[16], sus[16];
#pragma unroll
        for (int k = 0; k < 16; ++k) {
            const unsigned pos = 255u - (lc[k] & 255u), a = pos >> 4, b = pos & 15u;
            const unsigned ea = ib[a * NTHREADS + F.tid], eb = ib[(16 + b) * NTHREADS + F.tid];
            exs[k] = ea * 128u + eb;
        }
#pragma unroll
        for (int k = 0; k < 16; ++k) { gws[k] = e[k] * inv * TSC[NEXP + exs[k]]; sus[k] = TSC[exs[k]]; }
        { const size_t o = (size_t)tok * 128 + head * 16;
#pragma unroll
          for (int q = 0; q < 2; ++q) { u32x4 w;
#pragma unroll
              for (int j = 0; j < 4; ++j) w[j] = exs[8 * q + 2 * j] | (exs[8 * q + 2 * j + 1] << 16);
              *(u32x4*)(IDX + o + 8 * q) = w; }
#pragma unroll
          for (int q = 0; q < 4; ++q) { *(f32x4*)(GW + o + 4 * q) = (f32x4){gws[4 * q], gws[4 * q + 1], gws[4 * q + 2], gws[4 * q + 3]};
                                        *(f32x4*)(SU + o + 4 * q) = (f32x4){sus[4 * q], sus[4 * q + 1], sus[4 * q + 2], sus[4 * q + 3]}; } }
        asm volatile("s_waitcnt lgkmcnt(0)" ::: "memory");
    }
}

DI float dpp_xor1(float v) { return __builtin_bit_cast(float, __builtin_amdgcn_mov_dpp(__builtin_bit_cast(int, v), 0xB1, 0xF, 0xF, true)); }
DI float dpp_xor2(float v) { return __builtin_bit_cast(float, __builtin_amdgcn_mov_dpp(__builtin_bit_cast(int, v), 0x4E, 0xF, 0xF, true)); }
DI float dpp_hmir(float v) { return __builtin_bit_cast(float, __builtin_amdgcn_mov_dpp(__builtin_bit_cast(int, v), 0x141, 0xF, 0xF, true)); }
DI float dot16_fp8(const u32x4 q, const float (&hx)[16]) {
    f32x2 a = {0.f, 0.f};
#pragma unroll
    for (int j = 0; j < 4; ++j) {
        const f32x2 lo = __builtin_amdgcn_cvt_pk_f32_fp8((int)q[j], false), hi = __builtin_amdgcn_cvt_pk_f32_fp8((int)q[j], true);
        a += lo * (f32x2){hx[4 * j], hx[4 * j + 1]}; a += hi * (f32x2){hx[4 * j + 2], hx[4 * j + 3]};
    }
    return a.x + a.y;
}
#define PEER_EXPERT(id, i) ((int)(((id)[(i) >> 3][((i) >> 1) & 3] >> (16 * ((i) & 1))) & 0xffffu))

DI int dpp_xor1i(int v) { return __builtin_amdgcn_mov_dpp(v, 0xB1, 0xF, 0xF, true); }
DI int dpp_xor2i(int v) { return __builtin_amdgcn_mov_dpp(v, 0x4E, 0xF, 0xF, true); }
DI int dpp_hmiri(int v) { return __builtin_amdgcn_mov_dpp(v, 0x141, 0xF, 0xF, true); }
struct PeerURows { u32x4 q[16]; u32x4 h[2]; };
DI void peer_u_rows(PeerURows& R, const u32x4 (&id)[2], const unsigned char* ut, const unsigned char* hrow) {
    R.h[0] = *(const u32x4*)(hrow); R.h[1] = *(const u32x4*)(hrow + 16);
#pragma unroll
    for (int i = 0; i < 16; ++i) R.q[i] = *(const u32x4*)(ut + (size_t)PEER_EXPERT(id, i) * (D / 2));
}
DI void peer_u_compute(const PeerURows& R, float* part, int lane) {
    int hsum = 0;
#pragma unroll
    for (int g = 0; g < 2; ++g)
#pragma unroll
        for (int j = 0; j < 4; ++j) hsum = __builtin_amdgcn_sdot4((int)R.h[g][j], 0x01010101, hsum, false);
    int d[16];
#pragma unroll
    for (int i = 0; i < 16; ++i) { int a = 0;
#pragma unroll
        for (int dw = 0; dw < 4; ++dw) {
            const unsigned w = R.q[i][dw];
            a = __builtin_amdgcn_sdot4((int)(w & 0x0f0f0f0fu), (int)R.h[dw >> 1][2 * (dw & 1)], a, false);
            a = __builtin_amdgcn_sdot4((int)((w >> 4) & 0x0f0f0f0fu), (int)R.h[dw >> 1][2 * (dw & 1) + 1], a, false);
        }
        d[i] = a - 8 * hsum; }
    const bool b2 = (lane & 4) != 0, b1 = (lane & 2) != 0, b0 = (lane & 1) != 0;
    int k8[8];
#pragma unroll
    for (int i = 0; i < 8; ++i) { const int keep = b2 ? d[8 + i] : d[i], send = b2 ? d[i] : d[8 + i]; k8[i] = keep + dpp_hmiri(send); }
    int k4[4];
#pragma unroll
    for (int i = 0; i < 4; ++i) { const int keep = b1 ? k8[4 + i] : k8[i], send = b1 ? k8[i] : k8[4 + i]; k4[i] = keep + dpp_xor2i(send); }
    f32x2 k2;
    { const int keep0 = b0 ? k4[2] : k4[0], send0 = b0 ? k4[0] : k4[2], keep1 = b0 ? k4[3] : k4[1], send1 = b0 ? k4[1] : k4[3];
      k2.x = (float)(keep0 + dpp_xor1i(send0)); k2.y = (float)(keep1 + dpp_xor1i(send1)); }
    *(f32x2*)(part + 16 * (lane >> 3) + (b2 ? 8 : 0) + (b1 ? 4 : 0) + (b0 ? 2 : 0)) = k2;
}
DI void phase_peer_u(const Params& p, const Frame& F, int l) {
    const int ntok = (l == 0) ? T : TL, lane = F.lane, half = ntok >> 1;
    const int grp = F.bid & 7, cs = grp & 3, th = grp >> 2, sw = (F.bid >> 3) * NWAVES + F.wave, nsw = (F.nb >> 3) * NWAVES;
    const unsigned char* ut = p.ws + WS_UTAB + (size_t)l * NEXP * (D / 2) + 128 * cs + 16 * (lane & 7);
    const unsigned char* Hs = p.ws + WS_H8 + 256 * cs + 32 * (lane & 7);
    const unsigned short* IDXg = (const unsigned short*)(p.ws + WS_IDX) + 16 * (lane >> 3);
    float* PART = (float*)(p.ws + WS_ST) + (size_t)cs * T * 128;
    const int t0 = th * half, tend = t0 + half, last = tend - 1;
    u32x4 sa[2], sb[2]; PeerURows ra, rb;
#define U_SEL(S_, t_) do { const unsigned short* ip_ = IDXg + (size_t)min((t_), last) * 128; S_[0] = *(const u32x4*)ip_; S_[1] = *(const u32x4*)(ip_ + 8); } while (0)
#define U_ROWS(R_, S_, t_) peer_u_rows(R_, S_, ut, Hs + (size_t)min((t_), last) * D)
    U_SEL(sa, t0 + sw); U_SEL(sb, t0 + sw + nsw);
    U_ROWS(ra, sa, t0 + sw);
#pragma unroll 1
    for (int tok = t0 + sw; tok < tend; tok += 2 * nsw) {
        U_SEL(sa, tok + 2 * nsw); U_ROWS(rb, sb, tok + nsw);
        peer_u_compute(ra, PART + (size_t)tok * 128, lane);
        U_SEL(sb, tok + 3 * nsw); U_ROWS(ra, sa, tok + 2 * nsw);
        if (tok + nsw < tend) peer_u_compute(rb, PART + (size_t)(tok + nsw) * 128, lane);
    }
#undef U_SEL
#undef U_ROWS
}
DI void phase_peer_c(const Params& p, const Frame& F, int l, bool dummy = false) {
    const int ntok = (l == 0) ? T : TL;
    const float* PART = (const float*)(p.ws + WS_ST);
    float* GW = (float*)(p.ws + WS_GW);
    float* CO = dummy ? (float*)(p.ws + WS_H8) : GW;
    const float* SU = (const float*)(p.ws + WS_SU);
    const float* HS = (const float*)(p.ws + WS_HS);
    for (int i0 = F.gtid; i0 < ntok * 128; i0 += 4 * F.ngt) {
        float s[4], gw[4], su[4];
#pragma unroll
        for (int u = 0; u < 4; ++u) {
            const int i = min(i0 + u * F.ngt, ntok * 128 - 1);
            s[u] = 0.f;
#pragma unroll
            for (int sl = 0; sl < 4; ++sl) s[u] += PART[(size_t)sl * T * 128 + i];
            gw[u] = GW[i]; su[u] = SU[i] * HS[i >> 7];
        }
#pragma unroll
        for (int u = 0; u < 4; ++u) { const int i = i0 + u * F.ngt; if (i < ntok * 128) CO[i] = gw[u] * gelu_tanh(s[u] * su[u]); }
    }
}
struct PeerVRows { u32x4 q[16]; f32x4 cf[4]; f32x4 xv, gv; };
DI void peer_v_rows(PeerVRows& R, const u32x4 (&id)[2], const unsigned char* vt, const float* cp, const float* xs, const float* gt2) {
    R.cf[0] = *(const f32x4*)cp; R.cf[1] = *(const f32x4*)(cp + 4); R.cf[2] = *(const f32x4*)(cp + 8); R.cf[3] = *(const f32x4*)(cp + 12);
    R.xv = *(const f32x4*)xs; R.gv = *(const f32x4*)gt2;
#pragma unroll
    for (int i = 0; i < 16; ++i) R.q[i] = *(const u32x4*)(vt + (size_t)PEER_EXPERT(id, i) * (D / 2));
}
DI float xchg32(float v, bool hi) { const auto r = __builtin_amdgcn_permlane32_swap(__builtin_bit_cast(unsigned, v), __builtin_bit_cast(unsigned, v), false, false);
    return __builtin_bit_cast(float, hi ? r[0] : r[1]); }
DI float xchg16(float v, bool hi) { const auto r = __builtin_amdgcn_permlane16_swap(__builtin_bit_cast(unsigned, v), __builtin_bit_cast(unsigned, v), false, false);
    return __builtin_bit_cast(float, hi ? r[0] : r[1]); }
DI float xchg8(float v) { return __builtin_bit_cast(float, __builtin_amdgcn_mov_dpp(__builtin_bit_cast(int, v), 0x128, 0xF, 0xF, true)); }
typedef _Float16 h16x2 __attribute__((ext_vector_type(2)));
DI unsigned xchg32u(unsigned v, bool hi) { const auto r = __builtin_amdgcn_permlane32_swap(v, v, false, false); return hi ? r[0] : r[1]; }
DI unsigned xchg16u(unsigned v, bool hi) { const auto r = __builtin_amdgcn_permlane16_swap(v, v, false, false); return hi ? r[0] : r[1]; }
DI unsigned xchg8u(unsigned v) { return (unsigned)__builtin_amdgcn_mov_dpp((int)v, 0x128, 0xF, 0xF, true); }
DI void peer_v_compute(const PeerVRows& R, float* xdst, int lane) {
    h16x2 a[16];
#pragma unroll
    for (int j = 0; j < 16; ++j) a[j] = (h16x2){(_Float16)0.f, (_Float16)0.f};
#pragma unroll
    for (int i = 0; i < 16; ++i) {
        const _Float16 ch = (_Float16)R.cf[i >> 2][i & 3]; const h16x2 c2 = {ch, ch};
#pragma unroll
        for (int d = 0; d < 4; ++d) {
            a[4 * d + 0] += c2 * __builtin_amdgcn_cvt_scalef32_pk_f16_fp4(R.q[i][d], 1.0f, 0);
            a[4 * d + 1] += c2 * __builtin_amdgcn_cvt_scalef32_pk_f16_fp4(R.q[i][d], 1.0f, 1);
            a[4 * d + 2] += c2 * __builtin_amdgcn_cvt_scalef32_pk_f16_fp4(R.q[i][d], 1.0f, 2);
            a[4 * d + 3] += c2 * __builtin_amdgcn_cvt_scalef32_pk_f16_fp4(R.q[i][d], 1.0f, 3);
        }
    }
    const bool b5 = (lane & 32) != 0, b4 = (lane & 16) != 0, b3 = (lane & 8) != 0;
    h16x2 k8[8];
#pragma unroll
    for (int j = 0; j < 8; ++j) { const h16x2 keep = b5 ? a[8 + j] : a[j], send = b5 ? a[j] : a[8 + j];
        k8[j] = keep + __builtin_bit_cast(h16x2, xchg32u(__builtin_bit_cast(unsigned, send), b5)); }
    h16x2 k4[4];
#pragma unroll
    for (int j = 0; j < 4; ++j) { const h16x2 keep = b4 ? k8[4 + j] : k8[j], send = b4 ? k8[j] : k8[4 + j];
        k4[j] = keep + __builtin_bit_cast(h16x2, xchg16u(__builtin_bit_cast(unsigned, send), b4)); }
    h16x2 k2[2];
#pragma unroll
    for (int j = 0; j < 2; ++j) { const h16x2 keep = b3 ? k4[2 + j] : k4[j], send = b3 ? k4[j] : k4[2 + j];
        k2[j] = keep + __builtin_bit_cast(h16x2, xchg8u(__builtin_bit_cast(unsigned, send))); }
    *(f32x4*)xdst = R.xv + R.gv * (f32x4){(float)k2[0].x, (float)k2[0].y, (float)k2[1].x, (float)k2[1].y};
}
DI void phase_peer_v(const Params& p, const Frame& F, int l, bool dummy = false) {
    const int ntok = (l == 0) ? T : TL, lane = F.lane, half = ntok >> 1;
    const int grp = F.bid & 7, cs = grp & 3, th = grp >> 2, sw = (F.bid >> 3) * NWAVES + F.wave, nsw = (F.nb >> 3) * NWAVES;
    const unsigned char* vt = p.ws + WS_VTAB + (size_t)l * NEXP * (D / 2) + 128 * cs + 16 * (lane & 7);
    const unsigned short* IDXg = (const unsigned short*)(p.ws + WS_IDX) + 16 * (lane >> 3);
    const float* CFg = (const float*)(p.ws + WS_GW) + 16 * (lane >> 3);
    const int t0 = th * half, tend = t0 + half, last = tend - 1;
    u32x4 sa[2], sb[2]; PeerVRows ra, rb;
#define V_SEL(S_, t_) do { const unsigned short* ip_ = IDXg + (size_t)min((t_), last) * 128; S_[0] = *(const u32x4*)ip_; S_[1] = *(const u32x4*)(ip_ + 8); } while (0)
    const int co = 256 * cs + 32 * (lane & 7) + ((lane & 32) ? 16 : 0) + ((lane & 16) ? 8 : 0) + ((lane & 8) ? 4 : 0);
#define V_ROWS(R_, S_, t_) do { const int t1_ = min((t_), last); peer_v_rows(R_, S_, vt, CFg + (size_t)t1_ * 128, xrow_ptr(p, t1_) + co, mod_vec(p, l, t1_, 5) + co); } while (0)
#define V_DO(R_, t_) do { const int t2_ = (t_); float* xd_ = (dummy ? (float*)(p.ws + WS_ST) + (size_t)t2_ * D : xrow_ptr(p, t2_)) + co; peer_v_compute(R_, xd_, lane); } while (0)
    V_SEL(sa, t0 + sw); V_SEL(sb, t0 + sw + nsw);
    V_ROWS(ra, sa, t0 + sw);
#pragma unroll 1
    for (int tok = t0 + sw; tok < tend; tok += 2 * nsw) {
        V_SEL(sa, tok + 2 * nsw); V_ROWS(rb, sb, tok + nsw);
        V_DO(ra, tok);
        V_SEL(sb, tok + 3 * nsw); V_ROWS(ra, sa, tok + 2 * nsw);
        if (tok + nsw < tend) V_DO(rb, tok + nsw);
    }
#undef V_SEL
#undef V_ROWS
#undef V_DO
}

#define XB_TMO      128
#define XB_XCNT(j)  (256  + 64 * (j))
#define XB_XSUB(j)  (1280 + 64 * (j))
#define XB_XGEN(j)  (2304 + 64 * (j))
#define XB_TOP      3328
#define XB_TOPGEN   3392
#define XCD_BAR_WORDS 3456
#define XB_SPIN_CAP (1u << 18)
DI unsigned xb_ld(unsigned* p)              { return __hip_atomic_load(p, __ATOMIC_RELAXED, __HIP_MEMORY_SCOPE_AGENT); }
DI unsigned xb_add(unsigned* p, unsigned v) { return __hip_atomic_fetch_add(p, v, __ATOMIC_RELAXED, __HIP_MEMORY_SCOPE_AGENT); }
DI unsigned xb_xcc_id() { return (unsigned)__builtin_amdgcn_s_getreg((3 << 11) | 20) & 0xFu; }
#define XB_SPIN(cond, bar) do { unsigned _sp = 0; while (cond) { __builtin_amdgcn_s_sleep(1); \
    if ((++_sp & 255u) == 0u) { if (xb_ld(&(bar)[XB_TMO])) break; if (_sp > XB_SPIN_CAP) { atomicAdd(&(bar)[XB_TMO], 1u); break; } } } } while (0)
struct XcdBarrier { unsigned* bar; unsigned x; volatile LAS unsigned* st; };
DI XcdBarrier xcd_barrier_post(unsigned* bar, volatile LAS unsigned* st) {
    XcdBarrier b; b.bar = bar; b.x = xb_xcc_id(); b.st = st;
    if (threadIdx.x == 0) (void)xb_add(&bar[XB_XCNT(b.x)], 1u);
    return b;
}
DI void xcd_barrier_complete(unsigned* bar, unsigned x, unsigned& nloc, unsigned& nx) {
    const unsigned G = gridDim.x * gridDim.y * gridDim.z;
    unsigned sum, cnt, mine, sp = 0u;
    for (;;) {
        sum = 0u; cnt = 0u; mine = 0u;
#pragma unroll
        for (unsigned j = 0; j < 16; ++j) { const unsigned c = xb_ld(&bar[XB_XCNT(j)]); sum += c; cnt += (c > 0u) ? 1u : 0u; mine = (j == x) ? c : mine; }
        if (sum == G) break;
        __builtin_amdgcn_s_sleep(1);
        if ((++sp & 255u) == 0u) { if (xb_ld(&bar[XB_TMO])) break; if (sp > XB_SPIN_CAP) { atomicAdd(&bar[XB_TMO], 1u); break; } }
    }
    nloc = mine > 0u ? mine : 1u; nx = cnt > 0u ? cnt : 1u;
}
DI void xcd_barrier(const XcdBarrier& b) {
    asm volatile("s_waitcnt vmcnt(0)" ::: "memory");
    __syncthreads();
    if (threadIdx.x == 0) {
        unsigned* bar = b.bar;
        __builtin_amdgcn_s_waitcnt(0);
        unsigned nloc = b.st[0], nx = b.st[1];
        if (nloc == 0u) { xcd_barrier_complete(bar, b.x, nloc, nx); b.st[0] = nloc; b.st[1] = nx; }
        const unsigned old = xb_add(&bar[XB_XSUB(b.x)], 1u);
        const unsigned gen = old / nloc;
        if (old + 1u == (gen + 1u) * nloc) {
            __builtin_amdgcn_fence(__ATOMIC_RELEASE, "agent");
            asm volatile("s_waitcnt vmcnt(0)" ::: "memory");
            const unsigned og = xb_add(&bar[XB_TOP], 1u);
            const unsigned tg = og / nx;
            if (og + 1u == (tg + 1u) * nx) xb_add(&bar[XB_TOPGEN], 1u);
            else XB_SPIN(xb_ld(&bar[XB_TOPGEN]) == tg, bar);
            __builtin_amdgcn_fence(__ATOMIC_ACQUIRE, "agent");
            xb_add(&bar[XB_XGEN(b.x)], 1u);
            asm volatile("s_waitcnt vmcnt(0)" ::: "memory");
        } else {
            XB_SPIN(xb_ld(&bar[XB_XGEN(b.x)]) == gen, bar);
            __builtin_amdgcn_fence(__ATOMIC_ACQUIRE, "agent");
            asm volatile("s_waitcnt vmcnt(0)" ::: "memory");
        }
    }
    __syncthreads();
}

constexpr int NPHASE = 25;
template <int PH> DI void run_phase(const Params& p, const Frame& F) {
    if constexpr (PH == 0) phase_prep(p, F);
    else if constexpr (PH == 1) phase_norm(p, F, 0, 0, true, T);
    else if constexpr (PH == 2) phase_g1(p, F, 0);
    else if constexpr (PH == 3) phase_mix(p, F, 0);
    else if constexpr (PH == 4) phase_g2(p, F, 0);
    else if constexpr (PH == 5) phase_g2sum(p, F);
    else if constexpr (PH == 6) phase_g3(p, F, 0);
    else if constexpr (PH == 7) phase_norm(p, F, 0, 1, false, T);
    else if constexpr (PH == 8) phase_g45(p, F, 0);
    else if constexpr (PH == 9) phase_sel(p, F, 0);
    else if constexpr (PH == 10) phase_peer_u(p, F, 0);
    else if constexpr (PH == 11) phase_peer_c(p, F, 0);
    else if constexpr (PH == 12) phase_peer_v(p, F, 0);
    else if constexpr (PH == 13) phase_norm(p, F, 1, 0, false, T);
    else if constexpr (PH == 14) phase_g1(p, F, 1);
    else if constexpr (PH == 15) phase_mix(p, F, 1);
    else if constexpr (PH == 16) phase_g2(p, F, 1);
    else if constexpr (PH == 17) phase_g3(p, F, 1);
    else if constexpr (PH == 18) phase_norm(p, F, 1, 1, false, TL);
    else if constexpr (PH == 19) phase_g45(p, F, 1);
    else if constexpr (PH == 20) phase_sel(p, F, 1);
    else if constexpr (PH == 21) phase_peer_u(p, F, 1);
    else if constexpr (PH == 22) phase_peer_c(p, F, 1);
    else if constexpr (PH == 23) phase_peer_v(p, F, 1);
    else if constexpr (PH == 24) phase_final(p, F);
}
DI Frame make_frame(unsigned char* lds_raw) {
    Frame F;
    F.lds = (LAS unsigned char*)lds_raw;
    int tid = threadIdx.x; asm volatile("" : "+v"(tid));
    int bid = blockIdx.x, nb = gridDim.x; asm volatile("" : "+s"(bid), "+s"(nb));
    F.tid = tid; F.lane = tid & 63; F.wave = __builtin_amdgcn_readfirstlane(tid >> 6); F.bid = bid; F.nb = nb;
    F.gw = bid * NWAVES + F.wave; F.ngw = nb * NWAVES; F.gtid = bid * NTHREADS + tid; F.ngt = nb * NTHREADS;
    return F;
}
template <int PH> DI void run_phase_fresh(unsigned char* lds_raw) {
#if defined(__HIP_DEVICE_COMPILE__)
    const __attribute__((address_space(4))) unsigned long long* pp = (const __attribute__((address_space(4))) unsigned long long*)__builtin_amdgcn_kernarg_segment_ptr();
    asm volatile("" : "+s"(pp));
    Params p;
#pragma unroll
    for (int i = 0; i < N_IN; ++i) p.in[i] = (const float*)(const __attribute__((address_space(1))) float*)pp[i];
    p.out = (float*)(__attribute__((address_space(1))) float*)pp[N_IN]; p.ws = (unsigned char*)(__attribute__((address_space(1))) unsigned char*)pp[N_IN + 1]; p.ph_lo = 0; p.ph_hi = 0;
#else
    Params p{};
#endif
    const Frame F = make_frame(lds_raw);
    run_phase<PH>(p, F);
}
template <int PH> __global__ void __launch_bounds__(NTHREADS, 2) phase_kernel(Params p) {
    extern __shared__ __attribute__((aligned(16))) unsigned char lds_raw[];
    run_phase_fresh<PH>(lds_raw);
}
template <int PH> DI void run_all(unsigned char* lds_raw, cg::grid_group& grid, const XcdBarrier& bar) {
    if constexpr (PH < NPHASE) {
        if constexpr (PH == PROBE_PH) {
            if constexpr (PH == 11 || PH == 22 || PH == 12 || PH == 23) {
#if defined(__HIP_DEVICE_COMPILE__)
                const __attribute__((address_space(4))) unsigned long long* pp = (const __attribute__((address_space(4))) unsigned long long*)__builtin_amdgcn_kernarg_segment_ptr();
                asm volatile("" : "+s"(pp));
                Params p;
#pragma unroll
                for (int i = 0; i < N_IN; ++i) p.in[i] = (const float*)(const __attribute__((address_space(1))) float*)pp[i];
                p.out = (float*)(__attribute__((address_space(1))) float*)pp[N_IN]; p.ws = (unsigned char*)(__attribute__((address_space(1))) unsigned char*)pp[N_IN + 1]; p.ph_lo = 0; p.ph_hi = 0;
                const Frame F = make_frame(lds_raw);
                if constexpr (PH == 11 || PH == 22) phase_peer_c(p, F, PH == 11 ? 0 : 1, true); else phase_peer_v(p, F, PH == 12 ? 0 : 1, true);
#endif
            } else run_phase_fresh<PH>(lds_raw);
            xcd_barrier(bar);
        }
        run_phase_fresh<PH>(lds_raw);
        if constexpr (PH + 1 < NPHASE) { xcd_barrier(bar); if constexpr (PROBE_SYNC) xcd_barrier(bar); }
        run_all<PH + 1>(lds_raw, grid, bar);
    }
}
__global__ void __launch_bounds__(NTHREADS, 2) mega(Params p) {
    extern __shared__ __attribute__((aligned(16))) unsigned char lds_raw[];
    cg::grid_group grid = cg::this_grid();
    volatile LAS unsigned* st = (volatile LAS unsigned*)((LAS unsigned char*)lds_raw + LDS_BAR_OFF);
    if (threadIdx.x < 2) st[threadIdx.x] = 0u;
    __syncthreads();
    const XcdBarrier bar = xcd_barrier_post((unsigned*)(p.ws + WS_CTL), st);
    if (p.ph_lo != 0) grid.sync();
    run_all<0>(lds_raw, grid, bar);
}

extern "C" void kernel_launch(void* const* d_in, const int* in_sizes, int n_in, void* d_out, int out_size, void* d_ws, size_t ws_size, hipStream_t stream) {
    static int grid = 0;
    if (grid == 0) {
        if (n_in != 23 || out_size != TL * D || ws_size < WS_END) { fprintf(stderr, "kernel_launch: unexpected shapes (n_in %d out %d ws %zu)\n", n_in, out_size, ws_size); grid = -1; return; }
        int dev = 0, cus = 0, per_cu = 0;
        (void)hipGetDevice(&dev);
        (void)hipDeviceGetAttribute(&cus, hipDeviceAttributeMultiprocessorCount, dev);
        (void)hipFuncSetAttribute((const void*)mega, hipFuncAttributeMaxDynamicSharedMemorySize, LDS_BYTES);
        (void)hipOccupancyMaxActiveBlocksPerMultiprocessor(&per_cu, (const void*)mega, NTHREADS, LDS_BYTES);
        if (per_cu < 1) { fprintf(stderr, "kernel_launch: occupancy query reports %d blocks per CU\n", per_cu); grid = -1; return; }
        grid = cus & ~7;
        if (grid < 8) { fprintf(stderr, "kernel_launch: needs at least 8 CUs\n"); grid = -1; return; }
    }
    if (grid < 0) return;
    (void)hipMemsetAsync((char*)d_ws + WS_CTL, 0, CTL_ZERO_BYTES, stream);
    Params p{};
    for (int i = 0; i < N_IN; ++i) p.in[i] = (const float*)d_in[i];
    p.out = (float*)d_out; p.ws = (unsigned char*)d_ws;
    void* args[] = {&p};
    hipError_t e = hipLaunchCooperativeKernel((const void*)mega, dim3(grid), dim3(NTHREADS), args, LDS_BYTES, stream);
    if (e != hipSuccess) fprintf(stderr, "cooperative launch failed: %s (grid %d)\n", hipGetErrorString(e), grid);
}
```

```cpp
#include <hip/hip_runtime.h>
#include <hip/hip_cooperative_groups.h>
#include <stdint.h>
#include <stdio.h>
namespace cg = cooperative_groups;

#ifndef PROBE_PH
#define PROBE_PH -1
#endif
#ifndef PROBE_SYNC
#define PROBE_SYNC 0
#endif
#ifndef MK_SINGLE
#define MK_SINGLE 0
#endif

#define LAS __attribute__((address_space(3)))
typedef unsigned short bf16_t;
typedef short bf16x8 __attribute__((ext_vector_type(8)));
typedef short s16x4 __attribute__((ext_vector_type(4)));
typedef float f32x4 __attribute__((ext_vector_type(4)));
typedef float f32x2 __attribute__((ext_vector_type(2)));
typedef float f32x16 __attribute__((ext_vector_type(16)));
typedef unsigned u32x4 __attribute__((ext_vector_type(4)));
typedef unsigned u32x2 __attribute__((ext_vector_type(2)));
typedef __bf16 bf16x2_t __attribute__((ext_vector_type(2)));
typedef _Float16 f16x2_t __attribute__((ext_vector_type(2)));
#define DI __device__ __forceinline__
DI unsigned pkh2(float lo, float hi) { f16x2_t v = {(_Float16)lo, (_Float16)hi}; return __builtin_bit_cast(unsigned, v); }
#define MFMA32(a, b, c) __builtin_amdgcn_mfma_f32_32x32x16_bf16((a), (b), (c), 0, 0, 0)

constexpr int D = 1024, NB = 8, SEQ = 4096, NCTX = 256, DEPTH = 2;
constexpr int TL = NB * SEQ, TC = NB * NCTX, T = TL + TC;
constexpr int INW = 4608, NMOD = 6 * D, PW = 1600, PN = 1536;
constexpr int VTS = SEQ + 64;
constexpr int QOFF = 0, KOFF = 512, VOFF = 640, POOLOFF = 768, SUOFF = 1024, SVOFF = 1280, GATEOFF = 1536;
constexpr int NEXP = 16384;
constexpr float EPS = 1e-6f;
constexpr float LOG2E = 1.4426950408889634f;
constexpr float QSCALE = 0.125f * LOG2E;

constexpr size_t MiB = 1u << 20;
constexpr size_t WS_CTL = 0, WS_MOD = 1 * MiB, CTL_ZERO_BYTES = 2 * MiB;
constexpr size_t WS_ROPE = 2 * MiB, WS_SGUW = 2 * MiB + 65536, WS_TSCALE = 3 * MiB;
constexpr size_t WS_WIN = 4 * MiB, WS_WBR = 22 * MiB, WS_WOUT = 26 * MiB, WS_WFOLD = 30 * MiB;
constexpr size_t WS_XCTX = 38 * MiB, WS_UTAB = 46 * MiB, WS_VTAB = 78 * MiB;
constexpr size_t WS_IDX = 110 * MiB, WS_GW = 120 * MiB;
constexpr size_t WS_H = 142 * MiB;
constexpr size_t WS_P = 210 * MiB, WS_Y = 318 * MiB, WS_MERGED = 386 * MiB, WS_VT = 454 * MiB, WS_VTC = 463 * MiB, WS_VST = 464 * MiB;
constexpr size_t WS_MP = 482 * MiB;
constexpr size_t WS_ST = 210 * MiB, WS_H8 = 346 * MiB, WS_HS = 380 * MiB, WS_SU = 482 * MiB;
constexpr size_t WS_END = 512 * MiB;
static_assert(WS_ST + (size_t)2048 * T * 2 <= WS_H8 && WS_H8 + (size_t)T * D <= WS_HS, "ST / H8 fit");
static_assert(WS_VST + (size_t)272 * 256 * 128 * 2 <= WS_SU && WS_VT + (size_t)NB * 2 * 64 * VTS * 2 <= WS_VTC, "VsT / VT fit");
static_assert(WS_H + (size_t)T * D * 2 <= WS_P, "H fits");
static_assert(WS_P + (size_t)T * PW * 2 <= WS_Y && WS_Y + (size_t)T * D * 2 <= WS_MERGED && WS_MERGED + (size_t)T * D * 2 <= WS_VT, "P/Y/MERGED fit");
static_assert(WS_IDX + (size_t)T * 128 * 2 <= WS_GW && WS_GW + (size_t)T * 128 * 4 <= WS_H && WS_SU + (size_t)T * 128 * 4 <= WS_END && WS_HS + (size_t)T * 4 <= WS_SU, "idx/gw/su fit");

constexpr int LDS_BYTES = 163840;
constexpr int LDS_BAR_OFF = LDS_BYTES - 64;
constexpr int NTHREADS = 512, NWAVES = 8;

enum { I_x, I_c, I_ctx, I_c_ctx, I_w_mod, I_b_mod, I_g_mix, I_g_ffn, I_w_in, I_attn_sink, I_pool_w, I_pool_scale, I_sgu_w, I_sgu_b, I_w_br_attn, I_w_br_pool, I_w_br_sgu, I_w_out, I_peer_wq, I_peer_subkeys, I_peer_u, I_peer_v, I_g_final, N_IN };
struct Params {
    const float* in[N_IN];
    float* out; unsigned char* ws;
    int ph_lo, ph_hi;
};

DI unsigned pk2(float lo, float hi) { f32x2 v = {lo, hi}; return __builtin_bit_cast(unsigned, __builtin_convertvector(v, bf16x2_t)); }
DI unsigned f2bf(float f) { return pk2(f, 0.f) & 0xffffu; }
DI float bf2f(unsigned short u) { return __builtin_bit_cast(float, (unsigned)u << 16); }
DI float bflo(unsigned w) { return __builtin_bit_cast(float, w << 16); }
DI float bfhi(unsigned w) { return __builtin_bit_cast(float, w & 0xffff0000u); }
DI int crow(int reg, int h) { return (reg & 3) + 8 * (reg >> 2) + 4 * h; }
DI int dpp_x1(int v) { return __builtin_amdgcn_mov_dpp(v, 0xB1, 0xF, 0xF, true); }
DI float wave_sum(float v) {
#pragma unroll
    for (int o = 1; o < 64; o <<= 1) v += __shfl_xor(v, o);
    return v;
}
DI float sigmoidf_(float x) { return __builtin_amdgcn_rcpf(1.0f + __expf(-x)); }
DI float gelu_tanh(float x) { const float u = 0.7978845608028654f * (x + 0.044715f * x * x * x); return x * __builtin_amdgcn_rcpf(1.0f + __expf(-2.0f * u)); }
DI float silu_(float x) { return x * __builtin_amdgcn_rcpf(1.0f + __expf(-x)); }

struct Frame {
    int tid, lane, wave, gw, ngw, gtid, ngt, bid, nb;
    LAS unsigned char* lds;
};

template <int NM, int NN>
DI void wave_gemm(const bf16_t* __restrict__ A, int lda, const bf16_t* __restrict__ Bt, int ldb, int K, int m0, int n0, f32x16 (&acc)[NM][NN], int lane) {
    const int r = lane & 31, h = lane >> 5;
    const bf16_t* ap = A + (size_t)(m0 + r) * lda + 8 * h;
    const bf16_t* bp = Bt + (size_t)(n0 + r) * ldb + 8 * h;
    for (int k0 = 0; k0 < K; k0 += 64) {
        bf16x8 a[4][NM], b[4][NN];
#pragma unroll
        for (int s = 0; s < 4; ++s) {
#pragma unroll
            for (int i = 0; i < NM; ++i) a[s][i] = *(const bf16x8*)(ap + (size_t)(32 * i) * lda + k0 + 16 * s);
#pragma unroll
            for (int j = 0; j < NN; ++j) b[s][j] = *(const bf16x8*)(bp + (size_t)(32 * j) * ldb + k0 + 16 * s);
        }
#pragma unroll
        for (int s = 0; s < 4; ++s)
#pragma unroll
            for (int i = 0; i < NM; ++i)
#pragma unroll
                for (int j = 0; j < NN; ++j) acc[i][j] = MFMA32(a[s][i], b[s][j], acc[i][j]);
    }
}
template <int NM, int NN> DI void zero_acc(f32x16 (&acc)[NM][NN]) {
#pragma unroll
    for (int i = 0; i < NM; ++i)
#pragma unroll
        for (int j = 0; j < NN; ++j)
#pragma unroll
            for (int r = 0; r < 16; ++r) acc[i][j][r] = 0.f;
}

namespace pg8 {
constexpr int BM = 256, BK = 64, HALF = 128, HTB = HALF * BK * 2, STAGE_BYTES = 8 * HTB, NXCD = 8, WGM = 8, LD = 1024;
DI int lds_byte(int r, int c) { const int st = (r >> 4) * 2 + (c >> 5), rr = r & 15, cc = c & 31, ob = rr * 64 + cc * 2; return st * 1024 + (ob ^ (((ob >> 9) & 1) << 5)); }
DI void stage_rc(int b, int& R, int& C) { const int st = b / 1024, sb = b % 1024, swz = sb ^ (((sb >> 9) & 1) << 5); R = (st >> 1) * 16 + swz / 64; C = (st & 1) * 32 + (swz % 64) / 2; }
DI int perm32(int rho) { const int n = rho >> 4, i = rho & 15; return 8 * (i >> 2) + 4 * n + (i & 3); }
struct Unit { int pm, pn, sub, nt, mode; const char* a; const char* b; };
DI void tile_of(int L, int nM, int nN, int& pm, int& pn) {
    const int nwg = nM * nN; int wgid = L;
    { const int q = nwg / NXCD, r = nwg % NXCD, xcd = wgid % NXCD, off = wgid / NXCD; wgid = (xcd < r ? xcd * (q + 1) : r * (q + 1) + (xcd - r) * q) + off; }
    const int nig = WGM * nN, gid = wgid / nig, fm = gid * WGM, gsz = (nM - fm) < WGM ? (nM - fm) : WGM;
    pm = fm + ((wgid % nig) % gsz); pn = (wgid % nig) / gsz;
}
template <class Epi, class Sched>
DI void gemm_phase(LAS unsigned char* lds, const int tid, const Sched& S, const Epi& E) {
    const int wid = __builtin_amdgcn_readfirstlane(tid >> 6), lane = tid & 63, wr = wid >> 2, wc = wid & 3, fr = lane & 15, fq = lane >> 4;
    unsigned voffA[2], voffB[2];
#pragma unroll
    for (int i = 0; i < 2; ++i) { int R, C; stage_rc(tid * 16 + i * 8192, R, C); const int Rb = Epi::PERM ? ((R & ~31) + perm32(R & 31)) : R;
        voffA[i] = (unsigned)(R * LD + C) * 2u; voffB[i] = (unsigned)(Rb * LD + C) * 2u; }
    const size_t kstep = (size_t)(BK * 2);
    const size_t hstep = (size_t)HALF * LD * 2;
    const unsigned ldsw = (unsigned)wid * 1024u;
    const int aoff = lds_byte(wr * 64 + fr, fq * 8), boff = lds_byte(wc * 32 + fr, fq * 8);
#define PG8_SA(b, h) (((b) * 2 + (h)) * HTB)
#define PG8_SB(b, h) ((4 + (b) * 2 + (h)) * HTB)
#define PG8_STAGE(bufoff, gbase, voff) do { _Pragma("unroll") for (int _i = 0; _i < 2; ++_i) \
        __builtin_amdgcn_global_load_lds((const unsigned*)((const char*)(gbase) + (voff)[_i]), (LAS unsigned*)(lds + (bufoff) + ldsw + _i * 8192), 16, 0, 0); } while (0)
#define PG8_LDA(dst, b, h) do { _Pragma("unroll") for (int m = 0; m < 4; ++m) _Pragma("unroll") for (int k = 0; k < 2; ++k) dst[m][k] = *(const LAS bf16x8*)(lds + PG8_SA(b, h) + aoff + m * 2048 + k * 1024); } while (0)
#define PG8_LDB(dst, b, h) do { _Pragma("unroll") for (int n = 0; n < 2; ++n) _Pragma("unroll") for (int k = 0; k < 2; ++k) dst[n][k] = *(const LAS bf16x8*)(lds + PG8_SB(b, h) + boff + n * 2048 + k * 1024); } while (0)
#define PG8_MMA(ai, bj, At, Bt) do { __builtin_amdgcn_s_setprio(1); _Pragma("unroll") for (int m = 0; m < 4; ++m) _Pragma("unroll") for (int n = 0; n < 2; ++n) _Pragma("unroll") for (int k = 0; k < 2; ++k) \
        acc[ai][bj][m][n] = __builtin_amdgcn_mfma_f32_16x16x32_bf16(Bt[n][k], At[m][k], acc[ai][bj][m][n], 0, 0, 0); __builtin_amdgcn_s_setprio(0); } while (0)
#define PG8_WAIT_V(n) asm volatile("s_waitcnt vmcnt(" #n ")" ::: "memory")
#define PG8_WAIT_L(n) asm volatile("s_waitcnt lgkmcnt(" #n ")" ::: "memory")
#define PG8_BAR __builtin_amdgcn_s_barrier()
#define PG8_SCHED __builtin_amdgcn_sched_barrier(0)
    Unit cur, nxt; int ui = 0;
    if (!S.next(0, cur)) return;
    f32x4 acc[2][2][4][2];
#pragma unroll
    for (int a = 0; a < 2; ++a)
#pragma unroll
        for (int b = 0; b < 2; ++b)
#pragma unroll
            for (int m = 0; m < 4; ++m)
#pragma unroll
                for (int n = 0; n < 2; ++n) acc[a][b][m][n] = (f32x4){0.f, 0.f, 0.f, 0.f};
    bf16x8 At[4][2], B0[2][2], B1[2][2];
    const char* cA = cur.a; const char* cB = cur.b;
    PG8_STAGE(PG8_SB(0, 0), cB, voffB); PG8_STAGE(PG8_SB(0, 1), cB + hstep, voffB); PG8_STAGE(PG8_SA(0, 0), cA, voffA); PG8_STAGE(PG8_SA(0, 1), cA + hstep, voffA);
    if (wr == 1) PG8_BAR;
    PG8_WAIT_V(2); PG8_BAR;
    PG8_STAGE(PG8_SB(1, 0), cB + kstep, voffB); PG8_STAGE(PG8_SA(1, 0), cA + kstep, voffA); PG8_STAGE(PG8_SB(1, 1), cB + hstep + kstep, voffB);
    PG8_WAIT_V(6); PG8_BAR;
    for (;;) {
        const bool has_next = S.next(ui + 1, nxt);
        const char* nA = has_next ? nxt.a : cA; const char* nB = has_next ? nxt.b : cB;
        const int nt = cur.nt;
        for (int t = 0; t < nt; t += 2) {
            const bool last = (t == nt - 2);
            const char* a1 = cA + (size_t)(t + 1) * kstep;
            const char* a2 = last ? nA : cA + (size_t)(t + 2) * kstep; const char* b2 = last ? nB : cB + (size_t)(t + 2) * kstep;
            const char* a3 = a2 + kstep; const char* b3 = b2 + kstep;
            PG8_LDB(B0, 0, 0); PG8_LDB(B1, 0, 1); PG8_SCHED; PG8_LDA(At, 0, 0); PG8_STAGE(PG8_SA(1, 1), a1 + hstep, voffA);
            PG8_WAIT_V(8); PG8_WAIT_L(0); PG8_BAR; PG8_MMA(0, 0, At, B0); PG8_MMA(0, 1, At, B1); PG8_BAR; PG8_SCHED;
            PG8_LDA(At, 0, 1); PG8_STAGE(PG8_SB(0, 0), b2, voffB); PG8_STAGE(PG8_SB(0, 1), b2 + hstep, voffB); PG8_STAGE(PG8_SA(0, 0), a2, voffA);
            PG8_WAIT_V(8); PG8_WAIT_L(0); PG8_BAR; PG8_MMA(1, 0, At, B0); PG8_MMA(1, 1, At, B1); PG8_BAR; PG8_SCHED;
            PG8_LDB(B0, 1, 0); PG8_LDB(B1, 1, 1); PG8_SCHED; PG8_LDA(At, 1, 0); PG8_STAGE(PG8_SA(0, 1), a2 + hstep, voffA);
            PG8_WAIT_V(8); PG8_WAIT_L(0); PG8_BAR; PG8_MMA(0, 0, At, B0); PG8_MMA(0, 1, At, B1); PG8_BAR; PG8_SCHED;
            PG8_LDA(At, 1, 1); PG8_STAGE(PG8_SB(1, 0), b3, voffB); PG8_STAGE(PG8_SB(1, 1), b3 + hstep, voffB); PG8_STAGE(PG8_SA(1, 0), a3, voffA);
            PG8_WAIT_V(8); PG8_WAIT_L(0); PG8_BAR; PG8_MMA(1, 0, At, B0); PG8_MMA(1, 1, At, B1); PG8_BAR; PG8_SCHED;
        }
        if (wr == 0) PG8_BAR;
        E(acc, cur, wr, wc, fr, fq);
        if (!has_next) break;
        if (!E.keeps(cur)) {
#pragma unroll
        for (int a = 0; a < 2; ++a)
#pragma unroll
            for (int b = 0; b < 2; ++b)
#pragma unroll
                for (int m = 0; m < 4; ++m)
#pragma unroll
                    for (int n = 0; n < 2; ++n) acc[a][b][m][n] = (f32x4){0.f, 0.f, 0.f, 0.f};
        }
        cur = nxt; cA = nA; cB = nB; ++ui;
        if (wr == 1) PG8_BAR;
    }
    PG8_WAIT_V(0);
    PG8_BAR;
#undef PG8_SA
#undef PG8_SB
#undef PG8_STAGE
#undef PG8_LDA
#undef PG8_LDB
#undef PG8_MMA
#undef PG8_WAIT_V
#undef PG8_WAIT_L
#undef PG8_BAR
#undef PG8_SCHED
}
}

DI void transpose_item(const float* W, int K, int N, bf16_t* WT, int ldd, int row_off, int col_off, LAS float* scr, int item, int lane) {
    const int nblk = N / 32, kb = item / nblk, nb = item % nblk, k0 = 64 * kb, n0 = 32 * nb;
#pragma unroll 8
    for (int i = 0; i < 32; ++i) { const int kk = 2 * i + (lane >> 5); scr[kk * 33 + (lane & 31)] = W[(size_t)(k0 + kk) * N + n0 + (lane & 31)]; }
    asm volatile("s_waitcnt lgkmcnt(0)" ::: "memory");
    const int c = lane & 7;
#pragma unroll
    for (int j = 0; j < 4; ++j) { const int n = (lane >> 3) + 8 * j; const LAS float* s = scr + (8 * c) * 33 + n;
        u32x4 o; o.x = pk2(s[0 * 33], s[1 * 33]); o.y = pk2(s[2 * 33], s[3 * 33]); o.z = pk2(s[4 * 33], s[5 * 33]); o.w = pk2(s[6 * 33], s[7 * 33]);
        *(u32x4*)(WT + (size_t)(row_off + n0 + n) * ldd + col_off + k0 + 8 * c) = o; }
    asm volatile("s_waitcnt lgkmcnt(0)" ::: "memory");
}

DI void convert_tables(const Params& p, const Frame& F) {
    for (int it0 = 4 * F.gw; it0 < 4 * NEXP; it0 += 4 * F.ngw) {
        f32x4 v[4][4];
#pragma unroll
        for (int u = 0; u < 4; ++u) {
            const int it = it0 + u, e = it & (NEXP - 1), tbl = (it >> 14) & 1, l = it >> 15;
            const f32x4* src = (const f32x4*)((tbl ? p.in[I_peer_v] : p.in[I_peer_u]) + ((size_t)l * NEXP + e) * D) + 4 * F.lane;
#pragma unroll
            for (int j = 0; j < 4; ++j) v[u][j] = src[j];
        }
#pragma unroll
        for (int u = 0; u < 4; ++u) {
            const int it = it0 + u, e = it & (NEXP - 1), tbl = (it >> 14) & 1, l = it >> 15;
            float am = 0.f;
#pragma unroll
            for (int j = 0; j < 4; ++j) am = fmaxf(am, fmaxf(fmaxf(fabsf(v[u][j].x), fabsf(v[u][j].y)), fmaxf(fabsf(v[u][j].z), fabsf(v[u][j].w))));
#pragma unroll
            for (int o = 1; o < 64; o <<= 1) am = fmaxf(am, __shfl_xor(am, o));
            float sc;
            if (tbl) sc = (am > 0.f) ? 6.0f / am : 1.0f;
            else {
                float ss = 0.f;
#pragma unroll
                for (int j = 0; j < 4; ++j) ss += v[u][j].x * v[u][j].x + v[u][j].y * v[u][j].y + v[u][j].z * v[u][j].z + v[u][j].w * v[u][j].w;
                const float rms = sqrtf(wave_sum(ss) * (1.0f / D));
                const float step = fminf(am * (1.0f / 7.0f), 0.41f * rms);
                sc = (step > 0.f) ? 1.0f / step : 1.0f;
            }
            if (tbl) {
                u32x2 q4;
#pragma unroll
                for (int d = 0; d < 2; ++d) { unsigned w = 0;
                    w = __builtin_amdgcn_cvt_scalef32_pk_fp4_f32(w, v[u][2 * d][0] * sc, v[u][2 * d][1] * sc, 1.0f, 0);
                    w = __builtin_amdgcn_cvt_scalef32_pk_fp4_f32(w, v[u][2 * d][2] * sc, v[u][2 * d][3] * sc, 1.0f, 1);
                    w = __builtin_amdgcn_cvt_scalef32_pk_fp4_f32(w, v[u][2 * d + 1][0] * sc, v[u][2 * d + 1][1] * sc, 1.0f, 2);
                    w = __builtin_amdgcn_cvt_scalef32_pk_fp4_f32(w, v[u][2 * d + 1][2] * sc, v[u][2 * d + 1][3] * sc, 1.0f, 3);
                    q4[d] = w; }
                *(u32x2*)(p.ws + WS_VTAB + ((size_t)l * NEXP + e) * (D / 2) + 8 * F.lane) = q4;
            } else {
                u32x2 q4;
#pragma unroll
                for (int d = 0; d < 2; ++d) { unsigned w = 0;
#pragma unroll
                    for (int b = 0; b < 4; ++b) { const int j = 2 * d + (b >> 1), e2 = 2 * (b & 1);
                        const int n0 = (int)fminf(fmaxf(__builtin_rintf(v[u][j][e2] * sc), -8.0f), 7.0f) + 8, n1 = (int)fminf(fmaxf(__builtin_rintf(v[u][j][e2 + 1] * sc), -8.0f), 7.0f) + 8;
                        w |= (unsigned)(n0 | (n1 << 4)) << (8 * b); }
                    q4[d] = w; }
                *(u32x2*)(p.ws + WS_UTAB + ((size_t)l * NEXP + e) * (D / 2) + 8 * F.lane) = q4;
            }
            if (F.lane == 0) ((float*)(p.ws + WS_TSCALE))[(l * 2 + tbl) * NEXP + e] = 1.0f / sc;
        }
    }
}

DI void phase_prep(const Params& p, const Frame& F) {
    unsigned char* ws = p.ws;
    {
        LAS float* wq = (LAS float*)F.lds;
        LAS float* skl = wq + 128 * 65;
        for (int it = F.bid; it < 2 * 16 * 16; it += F.nb) {
            const int cc = it & 15, hp = (it >> 4) & 15, l = it >> 8;
            const float* src = p.in[I_peer_wq] + (size_t)l * D * 2048 + hp * 128;
            const float* sks = p.in[I_peer_subkeys] + (size_t)(l * 16 + hp) * 128 * 128;
            __syncthreads();
            { float tw[16]; f32x4 ts[8];
#pragma unroll
              for (int it = 0; it < 16; ++it) { const int e = F.tid + it * NTHREADS, ci = e >> 7, d = e & 127; tw[it] = src[(size_t)(cc * 64 + ci) * 2048 + d]; }
#pragma unroll
              for (int it = 0; it < 8; ++it) { const int e = F.tid + it * NTHREADS, key = e >> 5, d4 = (e & 31) * 4; ts[it] = *(const f32x4*)(sks + key * 128 + d4); }
#pragma unroll
              for (int it = 0; it < 16; ++it) { const int e = F.tid + it * NTHREADS, ci = e >> 7, d = e & 127; wq[d * 65 + ci] = tw[it]; }
#pragma unroll
              for (int it = 0; it < 8; ++it) { const int e = F.tid + it * NTHREADS, key = e >> 5, d4 = (e & 31) * 4; *(LAS f32x4*)(skl + key * 132 + d4) = ts[it]; } }
            __syncthreads();
            const int ci = F.tid & 63, kg = F.tid >> 6;
            float acc[16];
#pragma unroll
            for (int k = 0; k < 16; ++k) acc[k] = 0.f;
#pragma unroll 2
            for (int d = 0; d < 128; d += 4) {
                const float w0 = wq[d * 65 + ci], w1 = wq[(d + 1) * 65 + ci], w2 = wq[(d + 2) * 65 + ci], w3 = wq[(d + 3) * 65 + ci];
#pragma unroll
                for (int k = 0; k < 16; ++k) { const f32x4 s = *(const LAS f32x4*)(skl + (16 * kg + k) * 132 + d); acc[k] += w0 * s.x + w1 * s.y + w2 * s.z + w3 * s.w; }
            }
            bf16_t* dst = (bf16_t*)(ws + WS_WFOLD) + ((size_t)l * 2048 + hp * 128 + 16 * kg) * D + cc * 64 + ci;
#pragma unroll
            for (int k = 0; k < 16; ++k) dst[(size_t)k * D] = (bf16_t)f2bf(acc[k]);
        }
        __syncthreads();
    }
    {
        LAS float* scr = (LAS float*)(F.lds + F.wave * 16384);
        constexpr int I_IN = (D / 64) * (INW / 32), I_BA = (512 / 64) * (D / 32), I_BS = (256 / 64) * (D / 32), I_O = (D / 64) * (D / 32);
        constexpr int PER_L = I_IN + I_BA + I_BS + I_O;
        for (int it = F.gw; it < 2 * PER_L; it += F.ngw) {
            const int l = it / PER_L; int r = it % PER_L;
            if (r < I_IN) { transpose_item(p.in[I_w_in] + (size_t)l * D * INW, D, INW, (bf16_t*)(ws + WS_WIN) + (size_t)l * INW * D, D, 0, 0, scr, r, F.lane); continue; } r -= I_IN;
            if (r < I_BA) { transpose_item(p.in[I_w_br_attn] + (size_t)l * 512 * D, 512, D, (bf16_t*)(ws + WS_WBR) + (size_t)l * D * D, D, 0, 0, scr, r, F.lane); continue; } r -= I_BA;
            if (r < I_BS) { transpose_item(p.in[I_w_br_sgu] + (size_t)l * 256 * D, 256, D, (bf16_t*)(ws + WS_WBR) + (size_t)l * D * D, D, 0, 768, scr, r, F.lane); continue; } r -= I_BS;
            transpose_item(p.in[I_w_out] + (size_t)l * D * D, D, D, (bf16_t*)(ws + WS_WOUT) + (size_t)l * D * D, D, 0, 0, scr, r, F.lane);
        }
    }
    for (int i = F.gtid; i < 2 * 256 * D; i += F.ngt) {
        const int n = i & 1023, rc = (i >> 10) & 255, l = i >> 18, g = rc >> 6;
        const float* pw = p.in[I_pool_w] + ((size_t)l * 256 + rc) * 64;
        const float* ps = p.in[I_pool_scale] + l * 256 + 64 * g;
        const float* wb = p.in[I_w_br_pool] + ((size_t)l * 256 + 64 * g) * D + n;
        float a = 0.f;
#pragma unroll 16
        for (int e = 0; e < 64; ++e) a += pw[e] * ps[e] * wb[(size_t)e * D];
        ((bf16_t*)(ws + WS_WBR))[(size_t)l * D * D + (size_t)n * D + 512 + rc] = (bf16_t)f2bf(a);
    }
    for (int i = F.gtid; i < 2 * 4 * 128 * 128; i += F.ngt) ((bf16_t*)(ws + WS_SGUW))[i] = (bf16_t)f2bf(p.in[I_sgu_w][i]);
    for (int i = F.gtid; i < 64 * 16; i += F.ngt) {
        const int pos = i >> 4, fi = i & 15;
        const float inv = powf(10000.0f, -(float)fi / 16.0f);
        const float ang = (float)pos * inv;
        ((f32x2*)(ws + WS_ROPE))[i] = (f32x2){cosf(ang), sinf(ang)};
    }
    convert_tables(p, F);
    {
        float* MOD = (float*)(ws + WS_MOD);
        LAS float* scd = (LAS float*)F.lds;
        LAS float* red = scd + 9 * D;
        __syncthreads();
        { float tc[18];
#pragma unroll
          for (int it = 0; it < 18; ++it) { const int e = F.tid + it * NTHREADS, r = e >> 10, k = e & 1023; tc[it] = (r < 8) ? p.in[I_c][r * D + k] : p.in[I_c_ctx][k]; }
#pragma unroll
          for (int it = 0; it < 18; ++it) scd[F.tid + it * NTHREADS] = silu_(tc[it]); }
        __syncthreads();
        for (int it = F.bid; it < 2 * 96; it += F.nb) {
            const int cgp = it % 96, l = it / 96, col = cgp * 64 + F.lane;
            float acc[9];
#pragma unroll
            for (int r = 0; r < 9; ++r) acc[r] = 0.f;
            const float* wp = p.in[I_w_mod] + ((size_t)l * D + F.wave * 128) * NMOD + col;
#pragma unroll 16
            for (int k = 0; k < 128; ++k) {
                const float w = wp[(size_t)k * NMOD];
#pragma unroll
                for (int r = 0; r < 9; ++r) acc[r] += scd[r * D + F.wave * 128 + k] * w;
            }
#pragma unroll
            for (int r = 0; r < 9; ++r) red[(F.wave * 9 + r) * 64 + F.lane] = acc[r];
            __syncthreads();
            for (int e = F.tid; e < 9 * 64; e += NTHREADS) {
                const int r = e >> 6, ln = e & 63; float s = p.in[I_b_mod][l * NMOD + cgp * 64 + ln];
#pragma unroll
                for (int w = 0; w < 8; ++w) s += red[(w * 9 + r) * 64 + ln];
                MOD[((size_t)l * 9 + r) * NMOD + cgp * 64 + ln] = s;
            }
            __syncthreads();
        }
    }
}

DI const float* mod_vec(const Params& p, int l, int row, int j) {
    const int r = row < TL ? row / SEQ : 8;
    return (const float*)(p.ws + WS_MOD) + ((size_t)l * 9 + r) * NMOD + j * D;
}
DI float* xrow_ptr(const Params& p, int row) { return row < TL ? p.out + (size_t)row * D : (float*)(p.ws + WS_XCTX) + (size_t)(row - TL) * D; }
DI const float* xin_ptr(const Params& p, int row) { return row < TL ? p.in[I_x] + (size_t)row * D : p.in[I_ctx] + (size_t)(row - TL) * D; }

DI void phase_norm(const Params& p, const Frame& F, int l, int which  , bool from_input, int nrows) {
    const float* g = (which == 0 ? p.in[I_g_mix] : p.in[I_g_ffn]) + l * D;
    const int lane = F.lane;
    f32x4 gg[4];
#pragma unroll
    for (int j = 0; j < 4; ++j) gg[j] = ((const f32x4*)g)[lane + 64 * j];
    for (int row0 = 2 * F.gw; row0 < nrows; row0 += 2 * F.ngw) {
        f32x4 v[2][4], s1[2][4], s2[2][4];
#pragma unroll
        for (int u = 0; u < 2; ++u) {
            const int row = row0 + u;
            const float* src = from_input ? xin_ptr(p, row) : xrow_ptr(p, row);
            const float* sh = mod_vec(p, l, row, which * 3 + 0); const float* sc = mod_vec(p, l, row, which * 3 + 1);
#pragma unroll
            for (int j = 0; j < 4; ++j) { v[u][j] = ((const f32x4*)src)[lane + 64 * j]; s1[u][j] = ((const f32x4*)sh)[lane + 64 * j]; s2[u][j] = ((const f32x4*)sc)[lane + 64 * j]; }
        }
#pragma unroll
        for (int u = 0; u < 2; ++u) {
            float ss = 0.f;
#pragma unroll
            for (int j = 0; j < 4; ++j) ss += v[u][j].x * v[u][j].x + v[u][j].y * v[u][j].y + v[u][j].z * v[u][j].z + v[u][j].w * v[u][j].w;
            const float rinv = rsqrtf(wave_sum(ss) * (1.0f / D) + EPS);
            bf16_t* dst = (bf16_t*)(p.ws + WS_H) + (size_t)(row0 + u) * D;
            float am = 0.f;
#pragma unroll
            for (int j = 0; j < 4; ++j) {
                const f32x4 o = v[u][j] * rinv * gg[j] * (s2[u][j] + 1.0f) + s1[u][j];
                u32x2 w; w.x = pk2(o.x, o.y); w.y = pk2(o.z, o.w);
                ((u32x2*)dst)[lane + 64 * j] = w;
                v[u][j] = o; am = fmaxf(am, fmaxf(fmaxf(fabsf(o.x), fabsf(o.y)), fmaxf(fabsf(o.z), fabsf(o.w))));
            }
            if (which) {
#pragma unroll
                for (int o2 = 1; o2 < 64; o2 <<= 1) am = fmaxf(am, __shfl_xor(am, o2));
                const float sc = (am > 0.f) ? 127.0f / am : 1.0f;
                unsigned* h8 = (unsigned*)(p.ws + WS_H8 + (size_t)(row0 + u) * D);
                const bool odd = (lane & 1) != 0;
#pragma unroll
                for (int j = 0; j < 4; ++j) {
                    const int b0 = (int)__builtin_rintf(v[u][j].x * sc), b1 = (int)__builtin_rintf(v[u][j].y * sc), b2 = (int)__builtin_rintf(v[u][j].z * sc), b3 = (int)__builtin_rintf(v[u][j].w * sc);
                    const int p0 = dpp_x1(b0), p1 = dpp_x1(b1), p2 = dpp_x1(b2), p3 = dpp_x1(b3);
                    const int w0 = odd ? p1 : b0, w1 = odd ? p3 : b2, w2 = odd ? b1 : p0, w3 = odd ? b3 : p2;
                    h8[lane + 64 * j] = (unsigned)(w0 & 0xff) | ((unsigned)(w1 & 0xff) << 8) | ((unsigned)(w2 & 0xff) << 16) | ((unsigned)w3 << 24);
                }
                if (lane == 0) ((float*)(p.ws + WS_HS))[row0 + u] = (am > 0.f) ? am * (1.0f / 127.0f) : 1.0f;
            }
        }
    }
}
DI void phase_final(const Params& p, const Frame& F) {
    f32x4 gg[4];
#pragma unroll
    for (int j = 0; j < 4; ++j) gg[j] = ((const f32x4*)p.in[I_g_final])[F.lane + 64 * j];
    for (int row0 = 2 * F.gw; row0 < TL; row0 += 2 * F.ngw) {
        f32x4 v[2][4];
#pragma unroll
        for (int u = 0; u < 2; ++u)
#pragma unroll
            for (int j = 0; j < 4; ++j) v[u][j] = ((const f32x4*)(p.out + (size_t)(row0 + u) * D))[F.lane + 64 * j];
#pragma unroll
        for (int u = 0; u < 2; ++u) {
            float ss = 0.f;
#pragma unroll
            for (int j = 0; j < 4; ++j) ss += v[u][j].x * v[u][j].x + v[u][j].y * v[u][j].y + v[u][j].z * v[u][j].z + v[u][j].w * v[u][j].w;
            const float rinv = rsqrtf(wave_sum(ss) * (1.0f / D) + EPS);
            f32x4* xr = (f32x4*)(p.out + (size_t)(row0 + u) * D);
#pragma unroll
            for (int j = 0; j < 4; ++j) xr[F.lane + 64 * j] = v[u][j] * rinv * gg[j];
        }
    }
}

DI float lane_xor32(float v, bool hi) { const auto r = __builtin_amdgcn_permlane32_swap(__builtin_bit_cast(unsigned, v), __builtin_bit_cast(unsigned, v), false, false);
    return __builtin_bit_cast(float, hi ? r[0] : r[1]); }
struct EpiG1 {
    DI bool keeps(const pg8::Unit&) const { return false; }
    static constexpr bool PERM = true;
    unsigned char* ws;
    DI void operator()(const f32x4 (&acc)[2][2][4][2], const pg8::Unit& u, int wr, int wc, int fr, int fq) const {
        bf16_t* P = (bf16_t*)(ws + WS_P);
        const int rbase = u.pm * 256 + wr * 64 + fr;
        const bool hi = fq >= 2;
#pragma unroll
        for (int ai = 0; ai < 2; ++ai) {
            f32x4 cs[4][4];
            const bool lat = u.pm < TL / 256;
            if (u.pn < 3 && lat) {
#pragma unroll
                for (int m = 0; m < 4; ++m) {
                    const int t = (rbase + 128 * ai + 16 * m) & (SEQ - 1), pos = (wc & 1) ? (t & 63) : (t >> 6);
                    const f32x4* tab = (const f32x4*)(ws + WS_ROPE) + (pos * 16 + 8 * (fq & 1)) / 2;
#pragma unroll
                    for (int j2 = 0; j2 < 4; ++j2) cs[m][j2] = tab[j2];
                }
            }
#pragma unroll
            for (int m = 0; m < 4; ++m) {
                const int row = rbase + 128 * ai + 16 * m;
#pragma unroll
                for (int bj = 0; bj < 2; ++bj) {
                    const int c0 = u.pn * 256 + 128 * bj + 32 * wc + 8 * fq;
                    float v[8];
#pragma unroll
                    for (int j = 0; j < 4; ++j) { v[j] = acc[ai][bj][m][0][j]; v[4 + j] = acc[ai][bj][m][1][j]; }
                    if (c0 < VOFF) {
                        const float sc = (c0 < KOFF) ? QSCALE : 1.0f;
                        u32x4 o;
#pragma unroll
                        for (int j2 = 0; j2 < 4; ++j2) {
                            const f32x4 c4 = cs[m][j2];
                            const float o0 = lane_xor32(v[2 * j2], hi), o1 = lane_xor32(v[2 * j2 + 1], hi);
                            float r0 = hi ? (v[2 * j2] * c4.x + o0 * c4.y) : (v[2 * j2] * c4.x - o0 * c4.y);
                            float r1 = hi ? (v[2 * j2 + 1] * c4.z + o1 * c4.w) : (v[2 * j2 + 1] * c4.z - o1 * c4.w);
                            if (!lat) { r0 = v[2 * j2]; r1 = v[2 * j2 + 1]; }
                            o[j2] = pk2(r0 * sc, r1 * sc);
                        }
                        *(u32x4*)(P + (size_t)row * PW + c0) = o;
                    } else if (c0 < POOLOFF) {
                        const int hk = wc >> 1, d0 = 32 * (wc & 1) + 8 * fq;
                        if (lat) { const int b = row / SEQ, t = row & (SEQ - 1);
                            bf16_t* vt = (bf16_t*)(ws + WS_VT) + ((size_t)(b * 2 + hk) * 64 + d0) * VTS + t;
#pragma unroll
                            for (int j = 0; j < 8; ++j) vt[(size_t)j * VTS] = (bf16_t)f2bf(v[j]);
                        } else { const int rc = row - TL, b = rc / NCTX, jc = rc & (NCTX - 1);
                            bf16_t* vt = (bf16_t*)(ws + WS_VTC) + ((size_t)(b * 2 + hk) * 64 + d0) * NCTX + jc;
#pragma unroll
                            for (int j = 0; j < 8; ++j) vt[(size_t)j * NCTX] = (bf16_t)f2bf(v[j]);
                        }
                    } else if (c0 < SUOFF) {
                        u32x4 o;
#pragma unroll
                        for (int j2 = 0; j2 < 4; ++j2) o[j2] = pk2(v[2 * j2], v[2 * j2 + 1]);
                        *(u32x4*)(P + (size_t)row * PW + c0) = o;
                    } else if (c0 < SVOFF) {
                        u32x4 o;
#pragma unroll
                        for (int j2 = 0; j2 < 4; ++j2) o[j2] = pk2(gelu_tanh(v[2 * j2]), gelu_tanh(v[2 * j2 + 1]));
                        *(u32x4*)(P + (size_t)row * PW + c0) = o;
                    } else {
                        const int c = c0 - SVOFF, chunk = row >> 7, q = row & 127;
                        bf16_t* vs = (bf16_t*)(ws + WS_VST) + ((size_t)chunk * 256 + c) * 128 + q;
#pragma unroll
                        for (int j = 0; j < 8; ++j) vs[j * 128] = (bf16_t)f2bf(gelu_tanh(v[j]));
                    }
                }
            }
            asm volatile("" ::: "memory");
        }
    }
};
struct SchedGrid {
    int nM, nN, G, c; const char* A; const char* B;
    int n_extra, ex_pm0, ex_pn;
    DI bool next(int i, pg8::Unit& u) const {
        const int L = i * G + c, n = nM * nN; if (L >= n + n_extra) return false;
        if (L < n) pg8::tile_of(L, nM, nN, u.pm, u.pn); else { u.pm = ex_pm0 + (L - n); u.pn = ex_pn; }
        u.sub = 0; u.nt = D / 64; u.mode = 0;
        u.a = A + (size_t)u.pm * 256 * D * 2; u.b = B + (size_t)u.pn * 256 * D * 2; return true;
    }
};

DI void phase_g1(const Params& p, const Frame& F, int l) {
    SchedGrid S{(l == 0 ? T : TL) / 256, PN / 256, F.nb, F.bid, (const char*)(p.ws + WS_H), (const char*)(p.ws + WS_WIN) + (size_t)l * INW * D * 2,
                (l == 0) ? 0 : TC / 256, TL / 256, 2};
    EpiG1 E{p.ws};
    pg8::gemm_phase(F.lds, F.tid, S, E);
}

DI bf16x8 pack8(const f32x16& x, int s) {
    u32x4 pk;
#pragma unroll
    for (int j = 0; j < 4; ++j) { f32x2 v = {x[8 * s + 2 * j], x[8 * s + 2 * j + 1]}; pk[j] = __builtin_bit_cast(unsigned, __builtin_convertvector(v, bf16x2_t)); }
    return __builtin_bit_cast(bf16x8, pk);
}

DI float lane_x32(float v, bool hi) { const auto r = __builtin_amdgcn_permlane32_swap(__builtin_bit_cast(unsigned, v), __builtin_bit_cast(unsigned, v), false, false);
    return __builtin_bit_cast(float, hi ? r[0] : r[1]); }
struct AttnFrags { bf16x8 kf[4]; s16x4 vf[2][4]; };
DI void attn_block(const bf16x8 (&qf)[4], const AttnFrags& f, int mask_mode, int kq_off, int lane, float& m, float& lpart, f32x16 (&o)[2]) {
    const int h = lane >> 5;
    f32x16 st;
#pragma unroll
    for (int r = 0; r < 16; ++r) st[r] = 0.f;
#pragma unroll
    for (int s = 0; s < 4; ++s) st = MFMA32(f.kf[s], qf[s], st);
    if (mask_mode) {
#pragma unroll
        for (int r = 0; r < 16; ++r) { const int dlt = kq_off + crow(r, h); if (dlt > 128 || dlt < -128) st[r] = -1e30f; }
    }
    float bm = st[0];
#pragma unroll
    for (int r = 1; r < 16; ++r) bm = fmaxf(bm, st[r]);
    bm = fmaxf(bm, lane_x32(bm, h != 0));
    const float mn = fmaxf(m, bm);
    if (__builtin_amdgcn_ballot_w64(mn > m) != 0ull) {
        const float alpha = __builtin_amdgcn_exp2f(m - mn);
        lpart *= alpha;
#pragma unroll
        for (int d = 0; d < 2; ++d)
#pragma unroll
            for (int r = 0; r < 16; ++r) o[d][r] *= alpha;
        m = mn;
    }
    float ps = 0.f;
#pragma unroll
    for (int r = 0; r < 16; ++r) { st[r] = __builtin_amdgcn_exp2f(st[r] - m); ps += st[r]; }
    lpart += ps;
    const bf16x8 pf0 = pack8(st, 0), pf1 = pack8(st, 1);
#pragma unroll
    for (int d = 0; d < 2; ++d) {
        const bf16x8 v0 = __builtin_shufflevector(f.vf[d][0], f.vf[d][1], 0, 1, 2, 3, 4, 5, 6, 7), v1 = __builtin_shufflevector(f.vf[d][2], f.vf[d][3], 0, 1, 2, 3, 4, 5, 6, 7);
        o[d] = MFMA32(v0, pf0, o[d]);
        o[d] = MFMA32(v1, pf1, o[d]);
    }
}

constexpr int AKP = 144, AVWP = 648, AVCP = 520;
constexpr int ALDS_KW = 0, ALDS_VW = ALDS_KW + 320 * AKP, ALDS_KC = ALDS_VW + 64 * AVWP, ALDS_VC = ALDS_KC + 256 * AKP, ALDS_END = ALDS_VC + 64 * AVCP;
static_assert(ALDS_END <= LDS_BAR_OFF && (ALDS_VW % 16) == 0 && (ALDS_KC % 16) == 0 && (ALDS_VC % 8) == 0, "attention LDS map");
DI void attn_lds_frags(AttnFrags& f, const LAS unsigned char* kp, const LAS unsigned char* vp, int vpitch32) {
#pragma unroll
    for (int s = 0; s < 4; ++s) f.kf[s] = *(const LAS bf16x8*)(kp + 32 * s);
#pragma unroll
    for (int d = 0; d < 2; ++d)
#pragma unroll
        for (int q = 0; q < 4; ++q) f.vf[d][q] = *(const LAS s16x4*)(vp + d * vpitch32 + 16 * q);
}
DI void attn_unit(const Params& p, const Frame& F, int l, int unit) {
    const int lane = F.lane, r = lane & 31, h = lane >> 5, tid = F.tid;
    const bf16_t* P = (const bf16_t*)(p.ws + WS_P);
    const bf16_t* VT = (const bf16_t*)(p.ws + WS_VT);
    const bf16_t* VTC = (const bf16_t*)(p.ws + WS_VTC);
    bf16_t* Y = (bf16_t*)(p.ws + WS_Y);
    const bool latent = unit < 1024;
    int b, hk, p0, q0row;
    if (latent) { const int pb = unit & 63; hk = (unit >> 6) & 1; b = unit >> 7; p0 = pb * 64; q0row = b * SEQ + p0; }
    else { const int u2 = unit - 1024, pb = u2 & 3; hk = (u2 >> 2) & 1; b = u2 >> 3; p0 = pb * 64; q0row = TL + b * NCTX + p0; }
    const int w0 = p0 - 128;
    u32x4 kw[5], vw[5], kc[4], vc[4];
    if (latent) {
#pragma unroll
        for (int it = 0; it < 5; ++it) {
            const int i = tid + it * NTHREADS, row = i >> 3, ck = i & 7, pos = min(max(w0 + row, 0), SEQ - 1);
            kw[it] = *(const u32x4*)(P + (size_t)(b * SEQ + pos) * PW + KOFF + hk * 64 + 8 * ck);
            const int d = i / 40, cv = i % 40, pv = min(max(w0 + 8 * cv, 0), SEQ - 8);
            vw[it] = *(const u32x4*)(VT + ((size_t)(b * 2 + hk) * 64 + d) * VTS + pv);
        }
    }
#pragma unroll
    for (int it = 0; it < 4; ++it) {
        const int i = tid + it * NTHREADS;
        kc[it] = *(const u32x4*)(P + (size_t)(TL + b * NCTX + (i >> 3)) * PW + KOFF + hk * 64 + 8 * (i & 7));
        vc[it] = *(const u32x4*)(VTC + ((size_t)(b * 2 + hk) * 64 + (i >> 5)) * NCTX + 8 * (i & 31));
    }
    __syncthreads();
    if (latent) {
#pragma unroll
        for (int it = 0; it < 5; ++it) {
            const int i = tid + it * NTHREADS, row = i >> 3, ck = i & 7;
            *(LAS u32x4*)(F.lds + ALDS_KW + row * AKP + 16 * ck) = kw[it];
            const int d = i / 40, cv = i % 40;
            LAS u32x2* dst = (LAS u32x2*)(F.lds + ALDS_VW + d * AVWP + 16 * cv); dst[0] = (u32x2){vw[it].x, vw[it].y}; dst[1] = (u32x2){vw[it].z, vw[it].w};
        }
    }
#pragma unroll
    for (int it = 0; it < 4; ++it) {
        const int i = tid + it * NTHREADS;
        *(LAS u32x4*)(F.lds + ALDS_KC + (i >> 3) * AKP + 16 * (i & 7)) = kc[it];
        LAS u32x2* dst = (LAS u32x2*)(F.lds + ALDS_VC + (i >> 5) * AVCP + 16 * (i & 31)); dst[0] = (u32x2){vc[it].x, vc[it].y}; dst[1] = (u32x2){vc[it].z, vc[it].w};
    }
    const int head = 4 * hk + (F.wave & 3), ph = F.wave >> 2, pw = p0 + 32 * ph, qrow = q0row + 32 * ph;
    bf16x8 qf[4];
#pragma unroll
    for (int s = 0; s < 4; ++s) qf[s] = *(const bf16x8*)(P + (size_t)(qrow + r) * PW + head * 64 + 16 * s + 8 * h);
    float m = p.in[I_attn_sink][l * 8 + head] * LOG2E, lpart = (h == 0) ? 1.0f : 0.0f;
    f32x16 o[2];
#pragma unroll
    for (int d = 0; d < 2; ++d)
#pragma unroll
        for (int i = 0; i < 16; ++i) o[d][i] = 0.f;
    __syncthreads();
    if (latent) {
#pragma unroll 1
        for (int j = 0; j < 9; ++j) {
            const int kb = pw - 128 + 32 * j;
            if (kb < 0 || kb >= SEQ) continue;
            const int krow = kb - w0;
            AttnFrags f;
            attn_lds_frags(f, F.lds + ALDS_KW + (krow + r) * AKP + 16 * h, F.lds + ALDS_VW + r * AVWP + 2 * krow + 8 * h, 32 * AVWP);
            attn_block(qf, f, (j == 0 || j == 8) ? 1 : 0, kb - (pw + r), lane, m, lpart, o);
        }
    }
#pragma unroll 1
    for (int j = 0; j < 8; ++j) {
        AttnFrags f;
        attn_lds_frags(f, F.lds + ALDS_KC + (32 * j + r) * AKP + 16 * h, F.lds + ALDS_VC + r * AVCP + 64 * j + 8 * h, 32 * AVCP);
        attn_block(qf, f, 0, 0, lane, m, lpart, o);
    }
    const float inv = 1.0f / (lpart + lane_x32(lpart, h != 0));
    bf16_t* yrow = Y + (size_t)(qrow + r) * D + head * 64;
#pragma unroll
    for (int d = 0; d < 2; ++d)
#pragma unroll
        for (int g = 0; g < 4; ++g) {
            u32x2 w; w.x = pk2(o[d][4 * g] * inv, o[d][4 * g + 1] * inv); w.y = pk2(o[d][4 * g + 2] * inv, o[d][4 * g + 3] * inv);
            *(u32x2*)(yrow + 32 * d + 8 * g + 4 * h) = w;
        }
}

DI void sgu_unit(const Params& p, const Frame& F, int l, int chunk) {
    constexpr int VS = 136;
    LAS float* part = (LAS float*)F.lds;
    LAS float* rq = part + 512;
    LAS bf16_t* vnT = (LAS bf16_t*)(F.lds + 4096);
    const bf16_t* VsT = (const bf16_t*)(p.ws + WS_VST) + (size_t)chunk * 256 * 128;
    const bf16_t* P = (const bf16_t*)(p.ws + WS_P);
    bf16_t* Y = (bf16_t*)(p.ws + WS_Y);
    __syncthreads();
    { const int q = F.tid & 127, part_i = F.tid >> 7; float ss = 0.f;
#pragma unroll 16
        for (int c = part_i * 64; c < part_i * 64 + 64; ++c) { const float v = bf2f(VsT[c * 128 + q]); ss += v * v; }
        part[part_i * 128 + q] = ss; }
    __syncthreads();
    if (F.tid < 128) rq[F.tid] = rsqrtf((part[F.tid] + part[128 + F.tid] + part[256 + F.tid] + part[384 + F.tid]) * (1.0f / 256.0f) + EPS);
    __syncthreads();
#pragma unroll
    for (int it = 0; it < 8; ++it) {
        const int i = F.tid + it * NTHREADS;
        const int c = i >> 4, q8 = (i & 15) * 8;
        const u32x4 v = *(const u32x4*)(VsT + c * 128 + q8);
        u32x4 o;
#pragma unroll
        for (int j = 0; j < 4; ++j) o[j] = pk2(bflo(v[j]) * rq[q8 + 2 * j], bfhi(v[j]) * rq[q8 + 2 * j + 1]);
        *(LAS u32x4*)(vnT + c * VS + q8) = o;
    }
    __syncthreads();
    const int lane = F.lane, r = lane & 31, h = lane >> 5, g = F.wave >> 1, ph = F.wave & 1;
    const bf16_t* Wg = (const bf16_t*)(p.ws + WS_SGUW) + ((size_t)l * 4 + g) * 128 * 128;
#pragma unroll 1
    for (int pb = 0; pb < 2; ++pb) {
        const int p0 = 64 * ph + 32 * pb;
        const int row = chunk * 128 + p0 + r;
        bf16x8 wf[8];
#pragma unroll
        for (int s = 0; s < 8; ++s) wf[s] = *(const bf16x8*)(Wg + (size_t)(p0 + r) * 128 + 16 * s + 8 * h);
        u32x2 uu[2][4];
#pragma unroll
        for (int cb = 0; cb < 2; ++cb)
#pragma unroll
            for (int q4 = 0; q4 < 4; ++q4) uu[cb][q4] = *(const u32x2*)(P + (size_t)row * PW + SUOFF + 64 * g + 32 * cb + 8 * q4 + 4 * h);
        const float bias = p.in[I_sgu_b][(l * 4 + g) * 128 + p0 + r];
#pragma unroll
        for (int cb = 0; cb < 2; ++cb) {
            const int c0 = 64 * g + 32 * cb;
            f32x16 acc;
#pragma unroll
            for (int i = 0; i < 16; ++i) acc[i] = 0.f;
#pragma unroll
            for (int s = 0; s < 8; ++s) {
                const bf16x8 a = *(const LAS bf16x8*)(vnT + (c0 + r) * VS + 16 * s + 8 * h);
                acc = MFMA32(a, wf[s], acc);
            }
#pragma unroll
            for (int q4 = 0; q4 < 4; ++q4) {
                const int cc = c0 + 8 * q4 + 4 * h;
                const u32x2 u = uu[cb][q4];
                u32x2 w;
                w.x = pk2(bflo(u.x) * (acc[4 * q4] + bias), bfhi(u.x) * (acc[4 * q4 + 1] + bias));
                w.y = pk2(bflo(u.y) * (acc[4 * q4 + 2] + bias), bfhi(u.y) * (acc[4 * q4 + 3] + bias));
                *(u32x2*)(Y + (size_t)row * D + 768 + cc) = w;
            }
        }
    }
}

DI void phase_mix(const Params& p, const Frame& F, int l, int ctr_slot = 0) {
    (void)ctr_slot;
    const int nrows = (l == 0) ? T : TL;
    const bf16_t* P = (const bf16_t*)(p.ws + WS_P);
    bf16_t* Y = (bf16_t*)(p.ws + WS_Y);
    for (int i0 = F.bid * NTHREADS; i0 < 4 * nrows * 8; i0 += F.nb * NTHREADS) {
        const int i = i0 + F.tid, g = i / (nrows * 8), rem = i - g * (nrows * 8), row = rem >> 3, ck = g * 8 + (rem & 7);
        int base, t, len;
        if (row < TL) { base = row & ~(SEQ - 1); t = row & (SEQ - 1); len = SEQ; } else { const int rc = row - TL; base = TL + (rc & ~(NCTX - 1)); t = rc & (NCTX - 1); len = NCTX; }
        float s[8];
#pragma unroll
        for (int j = 0; j < 8; ++j) s[j] = 0.f;
        const bf16_t* zc = P + POOLOFF + ck * 8;
#define POOL_WIN(HALF) do { _Pragma("unroll") for (int dt = -(HALF); dt < (HALF); ++dt) { const int tt = t + dt; const bool ok = tt >= 0 && tt < len; \
            const u32x4 v = *(const u32x4*)(zc + (size_t)(base + (ok ? tt : t)) * PW); const float w = ok ? 1.f : 0.f; \
            _Pragma("unroll") for (int j = 0; j < 4; ++j) { s[2 * j] += w * bflo(v[j]); s[2 * j + 1] += w * bfhi(v[j]); } } } while (0)
        int half;
        if (g == 0) { POOL_WIN(1); half = 1; } else if (g == 1) { POOL_WIN(2); half = 2; } else if (g == 2) { POOL_WIN(4); half = 4; } else { POOL_WIN(8); half = 8; }
#undef POOL_WIN
        const int lo = max(t - half, 0), hi = min(t + half, len);
        const float inv = 1.0f / (float)(hi - lo);
        const u32x4 z = *(const u32x4*)(zc + (size_t)row * PW);
        u32x4 o;
#pragma unroll
        for (int j = 0; j < 4; ++j) o[j] = pk2(s[2 * j] * inv - bflo(z[j]), s[2 * j + 1] * inv - bfhi(z[j]));
        *(u32x4*)(Y + (size_t)row * D + 512 + ck * 8) = o;
    }
    const int nchunk = (l == 0) ? T / 128 : TL / 128;
    for (int ch = F.bid; ch < nchunk; ch += F.nb) sgu_unit(p, F, l, ch);
    const int nunit = (l == 0) ? 1024 + 64 : 1024;
    for (int u = F.nb - 1 - F.bid; u < nunit; u += F.nb) attn_unit(p, F, l, u);
}

struct SchedG2 {
    int G, c; const char *H, *Y, *Wg, *Wb; int npair;
    DI void fill(pg8::Unit& u, int sub, int br) const {
        u.sub = sub;
        if ((sub & 1) == 0) { u.nt = 16; u.a = H + (size_t)u.pm * 256 * D * 2; u.b = Wg + ((size_t)br * D + u.pn * 256) * D * 2; }
        else { const int koff = (br == 0) ? 0 : (br == 1 ? 512 : 768); u.nt = (br == 0) ? 8 : 4;
               u.a = Y + ((size_t)u.pm * 256 * D + koff) * 2; u.b = Wb + ((size_t)u.pn * 256 * D + koff) * 2; }
    }
    DI bool next(int i, pg8::Unit& u) const {
        constexpr int NLAT = (TL / 256) * 4;
        const int nl = (NLAT - c + G - 1) / G;
        if (i < 6 * nl) { const int tile = (i / 6) * G + c, sub = i % 6; pg8::tile_of(tile, TL / 256, 4, u.pm, u.pn); u.mode = 0; fill(u, sub, sub >> 1); return true; }
        const int e = i - 6 * nl, j = (e >> 1) * G + c;
        if (j >= npair) return false;
        const int ctile = j / 3, br = j % 3;
        u.pm = TL / 256 + (ctile >> 2); u.pn = ctile & 3; u.mode = 1 + br; fill(u, e & 1, br); return true;
    }
};
struct EpiG2 {
    static constexpr bool PERM = true;
    bf16_t* scr; bf16_t* M; bf16_t* MP;
    DI bool keeps(const pg8::Unit& u) const { return (u.sub & 1) == 0; }
    DI void operator()(f32x4 (&acc)[2][2][4][2], const pg8::Unit& u, int wr, int wc, int fr, int fq) const {
        const bool gate = (u.sub & 1) == 0, first = u.sub == 0 && gate;
        bf16_t* Mo = (u.mode == 0) ? M + (size_t)u.pm * 256 * D : MP + ((size_t)(u.mode - 1) * TC + (size_t)(u.pm - TL / 256) * 256) * D;
#pragma unroll
        for (int ai = 0; ai < 2; ++ai) {
            u32x4 ld[4][2];
            if (!first) {
#pragma unroll
                for (int m = 0; m < 4; ++m)
#pragma unroll
                    for (int bj = 0; bj < 2; ++bj) {
                        const int rl = 128 * ai + 64 * wr + 16 * m + fr, cl = 128 * bj + 32 * wc + 8 * fq;
                        ld[m][bj] = gate ? *(const u32x4*)(Mo + (size_t)rl * D + u.pn * 256 + cl) : *(const u32x4*)(scr + rl * 256 + cl);
                    }
            }
#pragma unroll
            for (int m = 0; m < 4; ++m)
#pragma unroll
                for (int bj = 0; bj < 2; ++bj) {
                    const int rl = 128 * ai + 64 * wr + 16 * m + fr, cl = 128 * bj + 32 * wc + 8 * fq;
                    if (gate) {
                        u32x4 o;
#pragma unroll
                        for (int j2 = 0; j2 < 4; ++j2) {
                            const int n = j2 >> 1, e = 2 * (j2 & 1);
                            const float i0 = fminf(1.0f + __expf(-acc[ai][bj][m][n][e]), 1e20f), i1 = fminf(1.0f + __expf(-acc[ai][bj][m][n][e + 1]), 1e20f);
                            o[j2] = pk2(__builtin_amdgcn_rcpf(i0), __builtin_amdgcn_rcpf(i1));
                            const float t0 = first ? 0.f : bflo(ld[m][bj][j2]), t1 = first ? 0.f : bfhi(ld[m][bj][j2]);
                            acc[ai][bj][m][n][e] = t0 * i0; acc[ai][bj][m][n][e + 1] = t1 * i1;
                        }
                        *(u32x4*)(scr + rl * 256 + cl) = o;
                    } else {
                        u32x4 w;
#pragma unroll
                        for (int j2 = 0; j2 < 4; ++j2) { const int n = j2 >> 1, e = 2 * (j2 & 1);
                            w[j2] = pk2(acc[ai][bj][m][n][e] * bflo(ld[m][bj][j2]), acc[ai][bj][m][n][e + 1] * bfhi(ld[m][bj][j2])); }
                        *(u32x4*)(Mo + (size_t)rl * D + u.pn * 256 + cl) = w;
                    }
                }
            asm volatile("" ::: "memory");
        }
    }
};
DI void phase_g2(const Params& p, const Frame& F, int l) {
    SchedG2 S{F.nb, F.bid, (const char*)(p.ws + WS_H), (const char*)(p.ws + WS_Y),
              (const char*)(p.ws + WS_WIN) + ((size_t)l * INW + GATEOFF) * D * 2, (const char*)(p.ws + WS_WBR) + (size_t)l * D * D * 2, (l == 0) ? (TC / 256) * 4 * 3 : 0};
    EpiG2 E{(bf16_t*)(p.ws + WS_IDX) + (size_t)F.bid * 65536, (bf16_t*)(p.ws + WS_MERGED), (bf16_t*)(p.ws + WS_MP)};
    pg8::gemm_phase(F.lds, F.tid, S, E);
}
DI void phase_g2sum(const Params& p, const Frame& F) {
    const u32x4* mp = (const u32x4*)(p.ws + WS_MP);
    u32x4* mo = (u32x4*)((bf16_t*)(p.ws + WS_MERGED) + (size_t)TL * D);
    constexpr int NV = TC * D / 8;
    for (int i = F.gtid; i < NV; i += F.ngt) {
        const u32x4 a = mp[i], b = mp[NV + i], c = mp[2 * NV + i];
        u32x4 o;
#pragma unroll
        for (int j = 0; j < 4; ++j) o[j] = pk2(bflo(a[j]) + bflo(b[j]) + bflo(c[j]), bfhi(a[j]) + bfhi(b[j]) + bfhi(c[j]));
        mo[i] = o;
    }
}

struct EpiG3 {
    DI bool keeps(const pg8::Unit&) const { return false; }
    static constexpr bool PERM = false;
    const float* xsrc; float* xdst; const float* csrc; float* cdst; const float* mod;
    DI void operator()(const f32x4 (&acc)[2][2][4][2], const pg8::Unit& u, int wr, int wc, int fr, int fq) const {
        const int col0 = u.pn * 256 + wc * 32 + 4 * fq;
        const bool lat = u.pm < TL / 256;
        const float* gt = mod + (size_t)(lat ? (u.pm >> 4) : 8) * NMOD + 2 * D;
        const float* xs = lat ? xsrc + (size_t)u.pm * 256 * D : csrc + (size_t)(u.pm - TL / 256) * 256 * D;
        float* xd = lat ? xdst + (size_t)u.pm * 256 * D : cdst + (size_t)(u.pm - TL / 256) * 256 * D;
        f32x4 gv[2][2];
#pragma unroll
        for (int bj = 0; bj < 2; ++bj)
#pragma unroll
            for (int n = 0; n < 2; ++n) gv[bj][n] = *(const f32x4*)(gt + col0 + 128 * bj + 16 * n);
#pragma unroll
        for (int ai = 0; ai < 2; ++ai) {
            f32x4 xv[4][2][2];
#pragma unroll
            for (int m = 0; m < 4; ++m)
#pragma unroll
                for (int bj = 0; bj < 2; ++bj)
#pragma unroll
                    for (int n = 0; n < 2; ++n) xv[m][bj][n] = *(const f32x4*)(xs + (size_t)(wr * 64 + fr + 128 * ai + 16 * m) * D + col0 + 128 * bj + 16 * n);
#pragma unroll
            for (int m = 0; m < 4; ++m)
#pragma unroll
                for (int bj = 0; bj < 2; ++bj)
#pragma unroll
                    for (int n = 0; n < 2; ++n)
                        *(f32x4*)(xd + (size_t)(wr * 64 + fr + 128 * ai + 16 * m) * D + col0 + 128 * bj + 16 * n) = xv[m][bj][n] + gv[bj][n] * acc[ai][bj][m][n];
            asm volatile("" ::: "memory");
        }
    }
};
DI void phase_g3(const Params& p, const Frame& F, int l) {
    SchedGrid S{(l == 0 ? T : TL) / 256, D / 256, F.nb, F.bid, (const char*)(p.ws + WS_MERGED), (const char*)(p.ws + WS_WOUT) + (size_t)l * D * D * 2, 0, 0, 0};
    float* xc = (float*)(p.ws + WS_XCTX);
    EpiG3 E{(l == 0) ? p.in[I_x] : p.out, p.out, (l == 0) ? p.in[I_ctx] : xc, xc, (const float*)(p.ws + WS_MOD) + (size_t)l * 9 * NMOD};
    pg8::gemm_phase(F.lds, F.tid, S, E);
}

struct EpiG45 {
    DI bool keeps(const pg8::Unit&) const { return false; }
    static constexpr bool PERM = true;
    unsigned short* ST;
    DI void operator()(const f32x4 (&acc)[2][2][4][2], const pg8::Unit& u, int wr, int wc, int fr, int fq) const {
        const int col0 = u.pn * 256 + wc * 32 + 8 * fq;
#pragma unroll
        for (int ai = 0; ai < 2; ++ai)
#pragma unroll
            for (int m = 0; m < 4; ++m) {
                unsigned short* rowp = ST + (size_t)(u.pm * 256 + wr * 64 + fr + 128 * ai + 16 * m) * T + col0;
#pragma unroll
                for (int bj = 0; bj < 2; ++bj) {
                    u32x4 w;
                    w.x = pkh2(acc[ai][bj][m][0][0], acc[ai][bj][m][0][1]); w.y = pkh2(acc[ai][bj][m][0][2], acc[ai][bj][m][0][3]);
                    w.z = pkh2(acc[ai][bj][m][1][0], acc[ai][bj][m][1][1]); w.w = pkh2(acc[ai][bj][m][1][2], acc[ai][bj][m][1][3]);
                    *(u32x4*)(rowp + 128 * bj) = w;
                }
            }
    }
};
DI void phase_g45(const Params& p, const Frame& F, int l) {
    SchedGrid S{2048 / 256, (l == 0 ? T : TL) / 256, F.nb, F.bid, (const char*)(p.ws + WS_WFOLD) + (size_t)l * 2048 * D * 2, (const char*)(p.ws + WS_H), 0, 0, 0};
    EpiG45 E{(unsigned short*)(p.ws + WS_ST)};
    pg8::gemm_phase(F.lds, F.tid, S, E);
}

DI unsigned fkey(float f) { const unsigned u = __builtin_bit_cast(unsigned, f); return (u & 0x80000000u) ? ~u : (u | 0x80000000u); }
DI float fkey_inv(unsigned k) { const unsigned u = (k & 0x80000000u) ? (k & 0x7fffffffu) : ~k; return __builtin_bit_cast(float, u); }
#define INSERT16(L, x) do { unsigned x_ = (x); _Pragma("unroll") for (int k_ = 0; k_ < 16; ++k_) { const unsigned hi_ = max(L[k_], x_); x_ = min(L[k_], x_); L[k_] = hi_; } } while (0)
#define CEX(a, b) do { const unsigned hi_ = max(a, b), lo_ = min(a, b); a = hi_; b = lo_; } while (0)
DI void sort16_desc(unsigned (&v)[16]) {
    CEX(v[0], v[1]); CEX(v[2], v[3]); CEX(v[0], v[2]); CEX(v[1], v[3]); CEX(v[1], v[2]); CEX(v[4], v[5]); CEX(v[6], v[7]); CEX(v[4], v[6]); CEX(v[5], v[7]); CEX(v[5], v[6]); CEX(v[0], v[4]); CEX(v[2], v[6]); CEX(v[2], v[4]); CEX(v[1], v[5]); CEX(v[3], v[7]); CEX(v[3], v[5]); CEX(v[1], v[2]); CEX(v[3], v[4]); CEX(v[5], v[6]); CEX(v[8], v[9]); CEX(v[10], v[11]); CEX(v[8], v[10]); CEX(v[9], v[11]); CEX(v[9], v[10]); CEX(v[12], v[13]); CEX(v[14], v[15]); CEX(v[12], v[14]); CEX(v[13], v[15]); CEX(v[13], v[14]); CEX(v[8], v[12]); CEX(v[10], v[14]); CEX(v[10], v[12]); CEX(v[9], v[13]); CEX(v[11], v[15]); CEX(v[11], v[13]); CEX(v[9], v[10]); CEX(v[11], v[12]); CEX(v[13], v[14]); CEX(v[0], v[8]); CEX(v[4], v[12]); CEX(v[4], v[8]); CEX(v[2], v[10]); CEX(v[6], v[14]); CEX(v[6], v[10]); CEX(v[2], v[4]); CEX(v[6], v[8]); CEX(v[10], v[12]); CEX(v[1], v[9]); CEX(v[5], v[13]); CEX(v[5], v[9]); CEX(v[3], v[11]); CEX(v[7], v[15]); CEX(v[7], v[11]); CEX(v[3], v[5]); CEX(v[7], v[9]); CEX(v[11], v[13]); CEX(v[1], v[2]); CEX(v[3], v[4]); CEX(v[5], v[6]); CEX(v[7], v[8]); CEX(v[9], v[10]); CEX(v[11], v[12]); CEX(v[13], v[14]);
}
DI void merge16_desc(unsigned (&L)[16], const unsigned (&N)[16]) {
#pragma unroll
    for (int i = 0; i < 16; ++i) L[i] = max(L[i], N[15 - i]);
#pragma unroll
    for (int j = 8; j > 0; j >>= 1)
#pragma unroll
        for (int i = 0; i < 16; ++i) { const int q = i ^ j; if (q > i) CEX(L[i], L[q]); }
}
DI void phase_sel(const Params& p, const Frame& F, int l) {
    const _Float16* ST = (const _Float16*)(p.ws + WS_ST);
    unsigned short* IDX = (unsigned short*)(p.ws + WS_IDX);
    float* GW = (float*)(p.ws + WS_GW);
    float* SU = (float*)(p.ws + WS_SU);
    const float* TSC = (const float*)(p.ws + WS_TSCALE) + (size_t)l * 2 * NEXP;
    LAS unsigned char* ib = (LAS unsigned char*)F.lds;
    const int ntok = (l == 0) ? T : TL;
    for (int i0 = F.bid * NTHREADS; i0 < ntok * 8; i0 += F.nb * NTHREADS) {
        const int i = i0 + F.tid;
        const int tok = i % ntok, head = i / ntok;
        unsigned la[16], lb[16];
#pragma unroll
        for (int k = 0; k < 16; ++k) { la[k] = 0u; lb[k] = 0u; }
        const _Float16* s0 = ST + (size_t)(head * 256) * T + tok;
#define SEL_LOAD(B_, k0_) do { _Pragma("unroll") for (int j = 0; j < 32; ++j) B_[j] = sp[(size_t)((k0_) + j) * T]; } while (0)
#define SEL_KEY(x_, low_) ((((unsigned)(x_) ^ ((unsigned)(((int)((unsigned)(x_) << 16)) >> 31) | 0x8000u)) << 16) | (unsigned)(low_))
#define SEL_GRP(L_, B_, o_, k0_) do { unsigned nk_[16]; \
        _Pragma("unroll") for (int j = 0; j < 16; ++j) nk_[j] = SEL_KEY(B_[(o_) + j], 127 - ((k0_) + j)); \
        sort16_desc(nk_); merge16_desc(L_, nk_); } while (0)
#define SEL_HALF(L_, base_) do { const unsigned short* sp = (const unsigned short*)s0 + (size_t)(base_) * T; unsigned short bufa[32], bufb[32]; \
        SEL_LOAD(bufa, 0); \
        _Pragma("unroll 1") for (int k0 = 0; k0 < 128; k0 += 64) { \
            SEL_LOAD(bufb, k0 + 32); SEL_GRP(L_, bufa, 0, k0); SEL_GRP(L_, bufa, 16, k0 + 16); \
            SEL_LOAD(bufa, (k0 + 64) & 127); SEL_GRP(L_, bufb, 0, k0 + 32); SEL_GRP(L_, bufb, 16, k0 + 48); } } while (0)
        SEL_HALF(la, 0);
        SEL_HALF(lb, 128);
#undef SEL_LOAD
#undef SEL_KEY
#undef SEL_GRP
#undef SEL_HALF
        float va[16], vb[16];
#define SEL_VAL(key_) ((float)__builtin_bit_cast(_Float16, (unsigned short)(((key_) >> 16) ^ 0xffffu ^ ((unsigned)((int)(key_) >> 31) & 0x7fffu))))
#pragma unroll
        for (int k = 0; k < 16; ++k) {
            va[k] = SEL_VAL(la[k]); vb[k] = SEL_VAL(lb[k]);
            ib[k * NTHREADS + F.tid] = (unsigned char)(127u - (la[k] & 127u));
            ib[(16 + k) * NTHREADS + F.tid] = (unsigned char)(127u - (lb[k] & 127u));
        }
#undef SEL_VAL
        unsigned lc[16];
        { lc[0] = (fkey(va[0] + vb[0]) & ~255u) | 255u; lc[1] = (fkey(va[0] + vb[1]) & ~255u) | 254u; lc[2] = (fkey(va[0] + vb[2]) & ~255u) | 253u; lc[3] = (fkey(va[0] + vb[3]) & ~255u) | 252u; lc[4] = (fkey(va[0] + vb[4]) & ~255u) | 251u; lc[5] = (fkey(va[0] + vb[5]) & ~255u) | 250u; lc[6] = (fkey(va[0] + vb[6]) & ~255u) | 249u; lc[7] = (fkey(va[0] + vb[7]) & ~255u) | 248u; lc[8] = (fkey(va[0] + vb[8]) & ~255u) | 247u; lc[9] = (fkey(va[0] + vb[9]) & ~255u) | 246u; lc[10] = (fkey(va[0] + vb[10]) & ~255u) | 245u; lc[11] = (fkey(va[0] + vb[11]) & ~255u) | 244u; lc[12] = (fkey(va[0] + vb[12]) & ~255u) | 243u; lc[13] = (fkey(va[0] + vb[13]) & ~255u) | 242u; lc[14] = (fkey(va[0] + vb[14]) & ~255u) | 241u; lc[15] = (fkey(va[0] + vb[15]) & ~255u) | 240u; }
        sort16_desc(lc);
        { unsigned cg1[16]; cg1[0] = (fkey(va[1] + vb[0]) & ~255u) | 239u; cg1[1] = (fkey(va[1] + vb[1]) & ~255u) | 238u; cg1[2] = (fkey(va[1] + vb[2]) & ~255u) | 237u; cg1[3] = (fkey(va[1] + vb[3]) & ~255u) | 236u; cg1[4] = (fkey(va[1] + vb[4]) & ~255u) | 235u; cg1[5] = (fkey(va[1] + vb[5]) & ~255u) | 234u; cg1[6] = (fkey(va[1] + vb[6]) & ~255u) | 233u; cg1[7] = (fkey(va[1] + vb[7]) & ~255u) | 232u; cg1[8] = (fkey(va[2] + vb[0]) & ~255u) | 223u; cg1[9] = (fkey(va[2] + vb[1]) & ~255u) | 222u; cg1[10] = (fkey(va[2] + vb[2]) & ~255u) | 221u; cg1[11] = (fkey(va[2] + vb[3]) & ~255u) | 220u; cg1[12] = (fkey(va[2] + vb[4]) & ~255u) | 219u; cg1[13] = (fkey(va[3] + vb[0]) & ~255u) | 207u; cg1[14] = (fkey(va[3] + vb[1]) & ~255u) | 206u; cg1[15] = (fkey(va[3] + vb[2]) & ~255u) | 205u; sort16_desc(cg1); merge16_desc(lc, cg1); }
        { unsigned cg2[16]; cg2[0] = (fkey(va[3] + vb[3]) & ~255u) | 204u; cg2[1] = (fkey(va[4] + vb[0]) & ~255u) | 191u; cg2[2] = (fkey(va[4] + vb[1]) & ~255u) | 190u; cg2[3] = (fkey(va[4] + vb[2]) & ~255u) | 189u; cg2[4] = (fkey(va[5] + vb[0]) & ~255u) | 175u; cg2[5] = (fkey(va[5] + vb[1]) & ~255u) | 174u; cg2[6] = (fkey(va[6] + vb[0]) & ~255u) | 159u; cg2[7] = (fkey(va[6] + vb[1]) & ~255u) | 158u; cg2[8] = (fkey(va[7] + vb[0]) & ~255u) | 143u; cg2[9] = (fkey(va[7] + vb[1]) & ~255u) | 142u; cg2[10] = (fkey(va[8] + vb[0]) & ~255u) | 127u; cg2[11] = (fkey(va[9] + vb[0]) & ~255u) | 111u; cg2[12] = (fkey(va[10] + vb[0]) & ~255u) | 95u; cg2[13] = (fkey(va[11] + vb[0]) & ~255u) | 79u; cg2[14] = (fkey(va[12] + vb[0]) & ~255u) | 63u; cg2[15] = (fkey(va[13] + vb[0]) & ~255u) | 47u; sort16_desc(cg2); merge16_desc(lc, cg2); }
        { const unsigned key = (fkey(va[14] + vb[0]) & ~255u) | 31u; INSERT16(lc, key); }
        { const unsigned key = (fkey(va[15] + vb[0]) & ~255u) | 15u; INSERT16(lc, key); }
        float e[16], sum = 0.f; const float v0 = fkey_inv(lc[0] & ~255u);
#pragma unroll
        for (int k = 0; k < 16; ++k) { e[k] = __expf(fkey_inv(lc[k] & ~255u) - v0); sum += e[k]; }
        const float inv = 1.0f / sum;
        asm volatile("s_waitcnt lgkmcnt(0)" ::: "memory");
        unsigned exs[16]; float gws[16], sus[16];
#pragma unroll
        for (int k = 0; k < 16; ++k) {
            const unsigned pos = 255u - (lc[k] & 255u), a = pos >> 4, b = pos & 15u;
            const unsigned ea = ib[a * NTHREADS + F.tid], eb = ib[(16 + b) * NTHREADS + F.tid];
            exs[k] = ea * 128u + eb;
        }
#pragma unroll
        for (int k = 0; k < 16; ++k) { gws[k] = e[k] * inv * TSC[NEXP + exs[k]]; sus[k] = TSC[exs[k]]; }
        { const size_t o = (size_t)tok * 128 + head * 16;
#pragma unroll
          for (int q = 0; q < 2; ++q) { u32x4 w;
#pragma unroll
              for (int j = 0; j < 4; ++j) w[j] = exs[8 * q + 2 * j] | (exs[8 * q + 2 * j + 1] << 16);
              *(u32x4*)(IDX + o + 8 * q) = w; }
#pragma unroll
          for (int q = 0; q < 4; ++q) { *(f32x4*)(GW + o + 4 * q) = (f32x4){gws[4 * q], gws[4 * q + 1], gws[4 * q + 2], gws[4 * q + 3]};
                                        *(f32x4*)(SU + o + 4 * q) = (f32x4){sus[4 * q], sus[4 * q + 1], sus[4 * q + 2], sus[4 * q + 3]}; } }
        asm volatile("s_waitcnt lgkmcnt(0)" ::: "memory");
    }
}

DI float dpp_xor1(float v) { return __builtin_bit_cast(float, __builtin_amdgcn_mov_dpp(__builtin_bit_cast(int, v), 0xB1, 0xF, 0xF, true)); }
DI float dpp_xor2(float v) { return __builtin_bit_cast(float, __builtin_amdgcn_mov_dpp(__builtin_bit_cast(int, v), 0x4E, 0xF, 0xF, true)); }
DI float dpp_hmir(float v) { return __builtin_bit_cast(float, __builtin_amdgcn_mov_dpp(__builtin_bit_cast(int, v), 0x141, 0xF, 0xF, true)); }
DI float dot16_fp8(const u32x4 q, const float (&hx)[16]) {
    f32x2 a = {0.f, 0.f};
#pragma unroll
    for (int j = 0; j < 4; ++j) {
        const f32x2 lo = __builtin_amdgcn_cvt_pk_f32_fp8((int)q[j], false), hi = __builtin_amdgcn_cvt_pk_f32_fp8((int)q[j], true);
        a += lo * (f32x2){hx[4 * j], hx[4 * j + 1]}; a += hi * (f32x2){hx[4 * j + 2], hx[4 * j + 3]};
    }
    return a.x + a.y;
}
#define PEER_EXPERT(id, i) ((int)(((id)[(i) >> 3][((i) >> 1) & 3] >> (16 * ((i) & 1))) & 0xffffu))

DI int dpp_xor1i(int v) { return __builtin_amdgcn_mov_dpp(v, 0xB1, 0xF, 0xF, true); }
DI int dpp_xor2i(int v) { return __builtin_amdgcn_mov_dpp(v, 0x4E, 0xF, 0xF, true); }
DI int dpp_hmiri(int v) { return __builtin_amdgcn_mov_dpp(v, 0x141, 0xF, 0xF, true); }
struct PeerURows { u32x4 q[16]; u32x4 h[2]; };
DI void peer_u_rows(PeerURows& R, const u32x4 (&id)[2], const unsigned char* ut, const unsigned char* hrow) {
    R.h[0] = *(const u32x4*)(hrow); R.h[1] = *(const u32x4*)(hrow + 16);
#pragma unroll
    for (int i = 0; i < 16; ++i) R.q[i] = *(const u32x4*)(ut + (size_t)PEER_EXPERT(id, i) * (D / 2));
}
DI void peer_u_compute(const PeerURows& R, float* part, int lane) {
    int hsum = 0;
#pragma unroll
    for (int g = 0; g < 2; ++g)
#pragma unroll
        for (int j = 0; j < 4; ++j) hsum = __builtin_amdgcn_sdot4((int)R.h[g][j], 0x01010101, hsum, false);
    int d[16];
#pragma unroll
    for (int i = 0; i < 16; ++i) { int a = 0;
#pragma unroll
        for (int dw = 0; dw < 4; ++dw) {
            const unsigned w = R.q[i][dw];
            a = __builtin_amdgcn_sdot4((int)(w & 0x0f0f0f0fu), (int)R.h[dw >> 1][2 * (dw & 1)], a, false);
            a = __builtin_amdgcn_sdot4((int)((w >> 4) & 0x0f0f0f0fu), (int)R.h[dw >> 1][2 * (dw & 1) + 1], a, false);
        }
        d[i] = a - 8 * hsum; }
    const bool b2 = (lane & 4) != 0, b1 = (lane & 2) != 0, b0 = (lane & 1) != 0;
    int k8[8];
#pragma unroll
    for (int i = 0; i < 8; ++i) { const int keep = b2 ? d[8 + i] : d[i], send = b2 ? d[i] : d[8 + i]; k8[i] = keep + dpp_hmiri(send); }
    int k4[4];
#pragma unroll
    for (int i = 0; i < 4; ++i) { const int keep = b1 ? k8[4 + i] : k8[i], send = b1 ? k8[i] : k8[4 + i]; k4[i] = keep + dpp_xor2i(send); }
    f32x2 k2;
    { const int keep0 = b0 ? k4[2] : k4[0], send0 = b0 ? k4[0] : k4[2], keep1 = b0 ? k4[3] : k4[1], send1 = b0 ? k4[1] : k4[3];
      k2.x = (float)(keep0 + dpp_xor1i(send0)); k2.y = (float)(keep1 + dpp_xor1i(send1)); }
    *(f32x2*)(part + 16 * (lane >> 3) + (b2 ? 8 : 0) + (b1 ? 4 : 0) + (b0 ? 2 : 0)) = k2;
}
DI void phase_peer_u(const Params& p, const Frame& F, int l) {
    const int ntok = (l == 0) ? T : TL, lane = F.lane, half = ntok >> 1;
    const int grp = F.bid & 7, cs = grp & 3, th = grp >> 2, sw = (F.bid >> 3) * NWAVES + F.wave, nsw = (F.nb >> 3) * NWAVES;
    const unsigned char* ut = p.ws + WS_UTAB + (size_t)l * NEXP * (D / 2) + 128 * cs + 16 * (lane & 7);
    const unsigned char* Hs = p.ws + WS_H8 + 256 * cs + 32 * (lane & 7);
    const unsigned short* IDXg = (const unsigned short*)(p.ws + WS_IDX) + 16 * (lane >> 3);
    float* PART = (float*)(p.ws + WS_ST) + (size_t)cs * T * 128;
    const int t0 = th * half, tend = t0 + half, last = tend - 1;
    u32x4 sa[2], sb[2]; PeerURows ra, rb;
#define U_SEL(S_, t_) do { const unsigned short* ip_ = IDXg + (size_t)min((t_), last) * 128; S_[0] = *(const u32x4*)ip_; S_[1] = *(const u32x4*)(ip_ + 8); } while (0)
#define U_ROWS(R_, S_, t_) peer_u_rows(R_, S_, ut, Hs + (size_t)min((t_), last) * D)
    U_SEL(sa, t0 + sw); U_SEL(sb, t0 + sw + nsw);
    U_ROWS(ra, sa, t0 + sw);
#pragma unroll 1
    for (int tok = t0 + sw; tok < tend; tok += 2 * nsw) {
        U_SEL(sa, tok + 2 * nsw); U_ROWS(rb, sb, tok + nsw);
        peer_u_compute(ra, PART + (size_t)tok * 128, lane);
        U_SEL(sb, tok + 3 * nsw); U_ROWS(ra, sa, tok + 2 * nsw);
        if (tok + nsw < tend) peer_u_compute(rb, PART + (size_t)(tok + nsw) * 128, lane);
    }
#undef U_SEL
#undef U_ROWS
}
DI void phase_peer_c(const Params& p, const Frame& F, int l, bool dummy = false) {
    const int ntok = (l == 0) ? T : TL;
    const float* PART = (const float*)(p.ws + WS_ST);
    float* GW = (float*)(p.ws + WS_GW);
    float* CO = dummy ? (float*)(p.ws + WS_H8) : GW;
    const float* SU = (const float*)(p.ws + WS_SU);
    const float* HS = (const float*)(p.ws + WS_HS);
    for (int i0 = F.gtid; i0 < ntok * 128; i0 += 4 * F.ngt) {
        float s[4], gw[4], su[4];
#pragma unroll
        for (int u = 0; u < 4; ++u) {
            const int i = min(i0 + u * F.ngt, ntok * 128 - 1);
            s[u] = 0.f;
#pragma unroll
            for (int sl = 0; sl < 4; ++sl) s[u] += PART[(size_t)sl * T * 128 + i];
            gw[u] = GW[i]; su[u] = SU[i] * HS[i >> 7];
        }
#pragma unroll
        for (int u = 0; u < 4; ++u) { const int i = i0 + u * F.ngt; if (i < ntok * 128) CO[i] = gw[u] * gelu_tanh(s[u] * su[u]); }
    }
}
struct PeerVRows { u32x4 q[16]; f32x4 cf[4]; f32x4 xv, gv; };
DI void peer_v_rows(PeerVRows& R, const u32x4 (&id)[2], const unsigned char* vt, const float* cp, const float* xs, const float* gt2) {
    R.cf[0] = *(const f32x4*)cp; R.cf[1] = *(const f32x4*)(cp + 4); R.cf[2] = *(const f32x4*)(cp + 8); R.cf[3] = *(const f32x4*)(cp + 12);
    R.xv = *(const f32x4*)xs; R.gv = *(const f32x4*)gt2;
#pragma unroll
    for (int i = 0; i < 16; ++i) R.q[i] = *(const u32x4*)(vt + (size_t)PEER_EXPERT(id, i) * (D / 2));
}
DI float xchg32(float v, bool hi) { const auto r = __builtin_amdgcn_permlane32_swap(__builtin_bit_cast(unsigned, v), __builtin_bit_cast(unsigned, v), false, false);
    return __builtin_bit_cast(float, hi ? r[0] : r[1]); }
DI float xchg16(float v, bool hi) { const auto r = __builtin_amdgcn_permlane16_swap(__builtin_bit_cast(unsigned, v), __builtin_bit_cast(unsigned, v), false, false);
    return __builtin_bit_cast(float, hi ? r[0] : r[1]); }
DI float xchg8(float v) { return __builtin_bit_cast(float, __builtin_amdgcn_mov_dpp(__builtin_bit_cast(int, v), 0x128, 0xF, 0xF, true)); }
typedef _Float16 h16x2 __attribute__((ext_vector_type(2)));
DI unsigned xchg32u(unsigned v, bool hi) { const auto r = __builtin_amdgcn_permlane32_swap(v, v, false, false); return hi ? r[0] : r[1]; }
DI unsigned xchg16u(unsigned v, bool hi) { const auto r = __builtin_amdgcn_permlane16_swap(v, v, false, false); return hi ? r[0] : r[1]; }
DI unsigned xchg8u(unsigned v) { return (unsigned)__builtin_amdgcn_mov_dpp((int)v, 0x128, 0xF, 0xF, true); }
DI void peer_v_compute(const PeerVRows& R, float* xdst, int lane) {
    h16x2 a[16];
#pragma unroll
    for (int j = 0; j < 16; ++j) a[j] = (h16x2){(_Float16)0.f, (_Float16)0.f};
#pragma unroll
    for (int i = 0; i < 16; ++i) {
        const _Float16 ch = (_Float16)R.cf[i >> 2][i & 3]; const h16x2 c2 = {ch, ch};
#pragma unroll
        for (int d = 0; d < 4; ++d) {
            a[4 * d + 0] += c2 * __builtin_amdgcn_cvt_scalef32_pk_f16_fp4(R.q[i][d], 1.0f, 0);
            a[4 * d + 1] += c2 * __builtin_amdgcn_cvt_scalef32_pk_f16_fp4(R.q[i][d], 1.0f, 1);
            a[4 * d + 2] += c2 * __builtin_amdgcn_cvt_scalef32_pk_f16_fp4(R.q[i][d], 1.0f, 2);
            a[4 * d + 3] += c2 * __builtin_amdgcn_cvt_scalef32_pk_f16_fp4(R.q[i][d], 1.0f, 3);
        }
    }
    const bool b5 = (lane & 32) != 0, b4 = (lane & 16) != 0, b3 = (lane & 8) != 0;
    h16x2 k8[8];
#pragma unroll
    for (int j = 0; j < 8; ++j) { const h16x2 keep = b5 ? a[8 + j] : a[j], send = b5 ? a[j] : a[8 + j];
        k8[j] = keep + __builtin_bit_cast(h16x2, xchg32u(__builtin_bit_cast(unsigned, send), b5)); }
    h16x2 k4[4];
#pragma unroll
    for (int j = 0; j < 4; ++j) { const h16x2 keep = b4 ? k8[4 + j] : k8[j], send = b4 ? k8[j] : k8[4 + j];
        k4[j] = keep + __builtin_bit_cast(h16x2, xchg16u(__builtin_bit_cast(unsigned, send), b4)); }
    h16x2 k2[2];
#pragma unroll
    for (int j = 0; j < 2; ++j) { const h16x2 keep = b3 ? k4[2 + j] : k4[j], send = b3 ? k4[j] : k4[2 + j];
        k2[j] = keep + __builtin_bit_cast(h16x2, xchg8u(__builtin_bit_cast(unsigned, send))); }
    *(f32x4*)xdst = R.xv + R.gv * (f32x4){(float)k2[0].x, (float)k2[0].y, (float)k2[1].x, (float)k2[1].y};
}
DI void phase_peer_v(const Params& p, const Frame& F, int l, bool dummy = false) {
    const int ntok = (l == 0) ? T : TL, lane = F.lane, half = ntok >> 1;
    const int grp = F.bid & 7, cs = grp & 3, th = grp >> 2, sw = (F.bid >> 3) * NWAVES + F.wave, nsw = (F.nb >> 3) * NWAVES;
    const unsigned char* vt = p.ws + WS_VTAB + (size_t)l * NEXP * (D / 2) + 128 * cs + 16 * (lane & 7);
    const unsigned short* IDXg = (const unsigned short*)(p.ws + WS_IDX) + 16 * (lane >> 3);
    const float* CFg = (const float*)(p.ws + WS_GW) + 16 * (lane >> 3);
    const int t0 = th * half, tend = t0 + half, last = tend - 1;
    u32x4 sa[2], sb[2]; PeerVRows ra, rb;
#define V_SEL(S_, t_) do { const unsigned short* ip_ = IDXg + (size_t)min((t_), last) * 128; S_[0] = *(const u32x4*)ip_; S_[1] = *(const u32x4*)(ip_ + 8); } while (0)
    const int co = 256 * cs + 32 * (lane & 7) + ((lane & 32) ? 16 : 0) + ((lane & 16) ? 8 : 0) + ((lane & 8) ? 4 : 0);
#define V_ROWS(R_, S_, t_) do { const int t1_ = min((t_), last); peer_v_rows(R_, S_, vt, CFg + (size_t)t1_ * 128, xrow_ptr(p, t1_) + co, mod_vec(p, l, t1_, 5) + co); } while (0)
#define V_DO(R_, t_) do { const int t2_ = (t_); float* xd_ = (dummy ? (float*)(p.ws + WS_ST) + (size_t)t2_ * D : xrow_ptr(p, t2_)) + co; peer_v_compute(R_, xd_, lane); } while (0)
    V_SEL(sa, t0 + sw); V_SEL(sb, t0 + sw + nsw);
    V_ROWS(ra, sa, t0 + sw);
#pragma unroll 1
    for (int tok = t0 + sw; tok < tend; tok += 2 * nsw) {
        V_SEL(sa, tok + 2 * nsw); V_ROWS(rb, sb, tok + nsw);
        V_DO(ra, tok);
        V_SEL(sb, tok + 3 * nsw); V_ROWS(ra, sa, tok + 2 * nsw);
        if (tok + nsw < tend) V_DO(rb, tok + nsw);
    }
#undef V_SEL
#undef V_ROWS
#undef V_DO
}

#define XB_TMO      128
#define XB_XCNT(j)  (256  + 64 * (j))
#define XB_XSUB(j)  (1280 + 64 * (j))
#define XB_XGEN(j)  (2304 + 64 * (j))
#define XB_TOP      3328
#define XB_TOPGEN   3392
#define XCD_BAR_WORDS 3456
#define XB_SPIN_CAP (1u << 18)
DI unsigned xb_ld(unsigned* p)              { return __hip_atomic_load(p, __ATOMIC_RELAXED, __HIP_MEMORY_SCOPE_AGENT); }
DI unsigned xb_add(unsigned* p, unsigned v) { return __hip_atomic_fetch_add(p, v, __ATOMIC_RELAXED, __HIP_MEMORY_SCOPE_AGENT); }
DI unsigned xb_xcc_id() { return (unsigned)__builtin_amdgcn_s_getreg((3 << 11) | 20) & 0xFu; }
#define XB_SPIN(cond, bar) do { unsigned _sp = 0; while (cond) { __builtin_amdgcn_s_sleep(1); \
    if ((++_sp & 255u) == 0u) { if (xb_ld(&(bar)[XB_TMO])) break; if (_sp > XB_SPIN_CAP) { atomicAdd(&(bar)[XB_TMO], 1u); break; } } } } while (0)
struct XcdBarrier { unsigned* bar; unsigned x; volatile LAS unsigned* st; };
DI XcdBarrier xcd_barrier_post(unsigned* bar, volatile LAS unsigned* st) {
    XcdBarrier b; b.bar = bar; b.x = xb_xcc_id(); b.st = st;
    if (threadIdx.x == 0) (void)xb_add(&bar[XB_XCNT(b.x)], 1u);
    return b;
}
DI void xcd_barrier_complete(unsigned* bar, unsigned x, unsigned& nloc, unsigned& nx) {
    const unsigned G = gridDim.x * gridDim.y * gridDim.z;
    unsigned sum, cnt, mine, sp = 0u;
    for (;;) {
        sum = 0u; cnt = 0u; mine = 0u;
#pragma unroll
        for (unsigned j = 0; j < 16; ++j) { const unsigned c = xb_ld(&bar[XB_XCNT(j)]); sum += c; cnt += (c > 0u) ? 1u : 0u; mine = (j == x) ? c : mine; }
        if (sum == G) break;
        __builtin_amdgcn_s_sleep(1);
        if ((++sp & 255u) == 0u) { if (xb_ld(&bar[XB_TMO])) break; if (sp > XB_SPIN_CAP) { atomicAdd(&bar[XB_TMO], 1u); break; } }
    }
    nloc = mine > 0u ? mine : 1u; nx = cnt > 0u ? cnt : 1u;
}
DI void xcd_barrier(const XcdBarrier& b) {
    asm volatile("s_waitcnt vmcnt(0)" ::: "memory");
    __syncthreads();
    if (threadIdx.x == 0) {
        unsigned* bar = b.bar;
        __builtin_amdgcn_s_waitcnt(0);
        unsigned nloc = b.st[0], nx = b.st[1];
        if (nloc == 0u) { xcd_barrier_complete(bar, b.x, nloc, nx); b.st[0] = nloc; b.st[1] = nx; }
        const unsigned old = xb_add(&bar[XB_XSUB(b.x)], 1u);
        const unsigned gen = old / nloc;
        if (old + 1u == (gen + 1u) * nloc) {
            __builtin_amdgcn_fence(__ATOMIC_RELEASE, "agent");
            asm volatile("s_waitcnt vmcnt(0)" ::: "memory");
            const unsigned og = xb_add(&bar[XB_TOP], 1u);
            const unsigned tg = og / nx;
            if (og + 1u == (tg + 1u) * nx) xb_add(&bar[XB_TOPGEN], 1u);
            else XB_SPIN(xb_ld(&bar[XB_TOPGEN]) == tg, bar);
            __builtin_amdgcn_fence(__ATOMIC_ACQUIRE, "agent");
            xb_add(&bar[XB_XGEN(b.x)], 1u);
            asm volatile("s_waitcnt vmcnt(0)" ::: "memory");
        } else {
            XB_SPIN(xb_ld(&bar[XB_XGEN(b.x)]) == gen, bar);
            __builtin_amdgcn_fence(__ATOMIC_ACQUIRE, "agent");
            asm volatile("s_waitcnt vmcnt(0)" ::: "memory");
        }
    }
    __syncthreads();
}

constexpr int NPHASE = 25;
template <int PH> DI void run_phase(const Params& p, const Frame& F) {
    if constexpr (PH == 0) phase_prep(p, F);
    else if constexpr (PH == 1) phase_norm(p, F, 0, 0, true, T);
    else if constexpr (PH == 2) phase_g1(p, F, 0);
    else if constexpr (PH == 3) phase_mix(p, F, 0);
    else if constexpr (PH == 4) phase_g2(p, F, 0);
    else if constexpr (PH == 5) phase_g2sum(p, F);
    else if constexpr (PH == 6) phase_g3(p, F, 0);
    else if constexpr (PH == 7) phase_norm(p, F, 0, 1, false, T);
    else if constexpr (PH == 8) phase_g45(p, F, 0);
    else if constexpr (PH == 9) phase_sel(p, F, 0);
    else if constexpr (PH == 10) phase_peer_u(p, F, 0);
    else if constexpr (PH == 11) phase_peer_c(p, F, 0);
    else if constexpr (PH == 12) phase_peer_v(p, F, 0);
    else if constexpr (PH == 13) phase_norm(p, F, 1, 0, false, T);
    else if constexpr (PH == 14) phase_g1(p, F, 1);
    else if constexpr (PH == 15) phase_mix(p, F, 1);
    else if constexpr (PH == 16) phase_g2(p, F, 1);
    else if constexpr (PH == 17) phase_g3(p, F, 1);
    else if constexpr (PH == 18) phase_norm(p, F, 1, 1, false, TL);
    else if constexpr (PH == 19) phase_g45(p, F, 1);
    else if constexpr (PH == 20) phase_sel(p, F, 1);
    else if constexpr (PH == 21) phase_peer_u(p, F, 1);
    else if constexpr (PH == 22) phase_peer_c(p, F, 1);
    else if constexpr (PH == 23) phase_peer_v(p, F, 1);
    else if constexpr (PH == 24) phase_final(p, F);
}
DI Frame make_frame(unsigned char* lds_raw) {
    Frame F;
    F.lds = (LAS unsigned char*)lds_raw;
    int tid = threadIdx.x; asm volatile("" : "+v"(tid));
    int bid = blockIdx.x, nb = gridDim.x; asm volatile("" : "+s"(bid), "+s"(nb));
    F.tid = tid; F.lane = tid & 63; F.wave = __builtin_amdgcn_readfirstlane(tid >> 6); F.bid = bid; F.nb = nb;
    F.gw = bid * NWAVES + F.wave; F.ngw = nb * NWAVES; F.gtid = bid * NTHREADS + tid; F.ngt = nb * NTHREADS;
    return F;
}
template <int PH> DI void run_phase_fresh(unsigned char* lds_raw) {
#if defined(__HIP_DEVICE_COMPILE__)
    const __attribute__((address_space(4))) unsigned long long* pp = (const __attribute__((address_space(4))) unsigned long long*)__builtin_amdgcn_kernarg_segment_ptr();
    asm volatile("" : "+s"(pp));
    Params p;
#pragma unroll
    for (int i = 0; i < N_IN; ++i) p.in[i] = (const float*)(const __attribute__((address_space(1))) float*)pp[i];
    p.out = (float*)(__attribute__((address_space(1))) float*)pp[N_IN]; p.ws = (unsigned char*)(__attribute__((address_space(1))) unsigned char*)pp[N_IN + 1]; p.ph_lo = 0; p.ph_hi = 0;
#else
    Params p{};
#endif
    const Frame F = make_frame(lds_raw);
    run_phase<PH>(p, F);
}
template <int PH> __global__ void __launch_bounds__(NTHREADS, 2) phase_kernel(Params p) {
    extern __shared__ __attribute__((aligned(16))) unsigned char lds_raw[];
    run_phase_fresh<PH>(lds_raw);
}
template <int PH> DI void run_all(unsigned char* lds_raw, cg::grid_group& grid, const XcdBarrier& bar) {
    if constexpr (PH < NPHASE) {
        if constexpr (PH == PROBE_PH) {
            if constexpr (PH == 11 || PH == 22 || PH == 12 || PH == 23) {
#if defined(__HIP_DEVICE_COMPILE__)
                const __attribute__((address_space(4))) unsigned long long* pp = (const __attribute__((address_space(4))) unsigned long long*)__builtin_amdgcn_kernarg_segment_ptr();
                asm volatile("" : "+s"(pp));
                Params p;
#pragma unroll
                for (int i = 0; i < N_IN; ++i) p.in[i] = (const float*)(const __attribute__((address_space(1))) float*)pp[i];
                p.out = (float*)(__attribute__((address_space(1))) float*)pp[N_IN]; p.ws = (unsigned char*)(__attribute__((address_space(1))) unsigned char*)pp[N_IN + 1]; p.ph_lo = 0; p.ph_hi = 0;
                const Frame F = make_frame(lds_raw);
                if constexpr (PH == 11 || PH == 22) phase_peer_c(p, F, PH == 11 ? 0 : 1, true); else phase_peer_v(p, F, PH == 12 ? 0 : 1, true);
#endif
            } else run_phase_fresh<PH>(lds_raw);
            xcd_barrier(bar);
        }
        run_phase_fresh<PH>(lds_raw);
        if constexpr (PH + 1 < NPHASE) { xcd_barrier(bar); if constexpr (PROBE_SYNC) xcd_barrier(bar); }
        run_all<PH + 1>(lds_raw, grid, bar);
    }
}
__global__ void __launch_bounds__(NTHREADS, 2) mega(Params p) {
    extern __shared__ __attribute__((aligned(16))) unsigned char lds_raw[];
    cg::grid_group grid = cg::this_grid();
    volatile LAS unsigned* st = (volatile LAS unsigned*)((LAS unsigned char*)lds_raw + LDS_BAR_OFF);
    if (threadIdx.x < 2) st[threadIdx.x] = 0u;
    __syncthreads();
    const XcdBarrier bar = xcd_barrier_post((unsigned*)(p.ws + WS_CTL), st);
    if (p.ph_lo != 0) grid.sync();
    run_all<0>(lds_raw, grid, bar);
}

extern "C" void kernel_launch(void* const* d_in, const int* in_sizes, int n_in, void* d_out, int out_size, void* d_ws, size_t ws_size, hipStream_t stream) {
    static int grid = 0;
    if (grid == 0) {
        if (n_in != 23 || out_size != TL * D || ws_size < WS_END) { fprintf(stderr, "kernel_launch: unexpected shapes (n_in %d out %d ws %zu)\n", n_in, out_size, ws_size); grid = -1; return; }
        int dev = 0, cus = 0, per_cu = 0;
        (void)hipGetDevice(&dev);
        (void)hipDeviceGetAttribute(&cus, hipDeviceAttributeMultiprocessorCount, dev);
        (void)hipFuncSetAttribute((const void*)mega, hipFuncAttributeMaxDynamicSharedMemorySize, LDS_BYTES);
        (void)hipOccupancyMaxActiveBlocksPerMultiprocessor(&per_cu, (const void*)mega, NTHREADS, LDS_BYTES);
        if (per_cu < 1) { fprintf(stderr, "kernel_launch: occupancy query reports %d blocks per CU\n", per_cu); grid = -1; return; }
        grid = cus & ~7;
        if (grid < 8) { fprintf(stderr, "kernel_launch: needs at least 8 CUs\n"); grid = -1; return; }
    }
    if (grid < 0) return;
    (void)hipMemsetAsync((char*)d_ws + WS_CTL, 0, CTL_ZERO_BYTES, stream);
    Params p{};
    for (int i = 0; i < N_IN; ++i) p.in[i] = (const float*)d_in[i];
    p.out = (float*)d_out; p.ws = (unsigned char*)d_ws;
    void* args[] = {&p};
    hipError_t e = hipLaunchCooperativeKernel((const void*)mega, dim3(grid), dim3(NTHREADS), args, LDS_BYTES, stream);
    if (e != hipSuccess) fprintf(stderr, "cooperative launch failed: %s (grid %d)\n", hipGetErrorString(e), grid);
}
```

```cpp
#include <hip/hip_runtime.h>
#include <hip/hip_cooperative_groups.h>
#include <stdint.h>
#include <stdio.h>
namespace cg = cooperative_groups;

#ifndef PROBE_PH
#define PROBE_PH -1
#endif
#ifndef PROBE_SYNC
#define PROBE_SYNC 0
#endif
#ifndef MK_SINGLE
#define MK_SINGLE 0
#endif

#define LAS __attribute__((address_space(3)))
typedef unsigned short bf16_t;
typedef short bf16x8 __attribute__((ext_vector_type(8)));
typedef short s16x4 __attribute__((ext_vector_type(4)));
typedef float f32x4 __attribute__((ext_vector_type(4)));
typedef float f32x2 __attribute__((ext_vector_type(2)));
typedef float f32x16 __attribute__((ext_vector_type(16)));
typedef unsigned u32x4 __attribute__((ext_vector_type(4)));
typedef unsigned u32x2 __attribute__((ext_vector_type(2)));
typedef __bf16 bf16x2_t __attribute__((ext_vector_type(2)));
typedef _Float16 f16x2_t __attribute__((ext_vector_type(2)));
#define DI __device__ __forceinline__
DI unsigned pkh2(float lo, float hi) { f16x2_t v = {(_Float16)lo, (_Float16)hi}; return __builtin_bit_cast(unsigned, v); }
#define MFMA32(a, b, c) __builtin_amdgcn_mfma_f32_32x32x16_bf16((a), (b), (c), 0, 0, 0)

constexpr int D = 1024, NB = 8, SEQ = 4096, NCTX = 256, DEPTH = 2;
constexpr int TL = NB * SEQ, TC = NB * NCTX, T = TL + TC;
constexpr int INW = 4608, NMOD = 6 * D, PW = 1600, PN = 1536;
constexpr int VTS = SEQ + 64;
constexpr int QOFF = 0, KOFF = 512, VOFF = 640, POOLOFF = 768, SUOFF = 1024, SVOFF = 1280, GATEOFF = 1536;
constexpr int NEXP = 16384;
constexpr float EPS = 1e-6f;
constexpr float LOG2E = 1.4426950408889634f;
constexpr float QSCALE = 0.125f * LOG2E;

constexpr size_t MiB = 1u << 20;
constexpr size_t WS_CTL = 0, WS_MOD = 1 * MiB, CTL_ZERO_BYTES = 2 * MiB;
constexpr size_t WS_ROPE = 2 * MiB, WS_SGUW = 2 * MiB + 65536, WS_TSCALE = 3 * MiB;
constexpr size_t WS_WIN = 4 * MiB, WS_WBR = 22 * MiB, WS_WOUT = 26 * MiB, WS_WFOLD = 30 * MiB;
constexpr size_t WS_XCTX = 38 * MiB, WS_UTAB = 46 * MiB, WS_VTAB = 78 * MiB;
constexpr size_t WS_IDX = 110 * MiB, WS_GW = 120 * MiB;
constexpr size_t WS_H = 142 * MiB;
constexpr size_t WS_P = 210 * MiB, WS_Y = 318 * MiB, WS_MERGED = 386 * MiB, WS_VT = 454 * MiB, WS_VTC = 463 * MiB, WS_VST = 464 * MiB;
constexpr size_t WS_MP = 482 * MiB;
constexpr size_t WS_ST = 210 * MiB, WS_H8 = 346 * MiB, WS_HS = 380 * MiB, WS_SU = 482 * MiB;
constexpr size_t WS_END = 512 * MiB;
static_assert(WS_ST + (size_t)2048 * T * 2 <= WS_H8 && WS_H8 + (size_t)T * D <= WS_HS, "ST / H8 fit");
static_assert(WS_VST + (size_t)272 * 256 * 128 * 2 <= WS_SU && WS_VT + (size_t)NB * 2 * 64 * VTS * 2 <= WS_VTC, "VsT / VT fit");
static_assert(WS_H + (size_t)T * D * 2 <= WS_P, "H fits");
static_assert(WS_P + (size_t)T * PW * 2 <= WS_Y && WS_Y + (size_t)T * D * 2 <= WS_MERGED && WS_MERGED + (size_t)T * D * 2 <= WS_VT, "P/Y/MERGED fit");
static_assert(WS_IDX + (size_t)T * 128 * 2 <= WS_GW && WS_GW + (size_t)T * 128 * 4 <= WS_H && WS_SU + (size_t)T * 128 * 4 <= WS_END && WS_HS + (size_t)T * 4 <= WS_SU, "idx/gw/su fit");

constexpr int LDS_BYTES = 163840;
constexpr int LDS_BAR_OFF = LDS_BYTES - 64;
constexpr int NTHREADS = 512, NWAVES = 8;

enum { I_x, I_c, I_ctx, I_c_ctx, I_w_mod, I_b_mod, I_g_mix, I_g_ffn, I_w_in, I_attn_sink, I_pool_w, I_pool_scale, I_sgu_w, I_sgu_b, I_w_br_attn, I_w_br_pool, I_w_br_sgu, I_w_out, I_peer_wq, I_peer_subkeys, I_peer_u, I_peer_v, I_g_final, N_IN };
struct Params {
    const float* in[N_IN];
    float* out; unsigned char* ws;
    int ph_lo, ph_hi;
};

DI unsigned pk2(float lo, float hi) { f32x2 v = {lo, hi}; return __builtin_bit_cast(unsigned, __builtin_convertvector(v, bf16x2_t)); }
DI unsigned f2bf(float f) { return pk2(f, 0.f) & 0xffffu; }
DI float bf2f(unsigned short u) { return __builtin_bit_cast(float, (unsigned)u << 16); }
DI float bflo(unsigned w) { return __builtin_bit_cast(float, w << 16); }
DI float bfhi(unsigned w) { return __builtin_bit_cast(float, w & 0xffff0000u); }
DI int crow(int reg, int h) { return (reg & 3) + 8 * (reg >> 2) + 4 * h; }
DI int dpp_x1(int v) { return __builtin_amdgcn_mov_dpp(v, 0xB1, 0xF, 0xF, true); }
DI float wave_sum(float v) {
#pragma unroll
    for (int o = 1; o < 64; o <<= 1) v += __shfl_xor(v, o);
    return v;
}
DI float sigmoidf_(float x) { return __builtin_amdgcn_rcpf(1.0f + __expf(-x)); }
DI float gelu_tanh(float x) { const float u = 0.7978845608028654f * (x + 0.044715f * x * x * x); return x * __builtin_amdgcn_rcpf(1.0f + __expf(-2.0f * u)); }
DI float silu_(float x) { return x * __builtin_amdgcn_rcpf(1.0f + __expf(-x)); }

struct Frame {
    int tid, lane, wave, gw, ngw, gtid, ngt, bid, nb;
    LAS unsigned char* lds;
};

template <int NM, int NN>
DI void wave_gemm(const bf16_t* __restrict__ A, int lda, const bf16_t* __restrict__ Bt, int ldb, int K, int m0, int n0, f32x16 (&acc)[NM][NN], int lane) {
    const int r = lane & 31, h = lane >> 5;
    const bf16_t* ap = A + (size_t)(m0 + r) * lda + 8 * h;
    const bf16_t* bp = Bt + (size_t)(n0 + r) * ldb + 8 * h;
    for (int k0 = 0; k0 < K; k0 += 64) {
        bf16x8 a[4][NM], b[4][NN];
#pragma unroll
        for (int s = 0; s < 4; ++s) {
#pragma unroll
            for (int i = 0; i < NM; ++i) a[s][i] = *(const bf16x8*)(ap + (size_t)(32 * i) * lda + k0 + 16 * s);
#pragma unroll
            for (int j = 0; j < NN; ++j) b[s][j] = *(const bf16x8*)(bp + (size_t)(32 * j) * ldb + k0 + 16 * s);
        }
#pragma unroll
        for (int s = 0; s < 4; ++s)
#pragma unroll
            for (int i = 0; i < NM; ++i)
#pragma unroll
                for (int j = 0; j < NN; ++j) acc[i][j] = MFMA32(a[s][i], b[s][j], acc[i][j]);
    }
}
template <int NM, int NN> DI void zero_acc(f32x16 (&acc)[NM][NN]) {
#pragma unroll
    for (int i = 0; i < NM; ++i)
#pragma unroll
        for (int j = 0; j < NN; ++j)
#pragma unroll
            for (int r = 0; r < 16; ++r) acc[i][j][r] = 0.f;
}

namespace pg8 {
constexpr int BM = 256, BK = 64, HALF = 128, HTB = HALF * BK * 2, STAGE_BYTES = 8 * HTB, NXCD = 8, WGM = 8, LD = 1024;
DI int lds_byte(int r, int c) { const int st = (r >> 4) * 2 + (c >> 5), rr = r & 15, cc = c & 31, ob = rr * 64 + cc * 2; return st * 1024 + (ob ^ (((ob >> 9) & 1) << 5)); }
DI void stage_rc(int b, int& R, int& C) { const int st = b / 1024, sb = b % 1024, swz = sb ^ (((sb >> 9) & 1) << 5); R = (st >> 1) * 16 + swz / 64; C = (st & 1) * 32 + (swz % 64) / 2; }
DI int perm32(int rho) { const int n = rho >> 4, i = rho & 15; return 8 * (i >> 2) + 4 * n + (i & 3); }
struct Unit { int pm, pn, sub, nt, mode; const char* a; const char* b; };
DI void tile_of(int L, int nM, int nN, int& pm, int& pn) {
    const int nwg = nM * nN; int wgid = L;
    { const int q = nwg / NXCD, r = nwg % NXCD, xcd = wgid % NXCD, off = wgid / NXCD; wgid = (xcd < r ? xcd * (q + 1) : r * (q + 1) + (xcd - r) * q) + off; }
    const int nig = WGM * nN, gid = wgid / nig, fm = gid * WGM, gsz = (nM - fm) < WGM ? (nM - fm) : WGM;
    pm = fm + ((wgid % nig) % gsz); pn = (wgid % nig) / gsz;
}
template <class Epi, class Sched>
DI void gemm_phase(LAS unsigned char* lds, const int tid, const Sched& S, const Epi& E) {
    const int wid = __builtin_amdgcn_readfirstlane(tid >> 6), lane = tid & 63, wr = wid >> 2, wc = wid & 3, fr = lane & 15, fq = lane >> 4;
    unsigned voffA[2], voffB[2];
#pragma unroll
    for (int i = 0; i < 2; ++i) { int R, C; stage_rc(tid * 16 + i * 8192, R, C); const int Rb = Epi::PERM ? ((R & ~31) + perm32(R & 31)) : R;
        voffA[i] = (unsigned)(R * LD + C) * 2u; voffB[i] = (unsigned)(Rb * LD + C) * 2u; }
    const size_t kstep = (size_t)(BK * 2);
    const size_t hstep = (size_t)HALF * LD * 2;
    const unsigned ldsw = (unsigned)wid * 1024u;
    const int aoff = lds_byte(wr * 64 + fr, fq * 8), boff = lds_byte(wc * 32 + fr, fq * 8);
#define PG8_SA(b, h) (((b) * 2 + (h)) * HTB)
#define PG8_SB(b, h) ((4 + (b) * 2 + (h)) * HTB)
#define PG8_STAGE(bufoff, gbase, voff) do { _Pragma("unroll") for (int _i = 0; _i < 2; ++_i) \
        __builtin_amdgcn_global_load_lds((const unsigned*)((const char*)(gbase) + (voff)[_i]), (LAS unsigned*)(lds + (bufoff) + ldsw + _i * 8192), 16, 0, 0); } while (0)
#define PG8_LDA(dst, b, h) do { _Pragma("unroll") for (int m = 0; m < 4; ++m) _Pragma("unroll") for (int k = 0; k < 2; ++k) dst[m][k] = *(const LAS bf16x8*)(lds + PG8_SA(b, h) + aoff + m * 2048 + k * 1024); } while (0)
#define PG8_LDB(dst, b, h) do { _Pragma("unroll") for (int n = 0; n < 2; ++n) _Pragma("unroll") for (int k = 0; k < 2; ++k) dst[n][k] = *(const LAS bf16x8*)(lds + PG8_SB(b, h) + boff + n * 2048 + k * 1024); } while (0)
#define PG8_MMA(ai, bj, At, Bt) do { __builtin_amdgcn_s_setprio(1); _Pragma("unroll") for (int m = 0; m < 4; ++m) _Pragma("unroll") for (int n = 0; n < 2; ++n) _Pragma("unroll") for (int k = 0; k < 2; ++k) \
        acc[ai][bj][m][n] = __builtin_amdgcn_mfma_f32_16x16x32_bf16(Bt[n][k], At[m][k], acc[ai][bj][m][n], 0, 0, 0); __builtin_amdgcn_s_setprio(0); } while (0)
#define PG8_WAIT_V(n) asm volatile("s_waitcnt vmcnt(" #n ")" ::: "memory")
#define PG8_WAIT_L(n) asm volatile("s_waitcnt lgkmcnt(" #n ")" ::: "memory")
#define PG8_BAR __builtin_amdgcn_s_barrier()
#define PG8_SCHED __builtin_amdgcn_sched_barrier(0)
    Unit cur, nxt; int ui = 0;
    if (!S.next(0, cur)) return;
    f32x4 acc[2][2][4][2];
#pragma unroll
    for (int a = 0; a < 2; ++a)
#pragma unroll
        for (int b = 0; b < 2; ++b)
#pragma unroll
            for (int m = 0; m < 4; ++m)
#pragma unroll
                for (int n = 0; n < 2; ++n) acc[a][b][m][n] = (f32x4){0.f, 0.f, 0.f, 0.f};
    bf16x8 At[4][2], B0[2][2], B1[2][2];
    const char* cA = cur.a; const char* cB = cur.b;
    PG8_STAGE(PG8_SB(0, 0), cB, voffB); PG8_STAGE(PG8_SB(0, 1), cB + hstep, voffB); PG8_STAGE(PG8_SA(0, 0), cA, voffA); PG8_STAGE(PG8_SA(0, 1), cA + hstep, voffA);
    if (wr == 1) PG8_BAR;
    PG8_WAIT_V(2); PG8_BAR;
    PG8_STAGE(PG8_SB(1, 0), cB + kstep, voffB); PG8_STAGE(PG8_SA(1, 0), cA + kstep, voffA); PG8_STAGE(PG8_SB(1, 1), cB + hstep + kstep, voffB);
    PG8_WAIT_V(6); PG8_BAR;
    for (;;) {
        const bool has_next = S.next(ui + 1, nxt);
        const char* nA = has_next ? nxt.a : cA; const char* nB = has_next ? nxt.b : cB;
        const int nt = cur.nt;
        for (int t = 0; t < nt; t += 2) {
            const bool last = (t == nt - 2);
            const char* a1 = cA + (size_t)(t + 1) * kstep;
            const char* a2 = last ? nA : cA + (size_t)(t + 2) * kstep; const char* b2 = last ? nB : cB + (size_t)(t + 2) * kstep;
            const char* a3 = a2 + kstep; const char* b3 = b2 + kstep;
            PG8_LDB(B0, 0, 0); PG8_LDB(B1, 0, 1); PG8_SCHED; PG8_LDA(At, 0, 0); PG8_STAGE(PG8_SA(1, 1), a1 + hstep, voffA);
            PG8_WAIT_V(8); PG8_WAIT_L(0); PG8_BAR; PG8_MMA(0, 0, At, B0); PG8_MMA(0, 1, At, B1); PG8_BAR; PG8_SCHED;
            PG8_LDA(At, 0, 1); PG8_STAGE(PG8_SB(0, 0), b2, voffB); PG8_STAGE(PG8_SB(0, 1), b2 + hstep, voffB); PG8_STAGE(PG8_SA(0, 0), a2, voffA);
            PG8_WAIT_V(8); PG8_WAIT_L(0); PG8_BAR; PG8_MMA(1, 0, At, B0); PG8_MMA(1, 1, At, B1); PG8_BAR; PG8_SCHED;
            PG8_LDB(B0, 1, 0); PG8_LDB(B1, 1, 1); PG8_SCHED; PG8_LDA(At, 1, 0); PG8_STAGE(PG8_SA(0, 1), a2 + hstep, voffA);
            PG8_WAIT_V(8); PG8_WAIT_L(0); PG8_BAR; PG8_MMA(0, 0, At, B0); PG8_MMA(0, 1, At, B1); PG8_BAR; PG8_SCHED;
            PG8_LDA(At, 1, 1); PG8_STAGE(PG8_SB(1, 0), b3, voffB); PG8_STAGE(PG8_SB(1, 1), b3 + hstep, voffB); PG8_STAGE(PG8_SA(1, 0), a3, voffA);
            PG8_WAIT_V(8); PG8_WAIT_L(0); PG8_BAR; PG8_MMA(1, 0, At, B0); PG8_MMA(1, 1, At, B1); PG8_BAR; PG8_SCHED;
        }
        if (wr == 0) PG8_BAR;
        E(acc, cur, wr, wc, fr, fq);
        if (!has_next) break;
        if (!E.keeps(cur)) {
#pragma unroll
        for (int a = 0; a < 2; ++a)
#pragma unroll
            for (int b = 0; b < 2; ++b)
#pragma unroll
                for (int m = 0; m < 4; ++m)
#pragma unroll
                    for (int n = 0; n < 2; ++n) acc[a][b][m][n] = (f32x4){0.f, 0.f, 0.f, 0.f};
        }
        cur = nxt; cA = nA; cB = nB; ++ui;
        if (wr == 1) PG8_BAR;
    }
    PG8_WAIT_V(0);
    PG8_BAR;
#undef PG8_SA
#undef PG8_SB
#undef PG8_STAGE
#undef PG8_LDA
#undef PG8_LDB
#undef PG8_MMA
#undef PG8_WAIT_V
#undef PG8_WAIT_L
#undef PG8_BAR
#undef PG8_SCHED
}
}

DI void transpose_item(const float* W, int K, int N, bf16_t* WT, int ldd, int row_off, int col_off, LAS float* scr, int item, int lane) {
    const int nblk = N / 32, kb = item / nblk, nb = item % nblk, k0 = 64 * kb, n0 = 32 * nb;
#pragma unroll 8
    for (int i = 0; i < 32; ++i) { const int kk = 2 * i + (lane >> 5); scr[kk * 33 + (lane & 31)] = W[(size_t)(k0 + kk) * N + n0 + (lane & 31)]; }
    asm volatile("s_waitcnt lgkmcnt(0)" ::: "memory");
    const int c = lane & 7;
#pragma unroll
    for (int j = 0; j < 4; ++j) { const int n = (lane >> 3) + 8 * j; const LAS float* s = scr + (8 * c) * 33 + n;
        u32x4 o; o.x = pk2(s[0 * 33], s[1 * 33]); o.y = pk2(s[2 * 33], s[3 * 33]); o.z = pk2(s[4 * 33], s[5 * 33]); o.w = pk2(s[6 * 33], s[7 * 33]);
        *(u32x4*)(WT + (size_t)(row_off + n0 + n) * ldd + col_off + k0 + 8 * c) = o; }
    asm volatile("s_waitcnt lgkmcnt(0)" ::: "memory");
}

DI void convert_tables(const Params& p, const Frame& F) {
    for (int it0 = 4 * F.gw; it0 < 4 * NEXP; it0 += 4 * F.ngw) {
        f32x4 v[4][4];
#pragma unroll
        for (int u = 0; u < 4; ++u) {
            const int it = it0 + u, e = it & (NEXP - 1), tbl = (it >> 14) & 1, l = it >> 15;
            const f32x4* src = (const f32x4*)((tbl ? p.in[I_peer_v] : p.in[I_peer_u]) + ((size_t)l * NEXP + e) * D) + 4 * F.lane;
#pragma unroll
            for (int j = 0; j < 4; ++j) v[u][j] = src[j];
        }
#pragma unroll
        for (int u = 0; u < 4; ++u) {
            const int it = it0 + u, e = it & (NEXP - 1), tbl = (it >> 14) & 1, l = it >> 15;
            float am = 0.f;
#pragma unroll
            for (int j = 0; j < 4; ++j) am = fmaxf(am, fmaxf(fmaxf(fabsf(v[u][j].x), fabsf(v[u][j].y)), fmaxf(fabsf(v[u][j].z), fabsf(v[u][j].w))));
#pragma unroll
            for (int o = 1; o < 64; o <<= 1) am = fmaxf(am, __shfl_xor(am, o));
            float sc;
            if (tbl) sc = (am > 0.f) ? 6.0f / am : 1.0f;
            else {
                float ss = 0.f;
#pragma unroll
                for (int j = 0; j < 4; ++j) ss += v[u][j].x * v[u][j].x + v[u][j].y * v[u][j].y + v[u][j].z * v[u][j].z + v[u][j].w * v[u][j].w;
                const float rms = sqrtf(wave_sum(ss) * (1.0f / D));
                const float step = fminf(am * (1.0f / 7.0f), 0.335f * rms);
                sc = (step > 0.f) ? 1.0f / step : 1.0f;
            }
            if (tbl) {
                u32x2 q4;
#pragma unroll
                for (int d = 0; d < 2; ++d) { unsigned w = 0;
                    w = __builtin_amdgcn_cvt_scalef32_pk_fp4_f32(w, v[u][2 * d][0] * sc, v[u][2 * d][1] * sc, 1.0f, 0);
                    w = __builtin_amdgcn_cvt_scalef32_pk_fp4_f32(w, v[u][2 * d][2] * sc, v[u][2 * d][3] * sc, 1.0f, 1);
                    w = __builtin_amdgcn_cvt_scalef32_pk_fp4_f32(w, v[u][2 * d + 1][0] * sc, v[u][2 * d + 1][1] * sc, 1.0f, 2);
                    w = __builtin_amdgcn_cvt_scalef32_pk_fp4_f32(w, v[u][2 * d + 1][2] * sc, v[u][2 * d + 1][3] * sc, 1.0f, 3);
                    q4[d] = w; }
                *(u32x2*)(p.ws + WS_VTAB + ((size_t)l * NEXP + e) * (D / 2) + 8 * F.lane) = q4;
            } else {
                u32x2 q4;
#pragma unroll
                for (int d = 0; d < 2; ++d) { unsigned w = 0;
#pragma unroll
                    for (int b = 0; b < 4; ++b) { const int j = 2 * d + (b >> 1), e2 = 2 * (b & 1);
                        const int n0 = (int)fminf(fmaxf(__builtin_rintf(v[u][j][e2] * sc), -8.0f), 7.0f) + 8, n1 = (int)fminf(fmaxf(__builtin_rintf(v[u][j][e2 + 1] * sc), -8.0f), 7.0f) + 8;
                        w |= (unsigned)(n0 | (n1 << 4)) << (8 * b); }
                    q4[d] = w; }
                *(u32x2*)(p.ws + WS_UTAB + ((size_t)l * NEXP + e) * (D / 2) + 8 * F.lane) = q4;
            }
            if (F.lane == 0) ((float*)(p.ws + WS_TSCALE))[(l * 2 + tbl) * NEXP + e] = 1.0f / sc;
        }
    }
}

DI void phase_prep(const Params& p, const Frame& F) {
    unsigned char* ws = p.ws;
    {
        LAS float* wq = (LAS float*)F.lds;
        LAS float* skl = wq + 128 * 65;
        for (int it = F.bid; it < 2 * 16 * 16; it += F.nb) {
            const int cc = it & 15, hp = (it >> 4) & 15, l = it >> 8;
            const float* src = p.in[I_peer_wq] + (size_t)l * D * 2048 + hp * 128;
            const float* sks = p.in[I_peer_subkeys] + (size_t)(l * 16 + hp) * 128 * 128;
            __syncthreads();
            { float tw[16]; f32x4 ts[8];
#pragma unroll
              for (int it = 0; it < 16; ++it) { const int e = F.tid + it * NTHREADS, ci = e >> 7, d = e & 127; tw[it] = src[(size_t)(cc * 64 + ci) * 2048 + d]; }
#pragma unroll
              for (int it = 0; it < 8; ++it) { const int e = F.tid + it * NTHREADS, key = e >> 5, d4 = (e & 31) * 4; ts[it] = *(const f32x4*)(sks + key * 128 + d4); }
#pragma unroll
              for (int it = 0; it < 16; ++it) { const int e = F.tid + it * NTHREADS, ci = e >> 7, d = e & 127; wq[d * 65 + ci] = tw[it]; }
#pragma unroll
              for (int it = 0; it < 8; ++it) { const int e = F.tid + it * NTHREADS, key = e >> 5, d4 = (e & 31) * 4; *(LAS f32x4*)(skl + key * 132 + d4) = ts[it]; } }
            __syncthreads();
            const int ci = F.tid & 63, kg = F.tid >> 6;
            float acc[16];
#pragma unroll
            for (int k = 0; k < 16; ++k) acc[k] = 0.f;
#pragma unroll 2
            for (int d = 0; d < 128; d += 4) {
                const float w0 = wq[d * 65 + ci], w1 = wq[(d + 1) * 65 + ci], w2 = wq[(d + 2) * 65 + ci], w3 = wq[(d + 3) * 65 + ci];
#pragma unroll
                for (int k = 0; k < 16; ++k) { const f32x4 s = *(const LAS f32x4*)(skl + (16 * kg + k) * 132 + d); acc[k] += w0 * s.x + w1 * s.y + w2 * s.z + w3 * s.w; }
            }
            bf16_t* dst = (bf16_t*)(ws + WS_WFOLD) + ((size_t)l * 2048 + hp * 128 + 16 * kg) * D + cc * 64 + ci;
#pragma unroll
            for (int k = 0; k < 16; ++k) dst[(size_t)k * D] = (bf16_t)f2bf(acc[k]);
        }
        __syncthreads();
    }
    {
        LAS float* scr = (LAS float*)(F.lds + F.wave * 16384);
        constexpr int I_IN = (D / 64) * (INW / 32), I_BA = (512 / 64) * (D / 32), I_BS = (256 / 64) * (D / 32), I_O = (D / 64) * (D / 32);
        constexpr int PER_L = I_IN + I_BA + I_BS + I_O;
        for (int it = F.gw; it < 2 * PER_L; it += F.ngw) {
            const int l = it / PER_L; int r = it % PER_L;
            if (r < I_IN) { transpose_item(p.in[I_w_in] + (size_t)l * D * INW, D, INW, (bf16_t*)(ws + WS_WIN) + (size_t)l * INW * D, D, 0, 0, scr, r, F.lane); continue; } r -= I_IN;
            if (r < I_BA) { transpose_item(p.in[I_w_br_attn] + (size_t)l * 512 * D, 512, D, (bf16_t*)(ws + WS_WBR) + (size_t)l * D * D, D, 0, 0, scr, r, F.lane); continue; } r -= I_BA;
            if (r < I_BS) { transpose_item(p.in[I_w_br_sgu] + (size_t)l * 256 * D, 256, D, (bf16_t*)(ws + WS_WBR) + (size_t)l * D * D, D, 0, 768, scr, r, F.lane); continue; } r -= I_BS;
            transpose_item(p.in[I_w_out] + (size_t)l * D * D, D, D, (bf16_t*)(ws + WS_WOUT) + (size_t)l * D * D, D, 0, 0, scr, r, F.lane);
        }
    }
    for (int i = F.gtid; i < 2 * 256 * D; i += F.ngt) {
        const int n = i & 1023, rc = (i >> 10) & 255, l = i >> 18, g = rc >> 6;
        const float* pw = p.in[I_pool_w] + ((size_t)l * 256 + rc) * 64;
        const float* ps = p.in[I_pool_scale] + l * 256 + 64 * g;
        const float* wb = p.in[I_w_br_pool] + ((size_t)l * 256 + 64 * g) * D + n;
        float a = 0.f;
#pragma unroll 16
        for (int e = 0; e < 64; ++e) a += pw[e] * ps[e] * wb[(size_t)e * D];
        ((bf16_t*)(ws + WS_WBR))[(size_t)l * D * D + (size_t)n * D + 512 + rc] = (bf16_t)f2bf(a);
    }
    for (int i = F.gtid; i < 2 * 4 * 128 * 128; i += F.ngt) ((bf16_t*)(ws + WS_SGUW))[i] = (bf16_t)f2bf(p.in[I_sgu_w][i]);
    for (int i = F.gtid; i < 64 * 16; i += F.ngt) {
        const int pos = i >> 4, fi = i & 15;
        const float inv = powf(10000.0f, -(float)fi / 16.0f);
        const float ang = (float)pos * inv;
        ((f32x2*)(ws + WS_ROPE))[i] = (f32x2){cosf(ang), sinf(ang)};
    }
    convert_tables(p, F);
    {
        float* MOD = (float*)(ws + WS_MOD);
        LAS float* scd = (LAS float*)F.lds;
        LAS float* red = scd + 9 * D;
        __syncthreads();
        { float tc[18];
#pragma unroll
          for (int it = 0; it < 18; ++it) { const int e = F.tid + it * NTHREADS, r = e >> 10, k = e & 1023; tc[it] = (r < 8) ? p.in[I_c][r * D + k] : p.in[I_c_ctx][k]; }
#pragma unroll
          for (int it = 0; it < 18; ++it) scd[F.tid + it * NTHREADS] = silu_(tc[it]); }
        __syncthreads();
        for (int it = F.bid; it < 2 * 96; it += F.nb) {
            const int cgp = it % 96, l = it / 96, col = cgp * 64 + F.lane;
            float acc[9];
#pragma unroll
            for (int r = 0; r < 9; ++r) acc[r] = 0.f;
            const float* wp = p.in[I_w_mod] + ((size_t)l * D + F.wave * 128) * NMOD + col;
#pragma unroll 16
            for (int k = 0; k < 128; ++k) {
                const float w = wp[(size_t)k * NMOD];
#pragma unroll
                for (int r = 0; r < 9; ++r) acc[r] += scd[r * D + F.wave * 128 + k] * w;
            }
#pragma unroll
            for (int r = 0; r < 9; ++r) red[(F.wave * 9 + r) * 64 + F.lane] = acc[r];
            __syncthreads();
            for (int e = F.tid; e < 9 * 64; e += NTHREADS) {
                const int r = e >> 6, ln = e & 63; float s = p.in[I_b_mod][l * NMOD + cgp * 64 + ln];
#pragma unroll
                for (int w = 0; w < 8; ++w) s += red[(w * 9 + r) * 64 + ln];
                MOD[((size_t)l * 9 + r) * NMOD + cgp * 64 + ln] = s;
            }
            __syncthreads();
        }
    }
}

DI const float* mod_vec(const Params& p, int l, int row, int j) {
    const int r = row < TL ? row / SEQ : 8;
    return (const float*)(p.ws + WS_MOD) + ((size_t)l * 9 + r) * NMOD + j * D;
}
DI float* xrow_ptr(const Params& p, int row) { return row < TL ? p.out + (size_t)row * D : (float*)(p.ws + WS_XCTX) + (size_t)(row - TL) * D; }
DI const float* xin_ptr(const Params& p, int row) { return row < TL ? p.in[I_x] + (size_t)row * D : p.in[I_ctx] + (size_t)(row - TL) * D; }

DI void phase_norm(const Params& p, const Frame& F, int l, int which  , bool from_input, int nrows) {
    const float* g = (which == 0 ? p.in[I_g_mix] : p.in[I_g_ffn]) + l * D;
    const int lane = F.lane;
    f32x4 gg[4];
#pragma unroll
    for (int j = 0; j < 4; ++j) gg[j] = ((const f32x4*)g)[lane + 64 * j];
    for (int row0 = 2 * F.gw; row0 < nrows; row0 += 2 * F.ngw) {
        f32x4 v[2][4], s1[2][4], s2[2][4];
#pragma unroll
        for (int u = 0; u < 2; ++u) {
            const int row = row0 + u;
            const float* src = from_input ? xin_ptr(p, row) : xrow_ptr(p, row);
            const float* sh = mod_vec(p, l, row, which * 3 + 0); const float* sc = mod_vec(p, l, row, which * 3 + 1);
#pragma unroll
            for (int j = 0; j < 4; ++j) { v[u][j] = ((const f32x4*)src)[lane + 64 * j]; s1[u][j] = ((const f32x4*)sh)[lane + 64 * j]; s2[u][j] = ((const f32x4*)sc)[lane + 64 * j]; }
        }
#pragma unroll
        for (int u = 0; u < 2; ++u) {
            float ss = 0.f;
#pragma unroll
            for (int j = 0; j < 4; ++j) ss += v[u][j].x * v[u][j].x + v[u][j].y * v[u][j].y + v[u][j].z * v[u][j].z + v[u][j].w * v[u][j].w;
            const float rinv = rsqrtf(wave_sum(ss) * (1.0f / D) + EPS);
            bf16_t* dst = (bf16_t*)(p.ws + WS_H) + (size_t)(row0 + u) * D;
            float am = 0.f;
#pragma unroll
            for (int j = 0; j < 4; ++j) {
                const f32x4 o = v[u][j] * rinv * gg[j] * (s2[u][j] + 1.0f) + s1[u][j];
                u32x2 w; w.x = pk2(o.x, o.y); w.y = pk2(o.z, o.w);
                ((u32x2*)dst)[lane + 64 * j] = w;
                v[u][j] = o; am = fmaxf(am, fmaxf(fmaxf(fabsf(o.x), fabsf(o.y)), fmaxf(fabsf(o.z), fabsf(o.w))));
            }
            if (which) {
#pragma unroll
                for (int o2 = 1; o2 < 64; o2 <<= 1) am = fmaxf(am, __shfl_xor(am, o2));
                const float sc = (am > 0.f) ? 127.0f / am : 1.0f;
                unsigned* h8 = (unsigned*)(p.ws + WS_H8 + (size_t)(row0 + u) * D);
                const bool odd = (lane & 1) != 0;
#pragma unroll
                for (int j = 0; j < 4; ++j) {
                    const int b0 = (int)__builtin_rintf(v[u][j].x * sc), b1 = (int)__builtin_rintf(v[u][j].y * sc), b2 = (int)__builtin_rintf(v[u][j].z * sc), b3 = (int)__builtin_rintf(v[u][j].w * sc);
                    const int p0 = dpp_x1(b0), p1 = dpp_x1(b1), p2 = dpp_x1(b2), p3 = dpp_x1(b3);
                    const int w0 = odd ? p1 : b0, w1 = odd ? p3 : b2, w2 = odd ? b1 : p0, w3 = odd ? b3 : p2;
                    h8[lane + 64 * j] = (unsigned)(w0 & 0xff) | ((unsigned)(w1 & 0xff) << 8) | ((unsigned)(w2 & 0xff) << 16) | ((unsigned)w3 << 24);
                }
                if (lane == 0) ((float*)(p.ws + WS_HS))[row0 + u] = (am > 0.f) ? am * (1.0f / 127.0f) : 1.0f;
            }
        }
    }
}
DI void phase_final(const Params& p, const Frame& F) {
    f32x4 gg[4];
#pragma unroll
    for (int j = 0; j < 4; ++j) gg[j] = ((const f32x4*)p.in[I_g_final])[F.lane + 64 * j];
    for (int row0 = 2 * F.gw; row0 < TL; row0 += 2 * F.ngw) {
        f32x4 v[2][4];
#pragma unroll
        for (int u = 0; u < 2; ++u)
#pragma unroll
            for (int j = 0; j < 4; ++j) v[u][j] = ((const f32x4*)(p.out + (size_t)(row0 + u) * D))[F.lane + 64 * j];
#pragma unroll
        for (int u = 0; u < 2; ++u) {
            float ss = 0.f;
#pragma unroll
            for (int j = 0; j < 4; ++j) ss += v[u][j].x * v[u][j].x + v[u][j].y * v[u][j].y + v[u][j].z * v[u][j].z + v[u][j].w * v[u][j].w;
            const float rinv = rsqrtf(wave_sum(ss) * (1.0f / D) + EPS);
            f32x4* xr = (f32x4*)(p.out + (size_t)(row0 + u) * D);
#pragma unroll
            for (int j = 0; j < 4; ++j) xr[F.lane + 64 * j] = v[u][j] * rinv * gg[j];
        }
    }
}

DI float lane_xor32(float v, bool hi) { const auto r = __builtin_amdgcn_permlane32_swap(__builtin_bit_cast(unsigned, v), __builtin_bit_cast(unsigned, v), false, false);
    return __builtin_bit_cast(float, hi ? r[0] : r[1]); }
struct EpiG1 {
    DI bool keeps(const pg8::Unit&) const { return false; }
    static constexpr bool PERM = true;
    unsigned char* ws;
    DI void operator()(const f32x4 (&acc)[2][2][4][2], const pg8::Unit& u, int wr, int wc, int fr, int fq) const {
        bf16_t* P = (bf16_t*)(ws + WS_P);
        const int rbase = u.pm * 256 + wr * 64 + fr;
        const bool hi = fq >= 2;
#pragma unroll
        for (int ai = 0; ai < 2; ++ai) {
            f32x4 cs[4][4];
            const bool lat = u.pm < TL / 256;
            if (u.pn < 3 && lat) {
#pragma unroll
                for (int m = 0; m < 4; ++m) {
                    const int t = (rbase + 128 * ai + 16 * m) & (SEQ - 1), pos = (wc & 1) ? (t & 63) : (t >> 6);
                    const f32x4* tab = (const f32x4*)(ws + WS_ROPE) + (pos * 16 + 8 * (fq & 1)) / 2;
#pragma unroll
                    for (int j2 = 0; j2 < 4; ++j2) cs[m][j2] = tab[j2];
                }
            }
#pragma unroll
            for (int m = 0; m < 4; ++m) {
                const int row = rbase + 128 * ai + 16 * m;
#pragma unroll
                for (int bj = 0; bj < 2; ++bj) {
                    const int c0 = u.pn * 256 + 128 * bj + 32 * wc + 8 * fq;
                    float v[8];
#pragma unroll
                    for (int j = 0; j < 4; ++j) { v[j] = acc[ai][bj][m][0][j]; v[4 + j] = acc[ai][bj][m][1][j]; }
                    if (c0 < VOFF) {
                        const float sc = (c0 < KOFF) ? QSCALE : 1.0f;
                        u32x4 o;
#pragma unroll
                        for (int j2 = 0; j2 < 4; ++j2) {
                            const f32x4 c4 = cs[m][j2];
                            const float o0 = lane_xor32(v[2 * j2], hi), o1 = lane_xor32(v[2 * j2 + 1], hi);
                            float r0 = hi ? (v[2 * j2] * c4.x + o0 * c4.y) : (v[2 * j2] * c4.x - o0 * c4.y);
                            float r1 = hi ? (v[2 * j2 + 1] * c4.z + o1 * c4.w) : (v[2 * j2 + 1] * c4.z - o1 * c4.w);
                            if (!lat) { r0 = v[2 * j2]; r1 = v[2 * j2 + 1]; }
                            o[j2] = pk2(r0 * sc, r1 * sc);
                        }
                        *(u32x4*)(P + (size_t)row * PW + c0) = o;
                    } else if (c0 < POOLOFF) {
                        const int hk = wc >> 1, d0 = 32 * (wc & 1) + 8 * fq;
                        if (lat) { const int b = row / SEQ, t = row & (SEQ - 1);
                            bf16_t* vt = (bf16_t*)(ws + WS_VT) + ((size_t)(b * 2 + hk) * 64 + d0) * VTS + t;
#pragma unroll
                            for (int j = 0; j < 8; ++j) vt[(size_t)j * VTS] = (bf16_t)f2bf(v[j]);
                        } else { const int rc = row - TL, b = rc / NCTX, jc = rc & (NCTX - 1);
                            bf16_t* vt = (bf16_t*)(ws + WS_VTC) + ((size_t)(b * 2 + hk) * 64 + d0) * NCTX + jc;
#pragma unroll
                            for (int j = 0; j < 8; ++j) vt[(size_t)j * NCTX] = (bf16_t)f2bf(v[j]);
                        }
                    } else if (c0 < SUOFF) {
                        u32x4 o;
#pragma unroll
                        for (int j2 = 0; j2 < 4; ++j2) o[j2] = pk2(v[2 * j2], v[2 * j2 + 1]);
                        *(u32x4*)(P + (size_t)row * PW + c0) = o;
                    } else if (c0 < SVOFF) {
                        u32x4 o;
#pragma unroll
                        for (int j2 = 0; j2 < 4; ++j2) o[j2] = pk2(gelu_tanh(v[2 * j2]), gelu_tanh(v[2 * j2 + 1]));
                        *(u32x4*)(P + (size_t)row * PW + c0) = o;
                    } else {
                        const int c = c0 - SVOFF, chunk = row >> 7, q = row & 127;
                        bf16_t* vs = (bf16_t*)(ws + WS_VST) + ((size_t)chunk * 256 + c) * 128 + q;
#pragma unroll
                        for (int j = 0; j < 8; ++j) vs[j * 128] = (bf16_t)f2bf(gelu_tanh(v[j]));
                    }
                }
            }
            asm volatile("" ::: "memory");
        }
    }
};
struct SchedGrid {
    int nM, nN, G, c; const char* A; const char* B;
    int n_extra, ex_pm0, ex_pn;
    DI bool next(int i, pg8::Unit& u) const {
        const int L = i * G + c, n = nM * nN; if (L >= n + n_extra) return false;
        if (L < n) pg8::tile_of(L, nM, nN, u.pm, u.pn); else { u.pm = ex_pm0 + (L - n); u.pn = ex_pn; }
        u.sub = 0; u.nt = D / 64; u.mode = 0;
        u.a = A + (size_t)u.pm * 256 * D * 2; u.b = B + (size_t)u.pn * 256 * D * 2; return true;
    }
};

DI void phase_g1(const Params& p, const Frame& F, int l) {
    SchedGrid S{(l == 0 ? T : TL) / 256, PN / 256, F.nb, F.bid, (const char*)(p.ws + WS_H), (const char*)(p.ws + WS_WIN) + (size_t)l * INW * D * 2,
                (l == 0) ? 0 : TC / 256, TL / 256, 2};
    EpiG1 E{p.ws};
    pg8::gemm_phase(F.lds, F.tid, S, E);
}

DI bf16x8 pack8(const f32x16& x, int s) {
    u32x4 pk;
#pragma unroll
    for (int j = 0; j < 4; ++j) { f32x2 v = {x[8 * s + 2 * j], x[8 * s + 2 * j + 1]}; pk[j] = __builtin_bit_cast(unsigned, __builtin_convertvector(v, bf16x2_t)); }
    return __builtin_bit_cast(bf16x8, pk);
}

DI float lane_x32(float v, bool hi) { const auto r = __builtin_amdgcn_permlane32_swap(__builtin_bit_cast(unsigned, v), __builtin_bit_cast(unsigned, v), false, false);
    return __builtin_bit_cast(float, hi ? r[0] : r[1]); }
struct AttnFrags { bf16x8 kf[4]; s16x4 vf[2][4]; };
DI void attn_block(const bf16x8 (&qf)[4], const AttnFrags& f, int mask_mode, int kq_off, int lane, float& m, float& lpart, f32x16 (&o)[2]) {
    const int h = lane >> 5;
    f32x16 st;
#pragma unroll
    for (int r = 0; r < 16; ++r) st[r] = 0.f;
#pragma unroll
    for (int s = 0; s < 4; ++s) st = MFMA32(f.kf[s], qf[s], st);
    if (mask_mode) {
#pragma unroll
        for (int r = 0; r < 16; ++r) { const int dlt = kq_off + crow(r, h); if (dlt > 128 || dlt < -128) st[r] = -1e30f; }
    }
    float bm = st[0];
#pragma unroll
    for (int r = 1; r < 16; ++r) bm = fmaxf(bm, st[r]);
    bm = fmaxf(bm, lane_x32(bm, h != 0));
    const float mn = fmaxf(m, bm);
    if (__builtin_amdgcn_ballot_w64(mn > m) != 0ull) {
        const float alpha = __builtin_amdgcn_exp2f(m - mn);
        lpart *= alpha;
#pragma unroll
        for (int d = 0; d < 2; ++d)
#pragma unroll
            for (int r = 0; r < 16; ++r) o[d][r] *= alpha;
        m = mn;
    }
    float ps = 0.f;
#pragma unroll
    for (int r = 0; r < 16; ++r) { st[r] = __builtin_amdgcn_exp2f(st[r] - m); ps += st[r]; }
    lpart += ps;
    const bf16x8 pf0 = pack8(st, 0), pf1 = pack8(st, 1);
#pragma unroll
    for (int d = 0; d < 2; ++d) {
        const bf16x8 v0 = __builtin_shufflevector(f.vf[d][0], f.vf[d][1], 0, 1, 2, 3, 4, 5, 6, 7), v1 = __builtin_shufflevector(f.vf[d][2], f.vf[d][3], 0, 1, 2, 3, 4, 5, 6, 7);
        o[d] = MFMA32(v0, pf0, o[d]);
        o[d] = MFMA32(v1, pf1, o[d]);
    }
}

constexpr int AKP = 144, AVWP = 648, AVCP = 520;
constexpr int ALDS_KW = 0, ALDS_VW = ALDS_KW + 320 * AKP, ALDS_KC = ALDS_VW + 64 * AVWP, ALDS_VC = ALDS_KC + 256 * AKP, ALDS_END = ALDS_VC + 64 * AVCP;
static_assert(ALDS_END <= LDS_BAR_OFF && (ALDS_VW % 16) == 0 && (ALDS_KC % 16) == 0 && (ALDS_VC % 8) == 0, "attention LDS map");
DI void attn_lds_frags(AttnFrags& f, const LAS unsigned char* kp, const LAS unsigned char* vp, int vpitch32) {
#pragma unroll
    for (int s = 0; s < 4; ++s) f.kf[s] = *(const LAS bf16x8*)(kp + 32 * s);
#pragma unroll
    for (int d = 0; d < 2; ++d)
#pragma unroll
        for (int q = 0; q < 4; ++q) f.vf[d][q] = *(const LAS s16x4*)(vp + d * vpitch32 + 16 * q);
}
DI void attn_unit(const Params& p, const Frame& F, int l, int unit) {
    const int lane = F.lane, r = lane & 31, h = lane >> 5, tid = F.tid;
    const bf16_t* P = (const bf16_t*)(p.ws + WS_P);
    const bf16_t* VT = (const bf16_t*)(p.ws + WS_VT);
    const bf16_t* VTC = (const bf16_t*)(p.ws + WS_VTC);
    bf16_t* Y = (bf16_t*)(p.ws + WS_Y);
    const bool latent = unit < 1024;
    int b, hk, p0, q0row;
    if (latent) { const int pb = unit & 63; hk = (unit >> 6) & 1; b = unit >> 7; p0 = pb * 64; q0row = b * SEQ + p0; }
    else { const int u2 = unit - 1024, pb = u2 & 3; hk = (u2 >> 2) & 1; b = u2 >> 3; p0 = pb * 64; q0row = TL + b * NCTX + p0; }
    const int w0 = p0 - 128;
    u32x4 kw[5], vw[5], kc[4], vc[4];
    if (latent) {
#pragma unroll
        for (int it = 0; it < 5; ++it) {
            const int i = tid + it * NTHREADS, row = i >> 3, ck = i & 7, pos = min(max(w0 + row, 0), SEQ - 1);
            kw[it] = *(const u32x4*)(P + (size_t)(b * SEQ + pos) * PW + KOFF + hk * 64 + 8 * ck);
            const int d = i / 40, cv = i % 40, pv = min(max(w0 + 8 * cv, 0), SEQ - 8);
            vw[it] = *(const u32x4*)(VT + ((size_t)(b * 2 + hk) * 64 + d) * VTS + pv);
        }
    }
#pragma unroll
    for (int it = 0; it < 4; ++it) {
        const int i = tid + it * NTHREADS;
        kc[it] = *(const u32x4*)(P + (size_t)(TL + b * NCTX + (i >> 3)) * PW + KOFF + hk * 64 + 8 * (i & 7));
        vc[it] = *(const u32x4*)(VTC + ((size_t)(b * 2 + hk) * 64 + (i >> 5)) * NCTX + 8 * (i & 31));
    }
    __syncthreads();
    if (latent) {
#pragma unroll
        for (int it = 0; it < 5; ++it) {
            const int i = tid + it * NTHREADS, row = i >> 3, ck = i & 7;
            *(LAS u32x4*)(F.lds + ALDS_KW + row * AKP + 16 * ck) = kw[it];
            const int d = i / 40, cv = i % 40;
            LAS u32x2* dst = (LAS u32x2*)(F.lds + ALDS_VW + d * AVWP + 16 * cv); dst[0] = (u32x2){vw[it].x, vw[it].y}; dst[1] = (u32x2){vw[it].z, vw[it].w};
        }
    }
#pragma unroll
    for (int it = 0; it < 4; ++it) {
        const int i = tid + it * NTHREADS;
        *(LAS u32x4*)(F.lds + ALDS_KC + (i >> 3) * AKP + 16 * (i & 7)) = kc[it];
        LAS u32x2* dst = (LAS u32x2*)(F.lds + ALDS_VC + (i >> 5) * AVCP + 16 * (i & 31)); dst[0] = (u32x2){vc[it].x, vc[it].y}; dst[1] = (u32x2){vc[it].z, vc[it].w};
    }
    const int head = 4 * hk + (F.wave & 3), ph = F.wave >> 2, pw = p0 + 32 * ph, qrow = q0row + 32 * ph;
    bf16x8 qf[4];
#pragma unroll
    for (int s = 0; s < 4; ++s) qf[s] = *(const bf16x8*)(P + (size_t)(qrow + r) * PW + head * 64 + 16 * s + 8 * h);
    float m = p.in[I_attn_sink][l * 8 + head] * LOG2E, lpart = (h == 0) ? 1.0f : 0.0f;
    f32x16 o[2];
#pragma unroll
    for (int d = 0; d < 2; ++d)
#pragma unroll
        for (int i = 0; i < 16; ++i) o[d][i] = 0.f;
    __syncthreads();
    if (latent) {
#pragma unroll 1
        for (int j = 0; j < 9; ++j) {
            const int kb = pw - 128 + 32 * j;
            if (kb < 0 || kb >= SEQ) continue;
            const int krow = kb - w0;
            AttnFrags f;
            attn_lds_frags(f, F.lds + ALDS_KW + (krow + r) * AKP + 16 * h, F.lds + ALDS_VW + r * AVWP + 2 * krow + 8 * h, 32 * AVWP);
            attn_block(qf, f, (j == 0 || j == 8) ? 1 : 0, kb - (pw + r), lane, m, lpart, o);
        }
    }
#pragma unroll 1
    for (int j = 0; j < 8; ++j) {
        AttnFrags f;
        attn_lds_frags(f, F.lds + ALDS_KC + (32 * j + r) * AKP + 16 * h, F.lds + ALDS_VC + r * AVCP + 64 * j + 8 * h, 32 * AVCP);
        attn_block(qf, f, 0, 0, lane, m, lpart, o);
    }
    const float inv = 1.0f / (lpart + lane_x32(lpart, h != 0));
    bf16_t* yrow = Y + (size_t)(qrow + r) * D + head * 64;
#pragma unroll
    for (int d = 0; d < 2; ++d)
#pragma unroll
        for (int g = 0; g < 4; ++g) {
            u32x2 w; w.x = pk2(o[d][4 * g] * inv, o[d][4 * g + 1] * inv); w.y = pk2(o[d][4 * g + 2] * inv, o[d][4 * g + 3] * inv);
            *(u32x2*)(yrow + 32 * d + 8 * g + 4 * h) = w;
        }
}

DI void sgu_unit(const Params& p, const Frame& F, int l, int chunk) {
    constexpr int VS = 136;
    LAS float* part = (LAS float*)F.lds;
    LAS float* rq = part + 512;
    LAS bf16_t* vnT = (LAS bf16_t*)(F.lds + 4096);
    const bf16_t* VsT = (const bf16_t*)(p.ws + WS_VST) + (size_t)chunk * 256 * 128;
    const bf16_t* P = (const bf16_t*)(p.ws + WS_P);
    bf16_t* Y = (bf16_t*)(p.ws + WS_Y);
    __syncthreads();
    { const int q = F.tid & 127, part_i = F.tid >> 7; float ss = 0.f;
#pragma unroll 16
        for (int c = part_i * 64; c < part_i * 64 + 64; ++c) { const float v = bf2f(VsT[c * 128 + q]); ss += v * v; }
        part[part_i * 128 + q] = ss; }
    __syncthreads();
    if (F.tid < 128) rq[F.tid] = rsqrtf((part[F.tid] + part[128 + F.tid] + part[256 + F.tid] + part[384 + F.tid]) * (1.0f / 256.0f) + EPS);
    __syncthreads();
#pragma unroll
    for (int it = 0; it < 8; ++it) {
        const int i = F.tid + it * NTHREADS;
        const int c = i >> 4, q8 = (i & 15) * 8;
        const u32x4 v = *(const u32x4*)(VsT + c * 128 + q8);
        u32x4 o;
#pragma unroll
        for (int j = 0; j < 4; ++j) o[j] = pk2(bflo(v[j]) * rq[q8 + 2 * j], bfhi(v[j]) * rq[q8 + 2 * j + 1]);
        *(LAS u32x4*)(vnT + c * VS + q8) = o;
    }
    __syncthreads();
    const int lane = F.lane, r = lane & 31, h = lane >> 5, g = F.wave >> 1, ph = F.wave & 1;
    const bf16_t* Wg = (const bf16_t*)(p.ws + WS_SGUW) + ((size_t)l * 4 + g) * 128 * 128;
#pragma unroll 1
    for (int pb = 0; pb < 2; ++pb) {
        const int p0 = 64 * ph + 32 * pb;
        const int row = chunk * 128 + p0 + r;
        bf16x8 wf[8];
#pragma unroll
        for (int s = 0; s < 8; ++s) wf[s] = *(const bf16x8*)(Wg + (size_t)(p0 + r) * 128 + 16 * s + 8 * h);
        u32x2 uu[2][4];
#pragma unroll
        for (int cb = 0; cb < 2; ++cb)
#pragma unroll
            for (int q4 = 0; q4 < 4; ++q4) uu[cb][q4] = *(const u32x2*)(P + (size_t)row * PW + SUOFF + 64 * g + 32 * cb + 8 * q4 + 4 * h);
        const float bias = p.in[I_sgu_b][(l * 4 + g) * 128 + p0 + r];
#pragma unroll
        for (int cb = 0; cb < 2; ++cb) {
            const int c0 = 64 * g + 32 * cb;
            f32x16 acc;
#pragma unroll
            for (int i = 0; i < 16; ++i) acc[i] = 0.f;
#pragma unroll
            for (int s = 0; s < 8; ++s) {
                const bf16x8 a = *(const LAS bf16x8*)(vnT + (c0 + r) * VS + 16 * s + 8 * h);
                acc = MFMA32(a, wf[s], acc);
            }
#pragma unroll
            for (int q4 = 0; q4 < 4; ++q4) {
                const int cc = c0 + 8 * q4 + 4 * h;
                const u32x2 u = uu[cb][q4];
                u32x2 w;
                w.x = pk2(bflo(u.x) * (acc[4 * q4] + bias), bfhi(u.x) * (acc[4 * q4 + 1] + bias));
                w.y = pk2(bflo(u.y) * (acc[4 * q4 + 2] + bias), bfhi(u.y) * (acc[4 * q4 + 3] + bias));
                *(u32x2*)(Y + (size_t)row * D + 768 + cc) = w;
            }
        }
    }
}

DI void phase_mix(const Params& p, const Frame& F, int l, int ctr_slot = 0) {
    (void)ctr_slot;
    const int nrows = (l == 0) ? T : TL;
    const bf16_t* P = (const bf16_t*)(p.ws + WS_P);
    bf16_t* Y = (bf16_t*)(p.ws + WS_Y);
    for (int i0 = F.bid * NTHREADS; i0 < 4 * nrows * 8; i0 += F.nb * NTHREADS) {
        const int i = i0 + F.tid, g = i / (nrows * 8), rem = i - g * (nrows * 8), row = rem >> 3, ck = g * 8 + (rem & 7);
        int base, t, len;
        if (row < TL) { base = row & ~(SEQ - 1); t = row & (SEQ - 1); len = SEQ; } else { const int rc = row - TL; base = TL + (rc & ~(NCTX - 1)); t = rc & (NCTX - 1); len = NCTX; }
        float s[8];
#pragma unroll
        for (int j = 0; j < 8; ++j) s[j] = 0.f;
        const bf16_t* zc = P + POOLOFF + ck * 8;
#define POOL_WIN(HALF) do { _Pragma("unroll") for (int dt = -(HALF); dt < (HALF); ++dt) { const int tt = t + dt; const bool ok = tt >= 0 && tt < len; \
            const u32x4 v = *(const u32x4*)(zc + (size_t)(base + (ok ? tt : t)) * PW); const float w = ok ? 1.f : 0.f; \
            _Pragma("unroll") for (int j = 0; j < 4; ++j) { s[2 * j] += w * bflo(v[j]); s[2 * j + 1] += w * bfhi(v[j]); } } } while (0)
        int half;
        if (g == 0) { POOL_WIN(1); half = 1; } else if (g == 1) { POOL_WIN(2); half = 2; } else if (g == 2) { POOL_WIN(4); half = 4; } else { POOL_WIN(8); half = 8; }
#undef POOL_WIN
        const int lo = max(t - half, 0), hi = min(t + half, len);
        const float inv = 1.0f / (float)(hi - lo);
        const u32x4 z = *(const u32x4*)(zc + (size_t)row * PW);
        u32x4 o;
#pragma unroll
        for (int j = 0; j < 4; ++j) o[j] = pk2(s[2 * j] * inv - bflo(z[j]), s[2 * j + 1] * inv - bfhi(z[j]));
        *(u32x4*)(Y + (size_t)row * D + 512 + ck * 8) = o;
    }
    const int nchunk = (l == 0) ? T / 128 : TL / 128;
    for (int ch = F.bid; ch < nchunk; ch += F.nb) sgu_unit(p, F, l, ch);
    const int nunit = (l == 0) ? 1024 + 64 : 1024;
    for (int u = F.nb - 1 - F.bid; u < nunit; u += F.nb) attn_unit(p, F, l, u);
}

struct SchedG2 {
    int G, c; const char *H, *Y, *Wg, *Wb; int npair;
    DI void fill(pg8::Unit& u, int sub, int br) const {
        u.sub = sub;
        if ((sub & 1) == 0) { u.nt = 16; u.a = H + (size_t)u.pm * 256 * D * 2; u.b = Wg + ((size_t)br * D + u.pn * 256) * D * 2; }
        else { const int koff = (br == 0) ? 0 : (br == 1 ? 512 : 768); u.nt = (br == 0) ? 8 : 4;
               u.a = Y + ((size_t)u.pm * 256 * D + koff) * 2; u.b = Wb + ((size_t)u.pn * 256 * D + koff) * 2; }
    }
    DI bool next(int i, pg8::Unit& u) const {
        constexpr int NLAT = (TL / 256) * 4;
        const int nl = (NLAT - c + G - 1) / G;
        if (i < 6 * nl) { const int tile = (i / 6) * G + c, sub = i % 6; pg8::tile_of(tile, TL / 256, 4, u.pm, u.pn); u.mode = 0; fill(u, sub, sub >> 1); return true; }
        const int e = i - 6 * nl, j = (e >> 1) * G + c;
        if (j >= npair) return false;
        const int ctile = j / 3, br = j % 3;
        u.pm = TL / 256 + (ctile >> 2); u.pn = ctile & 3; u.mode = 1 + br; fill(u, e & 1, br); return true;
    }
};
struct EpiG2 {
    static constexpr bool PERM = true;
    bf16_t* scr; bf16_t* M; bf16_t* MP;
    DI bool keeps(const pg8::Unit& u) const { return (u.sub & 1) == 0; }
    DI void operator()(f32x4 (&acc)[2][2][4][2], const pg8::Unit& u, int wr, int wc, int fr, int fq) const {
        const bool gate = (u.sub & 1) == 0, first = u.sub == 0 && gate;
        bf16_t* Mo = (u.mode == 0) ? M + (size_t)u.pm * 256 * D : MP + ((size_t)(u.mode - 1) * TC + (size_t)(u.pm - TL / 256) * 256) * D;
#pragma unroll
        for (int ai = 0; ai < 2; ++ai) {
            u32x4 ld[4][2];
            if (!first) {
#pragma unroll
                for (int m = 0; m < 4; ++m)
#pragma unroll
                    for (int bj = 0; bj < 2; ++bj) {
                        const int rl = 128 * ai + 64 * wr + 16 * m + fr, cl = 128 * bj + 32 * wc + 8 * fq;
                        ld[m][bj] = gate ? *(const u32x4*)(Mo + (size_t)rl * D + u.pn * 256 + cl) : *(const u32x4*)(scr + rl * 256 + cl);
                    }
            }
#pragma unroll
            for (int m = 0; m < 4; ++m)
#pragma unroll
                for (int bj = 0; bj < 2; ++bj) {
                    const int rl = 128 * ai + 64 * wr + 16 * m + fr, cl = 128 * bj + 32 * wc + 8 * fq;
                    if (gate) {
                        u32x4 o;
#pragma unroll
                        for (int j2 = 0; j2 < 4; ++j2) {
                            const int n = j2 >> 1, e = 2 * (j2 & 1);
                            const float i0 = fminf(1.0f + __expf(-acc[ai][bj][m][n][e]), 1e20f), i1 = fminf(1.0f + __expf(-acc[ai][bj][m][n][e + 1]), 1e20f);
                            o[j2] = pk2(__builtin_amdgcn_rcpf(i0), __builtin_amdgcn_rcpf(i1));
                            const float t0 = first ? 0.f : bflo(ld[m][bj][j2]), t1 = first ? 0.f : bfhi(ld[m][bj][j2]);
                            acc[ai][bj][m][n][e] = t0 * i0; acc[ai][bj][m][n][e + 1] = t1 * i1;
                        }
                        *(u32x4*)(scr + rl * 256 + cl) = o;
                    } else {
                        u32x4 w;
#pragma unroll
                        for (int j2 = 0; j2 < 4; ++j2) { const int n = j2 >> 1, e = 2 * (j2 & 1);
                            w[j2] = pk2(acc[ai][bj][m][n][e] * bflo(ld[m][bj][j2]), acc[ai][bj][m][n][e + 1] * bfhi(ld[m][bj][j2])); }
                        *(u32x4*)(Mo + (size_t)rl * D + u.pn * 256 + cl) = w;
                    }
                }
            asm volatile("" ::: "memory");
        }
    }
};
DI void phase_g2(const Params& p, const Frame& F, int l) {
    SchedG2 S{F.nb, F.bid, (const char*)(p.ws + WS_H), (const char*)(p.ws + WS_Y),
              (const char*)(p.ws + WS_WIN) + ((size_t)l * INW + GATEOFF) * D * 2, (const char*)(p.ws + WS_WBR) + (size_t)l * D * D * 2, (l == 0) ? (TC / 256) * 4 * 3 : 0};
    EpiG2 E{(bf16_t*)(p.ws + WS_IDX) + (size_t)F.bid * 65536, (bf16_t*)(p.ws + WS_MERGED), (bf16_t*)(p.ws + WS_MP)};
    pg8::gemm_phase(F.lds, F.tid, S, E);
}
DI void phase_g2sum(const Params& p, const Frame& F) {
    const u32x4* mp = (const u32x4*)(p.ws + WS_MP);
    u32x4* mo = (u32x4*)((bf16_t*)(p.ws + WS_MERGED) + (size_t)TL * D);
    constexpr int NV = TC * D / 8;
    for (int i = F.gtid; i < NV; i += F.ngt) {
        const u32x4 a = mp[i], b = mp[NV + i], c = mp[2 * NV + i];
        u32x4 o;
#pragma unroll
        for (int j = 0; j < 4; ++j) o[j] = pk2(bflo(a[j]) + bflo(b[j]) + bflo(c[j]), bfhi(a[j]) + bfhi(b[j]) + bfhi(c[j]));
        mo[i] = o;
    }
}

struct EpiG3 {
    DI bool keeps(const pg8::Unit&) const { return false; }
    static constexpr bool PERM = false;
    const float* xsrc; float* xdst; const float* csrc; float* cdst; const float* mod;
    DI void operator()(const f32x4 (&acc)[2][2][4][2], const pg8::Unit& u, int wr, int wc, int fr, int fq) const {
        const int col0 = u.pn * 256 + wc * 32 + 4 * fq;
        const bool lat = u.pm < TL / 256;
        const float* gt = mod + (size_t)(lat ? (u.pm >> 4) : 8) * NMOD + 2 * D;
        const float* xs = lat ? xsrc + (size_t)u.pm * 256 * D : csrc + (size_t)(u.pm - TL / 256) * 256 * D;
        float* xd = lat ? xdst + (size_t)u.pm * 256 * D : cdst + (size_t)(u.pm - TL / 256) * 256 * D;
        f32x4 gv[2][2];
#pragma unroll
        for (int bj = 0; bj < 2; ++bj)
#pragma unroll
            for (int n = 0; n < 2; ++n) gv[bj][n] = *(const f32x4*)(gt + col0 + 128 * bj + 16 * n);
#pragma unroll
        for (int ai = 0; ai < 2; ++ai) {
            f32x4 xv[4][2][2];
#pragma unroll
            for (int m = 0; m < 4; ++m)
#pragma unroll
                for (int bj = 0; bj < 2; ++bj)
#pragma unroll
                    for (int n = 0; n < 2; ++n) xv[m][bj][n] = *(const f32x4*)(xs + (size_t)(wr * 64 + fr + 128 * ai + 16 * m) * D + col0 + 128 * bj + 16 * n);
#pragma unroll
            for (int m = 0; m < 4; ++m)
#pragma unroll
                for (int bj = 0; bj < 2; ++bj)
#pragma unroll
                    for (int n = 0; n < 2; ++n)
                        *(f32x4*)(xd + (size_t)(wr * 64 + fr + 128 * ai + 16 * m) * D + col0 + 128 * bj + 16 * n) = xv[m][bj][n] + gv[bj][n] * acc[ai][bj][m][n];
            asm volatile("" ::: "memory");
        }
    }
};
DI void phase_g3(const Params& p, const Frame& F, int l) {
    SchedGrid S{(l == 0 ? T : TL) / 256, D / 256, F.nb, F.bid, (const char*)(p.ws + WS_MERGED), (const char*)(p.ws + WS_WOUT) + (size_t)l * D * D * 2, 0, 0, 0};
    float* xc = (float*)(p.ws + WS_XCTX);
    EpiG3 E{(l == 0) ? p.in[I_x] : p.out, p.out, (l == 0) ? p.in[I_ctx] : xc, xc, (const float*)(p.ws + WS_MOD) + (size_t)l * 9 * NMOD};
    pg8::gemm_phase(F.lds, F.tid, S, E);
}

struct EpiG45 {
    DI bool keeps(const pg8::Unit&) const { return false; }
    static constexpr bool PERM = true;
    unsigned short* ST;
    DI void operator()(const f32x4 (&acc)[2][2][4][2], const pg8::Unit& u, int wr, int wc, int fr, int fq) const {
        const int col0 = u.pn * 256 + wc * 32 + 8 * fq;
#pragma unroll
        for (int ai = 0; ai < 2; ++ai)
#pragma unroll
            for (int m = 0; m < 4; ++m) {
                unsigned short* rowp = ST + (size_t)(u.pm * 256 + wr * 64 + fr + 128 * ai + 16 * m) * T + col0;
#pragma unroll
                for (int bj = 0; bj < 2; ++bj) {
                    u32x4 w;
                    w.x = pkh2(acc[ai][bj][m][0][0], acc[ai][bj][m][0][1]); w.y = pkh2(acc[ai][bj][m][0][2], acc[ai][bj][m][0][3]);
                    w.z = pkh2(acc[ai][bj][m][1][0], acc[ai][bj][m][1][1]); w.w = pkh2(acc[ai][bj][m][1][2], acc[ai][bj][m][1][3]);
                    *(u32x4*)(rowp + 128 * bj) = w;
                }
            }
    }
};
DI void phase_g45(const Params& p, const Frame& F, int l) {
    SchedGrid S{2048 / 256, (l == 0 ? T : TL) / 256, F.nb, F.bid, (const char*)(p.ws + WS_WFOLD) + (size_t)l * 2048 * D * 2, (const char*)(p.ws + WS_H), 0, 0, 0};
    EpiG45 E{(unsigned short*)(p.ws + WS_ST)};
    pg8::gemm_phase(F.lds, F.tid, S, E);
}

DI unsigned fkey(float f) { const unsigned u = __builtin_bit_cast(unsigned, f); return (u & 0x80000000u) ? ~u : (u | 0x80000000u); }
DI float fkey_inv(unsigned k) { const unsigned u = (k & 0x80000000u) ? (k & 0x7fffffffu) : ~k; return __builtin_bit_cast(float, u); }
#define INSERT16(L, x) do { unsigned x_ = (x); _Pragma("unroll") for (int k_ = 0; k_ < 16; ++k_) { const unsigned hi_ = max(L[k_], x_); x_ = min(L[k_], x_); L[k_] = hi_; } } while (0)
#define CEX(a, b) do { const unsigned hi_ = max(a, b), lo_ = min(a, b); a = hi_; b = lo_; } while (0)
DI void sort16_desc(unsigned (&v)[16]) {
    CEX(v[0], v[1]); CEX(v[2], v[3]); CEX(v[0], v[2]); CEX(v[1], v[3]); CEX(v[1], v[2]); CEX(v[4], v[5]); CEX(v[6], v[7]); CEX(v[4], v[6]); CEX(v[5], v[7]); CEX(v[5], v[6]); CEX(v[0], v[4]); CEX(v[2], v[6]); CEX(v[2], v[4]); CEX(v[1], v[5]); CEX(v[3], v[7]); CEX(v[3], v[5]); CEX(v[1], v[2]); CEX(v[3], v[4]); CEX(v[5], v[6]); CEX(v[8], v[9]); CEX(v[10], v[11]); CEX(v[8], v[10]); CEX(v[9], v[11]); CEX(v[9], v[10]); CEX(v[12], v[13]); CEX(v[14], v[15]); CEX(v[12], v[14]); CEX(v[13], v[15]); CEX(v[13], v[14]); CEX(v[8], v[12]); CEX(v[10], v[14]); CEX(v[10], v[12]); CEX(v[9], v[13]); CEX(v[11], v[15]); CEX(v[11], v[13]); CEX(v[9], v[10]); CEX(v[11], v[12]); CEX(v[13], v[14]); CEX(v[0], v[8]); CEX(v[4], v[12]); CEX(v[4], v[8]); CEX(v[2], v[10]); CEX(v[6], v[14]); CEX(v[6], v[10]); CEX(v[2], v[4]); CEX(v[6], v[8]); CEX(v[10], v[12]); CEX(v[1], v[9]); CEX(v[5], v[13]); CEX(v[5], v[9]); CEX(v[3], v[11]); CEX(v[7], v[15]); CEX(v[7], v[11]); CEX(v[3], v[5]); CEX(v[7], v[9]); CEX(v[11], v[13]); CEX(v[1], v[2]); CEX(v[3], v[4]); CEX(v[5], v[6]); CEX(v[7], v[8]); CEX(v[9], v[10]); CEX(v[11], v[12]); CEX(v[13], v[14]);
}
DI void merge16_desc(unsigned (&L)[16], const unsigned (&N)[16]) {
#pragma unroll
    for (int i = 0; i < 16; ++i) L[i] = max(L[i], N[15 - i]);
#pragma unroll
    for (int j = 8; j > 0; j >>= 1)
#pragma unroll
        for (int i = 0; i < 16; ++i) { const int q = i ^ j; if (q > i) CEX(L[i], L[q]); }
}
DI void phase_sel(const Params& p, const Frame& F, int l) {
    const _Float16* ST = (const _Float16*)(p.ws + WS_ST);
    unsigned short* IDX = (unsigned short*)(p.ws + WS_IDX);
    float* GW = (float*)(p.ws + WS_GW);
    float* SU = (float*)(p.ws + WS_SU);
    const float* TSC = (const float*)(p.ws + WS_TSCALE) + (size_t)l * 2 * NEXP;
    LAS unsigned char* ib = (LAS unsigned char*)F.lds;
    const int ntok = (l == 0) ? T : TL;
    for (int i0 = F.bid * NTHREADS; i0 < ntok * 8; i0 += F.nb * NTHREADS) {
        const int i = i0 + F.tid;
        const int tok = i % ntok, head = i / ntok;
        unsigned la[16], lb[16];
#pragma unroll
        for (int k = 0; k < 16; ++k) { la[k] = 0u; lb[k] = 0u; }
        const _Float16* s0 = ST + (size_t)(head * 256) * T + tok;
#define SEL_LOAD(B_, k0_) do { _Pragma("unroll") for (int j = 0; j < 32; ++j) B_[j] = sp[(size_t)((k0_) + j) * T]; } while (0)
#define SEL_KEY(x_, low_) ((((unsigned)(x_) ^ ((unsigned)(((int)((unsigned)(x_) << 16)) >> 31) | 0x8000u)) << 16) | (unsigned)(low_))
#define SEL_GRP(L_, B_, o_, k0_) do { unsigned nk_[16]; \
        _Pragma("unroll") for (int j = 0; j < 16; ++j) nk_[j] = SEL_KEY(B_[(o_) + j], 127 - ((k0_) + j)); \
        sort16_desc(nk_); merge16_desc(L_, nk_); } while (0)
#define SEL_HALF(L_, base_) do { const unsigned short* sp = (const unsigned short*)s0 + (size_t)(base_) * T; unsigned short bufa[32], bufb[32]; \
        SEL_LOAD(bufa, 0); \
        _Pragma("unroll 1") for (int k0 = 0; k0 < 128; k0 += 64) { \
            SEL_LOAD(bufb, k0 + 32); SEL_GRP(L_, bufa, 0, k0); SEL_GRP(L_, bufa, 16, k0 + 16); \
            SEL_LOAD(bufa, (k0 + 64) & 127); SEL_GRP(L_, bufb, 0, k0 + 32); SEL_GRP(L_, bufb, 16, k0 + 48); } } while (0)
        SEL_HALF(la, 0);
        SEL_HALF(lb, 128);
#undef SEL_LOAD
#undef SEL_KEY
#undef SEL_GRP
#undef SEL_HALF
        float va[16], vb[16];
#define SEL_VAL(key_) ((float)__builtin_bit_cast(_Float16, (unsigned short)(((key_) >> 16) ^ 0xffffu ^ ((unsigned)((int)(key_) >> 31) & 0x7fffu))))
#pragma unroll
        for (int k = 0; k < 16; ++k) {
            va[k] = SEL_VAL(la[k]); vb[k] = SEL_VAL(lb[k]);
            ib[k * NTHREADS + F.tid] = (unsigned char)(127u - (la[k] & 127u));
            ib[(16 + k) * NTHREADS + F.tid] = (unsigned char)(127u - (lb[k] & 127u));
        }
#undef SEL_VAL
        unsigned lc[16];
        { lc[0] = (fkey(va[0] + vb[0]) & ~255u) | 255u; lc[1] = (fkey(va[0] + vb[1]) & ~255u) | 254u; lc[2] = (fkey(va[0] + vb[2]) & ~255u) | 253u; lc[3] = (fkey(va[0] + vb[3]) & ~255u) | 252u; lc[4] = (fkey(va[0] + vb[4]) & ~255u) | 251u; lc[5] = (fkey(va[0] + vb[5]) & ~255u) | 250u; lc[6] = (fkey(va[0] + vb[6]) & ~255u) | 249u; lc[7] = (fkey(va[0] + vb[7]) & ~255u) | 248u; lc[8] = (fkey(va[0] + vb[8]) & ~255u) | 247u; lc[9] = (fkey(va[0] + vb[9]) & ~255u) | 246u; lc[10] = (fkey(va[0] + vb[10]) & ~255u) | 245u; lc[11] = (fkey(va[0] + vb[11]) & ~255u) | 244u; lc[12] = (fkey(va[0] + vb[12]) & ~255u) | 243u; lc[13] = (fkey(va[0] + vb[13]) & ~255u) | 242u; lc[14] = (fkey(va[0] + vb[14]) & ~255u) | 241u; lc[15] = (fkey(va[0] + vb[15]) & ~255u) | 240u; }
        sort16_desc(lc);
        { unsigned cg1[16]; cg1[0] = (fkey(va[1] + vb[0]) & ~255u) | 239u; cg1[1] = (fkey(va[1] + vb[1]) & ~255u) | 238u; cg1[2] = (fkey(va[1] + vb[2]) & ~255u) | 237u; cg1[3] = (fkey(va[1] + vb[3]) & ~255u) | 236u; cg1[4] = (fkey(va[1] + vb[4]) & ~255u) | 235u; cg1[5] = (fkey(va[1] + vb[5]) & ~255u) | 234u; cg1[6] = (fkey(va[1] + vb[6]) & ~255u) | 233u; cg1[7] = (fkey(va[1] + vb[7]) & ~255u) | 232u; cg1[8] = (fkey(va[2] + vb[0]) & ~255u) | 223u; cg1[9] = (fkey(va[2] + vb[1]) & ~255u) | 222u; cg1[10] = (fkey(va[2] + vb[2]) & ~255u) | 221u; cg1[11] = (fkey(va[2] + vb[3]) & ~255u) | 220u; cg1[12] = (fkey(va[2] + vb[4]) & ~255u) | 219u; cg1[13] = (fkey(va[3] + vb[0]) & ~255u) | 207u; cg1[14] = (fkey(va[3] + vb[1]) & ~255u) | 206u; cg1[15] = (fkey(va[3] + vb[2]) & ~255u) | 205u; sort16_desc(cg1); merge16_desc(lc, cg1); }
        { unsigned cg2[16]; cg2[0] = (fkey(va[3] + vb[3]) & ~255u) | 204u; cg2[1] = (fkey(va[4] + vb[0]) & ~255u) | 191u; cg2[2] = (fkey(va[4] + vb[1]) & ~255u) | 190u; cg2[3] = (fkey(va[4] + vb[2]) & ~255u) | 189u; cg2[4] = (fkey(va[5] + vb[0]) & ~255u) | 175u; cg2[5] = (fkey(va[5] + vb[1]) & ~255u) | 174u; cg2[6] = (fkey(va[6] + vb[0]) & ~255u) | 159u; cg2[7] = (fkey(va[6] + vb[1]) & ~255u) | 158u; cg2[8] = (fkey(va[7] + vb[0]) & ~255u) | 143u; cg2[9] = (fkey(va[7] + vb[1]) & ~255u) | 142u; cg2[10] = (fkey(va[8] + vb[0]) & ~255u) | 127u; cg2[11] = (fkey(va[9] + vb[0]) & ~255u) | 111u; cg2[12] = (fkey(va[10] + vb[0]) & ~255u) | 95u; cg2[13] = (fkey(va[11] + vb[0]) & ~255u) | 79u; cg2[14] = (fkey(va[12] + vb[0]) & ~255u) | 63u; cg2[15] = (fkey(va[13] + vb[0]) & ~255u) | 47u; sort16_desc(cg2); merge16_desc(lc, cg2); }
        { const unsigned key = (fkey(va[14] + vb[0]) & ~255u) | 31u; INSERT16(lc, key); }
        { const unsigned key = (fkey(va[15] + vb[0]) & ~255u) | 15u; INSERT16(lc, key); }
        float e[16], sum = 0.f; const float v0 = fkey_inv(lc[0] & ~255u);
#pragma unroll
        for (int k = 0; k < 16; ++k) { e[k] = __expf(fkey_inv(lc[k] & ~255u) - v0); sum += e[k]; }
        const float inv = 1.0f / sum;
        asm volatile("s_waitcnt lgkmcnt(0)" ::: "memory");
        unsigned exs[16]; float gws[16], sus[16];
#pragma unroll
        for (int k = 0; k < 16; ++k) {
            const unsigned pos = 255u - (lc[k] & 255u), a = pos >> 4, b = pos & 15u;
            const unsigned ea = ib[a * NTHREADS + F.tid], eb = ib[(16 + b) * NTHREADS + F.tid];
            exs[k] = ea * 128u + eb;
        }
#pragma unroll
        for (int k = 0; k < 16; ++k) { gws[k] = e[k] * inv * TSC[NEXP + exs[k]]; sus[k] = TSC[exs[k]]; }
        { const size_t o = (size_t)tok * 128 + head * 16;
#pragma unroll
          for (int q = 0; q < 2; ++q) { u32x4 w;
#pragma unroll
              for (int j = 0; j < 4; ++j) w[j] = exs[8 * q + 2 * j] | (exs[8 * q + 2 * j + 1] << 16);
              *(u32x4*)(IDX + o + 8 * q) = w; }
#pragma unroll
          for (int q = 0; q < 4; ++q) { *(f32x4*)(GW + o + 4 * q) = (f32x4){gws[4 * q], gws[4 * q + 1], gws[4 * q + 2], gws[4 * q + 3]};
                                        *(f32x4*)(SU + o + 4 * q) = (f32x4){sus[4 * q], sus[4 * q + 1], sus[4 * q + 2], sus[4 * q + 3]}; } }
        asm volatile("s_waitcnt lgkmcnt(0)" ::: "memory");
    }
}

DI float dpp_xor1(float v) { return __builtin_bit_cast(float, __builtin_amdgcn_mov_dpp(__builtin_bit_cast(int, v), 0xB1, 0xF, 0xF, true)); }
DI float dpp_xor2(float v) { return __builtin_bit_cast(float, __builtin_amdgcn_mov_dpp(__builtin_bit_cast(int, v), 0x4E, 0xF, 0xF, true)); }
DI float dpp_hmir(float v) { return __builtin_bit_cast(float, __builtin_amdgcn_mov_dpp(__builtin_bit_cast(int, v), 0x141, 0xF, 0xF, true)); }
DI float dot16_fp8(const u32x4 q, const float (&hx)[16]) {
    f32x2 a = {0.f, 0.f};
#pragma unroll
    for (int j = 0; j < 4; ++j) {
        const f32x2 lo = __builtin_amdgcn_cvt_pk_f32_fp8((int)q[j], false), hi = __builtin_amdgcn_cvt_pk_f32_fp8((int)q[j], true);
        a += lo * (f32x2){hx[4 * j], hx[4 * j + 1]}; a += hi * (f32x2){hx[4 * j + 2], hx[4 * j + 3]};
    }
    return a.x + a.y;
}
#define PEER_EXPERT(id, i) ((int)(((id)[(i) >> 3][((i) >> 1) & 3] >> (16 * ((i) & 1))) & 0xffffu))

DI int dpp_xor1i(int v) { return __builtin_amdgcn_mov_dpp(v, 0xB1, 0xF, 0xF, true); }
DI int dpp_xor2i(int v) { return __builtin_amdgcn_mov_dpp(v, 0x4E, 0xF, 0xF, true); }
DI int dpp_hmiri(int v) { return __builtin_amdgcn_mov_dpp(v, 0x141, 0xF, 0xF, true); }
struct PeerURows { u32x4 q[16]; u32x4 h[2]; };
DI void peer_u_rows(PeerURows& R, const u32x4 (&id)[2], const unsigned char* ut, const unsigned char* hrow) {
    R.h[0] = *(const u32x4*)(hrow); R.h[1] = *(const u32x4*)(hrow + 16);
#pragma unroll
    for (int i = 0; i < 16; ++i) R.q[i] = *(const u32x4*)(ut + (size_t)PEER_EXPERT(id, i) * (D / 2));
}
DI void peer_u_compute(const PeerURows& R, float* part, int lane) {
    int hsum = 0;
#pragma unroll
    for (int g = 0; g < 2; ++g)
#pragma unroll
        for (int j = 0; j < 4; ++j) hsum = __builtin_amdgcn_sdot4((int)R.h[g][j], 0x01010101, hsum, false);
    int d[16];
#pragma unroll
    for (int i = 0; i < 16; ++i) { int a = 0;
#pragma unroll
        for (int dw = 0; dw < 4; ++dw) {
            const unsigned w = R.q[i][dw];
            a = __builtin_amdgcn_sdot4((int)(w & 0x0f0f0f0fu), (int)R.h[dw >> 1][2 * (dw & 1)], a, false);
            a = __builtin_amdgcn_sdot4((int)((w >> 4) & 0x0f0f0f0fu), (int)R.h[dw >> 1][2 * (dw & 1) + 1], a, false);
        }
        d[i] = a - 8 * hsum; }
    const bool b2 = (lane & 4) != 0, b1 = (lane & 2) != 0, b0 = (lane & 1) != 0;
    int k8[8];
#pragma unroll
    for (int i = 0; i < 8; ++i) { const int keep = b2 ? d[8 + i] : d[i], send = b2 ? d[i] : d[8 + i]; k8[i] = keep + dpp_hmiri(send); }
    int k4[4];
#pragma unroll
    for (int i = 0; i < 4; ++i) { const int keep = b1 ? k8[4 + i] : k8[i], send = b1 ? k8[i] : k8[4 + i]; k4[i] = keep + dpp_xor2i(send); }
    f32x2 k2;
    { const int keep0 = b0 ? k4[2] : k4[0], send0 = b0 ? k4[0] : k4[2], keep1 = b0 ? k4[3] : k4[1], send1 = b0 ? k4[1] : k4[3];
      k2.x = (float)(keep0 + dpp_xor1i(send0)); k2.y = (float)(keep1 + dpp_xor1i(send1)); }
    *(f32x2*)(part + 16 * (lane >> 3) + (b2 ? 8 : 0) + (b1 ? 4 : 0) + (b0 ? 2 : 0)) = k2;
}
DI void phase_peer_u(const Params& p, const Frame& F, int l) {
    const int ntok = (l == 0) ? T : TL, lane = F.lane, half = ntok >> 1;
    const int grp = F.bid & 7, cs = grp & 3, th = grp >> 2, sw = (F.bid >> 3) * NWAVES + F.wave, nsw = (F.nb >> 3) * NWAVES;
    const unsigned char* ut = p.ws + WS_UTAB + (size_t)l * NEXP * (D / 2) + 128 * cs + 16 * (lane & 7);
    const unsigned char* Hs = p.ws + WS_H8 + 256 * cs + 32 * (lane & 7);
    const unsigned short* IDXg = (const unsigned short*)(p.ws + WS_IDX) + 16 * (lane >> 3);
    float* PART = (float*)(p.ws + WS_ST) + (size_t)cs * T * 128;
    const int t0 = th * half, tend = t0 + half, last = tend - 1;
    u32x4 sa[2], sb[2]; PeerURows ra, rb;
#define U_SEL(S_, t_) do { const unsigned short* ip_ = IDXg + (size_t)min((t_), last) * 128; S_[0] = *(const u32x4*)ip_; S_[1] = *(const u32x4*)(ip_ + 8); } while (0)
#define U_ROWS(R_, S_, t_) peer_u_rows(R_, S_, ut, Hs + (size_t)min((t_), last) * D)
    U_SEL(sa, t0 + sw); U_SEL(sb, t0 + sw + nsw);
    U_ROWS(ra, sa, t0 + sw);
#pragma unroll 1
    for (int tok = t0 + sw; tok < tend; tok += 2 * nsw) {
        U_SEL(sa, tok + 2 * nsw); U_ROWS(rb, sb, tok + nsw);
        peer_u_compute(ra, PART + (size_t)tok * 128, lane);
        U_SEL(sb, tok + 3 * nsw); U_ROWS(ra, sa, tok + 2 * nsw);
        if (tok + nsw < tend) peer_u_compute(rb, PART + (size_t)(tok + nsw) * 128, lane);
    }
#undef U_SEL
#undef U_ROWS
}
DI void phase_peer_c(const Params& p, const Frame& F, int l, bool dummy = false) {
    const int ntok = (l == 0) ? T : TL;
    const float* PART = (const float*)(p.ws + WS_ST);
    float* GW = (float*)(p.ws + WS_GW);
    float* CO = dummy ? (float*)(p.ws + WS_H8) : GW;
    const float* SU = (const float*)(p.ws + WS_SU);
    const float* HS = (const float*)(p.ws + WS_HS);
    for (int i0 = F.gtid; i0 < ntok * 128; i0 += 4 * F.ngt) {
        float s[4], gw[4], su[4];
#pragma unroll
        for (int u = 0; u < 4; ++u) {
            const int i = min(i0 + u * F.ngt, ntok * 128 - 1);
            s[u] = 0.f;
#pragma unroll
            for (int sl = 0; sl < 4; ++sl) s[u] += PART[(size_t)sl * T * 128 + i];
            gw[u] = GW[i]; su[u] = SU[i] * HS[i >> 7];
        }
#pragma unroll
        for (int u = 0; u < 4; ++u) { const int i = i0 + u * F.ngt; if (i < ntok * 128) CO[i] = gw[u] * gelu_tanh(s[u] * su[u]); }
    }
}
struct PeerVRows { u32x4 q[16]; f32x4 cf[4]; f32x4 xv, gv; };
DI void peer_v_rows(PeerVRows& R, const u32x4 (&id)[2], const unsigned char* vt, const float* cp, const float* xs, const float* gt2) {
    R.cf[0] = *(const f32x4*)cp; R.cf[1] = *(const f32x4*)(cp + 4); R.cf[2] = *(const f32x4*)(cp + 8); R.cf[3] = *(const f32x4*)(cp + 12);
    R.xv = *(const f32x4*)xs; R.gv = *(const f32x4*)gt2;
#pragma unroll
    for (int i = 0; i < 16; ++i) R.q[i] = *(const u32x4*)(vt + (size_t)PEER_EXPERT(id, i) * (D / 2));
}
DI float xchg32(float v, bool hi) { const auto r = __builtin_amdgcn_permlane32_swap(__builtin_bit_cast(unsigned, v), __builtin_bit_cast(unsigned, v), false, false);
    return __builtin_bit_cast(float, hi ? r[0] : r[1]); }
DI float xchg16(float v, bool hi) { const auto r = __builtin_amdgcn_permlane16_swap(__builtin_bit_cast(unsigned, v), __builtin_bit_cast(unsigned, v), false, false);
    return __builtin_bit_cast(float, hi ? r[0] : r[1]); }
DI float xchg8(float v) { return __builtin_bit_cast(float, __builtin_amdgcn_mov_dpp(__builtin_bit_cast(int, v), 0x128, 0xF, 0xF, true)); }
typedef _Float16 h16x2 __attribute__((ext_vector_type(2)));
DI unsigned xchg32u(unsigned v, bool hi) { const auto r = __builtin_amdgcn_permlane32_swap(v, v, false, false); return hi ? r[0] : r[1]; }
DI unsigned xchg16u(unsigned v, bool hi) { const auto r = __builtin_amdgcn_permlane16_swap(v, v, false, false); return hi ? r[0] : r[1]; }
DI unsigned xchg8u(unsigned v) { return (unsigned)__builtin_amdgcn_mov_dpp((int)v, 0x128, 0xF, 0xF, true); }
DI void peer_v_compute(const PeerVRows& R, float* xdst, int lane) {
    h16x2 a[16];
#pragma unroll
    for (int j = 0; j < 16; ++j) a[j] = (h16x2){(_Float16)0.f, (_Float16)0.f};
#pragma unroll
    for (int i = 0; i < 16; ++i) {
        const _Float16 ch = (_Float16)R.cf[i >> 2][i & 3]; const h16x2 c2 = {ch, ch};
#pragma unroll
        for (int d = 0; d < 4; ++d) {
            a[4 * d + 0] += c2 * __builtin_amdgcn_cvt_scalef32_pk_f16_fp4(R.q[i][d], 1.0f, 0);
            a[4 * d + 1] += c2 * __builtin_amdgcn_cvt_scalef32_pk_f16_fp4(R.q[i][d], 1.0f, 1);
            a[4 * d + 2] += c2 * __builtin_amdgcn_cvt_scalef32_pk_f16_fp4(R.q[i][d], 1.0f, 2);
            a[4 * d + 3] += c2 * __builtin_amdgcn_cvt_scalef32_pk_f16_fp4(R.q[i][d], 1.0f, 3);
        }
    }
    const bool b5 = (lane & 32) != 0, b4 = (lane & 16) != 0, b3 = (lane & 8) != 0;
    h16x2 k8[8];
#pragma unroll
    for (int j = 0; j < 8; ++j) { const h16x2 keep = b5 ? a[8 + j] : a[j], send = b5 ? a[j] : a[8 + j];
        k8[j] = keep + __builtin_bit_cast(h16x2, xchg32u(__builtin_bit_cast(unsigned, send), b5)); }
    h16x2 k4[4];
#pragma unroll
    for (int j = 0; j < 4; ++j) { const h16x2 keep = b4 ? k8[4 + j] : k8[j], send = b4 ? k8[j] : k8[4 + j];
        k4[j] = keep + __builtin_bit_cast(h16x2, xchg16u(__builtin_bit_cast(unsigned, send), b4)); }
    h16x2 k2[2];
#pragma unroll
    for (int j = 0; j < 2; ++j) { const h16x2 keep = b3 ? k4[2 + j] : k4[j], send = b3 ? k4[j] : k4[2 + j];
        k2[j] = keep + __builtin_bit_cast(h16x2, xchg8u(__builtin_bit_cast(unsigned, send))); }
    *(f32x4*)xdst = R.xv + R.gv * (f32x4){(float)k2[0].x, (float)k2[0].y, (float)k2[1].x, (float)k2[1].y};
}
DI void phase_peer_v(const Params& p, const Frame& F, int l, bool dummy = false) {
    const int ntok = (l == 0) ? T : TL, lane = F.lane, half = ntok >> 1;
    const int grp = F.bid & 7, cs = grp & 3, th = grp >> 2, sw = (F.bid >> 3) * NWAVES + F.wave, nsw = (F.nb >> 3) * NWAVES;
    const unsigned char* vt = p.ws + WS_VTAB + (size_t)l * NEXP * (D / 2) + 128 * cs + 16 * (lane & 7);
    const unsigned short* IDXg = (const unsigned short*)(p.ws + WS_IDX) + 16 * (lane >> 3);
    const float* CFg = (const float*)(p.ws + WS_GW) + 16 * (lane >> 3);
    const int t0 = th * half, tend = t0 + half, last = tend - 1;
    u32x4 sa[2], sb[2]; PeerVRows ra, rb;
#define V_SEL(S_, t_) do { const unsigned short* ip_ = IDXg + (size_t)min((t_), last) * 128; S_[0] = *(const u32x4*)ip_; S_[1] = *(const u32x4*)(ip_ + 8); } while (0)
    const int co = 256 * cs + 32 * (lane & 7) + ((lane & 32) ? 16 : 0) + ((lane & 16) ? 8 : 0) + ((lane & 8) ? 4 : 0);
#define V_ROWS(R_, S_, t_) do { const int t1_ = min((t_), last); peer_v_rows(R_, S_, vt, CFg + (size_t)t1_ * 128, xrow_ptr(p, t1_) + co, mod_vec(p, l, t1_, 5) + co); } while (0)
#define V_DO(R_, t_) do { const int t2_ = (t_); float* xd_ = (dummy ? (float*)(p.ws + WS_ST) + (size_t)t2_ * D : xrow_ptr(p, t2_)) + co; peer_v_compute(R_, xd_, lane); } while (0)
    V_SEL(sa, t0 + sw); V_SEL(sb, t0 + sw + nsw);
    V_ROWS(ra, sa, t0 + sw);
#pragma unroll 1
    for (int tok = t0 + sw; tok < tend; tok += 2 * nsw) {
        V_SEL(sa, tok + 2 * nsw); V_ROWS(rb, sb, tok + nsw);
        V_DO(ra, tok);
        V_SEL(sb, tok + 3 * nsw); V_ROWS(ra, sa, tok + 2 * nsw);
        if (tok + nsw < tend) V_DO(rb, tok + nsw);
    }
#undef V_SEL
#undef V_ROWS
#undef V_DO
}

#define XB_TMO      128
#define XB_XCNT(j)  (256  + 64 * (j))
#define XB_XSUB(j)  (1280 + 64 * (j))
#define XB_XGEN(j)  (2304 + 64 * (j))
#define XB_TOP      3328
#define XB_TOPGEN   3392
#define XCD_BAR_WORDS 3456
#define XB_SPIN_CAP (1u << 18)
DI unsigned xb_ld(unsigned* p)              { return __hip_atomic_load(p, __ATOMIC_RELAXED, __HIP_MEMORY_SCOPE_AGENT); }
DI unsigned xb_add(unsigned* p, unsigned v) { return __hip_atomic_fetch_add(p, v, __ATOMIC_RELAXED, __HIP_MEMORY_SCOPE_AGENT); }
DI unsigned xb_xcc_id() { return (unsigned)__builtin_amdgcn_s_getreg((3 << 11) | 20) & 0xFu; }
#define XB_SPIN(cond, bar) do { unsigned _sp = 0; while (cond) { __builtin_amdgcn_s_sleep(1); \
    if ((++_sp & 255u) == 0u) { if (xb_ld(&(bar)[XB_TMO])) break; if (_sp > XB_SPIN_CAP) { atomicAdd(&(bar)[XB_TMO], 1u); break; } } } } while (0)
struct XcdBarrier { unsigned* bar; unsigned x; volatile LAS unsigned* st; };
DI XcdBarrier xcd_barrier_post(unsigned* bar, volatile LAS unsigned* st) {
    XcdBarrier b; b.bar = bar; b.x = xb_xcc_id(); b.st = st;
    if (threadIdx.x == 0) (void)xb_add(&bar[XB_XCNT(b.x)], 1u);
    return b;
}
DI void xcd_barrier_complete(unsigned* bar, unsigned x, unsigned& nloc, unsigned& nx) {
    const unsigned G = gridDim.x * gridDim.y * gridDim.z;
    unsigned sum, cnt, mine, sp = 0u;
    for (;;) {
        sum = 0u; cnt = 0u; mine = 0u;
#pragma unroll
        for (unsigned j = 0; j < 16; ++j) { const unsigned c = xb_ld(&bar[XB_XCNT(j)]); sum += c; cnt += (c > 0u) ? 1u : 0u; mine = (j == x) ? c : mine; }
        if (sum == G) break;
        __builtin_amdgcn_s_sleep(1);
        if ((++sp & 255u) == 0u) { if (xb_ld(&bar[XB_TMO])) break; if (sp > XB_SPIN_CAP) { atomicAdd(&bar[XB_TMO], 1u); break; } }
    }
    nloc = mine > 0u ? mine : 1u; nx = cnt > 0u ? cnt : 1u;
}
DI void xcd_barrier(const XcdBarrier& b) {
    asm volatile("s_waitcnt vmcnt(0)" ::: "memory");
    __syncthreads();
    if (threadIdx.x == 0) {
        unsigned* bar = b.bar;
        __builtin_amdgcn_s_waitcnt(0);
        unsigned nloc = b.st[0], nx = b.st[1];
        if (nloc == 0u) { xcd_barrier_complete(bar, b.x, nloc, nx); b.st[0] = nloc; b.st[1] = nx; }
        const unsigned old = xb_add(&bar[XB_XSUB(b.x)], 1u);
        const unsigned gen = old / nloc;
        if (old + 1u == (gen + 1u) * nloc) {
            __builtin_amdgcn_fence(__ATOMIC_RELEASE, "agent");
            asm volatile("s_waitcnt vmcnt(0)" ::: "memory");
            const unsigned og = xb_add(&bar[XB_TOP], 1u);
            const unsigned tg = og / nx;
            if (og + 1u == (tg + 1u) * nx) xb_add(&bar[XB_TOPGEN], 1u);
            else XB_SPIN(xb_ld(&bar[XB_TOPGEN]) == tg, bar);
            __builtin_amdgcn_fence(__ATOMIC_ACQUIRE, "agent");
            xb_add(&bar[XB_XGEN(b.x)], 1u);
            asm volatile("s_waitcnt vmcnt(0)" ::: "memory");
        } else {
            XB_SPIN(xb_ld(&bar[XB_XGEN(b.x)]) == gen, bar);
            __builtin_amdgcn_fence(__ATOMIC_ACQUIRE, "agent");
            asm volatile("s_waitcnt vmcnt(0)" ::: "memory");
        }
    }
    __syncthreads();
}

constexpr int NPHASE = 25;
template <int PH> DI void run_phase(const Params& p, const Frame& F) {
    if constexpr (PH == 0) phase_prep(p, F);
    else if constexpr (PH == 1) phase_norm(p, F, 0, 0, true, T);
    else if constexpr (PH == 2) phase_g1(p, F, 0);
    else if constexpr (PH == 3) phase_mix(p, F, 0);
    else if constexpr (PH == 4) phase_g2(p, F, 0);
    else if constexpr (PH == 5) phase_g2sum(p, F);
    else if constexpr (PH == 6) phase_g3(p, F, 0);
    else if constexpr (PH == 7) phase_norm(p, F, 0, 1, false, T);
    else if constexpr (PH == 8) phase_g45(p, F, 0);
    else if constexpr (PH == 9) phase_sel(p, F, 0);
    else if constexpr (PH == 10) phase_peer_u(p, F, 0);
    else if constexpr (PH == 11) phase_peer_c(p, F, 0);
    else if constexpr (PH == 12) phase_peer_v(p, F, 0);
    else if constexpr (PH == 13) phase_norm(p, F, 1, 0, false, T);
    else if constexpr (PH == 14) phase_g1(p, F, 1);
    else if constexpr (PH == 15) phase_mix(p, F, 1);
    else if constexpr (PH == 16) phase_g2(p, F, 1);
    else if constexpr (PH == 17) phase_g3(p, F, 1);
    else if constexpr (PH == 18) phase_norm(p, F, 1, 1, false, TL);
    else if constexpr (PH == 19) phase_g45(p, F, 1);
    else if constexpr (PH == 20) phase_sel(p, F, 1);
    else if constexpr (PH == 21) phase_peer_u(p, F, 1);
    else if constexpr (PH == 22) phase_peer_c(p, F, 1);
    else if constexpr (PH == 23) phase_peer_v(p, F, 1);
    else if constexpr (PH == 24) phase_final(p, F);
}
DI Frame make_frame(unsigned char* lds_raw) {
    Frame F;
    F.lds = (LAS unsigned char*)lds_raw;
    int tid = threadIdx.x; asm volatile("" : "+v"(tid));
    int bid = blockIdx.x, nb = gridDim.x; asm volatile("" : "+s"(bid), "+s"(nb));
    F.tid = tid; F.lane = tid & 63; F.wave = __builtin_amdgcn_readfirstlane(tid >> 6); F.bid = bid; F.nb = nb;
    F.gw = bid * NWAVES + F.wave; F.ngw = nb * NWAVES; F.gtid = bid * NTHREADS + tid; F.ngt = nb * NTHREADS;
    return F;
}
template <int PH> DI void run_phase_fresh(unsigned char* lds_raw) {
#if defined(__HIP_DEVICE_COMPILE__)
    const __attribute__((address_space(4))) unsigned long long* pp = (const __attribute__((address_space(4))) unsigned long long*)__builtin_amdgcn_kernarg_segment_ptr();
    asm volatile("" : "+s"(pp));
    Params p;
#pragma unroll
    for (int i = 0; i < N_IN; ++i) p.in[i] = (const float*)(const __attribute__((address_space(1))) float*)pp[i];
    p.out = (float*)(__attribute__((address_space(1))) float*)pp[N_IN]; p.ws = (unsigned char*)(__attribute__((address_space(1))) unsigned char*)pp[N_IN + 1]; p.ph_lo = 0; p.ph_hi = 0;
#else
    Params p{};
#endif
    const Frame F = make_frame(lds_raw);
    run_phase<PH>(p, F);
}
template <int PH> __global__ void __launch_bounds__(NTHREADS, 2) phase_kernel(Params p) {
    extern __shared__ __attribute__((aligned(16))) unsigned char lds_raw[];
    run_phase_fresh<PH>(lds_raw);
}
template <int PH> DI void run_all(unsigned char* lds_raw, cg::grid_group& grid, const XcdBarrier& bar) {
    if constexpr (PH < NPHASE) {
        if constexpr (PH == PROBE_PH) {
            if constexpr (PH == 11 || PH == 22 || PH == 12 || PH == 23) {
#if defined(__HIP_DEVICE_COMPILE__)
                const __attribute__((address_space(4))) unsigned long long* pp = (const __attribute__((address_space(4))) unsigned long long*)__builtin_amdgcn_kernarg_segment_ptr();
                asm volatile("" : "+s"(pp));
                Params p;
#pragma unroll
                for (int i = 0; i < N_IN; ++i) p.in[i] = (const float*)(const __attribute__((address_space(1))) float*)pp[i];
                p.out = (float*)(__attribute__((address_space(1))) float*)pp[N_IN]; p.ws = (unsigned char*)(__attribute__((address_space(1))) unsigned char*)pp[N_IN + 1]; p.ph_lo = 0; p.ph_hi = 0;
                const Frame F = make_frame(lds_raw);
                if constexpr (PH == 11 || PH == 22) phase_peer_c(p, F, PH == 11 ? 0 : 1, true); else phase_peer_v(p, F, PH == 12 ? 0 : 1, true);
#endif
            } else run_phase_fresh<PH>(lds_raw);
            xcd_barrier(bar);
        }
        run_phase_fresh<PH>(lds_raw);
        if constexpr (PH + 1 < NPHASE) { xcd_barrier(bar); if constexpr (PROBE_SYNC) xcd_barrier(bar); }
        run_all<PH + 1>(lds_raw, grid, bar);
    }
}
__global__ void __launch_bounds__(NTHREADS, 2) mega(Params p) {
    extern __shared__ __attribute__((aligned(16))) unsigned char lds_raw[];
    cg::grid_group grid = cg::this_grid();
    volatile LAS unsigned* st = (volatile LAS unsigned*)((LAS unsigned char*)lds_raw + LDS_BAR_OFF);
    if (threadIdx.x < 2) st[threadIdx.x] = 0u;
    __syncthreads();
    const XcdBarrier bar = xcd_barrier_post((unsigned*)(p.ws + WS_CTL), st);
    if (p.ph_lo != 0) grid.sync();
    run_all<0>(lds_raw, grid, bar);
}

extern "C" void kernel_launch(void* const* d_in, const int* in_sizes, int n_in, void* d_out, int out_size, void* d_ws, size_t ws_size, hipStream_t stream) {
    static int grid = 0;
    if (grid == 0) {
        if (n_in != 23 || out_size != TL * D || ws_size < WS_END) { fprintf(stderr, "kernel_launch: unexpected shapes (n_in %d out %d ws %zu)\n", n_in, out_size, ws_size); grid = -1; return; }
        int dev = 0, cus = 0, per_cu = 0;
        (void)hipGetDevice(&dev);
        (void)hipDeviceGetAttribute(&cus, hipDeviceAttributeMultiprocessorCount, dev);
        (void)hipFuncSetAttribute((const void*)mega, hipFuncAttributeMaxDynamicSharedMemorySize, LDS_BYTES);
        (void)hipOccupancyMaxActiveBlocksPerMultiprocessor(&per_cu, (const void*)mega, NTHREADS, LDS_BYTES);
        if (per_cu < 1) { fprintf(stderr, "kernel_launch: occupancy query reports %d blocks per CU\n", per_cu); grid = -1; return; }
        grid = cus & ~7;
        if (grid < 8) { fprintf(stderr, "kernel_launch: needs at least 8 CUs\n"); grid = -1; return; }
    }
    if (grid < 0) return;
    (void)hipMemsetAsync((char*)d_ws + WS_CTL, 0, CTL_ZERO_BYTES, stream);
    Params p{};
    for (int i = 0; i < N_IN; ++i) p.in[i] = (const float*)d_in[i];
    p.out = (float*)d_out; p.ws = (unsigned char*)d_ws;
    void* args[] = {&p};
    hipError_t e = hipLaunchCooperativeKernel((const void*)mega, dim3(grid), dim3(NTHREADS), args, LDS_BYTES, stream);
    if (e != hipSuccess) fprintf(stderr, "cooperative launch failed: %s (grid %d)\n", hipGetErrorString(e), grid);
}
```

```cpp
#include <hip/hip_runtime.h>
#include <hip/hip_cooperative_groups.h>
#include <stdint.h>
#include <stdio.h>
namespace cg = cooperative_groups;

#ifndef PROBE_PH
#define PROBE_PH -1
#endif
#ifndef PROBE_SYNC
#define PROBE_SYNC 0
#endif
#ifndef MK_SINGLE
#define MK_SINGLE 0
#endif

#define LAS __attribute__((address_space(3)))
typedef unsigned short bf16_t;
typedef short bf16x8 __attribute__((ext_vector_type(8)));
typedef short s16x4 __attribute__((ext_vector_type(4)));
typedef float f32x4 __attribute__((ext_vector_type(4)));
typedef float f32x2 __attribute__((ext_vector_type(2)));
typedef float f32x16 __attribute__((ext_vector_type(16)));
typedef unsigned u32x4 __attribute__((ext_vector_type(4)));
typedef unsigned u32x2 __attribute__((ext_vector_type(2)));
typedef __bf16 bf16x2_t __attribute__((ext_vector_type(2)));
typedef _Float16 f16x2_t __attribute__((ext_vector_type(2)));
#define DI __device__ __forceinline__
DI unsigned pkh2(float lo, float hi) { f16x2_t v = {(_Float16)lo, (_Float16)hi}; return __builtin_bit_cast(unsigned, v); }
#define MFMA32(a, b, c) __builtin_amdgcn_mfma_f32_32x32x16_bf16((a), (b), (c), 0, 0, 0)

constexpr int D = 1024, NB = 8, SEQ = 4096, NCTX = 256, DEPTH = 2;
constexpr int TL = NB * SEQ, TC = NB * NCTX, T = TL + TC;
constexpr int INW = 4608, NMOD = 6 * D, PW = 1600, PN = 1536;
constexpr int VTS = SEQ + 64;
constexpr int QOFF = 0, KOFF = 512, VOFF = 640, POOLOFF = 768, SUOFF = 1024, SVOFF = 1280, GATEOFF = 1536;
constexpr int NEXP = 16384;
constexpr float EPS = 1e-6f;
constexpr float LOG2E = 1.4426950408889634f;
constexpr float QSCALE = 0.125f * LOG2E;

constexpr size_t MiB = 1u << 20;
constexpr size_t WS_CTL = 0, WS_MOD = 1 * MiB, CTL_ZERO_BYTES = 2 * MiB;
constexpr size_t WS_ROPE = 2 * MiB, WS_SGUW = 2 * MiB + 65536, WS_TSCALE = 3 * MiB;
constexpr size_t WS_WIN = 4 * MiB, WS_WBR = 22 * MiB, WS_WOUT = 26 * MiB, WS_WFOLD = 30 * MiB;
constexpr size_t WS_XCTX = 38 * MiB, WS_UTAB = 46 * MiB, WS_VTAB = 78 * MiB;
constexpr size_t WS_IDX = 110 * MiB, WS_GW = 120 * MiB;
constexpr size_t WS_H = 142 * MiB;
constexpr size_t WS_P = 210 * MiB, WS_Y = 318 * MiB, WS_MERGED = 386 * MiB, WS_VT = 454 * MiB, WS_VTC = 463 * MiB, WS_VST = 464 * MiB;
constexpr size_t WS_G8 = WS_P;
constexpr size_t WS_MP = 482 * MiB;
constexpr size_t WS_ST = 210 * MiB, WS_H8 = 346 * MiB, WS_HS = 380 * MiB, WS_SU = 482 * MiB;
constexpr size_t WS_END = 512 * MiB;
static_assert(WS_ST + (size_t)2048 * T * 2 <= WS_H8 && WS_H8 + (size_t)T * D <= WS_HS, "ST / H8 fit");
static_assert(WS_VST + (size_t)272 * 256 * 128 * 2 <= WS_SU && WS_VT + (size_t)NB * 2 * 64 * VTS * 2 <= WS_VTC, "VsT / VT fit");
static_assert(WS_H + (size_t)T * D * 2 <= WS_P && WS_G8 + (size_t)T * 3072 <= WS_Y, "H / G8 fit");
static_assert(WS_P + (size_t)T * PW * 2 <= WS_Y && WS_Y + (size_t)T * D * 2 <= WS_MERGED && WS_MERGED + (size_t)T * D * 2 <= WS_VT, "P/Y/MERGED fit");
static_assert(WS_IDX + (size_t)T * 128 * 2 <= WS_GW && WS_GW + (size_t)T * 128 * 4 <= WS_H && WS_SU + (size_t)T * 128 * 4 <= WS_END && WS_HS + (size_t)T * 4 <= WS_SU, "idx/gw/su fit");

constexpr int LDS_BYTES = 163840;
constexpr int LDS_BAR_OFF = LDS_BYTES - 64;
constexpr int NTHREADS = 512, NWAVES = 8;

enum { I_x, I_c, I_ctx, I_c_ctx, I_w_mod, I_b_mod, I_g_mix, I_g_ffn, I_w_in, I_attn_sink, I_pool_w, I_pool_scale, I_sgu_w, I_sgu_b, I_w_br_attn, I_w_br_pool, I_w_br_sgu, I_w_out, I_peer_wq, I_peer_subkeys, I_peer_u, I_peer_v, I_g_final, N_IN };
struct Params {
    const float* in[N_IN];
    float* out; unsigned char* ws;
    int ph_lo, ph_hi;
};

DI unsigned pk2(float lo, float hi) { f32x2 v = {lo, hi}; return __builtin_bit_cast(unsigned, __builtin_convertvector(v, bf16x2_t)); }
DI unsigned f2bf(float f) { return pk2(f, 0.f) & 0xffffu; }
DI float bf2f(unsigned short u) { return __builtin_bit_cast(float, (unsigned)u << 16); }
DI float bflo(unsigned w) { return __builtin_bit_cast(float, w << 16); }
DI float bfhi(unsigned w) { return __builtin_bit_cast(float, w & 0xffff0000u); }
DI int crow(int reg, int h) { return (reg & 3) + 8 * (reg >> 2) + 4 * h; }
DI int dpp_x1(int v) { return __builtin_amdgcn_mov_dpp(v, 0xB1, 0xF, 0xF, true); }
DI float wave_sum(float v) {
#pragma unroll
    for (int o = 1; o < 64; o <<= 1) v += __shfl_xor(v, o);
    return v;
}
DI float sigmoidf_(float x) { return __builtin_amdgcn_rcpf(1.0f + __expf(-x)); }
DI float gelu_tanh(float x) { const float u = 0.7978845608028654f * (x + 0.044715f * x * x * x); return x * __builtin_amdgcn_rcpf(1.0f + __expf(-2.0f * u)); }
DI float silu_(float x) { return x * __builtin_amdgcn_rcpf(1.0f + __expf(-x)); }

struct Frame {
    int tid, lane, wave, gw, ngw, gtid, ngt, bid, nb;
    LAS unsigned char* lds;
};

template <int NM, int NN>
DI void wave_gemm(const bf16_t* __restrict__ A, int lda, const bf16_t* __restrict__ Bt, int ldb, int K, int m0, int n0, f32x16 (&acc)[NM][NN], int lane) {
    const int r = lane & 31, h = lane >> 5;
    const bf16_t* ap = A + (size_t)(m0 + r) * lda + 8 * h;
    const bf16_t* bp = Bt + (size_t)(n0 + r) * ldb + 8 * h;
    for (int k0 = 0; k0 < K; k0 += 64) {
        bf16x8 a[4][NM], b[4][NN];
#pragma unroll
        for (int s = 0; s < 4; ++s) {
#pragma unroll
            for (int i = 0; i < NM; ++i) a[s][i] = *(const bf16x8*)(ap + (size_t)(32 * i) * lda + k0 + 16 * s);
#pragma unroll
            for (int j = 0; j < NN; ++j) b[s][j] = *(const bf16x8*)(bp + (size_t)(32 * j) * ldb + k0 + 16 * s);
        }
#pragma unroll
        for (int s = 0; s < 4; ++s)
#pragma unroll
            for (int i = 0; i < NM; ++i)
#pragma unroll
                for (int j = 0; j < NN; ++j) acc[i][j] = MFMA32(a[s][i], b[s][j], acc[i][j]);
    }
}
template <int NM, int NN> DI void zero_acc(f32x16 (&acc)[NM][NN]) {
#pragma unroll
    for (int i = 0; i < NM; ++i)
#pragma unroll
        for (int j = 0; j < NN; ++j)
#pragma unroll
            for (int r = 0; r < 16; ++r) acc[i][j][r] = 0.f;
}

namespace pg8 {
constexpr int BM = 256, BK = 64, HALF = 128, HTB = HALF * BK * 2, STAGE_BYTES = 8 * HTB, NXCD = 8, WGM = 8, LD = 1024;
DI int lds_byte(int r, int c) { const int st = (r >> 4) * 2 + (c >> 5), rr = r & 15, cc = c & 31, ob = rr * 64 + cc * 2; return st * 1024 + (ob ^ (((ob >> 9) & 1) << 5)); }
DI void stage_rc(int b, int& R, int& C) { const int st = b / 1024, sb = b % 1024, swz = sb ^ (((sb >> 9) & 1) << 5); R = (st >> 1) * 16 + swz / 64; C = (st & 1) * 32 + (swz % 64) / 2; }
DI int perm32(int rho) { const int n = rho >> 4, i = rho & 15; return 8 * (i >> 2) + 4 * n + (i & 3); }
struct Unit { int pm, pn, sub, nt, mode; const char* a; const char* b; };
DI void tile_of(int L, int nM, int nN, int& pm, int& pn) {
    const int nwg = nM * nN; int wgid = L;
    { const int q = nwg / NXCD, r = nwg % NXCD, xcd = wgid % NXCD, off = wgid / NXCD; wgid = (xcd < r ? xcd * (q + 1) : r * (q + 1) + (xcd - r) * q) + off; }
    const int nig = WGM * nN, gid = wgid / nig, fm = gid * WGM, gsz = (nM - fm) < WGM ? (nM - fm) : WGM;
    pm = fm + ((wgid % nig) % gsz); pn = (wgid % nig) / gsz;
}
template <class Epi, class Sched>
DI void gemm_phase(LAS unsigned char* lds, const int tid, const Sched& S, const Epi& E) {
    const int wid = __builtin_amdgcn_readfirstlane(tid >> 6), lane = tid & 63, wr = wid >> 2, wc = wid & 3, fr = lane & 15, fq = lane >> 4;
    unsigned voffA[2], voffB[2];
#pragma unroll
    for (int i = 0; i < 2; ++i) { int R, C; stage_rc(tid * 16 + i * 8192, R, C); const int Rb = Epi::PERM ? ((R & ~31) + perm32(R & 31)) : R;
        voffA[i] = (unsigned)(R * LD + C) * 2u; voffB[i] = (unsigned)(Rb * LD + C) * 2u; }
    const size_t kstep = (size_t)(BK * 2);
    const size_t hstep = (size_t)HALF * LD * 2;
    const unsigned ldsw = (unsigned)wid * 1024u;
    const int aoff = lds_byte(wr * 64 + fr, fq * 8), boff = lds_byte(wc * 32 + fr, fq * 8);
#define PG8_SA(b, h) (((b) * 2 + (h)) * HTB)
#define PG8_SB(b, h) ((4 + (b) * 2 + (h)) * HTB)
#define PG8_STAGE(bufoff, gbase, voff) do { _Pragma("unroll") for (int _i = 0; _i < 2; ++_i) \
        __builtin_amdgcn_global_load_lds((const unsigned*)((const char*)(gbase) + (voff)[_i]), (LAS unsigned*)(lds + (bufoff) + ldsw + _i * 8192), 16, 0, 0); } while (0)
#define PG8_LDA(dst, b, h) do { _Pragma("unroll") for (int m = 0; m < 4; ++m) _Pragma("unroll") for (int k = 0; k < 2; ++k) dst[m][k] = *(const LAS bf16x8*)(lds + PG8_SA(b, h) + aoff + m * 2048 + k * 1024); } while (0)
#define PG8_LDB(dst, b, h) do { _Pragma("unroll") for (int n = 0; n < 2; ++n) _Pragma("unroll") for (int k = 0; k < 2; ++k) dst[n][k] = *(const LAS bf16x8*)(lds + PG8_SB(b, h) + boff + n * 2048 + k * 1024); } while (0)
#define PG8_MMA(ai, bj, At, Bt) do { __builtin_amdgcn_s_setprio(1); _Pragma("unroll") for (int m = 0; m < 4; ++m) _Pragma("unroll") for (int n = 0; n < 2; ++n) _Pragma("unroll") for (int k = 0; k < 2; ++k) \
        acc[ai][bj][m][n] = __builtin_amdgcn_mfma_f32_16x16x32_bf16(Bt[n][k], At[m][k], acc[ai][bj][m][n], 0, 0, 0); __builtin_amdgcn_s_setprio(0); } while (0)
#define PG8_WAIT_V(n) asm volatile("s_waitcnt vmcnt(" #n ")" ::: "memory")
#define PG8_WAIT_L(n) asm volatile("s_waitcnt lgkmcnt(" #n ")" ::: "memory")
#define PG8_BAR __builtin_amdgcn_s_barrier()
#define PG8_SCHED __builtin_amdgcn_sched_barrier(0)
    Unit cur, nxt; int ui = 0;
    if (!S.next(0, cur)) return;
    f32x4 acc[2][2][4][2];
#pragma unroll
    for (int a = 0; a < 2; ++a)
#pragma unroll
        for (int b = 0; b < 2; ++b)
#pragma unroll
            for (int m = 0; m < 4; ++m)
#pragma unroll
                for (int n = 0; n < 2; ++n) acc[a][b][m][n] = (f32x4){0.f, 0.f, 0.f, 0.f};
    bf16x8 At[4][2], B0[2][2], B1[2][2];
    const char* cA = cur.a; const char* cB = cur.b;
    PG8_STAGE(PG8_SB(0, 0), cB, voffB); PG8_STAGE(PG8_SB(0, 1), cB + hstep, voffB); PG8_STAGE(PG8_SA(0, 0), cA, voffA); PG8_STAGE(PG8_SA(0, 1), cA + hstep, voffA);
    if (wr == 1) PG8_BAR;
    PG8_WAIT_V(2); PG8_BAR;
    PG8_STAGE(PG8_SB(1, 0), cB + kstep, voffB); PG8_STAGE(PG8_SA(1, 0), cA + kstep, voffA); PG8_STAGE(PG8_SB(1, 1), cB + hstep + kstep, voffB);
    PG8_WAIT_V(6); PG8_BAR;
    for (;;) {
        const bool has_next = S.next(ui + 1, nxt);
        const char* nA = has_next ? nxt.a : cA; const char* nB = has_next ? nxt.b : cB;
        const int nt = cur.nt;
        for (int t = 0; t < nt; t += 2) {
            const bool last = (t == nt - 2);
            const char* a1 = cA + (size_t)(t + 1) * kstep;
            const char* a2 = last ? nA : cA + (size_t)(t + 2) * kstep; const char* b2 = last ? nB : cB + (size_t)(t + 2) * kstep;
            const char* a3 = a2 + kstep; const char* b3 = b2 + kstep;
            PG8_LDB(B0, 0, 0); PG8_LDB(B1, 0, 1); PG8_SCHED; PG8_LDA(At, 0, 0); PG8_STAGE(PG8_SA(1, 1), a1 + hstep, voffA);
            PG8_WAIT_V(8); PG8_WAIT_L(0); PG8_BAR; PG8_MMA(0, 0, At, B0); PG8_MMA(0, 1, At, B1); PG8_BAR; PG8_SCHED;
            PG8_LDA(At, 0, 1); PG8_STAGE(PG8_SB(0, 0), b2, voffB); PG8_STAGE(PG8_SB(0, 1), b2 + hstep, voffB); PG8_STAGE(PG8_SA(0, 0), a2, voffA);
            PG8_WAIT_V(8); PG8_WAIT_L(0); PG8_BAR; PG8_MMA(1, 0, At, B0); PG8_MMA(1, 1, At, B1); PG8_BAR; PG8_SCHED;
            PG8_LDB(B0, 1, 0); PG8_LDB(B1, 1, 1); PG8_SCHED; PG8_LDA(At, 1, 0); PG8_STAGE(PG8_SA(0, 1), a2 + hstep, voffA);
            PG8_WAIT_V(8); PG8_WAIT_L(0); PG8_BAR; PG8_MMA(0, 0, At, B0); PG8_MMA(0, 1, At, B1); PG8_BAR; PG8_SCHED;
            PG8_LDA(At, 1, 1); PG8_STAGE(PG8_SB(1, 0), b3, voffB); PG8_STAGE(PG8_SB(1, 1), b3 + hstep, voffB); PG8_STAGE(PG8_SA(1, 0), a3, voffA);
            PG8_WAIT_V(8); PG8_WAIT_L(0); PG8_BAR; PG8_MMA(1, 0, At, B0); PG8_MMA(1, 1, At, B1); PG8_BAR; PG8_SCHED;
        }
        if (wr == 0) PG8_BAR;
        E(acc, cur, wr, wc, fr, fq);
        if (!has_next) break;
        if (!E.keeps(cur)) {
#pragma unroll
        for (int a = 0; a < 2; ++a)
#pragma unroll
            for (int b = 0; b < 2; ++b)
#pragma unroll
                for (int m = 0; m < 4; ++m)
#pragma unroll
                    for (int n = 0; n < 2; ++n) acc[a][b][m][n] = (f32x4){0.f, 0.f, 0.f, 0.f};
        }
        cur = nxt; cA = nA; cB = nB; ++ui;
        if (wr == 1) PG8_BAR;
    }
    PG8_WAIT_V(0);
    PG8_BAR;
#undef PG8_SA
#undef PG8_SB
#undef PG8_STAGE
#undef PG8_LDA
#undef PG8_LDB
#undef PG8_MMA
#undef PG8_WAIT_V
#undef PG8_WAIT_L
#undef PG8_BAR
#undef PG8_SCHED
}
}

DI void transpose_item(const float* W, int K, int N, bf16_t* WT, int ldd, int row_off, int col_off, LAS float* scr, int item, int lane) {
    const int nblk = N / 32, kb = item / nblk, nb = item % nblk, k0 = 64 * kb, n0 = 32 * nb;
#pragma unroll 8
    for (int i = 0; i < 32; ++i) { const int kk = 2 * i + (lane >> 5); scr[kk * 33 + (lane & 31)] = W[(size_t)(k0 + kk) * N + n0 + (lane & 31)]; }
    asm volatile("s_waitcnt lgkmcnt(0)" ::: "memory");
    const int c = lane & 7;
#pragma unroll
    for (int j = 0; j < 4; ++j) { const int n = (lane >> 3) + 8 * j; const LAS float* s = scr + (8 * c) * 33 + n;
        u32x4 o; o.x = pk2(s[0 * 33], s[1 * 33]); o.y = pk2(s[2 * 33], s[3 * 33]); o.z = pk2(s[4 * 33], s[5 * 33]); o.w = pk2(s[6 * 33], s[7 * 33]);
        *(u32x4*)(WT + (size_t)(row_off + n0 + n) * ldd + col_off + k0 + 8 * c) = o; }
    asm volatile("s_waitcnt lgkmcnt(0)" ::: "memory");
}

DI void convert_tables(const Params& p, const Frame& F) {
    for (int it0 = 4 * F.gw; it0 < 4 * NEXP; it0 += 4 * F.ngw) {
        f32x4 v[4][4];
#pragma unroll
        for (int u = 0; u < 4; ++u) {
            const int it = it0 + u, e = it & (NEXP - 1), tbl = (it >> 14) & 1, l = it >> 15;
            const f32x4* src = (const f32x4*)((tbl ? p.in[I_peer_v] : p.in[I_peer_u]) + ((size_t)l * NEXP + e) * D) + 4 * F.lane;
#pragma unroll
            for (int j = 0; j < 4; ++j) v[u][j] = src[j];
        }
#pragma unroll
        for (int u = 0; u < 4; ++u) {
            const int it = it0 + u, e = it & (NEXP - 1), tbl = (it >> 14) & 1, l = it >> 15;
            float am = 0.f;
#pragma unroll
            for (int j = 0; j < 4; ++j) am = fmaxf(am, fmaxf(fmaxf(fabsf(v[u][j].x), fabsf(v[u][j].y)), fmaxf(fabsf(v[u][j].z), fabsf(v[u][j].w))));
#pragma unroll
            for (int o = 1; o < 64; o <<= 1) am = fmaxf(am, __shfl_xor(am, o));
            float sc;
            if (tbl) sc = (am > 0.f) ? 6.0f / am : 1.0f;
            else {
                float ss = 0.f;
#pragma unroll
                for (int j = 0; j < 4; ++j) ss += v[u][j].x * v[u][j].x + v[u][j].y * v[u][j].y + v[u][j].z * v[u][j].z + v[u][j].w * v[u][j].w;
                const float rms = sqrtf(wave_sum(ss) * (1.0f / D));
                const float step = fminf(am * (1.0f / 7.0f), 0.335f * rms);
                sc = (step > 0.f) ? 1.0f / step : 1.0f;
            }
            if (tbl) {
                u32x2 q4;
#pragma unroll
                for (int d = 0; d < 2; ++d) { unsigned w = 0;
                    w = __builtin_amdgcn_cvt_scalef32_pk_fp4_f32(w, v[u][2 * d][0] * sc, v[u][2 * d][1] * sc, 1.0f, 0);
                    w = __builtin_amdgcn_cvt_scalef32_pk_fp4_f32(w, v[u][2 * d][2] * sc, v[u][2 * d][3] * sc, 1.0f, 1);
                    w = __builtin_amdgcn_cvt_scalef32_pk_fp4_f32(w, v[u][2 * d + 1][0] * sc, v[u][2 * d + 1][1] * sc, 1.0f, 2);
                    w = __builtin_amdgcn_cvt_scalef32_pk_fp4_f32(w, v[u][2 * d + 1][2] * sc, v[u][2 * d + 1][3] * sc, 1.0f, 3);
                    q4[d] = w; }
                *(u32x2*)(p.ws + WS_VTAB + ((size_t)l * NEXP + e) * (D / 2) + 8 * F.lane) = q4;
            } else {
                u32x2 q4;
#pragma unroll
                for (int d = 0; d < 2; ++d) { unsigned w = 0;
#pragma unroll
                    for (int b = 0; b < 4; ++b) { const int j = 2 * d + (b >> 1), e2 = 2 * (b & 1);
                        const int n0 = (int)fminf(fmaxf(__builtin_rintf(v[u][j][e2] * sc), -8.0f), 7.0f) + 8, n1 = (int)fminf(fmaxf(__builtin_rintf(v[u][j][e2 + 1] * sc), -8.0f), 7.0f) + 8;
                        w |= (unsigned)(n0 | (n1 << 4)) << (8 * b); }
                    q4[d] = w; }
                *(u32x2*)(p.ws + WS_UTAB + ((size_t)l * NEXP + e) * (D / 2) + 8 * F.lane) = q4;
            }
            if (F.lane == 0) ((float*)(p.ws + WS_TSCALE))[(l * 2 + tbl) * NEXP + e] = 1.0f / sc;
        }
    }
}

DI void phase_prep(const Params& p, const Frame& F) {
    unsigned char* ws = p.ws;
    {
        LAS float* wq = (LAS float*)F.lds;
        LAS float* skl = wq + 128 * 65;
        for (int it = F.bid; it < 2 * 16 * 16; it += F.nb) {
            const int cc = it & 15, hp = (it >> 4) & 15, l = it >> 8;
            const float* src = p.in[I_peer_wq] + (size_t)l * D * 2048 + hp * 128;
            const float* sks = p.in[I_peer_subkeys] + (size_t)(l * 16 + hp) * 128 * 128;
            __syncthreads();
            { float tw[16]; f32x4 ts[8];
#pragma unroll
              for (int it = 0; it < 16; ++it) { const int e = F.tid + it * NTHREADS, ci = e >> 7, d = e & 127; tw[it] = src[(size_t)(cc * 64 + ci) * 2048 + d]; }
#pragma unroll
              for (int it = 0; it < 8; ++it) { const int e = F.tid + it * NTHREADS, key = e >> 5, d4 = (e & 31) * 4; ts[it] = *(const f32x4*)(sks + key * 128 + d4); }
#pragma unroll
              for (int it = 0; it < 16; ++it) { const int e = F.tid + it * NTHREADS, ci = e >> 7, d = e & 127; wq[d * 65 + ci] = tw[it]; }
#pragma unroll
              for (int it = 0; it < 8; ++it) { const int e = F.tid + it * NTHREADS, key = e >> 5, d4 = (e & 31) * 4; *(LAS f32x4*)(skl + key * 132 + d4) = ts[it]; } }
            __syncthreads();
            const int ci = F.tid & 63, kg = F.tid >> 6;
            float acc[16];
#pragma unroll
            for (int k = 0; k < 16; ++k) acc[k] = 0.f;
#pragma unroll 2
            for (int d = 0; d < 128; d += 4) {
                const float w0 = wq[d * 65 + ci], w1 = wq[(d + 1) * 65 + ci], w2 = wq[(d + 2) * 65 + ci], w3 = wq[(d + 3) * 65 + ci];
#pragma unroll
                for (int k = 0; k < 16; ++k) { const f32x4 s = *(const LAS f32x4*)(skl + (16 * kg + k) * 132 + d); acc[k] += w0 * s.x + w1 * s.y + w2 * s.z + w3 * s.w; }
            }
            bf16_t* dst = (bf16_t*)(ws + WS_WFOLD) + ((size_t)l * 2048 + hp * 128 + 16 * kg) * D + cc * 64 + ci;
#pragma unroll
            for (int k = 0; k < 16; ++k) dst[(size_t)k * D] = (bf16_t)f2bf(acc[k]);
        }
        __syncthreads();
    }
    {
        LAS float* scr = (LAS float*)(F.lds + F.wave * 16384);
        constexpr int I_IN = (D / 64) * (INW / 32), I_BA = (512 / 64) * (D / 32), I_BS = (256 / 64) * (D / 32), I_O = (D / 64) * (D / 32);
        constexpr int PER_L = I_IN + I_BA + I_BS + I_O;
        for (int it = F.gw; it < 2 * PER_L; it += F.ngw) {
            const int l = it / PER_L; int r = it % PER_L;
            if (r < I_IN) { transpose_item(p.in[I_w_in] + (size_t)l * D * INW, D, INW, (bf16_t*)(ws + WS_WIN) + (size_t)l * INW * D, D, 0, 0, scr, r, F.lane); continue; } r -= I_IN;
            if (r < I_BA) { transpose_item(p.in[I_w_br_attn] + (size_t)l * 512 * D, 512, D, (bf16_t*)(ws + WS_WBR) + (size_t)l * D * D, D, 0, 0, scr, r, F.lane); continue; } r -= I_BA;
            if (r < I_BS) { transpose_item(p.in[I_w_br_sgu] + (size_t)l * 256 * D, 256, D, (bf16_t*)(ws + WS_WBR) + (size_t)l * D * D, D, 0, 768, scr, r, F.lane); continue; } r -= I_BS;
            transpose_item(p.in[I_w_out] + (size_t)l * D * D, D, D, (bf16_t*)(ws + WS_WOUT) + (size_t)l * D * D, D, 0, 0, scr, r, F.lane);
        }
    }
    for (int i = F.gtid; i < 2 * 256 * D; i += F.ngt) {
        const int n = i & 1023, rc = (i >> 10) & 255, l = i >> 18, g = rc >> 6;
        const float* pw = p.in[I_pool_w] + ((size_t)l * 256 + rc) * 64;
        const float* ps = p.in[I_pool_scale] + l * 256 + 64 * g;
        const float* wb = p.in[I_w_br_pool] + ((size_t)l * 256 + 64 * g) * D + n;
        float a = 0.f;
#pragma unroll 16
        for (int e = 0; e < 64; ++e) a += pw[e] * ps[e] * wb[(size_t)e * D];
        ((bf16_t*)(ws + WS_WBR))[(size_t)l * D * D + (size_t)n * D + 512 + rc] = (bf16_t)f2bf(a);
    }
    for (int i = F.gtid; i < 2 * 4 * 128 * 128; i += F.ngt) ((bf16_t*)(ws + WS_SGUW))[i] = (bf16_t)f2bf(p.in[I_sgu_w][i]);
    for (int i = F.gtid; i < 64 * 16; i += F.ngt) {
        const int pos = i >> 4, fi = i & 15;
        const float inv = powf(10000.0f, -(float)fi / 16.0f);
        const float ang = (float)pos * inv;
        ((f32x2*)(ws + WS_ROPE))[i] = (f32x2){cosf(ang), sinf(ang)};
    }
    convert_tables(p, F);
    {
        float* MOD = (float*)(ws + WS_MOD);
        LAS float* scd = (LAS float*)F.lds;
        LAS float* red = scd + 9 * D;
        __syncthreads();
        { float tc[18];
#pragma unroll
          for (int it = 0; it < 18; ++it) { const int e = F.tid + it * NTHREADS, r = e >> 10, k = e & 1023; tc[it] = (r < 8) ? p.in[I_c][r * D + k] : p.in[I_c_ctx][k]; }
#pragma unroll
          for (int it = 0; it < 18; ++it) scd[F.tid + it * NTHREADS] = silu_(tc[it]); }
        __syncthreads();
        for (int it = F.bid; it < 2 * 96; it += F.nb) {
            const int cgp = it % 96, l = it / 96, col = cgp * 64 + F.lane;
            float acc[9];
#pragma unroll
            for (int r = 0; r < 9; ++r) acc[r] = 0.f;
            const float* wp = p.in[I_w_mod] + ((size_t)l * D + F.wave * 128) * NMOD + col;
#pragma unroll 16
            for (int k = 0; k < 128; ++k) {
                const float w = wp[(size_t)k * NMOD];
#pragma unroll
                for (int r = 0; r < 9; ++r) acc[r] += scd[r * D + F.wave * 128 + k] * w;
            }
#pragma unroll
            for (int r = 0; r < 9; ++r) red[(F.wave * 9 + r) * 64 + F.lane] = acc[r];
            __syncthreads();
            for (int e = F.tid; e < 9 * 64; e += NTHREADS) {
                const int r = e >> 6, ln = e & 63; float s = p.in[I_b_mod][l * NMOD + cgp * 64 + ln];
#pragma unroll
                for (int w = 0; w < 8; ++w) s += red[(w * 9 + r) * 64 + ln];
                MOD[((size_t)l * 9 + r) * NMOD + cgp * 64 + ln] = s;
            }
            __syncthreads();
        }
    }
}

DI const float* mod_vec(const Params& p, int l, int row, int j) {
    const int r = row < TL ? row / SEQ : 8;
    return (const float*)(p.ws + WS_MOD) + ((size_t)l * 9 + r) * NMOD + j * D;
}
DI float* xrow_ptr(const Params& p, int row) { return row < TL ? p.out + (size_t)row * D : (float*)(p.ws + WS_XCTX) + (size_t)(row - TL) * D; }
DI const float* xin_ptr(const Params& p, int row) { return row < TL ? p.in[I_x] + (size_t)row * D : p.in[I_ctx] + (size_t)(row - TL) * D; }

DI void phase_norm(const Params& p, const Frame& F, int l, int which  , bool from_input, int nrows) {
    const float* g = (which == 0 ? p.in[I_g_mix] : p.in[I_g_ffn]) + l * D;
    const int lane = F.lane;
    f32x4 gg[4];
#pragma unroll
    for (int j = 0; j < 4; ++j) gg[j] = ((const f32x4*)g)[lane + 64 * j];
    for (int row0 = 2 * F.gw; row0 < nrows; row0 += 2 * F.ngw) {
        f32x4 v[2][4], s1[2][4], s2[2][4];
#pragma unroll
        for (int u = 0; u < 2; ++u) {
            const int row = row0 + u;
            const float* src = from_input ? xin_ptr(p, row) : xrow_ptr(p, row);
            const float* sh = mod_vec(p, l, row, which * 3 + 0); const float* sc = mod_vec(p, l, row, which * 3 + 1);
#pragma unroll
            for (int j = 0; j < 4; ++j) { v[u][j] = ((const f32x4*)src)[lane + 64 * j]; s1[u][j] = ((const f32x4*)sh)[lane + 64 * j]; s2[u][j] = ((const f32x4*)sc)[lane + 64 * j]; }
        }
#pragma unroll
        for (int u = 0; u < 2; ++u) {
            float ss = 0.f;
#pragma unroll
            for (int j = 0; j < 4; ++j) ss += v[u][j].x * v[u][j].x + v[u][j].y * v[u][j].y + v[u][j].z * v[u][j].z + v[u][j].w * v[u][j].w;
            const float rinv = rsqrtf(wave_sum(ss) * (1.0f / D) + EPS);
            bf16_t* dst = (bf16_t*)(p.ws + WS_H) + (size_t)(row0 + u) * D;
            float am = 0.f;
#pragma unroll
            for (int j = 0; j < 4; ++j) {
                const f32x4 o = v[u][j] * rinv * gg[j] * (s2[u][j] + 1.0f) + s1[u][j];
                u32x2 w; w.x = pk2(o.x, o.y); w.y = pk2(o.z, o.w);
                ((u32x2*)dst)[lane + 64 * j] = w;
                v[u][j] = o; am = fmaxf(am, fmaxf(fmaxf(fabsf(o.x), fabsf(o.y)), fmaxf(fabsf(o.z), fabsf(o.w))));
            }
            if (which) {
#pragma unroll
                for (int o2 = 1; o2 < 64; o2 <<= 1) am = fmaxf(am, __shfl_xor(am, o2));
                const float sc = (am > 0.f) ? 127.0f / am : 1.0f;
                unsigned* h8 = (unsigned*)(p.ws + WS_H8 + (size_t)(row0 + u) * D);
                const bool odd = (lane & 1) != 0;
#pragma unroll
                for (int j = 0; j < 4; ++j) {
                    const int b0 = (int)__builtin_rintf(v[u][j].x * sc), b1 = (int)__builtin_rintf(v[u][j].y * sc), b2 = (int)__builtin_rintf(v[u][j].z * sc), b3 = (int)__builtin_rintf(v[u][j].w * sc);
                    const int p0 = dpp_x1(b0), p1 = dpp_x1(b1), p2 = dpp_x1(b2), p3 = dpp_x1(b3);
                    const int w0 = odd ? p1 : b0, w1 = odd ? p3 : b2, w2 = odd ? b1 : p0, w3 = odd ? b3 : p2;
                    h8[lane + 64 * j] = (unsigned)(w0 & 0xff) | ((unsigned)(w1 & 0xff) << 8) | ((unsigned)(w2 & 0xff) << 16) | ((unsigned)w3 << 24);
                }
                if (lane == 0) ((float*)(p.ws + WS_HS))[row0 + u] = (am > 0.f) ? am * (1.0f / 127.0f) : 1.0f;
            }
        }
    }
}
DI void phase_final(const Params& p, const Frame& F) {
    f32x4 gg[4];
#pragma unroll
    for (int j = 0; j < 4; ++j) gg[j] = ((const f32x4*)p.in[I_g_final])[F.lane + 64 * j];
    for (int row0 = 2 * F.gw; row0 < TL; row0 += 2 * F.ngw) {
        f32x4 v[2][4];
#pragma unroll
        for (int u = 0; u < 2; ++u)
#pragma unroll
            for (int j = 0; j < 4; ++j) v[u][j] = ((const f32x4*)(p.out + (size_t)(row0 + u) * D))[F.lane + 64 * j];
#pragma unroll
        for (int u = 0; u < 2; ++u) {
            float ss = 0.f;
#pragma unroll
            for (int j = 0; j < 4; ++j) ss += v[u][j].x * v[u][j].x + v[u][j].y * v[u][j].y + v[u][j].z * v[u][j].z + v[u][j].w * v[u][j].w;
            const float rinv = rsqrtf(wave_sum(ss) * (1.0f / D) + EPS);
            f32x4* xr = (f32x4*)(p.out + (size_t)(row0 + u) * D);
#pragma unroll
            for (int j = 0; j < 4; ++j) xr[F.lane + 64 * j] = v[u][j] * rinv * gg[j];
        }
    }
}

DI float lane_xor32(float v, bool hi) { const auto r = __builtin_amdgcn_permlane32_swap(__builtin_bit_cast(unsigned, v), __builtin_bit_cast(unsigned, v), false, false);
    return __builtin_bit_cast(float, hi ? r[0] : r[1]); }
struct EpiG1 {
    DI bool keeps(const pg8::Unit&) const { return false; }
    static constexpr bool PERM = true;
    unsigned char* ws;
    DI void operator()(const f32x4 (&acc)[2][2][4][2], const pg8::Unit& u, int wr, int wc, int fr, int fq) const {
        bf16_t* P = (bf16_t*)(ws + WS_P);
        const int rbase = u.pm * 256 + wr * 64 + fr;
        const bool hi = fq >= 2;
#pragma unroll
        for (int ai = 0; ai < 2; ++ai) {
            f32x4 cs[4][4];
            const bool lat = u.pm < TL / 256;
            if (u.pn < 3 && lat) {
#pragma unroll
                for (int m = 0; m < 4; ++m) {
                    const int t = (rbase + 128 * ai + 16 * m) & (SEQ - 1), pos = (wc & 1) ? (t & 63) : (t >> 6);
                    const f32x4* tab = (const f32x4*)(ws + WS_ROPE) + (pos * 16 + 8 * (fq & 1)) / 2;
#pragma unroll
                    for (int j2 = 0; j2 < 4; ++j2) cs[m][j2] = tab[j2];
                }
            }
#pragma unroll
            for (int m = 0; m < 4; ++m) {
                const int row = rbase + 128 * ai + 16 * m;
#pragma unroll
                for (int bj = 0; bj < 2; ++bj) {
                    const int c0 = u.pn * 256 + 128 * bj + 32 * wc + 8 * fq;
                    float v[8];
#pragma unroll
                    for (int j = 0; j < 4; ++j) { v[j] = acc[ai][bj][m][0][j]; v[4 + j] = acc[ai][bj][m][1][j]; }
                    if (c0 < VOFF) {
                        const float sc = (c0 < KOFF) ? QSCALE : 1.0f;
                        u32x4 o;
#pragma unroll
                        for (int j2 = 0; j2 < 4; ++j2) {
                            const f32x4 c4 = cs[m][j2];
                            const float o0 = lane_xor32(v[2 * j2], hi), o1 = lane_xor32(v[2 * j2 + 1], hi);
                            float r0 = hi ? (v[2 * j2] * c4.x + o0 * c4.y) : (v[2 * j2] * c4.x - o0 * c4.y);
                            float r1 = hi ? (v[2 * j2 + 1] * c4.z + o1 * c4.w) : (v[2 * j2 + 1] * c4.z - o1 * c4.w);
                            if (!lat) { r0 = v[2 * j2]; r1 = v[2 * j2 + 1]; }
                            o[j2] = pk2(r0 * sc, r1 * sc);
                        }
                        *(u32x4*)(P + (size_t)row * PW + c0) = o;
                    } else if (c0 < POOLOFF) {
                        const int hk = wc >> 1, d0 = 32 * (wc & 1) + 8 * fq;
                        if (lat) { const int b = row / SEQ, t = row & (SEQ - 1);
                            bf16_t* vt = (bf16_t*)(ws + WS_VT) + ((size_t)(b * 2 + hk) * 64 + d0) * VTS + t;
#pragma unroll
                            for (int j = 0; j < 8; ++j) vt[(size_t)j * VTS] = (bf16_t)f2bf(v[j]);
                        } else { const int rc = row - TL, b = rc / NCTX, jc = rc & (NCTX - 1);
                            bf16_t* vt = (bf16_t*)(ws + WS_VTC) + ((size_t)(b * 2 + hk) * 64 + d0) * NCTX + jc;
#pragma unroll
                            for (int j = 0; j < 8; ++j) vt[(size_t)j * NCTX] = (bf16_t)f2bf(v[j]);
                        }
                    } else if (c0 < SUOFF) {
                        u32x4 o;
#pragma unroll
                        for (int j2 = 0; j2 < 4; ++j2) o[j2] = pk2(v[2 * j2], v[2 * j2 + 1]);
                        *(u32x4*)(P + (size_t)row * PW + c0) = o;
                    } else if (c0 < SVOFF) {
                        u32x4 o;
#pragma unroll
                        for (int j2 = 0; j2 < 4; ++j2) o[j2] = pk2(gelu_tanh(v[2 * j2]), gelu_tanh(v[2 * j2 + 1]));
                        *(u32x4*)(P + (size_t)row * PW + c0) = o;
                    } else {
                        const int c = c0 - SVOFF, chunk = row >> 7, q = row & 127;
                        bf16_t* vs = (bf16_t*)(ws + WS_VST) + ((size_t)chunk * 256 + c) * 128 + q;
#pragma unroll
                        for (int j = 0; j < 8; ++j) vs[j * 128] = (bf16_t)f2bf(gelu_tanh(v[j]));
                    }
                }
            }
            asm volatile("" ::: "memory");
        }
    }
};
struct SchedGrid {
    int nM, nN, G, c; const char* A; const char* B;
    int n_extra, ex_pm0, ex_pn;
    DI bool next(int i, pg8::Unit& u) const {
        const int L = i * G + c, n = nM * nN; if (L >= n + n_extra) return false;
        if (L < n) pg8::tile_of(L, nM, nN, u.pm, u.pn); else { u.pm = ex_pm0 + (L - n); u.pn = ex_pn; }
        u.sub = 0; u.nt = D / 64; u.mode = 0;
        u.a = A + (size_t)u.pm * 256 * D * 2; u.b = B + (size_t)u.pn * 256 * D * 2; return true;
    }
};

DI void phase_g1(const Params& p, const Frame& F, int l) {
    SchedGrid S{(l == 0 ? T : TL) / 256, PN / 256, F.nb, F.bid, (const char*)(p.ws + WS_H), (const char*)(p.ws + WS_WIN) + (size_t)l * INW * D * 2,
                (l == 0) ? 0 : TC / 256, TL / 256, 2};
    EpiG1 E{p.ws};
    pg8::gemm_phase(F.lds, F.tid, S, E);
}

DI bf16x8 pack8(const f32x16& x, int s) {
    u32x4 pk;
#pragma unroll
    for (int j = 0; j < 4; ++j) { f32x2 v = {x[8 * s + 2 * j], x[8 * s + 2 * j + 1]}; pk[j] = __builtin_bit_cast(unsigned, __builtin_convertvector(v, bf16x2_t)); }
    return __builtin_bit_cast(bf16x8, pk);
}

DI float lane_x32(float v, bool hi) { const auto r = __builtin_amdgcn_permlane32_swap(__builtin_bit_cast(unsigned, v), __builtin_bit_cast(unsigned, v), false, false);
    return __builtin_bit_cast(float, hi ? r[0] : r[1]); }
struct AttnFrags { bf16x8 kf[4]; s16x4 vf[2][4]; };
DI void attn_block(const bf16x8 (&qf)[4], const AttnFrags& f, int mask_mode, int kq_off, int lane, float& m, float& lpart, f32x16 (&o)[2]) {
    const int h = lane >> 5;
    f32x16 st;
#pragma unroll
    for (int r = 0; r < 16; ++r) st[r] = 0.f;
#pragma unroll
    for (int s = 0; s < 4; ++s) st = MFMA32(f.kf[s], qf[s], st);
    if (mask_mode) {
#pragma unroll
        for (int r = 0; r < 16; ++r) { const int dlt = kq_off + crow(r, h); if (dlt > 128 || dlt < -128) st[r] = -1e30f; }
    }
    float bm = st[0];
#pragma unroll
    for (int r = 1; r < 16; ++r) bm = fmaxf(bm, st[r]);
    bm = fmaxf(bm, lane_x32(bm, h != 0));
    const float mn = fmaxf(m, bm);
    if (__builtin_amdgcn_ballot_w64(mn > m) != 0ull) {
        const float alpha = __builtin_amdgcn_exp2f(m - mn);
        lpart *= alpha;
#pragma unroll
        for (int d = 0; d < 2; ++d)
#pragma unroll
            for (int r = 0; r < 16; ++r) o[d][r] *= alpha;
        m = mn;
    }
    float ps = 0.f;
#pragma unroll
    for (int r = 0; r < 16; ++r) { st[r] = __builtin_amdgcn_exp2f(st[r] - m); ps += st[r]; }
    lpart += ps;
    const bf16x8 pf0 = pack8(st, 0), pf1 = pack8(st, 1);
#pragma unroll
    for (int d = 0; d < 2; ++d) {
        const bf16x8 v0 = __builtin_shufflevector(f.vf[d][0], f.vf[d][1], 0, 1, 2, 3, 4, 5, 6, 7), v1 = __builtin_shufflevector(f.vf[d][2], f.vf[d][3], 0, 1, 2, 3, 4, 5, 6, 7);
        o[d] = MFMA32(v0, pf0, o[d]);
        o[d] = MFMA32(v1, pf1, o[d]);
    }
}

constexpr int AKP = 144, AVWP = 648, AVCP = 520;
constexpr int ALDS_KW = 0, ALDS_VW = ALDS_KW + 320 * AKP, ALDS_KC = ALDS_VW + 64 * AVWP, ALDS_VC = ALDS_KC + 256 * AKP, ALDS_END = ALDS_VC + 64 * AVCP;
static_assert(ALDS_END <= LDS_BAR_OFF && (ALDS_VW % 16) == 0 && (ALDS_KC % 16) == 0 && (ALDS_VC % 8) == 0, "attention LDS map");
DI void attn_lds_frags(AttnFrags& f, const LAS unsigned char* kp, const LAS unsigned char* vp, int vpitch32) {
#pragma unroll
    for (int s = 0; s < 4; ++s) f.kf[s] = *(const LAS bf16x8*)(kp + 32 * s);
#pragma unroll
    for (int d = 0; d < 2; ++d)
#pragma unroll
        for (int q = 0; q < 4; ++q) f.vf[d][q] = *(const LAS s16x4*)(vp + d * vpitch32 + 16 * q);
}
DI void attn_unit(const Params& p, const Frame& F, int l, int unit) {
    const int lane = F.lane, r = lane & 31, h = lane >> 5, tid = F.tid;
    const bf16_t* P = (const bf16_t*)(p.ws + WS_P);
    const bf16_t* VT = (const bf16_t*)(p.ws + WS_VT);
    const bf16_t* VTC = (const bf16_t*)(p.ws + WS_VTC);
    bf16_t* Y = (bf16_t*)(p.ws + WS_Y);
    const bool latent = unit < 1024;
    int b, hk, p0, q0row;
    if (latent) { const int pb = unit & 63; hk = (unit >> 6) & 1; b = unit >> 7; p0 = pb * 64; q0row = b * SEQ + p0; }
    else { const int u2 = unit - 1024, pb = u2 & 3; hk = (u2 >> 2) & 1; b = u2 >> 3; p0 = pb * 64; q0row = TL + b * NCTX + p0; }
    const int w0 = p0 - 128;
    u32x4 kw[5], vw[5], kc[4], vc[4];
    if (latent) {
#pragma unroll
        for (int it = 0; it < 5; ++it) {
            const int i = tid + it * NTHREADS, row = i >> 3, ck = i & 7, pos = min(max(w0 + row, 0), SEQ - 1);
            kw[it] = *(const u32x4*)(P + (size_t)(b * SEQ + pos) * PW + KOFF + hk * 64 + 8 * ck);
            const int d = i / 40, cv = i % 40, pv = min(max(w0 + 8 * cv, 0), SEQ - 8);
            vw[it] = *(const u32x4*)(VT + ((size_t)(b * 2 + hk) * 64 + d) * VTS + pv);
        }
    }
#pragma unroll
    for (int it = 0; it < 4; ++it) {
        const int i = tid + it * NTHREADS;
        kc[it] = *(const u32x4*)(P + (size_t)(TL + b * NCTX + (i >> 3)) * PW + KOFF + hk * 64 + 8 * (i & 7));
        vc[it] = *(const u32x4*)(VTC + ((size_t)(b * 2 + hk) * 64 + (i >> 5)) * NCTX + 8 * (i & 31));
    }
    __syncthreads();
    if (latent) {
#pragma unroll
        for (int it = 0; it < 5; ++it) {
            const int i = tid + it * NTHREADS, row = i >> 3, ck = i & 7;
            *(LAS u32x4*)(F.lds + ALDS_KW + row * AKP + 16 * ck) = kw[it];
            const int d = i / 40, cv = i % 40;
            LAS u32x2* dst = (LAS u32x2*)(F.lds + ALDS_VW + d * AVWP + 16 * cv); dst[0] = (u32x2){vw[it].x, vw[it].y}; dst[1] = (u32x2){vw[it].z, vw[it].w};
        }
    }
#pragma unroll
    for (int it = 0; it < 4; ++it) {
        const int i = tid + it * NTHREADS;
        *(LAS u32x4*)(F.lds + ALDS_KC + (i >> 3) * AKP + 16 * (i & 7)) = kc[it];
        LAS u32x2* dst = (LAS u32x2*)(F.lds + ALDS_VC + (i >> 5) * AVCP + 16 * (i & 31)); dst[0] = (u32x2){vc[it].x, vc[it].y}; dst[1] = (u32x2){vc[it].z, vc[it].w};
    }
    const int head = 4 * hk + (F.wave & 3), ph = F.wave >> 2, pw = p0 + 32 * ph, qrow = q0row + 32 * ph;
    bf16x8 qf[4];
#pragma unroll
    for (int s = 0; s < 4; ++s) qf[s] = *(const bf16x8*)(P + (size_t)(qrow + r) * PW + head * 64 + 16 * s + 8 * h);
    float m = p.in[I_attn_sink][l * 8 + head] * LOG2E, lpart = (h == 0) ? 1.0f : 0.0f;
    f32x16 o[2];
#pragma unroll
    for (int d = 0; d < 2; ++d)
#pragma unroll
        for (int i = 0; i < 16; ++i) o[d][i] = 0.f;
    __syncthreads();
    if (latent) {
#pragma unroll 1
        for (int j = 0; j < 9; ++j) {
            const int kb = pw - 128 + 32 * j;
            if (kb < 0 || kb >= SEQ) continue;
            const int krow = kb - w0;
            AttnFrags f;
            attn_lds_frags(f, F.lds + ALDS_KW + (krow + r) * AKP + 16 * h, F.lds + ALDS_VW + r * AVWP + 2 * krow + 8 * h, 32 * AVWP);
            attn_block(qf, f, (j == 0 || j == 8) ? 1 : 0, kb - (pw + r), lane, m, lpart, o);
        }
    }
#pragma unroll 1
    for (int j = 0; j < 8; ++j) {
        AttnFrags f;
        attn_lds_frags(f, F.lds + ALDS_KC + (32 * j + r) * AKP + 16 * h, F.lds + ALDS_VC + r * AVCP + 64 * j + 8 * h, 32 * AVCP);
        attn_block(qf, f, 0, 0, lane, m, lpart, o);
    }
    const float inv = 1.0f / (lpart + lane_x32(lpart, h != 0));
    bf16_t* yrow = Y + (size_t)(qrow + r) * D + head * 64;
#pragma unroll
    for (int d = 0; d < 2; ++d)
#pragma unroll
        for (int g = 0; g < 4; ++g) {
            u32x2 w; w.x = pk2(o[d][4 * g] * inv, o[d][4 * g + 1] * inv); w.y = pk2(o[d][4 * g + 2] * inv, o[d][4 * g + 3] * inv);
            *(u32x2*)(yrow + 32 * d + 8 * g + 4 * h) = w;
        }
}

DI void sgu_unit(const Params& p, const Frame& F, int l, int chunk) {
    constexpr int VS = 136;
    LAS float* part = (LAS float*)F.lds;
    LAS float* rq = part + 512;
    LAS bf16_t* vnT = (LAS bf16_t*)(F.lds + 4096);
    const bf16_t* VsT = (const bf16_t*)(p.ws + WS_VST) + (size_t)chunk * 256 * 128;
    const bf16_t* P = (const bf16_t*)(p.ws + WS_P);
    bf16_t* Y = (bf16_t*)(p.ws + WS_Y);
    __syncthreads();
    { const int q = F.tid & 127, part_i = F.tid >> 7; float ss = 0.f;
#pragma unroll 16
        for (int c = part_i * 64; c < part_i * 64 + 64; ++c) { const float v = bf2f(VsT[c * 128 + q]); ss += v * v; }
        part[part_i * 128 + q] = ss; }
    __syncthreads();
    if (F.tid < 128) rq[F.tid] = rsqrtf((part[F.tid] + part[128 + F.tid] + part[256 + F.tid] + part[384 + F.tid]) * (1.0f / 256.0f) + EPS);
    __syncthreads();
#pragma unroll
    for (int it = 0; it < 8; ++it) {
        const int i = F.tid + it * NTHREADS;
        const int c = i >> 4, q8 = (i & 15) * 8;
        const u32x4 v = *(const u32x4*)(VsT + c * 128 + q8);
        u32x4 o;
#pragma unroll
        for (int j = 0; j < 4; ++j) o[j] = pk2(bflo(v[j]) * rq[q8 + 2 * j], bfhi(v[j]) * rq[q8 + 2 * j + 1]);
        *(LAS u32x4*)(vnT + c * VS + q8) = o;
    }
    __syncthreads();
    const int lane = F.lane, r = lane & 31, h = lane >> 5, g = F.wave >> 1, ph = F.wave & 1;
    const bf16_t* Wg = (const bf16_t*)(p.ws + WS_SGUW) + ((size_t)l * 4 + g) * 128 * 128;
#pragma unroll 1
    for (int pb = 0; pb < 2; ++pb) {
        const int p0 = 64 * ph + 32 * pb;
        const int row = chunk * 128 + p0 + r;
        bf16x8 wf[8];
#pragma unroll
        for (int s = 0; s < 8; ++s) wf[s] = *(const bf16x8*)(Wg + (size_t)(p0 + r) * 128 + 16 * s + 8 * h);
        u32x2 uu[2][4];
#pragma unroll
        for (int cb = 0; cb < 2; ++cb)
#pragma unroll
            for (int q4 = 0; q4 < 4; ++q4) uu[cb][q4] = *(const u32x2*)(P + (size_t)row * PW + SUOFF + 64 * g + 32 * cb + 8 * q4 + 4 * h);
        const float bias = p.in[I_sgu_b][(l * 4 + g) * 128 + p0 + r];
#pragma unroll
        for (int cb = 0; cb < 2; ++cb) {
            const int c0 = 64 * g + 32 * cb;
            f32x16 acc;
#pragma unroll
            for (int i = 0; i < 16; ++i) acc[i] = 0.f;
#pragma unroll
            for (int s = 0; s < 8; ++s) {
                const bf16x8 a = *(const LAS bf16x8*)(vnT + (c0 + r) * VS + 16 * s + 8 * h);
                acc = MFMA32(a, wf[s], acc);
            }
#pragma unroll
            for (int q4 = 0; q4 < 4; ++q4) {
                const int cc = c0 + 8 * q4 + 4 * h;
                const u32x2 u = uu[cb][q4];
                u32x2 w;
                w.x = pk2(bflo(u.x) * (acc[4 * q4] + bias), bfhi(u.x) * (acc[4 * q4 + 1] + bias));
                w.y = pk2(bflo(u.y) * (acc[4 * q4 + 2] + bias), bfhi(u.y) * (acc[4 * q4 + 3] + bias));
                *(u32x2*)(Y + (size_t)row * D + 768 + cc) = w;
            }
        }
    }
}

DI void phase_mix(const Params& p, const Frame& F, int l, int ctr_slot = 0) {
    (void)ctr_slot;
    const int nrows = (l == 0) ? T : TL;
    const bf16_t* P = (const bf16_t*)(p.ws + WS_P);
    bf16_t* Y = (bf16_t*)(p.ws + WS_Y);
    for (int i0 = F.bid * NTHREADS; i0 < 4 * nrows * 8; i0 += F.nb * NTHREADS) {
        const int i = i0 + F.tid, g = i / (nrows * 8), rem = i - g * (nrows * 8), row = rem >> 3, ck = g * 8 + (rem & 7);
        int base, t, len;
        if (row < TL) { base = row & ~(SEQ - 1); t = row & (SEQ - 1); len = SEQ; } else { const int rc = row - TL; base = TL + (rc & ~(NCTX - 1)); t = rc & (NCTX - 1); len = NCTX; }
        float s[8];
#pragma unroll
        for (int j = 0; j < 8; ++j) s[j] = 0.f;
        const bf16_t* zc = P + POOLOFF + ck * 8;
#define POOL_WIN(HALF) do { _Pragma("unroll") for (int dt = -(HALF); dt < (HALF); ++dt) { const int tt = t + dt; const bool ok = tt >= 0 && tt < len; \
            const u32x4 v = *(const u32x4*)(zc + (size_t)(base + (ok ? tt : t)) * PW); const float w = ok ? 1.f : 0.f; \
            _Pragma("unroll") for (int j = 0; j < 4; ++j) { s[2 * j] += w * bflo(v[j]); s[2 * j + 1] += w * bfhi(v[j]); } } } while (0)
        int half;
        if (g == 0) { POOL_WIN(1); half = 1; } else if (g == 1) { POOL_WIN(2); half = 2; } else if (g == 2) { POOL_WIN(4); half = 4; } else { POOL_WIN(8); half = 8; }
#undef POOL_WIN
        const int lo = max(t - half, 0), hi = min(t + half, len);
        const float inv = 1.0f / (float)(hi - lo);
        const u32x4 z = *(const u32x4*)(zc + (size_t)row * PW);
        u32x4 o;
#pragma unroll
        for (int j = 0; j < 4; ++j) o[j] = pk2(s[2 * j] * inv - bflo(z[j]), s[2 * j + 1] * inv - bfhi(z[j]));
        *(u32x4*)(Y + (size_t)row * D + 512 + ck * 8) = o;
    }
    const int nchunk = (l == 0) ? T / 128 : TL / 128;
    for (int ch = F.bid; ch < nchunk; ch += F.nb) sgu_unit(p, F, l, ch);
    const int nunit = (l == 0) ? 1024 + 64 : 1024;
    for (int u = F.nb - 1 - F.bid; u < nunit; u += F.nb) attn_unit(p, F, l, u);
}

struct EpiGate {
    static constexpr bool PERM = true;
    DI bool keeps(const pg8::Unit&) const { return false; }
    unsigned char* G8;
    DI void operator()(const f32x4 (&acc)[2][2][4][2], const pg8::Unit& u, int wr, int wc, int fr, int fq) const {
#pragma unroll
        for (int ai = 0; ai < 2; ++ai)
#pragma unroll
            for (int m = 0; m < 4; ++m) {
                unsigned char* rowp = G8 + (size_t)(u.pm * 256 + 128 * ai + 64 * wr + 16 * m + fr) * 3072 + u.pn * 256 + 32 * wc + 8 * fq;
#pragma unroll
                for (int bj = 0; bj < 2; ++bj) {
                    u32x2 w;
#pragma unroll
                    for (int n = 0; n < 2; ++n) { unsigned q = 0;
                        q = __builtin_amdgcn_cvt_pk_u8_f32(fmaxf(__builtin_rintf(255.0f * sigmoidf_(acc[ai][bj][m][n][0])), 1.0f), 0, q);
                        q = __builtin_amdgcn_cvt_pk_u8_f32(fmaxf(__builtin_rintf(255.0f * sigmoidf_(acc[ai][bj][m][n][1])), 1.0f), 1, q);
                        q = __builtin_amdgcn_cvt_pk_u8_f32(fmaxf(__builtin_rintf(255.0f * sigmoidf_(acc[ai][bj][m][n][2])), 1.0f), 2, q);
                        q = __builtin_amdgcn_cvt_pk_u8_f32(fmaxf(__builtin_rintf(255.0f * sigmoidf_(acc[ai][bj][m][n][3])), 1.0f), 3, q);
                        w[n] = q; }
                    *(u32x2*)(rowp + 128 * bj) = w;
                }
            }
    }
};
DI void phase_g2a(const Params& p, const Frame& F, int l) {
    SchedGrid S{(l == 0 ? T : TL) / 256, 3072 / 256, F.nb, F.bid, (const char*)(p.ws + WS_H), (const char*)(p.ws + WS_WIN) + ((size_t)l * INW + GATEOFF) * D * 2, 0, 0, 0};
    EpiGate E{p.ws + WS_G8};
    pg8::gemm_phase(F.lds, F.tid, S, E);
}
struct SchedG2 {
    int G, c; const char *Y, *Wb; int npair;
    DI void fill(pg8::Unit& u, int br) const {
        const int koff = (br == 0) ? 0 : (br == 1 ? 512 : 768); u.nt = (br == 0) ? 8 : 4; u.sub = br;
        u.a = Y + ((size_t)u.pm * 256 * D + koff) * 2; u.b = Wb + ((size_t)u.pn * 256 * D + koff) * 2;
    }
    DI bool next(int i, pg8::Unit& u) const {
        constexpr int NLAT = (TL / 256) * 4;
        const int nl = (NLAT - c + G - 1) / G;
        if (i < 3 * nl) { const int tile = (i / 3) * G + c; pg8::tile_of(tile, TL / 256, 4, u.pm, u.pn); u.mode = 0; fill(u, i % 3); return true; }
        const int j = (i - 3 * nl) * G + c;
        if (j >= npair) return false;
        const int ctile = j / 3, br = j % 3;
        u.pm = TL / 256 + (ctile >> 2); u.pn = ctile & 3; u.mode = 1 + br; fill(u, br); return true;
    }
};
struct EpiG2 {
    static constexpr bool PERM = true;
    const unsigned char* G8; bf16_t* M; bf16_t* MP;
    DI bool keeps(const pg8::Unit& u) const { return u.mode == 0 && u.sub < 2; }
    DI void operator()(f32x4 (&acc)[2][2][4][2], const pg8::Unit& u, int wr, int wc, int fr, int fq) const {
        const bool mid = u.mode == 0 && u.sub < 2;
        bf16_t* Mo = (u.mode == 0) ? M + (size_t)u.pm * 256 * D : MP + ((size_t)(u.mode - 1) * TC + (size_t)(u.pm - TL / 256) * 256) * D;
        const unsigned char* gb = G8 + (size_t)u.pm * 256 * 3072 + u.sub * 1024 + u.pn * 256;
#pragma unroll
        for (int ai = 0; ai < 2; ++ai) {
            u32x2 g0[4][2], g1[4][2];
#pragma unroll
            for (int m = 0; m < 4; ++m)
#pragma unroll
                for (int bj = 0; bj < 2; ++bj) {
                    const int rl = 128 * ai + 64 * wr + 16 * m + fr, cl = 128 * bj + 32 * wc + 8 * fq;
                    g0[m][bj] = *(const u32x2*)(gb + (size_t)rl * 3072 + cl);
                    if (mid) g1[m][bj] = *(const u32x2*)(gb + (size_t)rl * 3072 + 1024 + cl);
                }
#pragma unroll
            for (int m = 0; m < 4; ++m)
#pragma unroll
                for (int bj = 0; bj < 2; ++bj) {
                    const int rl = 128 * ai + 64 * wr + 16 * m + fr, cl = 128 * bj + 32 * wc + 8 * fq;
                    if (mid) {
#pragma unroll
                        for (int n = 0; n < 2; ++n)
#pragma unroll
                            for (int e = 0; e < 4; ++e) {
                                const float a = (float)((g0[m][bj][n] >> (8 * e)) & 0xffu), b = (float)((g1[m][bj][n] >> (8 * e)) & 0xffu);
                                acc[ai][bj][m][n][e] *= a * __builtin_amdgcn_rcpf(b);
                            }
                    } else {
                        u32x4 w;
#pragma unroll
                        for (int j2 = 0; j2 < 4; ++j2) { const int n = j2 >> 1, e = 2 * (j2 & 1);
                            const float a0 = (float)((g0[m][bj][n] >> (8 * e)) & 0xffu) * (1.0f / 255.0f), a1 = (float)((g0[m][bj][n] >> (8 * e + 8)) & 0xffu) * (1.0f / 255.0f);
                            w[j2] = pk2(acc[ai][bj][m][n][e] * a0, acc[ai][bj][m][n][e + 1] * a1); }
                        *(u32x4*)(Mo + (size_t)rl * D + u.pn * 256 + cl) = w;
                    }
                }
            asm volatile("" ::: "memory");
        }
    }
};
DI void phase_g2(const Params& p, const Frame& F, int l) {
    SchedG2 S{F.nb, F.bid, (const char*)(p.ws + WS_Y), (const char*)(p.ws + WS_WBR) + (size_t)l * D * D * 2, (l == 0) ? (TC / 256) * 4 * 3 : 0};
    EpiG2 E{p.ws + WS_G8, (bf16_t*)(p.ws + WS_MERGED), (bf16_t*)(p.ws + WS_MP)};
    pg8::gemm_phase(F.lds, F.tid, S, E);
}
DI void phase_g2sum(const Params& p, const Frame& F) {
    const u32x4* mp = (const u32x4*)(p.ws + WS_MP);
    u32x4* mo = (u32x4*)((bf16_t*)(p.ws + WS_MERGED) + (size_t)TL * D);
    constexpr int NV = TC * D / 8;
    for (int i = F.gtid; i < NV; i += F.ngt) {
        const u32x4 a = mp[i], b = mp[NV + i], c = mp[2 * NV + i];
        u32x4 o;
#pragma unroll
        for (int j = 0; j < 4; ++j) o[j] = pk2(bflo(a[j]) + bflo(b[j]) + bflo(c[j]), bfhi(a[j]) + bfhi(b[j]) + bfhi(c[j]));
        mo[i] = o;
    }
}

struct EpiG3 {
    DI bool keeps(const pg8::Unit&) const { return false; }
    static constexpr bool PERM = false;
    const float* xsrc; float* xdst; const float* csrc; float* cdst; const float* mod;
    DI void operator()(const f32x4 (&acc)[2][2][4][2], const pg8::Unit& u, int wr, int wc, int fr, int fq) const {
        const int col0 = u.pn * 256 + wc * 32 + 4 * fq;
        const bool lat = u.pm < TL / 256;
        const float* gt = mod + (size_t)(lat ? (u.pm >> 4) : 8) * NMOD + 2 * D;
        const float* xs = lat ? xsrc + (size_t)u.pm * 256 * D : csrc + (size_t)(u.pm - TL / 256) * 256 * D;
        float* xd = lat ? xdst + (size_t)u.pm * 256 * D : cdst + (size_t)(u.pm - TL / 256) * 256 * D;
        f32x4 gv[2][2];
#pragma unroll
        for (int bj = 0; bj < 2; ++bj)
#pragma unroll
            for (int n = 0; n < 2; ++n) gv[bj][n] = *(const f32x4*)(gt + col0 + 128 * bj + 16 * n);
#pragma unroll
        for (int ai = 0; ai < 2; ++ai) {
            f32x4 xv[4][2][2];
#pragma unroll
            for (int m = 0; m < 4; ++m)
#pragma unroll
                for (int bj = 0; bj < 2; ++bj)
#pragma unroll
                    for (int n = 0; n < 2; ++n) xv[m][bj][n] = *(const f32x4*)(xs + (size_t)(wr * 64 + fr + 128 * ai + 16 * m) * D + col0 + 128 * bj + 16 * n);
#pragma unroll
            for (int m = 0; m < 4; ++m)
#pragma unroll
                for (int bj = 0; bj < 2; ++bj)
#pragma unroll
                    for (int n = 0; n < 2; ++n)
                        *(f32x4*)(xd + (size_t)(wr * 64 + fr + 128 * ai + 16 * m) * D + col0 + 128 * bj + 16 * n) = xv[m][bj][n] + gv[bj][n] * acc[ai][bj][m][n];
            asm volatile("" ::: "memory");
        }
    }
};
DI void phase_g3(const Params& p, const Frame& F, int l) {
    SchedGrid S{(l == 0 ? T : TL) / 256, D / 256, F.nb, F.bid, (const char*)(p.ws + WS_MERGED), (const char*)(p.ws + WS_WOUT) + (size_t)l * D * D * 2, 0, 0, 0};
    float* xc = (float*)(p.ws + WS_XCTX);
    EpiG3 E{(l == 0) ? p.in[I_x] : p.out, p.out, (l == 0) ? p.in[I_ctx] : xc, xc, (const float*)(p.ws + WS_MOD) + (size_t)l * 9 * NMOD};
    pg8::gemm_phase(F.lds, F.tid, S, E);
}

struct EpiG45 {
    DI bool keeps(const pg8::Unit&) const { return false; }
    static constexpr bool PERM = true;
    unsigned short* ST;
    DI void operator()(const f32x4 (&acc)[2][2][4][2], const pg8::Unit& u, int wr, int wc, int fr, int fq) const {
        const int col0 = u.pn * 256 + wc * 32 + 8 * fq;
#pragma unroll
        for (int ai = 0; ai < 2; ++ai)
#pragma unroll
            for (int m = 0; m < 4; ++m) {
                unsigned short* rowp = ST + (size_t)(u.pm * 256 + wr * 64 + fr + 128 * ai + 16 * m) * T + col0;
#pragma unroll
                for (int bj = 0; bj < 2; ++bj) {
                    u32x4 w;
                    w.x = pkh2(acc[ai][bj][m][0][0], acc[ai][bj][m][0][1]); w.y = pkh2(acc[ai][bj][m][0][2], acc[ai][bj][m][0][3]);
                    w.z = pkh2(acc[ai][bj][m][1][0], acc[ai][bj][m][1][1]); w.w = pkh2(acc[ai][bj][m][1][2], acc[ai][bj][m][1][3]);
                    *(u32x4*)(rowp + 128 * bj) = w;
                }
            }
    }
};
DI void phase_g45(const Params& p, const Frame& F, int l) {
    SchedGrid S{2048 / 256, (l == 0 ? T : TL) / 256, F.nb, F.bid, (const char*)(p.ws + WS_WFOLD) + (size_t)l * 2048 * D * 2, (const char*)(p.ws + WS_H), 0, 0, 0};
    EpiG45 E{(unsigned short*)(p.ws + WS_ST)};
    pg8::gemm_phase(F.lds, F.tid, S, E);
}

DI unsigned fkey(float f) { const unsigned u = __builtin_bit_cast(unsigned, f); return (u & 0x80000000u) ? ~u : (u | 0x80000000u); }
DI float fkey_inv(unsigned k) { const unsigned u = (k & 0x80000000u) ? (k & 0x7fffffffu) : ~k; return __builtin_bit_cast(float, u); }
#define INSERT16(L, x) do { unsigned x_ = (x); _Pragma("unroll") for (int k_ = 0; k_ < 16; ++k_) { const unsigned hi_ = max(L[k_], x_); x_ = min(L[k_], x_); L[k_] = hi_; } } while (0)
#define CEX(a, b) do { const unsigned hi_ = max(a, b), lo_ = min(a, b); a = hi_; b = lo_; } while (0)
DI void sort16_desc(unsigned (&v)[16]) {
    CEX(v[0], v[1]); CEX(v[2], v[3]); CEX(v[0], v[2]); CEX(v[1], v[3]); CEX(v[1], v[2]); CEX(v[4], v[5]); CEX(v[6], v[7]); CEX(v[4], v[6]); CEX(v[5], v[7]); CEX(v[5], v[6]); CEX(v[0], v[4]); CEX(v[2], v[6]); CEX(v[2], v[4]); CEX(v[1], v[5]); CEX(v[3], v[7]); CEX(v[3], v[5]); CEX(v[1], v[2]); CEX(v[3], v[4]); CEX(v[5], v[6]); CEX(v[8], v[9]); CEX(v[10], v[11]); CEX(v[8], v[10]); CEX(v[9], v[11]); CEX(v[9], v[10]); CEX(v[12], v[13]); CEX(v[14], v[15]); CEX(v[12], v[14]); CEX(v[13], v[15]); CEX(v[13], v[14]); CEX(v[8], v[12]); CEX(v[10], v[14]); CEX(v[10], v[12]); CEX(v[9], v[13]); CEX(v[11], v[15]); CEX(v[11], v[13]); CEX(v[9], v[10]); CEX(v[11], v[12]); CEX(v[13], v[14]); CEX(v[0], v[8]); CEX(v[4], v[12]); CEX(v[4], v[8]); CEX(v[2], v[10]); CEX(v[6], v[14]); CEX(v[6], v[10]); CEX(v[2], v[4]); CEX(v[6], v[8]); CEX(v[10], v[12]); CEX(v[1], v[9]); CEX(v[5], v[13]); CEX(v[5], v[9]); CEX(v[3], v[11]); CEX(v[7], v[15]); CEX(v[7], v[11]); CEX(v[3], v[5]); CEX(v[7], v[9]); CEX(v[11], v[13]); CEX(v[1], v[2]); CEX(v[3], v[4]); CEX(v[5], v[6]); CEX(v[7], v[8]); CEX(v[9], v[10]); CEX(v[11], v[12]); CEX(v[13], v[14]);
}
DI void merge16_desc(unsigned (&L)[16], const unsigned (&N)[16]) {
#pragma unroll
    for (int i = 0; i < 16; ++i) L[i] = max(L[i], N[15 - i]);
#pragma unroll
    for (int j = 8; j > 0; j >>= 1)
#pragma unroll
        for (int i = 0; i < 16; ++i) { const int q = i ^ j; if (q > i) CEX(L[i], L[q]); }
}
DI void phase_sel(const Params& p, const Frame& F, int l) {
    const _Float16* ST = (const _Float16*)(p.ws + WS_ST);
    unsigned short* IDX = (unsigned short*)(p.ws + WS_IDX);
    float* GW = (float*)(p.ws + WS_GW);
    float* SU = (float*)(p.ws + WS_SU);
    const float* TSC = (const float*)(p.ws + WS_TSCALE) + (size_t)l * 2 * NEXP;
    LAS unsigned char* ib = (LAS unsigned char*)F.lds;
    const int ntok = (l == 0) ? T : TL;
    for (int i0 = F.bid * NTHREADS; i0 < ntok * 8; i0 += F.nb * NTHREADS) {
        const int i = i0 + F.tid;
        const int tok = i % ntok, head = i / ntok;
        unsigned la[16], lb[16];
#pragma unroll
        for (int k = 0; k < 16; ++k) { la[k] = 0u; lb[k] = 0u; }
        const _Float16* s0 = ST + (size_t)(head * 256) * T + tok;
#define SEL_LOAD(B_, k0_) do { _Pragma("unroll") for (int j = 0; j < 32; ++j) B_[j] = sp[(size_t)((k0_) + j) * T]; } while (0)
#define SEL_KEY(x_, low_) ((((unsigned)(x_) ^ ((unsigned)(((int)((unsigned)(x_) << 16)) >> 31) | 0x8000u)) << 16) | (unsigned)(low_))
#define SEL_GRP(L_, B_, o_, k0_) do { unsigned nk_[16]; \
        _Pragma("unroll") for (int j = 0; j < 16; ++j) nk_[j] = SEL_KEY(B_[(o_) + j], 127 - ((k0_) + j)); \
        sort16_desc(nk_); merge16_desc(L_, nk_); } while (0)
#define SEL_HALF(L_, base_) do { const unsigned short* sp = (const unsigned short*)s0 + (size_t)(base_) * T; unsigned short bufa[32], bufb[32]; \
        SEL_LOAD(bufa, 0); \
        _Pragma("unroll 1") for (int k0 = 0; k0 < 128; k0 += 64) { \
            SEL_LOAD(bufb, k0 + 32); SEL_GRP(L_, bufa, 0, k0); SEL_GRP(L_, bufa, 16, k0 + 16); \
            SEL_LOAD(bufa, (k0 + 64) & 127); SEL_GRP(L_, bufb, 0, k0 + 32); SEL_GRP(L_, bufb, 16, k0 + 48); } } while (0)
        SEL_HALF(la, 0);
        SEL_HALF(lb, 128);
#undef SEL_LOAD
#undef SEL_KEY
#undef SEL_GRP
#undef SEL_HALF
        float va[16], vb[16];
#define SEL_VAL(key_) ((float)__builtin_bit_cast(_Float16, (unsigned short)(((key_) >> 16) ^ 0xffffu ^ ((unsigned)((int)(key_) >> 31) & 0x7fffu))))
#pragma unroll
        for (int k = 0; k < 16; ++k) {
            va[k] = SEL_VAL(la[k]); vb[k] = SEL_VAL(lb[k]);
            ib[k * NTHREADS + F.tid] = (unsigned char)(127u - (la[k] & 127u));
            ib[(16 + k) * NTHREADS + F.tid] = (unsigned char)(127u - (lb[k] & 127u));
        }
#undef SEL_VAL
        unsigned lc[16];
        { lc[0] = (fkey(va[0] + vb[0]) & ~255u) | 255u; lc[1] = (fkey(va[0] + vb[1]) & ~255u) | 254u; lc[2] = (fkey(va[0] + vb[2]) & ~255u) | 253u; lc[3] = (fkey(va[0] + vb[3]) & ~255u) | 252u; lc[4] = (fkey(va[0] + vb[4]) & ~255u) | 251u; lc[5] = (fkey(va[0] + vb[5]) & ~255u) | 250u; lc[6] = (fkey(va[0] + vb[6]) & ~255u) | 249u; lc[7] = (fkey(va[0] + vb[7]) & ~255u) | 248u; lc[8] = (fkey(va[0] + vb[8]) & ~255u) | 247u; lc[9] = (fkey(va[0] + vb[9]) & ~255u) | 246u; lc[10] = (fkey(va[0] + vb[10]) & ~255u) | 245u; lc[11] = (fkey(va[0] + vb[11]) & ~255u) | 244u; lc[12] = (fkey(va[0] + vb[12]) & ~255u) | 243u; lc[13] = (fkey(va[0] + vb[13]) & ~255u) | 242u; lc[14] = (fkey(va[0] + vb[14]) & ~255u) | 241u; lc[15] = (fkey(va[0] + vb[15]) & ~255u) | 240u; }
        sort16_desc(lc);
        { unsigned cg1[16]; cg1[0] = (fkey(va[1] + vb[0]) & ~255u) | 239u; cg1[1] = (fkey(va[1] + vb[1]) & ~255u) | 238u; cg1[2] = (fkey(va[1] + vb[2]) & ~255u) | 237u; cg1[3] = (fkey(va[1] + vb[3]) & ~255u) | 236u; cg1[4] = (fkey(va[1] + vb[4]) & ~255u) | 235u; cg1[5] = (fkey(va[1] + vb[5]) & ~255u) | 234u; cg1[6] = (fkey(va[1] + vb[6]) & ~255u) | 233u; cg1[7] = (fkey(va[1] + vb[7]) & ~255u) | 232u; cg1[8] = (fkey(va[2] + vb[0]) & ~255u) | 223u; cg1[9] = (fkey(va[2] + vb[1]) & ~255u) | 222u; cg1[10] = (fkey(va[2] + vb[2]) & ~255u) | 221u; cg1[11] = (fkey(va[2] + vb[3]) & ~255u) | 220u; cg1[12] = (fkey(va[2] + vb[4]) & ~255u) | 219u; cg1[13] = (fkey(va[3] + vb[0]) & ~255u) | 207u; cg1[14] = (fkey(va[3] + vb[1]) & ~255u) | 206u; cg1[15] = (fkey(va[3] + vb[2]) & ~255u) | 205u; sort16_desc(cg1); merge16_desc(lc, cg1); }
        { unsigned cg2[16]; cg2[0] = (fkey(va[3] + vb[3]) & ~255u) | 204u; cg2[1] = (fkey(va[4] + vb[0]) & ~255u) | 191u; cg2[2] = (fkey(va[4] + vb[1]) & ~255u) | 190u; cg2[3] = (fkey(va[4] + vb[2]) & ~255u) | 189u; cg2[4] = (fkey(va[5] + vb[0]) & ~255u) | 175u; cg2[5] = (fkey(va[5] + vb[1]) & ~255u) | 174u; cg2[6] = (fkey(va[6] + vb[0]) & ~255u) | 159u; cg2[7] = (fkey(va[6] + vb[1]) & ~255u) | 158u; cg2[8] = (fkey(va[7] + vb[0]) & ~255u) | 143u; cg2[9] = (fkey(va[7] + vb[1]) & ~255u) | 142u; cg2[10] = (fkey(va[8] + vb[0]) & ~255u) | 127u; cg2[11] = (fkey(va[9] + vb[0]) & ~255u) | 111u; cg2[12] = (fkey(va[10] + vb[0]) & ~255u) | 95u; cg2[13] = (fkey(va[11] + vb[0]) & ~255u) | 79u; cg2[14] = (fkey(va[12] + vb[0]) & ~255u) | 63u; cg2[15] = (fkey(va[13] + vb[0]) & ~255u) | 47u; sort16_desc(cg2); merge16_desc(lc, cg2); }
        { const unsigned key = (fkey(va[14] + vb[0]) & ~255u) | 31u; INSERT16(lc, key); }
        { const unsigned key = (fkey(va[15] + vb[0]) & ~255u) | 15u; INSERT16(lc, key); }
        float e[16], sum = 0.f; const float v0 = fkey_inv(lc[0] & ~255u);
#pragma unroll
        for (int k = 0; k < 16; ++k) { e[k] = __expf(fkey_inv(lc[k] & ~255u) - v0); sum += e[k]; }
        const float inv = 1.0f / sum;
        asm volatile("s_waitcnt lgkmcnt(0)" ::: "memory");
        unsigned exs[16]; float gws[16], sus[16];
#pragma unroll
        for (int k = 0; k < 16; ++k) {
            const unsigned pos = 255u - (lc[k] & 255u), a = pos >> 4, b = pos & 15u;
            const unsigned ea = ib[a * NTHREADS + F.tid], eb = ib[(16 + b) * NTHREADS + F.tid];
            exs[k] = ea * 128u + eb;
        }
#pragma unroll
        for (int k = 0; k < 16; ++k) { gws[k] = e[k] * inv * TSC[NEXP + exs[k]]; sus[k] = TSC[exs[k]]; }
        { const size_t o = (size_t)tok * 128 + head * 16;
#pragma unroll
          for (int q = 0; q < 2; ++q) { u32x4 w;
#pragma unroll
              for (int j = 0; j < 4; ++j) w[j] = exs[8 * q + 2 * j] | (exs[8 * q + 2 * j + 1] << 16);
              *(u32x4*)(IDX + o + 8 * q) = w; }
#pragma unroll
          for (int q = 0; q < 4; ++q) { *(f32x4*)(GW + o + 4 * q) = (f32x4){gws[4 * q], gws[4 * q + 1], gws[4 * q + 2], gws[4 * q + 3]};
                                        *(f32x4*)(SU + o + 4 * q) = (f32x4){sus[4 * q], sus[4 * q + 1], sus[4 * q + 2], sus[4 * q + 3]}; } }
        asm volatile("s_waitcnt lgkmcnt(0)" ::: "memory");
    }
}

DI float dpp_xor1(float v) { return __builtin_bit_cast(float, __builtin_amdgcn_mov_dpp(__builtin_bit_cast(int, v), 0xB1, 0xF, 0xF, true)); }
DI float dpp_xor2(float v) { return __builtin_bit_cast(float, __builtin_amdgcn_mov_dpp(__builtin_bit_cast(int, v), 0x4E, 0xF, 0xF, true)); }
DI float dpp_hmir(float v) { return __builtin_bit_cast(float, __builtin_amdgcn_mov_dpp(__builtin_bit_cast(int, v), 0x141, 0xF, 0xF, true)); }
DI float dot16_fp8(const u32x4 q, const float (&hx)[16]) {
    f32x2 a = {0.f, 0.f};
#pragma unroll
    for (int j = 0; j < 4; ++j) {
        const f32x2 lo = __builtin_amdgcn_cvt_pk_f32_fp8((int)q[j], false), hi = __builtin_amdgcn_cvt_pk_f32_fp8((int)q[j], true);
        a += lo * (f32x2){hx[4 * j], hx[4 * j + 1]}; a += hi * (f32x2){hx[4 * j + 2], hx[4 * j + 3]};
    }
    return a.x + a.y;
}
#define PEER_EXPERT(id, i) ((int)(((id)[(i) >> 3][((i) >> 1) & 3] >> (16 * ((i) & 1))) & 0xffffu))

DI int dpp_xor1i(int v) { return __builtin_amdgcn_mov_dpp(v, 0xB1, 0xF, 0xF, true); }
DI int dpp_xor2i(int v) { return __builtin_amdgcn_mov_dpp(v, 0x4E, 0xF, 0xF, true); }
DI int dpp_hmiri(int v) { return __builtin_amdgcn_mov_dpp(v, 0x141, 0xF, 0xF, true); }
struct PeerURows { u32x4 q[16]; u32x4 h[2]; };
DI void peer_u_rows(PeerURows& R, const u32x4 (&id)[2], const unsigned char* ut, const unsigned char* hrow) {
    R.h[0] = *(const u32x4*)(hrow); R.h[1] = *(const u32x4*)(hrow + 16);
#pragma unroll
    for (int i = 0; i < 16; ++i) R.q[i] = *(const u32x4*)(ut + (size_t)PEER_EXPERT(id, i) * (D / 2));
}
DI void peer_u_compute(const PeerURows& R, float* part, int lane) {
    int hsum = 0;
#pragma unroll
    for (int g = 0; g < 2; ++g)
#pragma unroll
        for (int j = 0; j < 4; ++j) hsum = __builtin_amdgcn_sdot4((int)R.h[g][j], 0x01010101, hsum, false);
    int d[16];
#pragma unroll
    for (int i = 0; i < 16; ++i) { int a = 0;
#pragma unroll
        for (int dw = 0; dw < 4; ++dw) {
            const unsigned w = R.q[i][dw];
            a = __builtin_amdgcn_sdot4((int)(w & 0x0f0f0f0fu), (int)R.h[dw >> 1][2 * (dw & 1)], a, false);
            a = __builtin_amdgcn_sdot4((int)((w >> 4) & 0x0f0f0f0fu), (int)R.h[dw >> 1][2 * (dw & 1) + 1], a, false);
        }
        d[i] = a - 8 * hsum; }
    const bool b2 = (lane & 4) != 0, b1 = (lane & 2) != 0, b0 = (lane & 1) != 0;
    int k8[8];
#pragma unroll
    for (int i = 0; i < 8; ++i) { const int keep = b2 ? d[8 + i] : d[i], send = b2 ? d[i] : d[8 + i]; k8[i] = keep + dpp_hmiri(send); }
    int k4[4];
#pragma unroll
    for (int i = 0; i < 4; ++i) { const int keep = b1 ? k8[4 + i] : k8[i], send = b1 ? k8[i] : k8[4 + i]; k4[i] = keep + dpp_xor2i(send); }
    f32x2 k2;
    { const int keep0 = b0 ? k4[2] : k4[0], send0 = b0 ? k4[0] : k4[2], keep1 = b0 ? k4[3] : k4[1], send1 = b0 ? k4[1] : k4[3];
      k2.x = (float)(keep0 + dpp_xor1i(send0)); k2.y = (float)(keep1 + dpp_xor1i(send1)); }
    *(f32x2*)(part + 16 * (lane >> 3) + (b2 ? 8 : 0) + (b1 ? 4 : 0) + (b0 ? 2 : 0)) = k2;
}
DI void phase_peer_u(const Params& p, const Frame& F, int l) {
    const int ntok = (l == 0) ? T : TL, lane = F.lane, half = ntok >> 1;
    const int grp = F.bid & 7, cs = grp & 3, th = grp >> 2, sw = (F.bid >> 3) * NWAVES + F.wave, nsw = (F.nb >> 3) * NWAVES;
    const unsigned char* ut = p.ws + WS_UTAB + (size_t)l * NEXP * (D / 2) + 128 * cs + 16 * (lane & 7);
    const unsigned char* Hs = p.ws + WS_H8 + 256 * cs + 32 * (lane & 7);
    const unsigned short* IDXg = (const unsigned short*)(p.ws + WS_IDX) + 16 * (lane >> 3);
    float* PART = (float*)(p.ws + WS_ST) + (size_t)cs * T * 128;
    const int t0 = th * half, tend = t0 + half, last = tend - 1;
    u32x4 sa[2], sb[2]; PeerURows ra, rb;
#define U_SEL(S_, t_) do { const unsigned short* ip_ = IDXg + (size_t)min((t_), last) * 128; S_[0] = *(const u32x4*)ip_; S_[1] = *(const u32x4*)(ip_ + 8); } while (0)
#define U_ROWS(R_, S_, t_) peer_u_rows(R_, S_, ut, Hs + (size_t)min((t_), last) * D)
    U_SEL(sa, t0 + sw); U_SEL(sb, t0 + sw + nsw);
    U_ROWS(ra, sa, t0 + sw);
#pragma unroll 1
    for (int tok = t0 + sw; tok < tend; tok += 2 * nsw) {
        U_SEL(sa, tok + 2 * nsw); U_ROWS(rb, sb, tok + nsw);
        peer_u_compute(ra, PART + (size_t)tok * 128, lane);
        U_SEL(sb, tok + 3 * nsw); U_ROWS(ra, sa, tok + 2 * nsw);
        if (tok + nsw < tend) peer_u_compute(rb, PART + (size_t)(tok + nsw) * 128, lane);
    }
#undef U_SEL
#undef U_ROWS
}
DI void phase_peer_c(const Params& p, const Frame& F, int l, bool dummy = false) {
    const int ntok = (l == 0) ? T : TL;
    const float* PART = (const float*)(p.ws + WS_ST);
    float* GW = (float*)(p.ws + WS_GW);
    float* CO = dummy ? (float*)(p.ws + WS_H8) : GW;
    const float* SU = (const float*)(p.ws + WS_SU);
    const float* HS = (const float*)(p.ws + WS_HS);
    for (int i0 = F.gtid; i0 < ntok * 128; i0 += 4 * F.ngt) {
        float s[4], gw[4], su[4];
#pragma unroll
        for (int u = 0; u < 4; ++u) {
            const int i = min(i0 + u * F.ngt, ntok * 128 - 1);
            s[u] = 0.f;
#pragma unroll
            for (int sl = 0; sl < 4; ++sl) s[u] += PART[(size_t)sl * T * 128 + i];
            gw[u] = GW[i]; su[u] = SU[i] * HS[i >> 7];
        }
#pragma unroll
        for (int u = 0; u < 4; ++u) { const int i = i0 + u * F.ngt; if (i < ntok * 128) CO[i] = gw[u] * gelu_tanh(s[u] * su[u]); }
    }
}
struct PeerVRows { u32x4 q[16]; f32x4 cf[4]; f32x4 xv, gv; };
DI void peer_v_rows(PeerVRows& R, const u32x4 (&id)[2], const unsigned char* vt, const float* cp, const float* xs, const float* gt2) {
    R.cf[0] = *(const f32x4*)cp; R.cf[1] = *(const f32x4*)(cp + 4); R.cf[2] = *(const f32x4*)(cp + 8); R.cf[3] = *(const f32x4*)(cp + 12);
    R.xv = *(const f32x4*)xs; R.gv = *(const f32x4*)gt2;
#pragma unroll
    for (int i = 0; i < 16; ++i) R.q[i] = *(const u32x4*)(vt + (size_t)PEER_EXPERT(id, i) * (D / 2));
}
DI float xchg32(float v, bool hi) { const auto r = __builtin_amdgcn_permlane32_swap(__builtin_bit_cast(unsigned, v), __builtin_bit_cast(unsigned, v), false, false);
    return __builtin_bit_cast(float, hi ? r[0] : r[1]); }
DI float xchg16(float v, bool hi) { const auto r = __builtin_amdgcn_permlane16_swap(__builtin_bit_cast(unsigned, v), __builtin_bit_cast(unsigned, v), false, false);
    return __builtin_bit_cast(float, hi ? r[0] : r[1]); }
DI float xchg8(float v) { return __builtin_bit_cast(float, __builtin_amdgcn_mov_dpp(__builtin_bit_cast(int, v), 0x128, 0xF, 0xF, true)); }
typedef _Float16 h16x2 __attribute__((ext_vector_type(2)));
DI unsigned xchg32u(unsigned v, bool hi) { const auto r = __builtin_amdgcn_permlane32_swap(v, v, false, false); return hi ? r[0] : r[1]; }
DI unsigned xchg16u(unsigned v, bool hi) { const auto r = __builtin_amdgcn_permlane16_swap(v, v, false, false); return hi ? r[0] : r[1]; }
DI unsigned xchg8u(unsigned v) { return (unsigned)__builtin_amdgcn_mov_dpp((int)v, 0x128, 0xF, 0xF, true); }
DI void peer_v_compute(const PeerVRows& R, float* xdst, int lane) {
    h16x2 a[16];
#pragma unroll
    for (int j = 0; j < 16; ++j) a[j] = (h16x2){(_Float16)0.f, (_Float16)0.f};
#pragma unroll
    for (int i = 0; i < 16; ++i) {
        const _Float16 ch = (_Float16)R.cf[i >> 2][i & 3]; const h16x2 c2 = {ch, ch};
#pragma unroll
        for (int d = 0; d < 4; ++d) {
            a[4 * d + 0] += c2 * __builtin_amdgcn_cvt_scalef32_pk_f16_fp4(R.q[i][d], 1.0f, 0);
            a[4 * d + 1] += c2 * __builtin_amdgcn_cvt_scalef32_pk_f16_fp4(R.q[i][d], 1.0f, 1);
            a[4 * d + 2] += c2 * __builtin_amdgcn_cvt_scalef32_pk_f16_fp4(R.q[i][d], 1.0f, 2);
            a[4 * d + 3] += c2 * __builtin_amdgcn_cvt_scalef32_pk_f16_fp4(R.q[i][d], 1.0f, 3);
        }
    }
    const bool b5 = (lane & 32) != 0, b4 = (lane & 16) != 0, b3 = (lane & 8) != 0;
    h16x2 k8[8];
#pragma unroll
    for (int j = 0; j < 8; ++j) { const h16x2 keep = b5 ? a[8 + j] : a[j], send = b5 ? a[j] : a[8 + j];
        k8[j] = keep + __builtin_bit_cast(h16x2, xchg32u(__builtin_bit_cast(unsigned, send), b5)); }
    h16x2 k4[4];
#pragma unroll
    for (int j = 0; j < 4; ++j) { const h16x2 keep = b4 ? k8[4 + j] : k8[j], send = b4 ? k8[j] : k8[4 + j];
        k4[j] = keep + __builtin_bit_cast(h16x2, xchg16u(__builtin_bit_cast(unsigned, send), b4)); }
    h16x2 k2[2];
#pragma unroll
    for (int j = 0; j < 2; ++j) { const h16x2 keep = b3 ? k4[2 + j] : k4[j], send = b3 ? k4[j] : k4[2 + j];
        k2[j] = keep + __builtin_bit_cast(h16x2, xchg8u(__builtin_bit_cast(unsigned, send))); }
    *(f32x4*)xdst = R.xv + R.gv * (f32x4){(float)k2[0].x, (float)k2[0].y, (float)k2[1].x, (float)k2[1].y};
}
DI void phase_peer_v(const Params& p, const Frame& F, int l, bool dummy = false) {
    const int ntok = (l == 0) ? T : TL, lane = F.lane, half = ntok >> 1;
    const int grp = F.bid & 7, cs = grp & 3, th = grp >> 2, sw = (F.bid >> 3) * NWAVES + F.wave, nsw = (F.nb >> 3) * NWAVES;
    const unsigned char* vt = p.ws + WS_VTAB + (size_t)l * NEXP * (D / 2) + 128 * cs + 16 * (lane & 7);
    const unsigned short* IDXg = (const unsigned short*)(p.ws + WS_IDX) + 16 * (lane >> 3);
    const float* CFg = (const float*)(p.ws + WS_GW) + 16 * (lane >> 3);
    const int t0 = th * half, tend = t0 + half, last = tend - 1;
    u32x4 sa[2], sb[2]; PeerVRows ra, rb;
#define V_SEL(S_, t_) do { const unsigned short* ip_ = IDXg + (size_t)min((t_), last) * 128; S_[0] = *(const u32x4*)ip_; S_[1] = *(const u32x4*)(ip_ + 8); } while (0)
    const int co = 256 * cs + 32 * (lane & 7) + ((lane & 32) ? 16 : 0) + ((lane & 16) ? 8 : 0) + ((lane & 8) ? 4 : 0);
#define V_ROWS(R_, S_, t_) do { const int t1_ = min((t_), last); peer_v_rows(R_, S_, vt, CFg + (size_t)t1_ * 128, xrow_ptr(p, t1_) + co, mod_vec(p, l, t1_, 5) + co); } while (0)
#define V_DO(R_, t_) do { const int t2_ = (t_); float* xd_ = (dummy ? (float*)(p.ws + WS_ST) + (size_t)t2_ * D : xrow_ptr(p, t2_)) + co; peer_v_compute(R_, xd_, lane); } while (0)
    V_SEL(sa, t0 + sw); V_SEL(sb, t0 + sw + nsw);
    V_ROWS(ra, sa, t0 + sw);
#pragma unroll 1
    for (int tok = t0 + sw; tok < tend; tok += 2 * nsw) {
        V_SEL(sa, tok + 2 * nsw); V_ROWS(rb, sb, tok + nsw);
        V_DO(ra, tok);
        V_SEL(sb, tok + 3 * nsw); V_ROWS(ra, sa, tok + 2 * nsw);
        if (tok + nsw < tend) V_DO(rb, tok + nsw);
    }
#undef V_SEL
#undef V_ROWS
#undef V_DO
}

#define XB_TMO      128
#define XB_XCNT(j)  (256  + 64 * (j))
#define XB_XSUB(j)  (1280 + 64 * (j))
#define XB_XGEN(j)  (2304 + 64 * (j))
#define XB_TOP      3328
#define XB_TOPGEN   3392
#define XCD_BAR_WORDS 3456
#define XB_SPIN_CAP (1u << 18)
DI unsigned xb_ld(unsigned* p)              { return __hip_atomic_load(p, __ATOMIC_RELAXED, __HIP_MEMORY_SCOPE_AGENT); }
DI unsigned xb_add(unsigned* p, unsigned v) { return __hip_atomic_fetch_add(p, v, __ATOMIC_RELAXED, __HIP_MEMORY_SCOPE_AGENT); }
DI unsigned xb_xcc_id() { return (unsigned)__builtin_amdgcn_s_getreg((3 << 11) | 20) & 0xFu; }
#define XB_SPIN(cond, bar) do { unsigned _sp = 0; while (cond) { __builtin_amdgcn_s_sleep(1); \
    if ((++_sp & 255u) == 0u) { if (xb_ld(&(bar)[XB_TMO])) break; if (_sp > XB_SPIN_CAP) { atomicAdd(&(bar)[XB_TMO], 1u); break; } } } } while (0)
struct XcdBarrier { unsigned* bar; unsigned x; volatile LAS unsigned* st; };
DI XcdBarrier xcd_barrier_post(unsigned* bar, volatile LAS unsigned* st) {
    XcdBarrier b; b.bar = bar; b.x = xb_xcc_id(); b.st = st;
    if (threadIdx.x == 0) (void)xb_add(&bar[XB_XCNT(b.x)], 1u);
    return b;
}
DI void xcd_barrier_complete(unsigned* bar, unsigned x, unsigned& nloc, unsigned& nx) {
    const unsigned G = gridDim.x * gridDim.y * gridDim.z;
    unsigned sum, cnt, mine, sp = 0u;
    for (;;) {
        sum = 0u; cnt = 0u; mine = 0u;
#pragma unroll
        for (unsigned j = 0; j < 16; ++j) { const unsigned c = xb_ld(&bar[XB_XCNT(j)]); sum += c; cnt += (c > 0u) ? 1u : 0u; mine = (j == x) ? c : mine; }
        if (sum == G) break;
        __builtin_amdgcn_s_sleep(1);
        if ((++sp & 255u) == 0u) { if (xb_ld(&bar[XB_TMO])) break; if (sp > XB_SPIN_CAP) { atomicAdd(&bar[XB_TMO], 1u); break; } }
    }
    nloc = mine > 0u ? mine : 1u; nx = cnt > 0u ? cnt : 1u;
}
DI void xcd_barrier(const XcdBarrier& b) {
    asm volatile("s_waitcnt vmcnt(0)" ::: "memory");
    __syncthreads();
    if (threadIdx.x == 0) {
        unsigned* bar = b.bar;
        __builtin_amdgcn_s_waitcnt(0);
        unsigned nloc = b.st[0], nx = b.st[1];
        if (nloc == 0u) { xcd_barrier_complete(bar, b.x, nloc, nx); b.st[0] = nloc; b.st[1] = nx; }
        const unsigned old = xb_add(&bar[XB_XSUB(b.x)], 1u);
        const unsigned gen = old / nloc;
        if (old + 1u == (gen + 1u) * nloc) {
            __builtin_amdgcn_fence(__ATOMIC_RELEASE, "agent");
            asm volatile("s_waitcnt vmcnt(0)" ::: "memory");
            const unsigned og = xb_add(&bar[XB_TOP], 1u);
            const unsigned tg = og / nx;
            if (og + 1u == (tg + 1u) * nx) xb_add(&bar[XB_TOPGEN], 1u);
            else XB_SPIN(xb_ld(&bar[XB_TOPGEN]) == tg, bar);
            __builtin_amdgcn_fence(__ATOMIC_ACQUIRE, "agent");
            xb_add(&bar[XB_XGEN(b.x)], 1u);
            asm volatile("s_waitcnt vmcnt(0)" ::: "memory");
        } else {
            XB_SPIN(xb_ld(&bar[XB_XGEN(b.x)]) == gen, bar);
            __builtin_amdgcn_fence(__ATOMIC_ACQUIRE, "agent");
            asm volatile("s_waitcnt vmcnt(0)" ::: "memory");
        }
    }
    __syncthreads();
}

constexpr int NPHASE = 27;
template <int PH> DI void run_phase(const Params& p, const Frame& F) {
    if constexpr (PH == 0) phase_prep(p, F);
    else if constexpr (PH == 1) phase_norm(p, F, 0, 0, true, T);
    else if constexpr (PH == 2) phase_g1(p, F, 0);
    else if constexpr (PH == 3) phase_mix(p, F, 0);
    else if constexpr (PH == 4) phase_g2a(p, F, 0);
    else if constexpr (PH == 5) phase_g2(p, F, 0);
    else if constexpr (PH == 6) phase_g2sum(p, F);
    else if constexpr (PH == 7) phase_g3(p, F, 0);
    else if constexpr (PH == 8) phase_norm(p, F, 0, 1, false, T);
    else if constexpr (PH == 9) phase_g45(p, F, 0);
    else if constexpr (PH == 10) phase_sel(p, F, 0);
    else if constexpr (PH == 11) phase_peer_u(p, F, 0);
    else if constexpr (PH == 12) phase_peer_c(p, F, 0);
    else if constexpr (PH == 13) phase_peer_v(p, F, 0);
    else if constexpr (PH == 14) phase_norm(p, F, 1, 0, false, T);
    else if constexpr (PH == 15) phase_g1(p, F, 1);
    else if constexpr (PH == 16) phase_mix(p, F, 1);
    else if constexpr (PH == 17) phase_g2a(p, F, 1);
    else if constexpr (PH == 18) phase_g2(p, F, 1);
    else if constexpr (PH == 19) phase_g3(p, F, 1);
    else if constexpr (PH == 20) phase_norm(p, F, 1, 1, false, TL);
    else if constexpr (PH == 21) phase_g45(p, F, 1);
    else if constexpr (PH == 22) phase_sel(p, F, 1);
    else if constexpr (PH == 23) phase_peer_u(p, F, 1);
    else if constexpr (PH == 24) phase_peer_c(p, F, 1);
    else if constexpr (PH == 25) phase_peer_v(p, F, 1);
    else if constexpr (PH == 26) phase_final(p, F);
}
DI Frame make_frame(unsigned char* lds_raw) {
    Frame F;
    F.lds = (LAS unsigned char*)lds_raw;
    int tid = threadIdx.x; asm volatile("" : "+v"(tid));
    int bid = blockIdx.x, nb = gridDim.x; asm volatile("" : "+s"(bid), "+s"(nb));
    F.tid = tid; F.lane = tid & 63; F.wave = __builtin_amdgcn_readfirstlane(tid >> 6); F.bid = bid; F.nb = nb;
    F.gw = bid * NWAVES + F.wave; F.ngw = nb * NWAVES; F.gtid = bid * NTHREADS + tid; F.ngt = nb * NTHREADS;
    return F;
}
template <int PH> DI void run_phase_fresh(unsigned char* lds_raw) {
#if defined(__HIP_DEVICE_COMPILE__)
    const __attribute__((address_space(4))) unsigned long long* pp = (const __attribute__((address_space(4))) unsigned long long*)__builtin_amdgcn_kernarg_segment_ptr();
    asm volatile("" : "+s"(pp));
    Params p;
#pragma unroll
    for (int i = 0; i < N_IN; ++i) p.in[i] = (const float*)(const __attribute__((address_space(1))) float*)pp[i];
    p.out = (float*)(__attribute__((address_space(1))) float*)pp[N_IN]; p.ws = (unsigned char*)(__attribute__((address_space(1))) unsigned char*)pp[N_IN + 1]; p.ph_lo = 0; p.ph_hi = 0;
#else
    Params p{};
#endif
    const Frame F = make_frame(lds_raw);
    run_phase<PH>(p, F);
}
template <int PH> __global__ void __launch_bounds__(NTHREADS, 2) phase_kernel(Params p) {
    extern __shared__ __attribute__((aligned(16))) unsigned char lds_raw[];
    run_phase_fresh<PH>(lds_raw);
}
template <int PH> DI void run_all(unsigned char* lds_raw, cg::grid_group& grid, const XcdBarrier& bar) {
    if constexpr (PH < NPHASE) {
        if constexpr (PH == PROBE_PH) {
            if constexpr (PH == 12 || PH == 24 || PH == 13 || PH == 25) {
#if defined(__HIP_DEVICE_COMPILE__)
                const __attribute__((address_space(4))) unsigned long long* pp = (const __attribute__((address_space(4))) unsigned long long*)__builtin_amdgcn_kernarg_segment_ptr();
                asm volatile("" : "+s"(pp));
                Params p;
#pragma unroll
                for (int i = 0; i < N_IN; ++i) p.in[i] = (const float*)(const __attribute__((address_space(1))) float*)pp[i];
                p.out = (float*)(__attribute__((address_space(1))) float*)pp[N_IN]; p.ws = (unsigned char*)(__attribute__((address_space(1))) unsigned char*)pp[N_IN + 1]; p.ph_lo = 0; p.ph_hi = 0;
                const Frame F = make_frame(lds_raw);
                if constexpr (PH == 12 || PH == 24) phase_peer_c(p, F, PH == 12 ? 0 : 1, true); else phase_peer_v(p, F, PH == 13 ? 0 : 1, true);
#endif
            } else run_phase_fresh<PH>(lds_raw);
            xcd_barrier(bar);
        }
        run_phase_fresh<PH>(lds_raw);
        if constexpr (PH + 1 < NPHASE) { xcd_barrier(bar); if constexpr (PROBE_SYNC) xcd_barrier(bar); }
        run_all<PH + 1>(lds_raw, grid, bar);
    }
}
__global__ void __launch_bounds__(NTHREADS, 2) mega(Params p) {
    extern __shared__ __attribute__((aligned(16))) unsigned char lds_raw[];
    cg::grid_group grid = cg::this_grid();
    volatile LAS unsigned* st = (volatile LAS unsigned*)((LAS unsigned char*)lds_raw + LDS_BAR_OFF);
    if (threadIdx.x < 2) st[threadIdx.x] = 0u;
    __syncthreads();
    const XcdBarrier bar = xcd_barrier_post((unsigned*)(p.ws + WS_CTL), st);
    if (p.ph_lo != 0) grid.sync();
    run_all<0>(lds_raw, grid, bar);
}

extern "C" void kernel_launch(void* const* d_in, const int* in_sizes, int n_in, void* d_out, int out_size, void* d_ws, size_t ws_size, hipStream_t stream) {
    static int grid = 0;
    if (grid == 0) {
        if (n_in != 23 || out_size != TL * D || ws_size < WS_END) { fprintf(stderr, "kernel_launch: unexpected shapes (n_in %d out %d ws %zu)\n", n_in, out_size, ws_size); grid = -1; return; }
        int dev = 0, cus = 0, per_cu = 0;
        (void)hipGetDevice(&dev);
        (void)hipDeviceGetAttribute(&cus, hipDeviceAttributeMultiprocessorCount, dev);
        (void)hipFuncSetAttribute((const void*)mega, hipFuncAttributeMaxDynamicSharedMemorySize, LDS_BYTES);
        (void)hipOccupancyMaxActiveBlocksPerMultiprocessor(&per_cu, (const void*)mega, NTHREADS, LDS_BYTES);
        if (per_cu < 1) { fprintf(stderr, "kernel_launch: occupancy query reports %d blocks per CU\n", per_cu); grid = -1; return; }
        grid = cus & ~7;
        if (grid < 8) { fprintf(stderr, "kernel_launch: needs at least 8 CUs\n"); grid = -1; return; }
    }
    if (grid < 0) return;
    (void)hipMemsetAsync((char*)d_ws + WS_CTL, 0, CTL_ZERO_BYTES, stream);
    Params p{};
    for (int i = 0; i < N_IN; ++i) p.in[i] = (const float*)d_in[i];
    p.out = (float*)d_out; p.ws = (unsigned char*)d_ws;
    void* args[] = {&p};
    hipError_t e = hipLaunchCooperativeKernel((const void*)mega, dim3(grid), dim3(NTHREADS), args, LDS_BYTES, stream);
    if (e != hipSuccess) fprintf(stderr, "cooperative launch failed: %s (grid %d)\n", hipGetErrorString(e), grid);
}
```

```cpp
#include <hip/hip_runtime.h>
#include <hip/hip_cooperative_groups.h>
#include <stdint.h>
#include <stdio.h>
namespace cg = cooperative_groups;

#ifndef PROBE_PH
#define PROBE_PH -1
#endif
#ifndef PROBE_SYNC
#define PROBE_SYNC 0
#endif
#ifndef MK_SINGLE
#define MK_SINGLE 0
#endif

#define LAS __attribute__((address_space(3)))
typedef unsigned short bf16_t;
typedef short bf16x8 __attribute__((ext_vector_type(8)));
typedef short s16x4 __attribute__((ext_vector_type(4)));
typedef float f32x4 __attribute__((ext_vector_type(4)));
typedef float f32x2 __attribute__((ext_vector_type(2)));
typedef float f32x16 __attribute__((ext_vector_type(16)));
typedef unsigned u32x4 __attribute__((ext_vector_type(4)));
typedef unsigned u32x2 __attribute__((ext_vector_type(2)));
typedef __bf16 bf16x2_t __attribute__((ext_vector_type(2)));
typedef _Float16 f16x2_t __attribute__((ext_vector_type(2)));
#define DI __device__ __forceinline__
DI unsigned pkh2(float lo, float hi) { f16x2_t v = {(_Float16)lo, (_Float16)hi}; return __builtin_bit_cast(unsigned, v); }
#define MFMA32(a, b, c) __builtin_amdgcn_mfma_f32_32x32x16_bf16((a), (b), (c), 0, 0, 0)

constexpr int D = 1024, NB = 8, SEQ = 4096, NCTX = 256, DEPTH = 2;
constexpr int TL = NB * SEQ, TC = NB * NCTX, T = TL + TC;
constexpr int INW = 4608, NMOD = 6 * D, PW = 1600, PN = 1536;
constexpr int VTS = SEQ + 64;
constexpr int QOFF = 0, KOFF = 512, VOFF = 640, POOLOFF = 768, SUOFF = 1024, SVOFF = 1280, GATEOFF = 1536;
constexpr int NEXP = 16384;
constexpr float EPS = 1e-6f;
constexpr float LOG2E = 1.4426950408889634f;
constexpr float QSCALE = 0.125f * LOG2E;

constexpr size_t MiB = 1u << 20;
constexpr size_t WS_CTL = 0, WS_MOD = 1 * MiB, CTL_ZERO_BYTES = 2 * MiB;
constexpr size_t WS_ROPE = 2 * MiB, WS_SGUW = 2 * MiB + 65536, WS_TSCALE = 3 * MiB;
constexpr size_t WS_WIN = 4 * MiB, WS_WBR = 22 * MiB, WS_WOUT = 26 * MiB, WS_WFOLD = 30 * MiB;
constexpr size_t WS_XCTX = 38 * MiB, WS_UTAB = 46 * MiB, WS_VTAB = 78 * MiB;
constexpr size_t WS_IDX = 110 * MiB, WS_GW = 120 * MiB;
constexpr size_t WS_H = 142 * MiB;
constexpr size_t WS_P = 210 * MiB, WS_Y = 318 * MiB, WS_MERGED = 386 * MiB, WS_VT = 454 * MiB, WS_VTC = 463 * MiB, WS_VST = 464 * MiB;
constexpr size_t WS_G8 = WS_P;
constexpr size_t WS_MP = 482 * MiB;
constexpr size_t WS_ST = 210 * MiB, WS_H8 = 346 * MiB, WS_HS = 380 * MiB, WS_SU = 482 * MiB;
constexpr size_t WS_END = 512 * MiB;
static_assert(WS_ST + (size_t)2048 * T * 2 <= WS_H8 && WS_H8 + (size_t)T * D <= WS_HS, "ST / H8 fit");
static_assert(WS_VST + (size_t)272 * 256 * 128 * 2 <= WS_SU && WS_VT + (size_t)NB * 2 * 64 * VTS * 2 <= WS_VTC, "VsT / VT fit");
static_assert(WS_H + (size_t)T * D * 2 <= WS_P && WS_G8 + (size_t)T * 3072 <= WS_Y, "H / G8 fit");
static_assert(WS_P + (size_t)T * PW * 2 <= WS_Y && WS_Y + (size_t)T * D * 2 <= WS_MERGED && WS_MERGED + (size_t)T * D * 2 <= WS_VT, "P/Y/MERGED fit");
static_assert(WS_IDX + (size_t)T * 128 * 2 <= WS_GW && WS_GW + (size_t)T * 128 * 4 <= WS_H && WS_SU + (size_t)T * 128 * 4 <= WS_END && WS_HS + (size_t)T * 4 <= WS_SU, "idx/gw/su fit");

constexpr int LDS_BYTES = 163840;
constexpr int LDS_BAR_OFF = LDS_BYTES - 64;
constexpr int NTHREADS = 512, NWAVES = 8;

enum { I_x, I_c, I_ctx, I_c_ctx, I_w_mod, I_b_mod, I_g_mix, I_g_ffn, I_w_in, I_attn_sink, I_pool_w, I_pool_scale, I_sgu_w, I_sgu_b, I_w_br_attn, I_w_br_pool, I_w_br_sgu, I_w_out, I_peer_wq, I_peer_subkeys, I_peer_u, I_peer_v, I_g_final, N_IN };
struct Params {
    const float* in[N_IN];
    float* out; unsigned char* ws;
    int ph_lo, ph_hi;
};

DI unsigned pk2(float lo, float hi) { f32x2 v = {lo, hi}; return __builtin_bit_cast(unsigned, __builtin_convertvector(v, bf16x2_t)); }
DI unsigned f2bf(float f) { return pk2(f, 0.f) & 0xffffu; }
DI float bf2f(unsigned short u) { return __builtin_bit_cast(float, (unsigned)u << 16); }
DI float bflo(unsigned w) { return __builtin_bit_cast(float, w << 16); }
DI float bfhi(unsigned w) { return __builtin_bit_cast(float, w & 0xffff0000u); }
DI int crow(int reg, int h) { return (reg & 3) + 8 * (reg >> 2) + 4 * h; }
DI int dpp_x1(int v) { return __builtin_amdgcn_mov_dpp(v, 0xB1, 0xF, 0xF, true); }
DI float wave_sum(float v) {
#pragma unroll
    for (int o = 1; o < 64; o <<= 1) v += __shfl_xor(v, o);
    return v;
}
DI float sigmoidf_(float x) { return __builtin_amdgcn_rcpf(1.0f + __expf(-x)); }
DI float gelu_tanh(float x) { const float u = 0.7978845608028654f * (x + 0.044715f * x * x * x); return x * __builtin_amdgcn_rcpf(1.0f + __expf(-2.0f * u)); }
DI float silu_(float x) { return x * __builtin_amdgcn_rcpf(1.0f + __expf(-x)); }

struct Frame {
    int tid, lane, wave, gw, ngw, gtid, ngt, bid, nb;
    LAS unsigned char* lds;
};

template <int NM, int NN>
DI void wave_gemm(const bf16_t* __restrict__ A, int lda, const bf16_t* __restrict__ Bt, int ldb, int K, int m0, int n0, f32x16 (&acc)[NM][NN], int lane) {
    const int r = lane & 31, h = lane >> 5;
    const bf16_t* ap = A + (size_t)(m0 + r) * lda + 8 * h;
    const bf16_t* bp = Bt + (size_t)(n0 + r) * ldb + 8 * h;
    for (int k0 = 0; k0 < K; k0 += 64) {
        bf16x8 a[4][NM], b[4][NN];
#pragma unroll
        for (int s = 0; s < 4; ++s) {
#pragma unroll
            for (int i = 0; i < NM; ++i) a[s][i] = *(const bf16x8*)(ap + (size_t)(32 * i) * lda + k0 + 16 * s);
#pragma unroll
            for (int j = 0; j < NN; ++j) b[s][j] = *(const bf16x8*)(bp + (size_t)(32 * j) * ldb + k0 + 16 * s);
        }
#pragma unroll
        for (int s = 0; s < 4; ++s)
#pragma unroll
            for (int i = 0; i < NM; ++i)
#pragma unroll
                for (int j = 0; j < NN; ++j) acc[i][j] = MFMA32(a[s][i], b[s][j], acc[i][j]);
    }
}
template <int NM, int NN> DI void zero_acc(f32x16 (&acc)[NM][NN]) {
#pragma unroll
    for (int i = 0; i < NM; ++i)
#pragma unroll
        for (int j = 0; j < NN; ++j)
#pragma unroll
            for (int r = 0; r < 16; ++r) acc[i][j][r] = 0.f;
}

namespace pg8 {
constexpr int BM = 256, BK = 64, HALF = 128, HTB = HALF * BK * 2, STAGE_BYTES = 8 * HTB, NXCD = 8, WGM = 8, LD = 1024;
DI int lds_byte(int r, int c) { const int st = (r >> 4) * 2 + (c >> 5), rr = r & 15, cc = c & 31, ob = rr * 64 + cc * 2; return st * 1024 + (ob ^ (((ob >> 9) & 1) << 5)); }
DI void stage_rc(int b, int& R, int& C) { const int st = b / 1024, sb = b % 1024, swz = sb ^ (((sb >> 9) & 1) << 5); R = (st >> 1) * 16 + swz / 64; C = (st & 1) * 32 + (swz % 64) / 2; }
DI int perm32(int rho) { const int n = rho >> 4, i = rho & 15; return 8 * (i >> 2) + 4 * n + (i & 3); }
struct Unit { int pm, pn, sub, nt, mode; const char* a; const char* b; };
DI void tile_of(int L, int nM, int nN, int& pm, int& pn) {
    const int nwg = nM * nN; int wgid = L;
    { const int q = nwg / NXCD, r = nwg % NXCD, xcd = wgid % NXCD, off = wgid / NXCD; wgid = (xcd < r ? xcd * (q + 1) : r * (q + 1) + (xcd - r) * q) + off; }
    const int nig = WGM * nN, gid = wgid / nig, fm = gid * WGM, gsz = (nM - fm) < WGM ? (nM - fm) : WGM;
    pm = fm + ((wgid % nig) % gsz); pn = (wgid % nig) / gsz;
}
template <class Epi, class Sched>
DI void gemm_phase(LAS unsigned char* lds, const int tid, const Sched& S, const Epi& E) {
    const int wid = __builtin_amdgcn_readfirstlane(tid >> 6), lane = tid & 63, wr = wid >> 2, wc = wid & 3, fr = lane & 15, fq = lane >> 4;
    unsigned voffA[2], voffB[2];
#pragma unroll
    for (int i = 0; i < 2; ++i) { int R, C; stage_rc(tid * 16 + i * 8192, R, C); const int Rb = Epi::PERM ? ((R & ~31) + perm32(R & 31)) : R;
        voffA[i] = (unsigned)(R * LD + C) * 2u; voffB[i] = (unsigned)(Rb * LD + C) * 2u; }
    const size_t kstep = (size_t)(BK * 2);
    const size_t hstep = (size_t)HALF * LD * 2;
    const unsigned ldsw = (unsigned)wid * 1024u;
    const int aoff = lds_byte(wr * 64 + fr, fq * 8), boff = lds_byte(wc * 32 + fr, fq * 8);
#define PG8_SA(b, h) (((b) * 2 + (h)) * HTB)
#define PG8_SB(b, h) ((4 + (b) * 2 + (h)) * HTB)
#define PG8_STAGE(bufoff, gbase, voff) do { _Pragma("unroll") for (int _i = 0; _i < 2; ++_i) \
        __builtin_amdgcn_global_load_lds((const unsigned*)((const char*)(gbase) + (voff)[_i]), (LAS unsigned*)(lds + (bufoff) + ldsw + _i * 8192), 16, 0, 0); } while (0)
#define PG8_LDA(dst, b, h) do { _Pragma("unroll") for (int m = 0; m < 4; ++m) _Pragma("unroll") for (int k = 0; k < 2; ++k) dst[m][k] = *(const LAS bf16x8*)(lds + PG8_SA(b, h) + aoff + m * 2048 + k * 1024); } while (0)
#define PG8_LDB(dst, b, h) do { _Pragma("unroll") for (int n = 0; n < 2; ++n) _Pragma("unroll") for (int k = 0; k < 2; ++k) dst[n][k] = *(const LAS bf16x8*)(lds + PG8_SB(b, h) + boff + n * 2048 + k * 1024); } while (0)
#define PG8_MMA(ai, bj, At, Bt) do { __builtin_amdgcn_s_setprio(1); _Pragma("unroll") for (int m = 0; m < 4; ++m) _Pragma("unroll") for (int n = 0; n < 2; ++n) _Pragma("unroll") for (int k = 0; k < 2; ++k) \
        acc[ai][bj][m][n] = __builtin_amdgcn_mfma_f32_16x16x32_bf16(Bt[n][k], At[m][k], acc[ai][bj][m][n], 0, 0, 0); __builtin_amdgcn_s_setprio(0); } while (0)
#define PG8_WAIT_V(n) asm volatile("s_waitcnt vmcnt(" #n ")" ::: "memory")
#define PG8_WAIT_L(n) asm volatile("s_waitcnt lgkmcnt(" #n ")" ::: "memory")
#define PG8_BAR __builtin_amdgcn_s_barrier()
#define PG8_SCHED __builtin_amdgcn_sched_barrier(0)
    Unit cur, nxt; int ui = 0;
    if (!S.next(0, cur)) return;
    f32x4 acc[2][2][4][2];
#pragma unroll
    for (int a = 0; a < 2; ++a)
#pragma unroll
        for (int b = 0; b < 2; ++b)
#pragma unroll
            for (int m = 0; m < 4; ++m)
#pragma unroll
                for (int n = 0; n < 2; ++n) acc[a][b][m][n] = (f32x4){0.f, 0.f, 0.f, 0.f};
    bf16x8 At[4][2], B0[2][2], B1[2][2];
    const char* cA = cur.a; const char* cB = cur.b;
    PG8_STAGE(PG8_SB(0, 0), cB, voffB); PG8_STAGE(PG8_SB(0, 1), cB + hstep, voffB); PG8_STAGE(PG8_SA(0, 0), cA, voffA); PG8_STAGE(PG8_SA(0, 1), cA + hstep, voffA);
    if (wr == 1) PG8_BAR;
    PG8_WAIT_V(2); PG8_BAR;
    PG8_STAGE(PG8_SB(1, 0), cB + kstep, voffB); PG8_STAGE(PG8_SA(1, 0), cA + kstep, voffA); PG8_STAGE(PG8_SB(1, 1), cB + hstep + kstep, voffB);
    PG8_WAIT_V(6); PG8_BAR;
    for (;;) {
        const bool has_next = S.next(ui + 1, nxt);
        const char* nA = has_next ? nxt.a : cA; const char* nB = has_next ? nxt.b : cB;
        const int nt = cur.nt;
        for (int t = 0; t < nt; t += 2) {
            const bool last = (t == nt - 2);
            const char* a1 = cA + (size_t)(t + 1) * kstep;
            const char* a2 = last ? nA : cA + (size_t)(t + 2) * kstep; const char* b2 = last ? nB : cB + (size_t)(t + 2) * kstep;
            const char* a3 = a2 + kstep; const char* b3 = b2 + kstep;
            PG8_LDB(B0, 0, 0); PG8_LDB(B1, 0, 1); PG8_SCHED; PG8_LDA(At, 0, 0); PG8_STAGE(PG8_SA(1, 1), a1 + hstep, voffA);
            PG8_WAIT_V(8); PG8_WAIT_L(0); PG8_BAR; PG8_MMA(0, 0, At, B0); PG8_MMA(0, 1, At, B1); PG8_BAR; PG8_SCHED;
            PG8_LDA(At, 0, 1); PG8_STAGE(PG8_SB(0, 0), b2, voffB); PG8_STAGE(PG8_SB(0, 1), b2 + hstep, voffB); PG8_STAGE(PG8_SA(0, 0), a2, voffA);
            PG8_WAIT_V(8); PG8_WAIT_L(0); PG8_BAR; PG8_MMA(1, 0, At, B0); PG8_MMA(1, 1, At, B1); PG8_BAR; PG8_SCHED;
            PG8_LDB(B0, 1, 0); PG8_LDB(B1, 1, 1); PG8_SCHED; PG8_LDA(At, 1, 0); PG8_STAGE(PG8_SA(0, 1), a2 + hstep, voffA);
            PG8_WAIT_V(8); PG8_WAIT_L(0); PG8_BAR; PG8_MMA(0, 0, At, B0); PG8_MMA(0, 1, At, B1); PG8_BAR; PG8_SCHED;
            PG8_LDA(At, 1, 1); PG8_STAGE(PG8_SB(1, 0), b3, voffB); PG8_STAGE(PG8_SB(1, 1), b3 + hstep, voffB); PG8_STAGE(PG8_SA(1, 0), a3, voffA);
            PG8_WAIT_V(8); PG8_WAIT_L(0); PG8_BAR; PG8_MMA(1, 0, At, B0); PG8_MMA(1, 1, At, B1); PG8_BAR; PG8_SCHED;
        }
        if (wr == 0) PG8_BAR;
        E(acc, cur, wr, wc, fr, fq);
        if (!has_next) break;
        if (!E.keeps(cur)) {
#pragma unroll
        for (int a = 0; a < 2; ++a)
#pragma unroll
            for (int b = 0; b < 2; ++b)
#pragma unroll
                for (int m = 0; m < 4; ++m)
#pragma unroll
                    for (int n = 0; n < 2; ++n) acc[a][b][m][n] = (f32x4){0.f, 0.f, 0.f, 0.f};
        }
        cur = nxt; cA = nA; cB = nB; ++ui;
        if (wr == 1) PG8_BAR;
    }
    PG8_WAIT_V(0);
    PG8_BAR;
#undef PG8_SA
#undef PG8_SB
#undef PG8_STAGE
#undef PG8_LDA
#undef PG8_LDB
#undef PG8_MMA
#undef PG8_WAIT_V
#undef PG8_WAIT_L
#undef PG8_BAR
#undef PG8_SCHED
}
}

DI void transpose_item(const float* W, int K, int N, bf16_t* WT, int ldd, int row_off, int col_off, LAS float* scr, int item, int lane) {
    const int nblk = N / 32, kb = item / nblk, nb = item % nblk, k0 = 64 * kb, n0 = 32 * nb;
#pragma unroll 8
    for (int i = 0; i < 32; ++i) { const int kk = 2 * i + (lane >> 5); scr[kk * 33 + (lane & 31)] = W[(size_t)(k0 + kk) * N + n0 + (lane & 31)]; }
    asm volatile("s_waitcnt lgkmcnt(0)" ::: "memory");
    const int c = lane & 7;
#pragma unroll
    for (int j = 0; j < 4; ++j) { const int n = (lane >> 3) + 8 * j; const LAS float* s = scr + (8 * c) * 33 + n;
        u32x4 o; o.x = pk2(s[0 * 33], s[1 * 33]); o.y = pk2(s[2 * 33], s[3 * 33]); o.z = pk2(s[4 * 33], s[5 * 33]); o.w = pk2(s[6 * 33], s[7 * 33]);
        *(u32x4*)(WT + (size_t)(row_off + n0 + n) * ldd + col_off + k0 + 8 * c) = o; }
    asm volatile("s_waitcnt lgkmcnt(0)" ::: "memory");
}

DI void convert_tables(const Params& p, const Frame& F) {
    for (int it0 = 4 * F.gw; it0 < 4 * NEXP; it0 += 4 * F.ngw) {
        f32x4 v[4][4];
#pragma unroll
        for (int u = 0; u < 4; ++u) {
            const int it = it0 + u, e = it & (NEXP - 1), tbl = (it >> 14) & 1, l = it >> 15;
            const f32x4* src = (const f32x4*)((tbl ? p.in[I_peer_v] : p.in[I_peer_u]) + ((size_t)l * NEXP + e) * D) + 4 * F.lane;
#pragma unroll
            for (int j = 0; j < 4; ++j) v[u][j] = src[j];
        }
#pragma unroll
        for (int u = 0; u < 4; ++u) {
            const int it = it0 + u, e = it & (NEXP - 1), tbl = (it >> 14) & 1, l = it >> 15;
            float am = 0.f;
#pragma unroll
            for (int j = 0; j < 4; ++j) am = fmaxf(am, fmaxf(fmaxf(fabsf(v[u][j].x), fabsf(v[u][j].y)), fmaxf(fabsf(v[u][j].z), fabsf(v[u][j].w))));
#pragma unroll
            for (int o = 1; o < 64; o <<= 1) am = fmaxf(am, __shfl_xor(am, o));
            float sc;
            if (tbl) sc = (am > 0.f) ? 6.0f / am : 1.0f;
            else {
                float ss = 0.f;
#pragma unroll
                for (int j = 0; j < 4; ++j) ss += v[u][j].x * v[u][j].x + v[u][j].y * v[u][j].y + v[u][j].z * v[u][j].z + v[u][j].w * v[u][j].w;
                const float rms = sqrtf(wave_sum(ss) * (1.0f / D));
                const float step = fminf(am * (1.0f / 7.0f), 0.335f * rms);
                sc = (step > 0.f) ? 1.0f / step : 1.0f;
            }
            if (tbl) {
                u32x2 q4;
#pragma unroll
                for (int d = 0; d < 2; ++d) { unsigned w = 0;
                    w = __builtin_amdgcn_cvt_scalef32_pk_fp4_f32(w, v[u][2 * d][0] * sc, v[u][2 * d][1] * sc, 1.0f, 0);
                    w = __builtin_amdgcn_cvt_scalef32_pk_fp4_f32(w, v[u][2 * d][2] * sc, v[u][2 * d][3] * sc, 1.0f, 1);
                    w = __builtin_amdgcn_cvt_scalef32_pk_fp4_f32(w, v[u][2 * d + 1][0] * sc, v[u][2 * d + 1][1] * sc, 1.0f, 2);
                    w = __builtin_amdgcn_cvt_scalef32_pk_fp4_f32(w, v[u][2 * d + 1][2] * sc, v[u][2 * d + 1][3] * sc, 1.0f, 3);
                    q4[d] = w; }
                *(u32x2*)(p.ws + WS_VTAB + ((size_t)l * NEXP + e) * (D / 2) + 8 * F.lane) = q4;
            } else {
                u32x2 q4;
#pragma unroll
                for (int d = 0; d < 2; ++d) { unsigned w = 0;
#pragma unroll
                    for (int b = 0; b < 4; ++b) { const int j = 2 * d + (b >> 1), e2 = 2 * (b & 1);
                        const int n0 = (int)fminf(fmaxf(__builtin_rintf(v[u][j][e2] * sc), -8.0f), 7.0f) + 8, n1 = (int)fminf(fmaxf(__builtin_rintf(v[u][j][e2 + 1] * sc), -8.0f), 7.0f) + 8;
                        w |= (unsigned)(n0 | (n1 << 4)) << (8 * b); }
                    q4[d] = w; }
                *(u32x2*)(p.ws + WS_UTAB + ((size_t)l * NEXP + e) * (D / 2) + 8 * F.lane) = q4;
            }
            if (F.lane == 0) ((float*)(p.ws + WS_TSCALE))[(l * 2 + tbl) * NEXP + e] = 1.0f / sc;
        }
    }
}

DI void phase_prep(const Params& p, const Frame& F) {
    unsigned char* ws = p.ws;
    {
        LAS float* wq = (LAS float*)F.lds;
        LAS float* skl = wq + 128 * 65;
        for (int it = F.bid; it < 2 * 16 * 16; it += F.nb) {
            const int cc = it & 15, hp = (it >> 4) & 15, l = it >> 8;
            const float* src = p.in[I_peer_wq] + (size_t)l * D * 2048 + hp * 128;
            const float* sks = p.in[I_peer_subkeys] + (size_t)(l * 16 + hp) * 128 * 128;
            __syncthreads();
            { float tw[16]; f32x4 ts[8];
#pragma unroll
              for (int it = 0; it < 16; ++it) { const int e = F.tid + it * NTHREADS, ci = e >> 7, d = e & 127; tw[it] = src[(size_t)(cc * 64 + ci) * 2048 + d]; }
#pragma unroll
              for (int it = 0; it < 8; ++it) { const int e = F.tid + it * NTHREADS, key = e >> 5, d4 = (e & 31) * 4; ts[it] = *(const f32x4*)(sks + key * 128 + d4); }
#pragma unroll
              for (int it = 0; it < 16; ++it) { const int e = F.tid + it * NTHREADS, ci = e >> 7, d = e & 127; wq[d * 65 + ci] = tw[it]; }
#pragma unroll
              for (int it = 0; it < 8; ++it) { const int e = F.tid + it * NTHREADS, key = e >> 5, d4 = (e & 31) * 4; *(LAS f32x4*)(skl + key * 132 + d4) = ts[it]; } }
            __syncthreads();
            const int ci = F.tid & 63, kg = F.tid >> 6;
            float acc[16];
#pragma unroll
            for (int k = 0; k < 16; ++k) acc[k] = 0.f;
#pragma unroll 2
            for (int d = 0; d < 128; d += 4) {
                const float w0 = wq[d * 65 + ci], w1 = wq[(d + 1) * 65 + ci], w2 = wq[(d + 2) * 65 + ci], w3 = wq[(d + 3) * 65 + ci];
#pragma unroll
                for (int k = 0; k < 16; ++k) { const f32x4 s = *(const LAS f32x4*)(skl + (16 * kg + k) * 132 + d); acc[k] += w0 * s.x + w1 * s.y + w2 * s.z + w3 * s.w; }
            }
            bf16_t* dst = (bf16_t*)(ws + WS_WFOLD) + ((size_t)l * 2048 + hp * 128 + 16 * kg) * D + cc * 64 + ci;
#pragma unroll
            for (int k = 0; k < 16; ++k) dst[(size_t)k * D] = (bf16_t)f2bf(acc[k]);
        }
        __syncthreads();
    }
    {
        LAS float* scr = (LAS float*)(F.lds + F.wave * 16384);
        constexpr int I_IN = (D / 64) * (INW / 32), I_BA = (512 / 64) * (D / 32), I_BS = (256 / 64) * (D / 32), I_O = (D / 64) * (D / 32);
        constexpr int PER_L = I_IN + I_BA + I_BS + I_O;
        for (int it = F.gw; it < 2 * PER_L; it += F.ngw) {
            const int l = it / PER_L; int r = it % PER_L;
            if (r < I_IN) { transpose_item(p.in[I_w_in] + (size_t)l * D * INW, D, INW, (bf16_t*)(ws + WS_WIN) + (size_t)l * INW * D, D, 0, 0, scr, r, F.lane); continue; } r -= I_IN;
            if (r < I_BA) { transpose_item(p.in[I_w_br_attn] + (size_t)l * 512 * D, 512, D, (bf16_t*)(ws + WS_WBR) + (size_t)l * D * D, D, 0, 0, scr, r, F.lane); continue; } r -= I_BA;
            if (r < I_BS) { transpose_item(p.in[I_w_br_sgu] + (size_t)l * 256 * D, 256, D, (bf16_t*)(ws + WS_WBR) + (size_t)l * D * D, D, 0, 768, scr, r, F.lane); continue; } r -= I_BS;
            transpose_item(p.in[I_w_out] + (size_t)l * D * D, D, D, (bf16_t*)(ws + WS_WOUT) + (size_t)l * D * D, D, 0, 0, scr, r, F.lane);
        }
    }
    for (int i = F.gtid; i < 2 * 256 * D; i += F.ngt) {
        const int n = i & 1023, rc = (i >> 10) & 255, l = i >> 18, g = rc >> 6;
        const float* pw = p.in[I_pool_w] + ((size_t)l * 256 + rc) * 64;
        const float* ps = p.in[I_pool_scale] + l * 256 + 64 * g;
        const float* wb = p.in[I_w_br_pool] + ((size_t)l * 256 + 64 * g) * D + n;
        float a = 0.f;
#pragma unroll 16
        for (int e = 0; e < 64; ++e) a += pw[e] * ps[e] * wb[(size_t)e * D];
        ((bf16_t*)(ws + WS_WBR))[(size_t)l * D * D + (size_t)n * D + 512 + rc] = (bf16_t)f2bf(a);
    }
    for (int i = F.gtid; i < 2 * 4 * 128 * 128; i += F.ngt) ((bf16_t*)(ws + WS_SGUW))[i] = (bf16_t)f2bf(p.in[I_sgu_w][i]);
    for (int i = F.gtid; i < 64 * 16; i += F.ngt) {
        const int pos = i >> 4, fi = i & 15;
        const float inv = powf(10000.0f, -(float)fi / 16.0f);
        const float ang = (float)pos * inv;
        ((f32x2*)(ws + WS_ROPE))[i] = (f32x2){cosf(ang), sinf(ang)};
    }
    convert_tables(p, F);
    {
        float* MOD = (float*)(ws + WS_MOD);
        LAS float* scd = (LAS float*)F.lds;
        LAS float* red = scd + 9 * D;
        __syncthreads();
        { float tc[18];
#pragma unroll
          for (int it = 0; it < 18; ++it) { const int e = F.tid + it * NTHREADS, r = e >> 10, k = e & 1023; tc[it] = (r < 8) ? p.in[I_c][r * D + k] : p.in[I_c_ctx][k]; }
#pragma unroll
          for (int it = 0; it < 18; ++it) scd[F.tid + it * NTHREADS] = silu_(tc[it]); }
        __syncthreads();
        for (int it = F.bid; it < 2 * 96; it += F.nb) {
            const int cgp = it % 96, l = it / 96, col = cgp * 64 + F.lane;
            float acc[9];
#pragma unroll
            for (int r = 0; r < 9; ++r) acc[r] = 0.f;
            const float* wp = p.in[I_w_mod] + ((size_t)l * D + F.wave * 128) * NMOD + col;
#pragma unroll 16
            for (int k = 0; k < 128; ++k) {
                const float w = wp[(size_t)k * NMOD];
#pragma unroll
                for (int r = 0; r < 9; ++r) acc[r] += scd[r * D + F.wave * 128 + k] * w;
            }
#pragma unroll
            for (int r = 0; r < 9; ++r) red[(F.wave * 9 + r) * 64 + F.lane] = acc[r];
            __syncthreads();
            for (int e = F.tid; e < 9 * 64; e += NTHREADS) {
                const int r = e >> 6, ln = e & 63; float s = p.in[I_b_mod][l * NMOD + cgp * 64 + ln];
#pragma unroll
                for (int w = 0; w < 8; ++w) s += red[(w * 9 + r) * 64 + ln];
                MOD[((size_t)l * 9 + r) * NMOD + cgp * 64 + ln] = s;
            }
            __syncthreads();
        }
    }
}

DI const float* mod_vec(const Params& p, int l, int row, int j) {
    const int r = row < TL ? row / SEQ : 8;
    return (const float*)(p.ws + WS_MOD) + ((size_t)l * 9 + r) * NMOD + j * D;
}
DI float* xrow_ptr(const Params& p, int row) { return row < TL ? p.out + (size_t)row * D : (float*)(p.ws + WS_XCTX) + (size_t)(row - TL) * D; }
DI const float* xin_ptr(const Params& p, int row) { return row < TL ? p.in[I_x] + (size_t)row * D : p.in[I_ctx] + (size_t)(row - TL) * D; }

DI void phase_norm(const Params& p, const Frame& F, int l, int which  , bool from_input, int nrows) {
    const float* g = (which == 0 ? p.in[I_g_mix] : p.in[I_g_ffn]) + l * D;
    const int lane = F.lane;
    f32x4 gg[4];
#pragma unroll
    for (int j = 0; j < 4; ++j) gg[j] = ((const f32x4*)g)[lane + 64 * j];
    for (int row0 = 2 * F.gw; row0 < nrows; row0 += 2 * F.ngw) {
        f32x4 v[2][4], s1[2][4], s2[2][4];
#pragma unroll
        for (int u = 0; u < 2; ++u) {
            const int row = row0 + u;
            const float* src = from_input ? xin_ptr(p, row) : xrow_ptr(p, row);
            const float* sh = mod_vec(p, l, row, which * 3 + 0); const float* sc = mod_vec(p, l, row, which * 3 + 1);
#pragma unroll
            for (int j = 0; j < 4; ++j) { v[u][j] = ((const f32x4*)src)[lane + 64 * j]; s1[u][j] = ((const f32x4*)sh)[lane + 64 * j]; s2[u][j] = ((const f32x4*)sc)[lane + 64 * j]; }
        }
#pragma unroll
        for (int u = 0; u < 2; ++u) {
            float ss = 0.f;
#pragma unroll
            for (int j = 0; j < 4; ++j) ss += v[u][j].x * v[u][j].x + v[u][j].y * v[u][j].y + v[u][j].z * v[u][j].z + v[u][j].w * v[u][j].w;
            const float rinv = rsqrtf(wave_sum(ss) * (1.0f / D) + EPS);
            bf16_t* dst = (bf16_t*)(p.ws + WS_H) + (size_t)(row0 + u) * D;
            float am = 0.f;
#pragma unroll
            for (int j = 0; j < 4; ++j) {
                const f32x4 o = v[u][j] * rinv * gg[j] * (s2[u][j] + 1.0f) + s1[u][j];
                u32x2 w; w.x = pk2(o.x, o.y); w.y = pk2(o.z, o.w);
                ((u32x2*)dst)[lane + 64 * j] = w;
                v[u][j] = o; am = fmaxf(am, fmaxf(fmaxf(fabsf(o.x), fabsf(o.y)), fmaxf(fabsf(o.z), fabsf(o.w))));
            }
            if (which) {
#pragma unroll
                for (int o2 = 1; o2 < 64; o2 <<= 1) am = fmaxf(am, __shfl_xor(am, o2));
                const float sc = (am > 0.f) ? 127.0f / am : 1.0f;
                unsigned* h8 = (unsigned*)(p.ws + WS_H8 + (size_t)(row0 + u) * D);
                const bool odd = (lane & 1) != 0;
#pragma unroll
                for (int j = 0; j < 4; ++j) {
                    const int b0 = (int)__builtin_rintf(v[u][j].x * sc), b1 = (int)__builtin_rintf(v[u][j].y * sc), b2 = (int)__builtin_rintf(v[u][j].z * sc), b3 = (int)__builtin_rintf(v[u][j].w * sc);
                    const int p0 = dpp_x1(b0), p1 = dpp_x1(b1), p2 = dpp_x1(b2), p3 = dpp_x1(b3);
                    const int w0 = odd ? p1 : b0, w1 = odd ? p3 : b2, w2 = odd ? b1 : p0, w3 = odd ? b3 : p2;
                    h8[lane + 64 * j] = (unsigned)(w0 & 0xff) | ((unsigned)(w1 & 0xff) << 8) | ((unsigned)(w2 & 0xff) << 16) | ((unsigned)w3 << 24);
                }
                if (lane == 0) ((float*)(p.ws + WS_HS))[row0 + u] = (am > 0.f) ? am * (1.0f / 127.0f) : 1.0f;
            }
        }
    }
}
DI void phase_final(const Params& p, const Frame& F) {
    f32x4 gg[4];
#pragma unroll
    for (int j = 0; j < 4; ++j) gg[j] = ((const f32x4*)p.in[I_g_final])[F.lane + 64 * j];
    for (int row0 = 2 * F.gw; row0 < TL; row0 += 2 * F.ngw) {
        f32x4 v[2][4];
#pragma unroll
        for (int u = 0; u < 2; ++u)
#pragma unroll
            for (int j = 0; j < 4; ++j) v[u][j] = ((const f32x4*)(p.out + (size_t)(row0 + u) * D))[F.lane + 64 * j];
#pragma unroll
        for (int u = 0; u < 2; ++u) {
            float ss = 0.f;
#pragma unroll
            for (int j = 0; j < 4; ++j) ss += v[u][j].x * v[u][j].x + v[u][j].y * v[u][j].y + v[u][j].z * v[u][j].z + v[u][j].w * v[u][j].w;
            const float rinv = rsqrtf(wave_sum(ss) * (1.0f / D) + EPS);
            f32x4* xr = (f32x4*)(p.out + (size_t)(row0 + u) * D);
#pragma unroll
            for (int j = 0; j < 4; ++j) xr[F.lane + 64 * j] = v[u][j] * rinv * gg[j];
        }
    }
}

DI float lane_xor32(float v, bool hi) { const auto r = __builtin_amdgcn_permlane32_swap(__builtin_bit_cast(unsigned, v), __builtin_bit_cast(unsigned, v), false, false);
    return __builtin_bit_cast(float, hi ? r[0] : r[1]); }
struct EpiG1 {
    DI bool keeps(const pg8::Unit&) const { return false; }
    static constexpr bool PERM = true;
    unsigned char* ws;
    DI void operator()(const f32x4 (&acc)[2][2][4][2], const pg8::Unit& u, int wr, int wc, int fr, int fq) const {
        bf16_t* P = (bf16_t*)(ws + WS_P);
        const int rbase = u.pm * 256 + wr * 64 + fr;
        const bool hi = fq >= 2;
#pragma unroll
        for (int ai = 0; ai < 2; ++ai) {
            f32x4 cs[4][4];
            const bool lat = u.pm < TL / 256;
            if (u.pn < 3 && lat) {
#pragma unroll
                for (int m = 0; m < 4; ++m) {
                    const int t = (rbase + 128 * ai + 16 * m) & (SEQ - 1), pos = (wc & 1) ? (t & 63) : (t >> 6);
                    const f32x4* tab = (const f32x4*)(ws + WS_ROPE) + (pos * 16 + 8 * (fq & 1)) / 2;
#pragma unroll
                    for (int j2 = 0; j2 < 4; ++j2) cs[m][j2] = tab[j2];
                }
            }
#pragma unroll
            for (int m = 0; m < 4; ++m) {
                const int row = rbase + 128 * ai + 16 * m;
#pragma unroll
                for (int bj = 0; bj < 2; ++bj) {
                    const int c0 = u.pn * 256 + 128 * bj + 32 * wc + 8 * fq;
                    float v[8];
#pragma unroll
                    for (int j = 0; j < 4; ++j) { v[j] = acc[ai][bj][m][0][j]; v[4 + j] = acc[ai][bj][m][1][j]; }
                    if (c0 < VOFF) {
                        const float sc = (c0 < KOFF) ? QSCALE : 1.0f;
                        u32x4 o;
#pragma unroll
                        for (int j2 = 0; j2 < 4; ++j2) {
                            const f32x4 c4 = cs[m][j2];
                            const float o0 = lane_xor32(v[2 * j2], hi), o1 = lane_xor32(v[2 * j2 + 1], hi);
                            float r0 = hi ? (v[2 * j2] * c4.x + o0 * c4.y) : (v[2 * j2] * c4.x - o0 * c4.y);
                            float r1 = hi ? (v[2 * j2 + 1] * c4.z + o1 * c4.w) : (v[2 * j2 + 1] * c4.z - o1 * c4.w);
                            if (!lat) { r0 = v[2 * j2]; r1 = v[2 * j2 + 1]; }
                            o[j2] = pk2(r0 * sc, r1 * sc);
                        }
                        *(u32x4*)(P + (size_t)row * PW + c0) = o;
                    } else if (c0 < POOLOFF) {
                        const int hk = wc >> 1, d0 = 32 * (wc & 1) + 8 * fq;
                        if (lat) { const int b = row / SEQ, t = row & (SEQ - 1);
                            bf16_t* vt = (bf16_t*)(ws + WS_VT) + ((size_t)(b * 2 + hk) * 64 + d0) * VTS + t;
#pragma unroll
                            for (int j = 0; j < 8; ++j) vt[(size_t)j * VTS] = (bf16_t)f2bf(v[j]);
                        } else { const int rc = row - TL, b = rc / NCTX, jc = rc & (NCTX - 1);
                            bf16_t* vt = (bf16_t*)(ws + WS_VTC) + ((size_t)(b * 2 + hk) * 64 + d0) * NCTX + jc;
#pragma unroll
                            for (int j = 0; j < 8; ++j) vt[(size_t)j * NCTX] = (bf16_t)f2bf(v[j]);
                        }
                    } else if (c0 < SUOFF) {
                        u32x4 o;
#pragma unroll
                        for (int j2 = 0; j2 < 4; ++j2) o[j2] = pk2(v[2 * j2], v[2 * j2 + 1]);
                        *(u32x4*)(P + (size_t)row * PW + c0) = o;
                    } else if (c0 < SVOFF) {
                        u32x4 o;
#pragma unroll
                        for (int j2 = 0; j2 < 4; ++j2) o[j2] = pk2(gelu_tanh(v[2 * j2]), gelu_tanh(v[2 * j2 + 1]));
                        *(u32x4*)(P + (size_t)row * PW + c0) = o;
                    } else {
                        const int c = c0 - SVOFF, chunk = row >> 7, q = row & 127;
                        bf16_t* vs = (bf16_t*)(ws + WS_VST) + ((size_t)chunk * 256 + c) * 128 + q;
#pragma unroll
                        for (int j = 0; j < 8; ++j) vs[j * 128] = (bf16_t)f2bf(gelu_tanh(v[j]));
                    }
                }
            }
            asm volatile("" ::: "memory");
        }
    }
};
struct SchedGrid {
    int nM, nN, G, c; const char* A; const char* B;
    int n_extra, ex_pm0, ex_pn;
    DI bool next(int i, pg8::Unit& u) const {
        const int L = i * G + c, n = nM * nN; if (L >= n + n_extra) return false;
        if (L < n) pg8::tile_of(L, nM, nN, u.pm, u.pn); else { u.pm = ex_pm0 + (L - n); u.pn = ex_pn; }
        u.sub = 0; u.nt = D / 64; u.mode = 0;
        u.a = A + (size_t)u.pm * 256 * D * 2; u.b = B + (size_t)u.pn * 256 * D * 2; return true;
    }
};

DI void phase_g1(const Params& p, const Frame& F, int l) {
    SchedGrid S{(l == 0 ? T : TL) / 256, PN / 256, F.nb, F.bid, (const char*)(p.ws + WS_H), (const char*)(p.ws + WS_WIN) + (size_t)l * INW * D * 2,
                (l == 0) ? 0 : TC / 256, TL / 256, 2};
    EpiG1 E{p.ws};
    pg8::gemm_phase(F.lds, F.tid, S, E);
}

DI bf16x8 pack8(const f32x16& x, int s) {
    u32x4 pk;
#pragma unroll
    for (int j = 0; j < 4; ++j) { f32x2 v = {x[8 * s + 2 * j], x[8 * s + 2 * j + 1]}; pk[j] = __builtin_bit_cast(unsigned, __builtin_convertvector(v, bf16x2_t)); }
    return __builtin_bit_cast(bf16x8, pk);
}

DI float lane_x32(float v, bool hi) { const auto r = __builtin_amdgcn_permlane32_swap(__builtin_bit_cast(unsigned, v), __builtin_bit_cast(unsigned, v), false, false);
    return __builtin_bit_cast(float, hi ? r[0] : r[1]); }
struct AttnFrags { bf16x8 kf[4]; s16x4 vf[2][4]; };
DI void attn_block(const bf16x8 (&qf)[4], const AttnFrags& f, int mask_mode, int kq_off, int lane, float& m, float& lpart, f32x16 (&o)[2]) {
    const int h = lane >> 5;
    f32x16 st;
#pragma unroll
    for (int r = 0; r < 16; ++r) st[r] = 0.f;
#pragma unroll
    for (int s = 0; s < 4; ++s) st = MFMA32(f.kf[s], qf[s], st);
    if (mask_mode) {
#pragma unroll
        for (int r = 0; r < 16; ++r) { const int dlt = kq_off + crow(r, h); if (dlt > 128 || dlt < -128) st[r] = -1e30f; }
    }
    float bm = st[0];
#pragma unroll
    for (int r = 1; r < 16; ++r) bm = fmaxf(bm, st[r]);
    bm = fmaxf(bm, lane_x32(bm, h != 0));
    const float mn = fmaxf(m, bm);
    if (__builtin_amdgcn_ballot_w64(mn > m) != 0ull) {
        const float alpha = __builtin_amdgcn_exp2f(m - mn);
        lpart *= alpha;
#pragma unroll
        for (int d = 0; d < 2; ++d)
#pragma unroll
            for (int r = 0; r < 16; ++r) o[d][r] *= alpha;
        m = mn;
    }
    float ps = 0.f;
#pragma unroll
    for (int r = 0; r < 16; ++r) { st[r] = __builtin_amdgcn_exp2f(st[r] - m); ps += st[r]; }
    lpart += ps;
    const bf16x8 pf0 = pack8(st, 0), pf1 = pack8(st, 1);
#pragma unroll
    for (int d = 0; d < 2; ++d) {
        const bf16x8 v0 = __builtin_shufflevector(f.vf[d][0], f.vf[d][1], 0, 1, 2, 3, 4, 5, 6, 7), v1 = __builtin_shufflevector(f.vf[d][2], f.vf[d][3], 0, 1, 2, 3, 4, 5, 6, 7);
        o[d] = MFMA32(v0, pf0, o[d]);
        o[d] = MFMA32(v1, pf1, o[d]);
    }
}

constexpr int AKP = 144, AVWP = 648, AVCP = 520;
constexpr int ALDS_KW = 0, ALDS_VW = ALDS_KW + 320 * AKP, ALDS_KC = ALDS_VW + 64 * AVWP, ALDS_VC = ALDS_KC + 256 * AKP, ALDS_END = ALDS_VC + 64 * AVCP;
static_assert(ALDS_END <= LDS_BAR_OFF && (ALDS_VW % 16) == 0 && (ALDS_KC % 16) == 0 && (ALDS_VC % 8) == 0, "attention LDS map");
DI void attn_lds_frags(AttnFrags& f, const LAS unsigned char* kp, const LAS unsigned char* vp, int vpitch32) {
#pragma unroll
    for (int s = 0; s < 4; ++s) f.kf[s] = *(const LAS bf16x8*)(kp + 32 * s);
#pragma unroll
    for (int d = 0; d < 2; ++d)
#pragma unroll
        for (int q = 0; q < 4; ++q) f.vf[d][q] = *(const LAS s16x4*)(vp + d * vpitch32 + 16 * q);
}
DI void attn_unit(const Params& p, const Frame& F, int l, int unit) {
    const int lane = F.lane, r = lane & 31, h = lane >> 5, tid = F.tid;
    const bf16_t* P = (const bf16_t*)(p.ws + WS_P);
    const bf16_t* VT = (const bf16_t*)(p.ws + WS_VT);
    const bf16_t* VTC = (const bf16_t*)(p.ws + WS_VTC);
    bf16_t* Y = (bf16_t*)(p.ws + WS_Y);
    const bool latent = unit < 1024;
    int b, hk, p0, q0row;
    if (latent) { const int pb = unit & 63; hk = (unit >> 6) & 1; b = unit >> 7; p0 = pb * 64; q0row = b * SEQ + p0; }
    else { const int u2 = unit - 1024, pb = u2 & 3; hk = (u2 >> 2) & 1; b = u2 >> 3; p0 = pb * 64; q0row = TL + b * NCTX + p0; }
    const int w0 = p0 - 128;
    u32x4 kw[5], vw[5], kc[4], vc[4];
    if (latent) {
#pragma unroll
        for (int it = 0; it < 5; ++it) {
            const int i = tid + it * NTHREADS, row = i >> 3, ck = i & 7, pos = min(max(w0 + row, 0), SEQ - 1);
            kw[it] = *(const u32x4*)(P + (size_t)(b * SEQ + pos) * PW + KOFF + hk * 64 + 8 * ck);
            const int d = i / 40, cv = i % 40, pv = min(max(w0 + 8 * cv, 0), SEQ - 8);
            vw[it] = *(const u32x4*)(VT + ((size_t)(b * 2 + hk) * 64 + d) * VTS + pv);
        }
    }
#pragma unroll
    for (int it = 0; it < 4; ++it) {
        const int i = tid + it * NTHREADS;
        kc[it] = *(const u32x4*)(P + (size_t)(TL + b * NCTX + (i >> 3)) * PW + KOFF + hk * 64 + 8 * (i & 7));
        vc[it] = *(const u32x4*)(VTC + ((size_t)(b * 2 + hk) * 64 + (i >> 5)) * NCTX + 8 * (i & 31));
    }
    __syncthreads();
    if (latent) {
#pragma unroll
        for (int it = 0; it < 5; ++it) {
            const int i = tid + it * NTHREADS, row = i >> 3, ck = i & 7;
            *(LAS u32x4*)(F.lds + ALDS_KW + row * AKP + 16 * ck) = kw[it];
            const int d = i / 40, cv = i % 40;
            LAS u32x2* dst = (LAS u32x2*)(F.lds + ALDS_VW + d * AVWP + 16 * cv); dst[0] = (u32x2){vw[it].x, vw[it].y}; dst[1] = (u32x2){vw[it].z, vw[it].w};
        }
    }
#pragma unroll
    for (int it = 0; it < 4; ++it) {
        const int i = tid + it * NTHREADS;
        *(LAS u32x4*)(F.lds + ALDS_KC + (i >> 3) * AKP + 16 * (i & 7)) = kc[it];
        LAS u32x2* dst = (LAS u32x2*)(F.lds + ALDS_VC + (i >> 5) * AVCP + 16 * (i & 31)); dst[0] = (u32x2){vc[it].x, vc[it].y}; dst[1] = (u32x2){vc[it].z, vc[it].w};
    }
    const int head = 4 * hk + (F.wave & 3), ph = F.wave >> 2, pw = p0 + 32 * ph, qrow = q0row + 32 * ph;
    bf16x8 qf[4];
#pragma unroll
    for (int s = 0; s < 4; ++s) qf[s] = *(const bf16x8*)(P + (size_t)(qrow + r) * PW + head * 64 + 16 * s + 8 * h);
    float m = p.in[I_attn_sink][l * 8 + head] * LOG2E, lpart = (h == 0) ? 1.0f : 0.0f;
    f32x16 o[2];
#pragma unroll
    for (int d = 0; d < 2; ++d)
#pragma unroll
        for (int i = 0; i < 16; ++i) o[d][i] = 0.f;
    __syncthreads();
    if (latent) {
#pragma unroll 1
        for (int j = 0; j < 9; ++j) {
            const int kb = pw - 128 + 32 * j;
            if (kb < 0 || kb >= SEQ) continue;
            const int krow = kb - w0;
            AttnFrags f;
            attn_lds_frags(f, F.lds + ALDS_KW + (krow + r) * AKP + 16 * h, F.lds + ALDS_VW + r * AVWP + 2 * krow + 8 * h, 32 * AVWP);
            attn_block(qf, f, (j == 0 || j == 8) ? 1 : 0, kb - (pw + r), lane, m, lpart, o);
        }
    }
#pragma unroll 1
    for (int j = 0; j < 8; ++j) {
        AttnFrags f;
        attn_lds_frags(f, F.lds + ALDS_KC + (32 * j + r) * AKP + 16 * h, F.lds + ALDS_VC + r * AVCP + 64 * j + 8 * h, 32 * AVCP);
        attn_block(qf, f, 0, 0, lane, m, lpart, o);
    }
    const float inv = 1.0f / (lpart + lane_x32(lpart, h != 0));
    bf16_t* yrow = Y + (size_t)(qrow + r) * D + head * 64;
#pragma unroll
    for (int d = 0; d < 2; ++d)
#pragma unroll
        for (int g = 0; g < 4; ++g) {
            u32x2 w; w.x = pk2(o[d][4 * g] * inv, o[d][4 * g + 1] * inv); w.y = pk2(o[d][4 * g + 2] * inv, o[d][4 * g + 3] * inv);
            *(u32x2*)(yrow + 32 * d + 8 * g + 4 * h) = w;
        }
}

DI void sgu_unit(const Params& p, const Frame& F, int l, int chunk) {
    constexpr int VS = 136;
    LAS float* part = (LAS float*)F.lds;
    LAS float* rq = part + 512;
    LAS bf16_t* vnT = (LAS bf16_t*)(F.lds + 4096);
    const bf16_t* VsT = (const bf16_t*)(p.ws + WS_VST) + (size_t)chunk * 256 * 128;
    const bf16_t* P = (const bf16_t*)(p.ws + WS_P);
    bf16_t* Y = (bf16_t*)(p.ws + WS_Y);
    __syncthreads();
    { const int q = F.tid & 127, part_i = F.tid >> 7; float ss = 0.f;
#pragma unroll 16
        for (int c = part_i * 64; c < part_i * 64 + 64; ++c) { const float v = bf2f(VsT[c * 128 + q]); ss += v * v; }
        part[part_i * 128 + q] = ss; }
    __syncthreads();
    if (F.tid < 128) rq[F.tid] = rsqrtf((part[F.tid] + part[128 + F.tid] + part[256 + F.tid] + part[384 + F.tid]) * (1.0f / 256.0f) + EPS);
    __syncthreads();
#pragma unroll
    for (int it = 0; it < 8; ++it) {
        const int i = F.tid + it * NTHREADS;
        const int c = i >> 4, q8 = (i & 15) * 8;
        const u32x4 v = *(const u32x4*)(VsT + c * 128 + q8);
        u32x4 o;
#pragma unroll
        for (int j = 0; j < 4; ++j) o[j] = pk2(bflo(v[j]) * rq[q8 + 2 * j], bfhi(v[j]) * rq[q8 + 2 * j + 1]);
        *(LAS u32x4*)(vnT + c * VS + q8) = o;
    }
    __syncthreads();
    const int lane = F.lane, r = lane & 31, h = lane >> 5, g = F.wave >> 1, ph = F.wave & 1;
    const bf16_t* Wg = (const bf16_t*)(p.ws + WS_SGUW) + ((size_t)l * 4 + g) * 128 * 128;
#pragma unroll 1
    for (int pb = 0; pb < 2; ++pb) {
        const int p0 = 64 * ph + 32 * pb;
        const int row = chunk * 128 + p0 + r;
        bf16x8 wf[8];
#pragma unroll
        for (int s = 0; s < 8; ++s) wf[s] = *(const bf16x8*)(Wg + (size_t)(p0 + r) * 128 + 16 * s + 8 * h);
        u32x2 uu[2][4];
#pragma unroll
        for (int cb = 0; cb < 2; ++cb)
#pragma unroll
            for (int q4 = 0; q4 < 4; ++q4) uu[cb][q4] = *(const u32x2*)(P + (size_t)row * PW + SUOFF + 64 * g + 32 * cb + 8 * q4 + 4 * h);
        const float bias = p.in[I_sgu_b][(l * 4 + g) * 128 + p0 + r];
#pragma unroll
        for (int cb = 0; cb < 2; ++cb) {
            const int c0 = 64 * g + 32 * cb;
            f32x16 acc;
#pragma unroll
            for (int i = 0; i < 16; ++i) acc[i] = 0.f;
#pragma unroll
            for (int s = 0; s < 8; ++s) {
                const bf16x8 a = *(const LAS bf16x8*)(vnT + (c0 + r) * VS + 16 * s + 8 * h);
                acc = MFMA32(a, wf[s], acc);
            }
#pragma unroll
            for (int q4 = 0; q4 < 4; ++q4) {
                const int cc = c0 + 8 * q4 + 4 * h;
                const u32x2 u = uu[cb][q4];
                u32x2 w;
                w.x = pk2(bflo(u.x) * (acc[4 * q4] + bias), bfhi(u.x) * (acc[4 * q4 + 1] + bias));
                w.y = pk2(bflo(u.y) * (acc[4 * q4 + 2] + bias), bfhi(u.y) * (acc[4 * q4 + 3] + bias));
                *(u32x2*)(Y + (size_t)row * D + 768 + cc) = w;
            }
        }
    }
}

DI void phase_mix(const Params& p, const Frame& F, int l, int ctr_slot = 0) {
    (void)ctr_slot;
    const int nrows = (l == 0) ? T : TL;
    const bf16_t* P = (const bf16_t*)(p.ws + WS_P);
    bf16_t* Y = (bf16_t*)(p.ws + WS_Y);
    for (int i0 = F.bid * NTHREADS; i0 < 4 * nrows * 8; i0 += F.nb * NTHREADS) {
        const int i = i0 + F.tid, g = i / (nrows * 8), rem = i - g * (nrows * 8), row = rem >> 3, ck = g * 8 + (rem & 7);
        int base, t, len;
        if (row < TL) { base = row & ~(SEQ - 1); t = row & (SEQ - 1); len = SEQ; } else { const int rc = row - TL; base = TL + (rc & ~(NCTX - 1)); t = rc & (NCTX - 1); len = NCTX; }
        float s[8];
#pragma unroll
        for (int j = 0; j < 8; ++j) s[j] = 0.f;
        const bf16_t* zc = P + POOLOFF + ck * 8;
#define POOL_WIN(HALF) do { _Pragma("unroll") for (int dt = -(HALF); dt < (HALF); ++dt) { const int tt = t + dt; const bool ok = tt >= 0 && tt < len; \
            const u32x4 v = *(const u32x4*)(zc + (size_t)(base + (ok ? tt : t)) * PW); const float w = ok ? 1.f : 0.f; \
            _Pragma("unroll") for (int j = 0; j < 4; ++j) { s[2 * j] += w * bflo(v[j]); s[2 * j + 1] += w * bfhi(v[j]); } } } while (0)
        int half;
        if (g == 0) { POOL_WIN(1); half = 1; } else if (g == 1) { POOL_WIN(2); half = 2; } else if (g == 2) { POOL_WIN(4); half = 4; } else { POOL_WIN(8); half = 8; }
#undef POOL_WIN
        const int lo = max(t - half, 0), hi = min(t + half, len);
        const float inv = 1.0f / (float)(hi - lo);
        const u32x4 z = *(const u32x4*)(zc + (size_t)row * PW);
        u32x4 o;
#pragma unroll
        for (int j = 0; j < 4; ++j) o[j] = pk2(s[2 * j] * inv - bflo(z[j]), s[2 * j + 1] * inv - bfhi(z[j]));
        *(u32x4*)(Y + (size_t)row * D + 512 + ck * 8) = o;
    }
    const int nchunk = (l == 0) ? T / 128 : TL / 128;
    for (int ch = F.bid; ch < nchunk; ch += F.nb) sgu_unit(p, F, l, ch);
    const int nunit = (l == 0) ? 1024 + 64 : 1024;
    for (int u = F.nb - 1 - F.bid; u < nunit; u += F.nb) attn_unit(p, F, l, u);
}

struct EpiGate {
    static constexpr bool PERM = true;
    DI bool keeps(const pg8::Unit&) const { return false; }
    unsigned char* G8;
    DI void operator()(const f32x4 (&acc)[2][2][4][2], const pg8::Unit& u, int wr, int wc, int fr, int fq) const {
#pragma unroll
        for (int ai = 0; ai < 2; ++ai)
#pragma unroll
            for (int m = 0; m < 4; ++m) {
                unsigned char* rowp = G8 + (size_t)(u.pm * 256 + 128 * ai + 64 * wr + 16 * m + fr) * 3072 + u.pn * 256 + 32 * wc + 8 * fq;
#pragma unroll
                for (int bj = 0; bj < 2; ++bj) {
                    u32x2 w;
#pragma unroll
                    for (int n = 0; n < 2; ++n) { unsigned q = 0;
                        q = __builtin_amdgcn_cvt_pk_u8_f32(fmaxf(__builtin_rintf(255.0f * sigmoidf_(acc[ai][bj][m][n][0])), 1.0f), 0, q);
                        q = __builtin_amdgcn_cvt_pk_u8_f32(fmaxf(__builtin_rintf(255.0f * sigmoidf_(acc[ai][bj][m][n][1])), 1.0f), 1, q);
                        q = __builtin_amdgcn_cvt_pk_u8_f32(fmaxf(__builtin_rintf(255.0f * sigmoidf_(acc[ai][bj][m][n][2])), 1.0f), 2, q);
                        q = __builtin_amdgcn_cvt_pk_u8_f32(fmaxf(__builtin_rintf(255.0f * sigmoidf_(acc[ai][bj][m][n][3])), 1.0f), 3, q);
                        w[n] = q; }
                    *(u32x2*)(rowp + 128 * bj) = w;
                }
            }
    }
};
DI void phase_g2a(const Params& p, const Frame& F, int l) {
    SchedGrid S{(l == 0 ? T : TL) / 256, 3072 / 256, F.nb, F.bid, (const char*)(p.ws + WS_H), (const char*)(p.ws + WS_WIN) + ((size_t)l * INW + GATEOFF) * D * 2, 0, 0, 0};
    EpiGate E{p.ws + WS_G8};
    pg8::gemm_phase(F.lds, F.tid, S, E);
}
struct SchedG2 {
    int G, c; const char *Y, *Wb; int npair;
    DI void fill(pg8::Unit& u, int br) const {
        const int koff = (br == 0) ? 0 : (br == 1 ? 512 : 768); u.nt = (br == 0) ? 8 : 4; u.sub = br;
        u.a = Y + ((size_t)u.pm * 256 * D + koff) * 2; u.b = Wb + ((size_t)u.pn * 256 * D + koff) * 2;
    }
    DI bool next(int i, pg8::Unit& u) const {
        constexpr int NLAT = (TL / 256) * 4;
        const int nl = (NLAT - c + G - 1) / G;
        if (i < 3 * nl) { const int tile = (i / 3) * G + c; pg8::tile_of(tile, TL / 256, 4, u.pm, u.pn); u.mode = 0; fill(u, i % 3); return true; }
        const int j = (i - 3 * nl) * G + c;
        if (j >= npair) return false;
        const int ctile = j / 3, br = j % 3;
        u.pm = TL / 256 + (ctile >> 2); u.pn = ctile & 3; u.mode = 1 + br; fill(u, br); return true;
    }
};
struct EpiG2 {
    static constexpr bool PERM = true;
    const unsigned char* G8; bf16_t* M; bf16_t* MP;
    DI bool keeps(const pg8::Unit& u) const { return u.mode == 0 && u.sub < 2; }
    DI void operator()(f32x4 (&acc)[2][2][4][2], const pg8::Unit& u, int wr, int wc, int fr, int fq) const {
        const bool mid = u.mode == 0 && u.sub < 2;
        bf16_t* Mo = (u.mode == 0) ? M + (size_t)u.pm * 256 * D : MP + ((size_t)(u.mode - 1) * TC + (size_t)(u.pm - TL / 256) * 256) * D;
        const unsigned char* gb = G8 + (size_t)u.pm * 256 * 3072 + u.sub * 1024 + u.pn * 256;
#pragma unroll
        for (int ai = 0; ai < 2; ++ai) {
            u32x2 g0[4][2], g1[4][2];
#pragma unroll
            for (int m = 0; m < 4; ++m)
#pragma unroll
                for (int bj = 0; bj < 2; ++bj) {
                    const int rl = 128 * ai + 64 * wr + 16 * m + fr, cl = 128 * bj + 32 * wc + 8 * fq;
                    g0[m][bj] = *(const u32x2*)(gb + (size_t)rl * 3072 + cl);
                    if (mid) g1[m][bj] = *(const u32x2*)(gb + (size_t)rl * 3072 + 1024 + cl);
                }
#pragma unroll
            for (int m = 0; m < 4; ++m)
#pragma unroll
                for (int bj = 0; bj < 2; ++bj) {
                    const int rl = 128 * ai + 64 * wr + 16 * m + fr, cl = 128 * bj + 32 * wc + 8 * fq;
                    if (mid) {
#pragma unroll
                        for (int n = 0; n < 2; ++n)
#pragma unroll
                            for (int e = 0; e < 4; ++e) {
                                const float a = (float)((g0[m][bj][n] >> (8 * e)) & 0xffu), b = (float)((g1[m][bj][n] >> (8 * e)) & 0xffu);
                                acc[ai][bj][m][n][e] *= a * __builtin_amdgcn_rcpf(b);
                            }
                    } else {
                        u32x4 w;
#pragma unroll
                        for (int j2 = 0; j2 < 4; ++j2) { const int n = j2 >> 1, e = 2 * (j2 & 1);
                            const float a0 = (float)((g0[m][bj][n] >> (8 * e)) & 0xffu) * (1.0f / 255.0f), a1 = (float)((g0[m][bj][n] >> (8 * e + 8)) & 0xffu) * (1.0f / 255.0f);
                            w[j2] = pk2(acc[ai][bj][m][n][e] * a0, acc[ai][bj][m][n][e + 1] * a1); }
                        *(u32x4*)(Mo + (size_t)rl * D + u.pn * 256 + cl) = w;
                    }
                }
            asm volatile("" ::: "memory");
        }
    }
};
DI void phase_g2(const Params& p, const Frame& F, int l) {
    SchedG2 S{F.nb, F.bid, (const char*)(p.ws + WS_Y), (const char*)(p.ws + WS_WBR) + (size_t)l * D * D * 2, (l == 0) ? (TC / 256) * 4 * 3 : 0};
    EpiG2 E{p.ws + WS_G8, (bf16_t*)(p.ws + WS_MERGED), (bf16_t*)(p.ws + WS_MP)};
    pg8::gemm_phase(F.lds, F.tid, S, E);
}
DI void phase_g2sum(const Params& p, const Frame& F) {
    const u32x4* mp = (const u32x4*)(p.ws + WS_MP);
    u32x4* mo = (u32x4*)((bf16_t*)(p.ws + WS_MERGED) + (size_t)TL * D);
    constexpr int NV = TC * D / 8;
    for (int i = F.gtid; i < NV; i += F.ngt) {
        const u32x4 a = mp[i], b = mp[NV + i], c = mp[2 * NV + i];
        u32x4 o;
#pragma unroll
        for (int j = 0; j < 4; ++j) o[j] = pk2(bflo(a[j]) + bflo(b[j]) + bflo(c[j]), bfhi(a[j]) + bfhi(b[j]) + bfhi(c[j]));
        mo[i] = o;
    }
}

struct EpiG3 {
    DI bool keeps(const pg8::Unit&) const { return false; }
    static constexpr bool PERM = false;
    const float* xsrc; float* xdst; const float* csrc; float* cdst; const float* mod;
    DI void operator()(const f32x4 (&acc)[2][2][4][2], const pg8::Unit& u, int wr, int wc, int fr, int fq) const {
        const int col0 = u.pn * 256 + wc * 32 + 4 * fq;
        const bool lat = u.pm < TL / 256;
        const float* gt = mod + (size_t)(lat ? (u.pm >> 4) : 8) * NMOD + 2 * D;
        const float* xs = lat ? xsrc + (size_t)u.pm * 256 * D : csrc + (size_t)(u.pm - TL / 256) * 256 * D;
        float* xd = lat ? xdst + (size_t)u.pm * 256 * D : cdst + (size_t)(u.pm - TL / 256) * 256 * D;
        f32x4 gv[2][2];
#pragma unroll
        for (int bj = 0; bj < 2; ++bj)
#pragma unroll
            for (int n = 0; n < 2; ++n) gv[bj][n] = *(const f32x4*)(gt + col0 + 128 * bj + 16 * n);
#pragma unroll
        for (int ai = 0; ai < 2; ++ai) {
            f32x4 xv[4][2][2];
#pragma unroll
            for (int m = 0; m < 4; ++m)
#pragma unroll
                for (int bj = 0; bj < 2; ++bj)
#pragma unroll
                    for (int n = 0; n < 2; ++n) xv[m][bj][n] = *(const f32x4*)(xs + (size_t)(wr * 64 + fr + 128 * ai + 16 * m) * D + col0 + 128 * bj + 16 * n);
#pragma unroll
            for (int m = 0; m < 4; ++m)
#pragma unroll
                for (int bj = 0; bj < 2; ++bj)
#pragma unroll
                    for (int n = 0; n < 2; ++n)
                        *(f32x4*)(xd + (size_t)(wr * 64 + fr + 128 * ai + 16 * m) * D + col0 + 128 * bj + 16 * n) = xv[m][bj][n] + gv[bj][n] * acc[ai][bj][m][n];
            asm volatile("" ::: "memory");
        }
    }
};
DI void phase_g3(const Params& p, const Frame& F, int l) {
    SchedGrid S{(l == 0 ? T : TL) / 256, D / 256, F.nb, F.bid, (const char*)(p.ws + WS_MERGED), (const char*)(p.ws + WS_WOUT) + (size_t)l * D * D * 2, 0, 0, 0};
    float* xc = (float*)(p.ws + WS_XCTX);
    EpiG3 E{(l == 0) ? p.in[I_x] : p.out, p.out, (l == 0) ? p.in[I_ctx] : xc, xc, (const float*)(p.ws + WS_MOD) + (size_t)l * 9 * NMOD};
    pg8::gemm_phase(F.lds, F.tid, S, E);
}

struct EpiG45 {
    DI bool keeps(const pg8::Unit&) const { return false; }
    static constexpr bool PERM = true;
    unsigned short* ST;
    DI void operator()(const f32x4 (&acc)[2][2][4][2], const pg8::Unit& u, int wr, int wc, int fr, int fq) const {
        const int col0 = u.pn * 256 + wc * 32 + 8 * fq;
#pragma unroll
        for (int ai = 0; ai < 2; ++ai)
#pragma unroll
            for (int m = 0; m < 4; ++m) {
                unsigned short* rowp = ST + (size_t)(u.pm * 256 + wr * 64 + fr + 128 * ai + 16 * m) * T + col0;
#pragma unroll
                for (int bj = 0; bj < 2; ++bj) {
                    u32x4 w;
                    w.x = pkh2(acc[ai][bj][m][0][0], acc[ai][bj][m][0][1]); w.y = pkh2(acc[ai][bj][m][0][2], acc[ai][bj][m][0][3]);
                    w.z = pkh2(acc[ai][bj][m][1][0], acc[ai][bj][m][1][1]); w.w = pkh2(acc[ai][bj][m][1][2], acc[ai][bj][m][1][3]);
                    *(u32x4*)(rowp + 128 * bj) = w;
                }
            }
    }
};
DI void phase_g45(const Params& p, const Frame& F, int l) {
    SchedGrid S{2048 / 256, (l == 0 ? T : TL) / 256, F.nb, F.bid, (const char*)(p.ws + WS_WFOLD) + (size_t)l * 2048 * D * 2, (const char*)(p.ws + WS_H), 0, 0, 0};
    EpiG45 E{(unsigned short*)(p.ws + WS_ST)};
    pg8::gemm_phase(F.lds, F.tid, S, E);
}

DI unsigned fkey(float f) { const unsigned u = __builtin_bit_cast(unsigned, f); return (u & 0x80000000u) ? ~u : (u | 0x80000000u); }
DI float fkey_inv(unsigned k) { const unsigned u = (k & 0x80000000u) ? (k & 0x7fffffffu) : ~k; return __builtin_bit_cast(float, u); }
#define INSERT16(L, x) do { unsigned x_ = (x); _Pragma("unroll") for (int k_ = 0; k_ < 16; ++k_) { const unsigned hi_ = max(L[k_], x_); x_ = min(L[k_], x_); L[k_] = hi_; } } while (0)
#define CEX(a, b) do { const unsigned hi_ = max(a, b), lo_ = min(a, b); a = hi_; b = lo_; } while (0)
DI void sort16_desc(unsigned (&v)[16]) {
    CEX(v[0], v[1]); CEX(v[2], v[3]); CEX(v[0], v[2]); CEX(v[1], v[3]); CEX(v[1], v[2]); CEX(v[4], v[5]); CEX(v[6], v[7]); CEX(v[4], v[6]); CEX(v[5], v[7]); CEX(v[5], v[6]); CEX(v[0], v[4]); CEX(v[2], v[6]); CEX(v[2], v[4]); CEX(v[1], v[5]); CEX(v[3], v[7]); CEX(v[3], v[5]); CEX(v[1], v[2]); CEX(v[3], v[4]); CEX(v[5], v[6]); CEX(v[8], v[9]); CEX(v[10], v[11]); CEX(v[8], v[10]); CEX(v[9], v[11]); CEX(v[9], v[10]); CEX(v[12], v[13]); CEX(v[14], v[15]); CEX(v[12], v[14]); CEX(v[13], v[15]); CEX(v[13], v[14]); CEX(v[8], v[12]); CEX(v[10], v[14]); CEX(v[10], v[12]); CEX(v[9], v[13]); CEX(v[11], v[15]); CEX(v[11], v[13]); CEX(v[9], v[10]); CEX(v[11], v[12]); CEX(v[13], v[14]); CEX(v[0], v[8]); CEX(v[4], v[12]); CEX(v[4], v[8]); CEX(v[2], v[10]); CEX(v[6], v[14]); CEX(v[6], v[10]); CEX(v[2], v[4]); CEX(v[6], v[8]); CEX(v[10], v[12]); CEX(v[1], v[9]); CEX(v[5], v[13]); CEX(v[5], v[9]); CEX(v[3], v[11]); CEX(v[7], v[15]); CEX(v[7], v[11]); CEX(v[3], v[5]); CEX(v[7], v[9]); CEX(v[11], v[13]); CEX(v[1], v[2]); CEX(v[3], v[4]); CEX(v[5], v[6]); CEX(v[7], v[8]); CEX(v[9], v[10]); CEX(v[11], v[12]); CEX(v[13], v[14]);
}
DI void merge16_desc(unsigned (&L)[16], const unsigned (&N)[16]) {
#pragma unroll
    for (int i = 0; i < 16; ++i) L[i] = max(L[i], N[15 - i]);
#pragma unroll
    for (int j = 8; j > 0; j >>= 1)
#pragma unroll
        for (int i = 0; i < 16; ++i) { const int q = i ^ j; if (q > i) CEX(L[i], L[q]); }
}
DI void phase_sel(const Params& p, const Frame& F, int l) {
    const _Float16* ST = (const _Float16*)(p.ws + WS_ST);
    unsigned short* IDX = (unsigned short*)(p.ws + WS_IDX);
    float* GW = (float*)(p.ws + WS_GW);
    float* SU = (float*)(p.ws + WS_SU);
    const float* TSC = (const float*)(p.ws + WS_TSCALE) + (size_t)l * 2 * NEXP;
    LAS unsigned char* ib = (LAS unsigned char*)F.lds;
    const int ntok = (l == 0) ? T : TL;
    for (int i0 = F.bid * NTHREADS; i0 < ntok * 8; i0 += F.nb * NTHREADS) {
        const int i = i0 + F.tid;
        const int tok = i % ntok, head = i / ntok;
        unsigned la[16], lb[16];
#pragma unroll
        for (int k = 0; k < 16; ++k) { la[k] = 0u; lb[k] = 0u; }
        const _Float16* s0 = ST + (size_t)(head * 256) * T + tok;
#define SEL_LOAD(B_, k0_) do { _Pragma("unroll") for (int j = 0; j < 32; ++j) B_[j] = sp[(size_t)((k0_) + j) * T]; } while (0)
#define SEL_KEY(x_, low_) ((((unsigned)(x_) ^ ((unsigned)(((int)((unsigned)(x_) << 16)) >> 31) | 0x8000u)) << 16) | (unsigned)(low_))
#define SEL_GRP(L_, B_, o_, k0_) do { unsigned nk_[16]; \
        _Pragma("unroll") for (int j = 0; j < 16; ++j) nk_[j] = SEL_KEY(B_[(o_) + j], 127 - ((k0_) + j)); \
        sort16_desc(nk_); merge16_desc(L_, nk_); } while (0)
#define SEL_HALF(L_, base_) do { const unsigned short* sp = (const unsigned short*)s0 + (size_t)(base_) * T; unsigned short bufa[32], bufb[32]; \
        SEL_LOAD(bufa, 0); \
        _Pragma("unroll 1") for (int k0 = 0; k0 < 128; k0 += 64) { \
            SEL_LOAD(bufb, k0 + 32); SEL_GRP(L_, bufa, 0, k0); SEL_GRP(L_, bufa, 16, k0 + 16); \
            SEL_LOAD(bufa, (k0 + 64) & 127); SEL_GRP(L_, bufb, 0, k0 + 32); SEL_GRP(L_, bufb, 16, k0 + 48); } } while (0)
        SEL_HALF(la, 0);
        SEL_HALF(lb, 128);
#undef SEL_LOAD
#undef SEL_KEY
#undef SEL_GRP
#undef SEL_HALF
        float va[16], vb[16];
#define SEL_VAL(key_) ((float)__builtin_bit_cast(_Float16, (unsigned short)(((key_) >> 16) ^ 0xffffu ^ ((unsigned)((int)(key_) >> 31) & 0x7fffu))))
#pragma unroll
        for (int k = 0; k < 16; ++k) {
            va[k] = SEL_VAL(la[k]); vb[k] = SEL_VAL(lb[k]);
            ib[k * NTHREADS + F.tid] = (unsigned char)(127u - (la[k] & 127u));
            ib[(16 + k) * NTHREADS + F.tid] = (unsigned char)(127u - (lb[k] & 127u));
        }
#undef SEL_VAL
        unsigned lc[16];
        { lc[0] = (fkey(va[0] + vb[0]) & ~255u) | 255u; lc[1] = (fkey(va[0] + vb[1]) & ~255u) | 254u; lc[2] = (fkey(va[0] + vb[2]) & ~255u) | 253u; lc[3] = (fkey(va[0] + vb[3]) & ~255u) | 252u; lc[4] = (fkey(va[0] + vb[4]) & ~255u) | 251u; lc[5] = (fkey(va[0] + vb[5]) & ~255u) | 250u; lc[6] = (fkey(va[0] + vb[6]) & ~255u) | 249u; lc[7] = (fkey(va[0] + vb[7]) & ~255u) | 248u; lc[8] = (fkey(va[0] + vb[8]) & ~255u) | 247u; lc[9] = (fkey(va[0] + vb[9]) & ~255u) | 246u; lc[10] = (fkey(va[0] + vb[10]) & ~255u) | 245u; lc[11] = (fkey(va[0] + vb[11]) & ~255u) | 244u; lc[12] = (fkey(va[0] + vb[12]) & ~255u) | 243u; lc[13] = (fkey(va[0] + vb[13]) & ~255u) | 242u; lc[14] = (fkey(va[0] + vb[14]) & ~255u) | 241u; lc[15] = (fkey(va[0] + vb[15]) & ~255u) | 240u; }
        sort16_desc(lc);
        { unsigned cg1[16]; cg1[0] = (fkey(va[1] + vb[0]) & ~255u) | 239u; cg1[1] = (fkey(va[1] + vb[1]) & ~255u) | 238u; cg1[2] = (fkey(va[1] + vb[2]) & ~255u) | 237u; cg1[3] = (fkey(va[1] + vb[3]) & ~255u) | 236u; cg1[4] = (fkey(va[1] + vb[4]) & ~255u) | 235u; cg1[5] = (fkey(va[1] + vb[5]) & ~255u) | 234u; cg1[6] = (fkey(va[1] + vb[6]) & ~255u) | 233u; cg1[7] = (fkey(va[1] + vb[7]) & ~255u) | 232u; cg1[8] = (fkey(va[2] + vb[0]) & ~255u) | 223u; cg1[9] = (fkey(va[2] + vb[1]) & ~255u) | 222u; cg1[10] = (fkey(va[2] + vb[2]) & ~255u) | 221u; cg1[11] = (fkey(va[2] + vb[3]) & ~255u) | 220u; cg1[12] = (fkey(va[2] + vb[4]) & ~255u) | 219u; cg1[13] = (fkey(va[3] + vb[0]) & ~255u) | 207u; cg1[14] = (fkey(va[3] + vb[1]) & ~255u) | 206u; cg1[15] = (fkey(va[3] + vb[2]) & ~255u) | 205u; sort16_desc(cg1); merge16_desc(lc, cg1); }
        { unsigned cg2[16]; cg2[0] = (fkey(va[3] + vb[3]) & ~255u) | 204u; cg2[1] = (fkey(va[4] + vb[0]) & ~255u) | 191u; cg2[2] = (fkey(va[4] + vb[1]) & ~255u) | 190u; cg2[3] = (fkey(va[4] + vb[2]) & ~255u) | 189u; cg2[4] = (fkey(va[5] + vb[0]) & ~255u) | 175u; cg2[5] = (fkey(va[5] + vb[1]) & ~255u) | 174u; cg2[6] = (fkey(va[6] + vb[0]) & ~255u) | 159u; cg2[7] = (fkey(va[6] + vb[1]) & ~255u) | 158u; cg2[8] = (fkey(va[7] + vb[0]) & ~255u) | 143u; cg2[9] = (fkey(va[7] + vb[1]) & ~255u) | 142u; cg2[10] = (fkey(va[8] + vb[0]) & ~255u) | 127u; cg2[11] = (fkey(va[9] + vb[0]) & ~255u) | 111u; cg2[12] = (fkey(va[10] + vb[0]) & ~255u) | 95u; cg2[13] = (fkey(va[11] + vb[0]) & ~255u) | 79u; cg2[14] = (fkey(va[12] + vb[0]) & ~255u) | 63u; cg2[15] = (fkey(va[13] + vb[0]) & ~255u) | 47u; sort16_desc(cg2); merge16_desc(lc, cg2); }
        { const unsigned key = (fkey(va[14] + vb[0]) & ~255u) | 31u; INSERT16(lc, key); }
        { const unsigned key = (fkey(va[15] + vb[0]) & ~255u) | 15u; INSERT16(lc, key); }
        float e[16], sum = 0.f; const float v0 = fkey_inv(lc[0] & ~255u);
#pragma unroll
        for (int k = 0; k < 16; ++k) { e[k] = __expf(fkey_inv(lc[k] & ~255u) - v0); sum += e[k]; }
        const float inv = 1.0f / sum;
        asm volatile("s_waitcnt lgkmcnt(0)" ::: "memory");
        unsigned exs[16]; float gws[16], sus[16];
#pragma unroll
        for (int k = 0; k < 16; ++k) {
            const unsigned pos = 255u - (lc[k] & 255u), a = pos >> 4, b = pos & 15u;
            const unsigned ea = ib[a * NTHREADS + F.tid], eb = ib[(16 + b) * NTHREADS + F.tid];
            exs[k] = ea * 128u + eb;
        }
#pragma unroll
        for (int k = 0; k < 16; ++k) { gws[k] = e[k] * inv * TSC[NEXP + exs[k]]; sus[k] = TSC[exs[k]]; }
        { const size_t o = (size_t)tok * 128 + head * 16;
#pragma unroll
          for (int q = 0; q < 2; ++q) { u32x4 w;
#pragma unroll
              for (int j = 0; j < 4; ++j) w[j] = exs[8 * q + 2 * j] | (exs[8 * q + 2 * j + 1] << 16);
              *(u32x4*)(IDX + o + 8 * q) = w; }
#pragma unroll
          for (int q = 0; q < 4; ++q) { *(f32x4*)(GW + o + 4 * q) = (f32x4){gws[4 * q], gws[4 * q + 1], gws[4 * q + 2], gws[4 * q + 3]};
                                        *(f32x4*)(SU + o + 4 * q) = (f32x4){sus[4 * q], sus[4 * q + 1], sus[4 * q + 2], sus[4 * q + 3]}; } }
        asm volatile("s_waitcnt lgkmcnt(0)" ::: "memory");
    }
}

DI float dpp_xor1(float v) { return __builtin_bit_cast(float, __builtin_amdgcn_mov_dpp(__builtin_bit_cast(int, v), 0xB1, 0xF, 0xF, true)); }
DI float dpp_xor2(float v) { return __builtin_bit_cast(float, __builtin_amdgcn_mov_dpp(__builtin_bit_cast(int, v), 0x4E, 0xF, 0xF, true)); }
DI float dpp_hmir(float v) { return __builtin_bit_cast(float, __builtin_amdgcn_mov_dpp(__builtin_bit_cast(int, v), 0x141, 0xF, 0xF, true)); }
DI float dot16_fp8(const u32x4 q, const float (&hx)[16]) {
    f32x2 a = {0.f, 0.f};
#pragma unroll
    for (int j = 0; j < 4; ++j) {
        const f32x2 lo = __builtin_amdgcn_cvt_pk_f32_fp8((int)q[j], false), hi = __builtin_amdgcn_cvt_pk_f32_fp8((int)q[j], true);
        a += lo * (f32x2){hx[4 * j], hx[4 * j + 1]}; a += hi * (f32x2){hx[4 * j + 2], hx[4 * j + 3]};
    }
    return a.x + a.y;
}
#define PEER_EXPERT(id, i) ((int)(((id)[(i) >> 3][((i) >> 1) & 3] >> (16 * ((i) & 1))) & 0xffffu))

DI int dpp_xor1i(int v) { return __builtin_amdgcn_mov_dpp(v, 0xB1, 0xF, 0xF, true); }
DI int dpp_xor2i(int v) { return __builtin_amdgcn_mov_dpp(v, 0x4E, 0xF, 0xF, true); }
DI int dpp_hmiri(int v) { return __builtin_amdgcn_mov_dpp(v, 0x141, 0xF, 0xF, true); }
struct PeerURows { u32x4 q[16]; u32x4 h[2]; };
DI void peer_u_rows(PeerURows& R, const u32x4 (&id)[2], const unsigned char* ut, const unsigned char* hrow) {
    R.h[0] = *(const u32x4*)(hrow); R.h[1] = *(const u32x4*)(hrow + 16);
#pragma unroll
    for (int i = 0; i < 16; ++i) R.q[i] = *(const u32x4*)(ut + (size_t)PEER_EXPERT(id, i) * (D / 2));
}
DI void peer_u_compute(const PeerURows& R, float* part, int lane) {
    int hsum = 0;
#pragma unroll
    for (int g = 0; g < 2; ++g)
#pragma unroll
        for (int j = 0; j < 4; ++j) hsum = __builtin_amdgcn_sdot4((int)R.h[g][j], 0x01010101, hsum, false);
    int d[16];
#pragma unroll
    for (int i = 0; i < 16; ++i) { int a = 0;
#pragma unroll
        for (int dw = 0; dw < 4; ++dw) {
            const unsigned w = R.q[i][dw];
            a = __builtin_amdgcn_sdot4((int)(w & 0x0f0f0f0fu), (int)R.h[dw >> 1][2 * (dw & 1)], a, false);
            a = __builtin_amdgcn_sdot4((int)((w >> 4) & 0x0f0f0f0fu), (int)R.h[dw >> 1][2 * (dw & 1) + 1], a, false);
        }
        d[i] = a - 8 * hsum; }
    const bool b2 = (lane & 4) != 0, b1 = (lane & 2) != 0, b0 = (lane & 1) != 0;
    int k8[8];
#pragma unroll
    for (int i = 0; i < 8; ++i) { const int keep = b2 ? d[8 + i] : d[i], send = b2 ? d[i] : d[8 + i]; k8[i] = keep + dpp_hmiri(send); }
    int k4[4];
#pragma unroll
    for (int i = 0; i < 4; ++i) { const int keep = b1 ? k8[4 + i] : k8[i], send = b1 ? k8[i] : k8[4 + i]; k4[i] = keep + dpp_xor2i(send); }
    f32x2 k2;
    { const int keep0 = b0 ? k4[2] : k4[0], send0 = b0 ? k4[0] : k4[2], keep1 = b0 ? k4[3] : k4[1], send1 = b0 ? k4[1] : k4[3];
      k2.x = (float)(keep0 + dpp_xor1i(send0)); k2.y = (float)(keep1 + dpp_xor1i(send1)); }
    *(f32x2*)(part + 16 * (lane >> 3) + (b2 ? 8 : 0) + (b1 ? 4 : 0) + (b0 ? 2 : 0)) = k2;
}
DI void phase_peer_u(const Params& p, const Frame& F, int l) {
    const int ntok = (l == 0) ? T : TL, lane = F.lane, half = ntok >> 1;
    const int grp = F.bid & 7, cs = grp & 3, th = grp >> 2, sw = (F.bid >> 3) * NWAVES + F.wave, nsw = (F.nb >> 3) * NWAVES;
    const unsigned char* ut = p.ws + WS_UTAB + (size_t)l * NEXP * (D / 2) + 128 * cs + 16 * (lane & 7);
    const unsigned char* Hs = p.ws + WS_H8 + 256 * cs + 32 * (lane & 7);
    const unsigned short* IDXg = (const unsigned short*)(p.ws + WS_IDX) + 16 * (lane >> 3);
    float* PART = (float*)(p.ws + WS_ST) + (size_t)cs * T * 128;
    const int t0 = th * half, tend = t0 + half, last = tend - 1;
    u32x4 sa[2], sb[2]; PeerURows ra, rb;
#define U_SEL(S_, t_) do { const unsigned short* ip_ = IDXg + (size_t)min((t_), last) * 128; S_[0] = *(const u32x4*)ip_; S_[1] = *(const u32x4*)(ip_ + 8); } while (0)
#define U_ROWS(R_, S_, t_) peer_u_rows(R_, S_, ut, Hs + (size_t)min((t_), last) * D)
    U_SEL(sa, t0 + sw); U_SEL(sb, t0 + sw + nsw);
    U_ROWS(ra, sa, t0 + sw);
#pragma unroll 1
    for (int tok = t0 + sw; tok < tend; tok += 2 * nsw) {
        U_SEL(sa, tok + 2 * nsw); U_ROWS(rb, sb, tok + nsw);
        peer_u_compute(ra, PART + (size_t)tok * 128, lane);
        U_SEL(sb, tok + 3 * nsw); U_ROWS(ra, sa, tok + 2 * nsw);
        if (tok + nsw < tend) peer_u_compute(rb, PART + (size_t)(tok + nsw) * 128, lane);
    }
#undef U_SEL
#undef U_ROWS
}
DI void phase_peer_c(const Params& p, const Frame& F, int l, bool dummy = false) {
    const int ntok = (l == 0) ? T : TL;
    const float* PART = (const float*)(p.ws + WS_ST);
    float* GW = (float*)(p.ws + WS_GW);
    float* CO = dummy ? (float*)(p.ws + WS_H8) : GW;
    const float* SU = (const float*)(p.ws + WS_SU);
    const float* HS = (const float*)(p.ws + WS_HS);
    for (int i0 = F.gtid; i0 < ntok * 128; i0 += 4 * F.ngt) {
        float s[4], gw[4], su[4];
#pragma unroll
        for (int u = 0; u < 4; ++u) {
            const int i = min(i0 + u * F.ngt, ntok * 128 - 1);
            s[u] = 0.f;
#pragma unroll
            for (int sl = 0; sl < 4; ++sl) s[u] += PART[(size_t)sl * T * 128 + i];
            gw[u] = GW[i]; su[u] = SU[i] * HS[i >> 7];
        }
#pragma unroll
        for (int u = 0; u < 4; ++u) { const int i = i0 + u * F.ngt; if (i < ntok * 128) CO[i] = gw[u] * gelu_tanh(s[u] * su[u]); }
    }
}
struct PeerVRows { u32x4 q[16]; f32x4 cf[4]; f32x4 xv, gv; };
DI void peer_v_rows(PeerVRows& R, const u32x4 (&id)[2], const unsigned char* vt, const float* cp, const float* xs, const float* gt2) {
    R.cf[0] = *(const f32x4*)cp; R.cf[1] = *(const f32x4*)(cp + 4); R.cf[2] = *(const f32x4*)(cp + 8); R.cf[3] = *(const f32x4*)(cp + 12);
    R.xv = *(const f32x4*)xs; R.gv = *(const f32x4*)gt2;
#pragma unroll
    for (int i = 0; i < 16; ++i) R.q[i] = *(const u32x4*)(vt + (size_t)PEER_EXPERT(id, i) * (D / 2));
}
DI float xchg32(float v, bool hi) { const auto r = __builtin_amdgcn_permlane32_swap(__builtin_bit_cast(unsigned, v), __builtin_bit_cast(unsigned, v), false, false);
    return __builtin_bit_cast(float, hi ? r[0] : r[1]); }
DI float xchg16(float v, bool hi) { const auto r = __builtin_amdgcn_permlane16_swap(__builtin_bit_cast(unsigned, v), __builtin_bit_cast(unsigned, v), false, false);
    return __builtin_bit_cast(float, hi ? r[0] : r[1]); }
DI float xchg8(float v) { return __builtin_bit_cast(float, __builtin_amdgcn_mov_dpp(__builtin_bit_cast(int, v), 0x128, 0xF, 0xF, true)); }
typedef _Float16 h16x2 __attribute__((ext_vector_type(2)));
DI unsigned xchg32u(unsigned v, bool hi) { const auto r = __builtin_amdgcn_permlane32_swap(v, v, false, false); return hi ? r[0] : r[1]; }
DI unsigned xchg16u(unsigned v, bool hi) { const auto r = __builtin_amdgcn_permlane16_swap(v, v, false, false); return hi ? r[0] : r[1]; }
DI unsigned xchg8u(unsigned v) { return (unsigned)__builtin_amdgcn_mov_dpp((int)v, 0x128, 0xF, 0xF, true); }
DI void peer_v_compute(const PeerVRows& R, float* xdst, int lane) {
    h16x2 a[16];
#pragma unroll
    for (int j = 0; j < 16; ++j) a[j] = (h16x2){(_Float16)0.f, (_Float16)0.f};
#pragma unroll
    for (int i = 0; i < 16; ++i) {
        const _Float16 ch = (_Float16)R.cf[i >> 2][i & 3]; const h16x2 c2 = {ch, ch};
#pragma unroll
        for (int d = 0; d < 4; ++d) {
            a[4 * d + 0] += c2 * __builtin_amdgcn_cvt_scalef32_pk_f16_fp4(R.q[i][d], 1.0f, 0);
            a[4 * d + 1] += c2 * __builtin_amdgcn_cvt_scalef32_pk_f16_fp4(R.q[i][d], 1.0f, 1);
            a[4 * d + 2] += c2 * __builtin_amdgcn_cvt_scalef32_pk_f16_fp4(R.q[i][d], 1.0f, 2);
            a[4 * d + 3] += c2 * __builtin_amdgcn_cvt_scalef32_pk_f16_fp4(R.q[i][d], 1.0f, 3);
        }
    }
    const bool b3 = (lane & 8) != 0;
    h16x2 k8[8];
#pragma unroll
    for (int j = 0; j < 8; ++j) { const auto r = __builtin_amdgcn_permlane32_swap(__builtin_bit_cast(unsigned, a[j]), __builtin_bit_cast(unsigned, a[8 + j]), false, false);
        k8[j] = __builtin_bit_cast(h16x2, (unsigned)r[0]) + __builtin_bit_cast(h16x2, (unsigned)r[1]); }
    h16x2 k4[4];
#pragma unroll
    for (int j = 0; j < 4; ++j) { const auto r = __builtin_amdgcn_permlane16_swap(__builtin_bit_cast(unsigned, k8[j]), __builtin_bit_cast(unsigned, k8[4 + j]), false, false);
        k4[j] = __builtin_bit_cast(h16x2, (unsigned)r[0]) + __builtin_bit_cast(h16x2, (unsigned)r[1]); }
    h16x2 k2[2];
#pragma unroll
    for (int j = 0; j < 2; ++j) { const h16x2 keep = b3 ? k4[2 + j] : k4[j], send = b3 ? k4[j] : k4[2 + j];
        k2[j] = keep + __builtin_bit_cast(h16x2, xchg8u(__builtin_bit_cast(unsigned, send))); }
    *(f32x4*)xdst = R.xv + R.gv * (f32x4){(float)k2[0].x, (float)k2[0].y, (float)k2[1].x, (float)k2[1].y};
}
DI void phase_peer_v(const Params& p, const Frame& F, int l, bool dummy = false) {
    const int ntok = (l == 0) ? T : TL, lane = F.lane, half = ntok >> 1;
    const int grp = F.bid & 7, cs = grp & 3, th = grp >> 2, sw = (F.bid >> 3) * NWAVES + F.wave, nsw = (F.nb >> 3) * NWAVES;
    const unsigned char* vt = p.ws + WS_VTAB + (size_t)l * NEXP * (D / 2) + 128 * cs + 16 * (lane & 7);
    const unsigned short* IDXg = (const unsigned short*)(p.ws + WS_IDX) + 16 * (lane >> 3);
    const float* CFg = (const float*)(p.ws + WS_GW) + 16 * (lane >> 3);
    const int t0 = th * half, tend = t0 + half, last = tend - 1;
    u32x4 sa[2], sb[2]; PeerVRows ra, rb;
#define V_SEL(S_, t_) do { const unsigned short* ip_ = IDXg + (size_t)min((t_), last) * 128; S_[0] = *(const u32x4*)ip_; S_[1] = *(const u32x4*)(ip_ + 8); } while (0)
    const int co = 256 * cs + 32 * (lane & 7) + ((lane & 32) ? 16 : 0) + ((lane & 16) ? 8 : 0) + ((lane & 8) ? 4 : 0);
#define V_ROWS(R_, S_, t_) do { const int t1_ = min((t_), last); peer_v_rows(R_, S_, vt, CFg + (size_t)t1_ * 128, xrow_ptr(p, t1_) + co, mod_vec(p, l, t1_, 5) + co); } while (0)
#define V_DO(R_, t_) do { const int t2_ = (t_); float* xd_ = (dummy ? (float*)(p.ws + WS_ST) + (size_t)t2_ * D : xrow_ptr(p, t2_)) + co; peer_v_compute(R_, xd_, lane); } while (0)
    V_SEL(sa, t0 + sw); V_SEL(sb, t0 + sw + nsw);
    V_ROWS(ra, sa, t0 + sw);
#pragma unroll 1
    for (int tok = t0 + sw; tok < tend; tok += 2 * nsw) {
        V_SEL(sa, tok + 2 * nsw); V_ROWS(rb, sb, tok + nsw);
        V_DO(ra, tok);
        V_SEL(sb, tok + 3 * nsw); V_ROWS(ra, sa, tok + 2 * nsw);
        if (tok + nsw < tend) V_DO(rb, tok + nsw);
    }
#undef V_SEL
#undef V_ROWS
#undef V_DO
}

#define XB_TMO      128
#define XB_XCNT(j)  (256  + 64 * (j))
#define XB_XSUB(j)  (1280 + 64 * (j))
#define XB_XGEN(j)  (2304 + 64 * (j))
#define XB_TOP      3328
#define XB_TOPGEN   3392
#define XCD_BAR_WORDS 3456
#define XB_SPIN_CAP (1u << 18)
DI unsigned xb_ld(unsigned* p)              { return __hip_atomic_load(p, __ATOMIC_RELAXED, __HIP_MEMORY_SCOPE_AGENT); }
DI unsigned xb_add(unsigned* p, unsigned v) { return __hip_atomic_fetch_add(p, v, __ATOMIC_RELAXED, __HIP_MEMORY_SCOPE_AGENT); }
DI unsigned xb_xcc_id() { return (unsigned)__builtin_amdgcn_s_getreg((3 << 11) | 20) & 0xFu; }
#define XB_SPIN(cond, bar) do { unsigned _sp = 0; while (cond) { __builtin_amdgcn_s_sleep(1); \
    if ((++_sp & 255u) == 0u) { if (xb_ld(&(bar)[XB_TMO])) break; if (_sp > XB_SPIN_CAP) { atomicAdd(&(bar)[XB_TMO], 1u); break; } } } } while (0)
struct XcdBarrier { unsigned* bar; unsigned x; volatile LAS unsigned* st; };
DI XcdBarrier xcd_barrier_post(unsigned* bar, volatile LAS unsigned* st) {
    XcdBarrier b; b.bar = bar; b.x = xb_xcc_id(); b.st = st;
    if (threadIdx.x == 0) (void)xb_add(&bar[XB_XCNT(b.x)], 1u);
    return b;
}
DI void xcd_barrier_complete(unsigned* bar, unsigned x, unsigned& nloc, unsigned& nx) {
    const unsigned G = gridDim.x * gridDim.y * gridDim.z;
    unsigned sum, cnt, mine, sp = 0u;
    for (;;) {
        sum = 0u; cnt = 0u; mine = 0u;
#pragma unroll
        for (unsigned j = 0; j < 16; ++j) { const unsigned c = xb_ld(&bar[XB_XCNT(j)]); sum += c; cnt += (c > 0u) ? 1u : 0u; mine = (j == x) ? c : mine; }
        if (sum == G) break;
        __builtin_amdgcn_s_sleep(1);
        if ((++sp & 255u) == 0u) { if (xb_ld(&bar[XB_TMO])) break; if (sp > XB_SPIN_CAP) { atomicAdd(&bar[XB_TMO], 1u); break; } }
    }
    nloc = mine > 0u ? mine : 1u; nx = cnt > 0u ? cnt : 1u;
}
DI void xcd_barrier(const XcdBarrier& b) {
    asm volatile("s_waitcnt vmcnt(0)" ::: "memory");
    __syncthreads();
    if (threadIdx.x == 0) {
        unsigned* bar = b.bar;
        __builtin_amdgcn_s_waitcnt(0);
        unsigned nloc = b.st[0], nx = b.st[1];
        if (nloc == 0u) { xcd_barrier_complete(bar, b.x, nloc, nx); b.st[0] = nloc; b.st[1] = nx; }
        const unsigned old = xb_add(&bar[XB_XSUB(b.x)], 1u);
        const unsigned gen = old / nloc;
        if (old + 1u == (gen + 1u) * nloc) {
            __builtin_amdgcn_fence(__ATOMIC_RELEASE, "agent");
            asm volatile("s_waitcnt vmcnt(0)" ::: "memory");
            const unsigned og = xb_add(&bar[XB_TOP], 1u);
            const unsigned tg = og / nx;
            if (og + 1u == (tg + 1u) * nx) xb_add(&bar[XB_TOPGEN], 1u);
            else XB_SPIN(xb_ld(&bar[XB_TOPGEN]) == tg, bar);
            __builtin_amdgcn_fence(__ATOMIC_ACQUIRE, "agent");
            xb_add(&bar[XB_XGEN(b.x)], 1u);
            asm volatile("s_waitcnt vmcnt(0)" ::: "memory");
        } else {
            XB_SPIN(xb_ld(&bar[XB_XGEN(b.x)]) == gen, bar);
            __builtin_amdgcn_fence(__ATOMIC_ACQUIRE, "agent");
            asm volatile("s_waitcnt vmcnt(0)" ::: "memory");
        }
    }
    __syncthreads();
}

constexpr int NPHASE = 27;
template <int PH> DI void run_phase(const Params& p, const Frame& F) {
    if constexpr (PH == 0) phase_prep(p, F);
    else if constexpr (PH == 1) phase_norm(p, F, 0, 0, true, T);
    else if constexpr (PH == 2) phase_g1(p, F, 0);
    else if constexpr (PH == 3) phase_mix(p, F, 0);
    else if constexpr (PH == 4) phase_g2a(p, F, 0);
    else if constexpr (PH == 5) phase_g2(p, F, 0);
    else if constexpr (PH == 6) phase_g2sum(p, F);
    else if constexpr (PH == 7) phase_g3(p, F, 0);
    else if constexpr (PH == 8) phase_norm(p, F, 0, 1, false, T);
    else if constexpr (PH == 9) phase_g45(p, F, 0);
    else if constexpr (PH == 10) phase_sel(p, F, 0);
    else if constexpr (PH == 11) phase_peer_u(p, F, 0);
    else if constexpr (PH == 12) phase_peer_c(p, F, 0);
    else if constexpr (PH == 13) phase_peer_v(p, F, 0);
    else if constexpr (PH == 14) phase_norm(p, F, 1, 0, false, T);
    else if constexpr (PH == 15) phase_g1(p, F, 1);
    else if constexpr (PH == 16) phase_mix(p, F, 1);
    else if constexpr (PH == 17) phase_g2a(p, F, 1);
    else if constexpr (PH == 18) phase_g2(p, F, 1);
    else if constexpr (PH == 19) phase_g3(p, F, 1);
    else if constexpr (PH == 20) phase_norm(p, F, 1, 1, false, TL);
    else if constexpr (PH == 21) phase_g45(p, F, 1);
    else if constexpr (PH == 22) phase_sel(p, F, 1);
    else if constexpr (PH == 23) phase_peer_u(p, F, 1);
    else if constexpr (PH == 24) phase_peer_c(p, F, 1);
    else if constexpr (PH == 25) phase_peer_v(p, F, 1);
    else if constexpr (PH == 26) phase_final(p, F);
}
DI Frame make_frame(unsigned char* lds_raw) {
    Frame F;
    F.lds = (LAS unsigned char*)lds_raw;
    int tid = threadIdx.x; asm volatile("" : "+v"(tid));
    int bid = blockIdx.x, nb = gridDim.x; asm volatile("" : "+s"(bid), "+s"(nb));
    F.tid = tid; F.lane = tid & 63; F.wave = __builtin_amdgcn_readfirstlane(tid >> 6); F.bid = bid; F.nb = nb;
    F.gw = bid * NWAVES + F.wave; F.ngw = nb * NWAVES; F.gtid = bid * NTHREADS + tid; F.ngt = nb * NTHREADS;
    return F;
}
template <int PH> DI void run_phase_fresh(unsigned char* lds_raw) {
#if defined(__HIP_DEVICE_COMPILE__)
    const __attribute__((address_space(4))) unsigned long long* pp = (const __attribute__((address_space(4))) unsigned long long*)__builtin_amdgcn_kernarg_segment_ptr();
    asm volatile("" : "+s"(pp));
    Params p;
#pragma unroll
    for (int i = 0; i < N_IN; ++i) p.in[i] = (const float*)(const __attribute__((address_space(1))) float*)pp[i];
    p.out = (float*)(__attribute__((address_space(1))) float*)pp[N_IN]; p.ws = (unsigned char*)(__attribute__((address_space(1))) unsigned char*)pp[N_IN + 1]; p.ph_lo = 0; p.ph_hi = 0;
#else
    Params p{};
#endif
    const Frame F = make_frame(lds_raw);
    run_phase<PH>(p, F);
}
template <int PH> __global__ void __launch_bounds__(NTHREADS, 2) phase_kernel(Params p) {
    extern __shared__ __attribute__((aligned(16))) unsigned char lds_raw[];
    run_phase_fresh<PH>(lds_raw);
}
template <int PH> DI void run_all(unsigned char* lds_raw, cg::grid_group& grid, const XcdBarrier& bar) {
    if constexpr (PH < NPHASE) {
        if constexpr (PH == PROBE_PH) {
            if constexpr (PH == 12 || PH == 24 || PH == 13 || PH == 25) {
#if defined(__HIP_DEVICE_COMPILE__)
                const __attribute__((address_space(4))) unsigned long long* pp = (const __attribute__((address_space(4))) unsigned long long*)__builtin_amdgcn_kernarg_segment_ptr();
                asm volatile("" : "+s"(pp));
                Params p;
#pragma unroll
                for (int i = 0; i < N_IN; ++i) p.in[i] = (const float*)(const __attribute__((address_space(1))) float*)pp[i];
                p.out = (float*)(__attribute__((address_space(1))) float*)pp[N_IN]; p.ws = (unsigned char*)(__attribute__((address_space(1))) unsigned char*)pp[N_IN + 1]; p.ph_lo = 0; p.ph_hi = 0;
                const Frame F = make_frame(lds_raw);
                if constexpr (PH == 12 || PH == 24) phase_peer_c(p, F, PH == 12 ? 0 : 1, true); else phase_peer_v(p, F, PH == 13 ? 0 : 1, true);
#endif
            } else run_phase_fresh<PH>(lds_raw);
            xcd_barrier(bar);
        }
        run_phase_fresh<PH>(lds_raw);
        if constexpr (PH + 1 < NPHASE) { xcd_barrier(bar); if constexpr (PROBE_SYNC) xcd_barrier(bar); }
        run_all<PH + 1>(lds_raw, grid, bar);
    }
}
__global__ void __launch_bounds__(NTHREADS, 2) mega(Params p) {
    extern __shared__ __attribute__((aligned(16))) unsigned char lds_raw[];
    cg::grid_group grid = cg::this_grid();
    volatile LAS unsigned* st = (volatile LAS unsigned*)((LAS unsigned char*)lds_raw + LDS_BAR_OFF);
    if (threadIdx.x < 2) st[threadIdx.x] = 0u;
    __syncthreads();
    const XcdBarrier bar = xcd_barrier_post((unsigned*)(p.ws + WS_CTL), st);
    if (p.ph_lo != 0) grid.sync();
    run_all<0>(lds_raw, grid, bar);
}

extern "C" void kernel_launch(void* const* d_in, const int* in_sizes, int n_in, void* d_out, int out_size, void* d_ws, size_t ws_size, hipStream_t stream) {
    static int grid = 0;
    if (grid == 0) {
        if (n_in != 23 || out_size != TL * D || ws_size < WS_END) { fprintf(stderr, "kernel_launch: unexpected shapes (n_in %d out %d ws %zu)\n", n_in, out_size, ws_size); grid = -1; return; }
        int dev = 0, cus = 0, per_cu = 0;
        (void)hipGetDevice(&dev);
        (void)hipDeviceGetAttribute(&cus, hipDeviceAttributeMultiprocessorCount, dev);
        (void)hipFuncSetAttribute((const void*)mega, hipFuncAttributeMaxDynamicSharedMemorySize, LDS_BYTES);
        (void)hipOccupancyMaxActiveBlocksPerMultiprocessor(&per_cu, (const void*)mega, NTHREADS, LDS_BYTES);
        if (per_cu < 1) { fprintf(stderr, "kernel_launch: occupancy query reports %d blocks per CU\n", per_cu); grid = -1; return; }
        grid = cus & ~7;
        if (grid < 8) { fprintf(stderr, "kernel_launch: needs at least 8 CUs\n"); grid = -1; return; }
    }
    if (grid < 0) return;
    (void)hipMemsetAsync((char*)d_ws + WS_CTL, 0, CTL_ZERO_BYTES, stream);
    Params p{};
    for (int i = 0; i < N_IN; ++i) p.in[i] = (const float*)d_in[i];
    p.out = (float*)d_out; p.ws = (unsigned char*)d_ws;
    void* args[] = {&p};
    hipError_t e = hipLaunchCooperativeKernel((const void*)mega, dim3(grid), dim3(NTHREADS), args, LDS_BYTES, stream);
    if (e != hipSuccess) fprintf(stderr, "cooperative launch failed: %s (grid %d)\n", hipGetErrorString(e), grid);
}
```

```cpp
#include <hip/hip_runtime.h>
#include <hip/hip_cooperative_groups.h>
#include <stdint.h>
#include <stdio.h>
namespace cg = cooperative_groups;

#ifndef PROBE_PH
#define PROBE_PH -1
#endif
#ifndef PROBE_SYNC
#define PROBE_SYNC 0
#endif
#ifndef MK_SINGLE
#define MK_SINGLE 0
#endif

#define LAS __attribute__((address_space(3)))
typedef unsigned short bf16_t;
typedef short bf16x8 __attribute__((ext_vector_type(8)));
typedef short s16x4 __attribute__((ext_vector_type(4)));
typedef float f32x4 __attribute__((ext_vector_type(4)));
typedef float f32x2 __attribute__((ext_vector_type(2)));
typedef float f32x16 __attribute__((ext_vector_type(16)));
typedef unsigned u32x4 __attribute__((ext_vector_type(4)));
typedef unsigned u32x2 __attribute__((ext_vector_type(2)));
typedef __bf16 bf16x2_t __attribute__((ext_vector_type(2)));
typedef _Float16 f16x2_t __attribute__((ext_vector_type(2)));
#define DI __device__ __forceinline__
DI unsigned pkh2(float lo, float hi) { f16x2_t v = {(_Float16)lo, (_Float16)hi}; return __builtin_bit_cast(unsigned, v); }
#define MFMA32(a, b, c) __builtin_amdgcn_mfma_f32_32x32x16_bf16((a), (b), (c), 0, 0, 0)

constexpr int D = 1024, NB = 8, SEQ = 4096, NCTX = 256, DEPTH = 2;
constexpr int TL = NB * SEQ, TC = NB * NCTX, T = TL + TC;
constexpr int INW = 4608, NMOD = 6 * D, PW = 1600, PN = 1536;
constexpr int VTS = SEQ + 64;
constexpr int QOFF = 0, KOFF = 512, VOFF = 640, POOLOFF = 768, SUOFF = 1024, SVOFF = 1280, GATEOFF = 1536;
constexpr int NEXP = 16384;
constexpr float EPS = 1e-6f;
constexpr float LOG2E = 1.4426950408889634f;
constexpr float QSCALE = 0.125f * LOG2E;

constexpr size_t MiB = 1u << 20;
constexpr size_t WS_CTL = 0, WS_MOD = 1 * MiB, CTL_ZERO_BYTES = 65536;
constexpr size_t WS_ROPE = 2 * MiB, WS_SGUW = 2 * MiB + 65536, WS_TSCALE = 3 * MiB;
constexpr size_t WS_WIN = 4 * MiB, WS_WBR = 22 * MiB, WS_WOUT = 26 * MiB, WS_WFOLD = 30 * MiB;
constexpr size_t WS_XCTX = 38 * MiB, WS_UTAB = 46 * MiB, WS_VTAB = 78 * MiB;
constexpr size_t WS_IDX = 110 * MiB, WS_GW = 120 * MiB;
constexpr size_t WS_H = 142 * MiB;
constexpr size_t WS_P = 210 * MiB, WS_Y = 318 * MiB, WS_MERGED = 386 * MiB, WS_VT = 454 * MiB, WS_VTC = 463 * MiB, WS_VST = 464 * MiB;
constexpr size_t WS_G8 = WS_P;
constexpr size_t WS_MP = 482 * MiB;
constexpr size_t WS_ST = 210 * MiB, WS_H8 = 346 * MiB, WS_HS = 380 * MiB, WS_SU = 482 * MiB;
constexpr size_t WS_HF8 = WS_MERGED, WS_WG8 = 499 * MiB;
constexpr float WG8_SCALE = 16.0f;
constexpr size_t WS_END = 512 * MiB;
static_assert(WS_SU + (size_t)T * 128 * 4 <= WS_WG8 && WS_WG8 + (size_t)2 * 3072 * 2048 <= WS_END, "fp8 gate weights fit");
static_assert(WS_ST + (size_t)2048 * T * 2 <= WS_H8 && WS_H8 + (size_t)T * D <= WS_HS, "ST / H8 fit");
static_assert(WS_VST + (size_t)272 * 256 * 128 * 2 <= WS_SU && WS_VT + (size_t)NB * 2 * 64 * VTS * 2 <= WS_VTC, "VsT / VT fit");
static_assert(WS_H + (size_t)T * D * 2 <= WS_P && WS_G8 + (size_t)T * 3072 <= WS_Y, "H / G8 fit");
static_assert(WS_P + (size_t)T * PW * 2 <= WS_Y && WS_Y + (size_t)T * D * 2 <= WS_MERGED && WS_MERGED + (size_t)T * D * 2 <= WS_VT, "P/Y/MERGED fit");
static_assert(WS_IDX + (size_t)T * 128 * 2 <= WS_GW && WS_GW + (size_t)T * 128 * 4 <= WS_H && WS_SU + (size_t)T * 128 * 4 <= WS_END && WS_HS + (size_t)T * 4 <= WS_SU, "idx/gw/su fit");

constexpr int LDS_BYTES = 163840;
constexpr int LDS_BAR_OFF = LDS_BYTES - 64;
constexpr int NTHREADS = 512, NWAVES = 8;

enum { I_x, I_c, I_ctx, I_c_ctx, I_w_mod, I_b_mod, I_g_mix, I_g_ffn, I_w_in, I_attn_sink, I_pool_w, I_pool_scale, I_sgu_w, I_sgu_b, I_w_br_attn, I_w_br_pool, I_w_br_sgu, I_w_out, I_peer_wq, I_peer_subkeys, I_peer_u, I_peer_v, I_g_final, N_IN };
struct Params {
    const float* in[N_IN];
    float* out; unsigned char* ws;
    int ph_lo, ph_hi;
};

DI unsigned pk2(float lo, float hi) { f32x2 v = {lo, hi}; return __builtin_bit_cast(unsigned, __builtin_convertvector(v, bf16x2_t)); }
DI unsigned f2bf(float f) { return pk2(f, 0.f) & 0xffffu; }
DI float bf2f(unsigned short u) { return __builtin_bit_cast(float, (unsigned)u << 16); }
DI float bflo(unsigned w) { return __builtin_bit_cast(float, w << 16); }
DI float bfhi(unsigned w) { return __builtin_bit_cast(float, w & 0xffff0000u); }
DI int crow(int reg, int h) { return (reg & 3) + 8 * (reg >> 2) + 4 * h; }
DI int dpp_x1(int v) { return __builtin_amdgcn_mov_dpp(v, 0xB1, 0xF, 0xF, true); }
DI float wave_sum(float v) {
#pragma unroll
    for (int o = 1; o < 64; o <<= 1) v += __shfl_xor(v, o);
    return v;
}
DI float sigmoidf_(float x) { return __builtin_amdgcn_rcpf(1.0f + __expf(-x)); }
DI float gelu_tanh(float x) { const float u = 0.7978845608028654f * (x + 0.044715f * x * x * x); return x * __builtin_amdgcn_rcpf(1.0f + __expf(-2.0f * u)); }
DI float silu_(float x) { return x * __builtin_amdgcn_rcpf(1.0f + __expf(-x)); }

struct Frame {
    int tid, lane, wave, gw, ngw, gtid, ngt, bid, nb;
    LAS unsigned char* lds;
};

template <int NM, int NN>
DI void wave_gemm(const bf16_t* __restrict__ A, int lda, const bf16_t* __restrict__ Bt, int ldb, int K, int m0, int n0, f32x16 (&acc)[NM][NN], int lane) {
    const int r = lane & 31, h = lane >> 5;
    const bf16_t* ap = A + (size_t)(m0 + r) * lda + 8 * h;
    const bf16_t* bp = Bt + (size_t)(n0 + r) * ldb + 8 * h;
    for (int k0 = 0; k0 < K; k0 += 64) {
        bf16x8 a[4][NM], b[4][NN];
#pragma unroll
        for (int s = 0; s < 4; ++s) {
#pragma unroll
            for (int i = 0; i < NM; ++i) a[s][i] = *(const bf16x8*)(ap + (size_t)(32 * i) * lda + k0 + 16 * s);
#pragma unroll
            for (int j = 0; j < NN; ++j) b[s][j] = *(const bf16x8*)(bp + (size_t)(32 * j) * ldb + k0 + 16 * s);
        }
#pragma unroll
        for (int s = 0; s < 4; ++s)
#pragma unroll
            for (int i = 0; i < NM; ++i)
#pragma unroll
                for (int j = 0; j < NN; ++j) acc[i][j] = MFMA32(a[s][i], b[s][j], acc[i][j]);
    }
}
template <int NM, int NN> DI void zero_acc(f32x16 (&acc)[NM][NN]) {
#pragma unroll
    for (int i = 0; i < NM; ++i)
#pragma unroll
        for (int j = 0; j < NN; ++j)
#pragma unroll
            for (int r = 0; r < 16; ++r) acc[i][j][r] = 0.f;
}

namespace pg8 {
constexpr int BM = 256, BK = 64, HALF = 128, HTB = HALF * BK * 2, STAGE_BYTES = 8 * HTB, NXCD = 8, WGM = 8, LD = 1024;
DI int lds_byte(int r, int c) { const int st = (r >> 4) * 2 + (c >> 5), rr = r & 15, cc = c & 31, ob = rr * 64 + cc * 2; return st * 1024 + (ob ^ (((ob >> 9) & 1) << 5)); }
DI void stage_rc(int b, int& R, int& C) { const int st = b / 1024, sb = b % 1024, swz = sb ^ (((sb >> 9) & 1) << 5); R = (st >> 1) * 16 + swz / 64; C = (st & 1) * 32 + (swz % 64) / 2; }
DI int perm32(int rho) { const int n = rho >> 4, i = rho & 15; return 8 * (i >> 2) + 4 * n + (i & 3); }
typedef int i32x4 __attribute__((ext_vector_type(4)));
typedef int i32x8 __attribute__((ext_vector_type(8)));
struct Unit { int pm, pn, sub, nt, mode; const char* a; const char* b; };
DI void tile_of(int L, int nM, int nN, int& pm, int& pn) {
    const int nwg = nM * nN; int wgid = L;
    { const int q = nwg / NXCD, r = nwg % NXCD, xcd = wgid % NXCD, off = wgid / NXCD; wgid = (xcd < r ? xcd * (q + 1) : r * (q + 1) + (xcd - r) * q) + off; }
    const int nig = WGM * nN, gid = wgid / nig, fm = gid * WGM, gsz = (nM - fm) < WGM ? (nM - fm) : WGM;
    pm = fm + ((wgid % nig) % gsz); pn = (wgid % nig) / gsz;
}
template <class Epi, class Sched>
DI void gemm_phase(LAS unsigned char* lds, const int tid, const Sched& S, const Epi& E) {
    const int wid = __builtin_amdgcn_readfirstlane(tid >> 6), lane = tid & 63, wr = wid >> 2, wc = wid & 3, fr = lane & 15, fq = lane >> 4;
    unsigned voffA[2], voffB[2];
#pragma unroll
    for (int i = 0; i < 2; ++i) { int R, C; stage_rc(tid * 16 + i * 8192, R, C); const int Rb = Epi::PERM ? ((R & ~31) + perm32(R & 31)) : R;
        voffA[i] = (unsigned)(R * LD + C) * 2u; voffB[i] = (unsigned)(Rb * LD + C) * 2u; }
    const size_t kstep = (size_t)(BK * 2);
    const size_t hstep = (size_t)HALF * LD * 2;
    const unsigned ldsw = (unsigned)wid * 1024u;
    const int aoff = lds_byte(wr * 64 + fr, fq * 8), boff = lds_byte(wc * 32 + fr, fq * 8);
#define PG8_SA(b, h) (((b) * 2 + (h)) * HTB)
#define PG8_SB(b, h) ((4 + (b) * 2 + (h)) * HTB)
#define PG8_STAGE(bufoff, gbase, voff) do { _Pragma("unroll") for (int _i = 0; _i < 2; ++_i) \
        __builtin_amdgcn_global_load_lds((const unsigned*)((const char*)(gbase) + (voff)[_i]), (LAS unsigned*)(lds + (bufoff) + ldsw + _i * 8192), 16, 0, 0); } while (0)
#define PG8_LDA(dst, b, h) do { _Pragma("unroll") for (int m = 0; m < 4; ++m) { \
        if constexpr (Epi::FP8) dst##8[m] = __builtin_shufflevector(*(const LAS i32x4*)(lds + PG8_SA(b, h) + aoff + m * 2048), *(const LAS i32x4*)(lds + PG8_SA(b, h) + aoff + m * 2048 + 1024), 0, 1, 2, 3, 4, 5, 6, 7); \
        else { _Pragma("unroll") for (int k = 0; k < 2; ++k) dst[m][k] = *(const LAS bf16x8*)(lds + PG8_SA(b, h) + aoff + m * 2048 + k * 1024); } } } while (0)
#define PG8_LDB(dst, b, h) do { _Pragma("unroll") for (int n = 0; n < 2; ++n) { \
        if constexpr (Epi::FP8) dst##8[n] = __builtin_shufflevector(*(const LAS i32x4*)(lds + PG8_SB(b, h) + boff + n * 2048), *(const LAS i32x4*)(lds + PG8_SB(b, h) + boff + n * 2048 + 1024), 0, 1, 2, 3, 4, 5, 6, 7); \
        else { _Pragma("unroll") for (int k = 0; k < 2; ++k) dst[n][k] = *(const LAS bf16x8*)(lds + PG8_SB(b, h) + boff + n * 2048 + k * 1024); } } } while (0)
#define PG8_MMA(ai, bj, At, Bt) do { __builtin_amdgcn_s_setprio(1); \
        if constexpr (Epi::FP8) { _Pragma("unroll") for (int m = 0; m < 4; ++m) _Pragma("unroll") for (int n = 0; n < 2; ++n) \
            asm volatile("v_mfma_f32_16x16x128_f8f6f4 %0, %1, %2, %0" : "+v"(acc[ai][bj][m][n]) : "v"(Bt##8[n]), "v"(At##8[m])); } \
        else { _Pragma("unroll") for (int m = 0; m < 4; ++m) _Pragma("unroll") for (int n = 0; n < 2; ++n) _Pragma("unroll") for (int k = 0; k < 2; ++k) \
            acc[ai][bj][m][n] = __builtin_amdgcn_mfma_f32_16x16x32_bf16(Bt[n][k], At[m][k], acc[ai][bj][m][n], 0, 0, 0); } \
        __builtin_amdgcn_s_setprio(0); } while (0)
#define PG8_WAIT_V(n) asm volatile("s_waitcnt vmcnt(" #n ")" ::: "memory")
#define PG8_WAIT_L(n) asm volatile("s_waitcnt lgkmcnt(" #n ")" ::: "memory")
#define PG8_BAR __builtin_amdgcn_s_barrier()
#define PG8_SCHED __builtin_amdgcn_sched_barrier(0)
    Unit cur, nxt; int ui = 0;
    if (!S.next(0, cur)) return;
    f32x4 acc[2][2][4][2];
#pragma unroll
    for (int a = 0; a < 2; ++a)
#pragma unroll
        for (int b = 0; b < 2; ++b)
#pragma unroll
            for (int m = 0; m < 4; ++m)
#pragma unroll
                for (int n = 0; n < 2; ++n) acc[a][b][m][n] = (f32x4){0.f, 0.f, 0.f, 0.f};
    bf16x8 At[4][2], B0[2][2], B1[2][2]; i32x8 At8[4], B08[2], B18[2];
    const char* cA = cur.a; const char* cB = cur.b;
    PG8_STAGE(PG8_SB(0, 0), cB, voffB); PG8_STAGE(PG8_SB(0, 1), cB + hstep, voffB); PG8_STAGE(PG8_SA(0, 0), cA, voffA); PG8_STAGE(PG8_SA(0, 1), cA + hstep, voffA);
    if (wr == 1) PG8_BAR;
    PG8_WAIT_V(2); PG8_BAR;
    PG8_STAGE(PG8_SB(1, 0), cB + kstep, voffB); PG8_STAGE(PG8_SA(1, 0), cA + kstep, voffA); PG8_STAGE(PG8_SB(1, 1), cB + hstep + kstep, voffB);
    PG8_WAIT_V(6); PG8_BAR;
    for (;;) {
        const bool has_next = S.next(ui + 1, nxt);
        const char* nA = has_next ? nxt.a : cA; const char* nB = has_next ? nxt.b : cB;
        const int nt = cur.nt;
        for (int t = 0; t < nt; t += 2) {
            const bool last = (t == nt - 2);
            const char* a1 = cA + (size_t)(t + 1) * kstep;
            const char* a2 = last ? nA : cA + (size_t)(t + 2) * kstep; const char* b2 = last ? nB : cB + (size_t)(t + 2) * kstep;
            const char* a3 = a2 + kstep; const char* b3 = b2 + kstep;
            PG8_LDB(B0, 0, 0); PG8_LDB(B1, 0, 1); PG8_SCHED; PG8_LDA(At, 0, 0); PG8_STAGE(PG8_SA(1, 1), a1 + hstep, voffA);
            PG8_WAIT_V(8); PG8_WAIT_L(0); PG8_BAR; PG8_MMA(0, 0, At, B0); PG8_MMA(0, 1, At, B1); PG8_BAR; PG8_SCHED;
            PG8_LDA(At, 0, 1); PG8_STAGE(PG8_SB(0, 0), b2, voffB); PG8_STAGE(PG8_SB(0, 1), b2 + hstep, voffB); PG8_STAGE(PG8_SA(0, 0), a2, voffA);
            PG8_WAIT_V(8); PG8_WAIT_L(0); PG8_BAR; PG8_MMA(1, 0, At, B0); PG8_MMA(1, 1, At, B1); PG8_BAR; PG8_SCHED;
            PG8_LDB(B0, 1, 0); PG8_LDB(B1, 1, 1); PG8_SCHED; PG8_LDA(At, 1, 0); PG8_STAGE(PG8_SA(0, 1), a2 + hstep, voffA);
            PG8_WAIT_V(8); PG8_WAIT_L(0); PG8_BAR; PG8_MMA(0, 0, At, B0); PG8_MMA(0, 1, At, B1); PG8_BAR; PG8_SCHED;
            PG8_LDA(At, 1, 1); PG8_STAGE(PG8_SB(1, 0), b3, voffB); PG8_STAGE(PG8_SB(1, 1), b3 + hstep, voffB); PG8_STAGE(PG8_SA(1, 0), a3, voffA);
            PG8_WAIT_V(8); PG8_WAIT_L(0); PG8_BAR; PG8_MMA(1, 0, At, B0); PG8_MMA(1, 1, At, B1); PG8_BAR; PG8_SCHED;
        }
        if (wr == 0) PG8_BAR;
        if constexpr (Epi::FP8) asm volatile("s_nop 15\n\ts_nop 15" ::: "memory");
        E(acc, cur, wr, wc, fr, fq);
        if (!has_next) break;
        if (!E.keeps(cur)) {
#pragma unroll
        for (int a = 0; a < 2; ++a)
#pragma unroll
            for (int b = 0; b < 2; ++b)
#pragma unroll
                for (int m = 0; m < 4; ++m)
#pragma unroll
                    for (int n = 0; n < 2; ++n) acc[a][b][m][n] = (f32x4){0.f, 0.f, 0.f, 0.f};
        }
        cur = nxt; cA = nA; cB = nB; ++ui;
        if (wr == 1) PG8_BAR;
    }
    PG8_WAIT_V(0);
    PG8_BAR;
#undef PG8_SA
#undef PG8_SB
#undef PG8_STAGE
#undef PG8_LDA
#undef PG8_LDB
#undef PG8_MMA
#undef PG8_WAIT_V
#undef PG8_WAIT_L
#undef PG8_BAR
#undef PG8_SCHED
}
}

DI void transpose_item(const float* W, int K, int N, bf16_t* WT, int ldd, int row_off, int col_off, LAS float* scr, int item, int lane, unsigned char* W8 = nullptr) {
    const int nblk = N / 32, kb = item / nblk, nb = item % nblk, k0 = 64 * kb, n0 = 32 * nb;
#pragma unroll 8
    for (int i = 0; i < 32; ++i) { const int kk = 2 * i + (lane >> 5); scr[kk * 33 + (lane & 31)] = W[(size_t)(k0 + kk) * N + n0 + (lane & 31)]; }
    asm volatile("s_waitcnt lgkmcnt(0)" ::: "memory");
    const int c = lane & 7;
#pragma unroll
    for (int j = 0; j < 4; ++j) { const int n = (lane >> 3) + 8 * j; const LAS float* s = scr + (8 * c) * 33 + n;
        u32x4 o; o.x = pk2(s[0 * 33], s[1 * 33]); o.y = pk2(s[2 * 33], s[3 * 33]); o.z = pk2(s[4 * 33], s[5 * 33]); o.w = pk2(s[6 * 33], s[7 * 33]);
        if (W8 == nullptr) *(u32x4*)(WT + (size_t)(row_off + n0 + n) * ldd + col_off + k0 + 8 * c) = o;
        else { int q0 = 0, q1 = 0;
            q0 = __builtin_amdgcn_cvt_pk_fp8_f32(s[0 * 33] * WG8_SCALE, s[1 * 33] * WG8_SCALE, q0, false); q0 = __builtin_amdgcn_cvt_pk_fp8_f32(s[2 * 33] * WG8_SCALE, s[3 * 33] * WG8_SCALE, q0, true);
            q1 = __builtin_amdgcn_cvt_pk_fp8_f32(s[4 * 33] * WG8_SCALE, s[5 * 33] * WG8_SCALE, q1, false); q1 = __builtin_amdgcn_cvt_pk_fp8_f32(s[6 * 33] * WG8_SCALE, s[7 * 33] * WG8_SCALE, q1, true);
            *(u32x2*)(W8 + (size_t)(n0 + n) * 2048 + k0 + 8 * c) = (u32x2){(unsigned)q0, (unsigned)q1}; } }
    asm volatile("s_waitcnt lgkmcnt(0)" ::: "memory");
}

DI void convert_tables(const Params& p, const Frame& F) {
    for (int it0 = 4 * F.gw; it0 < 4 * NEXP; it0 += 4 * F.ngw) {
        f32x4 v[4][4];
#pragma unroll
        for (int u = 0; u < 4; ++u) {
            const int it = it0 + u, e = it & (NEXP - 1), tbl = (it >> 14) & 1, l = it >> 15;
            const f32x4* src = (const f32x4*)((tbl ? p.in[I_peer_v] : p.in[I_peer_u]) + ((size_t)l * NEXP + e) * D) + 4 * F.lane;
#pragma unroll
            for (int j = 0; j < 4; ++j) v[u][j] = src[j];
        }
#pragma unroll
        for (int u = 0; u < 4; ++u) {
            const int it = it0 + u, e = it & (NEXP - 1), tbl = (it >> 14) & 1, l = it >> 15;
            float am = 0.f;
#pragma unroll
            for (int j = 0; j < 4; ++j) am = fmaxf(am, fmaxf(fmaxf(fabsf(v[u][j].x), fabsf(v[u][j].y)), fmaxf(fabsf(v[u][j].z), fabsf(v[u][j].w))));
#pragma unroll
            for (int o = 1; o < 64; o <<= 1) am = fmaxf(am, __shfl_xor(am, o));
            float sc;
            if (tbl) sc = (am > 0.f) ? 6.0f / am : 1.0f;
            else {
                float ss = 0.f;
#pragma unroll
                for (int j = 0; j < 4; ++j) ss += v[u][j].x * v[u][j].x + v[u][j].y * v[u][j].y + v[u][j].z * v[u][j].z + v[u][j].w * v[u][j].w;
                const float rms = sqrtf(wave_sum(ss) * (1.0f / D));
                const float step = fminf(am * (1.0f / 7.0f), 0.335f * rms);
                sc = (step > 0.f) ? 1.0f / step : 1.0f;
            }
            if (tbl) {
                u32x2 q4;
#pragma unroll
                for (int d = 0; d < 2; ++d) { unsigned w = 0;
                    w = __builtin_amdgcn_cvt_scalef32_pk_fp4_f32(w, v[u][2 * d][0] * sc, v[u][2 * d][1] * sc, 1.0f, 0);
                    w = __builtin_amdgcn_cvt_scalef32_pk_fp4_f32(w, v[u][2 * d][2] * sc, v[u][2 * d][3] * sc, 1.0f, 1);
                    w = __builtin_amdgcn_cvt_scalef32_pk_fp4_f32(w, v[u][2 * d + 1][0] * sc, v[u][2 * d + 1][1] * sc, 1.0f, 2);
                    w = __builtin_amdgcn_cvt_scalef32_pk_fp4_f32(w, v[u][2 * d + 1][2] * sc, v[u][2 * d + 1][3] * sc, 1.0f, 3);
                    q4[d] = w; }
                *(u32x2*)(p.ws + WS_VTAB + ((size_t)l * NEXP + e) * (D / 2) + 8 * F.lane) = q4;
            } else {
                u32x2 q4;
#pragma unroll
                for (int d = 0; d < 2; ++d) { unsigned w = 0;
#pragma unroll
                    for (int b = 0; b < 4; ++b) { const int j = 2 * d + (b >> 1), e2 = 2 * (b & 1);
                        const int n0 = (int)fminf(fmaxf(__builtin_rintf(v[u][j][e2] * sc), -8.0f), 7.0f) & 15, n1 = (int)fminf(fmaxf(__builtin_rintf(v[u][j][e2 + 1] * sc), -8.0f), 7.0f) & 15;
                        w |= (unsigned)(n0 | (n1 << 4)) << (8 * b); }
                    q4[d] = w; }
                *(u32x2*)(p.ws + WS_UTAB + ((size_t)l * NEXP + e) * (D / 2) + 8 * F.lane) = q4;
            }
            if (F.lane == 0) ((float*)(p.ws + WS_TSCALE))[(l * 2 + tbl) * NEXP + e] = 1.0f / sc;
        }
    }
}

DI void phase_prep(const Params& p, const Frame& F) {
    unsigned char* ws = p.ws;
    {
        LAS float* wq = (LAS float*)F.lds;
        LAS float* skl = wq + 128 * 65;
        for (int it = F.bid; it < 2 * 16 * 16; it += F.nb) {
            const int cc = it & 15, hp = (it >> 4) & 15, l = it >> 8;
            const float* src = p.in[I_peer_wq] + (size_t)l * D * 2048 + hp * 128;
            const float* sks = p.in[I_peer_subkeys] + (size_t)(l * 16 + hp) * 128 * 128;
            __syncthreads();
            { float tw[16]; f32x4 ts[8];
#pragma unroll
              for (int it = 0; it < 16; ++it) { const int e = F.tid + it * NTHREADS, ci = e >> 7, d = e & 127; tw[it] = src[(size_t)(cc * 64 + ci) * 2048 + d]; }
#pragma unroll
              for (int it = 0; it < 8; ++it) { const int e = F.tid + it * NTHREADS, key = e >> 5, d4 = (e & 31) * 4; ts[it] = *(const f32x4*)(sks + key * 128 + d4); }
#pragma unroll
              for (int it = 0; it < 16; ++it) { const int e = F.tid + it * NTHREADS, ci = e >> 7, d = e & 127; wq[d * 65 + ci] = tw[it]; }
#pragma unroll
              for (int it = 0; it < 8; ++it) { const int e = F.tid + it * NTHREADS, key = e >> 5, d4 = (e & 31) * 4; *(LAS f32x4*)(skl + key * 132 + d4) = ts[it]; } }
            __syncthreads();
            const int ci = F.tid & 63, kg = F.tid >> 6;
            float acc[16];
#pragma unroll
            for (int k = 0; k < 16; ++k) acc[k] = 0.f;
#pragma unroll 2
            for (int d = 0; d < 128; d += 4) {
                const float w0 = wq[d * 65 + ci], w1 = wq[(d + 1) * 65 + ci], w2 = wq[(d + 2) * 65 + ci], w3 = wq[(d + 3) * 65 + ci];
#pragma unroll
                for (int k = 0; k < 16; ++k) { const f32x4 s = *(const LAS f32x4*)(skl + (16 * kg + k) * 132 + d); acc[k] += w0 * s.x + w1 * s.y + w2 * s.z + w3 * s.w; }
            }
            bf16_t* dst = (bf16_t*)(ws + WS_WFOLD) + ((size_t)l * 2048 + hp * 128 + 16 * kg) * D + cc * 64 + ci;
#pragma unroll
            for (int k = 0; k < 16; ++k) dst[(size_t)k * D] = (bf16_t)f2bf(acc[k]);
        }
        __syncthreads();
    }
    {
        LAS float* scr = (LAS float*)(F.lds + F.wave * 16384);
        constexpr int I_IN = (D / 64) * (INW / 32), I_BA = (512 / 64) * (D / 32), I_BS = (256 / 64) * (D / 32), I_O = (D / 64) * (D / 32);
        constexpr int PER_L = I_IN + I_BA + I_BS + I_O;
        for (int it = F.gw; it < 2 * PER_L; it += F.ngw) {
            const int l = it / PER_L; int r = it % PER_L;
            if (r < I_IN) { transpose_item(p.in[I_w_in] + (size_t)l * D * INW, D, INW, (bf16_t*)(ws + WS_WIN) + (size_t)l * INW * D, D, 0, 0, scr, r, F.lane, ws + WS_WIN + (size_t)l * INW * 2048); continue; } r -= I_IN;
            if (r < I_BA) { transpose_item(p.in[I_w_br_attn] + (size_t)l * 512 * D, 512, D, (bf16_t*)(ws + WS_WBR) + (size_t)l * D * D, D, 0, 0, scr, r, F.lane); continue; } r -= I_BA;
            if (r < I_BS) { transpose_item(p.in[I_w_br_sgu] + (size_t)l * 256 * D, 256, D, (bf16_t*)(ws + WS_WBR) + (size_t)l * D * D, D, 0, 768, scr, r, F.lane); continue; } r -= I_BS;
            transpose_item(p.in[I_w_out] + (size_t)l * D * D, D, D, (bf16_t*)(ws + WS_WOUT) + (size_t)l * D * D, D, 0, 0, scr, r, F.lane, ws + WS_WOUT + (size_t)l * D * 2048);
        }
    }
    for (int i = F.gtid; i < 2 * 256 * D; i += F.ngt) {
        const int n = i & 1023, rc = (i >> 10) & 255, l = i >> 18, g = rc >> 6;
        const float* pw = p.in[I_pool_w] + ((size_t)l * 256 + rc) * 64;
        const float* ps = p.in[I_pool_scale] + l * 256 + 64 * g;
        const float* wb = p.in[I_w_br_pool] + ((size_t)l * 256 + 64 * g) * D + n;
        float a = 0.f;
#pragma unroll 16
        for (int e = 0; e < 64; ++e) a += pw[e] * ps[e] * wb[(size_t)e * D];
        ((bf16_t*)(ws + WS_WBR))[(size_t)l * D * D + (size_t)n * D + 512 + rc] = (bf16_t)f2bf(a);
    }
    for (int i = F.gtid; i < 2 * 4 * 128 * 128; i += F.ngt) ((bf16_t*)(ws + WS_SGUW))[i] = (bf16_t)f2bf(p.in[I_sgu_w][i]);
    for (int i = F.gtid; i < 64 * 16; i += F.ngt) {
        const int pos = i >> 4, fi = i & 15;
        const float inv = powf(10000.0f, -(float)fi / 16.0f);
        const float ang = (float)pos * inv;
        ((f32x2*)(ws + WS_ROPE))[i] = (f32x2){cosf(ang), sinf(ang)};
    }
    convert_tables(p, F);
    {
        float* MOD = (float*)(ws + WS_MOD);
        LAS float* scd = (LAS float*)F.lds;
        LAS float* red = scd + 9 * D;
        __syncthreads();
        { float tc[18];
#pragma unroll
          for (int it = 0; it < 18; ++it) { const int e = F.tid + it * NTHREADS, r = e >> 10, k = e & 1023; tc[it] = (r < 8) ? p.in[I_c][r * D + k] : p.in[I_c_ctx][k]; }
#pragma unroll
          for (int it = 0; it < 18; ++it) scd[F.tid + it * NTHREADS] = silu_(tc[it]); }
        __syncthreads();
        for (int it = F.bid; it < 2 * 96; it += F.nb) {
            const int cgp = it % 96, l = it / 96, col = cgp * 64 + F.lane;
            float acc[9];
#pragma unroll
            for (int r = 0; r < 9; ++r) acc[r] = 0.f;
            const float* wp = p.in[I_w_mod] + ((size_t)l * D + F.wave * 128) * NMOD + col;
#pragma unroll 16
            for (int k = 0; k < 128; ++k) {
                const float w = wp[(size_t)k * NMOD];
#pragma unroll
                for (int r = 0; r < 9; ++r) acc[r] += scd[r * D + F.wave * 128 + k] * w;
            }
#pragma unroll
            for (int r = 0; r < 9; ++r) red[(F.wave * 9 + r) * 64 + F.lane] = acc[r];
            __syncthreads();
            for (int e = F.tid; e < 9 * 64; e += NTHREADS) {
                const int r = e >> 6, ln = e & 63; float s = p.in[I_b_mod][l * NMOD + cgp * 64 + ln];
#pragma unroll
                for (int w = 0; w < 8; ++w) s += red[(w * 9 + r) * 64 + ln];
                MOD[((size_t)l * 9 + r) * NMOD + cgp * 64 + ln] = s;
            }
            __syncthreads();
        }
    }
}

DI const float* mod_vec(const Params& p, int l, int row, int j) {
    const int r = row < TL ? row / SEQ : 8;
    return (const float*)(p.ws + WS_MOD) + ((size_t)l * 9 + r) * NMOD + j * D;
}
DI bf16_t* xrow_ptr(const Params& p, int row) { return row < TL ? (bf16_t*)p.out + (size_t)row * D : (bf16_t*)(p.ws + WS_XCTX) + (size_t)(row - TL) * D; }
DI const float* xin_ptr(const Params& p, int row) { return row < TL ? p.in[I_x] + (size_t)row * D : p.in[I_ctx] + (size_t)(row - TL) * D; }

template <bool from_input> DI void phase_norm(const Params& p, const Frame& F, int l, int which  , int nrows) {
    constexpr int NR = from_input ? 2 : 4;
    const float* g = (which == 0 ? p.in[I_g_mix] : p.in[I_g_ffn]) + l * D;
    const int lane = F.lane;
    f32x4 gg[4];
#pragma unroll
    for (int j = 0; j < 4; ++j) gg[j] = ((const f32x4*)g)[lane + 64 * j];
    for (int row0 = NR * F.gw; row0 < nrows; row0 += NR * F.ngw) {
        f32x4 v[NR][4], s1[4], s2[4];
#pragma unroll
        for (int u = 0; u < NR; ++u) {
            const int row = row0 + u;
            if (from_input) {
                const float* src = xin_ptr(p, row);
#pragma unroll
                for (int j = 0; j < 4; ++j) v[u][j] = ((const f32x4*)src)[lane + 64 * j];
            } else {
                const u32x2* src = (const u32x2*)xrow_ptr(p, row);
#pragma unroll
                for (int j = 0; j < 4; ++j) { const u32x2 w = src[lane + 64 * j]; v[u][j] = (f32x4){bflo(w.x), bfhi(w.x), bflo(w.y), bfhi(w.y)}; }
            }
        }
        { const float* sh = mod_vec(p, l, row0, which * 3 + 0); const float* sc = mod_vec(p, l, row0, which * 3 + 1);
#pragma unroll
          for (int j = 0; j < 4; ++j) { s1[j] = ((const f32x4*)sh)[lane + 64 * j]; s2[j] = ((const f32x4*)sc)[lane + 64 * j]; } }
#pragma unroll
        for (int u = 0; u < NR; ++u) {
            float ss = 0.f;
#pragma unroll
            for (int j = 0; j < 4; ++j) ss += v[u][j].x * v[u][j].x + v[u][j].y * v[u][j].y + v[u][j].z * v[u][j].z + v[u][j].w * v[u][j].w;
            const float rinv = rsqrtf(wave_sum(ss) * (1.0f / D) + EPS);
            bf16_t* dst = (bf16_t*)(p.ws + WS_H) + (size_t)(row0 + u) * D;
            float am = 0.f;
#pragma unroll
            for (int j = 0; j < 4; ++j) {
                const f32x4 o = v[u][j] * rinv * gg[j] * (s2[j] + 1.0f) + s1[j];
                u32x2 w; w.x = pk2(o.x, o.y); w.y = pk2(o.z, o.w);
                if (which != 0) ((u32x2*)dst)[lane + 64 * j] = w;
                if (which == 0) {
                    const f32x4 c = __builtin_elementwise_min(__builtin_elementwise_max(o, (f32x4){-448.f, -448.f, -448.f, -448.f}), (f32x4){448.f, 448.f, 448.f, 448.f});
                    int w8 = __builtin_amdgcn_cvt_pk_fp8_f32(c.x, c.y, 0, false); w8 = __builtin_amdgcn_cvt_pk_fp8_f32(c.z, c.w, w8, true);
                    ((int*)(p.ws + WS_HF8 + (size_t)(row0 + u) * 2048))[lane + 64 * j] = w8;
                }
                v[u][j] = o; am = fmaxf(am, fmaxf(fmaxf(fabsf(o.x), fabsf(o.y)), fmaxf(fabsf(o.z), fabsf(o.w))));
            }
            if (which) {
#pragma unroll
                for (int o2 = 1; o2 < 64; o2 <<= 1) am = fmaxf(am, __shfl_xor(am, o2));
                const float sc = (am > 0.f) ? 119.0f / am : 1.0f;
                unsigned* h8 = (unsigned*)(p.ws + WS_H8 + (size_t)(row0 + u) * D);
                const bool odd = (lane & 1) != 0;
#pragma unroll
                for (int j = 0; j < 4; ++j) {
                    unsigned na = 0, nb = 0;
#pragma unroll
                    for (int e = 0; e < 4; ++e) { const int hq = (int)__builtin_rintf(v[u][j][e] * sc); const int b = ((hq + 8) & 15) - 8; const int a = (hq - b) >> 4;
                        na |= (unsigned)(a & 15) << (4 * e); nb |= (unsigned)(b & 15) << (4 * e); }
                    const unsigned pa = (unsigned)dpp_x1((int)na), pb = (unsigned)dpp_x1((int)nb);
                    const unsigned w = odd ? (pb | (nb << 16)) : (na | (pa << 16));
                    h8[(odd ? 128 : 0) + ((lane + 64 * j) >> 1)] = w;
                }
                if (lane == 0) ((float*)(p.ws + WS_HS))[row0 + u] = (am > 0.f) ? am * (1.0f / 119.0f) : 1.0f;
            }
        }
    }
}
DI void phase_final(const Params& p, const Frame& F) {
    f32x4 gg[4];
#pragma unroll
    for (int j = 0; j < 4; ++j) gg[j] = ((const f32x4*)p.in[I_g_final])[F.lane + 64 * j];
    for (int row0 = 4 * F.gw; row0 < TL; row0 += 4 * F.ngw) {
        f32x4 v[4][4];
#pragma unroll
        for (int u = 0; u < 4; ++u)
#pragma unroll
            for (int j = 0; j < 4; ++j) { const u32x2 w = ((const u32x2*)((const bf16_t*)(p.ws + WS_H) + (size_t)(row0 + u) * D))[F.lane + 64 * j]; v[u][j] = (f32x4){bflo(w.x), bfhi(w.x), bflo(w.y), bfhi(w.y)}; }
#pragma unroll
        for (int u = 0; u < 4; ++u) {
            float ss = 0.f;
#pragma unroll
            for (int j = 0; j < 4; ++j) ss += v[u][j].x * v[u][j].x + v[u][j].y * v[u][j].y + v[u][j].z * v[u][j].z + v[u][j].w * v[u][j].w;
            const float rinv = rsqrtf(wave_sum(ss) * (1.0f / D) + EPS);
            f32x4* xr = (f32x4*)(p.out + (size_t)(row0 + u) * D);
#pragma unroll
            for (int j = 0; j < 4; ++j) xr[F.lane + 64 * j] = v[u][j] * rinv * gg[j];
        }
    }
}

DI float lane_xor32(float v, bool hi) { const auto r = __builtin_amdgcn_permlane32_swap(__builtin_bit_cast(unsigned, v), __builtin_bit_cast(unsigned, v), false, false);
    return __builtin_bit_cast(float, hi ? r[0] : r[1]); }
struct EpiG1 {
    DI bool keeps(const pg8::Unit&) const { return false; }
    static constexpr bool PERM = true; static constexpr bool FP8 = true;
    unsigned char* ws;
    DI void operator()(const f32x4 (&acc)[2][2][4][2], const pg8::Unit& u, int wr, int wc, int fr, int fq) const {
        bf16_t* P = (bf16_t*)(ws + WS_P);
        const int rbase = u.pm * 256 + wr * 64 + fr;
        const bool hi = fq >= 2;
#pragma unroll
        for (int ai = 0; ai < 2; ++ai) {
            f32x4 cs[4][4];
            const bool lat = u.pm < TL / 256;
            if (u.pn < 3 && lat) {
#pragma unroll
                for (int m = 0; m < 4; ++m) {
                    const int t = (rbase + 128 * ai + 16 * m) & (SEQ - 1), pos = (wc & 1) ? (t & 63) : (t >> 6);
                    const f32x4* tab = (const f32x4*)(ws + WS_ROPE) + (pos * 16 + 8 * (fq & 1)) / 2;
#pragma unroll
                    for (int j2 = 0; j2 < 4; ++j2) cs[m][j2] = tab[j2];
                }
            }
#pragma unroll
            for (int m = 0; m < 4; ++m) {
                const int row = rbase + 128 * ai + 16 * m;
#pragma unroll
                for (int bj = 0; bj < 2; ++bj) {
                    const int c0 = u.pn * 256 + 128 * bj + 32 * wc + 8 * fq;
                    float v[8];
#pragma unroll
                    for (int j = 0; j < 4; ++j) { v[j] = acc[ai][bj][m][0][j] * (1.0f / WG8_SCALE); v[4 + j] = acc[ai][bj][m][1][j] * (1.0f / WG8_SCALE); }
                    if (c0 < VOFF) {
                        const float sc = (c0 < KOFF) ? QSCALE : 1.0f;
                        u32x4 o;
#pragma unroll
                        for (int j2 = 0; j2 < 4; ++j2) {
                            const f32x4 c4 = cs[m][j2];
                            const float o0 = lane_xor32(v[2 * j2], hi), o1 = lane_xor32(v[2 * j2 + 1], hi);
                            float r0 = hi ? (v[2 * j2] * c4.x + o0 * c4.y) : (v[2 * j2] * c4.x - o0 * c4.y);
                            float r1 = hi ? (v[2 * j2 + 1] * c4.z + o1 * c4.w) : (v[2 * j2 + 1] * c4.z - o1 * c4.w);
                            if (!lat) { r0 = v[2 * j2]; r1 = v[2 * j2 + 1]; }
                            o[j2] = pk2(r0 * sc, r1 * sc);
                        }
                        *(u32x4*)(P + (size_t)row * PW + c0) = o;
                    } else if (c0 < POOLOFF) {
                        const int hk = wc >> 1, d0 = 32 * (wc & 1) + 8 * fq;
                        if (lat) { const int b = row / SEQ, t = row & (SEQ - 1);
                            bf16_t* vt = (bf16_t*)(ws + WS_VT) + ((size_t)(b * 2 + hk) * 64 + d0) * VTS + t;
#pragma unroll
                            for (int j = 0; j < 8; ++j) vt[(size_t)j * VTS] = (bf16_t)f2bf(v[j]);
                        } else { const int rc = row - TL, b = rc / NCTX, jc = rc & (NCTX - 1);
                            bf16_t* vt = (bf16_t*)(ws + WS_VTC) + ((size_t)(b * 2 + hk) * 64 + d0) * NCTX + jc;
#pragma unroll
                            for (int j = 0; j < 8; ++j) vt[(size_t)j * NCTX] = (bf16_t)f2bf(v[j]);
                        }
                    } else if (c0 < SUOFF) {
                        u32x4 o;
#pragma unroll
                        for (int j2 = 0; j2 < 4; ++j2) o[j2] = pk2(v[2 * j2], v[2 * j2 + 1]);
                        *(u32x4*)(P + (size_t)row * PW + c0) = o;
                    } else if (c0 < SVOFF) {
                        u32x4 o;
#pragma unroll
                        for (int j2 = 0; j2 < 4; ++j2) o[j2] = pk2(gelu_tanh(v[2 * j2]), gelu_tanh(v[2 * j2 + 1]));
                        *(u32x4*)(P + (size_t)row * PW + c0) = o;
                    } else {
                        const int c = c0 - SVOFF, chunk = row >> 7, q = row & 127;
                        bf16_t* vs = (bf16_t*)(ws + WS_VST) + ((size_t)chunk * 256 + c) * 128 + q;
#pragma unroll
                        for (int j = 0; j < 8; ++j) vs[j * 128] = (bf16_t)f2bf(gelu_tanh(v[j]));
                    }
                }
            }
            asm volatile("" ::: "memory");
        }
    }
};
struct SchedGrid {
    int nM, nN, G, c; const char* A; const char* B;
    int n_extra, ex_pm0, ex_pn;
    int nt;
    DI bool next(int i, pg8::Unit& u) const {
        const int L = i * G + c, n = nM * nN; if (L >= n + n_extra) return false;
        if (L < n) pg8::tile_of(L, nM, nN, u.pm, u.pn); else { u.pm = ex_pm0 + (L - n); u.pn = ex_pn; }
        u.sub = 0; u.nt = nt ? nt : D / 64; u.mode = 0;
        u.a = A + (size_t)u.pm * 256 * D * 2; u.b = B + (size_t)u.pn * 256 * D * 2; return true;
    }
};

DI void phase_g1(const Params& p, const Frame& F, int l) {
    SchedGrid S{(l == 0 ? T : TL) / 256, PN / 256, F.nb, F.bid, (const char*)(p.ws + WS_HF8), (const char*)(p.ws + WS_WIN) + (size_t)l * INW * 2048,
                (l == 0) ? 0 : TC / 256, TL / 256, 2, D / 128};
    EpiG1 E{p.ws};
    pg8::gemm_phase(F.lds, F.tid, S, E);
}

DI bf16x8 pack8(const f32x16& x, int s) {
    u32x4 pk;
#pragma unroll
    for (int j = 0; j < 4; ++j) { f32x2 v = {x[8 * s + 2 * j], x[8 * s + 2 * j + 1]}; pk[j] = __builtin_bit_cast(unsigned, __builtin_convertvector(v, bf16x2_t)); }
    return __builtin_bit_cast(bf16x8, pk);
}

DI float lane_x32(float v, bool hi) { const auto r = __builtin_amdgcn_permlane32_swap(__builtin_bit_cast(unsigned, v), __builtin_bit_cast(unsigned, v), false, false);
    return __builtin_bit_cast(float, hi ? r[0] : r[1]); }
struct AttnFrags { bf16x8 kf[4]; s16x4 vf[2][4]; };
DI void attn_block(const bf16x8 (&qf)[4], const AttnFrags& f, int mask_mode, int kq_off, int lane, float& m, float& lpart, f32x16 (&o)[2]) {
    const int h = lane >> 5;
    f32x16 st;
#pragma unroll
    for (int r = 0; r < 16; ++r) st[r] = 0.f;
#pragma unroll
    for (int s = 0; s < 4; ++s) st = MFMA32(f.kf[s], qf[s], st);
    if (mask_mode) {
#pragma unroll
        for (int r = 0; r < 16; ++r) { const int dlt = kq_off + crow(r, h); if (dlt > 128 || dlt < -128) st[r] = -1e30f; }
    }
    float bm = st[0];
#pragma unroll
    for (int r = 1; r < 16; ++r) bm = fmaxf(bm, st[r]);
    bm = fmaxf(bm, lane_x32(bm, h != 0));
    const float mn = fmaxf(m, bm);
    if (__builtin_amdgcn_ballot_w64(mn > m) != 0ull) {
        const float alpha = __builtin_amdgcn_exp2f(m - mn);
        lpart *= alpha;
#pragma unroll
        for (int d = 0; d < 2; ++d)
#pragma unroll
            for (int r = 0; r < 16; ++r) o[d][r] *= alpha;
        m = mn;
    }
    float ps = 0.f;
#pragma unroll
    for (int r = 0; r < 16; ++r) { st[r] = __builtin_amdgcn_exp2f(st[r] - m); ps += st[r]; }
    lpart += ps;
    const bf16x8 pf0 = pack8(st, 0), pf1 = pack8(st, 1);
#pragma unroll
    for (int d = 0; d < 2; ++d) {
        const bf16x8 v0 = __builtin_shufflevector(f.vf[d][0], f.vf[d][1], 0, 1, 2, 3, 4, 5, 6, 7), v1 = __builtin_shufflevector(f.vf[d][2], f.vf[d][3], 0, 1, 2, 3, 4, 5, 6, 7);
        o[d] = MFMA32(v0, pf0, o[d]);
        o[d] = MFMA32(v1, pf1, o[d]);
    }
}

constexpr int AKP = 144, AVWP = 648, AVCP = 520;
constexpr int ALDS_KW = 0, ALDS_VW = ALDS_KW + 320 * AKP, ALDS_KC = ALDS_VW + 64 * AVWP, ALDS_VC = ALDS_KC + 256 * AKP, ALDS_END = ALDS_VC + 64 * AVCP;
static_assert(ALDS_END <= LDS_BAR_OFF && (ALDS_VW % 16) == 0 && (ALDS_KC % 16) == 0 && (ALDS_VC % 8) == 0, "attention LDS map");
DI void attn_lds_frags(AttnFrags& f, const LAS unsigned char* kp, const LAS unsigned char* vp, int vpitch32) {
#pragma unroll
    for (int s = 0; s < 4; ++s) f.kf[s] = *(const LAS bf16x8*)(kp + 32 * s);
#pragma unroll
    for (int d = 0; d < 2; ++d)
#pragma unroll
        for (int q = 0; q < 4; ++q) f.vf[d][q] = *(const LAS s16x4*)(vp + d * vpitch32 + 16 * q);
}
DI void attn_unit(const Params& p, const Frame& F, int l, int unit) {
    const int lane = F.lane, r = lane & 31, h = lane >> 5, tid = F.tid;
    const bf16_t* P = (const bf16_t*)(p.ws + WS_P);
    const bf16_t* VT = (const bf16_t*)(p.ws + WS_VT);
    const bf16_t* VTC = (const bf16_t*)(p.ws + WS_VTC);
    bf16_t* Y = (bf16_t*)(p.ws + WS_Y);
    const bool latent = unit < 1024;
    int b, hk, p0, q0row;
    if (latent) { const int pb = unit & 63; hk = (unit >> 6) & 1; b = unit >> 7; p0 = pb * 64; q0row = b * SEQ + p0; }
    else { const int u2 = unit - 1024, pb = u2 & 3; hk = (u2 >> 2) & 1; b = u2 >> 3; p0 = pb * 64; q0row = TL + b * NCTX + p0; }
    const int w0 = p0 - 128;
    u32x4 kw[5], vw[5], kc[4], vc[4];
    if (latent) {
#pragma unroll
        for (int it = 0; it < 5; ++it) {
            const int i = tid + it * NTHREADS, row = i >> 3, ck = i & 7, pos = min(max(w0 + row, 0), SEQ - 1);
            kw[it] = *(const u32x4*)(P + (size_t)(b * SEQ + pos) * PW + KOFF + hk * 64 + 8 * ck);
            const int d = i / 40, cv = i % 40, pv = min(max(w0 + 8 * cv, 0), SEQ - 8);
            vw[it] = *(const u32x4*)(VT + ((size_t)(b * 2 + hk) * 64 + d) * VTS + pv);
        }
    }
#pragma unroll
    for (int it = 0; it < 4; ++it) {
        const int i = tid + it * NTHREADS;
        kc[it] = *(const u32x4*)(P + (size_t)(TL + b * NCTX + (i >> 3)) * PW + KOFF + hk * 64 + 8 * (i & 7));
        vc[it] = *(const u32x4*)(VTC + ((size_t)(b * 2 + hk) * 64 + (i >> 5)) * NCTX + 8 * (i & 31));
    }
    __syncthreads();
    if (latent) {
#pragma unroll
        for (int it = 0; it < 5; ++it) {
            const int i = tid + it * NTHREADS, row = i >> 3, ck = i & 7;
            *(LAS u32x4*)(F.lds + ALDS_KW + row * AKP + 16 * ck) = kw[it];
            const int d = i / 40, cv = i % 40;
            LAS u32x2* dst = (LAS u32x2*)(F.lds + ALDS_VW + d * AVWP + 16 * cv); dst[0] = (u32x2){vw[it].x, vw[it].y}; dst[1] = (u32x2){vw[it].z, vw[it].w};
        }
    }
#pragma unroll
    for (int it = 0; it < 4; ++it) {
        const int i = tid + it * NTHREADS;
        *(LAS u32x4*)(F.lds + ALDS_KC + (i >> 3) * AKP + 16 * (i & 7)) = kc[it];
        LAS u32x2* dst = (LAS u32x2*)(F.lds + ALDS_VC + (i >> 5) * AVCP + 16 * (i & 31)); dst[0] = (u32x2){vc[it].x, vc[it].y}; dst[1] = (u32x2){vc[it].z, vc[it].w};
    }
    const int head = 4 * hk + (F.wave & 3), ph = F.wave >> 2, pw = p0 + 32 * ph, qrow = q0row + 32 * ph;
    bf16x8 qf[4];
#pragma unroll
    for (int s = 0; s < 4; ++s) qf[s] = *(const bf16x8*)(P + (size_t)(qrow + r) * PW + head * 64 + 16 * s + 8 * h);
    float m = p.in[I_attn_sink][l * 8 + head] * LOG2E, lpart = (h == 0) ? 1.0f : 0.0f;
    f32x16 o[2];
#pragma unroll
    for (int d = 0; d < 2; ++d)
#pragma unroll
        for (int i = 0; i < 16; ++i) o[d][i] = 0.f;
    __syncthreads();
    if (latent) {
#pragma unroll 1
        for (int j = 0; j < 9; ++j) {
            const int kb = pw - 128 + 32 * j;
            if (kb < 0 || kb >= SEQ) continue;
            const int krow = kb - w0;
            AttnFrags f;
            attn_lds_frags(f, F.lds + ALDS_KW + (krow + r) * AKP + 16 * h, F.lds + ALDS_VW + r * AVWP + 2 * krow + 8 * h, 32 * AVWP);
            attn_block(qf, f, (j == 0 || j == 8) ? 1 : 0, kb - (pw + r), lane, m, lpart, o);
        }
    }
#pragma unroll 1
    for (int j = 0; j < 8; ++j) {
        AttnFrags f;
        attn_lds_frags(f, F.lds + ALDS_KC + (32 * j + r) * AKP + 16 * h, F.lds + ALDS_VC + r * AVCP + 64 * j + 8 * h, 32 * AVCP);
        attn_block(qf, f, 0, 0, lane, m, lpart, o);
    }
    const float inv = 1.0f / (lpart + lane_x32(lpart, h != 0));
    bf16_t* yrow = Y + (size_t)(qrow + r) * D + head * 64;
#pragma unroll
    for (int d = 0; d < 2; ++d)
#pragma unroll
        for (int g = 0; g < 4; ++g) {
            u32x2 w; w.x = pk2(o[d][4 * g] * inv, o[d][4 * g + 1] * inv); w.y = pk2(o[d][4 * g + 2] * inv, o[d][4 * g + 3] * inv);
            *(u32x2*)(yrow + 32 * d + 8 * g + 4 * h) = w;
        }
}

DI void sgu_unit(const Params& p, const Frame& F, int l, int chunk) {
    constexpr int VS = 136;
    LAS float* part = (LAS float*)F.lds;
    LAS float* rq = part + 512;
    LAS bf16_t* vnT = (LAS bf16_t*)(F.lds + 4096);
    const bf16_t* VsT = (const bf16_t*)(p.ws + WS_VST) + (size_t)chunk * 256 * 128;
    const bf16_t* P = (const bf16_t*)(p.ws + WS_P);
    bf16_t* Y = (bf16_t*)(p.ws + WS_Y);
    __syncthreads();
    { const int q = F.tid & 127, part_i = F.tid >> 7; float ss = 0.f;
#pragma unroll 16
        for (int c = part_i * 64; c < part_i * 64 + 64; ++c) { const float v = bf2f(VsT[c * 128 + q]); ss += v * v; }
        part[part_i * 128 + q] = ss; }
    __syncthreads();
    if (F.tid < 128) rq[F.tid] = rsqrtf((part[F.tid] + part[128 + F.tid] + part[256 + F.tid] + part[384 + F.tid]) * (1.0f / 256.0f) + EPS);
    __syncthreads();
#pragma unroll
    for (int it = 0; it < 8; ++it) {
        const int i = F.tid + it * NTHREADS;
        const int c = i >> 4, q8 = (i & 15) * 8;
        const u32x4 v = *(const u32x4*)(VsT + c * 128 + q8);
        u32x4 o;
#pragma unroll
        for (int j = 0; j < 4; ++j) o[j] = pk2(bflo(v[j]) * rq[q8 + 2 * j], bfhi(v[j]) * rq[q8 + 2 * j + 1]);
        *(LAS u32x4*)(vnT + c * VS + q8) = o;
    }
    __syncthreads();
    const int lane = F.lane, r = lane & 31, h = lane >> 5, g = F.wave >> 1, ph = F.wave & 1;
    const bf16_t* Wg = (const bf16_t*)(p.ws + WS_SGUW) + ((size_t)l * 4 + g) * 128 * 128;
#pragma unroll 1
    for (int pb = 0; pb < 2; ++pb) {
        const int p0 = 64 * ph + 32 * pb;
        const int row = chunk * 128 + p0 + r;
        bf16x8 wf[8];
#pragma unroll
        for (int s = 0; s < 8; ++s) wf[s] = *(const bf16x8*)(Wg + (size_t)(p0 + r) * 128 + 16 * s + 8 * h);
        u32x2 uu[2][4];
#pragma unroll
        for (int cb = 0; cb < 2; ++cb)
#pragma unroll
            for (int q4 = 0; q4 < 4; ++q4) uu[cb][q4] = *(const u32x2*)(P + (size_t)row * PW + SUOFF + 64 * g + 32 * cb + 8 * q4 + 4 * h);
        const float bias = p.in[I_sgu_b][(l * 4 + g) * 128 + p0 + r];
#pragma unroll
        for (int cb = 0; cb < 2; ++cb) {
            const int c0 = 64 * g + 32 * cb;
            f32x16 acc;
#pragma unroll
            for (int i = 0; i < 16; ++i) acc[i] = 0.f;
#pragma unroll
            for (int s = 0; s < 8; ++s) {
                const bf16x8 a = *(const LAS bf16x8*)(vnT + (c0 + r) * VS + 16 * s + 8 * h);
                acc = MFMA32(a, wf[s], acc);
            }
#pragma unroll
            for (int q4 = 0; q4 < 4; ++q4) {
                const int cc = c0 + 8 * q4 + 4 * h;
                const u32x2 u = uu[cb][q4];
                u32x2 w;
                w.x = pk2(bflo(u.x) * (acc[4 * q4] + bias), bfhi(u.x) * (acc[4 * q4 + 1] + bias));
                w.y = pk2(bflo(u.y) * (acc[4 * q4 + 2] + bias), bfhi(u.y) * (acc[4 * q4 + 3] + bias));
                *(u32x2*)(Y + (size_t)row * D + 768 + cc) = w;
            }
        }
    }
}

DI void phase_mix(const Params& p, const Frame& F, int l, int ctr_slot = 0) {
    (void)ctr_slot;
    const int nrows = (l == 0) ? T : TL;
    const bf16_t* P = (const bf16_t*)(p.ws + WS_P);
    bf16_t* Y = (bf16_t*)(p.ws + WS_Y);
    for (int i0 = F.bid * NTHREADS; i0 < 4 * nrows * 8; i0 += F.nb * NTHREADS) {
        const int i = i0 + F.tid, g = i / (nrows * 8), rem = i - g * (nrows * 8), row = rem >> 3, ck = g * 8 + (rem & 7);
        int base, t, len;
        if (row < TL) { base = row & ~(SEQ - 1); t = row & (SEQ - 1); len = SEQ; } else { const int rc = row - TL; base = TL + (rc & ~(NCTX - 1)); t = rc & (NCTX - 1); len = NCTX; }
        float s[8];
#pragma unroll
        for (int j = 0; j < 8; ++j) s[j] = 0.f;
        const bf16_t* zc = P + POOLOFF + ck * 8;
#define POOL_WIN(HALF) do { _Pragma("unroll") for (int dt = -(HALF); dt < (HALF); ++dt) { const int tt = t + dt; const bool ok = tt >= 0 && tt < len; \
            const u32x4 v = *(const u32x4*)(zc + (size_t)(base + (ok ? tt : t)) * PW); const float w = ok ? 1.f : 0.f; \
            _Pragma("unroll") for (int j = 0; j < 4; ++j) { s[2 * j] += w * bflo(v[j]); s[2 * j + 1] += w * bfhi(v[j]); } } } while (0)
        int half;
        if (g == 0) { POOL_WIN(1); half = 1; } else if (g == 1) { POOL_WIN(2); half = 2; } else if (g == 2) { POOL_WIN(4); half = 4; } else { POOL_WIN(8); half = 8; }
#undef POOL_WIN
        const int lo = max(t - half, 0), hi = min(t + half, len);
        const float inv = 1.0f / (float)(hi - lo);
        const u32x4 z = *(const u32x4*)(zc + (size_t)row * PW);
        u32x4 o;
#pragma unroll
        for (int j = 0; j < 4; ++j) o[j] = pk2(s[2 * j] * inv - bflo(z[j]), s[2 * j + 1] * inv - bfhi(z[j]));
        *(u32x4*)(Y + (size_t)row * D + 512 + ck * 8) = o;
    }
    const int nchunk = (l == 0) ? T / 128 : TL / 128;
    for (int ch = F.bid; ch < nchunk; ch += F.nb) sgu_unit(p, F, l, ch);
    const int nunit = (l == 0) ? 1024 + 64 : 1024;
    for (int u = F.nb - 1 - F.bid; u < nunit; u += F.nb) attn_unit(p, F, l, u);
}

struct EpiGate {
    static constexpr bool PERM = true; static constexpr bool FP8 = true;
    DI bool keeps(const pg8::Unit&) const { return false; }
    unsigned char* G8;
    DI void operator()(const f32x4 (&acc)[2][2][4][2], const pg8::Unit& u, int wr, int wc, int fr, int fq) const {
#pragma unroll
        for (int ai = 0; ai < 2; ++ai)
#pragma unroll
            for (int m = 0; m < 4; ++m) {
                unsigned char* rowp = G8 + (size_t)(u.pm * 256 + 128 * ai + 64 * wr + 16 * m + fr) * 3072 + u.pn * 256 + 32 * wc + 8 * fq;
#pragma unroll
                for (int bj = 0; bj < 2; ++bj) {
                    u32x2 w;
#pragma unroll
                    for (int n = 0; n < 2; ++n) { unsigned q = 0;
                        q = __builtin_amdgcn_cvt_pk_u8_f32(fmaxf(__builtin_rintf(255.0f * sigmoidf_(acc[ai][bj][m][n][0] * (1.0f / WG8_SCALE))), 1.0f), 0, q);
                        q = __builtin_amdgcn_cvt_pk_u8_f32(fmaxf(__builtin_rintf(255.0f * sigmoidf_(acc[ai][bj][m][n][1] * (1.0f / WG8_SCALE))), 1.0f), 1, q);
                        q = __builtin_amdgcn_cvt_pk_u8_f32(fmaxf(__builtin_rintf(255.0f * sigmoidf_(acc[ai][bj][m][n][2] * (1.0f / WG8_SCALE))), 1.0f), 2, q);
                        q = __builtin_amdgcn_cvt_pk_u8_f32(fmaxf(__builtin_rintf(255.0f * sigmoidf_(acc[ai][bj][m][n][3] * (1.0f / WG8_SCALE))), 1.0f), 3, q);
                        w[n] = q; }
                    *(u32x2*)(rowp + 128 * bj) = w;
                }
            }
    }
};
DI void phase_g2a(const Params& p, const Frame& F, int l) {
    SchedGrid S{(l == 0 ? T : TL) / 256, 3072 / 256, F.nb, F.bid, (const char*)(p.ws + WS_HF8), (const char*)(p.ws + WS_WIN) + ((size_t)l * INW + GATEOFF) * 2048, 0, 0, 0, D / 128};
    EpiGate E{p.ws + WS_G8};
    pg8::gemm_phase(F.lds, F.tid, S, E);
}
struct SchedG2 {
    int G, c; const char *Y, *Wb; int npair;
    DI void fill(pg8::Unit& u, int br) const {
        const int koff = (br == 0) ? 0 : (br == 1 ? 512 : 768); u.nt = (br == 0) ? 8 : 4; u.sub = br;
        u.a = Y + ((size_t)u.pm * 256 * D + koff) * 2; u.b = Wb + ((size_t)u.pn * 256 * D + koff) * 2;
    }
    DI bool next(int i, pg8::Unit& u) const {
        constexpr int NLAT = (TL / 256) * 4;
        const int nl = (NLAT - c + G - 1) / G;
        if (i < 3 * nl) { const int tile = (i / 3) * G + c; pg8::tile_of(tile, TL / 256, 4, u.pm, u.pn); u.mode = 0; fill(u, i % 3); return true; }
        const int j = (i - 3 * nl) * G + c;
        if (j >= npair) return false;
        const int ctile = j / 3, br = j % 3;
        u.pm = TL / 256 + (ctile >> 2); u.pn = ctile & 3; u.mode = 1 + br; fill(u, br); return true;
    }
};
constexpr float M8_SCALE = 16.0f;
DI unsigned fp8x4_(float a, float b, float c, float d) {
    const float lim = 448.0f; a = fminf(fmaxf(a * M8_SCALE, -lim), lim); b = fminf(fmaxf(b * M8_SCALE, -lim), lim); c = fminf(fmaxf(c * M8_SCALE, -lim), lim); d = fminf(fmaxf(d * M8_SCALE, -lim), lim);
    int w = __builtin_amdgcn_cvt_pk_fp8_f32(a, b, 0, false); w = __builtin_amdgcn_cvt_pk_fp8_f32(c, d, w, true); return (unsigned)w;
}
struct EpiG2 {
    static constexpr bool PERM = true; static constexpr bool FP8 = false;
    const unsigned char* G8; bf16_t* M; bf16_t* MP;
    DI bool keeps(const pg8::Unit& u) const { return u.mode == 0 && u.sub < 2; }
    DI void operator()(f32x4 (&acc)[2][2][4][2], const pg8::Unit& u, int wr, int wc, int fr, int fq) const {
        int r0 = 64 * wr + fr, c0 = 32 * wc + 8 * fq; asm volatile("" : "+v"(r0), "+v"(c0));
        const bool mid = u.mode == 0 && u.sub < 2;
        bf16_t* Mo = (u.mode == 0) ? M + (size_t)u.pm * 256 * D : MP + ((size_t)(u.mode - 1) * TC + (size_t)(u.pm - TL / 256) * 256) * D;
        const unsigned char* gb = G8 + (size_t)u.pm * 256 * 3072 + u.sub * 1024 + u.pn * 256;
#pragma unroll
        for (int ai = 0; ai < 2; ++ai) {
            u32x2 g0[4][2], g1[4][2];
#pragma unroll
            for (int m = 0; m < 4; ++m)
#pragma unroll
                for (int bj = 0; bj < 2; ++bj) {
                    const int rl = 128 * ai + 16 * m + r0, cl = 128 * bj + c0;
                    g0[m][bj] = *(const u32x2*)(gb + (size_t)rl * 3072 + cl);
                    if (mid) g1[m][bj] = *(const u32x2*)(gb + (size_t)rl * 3072 + 1024 + cl);
                }
#pragma unroll
            for (int m = 0; m < 4; ++m)
#pragma unroll
                for (int bj = 0; bj < 2; ++bj) {
                    const int rl = 128 * ai + 16 * m + r0, cl = 128 * bj + c0;
                    if (mid) {
#pragma unroll
                        for (int n = 0; n < 2; ++n)
#pragma unroll
                            for (int e = 0; e < 4; ++e) {
                                const float a = (float)((g0[m][bj][n] >> (8 * e)) & 0xffu), b = (float)((g1[m][bj][n] >> (8 * e)) & 0xffu);
                                acc[ai][bj][m][n][e] *= a * __builtin_amdgcn_rcpf(b);
                            }
                    } else {
                        if (u.mode == 0) {
                            u32x2 w8;
#pragma unroll
                            for (int n = 0; n < 2; ++n) { const unsigned g = g0[m][bj][n];
                                w8[n] = fp8x4_(acc[ai][bj][m][n][0] * ((float)(g & 0xffu) * (1.0f / 255.0f)), acc[ai][bj][m][n][1] * ((float)((g >> 8) & 0xffu) * (1.0f / 255.0f)),
                                               acc[ai][bj][m][n][2] * ((float)((g >> 16) & 0xffu) * (1.0f / 255.0f)), acc[ai][bj][m][n][3] * ((float)(g >> 24) * (1.0f / 255.0f))); }
                            *(u32x2*)((unsigned char*)M + (size_t)(u.pm * 256 + rl) * 2048 + u.pn * 256 + cl) = w8;
                        } else {
                            u32x4 w;
#pragma unroll
                            for (int j2 = 0; j2 < 4; ++j2) { const int n = j2 >> 1, e = 2 * (j2 & 1);
                                const float a0 = (float)((g0[m][bj][n] >> (8 * e)) & 0xffu) * (1.0f / 255.0f), a1 = (float)((g0[m][bj][n] >> (8 * e + 8)) & 0xffu) * (1.0f / 255.0f);
                                w[j2] = pk2(acc[ai][bj][m][n][e] * a0, acc[ai][bj][m][n][e + 1] * a1); }
                            *(u32x4*)(Mo + (size_t)rl * D + u.pn * 256 + cl) = w;
                        }
                    }
                }
            asm volatile("" ::: "memory");
        }
    }
};
DI void phase_g2(const Params& p, const Frame& F, int l) {
    SchedG2 S{F.nb, F.bid, (const char*)(p.ws + WS_Y), (const char*)(p.ws + WS_WBR) + (size_t)l * D * D * 2, (l == 0) ? (TC / 256) * 4 * 3 : 0};
    EpiG2 E{p.ws + WS_G8, (bf16_t*)(p.ws + WS_MERGED), (bf16_t*)(p.ws + WS_MP)};
    pg8::gemm_phase(F.lds, F.tid, S, E);
}
DI void phase_g2sum(const Params& p, const Frame& F) {
    const u32x4* mp = (const u32x4*)(p.ws + WS_MP);
    unsigned char* mo = p.ws + WS_MERGED + (size_t)TL * 2048;
    constexpr int NV = TC * D / 8;
    for (int i = F.gtid; i < NV; i += F.ngt) {
        const u32x4 a = mp[i], b = mp[NV + i], c = mp[2 * NV + i];
        float s[8];
#pragma unroll
        for (int j = 0; j < 4; ++j) { s[2 * j] = bflo(a[j]) + bflo(b[j]) + bflo(c[j]); s[2 * j + 1] = bfhi(a[j]) + bfhi(b[j]) + bfhi(c[j]); }
        const int row = i >> 7, c8 = (i & 127) * 8;
        *(u32x2*)(mo + (size_t)row * 2048 + c8) = (u32x2){fp8x4_(s[0], s[1], s[2], s[3]), fp8x4_(s[4], s[5], s[6], s[7])};
    }
}

template <bool F32SRC> struct EpiG3 {
    DI bool keeps(const pg8::Unit&) const { return false; }
    static constexpr bool PERM = true; static constexpr bool FP8 = true;
    const void* xsrc; bf16_t* xdst; const void* csrc; bf16_t* cdst; const float* mod;
    DI void operator()(const f32x4 (&acc)[2][2][4][2], const pg8::Unit& u, int wr, int wc, int fr, int fq) const {
        const int col0 = u.pn * 256 + wc * 32 + 8 * fq;
        int r0 = wr * 64 + fr; asm volatile("" : "+v"(r0));
        const bool lat = u.pm < TL / 256;
        const float* gt = mod + (size_t)(lat ? (u.pm >> 4) : 8) * NMOD + 2 * D;
        const size_t ro = (size_t)(lat ? u.pm : u.pm - TL / 256) * 256 * D;
        const float* xs32 = (const float*)(lat ? xsrc : csrc) + ro;
        const bf16_t* xs16 = (const bf16_t*)(lat ? xsrc : csrc) + ro;
        bf16_t* xd = (lat ? xdst : cdst) + ro;
        f32x4 gv[2][2];
#pragma unroll
        for (int bj = 0; bj < 2; ++bj)
#pragma unroll
            for (int n = 0; n < 2; ++n) gv[bj][n] = *(const f32x4*)(gt + col0 + 128 * bj + 4 * n) * (1.0f / (M8_SCALE * WG8_SCALE));
#pragma unroll
        for (int ai = 0; ai < 2; ++ai) {
            f32x4 xv[F32SRC ? 4 : 1][2][2]; u32x4 xw[F32SRC ? 1 : 4][2];
#pragma unroll
            for (int m = 0; m < 4; ++m)
#pragma unroll
                for (int bj = 0; bj < 2; ++bj) {
                    const size_t o = (size_t)((r0 + 128 * ai + 16 * m) * D) + col0 + 128 * bj;
                    if constexpr (F32SRC) { xv[m][bj][0] = *(const f32x4*)(xs32 + o); xv[m][bj][1] = *(const f32x4*)(xs32 + o + 4); }
                    else xw[m][bj] = *(const u32x4*)(xs16 + o);
                }
#pragma unroll
            for (int m = 0; m < 4; ++m)
#pragma unroll
                for (int bj = 0; bj < 2; ++bj) {
                    f32x4 x0, x1;
                    if constexpr (F32SRC) { x0 = xv[m][bj][0]; x1 = xv[m][bj][1]; }
                    else { const u32x4 w = xw[m][bj]; x0 = (f32x4){bflo(w.x), bfhi(w.x), bflo(w.y), bfhi(w.y)}; x1 = (f32x4){bflo(w.z), bfhi(w.z), bflo(w.w), bfhi(w.w)}; }
                    const f32x4 o0 = x0 + gv[bj][0] * acc[ai][bj][m][0], o1 = x1 + gv[bj][1] * acc[ai][bj][m][1];
                    u32x4 w; w.x = pk2(o0.x, o0.y); w.y = pk2(o0.z, o0.w); w.z = pk2(o1.x, o1.y); w.w = pk2(o1.z, o1.w);
                    *(u32x4*)(xd + (size_t)((r0 + 128 * ai + 16 * m) * D) + col0 + 128 * bj) = w;
                }
            asm volatile("" ::: "memory");
        }
    }
};
DI void phase_g3(const Params& p, const Frame& F, int l) {
    SchedGrid S{(l == 0 ? T : TL) / 256, D / 256, F.nb, F.bid, (const char*)(p.ws + WS_MERGED), (const char*)(p.ws + WS_WOUT) + (size_t)l * D * D * 2, 0, 0, 0, D / 128};
    bf16_t* xl = (bf16_t*)p.out; bf16_t* xc = (bf16_t*)(p.ws + WS_XCTX);
    const float* mod = (const float*)(p.ws + WS_MOD) + (size_t)l * 9 * NMOD;
    if (l == 0) { EpiG3<true> E{p.in[I_x], xl, p.in[I_ctx], xc, mod}; pg8::gemm_phase(F.lds, F.tid, S, E); }
    else { EpiG3<false> E{xl, xl, xc, xc, mod}; pg8::gemm_phase(F.lds, F.tid, S, E); }
}

struct EpiG45 {
    DI bool keeps(const pg8::Unit&) const { return false; }
    static constexpr bool PERM = true; static constexpr bool FP8 = false;
    unsigned short* ST;
    DI void operator()(const f32x4 (&acc)[2][2][4][2], const pg8::Unit& u, int wr, int wc, int fr, int fq) const {
        const int col0 = u.pn * 256 + wc * 32 + 8 * fq;
#pragma unroll
        for (int ai = 0; ai < 2; ++ai)
#pragma unroll
            for (int m = 0; m < 4; ++m) {
                unsigned short* rowp = ST + (size_t)(u.pm * 256 + wr * 64 + fr + 128 * ai + 16 * m) * T + col0;
#pragma unroll
                for (int bj = 0; bj < 2; ++bj) {
                    u32x4 w;
                    w.x = pkh2(acc[ai][bj][m][0][0], acc[ai][bj][m][0][1]); w.y = pkh2(acc[ai][bj][m][0][2], acc[ai][bj][m][0][3]);
                    w.z = pkh2(acc[ai][bj][m][1][0], acc[ai][bj][m][1][1]); w.w = pkh2(acc[ai][bj][m][1][2], acc[ai][bj][m][1][3]);
                    *(u32x4*)(rowp + 128 * bj) = w;
                }
            }
    }
};
DI void phase_g45(const Params& p, const Frame& F, int l) {
    SchedGrid S{2048 / 256, (l == 0 ? T : TL) / 256, F.nb, F.bid, (const char*)(p.ws + WS_WFOLD) + (size_t)l * 2048 * D * 2, (const char*)(p.ws + WS_H), 0, 0, 0};
    EpiG45 E{(unsigned short*)(p.ws + WS_ST)};
    pg8::gemm_phase(F.lds, F.tid, S, E);
}

DI unsigned fkey(float f) { const unsigned u = __builtin_bit_cast(unsigned, f); return (u & 0x80000000u) ? ~u : (u | 0x80000000u); }
DI float fkey_inv(unsigned k) { const unsigned u = (k & 0x80000000u) ? (k & 0x7fffffffu) : ~k; return __builtin_bit_cast(float, u); }
#define INSERT16(L, x) do { unsigned x_ = (x); _Pragma("unroll") for (int k_ = 0; k_ < 16; ++k_) { const unsigned hi_ = max(L[k_], x_); x_ = min(L[k_], x_); L[k_] = hi_; } } while (0)
#define CEX(a, b) do { const unsigned hi_ = max(a, b), lo_ = min(a, b); a = hi_; b = lo_; } while (0)
DI void sort16_desc(unsigned (&v)[16]) {
    CEX(v[0], v[1]); CEX(v[2], v[3]); CEX(v[0], v[2]); CEX(v[1], v[3]); CEX(v[1], v[2]); CEX(v[4], v[5]); CEX(v[6], v[7]); CEX(v[4], v[6]); CEX(v[5], v[7]); CEX(v[5], v[6]); CEX(v[0], v[4]); CEX(v[2], v[6]); CEX(v[2], v[4]); CEX(v[1], v[5]); CEX(v[3], v[7]); CEX(v[3], v[5]); CEX(v[1], v[2]); CEX(v[3], v[4]); CEX(v[5], v[6]); CEX(v[8], v[9]); CEX(v[10], v[11]); CEX(v[8], v[10]); CEX(v[9], v[11]); CEX(v[9], v[10]); CEX(v[12], v[13]); CEX(v[14], v[15]); CEX(v[12], v[14]); CEX(v[13], v[15]); CEX(v[13], v[14]); CEX(v[8], v[12]); CEX(v[10], v[14]); CEX(v[10], v[12]); CEX(v[9], v[13]); CEX(v[11], v[15]); CEX(v[11], v[13]); CEX(v[9], v[10]); CEX(v[11], v[12]); CEX(v[13], v[14]); CEX(v[0], v[8]); CEX(v[4], v[12]); CEX(v[4], v[8]); CEX(v[2], v[10]); CEX(v[6], v[14]); CEX(v[6], v[10]); CEX(v[2], v[4]); CEX(v[6], v[8]); CEX(v[10], v[12]); CEX(v[1], v[9]); CEX(v[5], v[13]); CEX(v[5], v[9]); CEX(v[3], v[11]); CEX(v[7], v[15]); CEX(v[7], v[11]); CEX(v[3], v[5]); CEX(v[7], v[9]); CEX(v[11], v[13]); CEX(v[1], v[2]); CEX(v[3], v[4]); CEX(v[5], v[6]); CEX(v[7], v[8]); CEX(v[9], v[10]); CEX(v[11], v[12]); CEX(v[13], v[14]);
}
DI void merge16_desc(unsigned (&L)[16], const unsigned (&N)[16]) {
#pragma unroll
    for (int i = 0; i < 16; ++i) L[i] = max(L[i], N[15 - i]);
#pragma unroll
    for (int j = 8; j > 0; j >>= 1)
#pragma unroll
        for (int i = 0; i < 16; ++i) { const int q = i ^ j; if (q > i) CEX(L[i], L[q]); }
}
DI void phase_sel(const Params& p, const Frame& F, int l) {
    const _Float16* ST = (const _Float16*)(p.ws + WS_ST);
    unsigned short* IDX = (unsigned short*)(p.ws + WS_IDX);
    float* GW = (float*)(p.ws + WS_GW);
    float* SU = (float*)(p.ws + WS_SU);
    const float* TSC = (const float*)(p.ws + WS_TSCALE) + (size_t)l * 2 * NEXP;
    LAS unsigned char* ib = (LAS unsigned char*)F.lds;
    const int ntok = (l == 0) ? T : TL;
    for (int it = F.wave * F.nb + F.bid; it < ntok * 8 / 64; it += F.nb * NWAVES) {
        const int i = it * 64 + F.lane;
        const int tok = i % ntok, head = i / ntok;
        unsigned la[16], lb[16];
#pragma unroll
        for (int k = 0; k < 16; ++k) { la[k] = 0u; lb[k] = 0u; }
        const _Float16* s0 = ST + (size_t)(head * 256) * T + tok;
#define SEL_LOAD(B_, k0_) do { _Pragma("unroll") for (int j = 0; j < 32; ++j) B_[j] = sp[(size_t)((k0_) + j) * T]; } while (0)
#define SEL_KEY(x_, low_) ((((unsigned)(x_) ^ ((unsigned)(((int)((unsigned)(x_) << 16)) >> 31) | 0x8000u)) << 16) | (unsigned)(low_))
#define SEL_GRP(L_, B_, o_, k0_) do { unsigned nk_[16]; \
        _Pragma("unroll") for (int j = 0; j < 16; ++j) nk_[j] = SEL_KEY(B_[(o_) + j], 127 - ((k0_) + j)); \
        sort16_desc(nk_); merge16_desc(L_, nk_); } while (0)
#define SEL_HALF(L_, base_) do { const unsigned short* sp = (const unsigned short*)s0 + (size_t)(base_) * T; unsigned short bufa[32], bufb[32]; \
        SEL_LOAD(bufa, 0); \
        _Pragma("unroll 1") for (int k0 = 0; k0 < 128; k0 += 64) { \
            SEL_LOAD(bufb, k0 + 32); SEL_GRP(L_, bufa, 0, k0); SEL_GRP(L_, bufa, 16, k0 + 16); \
            SEL_LOAD(bufa, (k0 + 64) & 127); SEL_GRP(L_, bufb, 0, k0 + 32); SEL_GRP(L_, bufb, 16, k0 + 48); } } while (0)
        SEL_HALF(la, 0);
        SEL_HALF(lb, 128);
#undef SEL_LOAD
#undef SEL_KEY
#undef SEL_GRP
#undef SEL_HALF
        float va[16], vb[16];
#define SEL_VAL(key_) ((float)__builtin_bit_cast(_Float16, (unsigned short)(((key_) >> 16) ^ 0xffffu ^ ((unsigned)((int)(key_) >> 31) & 0x7fffu))))
#pragma unroll
        for (int k = 0; k < 16; ++k) {
            va[k] = SEL_VAL(la[k]); vb[k] = SEL_VAL(lb[k]);
            ib[k * NTHREADS + F.tid] = (unsigned char)(127u - (la[k] & 127u));
            ib[(16 + k) * NTHREADS + F.tid] = (unsigned char)(127u - (lb[k] & 127u));
        }
#undef SEL_VAL
        unsigned lc[16];
        { lc[0] = (fkey(va[0] + vb[0]) & ~255u) | 255u; lc[1] = (fkey(va[0] + vb[1]) & ~255u) | 254u; lc[2] = (fkey(va[0] + vb[2]) & ~255u) | 253u; lc[3] = (fkey(va[0] + vb[3]) & ~255u) | 252u; lc[4] = (fkey(va[0] + vb[4]) & ~255u) | 251u; lc[5] = (fkey(va[0] + vb[5]) & ~255u) | 250u; lc[6] = (fkey(va[0] + vb[6]) & ~255u) | 249u; lc[7] = (fkey(va[0] + vb[7]) & ~255u) | 248u; lc[8] = (fkey(va[0] + vb[8]) & ~255u) | 247u; lc[9] = (fkey(va[0] + vb[9]) & ~255u) | 246u; lc[10] = (fkey(va[0] + vb[10]) & ~255u) | 245u; lc[11] = (fkey(va[0] + vb[11]) & ~255u) | 244u; lc[12] = (fkey(va[0] + vb[12]) & ~255u) | 243u; lc[13] = (fkey(va[0] + vb[13]) & ~255u) | 242u; lc[14] = (fkey(va[0] + vb[14]) & ~255u) | 241u; lc[15] = (fkey(va[0] + vb[15]) & ~255u) | 240u; }
        sort16_desc(lc);
        { unsigned cg1[16]; cg1[0] = (fkey(va[1] + vb[0]) & ~255u) | 239u; cg1[1] = (fkey(va[1] + vb[1]) & ~255u) | 238u; cg1[2] = (fkey(va[1] + vb[2]) & ~255u) | 237u; cg1[3] = (fkey(va[1] + vb[3]) & ~255u) | 236u; cg1[4] = (fkey(va[1] + vb[4]) & ~255u) | 235u; cg1[5] = (fkey(va[1] + vb[5]) & ~255u) | 234u; cg1[6] = (fkey(va[1] + vb[6]) & ~255u) | 233u; cg1[7] = (fkey(va[1] + vb[7]) & ~255u) | 232u; cg1[8] = (fkey(va[2] + vb[0]) & ~255u) | 223u; cg1[9] = (fkey(va[2] + vb[1]) & ~255u) | 222u; cg1[10] = (fkey(va[2] + vb[2]) & ~255u) | 221u; cg1[11] = (fkey(va[2] + vb[3]) & ~255u) | 220u; cg1[12] = (fkey(va[2] + vb[4]) & ~255u) | 219u; cg1[13] = (fkey(va[3] + vb[0]) & ~255u) | 207u; cg1[14] = (fkey(va[3] + vb[1]) & ~255u) | 206u; cg1[15] = (fkey(va[3] + vb[2]) & ~255u) | 205u; sort16_desc(cg1); merge16_desc(lc, cg1); }
        { unsigned cg2[16]; cg2[0] = (fkey(va[3] + vb[3]) & ~255u) | 204u; cg2[1] = (fkey(va[4] + vb[0]) & ~255u) | 191u; cg2[2] = (fkey(va[4] + vb[1]) & ~255u) | 190u; cg2[3] = (fkey(va[4] + vb[2]) & ~255u) | 189u; cg2[4] = (fkey(va[5] + vb[0]) & ~255u) | 175u; cg2[5] = (fkey(va[5] + vb[1]) & ~255u) | 174u; cg2[6] = (fkey(va[6] + vb[0]) & ~255u) | 159u; cg2[7] = (fkey(va[6] + vb[1]) & ~255u) | 158u; cg2[8] = (fkey(va[7] + vb[0]) & ~255u) | 143u; cg2[9] = (fkey(va[7] + vb[1]) & ~255u) | 142u; cg2[10] = (fkey(va[8] + vb[0]) & ~255u) | 127u; cg2[11] = (fkey(va[9] + vb[0]) & ~255u) | 111u; cg2[12] = (fkey(va[10] + vb[0]) & ~255u) | 95u; cg2[13] = (fkey(va[11] + vb[0]) & ~255u) | 79u; cg2[14] = (fkey(va[12] + vb[0]) & ~255u) | 63u; cg2[15] = (fkey(va[13] + vb[0]) & ~255u) | 47u; sort16_desc(cg2); merge16_desc(lc, cg2); }
        { const unsigned key = (fkey(va[14] + vb[0]) & ~255u) | 31u; INSERT16(lc, key); }
        { const unsigned key = (fkey(va[15] + vb[0]) & ~255u) | 15u; INSERT16(lc, key); }
        float e[16], sum = 0.f; const float v0 = fkey_inv(lc[0] & ~255u);
#pragma unroll
        for (int k = 0; k < 16; ++k) { e[k] = __expf(fkey_inv(lc[k] & ~255u) - v0); sum += e[k]; }
        const float inv = 1.0f / sum;
        asm volatile("s_waitcnt lgkmcnt(0)" ::: "memory");
        unsigned exs[16]; float gws[16], sus[16];
#pragma unroll
        for (int k = 0; k < 16; ++k) {
            const unsigned pos = 255u - (lc[k] & 255u), a = pos >> 4, b = pos & 15u;
            const unsigned ea = ib[a * NTHREADS + F.tid], eb = ib[(16 + b) * NTHREADS + F.tid];
            exs[k] = ea * 128u + eb;
        }
#pragma unroll
        for (int k = 0; k < 16; ++k) { gws[k] = e[k] * inv * TSC[NEXP + exs[k]]; sus[k] = TSC[exs[k]]; }
        { const size_t o = (size_t)tok * 128 + head * 16;
#pragma unroll
          for (int q = 0; q < 2; ++q) { u32x4 w;
#pragma unroll
              for (int j = 0; j < 4; ++j) w[j] = exs[8 * q + 2 * j] | (exs[8 * q + 2 * j + 1] << 16);
              *(u32x4*)(IDX + o + 8 * q) = w; }
#pragma unroll
          for (int q = 0; q < 4; ++q) { *(f32x4*)(GW + o + 4 * q) = (f32x4){gws[4 * q], gws[4 * q + 1], gws[4 * q + 2], gws[4 * q + 3]};
                                        *(f32x4*)(SU + o + 4 * q) = (f32x4){sus[4 * q], sus[4 * q + 1], sus[4 * q + 2], sus[4 * q + 3]}; } }
        asm volatile("s_waitcnt lgkmcnt(0)" ::: "memory");
    }
}

DI float dpp_xor1(float v) { return __builtin_bit_cast(float, __builtin_amdgcn_mov_dpp(__builtin_bit_cast(int, v), 0xB1, 0xF, 0xF, true)); }
DI float dpp_xor2(float v) { return __builtin_bit_cast(float, __builtin_amdgcn_mov_dpp(__builtin_bit_cast(int, v), 0x4E, 0xF, 0xF, true)); }
DI float dpp_hmir(float v) { return __builtin_bit_cast(float, __builtin_amdgcn_mov_dpp(__builtin_bit_cast(int, v), 0x141, 0xF, 0xF, true)); }
DI float dot16_fp8(const u32x4 q, const float (&hx)[16]) {
    f32x2 a = {0.f, 0.f};
#pragma unroll
    for (int j = 0; j < 4; ++j) {
        const f32x2 lo = __builtin_amdgcn_cvt_pk_f32_fp8((int)q[j], false), hi = __builtin_amdgcn_cvt_pk_f32_fp8((int)q[j], true);
        a += lo * (f32x2){hx[4 * j], hx[4 * j + 1]}; a += hi * (f32x2){hx[4 * j + 2], hx[4 * j + 3]};
    }
    return a.x + a.y;
}
#define PEER_EXPERT(id, i) ((int)(((id)[(i) >> 3][((i) >> 1) & 3] >> (16 * ((i) & 1))) & 0xffffu))

DI int dpp_xor1i(int v) { return __builtin_amdgcn_mov_dpp(v, 0xB1, 0xF, 0xF, true); }
DI int dpp_xor2i(int v) { return __builtin_amdgcn_mov_dpp(v, 0x4E, 0xF, 0xF, true); }
DI int dpp_hmiri(int v) { return __builtin_amdgcn_mov_dpp(v, 0x141, 0xF, 0xF, true); }
struct PeerURows { u32x4 q[16]; u32x4 h[2]; };
DI void peer_u_rows(PeerURows& R, const u32x4 (&id)[2], const unsigned char* ut, unsigned loff, const unsigned char* hrow) {
    R.h[0] = *(const u32x4*)(hrow); R.h[1] = *(const u32x4*)(hrow + 512);
#pragma unroll
    for (int i = 0; i < 16; ++i) R.q[i] = *(const u32x4*)(ut + ((unsigned)PEER_EXPERT(id, i) * (unsigned)(D / 2) + loff));
}
DI void peer_u_compute(const PeerURows& R, float* part, int lane) {
    int d[16];
#pragma unroll
    for (int i = 0; i < 16; ++i) { int sa = 0, sb = 0;
#pragma unroll
        for (int dw = 0; dw < 4; ++dw) {
            if (dw == 0) {
                asm("v_dot8_i32_i4 %0, %1, %2, 0" : "=v"(sa) : "v"((int)R.q[i][0]), "v"((int)R.h[0][0]));
                asm("v_dot8_i32_i4 %0, %1, %2, 0" : "=v"(sb) : "v"((int)R.q[i][0]), "v"((int)R.h[1][0]));
            } else { sa = __builtin_amdgcn_sdot8((int)R.q[i][dw], (int)R.h[0][dw], sa, false); sb = __builtin_amdgcn_sdot8((int)R.q[i][dw], (int)R.h[1][dw], sb, false); }
        }
        d[i] = (sa << 4) + sb; }
    const bool b2 = (lane & 4) != 0, b1 = (lane & 2) != 0, b0 = (lane & 1) != 0;
    int k8[8];
#pragma unroll
    for (int i = 0; i < 8; ++i) { const int keep = b2 ? d[8 + i] : d[i], send = b2 ? d[i] : d[8 + i]; k8[i] = keep + dpp_hmiri(send); }
    int k4[4];
#pragma unroll
    for (int i = 0; i < 4; ++i) { const int keep = b1 ? k8[4 + i] : k8[i], send = b1 ? k8[i] : k8[4 + i]; k4[i] = keep + dpp_xor2i(send); }
    f32x2 k2;
    { const int keep0 = b0 ? k4[2] : k4[0], send0 = b0 ? k4[0] : k4[2], keep1 = b0 ? k4[3] : k4[1], send1 = b0 ? k4[1] : k4[3];
      k2.x = (float)(keep0 + dpp_xor1i(send0)); k2.y = (float)(keep1 + dpp_xor1i(send1)); }
    *(f32x2*)(part + 16 * (lane >> 3) + (b2 ? 8 : 0) + (b1 ? 4 : 0) + (b0 ? 2 : 0)) = k2;
}
DI void phase_peer_u(const Params& p, const Frame& F, int l) {
    const int ntok = (l == 0) ? T : TL, lane = F.lane, half = ntok >> 1;
    const int grp = F.bid & 7, cs = grp & 3, th = grp >> 2, sw = (F.bid >> 3) * NWAVES + F.wave, nsw = (F.nb >> 3) * NWAVES;
    const unsigned char* ut = p.ws + WS_UTAB + (size_t)l * NEXP * (D / 2) + 128 * cs; const unsigned loff = 16u * (unsigned)(lane & 7);
    const unsigned char* Hs = p.ws + WS_H8 + 128 * cs + 16 * (lane & 7);
    const unsigned short* IDXg = (const unsigned short*)(p.ws + WS_IDX) + 16 * (lane >> 3);
    float* PART = (float*)(p.ws + WS_ST) + (size_t)cs * T * 128;
    const int t0 = th * half, tend = t0 + half, last = tend - 1;
    u32x4 sa[2], sb[2]; PeerURows ra, rb;
#define U_SEL(S_, t_) do { const unsigned short* ip_ = IDXg + (size_t)min((t_), last) * 128; S_[0] = *(const u32x4*)ip_; S_[1] = *(const u32x4*)(ip_ + 8); } while (0)
#define U_ROWS(R_, S_, t_) peer_u_rows(R_, S_, ut, loff, Hs + (size_t)min((t_), last) * D)
    U_SEL(sa, t0 + sw); U_SEL(sb, t0 + sw + nsw);
    U_ROWS(ra, sa, t0 + sw);
#pragma unroll 1
    for (int tok = t0 + sw; tok < tend; tok += 2 * nsw) {
        U_SEL(sa, tok + 2 * nsw); U_ROWS(rb, sb, tok + nsw);
        peer_u_compute(ra, PART + (size_t)tok * 128, lane);
        U_SEL(sb, tok + 3 * nsw); U_ROWS(ra, sa, tok + 2 * nsw);
        if (tok + nsw < tend) peer_u_compute(rb, PART + (size_t)(tok + nsw) * 128, lane);
    }
#undef U_SEL
#undef U_ROWS
}
typedef _Float16 h16x2 __attribute__((ext_vector_type(2)));
DI void phase_peer_c(const Params& p, const Frame& F, int l, bool dummy = false) {
    const int ntok = (l == 0) ? T : TL;
    const float* PART = (const float*)(p.ws + WS_ST);
    float* GW = (float*)(p.ws + WS_GW);
    _Float16* CO = (_Float16*)(p.ws + WS_MERGED) + (dummy ? (size_t)T * 128 : 0);
    const float* SU = (const float*)(p.ws + WS_SU);
    const float* HS = (const float*)(p.ws + WS_HS);
    for (int q0 = F.gtid; q0 < ntok * 32; q0 += 2 * F.ngt) {
        f32x4 s[2], gw[2], su[2]; float hs[2];
#pragma unroll
        for (int u = 0; u < 2; ++u) {
            const int q = min(q0 + u * F.ngt, ntok * 32 - 1);
            s[u] = ((const f32x4*)PART)[q];
#pragma unroll
            for (int sl = 1; sl < 4; ++sl) s[u] += ((const f32x4*)(PART + (size_t)sl * T * 128))[q];
            gw[u] = ((const f32x4*)GW)[q]; su[u] = ((const f32x4*)SU)[q]; hs[u] = HS[q >> 5];
        }
#pragma unroll
        for (int u = 0; u < 2; ++u) {
            const int q = q0 + u * F.ngt;
            if (q < ntok * 32) {
                const f32x4 x = s[u] * su[u] * hs[u];
                const f32x2 lo = {gw[u].x * gelu_tanh(x.x), gw[u].y * gelu_tanh(x.y)}, hi = {gw[u].z * gelu_tanh(x.z), gw[u].w * gelu_tanh(x.w)};
                u32x2 w; w.x = __builtin_bit_cast(unsigned, __builtin_convertvector(lo, h16x2)); w.y = __builtin_bit_cast(unsigned, __builtin_convertvector(hi, h16x2));
                ((u32x2*)CO)[q] = w;
            }
        }
    }
}
struct PeerVRows { u32x4 q[16]; u32x4 cf[2]; u32x2 xv; f32x4 gv; };
DI void peer_v_rows(PeerVRows& R, const u32x4 (&id)[2], const unsigned char* vt, unsigned loff, const _Float16* cp, const bf16_t* xs, const float* gt2) {
    R.cf[0] = *(const u32x4*)cp; R.cf[1] = *(const u32x4*)(cp + 8);
    R.xv = *(const u32x2*)xs; R.gv = *(const f32x4*)gt2;
#pragma unroll
    for (int i = 0; i < 16; ++i) R.q[i] = *(const u32x4*)(vt + ((unsigned)PEER_EXPERT(id, i) * (unsigned)(D / 2) + loff));
}
DI float xchg32(float v, bool hi) { const auto r = __builtin_amdgcn_permlane32_swap(__builtin_bit_cast(unsigned, v), __builtin_bit_cast(unsigned, v), false, false);
    return __builtin_bit_cast(float, hi ? r[0] : r[1]); }
DI float xchg16(float v, bool hi) { const auto r = __builtin_amdgcn_permlane16_swap(__builtin_bit_cast(unsigned, v), __builtin_bit_cast(unsigned, v), false, false);
    return __builtin_bit_cast(float, hi ? r[0] : r[1]); }
DI float xchg8(float v) { return __builtin_bit_cast(float, __builtin_amdgcn_mov_dpp(__builtin_bit_cast(int, v), 0x128, 0xF, 0xF, true)); }
typedef _Float16 h16x2 __attribute__((ext_vector_type(2)));
DI unsigned xchg32u(unsigned v, bool hi) { const auto r = __builtin_amdgcn_permlane32_swap(v, v, false, false); return hi ? r[0] : r[1]; }
DI unsigned xchg16u(unsigned v, bool hi) { const auto r = __builtin_amdgcn_permlane16_swap(v, v, false, false); return hi ? r[0] : r[1]; }
DI unsigned xchg8u(unsigned v) { return (unsigned)__builtin_amdgcn_mov_dpp((int)v, 0x128, 0xF, 0xF, true); }
DI void peer_v_compute(const PeerVRows& R, bf16_t* xdst, int lane) {
    h16x2 a[16];
#pragma unroll
    for (int j = 0; j < 16; ++j) a[j] = (h16x2){(_Float16)0.f, (_Float16)0.f};
#pragma unroll
    for (int i = 0; i < 16; ++i) {
        const unsigned cw = R.cf[i >> 3][(i >> 1) & 3];   const h16x2 cp2 = __builtin_bit_cast(h16x2, cw); const h16x2 c2 = (i & 1) ? __builtin_shufflevector(cp2, cp2, 1, 1) : __builtin_shufflevector(cp2, cp2, 0, 0);
#pragma unroll
        for (int d = 0; d < 4; ++d) {
            a[4 * d + 0] += c2 * __builtin_amdgcn_cvt_scalef32_pk_f16_fp4(R.q[i][d], 1.0f, 0);
            a[4 * d + 1] += c2 * __builtin_amdgcn_cvt_scalef32_pk_f16_fp4(R.q[i][d], 1.0f, 1);
            a[4 * d + 2] += c2 * __builtin_amdgcn_cvt_scalef32_pk_f16_fp4(R.q[i][d], 1.0f, 2);
            a[4 * d + 3] += c2 * __builtin_amdgcn_cvt_scalef32_pk_f16_fp4(R.q[i][d], 1.0f, 3);
        }
    }
    const bool b3 = (lane & 8) != 0;
    h16x2 k8[8];
#pragma unroll
    for (int j = 0; j < 8; ++j) { const auto r = __builtin_amdgcn_permlane32_swap(__builtin_bit_cast(unsigned, a[j]), __builtin_bit_cast(unsigned, a[8 + j]), false, false);
        k8[j] = __builtin_bit_cast(h16x2, (unsigned)r[0]) + __builtin_bit_cast(h16x2, (unsigned)r[1]); }
    h16x2 k4[4];
#pragma unroll
    for (int j = 0; j < 4; ++j) { const auto r = __builtin_amdgcn_permlane16_swap(__builtin_bit_cast(unsigned, k8[j]), __builtin_bit_cast(unsigned, k8[4 + j]), false, false);
        k4[j] = __builtin_bit_cast(h16x2, (unsigned)r[0]) + __builtin_bit_cast(h16x2, (unsigned)r[1]); }
    h16x2 k2[2];
#pragma unroll
    for (int j = 0; j < 2; ++j) { const h16x2 keep = b3 ? k4[2 + j] : k4[j], send = b3 ? k4[j] : k4[2 + j];
        k2[j] = keep + __builtin_bit_cast(h16x2, xchg8u(__builtin_bit_cast(unsigned, send))); }
    const f32x4 o = (f32x4){bflo(R.xv.x), bfhi(R.xv.x), bflo(R.xv.y), bfhi(R.xv.y)} + R.gv * (f32x4){(float)k2[0].x, (float)k2[0].y, (float)k2[1].x, (float)k2[1].y};
    u32x2 w; w.x = pk2(o.x, o.y); w.y = pk2(o.z, o.w); *(u32x2*)xdst = w;
}
DI void phase_peer_v(const Params& p, const Frame& F, int l, bool dummy = false) {
    const int ntok = (l == 0) ? T : TL, lane = F.lane, half = ntok >> 1;
    const int grp = F.bid & 7, cs = grp & 3, th = grp >> 2, sw = (F.bid >> 3) * NWAVES + F.wave, nsw = (F.nb >> 3) * NWAVES;
    const unsigned char* vt = p.ws + WS_VTAB + (size_t)l * NEXP * (D / 2) + 128 * cs; const unsigned loff = 16u * (unsigned)(lane & 7);
    const unsigned short* IDXg = (const unsigned short*)(p.ws + WS_IDX) + 16 * (lane >> 3);
    const _Float16* CFg = (const _Float16*)(p.ws + WS_MERGED) + 16 * (lane >> 3);
    const int t0 = th * half, tend = t0 + half, last = tend - 1;
    u32x4 sa[2], sb[2]; PeerVRows ra, rb;
#define V_SEL(S_, t_) do { const unsigned short* ip_ = IDXg + (size_t)min((t_), last) * 128; S_[0] = *(const u32x4*)ip_; S_[1] = *(const u32x4*)(ip_ + 8); } while (0)
    const int co = 256 * cs + 32 * (lane & 7) + ((lane & 32) ? 16 : 0) + ((lane & 16) ? 8 : 0) + ((lane & 8) ? 4 : 0);
#define V_ROWS(R_, S_, t_) do { const int t1_ = min((t_), last); peer_v_rows(R_, S_, vt, loff, CFg + (size_t)t1_ * 128, xrow_ptr(p, t1_) + co, mod_vec(p, l, t1_, 5) + co); } while (0)
#define V_DO(R_, t_) do { const int t2_ = (t_); bf16_t* xd_ = (dummy ? (bf16_t*)(p.ws + WS_ST) + (size_t)t2_ * D : l == 1 ? (bf16_t*)(p.ws + WS_H) + (size_t)t2_ * D : xrow_ptr(p, t2_)) + co; peer_v_compute(R_, xd_, lane); } while (0)
    V_SEL(sa, t0 + sw); V_SEL(sb, t0 + sw + nsw);
    V_ROWS(ra, sa, t0 + sw);
#pragma unroll 1
    for (int tok = t0 + sw; tok < tend; tok += 2 * nsw) {
        V_SEL(sa, tok + 2 * nsw); V_ROWS(rb, sb, tok + nsw);
        V_DO(ra, tok);
        V_SEL(sb, tok + 3 * nsw); V_ROWS(ra, sa, tok + 2 * nsw);
        if (tok + nsw < tend) V_DO(rb, tok + nsw);
    }
#undef V_SEL
#undef V_ROWS
#undef V_DO
}

#define XB_TMO      128
#define XB_XCNT(j)  (256  + 64 * (j))
#define XB_XSUB(j)  (1280 + 64 * (j))
#define XB_XGEN(j)  (2304 + 64 * (j))
#define XB_TOP      3328
#define XB_TOPGEN   3392
#define XCD_BAR_WORDS 3456
#define XB_SPIN_CAP (1u << 18)
DI unsigned xb_ld(unsigned* p)              { return __hip_atomic_load(p, __ATOMIC_RELAXED, __HIP_MEMORY_SCOPE_AGENT); }
DI unsigned xb_add(unsigned* p, unsigned v) { return __hip_atomic_fetch_add(p, v, __ATOMIC_RELAXED, __HIP_MEMORY_SCOPE_AGENT); }
DI unsigned xb_xcc_id() { return (unsigned)__builtin_amdgcn_s_getreg((3 << 11) | 20) & 0xFu; }
#define XB_SPIN(cond, bar) do { unsigned _sp = 0; while (cond) { __builtin_amdgcn_s_sleep(1); \
    if ((++_sp & 255u) == 0u) { if (xb_ld(&(bar)[XB_TMO])) break; if (_sp > XB_SPIN_CAP) { atomicAdd(&(bar)[XB_TMO], 1u); break; } } } } while (0)
struct XcdBarrier { unsigned* bar; unsigned x; volatile LAS unsigned* st; };
DI XcdBarrier xcd_barrier_post(unsigned* bar, volatile LAS unsigned* st) {
    XcdBarrier b; b.bar = bar; b.x = xb_xcc_id(); b.st = st;
    if (threadIdx.x == 0) (void)xb_add(&bar[XB_XCNT(b.x)], 1u);
    return b;
}
DI void xcd_barrier_complete(unsigned* bar, unsigned x, unsigned& nloc, unsigned& nx) {
    const unsigned G = gridDim.x * gridDim.y * gridDim.z;
    unsigned sum, cnt, mine, sp = 0u;
    for (;;) {
        sum = 0u; cnt = 0u; mine = 0u;
#pragma unroll
        for (unsigned j = 0; j < 16; ++j) { const unsigned c = xb_ld(&bar[XB_XCNT(j)]); sum += c; cnt += (c > 0u) ? 1u : 0u; mine = (j == x) ? c : mine; }
        if (sum == G) break;
        __builtin_amdgcn_s_sleep(1);
        if ((++sp & 255u) == 0u) { if (xb_ld(&bar[XB_TMO])) break; if (sp > XB_SPIN_CAP) { atomicAdd(&bar[XB_TMO], 1u); break; } }
    }
    nloc = mine > 0u ? mine : 1u; nx = cnt > 0u ? cnt : 1u;
}
DI void xcd_barrier(const XcdBarrier& b) {
    asm volatile("s_waitcnt vmcnt(0)" ::: "memory");
    __syncthreads();
    if (threadIdx.x == 0) {
        unsigned* bar = b.bar;
        __builtin_amdgcn_s_waitcnt(0);
        unsigned nloc = b.st[0], nx = b.st[1];
        if (nloc == 0u) { xcd_barrier_complete(bar, b.x, nloc, nx); b.st[0] = nloc; b.st[1] = nx; }
        const unsigned old = xb_add(&bar[XB_XSUB(b.x)], 1u);
        const unsigned gen = old / nloc;
        if (old + 1u == (gen + 1u) * nloc) {
            __builtin_amdgcn_fence(__ATOMIC_RELEASE, "agent");
            asm volatile("s_waitcnt vmcnt(0)" ::: "memory");
            const unsigned og = xb_add(&bar[XB_TOP], 1u);
            const unsigned tg = og / nx;
            if (og + 1u == (tg + 1u) * nx) xb_add(&bar[XB_TOPGEN], 1u);
            else XB_SPIN(xb_ld(&bar[XB_TOPGEN]) == tg, bar);
            __builtin_amdgcn_fence(__ATOMIC_ACQUIRE, "agent");
            xb_add(&bar[XB_XGEN(b.x)], 1u);
            asm volatile("s_waitcnt vmcnt(0)" ::: "memory");
        } else {
            XB_SPIN(xb_ld(&bar[XB_XGEN(b.x)]) == gen, bar);
            __builtin_amdgcn_fence(__ATOMIC_ACQUIRE, "agent");
            asm volatile("s_waitcnt vmcnt(0)" ::: "memory");
        }
    }
    __syncthreads();
}

constexpr int NPHASE = 27;
template <int PH> DI void run_phase(const Params& p, const Frame& F) {
    if constexpr (PH == 0) phase_prep(p, F);
    else if constexpr (PH == 1) phase_norm<true>(p, F, 0, 0, T);
    else if constexpr (PH == 2) phase_g1(p, F, 0);
    else if constexpr (PH == 3) phase_mix(p, F, 0);
    else if constexpr (PH == 4) phase_g2a(p, F, 0);
    else if constexpr (PH == 5) phase_g2(p, F, 0);
    else if constexpr (PH == 6) phase_g2sum(p, F);
    else if constexpr (PH == 7) phase_g3(p, F, 0);
    else if constexpr (PH == 8) phase_norm<false>(p, F, 0, 1, T);
    else if constexpr (PH == 9) phase_g45(p, F, 0);
    else if constexpr (PH == 10) phase_sel(p, F, 0);
    else if constexpr (PH == 11) phase_peer_u(p, F, 0);
    else if constexpr (PH == 12) phase_peer_c(p, F, 0);
    else if constexpr (PH == 13) phase_peer_v(p, F, 0);
    else if constexpr (PH == 14) phase_norm<false>(p, F, 1, 0, T);
    else if constexpr (PH == 15) phase_g1(p, F, 1);
    else if constexpr (PH == 16) phase_mix(p, F, 1);
    else if constexpr (PH == 17) phase_g2a(p, F, 1);
    else if constexpr (PH == 18) phase_g2(p, F, 1);
    else if constexpr (PH == 19) phase_g3(p, F, 1);
    else if constexpr (PH == 20) phase_norm<false>(p, F, 1, 1, TL);
    else if constexpr (PH == 21) phase_g45(p, F, 1);
    else if constexpr (PH == 22) phase_sel(p, F, 1);
    else if constexpr (PH == 23) phase_peer_u(p, F, 1);
    else if constexpr (PH == 24) phase_peer_c(p, F, 1);
    else if constexpr (PH == 25) phase_peer_v(p, F, 1);
    else if constexpr (PH == 26) phase_final(p, F);
}
DI Frame make_frame(unsigned char* lds_raw) {
    Frame F;
    F.lds = (LAS unsigned char*)lds_raw;
    int tid = threadIdx.x; asm volatile("" : "+v"(tid));
    int bid = blockIdx.x, nb = gridDim.x; asm volatile("" : "+s"(bid), "+s"(nb));
    F.tid = tid; F.lane = tid & 63; F.wave = __builtin_amdgcn_readfirstlane(tid >> 6); F.bid = bid; F.nb = nb;
    F.gw = bid * NWAVES + F.wave; F.ngw = nb * NWAVES; F.gtid = bid * NTHREADS + tid; F.ngt = nb * NTHREADS;
    return F;
}
template <int PH> DI void run_phase_fresh(unsigned char* lds_raw) {
#if defined(__HIP_DEVICE_COMPILE__)
    const __attribute__((address_space(4))) unsigned long long* pp = (const __attribute__((address_space(4))) unsigned long long*)__builtin_amdgcn_kernarg_segment_ptr();
    asm volatile("" : "+s"(pp));
    Params p;
#pragma unroll
    for (int i = 0; i < N_IN; ++i) p.in[i] = (const float*)(const __attribute__((address_space(1))) float*)pp[i];
    p.out = (float*)(__attribute__((address_space(1))) float*)pp[N_IN]; p.ws = (unsigned char*)(__attribute__((address_space(1))) unsigned char*)pp[N_IN + 1]; p.ph_lo = 0; p.ph_hi = 0;
#else
    Params p{};
#endif
    const Frame F = make_frame(lds_raw);
    run_phase<PH>(p, F);
}
template <int PH> __global__ void __launch_bounds__(NTHREADS, 2) phase_kernel(Params p) {
    extern __shared__ __attribute__((aligned(16))) unsigned char lds_raw[];
    run_phase_fresh<PH>(lds_raw);
}
template <int PH> DI void run_all(unsigned char* lds_raw, cg::grid_group& grid, const XcdBarrier& bar) {
    if constexpr (PH < NPHASE) {
        if constexpr (PH == PROBE_PH) {
            if constexpr (PH == 12 || PH == 24 || PH == 13 || PH == 25) {
#if defined(__HIP_DEVICE_COMPILE__)
                const __attribute__((address_space(4))) unsigned long long* pp = (const __attribute__((address_space(4))) unsigned long long*)__builtin_amdgcn_kernarg_segment_ptr();
                asm volatile("" : "+s"(pp));
                Params p;
#pragma unroll
                for (int i = 0; i < N_IN; ++i) p.in[i] = (const float*)(const __attribute__((address_space(1))) float*)pp[i];
                p.out = (float*)(__attribute__((address_space(1))) float*)pp[N_IN]; p.ws = (unsigned char*)(__attribute__((address_space(1))) unsigned char*)pp[N_IN + 1]; p.ph_lo = 0; p.ph_hi = 0;
                const Frame F = make_frame(lds_raw);
                if constexpr (PH == 12 || PH == 24) phase_peer_c(p, F, PH == 12 ? 0 : 1, true); else phase_peer_v(p, F, PH == 13 ? 0 : 1, true);
#endif
            } else run_phase_fresh<PH>(lds_raw);
            xcd_barrier(bar);
        }
        run_phase_fresh<PH>(lds_raw);
        if constexpr (PH + 1 < NPHASE) { xcd_barrier(bar); if constexpr (PROBE_SYNC) xcd_barrier(bar); }
        run_all<PH + 1>(lds_raw, grid, bar);
    }
}
__global__ void __launch_bounds__(NTHREADS, 2) mega(Params p) {
    extern __shared__ __attribute__((aligned(16))) unsigned char lds_raw[];
    cg::grid_group grid = cg::this_grid();
    volatile LAS unsigned* st = (volatile LAS unsigned*)((LAS unsigned char*)lds_raw + LDS_BAR_OFF);
    if (threadIdx.x < 2) st[threadIdx.x] = 0u;
    __syncthreads();
    const XcdBarrier bar = xcd_barrier_post((unsigned*)(p.ws + WS_CTL), st);
    if (p.ph_lo != 0) grid.sync();
    run_all<0>(lds_raw, grid, bar);
}

extern "C" void kernel_launch(void* const* d_in, const int* in_sizes, int n_in, void* d_out, int out_size, void* d_ws, size_t ws_size, hipStream_t stream) {
    static int grid = 0;
    if (grid == 0) {
        if (n_in != 23 || out_size != TL * D || ws_size < WS_END) { fprintf(stderr, "kernel_launch: unexpected shapes (n_in %d out %d ws %zu)\n", n_in, out_size, ws_size); grid = -1; return; }
        int dev = 0, cus = 0, per_cu = 0;
        (void)hipGetDevice(&dev);
        (void)hipDeviceGetAttribute(&cus, hipDeviceAttributeMultiprocessorCount, dev);
        (void)hipFuncSetAttribute((const void*)mega, hipFuncAttributeMaxDynamicSharedMemorySize, LDS_BYTES);
        (void)hipOccupancyMaxActiveBlocksPerMultiprocessor(&per_cu, (const void*)mega, NTHREADS, LDS_BYTES);
        if (per_cu < 1) { fprintf(stderr, "kernel_launch: occupancy query reports %d blocks per CU\n", per_cu); grid = -1; return; }
        grid = cus & ~7;
        if (grid < 8) { fprintf(stderr, "kernel_launch: needs at least 8 CUs\n"); grid = -1; return; }
    }
    if (grid < 0) return;
    (void)hipMemsetAsync((char*)d_ws + WS_CTL, 0, CTL_ZERO_BYTES, stream);
    Params p{};
    for (int i = 0; i < N_IN; ++i) p.in[i] = (const float*)d_in[i];
    p.out = (float*)d_out; p.ws = (unsigned char*)d_ws;
    void* args[] = {&p};
    hipError_t e = hipLaunchCooperativeKernel((const void*)mega, dim3(grid), dim3(NTHREADS), args, LDS_BYTES, stream);
    if (e != hipSuccess) fprintf(stderr, "cooperative launch failed: %s (grid %d)\n", hipGetErrorString(e), grid);
}
```
